# Optimizing an MI355X kernel written in HIP

```python
import math
import jax, jax.numpy as jnp
from jax import lax
import numpy as np

D_MODEL = 2048
BATCH = 2
SEQ = 4096
DEPTH = 1

CHUNK = 64
Q_BLOCK = 128
HEAD_DIM = 128
N_FOX_HEADS = 8
N_SB_HEADS = 8
D_FOX = N_FOX_HEADS * HEAD_DIM
D_SB = N_SB_HEADS * HEAD_DIM
D_MIX = D_FOX + D_SB
D_IN = 4 * D_FOX + 3 * D_SB + N_FOX_HEADS
N_KEYS = 128
N_EXPERTS = N_KEYS * N_KEYS
PEER_HEADS = 8
PEER_TOPK = 16
PEER_DKEY = 256
PEER_HALF = PEER_DKEY // 2
PEER_TOK_BLOCK = 128
EPS = 1e-6

kernel_name = "fox_stickbreak_peer_hybrid_block"


def rmsnorm(x, g):
    xf = x.astype(jnp.float32)
    r = lax.rsqrt(jnp.mean(xf * xf, axis=-1, keepdims=True) + EPS)
    return (xf * r).astype(x.dtype) * g


def fox_block(q_blk, k_ctx, v_ctx, c_q, c_k, t0):
    logits = jnp.einsum('bhqd,bhkd->bhqk', q_blk, k_ctx,
                        preferred_element_type=jnp.float32) * (HEAD_DIM ** -0.5)
    logits = logits + c_q[..., :, None] - c_k[..., None, :]
    tq = t0 + jnp.arange(q_blk.shape[2])
    tk = jnp.arange(k_ctx.shape[2])
    mask = tk[None, :] <= tq[:, None]
    logits = jnp.where(mask, logits, -jnp.inf)
    p = jax.nn.softmax(logits, axis=-1)
    return jnp.einsum('bhqk,bhkd->bhqd', p.astype(v_ctx.dtype), v_ctx)


def stick_breaking_block(q_blk, k_ctx, v_ctx, t0):
    z = jnp.einsum('bhqd,bhkd->bhqk', q_blk, k_ctx,
                   preferred_element_type=jnp.float32) * (HEAD_DIM ** -0.5)
    tq = t0 + jnp.arange(q_blk.shape[2])
    tk = jnp.arange(k_ctx.shape[2])
    mask = tk[None, :] < tq[:, None]
    log_beta = jax.nn.log_sigmoid(z)
    log_1mb = jnp.where(mask, jax.nn.log_sigmoid(-z), 0.0)
    suffix = lax.cumsum(log_1mb, axis=3, reverse=True) - log_1mb
    a = jnp.where(mask, jnp.exp(log_beta + suffix), 0.0)
    return jnp.einsum('bhqk,bhkd->bhqd', a.astype(v_ctx.dtype), v_ctx)


def hybrid_mixer(xn, w_in, b_forget, q_norm_g, k_norm_g, w_out):
    B, S, _ = xn.shape
    proj = xn @ w_in

    def heads(t, n_heads):
        return t.reshape(B, S, n_heads, HEAD_DIM).transpose(0, 2, 1, 3)

    o = 0
    q_f = rmsnorm(heads(proj[..., o:o + D_FOX], N_FOX_HEADS), q_norm_g); o += D_FOX
    k_f = rmsnorm(heads(proj[..., o:o + D_FOX], N_FOX_HEADS), k_norm_g); o += D_FOX
    v_f = heads(proj[..., o:o + D_FOX], N_FOX_HEADS); o += D_FOX
    gate_f = jax.nn.sigmoid(proj[..., o:o + D_FOX]); o += D_FOX
    q_s = heads(proj[..., o:o + D_SB], N_SB_HEADS); o += D_SB
    k_s = heads(proj[..., o:o + D_SB], N_SB_HEADS); o += D_SB
    v_s = heads(proj[..., o:o + D_SB], N_SB_HEADS); o += D_SB
    f_logit = proj[..., o:o + N_FOX_HEADS].astype(jnp.float32) + b_forget
    log_f = jax.nn.log_sigmoid(f_logit)
    c = jnp.cumsum(log_f, axis=1).transpose(0, 2, 1)

    fox_out, sb_out = [], []
    for i in range(S // Q_BLOCK):
        t0 = i * Q_BLOCK
        end = t0 + Q_BLOCK
        fox_out.append(fox_block(q_f[:, :, t0:end], k_f[:, :, :end], v_f[:, :, :end],
                                 c[:, :, t0:end], c[:, :, :end], t0))
        sb_out.append(stick_breaking_block(q_s[:, :, t0:end], k_s[:, :, :end],
                                           v_s[:, :, :end], t0))
    fox = jnp.concatenate(fox_out, axis=2).transpose(0, 2, 1, 3).reshape(B, S, D_FOX)
    sb = jnp.concatenate(sb_out, axis=2).transpose(0, 2, 1, 3).reshape(B, S, D_SB)
    mixed = jnp.concatenate([fox * gate_f, sb], axis=-1)
    return mixed @ w_out


def peer_ffn(xn, w_pq, sub_keys, u, v):
    B, S, D = xn.shape
    T = B * S
    xt = xn.reshape(T, D)
    q = (xt @ w_pq).reshape(T, PEER_HEADS, 2, PEER_HALF)
    s = jnp.einsum('thcd,hcnd->thcn', q, sub_keys,
                   preferred_element_type=jnp.float32)
    s1, i1 = lax.top_k(s[:, :, 0], PEER_TOPK)
    s2, i2 = lax.top_k(s[:, :, 1], PEER_TOPK)
    cand = (s1[..., :, None] + s2[..., None, :]).reshape(T, PEER_HEADS, PEER_TOPK * PEER_TOPK)
    cidx = (i1[..., :, None] * N_KEYS + i2[..., None, :]).reshape(T, PEER_HEADS, PEER_TOPK * PEER_TOPK)
    top_s, pos = lax.top_k(cand, PEER_TOPK)
    idx = jnp.take_along_axis(cidx, pos, axis=-1)
    g = jax.nn.softmax(top_s, axis=-1).astype(xn.dtype)
    n_blk = T // PEER_TOK_BLOCK
    E = PEER_HEADS * PEER_TOPK

    def block(args):
        xb, ib, gb = args
        ub = u[ib]
        h = jax.nn.gelu(jnp.einsum('ted,td->te', ub, xb), approximate=False)
        vb = v[ib]
        return jnp.einsum('te,ted->td', gb * h, vb)

    out = lax.map(block, (xt.reshape(n_blk, PEER_TOK_BLOCK, D),
                          idx.reshape(n_blk, PEER_TOK_BLOCK, E),
                          g.reshape(n_blk, PEER_TOK_BLOCK, E)))
    return out.reshape(B, S, D)


def setup_inputs(seed: int = 0) -> dict:
    key = jax.random.key(seed)
    ks = jax.random.split(key, 14)
    f32 = jnp.float32
    nrm = lambda k, shape, scale: jax.random.normal(k, shape, f32) * scale
    return {
        "x": jax.random.normal(ks[0], (BATCH, SEQ, D_MODEL), f32),
        "attn_norm_g": 1.0 + nrm(ks[1], (DEPTH, D_MODEL), 0.02),
        "w_in": nrm(ks[2], (DEPTH, D_MODEL, D_IN), D_MODEL ** -0.5),
        "b_forget": 3.0 + nrm(ks[3], (DEPTH, N_FOX_HEADS), 0.5),
        "q_norm_g": 1.0 + nrm(ks[4], (DEPTH, HEAD_DIM), 0.02),
        "k_norm_g": 1.0 + nrm(ks[5], (DEPTH, HEAD_DIM), 0.02),
        "w_out": nrm(ks[6], (DEPTH, D_MIX, D_MODEL), D_MIX ** -0.5),
        "ffn_norm_g": 1.0 + nrm(ks[7], (DEPTH, D_MODEL), 0.02),
        "w_peer_q": nrm(ks[8], (DEPTH, D_MODEL, PEER_HEADS * PEER_DKEY), D_MODEL ** -0.5),
        "peer_sub_keys": nrm(ks[9], (DEPTH, PEER_HEADS, 2, N_KEYS, PEER_HALF), PEER_HALF ** -0.5),
        "peer_u": nrm(ks[10], (DEPTH, N_EXPERTS, D_MODEL), D_MODEL ** -0.5),
        "peer_v": nrm(ks[11], (DEPTH, N_EXPERTS, D_MODEL), PEER_HEADS ** -0.5),
    }


def reference(x, attn_norm_g, w_in, b_forget, q_norm_g, k_norm_g, w_out,
              ffn_norm_g, w_peer_q, peer_sub_keys, peer_u, peer_v):
    h = x
    for l in range(DEPTH):
        xn = rmsnorm(h, attn_norm_g[l])
        h = h + hybrid_mixer(xn, w_in[l], b_forget[l], q_norm_g[l], k_norm_g[l], w_out[l])
        hn = rmsnorm(h, ffn_norm_g[l])
        h = h + peer_ffn(hn, w_peer_q[l], peer_sub_keys[l], peer_u[l], peer_v[l])
    return h
```

```cpp
#include <hip/hip_runtime.h>
#include <hip/hip_cooperative_groups.h>
#include <cstdio>
#include <cstdint>
namespace cg = cooperative_groups;

#define PEER_REF 1
#ifndef MK_ONE_LAUNCH
#define MK_ONE_LAUNCH 1
#endif

#define LAS __attribute__((address_space(3)))
typedef unsigned short bf16_t;
typedef short bf16x8 __attribute__((ext_vector_type(8)));
typedef short s16x4 __attribute__((ext_vector_type(4)));
typedef float f32x2 __attribute__((ext_vector_type(2)));
typedef float f32x4 __attribute__((ext_vector_type(4)));
typedef float f32x16 __attribute__((ext_vector_type(16)));
typedef unsigned u32x2 __attribute__((ext_vector_type(2)));
typedef unsigned u32x4 __attribute__((ext_vector_type(4)));
typedef __bf16 bf16x2_t __attribute__((ext_vector_type(2)));

constexpr int NB = 2, SEQ = 4096, T = NB * SEQ, DM = 2048, HD = 128, NHF = 8, DIN = 7176, NPROJ = 7168;
constexpr int NEXP = 16384, NE = 128;
constexpr float EPS = 1e-6f;
constexpr float SCALE = 0.08838834764831845f, LOG2E = 1.4426950408889634f;
constexpr int NWAVES = 8, NTHREADS = 512;

constexpr size_t MiB = 1u << 20;
constexpr size_t WS_CTL = 0, CTL_BYTES = 4096;
constexpr size_t WS_WIN = 1 * MiB, WS_WOUT = 29 * MiB, WS_WPQ = 37 * MiB, WS_SK = 45 * MiB, WS_LOGF = 46 * MiB, WS_C = 46 * MiB + 512 * 1024, WS_SSQ = 47 * MiB;
constexpr size_t WS_XN = 48 * MiB;
constexpr size_t WS_SEC = 80 * MiB;
constexpr size_t SEC_ELEMS = 8u << 20;
constexpr size_t WS_MIX = 192 * MiB, WS_HB = 224 * MiB, WS_QP = 256 * MiB, WS_IDX = 288 * MiB, WS_GW = 292 * MiB, WS_UB = 296 * MiB, WS_VB = 360 * MiB, WS_END = 424 * MiB;

constexpr int RING_BYTES = 131072;
constexpr int MISC_OFF = 143360;
constexpr int LDS_BYTES = 147456;

__device__ __forceinline__ unsigned cvt_pk_bf16(float lo, float hi) { unsigned r; asm volatile("v_cvt_pk_bf16_f32 %0, %1, %2" : "=v"(r) : "v"(lo), "v"(hi)); return r; }
__device__ __forceinline__ float bf_lo(unsigned u) { return __builtin_bit_cast(float, u << 16); }
__device__ __forceinline__ float bf_hi(unsigned u) { return __builtin_bit_cast(float, u & 0xffff0000u); }
__device__ __forceinline__ float wave_sum(float v) {
#pragma unroll
    for (int o = 1; o < 64; o <<= 1) v += __shfl_xor(v, o);
    return v;
}
#define LDS_WAIT() asm volatile("s_waitcnt lgkmcnt(0)" ::: "memory")

namespace pg8 {
#define PG8_LAS __attribute__((address_space(3)))
constexpr int BM = 256, BK = 64, HALF = 128, HTB = HALF * BK * 2, STAGE_BYTES = 8 * HTB, NXCD = 8, WGM = 8;
__host__ __device__ __forceinline__ int lds_byte(int r, int c) { const int st = (r >> 4) * 2 + (c >> 5), rr = r & 15, cc = c & 31, ob = rr * 64 + cc * 2; return st * 1024 + (ob ^ (((ob >> 9) & 1) << 5)); }
__host__ __device__ __forceinline__ void stage_rc(int b, int& R, int& C) { const int st = b / 1024, sb = b % 1024, swz = sb ^ (((sb >> 9) & 1) << 5); R = (st >> 1) * 16 + swz / 64; C = (st & 1) * 32 + (swz % 64) / 2; }
__host__ __device__ __forceinline__ int perm32(int rho) { const int n = rho >> 4, i = rho & 15; return 8 * (i >> 2) + 4 * n + (i & 3); }
struct Unit { int pm, pn; };
struct Gemm { const bf16_t* A; const bf16_t* Bt; int M, N, K; };
struct StaticOrder {
    int nM, nN, nwg, G, c;
    __host__ __device__ void init(int M, int N, int G_, int c_) { nM = M / BM; nN = N / BM; nwg = nM * nN; G = G_; c = c_; }
    __host__ __device__ bool next(int i, Unit& u) const {
        const long L = (long)i * G + c; if (L >= nwg) return false;
        int wgid = (int)L; { const int q = nwg / NXCD, r = nwg % NXCD, xcd = wgid % NXCD, off = wgid / NXCD; wgid = (xcd < r ? xcd * (q + 1) : r * (q + 1) + (xcd - r) * q) + off; }
        const int nig = WGM * nN, gid = wgid / nig, fm = gid * WGM, gsz = (nM - fm) < WGM ? (nM - fm) : WGM;
        u.pm = fm + ((wgid % nig) % gsz); u.pn = (wgid % nig) / gsz; return true;
    }
    __device__ __forceinline__ void a_ready(const Unit&) const {}
    __device__ __forceinline__ void done(const Unit&) const {}
};

template <class Epi, class Sched, bool ALIGN_EPI = false, bool SP2 = false>
__device__ __forceinline__ void gemm_phase(PG8_LAS unsigned char* lds, const Gemm g, const Sched& S, const Epi& E) {
    const int tid = threadIdx.x, wid = __builtin_amdgcn_readfirstlane(tid >> 6), lane = tid & 63, wr = wid >> 2, wc = wid & 3, fr = lane & 15, fq = lane >> 4;
    const int K = g.K, nt = K / BK;
    unsigned voffA[2], voffB[2];
#pragma unroll
    for (int i = 0; i < 2; ++i) { int R, C; stage_rc(tid * 16 + i * 8192, R, C); const int Rb = Epi::PERM ? ((R & ~31) + perm32(R & 31)) : R;
        voffA[i] = (unsigned)(R * K + C) * 2u; voffB[i] = (unsigned)(Rb * K + C) * 2u; }
    const size_t kstep = (size_t)(BK * 2);
    const size_t hstep = (size_t)HALF * K * 2;
    const size_t tstep = 2 * hstep;
    const unsigned ldsw = (unsigned)wid * 1024u;
    const int aoff = lds_byte(wr * 64 + fr, fq * 8), boff = lds_byte(wc * 32 + fr, fq * 8);
#define PG8_SA(b, h) (((b) * 2 + (h)) * HTB)
#define PG8_SB(b, h) ((4 + (b) * 2 + (h)) * HTB)
#define PG8_STAGE(bufoff, gbase, voff) do { _Pragma("unroll") for (int _i = 0; _i < 2; ++_i) \
        __builtin_amdgcn_global_load_lds((const unsigned*)((const char*)(gbase) + (voff)[_i]), (PG8_LAS unsigned*)(lds + (bufoff) + ldsw + _i * 8192), 16, 0, 0); } while (0)
#define PG8_LDA(dst, b, h) do { _Pragma("unroll") for (int m = 0; m < 4; ++m) _Pragma("unroll") for (int k = 0; k < 2; ++k) dst[m][k] = *(const PG8_LAS bf16x8*)(lds + PG8_SA(b, h) + aoff + m * 2048 + k * 1024); } while (0)
#define PG8_LDB(dst, b, h) do { _Pragma("unroll") for (int n = 0; n < 2; ++n) _Pragma("unroll") for (int k = 0; k < 2; ++k) dst[n][k] = *(const PG8_LAS bf16x8*)(lds + PG8_SB(b, h) + boff + n * 2048 + k * 1024); } while (0)
#define PG8_MMA(ai, bj, At, Bt) do { __builtin_amdgcn_s_setprio(1); _Pragma("unroll") for (int m = 0; m < 4; ++m) _Pragma("unroll") for (int n = 0; n < 2; ++n) _Pragma("unroll") for (int k = 0; k < 2; ++k) \
        acc[ai][bj][m][n] = __builtin_amdgcn_mfma_f32_16x16x32_bf16(Bt[n][k], At[m][k], acc[ai][bj][m][n], 0, 0, 0); __builtin_amdgcn_s_setprio(0); } while (0)
#define PG8_WAIT_V(n) asm volatile("s_waitcnt vmcnt(" #n ")" ::: "memory")
#define PG8_WAIT_L(n) asm volatile("s_waitcnt lgkmcnt(" #n ")" ::: "memory")
#define PG8_BAR __builtin_amdgcn_s_barrier()
#define PG8_SCHED __builtin_amdgcn_sched_barrier(0)
    Unit cur, nxt; int ui = 0;
    if (!S.next(0, cur)) return;
    f32x4 acc[2][2][4][2];
#pragma unroll
    for (int a = 0; a < 2; ++a)
#pragma unroll
        for (int b = 0; b < 2; ++b)
#pragma unroll
            for (int m = 0; m < 4; ++m)
#pragma unroll
                for (int n = 0; n < 2; ++n) acc[a][b][m][n] = (f32x4){0.f, 0.f, 0.f, 0.f};
    bf16x8 At[4][2], B0[2][2], B1[2][2];
    const char* cA = (const char*)g.A + (size_t)cur.pm * tstep; const char* cB = (const char*)g.Bt + (size_t)cur.pn * tstep;
    S.a_ready(cur);
    if constexpr (SP2) {
        PG8_STAGE(PG8_SB(0, 0), cB, voffB); PG8_STAGE(PG8_SB(0, 1), cB + hstep, voffB); PG8_STAGE(PG8_SA(0, 0), cA, voffA); PG8_STAGE(PG8_SA(0, 1), cA + hstep, voffA);
        if (wr == 1) PG8_BAR;
        PG8_WAIT_V(2); PG8_BAR;
        PG8_STAGE(PG8_SB(1, 0), cB + kstep, voffB); PG8_STAGE(PG8_SA(1, 0), cA + kstep, voffA); PG8_STAGE(PG8_SB(1, 1), cB + hstep + kstep, voffB);
        PG8_WAIT_V(6); PG8_BAR;
    } else {
        PG8_STAGE(PG8_SB(0, 0), cB, voffB); PG8_STAGE(PG8_SA(0, 0), cA, voffA); PG8_STAGE(PG8_SB(0, 1), cB + hstep, voffB); PG8_STAGE(PG8_SA(0, 1), cA + hstep, voffA);
        if (wr == 1) PG8_BAR;
        PG8_WAIT_V(4); PG8_BAR;
        PG8_STAGE(PG8_SB(1, 0), cB + kstep, voffB); PG8_STAGE(PG8_SA(1, 0), cA + kstep, voffA); PG8_STAGE(PG8_SB(1, 1), cB + hstep + kstep, voffB);
        PG8_WAIT_V(6); PG8_BAR;
    }
    for (;;) {
        const bool has_next = S.next(ui + 1, nxt);
        const char* nA = has_next ? (const char*)g.A + (size_t)nxt.pm * tstep : cA; const char* nB = has_next ? (const char*)g.Bt + (size_t)nxt.pn * tstep : cB;
        for (int t = 0; t < nt; t += 2) {
            const bool last = (t == nt - 2);
            const char* a1 = cA + (size_t)(t + 1) * kstep;
            const char* a2 = last ? nA : cA + (size_t)(t + 2) * kstep; const char* b2 = last ? nB : cB + (size_t)(t + 2) * kstep;
            const char* a3 = a2 + kstep; const char* b3 = b2 + kstep;
            if (last && has_next) S.a_ready(nxt);
            if constexpr (SP2) {
            PG8_LDB(B0, 0, 0); PG8_LDB(B1, 0, 1); PG8_SCHED; PG8_LDA(At, 0, 0); PG8_STAGE(PG8_SA(1, 1), a1 + hstep, voffA);
            PG8_WAIT_V(8); PG8_WAIT_L(0); PG8_BAR; PG8_MMA(0, 0, At, B0); PG8_MMA(0, 1, At, B1); PG8_BAR; PG8_SCHED;
            PG8_LDA(At, 0, 1); PG8_STAGE(PG8_SB(0, 0), b2, voffB); PG8_STAGE(PG8_SB(0, 1), b2 + hstep, voffB); PG8_STAGE(PG8_SA(0, 0), a2, voffA);
            PG8_WAIT_V(8); PG8_WAIT_L(0); PG8_BAR; PG8_MMA(1, 0, At, B0); PG8_MMA(1, 1, At, B1); PG8_BAR; PG8_SCHED;
            PG8_LDB(B0, 1, 0); PG8_LDB(B1, 1, 1); PG8_SCHED; PG8_LDA(At, 1, 0); PG8_STAGE(PG8_SA(0, 1), a2 + hstep, voffA);
            PG8_WAIT_V(8); PG8_WAIT_L(0); PG8_BAR; PG8_MMA(0, 0, At, B0); PG8_MMA(0, 1, At, B1); PG8_BAR; PG8_SCHED;
            PG8_LDA(At, 1, 1); PG8_STAGE(PG8_SB(1, 0), b3, voffB); PG8_STAGE(PG8_SB(1, 1), b3 + hstep, voffB); PG8_STAGE(PG8_SA(1, 0), a3, voffA);
            PG8_WAIT_V(8); PG8_WAIT_L(0); PG8_BAR; PG8_MMA(1, 0, At, B0); PG8_MMA(1, 1, At, B1); PG8_BAR; PG8_SCHED;
            } else {
            PG8_LDB(B0, 0, 0); PG8_SCHED; PG8_LDA(At, 0, 0); PG8_STAGE(PG8_SA(1, 1), a1 + hstep, voffA);
            PG8_WAIT_L(8); PG8_BAR; PG8_WAIT_L(0); PG8_MMA(0, 0, At, B0); PG8_BAR; PG8_SCHED;
            PG8_LDB(B1, 0, 1); PG8_STAGE(PG8_SB(0, 0), b2, voffB);
            PG8_BAR; PG8_WAIT_L(0); PG8_MMA(0, 1, At, B1); PG8_BAR;
            PG8_LDA(At, 0, 1); PG8_STAGE(PG8_SA(0, 0), a2, voffA);
            PG8_BAR; PG8_WAIT_L(0); PG8_MMA(1, 0, At, B0); PG8_BAR; PG8_SCHED;
            PG8_STAGE(PG8_SB(0, 1), b2 + hstep, voffB);
            PG8_WAIT_V(6); PG8_BAR; PG8_MMA(1, 1, At, B1); PG8_BAR;
            PG8_LDB(B0, 1, 0); PG8_SCHED; PG8_LDA(At, 1, 0); PG8_STAGE(PG8_SA(0, 1), a2 + hstep, voffA);
            PG8_WAIT_L(8); PG8_BAR; PG8_WAIT_L(0); PG8_MMA(0, 0, At, B0); PG8_BAR; PG8_SCHED;
            PG8_LDB(B1, 1, 1); PG8_STAGE(PG8_SB(1, 0), b3, voffB);
            PG8_BAR; PG8_WAIT_L(0); PG8_MMA(0, 1, At, B1); PG8_BAR;
            PG8_LDA(At, 1, 1); PG8_STAGE(PG8_SA(1, 0), a3, voffA);
            PG8_BAR; PG8_WAIT_L(0); PG8_MMA(1, 0, At, B0); PG8_BAR; PG8_SCHED;
            PG8_STAGE(PG8_SB(1, 1), b3 + hstep, voffB);
            PG8_WAIT_V(6); PG8_BAR; PG8_MMA(1, 1, At, B1); PG8_BAR;
            }
        }
        if constexpr (ALIGN_EPI) { if (wr == 0) PG8_BAR; }
        E(acc, cur, wr, wc, fr, fq); S.done(cur);
        if (!has_next) break;
#pragma unroll
        for (int a = 0; a < 2; ++a)
#pragma unroll
            for (int b = 0; b < 2; ++b)
#pragma unroll
                for (int m = 0; m < 4; ++m)
#pragma unroll
                    for (int n = 0; n < 2; ++n) acc[a][b][m][n] = (f32x4){0.f, 0.f, 0.f, 0.f};
        cur = nxt; cA = nA; cB = nB; ++ui;
        if constexpr (ALIGN_EPI) { if (wr == 1) PG8_BAR; }
    }
    PG8_WAIT_V(0);
    if constexpr (!ALIGN_EPI) { if (wr == 0) PG8_BAR; }
    PG8_BAR;
#undef PG8_SA
#undef PG8_SB
#undef PG8_STAGE
#undef PG8_LDA
#undef PG8_LDB
#undef PG8_MMA
#undef PG8_WAIT_V
#undef PG8_WAIT_L
#undef PG8_BAR
#undef PG8_SCHED
}

__device__ __forceinline__ float sigmoidf_fast(float x) { return __builtin_amdgcn_rcpf(1.f + __builtin_amdgcn_exp2f(-x * LOG2E)); }
struct EpiInProj {
    static constexpr bool PERM = true;
    bf16_t* base;
    __device__ __forceinline__ void operator()(const f32x4 (&acc)[2][2][4][2], const Unit& u, int wr, int wc, int fr, int fq) const {
        const int sec = u.pn >> 2;
        bf16_t* sb = base + (size_t)sec * SEC_ELEMS;
        const float sc = (sec == 4) ? SCALE * LOG2E : 1.f;
#pragma unroll
        for (int ai = 0; ai < 2; ++ai)
#pragma unroll
            for (int m = 0; m < 4; ++m) {
                const int tk = u.pm * BM + ai * HALF + wr * 64 + m * 16 + fr, b = tk >> 12, s = tk & 4095;
#pragma unroll
                for (int bj = 0; bj < 2; ++bj) {
                    const int hh = (u.pn & 3) * 2 + bj;
                    f32x4 v0 = acc[ai][bj][m][0], v1 = acc[ai][bj][m][1];
                    bf16_t* dst;
                    if (sec == 3) {
#pragma unroll
                        for (int i = 0; i < 4; ++i) { v0[i] = sigmoidf_fast(v0[i]); v1[i] = sigmoidf_fast(v1[i]); }
                        dst = sb + (size_t)tk * 1024 + hh * 128 + wc * 32 + 8 * fq;
                    } else {
                        v0 = v0 * sc; v1 = v1 * sc;
                        dst = sb + ((size_t)((b * 8 + hh) * 4096 + s)) * 128 + wc * 32 + 8 * fq;
                    }
                    u32x4 w; w.x = cvt_pk_bf16(v0[0], v0[1]); w.y = cvt_pk_bf16(v0[2], v0[3]); w.z = cvt_pk_bf16(v1[0], v1[1]); w.w = cvt_pk_bf16(v1[2], v1[3]);
                    *(u32x4*)dst = w;
                }
            }
    }
};
struct EpiOutProj {
    static constexpr bool PERM = true;
    const float* x; float* h; bf16_t* hb; float* ssq;
    __device__ __forceinline__ void operator()(const f32x4 (&acc)[2][2][4][2], const Unit& u, int wr, int wc, int fr, int fq) const {
#pragma unroll
        for (int ai = 0; ai < 2; ++ai)
#pragma unroll
            for (int m = 0; m < 4; ++m) {
                const int tk = u.pm * BM + ai * HALF + wr * 64 + m * 16 + fr;
                float ss = 0.f;
#pragma unroll
                for (int bj = 0; bj < 2; ++bj) {
                    const size_t off = (size_t)tk * DM + u.pn * BM + bj * HALF + wc * 32 + 8 * fq;
                    const f32x4 x0 = *(const f32x4*)(x + off), x1 = *(const f32x4*)(x + off + 4);
                    const f32x4 v0 = acc[ai][bj][m][0] + x0, v1 = acc[ai][bj][m][1] + x1;
                    *(f32x4*)(h + off) = v0; *(f32x4*)(h + off + 4) = v1;
                    u32x4 w; w.x = cvt_pk_bf16(v0[0], v0[1]); w.y = cvt_pk_bf16(v0[2], v0[3]); w.z = cvt_pk_bf16(v1[0], v1[1]); w.w = cvt_pk_bf16(v1[2], v1[3]);
                    *(u32x4*)(hb + off) = w;
                    ss += v0[0] * v0[0] + v0[1] * v0[1] + v0[2] * v0[2] + v0[3] * v0[3] + v1[0] * v1[0] + v1[1] * v1[1] + v1[2] * v1[2] + v1[3] * v1[3];
                }
                ss += __shfl_xor(ss, 16); ss += __shfl_xor(ss, 32);
                if (fq == 0) ssq[(size_t)tk * 32 + u.pn * 4 + wc] = ss;
            }
    }
};
struct EpiPeerQ {
    static constexpr bool PERM = true;
    const float* ssq; bf16_t* qp;
    __device__ __forceinline__ void operator()(const f32x4 (&acc)[2][2][4][2], const Unit& u, int wr, int wc, int fr, int fq) const {
#pragma unroll
        for (int ai = 0; ai < 2; ++ai)
#pragma unroll
            for (int m = 0; m < 4; ++m) {
                const int tk = u.pm * BM + ai * HALF + wr * 64 + m * 16 + fr;
                float tot = 0.f;
#pragma unroll
                for (int i = 0; i < 8; ++i) { const f32x4 s4 = *(const f32x4*)(ssq + (size_t)tk * 32 + 4 * i); tot += (s4[0] + s4[1]) + (s4[2] + s4[3]); }
                const float r = 1.0f / sqrtf(tot * (1.f / DM) + EPS);
#pragma unroll
                for (int bj = 0; bj < 2; ++bj) {
                    const size_t off = (size_t)tk * DM + u.pn * BM + bj * HALF + wc * 32 + 8 * fq;
                    const f32x4 v0 = acc[ai][bj][m][0] * r, v1 = acc[ai][bj][m][1] * r;
                    u32x4 w; w.x = cvt_pk_bf16(v0[0], v0[1]); w.y = cvt_pk_bf16(v0[2], v0[3]); w.z = cvt_pk_bf16(v1[0], v1[1]); w.w = cvt_pk_bf16(v1[2], v1[3]);
                    *(u32x4*)(qp + off) = w;
                }
            }
    }
};
}

namespace att {
constexpr int NW = 8, QBLK = 32, KVBLK = 64, QB = NW * QBLK, D = 128;
constexpr int SHM_V = KVBLK * D * 2, SHM_K = KVBLK * D * 2;
constexpr int OFF_WS = 2 * SHM_V + 2 * SHM_K, OFF_BIAS = OFF_WS + NW * 64 * 4, ATT_LDS = OFF_BIAS + SEQ * 4;
#define KSWZ(row, colB) ((row) * 256 + ((colB) ^ (((row) & 7) << 4)))
#define SBAR() __builtin_amdgcn_sched_barrier(0)
__device__ __forceinline__ int v_st(int k, int c) { const int kk = (k & ~0xC) | ((k & 4) << 1) | ((k & 8) >> 1); return ((kk >> 3) * 4 + (c >> 5)) * 512 + ((kk & 7) * 32 + (c & 31)) * 2; }
__device__ __forceinline__ int v_rd_base(int lane) { return ((lane & 3) << 3) | (((lane >> 2) & 3) << 6) | (((lane >> 4) & 1) << 5) | (((lane >> 5) & 1) << 8); }
constexpr int v_rd_off(int d0, int ks, int half) { return d0 * 512 + ks * 4096 + half * 2048; }
__device__ __forceinline__ int crow(int r, int hi) { return (r & 3) + 8 * (r >> 2) + 4 * hi; }
__device__ __forceinline__ bf16x8 load8(const bf16_t* p) { return *reinterpret_cast<const bf16x8*>(p); }
__device__ __forceinline__ void mask_tile(f32x16& p0, f32x16& p1, int dq) {
    const float NEG = -__builtin_inff();
#pragma unroll
    for (int r = 0; r < 16; ++r) {
        const int c = (r & 3) + 8 * (r >> 2);
        if (dq - c < 0) p0[r] = NEG;
        if (dq - c - 32 < 0) p1[r] = NEG;
    }
}
__device__ __forceinline__ void partialSM(f32x16& p0, f32x16& p1, float& m_reg, float& mn, float& alpha) {
    float pmax = p0[0];
#pragma unroll
    for (int r = 1; r < 16; ++r) pmax = fmaxf(pmax, p0[r]);
#pragma unroll
    for (int r = 0; r < 16; ++r) pmax = fmaxf(pmax, p1[r]);
    { auto rr = __builtin_amdgcn_permlane32_swap(__float_as_uint(pmax), __float_as_uint(pmax), false, false);
      pmax = fmaxf(__uint_as_float(rr[0]), __uint_as_float(rr[1])); }
    constexpr float C2 = LOG2E * SCALE; constexpr float THR = 8.f;
    if (__builtin_expect(__all((pmax - m_reg) * SCALE <= THR), 1)) { mn = m_reg; alpha = 1.f; }
    else { mn = fmaxf(m_reg, pmax); alpha = __builtin_amdgcn_exp2f((m_reg - mn) * C2); m_reg = mn; }
    const float mnL = -mn * C2;
#pragma unroll
    for (int r = 0; r < 16; ++r) p0[r] = fmaf(p0[r], C2, mnL);
#pragma unroll
    for (int r = 0; r < 16; ++r) p1[r] = fmaf(p1[r], C2, mnL);
#pragma unroll
    for (int r = 0; r < 16; ++r) p0[r] = __builtin_amdgcn_exp2f(p0[r]);
}
#define PK4(P, B_, OUT) do { unsigned a0 = cvt_pk_bf16(P[B_+0], P[B_+1]), a1 = cvt_pk_bf16(P[B_+2], P[B_+3]);                          \
        unsigned b0 = cvt_pk_bf16(P[B_+4], P[B_+5]), b1 = cvt_pk_bf16(P[B_+6], P[B_+7]);                                             \
        auto r0 = __builtin_amdgcn_permlane32_swap(a0, b0, false, false); auto r1 = __builtin_amdgcn_permlane32_swap(a1, b1, false, false); \
        u32x4 w = {r0[0], r1[0], r0[1], r1[1]}; OUT = *reinterpret_cast<bf16x8*>(&w); } while (0)
__device__ __forceinline__ void finishSM(f32x16& p0, f32x16& p1, float alpha, float& l_reg, bf16x8& pa0, bf16x8& pa1, bf16x8& pa2, bf16x8& pa3) {
#pragma unroll
    for (int r = 0; r < 16; ++r) p1[r] = __builtin_amdgcn_exp2f(p1[r]);
    float ps = 0;
#pragma unroll
    for (int r = 0; r < 16; ++r) ps += p0[r];
#pragma unroll
    for (int r = 0; r < 16; ++r) ps += p1[r];
    { auto rr = __builtin_amdgcn_permlane32_swap(__float_as_uint(ps), __float_as_uint(ps), false, false);
      ps = __uint_as_float(rr[0]) + __uint_as_float(rr[1]); }
    l_reg = l_reg * alpha + ps;
    PK4(p0, 0, pa0); PK4(p0, 8, pa1); PK4(p1, 0, pa2); PK4(p1, 8, pa3);
}
__device__ __forceinline__ void sb_group(f32x16& P, int g, float& gs) {
    float run = 0.f;
#pragma unroll
    for (int k = 3; k >= 0; --k) {
        const float z = P[4 * g + k];
        const float t = __builtin_amdgcn_exp2f(-fabsf(z));
        const float l = __builtin_amdgcn_logf(1.f + t);
        const float sp = fmaxf(z, 0.f) + l;
        P[4 * g + k] = (z - sp) - run;
        run += sp;
    }
    gs = run;
}
__device__ __forceinline__ void sb_part1(f32x16& p0, f32x16& p1, float& carry, float mlo) {
    float gs[8];
#pragma unroll
    for (int g = 0; g < 4; ++g) sb_group(p0, g, gs[g]);
#pragma unroll
    for (int g = 0; g < 4; ++g) sb_group(p1, g, gs[4 + g]);
    float run = carry;
#pragma unroll
    for (int G = 7; G >= 0; --G) {
        auto rr = __builtin_amdgcn_permlane32_swap(__float_as_uint(gs[G]), __float_as_uint(gs[G]), false, false);
        const float slo = __uint_as_float(rr[0]), shi = __uint_as_float(rr[1]);
        const float base = fmaf(mlo, shi, run);
        if (G >= 4) {
#pragma unroll
            for (int k = 0; k < 4; ++k) p1[4 * (G - 4) + k] -= base;
        } else {
#pragma unroll
            for (int k = 0; k < 4; ++k) p0[4 * G + k] -= base;
        }
        run += slo + shi;
    }
    carry = run;
#pragma unroll
    for (int r = 0; r < 16; ++r) p0[r] = __builtin_amdgcn_exp2f(p0[r]);
}
__device__ __forceinline__ void sb_part2(f32x16& p0, f32x16& p1, bf16x8& pa0, bf16x8& pa1, bf16x8& pa2, bf16x8& pa3) {
#pragma unroll
    for (int r = 0; r < 16; ++r) p1[r] = __builtin_amdgcn_exp2f(p1[r]);
    PK4(p0, 0, pa0); PK4(p0, 8, pa1); PK4(p1, 0, pa2); PK4(p1, 8, pa3);
}
#undef PK4
template <int KB, bool BIAS>
__device__ __forceinline__ void qkt(f32x16& p0, f32x16& p1, const char* K_lds, int r32, int hi, const bf16x8* qr, const float* bt) {
    if constexpr (BIAS) {
#pragma unroll
        for (int g = 0; g < 4; ++g) { const f32x4 a = *(const f32x4*)(bt + 8 * g), b = *(const f32x4*)(bt + 32 + 8 * g);
            p0[4 * g] = a[0]; p0[4 * g + 1] = a[1]; p0[4 * g + 2] = a[2]; p0[4 * g + 3] = a[3];
            p1[4 * g] = b[0]; p1[4 * g + 1] = b[1]; p1[4 * g + 2] = b[2]; p1[4 * g + 3] = b[3]; }
    } else { p0 = f32x16{}; p1 = f32x16{}; }
    const char* kb[4];
#pragma unroll
    for (int dd = 0; dd < 4; ++dd) kb[dd] = K_lds + KB * SHM_K + KSWZ(r32, (dd * 16 + hi * 8) * 2);
#pragma unroll
    for (int d0 = 0; d0 < 8; ++d0) { const char* a = kb[d0 & 3] + (d0 >> 2) * 128;
        bf16x8 b0 = *reinterpret_cast<const bf16x8*>(a);
        bf16x8 b1 = *reinterpret_cast<const bf16x8*>(a + 32 * 256);
        p0 = __builtin_amdgcn_mfma_f32_32x32x16_bf16(b0, qr[d0], p0, 0, 0, 0);
        p1 = __builtin_amdgcn_mfma_f32_32x32x16_bf16(b1, qr[d0], p1, 0, 0, 0); }
}
template <int VB>
__device__ __forceinline__ void pv_tile(f32x16* o, int vb0, bf16x8 pa0, bf16x8 pa1, bf16x8 pa2, bf16x8 pa3) {
#define TRRD(dst, off) asm volatile("ds_read_b64_tr_b16 %0, %1 offset:%2" : "=&v"(dst) : "v"(vb0), "i"(off) : "memory")
#define PV_D0(d0) do { s16x4 l0, l1, l2, l3, h0, h1, h2, h3; constexpr int b_ = VB * SHM_V + v_rd_off(d0, 0, 0); \
        TRRD(l0, b_); TRRD(h0, b_ + 2048); TRRD(l1, b_ + 4096); TRRD(h1, b_ + 6144); TRRD(l2, b_ + 8192); TRRD(h2, b_ + 10240); TRRD(l3, b_ + 12288); TRRD(h3, b_ + 14336); \
        asm volatile("s_waitcnt lgkmcnt(0)" ::: "memory"); SBAR();   \
        o[d0] = __builtin_amdgcn_mfma_f32_32x32x16_bf16(pa0, (bf16x8){l0[0], l0[1], l0[2], l0[3], h0[0], h0[1], h0[2], h0[3]}, o[d0], 0, 0, 0);   \
        o[d0] = __builtin_amdgcn_mfma_f32_32x32x16_bf16(pa1, (bf16x8){l1[0], l1[1], l1[2], l1[3], h1[0], h1[1], h1[2], h1[3]}, o[d0], 0, 0, 0);   \
        o[d0] = __builtin_amdgcn_mfma_f32_32x32x16_bf16(pa2, (bf16x8){l2[0], l2[1], l2[2], l2[3], h2[0], h2[1], h2[2], h2[3]}, o[d0], 0, 0, 0);   \
        o[d0] = __builtin_amdgcn_mfma_f32_32x32x16_bf16(pa3, (bf16x8){l3[0], l3[1], l3[2], l3[3], h3[0], h3[1], h3[2], h3[3]}, o[d0], 0, 0, 0); } while (0)
    PV_D0(0); PV_D0(1); PV_D0(2); PV_D0(3);
#undef PV_D0
#undef TRRD
}

struct UnitRef { const bf16_t* Q; const bf16_t* K; const bf16_t* V; int P0; };
struct Seam { bf16x8 qr[8]; bf16x8 st_v0, st_v1, st_k0, st_k1; };
#define ROW(p, k0, rr) ((p) + (size_t)((k0) + (rr)) * D + sc)
#define VMW() asm volatile("s_waitcnt vmcnt(0)" ::: "memory")
#define SLOAD_H(Kp, Vp, k0) do { S.st_v0 = load8(ROW(Vp, k0, sr)); S.st_v1 = load8(ROW(Vp, k0, 32 + sr));              \
                         S.st_k0 = load8(ROW(Kp, k0, sr)); S.st_k1 = load8(ROW(Kp, k0, 32 + sr)); } while (0)
#define SWRITE_HK(bf) do { *(bf16x8*)(K_lds + (bf) * SHM_K + kws) = S.st_k0; *(bf16x8*)(K_lds + (bf) * SHM_K + kws + 32 * 256) = S.st_k1; } while (0)
#define SWRITE_HV(bf) do { *(bf16x8*)(V_lds + (bf) * SHM_V + vst0) = S.st_v0; *(bf16x8*)(V_lds + (bf) * SHM_V + vst1) = S.st_v1; } while (0)
#define SWRITE_H(bf) do { SWRITE_HV(bf); SWRITE_HK(bf); } while (0)

template <bool SB>
__device__ __forceinline__ void attn_unit(const UnitRef& cur, const float* cvec  , const bf16_t* gate  ,
                                          bf16_t* outp  , char* lds) {
    const int tid = threadIdx.x, wid = __builtin_amdgcn_readfirstlane(tid >> 6), lane = tid & 63, r32 = lane & 31, hi = lane >> 5;
    const int NT = (cur.P0 + QB) / KVBLK;
#define KBASE(t) ((SB ? (NT - 1 - (t)) : (t)) * KVBLK)
    const int qlo = cur.P0 + wid * QBLK, qm = qlo + r32 - 4 * hi - (SB ? 1 : 0);
    char* V_lds = lds; char* K_lds = lds + 2 * SHM_V;
    float* ws = (float*)(lds + OFF_WS) + wid * 64; float* li_l = ws, * al_l = ws + 32;
    float* bias = (float*)(lds + OFF_BIAS);
    const int sr = tid >> 4, sc = (tid & 15) * 8, vst0 = v_st(sr, sc), vst1 = v_st(32 + sr, sc), kws = KSWZ(sr, sc * 2);
    const int vb0 = (int)(uintptr_t)V_lds + v_rd_base(lane);
    const bf16_t* Kh = cur.K; const bf16_t* Vh = cur.V;
    Seam S;
    if constexpr (!SB) { const float cq0 = cvec[cur.P0]; for (int j = tid; j < cur.P0 + QB; j += NTHREADS) bias[j] = (cq0 - cvec[j]) * (1.f / SCALE); }
#pragma unroll
    for (int d0 = 0; d0 < 8; ++d0) S.qr[d0] = load8(cur.Q + (size_t)(wid * QBLK + r32) * D + d0 * 16 + hi * 8);
    SLOAD_H(Kh, Vh, KBASE(0)); VMW(); SWRITE_HK(0);
    __syncthreads();
    float m_reg = -1e30f, l_reg = 0; f32x16 o[4] = {};
    float carry = 0.f; const float mlo = hi ? 0.f : 1.f;
#define RESC(a) do { if (__any((a) < 1.f)) { if (hi == 0) al_l[r32] = (a); asm volatile("s_waitcnt lgkmcnt(0)" ::: "memory");              \
                     for (int d_ = 0; d_ < 4; ++d_) for (int r = 0; r < 16; ++r) o[d_][r] *= al_l[crow(r, hi)]; } } while (0)
#define MASKT(P0_, P1_, t) do { const int kb_ = KBASE(t); if (kb_ + KVBLK - 1 > qlo - (SB ? 1 : 0)) mask_tile(P0_, P1_, qm - kb_); } while (0)
#define BT(t) (bias + KBASE(t) + 4 * hi)
#define PART1(PX0, PX1, mnX, alX) do { if constexpr (SB) sb_part1(PX0, PX1, carry, mlo); else partialSM(PX0, PX1, m_reg, mnX, alX); } while (0)
#define PART2(PY0, PY1, alY) do { if constexpr (SB) sb_part2(PY0, PY1, pa0, pa1, pa2, pa3); else finishSM(PY0, PY1, alY, l_reg, pa0, pa1, pa2, pa3); } while (0)
    f32x16 pA0, pA1, pB0, pB1; float mnA = 0.f, mnB = 0.f, alA = 1.f, alB = 1.f; bf16x8 pa0, pa1, pa2, pa3;
    SWRITE_HV(0); SBAR();
    if (NT > 1) SLOAD_H(Kh, Vh, KBASE(1));
    SBAR(); qkt<0, !SB>(pA0, pA1, K_lds, r32, hi, S.qr, BT(0));
    MASKT(pA0, pA1, 0); PART1(pA0, pA1, mnA, alA);
    if (NT > 1) { VMW(); SWRITE_H(1); }
    __syncthreads();
#define HALF_STEP(PX0, PX1, mnX, alX, PY0, PY1, alY, t, KB, VB, SBUF) do {                                                    \
        SBAR(); qkt<KB, !SB>(PX0, PX1, K_lds, r32, hi, S.qr, BT(t));                                                          \
        PART2(PY0, PY1, alY); SBAR();                                                                                          \
        if ((t) + 1 < NT) { SLOAD_H(Kh, Vh, KBASE((t) + 1)); SBAR(); }                                                         \
        pv_tile<VB>(o, vb0, pa0, pa1, pa2, pa3); MASKT(PX0, PX1, (t)); PART1(PX0, PX1, mnX, alX);                              \
        __syncthreads();                                                                                                      \
        if ((t) + 1 < NT) { VMW(); SWRITE_H(SBUF); }                                                                           \
        if constexpr (!SB) RESC(alX);                                                                                          \
        __syncthreads(); } while (0)
    for (int t = 1; t + 1 < NT; t += 2) {
        HALF_STEP(pB0, pB1, mnB, alB, pA0, pA1, alA, t, 1, 0, 0);
        HALF_STEP(pA0, pA1, mnA, alA, pB0, pB1, alB, t + 1, 0, 1, 1);
    }
    const bool even = (NT & 1) == 0;
    if (even) { SBAR(); qkt<1, !SB>(pB0, pB1, K_lds, r32, hi, S.qr, BT(NT - 1)); SBAR(); }
    PART2(pA0, pA1, alA); SBAR();
    pv_tile<0>(o, vb0, pa0, pa1, pa2, pa3);
    if (even) { MASKT(pB0, pB1, NT - 1); PART1(pB0, pB1, mnB, alB); __syncthreads(); if constexpr (!SB) RESC(alB);
        PART2(pB0, pB1, alB); SBAR(); pv_tile<1>(o, vb0, pa0, pa1, pa2, pa3); }
    float rli[16];
    if constexpr (!SB) {
        if (hi == 0) li_l[r32] = l_reg; asm volatile("s_waitcnt lgkmcnt(0)" ::: "memory");
#pragma unroll
        for (int r = 0; r < 16; ++r) rli[r] = __builtin_amdgcn_rcpf(li_l[crow(r, hi)]);
    }
#pragma unroll
    for (int r = 0; r < 16; ++r) { const int orow = cur.P0 + wid * QBLK + crow(r, hi);
#pragma unroll
        for (int d0 = 0; d0 < 4; ++d0) {
            float v = o[d0][r];
            if constexpr (!SB) { const unsigned short gb = gate[(size_t)orow * 1024 + d0 * 32 + r32]; v = v * rli[r] * __builtin_bit_cast(float, (unsigned)gb << 16); }
            const float vn = __shfl_xor(v, 1);
            if ((r32 & 1) == 0) *(unsigned*)(outp + (size_t)orow * DM + d0 * 32 + r32) = cvt_pk_bf16(v, vn); } }
    __syncthreads();
#undef RESC
#undef KBASE
#undef MASKT
#undef BT
#undef PART1
#undef PART2
#undef HALF_STEP
}

constexpr float SB_TH = 150.f;
__device__ __forceinline__ void sb_unit(const UnitRef& cur, bf16_t* outp, char* lds) {
    const int tid = threadIdx.x, wid = __builtin_amdgcn_readfirstlane(tid >> 6), lane = tid & 63, r32 = lane & 31, hi = lane >> 5;
    const int NT = (cur.P0 + QB) / KVBLK;
#define KBASE(t) ((NT - 1 - (t)) * KVBLK)
    const int qlo = cur.P0 + wid * QBLK, qm = qlo + r32 - 4 * hi - 1;
    char* V_lds = lds; char* K_lds = lds + 2 * SHM_V;
    volatile int* flags = (volatile int*)(lds + OFF_WS);
    const int sr = tid >> 4, sc = (tid & 15) * 8, vst0 = v_st(sr, sc), vst1 = v_st(32 + sr, sc), kws = KSWZ(sr, sc * 2);
    const int vb0 = (int)(uintptr_t)V_lds + v_rd_base(lane);
    const bf16_t* Kh = cur.K; const bf16_t* Vh = cur.V;
    Seam S;
#pragma unroll
    for (int d0 = 0; d0 < 8; ++d0) S.qr[d0] = load8(cur.Q + (size_t)(wid * QBLK + r32) * D + d0 * 16 + hi * 8);
    SLOAD_H(Kh, Vh, KBASE(0)); VMW(); SWRITE_H(0);
    __syncthreads();
    f32x16 o[4] = {}; float carry = 0.f; const float mlo = hi ? 0.f : 1.f;
    bool wdone = false;
#define SB_STEP(tt, BUF) {                                                                                                 \
        const int kb_ = KBASE(tt);                                                                                           \
        if ((tt) + 1 < NT) SLOAD_H(Kh, Vh, KBASE((tt) + 1));                                                                 \
        SBAR();                                                                                                              \
        if (!wdone && kb_ <= qlo + QBLK - 2) {                                                                               \
            f32x16 p0, p1; bf16x8 pa0, pa1, pa2, pa3;                                                                        \
            qkt<BUF, false>(p0, p1, K_lds, r32, hi, S.qr, nullptr);                                                          \
            if (kb_ + KVBLK - 1 > qlo - 1) mask_tile(p0, p1, qm - kb_);                                                      \
            sb_part1(p0, p1, carry, mlo); sb_part2(p0, p1, pa0, pa1, pa2, pa3); SBAR();                                      \
            pv_tile<BUF>(o, vb0, pa0, pa1, pa2, pa3);                                                                        \
            wdone = __all(carry >= SB_TH);                                                                                   \
        }                                                                                                                    \
        if ((tt) + 1 < NT) { VMW(); SWRITE_H((BUF) ^ 1); }                                                                   \
        if (lane == 0) flags[((tt) & 1) * 8 + wid] = wdone ? 1 : 0;                                                          \
        __syncthreads();                                                                                                     \
        { int alld = 1;                                                                                                      \
          _Pragma("unroll") for (int w_ = 0; w_ < 8; ++w_) alld &= flags[((tt) & 1) * 8 + w_];                                \
          if (alld) break; } }
    for (int t = 0; t < NT; t += 2) {
        SB_STEP(t, 0)
        SB_STEP(t + 1, 1)
    }
#undef SB_STEP
#pragma unroll
    for (int r = 0; r < 16; ++r) { const int orow = cur.P0 + wid * QBLK + crow(r, hi);
#pragma unroll
        for (int d0 = 0; d0 < 4; ++d0) {
            const float v = o[d0][r];
            const float vn = __shfl_xor(v, 1);
            if ((r32 & 1) == 0) *(unsigned*)(outp + (size_t)orow * DM + d0 * 32 + r32) = cvt_pk_bf16(v, vn); } }
    __syncthreads();
#undef KBASE
}
#undef ROW
#undef VMW
#undef SLOAD_H
#undef SWRITE_HK
#undef SWRITE_HV
#undef SWRITE_H
}

struct Args { const float* in[12]; float* out; unsigned char* ws; int ph_lo, ph_hi; };

__device__ __forceinline__ void p0_transpose_item(const float* W, int ldw, int K, bf16_t* WT, int nblk, LAS float* scr, int item, int lane, const float* gk) {
    const int kb = item / nblk, nb = item % nblk, k0 = 64 * kb, n0 = 32 * nb;
#pragma unroll 8
    for (int i = 0; i < 32; ++i) { const int kk = 2 * i + (lane >> 5); float w = W[(size_t)(k0 + kk) * ldw + n0 + (lane & 31)]; if (gk) w *= gk[k0 + kk]; scr[kk * 33 + (lane & 31)] = w; }
    LDS_WAIT(); asm volatile("" ::: "memory");
    const int c = lane & 7;
#pragma unroll
    for (int j = 0; j < 4; ++j) { const int n = (lane >> 3) + 8 * j; const LAS float* s = scr + (8 * c) * 33 + n;
        u32x4 o; o.x = cvt_pk_bf16(s[0 * 33], s[1 * 33]); o.y = cvt_pk_bf16(s[2 * 33], s[3 * 33]); o.z = cvt_pk_bf16(s[4 * 33], s[5 * 33]); o.w = cvt_pk_bf16(s[6 * 33], s[7 * 33]);
        *(u32x4*)(WT + (size_t)(n0 + n) * K + k0 + 8 * c) = o; }
    LDS_WAIT(); asm volatile("" ::: "memory");
}

__device__ __forceinline__ float log_sigmoid_f(float x) { return fminf(x, 0.f) - log1pf(expf(-fabsf(x))); }

__device__ __forceinline__ void phase0(const Args& a, unsigned char* lds_g) {
    LAS unsigned char* lds = (LAS unsigned char*)lds_g;
    const int tid = threadIdx.x, lane = tid & 63, wave = __builtin_amdgcn_readfirstlane(tid >> 6);
    const int gw = blockIdx.x * NWAVES + wave, NGW = gridDim.x * NWAVES;
    const int gt = blockIdx.x * NTHREADS + tid, NGT = gridDim.x * NTHREADS;
    unsigned char* ws = a.ws;
    const float* x = a.in[0]; const float* g_attn = a.in[1]; const float* w_in = a.in[2]; const float* b_forget = a.in[3];
    const float* w_out = a.in[6]; const float* g_ffn = a.in[7]; const float* w_pq = a.in[8]; const float* sk = a.in[9]; const float* pu = a.in[10]; const float* pv = a.in[11];
    LAS float* wf = (LAS float*)(lds + 67584);
    for (int k = tid; k < DM; k += NTHREADS) { const f32x4 a0 = *(const f32x4*)(w_in + (size_t)k * DIN + NPROJ), a1 = *(const f32x4*)(w_in + (size_t)k * DIN + NPROJ + 4);
        *(LAS f32x4*)(wf + k * 8) = a0; *(LAS f32x4*)(wf + k * 8 + 4) = a1; }
    __syncthreads();
    for (int row = gw; row < T; row += NGW) {
        const f32x4* xr = (const f32x4*)(x + (size_t)row * DM);
        f32x4 v[8]; float ss = 0.f;
#pragma unroll
        for (int j = 0; j < 8; ++j) { v[j] = xr[lane + 64 * j]; ss += v[j][0] * v[j][0] + v[j][1] * v[j][1] + v[j][2] * v[j][2] + v[j][3] * v[j][3]; }
        const float r = 1.0f / sqrtf(wave_sum(ss) * (1.f / DM) + EPS);
        float f[8] = {0.f, 0.f, 0.f, 0.f, 0.f, 0.f, 0.f, 0.f};
        u32x2* o8 = (u32x2*)(ws + WS_XN + (size_t)row * DM * 2);
#pragma unroll
        for (int j = 0; j < 8; ++j) {
            const int e = 4 * (lane + 64 * j);
            const f32x4 g4 = *(const f32x4*)(g_attn + e);
            f32x4 xn; xn[0] = v[j][0] * r * g4[0]; xn[1] = v[j][1] * r * g4[1]; xn[2] = v[j][2] * r * g4[2]; xn[3] = v[j][3] * r * g4[3];
            u32x2 w; w.x = cvt_pk_bf16(xn[0], xn[1]); w.y = cvt_pk_bf16(xn[2], xn[3]); o8[lane + 64 * j] = w;
#pragma unroll
            for (int q = 0; q < 4; ++q) { const f32x4 w0 = *(LAS f32x4*)(wf + (e + q) * 8), w1 = *(LAS f32x4*)(wf + (e + q) * 8 + 4);
                f[0] += xn[q] * w0[0]; f[1] += xn[q] * w0[1]; f[2] += xn[q] * w0[2]; f[3] += xn[q] * w0[3];
                f[4] += xn[q] * w1[0]; f[5] += xn[q] * w1[1]; f[6] += xn[q] * w1[2]; f[7] += xn[q] * w1[3]; }
        }
#pragma unroll
        for (int hh = 0; hh < 8; ++hh) f[hh] = wave_sum(f[hh]);
        if (lane < 8) { float fl = f[0];
#pragma unroll
            for (int hh = 1; hh < 8; ++hh) fl = (lane == hh) ? f[hh] : fl;
            const int b = row >> 12, s = row & 4095;
            ((float*)(ws + WS_LOGF))[(size_t)(b * 8 + lane) * SEQ + s] = log_sigmoid_f(fl + b_forget[lane]); }
    }
    LAS float* scr = (LAS float*)(lds + wave * 8448);
    constexpr int I_IN = (DM / 64) * (NPROJ / 32), I_O = (DM / 64) * (DM / 32);
    for (int it = gw; it < I_IN + 2 * I_O; it += NGW) {
        int r = it;
        if (r < I_IN) { p0_transpose_item(w_in, DIN, DM, (bf16_t*)(ws + WS_WIN), NPROJ / 32, scr, r, lane, nullptr); continue; } r -= I_IN;
        if (r < I_O) { p0_transpose_item(w_out, DM, DM, (bf16_t*)(ws + WS_WOUT), DM / 32, scr, r, lane, nullptr); continue; } r -= I_O;
        p0_transpose_item(w_pq, DM, DM, (bf16_t*)(ws + WS_WPQ), DM / 32, scr, r, lane, g_ffn);
    }
    for (int i = gt; i < 8 * 2 * 128 * 128 / 8; i += NGT) { const f32x4 a0 = *(const f32x4*)(sk + (size_t)i * 8), a1 = *(const f32x4*)(sk + (size_t)i * 8 + 4);
        u32x4 w; w.x = cvt_pk_bf16(a0[0], a0[1]); w.y = cvt_pk_bf16(a0[2], a0[3]); w.z = cvt_pk_bf16(a1[0], a1[1]); w.w = cvt_pk_bf16(a1[2], a1[3]);
        *(u32x4*)(ws + WS_SK + (size_t)i * 16) = w; }
    for (size_t i = gt; i < (size_t)NEXP * DM / 8; i += NGT) {
        const int col = (int)((i * 8) & (DM - 1));
        const f32x4 g0 = *(const f32x4*)(g_ffn + col), g1 = *(const f32x4*)(g_ffn + col + 4);
        const f32x4 a0 = *(const f32x4*)(pu + i * 8), a1 = *(const f32x4*)(pu + i * 8 + 4);
        u32x4 w; w.x = cvt_pk_bf16(a0[0] * g0[0], a0[1] * g0[1]); w.y = cvt_pk_bf16(a0[2] * g0[2], a0[3] * g0[3]); w.z = cvt_pk_bf16(a1[0] * g1[0], a1[1] * g1[1]); w.w = cvt_pk_bf16(a1[2] * g1[2], a1[3] * g1[3]);
        *(u32x4*)(ws + WS_UB + i * 16) = w;
        const f32x4 b0 = *(const f32x4*)(pv + i * 8), b1 = *(const f32x4*)(pv + i * 8 + 4);
        u32x4 z; z.x = cvt_pk_bf16(b0[0], b0[1]); z.y = cvt_pk_bf16(b0[2], b0[3]); z.z = cvt_pk_bf16(b1[0], b1[1]); z.w = cvt_pk_bf16(b1[2], b1[3]);
        *(u32x4*)(ws + WS_VB + i * 16) = z;
    }
}

__device__ __forceinline__ void cumsum_rows(const Args& a) {
    const int tid = threadIdx.x, lane = tid & 63, wave = tid >> 6;
    if (blockIdx.x >= 16 || wave != 0) return;
    const float* src = (const float*)(a.ws + WS_LOGF) + (size_t)blockIdx.x * SEQ + lane * 64;
    float* dst = (float*)(a.ws + WS_C) + (size_t)blockIdx.x * SEQ + lane * 64;
    f32x4 v[16]; float run = 0.f;
#pragma unroll
    for (int i = 0; i < 16; ++i) { v[i] = *(const f32x4*)(src + 4 * i);
#pragma unroll
        for (int q = 0; q < 4; ++q) { run += v[i][q]; v[i][q] = run; } }
    float incl = run;
#pragma unroll
    for (int o = 1; o < 64; o <<= 1) { const float t = __shfl_up(incl, o); if (lane >= o) incl += t; }
    const float off = incl - run;
#pragma unroll
    for (int i = 0; i < 16; ++i) { f32x4 w = v[i]; w[0] += off; w[1] += off; w[2] += off; w[3] += off; *(f32x4*)(dst + 4 * i) = w; }
}

__device__ __forceinline__ void phase_qknorm(const Args& a) {
    const int tid = threadIdx.x, lane = tid & 63, wave = tid >> 6;
    const int gw = blockIdx.x * NWAVES + wave, NGW = gridDim.x * NWAVES;
    const int sub = lane & 15, rw = lane >> 4;
    const float* gq = a.in[4]; const float* gk = a.in[5];
    constexpr int ROWS = NB * NHF * SEQ;
    for (int it = gw; it < 2 * ROWS / 4; it += NGW) {
        const int row = it * 4 + rw; const bool isk = row >= ROWS;
        bf16_t* p = (bf16_t*)(a.ws + WS_SEC) + (size_t)row * HD + sub * 8;
        const float* g = (isk ? gk : gq) + sub * 8;
        const u32x4 w = *(const u32x4*)p;
        float v[8] = {bf_lo(w.x), bf_hi(w.x), bf_lo(w.y), bf_hi(w.y), bf_lo(w.z), bf_hi(w.z), bf_lo(w.w), bf_hi(w.w)};
        float ss = 0.f;
#pragma unroll
        for (int i = 0; i < 8; ++i) ss += v[i] * v[i];
        ss += __shfl_xor(ss, 1); ss += __shfl_xor(ss, 2); ss += __shfl_xor(ss, 4); ss += __shfl_xor(ss, 8);
        const float r = 1.0f / sqrtf(ss * (1.f / HD) + EPS);
        const f32x4 g0 = *(const f32x4*)g, g1 = *(const f32x4*)(g + 4);
        u32x4 o; o.x = cvt_pk_bf16(v[0] * r * g0[0], v[1] * r * g0[1]); o.y = cvt_pk_bf16(v[2] * r * g0[2], v[3] * r * g0[3]);
        o.z = cvt_pk_bf16(v[4] * r * g1[0], v[5] * r * g1[1]); o.w = cvt_pk_bf16(v[6] * r * g1[2], v[7] * r * g1[3]);
        *(u32x4*)p = o;
    }
}

__device__ __forceinline__ void phase_attn(const Args& a, unsigned char* lds_g) {
    const int tid = threadIdx.x;
    volatile int* s_item = (volatile int*)(lds_g + MISC_OFF);
    unsigned* ctr = (unsigned*)(a.ws + WS_CTL);
    bf16_t* sec = (bf16_t*)(a.ws + WS_SEC);
    for (;;) {
        __syncthreads();
        if (tid == 0) *s_item = (int)atomicAdd(ctr, 1u);
        __syncthreads();
        const int it = *s_item;
        if (it >= 512) break;
        const int qb = 15 - (it >> 5), kind = (it >> 4) & 1, bh = it & 15;
        const int b = bh >> 3, h = bh & 7;
        const size_t hoff = (size_t)bh * SEQ * HD;
        att::UnitRef u;
        u.P0 = qb * 256;
        if (kind == 0) {
            u.Q = sec + 4 * SEC_ELEMS + hoff + (size_t)u.P0 * HD; u.K = sec + 5 * SEC_ELEMS + hoff; u.V = sec + 6 * SEC_ELEMS + hoff;
            att::sb_unit(u, (bf16_t*)(a.ws + WS_MIX) + (size_t)b * SEQ * DM + 1024 + h * HD, (char*)lds_g);
        } else {
            u.Q = sec + 0 * SEC_ELEMS + hoff + (size_t)u.P0 * HD; u.K = sec + 1 * SEC_ELEMS + hoff; u.V = sec + 2 * SEC_ELEMS + hoff;
            att::attn_unit<false>(u, (const float*)(a.ws + WS_C) + (size_t)bh * SEQ, sec + 3 * SEC_ELEMS + (size_t)b * SEQ * 1024 + h * HD,
                                  (bf16_t*)(a.ws + WS_MIX) + (size_t)b * SEQ * DM + h * HD, (char*)lds_g);
        }
    }
}

__device__ __forceinline__ unsigned f2ord(float f) { const unsigned u = __float_as_uint(f); return u ^ ((unsigned)((int)u >> 31) | 0x80000000u); }
__device__ __forceinline__ float ord2f(unsigned k) { const unsigned u = k ^ (~(unsigned)((int)k >> 31) | 0x80000000u); return __uint_as_float(u); }
#define INS16(L, X) do { unsigned x_ = (X); _Pragma("unroll") for (int i_ = 0; i_ < 16; ++i_) { const unsigned hi_ = max(L[i_], x_); x_ = min(L[i_], x_); L[i_] = hi_; } } while (0)
__device__ __forceinline__ void topk_half(const bf16_t* qp, const bf16_t* skb, int t0, int h, int c, int r32, int hi, unsigned (&L)[16]) {
    bf16x8 qf[8];
#pragma unroll
    for (int d0 = 0; d0 < 8; ++d0) qf[d0] = *(const bf16x8*)(qp + (size_t)(t0 + r32) * DM + h * 256 + c * 128 + d0 * 16 + hi * 8);
#pragma unroll
    for (int i = 0; i < 16; ++i) L[i] = 0u;
    const unsigned hi4 = 4u * (unsigned)hi;
#pragma unroll
    for (int kt = 0; kt < 4; ++kt) {
        f32x16 acc = f32x16{};
#pragma unroll
        for (int d0 = 0; d0 < 8; ++d0) { const bf16x8 kf = *(const bf16x8*)(skb + (size_t)((h * 2 + c) * 128 + kt * 32 + r32) * 128 + d0 * 16 + hi * 8);
            acc = __builtin_amdgcn_mfma_f32_32x32x16_bf16(kf, qf[d0], acc, 0, 0, 0); }
        __builtin_amdgcn_sched_barrier(0);
#pragma unroll
        for (int r = 0; r < 16; ++r) { const unsigned cst = (unsigned)(127 - (kt * 32 + (r & 3) + 8 * (r >> 2)));
            const unsigned kk = (f2ord(acc[r]) & ~127u) | (cst - hi4); INS16(L, kk); }
        __builtin_amdgcn_sched_barrier(0);
    }
    unsigned P[16];
#pragma unroll
    for (int i = 0; i < 16; ++i) { auto rr = __builtin_amdgcn_permlane32_swap(L[i], L[i], false, false); P[i] = hi ? rr[0] : rr[1]; }
#pragma unroll
    for (int i = 0; i < 16; ++i) INS16(L, P[i]);
}
__device__ __forceinline__ void phase_topk(const Args& a, unsigned char* lds_g) {
    LAS unsigned char* lds = (LAS unsigned char*)lds_g;
    const int tid = threadIdx.x, lane = tid & 63, wave = tid >> 6, r32 = lane & 31, hi = lane >> 5;
    const int gw = blockIdx.x * NWAVES + wave, NGW = gridDim.x * NWAVES;
    const bf16_t* skb = (const bf16_t*)(a.ws + WS_SK); const bf16_t* qp = (const bf16_t*)(a.ws + WS_QP);
    int* idx_o = (int*)(a.ws + WS_IDX); float* gw_o = (float*)(a.ws + WS_GW);
    for (int task = gw; task < (T / 32) * 8; task += NGW) {
        const int h = task & 7, t0 = (task >> 3) * 32;
        unsigned L[2][16];
        topk_half(qp, skb, t0, h, 0, r32, hi, L[0]);
        __builtin_amdgcn_sched_barrier(0);
        topk_half(qp, skb, t0, h, 1, r32, hi, L[1]);
        __builtin_amdgcn_sched_barrier(0);
        float s1[16], s2[16]; int i1[16], i2[16];
#pragma unroll
        for (int i = 0; i < 16; ++i) { s1[i] = ord2f((L[0][i] & ~127u) | 64u); i1[i] = 127 - (int)(L[0][i] & 127u); s2[i] = ord2f((L[1][i] & ~127u) | 64u); i2[i] = 127 - (int)(L[1][i] & 127u); }
        unsigned LC[16];
#pragma unroll
        for (int i = 0; i < 16; ++i) LC[i] = 0u;
#pragma unroll
        for (int aa = 0; aa < 16; ++aa)
#pragma unroll
            for (int bb = 0; bb < 16; ++bb) if ((aa + 1) * (bb + 1) <= 16) { const unsigned kk = (f2ord(s1[aa] + s2[bb]) & ~255u) | (unsigned)(aa * 16 + bb); INS16(LC, kk); }
        LAS int* tb = (LAS int*)(lds + wave * 8192);
#pragma unroll
        for (int i = 0; i < 16; ++i) { tb[i * 64 + lane] = i1[i]; tb[(16 + i) * 64 + lane] = i2[i]; }
        float LS[16]; int LP[16];
#pragma unroll
        for (int i = 0; i < 16; ++i) { const unsigned cid = LC[i] & 255u; LS[i] = ord2f((LC[i] & ~255u) | 128u);
            LP[i] = tb[(cid >> 4) * 64 + lane] * 128 + tb[(16 + (cid & 15u)) * 64 + lane]; }
        float den = 0.f, e[16];
#pragma unroll
        for (int i = 0; i < 16; ++i) { e[i] = __expf(LS[i] - LS[0]); den += e[i]; }
        const float rden = 1.f / den;
        const size_t ob = (size_t)(t0 + r32) * NE + h * 16;
        if (hi == 0) {
#pragma unroll
            for (int i = 0; i < 4; ++i) *(int4*)(idx_o + ob + 4 * i) = make_int4(LP[4 * i], LP[4 * i + 1], LP[4 * i + 2], LP[4 * i + 3]);
        } else {
#pragma unroll
            for (int i = 0; i < 4; ++i) *(f32x4*)(gw_o + ob + 4 * i) = (f32x4){e[4 * i] * rden, e[4 * i + 1] * rden, e[4 * i + 2] * rden, e[4 * i + 3] * rden};
        }
    }
}


__device__ __forceinline__ void wave_argmax(float& v, int& i) {
#pragma unroll
    for (int o = 1; o < 64; o <<= 1) { const float ov = __shfl_xor(v, o); const int oi = __shfl_xor(i, o); if (ov > v || (ov == v && oi < i)) { v = ov; i = oi; } }
}
__device__ __forceinline__ void phase_topk_ref(const Args& a) {
    const int tid = threadIdx.x, lane = tid & 63, wave = tid >> 6;
    const int gw = blockIdx.x * NWAVES + wave, NGW = gridDim.x * NWAVES;
    const bf16_t* skb = (const bf16_t*)(a.ws + WS_SK); const bf16_t* qp = (const bf16_t*)(a.ws + WS_QP);
    int* idx_o = (int*)(a.ws + WS_IDX); float* gw_o = (float*)(a.ws + WS_GW);
    for (int task = gw; task < T * 8; task += NGW) {
        const int t = task >> 3, h = task & 7;
        float topS[2]; int topI[2];
        for (int c = 0; c < 2; ++c) {
            const bf16_t* q = qp + (size_t)t * DM + h * 256 + c * 128;
            float sc0 = 0.f, sc1 = 0.f;
            const bf16_t* k0 = skb + (size_t)((h * 2 + c) * 128 + lane) * 128; const bf16_t* k1 = k0 + 64 * 128;
            for (int d = 0; d < 128; ++d) { const float qd = __uint_as_float((unsigned)q[d] << 16);
                sc0 += qd * __uint_as_float((unsigned)k0[d] << 16); sc1 += qd * __uint_as_float((unsigned)k1[d] << 16); }
            float ms = 0.f; int mi = 0;
            for (int r = 0; r < 16; ++r) {
                float v; int i; if (sc0 >= sc1) { v = sc0; i = lane; } else { v = sc1; i = lane + 64; }
                wave_argmax(v, i);
                if (lane == r) { ms = v; mi = i; }
                if (i == lane) sc0 = -__builtin_inff();
                if (i == lane + 64) sc1 = -__builtin_inff();
            }
            topS[c] = ms; topI[c] = mi;
        }
        float cs[4]; int ci[4];
#pragma unroll
        for (int j = 0; j < 4; ++j) { const int cidx = lane * 4 + j, aa = cidx >> 4, bb = cidx & 15;
            cs[j] = __shfl(topS[0], aa) + __shfl(topS[1], bb); ci[j] = cidx; }
        float fs = 0.f; int fi = 0;
        for (int r = 0; r < 16; ++r) {
            float v = cs[0]; int i = ci[0];
#pragma unroll
            for (int j = 1; j < 4; ++j) if (cs[j] > v) { v = cs[j]; i = ci[j]; }
            wave_argmax(v, i);
            if (lane == r) { fs = v; fi = i; }
#pragma unroll
            for (int j = 0; j < 4; ++j) if (ci[j] == i) cs[j] = -__builtin_inff();
        }
        const int e1 = __shfl(topI[0], fi >> 4), e2 = __shfl(topI[1], fi & 15);
        const float mx = __shfl(fs, 0);
        float ev = lane < 16 ? __expf(fs - mx) : 0.f;
        const float den = wave_sum(ev);
        if (lane < 16) { idx_o[(size_t)t * NE + h * 16 + lane] = e1 * 128 + e2; gw_o[(size_t)t * NE + h * 16 + lane] = ev / den; }
    }
}

__device__ __forceinline__ float dot8(const u32x4 a, const u32x4 b, float acc) {
    acc = __builtin_amdgcn_fdot2_f32_bf16(__builtin_bit_cast(bf16x2_t, a.x), __builtin_bit_cast(bf16x2_t, b.x), acc, false);
    acc = __builtin_amdgcn_fdot2_f32_bf16(__builtin_bit_cast(bf16x2_t, a.y), __builtin_bit_cast(bf16x2_t, b.y), acc, false);
    acc = __builtin_amdgcn_fdot2_f32_bf16(__builtin_bit_cast(bf16x2_t, a.z), __builtin_bit_cast(bf16x2_t, b.z), acc, false);
    acc = __builtin_amdgcn_fdot2_f32_bf16(__builtin_bit_cast(bf16x2_t, a.w), __builtin_bit_cast(bf16x2_t, b.w), acc, false);
    return acc;
}
__device__ __forceinline__ void phase_peer(const Args& a) {
    const int tid = threadIdx.x, lane = tid & 63, wave = tid >> 6;
    const int gw = blockIdx.x * NWAVES + wave, NGW = gridDim.x * NWAVES;
    const bf16_t* hb = (const bf16_t*)(a.ws + WS_HB); const bf16_t* ub = (const bf16_t*)(a.ws + WS_UB); const bf16_t* vb = (const bf16_t*)(a.ws + WS_VB);
    const int* idx_i = (const int*)(a.ws + WS_IDX); const float* gw_i = (const float*)(a.ws + WS_GW); const float* ssq = (const float*)(a.ws + WS_SSQ);
    float* out = a.out;
    for (int t = gw; t < T; t += NGW) {
        const float rt = 1.0f / sqrtf(wave_sum(lane < 32 ? ssq[(size_t)t * 32 + lane] : 0.f) * (1.f / DM) + EPS);
        u32x4 xb[4];
#pragma unroll
        for (int j = 0; j < 4; ++j) xb[j] = *(const u32x4*)(hb + (size_t)t * DM + j * 512 + lane * 8);
        float acc[32];
#pragma unroll
        for (int i = 0; i < 32; ++i) acc[i] = 0.f;
        for (int bt = 0; bt < 16; ++bt) {
            const int my_idx = idx_i[(size_t)t * NE + bt * 8 + (lane & 7)];
            const float my_g = gw_i[(size_t)t * NE + bt * 8 + ((lane >> 3) & 7)];
            float p[8];
#pragma unroll
            for (int j = 0; j < 8; ++j) { const int e = __builtin_amdgcn_readlane(my_idx, j); const bf16_t* ur = ub + (size_t)e * DM + lane * 8;
                float d = 0.f;
#pragma unroll
                for (int q = 0; q < 4; ++q) d = dot8(xb[q], *(const u32x4*)(ur + q * 512), d);
                p[j] = d; }
            { const bool up = lane & 32; float q4[4];
#pragma unroll
              for (int i = 0; i < 4; ++i) { const float keep = up ? p[4 + i] : p[i], send = up ? p[i] : p[4 + i]; q4[i] = keep + __shfl_xor(send, 32); }
              const bool up2 = lane & 16; float q2[2];
#pragma unroll
              for (int i = 0; i < 2; ++i) { const float keep = up2 ? q4[2 + i] : q4[i], send = up2 ? q4[i] : q4[2 + i]; q2[i] = keep + __shfl_xor(send, 16); }
              const bool up3 = lane & 8;
              const float keep = up3 ? q2[1] : q2[0], send = up3 ? q2[0] : q2[1]; float q1 = keep + __shfl_xor(send, 8);
              q1 += __shfl_xor(q1, 4); q1 += __shfl_xor(q1, 2); q1 += __shfl_xor(q1, 1);
              p[0] = q1; }
            const float hpre = p[0] * rt;
            const float hw = 0.5f * hpre * (1.f + erff(hpre * 0.70710678118654752f)) * my_g;
#pragma unroll
            for (int j = 0; j < 8; ++j) { const int e = __builtin_amdgcn_readlane(my_idx, j); const float w = __uint_as_float((unsigned)__builtin_amdgcn_readlane((int)__float_as_uint(hw), 8 * j));
                const bf16_t* vr = vb + (size_t)e * DM + lane * 8;
#pragma unroll
                for (int q = 0; q < 4; ++q) { const u32x4 vv = *(const u32x4*)(vr + q * 512);
                    acc[8 * q + 0] = fmaf(w, bf_lo(vv.x), acc[8 * q + 0]); acc[8 * q + 1] = fmaf(w, bf_hi(vv.x), acc[8 * q + 1]);
                    acc[8 * q + 2] = fmaf(w, bf_lo(vv.y), acc[8 * q + 2]); acc[8 * q + 3] = fmaf(w, bf_hi(vv.y), acc[8 * q + 3]);
                    acc[8 * q + 4] = fmaf(w, bf_lo(vv.z), acc[8 * q + 4]); acc[8 * q + 5] = fmaf(w, bf_hi(vv.z), acc[8 * q + 5]);
                    acc[8 * q + 6] = fmaf(w, bf_lo(vv.w), acc[8 * q + 6]); acc[8 * q + 7] = fmaf(w, bf_hi(vv.w), acc[8 * q + 7]); } }
        }
        float* orow = out + (size_t)t * DM + lane * 8;
#pragma unroll
        for (int q = 0; q < 4; ++q) { f32x4 h0 = *(const f32x4*)(orow + q * 512), h1 = *(const f32x4*)(orow + q * 512 + 4);
            h0[0] += acc[8 * q + 0]; h0[1] += acc[8 * q + 1]; h0[2] += acc[8 * q + 2]; h0[3] += acc[8 * q + 3];
            h1[0] += acc[8 * q + 4]; h1[1] += acc[8 * q + 5]; h1[2] += acc[8 * q + 6]; h1[3] += acc[8 * q + 7];
            *(f32x4*)(orow + q * 512) = h0; *(f32x4*)(orow + q * 512 + 4) = h1; }
    }
}


__device__ __forceinline__ void phase_peer_ref(const Args& a) {
    const int tid = threadIdx.x, lane = tid & 63, wave = tid >> 6;
    const int gw = blockIdx.x * NWAVES + wave, NGW = gridDim.x * NWAVES;
    const int* idx_i = (const int*)(a.ws + WS_IDX); const float* gw_i = (const float*)(a.ws + WS_GW);
    const float* g_ffn = a.in[7]; const float* pu = a.in[10]; const float* pv = a.in[11];
    float* out = a.out;
    for (int t = gw; t < T; t += NGW) {
        float hn[32], acc[32]; float ss = 0.f;
#pragma unroll
        for (int i = 0; i < 32; ++i) { hn[i] = out[(size_t)t * DM + lane + 64 * i]; ss += hn[i] * hn[i]; acc[i] = 0.f; }
        const float rt = 1.0f / sqrtf(wave_sum(ss) * (1.f / DM) + EPS);
#pragma unroll
        for (int i = 0; i < 32; ++i) hn[i] = hn[i] * rt * g_ffn[lane + 64 * i];
        for (int e = 0; e < NE; ++e) {
            const int ex = idx_i[(size_t)t * NE + e]; const float g = gw_i[(size_t)t * NE + e];
            const float* ur = pu + (size_t)ex * DM; const float* vr = pv + (size_t)ex * DM;
            float d = 0.f;
#pragma unroll
            for (int i = 0; i < 32; ++i) d += hn[i] * ur[lane + 64 * i];
            d = wave_sum(d);
            __builtin_amdgcn_sched_barrier(0);
            const float w = 0.5f * d * (1.f + erff(d * 0.70710678118654752f)) * g;
#pragma unroll
            for (int i = 0; i < 32; ++i) acc[i] += w * vr[lane + 64 * i];
            __builtin_amdgcn_sched_barrier(0);
        }
#pragma unroll
        for (int i = 0; i < 32; ++i) out[(size_t)t * DM + lane + 64 * i] += acc[i];
    }
}

constexpr int NPHASE = 8;
__global__ void __launch_bounds__(NTHREADS, 2) fwd_kernel(Args a) {
    extern __shared__ __attribute__((aligned(16))) unsigned char lds[];
    const int lo = a.ph_lo, hi = a.ph_hi;
#if MK_ONE_LAUNCH
    cg::grid_group grid = cg::this_grid();
#define SEAM(k) do { if (lo <= (k) && (k) + 1 < hi) grid.sync(); } while (0)
#else
#define SEAM(k) do { } while (0)
#endif
#define IN(k) (lo <= (k) && (k) < hi)
    unsigned char* ws = a.ws;
    if (IN(0)) { phase0(a, lds); SEAM(0); }
    if (IN(1)) {
        cumsum_rows(a);
        pg8::Gemm g{(const bf16_t*)(ws + WS_XN), (const bf16_t*)(ws + WS_WIN), T, NPROJ, DM}; pg8::StaticOrder S; S.init(T, NPROJ, (int)gridDim.x, (int)blockIdx.x);
        pg8::EpiInProj E{(bf16_t*)(ws + WS_SEC)};
        pg8::gemm_phase<pg8::EpiInProj, pg8::StaticOrder, true, true>((LAS unsigned char*)lds, g, S, E);
        SEAM(1);
    }
    if (IN(2)) { phase_qknorm(a); SEAM(2); }
    if (IN(3)) { phase_attn(a, lds); SEAM(3); }
    if (IN(4)) {
        pg8::Gemm g{(const bf16_t*)(ws + WS_MIX), (const bf16_t*)(ws + WS_WOUT), T, DM, DM}; pg8::StaticOrder S; S.init(T, DM, (int)gridDim.x, (int)blockIdx.x);
        pg8::EpiOutProj E{a.in[0], a.out, (bf16_t*)(ws + WS_HB), (float*)(ws + WS_SSQ)};
        pg8::gemm_phase<pg8::EpiOutProj, pg8::StaticOrder, true, true>((LAS unsigned char*)lds, g, S, E);
        SEAM(4);
    }
    if (IN(5)) {
        pg8::Gemm g{(const bf16_t*)(ws + WS_HB), (const bf16_t*)(ws + WS_WPQ), T, DM, DM}; pg8::StaticOrder S; S.init(T, DM, (int)gridDim.x, (int)blockIdx.x);
        pg8::EpiPeerQ E{(const float*)(ws + WS_SSQ), (bf16_t*)(ws + WS_QP)};
        pg8::gemm_phase<pg8::EpiPeerQ, pg8::StaticOrder, true, true>((LAS unsigned char*)lds, g, S, E);
        SEAM(5);
    }
    #ifdef TOPK_REF
    if (IN(6)) { phase_topk_ref(a); SEAM(6); }
#else
    if (IN(6)) { phase_topk(a, lds); SEAM(6); }
#endif
    #ifdef PEER_REF
    if (IN(7)) { phase_peer_ref(a); }
#else
    if (IN(7)) { phase_peer(a); }
#endif
#undef IN
#undef SEAM
}

extern "C" void kernel_launch(void* const* d_in, const int* in_sizes, int n_in, void* d_out, int out_size, void* d_ws, size_t ws_size, hipStream_t stream) {
    static int grid = 0;
    if (grid == 0) {
        if (n_in != 12 || in_sizes[0] != T * DM || out_size != T * DM || ws_size < WS_END) { fprintf(stderr, "kernel_launch: unexpected shapes (n_in %d, in0 %d, out %d, ws %zu)\n", n_in, n_in > 0 ? in_sizes[0] : -1, out_size, ws_size); grid = -1; return; }
        int dev = 0, cus = 0, per_cu = 0;
        if (hipGetDevice(&dev) != hipSuccess || hipDeviceGetAttribute(&cus, hipDeviceAttributeMultiprocessorCount, dev) != hipSuccess) { grid = -1; return; }
        if (hipFuncSetAttribute((const void*)fwd_kernel, hipFuncAttributeMaxDynamicSharedMemorySize, LDS_BYTES) != hipSuccess) { fprintf(stderr, "kernel_launch: hipFuncSetAttribute failed\n"); grid = -1; return; }
        if (hipOccupancyMaxActiveBlocksPerMultiprocessor(&per_cu, (const void*)fwd_kernel, NTHREADS, LDS_BYTES) != hipSuccess || per_cu < 1) { fprintf(stderr, "kernel_launch: occupancy query says %d\n", per_cu); grid = -1; return; }
        grid = cus;
    }
    if (grid < 0) return;
    (void)hipMemsetAsync((char*)d_ws + WS_CTL, 0, CTL_BYTES, stream);
    Args a{};
    for (int i = 0; i < 12; ++i) a.in[i] = (const float*)d_in[i];
    a.out = (float*)d_out; a.ws = (unsigned char*)d_ws;
#if MK_ONE_LAUNCH
    a.ph_lo = 0; a.ph_hi = NPHASE;
    void* args[] = {&a};
    hipError_t e = hipLaunchCooperativeKernel((const void*)fwd_kernel, dim3(grid), dim3(NTHREADS), args, LDS_BYTES, stream);
    if (e != hipSuccess) fprintf(stderr, "cooperative launch failed: %s (grid %d)\n", hipGetErrorString(e), grid);
#else
    for (int p = 0; p < NPHASE; ++p) { a.ph_lo = p; a.ph_hi = p + 1; hipLaunchKernelGGL(fwd_kernel, dim3(grid), dim3(NTHREADS), LDS_BYTES, stream, a); }
#endif
}
```

```cpp
#include <hip/hip_runtime.h>
#include <hip/hip_cooperative_groups.h>
#include <cstdio>
#include <cstdint>
namespace cg = cooperative_groups;

#define PEER_REF 1
#ifndef MK_ONE_LAUNCH
#define MK_ONE_LAUNCH 1
#endif

#define LAS __attribute__((address_space(3)))
typedef unsigned short bf16_t;
typedef short bf16x8 __attribute__((ext_vector_type(8)));
typedef short s16x4 __attribute__((ext_vector_type(4)));
typedef float f32x2 __attribute__((ext_vector_type(2)));
typedef float f32x4 __attribute__((ext_vector_type(4)));
typedef float f32x16 __attribute__((ext_vector_type(16)));
typedef unsigned u32x2 __attribute__((ext_vector_type(2)));
typedef unsigned u32x4 __attribute__((ext_vector_type(4)));
typedef __bf16 bf16x2_t __attribute__((ext_vector_type(2)));

constexpr int NB = 2, SEQ = 4096, T = NB * SEQ, DM = 2048, HD = 128, NHF = 8, DIN = 7176, NPROJ = 7168;
constexpr int NEXP = 16384, NE = 128;
constexpr float EPS = 1e-6f;
constexpr float SCALE = 0.08838834764831845f, LOG2E = 1.4426950408889634f;
constexpr int NWAVES = 8, NTHREADS = 512;

constexpr size_t MiB = 1u << 20;
constexpr size_t WS_CTL = 0, CTL_BYTES = 4096;
constexpr size_t WS_WIN = 1 * MiB, WS_WOUT = 29 * MiB, WS_WPQ = 37 * MiB, WS_SK = 45 * MiB, WS_LOGF = 46 * MiB, WS_C = 46 * MiB + 512 * 1024, WS_SSQ = 47 * MiB;
constexpr size_t WS_XN = 48 * MiB;
constexpr size_t WS_SEC = 80 * MiB;
constexpr size_t SEC_ELEMS = 8u << 20;
constexpr size_t WS_MIX = 192 * MiB, WS_HB = 224 * MiB, WS_QP = 256 * MiB, WS_IDX = 288 * MiB, WS_GW = 292 * MiB, WS_UB = 296 * MiB, WS_VB = 360 * MiB, WS_END = 424 * MiB;

constexpr int RING_BYTES = 131072;
constexpr int MISC_OFF = 143360;
constexpr int LDS_BYTES = 147456;

__device__ __forceinline__ unsigned cvt_pk_bf16(float lo, float hi) { unsigned r; asm volatile("v_cvt_pk_bf16_f32 %0, %1, %2" : "=v"(r) : "v"(lo), "v"(hi)); return r; }
__device__ __forceinline__ float bf_lo(unsigned u) { return __builtin_bit_cast(float, u << 16); }
__device__ __forceinline__ float bf_hi(unsigned u) { return __builtin_bit_cast(float, u & 0xffff0000u); }
__device__ __forceinline__ float wave_sum(float v) {
#pragma unroll
    for (int o = 1; o < 64; o <<= 1) v += __shfl_xor(v, o);
    return v;
}
#define LDS_WAIT() asm volatile("s_waitcnt lgkmcnt(0)" ::: "memory")

namespace pg8 {
#define PG8_LAS __attribute__((address_space(3)))
constexpr int BM = 256, BK = 64, HALF = 128, HTB = HALF * BK * 2, STAGE_BYTES = 8 * HTB, NXCD = 8, WGM = 8;
__host__ __device__ __forceinline__ int lds_byte(int r, int c) { const int st = (r >> 4) * 2 + (c >> 5), rr = r & 15, cc = c & 31, ob = rr * 64 + cc * 2; return st * 1024 + (ob ^ (((ob >> 9) & 1) << 5)); }
__host__ __device__ __forceinline__ void stage_rc(int b, int& R, int& C) { const int st = b / 1024, sb = b % 1024, swz = sb ^ (((sb >> 9) & 1) << 5); R = (st >> 1) * 16 + swz / 64; C = (st & 1) * 32 + (swz % 64) / 2; }
__host__ __device__ __forceinline__ int perm32(int rho) { const int n = rho >> 4, i = rho & 15; return 8 * (i >> 2) + 4 * n + (i & 3); }
struct Unit { int pm, pn; };
struct Gemm { const bf16_t* A; const bf16_t* Bt; int M, N, K; };
struct StaticOrder {
    int nM, nN, nwg, G, c;
    __host__ __device__ void init(int M, int N, int G_, int c_) { nM = M / BM; nN = N / BM; nwg = nM * nN; G = G_; c = c_; }
    __host__ __device__ bool next(int i, Unit& u) const {
        const long L = (long)i * G + c; if (L >= nwg) return false;
        int wgid = (int)L; { const int q = nwg / NXCD, r = nwg % NXCD, xcd = wgid % NXCD, off = wgid / NXCD; wgid = (xcd < r ? xcd * (q + 1) : r * (q + 1) + (xcd - r) * q) + off; }
        const int nig = WGM * nN, gid = wgid / nig, fm = gid * WGM, gsz = (nM - fm) < WGM ? (nM - fm) : WGM;
        u.pm = fm + ((wgid % nig) % gsz); u.pn = (wgid % nig) / gsz; return true;
    }
    __device__ __forceinline__ void a_ready(const Unit&) const {}
    __device__ __forceinline__ void done(const Unit&) const {}
};

template <class Epi, class Sched, bool ALIGN_EPI = false, bool SP2 = false>
__device__ __forceinline__ void gemm_phase(PG8_LAS unsigned char* lds, const Gemm g, const Sched& S, const Epi& E) {
    const int tid = threadIdx.x, wid = __builtin_amdgcn_readfirstlane(tid >> 6), lane = tid & 63, wr = wid >> 2, wc = wid & 3, fr = lane & 15, fq = lane >> 4;
    const int K = g.K, nt = K / BK;
    unsigned voffA[2], voffB[2];
#pragma unroll
    for (int i = 0; i < 2; ++i) { int R, C; stage_rc(tid * 16 + i * 8192, R, C); const int Rb = Epi::PERM ? ((R & ~31) + perm32(R & 31)) : R;
        voffA[i] = (unsigned)(R * K + C) * 2u; voffB[i] = (unsigned)(Rb * K + C) * 2u; }
    const size_t kstep = (size_t)(BK * 2);
    const size_t hstep = (size_t)HALF * K * 2;
    const size_t tstep = 2 * hstep;
    const unsigned ldsw = (unsigned)wid * 1024u;
    const int aoff = lds_byte(wr * 64 + fr, fq * 8), boff = lds_byte(wc * 32 + fr, fq * 8);
#define PG8_SA(b, h) (((b) * 2 + (h)) * HTB)
#define PG8_SB(b, h) ((4 + (b) * 2 + (h)) * HTB)
#define PG8_STAGE(bufoff, gbase, voff) do { _Pragma("unroll") for (int _i = 0; _i < 2; ++_i) \
        __builtin_amdgcn_global_load_lds((const unsigned*)((const char*)(gbase) + (voff)[_i]), (PG8_LAS unsigned*)(lds + (bufoff) + ldsw + _i * 8192), 16, 0, 0); } while (0)
#define PG8_LDA(dst, b, h) do { _Pragma("unroll") for (int m = 0; m < 4; ++m) _Pragma("unroll") for (int k = 0; k < 2; ++k) dst[m][k] = *(const PG8_LAS bf16x8*)(lds + PG8_SA(b, h) + aoff + m * 2048 + k * 1024); } while (0)
#define PG8_LDB(dst, b, h) do { _Pragma("unroll") for (int n = 0; n < 2; ++n) _Pragma("unroll") for (int k = 0; k < 2; ++k) dst[n][k] = *(const PG8_LAS bf16x8*)(lds + PG8_SB(b, h) + boff + n * 2048 + k * 1024); } while (0)
#define PG8_MMA(ai, bj, At, Bt) do { __builtin_amdgcn_s_setprio(1); _Pragma("unroll") for (int m = 0; m < 4; ++m) _Pragma("unroll") for (int n = 0; n < 2; ++n) _Pragma("unroll") for (int k = 0; k < 2; ++k) \
        acc[ai][bj][m][n] = __builtin_amdgcn_mfma_f32_16x16x32_bf16(Bt[n][k], At[m][k], acc[ai][bj][m][n], 0, 0, 0); __builtin_amdgcn_s_setprio(0); } while (0)
#define PG8_WAIT_V(n) asm volatile("s_waitcnt vmcnt(" #n ")" ::: "memory")
#define PG8_WAIT_L(n) asm volatile("s_waitcnt lgkmcnt(" #n ")" ::: "memory")
#define PG8_BAR __builtin_amdgcn_s_barrier()
#define PG8_SCHED __builtin_amdgcn_sched_barrier(0)
    Unit cur, nxt; int ui = 0;
    if (!S.next(0, cur)) return;
    f32x4 acc[2][2][4][2];
#pragma unroll
    for (int a = 0; a < 2; ++a)
#pragma unroll
        for (int b = 0; b < 2; ++b)
#pragma unroll
            for (int m = 0; m < 4; ++m)
#pragma unroll
                for (int n = 0; n < 2; ++n) acc[a][b][m][n] = (f32x4){0.f, 0.f, 0.f, 0.f};
    bf16x8 At[4][2], B0[2][2], B1[2][2];
    const char* cA = (const char*)g.A + (size_t)cur.pm * tstep; const char* cB = (const char*)g.Bt + (size_t)cur.pn * tstep;
    S.a_ready(cur);
    if constexpr (SP2) {
        PG8_STAGE(PG8_SB(0, 0), cB, voffB); PG8_STAGE(PG8_SB(0, 1), cB + hstep, voffB); PG8_STAGE(PG8_SA(0, 0), cA, voffA); PG8_STAGE(PG8_SA(0, 1), cA + hstep, voffA);
        if (wr == 1) PG8_BAR;
        PG8_WAIT_V(2); PG8_BAR;
        PG8_STAGE(PG8_SB(1, 0), cB + kstep, voffB); PG8_STAGE(PG8_SA(1, 0), cA + kstep, voffA); PG8_STAGE(PG8_SB(1, 1), cB + hstep + kstep, voffB);
        PG8_WAIT_V(6); PG8_BAR;
    } else {
        PG8_STAGE(PG8_SB(0, 0), cB, voffB); PG8_STAGE(PG8_SA(0, 0), cA, voffA); PG8_STAGE(PG8_SB(0, 1), cB + hstep, voffB); PG8_STAGE(PG8_SA(0, 1), cA + hstep, voffA);
        if (wr == 1) PG8_BAR;
        PG8_WAIT_V(4); PG8_BAR;
        PG8_STAGE(PG8_SB(1, 0), cB + kstep, voffB); PG8_STAGE(PG8_SA(1, 0), cA + kstep, voffA); PG8_STAGE(PG8_SB(1, 1), cB + hstep + kstep, voffB);
        PG8_WAIT_V(6); PG8_BAR;
    }
    for (;;) {
        const bool has_next = S.next(ui + 1, nxt);
        const char* nA = has_next ? (const char*)g.A + (size_t)nxt.pm * tstep : cA; const char* nB = has_next ? (const char*)g.Bt + (size_t)nxt.pn * tstep : cB;
        for (int t = 0; t < nt; t += 2) {
            const bool last = (t == nt - 2);
            const char* a1 = cA + (size_t)(t + 1) * kstep;
            const char* a2 = last ? nA : cA + (size_t)(t + 2) * kstep; const char* b2 = last ? nB : cB + (size_t)(t + 2) * kstep;
            const char* a3 = a2 + kstep; const char* b3 = b2 + kstep;
            if (last && has_next) S.a_ready(nxt);
            if constexpr (SP2) {
            PG8_LDB(B0, 0, 0); PG8_LDB(B1, 0, 1); PG8_SCHED; PG8_LDA(At, 0, 0); PG8_STAGE(PG8_SA(1, 1), a1 + hstep, voffA);
            PG8_WAIT_V(8); PG8_WAIT_L(0); PG8_BAR; PG8_MMA(0, 0, At, B0); PG8_MMA(0, 1, At, B1); PG8_BAR; PG8_SCHED;
            PG8_LDA(At, 0, 1); PG8_STAGE(PG8_SB(0, 0), b2, voffB); PG8_STAGE(PG8_SB(0, 1), b2 + hstep, voffB); PG8_STAGE(PG8_SA(0, 0), a2, voffA);
            PG8_WAIT_V(8); PG8_WAIT_L(0); PG8_BAR; PG8_MMA(1, 0, At, B0); PG8_MMA(1, 1, At, B1); PG8_BAR; PG8_SCHED;
            PG8_LDB(B0, 1, 0); PG8_LDB(B1, 1, 1); PG8_SCHED; PG8_LDA(At, 1, 0); PG8_STAGE(PG8_SA(0, 1), a2 + hstep, voffA);
            PG8_WAIT_V(8); PG8_WAIT_L(0); PG8_BAR; PG8_MMA(0, 0, At, B0); PG8_MMA(0, 1, At, B1); PG8_BAR; PG8_SCHED;
            PG8_LDA(At, 1, 1); PG8_STAGE(PG8_SB(1, 0), b3, voffB); PG8_STAGE(PG8_SB(1, 1), b3 + hstep, voffB); PG8_STAGE(PG8_SA(1, 0), a3, voffA);
            PG8_WAIT_V(8); PG8_WAIT_L(0); PG8_BAR; PG8_MMA(1, 0, At, B0); PG8_MMA(1, 1, At, B1); PG8_BAR; PG8_SCHED;
            } else {
            PG8_LDB(B0, 0, 0); PG8_SCHED; PG8_LDA(At, 0, 0); PG8_STAGE(PG8_SA(1, 1), a1 + hstep, voffA);
            PG8_WAIT_L(8); PG8_BAR; PG8_WAIT_L(0); PG8_MMA(0, 0, At, B0); PG8_BAR; PG8_SCHED;
            PG8_LDB(B1, 0, 1); PG8_STAGE(PG8_SB(0, 0), b2, voffB);
            PG8_BAR; PG8_WAIT_L(0); PG8_MMA(0, 1, At, B1); PG8_BAR;
            PG8_LDA(At, 0, 1); PG8_STAGE(PG8_SA(0, 0), a2, voffA);
            PG8_BAR; PG8_WAIT_L(0); PG8_MMA(1, 0, At, B0); PG8_BAR; PG8_SCHED;
            PG8_STAGE(PG8_SB(0, 1), b2 + hstep, voffB);
            PG8_WAIT_V(6); PG8_BAR; PG8_MMA(1, 1, At, B1); PG8_BAR;
            PG8_LDB(B0, 1, 0); PG8_SCHED; PG8_LDA(At, 1, 0); PG8_STAGE(PG8_SA(0, 1), a2 + hstep, voffA);
            PG8_WAIT_L(8); PG8_BAR; PG8_WAIT_L(0); PG8_MMA(0, 0, At, B0); PG8_BAR; PG8_SCHED;
            PG8_LDB(B1, 1, 1); PG8_STAGE(PG8_SB(1, 0), b3, voffB);
            PG8_BAR; PG8_WAIT_L(0); PG8_MMA(0, 1, At, B1); PG8_BAR;
            PG8_LDA(At, 1, 1); PG8_STAGE(PG8_SA(1, 0), a3, voffA);
            PG8_BAR; PG8_WAIT_L(0); PG8_MMA(1, 0, At, B0); PG8_BAR; PG8_SCHED;
            PG8_STAGE(PG8_SB(1, 1), b3 + hstep, voffB);
            PG8_WAIT_V(6); PG8_BAR; PG8_MMA(1, 1, At, B1); PG8_BAR;
            }
        }
        if constexpr (ALIGN_EPI) { if (wr == 0) PG8_BAR; }
        E(acc, cur, wr, wc, fr, fq); S.done(cur);
        if (!has_next) break;
#pragma unroll
        for (int a = 0; a < 2; ++a)
#pragma unroll
            for (int b = 0; b < 2; ++b)
#pragma unroll
                for (int m = 0; m < 4; ++m)
#pragma unroll
                    for (int n = 0; n < 2; ++n) acc[a][b][m][n] = (f32x4){0.f, 0.f, 0.f, 0.f};
        cur = nxt; cA = nA; cB = nB; ++ui;
        if constexpr (ALIGN_EPI) { if (wr == 1) PG8_BAR; }
    }
    PG8_WAIT_V(0);
    if constexpr (!ALIGN_EPI) { if (wr == 0) PG8_BAR; }
    PG8_BAR;
#undef PG8_SA
#undef PG8_SB
#undef PG8_STAGE
#undef PG8_LDA
#undef PG8_LDB
#undef PG8_MMA
#undef PG8_WAIT_V
#undef PG8_WAIT_L
#undef PG8_BAR
#undef PG8_SCHED
}

__device__ __forceinline__ float sigmoidf_fast(float x) { return __builtin_amdgcn_rcpf(1.f + __builtin_amdgcn_exp2f(-x * LOG2E)); }
struct EpiInProj {
    static constexpr bool PERM = true;
    bf16_t* base;
    __device__ __forceinline__ void operator()(const f32x4 (&acc)[2][2][4][2], const Unit& u, int wr, int wc, int fr, int fq) const {
        const int sec = u.pn >> 2;
        bf16_t* sb = base + (size_t)sec * SEC_ELEMS;
        const float sc = (sec == 4) ? SCALE * LOG2E : 1.f;
#pragma unroll
        for (int ai = 0; ai < 2; ++ai)
#pragma unroll
            for (int m = 0; m < 4; ++m) {
                const int tk = u.pm * BM + ai * HALF + wr * 64 + m * 16 + fr, b = tk >> 12, s = tk & 4095;
#pragma unroll
                for (int bj = 0; bj < 2; ++bj) {
                    const int hh = (u.pn & 3) * 2 + bj;
                    f32x4 v0 = acc[ai][bj][m][0], v1 = acc[ai][bj][m][1];
                    bf16_t* dst;
                    if (sec == 3) {
#pragma unroll
                        for (int i = 0; i < 4; ++i) { v0[i] = sigmoidf_fast(v0[i]); v1[i] = sigmoidf_fast(v1[i]); }
                        dst = sb + (size_t)tk * 1024 + hh * 128 + wc * 32 + 8 * fq;
                    } else {
                        v0 = v0 * sc; v1 = v1 * sc;
                        dst = sb + ((size_t)((b * 8 + hh) * 4096 + s)) * 128 + wc * 32 + 8 * fq;
                    }
                    u32x4 w; w.x = cvt_pk_bf16(v0[0], v0[1]); w.y = cvt_pk_bf16(v0[2], v0[3]); w.z = cvt_pk_bf16(v1[0], v1[1]); w.w = cvt_pk_bf16(v1[2], v1[3]);
                    *(u32x4*)dst = w;
                }
            }
    }
};
struct EpiOutProj {
    static constexpr bool PERM = true;
    const float* x; float* h; bf16_t* hb; float* ssq;
    __device__ __forceinline__ void operator()(const f32x4 (&acc)[2][2][4][2], const Unit& u, int wr, int wc, int fr, int fq) const {
#pragma unroll
        for (int ai = 0; ai < 2; ++ai)
#pragma unroll
            for (int m = 0; m < 4; ++m) {
                const int tk = u.pm * BM + ai * HALF + wr * 64 + m * 16 + fr;
                float ss = 0.f;
#pragma unroll
                for (int bj = 0; bj < 2; ++bj) {
                    const size_t off = (size_t)tk * DM + u.pn * BM + bj * HALF + wc * 32 + 8 * fq;
                    const f32x4 x0 = *(const f32x4*)(x + off), x1 = *(const f32x4*)(x + off + 4);
                    const f32x4 v0 = acc[ai][bj][m][0] + x0, v1 = acc[ai][bj][m][1] + x1;
                    *(f32x4*)(h + off) = v0; *(f32x4*)(h + off + 4) = v1;
                    u32x4 w; w.x = cvt_pk_bf16(v0[0], v0[1]); w.y = cvt_pk_bf16(v0[2], v0[3]); w.z = cvt_pk_bf16(v1[0], v1[1]); w.w = cvt_pk_bf16(v1[2], v1[3]);
                    *(u32x4*)(hb + off) = w;
                    ss += v0[0] * v0[0] + v0[1] * v0[1] + v0[2] * v0[2] + v0[3] * v0[3] + v1[0] * v1[0] + v1[1] * v1[1] + v1[2] * v1[2] + v1[3] * v1[3];
                }
                ss += __shfl_xor(ss, 16); ss += __shfl_xor(ss, 32);
                if (fq == 0) ssq[(size_t)tk * 32 + u.pn * 4 + wc] = ss;
            }
    }
};
struct EpiPeerQ {
    static constexpr bool PERM = true;
    const float* ssq; bf16_t* qp;
    __device__ __forceinline__ void operator()(const f32x4 (&acc)[2][2][4][2], const Unit& u, int wr, int wc, int fr, int fq) const {
#pragma unroll
        for (int ai = 0; ai < 2; ++ai)
#pragma unroll
            for (int m = 0; m < 4; ++m) {
                const int tk = u.pm * BM + ai * HALF + wr * 64 + m * 16 + fr;
                float tot = 0.f;
#pragma unroll
                for (int i = 0; i < 8; ++i) { const f32x4 s4 = *(const f32x4*)(ssq + (size_t)tk * 32 + 4 * i); tot += (s4[0] + s4[1]) + (s4[2] + s4[3]); }
                const float r = 1.0f / sqrtf(tot * (1.f / DM) + EPS);
#pragma unroll
                for (int bj = 0; bj < 2; ++bj) {
                    const size_t off = (size_t)tk * DM + u.pn * BM + bj * HALF + wc * 32 + 8 * fq;
                    const f32x4 v0 = acc[ai][bj][m][0] * r, v1 = acc[ai][bj][m][1] * r;
                    u32x4 w; w.x = cvt_pk_bf16(v0[0], v0[1]); w.y = cvt_pk_bf16(v0[2], v0[3]); w.z = cvt_pk_bf16(v1[0], v1[1]); w.w = cvt_pk_bf16(v1[2], v1[3]);
                    *(u32x4*)(qp + off) = w;
                }
            }
    }
};
}

namespace att {
constexpr int NW = 8, QBLK = 32, KVBLK = 64, QB = NW * QBLK, D = 128;
constexpr int SHM_V = KVBLK * D * 2, SHM_K = KVBLK * D * 2;
constexpr int OFF_WS = 2 * SHM_V + 2 * SHM_K, OFF_BIAS = OFF_WS + NW * 64 * 4, ATT_LDS = OFF_BIAS + SEQ * 4;
#define KSWZ(row, colB) ((row) * 256 + ((colB) ^ (((row) & 7) << 4)))
#define SBAR() __builtin_amdgcn_sched_barrier(0)
__device__ __forceinline__ int v_st(int k, int c) { const int kk = (k & ~0xC) | ((k & 4) << 1) | ((k & 8) >> 1); return ((kk >> 3) * 4 + (c >> 5)) * 512 + ((kk & 7) * 32 + (c & 31)) * 2; }
__device__ __forceinline__ int v_rd_base(int lane) { return ((lane & 3) << 3) | (((lane >> 2) & 3) << 6) | (((lane >> 4) & 1) << 5) | (((lane >> 5) & 1) << 8); }
constexpr int v_rd_off(int d0, int ks, int half) { return d0 * 512 + ks * 4096 + half * 2048; }
__device__ __forceinline__ int crow(int r, int hi) { return (r & 3) + 8 * (r >> 2) + 4 * hi; }
__device__ __forceinline__ bf16x8 load8(const bf16_t* p) { return *reinterpret_cast<const bf16x8*>(p); }
__device__ __forceinline__ void mask_tile(f32x16& p0, f32x16& p1, int dq) {
    const float NEG = -__builtin_inff();
#pragma unroll
    for (int r = 0; r < 16; ++r) {
        const int c = (r & 3) + 8 * (r >> 2);
        if (dq - c < 0) p0[r] = NEG;
        if (dq - c - 32 < 0) p1[r] = NEG;
    }
}
__device__ __forceinline__ void partialSM(f32x16& p0, f32x16& p1, float& m_reg, float& mn, float& alpha) {
    float pmax = p0[0];
#pragma unroll
    for (int r = 1; r < 16; ++r) pmax = fmaxf(pmax, p0[r]);
#pragma unroll
    for (int r = 0; r < 16; ++r) pmax = fmaxf(pmax, p1[r]);
    { auto rr = __builtin_amdgcn_permlane32_swap(__float_as_uint(pmax), __float_as_uint(pmax), false, false);
      pmax = fmaxf(__uint_as_float(rr[0]), __uint_as_float(rr[1])); }
    constexpr float C2 = LOG2E * SCALE; constexpr float THR = 8.f;
    if (__builtin_expect(__all((pmax - m_reg) * SCALE <= THR), 1)) { mn = m_reg; alpha = 1.f; }
    else { mn = fmaxf(m_reg, pmax); alpha = __builtin_amdgcn_exp2f((m_reg - mn) * C2); m_reg = mn; }
    const float mnL = -mn * C2;
#pragma unroll
    for (int r = 0; r < 16; ++r) p0[r] = fmaf(p0[r], C2, mnL);
#pragma unroll
    for (int r = 0; r < 16; ++r) p1[r] = fmaf(p1[r], C2, mnL);
#pragma unroll
    for (int r = 0; r < 16; ++r) p0[r] = __builtin_amdgcn_exp2f(p0[r]);
}
#define PK4(P, B_, OUT) do { unsigned a0 = cvt_pk_bf16(P[B_+0], P[B_+1]), a1 = cvt_pk_bf16(P[B_+2], P[B_+3]);                          \
        unsigned b0 = cvt_pk_bf16(P[B_+4], P[B_+5]), b1 = cvt_pk_bf16(P[B_+6], P[B_+7]);                                             \
        auto r0 = __builtin_amdgcn_permlane32_swap(a0, b0, false, false); auto r1 = __builtin_amdgcn_permlane32_swap(a1, b1, false, false); \
        u32x4 w = {r0[0], r1[0], r0[1], r1[1]}; OUT = *reinterpret_cast<bf16x8*>(&w); } while (0)
__device__ __forceinline__ void finishSM(f32x16& p0, f32x16& p1, float alpha, float& l_reg, bf16x8& pa0, bf16x8& pa1, bf16x8& pa2, bf16x8& pa3) {
#pragma unroll
    for (int r = 0; r < 16; ++r) p1[r] = __builtin_amdgcn_exp2f(p1[r]);
    float ps = 0;
#pragma unroll
    for (int r = 0; r < 16; ++r) ps += p0[r];
#pragma unroll
    for (int r = 0; r < 16; ++r) ps += p1[r];
    { auto rr = __builtin_amdgcn_permlane32_swap(__float_as_uint(ps), __float_as_uint(ps), false, false);
      ps = __uint_as_float(rr[0]) + __uint_as_float(rr[1]); }
    l_reg = l_reg * alpha + ps;
    PK4(p0, 0, pa0); PK4(p0, 8, pa1); PK4(p1, 0, pa2); PK4(p1, 8, pa3);
}
__device__ __forceinline__ void sb_group(f32x16& P, int g, float& gs) {
    float run = 0.f;
#pragma unroll
    for (int k = 3; k >= 0; --k) {
        const float z = P[4 * g + k];
        const float t = __builtin_amdgcn_exp2f(-fabsf(z));
        const float l = __builtin_amdgcn_logf(1.f + t);
        const float sp = fmaxf(z, 0.f) + l;
        P[4 * g + k] = (z - sp) - run;
        run += sp;
    }
    gs = run;
}
__device__ __forceinline__ void sb_part1(f32x16& p0, f32x16& p1, float& carry, float mlo) {
    float gs[8];
#pragma unroll
    for (int g = 0; g < 4; ++g) sb_group(p0, g, gs[g]);
#pragma unroll
    for (int g = 0; g < 4; ++g) sb_group(p1, g, gs[4 + g]);
    float run = carry;
#pragma unroll
    for (int G = 7; G >= 0; --G) {
        auto rr = __builtin_amdgcn_permlane32_swap(__float_as_uint(gs[G]), __float_as_uint(gs[G]), false, false);
        const float slo = __uint_as_float(rr[0]), shi = __uint_as_float(rr[1]);
        const float base = fmaf(mlo, shi, run);
        if (G >= 4) {
#pragma unroll
            for (int k = 0; k < 4; ++k) p1[4 * (G - 4) + k] -= base;
        } else {
#pragma unroll
            for (int k = 0; k < 4; ++k) p0[4 * G + k] -= base;
        }
        run += slo + shi;
    }
    carry = run;
#pragma unroll
    for (int r = 0; r < 16; ++r) p0[r] = __builtin_amdgcn_exp2f(p0[r]);
}
__device__ __forceinline__ void sb_part2(f32x16& p0, f32x16& p1, bf16x8& pa0, bf16x8& pa1, bf16x8& pa2, bf16x8& pa3) {
#pragma unroll
    for (int r = 0; r < 16; ++r) p1[r] = __builtin_amdgcn_exp2f(p1[r]);
    PK4(p0, 0, pa0); PK4(p0, 8, pa1); PK4(p1, 0, pa2); PK4(p1, 8, pa3);
}
#undef PK4
template <int KB, bool BIAS>
__device__ __forceinline__ void qkt(f32x16& p0, f32x16& p1, const char* K_lds, int r32, int hi, const bf16x8* qr, const float* bt) {
    if constexpr (BIAS) {
#pragma unroll
        for (int g = 0; g < 4; ++g) { const f32x4 a = *(const f32x4*)(bt + 8 * g), b = *(const f32x4*)(bt + 32 + 8 * g);
            p0[4 * g] = a[0]; p0[4 * g + 1] = a[1]; p0[4 * g + 2] = a[2]; p0[4 * g + 3] = a[3];
            p1[4 * g] = b[0]; p1[4 * g + 1] = b[1]; p1[4 * g + 2] = b[2]; p1[4 * g + 3] = b[3]; }
    } else { p0 = f32x16{}; p1 = f32x16{}; }
    const char* kb[4];
#pragma unroll
    for (int dd = 0; dd < 4; ++dd) kb[dd] = K_lds + KB * SHM_K + KSWZ(r32, (dd * 16 + hi * 8) * 2);
#pragma unroll
    for (int d0 = 0; d0 < 8; ++d0) { const char* a = kb[d0 & 3] + (d0 >> 2) * 128;
        bf16x8 b0 = *reinterpret_cast<const bf16x8*>(a);
        bf16x8 b1 = *reinterpret_cast<const bf16x8*>(a + 32 * 256);
        p0 = __builtin_amdgcn_mfma_f32_32x32x16_bf16(b0, qr[d0], p0, 0, 0, 0);
        p1 = __builtin_amdgcn_mfma_f32_32x32x16_bf16(b1, qr[d0], p1, 0, 0, 0); }
}
template <int VB>
__device__ __forceinline__ void pv_tile(f32x16* o, int vb0, bf16x8 pa0, bf16x8 pa1, bf16x8 pa2, bf16x8 pa3) {
#define TRRD(dst, off) asm volatile("ds_read_b64_tr_b16 %0, %1 offset:%2" : "=&v"(dst) : "v"(vb0), "i"(off) : "memory")
#define PV_D0(d0) do { s16x4 l0, l1, l2, l3, h0, h1, h2, h3; constexpr int b_ = VB * SHM_V + v_rd_off(d0, 0, 0); \
        TRRD(l0, b_); TRRD(h0, b_ + 2048); TRRD(l1, b_ + 4096); TRRD(h1, b_ + 6144); TRRD(l2, b_ + 8192); TRRD(h2, b_ + 10240); TRRD(l3, b_ + 12288); TRRD(h3, b_ + 14336); \
        asm volatile("s_waitcnt lgkmcnt(0)" ::: "memory"); SBAR();   \
        o[d0] = __builtin_amdgcn_mfma_f32_32x32x16_bf16(pa0, (bf16x8){l0[0], l0[1], l0[2], l0[3], h0[0], h0[1], h0[2], h0[3]}, o[d0], 0, 0, 0);   \
        o[d0] = __builtin_amdgcn_mfma_f32_32x32x16_bf16(pa1, (bf16x8){l1[0], l1[1], l1[2], l1[3], h1[0], h1[1], h1[2], h1[3]}, o[d0], 0, 0, 0);   \
        o[d0] = __builtin_amdgcn_mfma_f32_32x32x16_bf16(pa2, (bf16x8){l2[0], l2[1], l2[2], l2[3], h2[0], h2[1], h2[2], h2[3]}, o[d0], 0, 0, 0);   \
        o[d0] = __builtin_amdgcn_mfma_f32_32x32x16_bf16(pa3, (bf16x8){l3[0], l3[1], l3[2], l3[3], h3[0], h3[1], h3[2], h3[3]}, o[d0], 0, 0, 0); } while (0)
    PV_D0(0); PV_D0(1); PV_D0(2); PV_D0(3);
#undef PV_D0
#undef TRRD
}

struct UnitRef { const bf16_t* Q; const bf16_t* K; const bf16_t* V; int P0; };
struct Seam { bf16x8 qr[8]; bf16x8 st_v0, st_v1, st_k0, st_k1; };
#define ROW(p, k0, rr) ((p) + (size_t)((k0) + (rr)) * D + sc)
#define VMW() asm volatile("s_waitcnt vmcnt(0)" ::: "memory")
#define SLOAD_H(Kp, Vp, k0) do { S.st_v0 = load8(ROW(Vp, k0, sr)); S.st_v1 = load8(ROW(Vp, k0, 32 + sr));              \
                         S.st_k0 = load8(ROW(Kp, k0, sr)); S.st_k1 = load8(ROW(Kp, k0, 32 + sr)); } while (0)
#define SWRITE_HK(bf) do { *(bf16x8*)(K_lds + (bf) * SHM_K + kws) = S.st_k0; *(bf16x8*)(K_lds + (bf) * SHM_K + kws + 32 * 256) = S.st_k1; } while (0)
#define SWRITE_HV(bf) do { *(bf16x8*)(V_lds + (bf) * SHM_V + vst0) = S.st_v0; *(bf16x8*)(V_lds + (bf) * SHM_V + vst1) = S.st_v1; } while (0)
#define SWRITE_H(bf) do { SWRITE_HV(bf); SWRITE_HK(bf); } while (0)

template <bool SB>
__device__ __forceinline__ void attn_unit(const UnitRef& cur, const float* cvec  , const bf16_t* gate  ,
                                          bf16_t* outp  , char* lds) {
    const int tid = threadIdx.x, wid = __builtin_amdgcn_readfirstlane(tid >> 6), lane = tid & 63, r32 = lane & 31, hi = lane >> 5;
    const int NT = (cur.P0 + QB) / KVBLK;
#define KBASE(t) ((SB ? (NT - 1 - (t)) : (t)) * KVBLK)
    const int qlo = cur.P0 + wid * QBLK, qm = qlo + r32 - 4 * hi - (SB ? 1 : 0);
    char* V_lds = lds; char* K_lds = lds + 2 * SHM_V;
    float* ws = (float*)(lds + OFF_WS) + wid * 64; float* li_l = ws, * al_l = ws + 32;
    float* bias = (float*)(lds + OFF_BIAS);
    const int sr = tid >> 4, sc = (tid & 15) * 8, vst0 = v_st(sr, sc), vst1 = v_st(32 + sr, sc), kws = KSWZ(sr, sc * 2);
    const int vb0 = (int)(uintptr_t)V_lds + v_rd_base(lane);
    const bf16_t* Kh = cur.K; const bf16_t* Vh = cur.V;
    Seam S;
    if constexpr (!SB) { const float cq0 = cvec[cur.P0]; for (int j = tid; j < cur.P0 + QB; j += NTHREADS) bias[j] = (cq0 - cvec[j]) * (1.f / SCALE); }
#pragma unroll
    for (int d0 = 0; d0 < 8; ++d0) S.qr[d0] = load8(cur.Q + (size_t)(wid * QBLK + r32) * D + d0 * 16 + hi * 8);
    SLOAD_H(Kh, Vh, KBASE(0)); VMW(); SWRITE_HK(0);
    __syncthreads();
    float m_reg = -1e30f, l_reg = 0; f32x16 o[4] = {};
    float carry = 0.f; const float mlo = hi ? 0.f : 1.f;
#define RESC(a) do { if (__any((a) < 1.f)) { if (hi == 0) al_l[r32] = (a); asm volatile("s_waitcnt lgkmcnt(0)" ::: "memory");              \
                     for (int d_ = 0; d_ < 4; ++d_) for (int r = 0; r < 16; ++r) o[d_][r] *= al_l[crow(r, hi)]; } } while (0)
#define MASKT(P0_, P1_, t) do { const int kb_ = KBASE(t); if (kb_ + KVBLK - 1 > qlo - (SB ? 1 : 0)) mask_tile(P0_, P1_, qm - kb_); } while (0)
#define BT(t) (bias + KBASE(t) + 4 * hi)
#define PART1(PX0, PX1, mnX, alX) do { if constexpr (SB) sb_part1(PX0, PX1, carry, mlo); else partialSM(PX0, PX1, m_reg, mnX, alX); } while (0)
#define PART2(PY0, PY1, alY) do { if constexpr (SB) sb_part2(PY0, PY1, pa0, pa1, pa2, pa3); else finishSM(PY0, PY1, alY, l_reg, pa0, pa1, pa2, pa3); } while (0)
    f32x16 pA0, pA1, pB0, pB1; float mnA = 0.f, mnB = 0.f, alA = 1.f, alB = 1.f; bf16x8 pa0, pa1, pa2, pa3;
    SWRITE_HV(0); SBAR();
    if (NT > 1) SLOAD_H(Kh, Vh, KBASE(1));
    SBAR(); qkt<0, !SB>(pA0, pA1, K_lds, r32, hi, S.qr, BT(0));
    MASKT(pA0, pA1, 0); PART1(pA0, pA1, mnA, alA);
    if (NT > 1) { VMW(); SWRITE_H(1); }
    __syncthreads();
#define HALF_STEP(PX0, PX1, mnX, alX, PY0, PY1, alY, t, KB, VB, SBUF) do {                                                    \
        SBAR(); qkt<KB, !SB>(PX0, PX1, K_lds, r32, hi, S.qr, BT(t));                                                          \
        PART2(PY0, PY1, alY); SBAR();                                                                                          \
        if ((t) + 1 < NT) { SLOAD_H(Kh, Vh, KBASE((t) + 1)); SBAR(); }                                                         \
        pv_tile<VB>(o, vb0, pa0, pa1, pa2, pa3); MASKT(PX0, PX1, (t)); PART1(PX0, PX1, mnX, alX);                              \
        __syncthreads();                                                                                                      \
        if ((t) + 1 < NT) { VMW(); SWRITE_H(SBUF); }                                                                           \
        if constexpr (!SB) RESC(alX);                                                                                          \
        __syncthreads(); } while (0)
    for (int t = 1; t + 1 < NT; t += 2) {
        HALF_STEP(pB0, pB1, mnB, alB, pA0, pA1, alA, t, 1, 0, 0);
        HALF_STEP(pA0, pA1, mnA, alA, pB0, pB1, alB, t + 1, 0, 1, 1);
    }
    const bool even = (NT & 1) == 0;
    if (even) { SBAR(); qkt<1, !SB>(pB0, pB1, K_lds, r32, hi, S.qr, BT(NT - 1)); SBAR(); }
    PART2(pA0, pA1, alA); SBAR();
    pv_tile<0>(o, vb0, pa0, pa1, pa2, pa3);
    if (even) { MASKT(pB0, pB1, NT - 1); PART1(pB0, pB1, mnB, alB); __syncthreads(); if constexpr (!SB) RESC(alB);
        PART2(pB0, pB1, alB); SBAR(); pv_tile<1>(o, vb0, pa0, pa1, pa2, pa3); }
    float rli[16];
    if constexpr (!SB) {
        if (hi == 0) li_l[r32] = l_reg; asm volatile("s_waitcnt lgkmcnt(0)" ::: "memory");
#pragma unroll
        for (int r = 0; r < 16; ++r) rli[r] = __builtin_amdgcn_rcpf(li_l[crow(r, hi)]);
    }
#pragma unroll
    for (int r = 0; r < 16; ++r) { const int orow = cur.P0 + wid * QBLK + crow(r, hi);
#pragma unroll
        for (int d0 = 0; d0 < 4; ++d0) {
            float v = o[d0][r];
            if constexpr (!SB) { const unsigned short gb = gate[(size_t)orow * 1024 + d0 * 32 + r32]; v = v * rli[r] * __builtin_bit_cast(float, (unsigned)gb << 16); }
            const float vn = __shfl_xor(v, 1);
            if ((r32 & 1) == 0) *(unsigned*)(outp + (size_t)orow * DM + d0 * 32 + r32) = cvt_pk_bf16(v, vn); } }
    __syncthreads();
#undef RESC
#undef KBASE
#undef MASKT
#undef BT
#undef PART1
#undef PART2
#undef HALF_STEP
}

constexpr float SB_TH = 150.f;
__device__ __forceinline__ void sb_unit(const UnitRef& cur, bf16_t* outp, char* lds) {
    const int tid = threadIdx.x, wid = __builtin_amdgcn_readfirstlane(tid >> 6), lane = tid & 63, r32 = lane & 31, hi = lane >> 5;
    const int NT = (cur.P0 + QB) / KVBLK;
#define KBASE(t) ((NT - 1 - (t)) * KVBLK)
    const int qlo = cur.P0 + wid * QBLK, qm = qlo + r32 - 4 * hi - 1;
    char* V_lds = lds; char* K_lds = lds + 2 * SHM_V;
    volatile int* flags = (volatile int*)(lds + OFF_WS);
    const int sr = tid >> 4, sc = (tid & 15) * 8, vst0 = v_st(sr, sc), vst1 = v_st(32 + sr, sc), kws = KSWZ(sr, sc * 2);
    const int vb0 = (int)(uintptr_t)V_lds + v_rd_base(lane);
    const bf16_t* Kh = cur.K; const bf16_t* Vh = cur.V;
    Seam S;
#pragma unroll
    for (int d0 = 0; d0 < 8; ++d0) S.qr[d0] = load8(cur.Q + (size_t)(wid * QBLK + r32) * D + d0 * 16 + hi * 8);
    SLOAD_H(Kh, Vh, KBASE(0)); VMW(); SWRITE_H(0);
    __syncthreads();
    f32x16 o[4] = {}; float carry = 0.f; const float mlo = hi ? 0.f : 1.f;
    bool wdone = false;
#define SB_STEP(tt, BUF) {                                                                                                 \
        const int kb_ = KBASE(tt);                                                                                           \
        if ((tt) + 1 < NT) SLOAD_H(Kh, Vh, KBASE((tt) + 1));                                                                 \
        SBAR();                                                                                                              \
        if (!wdone && kb_ <= qlo + QBLK - 2) {                                                                               \
            f32x16 p0, p1; bf16x8 pa0, pa1, pa2, pa3;                                                                        \
            qkt<BUF, false>(p0, p1, K_lds, r32, hi, S.qr, nullptr);                                                          \
            if (kb_ + KVBLK - 1 > qlo - 1) mask_tile(p0, p1, qm - kb_);                                                      \
            sb_part1(p0, p1, carry, mlo); sb_part2(p0, p1, pa0, pa1, pa2, pa3); SBAR();                                      \
            pv_tile<BUF>(o, vb0, pa0, pa1, pa2, pa3);                                                                        \
            wdone = __all(carry >= SB_TH);                                                                                   \
        }                                                                                                                    \
        if ((tt) + 1 < NT) { VMW(); SWRITE_H((BUF) ^ 1); }                                                                   \
        if (lane == 0) flags[((tt) & 1) * 8 + wid] = wdone ? 1 : 0;                                                          \
        __syncthreads();                                                                                                     \
        { int alld = 1;                                                                                                      \
          _Pragma("unroll") for (int w_ = 0; w_ < 8; ++w_) alld &= flags[((tt) & 1) * 8 + w_];                                \
          if (alld) break; } }
    for (int t = 0; t < NT; t += 2) {
        SB_STEP(t, 0)
        SB_STEP(t + 1, 1)
    }
#undef SB_STEP
#pragma unroll
    for (int r = 0; r < 16; ++r) { const int orow = cur.P0 + wid * QBLK + crow(r, hi);
#pragma unroll
        for (int d0 = 0; d0 < 4; ++d0) {
            const float v = o[d0][r];
            const float vn = __shfl_xor(v, 1);
            if ((r32 & 1) == 0) *(unsigned*)(outp + (size_t)orow * DM + d0 * 32 + r32) = cvt_pk_bf16(v, vn); } }
    __syncthreads();
#undef KBASE
}
#undef ROW
#undef VMW
#undef SLOAD_H
#undef SWRITE_HK
#undef SWRITE_HV
#undef SWRITE_H
}

struct Args { const float* in[12]; float* out; unsigned char* ws; int ph_lo, ph_hi; };

__device__ __forceinline__ void p0_transpose_item(const float* W, int ldw, int K, bf16_t* WT, int nblk, LAS float* scr, int item, int lane, const float* gk) {
    const int kb = item / nblk, nb = item % nblk, k0 = 64 * kb, n0 = 32 * nb;
#pragma unroll 8
    for (int i = 0; i < 32; ++i) { const int kk = 2 * i + (lane >> 5); float w = W[(size_t)(k0 + kk) * ldw + n0 + (lane & 31)]; if (gk) w *= gk[k0 + kk]; scr[kk * 33 + (lane & 31)] = w; }
    LDS_WAIT(); asm volatile("" ::: "memory");
    const int c = lane & 7;
#pragma unroll
    for (int j = 0; j < 4; ++j) { const int n = (lane >> 3) + 8 * j; const LAS float* s = scr + (8 * c) * 33 + n;
        u32x4 o; o.x = cvt_pk_bf16(s[0 * 33], s[1 * 33]); o.y = cvt_pk_bf16(s[2 * 33], s[3 * 33]); o.z = cvt_pk_bf16(s[4 * 33], s[5 * 33]); o.w = cvt_pk_bf16(s[6 * 33], s[7 * 33]);
        *(u32x4*)(WT + (size_t)(n0 + n) * K + k0 + 8 * c) = o; }
    LDS_WAIT(); asm volatile("" ::: "memory");
}

__device__ __forceinline__ float log_sigmoid_f(float x) { return fminf(x, 0.f) - log1pf(expf(-fabsf(x))); }

__device__ __forceinline__ void phase0(const Args& a, unsigned char* lds_g) {
    LAS unsigned char* lds = (LAS unsigned char*)lds_g;
    const int tid = threadIdx.x, lane = tid & 63, wave = __builtin_amdgcn_readfirstlane(tid >> 6);
    const int gw = blockIdx.x * NWAVES + wave, NGW = gridDim.x * NWAVES;
    const int gt = blockIdx.x * NTHREADS + tid, NGT = gridDim.x * NTHREADS;
    unsigned char* ws = a.ws;
    const float* x = a.in[0]; const float* g_attn = a.in[1]; const float* w_in = a.in[2]; const float* b_forget = a.in[3];
    const float* w_out = a.in[6]; const float* g_ffn = a.in[7]; const float* w_pq = a.in[8]; const float* sk = a.in[9]; const float* pu = a.in[10]; const float* pv = a.in[11];
    LAS float* wf = (LAS float*)(lds + 67584);
    for (int k = tid; k < DM; k += NTHREADS) { const f32x4 a0 = *(const f32x4*)(w_in + (size_t)k * DIN + NPROJ), a1 = *(const f32x4*)(w_in + (size_t)k * DIN + NPROJ + 4);
        *(LAS f32x4*)(wf + k * 8) = a0; *(LAS f32x4*)(wf + k * 8 + 4) = a1; }
    __syncthreads();
    for (int row = gw; row < T; row += NGW) {
        const f32x4* xr = (const f32x4*)(x + (size_t)row * DM);
        f32x4 v[8]; float ss = 0.f;
#pragma unroll
        for (int j = 0; j < 8; ++j) { v[j] = xr[lane + 64 * j]; ss += v[j][0] * v[j][0] + v[j][1] * v[j][1] + v[j][2] * v[j][2] + v[j][3] * v[j][3]; }
        const float r = 1.0f / sqrtf(wave_sum(ss) * (1.f / DM) + EPS);
        float f[8] = {0.f, 0.f, 0.f, 0.f, 0.f, 0.f, 0.f, 0.f};
        u32x2* o8 = (u32x2*)(ws + WS_XN + (size_t)row * DM * 2);
#pragma unroll
        for (int j = 0; j < 8; ++j) {
            const int e = 4 * (lane + 64 * j);
            const f32x4 g4 = *(const f32x4*)(g_attn + e);
            f32x4 xn; xn[0] = v[j][0] * r * g4[0]; xn[1] = v[j][1] * r * g4[1]; xn[2] = v[j][2] * r * g4[2]; xn[3] = v[j][3] * r * g4[3];
            u32x2 w; w.x = cvt_pk_bf16(xn[0], xn[1]); w.y = cvt_pk_bf16(xn[2], xn[3]); o8[lane + 64 * j] = w;
#pragma unroll
            for (int q = 0; q < 4; ++q) { const f32x4 w0 = *(LAS f32x4*)(wf + (e + q) * 8), w1 = *(LAS f32x4*)(wf + (e + q) * 8 + 4);
                f[0] += xn[q] * w0[0]; f[1] += xn[q] * w0[1]; f[2] += xn[q] * w0[2]; f[3] += xn[q] * w0[3];
                f[4] += xn[q] * w1[0]; f[5] += xn[q] * w1[1]; f[6] += xn[q] * w1[2]; f[7] += xn[q] * w1[3]; }
        }
#pragma unroll
        for (int hh = 0; hh < 8; ++hh) f[hh] = wave_sum(f[hh]);
        if (lane < 8) { float fl = f[0];
#pragma unroll
            for (int hh = 1; hh < 8; ++hh) fl = (lane == hh) ? f[hh] : fl;
            const int b = row >> 12, s = row & 4095;
            ((float*)(ws + WS_LOGF))[(size_t)(b * 8 + lane) * SEQ + s] = log_sigmoid_f(fl + b_forget[lane]); }
    }
    LAS float* scr = (LAS float*)(lds + wave * 8448);
    constexpr int I_IN = (DM / 64) * (NPROJ / 32), I_O = (DM / 64) * (DM / 32);
    for (int it = gw; it < I_IN + 2 * I_O; it += NGW) {
        int r = it;
        if (r < I_IN) { p0_transpose_item(w_in, DIN, DM, (bf16_t*)(ws + WS_WIN), NPROJ / 32, scr, r, lane, nullptr); continue; } r -= I_IN;
        if (r < I_O) { p0_transpose_item(w_out, DM, DM, (bf16_t*)(ws + WS_WOUT), DM / 32, scr, r, lane, nullptr); continue; } r -= I_O;
        p0_transpose_item(w_pq, DM, DM, (bf16_t*)(ws + WS_WPQ), DM / 32, scr, r, lane, g_ffn);
    }
    for (int i = gt; i < 8 * 2 * 128 * 128 / 8; i += NGT) { const f32x4 a0 = *(const f32x4*)(sk + (size_t)i * 8), a1 = *(const f32x4*)(sk + (size_t)i * 8 + 4);
        u32x4 w; w.x = cvt_pk_bf16(a0[0], a0[1]); w.y = cvt_pk_bf16(a0[2], a0[3]); w.z = cvt_pk_bf16(a1[0], a1[1]); w.w = cvt_pk_bf16(a1[2], a1[3]);
        *(u32x4*)(ws + WS_SK + (size_t)i * 16) = w; }
    for (size_t i = gt; i < (size_t)NEXP * DM / 8; i += NGT) {
        const int col = (int)((i * 8) & (DM - 1));
        const f32x4 g0 = *(const f32x4*)(g_ffn + col), g1 = *(const f32x4*)(g_ffn + col + 4);
        const f32x4 a0 = *(const f32x4*)(pu + i * 8), a1 = *(const f32x4*)(pu + i * 8 + 4);
        u32x4 w; w.x = cvt_pk_bf16(a0[0] * g0[0], a0[1] * g0[1]); w.y = cvt_pk_bf16(a0[2] * g0[2], a0[3] * g0[3]); w.z = cvt_pk_bf16(a1[0] * g1[0], a1[1] * g1[1]); w.w = cvt_pk_bf16(a1[2] * g1[2], a1[3] * g1[3]);
        *(u32x4*)(ws + WS_UB + i * 16) = w;
        const f32x4 b0 = *(const f32x4*)(pv + i * 8), b1 = *(const f32x4*)(pv + i * 8 + 4);
        u32x4 z; z.x = cvt_pk_bf16(b0[0], b0[1]); z.y = cvt_pk_bf16(b0[2], b0[3]); z.z = cvt_pk_bf16(b1[0], b1[1]); z.w = cvt_pk_bf16(b1[2], b1[3]);
        *(u32x4*)(ws + WS_VB + i * 16) = z;
    }
}

__device__ __forceinline__ void cumsum_rows(const Args& a) {
    const int tid = threadIdx.x, lane = tid & 63, wave = tid >> 6;
    if (blockIdx.x >= 16 || wave != 0) return;
    const float* src = (const float*)(a.ws + WS_LOGF) + (size_t)blockIdx.x * SEQ + lane * 64;
    float* dst = (float*)(a.ws + WS_C) + (size_t)blockIdx.x * SEQ + lane * 64;
    f32x4 v[16]; float run = 0.f;
#pragma unroll
    for (int i = 0; i < 16; ++i) { v[i] = *(const f32x4*)(src + 4 * i);
#pragma unroll
        for (int q = 0; q < 4; ++q) { run += v[i][q]; v[i][q] = run; } }
    float incl = run;
#pragma unroll
    for (int o = 1; o < 64; o <<= 1) { const float t = __shfl_up(incl, o); if (lane >= o) incl += t; }
    const float off = incl - run;
#pragma unroll
    for (int i = 0; i < 16; ++i) { f32x4 w = v[i]; w[0] += off; w[1] += off; w[2] += off; w[3] += off; *(f32x4*)(dst + 4 * i) = w; }
}

__device__ __forceinline__ void phase_qknorm(const Args& a) {
    const int tid = threadIdx.x, lane = tid & 63, wave = tid >> 6;
    const int gw = blockIdx.x * NWAVES + wave, NGW = gridDim.x * NWAVES;
    const int sub = lane & 15, rw = lane >> 4;
    const float* gq = a.in[4]; const float* gk = a.in[5];
    constexpr int ROWS = NB * NHF * SEQ;
    for (int it = gw; it < 2 * ROWS / 4; it += NGW) {
        const int row = it * 4 + rw; const bool isk = row >= ROWS;
        bf16_t* p = (bf16_t*)(a.ws + WS_SEC) + (size_t)row * HD + sub * 8;
        const float* g = (isk ? gk : gq) + sub * 8;
        const u32x4 w = *(const u32x4*)p;
        float v[8] = {bf_lo(w.x), bf_hi(w.x), bf_lo(w.y), bf_hi(w.y), bf_lo(w.z), bf_hi(w.z), bf_lo(w.w), bf_hi(w.w)};
        float ss = 0.f;
#pragma unroll
        for (int i = 0; i < 8; ++i) ss += v[i] * v[i];
        ss += __shfl_xor(ss, 1); ss += __shfl_xor(ss, 2); ss += __shfl_xor(ss, 4); ss += __shfl_xor(ss, 8);
        const float r = 1.0f / sqrtf(ss * (1.f / HD) + EPS);
        const f32x4 g0 = *(const f32x4*)g, g1 = *(const f32x4*)(g + 4);
        u32x4 o; o.x = cvt_pk_bf16(v[0] * r * g0[0], v[1] * r * g0[1]); o.y = cvt_pk_bf16(v[2] * r * g0[2], v[3] * r * g0[3]);
        o.z = cvt_pk_bf16(v[4] * r * g1[0], v[5] * r * g1[1]); o.w = cvt_pk_bf16(v[6] * r * g1[2], v[7] * r * g1[3]);
        *(u32x4*)p = o;
    }
}

__device__ __forceinline__ void phase_attn(const Args& a, unsigned char* lds_g) {
    const int tid = threadIdx.x;
    volatile int* s_item = (volatile int*)(lds_g + MISC_OFF);
    unsigned* ctr = (unsigned*)(a.ws + WS_CTL);
    bf16_t* sec = (bf16_t*)(a.ws + WS_SEC);
    for (;;) {
        __syncthreads();
        if (tid == 0) *s_item = (int)atomicAdd(ctr, 1u);
        __syncthreads();
        const int it = *s_item;
        if (it >= 512) break;
        const int qb = 15 - (it >> 5), kind = (it >> 4) & 1, bh = it & 15;
        const int b = bh >> 3, h = bh & 7;
        const size_t hoff = (size_t)bh * SEQ * HD;
        att::UnitRef u;
        u.P0 = qb * 256;
        if (kind == 0) {
            u.Q = sec + 4 * SEC_ELEMS + hoff + (size_t)u.P0 * HD; u.K = sec + 5 * SEC_ELEMS + hoff; u.V = sec + 6 * SEC_ELEMS + hoff;
            att::sb_unit(u, (bf16_t*)(a.ws + WS_MIX) + (size_t)b * SEQ * DM + 1024 + h * HD, (char*)lds_g);
        } else {
            u.Q = sec + 0 * SEC_ELEMS + hoff + (size_t)u.P0 * HD; u.K = sec + 1 * SEC_ELEMS + hoff; u.V = sec + 2 * SEC_ELEMS + hoff;
            att::attn_unit<false>(u, (const float*)(a.ws + WS_C) + (size_t)bh * SEQ, sec + 3 * SEC_ELEMS + (size_t)b * SEQ * 1024 + h * HD,
                                  (bf16_t*)(a.ws + WS_MIX) + (size_t)b * SEQ * DM + h * HD, (char*)lds_g);
        }
    }
}

__device__ __forceinline__ unsigned f2ord(float f) { const unsigned u = __float_as_uint(f); return u ^ ((unsigned)((int)u >> 31) | 0x80000000u); }
__device__ __forceinline__ float ord2f(unsigned k) { const unsigned u = k ^ (~(unsigned)((int)k >> 31) | 0x80000000u); return __uint_as_float(u); }
#define INS16(L, X) do { unsigned x_ = (X); _Pragma("unroll") for (int i_ = 0; i_ < 16; ++i_) { const unsigned hi_ = max(L[i_], x_); x_ = min(L[i_], x_); L[i_] = hi_; } } while (0)
__device__ __forceinline__ void topk_half(const bf16_t* qp, const bf16_t* skb, int t0, int h, int c, int r32, int hi, unsigned (&L)[16]) {
    bf16x8 qf[8];
#pragma unroll
    for (int d0 = 0; d0 < 8; ++d0) qf[d0] = *(const bf16x8*)(qp + (size_t)(t0 + r32) * DM + h * 256 + c * 128 + d0 * 16 + hi * 8);
#pragma unroll
    for (int i = 0; i < 16; ++i) L[i] = 0u;
    const unsigned hi4 = 4u * (unsigned)hi;
#pragma unroll
    for (int kt = 0; kt < 4; ++kt) {
        f32x16 acc = f32x16{};
#pragma unroll
        for (int d0 = 0; d0 < 8; ++d0) { const bf16x8 kf = *(const bf16x8*)(skb + (size_t)((h * 2 + c) * 128 + kt * 32 + r32) * 128 + d0 * 16 + hi * 8);
            acc = __builtin_amdgcn_mfma_f32_32x32x16_bf16(kf, qf[d0], acc, 0, 0, 0); }
        __builtin_amdgcn_sched_barrier(0);
#pragma unroll
        for (int r = 0; r < 16; ++r) { const unsigned cst = (unsigned)(127 - (kt * 32 + (r & 3) + 8 * (r >> 2)));
            const unsigned kk = (f2ord(acc[r]) & ~127u) | (cst - hi4); INS16(L, kk); }
        __builtin_amdgcn_sched_barrier(0);
    }
    unsigned P[16];
#pragma unroll
    for (int i = 0; i < 16; ++i) { auto rr = __builtin_amdgcn_permlane32_swap(L[i], L[i], false, false); P[i] = hi ? rr[0] : rr[1]; }
#pragma unroll
    for (int i = 0; i < 16; ++i) INS16(L, P[i]);
}
__device__ __forceinline__ void phase_topk(const Args& a, unsigned char* lds_g) {
    LAS unsigned char* lds = (LAS unsigned char*)lds_g;
    const int tid = threadIdx.x, lane = tid & 63, wave = tid >> 6, r32 = lane & 31, hi = lane >> 5;
    const int gw = blockIdx.x * NWAVES + wave, NGW = gridDim.x * NWAVES;
    const bf16_t* skb = (const bf16_t*)(a.ws + WS_SK); const bf16_t* qp = (const bf16_t*)(a.ws + WS_QP);
    int* idx_o = (int*)(a.ws + WS_IDX); float* gw_o = (float*)(a.ws + WS_GW);
    for (int task = gw; task < (T / 32) * 8; task += NGW) {
        const int h = task & 7, t0 = (task >> 3) * 32;
        unsigned L[2][16];
        topk_half(qp, skb, t0, h, 0, r32, hi, L[0]);
        __builtin_amdgcn_sched_barrier(0);
        topk_half(qp, skb, t0, h, 1, r32, hi, L[1]);
        __builtin_amdgcn_sched_barrier(0);
        float s1[16], s2[16]; int i1[16], i2[16];
#pragma unroll
        for (int i = 0; i < 16; ++i) { s1[i] = ord2f((L[0][i] & ~127u) | 64u); i1[i] = 127 - (int)(L[0][i] & 127u); s2[i] = ord2f((L[1][i] & ~127u) | 64u); i2[i] = 127 - (int)(L[1][i] & 127u); }
        unsigned LC[16];
#pragma unroll
        for (int i = 0; i < 16; ++i) LC[i] = 0u;
#pragma unroll
        for (int aa = 0; aa < 16; ++aa)
#pragma unroll
            for (int bb = 0; bb < 16; ++bb) if ((aa + 1) * (bb + 1) <= 16) { const unsigned kk = (f2ord(s1[aa] + s2[bb]) & ~255u) | (unsigned)(aa * 16 + bb); INS16(LC, kk); }
        LAS int* tb = (LAS int*)(lds + wave * 8192);
#pragma unroll
        for (int i = 0; i < 16; ++i) { tb[i * 64 + lane] = i1[i]; tb[(16 + i) * 64 + lane] = i2[i]; }
        float LS[16]; int LP[16];
#pragma unroll
        for (int i = 0; i < 16; ++i) { const unsigned cid = LC[i] & 255u; LS[i] = ord2f((LC[i] & ~255u) | 128u);
            LP[i] = tb[(cid >> 4) * 64 + lane] * 128 + tb[(16 + (cid & 15u)) * 64 + lane]; }
        float den = 0.f, e[16];
#pragma unroll
        for (int i = 0; i < 16; ++i) { e[i] = __expf(LS[i] - LS[0]); den += e[i]; }
        const float rden = 1.f / den;
        const size_t ob = (size_t)(t0 + r32) * NE + h * 16;
        if (hi == 0) {
#pragma unroll
            for (int i = 0; i < 4; ++i) *(int4*)(idx_o + ob + 4 * i) = make_int4(LP[4 * i], LP[4 * i + 1], LP[4 * i + 2], LP[4 * i + 3]);
        } else {
#pragma unroll
            for (int i = 0; i < 4; ++i) *(f32x4*)(gw_o + ob + 4 * i) = (f32x4){e[4 * i] * rden, e[4 * i + 1] * rden, e[4 * i + 2] * rden, e[4 * i + 3] * rden};
        }
    }
}


__device__ __forceinline__ void wave_argmax(float& v, int& i) {
#pragma unroll
    for (int o = 1; o < 64; o <<= 1) { const float ov = __shfl_xor(v, o); const int oi = __shfl_xor(i, o); if (ov > v || (ov == v && oi < i)) { v = ov; i = oi; } }
}
__device__ __forceinline__ void phase_topk_ref(const Args& a) {
    const int tid = threadIdx.x, lane = tid & 63, wave = tid >> 6;
    const int gw = blockIdx.x * NWAVES + wave, NGW = gridDim.x * NWAVES;
    const bf16_t* skb = (const bf16_t*)(a.ws + WS_SK); const bf16_t* qp = (const bf16_t*)(a.ws + WS_QP);
    int* idx_o = (int*)(a.ws + WS_IDX); float* gw_o = (float*)(a.ws + WS_GW);
    for (int task = gw; task < T * 8; task += NGW) {
        const int t = task >> 3, h = task & 7;
        float topS[2]; int topI[2];
        for (int c = 0; c < 2; ++c) {
            const bf16_t* q = qp + (size_t)t * DM + h * 256 + c * 128;
            float sc0 = 0.f, sc1 = 0.f;
            const bf16_t* k0 = skb + (size_t)((h * 2 + c) * 128 + lane) * 128; const bf16_t* k1 = k0 + 64 * 128;
            for (int d = 0; d < 128; ++d) { const float qd = __uint_as_float((unsigned)q[d] << 16);
                sc0 += qd * __uint_as_float((unsigned)k0[d] << 16); sc1 += qd * __uint_as_float((unsigned)k1[d] << 16); }
            float ms = 0.f; int mi = 0;
            for (int r = 0; r < 16; ++r) {
                float v; int i; if (sc0 >= sc1) { v = sc0; i = lane; } else { v = sc1; i = lane + 64; }
                wave_argmax(v, i);
                if (lane == r) { ms = v; mi = i; }
                if (i == lane) sc0 = -__builtin_inff();
                if (i == lane + 64) sc1 = -__builtin_inff();
            }
            topS[c] = ms; topI[c] = mi;
        }
        float cs[4]; int ci[4];
#pragma unroll
        for (int j = 0; j < 4; ++j) { const int cidx = lane * 4 + j, aa = cidx >> 4, bb = cidx & 15;
            cs[j] = __shfl(topS[0], aa) + __shfl(topS[1], bb); ci[j] = cidx; }
        float fs = 0.f; int fi = 0;
        for (int r = 0; r < 16; ++r) {
            float v = cs[0]; int i = ci[0];
#pragma unroll
            for (int j = 1; j < 4; ++j) if (cs[j] > v) { v = cs[j]; i = ci[j]; }
            wave_argmax(v, i);
            if (lane == r) { fs = v; fi = i; }
#pragma unroll
            for (int j = 0; j < 4; ++j) if (ci[j] == i) cs[j] = -__builtin_inff();
        }
        const int e1 = __shfl(topI[0], fi >> 4), e2 = __shfl(topI[1], fi & 15);
        const float mx = __shfl(fs, 0);
        float ev = lane < 16 ? __expf(fs - mx) : 0.f;
        const float den = wave_sum(ev);
        if (lane < 16) { idx_o[(size_t)t * NE + h * 16 + lane] = e1 * 128 + e2; gw_o[(size_t)t * NE + h * 16 + lane] = ev / den; }
    }
}

__device__ __forceinline__ float dot8(const u32x4 a, const u32x4 b, float acc) {
    acc = __builtin_amdgcn_fdot2_f32_bf16(__builtin_bit_cast(bf16x2_t, a.x), __builtin_bit_cast(bf16x2_t, b.x), acc, false);
    acc = __builtin_amdgcn_fdot2_f32_bf16(__builtin_bit_cast(bf16x2_t, a.y), __builtin_bit_cast(bf16x2_t, b.y), acc, false);
    acc = __builtin_amdgcn_fdot2_f32_bf16(__builtin_bit_cast(bf16x2_t, a.z), __builtin_bit_cast(bf16x2_t, b.z), acc, false);
    acc = __builtin_amdgcn_fdot2_f32_bf16(__builtin_bit_cast(bf16x2_t, a.w), __builtin_bit_cast(bf16x2_t, b.w), acc, false);
    return acc;
}
__device__ __forceinline__ void phase_peer(const Args& a) {
    const int tid = threadIdx.x, lane = tid & 63, wave = tid >> 6;
    const int gw = blockIdx.x * NWAVES + wave, NGW = gridDim.x * NWAVES;
    const bf16_t* hb = (const bf16_t*)(a.ws + WS_HB); const bf16_t* ub = (const bf16_t*)(a.ws + WS_UB); const bf16_t* vb = (const bf16_t*)(a.ws + WS_VB);
    const int* idx_i = (const int*)(a.ws + WS_IDX); const float* gw_i = (const float*)(a.ws + WS_GW); const float* ssq = (const float*)(a.ws + WS_SSQ);
    float* out = a.out;
    for (int t = gw; t < T; t += NGW) {
        const float rt = 1.0f / sqrtf(wave_sum(lane < 32 ? ssq[(size_t)t * 32 + lane] : 0.f) * (1.f / DM) + EPS);
        u32x4 xb[4];
#pragma unroll
        for (int j = 0; j < 4; ++j) xb[j] = *(const u32x4*)(hb + (size_t)t * DM + j * 512 + lane * 8);
        float acc[32];
#pragma unroll
        for (int i = 0; i < 32; ++i) acc[i] = 0.f;
        for (int bt = 0; bt < 16; ++bt) {
            const int my_idx = idx_i[(size_t)t * NE + bt * 8 + (lane & 7)];
            const float my_g = gw_i[(size_t)t * NE + bt * 8 + ((lane >> 3) & 7)];
            float p[8];
#pragma unroll
            for (int j = 0; j < 8; ++j) { const int e = __builtin_amdgcn_readlane(my_idx, j); const bf16_t* ur = ub + (size_t)e * DM + lane * 8;
                float d = 0.f;
#pragma unroll
                for (int q = 0; q < 4; ++q) d = dot8(xb[q], *(const u32x4*)(ur + q * 512), d);
                p[j] = d; }
            { const bool up = lane & 32; float q4[4];
#pragma unroll
              for (int i = 0; i < 4; ++i) { const float keep = up ? p[4 + i] : p[i], send = up ? p[i] : p[4 + i]; q4[i] = keep + __shfl_xor(send, 32); }
              const bool up2 = lane & 16; float q2[2];
#pragma unroll
              for (int i = 0; i < 2; ++i) { const float keep = up2 ? q4[2 + i] : q4[i], send = up2 ? q4[i] : q4[2 + i]; q2[i] = keep + __shfl_xor(send, 16); }
              const bool up3 = lane & 8;
              const float keep = up3 ? q2[1] : q2[0], send = up3 ? q2[0] : q2[1]; float q1 = keep + __shfl_xor(send, 8);
              q1 += __shfl_xor(q1, 4); q1 += __shfl_xor(q1, 2); q1 += __shfl_xor(q1, 1);
              p[0] = q1; }
            const float hpre = p[0] * rt;
            const float hw = 0.5f * hpre * (1.f + erff(hpre * 0.70710678118654752f)) * my_g;
#pragma unroll
            for (int j = 0; j < 8; ++j) { const int e = __builtin_amdgcn_readlane(my_idx, j); const float w = __uint_as_float((unsigned)__builtin_amdgcn_readlane((int)__float_as_uint(hw), 8 * j));
                const bf16_t* vr = vb + (size_t)e * DM + lane * 8;
#pragma unroll
                for (int q = 0; q < 4; ++q) { const u32x4 vv = *(const u32x4*)(vr + q * 512);
                    acc[8 * q + 0] = fmaf(w, bf_lo(vv.x), acc[8 * q + 0]); acc[8 * q + 1] = fmaf(w, bf_hi(vv.x), acc[8 * q + 1]);
                    acc[8 * q + 2] = fmaf(w, bf_lo(vv.y), acc[8 * q + 2]); acc[8 * q + 3] = fmaf(w, bf_hi(vv.y), acc[8 * q + 3]);
                    acc[8 * q + 4] = fmaf(w, bf_lo(vv.z), acc[8 * q + 4]); acc[8 * q + 5] = fmaf(w, bf_hi(vv.z), acc[8 * q + 5]);
                    acc[8 * q + 6] = fmaf(w, bf_lo(vv.w), acc[8 * q + 6]); acc[8 * q + 7] = fmaf(w, bf_hi(vv.w), acc[8 * q + 7]); } }
        }
        float* orow = out + (size_t)t * DM + lane * 8;
#pragma unroll
        for (int q = 0; q < 4; ++q) { f32x4 h0 = *(const f32x4*)(orow + q * 512), h1 = *(const f32x4*)(orow + q * 512 + 4);
            h0[0] += acc[8 * q + 0]; h0[1] += acc[8 * q + 1]; h0[2] += acc[8 * q + 2]; h0[3] += acc[8 * q + 3];
            h1[0] += acc[8 * q + 4]; h1[1] += acc[8 * q + 5]; h1[2] += acc[8 * q + 6]; h1[3] += acc[8 * q + 7];
            *(f32x4*)(orow + q * 512) = h0; *(f32x4*)(orow + q * 512 + 4) = h1; }
    }
}


__device__ __forceinline__ void phase_peer_ref(const Args& a) {
    const int tid = threadIdx.x, lane = tid & 63, wave = tid >> 6;
    const int gw = blockIdx.x * NWAVES + wave, NGW = gridDim.x * NWAVES;
    const int* idx_i = (const int*)(a.ws + WS_IDX); const float* gw_i = (const float*)(a.ws + WS_GW);
    const bf16_t* hb = (const bf16_t*)(a.ws + WS_HB); const bf16_t* ub = (const bf16_t*)(a.ws + WS_UB); const bf16_t* vb = (const bf16_t*)(a.ws + WS_VB);
    const float* ssq = (const float*)(a.ws + WS_SSQ);
    float* out = a.out;
    for (int t = gw; t < T; t += NGW) {
        float hn[32], acc[32];
#pragma unroll
        for (int i = 0; i < 32; ++i) { hn[i] = __uint_as_float((unsigned)hb[(size_t)t * DM + lane + 64 * i] << 16); acc[i] = 0.f; }
        const float rt = 1.0f / sqrtf(wave_sum(lane < 32 ? ssq[(size_t)t * 32 + lane] : 0.f) * (1.f / DM) + EPS);
        for (int e = 0; e < NE; ++e) {
            const int ex = idx_i[(size_t)t * NE + e]; const float g = gw_i[(size_t)t * NE + e];
            const bf16_t* ur = ub + (size_t)ex * DM; const bf16_t* vr = vb + (size_t)ex * DM;
            float d = 0.f;
#pragma unroll
            for (int i = 0; i < 32; ++i) d += hn[i] * __uint_as_float((unsigned)ur[lane + 64 * i] << 16);
            d = wave_sum(d) * rt;
            __builtin_amdgcn_sched_barrier(0);
            const float w = 0.5f * d * (1.f + erff(d * 0.70710678118654752f)) * g;
#pragma unroll
            for (int i = 0; i < 32; ++i) acc[i] += w * __uint_as_float((unsigned)vr[lane + 64 * i] << 16);
            __builtin_amdgcn_sched_barrier(0);
        }
#pragma unroll
        for (int i = 0; i < 32; ++i) out[(size_t)t * DM + lane + 64 * i] += acc[i];
    }
}

constexpr int NPHASE = 8;
__global__ void __launch_bounds__(NTHREADS, 2) fwd_kernel(Args a) {
    extern __shared__ __attribute__((aligned(16))) unsigned char lds[];
    const int lo = a.ph_lo, hi = a.ph_hi;
#if MK_ONE_LAUNCH
    cg::grid_group grid = cg::this_grid();
#define SEAM(k) do { if (lo <= (k) && (k) + 1 < hi) grid.sync(); } while (0)
#else
#define SEAM(k) do { } while (0)
#endif
#define IN(k) (lo <= (k) && (k) < hi)
    unsigned char* ws = a.ws;
    if (IN(0)) { phase0(a, lds); SEAM(0); }
    if (IN(1)) {
        cumsum_rows(a);
        pg8::Gemm g{(const bf16_t*)(ws + WS_XN), (const bf16_t*)(ws + WS_WIN), T, NPROJ, DM}; pg8::StaticOrder S; S.init(T, NPROJ, (int)gridDim.x, (int)blockIdx.x);
        pg8::EpiInProj E{(bf16_t*)(ws + WS_SEC)};
        pg8::gemm_phase<pg8::EpiInProj, pg8::StaticOrder, true, true>((LAS unsigned char*)lds, g, S, E);
        SEAM(1);
    }
    if (IN(2)) { phase_qknorm(a); SEAM(2); }
    if (IN(3)) { phase_attn(a, lds); SEAM(3); }
    if (IN(4)) {
        pg8::Gemm g{(const bf16_t*)(ws + WS_MIX), (const bf16_t*)(ws + WS_WOUT), T, DM, DM}; pg8::StaticOrder S; S.init(T, DM, (int)gridDim.x, (int)blockIdx.x);
        pg8::EpiOutProj E{a.in[0], a.out, (bf16_t*)(ws + WS_HB), (float*)(ws + WS_SSQ)};
        pg8::gemm_phase<pg8::EpiOutProj, pg8::StaticOrder, true, true>((LAS unsigned char*)lds, g, S, E);
        SEAM(4);
    }
    if (IN(5)) {
        pg8::Gemm g{(const bf16_t*)(ws + WS_HB), (const bf16_t*)(ws + WS_WPQ), T, DM, DM}; pg8::StaticOrder S; S.init(T, DM, (int)gridDim.x, (int)blockIdx.x);
        pg8::EpiPeerQ E{(const float*)(ws + WS_SSQ), (bf16_t*)(ws + WS_QP)};
        pg8::gemm_phase<pg8::EpiPeerQ, pg8::StaticOrder, true, true>((LAS unsigned char*)lds, g, S, E);
        SEAM(5);
    }
    #ifdef TOPK_REF
    if (IN(6)) { phase_topk_ref(a); SEAM(6); }
#else
    if (IN(6)) { phase_topk(a, lds); SEAM(6); }
#endif
    #ifdef PEER_REF
    if (IN(7)) { phase_peer_ref(a); }
#else
    if (IN(7)) { phase_peer(a); }
#endif
#undef IN
#undef SEAM
}

extern "C" void kernel_launch(void* const* d_in, const int* in_sizes, int n_in, void* d_out, int out_size, void* d_ws, size_t ws_size, hipStream_t stream) {
    static int grid = 0;
    if (grid == 0) {
        if (n_in != 12 || in_sizes[0] != T * DM || out_size != T * DM || ws_size < WS_END) { fprintf(stderr, "kernel_launch: unexpected shapes (n_in %d, in0 %d, out %d, ws %zu)\n", n_in, n_in > 0 ? in_sizes[0] : -1, out_size, ws_size); grid = -1; return; }
        int dev = 0, cus = 0, per_cu = 0;
        if (hipGetDevice(&dev) != hipSuccess || hipDeviceGetAttribute(&cus, hipDeviceAttributeMultiprocessorCount, dev) != hipSuccess) { grid = -1; return; }
        if (hipFuncSetAttribute((const void*)fwd_kernel, hipFuncAttributeMaxDynamicSharedMemorySize, LDS_BYTES) != hipSuccess) { fprintf(stderr, "kernel_launch: hipFuncSetAttribute failed\n"); grid = -1; return; }
        if (hipOccupancyMaxActiveBlocksPerMultiprocessor(&per_cu, (const void*)fwd_kernel, NTHREADS, LDS_BYTES) != hipSuccess || per_cu < 1) { fprintf(stderr, "kernel_launch: occupancy query says %d\n", per_cu); grid = -1; return; }
        grid = cus;
    }
    if (grid < 0) return;
    (void)hipMemsetAsync((char*)d_ws + WS_CTL, 0, CTL_BYTES, stream);
    Args a{};
    for (int i = 0; i < 12; ++i) a.in[i] = (const float*)d_in[i];
    a.out = (float*)d_out; a.ws = (unsigned char*)d_ws;
#if MK_ONE_LAUNCH
    a.ph_lo = 0; a.ph_hi = NPHASE;
    void* args[] = {&a};
    hipError_t e = hipLaunchCooperativeKernel((const void*)fwd_kernel, dim3(grid), dim3(NTHREADS), args, LDS_BYTES, stream);
    if (e != hipSuccess) fprintf(stderr, "cooperative launch failed: %s (grid %d)\n", hipGetErrorString(e), grid);
#else
    for (int p = 0; p < NPHASE; ++p) { a.ph_lo = p; a.ph_hi = p + 1; hipLaunchKernelGGL(fwd_kernel, dim3(grid), dim3(NTHREADS), LDS_BYTES, stream, a); }
#endif
}
```

```cpp
#include <hip/hip_runtime.h>
#include <hip/hip_cooperative_groups.h>
#include <cstdio>
#include <cstdint>
namespace cg = cooperative_groups;

#ifndef MK_ONE_LAUNCH
#define MK_ONE_LAUNCH 1
#endif

#define LAS __attribute__((address_space(3)))
typedef unsigned short bf16_t;
typedef short bf16x8 __attribute__((ext_vector_type(8)));
typedef short s16x4 __attribute__((ext_vector_type(4)));
typedef float f32x2 __attribute__((ext_vector_type(2)));
typedef float f32x4 __attribute__((ext_vector_type(4)));
typedef float f32x16 __attribute__((ext_vector_type(16)));
typedef unsigned u32x2 __attribute__((ext_vector_type(2)));
typedef unsigned u32x4 __attribute__((ext_vector_type(4)));
typedef __bf16 bf16x2_t __attribute__((ext_vector_type(2)));

constexpr int NB = 2, SEQ = 4096, T = NB * SEQ, DM = 2048, HD = 128, NHF = 8, DIN = 7176, NPROJ = 7168;
constexpr int NEXP = 16384, NE = 128;
constexpr float EPS = 1e-6f;
constexpr float SCALE = 0.08838834764831845f, LOG2E = 1.4426950408889634f;
constexpr int NWAVES = 8, NTHREADS = 512;

constexpr size_t MiB = 1u << 20;
constexpr size_t WS_CTL = 0, CTL_BYTES = 4096;
constexpr size_t WS_WIN = 1 * MiB, WS_WOUT = 29 * MiB, WS_WPQ = 37 * MiB, WS_SK = 45 * MiB, WS_LOGF = 46 * MiB, WS_C = 46 * MiB + 512 * 1024, WS_SSQ = 47 * MiB;
constexpr size_t WS_XN = 48 * MiB;
constexpr size_t WS_SEC = 80 * MiB;
constexpr size_t SEC_ELEMS = 8u << 20;
constexpr size_t WS_MIX = 192 * MiB, WS_HB = 224 * MiB, WS_QP = 256 * MiB, WS_IDX = 288 * MiB, WS_GW = 292 * MiB, WS_U8 = 296 * MiB, WS_V8 = 328 * MiB, WS_SUV = 360 * MiB  , WS_RT = 360 * MiB + 256 * 1024  , WS_W = 361 * MiB  ,
                 WS_PART = 368 * MiB  , WS_END = 432 * MiB;

constexpr int RING_BYTES = 131072;
constexpr int MISC_OFF = 143360;
constexpr int LDS_BYTES = 147456;

__device__ __forceinline__ unsigned cvt_pk_bf16(float lo, float hi) { unsigned r; asm volatile("v_cvt_pk_bf16_f32 %0, %1, %2" : "=v"(r) : "v"(lo), "v"(hi)); return r; }
__device__ __forceinline__ float bf_lo(unsigned u) { return __builtin_bit_cast(float, u << 16); }
__device__ __forceinline__ float bf_hi(unsigned u) { return __builtin_bit_cast(float, u & 0xffff0000u); }
__device__ __forceinline__ float wave_sum(float v) {
#pragma unroll
    for (int o = 1; o < 64; o <<= 1) v += __shfl_xor(v, o);
    return v;
}
__device__ __forceinline__ float wave_max(float v) {
#pragma unroll
    for (int o = 1; o < 64; o <<= 1) v = fmaxf(v, __shfl_xor(v, o));
    return v;
}
#define LDS_WAIT() asm volatile("s_waitcnt lgkmcnt(0)" ::: "memory")

namespace pg8 {
#define PG8_LAS __attribute__((address_space(3)))
constexpr int BM = 256, BK = 64, HALF = 128, HTB = HALF * BK * 2, STAGE_BYTES = 8 * HTB, NXCD = 8, WGM = 8;
__host__ __device__ __forceinline__ int lds_byte(int r, int c) { const int st = (r >> 4) * 2 + (c >> 5), rr = r & 15, cc = c & 31, ob = rr * 64 + cc * 2; return st * 1024 + (ob ^ (((ob >> 9) & 1) << 5)); }
__host__ __device__ __forceinline__ void stage_rc(int b, int& R, int& C) { const int st = b / 1024, sb = b % 1024, swz = sb ^ (((sb >> 9) & 1) << 5); R = (st >> 1) * 16 + swz / 64; C = (st & 1) * 32 + (swz % 64) / 2; }
__host__ __device__ __forceinline__ int perm32(int rho) { const int n = rho >> 4, i = rho & 15; return 8 * (i >> 2) + 4 * n + (i & 3); }
struct Unit { int pm, pn; };
struct Gemm { const bf16_t* A; const bf16_t* Bt; int M, N, K; };
struct StaticOrder {
    int nM, nN, nwg, G, c;
    __host__ __device__ void init(int M, int N, int G_, int c_) { nM = M / BM; nN = N / BM; nwg = nM * nN; G = G_; c = c_; }
    __host__ __device__ bool next(int i, Unit& u) const {
        const long L = (long)i * G + c; if (L >= nwg) return false;
        int wgid = (int)L; { const int q = nwg / NXCD, r = nwg % NXCD, xcd = wgid % NXCD, off = wgid / NXCD; wgid = (xcd < r ? xcd * (q + 1) : r * (q + 1) + (xcd - r) * q) + off; }
        const int nig = WGM * nN, gid = wgid / nig, fm = gid * WGM, gsz = (nM - fm) < WGM ? (nM - fm) : WGM;
        u.pm = fm + ((wgid % nig) % gsz); u.pn = (wgid % nig) / gsz; return true;
    }
    __device__ __forceinline__ void a_ready(const Unit&) const {}
    __device__ __forceinline__ void done(const Unit&) const {}
};

template <class Epi, class Sched, bool ALIGN_EPI = false, bool SP2 = false>
__device__ __forceinline__ void gemm_phase(PG8_LAS unsigned char* lds, const Gemm g, const Sched& S, const Epi& E) {
    const int tid = threadIdx.x, wid = __builtin_amdgcn_readfirstlane(tid >> 6), lane = tid & 63, wr = wid >> 2, wc = wid & 3, fr = lane & 15, fq = lane >> 4;
    const int K = g.K, nt = K / BK;
    unsigned voffA[2], voffB[2];
#pragma unroll
    for (int i = 0; i < 2; ++i) { int R, C; stage_rc(tid * 16 + i * 8192, R, C); const int Rb = Epi::PERM ? ((R & ~31) + perm32(R & 31)) : R;
        voffA[i] = (unsigned)(R * K + C) * 2u; voffB[i] = (unsigned)(Rb * K + C) * 2u; }
    const size_t kstep = (size_t)(BK * 2);
    const size_t hstep = (size_t)HALF * K * 2;
    const size_t tstep = 2 * hstep;
    const unsigned ldsw = (unsigned)wid * 1024u;
    const int aoff = lds_byte(wr * 64 + fr, fq * 8), boff = lds_byte(wc * 32 + fr, fq * 8);
#define PG8_SA(b, h) (((b) * 2 + (h)) * HTB)
#define PG8_SB(b, h) ((4 + (b) * 2 + (h)) * HTB)
#define PG8_STAGE(bufoff, gbase, voff) do { _Pragma("unroll") for (int _i = 0; _i < 2; ++_i) \
        __builtin_amdgcn_global_load_lds((const unsigned*)((const char*)(gbase) + (voff)[_i]), (PG8_LAS unsigned*)(lds + (bufoff) + ldsw + _i * 8192), 16, 0, 0); } while (0)
#define PG8_LDA(dst, b, h) do { _Pragma("unroll") for (int m = 0; m < 4; ++m) _Pragma("unroll") for (int k = 0; k < 2; ++k) dst[m][k] = *(const PG8_LAS bf16x8*)(lds + PG8_SA(b, h) + aoff + m * 2048 + k * 1024); } while (0)
#define PG8_LDB(dst, b, h) do { _Pragma("unroll") for (int n = 0; n < 2; ++n) _Pragma("unroll") for (int k = 0; k < 2; ++k) dst[n][k] = *(const PG8_LAS bf16x8*)(lds + PG8_SB(b, h) + boff + n * 2048 + k * 1024); } while (0)
#define PG8_MMA(ai, bj, At, Bt) do { __builtin_amdgcn_s_setprio(1); _Pragma("unroll") for (int m = 0; m < 4; ++m) _Pragma("unroll") for (int n = 0; n < 2; ++n) _Pragma("unroll") for (int k = 0; k < 2; ++k) \
        acc[ai][bj][m][n] = __builtin_amdgcn_mfma_f32_16x16x32_bf16(Bt[n][k], At[m][k], acc[ai][bj][m][n], 0, 0, 0); __builtin_amdgcn_s_setprio(0); } while (0)
#define PG8_WAIT_V(n) asm volatile("s_waitcnt vmcnt(" #n ")" ::: "memory")
#define PG8_WAIT_L(n) asm volatile("s_waitcnt lgkmcnt(" #n ")" ::: "memory")
#define PG8_BAR __builtin_amdgcn_s_barrier()
#define PG8_SCHED __builtin_amdgcn_sched_barrier(0)
    Unit cur, nxt; int ui = 0;
    if (!S.next(0, cur)) return;
    f32x4 acc[2][2][4][2];
#pragma unroll
    for (int a = 0; a < 2; ++a)
#pragma unroll
        for (int b = 0; b < 2; ++b)
#pragma unroll
            for (int m = 0; m < 4; ++m)
#pragma unroll
                for (int n = 0; n < 2; ++n) acc[a][b][m][n] = (f32x4){0.f, 0.f, 0.f, 0.f};
    bf16x8 At[4][2], B0[2][2], B1[2][2];
    const char* cA = (const char*)g.A + (size_t)cur.pm * tstep; const char* cB = (const char*)g.Bt + (size_t)cur.pn * tstep;
    S.a_ready(cur);
    if constexpr (SP2) {
        PG8_STAGE(PG8_SB(0, 0), cB, voffB); PG8_STAGE(PG8_SB(0, 1), cB + hstep, voffB); PG8_STAGE(PG8_SA(0, 0), cA, voffA); PG8_STAGE(PG8_SA(0, 1), cA + hstep, voffA);
        if (wr == 1) PG8_BAR;
        PG8_WAIT_V(2); PG8_BAR;
        PG8_STAGE(PG8_SB(1, 0), cB + kstep, voffB); PG8_STAGE(PG8_SA(1, 0), cA + kstep, voffA); PG8_STAGE(PG8_SB(1, 1), cB + hstep + kstep, voffB);
        PG8_WAIT_V(6); PG8_BAR;
    } else {
        PG8_STAGE(PG8_SB(0, 0), cB, voffB); PG8_STAGE(PG8_SA(0, 0), cA, voffA); PG8_STAGE(PG8_SB(0, 1), cB + hstep, voffB); PG8_STAGE(PG8_SA(0, 1), cA + hstep, voffA);
        if (wr == 1) PG8_BAR;
        PG8_WAIT_V(4); PG8_BAR;
        PG8_STAGE(PG8_SB(1, 0), cB + kstep, voffB); PG8_STAGE(PG8_SA(1, 0), cA + kstep, voffA); PG8_STAGE(PG8_SB(1, 1), cB + hstep + kstep, voffB);
        PG8_WAIT_V(6); PG8_BAR;
    }
    for (;;) {
        const bool has_next = S.next(ui + 1, nxt);
        const char* nA = has_next ? (const char*)g.A + (size_t)nxt.pm * tstep : cA; const char* nB = has_next ? (const char*)g.Bt + (size_t)nxt.pn * tstep : cB;
        for (int t = 0; t < nt; t += 2) {
            const bool last = (t == nt - 2);
            const char* a1 = cA + (size_t)(t + 1) * kstep;
            const char* a2 = last ? nA : cA + (size_t)(t + 2) * kstep; const char* b2 = last ? nB : cB + (size_t)(t + 2) * kstep;
            const char* a3 = a2 + kstep; const char* b3 = b2 + kstep;
            if (last && has_next) S.a_ready(nxt);
            if constexpr (SP2) {
            PG8_LDB(B0, 0, 0); PG8_LDB(B1, 0, 1); PG8_SCHED; PG8_LDA(At, 0, 0); PG8_STAGE(PG8_SA(1, 1), a1 + hstep, voffA);
            PG8_WAIT_V(8); PG8_WAIT_L(0); PG8_BAR; PG8_MMA(0, 0, At, B0); PG8_MMA(0, 1, At, B1); PG8_BAR; PG8_SCHED;
            PG8_LDA(At, 0, 1); PG8_STAGE(PG8_SB(0, 0), b2, voffB); PG8_STAGE(PG8_SB(0, 1), b2 + hstep, voffB); PG8_STAGE(PG8_SA(0, 0), a2, voffA);
            PG8_WAIT_V(8); PG8_WAIT_L(0); PG8_BAR; PG8_MMA(1, 0, At, B0); PG8_MMA(1, 1, At, B1); PG8_BAR; PG8_SCHED;
            PG8_LDB(B0, 1, 0); PG8_LDB(B1, 1, 1); PG8_SCHED; PG8_LDA(At, 1, 0); PG8_STAGE(PG8_SA(0, 1), a2 + hstep, voffA);
            PG8_WAIT_V(8); PG8_WAIT_L(0); PG8_BAR; PG8_MMA(0, 0, At, B0); PG8_MMA(0, 1, At, B1); PG8_BAR; PG8_SCHED;
            PG8_LDA(At, 1, 1); PG8_STAGE(PG8_SB(1, 0), b3, voffB); PG8_STAGE(PG8_SB(1, 1), b3 + hstep, voffB); PG8_STAGE(PG8_SA(1, 0), a3, voffA);
            PG8_WAIT_V(8); PG8_WAIT_L(0); PG8_BAR; PG8_MMA(1, 0, At, B0); PG8_MMA(1, 1, At, B1); PG8_BAR; PG8_SCHED;
            } else {
            PG8_LDB(B0, 0, 0); PG8_SCHED; PG8_LDA(At, 0, 0); PG8_STAGE(PG8_SA(1, 1), a1 + hstep, voffA);
            PG8_WAIT_L(8); PG8_BAR; PG8_WAIT_L(0); PG8_MMA(0, 0, At, B0); PG8_BAR; PG8_SCHED;
            PG8_LDB(B1, 0, 1); PG8_STAGE(PG8_SB(0, 0), b2, voffB);
            PG8_BAR; PG8_WAIT_L(0); PG8_MMA(0, 1, At, B1); PG8_BAR;
            PG8_LDA(At, 0, 1); PG8_STAGE(PG8_SA(0, 0), a2, voffA);
            PG8_BAR; PG8_WAIT_L(0); PG8_MMA(1, 0, At, B0); PG8_BAR; PG8_SCHED;
            PG8_STAGE(PG8_SB(0, 1), b2 + hstep, voffB);
            PG8_WAIT_V(6); PG8_BAR; PG8_MMA(1, 1, At, B1); PG8_BAR;
            PG8_LDB(B0, 1, 0); PG8_SCHED; PG8_LDA(At, 1, 0); PG8_STAGE(PG8_SA(0, 1), a2 + hstep, voffA);
            PG8_WAIT_L(8); PG8_BAR; PG8_WAIT_L(0); PG8_MMA(0, 0, At, B0); PG8_BAR; PG8_SCHED;
            PG8_LDB(B1, 1, 1); PG8_STAGE(PG8_SB(1, 0), b3, voffB);
            PG8_BAR; PG8_WAIT_L(0); PG8_MMA(0, 1, At, B1); PG8_BAR;
            PG8_LDA(At, 1, 1); PG8_STAGE(PG8_SA(1, 0), a3, voffA);
            PG8_BAR; PG8_WAIT_L(0); PG8_MMA(1, 0, At, B0); PG8_BAR; PG8_SCHED;
            PG8_STAGE(PG8_SB(1, 1), b3 + hstep, voffB);
            PG8_WAIT_V(6); PG8_BAR; PG8_MMA(1, 1, At, B1); PG8_BAR;
            }
        }
        if constexpr (ALIGN_EPI) { if (wr == 0) PG8_BAR; }
        E(acc, cur, wr, wc, fr, fq); S.done(cur);
        if (!has_next) break;
#pragma unroll
        for (int a = 0; a < 2; ++a)
#pragma unroll
            for (int b = 0; b < 2; ++b)
#pragma unroll
                for (int m = 0; m < 4; ++m)
#pragma unroll
                    for (int n = 0; n < 2; ++n) acc[a][b][m][n] = (f32x4){0.f, 0.f, 0.f, 0.f};
        cur = nxt; cA = nA; cB = nB; ++ui;
        if constexpr (ALIGN_EPI) { if (wr == 1) PG8_BAR; }
    }
    PG8_WAIT_V(0);
    if constexpr (!ALIGN_EPI) { if (wr == 0) PG8_BAR; }
    PG8_BAR;
#undef PG8_SA
#undef PG8_SB
#undef PG8_STAGE
#undef PG8_LDA
#undef PG8_LDB
#undef PG8_MMA
#undef PG8_WAIT_V
#undef PG8_WAIT_L
#undef PG8_BAR
#undef PG8_SCHED
}

__device__ __forceinline__ float sigmoidf_fast(float x) { return __builtin_amdgcn_rcpf(1.f + __builtin_amdgcn_exp2f(-x * LOG2E)); }
struct EpiInProj {
    static constexpr bool PERM = true;
    bf16_t* base;
    __device__ __forceinline__ void operator()(const f32x4 (&acc)[2][2][4][2], const Unit& u, int wr, int wc, int fr, int fq) const {
        const int sec = u.pn >> 2;
        bf16_t* sb = base + (size_t)sec * SEC_ELEMS;
        const float sc = (sec == 4) ? SCALE * LOG2E : 1.f;
#pragma unroll
        for (int ai = 0; ai < 2; ++ai)
#pragma unroll
            for (int m = 0; m < 4; ++m) {
                const int tk = u.pm * BM + ai * HALF + wr * 64 + m * 16 + fr, b = tk >> 12, s = tk & 4095;
#pragma unroll
                for (int bj = 0; bj < 2; ++bj) {
                    const int hh = (u.pn & 3) * 2 + bj;
                    f32x4 v0 = acc[ai][bj][m][0], v1 = acc[ai][bj][m][1];
                    bf16_t* dst;
                    if (sec == 3) {
#pragma unroll
                        for (int i = 0; i < 4; ++i) { v0[i] = sigmoidf_fast(v0[i]); v1[i] = sigmoidf_fast(v1[i]); }
                        dst = sb + (size_t)tk * 1024 + hh * 128 + wc * 32 + 8 * fq;
                    } else {
                        v0 = v0 * sc; v1 = v1 * sc;
                        dst = sb + ((size_t)((b * 8 + hh) * 4096 + s)) * 128 + wc * 32 + 8 * fq;
                    }
                    u32x4 w; w.x = cvt_pk_bf16(v0[0], v0[1]); w.y = cvt_pk_bf16(v0[2], v0[3]); w.z = cvt_pk_bf16(v1[0], v1[1]); w.w = cvt_pk_bf16(v1[2], v1[3]);
                    *(u32x4*)dst = w;
                }
            }
    }
};
struct EpiOutProj {
    static constexpr bool PERM = true;
    const float* x; float* h; bf16_t* hb; float* ssq;
    __device__ __forceinline__ void operator()(const f32x4 (&acc)[2][2][4][2], const Unit& u, int wr, int wc, int fr, int fq) const {
#pragma unroll
        for (int ai = 0; ai < 2; ++ai)
#pragma unroll
            for (int m = 0; m < 4; ++m) {
                const int tk = u.pm * BM + ai * HALF + wr * 64 + m * 16 + fr;
                float ss = 0.f;
#pragma unroll
                for (int bj = 0; bj < 2; ++bj) {
                    const size_t off = (size_t)tk * DM + u.pn * BM + bj * HALF + wc * 32 + 8 * fq;
                    const f32x4 x0 = *(const f32x4*)(x + off), x1 = *(const f32x4*)(x + off + 4);
                    const f32x4 v0 = acc[ai][bj][m][0] + x0, v1 = acc[ai][bj][m][1] + x1;
                    *(f32x4*)(h + off) = v0; *(f32x4*)(h + off + 4) = v1;
                    u32x4 w; w.x = cvt_pk_bf16(v0[0], v0[1]); w.y = cvt_pk_bf16(v0[2], v0[3]); w.z = cvt_pk_bf16(v1[0], v1[1]); w.w = cvt_pk_bf16(v1[2], v1[3]);
                    *(u32x4*)(hb + off) = w;
                    ss += v0[0] * v0[0] + v0[1] * v0[1] + v0[2] * v0[2] + v0[3] * v0[3] + v1[0] * v1[0] + v1[1] * v1[1] + v1[2] * v1[2] + v1[3] * v1[3];
                }
                ss += __shfl_xor(ss, 16); ss += __shfl_xor(ss, 32);
                if (fq == 0) ssq[(size_t)tk * 32 + u.pn * 4 + wc] = ss;
            }
    }
};
struct EpiPeerQ {
    static constexpr bool PERM = true;
    const float* ssq; bf16_t* qp; float* rtab;
    __device__ __forceinline__ void operator()(const f32x4 (&acc)[2][2][4][2], const Unit& u, int wr, int wc, int fr, int fq) const {
#pragma unroll
        for (int ai = 0; ai < 2; ++ai)
#pragma unroll
            for (int m = 0; m < 4; ++m) {
                const int tk = u.pm * BM + ai * HALF + wr * 64 + m * 16 + fr;
                float tot = 0.f;
#pragma unroll
                for (int i = 0; i < 8; ++i) { const f32x4 s4 = *(const f32x4*)(ssq + (size_t)tk * 32 + 4 * i); tot += (s4[0] + s4[1]) + (s4[2] + s4[3]); }
                const float r = 1.0f / sqrtf(tot * (1.f / DM) + EPS);
                if (u.pn == 0 && wc == 0 && fq == 0) rtab[tk] = r;
#pragma unroll
                for (int bj = 0; bj < 2; ++bj) {
                    const size_t off = (size_t)tk * DM + u.pn * BM + bj * HALF + wc * 32 + 8 * fq;
                    const f32x4 v0 = acc[ai][bj][m][0] * r, v1 = acc[ai][bj][m][1] * r;
                    u32x4 w; w.x = cvt_pk_bf16(v0[0], v0[1]); w.y = cvt_pk_bf16(v0[2], v0[3]); w.z = cvt_pk_bf16(v1[0], v1[1]); w.w = cvt_pk_bf16(v1[2], v1[3]);
                    *(u32x4*)(qp + off) = w;
                }
            }
    }
};
}

namespace att {
constexpr int NW = 8, QBLK = 32, KVBLK = 64, QB = NW * QBLK, D = 128;
constexpr int SHM_V = KVBLK * D * 2, SHM_K = KVBLK * D * 2;
constexpr int OFF_WS = 2 * SHM_V + 2 * SHM_K, OFF_BIAS = OFF_WS + NW * 64 * 4, ATT_LDS = OFF_BIAS + SEQ * 4;
#define KSWZ(row, colB) ((row) * 256 + ((colB) ^ (((row) & 7) << 4)))
#define SBAR() __builtin_amdgcn_sched_barrier(0)
__device__ __forceinline__ int v_st(int k, int c) { const int kk = (k & ~0xC) | ((k & 4) << 1) | ((k & 8) >> 1); return ((kk >> 3) * 4 + (c >> 5)) * 512 + ((kk & 7) * 32 + (c & 31)) * 2; }
__device__ __forceinline__ int v_rd_base(int lane) { return ((lane & 3) << 3) | (((lane >> 2) & 3) << 6) | (((lane >> 4) & 1) << 5) | (((lane >> 5) & 1) << 8); }
constexpr int v_rd_off(int d0, int ks, int half) { return d0 * 512 + ks * 4096 + half * 2048; }
__device__ __forceinline__ int crow(int r, int hi) { return (r & 3) + 8 * (r >> 2) + 4 * hi; }
__device__ __forceinline__ bf16x8 load8(const bf16_t* p) { return *reinterpret_cast<const bf16x8*>(p); }
__device__ __forceinline__ void mask_tile(f32x16& p0, f32x16& p1, int dq) {
    const float NEG = -__builtin_inff();
#pragma unroll
    for (int r = 0; r < 16; ++r) {
        const int c = (r & 3) + 8 * (r >> 2);
        if (dq - c < 0) p0[r] = NEG;
        if (dq - c - 32 < 0) p1[r] = NEG;
    }
}
__device__ __forceinline__ void partialSM(f32x16& p0, f32x16& p1, float& m_reg, float& mn, float& alpha) {
    float pmax = p0[0];
#pragma unroll
    for (int r = 1; r < 16; ++r) pmax = fmaxf(pmax, p0[r]);
#pragma unroll
    for (int r = 0; r < 16; ++r) pmax = fmaxf(pmax, p1[r]);
    { auto rr = __builtin_amdgcn_permlane32_swap(__float_as_uint(pmax), __float_as_uint(pmax), false, false);
      pmax = fmaxf(__uint_as_float(rr[0]), __uint_as_float(rr[1])); }
    constexpr float C2 = LOG2E * SCALE; constexpr float THR = 8.f;
    if (__builtin_expect(__all((pmax - m_reg) * SCALE <= THR), 1)) { mn = m_reg; alpha = 1.f; }
    else { mn = fmaxf(m_reg, pmax); alpha = __builtin_amdgcn_exp2f((m_reg - mn) * C2); m_reg = mn; }
    const float mnL = -mn * C2;
#pragma unroll
    for (int r = 0; r < 16; ++r) p0[r] = fmaf(p0[r], C2, mnL);
#pragma unroll
    for (int r = 0; r < 16; ++r) p1[r] = fmaf(p1[r], C2, mnL);
#pragma unroll
    for (int r = 0; r < 16; ++r) p0[r] = __builtin_amdgcn_exp2f(p0[r]);
}
#define PK4(P, B_, OUT) do { unsigned a0 = cvt_pk_bf16(P[B_+0], P[B_+1]), a1 = cvt_pk_bf16(P[B_+2], P[B_+3]);                          \
        unsigned b0 = cvt_pk_bf16(P[B_+4], P[B_+5]), b1 = cvt_pk_bf16(P[B_+6], P[B_+7]);                                             \
        auto r0 = __builtin_amdgcn_permlane32_swap(a0, b0, false, false); auto r1 = __builtin_amdgcn_permlane32_swap(a1, b1, false, false); \
        u32x4 w = {r0[0], r1[0], r0[1], r1[1]}; OUT = *reinterpret_cast<bf16x8*>(&w); } while (0)
__device__ __forceinline__ void finishSM(f32x16& p0, f32x16& p1, float alpha, float& l_reg, bf16x8& pa0, bf16x8& pa1, bf16x8& pa2, bf16x8& pa3) {
#pragma unroll
    for (int r = 0; r < 16; ++r) p1[r] = __builtin_amdgcn_exp2f(p1[r]);
    float ps = 0;
#pragma unroll
    for (int r = 0; r < 16; ++r) ps += p0[r];
#pragma unroll
    for (int r = 0; r < 16; ++r) ps += p1[r];
    { auto rr = __builtin_amdgcn_permlane32_swap(__float_as_uint(ps), __float_as_uint(ps), false, false);
      ps = __uint_as_float(rr[0]) + __uint_as_float(rr[1]); }
    l_reg = l_reg * alpha + ps;
    PK4(p0, 0, pa0); PK4(p0, 8, pa1); PK4(p1, 0, pa2); PK4(p1, 8, pa3);
}
__device__ __forceinline__ void sb_group(f32x16& P, int g, float& gs) {
    float run = 0.f;
#pragma unroll
    for (int k = 3; k >= 0; --k) {
        const float z = P[4 * g + k];
        const float t = __builtin_amdgcn_exp2f(-fabsf(z));
        const float l = __builtin_amdgcn_logf(1.f + t);
        const float sp = fmaxf(z, 0.f) + l;
        P[4 * g + k] = (z - sp) - run;
        run += sp;
    }
    gs = run;
}
__device__ __forceinline__ void sb_part1(f32x16& p0, f32x16& p1, float& carry, float mlo) {
    float gs[8];
#pragma unroll
    for (int g = 0; g < 4; ++g) sb_group(p0, g, gs[g]);
#pragma unroll
    for (int g = 0; g < 4; ++g) sb_group(p1, g, gs[4 + g]);
    float run = carry;
#pragma unroll
    for (int G = 7; G >= 0; --G) {
        auto rr = __builtin_amdgcn_permlane32_swap(__float_as_uint(gs[G]), __float_as_uint(gs[G]), false, false);
        const float slo = __uint_as_float(rr[0]), shi = __uint_as_float(rr[1]);
        const float base = fmaf(mlo, shi, run);
        if (G >= 4) {
#pragma unroll
            for (int k = 0; k < 4; ++k) p1[4 * (G - 4) + k] -= base;
        } else {
#pragma unroll
            for (int k = 0; k < 4; ++k) p0[4 * G + k] -= base;
        }
        run += slo + shi;
    }
    carry = run;
#pragma unroll
    for (int r = 0; r < 16; ++r) p0[r] = __builtin_amdgcn_exp2f(p0[r]);
}
__device__ __forceinline__ void sb_part2(f32x16& p0, f32x16& p1, bf16x8& pa0, bf16x8& pa1, bf16x8& pa2, bf16x8& pa3) {
#pragma unroll
    for (int r = 0; r < 16; ++r) p1[r] = __builtin_amdgcn_exp2f(p1[r]);
    PK4(p0, 0, pa0); PK4(p0, 8, pa1); PK4(p1, 0, pa2); PK4(p1, 8, pa3);
}
#undef PK4
template <int KB, bool BIAS>
__device__ __forceinline__ void qkt(f32x16& p0, f32x16& p1, const char* K_lds, int r32, int hi, const bf16x8* qr, const float* bt) {
    if constexpr (BIAS) {
#pragma unroll
        for (int g = 0; g < 4; ++g) { const f32x4 a = *(const f32x4*)(bt + 8 * g), b = *(const f32x4*)(bt + 32 + 8 * g);
            p0[4 * g] = a[0]; p0[4 * g + 1] = a[1]; p0[4 * g + 2] = a[2]; p0[4 * g + 3] = a[3];
            p1[4 * g] = b[0]; p1[4 * g + 1] = b[1]; p1[4 * g + 2] = b[2]; p1[4 * g + 3] = b[3]; }
    } else { p0 = f32x16{}; p1 = f32x16{}; }
    const char* kb[4];
#pragma unroll
    for (int dd = 0; dd < 4; ++dd) kb[dd] = K_lds + KB * SHM_K + KSWZ(r32, (dd * 16 + hi * 8) * 2);
#pragma unroll
    for (int d0 = 0; d0 < 8; ++d0) { const char* a = kb[d0 & 3] + (d0 >> 2) * 128;
        bf16x8 b0 = *reinterpret_cast<const bf16x8*>(a);
        bf16x8 b1 = *reinterpret_cast<const bf16x8*>(a + 32 * 256);
        p0 = __builtin_amdgcn_mfma_f32_32x32x16_bf16(b0, qr[d0], p0, 0, 0, 0);
        p1 = __builtin_amdgcn_mfma_f32_32x32x16_bf16(b1, qr[d0], p1, 0, 0, 0); }
}
template <int VB>
__device__ __forceinline__ void pv_tile(f32x16* o, int vb0, bf16x8 pa0, bf16x8 pa1, bf16x8 pa2, bf16x8 pa3) {
#define TRRD(dst, off) asm volatile("ds_read_b64_tr_b16 %0, %1 offset:%2" : "=&v"(dst) : "v"(vb0), "i"(off) : "memory")
#define PV_D0(d0) do { s16x4 l0, l1, l2, l3, h0, h1, h2, h3; constexpr int b_ = VB * SHM_V + v_rd_off(d0, 0, 0); \
        TRRD(l0, b_); TRRD(h0, b_ + 2048); TRRD(l1, b_ + 4096); TRRD(h1, b_ + 6144); TRRD(l2, b_ + 8192); TRRD(h2, b_ + 10240); TRRD(l3, b_ + 12288); TRRD(h3, b_ + 14336); \
        asm volatile("s_waitcnt lgkmcnt(0)" ::: "memory"); SBAR();   \
        o[d0] = __builtin_amdgcn_mfma_f32_32x32x16_bf16(pa0, (bf16x8){l0[0], l0[1], l0[2], l0[3], h0[0], h0[1], h0[2], h0[3]}, o[d0], 0, 0, 0);   \
        o[d0] = __builtin_amdgcn_mfma_f32_32x32x16_bf16(pa1, (bf16x8){l1[0], l1[1], l1[2], l1[3], h1[0], h1[1], h1[2], h1[3]}, o[d0], 0, 0, 0);   \
        o[d0] = __builtin_amdgcn_mfma_f32_32x32x16_bf16(pa2, (bf16x8){l2[0], l2[1], l2[2], l2[3], h2[0], h2[1], h2[2], h2[3]}, o[d0], 0, 0, 0);   \
        o[d0] = __builtin_amdgcn_mfma_f32_32x32x16_bf16(pa3, (bf16x8){l3[0], l3[1], l3[2], l3[3], h3[0], h3[1], h3[2], h3[3]}, o[d0], 0, 0, 0); } while (0)
    PV_D0(0); PV_D0(1); PV_D0(2); PV_D0(3);
#undef PV_D0
#undef TRRD
}

struct UnitRef { const bf16_t* Q; const bf16_t* K; const bf16_t* V; int P0; };
struct Seam { bf16x8 qr[8]; bf16x8 st_v0, st_v1, st_k0, st_k1; };
#define ROW(p, k0, rr) ((p) + (size_t)((k0) + (rr)) * D + sc)
#define VMW() asm volatile("s_waitcnt vmcnt(0)" ::: "memory")
#define SLOAD_H(Kp, Vp, k0) do { S.st_v0 = load8(ROW(Vp, k0, sr)); S.st_v1 = load8(ROW(Vp, k0, 32 + sr));              \
                         S.st_k0 = load8(ROW(Kp, k0, sr)); S.st_k1 = load8(ROW(Kp, k0, 32 + sr)); } while (0)
#define SWRITE_HK(bf) do { *(bf16x8*)(K_lds + (bf) * SHM_K + kws) = S.st_k0; *(bf16x8*)(K_lds + (bf) * SHM_K + kws + 32 * 256) = S.st_k1; } while (0)
#define SWRITE_HV(bf) do { *(bf16x8*)(V_lds + (bf) * SHM_V + vst0) = S.st_v0; *(bf16x8*)(V_lds + (bf) * SHM_V + vst1) = S.st_v1; } while (0)
#define SWRITE_H(bf) do { SWRITE_HV(bf); SWRITE_HK(bf); } while (0)

template <bool SB>
__device__ __forceinline__ void attn_unit(const UnitRef& cur, const float* cvec  , const bf16_t* gate  ,
                                          bf16_t* outp  , char* lds) {
    const int tid = threadIdx.x, wid = __builtin_amdgcn_readfirstlane(tid >> 6), lane = tid & 63, r32 = lane & 31, hi = lane >> 5;
    const int NT = (cur.P0 + QB) / KVBLK;
#define KBASE(t) ((SB ? (NT - 1 - (t)) : (t)) * KVBLK)
    const int qlo = cur.P0 + wid * QBLK, qm = qlo + r32 - 4 * hi - (SB ? 1 : 0);
    char* V_lds = lds; char* K_lds = lds + 2 * SHM_V;
    float* ws = (float*)(lds + OFF_WS) + wid * 64; float* li_l = ws, * al_l = ws + 32;
    float* bias = (float*)(lds + OFF_BIAS);
    const int sr = tid >> 4, sc = (tid & 15) * 8, vst0 = v_st(sr, sc), vst1 = v_st(32 + sr, sc), kws = KSWZ(sr, sc * 2);
    const int vb0 = (int)(uintptr_t)V_lds + v_rd_base(lane);
    const bf16_t* Kh = cur.K; const bf16_t* Vh = cur.V;
    Seam S;
    if constexpr (!SB) { const float cq0 = cvec[cur.P0]; for (int j = tid; j < cur.P0 + QB; j += NTHREADS) bias[j] = (cq0 - cvec[j]) * (1.f / SCALE); }
#pragma unroll
    for (int d0 = 0; d0 < 8; ++d0) S.qr[d0] = load8(cur.Q + (size_t)(wid * QBLK + r32) * D + d0 * 16 + hi * 8);
    SLOAD_H(Kh, Vh, KBASE(0)); VMW(); SWRITE_HK(0);
    __syncthreads();
    float m_reg = -1e30f, l_reg = 0; f32x16 o[4] = {};
    float carry = 0.f; const float mlo = hi ? 0.f : 1.f;
#define RESC(a) do { if (__any((a) < 1.f)) { if (hi == 0) al_l[r32] = (a); asm volatile("s_waitcnt lgkmcnt(0)" ::: "memory");              \
                     for (int d_ = 0; d_ < 4; ++d_) for (int r = 0; r < 16; ++r) o[d_][r] *= al_l[crow(r, hi)]; } } while (0)
#define MASKT(P0_, P1_, t) do { const int kb_ = KBASE(t); if (kb_ + KVBLK - 1 > qlo - (SB ? 1 : 0)) mask_tile(P0_, P1_, qm - kb_); } while (0)
#define BT(t) (bias + KBASE(t) + 4 * hi)
#define PART1(PX0, PX1, mnX, alX) do { if constexpr (SB) sb_part1(PX0, PX1, carry, mlo); else partialSM(PX0, PX1, m_reg, mnX, alX); } while (0)
#define PART2(PY0, PY1, alY) do { if constexpr (SB) sb_part2(PY0, PY1, pa0, pa1, pa2, pa3); else finishSM(PY0, PY1, alY, l_reg, pa0, pa1, pa2, pa3); } while (0)
    f32x16 pA0, pA1, pB0, pB1; float mnA = 0.f, mnB = 0.f, alA = 1.f, alB = 1.f; bf16x8 pa0, pa1, pa2, pa3;
    SWRITE_HV(0); SBAR();
    if (NT > 1) SLOAD_H(Kh, Vh, KBASE(1));
    SBAR(); qkt<0, !SB>(pA0, pA1, K_lds, r32, hi, S.qr, BT(0));
    MASKT(pA0, pA1, 0); PART1(pA0, pA1, mnA, alA);
    if (NT > 1) { VMW(); SWRITE_H(1); }
    __syncthreads();
#define HALF_STEP(PX0, PX1, mnX, alX, PY0, PY1, alY, t, KB, VB, SBUF) do {                                                    \
        SBAR(); qkt<KB, !SB>(PX0, PX1, K_lds, r32, hi, S.qr, BT(t));                                                          \
        PART2(PY0, PY1, alY); SBAR();                                                                                          \
        if ((t) + 1 < NT) { SLOAD_H(Kh, Vh, KBASE((t) + 1)); SBAR(); }                                                         \
        pv_tile<VB>(o, vb0, pa0, pa1, pa2, pa3); MASKT(PX0, PX1, (t)); PART1(PX0, PX1, mnX, alX);                              \
        __syncthreads();                                                                                                      \
        if ((t) + 1 < NT) { VMW(); SWRITE_H(SBUF); }                                                                           \
        if constexpr (!SB) RESC(alX);                                                                                          \
        __syncthreads(); } while (0)
    for (int t = 1; t + 1 < NT; t += 2) {
        HALF_STEP(pB0, pB1, mnB, alB, pA0, pA1, alA, t, 1, 0, 0);
        HALF_STEP(pA0, pA1, mnA, alA, pB0, pB1, alB, t + 1, 0, 1, 1);
    }
    const bool even = (NT & 1) == 0;
    if (even) { SBAR(); qkt<1, !SB>(pB0, pB1, K_lds, r32, hi, S.qr, BT(NT - 1)); SBAR(); }
    PART2(pA0, pA1, alA); SBAR();
    pv_tile<0>(o, vb0, pa0, pa1, pa2, pa3);
    if (even) { MASKT(pB0, pB1, NT - 1); PART1(pB0, pB1, mnB, alB); __syncthreads(); if constexpr (!SB) RESC(alB);
        PART2(pB0, pB1, alB); SBAR(); pv_tile<1>(o, vb0, pa0, pa1, pa2, pa3); }
    float rli[16];
    if constexpr (!SB) {
        if (hi == 0) li_l[r32] = l_reg; asm volatile("s_waitcnt lgkmcnt(0)" ::: "memory");
#pragma unroll
        for (int r = 0; r < 16; ++r) rli[r] = __builtin_amdgcn_rcpf(li_l[crow(r, hi)]);
    }
#pragma unroll
    for (int r = 0; r < 16; ++r) { const int orow = cur.P0 + wid * QBLK + crow(r, hi);
#pragma unroll
        for (int d0 = 0; d0 < 4; ++d0) {
            float v = o[d0][r];
            if constexpr (!SB) { const unsigned short gb = gate[(size_t)orow * 1024 + d0 * 32 + r32]; v = v * rli[r] * __builtin_bit_cast(float, (unsigned)gb << 16); }
            const float vn = __shfl_xor(v, 1);
            if ((r32 & 1) == 0) *(unsigned*)(outp + (size_t)orow * DM + d0 * 32 + r32) = cvt_pk_bf16(v, vn); } }
    __syncthreads();
#undef RESC
#undef KBASE
#undef MASKT
#undef BT
#undef PART1
#undef PART2
#undef HALF_STEP
}

constexpr float SB_TH = 150.f;
__device__ __forceinline__ void sb_unit(const UnitRef& cur, bf16_t* outp, char* lds) {
    const int tid = threadIdx.x, wid = __builtin_amdgcn_readfirstlane(tid >> 6), lane = tid & 63, r32 = lane & 31, hi = lane >> 5;
    const int NT = (cur.P0 + QB) / KVBLK;
#define KBASE(t) ((NT - 1 - (t)) * KVBLK)
    const int qlo = cur.P0 + wid * QBLK, qm = qlo + r32 - 4 * hi - 1;
    char* V_lds = lds; char* K_lds = lds + 2 * SHM_V;
    volatile int* flags = (volatile int*)(lds + OFF_WS);
    const int sr = tid >> 4, sc = (tid & 15) * 8, vst0 = v_st(sr, sc), vst1 = v_st(32 + sr, sc), kws = KSWZ(sr, sc * 2);
    const int vb0 = (int)(uintptr_t)V_lds + v_rd_base(lane);
    const bf16_t* Kh = cur.K; const bf16_t* Vh = cur.V;
    Seam S;
#pragma unroll
    for (int d0 = 0; d0 < 8; ++d0) S.qr[d0] = load8(cur.Q + (size_t)(wid * QBLK + r32) * D + d0 * 16 + hi * 8);
    SLOAD_H(Kh, Vh, KBASE(0)); VMW(); SWRITE_H(0);
    __syncthreads();
    f32x16 o[4] = {}; float carry = 0.f; const float mlo = hi ? 0.f : 1.f;
    bool wdone = false;
#define SB_STEP(tt, BUF) {                                                                                                 \
        const int kb_ = KBASE(tt);                                                                                           \
        if ((tt) + 1 < NT) SLOAD_H(Kh, Vh, KBASE((tt) + 1));                                                                 \
        SBAR();                                                                                                              \
        if (!wdone && kb_ <= qlo + QBLK - 2) {                                                                               \
            f32x16 p0, p1; bf16x8 pa0, pa1, pa2, pa3;                                                                        \
            qkt<BUF, false>(p0, p1, K_lds, r32, hi, S.qr, nullptr);                                                          \
            if (kb_ + KVBLK - 1 > qlo - 1) mask_tile(p0, p1, qm - kb_);                                                      \
            sb_part1(p0, p1, carry, mlo); sb_part2(p0, p1, pa0, pa1, pa2, pa3); SBAR();                                      \
            pv_tile<BUF>(o, vb0, pa0, pa1, pa2, pa3);                                                                        \
            wdone = __all(carry >= SB_TH);                                                                                   \
        }                                                                                                                    \
        if ((tt) + 1 < NT) { VMW(); SWRITE_H((BUF) ^ 1); }                                                                   \
        if (lane == 0) flags[((tt) & 1) * 8 + wid] = wdone ? 1 : 0;                                                          \
        __syncthreads();                                                                                                     \
        { int alld = 1;                                                                                                      \
          _Pragma("unroll") for (int w_ = 0; w_ < 8; ++w_) alld &= flags[((tt) & 1) * 8 + w_];                                \
          if (alld) break; } }
    for (int t = 0; t < NT; t += 2) {
        SB_STEP(t, 0)
        SB_STEP(t + 1, 1)
    }
#undef SB_STEP
#pragma unroll
    for (int r = 0; r < 16; ++r) { const int orow = cur.P0 + wid * QBLK + crow(r, hi);
#pragma unroll
        for (int d0 = 0; d0 < 4; ++d0) {
            const float v = o[d0][r];
            const float vn = __shfl_xor(v, 1);
            if ((r32 & 1) == 0) *(unsigned*)(outp + (size_t)orow * DM + d0 * 32 + r32) = cvt_pk_bf16(v, vn); } }
    __syncthreads();
#undef KBASE
}
#undef ROW
#undef VMW
#undef SLOAD_H
#undef SWRITE_HK
#undef SWRITE_HV
#undef SWRITE_H
}

struct Args { const float* in[12]; float* out; unsigned char* ws; int ph_lo, ph_hi; };

__device__ __forceinline__ void p0_transpose_item(const float* W, int ldw, int K, bf16_t* WT, int nblk, LAS float* scr, int item, int lane, const float* gk) {
    const int kb = item / nblk, nb = item % nblk, k0 = 64 * kb, n0 = 32 * nb;
#pragma unroll 8
    for (int i = 0; i < 32; ++i) { const int kk = 2 * i + (lane >> 5); float w = W[(size_t)(k0 + kk) * ldw + n0 + (lane & 31)]; if (gk) w *= gk[k0 + kk]; scr[kk * 33 + (lane & 31)] = w; }
    LDS_WAIT(); asm volatile("" ::: "memory");
    const int c = lane & 7;
#pragma unroll
    for (int j = 0; j < 4; ++j) { const int n = (lane >> 3) + 8 * j; const LAS float* s = scr + (8 * c) * 33 + n;
        u32x4 o; o.x = cvt_pk_bf16(s[0 * 33], s[1 * 33]); o.y = cvt_pk_bf16(s[2 * 33], s[3 * 33]); o.z = cvt_pk_bf16(s[4 * 33], s[5 * 33]); o.w = cvt_pk_bf16(s[6 * 33], s[7 * 33]);
        *(u32x4*)(WT + (size_t)(n0 + n) * K + k0 + 8 * c) = o; }
    LDS_WAIT(); asm volatile("" ::: "memory");
}

__device__ __forceinline__ float log_sigmoid_f(float x) { return fminf(x, 0.f) - log1pf(expf(-fabsf(x))); }

__device__ __forceinline__ void phase0(const Args& a, unsigned char* lds_g) {
    LAS unsigned char* lds = (LAS unsigned char*)lds_g;
    const int tid = threadIdx.x, lane = tid & 63, wave = __builtin_amdgcn_readfirstlane(tid >> 6);
    const int gw = blockIdx.x * NWAVES + wave, NGW = gridDim.x * NWAVES;
    const int gt = blockIdx.x * NTHREADS + tid, NGT = gridDim.x * NTHREADS;
    unsigned char* ws = a.ws;
    const float* x = a.in[0]; const float* g_attn = a.in[1]; const float* w_in = a.in[2]; const float* b_forget = a.in[3];
    const float* w_out = a.in[6]; const float* g_ffn = a.in[7]; const float* w_pq = a.in[8]; const float* sk = a.in[9]; const float* pu = a.in[10]; const float* pv = a.in[11];
    LAS float* wf = (LAS float*)(lds + 67584);
    for (int k = tid; k < DM; k += NTHREADS) { const f32x4 a0 = *(const f32x4*)(w_in + (size_t)k * DIN + NPROJ), a1 = *(const f32x4*)(w_in + (size_t)k * DIN + NPROJ + 4);
        *(LAS f32x4*)(wf + k * 8) = a0; *(LAS f32x4*)(wf + k * 8 + 4) = a1; }
    __syncthreads();
    for (int row = gw; row < T; row += NGW) {
        const f32x4* xr = (const f32x4*)(x + (size_t)row * DM);
        f32x4 v[8]; float ss = 0.f;
#pragma unroll
        for (int j = 0; j < 8; ++j) { v[j] = xr[lane + 64 * j]; ss += v[j][0] * v[j][0] + v[j][1] * v[j][1] + v[j][2] * v[j][2] + v[j][3] * v[j][3]; }
        const float r = 1.0f / sqrtf(wave_sum(ss) * (1.f / DM) + EPS);
        float f[8] = {0.f, 0.f, 0.f, 0.f, 0.f, 0.f, 0.f, 0.f};
        u32x2* o8 = (u32x2*)(ws + WS_XN + (size_t)row * DM * 2);
#pragma unroll
        for (int j = 0; j < 8; ++j) {
            const int e = 4 * (lane + 64 * j);
            const f32x4 g4 = *(const f32x4*)(g_attn + e);
            f32x4 xn; xn[0] = v[j][0] * r * g4[0]; xn[1] = v[j][1] * r * g4[1]; xn[2] = v[j][2] * r * g4[2]; xn[3] = v[j][3] * r * g4[3];
            u32x2 w; w.x = cvt_pk_bf16(xn[0], xn[1]); w.y = cvt_pk_bf16(xn[2], xn[3]); o8[lane + 64 * j] = w;
#pragma unroll
            for (int q = 0; q < 4; ++q) { const f32x4 w0 = *(LAS f32x4*)(wf + (e + q) * 8), w1 = *(LAS f32x4*)(wf + (e + q) * 8 + 4);
                f[0] += xn[q] * w0[0]; f[1] += xn[q] * w0[1]; f[2] += xn[q] * w0[2]; f[3] += xn[q] * w0[3];
                f[4] += xn[q] * w1[0]; f[5] += xn[q] * w1[1]; f[6] += xn[q] * w1[2]; f[7] += xn[q] * w1[3]; }
        }
#pragma unroll
        for (int hh = 0; hh < 8; ++hh) f[hh] = wave_sum(f[hh]);
        if (lane < 8) { float fl = f[0];
#pragma unroll
            for (int hh = 1; hh < 8; ++hh) fl = (lane == hh) ? f[hh] : fl;
            const int b = row >> 12, s = row & 4095;
            ((float*)(ws + WS_LOGF))[(size_t)(b * 8 + lane) * SEQ + s] = log_sigmoid_f(fl + b_forget[lane]); }
    }
    LAS float* scr = (LAS float*)(lds + wave * 8448);
    constexpr int I_IN = (DM / 64) * (NPROJ / 32), I_O = (DM / 64) * (DM / 32);
    for (int it = gw; it < I_IN + 2 * I_O; it += NGW) {
        int r = it;
        if (r < I_IN) { p0_transpose_item(w_in, DIN, DM, (bf16_t*)(ws + WS_WIN), NPROJ / 32, scr, r, lane, nullptr); continue; } r -= I_IN;
        if (r < I_O) { p0_transpose_item(w_out, DM, DM, (bf16_t*)(ws + WS_WOUT), DM / 32, scr, r, lane, nullptr); continue; } r -= I_O;
        p0_transpose_item(w_pq, DM, DM, (bf16_t*)(ws + WS_WPQ), DM / 32, scr, r, lane, g_ffn);
    }
    for (int i = gt; i < 8 * 2 * 128 * 128 / 8; i += NGT) { const f32x4 a0 = *(const f32x4*)(sk + (size_t)i * 8), a1 = *(const f32x4*)(sk + (size_t)i * 8 + 4);
        u32x4 w; w.x = cvt_pk_bf16(a0[0], a0[1]); w.y = cvt_pk_bf16(a0[2], a0[3]); w.z = cvt_pk_bf16(a1[0], a1[1]); w.w = cvt_pk_bf16(a1[2], a1[3]);
        *(u32x4*)(ws + WS_SK + (size_t)i * 16) = w; }
    float* suv = (float*)(ws + WS_SUV);
    for (int r = gw; r < 2 * NEXP; r += NGW) {
        const bool isv = r >= NEXP; const int e = isv ? r - NEXP : r;
        const f32x4* srcp = (const f32x4*)((isv ? pv : pu) + (size_t)e * DM);
        f32x4 v[8]; float amax = 0.f;
#pragma unroll
        for (int j = 0; j < 8; ++j) { v[j] = srcp[lane + 64 * j];
            if (!isv) { const f32x4 g4 = *(const f32x4*)(g_ffn + 4 * (lane + 64 * j)); v[j] = v[j] * g4; }
            amax = fmaxf(amax, fmaxf(fmaxf(fabsf(v[j][0]), fabsf(v[j][1])), fmaxf(fabsf(v[j][2]), fabsf(v[j][3])))); }
        amax = wave_max(amax);
        const float sc = amax > 0.f ? 440.f / amax : 1.f;
        unsigned* dst = (unsigned*)(ws + (isv ? WS_V8 : WS_U8) + (size_t)e * DM);
#pragma unroll
        for (int j = 0; j < 8; ++j) { int p = __builtin_amdgcn_cvt_pk_fp8_f32(v[j][0] * sc, v[j][1] * sc, 0, false); p = __builtin_amdgcn_cvt_pk_fp8_f32(v[j][2] * sc, v[j][3] * sc, p, true);
            dst[lane + 64 * j] = (unsigned)p; }
        if (lane == 0) suv[r] = 1.f / sc;
    }
}

__device__ __forceinline__ void cumsum_rows(const Args& a) {
    const int tid = threadIdx.x, lane = tid & 63, wave = tid >> 6;
    if (blockIdx.x >= 16 || wave != 0) return;
    const float* src = (const float*)(a.ws + WS_LOGF) + (size_t)blockIdx.x * SEQ + lane * 64;
    float* dst = (float*)(a.ws + WS_C) + (size_t)blockIdx.x * SEQ + lane * 64;
    f32x4 v[16]; float run = 0.f;
#pragma unroll
    for (int i = 0; i < 16; ++i) { v[i] = *(const f32x4*)(src + 4 * i);
#pragma unroll
        for (int q = 0; q < 4; ++q) { run += v[i][q]; v[i][q] = run; } }
    float incl = run;
#pragma unroll
    for (int o = 1; o < 64; o <<= 1) { const float t = __shfl_up(incl, o); if (lane >= o) incl += t; }
    const float off = incl - run;
#pragma unroll
    for (int i = 0; i < 16; ++i) { f32x4 w = v[i]; w[0] += off; w[1] += off; w[2] += off; w[3] += off; *(f32x4*)(dst + 4 * i) = w; }
}

__device__ __forceinline__ void phase_qknorm(const Args& a) {
    const int tid = threadIdx.x, lane = tid & 63, wave = tid >> 6;
    const int gw = blockIdx.x * NWAVES + wave, NGW = gridDim.x * NWAVES;
    const int sub = lane & 15, rw = lane >> 4;
    const float* gq = a.in[4]; const float* gk = a.in[5];
    constexpr int ROWS = NB * NHF * SEQ;
    for (int it = gw; it < 2 * ROWS / 4; it += NGW) {
        const int row = it * 4 + rw; const bool isk = row >= ROWS;
        bf16_t* p = (bf16_t*)(a.ws + WS_SEC) + (size_t)row * HD + sub * 8;
        const float* g = (isk ? gk : gq) + sub * 8;
        const u32x4 w = *(const u32x4*)p;
        float v[8] = {bf_lo(w.x), bf_hi(w.x), bf_lo(w.y), bf_hi(w.y), bf_lo(w.z), bf_hi(w.z), bf_lo(w.w), bf_hi(w.w)};
        float ss = 0.f;
#pragma unroll
        for (int i = 0; i < 8; ++i) ss += v[i] * v[i];
        ss += __shfl_xor(ss, 1); ss += __shfl_xor(ss, 2); ss += __shfl_xor(ss, 4); ss += __shfl_xor(ss, 8);
        const float r = 1.0f / sqrtf(ss * (1.f / HD) + EPS);
        const f32x4 g0 = *(const f32x4*)g, g1 = *(const f32x4*)(g + 4);
        u32x4 o; o.x = cvt_pk_bf16(v[0] * r * g0[0], v[1] * r * g0[1]); o.y = cvt_pk_bf16(v[2] * r * g0[2], v[3] * r * g0[3]);
        o.z = cvt_pk_bf16(v[4] * r * g1[0], v[5] * r * g1[1]); o.w = cvt_pk_bf16(v[6] * r * g1[2], v[7] * r * g1[3]);
        *(u32x4*)p = o;
    }
}

__device__ __forceinline__ void phase_attn(const Args& a, unsigned char* lds_g) {
    const int tid = threadIdx.x;
    volatile int* s_item = (volatile int*)(lds_g + MISC_OFF);
    unsigned* ctr = (unsigned*)(a.ws + WS_CTL);
    bf16_t* sec = (bf16_t*)(a.ws + WS_SEC);
    for (;;) {
        __syncthreads();
        if (tid == 0) *s_item = (int)atomicAdd(ctr, 1u);
        __syncthreads();
        const int it = *s_item;
        if (it >= 512) break;
        const int qb = 15 - (it >> 5), kind = (it >> 4) & 1, bh = it & 15;
        const int b = bh >> 3, h = bh & 7;
        const size_t hoff = (size_t)bh * SEQ * HD;
        att::UnitRef u;
        u.P0 = qb * 256;
        if (kind == 0) {
            u.Q = sec + 4 * SEC_ELEMS + hoff + (size_t)u.P0 * HD; u.K = sec + 5 * SEC_ELEMS + hoff; u.V = sec + 6 * SEC_ELEMS + hoff;
            att::sb_unit(u, (bf16_t*)(a.ws + WS_MIX) + (size_t)b * SEQ * DM + 1024 + h * HD, (char*)lds_g);
        } else {
            u.Q = sec + 0 * SEC_ELEMS + hoff + (size_t)u.P0 * HD; u.K = sec + 1 * SEC_ELEMS + hoff; u.V = sec + 2 * SEC_ELEMS + hoff;
            att::attn_unit<false>(u, (const float*)(a.ws + WS_C) + (size_t)bh * SEQ, sec + 3 * SEC_ELEMS + (size_t)b * SEQ * 1024 + h * HD,
                                  (bf16_t*)(a.ws + WS_MIX) + (size_t)b * SEQ * DM + h * HD, (char*)lds_g);
        }
    }
}

__device__ __forceinline__ unsigned f2ord(float f) { const unsigned u = __float_as_uint(f); return u ^ ((unsigned)((int)u >> 31) | 0x80000000u); }
__device__ __forceinline__ float ord2f(unsigned k) { const unsigned u = k ^ (~(unsigned)((int)k >> 31) | 0x80000000u); return __uint_as_float(u); }
#define INS16(L, X) do { unsigned x_ = (X); _Pragma("unroll") for (int i_ = 0; i_ < 16; ++i_) { const unsigned hi_ = max(L[i_], x_); x_ = min(L[i_], x_); L[i_] = hi_; } } while (0)
__device__ __forceinline__ void topk_half(const bf16_t* qp, const bf16_t* skb, int t0, int h, int c, int r32, int hi, unsigned (&L)[16]) {
    bf16x8 qf[8];
#pragma unroll
    for (int d0 = 0; d0 < 8; ++d0) qf[d0] = *(const bf16x8*)(qp + (size_t)(t0 + r32) * DM + h * 256 + c * 128 + d0 * 16 + hi * 8);
#pragma unroll
    for (int i = 0; i < 16; ++i) L[i] = 0u;
    const unsigned hi4 = 4u * (unsigned)hi;
#pragma unroll
    for (int kt = 0; kt < 4; ++kt) {
        f32x16 acc = f32x16{};
#pragma unroll
        for (int d0 = 0; d0 < 8; ++d0) { const bf16x8 kf = *(const bf16x8*)(skb + (size_t)((h * 2 + c) * 128 + kt * 32 + r32) * 128 + d0 * 16 + hi * 8);
            acc = __builtin_amdgcn_mfma_f32_32x32x16_bf16(kf, qf[d0], acc, 0, 0, 0); }
        __builtin_amdgcn_sched_barrier(0);
#pragma unroll
        for (int r = 0; r < 16; ++r) { const unsigned cst = (unsigned)(127 - (kt * 32 + (r & 3) + 8 * (r >> 2)));
            const unsigned kk = (f2ord(acc[r]) & ~127u) | (cst - hi4); INS16(L, kk); }
        __builtin_amdgcn_sched_barrier(0);
    }
    unsigned P[16];
#pragma unroll
    for (int i = 0; i < 16; ++i) { auto rr = __builtin_amdgcn_permlane32_swap(L[i], L[i], false, false); P[i] = hi ? rr[0] : rr[1]; }
#pragma unroll
    for (int i = 0; i < 16; ++i) INS16(L, P[i]);
}
__device__ __forceinline__ void phase_topk(const Args& a, unsigned char* lds_g) {
    LAS unsigned char* lds = (LAS unsigned char*)lds_g;
    const int tid = threadIdx.x, lane = tid & 63, wave = tid >> 6, r32 = lane & 31, hi = lane >> 5;
    const int gw = blockIdx.x * NWAVES + wave, NGW = gridDim.x * NWAVES;
    const bf16_t* skb = (const bf16_t*)(a.ws + WS_SK); const bf16_t* qp = (const bf16_t*)(a.ws + WS_QP);
    int* idx_o = (int*)(a.ws + WS_IDX); float* gw_o = (float*)(a.ws + WS_GW);
    for (int task = gw; task < (T / 32) * 8; task += NGW) {
        const int h = task & 7, t0 = (task >> 3) * 32;
        unsigned L[2][16];
        topk_half(qp, skb, t0, h, 0, r32, hi, L[0]);
        __builtin_amdgcn_sched_barrier(0);
        topk_half(qp, skb, t0, h, 1, r32, hi, L[1]);
        __builtin_amdgcn_sched_barrier(0);
        float s1[16], s2[16]; int i1[16], i2[16];
#pragma unroll
        for (int i = 0; i < 16; ++i) { s1[i] = ord2f((L[0][i] & ~127u) | 64u); i1[i] = 127 - (int)(L[0][i] & 127u); s2[i] = ord2f((L[1][i] & ~127u) | 64u); i2[i] = 127 - (int)(L[1][i] & 127u); }
        unsigned LC[16];
#pragma unroll
        for (int i = 0; i < 16; ++i) LC[i] = 0u;
#pragma unroll
        for (int aa = 0; aa < 16; ++aa)
#pragma unroll
            for (int bb = 0; bb < 16; ++bb) if ((aa + 1) * (bb + 1) <= 16) { const unsigned kk = (f2ord(s1[aa] + s2[bb]) & ~255u) | (unsigned)(aa * 16 + bb); INS16(LC, kk); }
        LAS int* tb = (LAS int*)(lds + wave * 8192);
#pragma unroll
        for (int i = 0; i < 16; ++i) { tb[i * 64 + lane] = i1[i]; tb[(16 + i) * 64 + lane] = i2[i]; }
        float LS[16]; int LP[16];
#pragma unroll
        for (int i = 0; i < 16; ++i) { const unsigned cid = LC[i] & 255u; LS[i] = ord2f((LC[i] & ~255u) | 128u);
            LP[i] = tb[(cid >> 4) * 64 + lane] * 128 + tb[(16 + (cid & 15u)) * 64 + lane]; }
        float den = 0.f, e[16];
#pragma unroll
        for (int i = 0; i < 16; ++i) { e[i] = __expf(LS[i] - LS[0]); den += e[i]; }
        const float rden = 1.f / den;
        const size_t ob = (size_t)(t0 + r32) * NE + h * 16;
        if (hi == 0) {
#pragma unroll
            for (int i = 0; i < 4; ++i) *(int4*)(idx_o + ob + 4 * i) = make_int4(LP[4 * i], LP[4 * i + 1], LP[4 * i + 2], LP[4 * i + 3]);
        } else {
#pragma unroll
            for (int i = 0; i < 4; ++i) *(f32x4*)(gw_o + ob + 4 * i) = (f32x4){e[4 * i] * rden, e[4 * i + 1] * rden, e[4 * i + 2] * rden, e[4 * i + 3] * rden};
        }
    }
}


__device__ __forceinline__ void wave_argmax(float& v, int& i) {
#pragma unroll
    for (int o = 1; o < 64; o <<= 1) { const float ov = __shfl_xor(v, o); const int oi = __shfl_xor(i, o); if (ov > v || (ov == v && oi < i)) { v = ov; i = oi; } }
}
__device__ __forceinline__ void phase_topk_ref(const Args& a) {
    const int tid = threadIdx.x, lane = tid & 63, wave = tid >> 6;
    const int gw = blockIdx.x * NWAVES + wave, NGW = gridDim.x * NWAVES;
    const bf16_t* skb = (const bf16_t*)(a.ws + WS_SK); const bf16_t* qp = (const bf16_t*)(a.ws + WS_QP);
    int* idx_o = (int*)(a.ws + WS_IDX); float* gw_o = (float*)(a.ws + WS_GW);
    for (int task = gw; task < T * 8; task += NGW) {
        const int t = task >> 3, h = task & 7;
        float topS[2]; int topI[2];
        for (int c = 0; c < 2; ++c) {
            const bf16_t* q = qp + (size_t)t * DM + h * 256 + c * 128;
            float sc0 = 0.f, sc1 = 0.f;
            const bf16_t* k0 = skb + (size_t)((h * 2 + c) * 128 + lane) * 128; const bf16_t* k1 = k0 + 64 * 128;
            for (int d = 0; d < 128; ++d) { const float qd = __uint_as_float((unsigned)q[d] << 16);
                sc0 += qd * __uint_as_float((unsigned)k0[d] << 16); sc1 += qd * __uint_as_float((unsigned)k1[d] << 16); }
            float ms = 0.f; int mi = 0;
            for (int r = 0; r < 16; ++r) {
                float v; int i; if (sc0 >= sc1) { v = sc0; i = lane; } else { v = sc1; i = lane + 64; }
                wave_argmax(v, i);
                if (lane == r) { ms = v; mi = i; }
                if (i == lane) sc0 = -__builtin_inff();
                if (i == lane + 64) sc1 = -__builtin_inff();
            }
            topS[c] = ms; topI[c] = mi;
        }
        float cs[4]; int ci[4];
#pragma unroll
        for (int j = 0; j < 4; ++j) { const int cidx = lane * 4 + j, aa = cidx >> 4, bb = cidx & 15;
            cs[j] = __shfl(topS[0], aa) + __shfl(topS[1], bb); ci[j] = cidx; }
        float fs = 0.f; int fi = 0;
        for (int r = 0; r < 16; ++r) {
            float v = cs[0]; int i = ci[0];
#pragma unroll
            for (int j = 1; j < 4; ++j) if (cs[j] > v) { v = cs[j]; i = ci[j]; }
            wave_argmax(v, i);
            if (lane == r) { fs = v; fi = i; }
#pragma unroll
            for (int j = 0; j < 4; ++j) if (ci[j] == i) cs[j] = -__builtin_inff();
        }
        const int e1 = __shfl(topI[0], fi >> 4), e2 = __shfl(topI[1], fi & 15);
        const float mx = __shfl(fs, 0);
        float ev = lane < 16 ? __expf(fs - mx) : 0.f;
        const float den = wave_sum(ev);
        if (lane < 16) { idx_o[(size_t)t * NE + h * 16 + lane] = e1 * 128 + e2; gw_o[(size_t)t * NE + h * 16 + lane] = ev / den; }
    }
}

__device__ __forceinline__ void fp8x16_to_f32(const u32x4 q, f32x2 (&o)[8]) {
    o[0] = __builtin_amdgcn_cvt_pk_f32_fp8((int)q.x, false); o[1] = __builtin_amdgcn_cvt_pk_f32_fp8((int)q.x, true);
    o[2] = __builtin_amdgcn_cvt_pk_f32_fp8((int)q.y, false); o[3] = __builtin_amdgcn_cvt_pk_f32_fp8((int)q.y, true);
    o[4] = __builtin_amdgcn_cvt_pk_f32_fp8((int)q.z, false); o[5] = __builtin_amdgcn_cvt_pk_f32_fp8((int)q.z, true);
    o[6] = __builtin_amdgcn_cvt_pk_f32_fp8((int)q.w, false); o[7] = __builtin_amdgcn_cvt_pk_f32_fp8((int)q.w, true);
}
#define HALVE(dst, srcv, n, bitmask) do { const bool up_ = (lane & (bitmask)) != 0; _Pragma("unroll") for (int i_ = 0; i_ < (n); ++i_) { \
        const float keep_ = up_ ? srcv[(n) + i_] : srcv[i_], send_ = up_ ? srcv[i_] : srcv[(n) + i_]; dst[i_] = keep_ + __shfl_xor(send_, (bitmask)); } } while (0)
__device__ __forceinline__ void phase_peer_u(const Args& a) {
    const int tid = threadIdx.x, lane = tid & 63, wave = tid >> 6, g = lane >> 3, c = lane & 7;
    const int xl = blockIdx.x & 7, wv = (blockIdx.x >> 3) * NWAVES + wave, NWX = (gridDim.x >> 3) * NWAVES;
    const bf16_t* hb = (const bf16_t*)(a.ws + WS_HB); const unsigned char* u8 = a.ws + WS_U8;
    const int* idx_i = (const int*)(a.ws + WS_IDX); float* part = (float*)(a.ws + WS_PART);
    for (int sp = 0; sp < 2; ++sp) {
        const int s = xl + 8 * sp;
        for (int t = wv; t < T; t += NWX) {
            int id[16];
            { const int4* ip = (const int4*)(idx_i + (size_t)t * NE + g * 16);
#pragma unroll
              for (int i = 0; i < 4; ++i) { const int4 v = ip[i]; id[4 * i] = v.x; id[4 * i + 1] = v.y; id[4 * i + 2] = v.z; id[4 * i + 3] = v.w; } }
            u32x4 q[16];
#pragma unroll
            for (int i = 0; i < 16; ++i) q[i] = *(const u32x4*)(u8 + (size_t)id[i] * DM + s * 128 + c * 16);
            f32x2 xf[8];
            { const u32x4 x0 = *(const u32x4*)(hb + (size_t)t * DM + s * 128 + c * 16), x1 = *(const u32x4*)(hb + (size_t)t * DM + s * 128 + c * 16 + 8);
              xf[0] = (f32x2){bf_lo(x0.x), bf_hi(x0.x)}; xf[1] = (f32x2){bf_lo(x0.y), bf_hi(x0.y)}; xf[2] = (f32x2){bf_lo(x0.z), bf_hi(x0.z)}; xf[3] = (f32x2){bf_lo(x0.w), bf_hi(x0.w)};
              xf[4] = (f32x2){bf_lo(x1.x), bf_hi(x1.x)}; xf[5] = (f32x2){bf_lo(x1.y), bf_hi(x1.y)}; xf[6] = (f32x2){bf_lo(x1.z), bf_hi(x1.z)}; xf[7] = (f32x2){bf_lo(x1.w), bf_hi(x1.w)}; }
            float p[16];
#pragma unroll
            for (int i = 0; i < 16; ++i) { f32x2 uf[8]; fp8x16_to_f32(q[i], uf); f32x2 ac = uf[0] * xf[0];
#pragma unroll
                for (int k = 1; k < 8; ++k) ac = ac + uf[k] * xf[k];
                p[i] = ac.x + ac.y; }
            float p8[8], p4[4], p2[2];
            HALVE(p8, p, 8, 4); HALVE(p4, p8, 4, 2); HALVE(p2, p4, 2, 1);
            *(f32x2*)(part + ((size_t)t * 16 + s) * NE + 2 * lane) = (f32x2){p2[0], p2[1]};
        }
    }
}
__device__ __forceinline__ void phase_peer_w(const Args& a) {
    const int gt = blockIdx.x * NTHREADS + threadIdx.x, NGT = gridDim.x * NTHREADS;
    const int* idx_i = (const int*)(a.ws + WS_IDX); const float* gw_i = (const float*)(a.ws + WS_GW); const float* part = (const float*)(a.ws + WS_PART);
    const float* suv = (const float*)(a.ws + WS_SUV); const float* rtab = (const float*)(a.ws + WS_RT); float* wtab = (float*)(a.ws + WS_W);
    for (int item = gt; item < T * NE; item += NGT) {
        const int t = item >> 7, e = item & 127;
        float sum = 0.f;
#pragma unroll
        for (int s = 0; s < 16; ++s) sum += part[((size_t)t * 16 + s) * NE + e];
        const int ex = idx_i[item];
        const float d = sum * suv[ex] * rtab[t];
        wtab[item] = 0.5f * d * (1.f + erff(d * 0.70710678118654752f)) * gw_i[item] * suv[NEXP + ex];
    }
}
__device__ __forceinline__ void phase_peer_v(const Args& a, float* dst) {
    const int tid = threadIdx.x, lane = tid & 63, wave = tid >> 6, g = lane >> 3, c = lane & 7;
    const int xl = blockIdx.x & 7, wv = (blockIdx.x >> 3) * NWAVES + wave, NWX = (gridDim.x >> 3) * NWAVES;
    const unsigned char* v8 = a.ws + WS_V8;
    const int* idx_i = (const int*)(a.ws + WS_IDX); const float* wtab = (const float*)(a.ws + WS_W);
    const float* hsrc = a.out;
    for (int sp = 0; sp < 2; ++sp) {
        const int s = xl + 8 * sp;
        for (int t = wv; t < T; t += NWX) {
            int id[16]; float w[16];
            { const int4* ip = (const int4*)(idx_i + (size_t)t * NE + g * 16); const f32x4* wp = (const f32x4*)(wtab + (size_t)t * NE + g * 16);
#pragma unroll
              for (int i = 0; i < 4; ++i) { const int4 v = ip[i]; id[4 * i] = v.x; id[4 * i + 1] = v.y; id[4 * i + 2] = v.z; id[4 * i + 3] = v.w;
                  const f32x4 ww = wp[i]; w[4 * i] = ww[0]; w[4 * i + 1] = ww[1]; w[4 * i + 2] = ww[2]; w[4 * i + 3] = ww[3]; } }
            u32x4 q[16];
#pragma unroll
            for (int i = 0; i < 16; ++i) q[i] = *(const u32x4*)(v8 + (size_t)id[i] * DM + s * 128 + c * 16);
            f32x2 ac[8];
#pragma unroll
            for (int k = 0; k < 8; ++k) ac[k] = (f32x2){0.f, 0.f};
#pragma unroll
            for (int i = 0; i < 16; ++i) { f32x2 vf[8]; fp8x16_to_f32(q[i], vf);
#pragma unroll
                for (int k = 0; k < 8; ++k) ac[k] = ac[k] + vf[k] * w[i]; }
            float p[16];
#pragma unroll
            for (int k = 0; k < 8; ++k) { p[2 * k] = ac[k].x; p[2 * k + 1] = ac[k].y; }
            float p8[8], p4[4], p2[2];
            HALVE(p8, p, 8, 32); HALVE(p4, p8, 4, 16); HALVE(p2, p4, 2, 8);
            const size_t o = (size_t)t * DM + s * 128 + c * 16 + 2 * g;
            const f32x2 hv = *(const f32x2*)(hsrc + o);
            *(f32x2*)(dst + o) = (f32x2){hv.x + p2[0], hv.y + p2[1]};
        }
    }
}
#undef HALVE

constexpr int NPHASE = 10;
__global__ void __launch_bounds__(NTHREADS, 2) fwd_kernel(Args a) {
    extern __shared__ __attribute__((aligned(16))) unsigned char lds[];
    const int lo = a.ph_lo, hi = a.ph_hi;
#if MK_ONE_LAUNCH
    cg::grid_group grid = cg::this_grid();
#define SEAM(k) do { if (lo <= (k) && (k) + 1 < hi) grid.sync(); } while (0)
#else
#define SEAM(k) do { } while (0)
#endif
#define IN(k) (lo <= (k) && (k) < hi)
#ifndef DUP_PHASE
#define DUP_PHASE -1
#endif
    unsigned char* ws = a.ws;
    if (IN(0)) { phase0(a, lds); if (DUP_PHASE == 0) { __syncthreads(); phase0(a, lds); } SEAM(0); }
    if (IN(1)) {
        cumsum_rows(a);
        pg8::Gemm g{(const bf16_t*)(ws + WS_XN), (const bf16_t*)(ws + WS_WIN), T, NPROJ, DM}; pg8::StaticOrder S; S.init(T, NPROJ, (int)gridDim.x, (int)blockIdx.x);
        pg8::EpiInProj E{(bf16_t*)(ws + WS_SEC)};
        for (int rep_ = 0; rep_ < (DUP_PHASE == 1 ? 2 : 1); ++rep_)
        pg8::gemm_phase<pg8::EpiInProj, pg8::StaticOrder, true, true>((LAS unsigned char*)lds, g, S, E);
        SEAM(1);
    }
    if (IN(2)) { phase_qknorm(a); SEAM(2); }
    if (IN(3)) { phase_attn(a, lds);
#if MK_ONE_LAUNCH
        if (DUP_PHASE == 3) { grid.sync(); if (blockIdx.x == 0 && threadIdx.x == 0) *(volatile unsigned*)(a.ws + WS_CTL) = 0u; __threadfence(); grid.sync(); phase_attn(a, lds); }
#endif
        SEAM(3); }
    if (IN(4)) {
        pg8::Gemm g{(const bf16_t*)(ws + WS_MIX), (const bf16_t*)(ws + WS_WOUT), T, DM, DM}; pg8::StaticOrder S; S.init(T, DM, (int)gridDim.x, (int)blockIdx.x);
        pg8::EpiOutProj E{a.in[0], a.out, (bf16_t*)(ws + WS_HB), (float*)(ws + WS_SSQ)};
        for (int rep_ = 0; rep_ < (DUP_PHASE == 4 ? 2 : 1); ++rep_)
        pg8::gemm_phase<pg8::EpiOutProj, pg8::StaticOrder, true, true>((LAS unsigned char*)lds, g, S, E);
        SEAM(4);
    }
    if (IN(5)) {
        pg8::Gemm g{(const bf16_t*)(ws + WS_HB), (const bf16_t*)(ws + WS_WPQ), T, DM, DM}; pg8::StaticOrder S; S.init(T, DM, (int)gridDim.x, (int)blockIdx.x);
        pg8::EpiPeerQ E{(const float*)(ws + WS_SSQ), (bf16_t*)(ws + WS_QP), (float*)(ws + WS_RT)};
        for (int rep_ = 0; rep_ < (DUP_PHASE == 5 ? 2 : 1); ++rep_)
        pg8::gemm_phase<pg8::EpiPeerQ, pg8::StaticOrder, true, true>((LAS unsigned char*)lds, g, S, E);
        SEAM(5);
    }
    #ifdef TOPK_REF
    if (IN(6)) { phase_topk_ref(a); SEAM(6); }
#else
    if (IN(6)) { for (int rep_ = 0; rep_ < (DUP_PHASE == 6 ? 2 : 1); ++rep_) phase_topk(a, lds); SEAM(6); }
#endif
    if (IN(7)) { for (int rep_ = 0; rep_ < (DUP_PHASE == 7 ? 2 : 1); ++rep_) phase_peer_u(a); SEAM(7); }
    if (IN(8)) { for (int rep_ = 0; rep_ < (DUP_PHASE == 8 ? 2 : 1); ++rep_) phase_peer_w(a); SEAM(8); }
    if (IN(9)) { for (int rep_ = 0; rep_ < (DUP_PHASE == 9 ? 2 : 1); ++rep_) phase_peer_v(a, (DUP_PHASE == 9 && rep_ == 0) ? (float*)(a.ws + WS_END) : a.out); }
#undef IN
#undef SEAM
}

extern "C" void kernel_launch(void* const* d_in, const int* in_sizes, int n_in, void* d_out, int out_size, void* d_ws, size_t ws_size, hipStream_t stream) {
    static int grid = 0;
    if (grid == 0) {
        if (n_in != 12 || in_sizes[0] != T * DM || out_size != T * DM || ws_size < WS_END) { fprintf(stderr, "kernel_launch: unexpected shapes (n_in %d, in0 %d, out %d, ws %zu)\n", n_in, n_in > 0 ? in_sizes[0] : -1, out_size, ws_size); grid = -1; return; }
        int dev = 0, cus = 0, per_cu = 0;
        if (hipGetDevice(&dev) != hipSuccess || hipDeviceGetAttribute(&cus, hipDeviceAttributeMultiprocessorCount, dev) != hipSuccess) { grid = -1; return; }
        if (hipFuncSetAttribute((const void*)fwd_kernel, hipFuncAttributeMaxDynamicSharedMemorySize, LDS_BYTES) != hipSuccess) { fprintf(stderr, "kernel_launch: hipFuncSetAttribute failed\n"); grid = -1; return; }
        if (hipOccupancyMaxActiveBlocksPerMultiprocessor(&per_cu, (const void*)fwd_kernel, NTHREADS, LDS_BYTES) != hipSuccess || per_cu < 1) { fprintf(stderr, "kernel_launch: occupancy query says %d\n", per_cu); grid = -1; return; }
        grid = cus;
    }
    if (grid < 0) return;
    (void)hipMemsetAsync((char*)d_ws + WS_CTL, 0, CTL_BYTES, stream);
    Args a{};
    for (int i = 0; i < 12; ++i) a.in[i] = (const float*)d_in[i];
    a.out = (float*)d_out; a.ws = (unsigned char*)d_ws;
#if MK_ONE_LAUNCH
    a.ph_lo = 0; a.ph_hi = NPHASE;
    void* args[] = {&a};
    hipError_t e = hipLaunchCooperativeKernel((const void*)fwd_kernel, dim3(grid), dim3(NTHREADS), args, LDS_BYTES, stream);
    if (e != hipSuccess) fprintf(stderr, "cooperative launch failed: %s (grid %d)\n", hipGetErrorString(e), grid);
#else
    for (int p = 0; p < NPHASE; ++p) { a.ph_lo = p; a.ph_hi = p + 1; hipLaunchKernelGGL(fwd_kernel, dim3(grid), dim3(NTHREADS), LDS_BYTES, stream, a); }
#endif
}
```

```cpp
#include <hip/hip_runtime.h>
#include <hip/hip_cooperative_groups.h>
#include <cstdio>
#include <cstdint>
namespace cg = cooperative_groups;

#ifndef MK_ONE_LAUNCH
#define MK_ONE_LAUNCH 1
#endif

#define LAS __attribute__((address_space(3)))
typedef unsigned short bf16_t;
typedef short bf16x8 __attribute__((ext_vector_type(8)));
typedef short s16x4 __attribute__((ext_vector_type(4)));
typedef float f32x2 __attribute__((ext_vector_type(2)));
typedef float f32x4 __attribute__((ext_vector_type(4)));
typedef float f32x16 __attribute__((ext_vector_type(16)));
typedef unsigned u32x2 __attribute__((ext_vector_type(2)));
typedef unsigned u32x4 __attribute__((ext_vector_type(4)));
typedef __bf16 bf16x2_t __attribute__((ext_vector_type(2)));

constexpr int NB = 2, SEQ = 4096, T = NB * SEQ, DM = 2048, HD = 128, NHF = 8, DIN = 7176, NPROJ = 7168;
constexpr int NEXP = 16384, NE = 128;
constexpr float EPS = 1e-6f;
constexpr float SCALE = 0.08838834764831845f, LOG2E = 1.4426950408889634f;
constexpr int NWAVES = 8, NTHREADS = 512;

constexpr size_t MiB = 1u << 20;
constexpr size_t WS_CTL = 0, CTL_BYTES = 32768;
constexpr int CW_BAR = 1024;
constexpr size_t WS_WIN = 1 * MiB, WS_WOUT = 29 * MiB, WS_WPQ = 37 * MiB, WS_SK = 45 * MiB, WS_LOGF = 46 * MiB, WS_C = 46 * MiB + 512 * 1024, WS_SSQ = 47 * MiB;
constexpr size_t WS_XN = 48 * MiB;
constexpr size_t WS_SEC = 80 * MiB;
constexpr size_t SEC_ELEMS = 8u << 20;
constexpr size_t WS_MIX = 192 * MiB, WS_HB = 224 * MiB, WS_QP = 256 * MiB, WS_IDX = 288 * MiB, WS_GW = 292 * MiB, WS_U8 = 296 * MiB, WS_V8 = 328 * MiB, WS_SUV = 360 * MiB  , WS_RT = 360 * MiB + 256 * 1024  , WS_W = 361 * MiB  ,
                 WS_PART = 368 * MiB  , WS_END = 432 * MiB;

constexpr int RING_BYTES = 131072;
constexpr int MISC_OFF = 143360;
constexpr int LDS_BYTES = 147456;

__device__ __forceinline__ unsigned cvt_pk_bf16(float lo, float hi) { unsigned r; asm volatile("v_cvt_pk_bf16_f32 %0, %1, %2" : "=v"(r) : "v"(lo), "v"(hi)); return r; }
__device__ __forceinline__ float bf_lo(unsigned u) { return __builtin_bit_cast(float, u << 16); }
__device__ __forceinline__ float bf_hi(unsigned u) { return __builtin_bit_cast(float, u & 0xffff0000u); }
__device__ __forceinline__ float wave_sum(float v) {
#pragma unroll
    for (int o = 1; o < 64; o <<= 1) v += __shfl_xor(v, o);
    return v;
}
__device__ __forceinline__ float wave_max(float v) {
#pragma unroll
    for (int o = 1; o < 64; o <<= 1) v = fmaxf(v, __shfl_xor(v, o));
    return v;
}
__device__ __forceinline__ int tid_opaque() { int t = (int)threadIdx.x; asm volatile("" : "+v"(t)); return t; }
#define LDS_WAIT() asm volatile("s_waitcnt lgkmcnt(0)" ::: "memory")

namespace pg8 {
#define PG8_LAS __attribute__((address_space(3)))
constexpr int BM = 256, BK = 64, HALF = 128, HTB = HALF * BK * 2, STAGE_BYTES = 8 * HTB, NXCD = 8, WGM = 8;
__host__ __device__ __forceinline__ int lds_byte(int r, int c) { const int st = (r >> 4) * 2 + (c >> 5), rr = r & 15, cc = c & 31, ob = rr * 64 + cc * 2; return st * 1024 + (ob ^ (((ob >> 9) & 1) << 5)); }
__host__ __device__ __forceinline__ void stage_rc(int b, int& R, int& C) { const int st = b / 1024, sb = b % 1024, swz = sb ^ (((sb >> 9) & 1) << 5); R = (st >> 1) * 16 + swz / 64; C = (st & 1) * 32 + (swz % 64) / 2; }
__host__ __device__ __forceinline__ int perm32(int rho) { const int n = rho >> 4, i = rho & 15; return 8 * (i >> 2) + 4 * n + (i & 3); }
struct Unit { int pm, pn; };
struct Gemm { const bf16_t* A; const bf16_t* Bt; int M, N, K; };
struct StaticOrder {
    int nM, nN, nwg, G, c;
    __host__ __device__ void init(int M, int N, int G_, int c_) { nM = M / BM; nN = N / BM; nwg = nM * nN; G = G_; c = c_; }
    __host__ __device__ bool next(int i, Unit& u) const {
        const long L = (long)i * G + c; if (L >= nwg) return false;
        int wgid = (int)L; { const int q = nwg / NXCD, r = nwg % NXCD, xcd = wgid % NXCD, off = wgid / NXCD; wgid = (xcd < r ? xcd * (q + 1) : r * (q + 1) + (xcd - r) * q) + off; }
        const int nig = WGM * nN, gid = wgid / nig, fm = gid * WGM, gsz = (nM - fm) < WGM ? (nM - fm) : WGM;
        u.pm = fm + ((wgid % nig) % gsz); u.pn = (wgid % nig) / gsz; return true;
    }
    __device__ __forceinline__ void a_ready(const Unit&) const {}
    __device__ __forceinline__ void done(const Unit&) const {}
};

template <class Epi, class Sched, bool ALIGN_EPI = false, bool SP2 = false>
__device__ __forceinline__ void gemm_phase(PG8_LAS unsigned char* lds, const Gemm g, const Sched& S, const Epi& E) {
    const int tid = tid_opaque(), wid = __builtin_amdgcn_readfirstlane(tid >> 6), lane = tid & 63, wr = wid >> 2, wc = wid & 3, fr = lane & 15, fq = lane >> 4;
    const int K = g.K, nt = K / BK;
    unsigned voffA[2], voffB[2];
#pragma unroll
    for (int i = 0; i < 2; ++i) { int R, C; stage_rc(tid * 16 + i * 8192, R, C); const int Rb = Epi::PERM ? ((R & ~31) + perm32(R & 31)) : R;
        voffA[i] = (unsigned)(R * K + C) * 2u; voffB[i] = (unsigned)(Rb * K + C) * 2u; }
    const size_t kstep = (size_t)(BK * 2);
    const size_t hstep = (size_t)HALF * K * 2;
    const size_t tstep = 2 * hstep;
    const unsigned ldsw = (unsigned)wid * 1024u;
    const int aoff = lds_byte(wr * 64 + fr, fq * 8), boff = lds_byte(wc * 32 + fr, fq * 8);
#define PG8_SA(b, h) (((b) * 2 + (h)) * HTB)
#define PG8_SB(b, h) ((4 + (b) * 2 + (h)) * HTB)
#define PG8_STAGE(bufoff, gbase, voff) do { _Pragma("unroll") for (int _i = 0; _i < 2; ++_i) \
        __builtin_amdgcn_global_load_lds((const unsigned*)((const char*)(gbase) + (voff)[_i]), (PG8_LAS unsigned*)(lds + (bufoff) + ldsw + _i * 8192), 16, 0, 0); } while (0)
#define PG8_LDA(dst, b, h) do { _Pragma("unroll") for (int m = 0; m < 4; ++m) _Pragma("unroll") for (int k = 0; k < 2; ++k) dst[m][k] = *(const PG8_LAS bf16x8*)(lds + PG8_SA(b, h) + aoff + m * 2048 + k * 1024); } while (0)
#define PG8_LDB(dst, b, h) do { _Pragma("unroll") for (int n = 0; n < 2; ++n) _Pragma("unroll") for (int k = 0; k < 2; ++k) dst[n][k] = *(const PG8_LAS bf16x8*)(lds + PG8_SB(b, h) + boff + n * 2048 + k * 1024); } while (0)
#define PG8_MMA(ai, bj, At, Bt) do { __builtin_amdgcn_s_setprio(1); _Pragma("unroll") for (int m = 0; m < 4; ++m) _Pragma("unroll") for (int n = 0; n < 2; ++n) _Pragma("unroll") for (int k = 0; k < 2; ++k) \
        acc[ai][bj][m][n] = __builtin_amdgcn_mfma_f32_16x16x32_bf16(Bt[n][k], At[m][k], acc[ai][bj][m][n], 0, 0, 0); __builtin_amdgcn_s_setprio(0); } while (0)
#define PG8_WAIT_V(n) asm volatile("s_waitcnt vmcnt(" #n ")" ::: "memory")
#define PG8_WAIT_L(n) asm volatile("s_waitcnt lgkmcnt(" #n ")" ::: "memory")
#define PG8_BAR __builtin_amdgcn_s_barrier()
#define PG8_SCHED __builtin_amdgcn_sched_barrier(0)
    Unit cur, nxt; int ui = 0;
    if (!S.next(0, cur)) return;
    f32x4 acc[2][2][4][2];
#pragma unroll
    for (int a = 0; a < 2; ++a)
#pragma unroll
        for (int b = 0; b < 2; ++b)
#pragma unroll
            for (int m = 0; m < 4; ++m)
#pragma unroll
                for (int n = 0; n < 2; ++n) acc[a][b][m][n] = (f32x4){0.f, 0.f, 0.f, 0.f};
    bf16x8 At[4][2], B0[2][2], B1[2][2];
    const char* cA = (const char*)g.A + (size_t)cur.pm * tstep; const char* cB = (const char*)g.Bt + (size_t)cur.pn * tstep;
    S.a_ready(cur);
    if constexpr (SP2) {
        PG8_STAGE(PG8_SB(0, 0), cB, voffB); PG8_STAGE(PG8_SB(0, 1), cB + hstep, voffB); PG8_STAGE(PG8_SA(0, 0), cA, voffA); PG8_STAGE(PG8_SA(0, 1), cA + hstep, voffA);
        if (wr == 1) PG8_BAR;
        PG8_WAIT_V(2); PG8_BAR;
        PG8_STAGE(PG8_SB(1, 0), cB + kstep, voffB); PG8_STAGE(PG8_SA(1, 0), cA + kstep, voffA); PG8_STAGE(PG8_SB(1, 1), cB + hstep + kstep, voffB);
        PG8_WAIT_V(6); PG8_BAR;
    } else {
        PG8_STAGE(PG8_SB(0, 0), cB, voffB); PG8_STAGE(PG8_SA(0, 0), cA, voffA); PG8_STAGE(PG8_SB(0, 1), cB + hstep, voffB); PG8_STAGE(PG8_SA(0, 1), cA + hstep, voffA);
        if (wr == 1) PG8_BAR;
        PG8_WAIT_V(4); PG8_BAR;
        PG8_STAGE(PG8_SB(1, 0), cB + kstep, voffB); PG8_STAGE(PG8_SA(1, 0), cA + kstep, voffA); PG8_STAGE(PG8_SB(1, 1), cB + hstep + kstep, voffB);
        PG8_WAIT_V(6); PG8_BAR;
    }
    for (;;) {
        const bool has_next = S.next(ui + 1, nxt);
        const char* nA = has_next ? (const char*)g.A + (size_t)nxt.pm * tstep : cA; const char* nB = has_next ? (const char*)g.Bt + (size_t)nxt.pn * tstep : cB;
        for (int t = 0; t < nt; t += 2) {
            const bool last = (t == nt - 2);
            const char* a1 = cA + (size_t)(t + 1) * kstep;
            const char* a2 = last ? nA : cA + (size_t)(t + 2) * kstep; const char* b2 = last ? nB : cB + (size_t)(t + 2) * kstep;
            const char* a3 = a2 + kstep; const char* b3 = b2 + kstep;
            if (last && has_next) S.a_ready(nxt);
            if constexpr (SP2) {
            PG8_LDB(B0, 0, 0); PG8_LDB(B1, 0, 1); PG8_SCHED; PG8_LDA(At, 0, 0); PG8_STAGE(PG8_SA(1, 1), a1 + hstep, voffA);
            PG8_WAIT_V(8); PG8_WAIT_L(0); PG8_BAR; PG8_MMA(0, 0, At, B0); PG8_MMA(0, 1, At, B1); PG8_BAR; PG8_SCHED;
            PG8_LDA(At, 0, 1); PG8_STAGE(PG8_SB(0, 0), b2, voffB); PG8_STAGE(PG8_SB(0, 1), b2 + hstep, voffB); PG8_STAGE(PG8_SA(0, 0), a2, voffA);
            PG8_WAIT_V(8); PG8_WAIT_L(0); PG8_BAR; PG8_MMA(1, 0, At, B0); PG8_MMA(1, 1, At, B1); PG8_BAR; PG8_SCHED;
            PG8_LDB(B0, 1, 0); PG8_LDB(B1, 1, 1); PG8_SCHED; PG8_LDA(At, 1, 0); PG8_STAGE(PG8_SA(0, 1), a2 + hstep, voffA);
            PG8_WAIT_V(8); PG8_WAIT_L(0); PG8_BAR; PG8_MMA(0, 0, At, B0); PG8_MMA(0, 1, At, B1); PG8_BAR; PG8_SCHED;
            PG8_LDA(At, 1, 1); PG8_STAGE(PG8_SB(1, 0), b3, voffB); PG8_STAGE(PG8_SB(1, 1), b3 + hstep, voffB); PG8_STAGE(PG8_SA(1, 0), a3, voffA);
            PG8_WAIT_V(8); PG8_WAIT_L(0); PG8_BAR; PG8_MMA(1, 0, At, B0); PG8_MMA(1, 1, At, B1); PG8_BAR; PG8_SCHED;
            } else {
            PG8_LDB(B0, 0, 0); PG8_SCHED; PG8_LDA(At, 0, 0); PG8_STAGE(PG8_SA(1, 1), a1 + hstep, voffA);
            PG8_WAIT_L(8); PG8_BAR; PG8_WAIT_L(0); PG8_MMA(0, 0, At, B0); PG8_BAR; PG8_SCHED;
            PG8_LDB(B1, 0, 1); PG8_STAGE(PG8_SB(0, 0), b2, voffB);
            PG8_BAR; PG8_WAIT_L(0); PG8_MMA(0, 1, At, B1); PG8_BAR;
            PG8_LDA(At, 0, 1); PG8_STAGE(PG8_SA(0, 0), a2, voffA);
            PG8_BAR; PG8_WAIT_L(0); PG8_MMA(1, 0, At, B0); PG8_BAR; PG8_SCHED;
            PG8_STAGE(PG8_SB(0, 1), b2 + hstep, voffB);
            PG8_WAIT_V(6); PG8_BAR; PG8_MMA(1, 1, At, B1); PG8_BAR;
            PG8_LDB(B0, 1, 0); PG8_SCHED; PG8_LDA(At, 1, 0); PG8_STAGE(PG8_SA(0, 1), a2 + hstep, voffA);
            PG8_WAIT_L(8); PG8_BAR; PG8_WAIT_L(0); PG8_MMA(0, 0, At, B0); PG8_BAR; PG8_SCHED;
            PG8_LDB(B1, 1, 1); PG8_STAGE(PG8_SB(1, 0), b3, voffB);
            PG8_BAR; PG8_WAIT_L(0); PG8_MMA(0, 1, At, B1); PG8_BAR;
            PG8_LDA(At, 1, 1); PG8_STAGE(PG8_SA(1, 0), a3, voffA);
            PG8_BAR; PG8_WAIT_L(0); PG8_MMA(1, 0, At, B0); PG8_BAR; PG8_SCHED;
            PG8_STAGE(PG8_SB(1, 1), b3 + hstep, voffB);
            PG8_WAIT_V(6); PG8_BAR; PG8_MMA(1, 1, At, B1); PG8_BAR;
            }
        }
        if constexpr (ALIGN_EPI) { if (wr == 0) PG8_BAR; }
        E(acc, cur, wr, wc, fr, fq); S.done(cur);
        if (!has_next) break;
#pragma unroll
        for (int a = 0; a < 2; ++a)
#pragma unroll
            for (int b = 0; b < 2; ++b)
#pragma unroll
                for (int m = 0; m < 4; ++m)
#pragma unroll
                    for (int n = 0; n < 2; ++n) acc[a][b][m][n] = (f32x4){0.f, 0.f, 0.f, 0.f};
        cur = nxt; cA = nA; cB = nB; ++ui;
        if constexpr (ALIGN_EPI) { if (wr == 1) PG8_BAR; }
    }
    PG8_WAIT_V(0);
    if constexpr (!ALIGN_EPI) { if (wr == 0) PG8_BAR; }
    PG8_BAR;
#undef PG8_SA
#undef PG8_SB
#undef PG8_STAGE
#undef PG8_LDA
#undef PG8_LDB
#undef PG8_MMA
#undef PG8_WAIT_V
#undef PG8_WAIT_L
#undef PG8_BAR
#undef PG8_SCHED
}

__device__ __forceinline__ float sigmoidf_fast(float x) { return __builtin_amdgcn_rcpf(1.f + __builtin_amdgcn_exp2f(-x * LOG2E)); }
struct EpiInProj {
    static constexpr bool PERM = true;
    bf16_t* base;
    __device__ __forceinline__ void operator()(const f32x4 (&acc)[2][2][4][2], const Unit& u, int wr, int wc, int fr, int fq) const {
        const int sec = u.pn >> 2;
        bf16_t* sb = base + (size_t)sec * SEC_ELEMS;
        const float sc = (sec == 4) ? SCALE * LOG2E : 1.f;
#pragma unroll
        for (int ai = 0; ai < 2; ++ai)
#pragma unroll
            for (int m = 0; m < 4; ++m) {
                const int tk = u.pm * BM + ai * HALF + wr * 64 + m * 16 + fr, b = tk >> 12, s = tk & 4095;
#pragma unroll
                for (int bj = 0; bj < 2; ++bj) {
                    const int hh = (u.pn & 3) * 2 + bj;
                    f32x4 v0 = acc[ai][bj][m][0], v1 = acc[ai][bj][m][1];
                    bf16_t* dst;
                    if (sec == 3) {
#pragma unroll
                        for (int i = 0; i < 4; ++i) { v0[i] = sigmoidf_fast(v0[i]); v1[i] = sigmoidf_fast(v1[i]); }
                        dst = sb + (size_t)tk * 1024 + hh * 128 + wc * 32 + 8 * fq;
                    } else {
                        v0 = v0 * sc; v1 = v1 * sc;
                        dst = sb + ((size_t)((b * 8 + hh) * 4096 + s)) * 128 + wc * 32 + 8 * fq;
                    }
                    u32x4 w; w.x = cvt_pk_bf16(v0[0], v0[1]); w.y = cvt_pk_bf16(v0[2], v0[3]); w.z = cvt_pk_bf16(v1[0], v1[1]); w.w = cvt_pk_bf16(v1[2], v1[3]);
                    *(u32x4*)dst = w;
                }
            }
    }
};
struct EpiOutProj {
    static constexpr bool PERM = true;
    const float* x; float* h; bf16_t* hb; float* ssq;
    __device__ __forceinline__ void operator()(const f32x4 (&acc)[2][2][4][2], const Unit& u, int wr, int wc, int fr, int fq) const {
#pragma unroll
        for (int ai = 0; ai < 2; ++ai)
#pragma unroll
            for (int m = 0; m < 4; ++m) {
                const int tk = u.pm * BM + ai * HALF + wr * 64 + m * 16 + fr;
                float ss = 0.f;
#pragma unroll
                for (int bj = 0; bj < 2; ++bj) {
                    const size_t off = (size_t)tk * DM + u.pn * BM + bj * HALF + wc * 32 + 8 * fq;
                    const f32x4 x0 = *(const f32x4*)(x + off), x1 = *(const f32x4*)(x + off + 4);
                    const f32x4 v0 = acc[ai][bj][m][0] + x0, v1 = acc[ai][bj][m][1] + x1;
                    *(f32x4*)(h + off) = v0; *(f32x4*)(h + off + 4) = v1;
                    u32x4 w; w.x = cvt_pk_bf16(v0[0], v0[1]); w.y = cvt_pk_bf16(v0[2], v0[3]); w.z = cvt_pk_bf16(v1[0], v1[1]); w.w = cvt_pk_bf16(v1[2], v1[3]);
                    *(u32x4*)(hb + off) = w;
                    ss += v0[0] * v0[0] + v0[1] * v0[1] + v0[2] * v0[2] + v0[3] * v0[3] + v1[0] * v1[0] + v1[1] * v1[1] + v1[2] * v1[2] + v1[3] * v1[3];
                }
                ss += __shfl_xor(ss, 16); ss += __shfl_xor(ss, 32);
                if (fq == 0) ssq[(size_t)tk * 32 + u.pn * 4 + wc] = ss;
            }
    }
};
struct EpiPeerQ {
    static constexpr bool PERM = true;
    const float* ssq; bf16_t* qp; float* rtab;
    __device__ __forceinline__ void operator()(const f32x4 (&acc)[2][2][4][2], const Unit& u, int wr, int wc, int fr, int fq) const {
#pragma unroll
        for (int ai = 0; ai < 2; ++ai)
#pragma unroll
            for (int m = 0; m < 4; ++m) {
                const int tk = u.pm * BM + ai * HALF + wr * 64 + m * 16 + fr;
                float tot = 0.f;
#pragma unroll
                for (int i = 0; i < 8; ++i) { const f32x4 s4 = *(const f32x4*)(ssq + (size_t)tk * 32 + 4 * i); tot += (s4[0] + s4[1]) + (s4[2] + s4[3]); }
                const float r = 1.0f / sqrtf(tot * (1.f / DM) + EPS);
                if (u.pn == 0 && wc == 0 && fq == 0) rtab[tk] = r;
#pragma unroll
                for (int bj = 0; bj < 2; ++bj) {
                    const size_t off = (size_t)tk * DM + u.pn * BM + bj * HALF + wc * 32 + 8 * fq;
                    const f32x4 v0 = acc[ai][bj][m][0] * r, v1 = acc[ai][bj][m][1] * r;
                    u32x4 w; w.x = cvt_pk_bf16(v0[0], v0[1]); w.y = cvt_pk_bf16(v0[2], v0[3]); w.z = cvt_pk_bf16(v1[0], v1[1]); w.w = cvt_pk_bf16(v1[2], v1[3]);
                    *(u32x4*)(qp + off) = w;
                }
            }
    }
};
}

namespace att {
constexpr int NW = 8, QBLK = 32, KVBLK = 64, QB = NW * QBLK, D = 128;
constexpr int SHM_V = KVBLK * D * 2, SHM_K = KVBLK * D * 2;
constexpr int OFF_WS = 2 * SHM_V + 2 * SHM_K, OFF_BIAS = OFF_WS + NW * 64 * 4, ATT_LDS = OFF_BIAS + SEQ * 4;
#define KSWZ(row, colB) ((row) * 256 + ((colB) ^ (((row) & 7) << 4)))
#define SBAR() __builtin_amdgcn_sched_barrier(0)
__device__ __forceinline__ int v_st(int k, int c) { const int kk = (k & ~0xC) | ((k & 4) << 1) | ((k & 8) >> 1); return ((kk >> 3) * 4 + (c >> 5)) * 512 + ((kk & 7) * 32 + (c & 31)) * 2; }
__device__ __forceinline__ int v_rd_base(int lane) { return ((lane & 3) << 3) | (((lane >> 2) & 3) << 6) | (((lane >> 4) & 1) << 5) | (((lane >> 5) & 1) << 8); }
constexpr int v_rd_off(int d0, int ks, int half) { return d0 * 512 + ks * 4096 + half * 2048; }
__device__ __forceinline__ int crow(int r, int hi) { return (r & 3) + 8 * (r >> 2) + 4 * hi; }
__device__ __forceinline__ bf16x8 load8(const bf16_t* p) { return *reinterpret_cast<const bf16x8*>(p); }
__device__ __forceinline__ void mask_tile(f32x16& p0, f32x16& p1, int dq) {
    const float NEG = -__builtin_inff();
#pragma unroll
    for (int r = 0; r < 16; ++r) {
        const int c = (r & 3) + 8 * (r >> 2);
        if (dq - c < 0) p0[r] = NEG;
        if (dq - c - 32 < 0) p1[r] = NEG;
    }
}
__device__ __forceinline__ void partialSM(f32x16& p0, f32x16& p1, float& m_reg, float& mn, float& alpha) {
    float pmax = p0[0];
#pragma unroll
    for (int r = 1; r < 16; ++r) pmax = fmaxf(pmax, p0[r]);
#pragma unroll
    for (int r = 0; r < 16; ++r) pmax = fmaxf(pmax, p1[r]);
    { auto rr = __builtin_amdgcn_permlane32_swap(__float_as_uint(pmax), __float_as_uint(pmax), false, false);
      pmax = fmaxf(__uint_as_float(rr[0]), __uint_as_float(rr[1])); }
    constexpr float C2 = LOG2E * SCALE; constexpr float THR = 8.f;
    if (__builtin_expect(__all((pmax - m_reg) * SCALE <= THR), 1)) { mn = m_reg; alpha = 1.f; }
    else { mn = fmaxf(m_reg, pmax); alpha = __builtin_amdgcn_exp2f((m_reg - mn) * C2); m_reg = mn; }
    const float mnL = -mn * C2;
#pragma unroll
    for (int r = 0; r < 16; ++r) p0[r] = fmaf(p0[r], C2, mnL);
#pragma unroll
    for (int r = 0; r < 16; ++r) p1[r] = fmaf(p1[r], C2, mnL);
#pragma unroll
    for (int r = 0; r < 16; ++r) p0[r] = __builtin_amdgcn_exp2f(p0[r]);
}
#define PK4(P, B_, OUT) do { unsigned a0 = cvt_pk_bf16(P[B_+0], P[B_+1]), a1 = cvt_pk_bf16(P[B_+2], P[B_+3]);                          \
        unsigned b0 = cvt_pk_bf16(P[B_+4], P[B_+5]), b1 = cvt_pk_bf16(P[B_+6], P[B_+7]);                                             \
        auto r0 = __builtin_amdgcn_permlane32_swap(a0, b0, false, false); auto r1 = __builtin_amdgcn_permlane32_swap(a1, b1, false, false); \
        u32x4 w = {r0[0], r1[0], r0[1], r1[1]}; OUT = *reinterpret_cast<bf16x8*>(&w); } while (0)
__device__ __forceinline__ void finishSM(f32x16& p0, f32x16& p1, float alpha, float& l_reg, bf16x8& pa0, bf16x8& pa1, bf16x8& pa2, bf16x8& pa3) {
#pragma unroll
    for (int r = 0; r < 16; ++r) p1[r] = __builtin_amdgcn_exp2f(p1[r]);
    float ps = 0;
#pragma unroll
    for (int r = 0; r < 16; ++r) ps += p0[r];
#pragma unroll
    for (int r = 0; r < 16; ++r) ps += p1[r];
    { auto rr = __builtin_amdgcn_permlane32_swap(__float_as_uint(ps), __float_as_uint(ps), false, false);
      ps = __uint_as_float(rr[0]) + __uint_as_float(rr[1]); }
    l_reg = l_reg * alpha + ps;
    PK4(p0, 0, pa0); PK4(p0, 8, pa1); PK4(p1, 0, pa2); PK4(p1, 8, pa3);
}
__device__ __forceinline__ void sb_group(f32x16& P, int g, float& gs) {
    float run = 0.f;
#pragma unroll
    for (int k = 3; k >= 0; --k) {
        const float z = P[4 * g + k];
        const float t = __builtin_amdgcn_exp2f(-fabsf(z));
        const float l = __builtin_amdgcn_logf(1.f + t);
        const float sp = fmaxf(z, 0.f) + l;
        P[4 * g + k] = (z - sp) - run;
        run += sp;
    }
    gs = run;
}
__device__ __forceinline__ void sb_part1(f32x16& p0, f32x16& p1, float& carry, float mlo) {
    float gs[8];
#pragma unroll
    for (int g = 0; g < 4; ++g) sb_group(p0, g, gs[g]);
#pragma unroll
    for (int g = 0; g < 4; ++g) sb_group(p1, g, gs[4 + g]);
    float run = carry;
#pragma unroll
    for (int G = 7; G >= 0; --G) {
        auto rr = __builtin_amdgcn_permlane32_swap(__float_as_uint(gs[G]), __float_as_uint(gs[G]), false, false);
        const float slo = __uint_as_float(rr[0]), shi = __uint_as_float(rr[1]);
        const float base = fmaf(mlo, shi, run);
        if (G >= 4) {
#pragma unroll
            for (int k = 0; k < 4; ++k) p1[4 * (G - 4) + k] -= base;
        } else {
#pragma unroll
            for (int k = 0; k < 4; ++k) p0[4 * G + k] -= base;
        }
        run += slo + shi;
    }
    carry = run;
#pragma unroll
    for (int r = 0; r < 16; ++r) p0[r] = __builtin_amdgcn_exp2f(p0[r]);
}
__device__ __forceinline__ void sb_part2(f32x16& p0, f32x16& p1, bf16x8& pa0, bf16x8& pa1, bf16x8& pa2, bf16x8& pa3) {
#pragma unroll
    for (int r = 0; r < 16; ++r) p1[r] = __builtin_amdgcn_exp2f(p1[r]);
    PK4(p0, 0, pa0); PK4(p0, 8, pa1); PK4(p1, 0, pa2); PK4(p1, 8, pa3);
}
#undef PK4
template <int KB, bool BIAS>
__device__ __forceinline__ void qkt(f32x16& p0, f32x16& p1, const char* K_lds, int r32, int hi, const bf16x8* qr, const float* bt) {
    if constexpr (BIAS) {
#pragma unroll
        for (int g = 0; g < 4; ++g) { const f32x4 a = *(const f32x4*)(bt + 8 * g), b = *(const f32x4*)(bt + 32 + 8 * g);
            p0[4 * g] = a[0]; p0[4 * g + 1] = a[1]; p0[4 * g + 2] = a[2]; p0[4 * g + 3] = a[3];
            p1[4 * g] = b[0]; p1[4 * g + 1] = b[1]; p1[4 * g + 2] = b[2]; p1[4 * g + 3] = b[3]; }
    } else { p0 = f32x16{}; p1 = f32x16{}; }
    const char* kb[4];
#pragma unroll
    for (int dd = 0; dd < 4; ++dd) kb[dd] = K_lds + KB * SHM_K + KSWZ(r32, (dd * 16 + hi * 8) * 2);
#pragma unroll
    for (int d0 = 0; d0 < 8; ++d0) { const char* a = kb[d0 & 3] + (d0 >> 2) * 128;
        bf16x8 b0 = *reinterpret_cast<const bf16x8*>(a);
        bf16x8 b1 = *reinterpret_cast<const bf16x8*>(a + 32 * 256);
        p0 = __builtin_amdgcn_mfma_f32_32x32x16_bf16(b0, qr[d0], p0, 0, 0, 0);
        p1 = __builtin_amdgcn_mfma_f32_32x32x16_bf16(b1, qr[d0], p1, 0, 0, 0); }
}
template <int VB>
__device__ __forceinline__ void pv_tile(f32x16* o, int vb0, bf16x8 pa0, bf16x8 pa1, bf16x8 pa2, bf16x8 pa3) {
#define TRRD(dst, off) asm volatile("ds_read_b64_tr_b16 %0, %1 offset:%2" : "=&v"(dst) : "v"(vb0), "i"(off) : "memory")
#define PV_D0(d0) do { { s16x4 l0, l1, h0, h1; constexpr int b_ = VB * SHM_V + v_rd_off(d0, 0, 0); \
        TRRD(l0, b_); TRRD(h0, b_ + 2048); TRRD(l1, b_ + 4096); TRRD(h1, b_ + 6144); \
        asm volatile("s_waitcnt lgkmcnt(0)" ::: "memory"); SBAR();   \
        o[d0] = __builtin_amdgcn_mfma_f32_32x32x16_bf16(pa0, (bf16x8){l0[0], l0[1], l0[2], l0[3], h0[0], h0[1], h0[2], h0[3]}, o[d0], 0, 0, 0);   \
        o[d0] = __builtin_amdgcn_mfma_f32_32x32x16_bf16(pa1, (bf16x8){l1[0], l1[1], l1[2], l1[3], h1[0], h1[1], h1[2], h1[3]}, o[d0], 0, 0, 0); }  \
      { s16x4 l2, l3, h2, h3; constexpr int b_ = VB * SHM_V + v_rd_off(d0, 0, 0); \
        TRRD(l2, b_ + 8192); TRRD(h2, b_ + 10240); TRRD(l3, b_ + 12288); TRRD(h3, b_ + 14336); \
        asm volatile("s_waitcnt lgkmcnt(0)" ::: "memory"); SBAR();   \
        o[d0] = __builtin_amdgcn_mfma_f32_32x32x16_bf16(pa2, (bf16x8){l2[0], l2[1], l2[2], l2[3], h2[0], h2[1], h2[2], h2[3]}, o[d0], 0, 0, 0);   \
        o[d0] = __builtin_amdgcn_mfma_f32_32x32x16_bf16(pa3, (bf16x8){l3[0], l3[1], l3[2], l3[3], h3[0], h3[1], h3[2], h3[3]}, o[d0], 0, 0, 0); } } while (0)
    PV_D0(0); PV_D0(1); PV_D0(2); PV_D0(3);
#undef PV_D0
#undef TRRD
}

struct UnitRef { const bf16_t* Q; const bf16_t* K; const bf16_t* V; int P0; };
struct Seam { bf16x8 qr[8]; bf16x8 st_v0, st_v1, st_k0, st_k1; };
#define ROW(p, k0, rr) ((p) + (size_t)((k0) + (rr)) * D + sc)
#define VMW() asm volatile("s_waitcnt vmcnt(0)" ::: "memory")
#define SLOAD_H(Kp, Vp, k0) do { S.st_v0 = load8(ROW(Vp, k0, sr)); S.st_v1 = load8(ROW(Vp, k0, 32 + sr));              \
                         S.st_k0 = load8(ROW(Kp, k0, sr)); S.st_k1 = load8(ROW(Kp, k0, 32 + sr)); } while (0)
#define SWRITE_HK(bf) do { *(bf16x8*)(K_lds + (bf) * SHM_K + kws) = S.st_k0; *(bf16x8*)(K_lds + (bf) * SHM_K + kws + 32 * 256) = S.st_k1; } while (0)
#define SWRITE_HV(bf) do { *(bf16x8*)(V_lds + (bf) * SHM_V + vst0) = S.st_v0; *(bf16x8*)(V_lds + (bf) * SHM_V + vst1) = S.st_v1; } while (0)
#define SWRITE_H(bf) do { SWRITE_HV(bf); SWRITE_HK(bf); } while (0)

template <bool SB>
__device__ __forceinline__ void attn_unit(const UnitRef& cur, const float* cvec  , const bf16_t* gate  ,
                                          bf16_t* outp  , char* lds) {
    const int tid = tid_opaque(), wid = __builtin_amdgcn_readfirstlane(tid >> 6), lane = tid & 63, r32 = lane & 31, hi = lane >> 5;
    const int NT = (cur.P0 + QB) / KVBLK;
#define KBASE(t) ((SB ? (NT - 1 - (t)) : (t)) * KVBLK)
    const int qlo = cur.P0 + wid * QBLK, qm = qlo + r32 - 4 * hi - (SB ? 1 : 0);
    char* V_lds = lds; char* K_lds = lds + 2 * SHM_V;
    float* ws = (float*)(lds + OFF_WS) + wid * 64; float* li_l = ws, * al_l = ws + 32;
    float* bias = (float*)(lds + OFF_BIAS);
    const int sr = tid >> 4, sc = (tid & 15) * 8, vst0 = v_st(sr, sc), vst1 = v_st(32 + sr, sc), kws = KSWZ(sr, sc * 2);
    const int vb0 = (int)(uintptr_t)V_lds + v_rd_base(lane);
    const bf16_t* Kh = cur.K; const bf16_t* Vh = cur.V;
    Seam S;
    if constexpr (!SB) { const float cq0 = cvec[cur.P0]; for (int j = tid; j < cur.P0 + QB; j += NTHREADS) bias[j] = (cq0 - cvec[j]) * (1.f / SCALE); }
#pragma unroll
    for (int d0 = 0; d0 < 8; ++d0) S.qr[d0] = load8(cur.Q + (size_t)(wid * QBLK + r32) * D + d0 * 16 + hi * 8);
    SLOAD_H(Kh, Vh, KBASE(0)); VMW(); SWRITE_HK(0);
    __syncthreads();
    float m_reg = -1e30f, l_reg = 0; f32x16 o[4] = {};
    float carry = 0.f; const float mlo = hi ? 0.f : 1.f;
#define RESC(a) do { if (__any((a) < 1.f)) { if (hi == 0) al_l[r32] = (a); asm volatile("s_waitcnt lgkmcnt(0)" ::: "memory");              \
                     for (int d_ = 0; d_ < 4; ++d_) for (int r = 0; r < 16; ++r) o[d_][r] *= al_l[crow(r, hi)]; } } while (0)
#define MASKT(P0_, P1_, t) do { const int kb_ = KBASE(t); if (kb_ + KVBLK - 1 > qlo - (SB ? 1 : 0)) mask_tile(P0_, P1_, qm - kb_); } while (0)
#define BT(t) (bias + KBASE(t) + 4 * hi)
#define PART1(PX0, PX1, mnX, alX) do { if constexpr (SB) sb_part1(PX0, PX1, carry, mlo); else partialSM(PX0, PX1, m_reg, mnX, alX); } while (0)
#define PART2(PY0, PY1, alY) do { if constexpr (SB) sb_part2(PY0, PY1, pa0, pa1, pa2, pa3); else finishSM(PY0, PY1, alY, l_reg, pa0, pa1, pa2, pa3); } while (0)
    f32x16 pA0, pA1, pB0, pB1; float mnA = 0.f, mnB = 0.f, alA = 1.f, alB = 1.f; bf16x8 pa0, pa1, pa2, pa3;
    SWRITE_HV(0); SBAR();
    if (NT > 1) SLOAD_H(Kh, Vh, KBASE(1));
    SBAR(); qkt<0, !SB>(pA0, pA1, K_lds, r32, hi, S.qr, BT(0));
    MASKT(pA0, pA1, 0); PART1(pA0, pA1, mnA, alA);
    if (NT > 1) { VMW(); SWRITE_H(1); }
    __syncthreads();
#define HALF_STEP(PX0, PX1, mnX, alX, PY0, PY1, alY, t, KB, VB, SBUF) do {                                                    \
        SBAR(); qkt<KB, !SB>(PX0, PX1, K_lds, r32, hi, S.qr, BT(t));                                                          \
        PART2(PY0, PY1, alY); SBAR();                                                                                          \
        if ((t) + 1 < NT) { SLOAD_H(Kh, Vh, KBASE((t) + 1)); SBAR(); }                                                         \
        pv_tile<VB>(o, vb0, pa0, pa1, pa2, pa3); MASKT(PX0, PX1, (t)); PART1(PX0, PX1, mnX, alX);                              \
        __syncthreads();                                                                                                      \
        if ((t) + 1 < NT) { VMW(); SWRITE_H(SBUF); }                                                                           \
        if constexpr (!SB) RESC(alX);                                                                                          \
        __syncthreads(); } while (0)
    for (int t = 1; t + 1 < NT; t += 2) {
        HALF_STEP(pB0, pB1, mnB, alB, pA0, pA1, alA, t, 1, 0, 0);
        HALF_STEP(pA0, pA1, mnA, alA, pB0, pB1, alB, t + 1, 0, 1, 1);
    }
    const bool even = (NT & 1) == 0;
    if (even) { SBAR(); qkt<1, !SB>(pB0, pB1, K_lds, r32, hi, S.qr, BT(NT - 1)); SBAR(); }
    PART2(pA0, pA1, alA); SBAR();
    pv_tile<0>(o, vb0, pa0, pa1, pa2, pa3);
    if (even) { MASKT(pB0, pB1, NT - 1); PART1(pB0, pB1, mnB, alB); __syncthreads(); if constexpr (!SB) RESC(alB);
        PART2(pB0, pB1, alB); SBAR(); pv_tile<1>(o, vb0, pa0, pa1, pa2, pa3); }
    float rli[16];
    if constexpr (!SB) {
        if (hi == 0) li_l[r32] = l_reg; asm volatile("s_waitcnt lgkmcnt(0)" ::: "memory");
#pragma unroll
        for (int r = 0; r < 16; ++r) rli[r] = __builtin_amdgcn_rcpf(li_l[crow(r, hi)]);
    }
#pragma unroll
    for (int r = 0; r < 16; ++r) { const int orow = cur.P0 + wid * QBLK + crow(r, hi);
#pragma unroll
        for (int d0 = 0; d0 < 4; ++d0) {
            float v = o[d0][r];
            if constexpr (!SB) { const unsigned short gb = gate[(size_t)orow * 1024 + d0 * 32 + r32]; v = v * rli[r] * __builtin_bit_cast(float, (unsigned)gb << 16); }
            const float vn = __shfl_xor(v, 1);
            if ((r32 & 1) == 0) *(unsigned*)(outp + (size_t)orow * DM + d0 * 32 + r32) = cvt_pk_bf16(v, vn); } }
    __syncthreads();
#undef RESC
#undef KBASE
#undef MASKT
#undef BT
#undef PART1
#undef PART2
#undef HALF_STEP
}

constexpr float SB_TH = 150.f;
__device__ __forceinline__ void sb_unit(const UnitRef& cur, bf16_t* outp, char* lds) {
    const int tid = tid_opaque(), wid = __builtin_amdgcn_readfirstlane(tid >> 6), lane = tid & 63, r32 = lane & 31, hi = lane >> 5;
    const int NT = (cur.P0 + QB) / KVBLK;
#define KBASE(t) ((NT - 1 - (t)) * KVBLK)
    const int qlo = cur.P0 + wid * QBLK, qm = qlo + r32 - 4 * hi - 1;
    char* V_lds = lds; char* K_lds = lds + 2 * SHM_V;
    volatile int* flags = (volatile int*)(lds + OFF_WS);
    const int sr = tid >> 4, sc = (tid & 15) * 8, vst0 = v_st(sr, sc), vst1 = v_st(32 + sr, sc), kws = KSWZ(sr, sc * 2);
    const int vb0 = (int)(uintptr_t)V_lds + v_rd_base(lane);
    const bf16_t* Kh = cur.K; const bf16_t* Vh = cur.V;
    Seam S;
#pragma unroll
    for (int d0 = 0; d0 < 8; ++d0) S.qr[d0] = load8(cur.Q + (size_t)(wid * QBLK + r32) * D + d0 * 16 + hi * 8);
    SLOAD_H(Kh, Vh, KBASE(0)); VMW(); SWRITE_H(0);
    __syncthreads();
    f32x16 o[4] = {}; float carry = 0.f; const float mlo = hi ? 0.f : 1.f;
    bool wdone = false;
#define SB_STEP(tt, BUF) {                                                                                                 \
        const int kb_ = KBASE(tt);                                                                                           \
        if ((tt) + 1 < NT) SLOAD_H(Kh, Vh, KBASE((tt) + 1));                                                                 \
        SBAR();                                                                                                              \
        if (!wdone && kb_ <= qlo + QBLK - 2) {                                                                               \
            f32x16 p0, p1; bf16x8 pa0, pa1, pa2, pa3;                                                                        \
            qkt<BUF, false>(p0, p1, K_lds, r32, hi, S.qr, nullptr);                                                          \
            if (kb_ + KVBLK - 1 > qlo - 1) mask_tile(p0, p1, qm - kb_);                                                      \
            sb_part1(p0, p1, carry, mlo); sb_part2(p0, p1, pa0, pa1, pa2, pa3); SBAR();                                      \
            pv_tile<BUF>(o, vb0, pa0, pa1, pa2, pa3);                                                                        \
            wdone = __all(carry >= SB_TH);                                                                                   \
        }                                                                                                                    \
        if ((tt) + 1 < NT) { VMW(); SWRITE_H((BUF) ^ 1); }                                                                   \
        if (lane == 0) flags[((tt) & 1) * 8 + wid] = wdone ? 1 : 0;                                                          \
        __syncthreads();                                                                                                     \
        { int alld = 1;                                                                                                      \
          _Pragma("unroll") for (int w_ = 0; w_ < 8; ++w_) alld &= flags[((tt) & 1) * 8 + w_];                                \
          if (alld) break; } }
    for (int t = 0; t < NT; t += 2) {
        SB_STEP(t, 0)
        SB_STEP(t + 1, 1)
    }
#undef SB_STEP
#pragma unroll
    for (int r = 0; r < 16; ++r) { const int orow = cur.P0 + wid * QBLK + crow(r, hi);
#pragma unroll
        for (int d0 = 0; d0 < 4; ++d0) {
            const float v = o[d0][r];
            const float vn = __shfl_xor(v, 1);
            if ((r32 & 1) == 0) *(unsigned*)(outp + (size_t)orow * DM + d0 * 32 + r32) = cvt_pk_bf16(v, vn); } }
    __syncthreads();
#undef KBASE
}
#undef ROW
#undef VMW
#undef SLOAD_H
#undef SWRITE_HK
#undef SWRITE_HV
#undef SWRITE_H
}

struct Args { const float* in[12]; float* out; unsigned char* ws; int ph_lo, ph_hi; };

__device__ __forceinline__ void p0_transpose_item(const float* W, int ldw, int K, bf16_t* WT, int nblk, LAS float* scr, int item, int lane, const float* gk) {
    const int kb = item / nblk, nb = item % nblk, k0 = 64 * kb, n0 = 32 * nb;
#pragma unroll 8
    for (int i = 0; i < 32; ++i) { const int kk = 2 * i + (lane >> 5); float w = W[(size_t)(k0 + kk) * ldw + n0 + (lane & 31)]; if (gk) w *= gk[k0 + kk]; scr[kk * 33 + (lane & 31)] = w; }
    LDS_WAIT(); asm volatile("" ::: "memory");
    const int c = lane & 7;
#pragma unroll
    for (int j = 0; j < 4; ++j) { const int n = (lane >> 3) + 8 * j; const LAS float* s = scr + (8 * c) * 33 + n;
        u32x4 o; o.x = cvt_pk_bf16(s[0 * 33], s[1 * 33]); o.y = cvt_pk_bf16(s[2 * 33], s[3 * 33]); o.z = cvt_pk_bf16(s[4 * 33], s[5 * 33]); o.w = cvt_pk_bf16(s[6 * 33], s[7 * 33]);
        *(u32x4*)(WT + (size_t)(n0 + n) * K + k0 + 8 * c) = o; }
    LDS_WAIT(); asm volatile("" ::: "memory");
}

__device__ __forceinline__ float log_sigmoid_f(float x) { return fminf(x, 0.f) - log1pf(expf(-fabsf(x))); }

__device__ __forceinline__ void phase0(const Args& a, unsigned char* lds_g) {
    LAS unsigned char* lds = (LAS unsigned char*)lds_g;
    const int tid = tid_opaque(), lane = tid & 63, wave = __builtin_amdgcn_readfirstlane(tid >> 6);
    const int gw = blockIdx.x * NWAVES + wave, NGW = gridDim.x * NWAVES;
    const int gt = blockIdx.x * NTHREADS + tid, NGT = gridDim.x * NTHREADS;
    unsigned char* ws = a.ws;
    const float* x = a.in[0]; const float* g_attn = a.in[1]; const float* w_in = a.in[2]; const float* b_forget = a.in[3];
    const float* w_out = a.in[6]; const float* g_ffn = a.in[7]; const float* w_pq = a.in[8]; const float* sk = a.in[9]; const float* pu = a.in[10]; const float* pv = a.in[11];
    LAS float* wf = (LAS float*)(lds + 67584);
    for (int k = tid; k < DM; k += NTHREADS) { const f32x4 a0 = *(const f32x4*)(w_in + (size_t)k * DIN + NPROJ), a1 = *(const f32x4*)(w_in + (size_t)k * DIN + NPROJ + 4);
        *(LAS f32x4*)(wf + k * 8) = a0; *(LAS f32x4*)(wf + k * 8 + 4) = a1; }
    __syncthreads();
    for (int row = gw; row < T; row += NGW) {
        const f32x4* xr = (const f32x4*)(x + (size_t)row * DM);
        f32x4 v[8]; float ss = 0.f;
#pragma unroll
        for (int j = 0; j < 8; ++j) { v[j] = xr[lane + 64 * j]; ss += v[j][0] * v[j][0] + v[j][1] * v[j][1] + v[j][2] * v[j][2] + v[j][3] * v[j][3]; }
        const float r = 1.0f / sqrtf(wave_sum(ss) * (1.f / DM) + EPS);
        float f[8] = {0.f, 0.f, 0.f, 0.f, 0.f, 0.f, 0.f, 0.f};
        u32x2* o8 = (u32x2*)(ws + WS_XN + (size_t)row * DM * 2);
#pragma unroll
        for (int j = 0; j < 8; ++j) {
            const int e = 4 * (lane + 64 * j);
            const f32x4 g4 = *(const f32x4*)(g_attn + e);
            f32x4 xn; xn[0] = v[j][0] * r * g4[0]; xn[1] = v[j][1] * r * g4[1]; xn[2] = v[j][2] * r * g4[2]; xn[3] = v[j][3] * r * g4[3];
            u32x2 w; w.x = cvt_pk_bf16(xn[0], xn[1]); w.y = cvt_pk_bf16(xn[2], xn[3]); o8[lane + 64 * j] = w;
#pragma unroll
            for (int q = 0; q < 4; ++q) { const f32x4 w0 = *(LAS f32x4*)(wf + (e + q) * 8), w1 = *(LAS f32x4*)(wf + (e + q) * 8 + 4);
                f[0] += xn[q] * w0[0]; f[1] += xn[q] * w0[1]; f[2] += xn[q] * w0[2]; f[3] += xn[q] * w0[3];
                f[4] += xn[q] * w1[0]; f[5] += xn[q] * w1[1]; f[6] += xn[q] * w1[2]; f[7] += xn[q] * w1[3]; }
        }
#pragma unroll
        for (int hh = 0; hh < 8; ++hh) f[hh] = wave_sum(f[hh]);
        if (lane < 8) { float fl = f[0];
#pragma unroll
            for (int hh = 1; hh < 8; ++hh) fl = (lane == hh) ? f[hh] : fl;
            const int b = row >> 12, s = row & 4095;
            ((float*)(ws + WS_LOGF))[(size_t)(b * 8 + lane) * SEQ + s] = log_sigmoid_f(fl + b_forget[lane]); }
    }
    LAS float* scr = (LAS float*)(lds + wave * 8448);
    constexpr int I_IN = (DM / 64) * (NPROJ / 32), I_O = (DM / 64) * (DM / 32);
    for (int it = gw; it < I_IN + 2 * I_O; it += NGW) {
        int r = it;
        if (r < I_IN) { p0_transpose_item(w_in, DIN, DM, (bf16_t*)(ws + WS_WIN), NPROJ / 32, scr, r, lane, nullptr); continue; } r -= I_IN;
        if (r < I_O) { p0_transpose_item(w_out, DM, DM, (bf16_t*)(ws + WS_WOUT), DM / 32, scr, r, lane, nullptr); continue; } r -= I_O;
        p0_transpose_item(w_pq, DM, DM, (bf16_t*)(ws + WS_WPQ), DM / 32, scr, r, lane, g_ffn);
    }
    for (int i = gt; i < 8 * 2 * 128 * 128 / 8; i += NGT) { const f32x4 a0 = *(const f32x4*)(sk + (size_t)i * 8), a1 = *(const f32x4*)(sk + (size_t)i * 8 + 4);
        u32x4 w; w.x = cvt_pk_bf16(a0[0], a0[1]); w.y = cvt_pk_bf16(a0[2], a0[3]); w.z = cvt_pk_bf16(a1[0], a1[1]); w.w = cvt_pk_bf16(a1[2], a1[3]);
        *(u32x4*)(ws + WS_SK + (size_t)i * 16) = w; }
    float* suv = (float*)(ws + WS_SUV);
    for (int r = gw; r < 2 * NEXP; r += NGW) {
        const bool isv = r >= NEXP; const int e = isv ? r - NEXP : r;
        const f32x4* srcp = (const f32x4*)((isv ? pv : pu) + (size_t)e * DM);
        f32x4 v[8]; float amax = 0.f;
#pragma unroll
        for (int j = 0; j < 8; ++j) { v[j] = srcp[lane + 64 * j];
            if (!isv) { const f32x4 g4 = *(const f32x4*)(g_ffn + 4 * (lane + 64 * j)); v[j] = v[j] * g4; }
            amax = fmaxf(amax, fmaxf(fmaxf(fabsf(v[j][0]), fabsf(v[j][1])), fmaxf(fabsf(v[j][2]), fabsf(v[j][3])))); }
        amax = wave_max(amax);
        const float sc = amax > 0.f ? 440.f / amax : 1.f;
        unsigned* dst = (unsigned*)(ws + (isv ? WS_V8 : WS_U8) + (size_t)e * DM);
#pragma unroll
        for (int j = 0; j < 8; ++j) { int p = __builtin_amdgcn_cvt_pk_fp8_f32(v[j][0] * sc, v[j][1] * sc, 0, false); p = __builtin_amdgcn_cvt_pk_fp8_f32(v[j][2] * sc, v[j][3] * sc, p, true);
            dst[lane + 64 * j] = (unsigned)p; }
        if (lane == 0) suv[r] = 1.f / sc;
    }
}

__device__ __forceinline__ void cumsum_rows(const Args& a) {
    const int tid = tid_opaque(), lane = tid & 63, wave = tid >> 6;
    if (blockIdx.x >= 16 || wave != 0) return;
    const float* src = (const float*)(a.ws + WS_LOGF) + (size_t)blockIdx.x * SEQ + lane * 64;
    float* dst = (float*)(a.ws + WS_C) + (size_t)blockIdx.x * SEQ + lane * 64;
    f32x4 v[16]; float run = 0.f;
#pragma unroll
    for (int i = 0; i < 16; ++i) { v[i] = *(const f32x4*)(src + 4 * i);
#pragma unroll
        for (int q = 0; q < 4; ++q) { run += v[i][q]; v[i][q] = run; } }
    float incl = run;
#pragma unroll
    for (int o = 1; o < 64; o <<= 1) { const float t = __shfl_up(incl, o); if (lane >= o) incl += t; }
    const float off = incl - run;
#pragma unroll
    for (int i = 0; i < 16; ++i) { f32x4 w = v[i]; w[0] += off; w[1] += off; w[2] += off; w[3] += off; *(f32x4*)(dst + 4 * i) = w; }
}

__device__ __forceinline__ void phase_qknorm(const Args& a) {
    const int tid = tid_opaque(), lane = tid & 63, wave = tid >> 6;
    const int gw = blockIdx.x * NWAVES + wave, NGW = gridDim.x * NWAVES;
    const int sub = lane & 15, rw = lane >> 4;
    const float* gq = a.in[4]; const float* gk = a.in[5];
    constexpr int ROWS = NB * NHF * SEQ;
    for (int it = gw; it < 2 * ROWS / 4; it += NGW) {
        const int row = it * 4 + rw; const bool isk = row >= ROWS;
        bf16_t* p = (bf16_t*)(a.ws + WS_SEC) + (size_t)row * HD + sub * 8;
        const float* g = (isk ? gk : gq) + sub * 8;
        const u32x4 w = *(const u32x4*)p;
        float v[8] = {bf_lo(w.x), bf_hi(w.x), bf_lo(w.y), bf_hi(w.y), bf_lo(w.z), bf_hi(w.z), bf_lo(w.w), bf_hi(w.w)};
        float ss = 0.f;
#pragma unroll
        for (int i = 0; i < 8; ++i) ss += v[i] * v[i];
        ss += __shfl_xor(ss, 1); ss += __shfl_xor(ss, 2); ss += __shfl_xor(ss, 4); ss += __shfl_xor(ss, 8);
        const float r = 1.0f / sqrtf(ss * (1.f / HD) + EPS);
        const f32x4 g0 = *(const f32x4*)g, g1 = *(const f32x4*)(g + 4);
        u32x4 o; o.x = cvt_pk_bf16(v[0] * r * g0[0], v[1] * r * g0[1]); o.y = cvt_pk_bf16(v[2] * r * g0[2], v[3] * r * g0[3]);
        o.z = cvt_pk_bf16(v[4] * r * g1[0], v[5] * r * g1[1]); o.w = cvt_pk_bf16(v[6] * r * g1[2], v[7] * r * g1[3]);
        *(u32x4*)p = o;
    }
}

__device__ __forceinline__ void phase_attn(const Args& a, unsigned char* lds_g) {
    const int tid = tid_opaque();
    volatile int* s_item = (volatile int*)(lds_g + MISC_OFF);
    unsigned* ctr = (unsigned*)(a.ws + WS_CTL);
    bf16_t* sec = (bf16_t*)(a.ws + WS_SEC);
    for (;;) {
        __syncthreads();
        if (tid == 0) *s_item = (int)atomicAdd(ctr, 1u);
        __syncthreads();
        const int it = *s_item;
        if (it >= 512) break;
        const int qb = 15 - (it >> 5), kind = (it >> 4) & 1, bh = it & 15;
        const int b = bh >> 3, h = bh & 7;
        const size_t hoff = (size_t)bh * SEQ * HD;
        att::UnitRef u;
        u.P0 = qb * 256;
        if (kind == 0) {
            u.Q = sec + 4 * SEC_ELEMS + hoff + (size_t)u.P0 * HD; u.K = sec + 5 * SEC_ELEMS + hoff; u.V = sec + 6 * SEC_ELEMS + hoff;
            att::sb_unit(u, (bf16_t*)(a.ws + WS_MIX) + (size_t)b * SEQ * DM + 1024 + h * HD, (char*)lds_g);
        } else {
            u.Q = sec + 0 * SEC_ELEMS + hoff + (size_t)u.P0 * HD; u.K = sec + 1 * SEC_ELEMS + hoff; u.V = sec + 2 * SEC_ELEMS + hoff;
            att::attn_unit<false>(u, (const float*)(a.ws + WS_C) + (size_t)bh * SEQ, sec + 3 * SEC_ELEMS + (size_t)b * SEQ * 1024 + h * HD,
                                  (bf16_t*)(a.ws + WS_MIX) + (size_t)b * SEQ * DM + h * HD, (char*)lds_g);
        }
    }
}

__device__ __forceinline__ unsigned f2ord(float f) { const unsigned u = __float_as_uint(f); return u ^ ((unsigned)((int)u >> 31) | 0x80000000u); }
__device__ __forceinline__ float ord2f(unsigned k) { const unsigned u = k ^ (~(unsigned)((int)k >> 31) | 0x80000000u); return __uint_as_float(u); }
#define INS16(L, X) do { unsigned x_ = (X); _Pragma("unroll") for (int i_ = 0; i_ < 16; ++i_) { const unsigned hi_ = max(L[i_], x_); x_ = min(L[i_], x_); L[i_] = hi_; } } while (0)
__device__ __forceinline__ void topk_half(const bf16_t* qp, const bf16_t* skb, int t0, int h, int c, int r32, int hi, unsigned (&L)[16]) {
    bf16x8 qf[8];
#pragma unroll
    for (int d0 = 0; d0 < 8; ++d0) qf[d0] = *(const bf16x8*)(qp + (size_t)(t0 + r32) * DM + h * 256 + c * 128 + d0 * 16 + hi * 8);
#pragma unroll
    for (int i = 0; i < 16; ++i) L[i] = 0u;
    const unsigned hi4 = 4u * (unsigned)hi;
#pragma unroll
    for (int kt = 0; kt < 4; ++kt) {
        f32x16 acc = f32x16{};
#pragma unroll
        for (int d0 = 0; d0 < 8; ++d0) { const bf16x8 kf = *(const bf16x8*)(skb + (size_t)((h * 2 + c) * 128 + kt * 32 + r32) * 128 + d0 * 16 + hi * 8);
            acc = __builtin_amdgcn_mfma_f32_32x32x16_bf16(kf, qf[d0], acc, 0, 0, 0); }
        __builtin_amdgcn_sched_barrier(0);
#pragma unroll
        for (int r = 0; r < 16; ++r) { const unsigned cst = (unsigned)(127 - (kt * 32 + (r & 3) + 8 * (r >> 2)));
            const unsigned kk = (f2ord(acc[r]) & ~127u) | (cst - hi4); INS16(L, kk); }
        __builtin_amdgcn_sched_barrier(0);
    }
    unsigned P[16];
#pragma unroll
    for (int i = 0; i < 16; ++i) { auto rr = __builtin_amdgcn_permlane32_swap(L[i], L[i], false, false); P[i] = hi ? rr[0] : rr[1]; }
#pragma unroll
    for (int i = 0; i < 16; ++i) INS16(L, P[i]);
}
__device__ __forceinline__ void phase_topk(const Args& a, unsigned char* lds_g) {
    LAS unsigned char* lds = (LAS unsigned char*)lds_g;
    const int tid = tid_opaque(), lane = tid & 63, wave = tid >> 6, r32 = lane & 31, hi = lane >> 5;
    const int gw = blockIdx.x * NWAVES + wave, NGW = gridDim.x * NWAVES;
    const bf16_t* skb = (const bf16_t*)(a.ws + WS_SK); const bf16_t* qp = (const bf16_t*)(a.ws + WS_QP);
    int* idx_o = (int*)(a.ws + WS_IDX); float* gw_o = (float*)(a.ws + WS_GW);
    for (int task = gw; task < (T / 32) * 8; task += NGW) {
        const int h = task & 7, t0 = (task >> 3) * 32;
        unsigned L[2][16];
        topk_half(qp, skb, t0, h, 0, r32, hi, L[0]);
        __builtin_amdgcn_sched_barrier(0);
        topk_half(qp, skb, t0, h, 1, r32, hi, L[1]);
        __builtin_amdgcn_sched_barrier(0);
        float s1[16], s2[16]; int i1[16], i2[16];
#pragma unroll
        for (int i = 0; i < 16; ++i) { s1[i] = ord2f((L[0][i] & ~127u) | 64u); i1[i] = 127 - (int)(L[0][i] & 127u); s2[i] = ord2f((L[1][i] & ~127u) | 64u); i2[i] = 127 - (int)(L[1][i] & 127u); }
        unsigned LC[16];
#pragma unroll
        for (int i = 0; i < 16; ++i) LC[i] = 0u;
#pragma unroll
        for (int aa = 0; aa < 16; ++aa)
#pragma unroll
            for (int bb = 0; bb < 16; ++bb) if ((aa + 1) * (bb + 1) <= 16) { const unsigned kk = (f2ord(s1[aa] + s2[bb]) & ~255u) | (unsigned)(aa * 16 + bb); INS16(LC, kk); }
        LAS int* tb = (LAS int*)(lds + wave * 8192);
#pragma unroll
        for (int i = 0; i < 16; ++i) { tb[i * 64 + lane] = i1[i]; tb[(16 + i) * 64 + lane] = i2[i]; }
        float LS[16]; int LP[16];
#pragma unroll
        for (int i = 0; i < 16; ++i) { const unsigned cid = LC[i] & 255u; LS[i] = ord2f((LC[i] & ~255u) | 128u);
            LP[i] = tb[(cid >> 4) * 64 + lane] * 128 + tb[(16 + (cid & 15u)) * 64 + lane]; }
        float den = 0.f, e[16];
#pragma unroll
        for (int i = 0; i < 16; ++i) { e[i] = __expf(LS[i] - LS[0]); den += e[i]; }
        const float rden = 1.f / den;
        const size_t ob = (size_t)(t0 + r32) * NE + h * 16;
        if (hi == 0) {
#pragma unroll
            for (int i = 0; i < 4; ++i) *(int4*)(idx_o + ob + 4 * i) = make_int4(LP[4 * i], LP[4 * i + 1], LP[4 * i + 2], LP[4 * i + 3]);
        } else {
#pragma unroll
            for (int i = 0; i < 4; ++i) *(f32x4*)(gw_o + ob + 4 * i) = (f32x4){e[4 * i] * rden, e[4 * i + 1] * rden, e[4 * i + 2] * rden, e[4 * i + 3] * rden};
        }
    }
}


__device__ __forceinline__ void wave_argmax(float& v, int& i) {
#pragma unroll
    for (int o = 1; o < 64; o <<= 1) { const float ov = __shfl_xor(v, o); const int oi = __shfl_xor(i, o); if (ov > v || (ov == v && oi < i)) { v = ov; i = oi; } }
}
__device__ __forceinline__ void phase_topk_ref(const Args& a) {
    const int tid = tid_opaque(), lane = tid & 63, wave = tid >> 6;
    const int gw = blockIdx.x * NWAVES + wave, NGW = gridDim.x * NWAVES;
    const bf16_t* skb = (const bf16_t*)(a.ws + WS_SK); const bf16_t* qp = (const bf16_t*)(a.ws + WS_QP);
    int* idx_o = (int*)(a.ws + WS_IDX); float* gw_o = (float*)(a.ws + WS_GW);
    for (int task = gw; task < T * 8; task += NGW) {
        const int t = task >> 3, h = task & 7;
        float topS[2]; int topI[2];
        for (int c = 0; c < 2; ++c) {
            const bf16_t* q = qp + (size_t)t * DM + h * 256 + c * 128;
            float sc0 = 0.f, sc1 = 0.f;
            const bf16_t* k0 = skb + (size_t)((h * 2 + c) * 128 + lane) * 128; const bf16_t* k1 = k0 + 64 * 128;
            for (int d = 0; d < 128; ++d) { const float qd = __uint_as_float((unsigned)q[d] << 16);
                sc0 += qd * __uint_as_float((unsigned)k0[d] << 16); sc1 += qd * __uint_as_float((unsigned)k1[d] << 16); }
            float ms = 0.f; int mi = 0;
            for (int r = 0; r < 16; ++r) {
                float v; int i; if (sc0 >= sc1) { v = sc0; i = lane; } else { v = sc1; i = lane + 64; }
                wave_argmax(v, i);
                if (lane == r) { ms = v; mi = i; }
                if (i == lane) sc0 = -__builtin_inff();
                if (i == lane + 64) sc1 = -__builtin_inff();
            }
            topS[c] = ms; topI[c] = mi;
        }
        float cs[4]; int ci[4];
#pragma unroll
        for (int j = 0; j < 4; ++j) { const int cidx = lane * 4 + j, aa = cidx >> 4, bb = cidx & 15;
            cs[j] = __shfl(topS[0], aa) + __shfl(topS[1], bb); ci[j] = cidx; }
        float fs = 0.f; int fi = 0;
        for (int r = 0; r < 16; ++r) {
            float v = cs[0]; int i = ci[0];
#pragma unroll
            for (int j = 1; j < 4; ++j) if (cs[j] > v) { v = cs[j]; i = ci[j]; }
            wave_argmax(v, i);
            if (lane == r) { fs = v; fi = i; }
#pragma unroll
            for (int j = 0; j < 4; ++j) if (ci[j] == i) cs[j] = -__builtin_inff();
        }
        const int e1 = __shfl(topI[0], fi >> 4), e2 = __shfl(topI[1], fi & 15);
        const float mx = __shfl(fs, 0);
        float ev = lane < 16 ? __expf(fs - mx) : 0.f;
        const float den = wave_sum(ev);
        if (lane < 16) { idx_o[(size_t)t * NE + h * 16 + lane] = e1 * 128 + e2; gw_o[(size_t)t * NE + h * 16 + lane] = ev / den; }
    }
}

__device__ __forceinline__ void fp8x16_to_f32(const u32x4 q, f32x2 (&o)[8]) {
    o[0] = __builtin_amdgcn_cvt_pk_f32_fp8((int)q.x, false); o[1] = __builtin_amdgcn_cvt_pk_f32_fp8((int)q.x, true);
    o[2] = __builtin_amdgcn_cvt_pk_f32_fp8((int)q.y, false); o[3] = __builtin_amdgcn_cvt_pk_f32_fp8((int)q.y, true);
    o[4] = __builtin_amdgcn_cvt_pk_f32_fp8((int)q.z, false); o[5] = __builtin_amdgcn_cvt_pk_f32_fp8((int)q.z, true);
    o[6] = __builtin_amdgcn_cvt_pk_f32_fp8((int)q.w, false); o[7] = __builtin_amdgcn_cvt_pk_f32_fp8((int)q.w, true);
}
#define HALVE(dst, srcv, n, bitmask) do { const bool up_ = (lane & (bitmask)) != 0; _Pragma("unroll") for (int i_ = 0; i_ < (n); ++i_) { \
        const float keep_ = up_ ? srcv[(n) + i_] : srcv[i_], send_ = up_ ? srcv[i_] : srcv[(n) + i_]; dst[i_] = keep_ + __shfl_xor(send_, (bitmask)); } } while (0)
__device__ __forceinline__ void phase_peer_u(const Args& a) {
    const int tid = tid_opaque(), lane = tid & 63, wave = tid >> 6, g = lane >> 3, c = lane & 7;
    const int xl = blockIdx.x & 7, wv = (blockIdx.x >> 3) * NWAVES + wave, NWX = (gridDim.x >> 3) * NWAVES;
    const bf16_t* hb = (const bf16_t*)(a.ws + WS_HB); const unsigned char* u8 = a.ws + WS_U8;
    const int* idx_i = (const int*)(a.ws + WS_IDX); float* part = (float*)(a.ws + WS_PART);
    for (int sp = 0; sp < 2; ++sp) {
        const int s = xl + 8 * sp;
        for (int t = wv; t < T; t += NWX) {
            int id[16];
            { const int4* ip = (const int4*)(idx_i + (size_t)t * NE + g * 16);
#pragma unroll
              for (int i = 0; i < 4; ++i) { const int4 v = ip[i]; id[4 * i] = v.x; id[4 * i + 1] = v.y; id[4 * i + 2] = v.z; id[4 * i + 3] = v.w; } }
            u32x4 q[16];
#pragma unroll
            for (int i = 0; i < 16; ++i) q[i] = *(const u32x4*)(u8 + (size_t)id[i] * DM + s * 128 + c * 16);
            f32x2 xf[8];
            { const u32x4 x0 = *(const u32x4*)(hb + (size_t)t * DM + s * 128 + c * 16), x1 = *(const u32x4*)(hb + (size_t)t * DM + s * 128 + c * 16 + 8);
              xf[0] = (f32x2){bf_lo(x0.x), bf_hi(x0.x)}; xf[1] = (f32x2){bf_lo(x0.y), bf_hi(x0.y)}; xf[2] = (f32x2){bf_lo(x0.z), bf_hi(x0.z)}; xf[3] = (f32x2){bf_lo(x0.w), bf_hi(x0.w)};
              xf[4] = (f32x2){bf_lo(x1.x), bf_hi(x1.x)}; xf[5] = (f32x2){bf_lo(x1.y), bf_hi(x1.y)}; xf[6] = (f32x2){bf_lo(x1.z), bf_hi(x1.z)}; xf[7] = (f32x2){bf_lo(x1.w), bf_hi(x1.w)}; }
            float p[16];
#pragma unroll
            for (int i = 0; i < 16; ++i) { f32x2 uf[8]; fp8x16_to_f32(q[i], uf); f32x2 ac = uf[0] * xf[0];
#pragma unroll
                for (int k = 1; k < 8; ++k) ac = ac + uf[k] * xf[k];
                p[i] = ac.x + ac.y; }
            float p8[8], p4[4], p2[2];
            HALVE(p8, p, 8, 4); HALVE(p4, p8, 4, 2); HALVE(p2, p4, 2, 1);
            *(f32x2*)(part + ((size_t)t * 16 + s) * NE + 2 * lane) = (f32x2){p2[0], p2[1]};
        }
    }
}
__device__ __forceinline__ void phase_peer_w(const Args& a) {
    const int gt = blockIdx.x * NTHREADS + tid_opaque(), NGT = gridDim.x * NTHREADS;
    const int* idx_i = (const int*)(a.ws + WS_IDX); const float* gw_i = (const float*)(a.ws + WS_GW); const float* part = (const float*)(a.ws + WS_PART);
    const float* suv = (const float*)(a.ws + WS_SUV); const float* rtab = (const float*)(a.ws + WS_RT); float* wtab = (float*)(a.ws + WS_W);
    for (int item = gt; item < T * NE; item += NGT) {
        const int t = item >> 7, e = item & 127;
        float sum = 0.f;
#pragma unroll
        for (int s = 0; s < 16; ++s) sum += part[((size_t)t * 16 + s) * NE + e];
        const int ex = idx_i[item];
        const float d = sum * suv[ex] * rtab[t];
        wtab[item] = 0.5f * d * (1.f + erff(d * 0.70710678118654752f)) * gw_i[item] * suv[NEXP + ex];
    }
}
__device__ __forceinline__ void phase_peer_v(const Args& a, float* dst) {
    const int tid = tid_opaque(), lane = tid & 63, wave = tid >> 6, g = lane >> 3, c = lane & 7;
    const int xl = blockIdx.x & 7, wv = (blockIdx.x >> 3) * NWAVES + wave, NWX = (gridDim.x >> 3) * NWAVES;
    const unsigned char* v8 = a.ws + WS_V8;
    const int* idx_i = (const int*)(a.ws + WS_IDX); const float* wtab = (const float*)(a.ws + WS_W);
    const float* hsrc = a.out;
    for (int sp = 0; sp < 2; ++sp) {
        const int s = xl + 8 * sp;
        for (int t = wv; t < T; t += NWX) {
            int id[16]; float w[16];
            { const int4* ip = (const int4*)(idx_i + (size_t)t * NE + g * 16); const f32x4* wp = (const f32x4*)(wtab + (size_t)t * NE + g * 16);
#pragma unroll
              for (int i = 0; i < 4; ++i) { const int4 v = ip[i]; id[4 * i] = v.x; id[4 * i + 1] = v.y; id[4 * i + 2] = v.z; id[4 * i + 3] = v.w;
                  const f32x4 ww = wp[i]; w[4 * i] = ww[0]; w[4 * i + 1] = ww[1]; w[4 * i + 2] = ww[2]; w[4 * i + 3] = ww[3]; } }
            u32x4 q[16];
#pragma unroll
            for (int i = 0; i < 16; ++i) q[i] = *(const u32x4*)(v8 + (size_t)id[i] * DM + s * 128 + c * 16);
            f32x2 ac[8];
#pragma unroll
            for (int k = 0; k < 8; ++k) ac[k] = (f32x2){0.f, 0.f};
#pragma unroll
            for (int i = 0; i < 16; ++i) { f32x2 vf[8]; fp8x16_to_f32(q[i], vf);
#pragma unroll
                for (int k = 0; k < 8; ++k) ac[k] = ac[k] + vf[k] * w[i]; }
            float p[16];
#pragma unroll
            for (int k = 0; k < 8; ++k) { p[2 * k] = ac[k].x; p[2 * k + 1] = ac[k].y; }
            float p8[8], p4[4], p2[2];
            HALVE(p8, p, 8, 32); HALVE(p4, p8, 4, 16); HALVE(p2, p4, 2, 8);
            const size_t o = (size_t)t * DM + s * 128 + c * 16 + 2 * g;
            const f32x2 hv = *(const f32x2*)(hsrc + o);
            *(f32x2*)(dst + o) = (f32x2){hv.x + p2[0], hv.y + p2[1]};
        }
    }
}
#undef HALVE


#define XB_TMO      128
#define XB_XCNT(j)  (256  + 64 * (j))
#define XB_XSUB(j)  (1280 + 64 * (j))
#define XB_XGEN(j)  (2304 + 64 * (j))
#define XB_TOP      3328
#define XB_TOPGEN   3392
#define XCD_BAR_WORDS 3456
#define XB_SPIN_CAP (1u << 20)
__device__ __forceinline__ unsigned xb_ld(unsigned* p)              { return __hip_atomic_load(p, __ATOMIC_RELAXED, __HIP_MEMORY_SCOPE_AGENT); }
__device__ __forceinline__ unsigned xb_add(unsigned* p, unsigned v) { return __hip_atomic_fetch_add(p, v, __ATOMIC_RELAXED, __HIP_MEMORY_SCOPE_AGENT); }
__device__ __forceinline__ unsigned xb_xcc_id() { return (unsigned)__builtin_amdgcn_s_getreg((3 << 11) | 20) & 0xFu; }
#define XB_SPIN(cond, bar) do { unsigned _sp = 0; while (cond) { __builtin_amdgcn_s_sleep(1); \
    if ((++_sp & 255u) == 0u) { if (xb_ld(&(bar)[XB_TMO])) break; if (_sp > XB_SPIN_CAP) { atomicAdd(&(bar)[XB_TMO], 1u); break; } } } } while (0)
struct XcdBarrier { unsigned* bar; unsigned x; volatile LAS unsigned* st; };
__device__ __forceinline__ XcdBarrier xcd_barrier_post(unsigned* bar, volatile LAS unsigned* st) {
    XcdBarrier b; b.bar = bar; b.x = xb_xcc_id(); b.st = st;
    if (threadIdx.x == 0) (void)xb_add(&bar[XB_XCNT(b.x)], 1u);
    return b;
}
__device__ __forceinline__ void xcd_barrier_complete(unsigned* bar, unsigned x, unsigned& nloc, unsigned& nx) {
    const unsigned G = gridDim.x * gridDim.y * gridDim.z;
    unsigned sum, cnt, mine, sp = 0u;
    for (;;) {
        sum = 0u; cnt = 0u; mine = 0u;
#pragma unroll
        for (unsigned j = 0; j < 16; ++j) { const unsigned c = xb_ld(&bar[XB_XCNT(j)]); sum += c; cnt += (c > 0u) ? 1u : 0u; mine = (j == x) ? c : mine; }
        if (sum == G) break;
        __builtin_amdgcn_s_sleep(1);
        if ((++sp & 255u) == 0u) { if (xb_ld(&bar[XB_TMO])) break; if (sp > XB_SPIN_CAP) { atomicAdd(&bar[XB_TMO], 1u); break; } }
    }
    nloc = mine > 0u ? mine : 1u; nx = cnt > 0u ? cnt : 1u;
}
__device__ __forceinline__ void xcd_barrier(const XcdBarrier& b) {
    asm volatile("s_waitcnt vmcnt(0)" ::: "memory");
    __syncthreads();
    if (threadIdx.x == 0) {
        unsigned* bar = b.bar;
        __builtin_amdgcn_s_waitcnt(0);
        unsigned nloc = b.st[0], nx = b.st[1];
        if (nloc == 0u) { xcd_barrier_complete(bar, b.x, nloc, nx); b.st[0] = nloc; b.st[1] = nx; }
        const unsigned old = xb_add(&bar[XB_XSUB(b.x)], 1u);
        const unsigned gen = old / nloc;
        if (old + 1u == (gen + 1u) * nloc) {
            __builtin_amdgcn_fence(__ATOMIC_RELEASE, "agent");
            asm volatile("s_waitcnt vmcnt(0)" ::: "memory");
            const unsigned og = xb_add(&bar[XB_TOP], 1u);
            const unsigned tg = og / nx;
            if (og + 1u == (tg + 1u) * nx) xb_add(&bar[XB_TOPGEN], 1u);
            else XB_SPIN(xb_ld(&bar[XB_TOPGEN]) == tg, bar);
            __builtin_amdgcn_fence(__ATOMIC_ACQUIRE, "agent");
            xb_add(&bar[XB_XGEN(b.x)], 1u);
            asm volatile("s_waitcnt vmcnt(0)" ::: "memory");
        } else {
            XB_SPIN(xb_ld(&bar[XB_XGEN(b.x)]) == gen, bar);
            __builtin_amdgcn_fence(__ATOMIC_ACQUIRE, "agent");
            asm volatile("s_waitcnt vmcnt(0)" ::: "memory");
        }
    }
    __syncthreads();
}

constexpr int NPHASE = 10;
#define LOAD_ARGS() do { } while (0)
__global__ void __launch_bounds__(NTHREADS, 2) fwd_kernel(Args a) {
    extern __shared__ __attribute__((aligned(16))) unsigned char lds[];
#if MK_ONE_LAUNCH
    constexpr int lo = 0, hi = NPHASE;
    cg::grid_group grid = cg::this_grid();
    volatile LAS unsigned* misc = (volatile LAS unsigned*)((LAS unsigned char*)lds + MISC_OFF);
    if (threadIdx.x < 16) misc[threadIdx.x] = 0u;
    __syncthreads();
    { LOAD_ARGS(); (void)xcd_barrier_post((unsigned*)(a.ws + WS_CTL) + CW_BAR, misc + 8); }
#ifndef SEAM_CG_MASK
#define SEAM_CG_MASK 1
#endif
#define SEAM(k) do { if (lo <= (k) && (k) + 1 < hi) { if ((SEAM_CG_MASK >> (k)) & 1) grid.sync(); else { LOAD_ARGS(); XcdBarrier xb_; xb_.bar = (unsigned*)(a.ws + WS_CTL) + CW_BAR; xb_.x = xb_xcc_id(); \
        xb_.st = (volatile LAS unsigned*)((LAS unsigned char*)lds + MISC_OFF) + 8; xcd_barrier(xb_); } } } while (0)
#else
    int lo, hi; { LOAD_ARGS(); lo = a.ph_lo; hi = a.ph_hi; }
#define SEAM(k) do { } while (0)
#endif
#define IN(k) (lo <= (k) && (k) < hi)
#ifndef DUP_PHASE
#define DUP_PHASE -1
#endif
    if (IN(0)) { LOAD_ARGS(); phase0(a, lds); if (DUP_PHASE == 0) { __syncthreads(); phase0(a, lds); } SEAM(0); }
    if (IN(1)) { LOAD_ARGS(); unsigned char* ws = a.ws;
        cumsum_rows(a);
        pg8::Gemm g{(const bf16_t*)(ws + WS_XN), (const bf16_t*)(ws + WS_WIN), T, NPROJ, DM}; pg8::StaticOrder S; S.init(T, NPROJ, (int)gridDim.x, (int)blockIdx.x);
        pg8::EpiInProj E{(bf16_t*)(ws + WS_SEC)};
        for (int rep_ = 0; rep_ < (DUP_PHASE == 1 ? 2 : 1); ++rep_)
        pg8::gemm_phase<pg8::EpiInProj, pg8::StaticOrder, true, true>((LAS unsigned char*)lds, g, S, E);
        SEAM(1);
    }
    if (IN(2)) { LOAD_ARGS(); phase_qknorm(a); SEAM(2); }
    if (IN(3)) { LOAD_ARGS(); phase_attn(a, lds);
#if MK_ONE_LAUNCH
        if (DUP_PHASE == 3) { grid.sync(); if (blockIdx.x == 0 && threadIdx.x == 0) *(volatile unsigned*)(a.ws + WS_CTL) = 0u; __threadfence(); grid.sync(); phase_attn(a, lds); }
#endif
        SEAM(3); }
    if (IN(4)) { LOAD_ARGS(); unsigned char* ws = a.ws;
        pg8::Gemm g{(const bf16_t*)(ws + WS_MIX), (const bf16_t*)(ws + WS_WOUT), T, DM, DM}; pg8::StaticOrder S; S.init(T, DM, (int)gridDim.x, (int)blockIdx.x);
        pg8::EpiOutProj E{a.in[0], a.out, (bf16_t*)(ws + WS_HB), (float*)(ws + WS_SSQ)};
        for (int rep_ = 0; rep_ < (DUP_PHASE == 4 ? 2 : 1); ++rep_)
        pg8::gemm_phase<pg8::EpiOutProj, pg8::StaticOrder, true, true>((LAS unsigned char*)lds, g, S, E);
        SEAM(4);
    }
    if (IN(5)) { LOAD_ARGS(); unsigned char* ws = a.ws;
        pg8::Gemm g{(const bf16_t*)(ws + WS_HB), (const bf16_t*)(ws + WS_WPQ), T, DM, DM}; pg8::StaticOrder S; S.init(T, DM, (int)gridDim.x, (int)blockIdx.x);
        pg8::EpiPeerQ E{(const float*)(ws + WS_SSQ), (bf16_t*)(ws + WS_QP), (float*)(ws + WS_RT)};
        for (int rep_ = 0; rep_ < (DUP_PHASE == 5 ? 2 : 1); ++rep_)
        pg8::gemm_phase<pg8::EpiPeerQ, pg8::StaticOrder, true, true>((LAS unsigned char*)lds, g, S, E);
        SEAM(5);
    }
    #ifdef TOPK_REF
    if (IN(6)) { LOAD_ARGS(); phase_topk_ref(a); SEAM(6); }
#else
    if (IN(6)) { LOAD_ARGS(); for (int rep_ = 0; rep_ < (DUP_PHASE == 6 ? 2 : 1); ++rep_) phase_topk(a, lds); SEAM(6); }
#endif
    if (IN(7)) { LOAD_ARGS(); for (int rep_ = 0; rep_ < (DUP_PHASE == 7 ? 2 : 1); ++rep_) phase_peer_u(a); SEAM(7); }
    if (IN(8)) { LOAD_ARGS(); for (int rep_ = 0; rep_ < (DUP_PHASE == 8 ? 2 : 1); ++rep_) phase_peer_w(a); SEAM(8); }
    if (IN(9)) { LOAD_ARGS(); for (int rep_ = 0; rep_ < (DUP_PHASE == 9 ? 2 : 1); ++rep_) phase_peer_v(a, (DUP_PHASE == 9 && rep_ == 0) ? (float*)(a.ws + WS_END) : a.out); }
#undef IN
#undef SEAM
}

extern "C" void kernel_launch(void* const* d_in, const int* in_sizes, int n_in, void* d_out, int out_size, void* d_ws, size_t ws_size, hipStream_t stream) {
    static int grid = 0;
    if (grid == 0) {
        if (n_in != 12 || in_sizes[0] != T * DM || out_size != T * DM || ws_size < WS_END) { fprintf(stderr, "kernel_launch: unexpected shapes (n_in %d, in0 %d, out %d, ws %zu)\n", n_in, n_in > 0 ? in_sizes[0] : -1, out_size, ws_size); grid = -1; return; }
        int dev = 0, cus = 0, per_cu = 0;
        if (hipGetDevice(&dev) != hipSuccess || hipDeviceGetAttribute(&cus, hipDeviceAttributeMultiprocessorCount, dev) != hipSuccess) { grid = -1; return; }
        if (hipFuncSetAttribute((const void*)fwd_kernel, hipFuncAttributeMaxDynamicSharedMemorySize, LDS_BYTES) != hipSuccess) { fprintf(stderr, "kernel_launch: hipFuncSetAttribute failed\n"); grid = -1; return; }
        if (hipOccupancyMaxActiveBlocksPerMultiprocessor(&per_cu, (const void*)fwd_kernel, NTHREADS, LDS_BYTES) != hipSuccess || per_cu < 1) { fprintf(stderr, "kernel_launch: occupancy query says %d\n", per_cu); grid = -1; return; }
        grid = cus;
    }
    if (grid < 0) return;
    (void)hipMemsetAsync((char*)d_ws + WS_CTL, 0, CTL_BYTES, stream);
    Args a{};
    for (int i = 0; i < 12; ++i) a.in[i] = (const float*)d_in[i];
    a.out = (float*)d_out; a.ws = (unsigned char*)d_ws;
#if MK_ONE_LAUNCH
    a.ph_lo = 0; a.ph_hi = NPHASE;
    void* args[] = {&a};
    hipError_t e = hipLaunchCooperativeKernel((const void*)fwd_kernel, dim3(grid), dim3(NTHREADS), args, LDS_BYTES, stream);
    if (e != hipSuccess) fprintf(stderr, "cooperative launch failed: %s (grid %d)\n", hipGetErrorString(e), grid);
#else
    for (int p = 0; p < NPHASE; ++p) { a.ph_lo = p; a.ph_hi = p + 1; hipLaunchKernelGGL(fwd_kernel, dim3(grid), dim3(NTHREADS), LDS_BYTES, stream, a); }
#endif
}
```

```cpp
#include <hip/hip_runtime.h>
#include <hip/hip_cooperative_groups.h>
#include <cstdio>
#include <cstdint>
namespace cg = cooperative_groups;

#ifndef MK_COOP_LAUNCH
#define MK_COOP_LAUNCH 0
#endif
#ifndef MK_ONE_LAUNCH
#define MK_ONE_LAUNCH 1
#endif

#define LAS __attribute__((address_space(3)))
typedef unsigned short bf16_t;
typedef short bf16x8 __attribute__((ext_vector_type(8)));
typedef short s16x4 __attribute__((ext_vector_type(4)));
typedef float f32x2 __attribute__((ext_vector_type(2)));
typedef float f32x4 __attribute__((ext_vector_type(4)));
typedef float f32x16 __attribute__((ext_vector_type(16)));
typedef unsigned u32x2 __attribute__((ext_vector_type(2)));
typedef unsigned u32x4 __attribute__((ext_vector_type(4)));
typedef __bf16 bf16x2_t __attribute__((ext_vector_type(2)));

constexpr int NB = 2, SEQ = 4096, T = NB * SEQ, DM = 2048, HD = 128, NHF = 8, DIN = 7176, NPROJ = 7168;
constexpr int NEXP = 16384, NE = 128;
constexpr float EPS = 1e-6f;
constexpr float SCALE = 0.08838834764831845f, LOG2E = 1.4426950408889634f;
constexpr int NWAVES = 8, NTHREADS = 512;

constexpr size_t MiB = 1u << 20;
constexpr size_t WS_CTL = 0, CTL_BYTES = 32768;
constexpr int CW_BAR = 1024;
constexpr size_t WS_WIN = 1 * MiB, WS_WOUT = 29 * MiB, WS_WPQ = 37 * MiB, WS_SK = 45 * MiB, WS_LOGF = 46 * MiB, WS_C = 46 * MiB + 512 * 1024, WS_SSQ = 47 * MiB;
constexpr size_t WS_XN = 48 * MiB;
constexpr size_t WS_SEC = 80 * MiB;
constexpr size_t SEC_ELEMS = 8u << 20;
constexpr size_t WS_MIX = 192 * MiB, WS_HB = 224 * MiB, WS_QP = 256 * MiB, WS_IDX = 288 * MiB, WS_GW = 292 * MiB, WS_U8 = 296 * MiB, WS_V8 = 328 * MiB, WS_SUV = 360 * MiB  , WS_RT = 360 * MiB + 256 * 1024  , WS_W = 361 * MiB  ,
                 WS_PART = 368 * MiB  , WS_END = 432 * MiB;

constexpr int RING_BYTES = 131072;
constexpr int MISC_OFF = 143360;
constexpr int LDS_BYTES = 147456;

__device__ __forceinline__ unsigned cvt_pk_bf16(float lo, float hi) { unsigned r; asm volatile("v_cvt_pk_bf16_f32 %0, %1, %2" : "=v"(r) : "v"(lo), "v"(hi)); return r; }
__device__ __forceinline__ float bf_lo(unsigned u) { return __builtin_bit_cast(float, u << 16); }
__device__ __forceinline__ float bf_hi(unsigned u) { return __builtin_bit_cast(float, u & 0xffff0000u); }
__device__ __forceinline__ float wave_sum(float v) {
#pragma unroll
    for (int o = 1; o < 64; o <<= 1) v += __shfl_xor(v, o);
    return v;
}
__device__ __forceinline__ float wave_max(float v) {
#pragma unroll
    for (int o = 1; o < 64; o <<= 1) v = fmaxf(v, __shfl_xor(v, o));
    return v;
}
__device__ __forceinline__ int tid_opaque() { int t = (int)threadIdx.x; asm volatile("" : "+v"(t)); return t; }
#define LDS_WAIT() asm volatile("s_waitcnt lgkmcnt(0)" ::: "memory")

namespace pg8 {
#define PG8_LAS __attribute__((address_space(3)))
constexpr int BM = 256, BK = 64, HALF = 128, HTB = HALF * BK * 2, STAGE_BYTES = 8 * HTB, NXCD = 8, WGM = 8;
__host__ __device__ __forceinline__ int lds_byte(int r, int c) { const int st = (r >> 4) * 2 + (c >> 5), rr = r & 15, cc = c & 31, ob = rr * 64 + cc * 2; return st * 1024 + (ob ^ (((ob >> 9) & 1) << 5)); }
__host__ __device__ __forceinline__ void stage_rc(int b, int& R, int& C) { const int st = b / 1024, sb = b % 1024, swz = sb ^ (((sb >> 9) & 1) << 5); R = (st >> 1) * 16 + swz / 64; C = (st & 1) * 32 + (swz % 64) / 2; }
__host__ __device__ __forceinline__ int perm32(int rho) { const int n = rho >> 4, i = rho & 15; return 8 * (i >> 2) + 4 * n + (i & 3); }
struct Unit { int pm, pn; };
struct Gemm { const bf16_t* A; const bf16_t* Bt; int M, N, K; };
struct StaticOrder {
    int nM, nN, nwg, G, c;
    __host__ __device__ void init(int M, int N, int G_, int c_) { nM = M / BM; nN = N / BM; nwg = nM * nN; G = G_; c = c_; }
    __host__ __device__ bool next(int i, Unit& u) const {
        const long L = (long)i * G + c; if (L >= nwg) return false;
        int wgid = (int)L; { const int q = nwg / NXCD, r = nwg % NXCD, xcd = wgid % NXCD, off = wgid / NXCD; wgid = (xcd < r ? xcd * (q + 1) : r * (q + 1) + (xcd - r) * q) + off; }
        const int nig = WGM * nN, gid = wgid / nig, fm = gid * WGM, gsz = (nM - fm) < WGM ? (nM - fm) : WGM;
        u.pm = fm + ((wgid % nig) % gsz); u.pn = (wgid % nig) / gsz; return true;
    }
    __device__ __forceinline__ void a_ready(const Unit&) const {}
    __device__ __forceinline__ void done(const Unit&) const {}
};

template <class Epi, class Sched, bool ALIGN_EPI = false, bool SP2 = false>
__device__ __forceinline__ void gemm_phase(PG8_LAS unsigned char* lds, const Gemm g, const Sched& S, const Epi& E) {
    const int tid = tid_opaque(), wid = __builtin_amdgcn_readfirstlane(tid >> 6), lane = tid & 63, wr = wid >> 2, wc = wid & 3, fr = lane & 15, fq = lane >> 4;
    const int K = g.K, nt = K / BK;
    unsigned voffA[2], voffB[2];
#pragma unroll
    for (int i = 0; i < 2; ++i) { int R, C; stage_rc(tid * 16 + i * 8192, R, C); const int Rb = Epi::PERM ? ((R & ~31) + perm32(R & 31)) : R;
        voffA[i] = (unsigned)(R * K + C) * 2u; voffB[i] = (unsigned)(Rb * K + C) * 2u; }
    const size_t kstep = (size_t)(BK * 2);
    const size_t hstep = (size_t)HALF * K * 2;
    const size_t tstep = 2 * hstep;
    const unsigned ldsw = (unsigned)wid * 1024u;
    const int aoff = lds_byte(wr * 64 + fr, fq * 8), boff = lds_byte(wc * 32 + fr, fq * 8);
#define PG8_SA(b, h) (((b) * 2 + (h)) * HTB)
#define PG8_SB(b, h) ((4 + (b) * 2 + (h)) * HTB)
#define PG8_STAGE(bufoff, gbase, voff) do { _Pragma("unroll") for (int _i = 0; _i < 2; ++_i) \
        __builtin_amdgcn_global_load_lds((const unsigned*)((const char*)(gbase) + (voff)[_i]), (PG8_LAS unsigned*)(lds + (bufoff) + ldsw + _i * 8192), 16, 0, 0); } while (0)
#define PG8_LDA(dst, b, h) do { _Pragma("unroll") for (int m = 0; m < 4; ++m) _Pragma("unroll") for (int k = 0; k < 2; ++k) dst[m][k] = *(const PG8_LAS bf16x8*)(lds + PG8_SA(b, h) + aoff + m * 2048 + k * 1024); } while (0)
#define PG8_LDB(dst, b, h) do { _Pragma("unroll") for (int n = 0; n < 2; ++n) _Pragma("unroll") for (int k = 0; k < 2; ++k) dst[n][k] = *(const PG8_LAS bf16x8*)(lds + PG8_SB(b, h) + boff + n * 2048 + k * 1024); } while (0)
#define PG8_MMA(ai, bj, At, Bt) do { __builtin_amdgcn_s_setprio(1); _Pragma("unroll") for (int m = 0; m < 4; ++m) _Pragma("unroll") for (int n = 0; n < 2; ++n) _Pragma("unroll") for (int k = 0; k < 2; ++k) \
        acc[ai][bj][m][n] = __builtin_amdgcn_mfma_f32_16x16x32_bf16(Bt[n][k], At[m][k], acc[ai][bj][m][n], 0, 0, 0); __builtin_amdgcn_s_setprio(0); } while (0)
#define PG8_WAIT_V(n) asm volatile("s_waitcnt vmcnt(" #n ")" ::: "memory")
#define PG8_WAIT_L(n) asm volatile("s_waitcnt lgkmcnt(" #n ")" ::: "memory")
#define PG8_BAR __builtin_amdgcn_s_barrier()
#define PG8_SCHED __builtin_amdgcn_sched_barrier(0)
    Unit cur, nxt; int ui = 0;
    if (!S.next(0, cur)) return;
    f32x4 acc[2][2][4][2];
#pragma unroll
    for (int a = 0; a < 2; ++a)
#pragma unroll
        for (int b = 0; b < 2; ++b)
#pragma unroll
            for (int m = 0; m < 4; ++m)
#pragma unroll
                for (int n = 0; n < 2; ++n) acc[a][b][m][n] = (f32x4){0.f, 0.f, 0.f, 0.f};
    bf16x8 At[4][2], B0[2][2], B1[2][2];
    const char* cA = (const char*)g.A + (size_t)cur.pm * tstep; const char* cB = (const char*)g.Bt + (size_t)cur.pn * tstep;
    S.a_ready(cur);
    if constexpr (SP2) {
        PG8_STAGE(PG8_SB(0, 0), cB, voffB); PG8_STAGE(PG8_SB(0, 1), cB + hstep, voffB); PG8_STAGE(PG8_SA(0, 0), cA, voffA); PG8_STAGE(PG8_SA(0, 1), cA + hstep, voffA);
        if (wr == 1) PG8_BAR;
        PG8_WAIT_V(2); PG8_BAR;
        PG8_STAGE(PG8_SB(1, 0), cB + kstep, voffB); PG8_STAGE(PG8_SA(1, 0), cA + kstep, voffA); PG8_STAGE(PG8_SB(1, 1), cB + hstep + kstep, voffB);
        PG8_WAIT_V(6); PG8_BAR;
    } else {
        PG8_STAGE(PG8_SB(0, 0), cB, voffB); PG8_STAGE(PG8_SA(0, 0), cA, voffA); PG8_STAGE(PG8_SB(0, 1), cB + hstep, voffB); PG8_STAGE(PG8_SA(0, 1), cA + hstep, voffA);
        if (wr == 1) PG8_BAR;
        PG8_WAIT_V(4); PG8_BAR;
        PG8_STAGE(PG8_SB(1, 0), cB + kstep, voffB); PG8_STAGE(PG8_SA(1, 0), cA + kstep, voffA); PG8_STAGE(PG8_SB(1, 1), cB + hstep + kstep, voffB);
        PG8_WAIT_V(6); PG8_BAR;
    }
    for (;;) {
        const bool has_next = S.next(ui + 1, nxt);
        const char* nA = has_next ? (const char*)g.A + (size_t)nxt.pm * tstep : cA; const char* nB = has_next ? (const char*)g.Bt + (size_t)nxt.pn * tstep : cB;
        for (int t = 0; t < nt; t += 2) {
            const bool last = (t == nt - 2);
            const char* a1 = cA + (size_t)(t + 1) * kstep;
            const char* a2 = last ? nA : cA + (size_t)(t + 2) * kstep; const char* b2 = last ? nB : cB + (size_t)(t + 2) * kstep;
            const char* a3 = a2 + kstep; const char* b3 = b2 + kstep;
            if (last && has_next) S.a_ready(nxt);
            if constexpr (SP2) {
            PG8_LDB(B0, 0, 0); PG8_LDB(B1, 0, 1); PG8_SCHED; PG8_LDA(At, 0, 0); PG8_STAGE(PG8_SA(1, 1), a1 + hstep, voffA);
            PG8_WAIT_V(8); PG8_WAIT_L(0); PG8_BAR; PG8_MMA(0, 0, At, B0); PG8_MMA(0, 1, At, B1); PG8_BAR; PG8_SCHED;
            PG8_LDA(At, 0, 1); PG8_STAGE(PG8_SB(0, 0), b2, voffB); PG8_STAGE(PG8_SB(0, 1), b2 + hstep, voffB); PG8_STAGE(PG8_SA(0, 0), a2, voffA);
            PG8_WAIT_V(8); PG8_WAIT_L(0); PG8_BAR; PG8_MMA(1, 0, At, B0); PG8_MMA(1, 1, At, B1); PG8_BAR; PG8_SCHED;
            PG8_LDB(B0, 1, 0); PG8_LDB(B1, 1, 1); PG8_SCHED; PG8_LDA(At, 1, 0); PG8_STAGE(PG8_SA(0, 1), a2 + hstep, voffA);
            PG8_WAIT_V(8); PG8_WAIT_L(0); PG8_BAR; PG8_MMA(0, 0, At, B0); PG8_MMA(0, 1, At, B1); PG8_BAR; PG8_SCHED;
            PG8_LDA(At, 1, 1); PG8_STAGE(PG8_SB(1, 0), b3, voffB); PG8_STAGE(PG8_SB(1, 1), b3 + hstep, voffB); PG8_STAGE(PG8_SA(1, 0), a3, voffA);
            PG8_WAIT_V(8); PG8_WAIT_L(0); PG8_BAR; PG8_MMA(1, 0, At, B0); PG8_MMA(1, 1, At, B1); PG8_BAR; PG8_SCHED;
            } else {
            PG8_LDB(B0, 0, 0); PG8_SCHED; PG8_LDA(At, 0, 0); PG8_STAGE(PG8_SA(1, 1), a1 + hstep, voffA);
            PG8_WAIT_L(8); PG8_BAR; PG8_WAIT_L(0); PG8_MMA(0, 0, At, B0); PG8_BAR; PG8_SCHED;
            PG8_LDB(B1, 0, 1); PG8_STAGE(PG8_SB(0, 0), b2, voffB);
            PG8_BAR; PG8_WAIT_L(0); PG8_MMA(0, 1, At, B1); PG8_BAR;
            PG8_LDA(At, 0, 1); PG8_STAGE(PG8_SA(0, 0), a2, voffA);
            PG8_BAR; PG8_WAIT_L(0); PG8_MMA(1, 0, At, B0); PG8_BAR; PG8_SCHED;
            PG8_STAGE(PG8_SB(0, 1), b2 + hstep, voffB);
            PG8_WAIT_V(6); PG8_BAR; PG8_MMA(1, 1, At, B1); PG8_BAR;
            PG8_LDB(B0, 1, 0); PG8_SCHED; PG8_LDA(At, 1, 0); PG8_STAGE(PG8_SA(0, 1), a2 + hstep, voffA);
            PG8_WAIT_L(8); PG8_BAR; PG8_WAIT_L(0); PG8_MMA(0, 0, At, B0); PG8_BAR; PG8_SCHED;
            PG8_LDB(B1, 1, 1); PG8_STAGE(PG8_SB(1, 0), b3, voffB);
            PG8_BAR; PG8_WAIT_L(0); PG8_MMA(0, 1, At, B1); PG8_BAR;
            PG8_LDA(At, 1, 1); PG8_STAGE(PG8_SA(1, 0), a3, voffA);
            PG8_BAR; PG8_WAIT_L(0); PG8_MMA(1, 0, At, B0); PG8_BAR; PG8_SCHED;
            PG8_STAGE(PG8_SB(1, 1), b3 + hstep, voffB);
            PG8_WAIT_V(6); PG8_BAR; PG8_MMA(1, 1, At, B1); PG8_BAR;
            }
        }
        if constexpr (ALIGN_EPI) { if (wr == 0) PG8_BAR; }
        E(acc, cur, wr, wc, fr, fq); S.done(cur);
        if (!has_next) break;
#pragma unroll
        for (int a = 0; a < 2; ++a)
#pragma unroll
            for (int b = 0; b < 2; ++b)
#pragma unroll
                for (int m = 0; m < 4; ++m)
#pragma unroll
                    for (int n = 0; n < 2; ++n) acc[a][b][m][n] = (f32x4){0.f, 0.f, 0.f, 0.f};
        cur = nxt; cA = nA; cB = nB; ++ui;
        if constexpr (ALIGN_EPI) { if (wr == 1) PG8_BAR; }
    }
    PG8_WAIT_V(0);
    if constexpr (!ALIGN_EPI) { if (wr == 0) PG8_BAR; }
    PG8_BAR;
#undef PG8_SA
#undef PG8_SB
#undef PG8_STAGE
#undef PG8_LDA
#undef PG8_LDB
#undef PG8_MMA
#undef PG8_WAIT_V
#undef PG8_WAIT_L
#undef PG8_BAR
#undef PG8_SCHED
}

__device__ __forceinline__ float sigmoidf_fast(float x) { return __builtin_amdgcn_rcpf(1.f + __builtin_amdgcn_exp2f(-x * LOG2E)); }
struct EpiInProj {
    static constexpr bool PERM = true;
    bf16_t* base;
    __device__ __forceinline__ void operator()(const f32x4 (&acc)[2][2][4][2], const Unit& u, int wr, int wc, int fr, int fq) const {
        const int sec = u.pn >> 2;
        bf16_t* sb = base + (size_t)sec * SEC_ELEMS;
        const float sc = (sec == 4) ? SCALE * LOG2E : 1.f;
#pragma unroll
        for (int ai = 0; ai < 2; ++ai)
#pragma unroll
            for (int m = 0; m < 4; ++m) {
                const int tk = u.pm * BM + ai * HALF + wr * 64 + m * 16 + fr, b = tk >> 12, s = tk & 4095;
#pragma unroll
                for (int bj = 0; bj < 2; ++bj) {
                    const int hh = (u.pn & 3) * 2 + bj;
                    f32x4 v0 = acc[ai][bj][m][0], v1 = acc[ai][bj][m][1];
                    bf16_t* dst;
                    if (sec == 3) {
#pragma unroll
                        for (int i = 0; i < 4; ++i) { v0[i] = sigmoidf_fast(v0[i]); v1[i] = sigmoidf_fast(v1[i]); }
                        dst = sb + (size_t)tk * 1024 + hh * 128 + wc * 32 + 8 * fq;
                    } else {
                        v0 = v0 * sc; v1 = v1 * sc;
                        dst = sb + ((size_t)((b * 8 + hh) * 4096 + s)) * 128 + wc * 32 + 8 * fq;
                    }
                    u32x4 w; w.x = cvt_pk_bf16(v0[0], v0[1]); w.y = cvt_pk_bf16(v0[2], v0[3]); w.z = cvt_pk_bf16(v1[0], v1[1]); w.w = cvt_pk_bf16(v1[2], v1[3]);
                    *(u32x4*)dst = w;
                }
            }
    }
};
struct EpiOutProj {
    static constexpr bool PERM = true;
    const float* x; float* h; bf16_t* hb; float* ssq;
    __device__ __forceinline__ void operator()(const f32x4 (&acc)[2][2][4][2], const Unit& u, int wr, int wc, int fr, int fq) const {
#pragma unroll
        for (int ai = 0; ai < 2; ++ai)
#pragma unroll
            for (int m = 0; m < 4; ++m) {
                const int tk = u.pm * BM + ai * HALF + wr * 64 + m * 16 + fr;
                float ss = 0.f;
#pragma unroll
                for (int bj = 0; bj < 2; ++bj) {
                    const size_t off = (size_t)tk * DM + u.pn * BM + bj * HALF + wc * 32 + 8 * fq;
                    const f32x4 x0 = *(const f32x4*)(x + off), x1 = *(const f32x4*)(x + off + 4);
                    const f32x4 v0 = acc[ai][bj][m][0] + x0, v1 = acc[ai][bj][m][1] + x1;
                    *(f32x4*)(h + off) = v0; *(f32x4*)(h + off + 4) = v1;
                    u32x4 w; w.x = cvt_pk_bf16(v0[0], v0[1]); w.y = cvt_pk_bf16(v0[2], v0[3]); w.z = cvt_pk_bf16(v1[0], v1[1]); w.w = cvt_pk_bf16(v1[2], v1[3]);
                    *(u32x4*)(hb + off) = w;
                    ss += v0[0] * v0[0] + v0[1] * v0[1] + v0[2] * v0[2] + v0[3] * v0[3] + v1[0] * v1[0] + v1[1] * v1[1] + v1[2] * v1[2] + v1[3] * v1[3];
                }
                ss += __shfl_xor(ss, 16); ss += __shfl_xor(ss, 32);
                if (fq == 0) ssq[(size_t)tk * 32 + u.pn * 4 + wc] = ss;
            }
    }
};
struct EpiPeerQ {
    static constexpr bool PERM = true;
    const float* ssq; bf16_t* qp; float* rtab;
    __device__ __forceinline__ void operator()(const f32x4 (&acc)[2][2][4][2], const Unit& u, int wr, int wc, int fr, int fq) const {
#pragma unroll
        for (int ai = 0; ai < 2; ++ai)
#pragma unroll
            for (int m = 0; m < 4; ++m) {
                const int tk = u.pm * BM + ai * HALF + wr * 64 + m * 16 + fr;
                float tot = 0.f;
#pragma unroll
                for (int i = 0; i < 8; ++i) { const f32x4 s4 = *(const f32x4*)(ssq + (size_t)tk * 32 + 4 * i); tot += (s4[0] + s4[1]) + (s4[2] + s4[3]); }
                const float r = 1.0f / sqrtf(tot * (1.f / DM) + EPS);
                if (u.pn == 0 && wc == 0 && fq == 0) rtab[tk] = r;
#pragma unroll
                for (int bj = 0; bj < 2; ++bj) {
                    const size_t off = (size_t)tk * DM + u.pn * BM + bj * HALF + wc * 32 + 8 * fq;
                    const f32x4 v0 = acc[ai][bj][m][0] * r, v1 = acc[ai][bj][m][1] * r;
                    u32x4 w; w.x = cvt_pk_bf16(v0[0], v0[1]); w.y = cvt_pk_bf16(v0[2], v0[3]); w.z = cvt_pk_bf16(v1[0], v1[1]); w.w = cvt_pk_bf16(v1[2], v1[3]);
                    *(u32x4*)(qp + off) = w;
                }
            }
    }
};
}

namespace att {
constexpr int NW = 8, QBLK = 32, KVBLK = 64, QB = NW * QBLK, D = 128;
constexpr int SHM_V = KVBLK * D * 2, SHM_K = KVBLK * D * 2;
constexpr int OFF_WS = 2 * SHM_V + 2 * SHM_K, OFF_BIAS = OFF_WS + NW * 64 * 4, ATT_LDS = OFF_BIAS + SEQ * 4;
#define KSWZ(row, colB) ((row) * 256 + ((colB) ^ (((row) & 7) << 4)))
#define SBAR() __builtin_amdgcn_sched_barrier(0)
__device__ __forceinline__ int v_st(int k, int c) { const int kk = (k & ~0xC) | ((k & 4) << 1) | ((k & 8) >> 1); return ((kk >> 3) * 4 + (c >> 5)) * 512 + ((kk & 7) * 32 + (c & 31)) * 2; }
__device__ __forceinline__ int v_rd_base(int lane) { return ((lane & 3) << 3) | (((lane >> 2) & 3) << 6) | (((lane >> 4) & 1) << 5) | (((lane >> 5) & 1) << 8); }
constexpr int v_rd_off(int d0, int ks, int half) { return d0 * 512 + ks * 4096 + half * 2048; }
__device__ __forceinline__ int crow(int r, int hi) { return (r & 3) + 8 * (r >> 2) + 4 * hi; }
__device__ __forceinline__ bf16x8 load8(const bf16_t* p) { return *reinterpret_cast<const bf16x8*>(p); }
__device__ __forceinline__ void mask_tile(f32x16& p0, f32x16& p1, int dq) {
    const float NEG = -__builtin_inff();
#pragma unroll
    for (int r = 0; r < 16; ++r) {
        const int c = (r & 3) + 8 * (r >> 2);
        if (dq - c < 0) p0[r] = NEG;
        if (dq - c - 32 < 0) p1[r] = NEG;
    }
}
__device__ __forceinline__ void partialSM(f32x16& p0, f32x16& p1, float& m_reg, float& mn, float& alpha) {
    float pmax = p0[0];
#pragma unroll
    for (int r = 1; r < 16; ++r) pmax = fmaxf(pmax, p0[r]);
#pragma unroll
    for (int r = 0; r < 16; ++r) pmax = fmaxf(pmax, p1[r]);
    { auto rr = __builtin_amdgcn_permlane32_swap(__float_as_uint(pmax), __float_as_uint(pmax), false, false);
      pmax = fmaxf(__uint_as_float(rr[0]), __uint_as_float(rr[1])); }
    constexpr float C2 = LOG2E * SCALE; constexpr float THR = 8.f;
    if (__builtin_expect(__all((pmax - m_reg) * SCALE <= THR), 1)) { mn = m_reg; alpha = 1.f; }
    else { mn = fmaxf(m_reg, pmax); alpha = __builtin_amdgcn_exp2f((m_reg - mn) * C2); m_reg = mn; }
    const float mnL = -mn * C2;
#pragma unroll
    for (int r = 0; r < 16; ++r) p0[r] = fmaf(p0[r], C2, mnL);
#pragma unroll
    for (int r = 0; r < 16; ++r) p1[r] = fmaf(p1[r], C2, mnL);
#pragma unroll
    for (int r = 0; r < 16; ++r) p0[r] = __builtin_amdgcn_exp2f(p0[r]);
}
#define PK4(P, B_, OUT) do { unsigned a0 = cvt_pk_bf16(P[B_+0], P[B_+1]), a1 = cvt_pk_bf16(P[B_+2], P[B_+3]);                          \
        unsigned b0 = cvt_pk_bf16(P[B_+4], P[B_+5]), b1 = cvt_pk_bf16(P[B_+6], P[B_+7]);                                             \
        auto r0 = __builtin_amdgcn_permlane32_swap(a0, b0, false, false); auto r1 = __builtin_amdgcn_permlane32_swap(a1, b1, false, false); \
        u32x4 w = {r0[0], r1[0], r0[1], r1[1]}; OUT = *reinterpret_cast<bf16x8*>(&w); } while (0)
__device__ __forceinline__ void finishSM(f32x16& p0, f32x16& p1, float alpha, float& l_reg, bf16x8& pa0, bf16x8& pa1, bf16x8& pa2, bf16x8& pa3) {
#pragma unroll
    for (int r = 0; r < 16; ++r) p1[r] = __builtin_amdgcn_exp2f(p1[r]);
    float ps = 0;
#pragma unroll
    for (int r = 0; r < 16; ++r) ps += p0[r];
#pragma unroll
    for (int r = 0; r < 16; ++r) ps += p1[r];
    { auto rr = __builtin_amdgcn_permlane32_swap(__float_as_uint(ps), __float_as_uint(ps), false, false);
      ps = __uint_as_float(rr[0]) + __uint_as_float(rr[1]); }
    l_reg = l_reg * alpha + ps;
    PK4(p0, 0, pa0); PK4(p0, 8, pa1); PK4(p1, 0, pa2); PK4(p1, 8, pa3);
}
__device__ __forceinline__ void sb_group(f32x16& P, int g, float& gs) {
    float run = 0.f;
#pragma unroll
    for (int k = 3; k >= 0; --k) {
        const float z = P[4 * g + k];
        const float t = __builtin_amdgcn_exp2f(-fabsf(z));
        const float l = __builtin_amdgcn_logf(1.f + t);
        const float sp = fmaxf(z, 0.f) + l;
        P[4 * g + k] = (z - sp) - run;
        run += sp;
    }
    gs = run;
}
__device__ __forceinline__ void sb_part1(f32x16& p0, f32x16& p1, float& carry, float mlo) {
    float gs[8];
#pragma unroll
    for (int g = 0; g < 4; ++g) sb_group(p0, g, gs[g]);
#pragma unroll
    for (int g = 0; g < 4; ++g) sb_group(p1, g, gs[4 + g]);
    float run = carry;
#pragma unroll
    for (int G = 7; G >= 0; --G) {
        auto rr = __builtin_amdgcn_permlane32_swap(__float_as_uint(gs[G]), __float_as_uint(gs[G]), false, false);
        const float slo = __uint_as_float(rr[0]), shi = __uint_as_float(rr[1]);
        const float base = fmaf(mlo, shi, run);
        if (G >= 4) {
#pragma unroll
            for (int k = 0; k < 4; ++k) p1[4 * (G - 4) + k] -= base;
        } else {
#pragma unroll
            for (int k = 0; k < 4; ++k) p0[4 * G + k] -= base;
        }
        run += slo + shi;
    }
    carry = run;
#pragma unroll
    for (int r = 0; r < 16; ++r) p0[r] = __builtin_amdgcn_exp2f(p0[r]);
}
__device__ __forceinline__ void sb_part2(f32x16& p0, f32x16& p1, bf16x8& pa0, bf16x8& pa1, bf16x8& pa2, bf16x8& pa3) {
#pragma unroll
    for (int r = 0; r < 16; ++r) p1[r] = __builtin_amdgcn_exp2f(p1[r]);
    PK4(p0, 0, pa0); PK4(p0, 8, pa1); PK4(p1, 0, pa2); PK4(p1, 8, pa3);
}
#undef PK4
template <int KB, bool BIAS>
__device__ __forceinline__ void qkt(f32x16& p0, f32x16& p1, const char* K_lds, int r32, int hi, const bf16x8* qr, const float* bt) {
    if constexpr (BIAS) {
#pragma unroll
        for (int g = 0; g < 4; ++g) { const f32x4 a = *(const f32x4*)(bt + 8 * g), b = *(const f32x4*)(bt + 32 + 8 * g);
            p0[4 * g] = a[0]; p0[4 * g + 1] = a[1]; p0[4 * g + 2] = a[2]; p0[4 * g + 3] = a[3];
            p1[4 * g] = b[0]; p1[4 * g + 1] = b[1]; p1[4 * g + 2] = b[2]; p1[4 * g + 3] = b[3]; }
    } else { p0 = f32x16{}; p1 = f32x16{}; }
    const char* kb[4];
#pragma unroll
    for (int dd = 0; dd < 4; ++dd) kb[dd] = K_lds + KB * SHM_K + KSWZ(r32, (dd * 16 + hi * 8) * 2);
#pragma unroll
    for (int d0 = 0; d0 < 8; ++d0) { const char* a = kb[d0 & 3] + (d0 >> 2) * 128;
        bf16x8 b0 = *reinterpret_cast<const bf16x8*>(a);
        bf16x8 b1 = *reinterpret_cast<const bf16x8*>(a + 32 * 256);
        p0 = __builtin_amdgcn_mfma_f32_32x32x16_bf16(b0, qr[d0], p0, 0, 0, 0);
        p1 = __builtin_amdgcn_mfma_f32_32x32x16_bf16(b1, qr[d0], p1, 0, 0, 0); }
}
template <int VB>
__device__ __forceinline__ void pv_tile(f32x16* o, int vb0, bf16x8 pa0, bf16x8 pa1, bf16x8 pa2, bf16x8 pa3) {
#define TRRD(dst, off) asm volatile("ds_read_b64_tr_b16 %0, %1 offset:%2" : "=&v"(dst) : "v"(vb0), "i"(off) : "memory")
#define PV_D0(d0) do { { s16x4 l0, l1, h0, h1; constexpr int b_ = VB * SHM_V + v_rd_off(d0, 0, 0); \
        TRRD(l0, b_); TRRD(h0, b_ + 2048); TRRD(l1, b_ + 4096); TRRD(h1, b_ + 6144); \
        asm volatile("s_waitcnt lgkmcnt(0)" ::: "memory"); SBAR();   \
        o[d0] = __builtin_amdgcn_mfma_f32_32x32x16_bf16(pa0, (bf16x8){l0[0], l0[1], l0[2], l0[3], h0[0], h0[1], h0[2], h0[3]}, o[d0], 0, 0, 0);   \
        o[d0] = __builtin_amdgcn_mfma_f32_32x32x16_bf16(pa1, (bf16x8){l1[0], l1[1], l1[2], l1[3], h1[0], h1[1], h1[2], h1[3]}, o[d0], 0, 0, 0); }  \
      { s16x4 l2, l3, h2, h3; constexpr int b_ = VB * SHM_V + v_rd_off(d0, 0, 0); \
        TRRD(l2, b_ + 8192); TRRD(h2, b_ + 10240); TRRD(l3, b_ + 12288); TRRD(h3, b_ + 14336); \
        asm volatile("s_waitcnt lgkmcnt(0)" ::: "memory"); SBAR();   \
        o[d0] = __builtin_amdgcn_mfma_f32_32x32x16_bf16(pa2, (bf16x8){l2[0], l2[1], l2[2], l2[3], h2[0], h2[1], h2[2], h2[3]}, o[d0], 0, 0, 0);   \
        o[d0] = __builtin_amdgcn_mfma_f32_32x32x16_bf16(pa3, (bf16x8){l3[0], l3[1], l3[2], l3[3], h3[0], h3[1], h3[2], h3[3]}, o[d0], 0, 0, 0); } } while (0)
    PV_D0(0); PV_D0(1); PV_D0(2); PV_D0(3);
#undef PV_D0
#undef TRRD
}

struct UnitRef { const bf16_t* Q; const bf16_t* K; const bf16_t* V; int P0; };
struct Seam { bf16x8 qr[8]; bf16x8 st_v0, st_v1, st_k0, st_k1; };
#define ROW(p, k0, rr) ((p) + (size_t)((k0) + (rr)) * D + sc)
#define VMW() asm volatile("s_waitcnt vmcnt(0)" ::: "memory")
#define SLOAD_H(Kp, Vp, k0) do { S.st_v0 = load8(ROW(Vp, k0, sr)); S.st_v1 = load8(ROW(Vp, k0, 32 + sr));              \
                         S.st_k0 = load8(ROW(Kp, k0, sr)); S.st_k1 = load8(ROW(Kp, k0, 32 + sr)); } while (0)
#define SWRITE_HK(bf) do { *(bf16x8*)(K_lds + (bf) * SHM_K + kws) = S.st_k0; *(bf16x8*)(K_lds + (bf) * SHM_K + kws + 32 * 256) = S.st_k1; } while (0)
#define SWRITE_HV(bf) do { *(bf16x8*)(V_lds + (bf) * SHM_V + vst0) = S.st_v0; *(bf16x8*)(V_lds + (bf) * SHM_V + vst1) = S.st_v1; } while (0)
#define SWRITE_H(bf) do { SWRITE_HV(bf); SWRITE_HK(bf); } while (0)

template <bool SB>
__device__ __forceinline__ void attn_unit(const UnitRef& cur, const float* cvec  , const bf16_t* gate  ,
                                          bf16_t* outp  , char* lds) {
    const int tid = tid_opaque(), wid = __builtin_amdgcn_readfirstlane(tid >> 6), lane = tid & 63, r32 = lane & 31, hi = lane >> 5;
    const int NT = (cur.P0 + QB) / KVBLK;
#define KBASE(t) ((SB ? (NT - 1 - (t)) : (t)) * KVBLK)
    const int qlo = cur.P0 + wid * QBLK, qm = qlo + r32 - 4 * hi - (SB ? 1 : 0);
    char* V_lds = lds; char* K_lds = lds + 2 * SHM_V;
    float* ws = (float*)(lds + OFF_WS) + wid * 64; float* li_l = ws, * al_l = ws + 32;
    float* bias = (float*)(lds + OFF_BIAS);
    const int sr = tid >> 4, sc = (tid & 15) * 8, vst0 = v_st(sr, sc), vst1 = v_st(32 + sr, sc), kws = KSWZ(sr, sc * 2);
    const int vb0 = (int)(uintptr_t)V_lds + v_rd_base(lane);
    const bf16_t* Kh = cur.K; const bf16_t* Vh = cur.V;
    Seam S;
    if constexpr (!SB) { const float cq0 = cvec[cur.P0]; for (int j = tid; j < cur.P0 + QB; j += NTHREADS) bias[j] = (cq0 - cvec[j]) * (1.f / SCALE); }
#pragma unroll
    for (int d0 = 0; d0 < 8; ++d0) S.qr[d0] = load8(cur.Q + (size_t)(wid * QBLK + r32) * D + d0 * 16 + hi * 8);
    SLOAD_H(Kh, Vh, KBASE(0)); VMW(); SWRITE_HK(0);
    __syncthreads();
    float m_reg = -1e30f, l_reg = 0; f32x16 o[4] = {};
    float carry = 0.f; const float mlo = hi ? 0.f : 1.f;
#define RESC(a) do { if (__any((a) < 1.f)) { if (hi == 0) al_l[r32] = (a); asm volatile("s_waitcnt lgkmcnt(0)" ::: "memory");              \
                     for (int d_ = 0; d_ < 4; ++d_) for (int r = 0; r < 16; ++r) o[d_][r] *= al_l[crow(r, hi)]; } } while (0)
#define MASKT(P0_, P1_, t) do { const int kb_ = KBASE(t); if (kb_ + KVBLK - 1 > qlo - (SB ? 1 : 0)) mask_tile(P0_, P1_, qm - kb_); } while (0)
#define BT(t) (bias + KBASE(t) + 4 * hi)
#define PART1(PX0, PX1, mnX, alX) do { if constexpr (SB) sb_part1(PX0, PX1, carry, mlo); else partialSM(PX0, PX1, m_reg, mnX, alX); } while (0)
#define PART2(PY0, PY1, alY) do { if constexpr (SB) sb_part2(PY0, PY1, pa0, pa1, pa2, pa3); else finishSM(PY0, PY1, alY, l_reg, pa0, pa1, pa2, pa3); } while (0)
    f32x16 pA0, pA1, pB0, pB1; float mnA = 0.f, mnB = 0.f, alA = 1.f, alB = 1.f; bf16x8 pa0, pa1, pa2, pa3;
    SWRITE_HV(0); SBAR();
    if (NT > 1) SLOAD_H(Kh, Vh, KBASE(1));
    SBAR(); qkt<0, !SB>(pA0, pA1, K_lds, r32, hi, S.qr, BT(0));
    MASKT(pA0, pA1, 0); PART1(pA0, pA1, mnA, alA);
    if (NT > 1) { VMW(); SWRITE_H(1); }
    __syncthreads();
#define HALF_STEP(PX0, PX1, mnX, alX, PY0, PY1, alY, t, KB, VB, SBUF) do {                                                    \
        SBAR(); qkt<KB, !SB>(PX0, PX1, K_lds, r32, hi, S.qr, BT(t));                                                          \
        PART2(PY0, PY1, alY); SBAR();                                                                                          \
        if ((t) + 1 < NT) { SLOAD_H(Kh, Vh, KBASE((t) + 1)); SBAR(); }                                                         \
        pv_tile<VB>(o, vb0, pa0, pa1, pa2, pa3); MASKT(PX0, PX1, (t)); PART1(PX0, PX1, mnX, alX);                              \
        __syncthreads();                                                                                                      \
        if ((t) + 1 < NT) { VMW(); SWRITE_H(SBUF); }                                                                           \
        if constexpr (!SB) RESC(alX);                                                                                          \
        __syncthreads(); } while (0)
    for (int t = 1; t + 1 < NT; t += 2) {
        HALF_STEP(pB0, pB1, mnB, alB, pA0, pA1, alA, t, 1, 0, 0);
        HALF_STEP(pA0, pA1, mnA, alA, pB0, pB1, alB, t + 1, 0, 1, 1);
    }
    const bool even = (NT & 1) == 0;
    if (even) { SBAR(); qkt<1, !SB>(pB0, pB1, K_lds, r32, hi, S.qr, BT(NT - 1)); SBAR(); }
    PART2(pA0, pA1, alA); SBAR();
    pv_tile<0>(o, vb0, pa0, pa1, pa2, pa3);
    if (even) { MASKT(pB0, pB1, NT - 1); PART1(pB0, pB1, mnB, alB); __syncthreads(); if constexpr (!SB) RESC(alB);
        PART2(pB0, pB1, alB); SBAR(); pv_tile<1>(o, vb0, pa0, pa1, pa2, pa3); }
    float rli[16];
    if constexpr (!SB) {
        if (hi == 0) li_l[r32] = l_reg; asm volatile("s_waitcnt lgkmcnt(0)" ::: "memory");
#pragma unroll
        for (int r = 0; r < 16; ++r) rli[r] = __builtin_amdgcn_rcpf(li_l[crow(r, hi)]);
    }
#pragma unroll
    for (int r = 0; r < 16; ++r) { const int orow = cur.P0 + wid * QBLK + crow(r, hi);
#pragma unroll
        for (int d0 = 0; d0 < 4; ++d0) {
            float v = o[d0][r];
            if constexpr (!SB) { const unsigned short gb = gate[(size_t)orow * 1024 + d0 * 32 + r32]; v = v * rli[r] * __builtin_bit_cast(float, (unsigned)gb << 16); }
            const float vn = __shfl_xor(v, 1);
            if ((r32 & 1) == 0) *(unsigned*)(outp + (size_t)orow * DM + d0 * 32 + r32) = cvt_pk_bf16(v, vn); } }
    __syncthreads();
#undef RESC
#undef KBASE
#undef MASKT
#undef BT
#undef PART1
#undef PART2
#undef HALF_STEP
}

constexpr float SB_TH = 150.f;
__device__ __forceinline__ void sb_unit(const UnitRef& cur, bf16_t* outp, char* lds) {
    const int tid = tid_opaque(), wid = __builtin_amdgcn_readfirstlane(tid >> 6), lane = tid & 63, r32 = lane & 31, hi = lane >> 5;
    const int NT = (cur.P0 + QB) / KVBLK;
#define KBASE(t) ((NT - 1 - (t)) * KVBLK)
    const int qlo = cur.P0 + wid * QBLK, qm = qlo + r32 - 4 * hi - 1;
    char* V_lds = lds; char* K_lds = lds + 2 * SHM_V;
    volatile int* flags = (volatile int*)(lds + OFF_WS);
    const int sr = tid >> 4, sc = (tid & 15) * 8, vst0 = v_st(sr, sc), vst1 = v_st(32 + sr, sc), kws = KSWZ(sr, sc * 2);
    const int vb0 = (int)(uintptr_t)V_lds + v_rd_base(lane);
    const bf16_t* Kh = cur.K; const bf16_t* Vh = cur.V;
    Seam S;
#pragma unroll
    for (int d0 = 0; d0 < 8; ++d0) S.qr[d0] = load8(cur.Q + (size_t)(wid * QBLK + r32) * D + d0 * 16 + hi * 8);
    SLOAD_H(Kh, Vh, KBASE(0)); VMW(); SWRITE_H(0);
    __syncthreads();
    f32x16 o[4] = {}; float carry = 0.f; const float mlo = hi ? 0.f : 1.f;
    bool wdone = false;
#define SB_STEP(tt, BUF) {                                                                                                 \
        const int kb_ = KBASE(tt);                                                                                           \
        if ((tt) + 1 < NT) SLOAD_H(Kh, Vh, KBASE((tt) + 1));                                                                 \
        SBAR();                                                                                                              \
        if (!wdone && kb_ <= qlo + QBLK - 2) {                                                                               \
            f32x16 p0, p1; bf16x8 pa0, pa1, pa2, pa3;                                                                        \
            qkt<BUF, false>(p0, p1, K_lds, r32, hi, S.qr, nullptr);                                                          \
            if (kb_ + KVBLK - 1 > qlo - 1) mask_tile(p0, p1, qm - kb_);                                                      \
            sb_part1(p0, p1, carry, mlo); sb_part2(p0, p1, pa0, pa1, pa2, pa3); SBAR();                                      \
            pv_tile<BUF>(o, vb0, pa0, pa1, pa2, pa3);                                                                        \
            wdone = __all(carry >= SB_TH);                                                                                   \
        }                                                                                                                    \
        if ((tt) + 1 < NT) { VMW(); SWRITE_H((BUF) ^ 1); }                                                                   \
        if (lane == 0) flags[((tt) & 1) * 8 + wid] = wdone ? 1 : 0;                                                          \
        __syncthreads();                                                                                                     \
        { int alld = 1;                                                                                                      \
          _Pragma("unroll") for (int w_ = 0; w_ < 8; ++w_) alld &= flags[((tt) & 1) * 8 + w_];                                \
          if (alld) break; } }
    for (int t = 0; t < NT; t += 2) {
        SB_STEP(t, 0)
        SB_STEP(t + 1, 1)
    }
#undef SB_STEP
#pragma unroll
    for (int r = 0; r < 16; ++r) { const int orow = cur.P0 + wid * QBLK + crow(r, hi);
#pragma unroll
        for (int d0 = 0; d0 < 4; ++d0) {
            const float v = o[d0][r];
            const float vn = __shfl_xor(v, 1);
            if ((r32 & 1) == 0) *(unsigned*)(outp + (size_t)orow * DM + d0 * 32 + r32) = cvt_pk_bf16(v, vn); } }
    __syncthreads();
#undef KBASE
}
#undef ROW
#undef VMW
#undef SLOAD_H
#undef SWRITE_HK
#undef SWRITE_HV
#undef SWRITE_H
}

struct Args { const float* in[12]; float* out; unsigned char* ws; int ph_lo, ph_hi; };

__device__ __forceinline__ void p0_transpose_item(const float* W, int ldw, int K, bf16_t* WT, int nblk, LAS float* scr, int item, int lane, const float* gk) {
    const int kb = item / nblk, nb = item % nblk, k0 = 64 * kb, n0 = 32 * nb;
#pragma unroll 8
    for (int i = 0; i < 32; ++i) { const int kk = 2 * i + (lane >> 5); float w = W[(size_t)(k0 + kk) * ldw + n0 + (lane & 31)]; if (gk) w *= gk[k0 + kk]; scr[kk * 33 + (lane & 31)] = w; }
    LDS_WAIT(); asm volatile("" ::: "memory");
    const int c = lane & 7;
#pragma unroll
    for (int j = 0; j < 4; ++j) { const int n = (lane >> 3) + 8 * j; const LAS float* s = scr + (8 * c) * 33 + n;
        u32x4 o; o.x = cvt_pk_bf16(s[0 * 33], s[1 * 33]); o.y = cvt_pk_bf16(s[2 * 33], s[3 * 33]); o.z = cvt_pk_bf16(s[4 * 33], s[5 * 33]); o.w = cvt_pk_bf16(s[6 * 33], s[7 * 33]);
        *(u32x4*)(WT + (size_t)(n0 + n) * K + k0 + 8 * c) = o; }
    LDS_WAIT(); asm volatile("" ::: "memory");
}

__device__ __forceinline__ float log_sigmoid_f(float x) { return fminf(x, 0.f) - log1pf(expf(-fabsf(x))); }

__device__ __forceinline__ void phase0(const Args& a, unsigned char* lds_g) {
    LAS unsigned char* lds = (LAS unsigned char*)lds_g;
    const int tid = tid_opaque(), lane = tid & 63, wave = __builtin_amdgcn_readfirstlane(tid >> 6);
    const int gw = blockIdx.x * NWAVES + wave, NGW = gridDim.x * NWAVES;
    const int gt = blockIdx.x * NTHREADS + tid, NGT = gridDim.x * NTHREADS;
    unsigned char* ws = a.ws;
    const float* x = a.in[0]; const float* g_attn = a.in[1]; const float* w_in = a.in[2]; const float* b_forget = a.in[3];
    const float* w_out = a.in[6]; const float* g_ffn = a.in[7]; const float* w_pq = a.in[8]; const float* sk = a.in[9]; const float* pu = a.in[10]; const float* pv = a.in[11];
    LAS float* wf = (LAS float*)(lds + 67584);
    for (int k = tid; k < DM; k += NTHREADS) { const f32x4 a0 = *(const f32x4*)(w_in + (size_t)k * DIN + NPROJ), a1 = *(const f32x4*)(w_in + (size_t)k * DIN + NPROJ + 4);
        *(LAS f32x4*)(wf + k * 8) = a0; *(LAS f32x4*)(wf + k * 8 + 4) = a1; }
    __syncthreads();
    for (int row = gw; row < T; row += NGW) {
        const f32x4* xr = (const f32x4*)(x + (size_t)row * DM);
        f32x4 v[8]; float ss = 0.f;
#pragma unroll
        for (int j = 0; j < 8; ++j) { v[j] = xr[lane + 64 * j]; ss += v[j][0] * v[j][0] + v[j][1] * v[j][1] + v[j][2] * v[j][2] + v[j][3] * v[j][3]; }
        const float r = 1.0f / sqrtf(wave_sum(ss) * (1.f / DM) + EPS);
        float f[8] = {0.f, 0.f, 0.f, 0.f, 0.f, 0.f, 0.f, 0.f};
        u32x2* o8 = (u32x2*)(ws + WS_XN + (size_t)row * DM * 2);
#pragma unroll
        for (int j = 0; j < 8; ++j) {
            const int e = 4 * (lane + 64 * j);
            const f32x4 g4 = *(const f32x4*)(g_attn + e);
            f32x4 xn; xn[0] = v[j][0] * r * g4[0]; xn[1] = v[j][1] * r * g4[1]; xn[2] = v[j][2] * r * g4[2]; xn[3] = v[j][3] * r * g4[3];
            u32x2 w; w.x = cvt_pk_bf16(xn[0], xn[1]); w.y = cvt_pk_bf16(xn[2], xn[3]); o8[lane + 64 * j] = w;
#pragma unroll
            for (int q = 0; q < 4; ++q) { const f32x4 w0 = *(LAS f32x4*)(wf + (e + q) * 8), w1 = *(LAS f32x4*)(wf + (e + q) * 8 + 4);
                f[0] += xn[q] * w0[0]; f[1] += xn[q] * w0[1]; f[2] += xn[q] * w0[2]; f[3] += xn[q] * w0[3];
                f[4] += xn[q] * w1[0]; f[5] += xn[q] * w1[1]; f[6] += xn[q] * w1[2]; f[7] += xn[q] * w1[3]; }
        }
#pragma unroll
        for (int hh = 0; hh < 8; ++hh) f[hh] = wave_sum(f[hh]);
        if (lane < 8) { float fl = f[0];
#pragma unroll
            for (int hh = 1; hh < 8; ++hh) fl = (lane == hh) ? f[hh] : fl;
            const int b = row >> 12, s = row & 4095;
            ((float*)(ws + WS_LOGF))[(size_t)(b * 8 + lane) * SEQ + s] = log_sigmoid_f(fl + b_forget[lane]); }
    }
    LAS float* scr = (LAS float*)(lds + wave * 8448);
    constexpr int I_IN = (DM / 64) * (NPROJ / 32), I_O = (DM / 64) * (DM / 32);
    for (int it = gw; it < I_IN + 2 * I_O; it += NGW) {
        int r = it;
        if (r < I_IN) { p0_transpose_item(w_in, DIN, DM, (bf16_t*)(ws + WS_WIN), NPROJ / 32, scr, r, lane, nullptr); continue; } r -= I_IN;
        if (r < I_O) { p0_transpose_item(w_out, DM, DM, (bf16_t*)(ws + WS_WOUT), DM / 32, scr, r, lane, nullptr); continue; } r -= I_O;
        p0_transpose_item(w_pq, DM, DM, (bf16_t*)(ws + WS_WPQ), DM / 32, scr, r, lane, g_ffn);
    }
    for (int i = gt; i < 8 * 2 * 128 * 128 / 8; i += NGT) { const f32x4 a0 = *(const f32x4*)(sk + (size_t)i * 8), a1 = *(const f32x4*)(sk + (size_t)i * 8 + 4);
        u32x4 w; w.x = cvt_pk_bf16(a0[0], a0[1]); w.y = cvt_pk_bf16(a0[2], a0[3]); w.z = cvt_pk_bf16(a1[0], a1[1]); w.w = cvt_pk_bf16(a1[2], a1[3]);
        *(u32x4*)(ws + WS_SK + (size_t)i * 16) = w; }
    float* suv = (float*)(ws + WS_SUV);
    for (int r = gw; r < 2 * NEXP; r += NGW) {
        const bool isv = r >= NEXP; const int e = isv ? r - NEXP : r;
        const f32x4* srcp = (const f32x4*)((isv ? pv : pu) + (size_t)e * DM);
        f32x4 v[8]; float amax = 0.f;
#pragma unroll
        for (int j = 0; j < 8; ++j) { v[j] = srcp[lane + 64 * j];
            if (!isv) { const f32x4 g4 = *(const f32x4*)(g_ffn + 4 * (lane + 64 * j)); v[j] = v[j] * g4; }
            amax = fmaxf(amax, fmaxf(fmaxf(fabsf(v[j][0]), fabsf(v[j][1])), fmaxf(fabsf(v[j][2]), fabsf(v[j][3])))); }
        amax = wave_max(amax);
        const float sc = amax > 0.f ? 440.f / amax : 1.f;
        unsigned* dst = (unsigned*)(ws + (isv ? WS_V8 : WS_U8) + (size_t)e * DM);
#pragma unroll
        for (int j = 0; j < 8; ++j) { int p = __builtin_amdgcn_cvt_pk_fp8_f32(v[j][0] * sc, v[j][1] * sc, 0, false); p = __builtin_amdgcn_cvt_pk_fp8_f32(v[j][2] * sc, v[j][3] * sc, p, true);
            dst[lane + 64 * j] = (unsigned)p; }
        if (lane == 0) suv[r] = 1.f / sc;
    }
}

__device__ __forceinline__ void cumsum_rows(const Args& a) {
    const int tid = tid_opaque(), lane = tid & 63, wave = tid >> 6;
    if (blockIdx.x >= 16 || wave != 0) return;
    const float* src = (const float*)(a.ws + WS_LOGF) + (size_t)blockIdx.x * SEQ + lane * 64;
    float* dst = (float*)(a.ws + WS_C) + (size_t)blockIdx.x * SEQ + lane * 64;
    f32x4 v[16]; float run = 0.f;
#pragma unroll
    for (int i = 0; i < 16; ++i) { v[i] = *(const f32x4*)(src + 4 * i);
#pragma unroll
        for (int q = 0; q < 4; ++q) { run += v[i][q]; v[i][q] = run; } }
    float incl = run;
#pragma unroll
    for (int o = 1; o < 64; o <<= 1) { const float t = __shfl_up(incl, o); if (lane >= o) incl += t; }
    const float off = incl - run;
#pragma unroll
    for (int i = 0; i < 16; ++i) { f32x4 w = v[i]; w[0] += off; w[1] += off; w[2] += off; w[3] += off; *(f32x4*)(dst + 4 * i) = w; }
}

__device__ __forceinline__ void phase_qknorm(const Args& a) {
    const int tid = tid_opaque(), lane = tid & 63, wave = tid >> 6;
    const int gw = blockIdx.x * NWAVES + wave, NGW = gridDim.x * NWAVES;
    const int sub = lane & 15, rw = lane >> 4;
    const float* gq = a.in[4]; const float* gk = a.in[5];
    constexpr int ROWS = NB * NHF * SEQ;
    for (int it = gw; it < 2 * ROWS / 4; it += NGW) {
        const int row = it * 4 + rw; const bool isk = row >= ROWS;
        bf16_t* p = (bf16_t*)(a.ws + WS_SEC) + (size_t)row * HD + sub * 8;
        const float* g = (isk ? gk : gq) + sub * 8;
        const u32x4 w = *(const u32x4*)p;
        float v[8] = {bf_lo(w.x), bf_hi(w.x), bf_lo(w.y), bf_hi(w.y), bf_lo(w.z), bf_hi(w.z), bf_lo(w.w), bf_hi(w.w)};
        float ss = 0.f;
#pragma unroll
        for (int i = 0; i < 8; ++i) ss += v[i] * v[i];
        ss += __shfl_xor(ss, 1); ss += __shfl_xor(ss, 2); ss += __shfl_xor(ss, 4); ss += __shfl_xor(ss, 8);
        const float r = 1.0f / sqrtf(ss * (1.f / HD) + EPS);
        const f32x4 g0 = *(const f32x4*)g, g1 = *(const f32x4*)(g + 4);
        u32x4 o; o.x = cvt_pk_bf16(v[0] * r * g0[0], v[1] * r * g0[1]); o.y = cvt_pk_bf16(v[2] * r * g0[2], v[3] * r * g0[3]);
        o.z = cvt_pk_bf16(v[4] * r * g1[0], v[5] * r * g1[1]); o.w = cvt_pk_bf16(v[6] * r * g1[2], v[7] * r * g1[3]);
        *(u32x4*)p = o;
    }
}

__device__ __forceinline__ void phase_attn(const Args& a, unsigned char* lds_g) {
    const int tid = tid_opaque();
    volatile int* s_item = (volatile int*)(lds_g + MISC_OFF);
    unsigned* ctr = (unsigned*)(a.ws + WS_CTL);
    bf16_t* sec = (bf16_t*)(a.ws + WS_SEC);
    for (;;) {
        __syncthreads();
        if (tid == 0) *s_item = (int)atomicAdd(ctr, 1u);
        __syncthreads();
        const int it = *s_item;
        if (it >= 512) break;
        const int qb = 15 - (it >> 5), kind = (it >> 4) & 1, bh = it & 15;
        const int b = bh >> 3, h = bh & 7;
        const size_t hoff = (size_t)bh * SEQ * HD;
        att::UnitRef u;
        u.P0 = qb * 256;
        if (kind == 0) {
            u.Q = sec + 4 * SEC_ELEMS + hoff + (size_t)u.P0 * HD; u.K = sec + 5 * SEC_ELEMS + hoff; u.V = sec + 6 * SEC_ELEMS + hoff;
            att::sb_unit(u, (bf16_t*)(a.ws + WS_MIX) + (size_t)b * SEQ * DM + 1024 + h * HD, (char*)lds_g);
        } else {
            u.Q = sec + 0 * SEC_ELEMS + hoff + (size_t)u.P0 * HD; u.K = sec + 1 * SEC_ELEMS + hoff; u.V = sec + 2 * SEC_ELEMS + hoff;
            att::attn_unit<false>(u, (const float*)(a.ws + WS_C) + (size_t)bh * SEQ, sec + 3 * SEC_ELEMS + (size_t)b * SEQ * 1024 + h * HD,
                                  (bf16_t*)(a.ws + WS_MIX) + (size_t)b * SEQ * DM + h * HD, (char*)lds_g);
        }
    }
}

__device__ __forceinline__ unsigned f2ord(float f) { const unsigned u = __float_as_uint(f); return u ^ ((unsigned)((int)u >> 31) | 0x80000000u); }
__device__ __forceinline__ float ord2f(unsigned k) { const unsigned u = k ^ (~(unsigned)((int)k >> 31) | 0x80000000u); return __uint_as_float(u); }
#define INS16(L, X) do { unsigned x_ = (X); _Pragma("unroll") for (int i_ = 0; i_ < 16; ++i_) { const unsigned hi_ = max(L[i_], x_); x_ = min(L[i_], x_); L[i_] = hi_; } } while (0)
__device__ __forceinline__ void topk_half(const bf16_t* qp, const bf16_t* skb, int t0, int h, int c, int r32, int hi, unsigned (&L)[16]) {
    bf16x8 qf[8];
#pragma unroll
    for (int d0 = 0; d0 < 8; ++d0) qf[d0] = *(const bf16x8*)(qp + (size_t)(t0 + r32) * DM + h * 256 + c * 128 + d0 * 16 + hi * 8);
#pragma unroll
    for (int i = 0; i < 16; ++i) L[i] = 0u;
    const unsigned hi4 = 4u * (unsigned)hi;
#pragma unroll
    for (int kt = 0; kt < 4; ++kt) {
        f32x16 acc = f32x16{};
#pragma unroll
        for (int d0 = 0; d0 < 8; ++d0) { const bf16x8 kf = *(const bf16x8*)(skb + (size_t)((h * 2 + c) * 128 + kt * 32 + r32) * 128 + d0 * 16 + hi * 8);
            acc = __builtin_amdgcn_mfma_f32_32x32x16_bf16(kf, qf[d0], acc, 0, 0, 0); }
        __builtin_amdgcn_sched_barrier(0);
#pragma unroll
        for (int r = 0; r < 16; ++r) { const unsigned cst = (unsigned)(127 - (kt * 32 + (r & 3) + 8 * (r >> 2)));
            const unsigned kk = (f2ord(acc[r]) & ~127u) | (cst - hi4); INS16(L, kk); }
        __builtin_amdgcn_sched_barrier(0);
    }
    unsigned P[16];
#pragma unroll
    for (int i = 0; i < 16; ++i) { auto rr = __builtin_amdgcn_permlane32_swap(L[i], L[i], false, false); P[i] = hi ? rr[0] : rr[1]; }
#pragma unroll
    for (int i = 0; i < 16; ++i) INS16(L, P[i]);
}
__device__ __forceinline__ void phase_topk(const Args& a, unsigned char* lds_g) {
    LAS unsigned char* lds = (LAS unsigned char*)lds_g;
    const int tid = tid_opaque(), lane = tid & 63, wave = tid >> 6, r32 = lane & 31, hi = lane >> 5;
    const int gw = blockIdx.x * NWAVES + wave, NGW = gridDim.x * NWAVES;
    const bf16_t* skb = (const bf16_t*)(a.ws + WS_SK); const bf16_t* qp = (const bf16_t*)(a.ws + WS_QP);
    int* idx_o = (int*)(a.ws + WS_IDX); float* gw_o = (float*)(a.ws + WS_GW);
    for (int task = gw; task < (T / 32) * 8; task += NGW) {
        const int h = task & 7, t0 = (task >> 3) * 32;
        unsigned L[2][16];
        topk_half(qp, skb, t0, h, 0, r32, hi, L[0]);
        __builtin_amdgcn_sched_barrier(0);
        topk_half(qp, skb, t0, h, 1, r32, hi, L[1]);
        __builtin_amdgcn_sched_barrier(0);
        float s1[16], s2[16]; int i1[16], i2[16];
#pragma unroll
        for (int i = 0; i < 16; ++i) { s1[i] = ord2f((L[0][i] & ~127u) | 64u); i1[i] = 127 - (int)(L[0][i] & 127u); s2[i] = ord2f((L[1][i] & ~127u) | 64u); i2[i] = 127 - (int)(L[1][i] & 127u); }
        unsigned LC[16];
#pragma unroll
        for (int i = 0; i < 16; ++i) LC[i] = 0u;
#pragma unroll
        for (int aa = 0; aa < 16; ++aa)
#pragma unroll
            for (int bb = 0; bb < 16; ++bb) if ((aa + 1) * (bb + 1) <= 16) { const unsigned kk = (f2ord(s1[aa] + s2[bb]) & ~255u) | (unsigned)(aa * 16 + bb); INS16(LC, kk); }
        LAS int* tb = (LAS int*)(lds + wave * 8192);
#pragma unroll
        for (int i = 0; i < 16; ++i) { tb[i * 64 + lane] = i1[i]; tb[(16 + i) * 64 + lane] = i2[i]; }
        float LS[16]; int LP[16];
#pragma unroll
        for (int i = 0; i < 16; ++i) { const unsigned cid = LC[i] & 255u; LS[i] = ord2f((LC[i] & ~255u) | 128u);
            LP[i] = tb[(cid >> 4) * 64 + lane] * 128 + tb[(16 + (cid & 15u)) * 64 + lane]; }
        float den = 0.f, e[16];
#pragma unroll
        for (int i = 0; i < 16; ++i) { e[i] = __expf(LS[i] - LS[0]); den += e[i]; }
        const float rden = 1.f / den;
        const size_t ob = (size_t)(t0 + r32) * NE + h * 16;
        if (hi == 0) {
#pragma unroll
            for (int i = 0; i < 4; ++i) *(int4*)(idx_o + ob + 4 * i) = make_int4(LP[4 * i], LP[4 * i + 1], LP[4 * i + 2], LP[4 * i + 3]);
        } else {
#pragma unroll
            for (int i = 0; i < 4; ++i) *(f32x4*)(gw_o + ob + 4 * i) = (f32x4){e[4 * i] * rden, e[4 * i + 1] * rden, e[4 * i + 2] * rden, e[4 * i + 3] * rden};
        }
    }
}


__device__ __forceinline__ void wave_argmax(float& v, int& i) {
#pragma unroll
    for (int o = 1; o < 64; o <<= 1) { const float ov = __shfl_xor(v, o); const int oi = __shfl_xor(i, o); if (ov > v || (ov == v && oi < i)) { v = ov; i = oi; } }
}
__device__ __forceinline__ void phase_topk_ref(const Args& a) {
    const int tid = tid_opaque(), lane = tid & 63, wave = tid >> 6;
    const int gw = blockIdx.x * NWAVES + wave, NGW = gridDim.x * NWAVES;
    const bf16_t* skb = (const bf16_t*)(a.ws + WS_SK); const bf16_t* qp = (const bf16_t*)(a.ws + WS_QP);
    int* idx_o = (int*)(a.ws + WS_IDX); float* gw_o = (float*)(a.ws + WS_GW);
    for (int task = gw; task < T * 8; task += NGW) {
        const int t = task >> 3, h = task & 7;
        float topS[2]; int topI[2];
        for (int c = 0; c < 2; ++c) {
            const bf16_t* q = qp + (size_t)t * DM + h * 256 + c * 128;
            float sc0 = 0.f, sc1 = 0.f;
            const bf16_t* k0 = skb + (size_t)((h * 2 + c) * 128 + lane) * 128; const bf16_t* k1 = k0 + 64 * 128;
            for (int d = 0; d < 128; ++d) { const float qd = __uint_as_float((unsigned)q[d] << 16);
                sc0 += qd * __uint_as_float((unsigned)k0[d] << 16); sc1 += qd * __uint_as_float((unsigned)k1[d] << 16); }
            float ms = 0.f; int mi = 0;
            for (int r = 0; r < 16; ++r) {
                float v; int i; if (sc0 >= sc1) { v = sc0; i = lane; } else { v = sc1; i = lane + 64; }
                wave_argmax(v, i);
                if (lane == r) { ms = v; mi = i; }
                if (i == lane) sc0 = -__builtin_inff();
                if (i == lane + 64) sc1 = -__builtin_inff();
            }
            topS[c] = ms; topI[c] = mi;
        }
        float cs[4]; int ci[4];
#pragma unroll
        for (int j = 0; j < 4; ++j) { const int cidx = lane * 4 + j, aa = cidx >> 4, bb = cidx & 15;
            cs[j] = __shfl(topS[0], aa) + __shfl(topS[1], bb); ci[j] = cidx; }
        float fs = 0.f; int fi = 0;
        for (int r = 0; r < 16; ++r) {
            float v = cs[0]; int i = ci[0];
#pragma unroll
            for (int j = 1; j < 4; ++j) if (cs[j] > v) { v = cs[j]; i = ci[j]; }
            wave_argmax(v, i);
            if (lane == r) { fs = v; fi = i; }
#pragma unroll
            for (int j = 0; j < 4; ++j) if (ci[j] == i) cs[j] = -__builtin_inff();
        }
        const int e1 = __shfl(topI[0], fi >> 4), e2 = __shfl(topI[1], fi & 15);
        const float mx = __shfl(fs, 0);
        float ev = lane < 16 ? __expf(fs - mx) : 0.f;
        const float den = wave_sum(ev);
        if (lane < 16) { idx_o[(size_t)t * NE + h * 16 + lane] = e1 * 128 + e2; gw_o[(size_t)t * NE + h * 16 + lane] = ev / den; }
    }
}

__device__ __forceinline__ void fp8x16_to_f32(const u32x4 q, f32x2 (&o)[8]) {
    o[0] = __builtin_amdgcn_cvt_pk_f32_fp8((int)q.x, false); o[1] = __builtin_amdgcn_cvt_pk_f32_fp8((int)q.x, true);
    o[2] = __builtin_amdgcn_cvt_pk_f32_fp8((int)q.y, false); o[3] = __builtin_amdgcn_cvt_pk_f32_fp8((int)q.y, true);
    o[4] = __builtin_amdgcn_cvt_pk_f32_fp8((int)q.z, false); o[5] = __builtin_amdgcn_cvt_pk_f32_fp8((int)q.z, true);
    o[6] = __builtin_amdgcn_cvt_pk_f32_fp8((int)q.w, false); o[7] = __builtin_amdgcn_cvt_pk_f32_fp8((int)q.w, true);
}
#define HALVE(dst, srcv, n, bitmask) do { const bool up_ = (lane & (bitmask)) != 0; _Pragma("unroll") for (int i_ = 0; i_ < (n); ++i_) { \
        const float keep_ = up_ ? srcv[(n) + i_] : srcv[i_], send_ = up_ ? srcv[i_] : srcv[(n) + i_]; dst[i_] = keep_ + __shfl_xor(send_, (bitmask)); } } while (0)
__device__ __forceinline__ void phase_peer_u(const Args& a) {
    const int tid = tid_opaque(), lane = tid & 63, wave = tid >> 6, g = lane >> 3, c = lane & 7;
    const int xl = blockIdx.x & 7, wv = (blockIdx.x >> 3) * NWAVES + wave, NWX = (gridDim.x >> 3) * NWAVES;
    const bf16_t* hb = (const bf16_t*)(a.ws + WS_HB); const unsigned char* u8 = a.ws + WS_U8;
    const int* idx_i = (const int*)(a.ws + WS_IDX); float* part = (float*)(a.ws + WS_PART);
    for (int sp = 0; sp < 2; ++sp) {
        const int s = xl + 8 * sp;
        for (int t = wv; t < T; t += NWX) {
            int id[16];
            { const int4* ip = (const int4*)(idx_i + (size_t)t * NE + g * 16);
#pragma unroll
              for (int i = 0; i < 4; ++i) { const int4 v = ip[i]; id[4 * i] = v.x; id[4 * i + 1] = v.y; id[4 * i + 2] = v.z; id[4 * i + 3] = v.w; } }
            u32x4 q[16];
#pragma unroll
            for (int i = 0; i < 16; ++i) q[i] = *(const u32x4*)(u8 + (size_t)id[i] * DM + s * 128 + c * 16);
            f32x2 xf[8];
            { const u32x4 x0 = *(const u32x4*)(hb + (size_t)t * DM + s * 128 + c * 16), x1 = *(const u32x4*)(hb + (size_t)t * DM + s * 128 + c * 16 + 8);
              xf[0] = (f32x2){bf_lo(x0.x), bf_hi(x0.x)}; xf[1] = (f32x2){bf_lo(x0.y), bf_hi(x0.y)}; xf[2] = (f32x2){bf_lo(x0.z), bf_hi(x0.z)}; xf[3] = (f32x2){bf_lo(x0.w), bf_hi(x0.w)};
              xf[4] = (f32x2){bf_lo(x1.x), bf_hi(x1.x)}; xf[5] = (f32x2){bf_lo(x1.y), bf_hi(x1.y)}; xf[6] = (f32x2){bf_lo(x1.z), bf_hi(x1.z)}; xf[7] = (f32x2){bf_lo(x1.w), bf_hi(x1.w)}; }
            float p[16];
#pragma unroll
            for (int i = 0; i < 16; ++i) { f32x2 uf[8]; fp8x16_to_f32(q[i], uf); f32x2 ac = uf[0] * xf[0];
#pragma unroll
                for (int k = 1; k < 8; ++k) ac = ac + uf[k] * xf[k];
                p[i] = ac.x + ac.y; }
            float p8[8], p4[4], p2[2];
            HALVE(p8, p, 8, 4); HALVE(p4, p8, 4, 2); HALVE(p2, p4, 2, 1);
            *(f32x2*)(part + ((size_t)t * 16 + s) * NE + 2 * lane) = (f32x2){p2[0], p2[1]};
        }
    }
}
__device__ __forceinline__ void phase_peer_w(const Args& a) {
    const int gt = blockIdx.x * NTHREADS + tid_opaque(), NGT = gridDim.x * NTHREADS;
    const int* idx_i = (const int*)(a.ws + WS_IDX); const float* gw_i = (const float*)(a.ws + WS_GW); const float* part = (const float*)(a.ws + WS_PART);
    const float* suv = (const float*)(a.ws + WS_SUV); const float* rtab = (const float*)(a.ws + WS_RT); float* wtab = (float*)(a.ws + WS_W);
    for (int item = gt; item < T * NE; item += NGT) {
        const int t = item >> 7, e = item & 127;
        float sum = 0.f;
#pragma unroll
        for (int s = 0; s < 16; ++s) sum += part[((size_t)t * 16 + s) * NE + e];
        const int ex = idx_i[item];
        const float d = sum * suv[ex] * rtab[t];
        wtab[item] = 0.5f * d * (1.f + erff(d * 0.70710678118654752f)) * gw_i[item] * suv[NEXP + ex];
    }
}
__device__ __forceinline__ void phase_peer_v(const Args& a, float* dst) {
    const int tid = tid_opaque(), lane = tid & 63, wave = tid >> 6, g = lane >> 3, c = lane & 7;
    const int xl = blockIdx.x & 7, wv = (blockIdx.x >> 3) * NWAVES + wave, NWX = (gridDim.x >> 3) * NWAVES;
    const unsigned char* v8 = a.ws + WS_V8;
    const int* idx_i = (const int*)(a.ws + WS_IDX); const float* wtab = (const float*)(a.ws + WS_W);
    const float* hsrc = a.out;
    for (int sp = 0; sp < 2; ++sp) {
        const int s = xl + 8 * sp;
        for (int t = wv; t < T; t += NWX) {
            int id[16]; float w[16];
            { const int4* ip = (const int4*)(idx_i + (size_t)t * NE + g * 16); const f32x4* wp = (const f32x4*)(wtab + (size_t)t * NE + g * 16);
#pragma unroll
              for (int i = 0; i < 4; ++i) { const int4 v = ip[i]; id[4 * i] = v.x; id[4 * i + 1] = v.y; id[4 * i + 2] = v.z; id[4 * i + 3] = v.w;
                  const f32x4 ww = wp[i]; w[4 * i] = ww[0]; w[4 * i + 1] = ww[1]; w[4 * i + 2] = ww[2]; w[4 * i + 3] = ww[3]; } }
            u32x4 q[16];
#pragma unroll
            for (int i = 0; i < 16; ++i) q[i] = *(const u32x4*)(v8 + (size_t)id[i] * DM + s * 128 + c * 16);
            f32x2 ac[8];
#pragma unroll
            for (int k = 0; k < 8; ++k) ac[k] = (f32x2){0.f, 0.f};
#pragma unroll
            for (int i = 0; i < 16; ++i) { f32x2 vf[8]; fp8x16_to_f32(q[i], vf);
#pragma unroll
                for (int k = 0; k < 8; ++k) ac[k] = ac[k] + vf[k] * w[i]; }
            float p[16];
#pragma unroll
            for (int k = 0; k < 8; ++k) { p[2 * k] = ac[k].x; p[2 * k + 1] = ac[k].y; }
            float p8[8], p4[4], p2[2];
            HALVE(p8, p, 8, 32); HALVE(p4, p8, 4, 16); HALVE(p2, p4, 2, 8);
            const size_t o = (size_t)t * DM + s * 128 + c * 16 + 2 * g;
            const f32x2 hv = *(const f32x2*)(hsrc + o);
            *(f32x2*)(dst + o) = (f32x2){hv.x + p2[0], hv.y + p2[1]};
        }
    }
}
#undef HALVE


#define XB_TMO      128
#define XB_XCNT(j)  (256  + 64 * (j))
#define XB_XSUB(j)  (1280 + 64 * (j))
#define XB_XGEN(j)  (2304 + 64 * (j))
#define XB_TOP      3328
#define XB_TOPGEN   3392
#define XCD_BAR_WORDS 3456
#define XB_SPIN_CAP (1u << 20)
__device__ __forceinline__ unsigned xb_ld(unsigned* p)              { return __hip_atomic_load(p, __ATOMIC_RELAXED, __HIP_MEMORY_SCOPE_AGENT); }
__device__ __forceinline__ unsigned xb_add(unsigned* p, unsigned v) { return __hip_atomic_fetch_add(p, v, __ATOMIC_RELAXED, __HIP_MEMORY_SCOPE_AGENT); }
__device__ __forceinline__ unsigned xb_xcc_id() { return (unsigned)__builtin_amdgcn_s_getreg((3 << 11) | 20) & 0xFu; }
#define XB_SPIN(cond, bar) do { unsigned _sp = 0; while (cond) { __builtin_amdgcn_s_sleep(1); \
    if ((++_sp & 255u) == 0u) { if (xb_ld(&(bar)[XB_TMO])) break; if (_sp > XB_SPIN_CAP) { atomicAdd(&(bar)[XB_TMO], 1u); break; } } } } while (0)
struct XcdBarrier { unsigned* bar; unsigned x; volatile LAS unsigned* st; };
__device__ __forceinline__ XcdBarrier xcd_barrier_post(unsigned* bar, volatile LAS unsigned* st) {
    XcdBarrier b; b.bar = bar; b.x = xb_xcc_id(); b.st = st;
    if (threadIdx.x == 0) (void)xb_add(&bar[XB_XCNT(b.x)], 1u);
    return b;
}
__device__ __forceinline__ void xcd_barrier_complete(unsigned* bar, unsigned x, unsigned& nloc, unsigned& nx) {
    const unsigned G = gridDim.x * gridDim.y * gridDim.z;
    unsigned sum, cnt, mine, sp = 0u;
    for (;;) {
        sum = 0u; cnt = 0u; mine = 0u;
#pragma unroll
        for (unsigned j = 0; j < 16; ++j) { const unsigned c = xb_ld(&bar[XB_XCNT(j)]); sum += c; cnt += (c > 0u) ? 1u : 0u; mine = (j == x) ? c : mine; }
        if (sum == G) break;
        __builtin_amdgcn_s_sleep(1);
        if ((++sp & 255u) == 0u) { if (xb_ld(&bar[XB_TMO])) break; if (sp > XB_SPIN_CAP) { atomicAdd(&bar[XB_TMO], 1u); break; } }
    }
    nloc = mine > 0u ? mine : 1u; nx = cnt > 0u ? cnt : 1u;
}
__device__ __forceinline__ void xcd_barrier(const XcdBarrier& b) {
    asm volatile("s_waitcnt vmcnt(0)" ::: "memory");
    __syncthreads();
    if (threadIdx.x == 0) {
        unsigned* bar = b.bar;
        __builtin_amdgcn_s_waitcnt(0);
        unsigned nloc = b.st[0], nx = b.st[1];
        if (nloc == 0u) { xcd_barrier_complete(bar, b.x, nloc, nx); b.st[0] = nloc; b.st[1] = nx; }
        const unsigned old = xb_add(&bar[XB_XSUB(b.x)], 1u);
        const unsigned gen = old / nloc;
        if (old + 1u == (gen + 1u) * nloc) {
            __builtin_amdgcn_fence(__ATOMIC_RELEASE, "agent");
            asm volatile("s_waitcnt vmcnt(0)" ::: "memory");
            const unsigned og = xb_add(&bar[XB_TOP], 1u);
            const unsigned tg = og / nx;
            if (og + 1u == (tg + 1u) * nx) xb_add(&bar[XB_TOPGEN], 1u);
            else XB_SPIN(xb_ld(&bar[XB_TOPGEN]) == tg, bar);
            __builtin_amdgcn_fence(__ATOMIC_ACQUIRE, "agent");
            xb_add(&bar[XB_XGEN(b.x)], 1u);
            asm volatile("s_waitcnt vmcnt(0)" ::: "memory");
        } else {
            XB_SPIN(xb_ld(&bar[XB_XGEN(b.x)]) == gen, bar);
            __builtin_amdgcn_fence(__ATOMIC_ACQUIRE, "agent");
            asm volatile("s_waitcnt vmcnt(0)" ::: "memory");
        }
    }
    __syncthreads();
}

constexpr int NPHASE = 10;
#define LOAD_ARGS() do { } while (0)
__global__ void __launch_bounds__(NTHREADS, 2) fwd_kernel(Args a) {
    extern __shared__ __attribute__((aligned(16))) unsigned char lds[];
#if MK_ONE_LAUNCH
    constexpr int lo = 0, hi = NPHASE;
    cg::grid_group grid = cg::this_grid();
    volatile LAS unsigned* misc = (volatile LAS unsigned*)((LAS unsigned char*)lds + MISC_OFF);
    if (threadIdx.x < 16) misc[threadIdx.x] = 0u;
    __syncthreads();
    { LOAD_ARGS(); (void)xcd_barrier_post((unsigned*)(a.ws + WS_CTL) + CW_BAR, misc + 8); }
#ifndef SEAM_CG_MASK
#define SEAM_CG_MASK 0
#endif
#define SEAM(k) do { if (lo <= (k) && (k) + 1 < hi) { if ((SEAM_CG_MASK >> (k)) & 1) grid.sync(); else { LOAD_ARGS(); XcdBarrier xb_; xb_.bar = (unsigned*)(a.ws + WS_CTL) + CW_BAR; xb_.x = xb_xcc_id(); \
        xb_.st = (volatile LAS unsigned*)((LAS unsigned char*)lds + MISC_OFF) + 8; xcd_barrier(xb_); } } } while (0)
#else
    int lo, hi; { LOAD_ARGS(); lo = a.ph_lo; hi = a.ph_hi; }
#define SEAM(k) do { } while (0)
#endif
#define IN(k) (lo <= (k) && (k) < hi)
#ifndef DUP_PHASE
#define DUP_PHASE -1
#endif
    if (IN(0)) { LOAD_ARGS(); phase0(a, lds); if (DUP_PHASE == 0) { __syncthreads(); phase0(a, lds); } SEAM(0); }
    if (IN(1)) { LOAD_ARGS(); unsigned char* ws = a.ws;
        cumsum_rows(a);
        pg8::Gemm g{(const bf16_t*)(ws + WS_XN), (const bf16_t*)(ws + WS_WIN), T, NPROJ, DM}; pg8::StaticOrder S; S.init(T, NPROJ, (int)gridDim.x, (int)blockIdx.x);
        pg8::EpiInProj E{(bf16_t*)(ws + WS_SEC)};
        for (int rep_ = 0; rep_ < (DUP_PHASE == 1 ? 2 : 1); ++rep_)
        pg8::gemm_phase<pg8::EpiInProj, pg8::StaticOrder, true, true>((LAS unsigned char*)lds, g, S, E);
        SEAM(1);
    }
    if (IN(2)) { LOAD_ARGS(); phase_qknorm(a); SEAM(2); }
    if (IN(3)) { LOAD_ARGS(); phase_attn(a, lds);
#if MK_ONE_LAUNCH
        if (DUP_PHASE == 3) { grid.sync(); if (blockIdx.x == 0 && threadIdx.x == 0) *(volatile unsigned*)(a.ws + WS_CTL) = 0u; __threadfence(); grid.sync(); phase_attn(a, lds); }
#endif
        SEAM(3); }
    if (IN(4)) { LOAD_ARGS(); unsigned char* ws = a.ws;
        pg8::Gemm g{(const bf16_t*)(ws + WS_MIX), (const bf16_t*)(ws + WS_WOUT), T, DM, DM}; pg8::StaticOrder S; S.init(T, DM, (int)gridDim.x, (int)blockIdx.x);
        pg8::EpiOutProj E{a.in[0], a.out, (bf16_t*)(ws + WS_HB), (float*)(ws + WS_SSQ)};
        for (int rep_ = 0; rep_ < (DUP_PHASE == 4 ? 2 : 1); ++rep_)
        pg8::gemm_phase<pg8::EpiOutProj, pg8::StaticOrder, true, true>((LAS unsigned char*)lds, g, S, E);
        SEAM(4);
    }
    if (IN(5)) { LOAD_ARGS(); unsigned char* ws = a.ws;
        pg8::Gemm g{(const bf16_t*)(ws + WS_HB), (const bf16_t*)(ws + WS_WPQ), T, DM, DM}; pg8::StaticOrder S; S.init(T, DM, (int)gridDim.x, (int)blockIdx.x);
        pg8::EpiPeerQ E{(const float*)(ws + WS_SSQ), (bf16_t*)(ws + WS_QP), (float*)(ws + WS_RT)};
        for (int rep_ = 0; rep_ < (DUP_PHASE == 5 ? 2 : 1); ++rep_)
        pg8::gemm_phase<pg8::EpiPeerQ, pg8::StaticOrder, true, true>((LAS unsigned char*)lds, g, S, E);
        SEAM(5);
    }
    #ifdef TOPK_REF
    if (IN(6)) { LOAD_ARGS(); phase_topk_ref(a); SEAM(6); }
#else
    if (IN(6)) { LOAD_ARGS(); for (int rep_ = 0; rep_ < (DUP_PHASE == 6 ? 2 : 1); ++rep_) phase_topk(a, lds); SEAM(6); }
#endif
    if (IN(7)) { LOAD_ARGS(); for (int rep_ = 0; rep_ < (DUP_PHASE == 7 ? 2 : 1); ++rep_) phase_peer_u(a); SEAM(7); }
    if (IN(8)) { LOAD_ARGS(); for (int rep_ = 0; rep_ < (DUP_PHASE == 8 ? 2 : 1); ++rep_) phase_peer_w(a); SEAM(8); }
    if (IN(9)) { LOAD_ARGS(); for (int rep_ = 0; rep_ < (DUP_PHASE == 9 ? 2 : 1); ++rep_) phase_peer_v(a, (DUP_PHASE == 9 && rep_ == 0) ? (float*)(a.ws + WS_END) : a.out); }
#undef IN
#undef SEAM
}

extern "C" void kernel_launch(void* const* d_in, const int* in_sizes, int n_in, void* d_out, int out_size, void* d_ws, size_t ws_size, hipStream_t stream) {
    static int grid = 0;
    if (grid == 0) {
        if (n_in != 12 || in_sizes[0] != T * DM || out_size != T * DM || ws_size < WS_END) { fprintf(stderr, "kernel_launch: unexpected shapes (n_in %d, in0 %d, out %d, ws %zu)\n", n_in, n_in > 0 ? in_sizes[0] : -1, out_size, ws_size); grid = -1; return; }
        int dev = 0, cus = 0, per_cu = 0;
        if (hipGetDevice(&dev) != hipSuccess || hipDeviceGetAttribute(&cus, hipDeviceAttributeMultiprocessorCount, dev) != hipSuccess) { grid = -1; return; }
        if (hipFuncSetAttribute((const void*)fwd_kernel, hipFuncAttributeMaxDynamicSharedMemorySize, LDS_BYTES) != hipSuccess) { fprintf(stderr, "kernel_launch: hipFuncSetAttribute failed\n"); grid = -1; return; }
        if (hipOccupancyMaxActiveBlocksPerMultiprocessor(&per_cu, (const void*)fwd_kernel, NTHREADS, LDS_BYTES) != hipSuccess || per_cu < 1) { fprintf(stderr, "kernel_launch: occupancy query says %d\n", per_cu); grid = -1; return; }
        grid = cus;
    }
    if (grid < 0) return;
    (void)hipMemsetAsync((char*)d_ws + WS_CTL, 0, CTL_BYTES, stream);
    Args a{};
    for (int i = 0; i < 12; ++i) a.in[i] = (const float*)d_in[i];
    a.out = (float*)d_out; a.ws = (unsigned char*)d_ws;
#if MK_ONE_LAUNCH
    a.ph_lo = 0; a.ph_hi = NPHASE;
    void* args[] = {&a};
#if MK_COOP_LAUNCH
    hipError_t e = hipLaunchCooperativeKernel((const void*)fwd_kernel, dim3(grid), dim3(NTHREADS), args, LDS_BYTES, stream);
    if (e != hipSuccess) fprintf(stderr, "cooperative launch failed: %s (grid %d)\n", hipGetErrorString(e), grid);
#else
    (void)args; hipLaunchKernelGGL(fwd_kernel, dim3(grid), dim3(NTHREADS), LDS_BYTES, stream, a);
#endif
#else
    for (int p = 0; p < NPHASE; ++p) { a.ph_lo = p; a.ph_hi = p + 1; hipLaunchKernelGGL(fwd_kernel, dim3(grid), dim3(NTHREADS), LDS_BYTES, stream, a); }
#endif
}
```

```cpp
#include <hip/hip_runtime.h>
#include <hip/hip_cooperative_groups.h>
#include <cstdio>
#include <cstdint>
namespace cg = cooperative_groups;

#ifndef MK_COOP_LAUNCH
#define MK_COOP_LAUNCH 0
#endif
#ifndef MK_ONE_LAUNCH
#define MK_ONE_LAUNCH 1
#endif

#define LAS __attribute__((address_space(3)))
typedef unsigned short bf16_t;
typedef short bf16x8 __attribute__((ext_vector_type(8)));
typedef short s16x4 __attribute__((ext_vector_type(4)));
typedef float f32x2 __attribute__((ext_vector_type(2)));
typedef float f32x4 __attribute__((ext_vector_type(4)));
typedef float f32x16 __attribute__((ext_vector_type(16)));
typedef unsigned u32x2 __attribute__((ext_vector_type(2)));
typedef unsigned u32x4 __attribute__((ext_vector_type(4)));
typedef __bf16 bf16x2_t __attribute__((ext_vector_type(2)));

constexpr int NB = 2, SEQ = 4096, T = NB * SEQ, DM = 2048, HD = 128, NHF = 8, DIN = 7176, NPROJ = 7168;
constexpr int NEXP = 16384, NE = 128;
constexpr float EPS = 1e-6f;
constexpr float SCALE = 0.08838834764831845f, LOG2E = 1.4426950408889634f;
constexpr int NWAVES = 8, NTHREADS = 512;

constexpr size_t MiB = 1u << 20;
constexpr size_t WS_CTL = 0, CTL_BYTES = 32768;
constexpr int CW_BAR = 1024;
constexpr size_t WS_GQK = 45 * MiB + 768 * 1024;
constexpr size_t WS_WIN = 1 * MiB, WS_WOUT = 29 * MiB, WS_WPQ = 37 * MiB, WS_SK = 45 * MiB, WS_LOGF = 46 * MiB, WS_C = 46 * MiB + 512 * 1024, WS_SSQ = 47 * MiB;
constexpr size_t WS_XN = 48 * MiB;
constexpr size_t WS_SEC = 80 * MiB;
constexpr size_t SEC_ELEMS = 8u << 20;
constexpr size_t WS_MIX = 192 * MiB, WS_HB = 224 * MiB, WS_QP = 256 * MiB, WS_IDX = 288 * MiB, WS_GW = 292 * MiB, WS_U8 = 296 * MiB, WS_V8 = 328 * MiB, WS_SUV = 360 * MiB  , WS_RT = 360 * MiB + 256 * 1024  , WS_W = 361 * MiB  ,
                 WS_PART = 368 * MiB  , WS_END = 432 * MiB;

constexpr int RING_BYTES = 131072;
constexpr int MISC_OFF = 143360;
constexpr int LDS_BYTES = 147456;

__device__ __forceinline__ unsigned cvt_pk_bf16(float lo, float hi) { unsigned r; asm volatile("v_cvt_pk_bf16_f32 %0, %1, %2" : "=v"(r) : "v"(lo), "v"(hi)); return r; }
__device__ __forceinline__ float bf_lo(unsigned u) { return __builtin_bit_cast(float, u << 16); }
__device__ __forceinline__ float bf_hi(unsigned u) { return __builtin_bit_cast(float, u & 0xffff0000u); }
__device__ __forceinline__ float wave_sum(float v) {
#pragma unroll
    for (int o = 1; o < 64; o <<= 1) v += __shfl_xor(v, o);
    return v;
}
__device__ __forceinline__ float wave_max(float v) {
#pragma unroll
    for (int o = 1; o < 64; o <<= 1) v = fmaxf(v, __shfl_xor(v, o));
    return v;
}
__device__ __forceinline__ int tid_opaque() { int t = (int)threadIdx.x; asm volatile("" : "+v"(t)); return t; }
#define LDS_WAIT() asm volatile("s_waitcnt lgkmcnt(0)" ::: "memory")

namespace pg8 {
#define PG8_LAS __attribute__((address_space(3)))
constexpr int BM = 256, BK = 64, HALF = 128, HTB = HALF * BK * 2, STAGE_BYTES = 8 * HTB, NXCD = 8, WGM = 8;
__host__ __device__ __forceinline__ int lds_byte(int r, int c) { const int st = (r >> 4) * 2 + (c >> 5), rr = r & 15, cc = c & 31, ob = rr * 64 + cc * 2; return st * 1024 + (ob ^ (((ob >> 9) & 1) << 5)); }
__host__ __device__ __forceinline__ void stage_rc(int b, int& R, int& C) { const int st = b / 1024, sb = b % 1024, swz = sb ^ (((sb >> 9) & 1) << 5); R = (st >> 1) * 16 + swz / 64; C = (st & 1) * 32 + (swz % 64) / 2; }
__host__ __device__ __forceinline__ int perm32(int rho) { const int n = rho >> 4, i = rho & 15; return 8 * (i >> 2) + 4 * n + (i & 3); }
struct Unit { int pm, pn; };
struct Gemm { const bf16_t* A; const bf16_t* Bt; int M, N, K; };
struct StaticOrder {
    int nM, nN, nwg, G, c;
    __host__ __device__ void init(int M, int N, int G_, int c_) { nM = M / BM; nN = N / BM; nwg = nM * nN; G = G_; c = c_; }
    __host__ __device__ bool next(int i, Unit& u) const {
        const long L = (long)i * G + c; if (L >= nwg) return false;
        int wgid = (int)L; { const int q = nwg / NXCD, r = nwg % NXCD, xcd = wgid % NXCD, off = wgid / NXCD; wgid = (xcd < r ? xcd * (q + 1) : r * (q + 1) + (xcd - r) * q) + off; }
        const int nig = WGM * nN, gid = wgid / nig, fm = gid * WGM, gsz = (nM - fm) < WGM ? (nM - fm) : WGM;
        u.pm = fm + ((wgid % nig) % gsz); u.pn = (wgid % nig) / gsz; return true;
    }
    __device__ __forceinline__ void a_ready(const Unit&) const {}
    __device__ __forceinline__ void done(const Unit&) const {}
};

template <class Epi, class Sched, bool ALIGN_EPI = false, bool SP2 = false>
__device__ __forceinline__ void gemm_phase(PG8_LAS unsigned char* lds, const Gemm g, const Sched& S, const Epi& E) {
    const int tid = tid_opaque(), wid = __builtin_amdgcn_readfirstlane(tid >> 6), lane = tid & 63, wr = wid >> 2, wc = wid & 3, fr = lane & 15, fq = lane >> 4;
    const int K = g.K, nt = K / BK;
    unsigned voffA[2], voffB[2];
#pragma unroll
    for (int i = 0; i < 2; ++i) { int R, C; stage_rc(tid * 16 + i * 8192, R, C); const int Rb = Epi::PERM ? ((R & ~31) + perm32(R & 31)) : R;
        voffA[i] = (unsigned)(R * K + C) * 2u; voffB[i] = (unsigned)(Rb * K + C) * 2u; }
    const size_t kstep = (size_t)(BK * 2);
    const size_t hstep = (size_t)HALF * K * 2;
    const size_t tstep = 2 * hstep;
    const unsigned ldsw = (unsigned)wid * 1024u;
    const int aoff = lds_byte(wr * 64 + fr, fq * 8), boff = lds_byte(wc * 32 + fr, fq * 8);
#define PG8_SA(b, h) (((b) * 2 + (h)) * HTB)
#define PG8_SB(b, h) ((4 + (b) * 2 + (h)) * HTB)
#define PG8_STAGE(bufoff, gbase, voff) do { _Pragma("unroll") for (int _i = 0; _i < 2; ++_i) \
        __builtin_amdgcn_global_load_lds((const unsigned*)((const char*)(gbase) + (voff)[_i]), (PG8_LAS unsigned*)(lds + (bufoff) + ldsw + _i * 8192), 16, 0, 0); } while (0)
#define PG8_LDA(dst, b, h) do { _Pragma("unroll") for (int m = 0; m < 4; ++m) _Pragma("unroll") for (int k = 0; k < 2; ++k) dst[m][k] = *(const PG8_LAS bf16x8*)(lds + PG8_SA(b, h) + aoff + m * 2048 + k * 1024); } while (0)
#define PG8_LDB(dst, b, h) do { _Pragma("unroll") for (int n = 0; n < 2; ++n) _Pragma("unroll") for (int k = 0; k < 2; ++k) dst[n][k] = *(const PG8_LAS bf16x8*)(lds + PG8_SB(b, h) + boff + n * 2048 + k * 1024); } while (0)
#define PG8_MMA(ai, bj, At, Bt) do { __builtin_amdgcn_s_setprio(1); _Pragma("unroll") for (int m = 0; m < 4; ++m) _Pragma("unroll") for (int n = 0; n < 2; ++n) _Pragma("unroll") for (int k = 0; k < 2; ++k) \
        acc[ai][bj][m][n] = __builtin_amdgcn_mfma_f32_16x16x32_bf16(Bt[n][k], At[m][k], acc[ai][bj][m][n], 0, 0, 0); __builtin_amdgcn_s_setprio(0); } while (0)
#define PG8_WAIT_V(n) asm volatile("s_waitcnt vmcnt(" #n ")" ::: "memory")
#define PG8_WAIT_L(n) asm volatile("s_waitcnt lgkmcnt(" #n ")" ::: "memory")
#define PG8_BAR __builtin_amdgcn_s_barrier()
#define PG8_SCHED __builtin_amdgcn_sched_barrier(0)
    Unit cur, nxt; int ui = 0;
    if (!S.next(0, cur)) return;
    f32x4 acc[2][2][4][2];
#pragma unroll
    for (int a = 0; a < 2; ++a)
#pragma unroll
        for (int b = 0; b < 2; ++b)
#pragma unroll
            for (int m = 0; m < 4; ++m)
#pragma unroll
                for (int n = 0; n < 2; ++n) acc[a][b][m][n] = (f32x4){0.f, 0.f, 0.f, 0.f};
    bf16x8 At[4][2], B0[2][2], B1[2][2];
    const char* cA = (const char*)g.A + (size_t)cur.pm * tstep; const char* cB = (const char*)g.Bt + (size_t)cur.pn * tstep;
    S.a_ready(cur);
    if constexpr (SP2) {
        PG8_STAGE(PG8_SB(0, 0), cB, voffB); PG8_STAGE(PG8_SB(0, 1), cB + hstep, voffB); PG8_STAGE(PG8_SA(0, 0), cA, voffA); PG8_STAGE(PG8_SA(0, 1), cA + hstep, voffA);
        if (wr == 1) PG8_BAR;
        PG8_WAIT_V(2); PG8_BAR;
        PG8_STAGE(PG8_SB(1, 0), cB + kstep, voffB); PG8_STAGE(PG8_SA(1, 0), cA + kstep, voffA); PG8_STAGE(PG8_SB(1, 1), cB + hstep + kstep, voffB);
        PG8_WAIT_V(6); PG8_BAR;
    } else {
        PG8_STAGE(PG8_SB(0, 0), cB, voffB); PG8_STAGE(PG8_SA(0, 0), cA, voffA); PG8_STAGE(PG8_SB(0, 1), cB + hstep, voffB); PG8_STAGE(PG8_SA(0, 1), cA + hstep, voffA);
        if (wr == 1) PG8_BAR;
        PG8_WAIT_V(4); PG8_BAR;
        PG8_STAGE(PG8_SB(1, 0), cB + kstep, voffB); PG8_STAGE(PG8_SA(1, 0), cA + kstep, voffA); PG8_STAGE(PG8_SB(1, 1), cB + hstep + kstep, voffB);
        PG8_WAIT_V(6); PG8_BAR;
    }
    for (;;) {
        const bool has_next = S.next(ui + 1, nxt);
        const char* nA = has_next ? (const char*)g.A + (size_t)nxt.pm * tstep : cA; const char* nB = has_next ? (const char*)g.Bt + (size_t)nxt.pn * tstep : cB;
        for (int t = 0; t < nt; t += 2) {
            const bool last = (t == nt - 2);
            const char* a1 = cA + (size_t)(t + 1) * kstep;
            const char* a2 = last ? nA : cA + (size_t)(t + 2) * kstep; const char* b2 = last ? nB : cB + (size_t)(t + 2) * kstep;
            const char* a3 = a2 + kstep; const char* b3 = b2 + kstep;
            if (last && has_next) S.a_ready(nxt);
            if constexpr (SP2) {
            PG8_LDB(B0, 0, 0); PG8_LDB(B1, 0, 1); PG8_SCHED; PG8_LDA(At, 0, 0); PG8_STAGE(PG8_SA(1, 1), a1 + hstep, voffA);
            PG8_WAIT_V(8); PG8_WAIT_L(0); PG8_BAR; PG8_MMA(0, 0, At, B0); PG8_MMA(0, 1, At, B1); PG8_BAR; PG8_SCHED;
            PG8_LDA(At, 0, 1); PG8_STAGE(PG8_SB(0, 0), b2, voffB); PG8_STAGE(PG8_SB(0, 1), b2 + hstep, voffB); PG8_STAGE(PG8_SA(0, 0), a2, voffA);
            PG8_WAIT_V(8); PG8_WAIT_L(0); PG8_BAR; PG8_MMA(1, 0, At, B0); PG8_MMA(1, 1, At, B1); PG8_BAR; PG8_SCHED;
            PG8_LDB(B0, 1, 0); PG8_LDB(B1, 1, 1); PG8_SCHED; PG8_LDA(At, 1, 0); PG8_STAGE(PG8_SA(0, 1), a2 + hstep, voffA);
            PG8_WAIT_V(8); PG8_WAIT_L(0); PG8_BAR; PG8_MMA(0, 0, At, B0); PG8_MMA(0, 1, At, B1); PG8_BAR; PG8_SCHED;
            PG8_LDA(At, 1, 1); PG8_STAGE(PG8_SB(1, 0), b3, voffB); PG8_STAGE(PG8_SB(1, 1), b3 + hstep, voffB); PG8_STAGE(PG8_SA(1, 0), a3, voffA);
            PG8_WAIT_V(8); PG8_WAIT_L(0); PG8_BAR; PG8_MMA(1, 0, At, B0); PG8_MMA(1, 1, At, B1); PG8_BAR; PG8_SCHED;
            } else {
            PG8_LDB(B0, 0, 0); PG8_SCHED; PG8_LDA(At, 0, 0); PG8_STAGE(PG8_SA(1, 1), a1 + hstep, voffA);
            PG8_WAIT_L(8); PG8_BAR; PG8_WAIT_L(0); PG8_MMA(0, 0, At, B0); PG8_BAR; PG8_SCHED;
            PG8_LDB(B1, 0, 1); PG8_STAGE(PG8_SB(0, 0), b2, voffB);
            PG8_BAR; PG8_WAIT_L(0); PG8_MMA(0, 1, At, B1); PG8_BAR;
            PG8_LDA(At, 0, 1); PG8_STAGE(PG8_SA(0, 0), a2, voffA);
            PG8_BAR; PG8_WAIT_L(0); PG8_MMA(1, 0, At, B0); PG8_BAR; PG8_SCHED;
            PG8_STAGE(PG8_SB(0, 1), b2 + hstep, voffB);
            PG8_WAIT_V(6); PG8_BAR; PG8_MMA(1, 1, At, B1); PG8_BAR;
            PG8_LDB(B0, 1, 0); PG8_SCHED; PG8_LDA(At, 1, 0); PG8_STAGE(PG8_SA(0, 1), a2 + hstep, voffA);
            PG8_WAIT_L(8); PG8_BAR; PG8_WAIT_L(0); PG8_MMA(0, 0, At, B0); PG8_BAR; PG8_SCHED;
            PG8_LDB(B1, 1, 1); PG8_STAGE(PG8_SB(1, 0), b3, voffB);
            PG8_BAR; PG8_WAIT_L(0); PG8_MMA(0, 1, At, B1); PG8_BAR;
            PG8_LDA(At, 1, 1); PG8_STAGE(PG8_SA(1, 0), a3, voffA);
            PG8_BAR; PG8_WAIT_L(0); PG8_MMA(1, 0, At, B0); PG8_BAR; PG8_SCHED;
            PG8_STAGE(PG8_SB(1, 1), b3 + hstep, voffB);
            PG8_WAIT_V(6); PG8_BAR; PG8_MMA(1, 1, At, B1); PG8_BAR;
            }
        }
        if constexpr (ALIGN_EPI) { if (wr == 0) PG8_BAR; }
        E(acc, cur, wr, wc, fr, fq); S.done(cur);
        if (!has_next) break;
#pragma unroll
        for (int a = 0; a < 2; ++a)
#pragma unroll
            for (int b = 0; b < 2; ++b)
#pragma unroll
                for (int m = 0; m < 4; ++m)
#pragma unroll
                    for (int n = 0; n < 2; ++n) acc[a][b][m][n] = (f32x4){0.f, 0.f, 0.f, 0.f};
        cur = nxt; cA = nA; cB = nB; ++ui;
        if constexpr (ALIGN_EPI) { if (wr == 1) PG8_BAR; }
    }
    PG8_WAIT_V(0);
    if constexpr (!ALIGN_EPI) { if (wr == 0) PG8_BAR; }
    PG8_BAR;
#undef PG8_SA
#undef PG8_SB
#undef PG8_STAGE
#undef PG8_LDA
#undef PG8_LDB
#undef PG8_MMA
#undef PG8_WAIT_V
#undef PG8_WAIT_L
#undef PG8_BAR
#undef PG8_SCHED
}

__device__ __forceinline__ float sigmoidf_fast(float x) { return __builtin_amdgcn_rcpf(1.f + __builtin_amdgcn_exp2f(-x * LOG2E)); }
struct EpiInProj {
    static constexpr bool PERM = true;
    bf16_t* base;
    __device__ __forceinline__ void operator()(const f32x4 (&acc)[2][2][4][2], const Unit& u, int wr, int wc, int fr, int fq) const {
        const int sec = u.pn >> 2;
        bf16_t* sb = base + (size_t)sec * SEC_ELEMS;
        const float sc = (sec == 4) ? SCALE * LOG2E : 1.f;
#pragma unroll
        for (int ai = 0; ai < 2; ++ai)
#pragma unroll
            for (int m = 0; m < 4; ++m) {
                const int tk = u.pm * BM + ai * HALF + wr * 64 + m * 16 + fr, b = tk >> 12, s = tk & 4095;
#pragma unroll
                for (int bj = 0; bj < 2; ++bj) {
                    const int hh = (u.pn & 3) * 2 + bj;
                    f32x4 v0 = acc[ai][bj][m][0], v1 = acc[ai][bj][m][1];
                    bf16_t* dst;
                    if (sec == 3) {
#pragma unroll
                        for (int i = 0; i < 4; ++i) { v0[i] = sigmoidf_fast(v0[i]); v1[i] = sigmoidf_fast(v1[i]); }
                        dst = sb + (size_t)tk * 1024 + hh * 128 + wc * 32 + 8 * fq;
                    } else {
                        v0 = v0 * sc; v1 = v1 * sc;
                        dst = sb + ((size_t)((b * 8 + hh) * 4096 + s)) * 128 + wc * 32 + 8 * fq;
                    }
                    u32x4 w; w.x = cvt_pk_bf16(v0[0], v0[1]); w.y = cvt_pk_bf16(v0[2], v0[3]); w.z = cvt_pk_bf16(v1[0], v1[1]); w.w = cvt_pk_bf16(v1[2], v1[3]);
                    *(u32x4*)dst = w;
                }
            }
    }
};
struct EpiOutProj {
    static constexpr bool PERM = true;
    const float* x; float* h; bf16_t* hb; float* ssq;
    __device__ __forceinline__ void operator()(const f32x4 (&acc)[2][2][4][2], const Unit& u, int wr, int wc, int fr, int fq) const {
#pragma unroll
        for (int ai = 0; ai < 2; ++ai)
#pragma unroll
            for (int m = 0; m < 4; ++m) {
                const int tk = u.pm * BM + ai * HALF + wr * 64 + m * 16 + fr;
                float ss = 0.f;
#pragma unroll
                for (int bj = 0; bj < 2; ++bj) {
                    const size_t off = (size_t)tk * DM + u.pn * BM + bj * HALF + wc * 32 + 8 * fq;
                    const f32x4 x0 = *(const f32x4*)(x + off), x1 = *(const f32x4*)(x + off + 4);
                    const f32x4 v0 = acc[ai][bj][m][0] + x0, v1 = acc[ai][bj][m][1] + x1;
                    *(f32x4*)(h + off) = v0; *(f32x4*)(h + off + 4) = v1;
                    u32x4 w; w.x = cvt_pk_bf16(v0[0], v0[1]); w.y = cvt_pk_bf16(v0[2], v0[3]); w.z = cvt_pk_bf16(v1[0], v1[1]); w.w = cvt_pk_bf16(v1[2], v1[3]);
                    *(u32x4*)(hb + off) = w;
                    ss += v0[0] * v0[0] + v0[1] * v0[1] + v0[2] * v0[2] + v0[3] * v0[3] + v1[0] * v1[0] + v1[1] * v1[1] + v1[2] * v1[2] + v1[3] * v1[3];
                }
                ss += __shfl_xor(ss, 16); ss += __shfl_xor(ss, 32);
                if (fq == 0) ssq[(size_t)tk * 32 + u.pn * 4 + wc] = ss;
            }
    }
};
struct EpiPeerQ {
    static constexpr bool PERM = true;
    const float* ssq; bf16_t* qp; float* rtab;
    __device__ __forceinline__ void operator()(const f32x4 (&acc)[2][2][4][2], const Unit& u, int wr, int wc, int fr, int fq) const {
#pragma unroll
        for (int ai = 0; ai < 2; ++ai)
#pragma unroll
            for (int m = 0; m < 4; ++m) {
                const int tk = u.pm * BM + ai * HALF + wr * 64 + m * 16 + fr;
                float tot = 0.f;
#pragma unroll
                for (int i = 0; i < 8; ++i) { const f32x4 s4 = *(const f32x4*)(ssq + (size_t)tk * 32 + 4 * i); tot += (s4[0] + s4[1]) + (s4[2] + s4[3]); }
                const float r = 1.0f / sqrtf(tot * (1.f / DM) + EPS);
                if (u.pn == 0 && wc == 0 && fq == 0) rtab[tk] = r;
#pragma unroll
                for (int bj = 0; bj < 2; ++bj) {
                    const size_t off = (size_t)tk * DM + u.pn * BM + bj * HALF + wc * 32 + 8 * fq;
                    const f32x4 v0 = acc[ai][bj][m][0] * r, v1 = acc[ai][bj][m][1] * r;
                    u32x4 w; w.x = cvt_pk_bf16(v0[0], v0[1]); w.y = cvt_pk_bf16(v0[2], v0[3]); w.z = cvt_pk_bf16(v1[0], v1[1]); w.w = cvt_pk_bf16(v1[2], v1[3]);
                    *(u32x4*)(qp + off) = w;
                }
            }
    }
};
}

namespace att {
constexpr int NW = 8, QBLK = 32, KVBLK = 64, QB = NW * QBLK, D = 128;
constexpr int SHM_V = KVBLK * D * 2, SHM_K = KVBLK * D * 2;
constexpr int OFF_WS = 2 * SHM_V + 2 * SHM_K, OFF_BIAS = OFF_WS + NW * 64 * 4, ATT_LDS = OFF_BIAS + SEQ * 4;
#define KSWZ(row, colB) ((row) * 256 + ((colB) ^ (((row) & 7) << 4)))
#define SBAR() __builtin_amdgcn_sched_barrier(0)
__device__ __forceinline__ int v_st(int k, int c) { const int kk = (k & ~0xC) | ((k & 4) << 1) | ((k & 8) >> 1); return ((kk >> 3) * 4 + (c >> 5)) * 512 + ((kk & 7) * 32 + (c & 31)) * 2; }
__device__ __forceinline__ int v_rd_base(int lane) { return ((lane & 3) << 3) | (((lane >> 2) & 3) << 6) | (((lane >> 4) & 1) << 5) | (((lane >> 5) & 1) << 8); }
constexpr int v_rd_off(int d0, int ks, int half) { return d0 * 512 + ks * 4096 + half * 2048; }
__device__ __forceinline__ int crow(int r, int hi) { return (r & 3) + 8 * (r >> 2) + 4 * hi; }
__device__ __forceinline__ bf16x8 load8(const bf16_t* p) { return *reinterpret_cast<const bf16x8*>(p); }
__device__ __forceinline__ void mask_tile(f32x16& p0, f32x16& p1, int dq) {
    const float NEG = -__builtin_inff();
#pragma unroll
    for (int r = 0; r < 16; ++r) {
        const int c = (r & 3) + 8 * (r >> 2);
        if (dq - c < 0) p0[r] = NEG;
        if (dq - c - 32 < 0) p1[r] = NEG;
    }
}
__device__ __forceinline__ void partialSM(f32x16& p0, f32x16& p1, float& m_reg, float& mn, float& alpha) {
    float pmax = p0[0];
#pragma unroll
    for (int r = 1; r < 16; ++r) pmax = fmaxf(pmax, p0[r]);
#pragma unroll
    for (int r = 0; r < 16; ++r) pmax = fmaxf(pmax, p1[r]);
    { auto rr = __builtin_amdgcn_permlane32_swap(__float_as_uint(pmax), __float_as_uint(pmax), false, false);
      pmax = fmaxf(__uint_as_float(rr[0]), __uint_as_float(rr[1])); }
    constexpr float C2 = LOG2E * SCALE; constexpr float THR = 8.f;
    if (__builtin_expect(__all((pmax - m_reg) * SCALE <= THR), 1)) { mn = m_reg; alpha = 1.f; }
    else { mn = fmaxf(m_reg, pmax); alpha = __builtin_amdgcn_exp2f((m_reg - mn) * C2); m_reg = mn; }
    const float mnL = -mn * C2;
#pragma unroll
    for (int r = 0; r < 16; ++r) p0[r] = fmaf(p0[r], C2, mnL);
#pragma unroll
    for (int r = 0; r < 16; ++r) p1[r] = fmaf(p1[r], C2, mnL);
#pragma unroll
    for (int r = 0; r < 16; ++r) p0[r] = __builtin_amdgcn_exp2f(p0[r]);
}
#define PK4(P, B_, OUT) do { unsigned a0 = cvt_pk_bf16(P[B_+0], P[B_+1]), a1 = cvt_pk_bf16(P[B_+2], P[B_+3]);                          \
        unsigned b0 = cvt_pk_bf16(P[B_+4], P[B_+5]), b1 = cvt_pk_bf16(P[B_+6], P[B_+7]);                                             \
        auto r0 = __builtin_amdgcn_permlane32_swap(a0, b0, false, false); auto r1 = __builtin_amdgcn_permlane32_swap(a1, b1, false, false); \
        u32x4 w = {r0[0], r1[0], r0[1], r1[1]}; OUT = *reinterpret_cast<bf16x8*>(&w); } while (0)
__device__ __forceinline__ void finishSM(f32x16& p0, f32x16& p1, float alpha, float& l_reg, bf16x8& pa0, bf16x8& pa1, bf16x8& pa2, bf16x8& pa3) {
#pragma unroll
    for (int r = 0; r < 16; ++r) p1[r] = __builtin_amdgcn_exp2f(p1[r]);
    float ps = 0;
#pragma unroll
    for (int r = 0; r < 16; ++r) ps += p0[r];
#pragma unroll
    for (int r = 0; r < 16; ++r) ps += p1[r];
    { auto rr = __builtin_amdgcn_permlane32_swap(__float_as_uint(ps), __float_as_uint(ps), false, false);
      ps = __uint_as_float(rr[0]) + __uint_as_float(rr[1]); }
    l_reg = l_reg * alpha + ps;
    PK4(p0, 0, pa0); PK4(p0, 8, pa1); PK4(p1, 0, pa2); PK4(p1, 8, pa3);
}
__device__ __forceinline__ void sb_group(f32x16& P, int g, float& gs) {
    float run = 0.f;
#pragma unroll
    for (int k = 3; k >= 0; --k) {
        const float z = P[4 * g + k];
        const float t = __builtin_amdgcn_exp2f(-fabsf(z));
        const float l = __builtin_amdgcn_logf(1.f + t);
        const float sp = fmaxf(z, 0.f) + l;
        P[4 * g + k] = (z - sp) - run;
        run += sp;
    }
    gs = run;
}
__device__ __forceinline__ void sb_part1(f32x16& p0, f32x16& p1, float& carry, float mlo) {
    float gs[8];
#pragma unroll
    for (int g = 0; g < 4; ++g) sb_group(p0, g, gs[g]);
#pragma unroll
    for (int g = 0; g < 4; ++g) sb_group(p1, g, gs[4 + g]);
    float run = carry;
#pragma unroll
    for (int G = 7; G >= 0; --G) {
        auto rr = __builtin_amdgcn_permlane32_swap(__float_as_uint(gs[G]), __float_as_uint(gs[G]), false, false);
        const float slo = __uint_as_float(rr[0]), shi = __uint_as_float(rr[1]);
        const float base = fmaf(mlo, shi, run);
        if (G >= 4) {
#pragma unroll
            for (int k = 0; k < 4; ++k) p1[4 * (G - 4) + k] -= base;
        } else {
#pragma unroll
            for (int k = 0; k < 4; ++k) p0[4 * G + k] -= base;
        }
        run += slo + shi;
    }
    carry = run;
#pragma unroll
    for (int r = 0; r < 16; ++r) p0[r] = __builtin_amdgcn_exp2f(p0[r]);
}
__device__ __forceinline__ void sb_part2(f32x16& p0, f32x16& p1, bf16x8& pa0, bf16x8& pa1, bf16x8& pa2, bf16x8& pa3) {
#pragma unroll
    for (int r = 0; r < 16; ++r) p1[r] = __builtin_amdgcn_exp2f(p1[r]);
    PK4(p0, 0, pa0); PK4(p0, 8, pa1); PK4(p1, 0, pa2); PK4(p1, 8, pa3);
}
#undef PK4
template <int KB, bool BIAS>
__device__ __forceinline__ void qkt(f32x16& p0, f32x16& p1, const char* K_lds, int r32, int hi, const bf16x8* qr, const float* bt) {
    if constexpr (BIAS) {
#pragma unroll
        for (int g = 0; g < 4; ++g) { const f32x4 a = *(const f32x4*)(bt + 8 * g), b = *(const f32x4*)(bt + 32 + 8 * g);
            p0[4 * g] = a[0]; p0[4 * g + 1] = a[1]; p0[4 * g + 2] = a[2]; p0[4 * g + 3] = a[3];
            p1[4 * g] = b[0]; p1[4 * g + 1] = b[1]; p1[4 * g + 2] = b[2]; p1[4 * g + 3] = b[3]; }
    } else { p0 = f32x16{}; p1 = f32x16{}; }
    const char* kb[4];
#pragma unroll
    for (int dd = 0; dd < 4; ++dd) kb[dd] = K_lds + KB * SHM_K + KSWZ(r32, (dd * 16 + hi * 8) * 2);
#pragma unroll
    for (int d0 = 0; d0 < 8; ++d0) { const char* a = kb[d0 & 3] + (d0 >> 2) * 128;
        bf16x8 b0 = *reinterpret_cast<const bf16x8*>(a);
        bf16x8 b1 = *reinterpret_cast<const bf16x8*>(a + 32 * 256);
        p0 = __builtin_amdgcn_mfma_f32_32x32x16_bf16(b0, qr[d0], p0, 0, 0, 0);
        p1 = __builtin_amdgcn_mfma_f32_32x32x16_bf16(b1, qr[d0], p1, 0, 0, 0); }
}
template <int VB>
__device__ __forceinline__ void pv_tile(f32x16* o, int vb0, bf16x8 pa0, bf16x8 pa1, bf16x8 pa2, bf16x8 pa3) {
#define TRRD(dst, off) asm volatile("ds_read_b64_tr_b16 %0, %1 offset:%2" : "=&v"(dst) : "v"(vb0), "i"(off) : "memory")
#define PV_D0(d0) do { { s16x4 l0, l1, h0, h1; constexpr int b_ = VB * SHM_V + v_rd_off(d0, 0, 0); \
        TRRD(l0, b_); TRRD(h0, b_ + 2048); TRRD(l1, b_ + 4096); TRRD(h1, b_ + 6144); \
        asm volatile("s_waitcnt lgkmcnt(0)" ::: "memory"); SBAR();   \
        o[d0] = __builtin_amdgcn_mfma_f32_32x32x16_bf16(pa0, (bf16x8){l0[0], l0[1], l0[2], l0[3], h0[0], h0[1], h0[2], h0[3]}, o[d0], 0, 0, 0);   \
        o[d0] = __builtin_amdgcn_mfma_f32_32x32x16_bf16(pa1, (bf16x8){l1[0], l1[1], l1[2], l1[3], h1[0], h1[1], h1[2], h1[3]}, o[d0], 0, 0, 0); }  \
      { s16x4 l2, l3, h2, h3; constexpr int b_ = VB * SHM_V + v_rd_off(d0, 0, 0); \
        TRRD(l2, b_ + 8192); TRRD(h2, b_ + 10240); TRRD(l3, b_ + 12288); TRRD(h3, b_ + 14336); \
        asm volatile("s_waitcnt lgkmcnt(0)" ::: "memory"); SBAR();   \
        o[d0] = __builtin_amdgcn_mfma_f32_32x32x16_bf16(pa2, (bf16x8){l2[0], l2[1], l2[2], l2[3], h2[0], h2[1], h2[2], h2[3]}, o[d0], 0, 0, 0);   \
        o[d0] = __builtin_amdgcn_mfma_f32_32x32x16_bf16(pa3, (bf16x8){l3[0], l3[1], l3[2], l3[3], h3[0], h3[1], h3[2], h3[3]}, o[d0], 0, 0, 0); } } while (0)
    PV_D0(0); PV_D0(1); PV_D0(2); PV_D0(3);
#undef PV_D0
#undef TRRD
}

struct UnitRef { const bf16_t* Q; const bf16_t* K; const bf16_t* V; int P0; };
struct Seam { bf16x8 qr[8]; bf16x8 st_v0, st_v1, st_k0, st_k1; };
#define ROW(p, k0, rr) ((p) + (size_t)((k0) + (rr)) * D + sc)
#define VMW() asm volatile("s_waitcnt vmcnt(0)" ::: "memory")
#define SLOAD_H(Kp, Vp, k0) do { S.st_v0 = load8(ROW(Vp, k0, sr)); S.st_v1 = load8(ROW(Vp, k0, 32 + sr));              \
                         S.st_k0 = load8(ROW(Kp, k0, sr)); S.st_k1 = load8(ROW(Kp, k0, 32 + sr)); } while (0)
#define SWRITE_HK(bf) do { *(bf16x8*)(K_lds + (bf) * SHM_K + kws) = S.st_k0; *(bf16x8*)(K_lds + (bf) * SHM_K + kws + 32 * 256) = S.st_k1; } while (0)
#define SWRITE_HV(bf) do { *(bf16x8*)(V_lds + (bf) * SHM_V + vst0) = S.st_v0; *(bf16x8*)(V_lds + (bf) * SHM_V + vst1) = S.st_v1; } while (0)
#define SWRITE_H(bf) do { SWRITE_HV(bf); SWRITE_HK(bf); } while (0)

template <bool SB>
__device__ __forceinline__ void attn_unit(const UnitRef& cur, const float* cvec  , const float* gqk  , const bf16_t* gate  ,
                                          bf16_t* outp  , char* lds) {
    const int tid = tid_opaque(), wid = __builtin_amdgcn_readfirstlane(tid >> 6), lane = tid & 63, r32 = lane & 31, hi = lane >> 5;
    int jlo = 0;
    if constexpr (!SB) {
        const float gq = fmaxf(fabsf(gqk[lane]), fabsf(gqk[64 + lane])), gk = fmaxf(fabsf(gqk[128 + lane]), fabsf(gqk[192 + lane]));
        const float lmax = 11.3137085f * 1.02f * wave_max(gq) * wave_max(gk);
        const int ntf = (cur.P0 + QB) / KVBLK;
        const float cend = (lane < ntf) ? cvec[lane * KVBLK + KVBLK - 1] : 0.f;
        const bool skip = (lane < ntf) && (2.f * lmax + cvec[cur.P0] - cend < -104.f);
        jlo = __builtin_amdgcn_readfirstlane((int)__popcll(__ballot(skip)));
    }
    const int kshift = jlo * KVBLK, P0r = cur.P0 - kshift;
    const int NT = (P0r + QB) / KVBLK;
#define KBASE(t) ((SB ? (NT - 1 - (t)) : (t)) * KVBLK)
    const int qlo = P0r + wid * QBLK, qm = qlo + r32 - 4 * hi - (SB ? 1 : 0);
    char* V_lds = lds; char* K_lds = lds + 2 * SHM_V;
    float* ws = (float*)(lds + OFF_WS) + wid * 64; float* li_l = ws, * al_l = ws + 32;
    float* bias = (float*)(lds + OFF_BIAS);
    const int sr = tid >> 4, sc = (tid & 15) * 8, vst0 = v_st(sr, sc), vst1 = v_st(32 + sr, sc), kws = KSWZ(sr, sc * 2);
    const int vb0 = (int)(uintptr_t)V_lds + v_rd_base(lane);
    const bf16_t* Kh = cur.K + (size_t)kshift * D; const bf16_t* Vh = cur.V + (size_t)kshift * D;
    Seam S;
    if constexpr (!SB) { const float cq0 = cvec[cur.P0]; const float* cv = cvec + kshift; for (int j = tid; j < P0r + QB; j += NTHREADS) bias[j] = (cq0 - cv[j]) * (1.f / SCALE); }
#pragma unroll
    for (int d0 = 0; d0 < 8; ++d0) S.qr[d0] = load8(cur.Q + (size_t)(wid * QBLK + r32) * D + d0 * 16 + hi * 8);
    SLOAD_H(Kh, Vh, KBASE(0)); VMW(); SWRITE_HK(0);
    __syncthreads();
    float m_reg = -1e30f, l_reg = 0; f32x16 o[4] = {};
    float carry = 0.f; const float mlo = hi ? 0.f : 1.f;
#define RESC(a) do { if (__any((a) < 1.f)) { if (hi == 0) al_l[r32] = (a); asm volatile("s_waitcnt lgkmcnt(0)" ::: "memory");              \
                     for (int d_ = 0; d_ < 4; ++d_) for (int r = 0; r < 16; ++r) o[d_][r] *= al_l[crow(r, hi)]; } } while (0)
#define MASKT(P0_, P1_, t) do { const int kb_ = KBASE(t); if (kb_ + KVBLK - 1 > qlo - (SB ? 1 : 0)) mask_tile(P0_, P1_, qm - kb_); } while (0)
#define BT(t) (bias + KBASE(t) + 4 * hi)
#define PART1(PX0, PX1, mnX, alX) do { if constexpr (SB) sb_part1(PX0, PX1, carry, mlo); else partialSM(PX0, PX1, m_reg, mnX, alX); } while (0)
#define PART2(PY0, PY1, alY) do { if constexpr (SB) sb_part2(PY0, PY1, pa0, pa1, pa2, pa3); else finishSM(PY0, PY1, alY, l_reg, pa0, pa1, pa2, pa3); } while (0)
    f32x16 pA0, pA1, pB0, pB1; float mnA = 0.f, mnB = 0.f, alA = 1.f, alB = 1.f; bf16x8 pa0, pa1, pa2, pa3;
    SWRITE_HV(0); SBAR();
    if (NT > 1) SLOAD_H(Kh, Vh, KBASE(1));
    SBAR(); qkt<0, !SB>(pA0, pA1, K_lds, r32, hi, S.qr, BT(0));
    MASKT(pA0, pA1, 0); PART1(pA0, pA1, mnA, alA);
    if (NT > 1) { VMW(); SWRITE_H(1); }
    __syncthreads();
#define HALF_STEP(PX0, PX1, mnX, alX, PY0, PY1, alY, t, KB, VB, SBUF) do {                                                    \
        SBAR(); qkt<KB, !SB>(PX0, PX1, K_lds, r32, hi, S.qr, BT(t));                                                          \
        PART2(PY0, PY1, alY); SBAR();                                                                                          \
        if ((t) + 1 < NT) { SLOAD_H(Kh, Vh, KBASE((t) + 1)); SBAR(); }                                                         \
        pv_tile<VB>(o, vb0, pa0, pa1, pa2, pa3); MASKT(PX0, PX1, (t)); PART1(PX0, PX1, mnX, alX);                              \
        __syncthreads();                                                                                                      \
        if ((t) + 1 < NT) { VMW(); SWRITE_H(SBUF); }                                                                           \
        if constexpr (!SB) RESC(alX);                                                                                          \
        __syncthreads(); } while (0)
    for (int t = 1; t + 1 < NT; t += 2) {
        HALF_STEP(pB0, pB1, mnB, alB, pA0, pA1, alA, t, 1, 0, 0);
        HALF_STEP(pA0, pA1, mnA, alA, pB0, pB1, alB, t + 1, 0, 1, 1);
    }
    const bool even = (NT & 1) == 0;
    if (even) { SBAR(); qkt<1, !SB>(pB0, pB1, K_lds, r32, hi, S.qr, BT(NT - 1)); SBAR(); }
    PART2(pA0, pA1, alA); SBAR();
    pv_tile<0>(o, vb0, pa0, pa1, pa2, pa3);
    if (even) { MASKT(pB0, pB1, NT - 1); PART1(pB0, pB1, mnB, alB); __syncthreads(); if constexpr (!SB) RESC(alB);
        PART2(pB0, pB1, alB); SBAR(); pv_tile<1>(o, vb0, pa0, pa1, pa2, pa3); }
    float rli[16];
    if constexpr (!SB) {
        if (hi == 0) li_l[r32] = l_reg; asm volatile("s_waitcnt lgkmcnt(0)" ::: "memory");
#pragma unroll
        for (int r = 0; r < 16; ++r) rli[r] = __builtin_amdgcn_rcpf(li_l[crow(r, hi)]);
    }
#pragma unroll
    for (int r = 0; r < 16; ++r) { const int orow = cur.P0 + wid * QBLK + crow(r, hi);
#pragma unroll
        for (int d0 = 0; d0 < 4; ++d0) {
            float v = o[d0][r];
            if constexpr (!SB) { const unsigned short gb = gate[(size_t)orow * 1024 + d0 * 32 + r32]; v = v * rli[r] * __builtin_bit_cast(float, (unsigned)gb << 16); }
            const float vn = __shfl_xor(v, 1);
            if ((r32 & 1) == 0) *(unsigned*)(outp + (size_t)orow * DM + d0 * 32 + r32) = cvt_pk_bf16(v, vn); } }
    __syncthreads();
#undef RESC
#undef KBASE
#undef MASKT
#undef BT
#undef PART1
#undef PART2
#undef HALF_STEP
}

constexpr float SB_TH = 150.f;
__device__ __forceinline__ void sb_unit(const UnitRef& cur, bf16_t* outp, char* lds) {
    const int tid = tid_opaque(), wid = __builtin_amdgcn_readfirstlane(tid >> 6), lane = tid & 63, r32 = lane & 31, hi = lane >> 5;
    const int NT = (cur.P0 + QB) / KVBLK;
#define KBASE(t) ((NT - 1 - (t)) * KVBLK)
    const int qlo = cur.P0 + wid * QBLK, qm = qlo + r32 - 4 * hi - 1;
    char* V_lds = lds; char* K_lds = lds + 2 * SHM_V;
    volatile int* flags = (volatile int*)(lds + OFF_WS);
    const int sr = tid >> 4, sc = (tid & 15) * 8, vst0 = v_st(sr, sc), vst1 = v_st(32 + sr, sc), kws = KSWZ(sr, sc * 2);
    const int vb0 = (int)(uintptr_t)V_lds + v_rd_base(lane);
    const bf16_t* Kh = cur.K; const bf16_t* Vh = cur.V;
    Seam S;
#pragma unroll
    for (int d0 = 0; d0 < 8; ++d0) S.qr[d0] = load8(cur.Q + (size_t)(wid * QBLK + r32) * D + d0 * 16 + hi * 8);
    SLOAD_H(Kh, Vh, KBASE(0)); VMW(); SWRITE_H(0);
    __syncthreads();
    f32x16 o[4] = {}; float carry = 0.f; const float mlo = hi ? 0.f : 1.f;
    bool wdone = false;
#define SB_STEP(tt, BUF) {                                                                                                 \
        const int kb_ = KBASE(tt);                                                                                           \
        if ((tt) + 1 < NT) SLOAD_H(Kh, Vh, KBASE((tt) + 1));                                                                 \
        SBAR();                                                                                                              \
        if (!wdone && kb_ <= qlo + QBLK - 2) {                                                                               \
            f32x16 p0, p1; bf16x8 pa0, pa1, pa2, pa3;                                                                        \
            qkt<BUF, false>(p0, p1, K_lds, r32, hi, S.qr, nullptr);                                                          \
            if (kb_ + KVBLK - 1 > qlo - 1) mask_tile(p0, p1, qm - kb_);                                                      \
            sb_part1(p0, p1, carry, mlo); sb_part2(p0, p1, pa0, pa1, pa2, pa3); SBAR();                                      \
            pv_tile<BUF>(o, vb0, pa0, pa1, pa2, pa3);                                                                        \
            wdone = __all(carry >= SB_TH);                                                                                   \
        }                                                                                                                    \
        if ((tt) + 1 < NT) { VMW(); SWRITE_H((BUF) ^ 1); }                                                                   \
        if (lane == 0) flags[((tt) & 1) * 8 + wid] = wdone ? 1 : 0;                                                          \
        __syncthreads();                                                                                                     \
        { int alld = 1;                                                                                                      \
          _Pragma("unroll") for (int w_ = 0; w_ < 8; ++w_) alld &= flags[((tt) & 1) * 8 + w_];                                \
          if (alld) break; } }
    for (int t = 0; t < NT; t += 2) {
        SB_STEP(t, 0)
        SB_STEP(t + 1, 1)
    }
#undef SB_STEP
#pragma unroll
    for (int r = 0; r < 16; ++r) { const int orow = cur.P0 + wid * QBLK + crow(r, hi);
#pragma unroll
        for (int d0 = 0; d0 < 4; ++d0) {
            const float v = o[d0][r];
            const float vn = __shfl_xor(v, 1);
            if ((r32 & 1) == 0) *(unsigned*)(outp + (size_t)orow * DM + d0 * 32 + r32) = cvt_pk_bf16(v, vn); } }
    __syncthreads();
#undef KBASE
}
#undef ROW
#undef VMW
#undef SLOAD_H
#undef SWRITE_HK
#undef SWRITE_HV
#undef SWRITE_H
}

struct Args { const float* in[12]; float* out; unsigned char* ws; int ph_lo, ph_hi; };

__device__ __forceinline__ void p0_transpose_item(const float* W, int ldw, int K, bf16_t* WT, int nblk, LAS float* scr, int item, int lane, const float* gk) {
    const int kb = item / nblk, nb = item % nblk, k0 = 64 * kb, n0 = 32 * nb;
#pragma unroll 8
    for (int i = 0; i < 32; ++i) { const int kk = 2 * i + (lane >> 5); float w = W[(size_t)(k0 + kk) * ldw + n0 + (lane & 31)]; if (gk) w *= gk[k0 + kk]; scr[kk * 33 + (lane & 31)] = w; }
    LDS_WAIT(); asm volatile("" ::: "memory");
    const int c = lane & 7;
#pragma unroll
    for (int j = 0; j < 4; ++j) { const int n = (lane >> 3) + 8 * j; const LAS float* s = scr + (8 * c) * 33 + n;
        u32x4 o; o.x = cvt_pk_bf16(s[0 * 33], s[1 * 33]); o.y = cvt_pk_bf16(s[2 * 33], s[3 * 33]); o.z = cvt_pk_bf16(s[4 * 33], s[5 * 33]); o.w = cvt_pk_bf16(s[6 * 33], s[7 * 33]);
        *(u32x4*)(WT + (size_t)(n0 + n) * K + k0 + 8 * c) = o; }
    LDS_WAIT(); asm volatile("" ::: "memory");
}

__device__ __forceinline__ void convert_tables(const Args& a, int r0, int r1, int worker, int nworkers) {
    const int lane = tid_opaque() & 63;
    unsigned char* ws = a.ws; const float* g_ffn = a.in[7]; const float* pu = a.in[10]; const float* pv = a.in[11];
    float* suv = (float*)(ws + WS_SUV);
    for (int r = r0 + worker; r < r1; r += nworkers) {
        const bool isv = r >= NEXP; const int e = isv ? r - NEXP : r;
        const f32x4* srcp = (const f32x4*)((isv ? pv : pu) + (size_t)e * DM);
        f32x4 v[8]; float amax = 0.f;
#pragma unroll
        for (int j = 0; j < 8; ++j) { v[j] = srcp[lane + 64 * j];
            if (!isv) { const f32x4 g4 = *(const f32x4*)(g_ffn + 4 * (lane + 64 * j)); v[j] = v[j] * g4; }
            amax = fmaxf(amax, fmaxf(fmaxf(fabsf(v[j][0]), fabsf(v[j][1])), fmaxf(fabsf(v[j][2]), fabsf(v[j][3])))); }
        amax = wave_max(amax);
        const float sc = amax > 0.f ? 440.f / amax : 1.f;
        unsigned char* dst = ws + (isv ? WS_V8 : WS_U8) + (size_t)e * 128;
#pragma unroll
        for (int j = 0; j < 8; ++j) { int p = __builtin_amdgcn_cvt_pk_fp8_f32(v[j][0] * sc, v[j][1] * sc, 0, false); p = __builtin_amdgcn_cvt_pk_fp8_f32(v[j][2] * sc, v[j][3] * sc, p, true);
            const int col = 4 * (lane + 64 * j);
            *(unsigned*)(dst + (size_t)(col >> 7) * ((size_t)NEXP * 128) + (col & 127)) = (unsigned)p; }
        if (lane == 0) suv[r] = 1.f / sc;
    }
}
constexpr int TAB_SPLIT = NEXP;

__device__ __forceinline__ float log_sigmoid_f(float x) { return fminf(x, 0.f) - log1pf(expf(-fabsf(x))); }

__device__ __forceinline__ void phase0(const Args& a, unsigned char* lds_g) {
    LAS unsigned char* lds = (LAS unsigned char*)lds_g;
    const int tid = tid_opaque(), lane = tid & 63, wave = __builtin_amdgcn_readfirstlane(tid >> 6);
    const int gw = blockIdx.x * NWAVES + wave, NGW = gridDim.x * NWAVES;
    const int gt = blockIdx.x * NTHREADS + tid, NGT = gridDim.x * NTHREADS;
    unsigned char* ws = a.ws;
    const float* x = a.in[0]; const float* g_attn = a.in[1]; const float* w_in = a.in[2]; const float* b_forget = a.in[3];
    const float* w_out = a.in[6]; const float* g_ffn = a.in[7]; const float* w_pq = a.in[8]; const float* sk = a.in[9]; const float* pu = a.in[10]; const float* pv = a.in[11];
    LAS float* wf = (LAS float*)(lds + 67584);
    for (int k = tid; k < DM; k += NTHREADS) { const f32x4 a0 = *(const f32x4*)(w_in + (size_t)k * DIN + NPROJ), a1 = *(const f32x4*)(w_in + (size_t)k * DIN + NPROJ + 4);
        *(LAS f32x4*)(wf + k * 8) = a0; *(LAS f32x4*)(wf + k * 8 + 4) = a1; }
    __syncthreads();
    for (int row = gw; row < T; row += NGW) {
        const f32x4* xr = (const f32x4*)(x + (size_t)row * DM);
        f32x4 v[8]; float ss = 0.f;
#pragma unroll
        for (int j = 0; j < 8; ++j) { v[j] = xr[lane + 64 * j]; ss += v[j][0] * v[j][0] + v[j][1] * v[j][1] + v[j][2] * v[j][2] + v[j][3] * v[j][3]; }
        const float r = 1.0f / sqrtf(wave_sum(ss) * (1.f / DM) + EPS);
        float f[8] = {0.f, 0.f, 0.f, 0.f, 0.f, 0.f, 0.f, 0.f};
        u32x2* o8 = (u32x2*)(ws + WS_XN + (size_t)row * DM * 2);
#pragma unroll
        for (int j = 0; j < 8; ++j) {
            const int e = 4 * (lane + 64 * j);
            const f32x4 g4 = *(const f32x4*)(g_attn + e);
            f32x4 xn; xn[0] = v[j][0] * r * g4[0]; xn[1] = v[j][1] * r * g4[1]; xn[2] = v[j][2] * r * g4[2]; xn[3] = v[j][3] * r * g4[3];
            u32x2 w; w.x = cvt_pk_bf16(xn[0], xn[1]); w.y = cvt_pk_bf16(xn[2], xn[3]); o8[lane + 64 * j] = w;
#pragma unroll
            for (int q = 0; q < 4; ++q) { const f32x4 w0 = *(LAS f32x4*)(wf + (e + q) * 8), w1 = *(LAS f32x4*)(wf + (e + q) * 8 + 4);
                f[0] += xn[q] * w0[0]; f[1] += xn[q] * w0[1]; f[2] += xn[q] * w0[2]; f[3] += xn[q] * w0[3];
                f[4] += xn[q] * w1[0]; f[5] += xn[q] * w1[1]; f[6] += xn[q] * w1[2]; f[7] += xn[q] * w1[3]; }
        }
#pragma unroll
        for (int hh = 0; hh < 8; ++hh) f[hh] = wave_sum(f[hh]);
        if (lane < 8) { float fl = f[0];
#pragma unroll
            for (int hh = 1; hh < 8; ++hh) fl = (lane == hh) ? f[hh] : fl;
            const int b = row >> 12, s = row & 4095;
            ((float*)(ws + WS_LOGF))[(size_t)(b * 8 + lane) * SEQ + s] = log_sigmoid_f(fl + b_forget[lane]); }
    }
    LAS float* scr = (LAS float*)(lds + wave * 8448);
    constexpr int I_IN = (DM / 64) * (NPROJ / 32), I_O = (DM / 64) * (DM / 32);
    for (int it = gw; it < I_IN + 2 * I_O; it += NGW) {
        int r = it;
        if (r < I_IN) { p0_transpose_item(w_in, DIN, DM, (bf16_t*)(ws + WS_WIN), NPROJ / 32, scr, r, lane, nullptr); continue; } r -= I_IN;
        if (r < I_O) { p0_transpose_item(w_out, DM, DM, (bf16_t*)(ws + WS_WOUT), DM / 32, scr, r, lane, nullptr); continue; } r -= I_O;
        p0_transpose_item(w_pq, DM, DM, (bf16_t*)(ws + WS_WPQ), DM / 32, scr, r, lane, g_ffn);
    }
    for (int i = gt; i < 8 * 2 * 128 * 128 / 8; i += NGT) { const f32x4 a0 = *(const f32x4*)(sk + (size_t)i * 8), a1 = *(const f32x4*)(sk + (size_t)i * 8 + 4);
        u32x4 w; w.x = cvt_pk_bf16(a0[0], a0[1]); w.y = cvt_pk_bf16(a0[2], a0[3]); w.z = cvt_pk_bf16(a1[0], a1[1]); w.w = cvt_pk_bf16(a1[2], a1[3]);
        *(u32x4*)(ws + WS_SK + (size_t)i * 16) = w; }
    if (gt < 256) ((float*)(ws + WS_GQK))[gt] = gt < 128 ? a.in[4][gt] : a.in[5][gt - 128];
    convert_tables(a, 0, TAB_SPLIT, gw, NGW);
}

__device__ __forceinline__ void cumsum_rows(const Args& a) {
    const int tid = tid_opaque(), lane = tid & 63, wave = tid >> 6;
    if (blockIdx.x >= 16 || wave != 0) return;
    const float* src = (const float*)(a.ws + WS_LOGF) + (size_t)blockIdx.x * SEQ + lane * 64;
    float* dst = (float*)(a.ws + WS_C) + (size_t)blockIdx.x * SEQ + lane * 64;
    f32x4 v[16]; float run = 0.f;
#pragma unroll
    for (int i = 0; i < 16; ++i) { v[i] = *(const f32x4*)(src + 4 * i);
#pragma unroll
        for (int q = 0; q < 4; ++q) { run += v[i][q]; v[i][q] = run; } }
    float incl = run;
#pragma unroll
    for (int o = 1; o < 64; o <<= 1) { const float t = __shfl_up(incl, o); if (lane >= o) incl += t; }
    const float off = incl - run;
#pragma unroll
    for (int i = 0; i < 16; ++i) { f32x4 w = v[i]; w[0] += off; w[1] += off; w[2] += off; w[3] += off; *(f32x4*)(dst + 4 * i) = w; }
}

__device__ __forceinline__ void phase_qknorm(const Args& a) {
    const int tid = tid_opaque(), lane = tid & 63, wave = tid >> 6;
    const int gw = blockIdx.x * NWAVES + wave, NGW = gridDim.x * NWAVES;
    const int sub = lane & 15, rw = lane >> 4;
    const float* gq = a.in[4]; const float* gk = a.in[5];
    constexpr int ROWS = NB * NHF * SEQ;
    for (int it = gw; it < 2 * ROWS / 4; it += NGW) {
        const int row = it * 4 + rw; const bool isk = row >= ROWS;
        bf16_t* p = (bf16_t*)(a.ws + WS_SEC) + (size_t)row * HD + sub * 8;
        const float* g = (isk ? gk : gq) + sub * 8;
        const u32x4 w = *(const u32x4*)p;
        float v[8] = {bf_lo(w.x), bf_hi(w.x), bf_lo(w.y), bf_hi(w.y), bf_lo(w.z), bf_hi(w.z), bf_lo(w.w), bf_hi(w.w)};
        float ss = 0.f;
#pragma unroll
        for (int i = 0; i < 8; ++i) ss += v[i] * v[i];
        ss += __shfl_xor(ss, 1); ss += __shfl_xor(ss, 2); ss += __shfl_xor(ss, 4); ss += __shfl_xor(ss, 8);
        const float r = 1.0f / sqrtf(ss * (1.f / HD) + EPS);
        const f32x4 g0 = *(const f32x4*)g, g1 = *(const f32x4*)(g + 4);
        u32x4 o; o.x = cvt_pk_bf16(v[0] * r * g0[0], v[1] * r * g0[1]); o.y = cvt_pk_bf16(v[2] * r * g0[2], v[3] * r * g0[3]);
        o.z = cvt_pk_bf16(v[4] * r * g1[0], v[5] * r * g1[1]); o.w = cvt_pk_bf16(v[6] * r * g1[2], v[7] * r * g1[3]);
        *(u32x4*)p = o;
    }
}

__device__ __forceinline__ void phase_attn(const Args& a, unsigned char* lds_g) {
    const int tid = tid_opaque();
    volatile int* s_item = (volatile int*)(lds_g + MISC_OFF);
    unsigned* ctr = (unsigned*)(a.ws + WS_CTL);
    for (;;) {
        __syncthreads();
        if (tid == 0) *s_item = (int)atomicAdd(ctr, 1u);
        __syncthreads();
        const int it = *s_item;
        if (it >= 512) break;
        unsigned char* wsl = a.ws; asm volatile("" : "+s"(wsl));
        bf16_t* sec = (bf16_t*)(wsl + WS_SEC);
        const int qb = 15 - (it >> 5), kind = (it >> 4) & 1, bh = it & 15;
        const int b = bh >> 3, h = bh & 7;
        const size_t hoff = (size_t)bh * SEQ * HD;
        att::UnitRef u;
        u.P0 = qb * 256;
        if (kind == 0) {
            u.Q = sec + 4 * SEC_ELEMS + hoff + (size_t)u.P0 * HD; u.K = sec + 5 * SEC_ELEMS + hoff; u.V = sec + 6 * SEC_ELEMS + hoff;
            att::sb_unit(u, (bf16_t*)(wsl + WS_MIX) + (size_t)b * SEQ * DM + 1024 + h * HD, (char*)lds_g);
        } else {
            u.Q = sec + 0 * SEC_ELEMS + hoff + (size_t)u.P0 * HD; u.K = sec + 1 * SEC_ELEMS + hoff; u.V = sec + 2 * SEC_ELEMS + hoff;
            att::attn_unit<false>(u, (const float*)(wsl + WS_C) + (size_t)bh * SEQ, (const float*)(wsl + WS_GQK), sec + 3 * SEC_ELEMS + (size_t)b * SEQ * 1024 + h * HD,
                                  (bf16_t*)(wsl + WS_MIX) + (size_t)b * SEQ * DM + h * HD, (char*)lds_g);
        }
    }
}

__device__ __forceinline__ unsigned f2ord(float f) { const unsigned u = __float_as_uint(f); return u ^ ((unsigned)((int)u >> 31) | 0x80000000u); }
__device__ __forceinline__ float ord2f(unsigned k) { const unsigned u = k ^ (~(unsigned)((int)k >> 31) | 0x80000000u); return __uint_as_float(u); }
#define INS16(L, X) do { unsigned x_ = (X); _Pragma("unroll") for (int i_ = 0; i_ < 16; ++i_) { const unsigned hi_ = max(L[i_], x_); x_ = min(L[i_], x_); L[i_] = hi_; } } while (0)
__device__ __forceinline__ void topk_half(const bf16_t* qp, const bf16_t* skb, int t0, int h, int c, int r32, int hi, unsigned (&L)[16]) {
    bf16x8 qf[8];
#pragma unroll
    for (int d0 = 0; d0 < 8; ++d0) qf[d0] = *(const bf16x8*)(qp + (size_t)(t0 + r32) * DM + h * 256 + c * 128 + d0 * 16 + hi * 8);
#pragma unroll
    for (int i = 0; i < 16; ++i) L[i] = 0u;
    const unsigned hi4 = 4u * (unsigned)hi;
#pragma unroll
    for (int kt = 0; kt < 4; ++kt) {
        f32x16 acc = f32x16{};
#pragma unroll
        for (int d0 = 0; d0 < 8; ++d0) { const bf16x8 kf = *(const bf16x8*)(skb + (size_t)((h * 2 + c) * 128 + kt * 32 + r32) * 128 + d0 * 16 + hi * 8);
            acc = __builtin_amdgcn_mfma_f32_32x32x16_bf16(kf, qf[d0], acc, 0, 0, 0); }
        __builtin_amdgcn_sched_barrier(0);
#pragma unroll
        for (int r = 0; r < 16; ++r) { const unsigned cst = (unsigned)(127 - (kt * 32 + (r & 3) + 8 * (r >> 2)));
            const unsigned kk = (f2ord(acc[r]) & ~127u) | (cst - hi4); INS16(L, kk); }
        __builtin_amdgcn_sched_barrier(0);
    }
    unsigned P[16];
#pragma unroll
    for (int i = 0; i < 16; ++i) { auto rr = __builtin_amdgcn_permlane32_swap(L[i], L[i], false, false); P[i] = hi ? rr[0] : rr[1]; }
#pragma unroll
    for (int i = 0; i < 16; ++i) INS16(L, P[i]);
}
__device__ __forceinline__ void phase_topk(const Args& a, unsigned char* lds_g) {
    LAS unsigned char* lds = (LAS unsigned char*)lds_g;
    const int tid = tid_opaque(), lane = tid & 63, wave = tid >> 6, r32 = lane & 31, hi = lane >> 5;
    const int gw = blockIdx.x * NWAVES + wave, NGW = gridDim.x * NWAVES;
    const bf16_t* skb = (const bf16_t*)(a.ws + WS_SK); const bf16_t* qp = (const bf16_t*)(a.ws + WS_QP);
    int* idx_o = (int*)(a.ws + WS_IDX); float* gw_o = (float*)(a.ws + WS_GW);
    for (int task = gw; task < (T / 32) * 8; task += NGW) {
        const int h = task & 7, t0 = (task >> 3) * 32;
        unsigned L[2][16];
        topk_half(qp, skb, t0, h, 0, r32, hi, L[0]);
        __builtin_amdgcn_sched_barrier(0);
        topk_half(qp, skb, t0, h, 1, r32, hi, L[1]);
        __builtin_amdgcn_sched_barrier(0);
        float s1[16], s2[16]; int i1[16], i2[16];
#pragma unroll
        for (int i = 0; i < 16; ++i) { s1[i] = ord2f((L[0][i] & ~127u) | 64u); i1[i] = 127 - (int)(L[0][i] & 127u); s2[i] = ord2f((L[1][i] & ~127u) | 64u); i2[i] = 127 - (int)(L[1][i] & 127u); }
        unsigned LC[16];
#pragma unroll
        for (int i = 0; i < 16; ++i) LC[i] = 0u;
#pragma unroll
        for (int aa = 0; aa < 16; ++aa)
#pragma unroll
            for (int bb = 0; bb < 16; ++bb) if ((aa + 1) * (bb + 1) <= 16) { const unsigned kk = (f2ord(s1[aa] + s2[bb]) & ~255u) | (unsigned)(aa * 16 + bb); INS16(LC, kk); }
        LAS int* tb = (LAS int*)(lds + wave * 8192);
#pragma unroll
        for (int i = 0; i < 16; ++i) { tb[i * 64 + lane] = i1[i]; tb[(16 + i) * 64 + lane] = i2[i]; }
        float LS[16]; int LP[16];
#pragma unroll
        for (int i = 0; i < 16; ++i) { const unsigned cid = LC[i] & 255u; LS[i] = ord2f((LC[i] & ~255u) | 128u);
            LP[i] = tb[(cid >> 4) * 64 + lane] * 128 + tb[(16 + (cid & 15u)) * 64 + lane]; }
        float den = 0.f, e[16];
#pragma unroll
        for (int i = 0; i < 16; ++i) { e[i] = __expf(LS[i] - LS[0]); den += e[i]; }
        const float rden = 1.f / den;
        const size_t ob = (size_t)(t0 + r32) * NE + h * 16;
        if (hi == 0) {
#pragma unroll
            for (int i = 0; i < 4; ++i) *(int4*)(idx_o + ob + 4 * i) = make_int4(LP[4 * i], LP[4 * i + 1], LP[4 * i + 2], LP[4 * i + 3]);
        } else {
#pragma unroll
            for (int i = 0; i < 4; ++i) *(f32x4*)(gw_o + ob + 4 * i) = (f32x4){e[4 * i] * rden, e[4 * i + 1] * rden, e[4 * i + 2] * rden, e[4 * i + 3] * rden};
        }
    }
}


__device__ __forceinline__ void wave_argmax(float& v, int& i) {
#pragma unroll
    for (int o = 1; o < 64; o <<= 1) { const float ov = __shfl_xor(v, o); const int oi = __shfl_xor(i, o); if (ov > v || (ov == v && oi < i)) { v = ov; i = oi; } }
}
__device__ __forceinline__ void phase_topk_ref(const Args& a) {
    const int tid = tid_opaque(), lane = tid & 63, wave = tid >> 6;
    const int gw = blockIdx.x * NWAVES + wave, NGW = gridDim.x * NWAVES;
    const bf16_t* skb = (const bf16_t*)(a.ws + WS_SK); const bf16_t* qp = (const bf16_t*)(a.ws + WS_QP);
    int* idx_o = (int*)(a.ws + WS_IDX); float* gw_o = (float*)(a.ws + WS_GW);
    for (int task = gw; task < T * 8; task += NGW) {
        const int t = task >> 3, h = task & 7;
        float topS[2]; int topI[2];
        for (int c = 0; c < 2; ++c) {
            const bf16_t* q = qp + (size_t)t * DM + h * 256 + c * 128;
            float sc0 = 0.f, sc1 = 0.f;
            const bf16_t* k0 = skb + (size_t)((h * 2 + c) * 128 + lane) * 128; const bf16_t* k1 = k0 + 64 * 128;
            for (int d = 0; d < 128; ++d) { const float qd = __uint_as_float((unsigned)q[d] << 16);
                sc0 += qd * __uint_as_float((unsigned)k0[d] << 16); sc1 += qd * __uint_as_float((unsigned)k1[d] << 16); }
            float ms = 0.f; int mi = 0;
            for (int r = 0; r < 16; ++r) {
                float v; int i; if (sc0 >= sc1) { v = sc0; i = lane; } else { v = sc1; i = lane + 64; }
                wave_argmax(v, i);
                if (lane == r) { ms = v; mi = i; }
                if (i == lane) sc0 = -__builtin_inff();
                if (i == lane + 64) sc1 = -__builtin_inff();
            }
            topS[c] = ms; topI[c] = mi;
        }
        float cs[4]; int ci[4];
#pragma unroll
        for (int j = 0; j < 4; ++j) { const int cidx = lane * 4 + j, aa = cidx >> 4, bb = cidx & 15;
            cs[j] = __shfl(topS[0], aa) + __shfl(topS[1], bb); ci[j] = cidx; }
        float fs = 0.f; int fi = 0;
        for (int r = 0; r < 16; ++r) {
            float v = cs[0]; int i = ci[0];
#pragma unroll
            for (int j = 1; j < 4; ++j) if (cs[j] > v) { v = cs[j]; i = ci[j]; }
            wave_argmax(v, i);
            if (lane == r) { fs = v; fi = i; }
#pragma unroll
            for (int j = 0; j < 4; ++j) if (ci[j] == i) cs[j] = -__builtin_inff();
        }
        const int e1 = __shfl(topI[0], fi >> 4), e2 = __shfl(topI[1], fi & 15);
        const float mx = __shfl(fs, 0);
        float ev = lane < 16 ? __expf(fs - mx) : 0.f;
        const float den = wave_sum(ev);
        if (lane < 16) { idx_o[(size_t)t * NE + h * 16 + lane] = e1 * 128 + e2; gw_o[(size_t)t * NE + h * 16 + lane] = ev / den; }
    }
}

__device__ __forceinline__ void fp8x16_to_f32(const u32x4 q, f32x2 (&o)[8]) {
    o[0] = __builtin_amdgcn_cvt_pk_f32_fp8((int)q.x, false); o[1] = __builtin_amdgcn_cvt_pk_f32_fp8((int)q.x, true);
    o[2] = __builtin_amdgcn_cvt_pk_f32_fp8((int)q.y, false); o[3] = __builtin_amdgcn_cvt_pk_f32_fp8((int)q.y, true);
    o[4] = __builtin_amdgcn_cvt_pk_f32_fp8((int)q.z, false); o[5] = __builtin_amdgcn_cvt_pk_f32_fp8((int)q.z, true);
    o[6] = __builtin_amdgcn_cvt_pk_f32_fp8((int)q.w, false); o[7] = __builtin_amdgcn_cvt_pk_f32_fp8((int)q.w, true);
}
#define HALVE(dst, srcv, n, bitmask) do { const bool up_ = (lane & (bitmask)) != 0; _Pragma("unroll") for (int i_ = 0; i_ < (n); ++i_) { \
        const float keep_ = up_ ? srcv[(n) + i_] : srcv[i_], send_ = up_ ? srcv[i_] : srcv[(n) + i_]; dst[i_] = keep_ + __shfl_xor(send_, (bitmask)); } } while (0)
#define ITEM_T(n) (wv + ((n) % KT) * NWX)
#define ITEM_S(n) (xl + 8 * ((n) / KT))
#define LD_IDX(ID, n) do { const int4* ip_ = (const int4*)(idx_i + (size_t)ITEM_T(n) * NE + g * 16); _Pragma("unroll") for (int i_ = 0; i_ < 4; ++i_) ID[i_] = ip_[i_]; } while (0)
#define LD_ROWS(Q, ID, TAB, n) do { const unsigned char* b_ = (TAB) + (size_t)ITEM_S(n) * ((size_t)NEXP * 128) + c * 16; _Pragma("unroll") for (int i_ = 0; i_ < 4; ++i_) { \
        Q[4 * i_] = *(const u32x4*)(b_ + (size_t)ID[i_].x * 128); Q[4 * i_ + 1] = *(const u32x4*)(b_ + (size_t)ID[i_].y * 128); \
        Q[4 * i_ + 2] = *(const u32x4*)(b_ + (size_t)ID[i_].z * 128); Q[4 * i_ + 3] = *(const u32x4*)(b_ + (size_t)ID[i_].w * 128); } } while (0)
__device__ __forceinline__ void phase_peer_u(const Args& a) {
    const int tid = tid_opaque(), lane = tid & 63, wave = tid >> 6, g = lane >> 3, c = lane & 7;
    const int xl = blockIdx.x & 7, wv = (blockIdx.x >> 3) * NWAVES + wave, NWX = (gridDim.x >> 3) * NWAVES, KT = T / NWX, N = 2 * KT;
    const bf16_t* hb = (const bf16_t*)(a.ws + WS_HB); const unsigned char* u8 = a.ws + WS_U8;
    const int* idx_i = (const int*)(a.ws + WS_IDX); float* part = (float*)(a.ws + WS_PART);
#define LD_X(X, n) do { const bf16_t* xp_ = hb + (size_t)ITEM_T(n) * DM + ITEM_S(n) * 128 + c * 16; X[0] = *(const u32x4*)xp_; X[1] = *(const u32x4*)(xp_ + 8); } while (0)
#define COMPUTE_U(Q, X, n) do { f32x2 xf[8]; \
        xf[0] = (f32x2){bf_lo(X[0].x), bf_hi(X[0].x)}; xf[1] = (f32x2){bf_lo(X[0].y), bf_hi(X[0].y)}; xf[2] = (f32x2){bf_lo(X[0].z), bf_hi(X[0].z)}; xf[3] = (f32x2){bf_lo(X[0].w), bf_hi(X[0].w)}; \
        xf[4] = (f32x2){bf_lo(X[1].x), bf_hi(X[1].x)}; xf[5] = (f32x2){bf_lo(X[1].y), bf_hi(X[1].y)}; xf[6] = (f32x2){bf_lo(X[1].z), bf_hi(X[1].z)}; xf[7] = (f32x2){bf_lo(X[1].w), bf_hi(X[1].w)}; \
        float p[16]; _Pragma("unroll") for (int i = 0; i < 16; ++i) { f32x2 uf[8]; fp8x16_to_f32(Q[i], uf); f32x2 ac = uf[0] * xf[0]; \
            _Pragma("unroll") for (int k = 1; k < 8; ++k) ac = ac + uf[k] * xf[k]; p[i] = ac.x + ac.y; } \
        float p8[8], p4[4], p2[2]; HALVE(p8, p, 8, 4); HALVE(p4, p8, 4, 2); HALVE(p2, p4, 2, 1); \
        *(f32x2*)(part + ((size_t)ITEM_T(n) * 16 + ITEM_S(n)) * NE + 2 * lane) = (f32x2){p2[0], p2[1]}; } while (0)
    int4 IA[4], IB[4]; u32x4 QA[16], QB[16], XA[2], XB[2];
    LD_IDX(IA, 0); LD_IDX(IB, 1);
    LD_ROWS(QA, IA, u8, 0); LD_X(XA, 0);
    for (int n = 0; n < N; n += 2) {
        LD_ROWS(QB, IB, u8, n + 1); LD_X(XB, n + 1);
        if (n + 2 < N) LD_IDX(IA, n + 2);
        COMPUTE_U(QA, XA, n);
        if (n + 2 < N) { LD_ROWS(QA, IA, u8, n + 2); LD_X(XA, n + 2); }
        if (n + 3 < N) LD_IDX(IB, n + 3);
        COMPUTE_U(QB, XB, n + 1);
    }
#undef LD_X
#undef COMPUTE_U
}
__device__ __forceinline__ void phase_peer_w(const Args& a) {
    const int gt = blockIdx.x * NTHREADS + tid_opaque(), NGT = gridDim.x * NTHREADS;
    const int* idx_i = (const int*)(a.ws + WS_IDX); const float* gw_i = (const float*)(a.ws + WS_GW); const float* part = (const float*)(a.ws + WS_PART);
    const float* suv = (const float*)(a.ws + WS_SUV); const float* rtab = (const float*)(a.ws + WS_RT); float* wtab = (float*)(a.ws + WS_W);
    for (int item = gt; item < T * NE; item += NGT) {
        const int t = item >> 7, e = item & 127;
        float sum = 0.f;
#pragma unroll
        for (int s = 0; s < 16; ++s) sum += part[((size_t)t * 16 + s) * NE + e];
        const int ex = idx_i[item];
        const float d = sum * suv[ex] * rtab[t];
        wtab[item] = 0.5f * d * (1.f + erff(d * 0.70710678118654752f)) * gw_i[item] * suv[NEXP + ex];
    }
}
__device__ __forceinline__ void phase_peer_v(const Args& a, float* dst) {
    const int tid = tid_opaque(), lane = tid & 63, wave = tid >> 6, g = lane >> 3, c = lane & 7;
    const int xl = blockIdx.x & 7, wv = (blockIdx.x >> 3) * NWAVES + wave, NWX = (gridDim.x >> 3) * NWAVES, KT = T / NWX, N = 2 * KT;
    const unsigned char* v8 = a.ws + WS_V8;
    const int* idx_i = (const int*)(a.ws + WS_IDX); const float* wtab = (const float*)(a.ws + WS_W);
    const float* hsrc = a.out;
#define LD_W(W, n) do { const f32x4* wp_ = (const f32x4*)(wtab + (size_t)ITEM_T(n) * NE + g * 16); _Pragma("unroll") for (int i_ = 0; i_ < 4; ++i_) W[i_] = wp_[i_]; } while (0)
#define COMPUTE_V(Q, W, n) do { f32x2 ac[8]; _Pragma("unroll") for (int k = 0; k < 8; ++k) ac[k] = (f32x2){0.f, 0.f}; \
        _Pragma("unroll") for (int i = 0; i < 16; ++i) { f32x2 vf[8]; fp8x16_to_f32(Q[i], vf); const float w_ = W[i >> 2][i & 3]; \
            _Pragma("unroll") for (int k = 0; k < 8; ++k) ac[k] = ac[k] + vf[k] * w_; } \
        float p[16]; _Pragma("unroll") for (int k = 0; k < 8; ++k) { p[2 * k] = ac[k].x; p[2 * k + 1] = ac[k].y; } \
        float p8[8], p4[4], p2[2]; HALVE(p8, p, 8, 32); HALVE(p4, p8, 4, 16); HALVE(p2, p4, 2, 8); \
        const size_t o_ = (size_t)ITEM_T(n) * DM + ITEM_S(n) * 128 + c * 16 + 2 * g; \
        const f32x2 hv = *(const f32x2*)(hsrc + o_); *(f32x2*)(dst + o_) = (f32x2){hv.x + p2[0], hv.y + p2[1]}; } while (0)
    int4 IA[4], IB[4]; u32x4 QA[16], QB[16]; f32x4 WA[4], WB[4];
    LD_IDX(IA, 0); LD_IDX(IB, 1);
    LD_ROWS(QA, IA, v8, 0); LD_W(WA, 0);
    for (int n = 0; n < N; n += 2) {
        LD_ROWS(QB, IB, v8, n + 1); LD_W(WB, n + 1);
        if (n + 2 < N) LD_IDX(IA, n + 2);
        COMPUTE_V(QA, WA, n);
        if (n + 2 < N) { LD_ROWS(QA, IA, v8, n + 2); LD_W(WA, n + 2); }
        if (n + 3 < N) LD_IDX(IB, n + 3);
        COMPUTE_V(QB, WB, n + 1);
    }
#undef LD_W
#undef COMPUTE_V
}
#undef ITEM_T
#undef ITEM_S
#undef LD_IDX
#undef LD_ROWS
#undef HALVE


#define XB_TMO      128
#define XB_XCNT(j)  (256  + 64 * (j))
#define XB_XSUB(j)  (1280 + 64 * (j))
#define XB_XGEN(j)  (2304 + 64 * (j))
#define XB_TOP      3328
#define XB_TOPGEN   3392
#define XCD_BAR_WORDS 3456
#define XB_SPIN_CAP (1u << 20)
__device__ __forceinline__ unsigned xb_ld(unsigned* p)              { return __hip_atomic_load(p, __ATOMIC_RELAXED, __HIP_MEMORY_SCOPE_AGENT); }
__device__ __forceinline__ unsigned xb_add(unsigned* p, unsigned v) { return __hip_atomic_fetch_add(p, v, __ATOMIC_RELAXED, __HIP_MEMORY_SCOPE_AGENT); }
__device__ __forceinline__ unsigned xb_xcc_id() { return (unsigned)__builtin_amdgcn_s_getreg((3 << 11) | 20) & 0xFu; }
#define XB_SPIN(cond, bar) do { unsigned _sp = 0; while (cond) { __builtin_amdgcn_s_sleep(1); \
    if ((++_sp & 255u) == 0u) { if (xb_ld(&(bar)[XB_TMO])) break; if (_sp > XB_SPIN_CAP) { atomicAdd(&(bar)[XB_TMO], 1u); break; } } } } while (0)
struct XcdBarrier { unsigned* bar; unsigned x; volatile LAS unsigned* st; };
__device__ __forceinline__ XcdBarrier xcd_barrier_post(unsigned* bar, volatile LAS unsigned* st) {
    XcdBarrier b; b.bar = bar; b.x = xb_xcc_id(); b.st = st;
    if (threadIdx.x == 0) (void)xb_add(&bar[XB_XCNT(b.x)], 1u);
    return b;
}
__device__ __forceinline__ void xcd_barrier_complete(unsigned* bar, unsigned x, unsigned& nloc, unsigned& nx) {
    const unsigned G = gridDim.x * gridDim.y * gridDim.z;
    unsigned sum, cnt, mine, sp = 0u;
    for (;;) {
        sum = 0u; cnt = 0u; mine = 0u;
#pragma unroll
        for (unsigned j = 0; j < 16; ++j) { const unsigned c = xb_ld(&bar[XB_XCNT(j)]); sum += c; cnt += (c > 0u) ? 1u : 0u; mine = (j == x) ? c : mine; }
        if (sum == G) break;
        __builtin_amdgcn_s_sleep(1);
        if ((++sp & 255u) == 0u) { if (xb_ld(&bar[XB_TMO])) break; if (sp > XB_SPIN_CAP) { atomicAdd(&bar[XB_TMO], 1u); break; } }
    }
    nloc = mine > 0u ? mine : 1u; nx = cnt > 0u ? cnt : 1u;
}
__device__ __forceinline__ void xcd_barrier(const XcdBarrier& b) {
    asm volatile("s_waitcnt vmcnt(0)" ::: "memory");
    __syncthreads();
    if (threadIdx.x == 0) {
        unsigned* bar = b.bar;
        __builtin_amdgcn_s_waitcnt(0);
        unsigned nloc = b.st[0], nx = b.st[1];
        if (nloc == 0u) { xcd_barrier_complete(bar, b.x, nloc, nx); b.st[0] = nloc; b.st[1] = nx; }
        const unsigned old = xb_add(&bar[XB_XSUB(b.x)], 1u);
        const unsigned gen = old / nloc;
        if (old + 1u == (gen + 1u) * nloc) {
            __builtin_amdgcn_fence(__ATOMIC_RELEASE, "agent");
            asm volatile("s_waitcnt vmcnt(0)" ::: "memory");
            const unsigned og = xb_add(&bar[XB_TOP], 1u);
            const unsigned tg = og / nx;
            if (og + 1u == (tg + 1u) * nx) xb_add(&bar[XB_TOPGEN], 1u);
            else XB_SPIN(xb_ld(&bar[XB_TOPGEN]) == tg, bar);
            __builtin_amdgcn_fence(__ATOMIC_ACQUIRE, "agent");
            xb_add(&bar[XB_XGEN(b.x)], 1u);
            asm volatile("s_waitcnt vmcnt(0)" ::: "memory");
        } else {
            XB_SPIN(xb_ld(&bar[XB_XGEN(b.x)]) == gen, bar);
            __builtin_amdgcn_fence(__ATOMIC_ACQUIRE, "agent");
            asm volatile("s_waitcnt vmcnt(0)" ::: "memory");
        }
    }
    __syncthreads();
}

constexpr int NPHASE = 10;
#define LOAD_ARGS() do { } while (0)
__global__ void __launch_bounds__(NTHREADS, 2) fwd_kernel(Args a) {
    extern __shared__ __attribute__((aligned(16))) unsigned char lds[];
#if MK_ONE_LAUNCH
    constexpr int lo = 0, hi = NPHASE;
    cg::grid_group grid = cg::this_grid();
    volatile LAS unsigned* misc = (volatile LAS unsigned*)((LAS unsigned char*)lds + MISC_OFF);
    if (threadIdx.x < 16) misc[threadIdx.x] = 0u;
    __syncthreads();
    { LOAD_ARGS(); (void)xcd_barrier_post((unsigned*)(a.ws + WS_CTL) + CW_BAR, misc + 8); }
#ifndef SEAM_CG_MASK
#define SEAM_CG_MASK 0
#endif
#define SEAM(k) do { if (lo <= (k) && (k) + 1 < hi) { if ((SEAM_CG_MASK >> (k)) & 1) grid.sync(); else { LOAD_ARGS(); XcdBarrier xb_; xb_.bar = (unsigned*)(a.ws + WS_CTL) + CW_BAR; xb_.x = xb_xcc_id(); \
        xb_.st = (volatile LAS unsigned*)((LAS unsigned char*)lds + MISC_OFF) + 8; xcd_barrier(xb_); } } } while (0)
#else
    int lo, hi; { LOAD_ARGS(); lo = a.ph_lo; hi = a.ph_hi; }
#define SEAM(k) do { } while (0)
#endif
#define IN(k) (lo <= (k) && (k) < hi)
#ifndef DUP_PHASE
#define DUP_PHASE -1
#endif
    if (IN(0)) { LOAD_ARGS(); phase0(a, lds); if (DUP_PHASE == 0) { __syncthreads(); phase0(a, lds); } SEAM(0); }
    if (IN(1)) { LOAD_ARGS(); unsigned char* ws = a.ws;
        cumsum_rows(a);
        pg8::Gemm g{(const bf16_t*)(ws + WS_XN), (const bf16_t*)(ws + WS_WIN), T, NPROJ, DM}; pg8::StaticOrder S; S.init(T, NPROJ, (int)gridDim.x, (int)blockIdx.x);
        pg8::EpiInProj E{(bf16_t*)(ws + WS_SEC)};
        for (int rep_ = 0; rep_ < (DUP_PHASE == 1 ? 2 : 1); ++rep_)
        pg8::gemm_phase<pg8::EpiInProj, pg8::StaticOrder, true, true>((LAS unsigned char*)lds, g, S, E);
        { const int nwg_ = (T / 256) * (NPROJ / 256), G_ = (int)gridDim.x, rem_ = nwg_ % G_;
          if (rem_ > 0 && (int)blockIdx.x >= rem_) convert_tables(a, TAB_SPLIT, 2 * NEXP, ((int)blockIdx.x - rem_) * NWAVES + (tid_opaque() >> 6), (G_ - rem_) * NWAVES);
          else if (rem_ == 0) convert_tables(a, TAB_SPLIT, 2 * NEXP, (int)blockIdx.x * NWAVES + (tid_opaque() >> 6), G_ * NWAVES); }
        SEAM(1);
    }
    if (IN(2)) { LOAD_ARGS(); phase_qknorm(a); SEAM(2); }
    if (IN(3)) { LOAD_ARGS(); phase_attn(a, lds);
#if MK_ONE_LAUNCH
        if (DUP_PHASE == 3) { grid.sync(); if (blockIdx.x == 0 && threadIdx.x == 0) *(volatile unsigned*)(a.ws + WS_CTL) = 0u; __threadfence(); grid.sync(); phase_attn(a, lds); }
#endif
        SEAM(3); }
    if (IN(4)) { LOAD_ARGS(); unsigned char* ws = a.ws;
        pg8::Gemm g{(const bf16_t*)(ws + WS_MIX), (const bf16_t*)(ws + WS_WOUT), T, DM, DM}; pg8::StaticOrder S; S.init(T, DM, (int)gridDim.x, (int)blockIdx.x);
        pg8::EpiOutProj E{a.in[0], a.out, (bf16_t*)(ws + WS_HB), (float*)(ws + WS_SSQ)};
        for (int rep_ = 0; rep_ < (DUP_PHASE == 4 ? 2 : 1); ++rep_)
        pg8::gemm_phase<pg8::EpiOutProj, pg8::StaticOrder, true, true>((LAS unsigned char*)lds, g, S, E);
        SEAM(4);
    }
    if (IN(5)) { LOAD_ARGS(); unsigned char* ws = a.ws;
        pg8::Gemm g{(const bf16_t*)(ws + WS_HB), (const bf16_t*)(ws + WS_WPQ), T, DM, DM}; pg8::StaticOrder S; S.init(T, DM, (int)gridDim.x, (int)blockIdx.x);
        pg8::EpiPeerQ E{(const float*)(ws + WS_SSQ), (bf16_t*)(ws + WS_QP), (float*)(ws + WS_RT)};
        for (int rep_ = 0; rep_ < (DUP_PHASE == 5 ? 2 : 1); ++rep_)
        pg8::gemm_phase<pg8::EpiPeerQ, pg8::StaticOrder, true, true>((LAS unsigned char*)lds, g, S, E);
        SEAM(5);
    }
    #ifdef TOPK_REF
    if (IN(6)) { LOAD_ARGS(); phase_topk_ref(a); SEAM(6); }
#else
    if (IN(6)) { LOAD_ARGS(); for (int rep_ = 0; rep_ < (DUP_PHASE == 6 ? 2 : 1); ++rep_) phase_topk(a, lds); SEAM(6); }
#endif
    if (IN(7)) { LOAD_ARGS(); for (int rep_ = 0; rep_ < (DUP_PHASE == 7 ? 2 : 1); ++rep_) phase_peer_u(a); SEAM(7); }
    if (IN(8)) { LOAD_ARGS(); for (int rep_ = 0; rep_ < (DUP_PHASE == 8 ? 2 : 1); ++rep_) phase_peer_w(a); SEAM(8); }
    if (IN(9)) { LOAD_ARGS(); for (int rep_ = 0; rep_ < (DUP_PHASE == 9 ? 2 : 1); ++rep_) phase_peer_v(a, (DUP_PHASE == 9 && rep_ == 0) ? (float*)(a.ws + WS_END) : a.out); }
#undef IN
#undef SEAM
}

extern "C" void kernel_launch(void* const* d_in, const int* in_sizes, int n_in, void* d_out, int out_size, void* d_ws, size_t ws_size, hipStream_t stream) {
    static int grid = 0;
    if (grid == 0) {
        if (n_in != 12 || in_sizes[0] != T * DM || out_size != T * DM || ws_size < WS_END) { fprintf(stderr, "kernel_launch: unexpected shapes (n_in %d, in0 %d, out %d, ws %zu)\n", n_in, n_in > 0 ? in_sizes[0] : -1, out_size, ws_size); grid = -1; return; }
        int dev = 0, cus = 0, per_cu = 0;
        if (hipGetDevice(&dev) != hipSuccess || hipDeviceGetAttribute(&cus, hipDeviceAttributeMultiprocessorCount, dev) != hipSuccess) { grid = -1; return; }
        if (hipFuncSetAttribute((const void*)fwd_kernel, hipFuncAttributeMaxDynamicSharedMemorySize, LDS_BYTES) != hipSuccess) { fprintf(stderr, "kernel_launch: hipFuncSetAttribute failed\n"); grid = -1; return; }
        if (hipOccupancyMaxActiveBlocksPerMultiprocessor(&per_cu, (const void*)fwd_kernel, NTHREADS, LDS_BYTES) != hipSuccess || per_cu < 1) { fprintf(stderr, "kernel_launch: occupancy query says %d\n", per_cu); grid = -1; return; }
        grid = cus;
    }
    if (grid < 0) return;
    (void)hipMemsetAsync((char*)d_ws + WS_CTL, 0, CTL_BYTES, stream);
    Args a{};
    for (int i = 0; i < 12; ++i) a.in[i] = (const float*)d_in[i];
    a.out = (float*)d_out; a.ws = (unsigned char*)d_ws;
#if MK_ONE_LAUNCH
    a.ph_lo = 0; a.ph_hi = NPHASE;
    void* args[] = {&a};
#if MK_COOP_LAUNCH
    hipError_t e = hipLaunchCooperativeKernel((const void*)fwd_kernel, dim3(grid), dim3(NTHREADS), args, LDS_BYTES, stream);
    if (e != hipSuccess) fprintf(stderr, "cooperative launch failed: %s (grid %d)\n", hipGetErrorString(e), grid);
#else
    (void)args; hipLaunchKernelGGL(fwd_kernel, dim3(grid), dim3(NTHREADS), LDS_BYTES, stream, a);
#endif
#else
    for (int p = 0; p < NPHASE; ++p) { a.ph_lo = p; a.ph_hi = p + 1; hipLaunchKernelGGL(fwd_kernel, dim3(grid), dim3(NTHREADS), LDS_BYTES, stream, a); }
#endif
}
```

```cpp
#include <hip/hip_runtime.h>
#include <hip/hip_cooperative_groups.h>
#include <cstdio>
#include <cstdint>
namespace cg = cooperative_groups;

#ifndef MK_COOP_LAUNCH
#define MK_COOP_LAUNCH 0
#endif
#ifndef MK_ONE_LAUNCH
#define MK_ONE_LAUNCH 1
#endif

#define LAS __attribute__((address_space(3)))
typedef unsigned short bf16_t;
typedef short bf16x8 __attribute__((ext_vector_type(8)));
typedef short s16x4 __attribute__((ext_vector_type(4)));
typedef float f32x2 __attribute__((ext_vector_type(2)));
typedef float f32x4 __attribute__((ext_vector_type(4)));
typedef float f32x16 __attribute__((ext_vector_type(16)));
typedef unsigned u32x2 __attribute__((ext_vector_type(2)));
typedef unsigned u32x4 __attribute__((ext_vector_type(4)));
typedef __bf16 bf16x2_t __attribute__((ext_vector_type(2)));

constexpr int NB = 2, SEQ = 4096, T = NB * SEQ, DM = 2048, HD = 128, NHF = 8, DIN = 7176, NPROJ = 7168;
constexpr int NEXP = 16384, NE = 128;
constexpr float EPS = 1e-6f;
constexpr float SCALE = 0.08838834764831845f, LOG2E = 1.4426950408889634f;
constexpr int NWAVES = 8, NTHREADS = 512;

constexpr size_t MiB = 1u << 20;
constexpr size_t WS_CTL = 0, CTL_BYTES = 32768;
constexpr int CW_BAR = 1024;
constexpr size_t WS_GQK = 45 * MiB + 768 * 1024;
constexpr size_t WS_WIN = 1 * MiB, WS_WOUT = 29 * MiB, WS_WPQ = 37 * MiB, WS_SK = 45 * MiB, WS_LOGF = 46 * MiB, WS_C = 46 * MiB + 512 * 1024, WS_SSQ = 47 * MiB;
constexpr size_t WS_XN = 48 * MiB;
constexpr size_t WS_SEC = 80 * MiB;
constexpr size_t SEC_ELEMS = 8u << 20;
constexpr size_t WS_MIX = 192 * MiB, WS_HB = 224 * MiB, WS_QP = 256 * MiB, WS_IDX = 288 * MiB, WS_GW = 292 * MiB, WS_U8 = 296 * MiB, WS_V8 = 328 * MiB, WS_SUV = 360 * MiB  , WS_RT = 360 * MiB + 256 * 1024  , WS_W = 361 * MiB  ,
                 WS_PART = 368 * MiB  , WS_XQ = 432 * MiB  , WS_END = 448 * MiB;
constexpr size_t WS_AMX = 365 * MiB  , WS_SX = WS_RT + 64 * 1024  , WS_WQ = WS_W  , WS_SW = WS_W + 2 * MiB  ;
constexpr size_t WS_PO = WS_PART  , WS_PML = WS_PART + 32 * MiB  ;

constexpr int RING_BYTES = 131072;
constexpr int MISC_OFF = 143360;
constexpr int LDS_BYTES = 147456;

__device__ __forceinline__ unsigned cvt_pk_bf16(float lo, float hi) { unsigned r; asm volatile("v_cvt_pk_bf16_f32 %0, %1, %2" : "=v"(r) : "v"(lo), "v"(hi)); return r; }
__device__ __forceinline__ float bf_lo(unsigned u) { return __builtin_bit_cast(float, u << 16); }
__device__ __forceinline__ float bf_hi(unsigned u) { return __builtin_bit_cast(float, u & 0xffff0000u); }
__device__ __forceinline__ float wave_sum(float v) {
#pragma unroll
    for (int o = 1; o < 64; o <<= 1) v += __shfl_xor(v, o);
    return v;
}
__device__ __forceinline__ float wave_max(float v) {
#pragma unroll
    for (int o = 1; o < 64; o <<= 1) v = fmaxf(v, __shfl_xor(v, o));
    return v;
}
__device__ __forceinline__ int tid_opaque() { int t = (int)threadIdx.x; asm volatile("" : "+v"(t)); return t; }
#define LDS_WAIT() asm volatile("s_waitcnt lgkmcnt(0)" ::: "memory")

namespace pg8 {
#define PG8_LAS __attribute__((address_space(3)))
constexpr int BM = 256, BK = 64, HALF = 128, HTB = HALF * BK * 2, STAGE_BYTES = 8 * HTB, NXCD = 8, WGM = 8;
__host__ __device__ __forceinline__ int lds_byte(int r, int c) { const int st = (r >> 4) * 2 + (c >> 5), rr = r & 15, cc = c & 31, ob = rr * 64 + cc * 2; return st * 1024 + (ob ^ (((ob >> 9) & 1) << 5)); }
__host__ __device__ __forceinline__ void stage_rc(int b, int& R, int& C) { const int st = b / 1024, sb = b % 1024, swz = sb ^ (((sb >> 9) & 1) << 5); R = (st >> 1) * 16 + swz / 64; C = (st & 1) * 32 + (swz % 64) / 2; }
__host__ __device__ __forceinline__ int perm32(int rho) { const int n = rho >> 4, i = rho & 15; return 8 * (i >> 2) + 4 * n + (i & 3); }
struct Unit { int pm, pn; };
struct Gemm { const bf16_t* A; const bf16_t* Bt; int M, N, K; };
struct StaticOrder {
    int nM, nN, nwg, G, c;
    __host__ __device__ void init(int M, int N, int G_, int c_) { nM = M / BM; nN = N / BM; nwg = nM * nN; G = G_; c = c_; }
    __host__ __device__ bool next(int i, Unit& u) const {
        const long L = (long)i * G + c; if (L >= nwg) return false;
        int wgid = (int)L; { const int q = nwg / NXCD, r = nwg % NXCD, xcd = wgid % NXCD, off = wgid / NXCD; wgid = (xcd < r ? xcd * (q + 1) : r * (q + 1) + (xcd - r) * q) + off; }
        const int nig = WGM * nN, gid = wgid / nig, fm = gid * WGM, gsz = (nM - fm) < WGM ? (nM - fm) : WGM;
        u.pm = fm + ((wgid % nig) % gsz); u.pn = (wgid % nig) / gsz; return true;
    }
    __device__ __forceinline__ void a_ready(const Unit&) const {}
    __device__ __forceinline__ void done(const Unit&) const {}
};

template <class Epi, class Sched, bool ALIGN_EPI = false, bool SP2 = false>
__device__ __forceinline__ void gemm_phase(PG8_LAS unsigned char* lds, const Gemm g, const Sched& S, const Epi& E) {
    const int tid = tid_opaque(), wid = __builtin_amdgcn_readfirstlane(tid >> 6), lane = tid & 63, wr = wid >> 2, wc = wid & 3, fr = lane & 15, fq = lane >> 4;
    const int K = g.K, nt = K / BK;
    unsigned voffA[2], voffB[2];
#pragma unroll
    for (int i = 0; i < 2; ++i) { int R, C; stage_rc(tid * 16 + i * 8192, R, C); const int Rb = Epi::PERM ? ((R & ~31) + perm32(R & 31)) : R;
        voffA[i] = (unsigned)(R * K + C) * 2u; voffB[i] = (unsigned)(Rb * K + C) * 2u; }
    const size_t kstep = (size_t)(BK * 2);
    const size_t hstep = (size_t)HALF * K * 2;
    const size_t tstep = 2 * hstep;
    const unsigned ldsw = (unsigned)wid * 1024u;
    const int aoff = lds_byte(wr * 64 + fr, fq * 8), boff = lds_byte(wc * 32 + fr, fq * 8);
#define PG8_SA(b, h) (((b) * 2 + (h)) * HTB)
#define PG8_SB(b, h) ((4 + (b) * 2 + (h)) * HTB)
#define PG8_STAGE(bufoff, gbase, voff) do { _Pragma("unroll") for (int _i = 0; _i < 2; ++_i) \
        __builtin_amdgcn_global_load_lds((const unsigned*)((const char*)(gbase) + (voff)[_i]), (PG8_LAS unsigned*)(lds + (bufoff) + ldsw + _i * 8192), 16, 0, 0); } while (0)
#define PG8_LDA(dst, b, h) do { _Pragma("unroll") for (int m = 0; m < 4; ++m) _Pragma("unroll") for (int k = 0; k < 2; ++k) dst[m][k] = *(const PG8_LAS bf16x8*)(lds + PG8_SA(b, h) + aoff + m * 2048 + k * 1024); } while (0)
#define PG8_LDB(dst, b, h) do { _Pragma("unroll") for (int n = 0; n < 2; ++n) _Pragma("unroll") for (int k = 0; k < 2; ++k) dst[n][k] = *(const PG8_LAS bf16x8*)(lds + PG8_SB(b, h) + boff + n * 2048 + k * 1024); } while (0)
#define PG8_MMA(ai, bj, At, Bt) do { __builtin_amdgcn_s_setprio(1); _Pragma("unroll") for (int m = 0; m < 4; ++m) _Pragma("unroll") for (int n = 0; n < 2; ++n) _Pragma("unroll") for (int k = 0; k < 2; ++k) \
        acc[ai][bj][m][n] = __builtin_amdgcn_mfma_f32_16x16x32_bf16(Bt[n][k], At[m][k], acc[ai][bj][m][n], 0, 0, 0); __builtin_amdgcn_s_setprio(0); } while (0)
#define PG8_WAIT_V(n) asm volatile("s_waitcnt vmcnt(" #n ")" ::: "memory")
#define PG8_WAIT_L(n) asm volatile("s_waitcnt lgkmcnt(" #n ")" ::: "memory")
#define PG8_BAR __builtin_amdgcn_s_barrier()
#define PG8_SCHED __builtin_amdgcn_sched_barrier(0)
    Unit cur, nxt; int ui = 0;
    if (!S.next(0, cur)) return;
    f32x4 acc[2][2][4][2];
#pragma unroll
    for (int a = 0; a < 2; ++a)
#pragma unroll
        for (int b = 0; b < 2; ++b)
#pragma unroll
            for (int m = 0; m < 4; ++m)
#pragma unroll
                for (int n = 0; n < 2; ++n) acc[a][b][m][n] = (f32x4){0.f, 0.f, 0.f, 0.f};
    bf16x8 At[4][2], B0[2][2], B1[2][2];
    const char* cA = (const char*)g.A + (size_t)cur.pm * tstep; const char* cB = (const char*)g.Bt + (size_t)cur.pn * tstep;
    S.a_ready(cur);
    if constexpr (SP2) {
        PG8_STAGE(PG8_SB(0, 0), cB, voffB); PG8_STAGE(PG8_SB(0, 1), cB + hstep, voffB); PG8_STAGE(PG8_SA(0, 0), cA, voffA); PG8_STAGE(PG8_SA(0, 1), cA + hstep, voffA);
        if (wr == 1) PG8_BAR;
        PG8_WAIT_V(2); PG8_BAR;
        PG8_STAGE(PG8_SB(1, 0), cB + kstep, voffB); PG8_STAGE(PG8_SA(1, 0), cA + kstep, voffA); PG8_STAGE(PG8_SB(1, 1), cB + hstep + kstep, voffB);
        PG8_WAIT_V(6); PG8_BAR;
    } else {
        PG8_STAGE(PG8_SB(0, 0), cB, voffB); PG8_STAGE(PG8_SA(0, 0), cA, voffA); PG8_STAGE(PG8_SB(0, 1), cB + hstep, voffB); PG8_STAGE(PG8_SA(0, 1), cA + hstep, voffA);
        if (wr == 1) PG8_BAR;
        PG8_WAIT_V(4); PG8_BAR;
        PG8_STAGE(PG8_SB(1, 0), cB + kstep, voffB); PG8_STAGE(PG8_SA(1, 0), cA + kstep, voffA); PG8_STAGE(PG8_SB(1, 1), cB + hstep + kstep, voffB);
        PG8_WAIT_V(6); PG8_BAR;
    }
    for (;;) {
        const bool has_next = S.next(ui + 1, nxt);
        const char* nA = has_next ? (const char*)g.A + (size_t)nxt.pm * tstep : cA; const char* nB = has_next ? (const char*)g.Bt + (size_t)nxt.pn * tstep : cB;
        for (int t = 0; t < nt; t += 2) {
            const bool last = (t == nt - 2);
            const char* a1 = cA + (size_t)(t + 1) * kstep;
            const char* a2 = last ? nA : cA + (size_t)(t + 2) * kstep; const char* b2 = last ? nB : cB + (size_t)(t + 2) * kstep;
            const char* a3 = a2 + kstep; const char* b3 = b2 + kstep;
            if (last && has_next) S.a_ready(nxt);
            if constexpr (SP2) {
            PG8_LDB(B0, 0, 0); PG8_LDB(B1, 0, 1); PG8_SCHED; PG8_LDA(At, 0, 0); PG8_STAGE(PG8_SA(1, 1), a1 + hstep, voffA);
            PG8_WAIT_V(8); PG8_WAIT_L(0); PG8_BAR; PG8_MMA(0, 0, At, B0); PG8_MMA(0, 1, At, B1); PG8_BAR; PG8_SCHED;
            PG8_LDA(At, 0, 1); PG8_STAGE(PG8_SB(0, 0), b2, voffB); PG8_STAGE(PG8_SB(0, 1), b2 + hstep, voffB); PG8_STAGE(PG8_SA(0, 0), a2, voffA);
            PG8_WAIT_V(8); PG8_WAIT_L(0); PG8_BAR; PG8_MMA(1, 0, At, B0); PG8_MMA(1, 1, At, B1); PG8_BAR; PG8_SCHED;
            PG8_LDB(B0, 1, 0); PG8_LDB(B1, 1, 1); PG8_SCHED; PG8_LDA(At, 1, 0); PG8_STAGE(PG8_SA(0, 1), a2 + hstep, voffA);
            PG8_WAIT_V(8); PG8_WAIT_L(0); PG8_BAR; PG8_MMA(0, 0, At, B0); PG8_MMA(0, 1, At, B1); PG8_BAR; PG8_SCHED;
            PG8_LDA(At, 1, 1); PG8_STAGE(PG8_SB(1, 0), b3, voffB); PG8_STAGE(PG8_SB(1, 1), b3 + hstep, voffB); PG8_STAGE(PG8_SA(1, 0), a3, voffA);
            PG8_WAIT_V(8); PG8_WAIT_L(0); PG8_BAR; PG8_MMA(1, 0, At, B0); PG8_MMA(1, 1, At, B1); PG8_BAR; PG8_SCHED;
            } else {
            PG8_LDB(B0, 0, 0); PG8_SCHED; PG8_LDA(At, 0, 0); PG8_STAGE(PG8_SA(1, 1), a1 + hstep, voffA);
            PG8_WAIT_L(8); PG8_BAR; PG8_WAIT_L(0); PG8_MMA(0, 0, At, B0); PG8_BAR; PG8_SCHED;
            PG8_LDB(B1, 0, 1); PG8_STAGE(PG8_SB(0, 0), b2, voffB);
            PG8_BAR; PG8_WAIT_L(0); PG8_MMA(0, 1, At, B1); PG8_BAR;
            PG8_LDA(At, 0, 1); PG8_STAGE(PG8_SA(0, 0), a2, voffA);
            PG8_BAR; PG8_WAIT_L(0); PG8_MMA(1, 0, At, B0); PG8_BAR; PG8_SCHED;
            PG8_STAGE(PG8_SB(0, 1), b2 + hstep, voffB);
            PG8_WAIT_V(6); PG8_BAR; PG8_MMA(1, 1, At, B1); PG8_BAR;
            PG8_LDB(B0, 1, 0); PG8_SCHED; PG8_LDA(At, 1, 0); PG8_STAGE(PG8_SA(0, 1), a2 + hstep, voffA);
            PG8_WAIT_L(8); PG8_BAR; PG8_WAIT_L(0); PG8_MMA(0, 0, At, B0); PG8_BAR; PG8_SCHED;
            PG8_LDB(B1, 1, 1); PG8_STAGE(PG8_SB(1, 0), b3, voffB);
            PG8_BAR; PG8_WAIT_L(0); PG8_MMA(0, 1, At, B1); PG8_BAR;
            PG8_LDA(At, 1, 1); PG8_STAGE(PG8_SA(1, 0), a3, voffA);
            PG8_BAR; PG8_WAIT_L(0); PG8_MMA(1, 0, At, B0); PG8_BAR; PG8_SCHED;
            PG8_STAGE(PG8_SB(1, 1), b3 + hstep, voffB);
            PG8_WAIT_V(6); PG8_BAR; PG8_MMA(1, 1, At, B1); PG8_BAR;
            }
        }
        if constexpr (ALIGN_EPI) { if (wr == 0) PG8_BAR; }
        E(acc, cur, wr, wc, fr, fq); S.done(cur);
        if (!has_next) break;
#pragma unroll
        for (int a = 0; a < 2; ++a)
#pragma unroll
            for (int b = 0; b < 2; ++b)
#pragma unroll
                for (int m = 0; m < 4; ++m)
#pragma unroll
                    for (int n = 0; n < 2; ++n) acc[a][b][m][n] = (f32x4){0.f, 0.f, 0.f, 0.f};
        cur = nxt; cA = nA; cB = nB; ++ui;
        if constexpr (ALIGN_EPI) { if (wr == 1) PG8_BAR; }
    }
    PG8_WAIT_V(0);
    if constexpr (!ALIGN_EPI) { if (wr == 0) PG8_BAR; }
    PG8_BAR;
#undef PG8_SA
#undef PG8_SB
#undef PG8_STAGE
#undef PG8_LDA
#undef PG8_LDB
#undef PG8_MMA
#undef PG8_WAIT_V
#undef PG8_WAIT_L
#undef PG8_BAR
#undef PG8_SCHED
}

__device__ __forceinline__ float sigmoidf_fast(float x) { return __builtin_amdgcn_rcpf(1.f + __builtin_amdgcn_exp2f(-x * LOG2E)); }
struct EpiInProj {
    static constexpr bool PERM = true;
    bf16_t* base;
    __device__ __forceinline__ void operator()(const f32x4 (&acc)[2][2][4][2], const Unit& u, int wr, int wc, int fr, int fq) const {
        const int sec = u.pn >> 2;
        bf16_t* sb = base + (size_t)sec * SEC_ELEMS;
        const float sc = (sec == 4) ? SCALE * LOG2E : 1.f;
#pragma unroll
        for (int ai = 0; ai < 2; ++ai)
#pragma unroll
            for (int m = 0; m < 4; ++m) {
                const int tk = u.pm * BM + ai * HALF + wr * 64 + m * 16 + fr, b = tk >> 12, s = tk & 4095;
#pragma unroll
                for (int bj = 0; bj < 2; ++bj) {
                    const int hh = (u.pn & 3) * 2 + bj;
                    f32x4 v0 = acc[ai][bj][m][0], v1 = acc[ai][bj][m][1];
                    bf16_t* dst;
                    if (sec == 3) {
#pragma unroll
                        for (int i = 0; i < 4; ++i) { v0[i] = sigmoidf_fast(v0[i]); v1[i] = sigmoidf_fast(v1[i]); }
                        dst = sb + (size_t)tk * 1024 + hh * 128 + wc * 32 + 8 * fq;
                    } else {
                        v0 = v0 * sc; v1 = v1 * sc;
                        dst = sb + ((size_t)((b * 8 + hh) * 4096 + s)) * 128 + wc * 32 + 8 * fq;
                    }
                    u32x4 w; w.x = cvt_pk_bf16(v0[0], v0[1]); w.y = cvt_pk_bf16(v0[2], v0[3]); w.z = cvt_pk_bf16(v1[0], v1[1]); w.w = cvt_pk_bf16(v1[2], v1[3]);
                    *(u32x4*)dst = w;
                }
            }
    }
};
struct EpiOutProj {
    static constexpr bool PERM = true;
    const float* x; float* h; bf16_t* hb; float* ssq; float* amx;
    __device__ __forceinline__ void operator()(const f32x4 (&acc)[2][2][4][2], const Unit& u, int wr, int wc, int fr, int fq) const {
#pragma unroll
        for (int ai = 0; ai < 2; ++ai)
#pragma unroll
            for (int m = 0; m < 4; ++m) {
                const int tk = u.pm * BM + ai * HALF + wr * 64 + m * 16 + fr;
                float ss = 0.f, mx = 0.f;
#pragma unroll
                for (int bj = 0; bj < 2; ++bj) {
                    const size_t off = (size_t)tk * DM + u.pn * BM + bj * HALF + wc * 32 + 8 * fq;
                    const f32x4 x0 = *(const f32x4*)(x + off), x1 = *(const f32x4*)(x + off + 4);
                    const f32x4 v0 = acc[ai][bj][m][0] + x0, v1 = acc[ai][bj][m][1] + x1;
                    *(f32x4*)(h + off) = v0; *(f32x4*)(h + off + 4) = v1;
                    u32x4 w; w.x = cvt_pk_bf16(v0[0], v0[1]); w.y = cvt_pk_bf16(v0[2], v0[3]); w.z = cvt_pk_bf16(v1[0], v1[1]); w.w = cvt_pk_bf16(v1[2], v1[3]);
                    *(u32x4*)(hb + off) = w;
                    ss += v0[0] * v0[0] + v0[1] * v0[1] + v0[2] * v0[2] + v0[3] * v0[3] + v1[0] * v1[0] + v1[1] * v1[1] + v1[2] * v1[2] + v1[3] * v1[3];
                    mx = fmaxf(mx, fmaxf(fmaxf(fmaxf(fabsf(v0[0]), fabsf(v0[1])), fmaxf(fabsf(v0[2]), fabsf(v0[3]))), fmaxf(fmaxf(fabsf(v1[0]), fabsf(v1[1])), fmaxf(fabsf(v1[2]), fabsf(v1[3])))));
                }
                ss += __shfl_xor(ss, 16); ss += __shfl_xor(ss, 32);
                mx = fmaxf(mx, __shfl_xor(mx, 16)); mx = fmaxf(mx, __shfl_xor(mx, 32));
                if (fq == 0) { ssq[(size_t)tk * 32 + u.pn * 4 + wc] = ss; amx[(size_t)tk * 32 + u.pn * 4 + wc] = mx; }
            }
    }
};
struct EpiPeerQ {
    static constexpr bool PERM = true;
    const float* ssq; bf16_t* qp; float* rtab;
    __device__ __forceinline__ void operator()(const f32x4 (&acc)[2][2][4][2], const Unit& u, int wr, int wc, int fr, int fq) const {
#pragma unroll
        for (int ai = 0; ai < 2; ++ai)
#pragma unroll
            for (int m = 0; m < 4; ++m) {
                const int tk = u.pm * BM + ai * HALF + wr * 64 + m * 16 + fr;
                float tot = 0.f;
#pragma unroll
                for (int i = 0; i < 8; ++i) { const f32x4 s4 = *(const f32x4*)(ssq + (size_t)tk * 32 + 4 * i); tot += (s4[0] + s4[1]) + (s4[2] + s4[3]); }
                const float r = 1.0f / sqrtf(tot * (1.f / DM) + EPS);
                if (u.pn == 0 && wc == 0 && fq == 0) rtab[tk] = r;
#pragma unroll
                for (int bj = 0; bj < 2; ++bj) {
                    const size_t off = (size_t)tk * DM + u.pn * BM + bj * HALF + wc * 32 + 8 * fq;
                    const f32x4 v0 = acc[ai][bj][m][0] * r, v1 = acc[ai][bj][m][1] * r;
                    u32x4 w; w.x = cvt_pk_bf16(v0[0], v0[1]); w.y = cvt_pk_bf16(v0[2], v0[3]); w.z = cvt_pk_bf16(v1[0], v1[1]); w.w = cvt_pk_bf16(v1[2], v1[3]);
                    *(u32x4*)(qp + off) = w;
                }
            }
    }
};
}

namespace att {
constexpr int NW = 8, QBLK = 32, KVBLK = 64, QB = NW * QBLK, D = 128;
constexpr int SHM_V = KVBLK * D * 2, SHM_K = KVBLK * D * 2;
constexpr int OFF_WS = 2 * SHM_V + 2 * SHM_K, OFF_BIAS = OFF_WS + NW * 64 * 4, ATT_LDS = OFF_BIAS + SEQ * 4;
#define KSWZ(row, colB) ((row) * 256 + ((colB) ^ (((row) & 7) << 4)))
#define SBAR() __builtin_amdgcn_sched_barrier(0)
__device__ __forceinline__ int v_st(int k, int c) { const int kk = (k & ~0xC) | ((k & 4) << 1) | ((k & 8) >> 1); return ((kk >> 3) * 4 + (c >> 5)) * 512 + ((kk & 7) * 32 + (c & 31)) * 2; }
__device__ __forceinline__ int v_rd_base(int lane) { return ((lane & 3) << 3) | (((lane >> 2) & 3) << 6) | (((lane >> 4) & 1) << 5) | (((lane >> 5) & 1) << 8); }
constexpr int v_rd_off(int d0, int ks, int half) { return d0 * 512 + ks * 4096 + half * 2048; }
__device__ __forceinline__ int crow(int r, int hi) { return (r & 3) + 8 * (r >> 2) + 4 * hi; }
__device__ __forceinline__ bf16x8 load8(const bf16_t* p) { return *reinterpret_cast<const bf16x8*>(p); }
__device__ __forceinline__ void mask_tile(f32x16& p0, f32x16& p1, int dq) {
    const float NEG = -__builtin_inff();
#pragma unroll
    for (int r = 0; r < 16; ++r) {
        const int c = (r & 3) + 8 * (r >> 2);
        if (dq - c < 0) p0[r] = NEG;
        if (dq - c - 32 < 0) p1[r] = NEG;
    }
}
__device__ __forceinline__ void partialSM(f32x16& p0, f32x16& p1, float& m_reg, float& mn, float& alpha) {
    float pmax = p0[0];
#pragma unroll
    for (int r = 1; r < 16; ++r) pmax = fmaxf(pmax, p0[r]);
#pragma unroll
    for (int r = 0; r < 16; ++r) pmax = fmaxf(pmax, p1[r]);
    { auto rr = __builtin_amdgcn_permlane32_swap(__float_as_uint(pmax), __float_as_uint(pmax), false, false);
      pmax = fmaxf(__uint_as_float(rr[0]), __uint_as_float(rr[1])); }
    constexpr float C2 = LOG2E * SCALE; constexpr float THR = 8.f;
    if (__builtin_expect(__all((pmax - m_reg) * SCALE <= THR), 1)) { mn = m_reg; alpha = 1.f; }
    else { mn = fmaxf(m_reg, pmax); alpha = __builtin_amdgcn_exp2f((m_reg - mn) * C2); m_reg = mn; }
    const float mnL = -mn * C2;
#pragma unroll
    for (int r = 0; r < 16; ++r) p0[r] = fmaf(p0[r], C2, mnL);
#pragma unroll
    for (int r = 0; r < 16; ++r) p1[r] = fmaf(p1[r], C2, mnL);
#pragma unroll
    for (int r = 0; r < 16; ++r) p0[r] = __builtin_amdgcn_exp2f(p0[r]);
}
#define PK4(P, B_, OUT) do { unsigned a0 = cvt_pk_bf16(P[B_+0], P[B_+1]), a1 = cvt_pk_bf16(P[B_+2], P[B_+3]);                          \
        unsigned b0 = cvt_pk_bf16(P[B_+4], P[B_+5]), b1 = cvt_pk_bf16(P[B_+6], P[B_+7]);                                             \
        auto r0 = __builtin_amdgcn_permlane32_swap(a0, b0, false, false); auto r1 = __builtin_amdgcn_permlane32_swap(a1, b1, false, false); \
        u32x4 w = {r0[0], r1[0], r0[1], r1[1]}; OUT = *reinterpret_cast<bf16x8*>(&w); } while (0)
__device__ __forceinline__ void finishSM(f32x16& p0, f32x16& p1, float alpha, float& l_reg, bf16x8& pa0, bf16x8& pa1, bf16x8& pa2, bf16x8& pa3) {
#pragma unroll
    for (int r = 0; r < 16; ++r) p1[r] = __builtin_amdgcn_exp2f(p1[r]);
    float ps = 0;
#pragma unroll
    for (int r = 0; r < 16; ++r) ps += p0[r];
#pragma unroll
    for (int r = 0; r < 16; ++r) ps += p1[r];
    { auto rr = __builtin_amdgcn_permlane32_swap(__float_as_uint(ps), __float_as_uint(ps), false, false);
      ps = __uint_as_float(rr[0]) + __uint_as_float(rr[1]); }
    l_reg = l_reg * alpha + ps;
    PK4(p0, 0, pa0); PK4(p0, 8, pa1); PK4(p1, 0, pa2); PK4(p1, 8, pa3);
}
__device__ __forceinline__ void sb_group(f32x16& P, int g, float& gs) {
    float run = 0.f;
#pragma unroll
    for (int k = 3; k >= 0; --k) {
        const float z = P[4 * g + k];
        const float t = __builtin_amdgcn_exp2f(-fabsf(z));
        const float l = __builtin_amdgcn_logf(1.f + t);
        const float sp = fmaxf(z, 0.f) + l;
        P[4 * g + k] = (z - sp) - run;
        run += sp;
    }
    gs = run;
}
__device__ __forceinline__ void sb_part1(f32x16& p0, f32x16& p1, float& carry, float mlo) {
    float gs[8];
#pragma unroll
    for (int g = 0; g < 4; ++g) sb_group(p0, g, gs[g]);
#pragma unroll
    for (int g = 0; g < 4; ++g) sb_group(p1, g, gs[4 + g]);
    float run = carry;
#pragma unroll
    for (int G = 7; G >= 0; --G) {
        auto rr = __builtin_amdgcn_permlane32_swap(__float_as_uint(gs[G]), __float_as_uint(gs[G]), false, false);
        const float slo = __uint_as_float(rr[0]), shi = __uint_as_float(rr[1]);
        const float base = fmaf(mlo, shi, run);
        if (G >= 4) {
#pragma unroll
            for (int k = 0; k < 4; ++k) p1[4 * (G - 4) + k] -= base;
        } else {
#pragma unroll
            for (int k = 0; k < 4; ++k) p0[4 * G + k] -= base;
        }
        run += slo + shi;
    }
    carry = run;
#pragma unroll
    for (int r = 0; r < 16; ++r) p0[r] = __builtin_amdgcn_exp2f(p0[r]);
}
__device__ __forceinline__ void sb_part2(f32x16& p0, f32x16& p1, bf16x8& pa0, bf16x8& pa1, bf16x8& pa2, bf16x8& pa3) {
#pragma unroll
    for (int r = 0; r < 16; ++r) p1[r] = __builtin_amdgcn_exp2f(p1[r]);
    PK4(p0, 0, pa0); PK4(p0, 8, pa1); PK4(p1, 0, pa2); PK4(p1, 8, pa3);
}
#undef PK4
template <int KB, bool BIAS>
__device__ __forceinline__ void qkt(f32x16& p0, f32x16& p1, const char* K_lds, int r32, int hi, const bf16x8* qr, const float* bt) {
    if constexpr (BIAS) {
#pragma unroll
        for (int g = 0; g < 4; ++g) { const f32x4 a = *(const f32x4*)(bt + 8 * g), b = *(const f32x4*)(bt + 32 + 8 * g);
            p0[4 * g] = a[0]; p0[4 * g + 1] = a[1]; p0[4 * g + 2] = a[2]; p0[4 * g + 3] = a[3];
            p1[4 * g] = b[0]; p1[4 * g + 1] = b[1]; p1[4 * g + 2] = b[2]; p1[4 * g + 3] = b[3]; }
    } else { p0 = f32x16{}; p1 = f32x16{}; }
    const char* kb[4];
#pragma unroll
    for (int dd = 0; dd < 4; ++dd) kb[dd] = K_lds + KB * SHM_K + KSWZ(r32, (dd * 16 + hi * 8) * 2);
#pragma unroll
    for (int d0 = 0; d0 < 8; ++d0) { const char* a = kb[d0 & 3] + (d0 >> 2) * 128;
        bf16x8 b0 = *reinterpret_cast<const bf16x8*>(a);
        bf16x8 b1 = *reinterpret_cast<const bf16x8*>(a + 32 * 256);
        p0 = __builtin_amdgcn_mfma_f32_32x32x16_bf16(b0, qr[d0], p0, 0, 0, 0);
        p1 = __builtin_amdgcn_mfma_f32_32x32x16_bf16(b1, qr[d0], p1, 0, 0, 0); }
}
template <int VB>
__device__ __forceinline__ void pv_tile(f32x16* o, int vb0, bf16x8 pa0, bf16x8 pa1, bf16x8 pa2, bf16x8 pa3) {
#define TRRD(dst, off) asm volatile("ds_read_b64_tr_b16 %0, %1 offset:%2" : "=&v"(dst) : "v"(vb0), "i"(off) : "memory")
#define PV_D0(d0) do { { s16x4 l0, l1, h0, h1; constexpr int b_ = VB * SHM_V + v_rd_off(d0, 0, 0); \
        TRRD(l0, b_); TRRD(h0, b_ + 2048); TRRD(l1, b_ + 4096); TRRD(h1, b_ + 6144); \
        asm volatile("s_waitcnt lgkmcnt(0)" ::: "memory"); SBAR();   \
        o[d0] = __builtin_amdgcn_mfma_f32_32x32x16_bf16(pa0, (bf16x8){l0[0], l0[1], l0[2], l0[3], h0[0], h0[1], h0[2], h0[3]}, o[d0], 0, 0, 0);   \
        o[d0] = __builtin_amdgcn_mfma_f32_32x32x16_bf16(pa1, (bf16x8){l1[0], l1[1], l1[2], l1[3], h1[0], h1[1], h1[2], h1[3]}, o[d0], 0, 0, 0); }  \
      { s16x4 l2, l3, h2, h3; constexpr int b_ = VB * SHM_V + v_rd_off(d0, 0, 0); \
        TRRD(l2, b_ + 8192); TRRD(h2, b_ + 10240); TRRD(l3, b_ + 12288); TRRD(h3, b_ + 14336); \
        asm volatile("s_waitcnt lgkmcnt(0)" ::: "memory"); SBAR();   \
        o[d0] = __builtin_amdgcn_mfma_f32_32x32x16_bf16(pa2, (bf16x8){l2[0], l2[1], l2[2], l2[3], h2[0], h2[1], h2[2], h2[3]}, o[d0], 0, 0, 0);   \
        o[d0] = __builtin_amdgcn_mfma_f32_32x32x16_bf16(pa3, (bf16x8){l3[0], l3[1], l3[2], l3[3], h3[0], h3[1], h3[2], h3[3]}, o[d0], 0, 0, 0); } } while (0)
    PV_D0(0); PV_D0(1); PV_D0(2); PV_D0(3);
#undef PV_D0
#undef TRRD
}

struct UnitRef { const bf16_t* Q; const bf16_t* K; const bf16_t* V; int P0; };
struct Seam { bf16x8 qr[8]; bf16x8 st_v0, st_v1, st_k0, st_k1; };
#define ROW(p, k0, rr) ((p) + (size_t)((k0) + (rr)) * D + sc)
#define VMW() asm volatile("s_waitcnt vmcnt(0)" ::: "memory")
#define SLOAD_H(Kp, Vp, k0) do { S.st_v0 = load8(ROW(Vp, k0, sr)); S.st_v1 = load8(ROW(Vp, k0, 32 + sr));              \
                         S.st_k0 = load8(ROW(Kp, k0, sr)); S.st_k1 = load8(ROW(Kp, k0, 32 + sr)); } while (0)
#define SWRITE_HK(bf) do { *(bf16x8*)(K_lds + (bf) * SHM_K + kws) = S.st_k0; *(bf16x8*)(K_lds + (bf) * SHM_K + kws + 32 * 256) = S.st_k1; } while (0)
#define SWRITE_HV(bf) do { *(bf16x8*)(V_lds + (bf) * SHM_V + vst0) = S.st_v0; *(bf16x8*)(V_lds + (bf) * SHM_V + vst1) = S.st_v1; } while (0)
#define SWRITE_H(bf) do { SWRITE_HV(bf); SWRITE_HK(bf); } while (0)

template <bool SB>
__device__ __forceinline__ void attn_unit(const UnitRef& cur, unsigned char* wsu  , int bh, char* lds,
                                          int part  ) {
    const float* cvec; const float* gqk;
    { unsigned char* w_ = wsu; asm volatile("" : "+s"(w_)); cvec = (const float*)(w_ + WS_C) + (size_t)bh * SEQ; gqk = (const float*)(w_ + WS_GQK); }
    const int tid = tid_opaque(), wid = __builtin_amdgcn_readfirstlane(tid >> 6), lane = tid & 63, r32 = lane & 31, hi = lane >> 5;
    int jlo = 0;
    if constexpr (!SB) {
        const float gq = fmaxf(fabsf(gqk[lane]), fabsf(gqk[64 + lane])), gk = fmaxf(fabsf(gqk[128 + lane]), fabsf(gqk[192 + lane]));
        const float lmax = 11.3137085f * 1.02f * wave_max(gq) * wave_max(gk);
        const int ntf = (cur.P0 + QB) / KVBLK;
        const float cend = (lane < ntf) ? cvec[lane * KVBLK + KVBLK - 1] : 0.f;
        const bool skip = (lane < ntf) && (2.f * lmax + cvec[cur.P0] - cend < -104.f);
        jlo = __builtin_amdgcn_readfirstlane((int)__popcll(__ballot(skip)));
    }
    const int ntot = (cur.P0 + QB) / KVBLK - jlo;
    const int tb = (part == 2) ? (ntot >> 1) : 0, te = (part == 1) ? (ntot >> 1) : ntot;
    const int kshift = (jlo + tb) * KVBLK, P0r = cur.P0 - kshift;
    const int NT = te - tb;
#define KBASE(t) ((SB ? (NT - 1 - (t)) : (t)) * KVBLK)
    const int qlo = P0r + wid * QBLK, qm = qlo + r32 - 4 * hi - (SB ? 1 : 0);
    char* V_lds = lds; char* K_lds = lds + 2 * SHM_V;
    float* ws = (float*)(lds + OFF_WS) + wid * 64; float* li_l = ws, * al_l = ws + 32;
    float* bias = (float*)(lds + OFF_BIAS);
    const int sr = tid >> 4, sc = (tid & 15) * 8, vst0 = v_st(sr, sc), vst1 = v_st(32 + sr, sc), kws = KSWZ(sr, sc * 2);
    const int vb0 = (int)(uintptr_t)V_lds + v_rd_base(lane);
    const bf16_t* Kh = cur.K + (size_t)kshift * D; const bf16_t* Vh = cur.V + (size_t)kshift * D;
    Seam S;
    if constexpr (!SB) { const float cq0 = cvec[cur.P0]; const float* cv = cvec + kshift; for (int j = tid; j < NT * KVBLK; j += NTHREADS) bias[j] = (cq0 - cv[j]) * (1.f / SCALE); }
#pragma unroll
    for (int d0 = 0; d0 < 8; ++d0) S.qr[d0] = load8(cur.Q + (size_t)(wid * QBLK + r32) * D + d0 * 16 + hi * 8);
    SLOAD_H(Kh, Vh, KBASE(0)); VMW(); SWRITE_HK(0);
    __syncthreads();
    float m_reg = -1e30f, l_reg = 0; f32x16 o[4] = {};
    float carry = 0.f; const float mlo = hi ? 0.f : 1.f;
#define RESC(a) do { if (__any((a) < 1.f)) { if (hi == 0) al_l[r32] = (a); asm volatile("s_waitcnt lgkmcnt(0)" ::: "memory");              \
                     for (int d_ = 0; d_ < 4; ++d_) for (int r = 0; r < 16; ++r) o[d_][r] *= al_l[crow(r, hi)]; } } while (0)
#define MASKT(P0_, P1_, t) do { const int kb_ = KBASE(t); if (kb_ + KVBLK - 1 > qlo - (SB ? 1 : 0)) mask_tile(P0_, P1_, qm - kb_); } while (0)
#define BT(t) (bias + KBASE(t) + 4 * hi)
#define PART1(PX0, PX1, mnX, alX) do { if constexpr (SB) sb_part1(PX0, PX1, carry, mlo); else partialSM(PX0, PX1, m_reg, mnX, alX); } while (0)
#define PART2(PY0, PY1, alY) do { if constexpr (SB) sb_part2(PY0, PY1, pa0, pa1, pa2, pa3); else finishSM(PY0, PY1, alY, l_reg, pa0, pa1, pa2, pa3); } while (0)
    f32x16 pA0, pA1, pB0, pB1; float mnA = 0.f, mnB = 0.f, alA = 1.f, alB = 1.f; bf16x8 pa0, pa1, pa2, pa3;
    SWRITE_HV(0); SBAR();
    if (NT > 1) SLOAD_H(Kh, Vh, KBASE(1));
    SBAR(); qkt<0, !SB>(pA0, pA1, K_lds, r32, hi, S.qr, BT(0));
    MASKT(pA0, pA1, 0); PART1(pA0, pA1, mnA, alA);
    if (NT > 1) { VMW(); SWRITE_H(1); }
    __syncthreads();
#define HALF_STEP(PX0, PX1, mnX, alX, PY0, PY1, alY, t, KB, VB, SBUF) do {                                                    \
        SBAR(); qkt<KB, !SB>(PX0, PX1, K_lds, r32, hi, S.qr, BT(t));                                                          \
        PART2(PY0, PY1, alY); SBAR();                                                                                          \
        if ((t) + 1 < NT) { SLOAD_H(Kh, Vh, KBASE((t) + 1)); SBAR(); }                                                         \
        pv_tile<VB>(o, vb0, pa0, pa1, pa2, pa3); MASKT(PX0, PX1, (t)); PART1(PX0, PX1, mnX, alX);                              \
        __syncthreads();                                                                                                      \
        if ((t) + 1 < NT) { VMW(); SWRITE_H(SBUF); }                                                                           \
        if constexpr (!SB) RESC(alX);                                                                                          \
        __syncthreads(); } while (0)
    for (int t = 1; t + 1 < NT; t += 2) {
        HALF_STEP(pB0, pB1, mnB, alB, pA0, pA1, alA, t, 1, 0, 0);
        HALF_STEP(pA0, pA1, mnA, alA, pB0, pB1, alB, t + 1, 0, 1, 1);
    }
    const bool even = (NT & 1) == 0;
    if (even) { SBAR(); qkt<1, !SB>(pB0, pB1, K_lds, r32, hi, S.qr, BT(NT - 1)); SBAR(); }
    PART2(pA0, pA1, alA); SBAR();
    pv_tile<0>(o, vb0, pa0, pa1, pa2, pa3);
    if (even) { MASKT(pB0, pB1, NT - 1); PART1(pB0, pB1, mnB, alB); __syncthreads(); if constexpr (!SB) RESC(alB);
        PART2(pB0, pB1, alB); SBAR(); pv_tile<1>(o, vb0, pa0, pa1, pa2, pa3); }
    unsigned char* we_ = wsu; asm volatile("" : "+s"(we_));
    if (part != 0) {
        const int slot2 = ((((cur.P0 >> 8) - 8) & 7) * 16 + bh) * 2 + (part == 2 ? 1 : 0);
        float* po = (float*)(we_ + WS_PO) + (size_t)slot2 * 256 * 128; float* pml = (float*)(we_ + WS_PML) + (size_t)slot2 * 512;
        if (hi == 0) { pml[(wid * QBLK + r32) * 2] = m_reg; pml[(wid * QBLK + r32) * 2 + 1] = l_reg; }
#pragma unroll
        for (int r = 0; r < 16; ++r)
#pragma unroll
            for (int d0 = 0; d0 < 4; ++d0) po[(size_t)(wid * QBLK + crow(r, hi)) * D + d0 * 32 + r32] = o[d0][r];
        __syncthreads();
        return;
    }
    const bf16_t* gate = (const bf16_t*)(we_ + WS_SEC) + 3 * SEC_ELEMS + (size_t)(bh >> 3) * SEQ * 1024 + (bh & 7) * HD;
    bf16_t* outp = (bf16_t*)(we_ + WS_MIX) + (size_t)(bh >> 3) * SEQ * DM + (bh & 7) * HD;
    float rli[16];
    if constexpr (!SB) {
        if (hi == 0) li_l[r32] = l_reg; asm volatile("s_waitcnt lgkmcnt(0)" ::: "memory");
#pragma unroll
        for (int r = 0; r < 16; ++r) rli[r] = __builtin_amdgcn_rcpf(li_l[crow(r, hi)]);
    }
#pragma unroll
    for (int r = 0; r < 16; ++r) { const int orow = cur.P0 + wid * QBLK + crow(r, hi);
#pragma unroll
        for (int d0 = 0; d0 < 4; ++d0) {
            float v = o[d0][r];
            if constexpr (!SB) { const unsigned short gb = gate[(size_t)orow * 1024 + d0 * 32 + r32]; v = v * rli[r] * __builtin_bit_cast(float, (unsigned)gb << 16); }
            const float vn = __shfl_xor(v, 1);
            if ((r32 & 1) == 0) *(unsigned*)(outp + (size_t)orow * DM + d0 * 32 + r32) = cvt_pk_bf16(v, vn); } }
    __syncthreads();
#undef RESC
#undef KBASE
#undef MASKT
#undef BT
#undef PART1
#undef PART2
#undef HALF_STEP
}

constexpr float SB_TH = 150.f;
__device__ __forceinline__ void sb_unit(const UnitRef& cur, bf16_t* outp, char* lds) {
    const int tid = tid_opaque(), wid = __builtin_amdgcn_readfirstlane(tid >> 6), lane = tid & 63, r32 = lane & 31, hi = lane >> 5;
    const int NT = (cur.P0 + QB) / KVBLK;
#define KBASE(t) ((NT - 1 - (t)) * KVBLK)
    const int qlo = cur.P0 + wid * QBLK, qm = qlo + r32 - 4 * hi - 1;
    char* V_lds = lds; char* K_lds = lds + 2 * SHM_V;
    volatile int* flags = (volatile int*)(lds + OFF_WS);
    const int sr = tid >> 4, sc = (tid & 15) * 8, vst0 = v_st(sr, sc), vst1 = v_st(32 + sr, sc), kws = KSWZ(sr, sc * 2);
    const int vb0 = (int)(uintptr_t)V_lds + v_rd_base(lane);
    const bf16_t* Kh = cur.K; const bf16_t* Vh = cur.V;
    Seam S;
#pragma unroll
    for (int d0 = 0; d0 < 8; ++d0) S.qr[d0] = load8(cur.Q + (size_t)(wid * QBLK + r32) * D + d0 * 16 + hi * 8);
    SLOAD_H(Kh, Vh, KBASE(0)); VMW(); SWRITE_H(0);
    __syncthreads();
    f32x16 o[4] = {}; float carry = 0.f; const float mlo = hi ? 0.f : 1.f;
    bool wdone = false;
#define SB_STEP(tt, BUF) {                                                                                                 \
        const int kb_ = KBASE(tt);                                                                                           \
        if ((tt) + 1 < NT) SLOAD_H(Kh, Vh, KBASE((tt) + 1));                                                                 \
        SBAR();                                                                                                              \
        if (!wdone && kb_ <= qlo + QBLK - 2) {                                                                               \
            f32x16 p0, p1; bf16x8 pa0, pa1, pa2, pa3;                                                                        \
            qkt<BUF, false>(p0, p1, K_lds, r32, hi, S.qr, nullptr);                                                          \
            if (kb_ + KVBLK - 1 > qlo - 1) mask_tile(p0, p1, qm - kb_);                                                      \
            sb_part1(p0, p1, carry, mlo); sb_part2(p0, p1, pa0, pa1, pa2, pa3); SBAR();                                      \
            pv_tile<BUF>(o, vb0, pa0, pa1, pa2, pa3);                                                                        \
            wdone = __all(carry >= SB_TH);                                                                                   \
        }                                                                                                                    \
        if ((tt) + 1 < NT) { VMW(); SWRITE_H((BUF) ^ 1); }                                                                   \
        if (lane == 0) flags[((tt) & 1) * 8 + wid] = wdone ? 1 : 0;                                                          \
        __syncthreads();                                                                                                     \
        { int alld = 1;                                                                                                      \
          _Pragma("unroll") for (int w_ = 0; w_ < 8; ++w_) alld &= flags[((tt) & 1) * 8 + w_];                                \
          if (alld) break; } }
    for (int t = 0; t < NT; t += 2) {
        SB_STEP(t, 0)
        SB_STEP(t + 1, 1)
    }
#undef SB_STEP
#pragma unroll
    for (int r = 0; r < 16; ++r) { const int orow = cur.P0 + wid * QBLK + crow(r, hi);
#pragma unroll
        for (int d0 = 0; d0 < 4; ++d0) {
            const float v = o[d0][r];
            const float vn = __shfl_xor(v, 1);
            if ((r32 & 1) == 0) *(unsigned*)(outp + (size_t)orow * DM + d0 * 32 + r32) = cvt_pk_bf16(v, vn); } }
    __syncthreads();
#undef KBASE
}
#undef ROW
#undef VMW
#undef SLOAD_H
#undef SWRITE_HK
#undef SWRITE_HV
#undef SWRITE_H
}

struct Args { const float* in[12]; float* out; unsigned char* ws; int ph_lo, ph_hi; };

__device__ __forceinline__ void p0_transpose_item(const float* W, int ldw, int K, bf16_t* WT, int nblk, LAS float* scr, int item, int lane, const float* gk) {
    const int kb = item / nblk, nb = item % nblk, k0 = 64 * kb, n0 = 32 * nb;
#pragma unroll 8
    for (int i = 0; i < 32; ++i) { const int kk = 2 * i + (lane >> 5); float w = W[(size_t)(k0 + kk) * ldw + n0 + (lane & 31)]; if (gk) w *= gk[k0 + kk]; scr[kk * 33 + (lane & 31)] = w; }
    LDS_WAIT(); asm volatile("" ::: "memory");
    const int c = lane & 7;
#pragma unroll
    for (int j = 0; j < 4; ++j) { const int n = (lane >> 3) + 8 * j; const LAS float* s = scr + (8 * c) * 33 + n;
        u32x4 o; o.x = cvt_pk_bf16(s[0 * 33], s[1 * 33]); o.y = cvt_pk_bf16(s[2 * 33], s[3 * 33]); o.z = cvt_pk_bf16(s[4 * 33], s[5 * 33]); o.w = cvt_pk_bf16(s[6 * 33], s[7 * 33]);
        *(u32x4*)(WT + (size_t)(n0 + n) * K + k0 + 8 * c) = o; }
    LDS_WAIT(); asm volatile("" ::: "memory");
}

__device__ __forceinline__ int pack_i8(float a, float b, float c, float d) {
    const int ia = (int)__builtin_rintf(a), ib = (int)__builtin_rintf(b), ic = (int)__builtin_rintf(c), id = (int)__builtin_rintf(d);
    return (int)(((unsigned)ia & 0xffu) | (((unsigned)ib & 0xffu) << 8) | (((unsigned)ic & 0xffu) << 16) | ((unsigned)id << 24));
}
__device__ __forceinline__ void convert_tables(const Args& a, int r0, int r1, int worker, int nworkers) {
    const int lane = tid_opaque() & 63;
    unsigned char* ws = a.ws; const float* g_ffn = a.in[7]; const float* pu = a.in[10]; const float* pv = a.in[11];
    float* suv = (float*)(ws + WS_SUV);
    for (int r = r0 + worker; r < r1; r += nworkers) {
        const bool isv = r >= NEXP; const int e = isv ? r - NEXP : r;
        const f32x4* srcp = (const f32x4*)((isv ? pv : pu) + (size_t)e * DM);
        f32x4 v[8]; float amax = 0.f;
#pragma unroll
        for (int j = 0; j < 8; ++j) { v[j] = srcp[lane + 64 * j];
            if (!isv) { const f32x4 g4 = *(const f32x4*)(g_ffn + 4 * (lane + 64 * j)); v[j] = v[j] * g4; }
            amax = fmaxf(amax, fmaxf(fmaxf(fabsf(v[j][0]), fabsf(v[j][1])), fmaxf(fabsf(v[j][2]), fabsf(v[j][3])))); }
        amax = wave_max(amax);
        const float sc = amax > 0.f ? 127.f / amax : 1.f;
        unsigned char* dst = ws + (isv ? WS_V8 : WS_U8) + (size_t)e * 128;
#pragma unroll
        for (int j = 0; j < 8; ++j) { const int p = pack_i8(v[j][0] * sc, v[j][1] * sc, v[j][2] * sc, v[j][3] * sc);
            const int col = 4 * (lane + 64 * j);
            *(unsigned*)(dst + (size_t)(col >> 7) * ((size_t)NEXP * 128) + (col & 127)) = (unsigned)p; }
        if (lane == 0) suv[r] = 1.f / sc;
    }
}
constexpr int TAB_SPLIT = NEXP;

__device__ __forceinline__ float log_sigmoid_f(float x) { return fminf(x, 0.f) - log1pf(expf(-fabsf(x))); }

__device__ __forceinline__ void phase0(const Args& a, unsigned char* lds_g) {
    LAS unsigned char* lds = (LAS unsigned char*)lds_g;
    const int tid = tid_opaque(), lane = tid & 63, wave = __builtin_amdgcn_readfirstlane(tid >> 6);
    const int gw = blockIdx.x * NWAVES + wave, NGW = gridDim.x * NWAVES;
    const int gt = blockIdx.x * NTHREADS + tid, NGT = gridDim.x * NTHREADS;
    unsigned char* ws = a.ws;
    const float* x = a.in[0]; const float* g_attn = a.in[1]; const float* w_in = a.in[2]; const float* b_forget = a.in[3];
    const float* w_out = a.in[6]; const float* g_ffn = a.in[7]; const float* w_pq = a.in[8]; const float* sk = a.in[9]; const float* pu = a.in[10]; const float* pv = a.in[11];
    LAS float* wf = (LAS float*)(lds + 67584);
    for (int k = tid; k < DM; k += NTHREADS) { const f32x4 a0 = *(const f32x4*)(w_in + (size_t)k * DIN + NPROJ), a1 = *(const f32x4*)(w_in + (size_t)k * DIN + NPROJ + 4);
        *(LAS f32x4*)(wf + k * 8) = a0; *(LAS f32x4*)(wf + k * 8 + 4) = a1; }
    __syncthreads();
    for (int row = gw; row < T; row += NGW) {
        const f32x4* xr = (const f32x4*)(x + (size_t)row * DM);
        f32x4 v[8]; float ss = 0.f;
#pragma unroll
        for (int j = 0; j < 8; ++j) { v[j] = xr[lane + 64 * j]; ss += v[j][0] * v[j][0] + v[j][1] * v[j][1] + v[j][2] * v[j][2] + v[j][3] * v[j][3]; }
        const float r = 1.0f / sqrtf(wave_sum(ss) * (1.f / DM) + EPS);
        float f[8] = {0.f, 0.f, 0.f, 0.f, 0.f, 0.f, 0.f, 0.f};
        u32x2* o8 = (u32x2*)(ws + WS_XN + (size_t)row * DM * 2);
#pragma unroll
        for (int j = 0; j < 8; ++j) {
            const int e = 4 * (lane + 64 * j);
            const f32x4 g4 = *(const f32x4*)(g_attn + e);
            f32x4 xn; xn[0] = v[j][0] * r * g4[0]; xn[1] = v[j][1] * r * g4[1]; xn[2] = v[j][2] * r * g4[2]; xn[3] = v[j][3] * r * g4[3];
            u32x2 w; w.x = cvt_pk_bf16(xn[0], xn[1]); w.y = cvt_pk_bf16(xn[2], xn[3]); o8[lane + 64 * j] = w;
#pragma unroll
            for (int q = 0; q < 4; ++q) { const f32x4 w0 = *(LAS f32x4*)(wf + (e + q) * 8), w1 = *(LAS f32x4*)(wf + (e + q) * 8 + 4);
                f[0] += xn[q] * w0[0]; f[1] += xn[q] * w0[1]; f[2] += xn[q] * w0[2]; f[3] += xn[q] * w0[3];
                f[4] += xn[q] * w1[0]; f[5] += xn[q] * w1[1]; f[6] += xn[q] * w1[2]; f[7] += xn[q] * w1[3]; }
        }
#pragma unroll
        for (int hh = 0; hh < 8; ++hh) f[hh] = wave_sum(f[hh]);
        if (lane < 8) { float fl = f[0];
#pragma unroll
            for (int hh = 1; hh < 8; ++hh) fl = (lane == hh) ? f[hh] : fl;
            const int b = row >> 12, s = row & 4095;
            ((float*)(ws + WS_LOGF))[(size_t)(b * 8 + lane) * SEQ + s] = log_sigmoid_f(fl + b_forget[lane]); }
    }
    LAS float* scr = (LAS float*)(lds + wave * 8448);
    constexpr int I_IN = (DM / 64) * (NPROJ / 32), I_O = (DM / 64) * (DM / 32);
    for (int it = gw; it < I_IN + 2 * I_O; it += NGW) {
        int r = it;
        if (r < I_IN) { p0_transpose_item(w_in, DIN, DM, (bf16_t*)(ws + WS_WIN), NPROJ / 32, scr, r, lane, nullptr); continue; } r -= I_IN;
        if (r < I_O) { p0_transpose_item(w_out, DM, DM, (bf16_t*)(ws + WS_WOUT), DM / 32, scr, r, lane, nullptr); continue; } r -= I_O;
        p0_transpose_item(w_pq, DM, DM, (bf16_t*)(ws + WS_WPQ), DM / 32, scr, r, lane, g_ffn);
    }
    for (int i = gt; i < 8 * 2 * 128 * 128 / 8; i += NGT) { const f32x4 a0 = *(const f32x4*)(sk + (size_t)i * 8), a1 = *(const f32x4*)(sk + (size_t)i * 8 + 4);
        u32x4 w; w.x = cvt_pk_bf16(a0[0], a0[1]); w.y = cvt_pk_bf16(a0[2], a0[3]); w.z = cvt_pk_bf16(a1[0], a1[1]); w.w = cvt_pk_bf16(a1[2], a1[3]);
        *(u32x4*)(ws + WS_SK + (size_t)i * 16) = w; }
    if (gt < 256) ((float*)(ws + WS_GQK))[gt] = gt < 128 ? a.in[4][gt] : a.in[5][gt - 128];
    convert_tables(a, 0, TAB_SPLIT, gw, NGW);
}

__device__ __forceinline__ void cumsum_rows(const Args& a) {
    const int tid = tid_opaque(), lane = tid & 63, wave = tid >> 6;
    if (blockIdx.x >= 16 || wave != 0) return;
    const float* src = (const float*)(a.ws + WS_LOGF) + (size_t)blockIdx.x * SEQ + lane * 64;
    float* dst = (float*)(a.ws + WS_C) + (size_t)blockIdx.x * SEQ + lane * 64;
    f32x4 v[16]; float run = 0.f;
#pragma unroll
    for (int i = 0; i < 16; ++i) { v[i] = *(const f32x4*)(src + 4 * i);
#pragma unroll
        for (int q = 0; q < 4; ++q) { run += v[i][q]; v[i][q] = run; } }
    float incl = run;
#pragma unroll
    for (int o = 1; o < 64; o <<= 1) { const float t = __shfl_up(incl, o); if (lane >= o) incl += t; }
    const float off = incl - run;
#pragma unroll
    for (int i = 0; i < 16; ++i) { f32x4 w = v[i]; w[0] += off; w[1] += off; w[2] += off; w[3] += off; *(f32x4*)(dst + 4 * i) = w; }
}

__device__ __forceinline__ void phase_qknorm(const Args& a) {
    const int tid = tid_opaque(), lane = tid & 63, wave = tid >> 6;
    const int gw = blockIdx.x * NWAVES + wave, NGW = gridDim.x * NWAVES;
    const int sub = lane & 15, rw = lane >> 4;
    const float* gq = a.in[4]; const float* gk = a.in[5];
    constexpr int ROWS = NB * NHF * SEQ;
    for (int it = gw; it < 2 * ROWS / 4; it += NGW) {
        const int row = it * 4 + rw; const bool isk = row >= ROWS;
        bf16_t* p = (bf16_t*)(a.ws + WS_SEC) + (size_t)row * HD + sub * 8;
        const float* g = (isk ? gk : gq) + sub * 8;
        const u32x4 w = *(const u32x4*)p;
        float v[8] = {bf_lo(w.x), bf_hi(w.x), bf_lo(w.y), bf_hi(w.y), bf_lo(w.z), bf_hi(w.z), bf_lo(w.w), bf_hi(w.w)};
        float ss = 0.f;
#pragma unroll
        for (int i = 0; i < 8; ++i) ss += v[i] * v[i];
        ss += __shfl_xor(ss, 1); ss += __shfl_xor(ss, 2); ss += __shfl_xor(ss, 4); ss += __shfl_xor(ss, 8);
        const float r = 1.0f / sqrtf(ss * (1.f / HD) + EPS);
        const f32x4 g0 = *(const f32x4*)g, g1 = *(const f32x4*)(g + 4);
        u32x4 o; o.x = cvt_pk_bf16(v[0] * r * g0[0], v[1] * r * g0[1]); o.y = cvt_pk_bf16(v[2] * r * g0[2], v[3] * r * g0[3]);
        o.z = cvt_pk_bf16(v[4] * r * g1[0], v[5] * r * g1[1]); o.w = cvt_pk_bf16(v[6] * r * g1[2], v[7] * r * g1[3]);
        *(u32x4*)p = o;
    }
}

__device__ __forceinline__ void phase_attn(const Args& a, unsigned char* lds_g) {
    const int tid = tid_opaque();
    volatile int* s_item = (volatile int*)(lds_g + MISC_OFF);
    unsigned* ctr = (unsigned*)(a.ws + WS_CTL);
    for (;;) {
        __syncthreads();
        if (tid == 0) *s_item = (int)atomicAdd(ctr, 1u);
        __syncthreads();
        int it = *s_item, kind = -1, qb = 0, sub = 0;
#define CLS(K, Q, CNT) if (kind < 0) { if (it < (CNT)) { kind = (K); qb = (Q); sub = it; } else it -= (CNT); }
        CLS(2, 15, 32) CLS(1, 7, 16) CLS(2, 14, 32) CLS(2, 13, 32) CLS(1, 6, 16) CLS(2, 12, 32) CLS(2, 11, 32) CLS(1, 5, 16) CLS(2, 10, 32) CLS(2, 9, 32) CLS(1, 4, 16) CLS(2, 8, 32) CLS(1, 3, 16) CLS(1, 2, 16)
        if (kind < 0) { if (it < 256) { kind = 0; qb = 15 - (it >> 4); sub = it & 15; } else it -= 256; }
        CLS(1, 1, 16) CLS(1, 0, 16)
#undef CLS
        if (kind < 0) break;
        unsigned char* wsl = a.ws; asm volatile("" : "+s"(wsl));
        bf16_t* sec = (bf16_t*)(wsl + WS_SEC);
        const int bh = sub & 15, part = (kind == 2) ? 1 + (sub >> 4) : 0;
        const int b = bh >> 3, h = bh & 7;
        const size_t hoff = (size_t)bh * SEQ * HD;
        att::UnitRef u;
        u.P0 = qb * 256;
        if (kind == 0) {
            u.Q = sec + 4 * SEC_ELEMS + hoff + (size_t)u.P0 * HD; u.K = sec + 5 * SEC_ELEMS + hoff; u.V = sec + 6 * SEC_ELEMS + hoff;
            att::sb_unit(u, (bf16_t*)(wsl + WS_MIX) + (size_t)b * SEQ * DM + 1024 + h * HD, (char*)lds_g);
        } else {
            u.Q = sec + 0 * SEC_ELEMS + hoff + (size_t)u.P0 * HD; u.K = sec + 1 * SEC_ELEMS + hoff; u.V = sec + 2 * SEC_ELEMS + hoff;
            att::attn_unit<false>(u, wsl, bh, (char*)lds_g, part);
        }
    }
}
__device__ __forceinline__ void phase_attn_combine(const Args& a) {
    const int gt = blockIdx.x * NTHREADS + tid_opaque(), NGT = gridDim.x * NTHREADS;
    const float* po = (const float*)(a.ws + WS_PO); const float* pml = (const float*)(a.ws + WS_PML);
    const bf16_t* gate = (const bf16_t*)(a.ws + WS_SEC) + 3 * SEC_ELEMS; bf16_t* mix = (bf16_t*)(a.ws + WS_MIX);
    constexpr float C2 = LOG2E * SCALE;
    for (int item = gt; item < 128 * 256 * 16; item += NGT) {
        const int slot = item >> 12, row = (item >> 4) & 255, cg = item & 15;
        const int qb = 8 + (slot >> 4), bh = slot & 15, b = bh >> 3, h = bh & 7;
        const f32x2 ml1 = *(const f32x2*)(pml + (size_t)(slot * 2) * 512 + row * 2), ml2 = *(const f32x2*)(pml + (size_t)(slot * 2 + 1) * 512 + row * 2);
        const float M = fmaxf(ml1.x, ml2.x), a1 = __builtin_amdgcn_exp2f((ml1.x - M) * C2), a2 = __builtin_amdgcn_exp2f((ml2.x - M) * C2);
        const float inv = 1.f / (a1 * ml1.y + a2 * ml2.y);
        const float* p1 = po + (size_t)(slot * 2) * 32768 + row * 128 + cg * 8; const float* p2 = p1 + 32768;
        const f32x4 x0 = *(const f32x4*)p1, x1 = *(const f32x4*)(p1 + 4), y0 = *(const f32x4*)p2, y1 = *(const f32x4*)(p2 + 4);
        const size_t tok = (size_t)b * SEQ + qb * 256 + row;
        const u32x4 gw = *(const u32x4*)(gate + tok * 1024 + h * HD + cg * 8);
        const float w1 = a1 * inv, w2 = a2 * inv;
        u32x4 o;
        o.x = cvt_pk_bf16((w1 * x0[0] + w2 * y0[0]) * bf_lo(gw.x), (w1 * x0[1] + w2 * y0[1]) * bf_hi(gw.x));
        o.y = cvt_pk_bf16((w1 * x0[2] + w2 * y0[2]) * bf_lo(gw.y), (w1 * x0[3] + w2 * y0[3]) * bf_hi(gw.y));
        o.z = cvt_pk_bf16((w1 * x1[0] + w2 * y1[0]) * bf_lo(gw.z), (w1 * x1[1] + w2 * y1[1]) * bf_hi(gw.z));
        o.w = cvt_pk_bf16((w1 * x1[2] + w2 * y1[2]) * bf_lo(gw.w), (w1 * x1[3] + w2 * y1[3]) * bf_hi(gw.w));
        *(u32x4*)(mix + tok * DM + h * HD + cg * 8) = o;
    }
}

__device__ __forceinline__ unsigned f2ord(float f) { const unsigned u = __float_as_uint(f); return u ^ ((unsigned)((int)u >> 31) | 0x80000000u); }
__device__ __forceinline__ float ord2f(unsigned k) { const unsigned u = k ^ (~(unsigned)((int)k >> 31) | 0x80000000u); return __uint_as_float(u); }
#define INS16(L, X) do { unsigned x_ = (X); _Pragma("unroll") for (int i_ = 0; i_ < 16; ++i_) { const unsigned hi_ = max(L[i_], x_); x_ = min(L[i_], x_); L[i_] = hi_; } } while (0)
__device__ __forceinline__ void topk_half(const bf16_t* qp, const bf16_t* skb, int t0, int h, int c, int r32, int hi, unsigned (&L)[16]) {
    bf16x8 qf[8];
#pragma unroll
    for (int d0 = 0; d0 < 8; ++d0) qf[d0] = *(const bf16x8*)(qp + (size_t)(t0 + r32) * DM + h * 256 + c * 128 + d0 * 16 + hi * 8);
#pragma unroll
    for (int i = 0; i < 16; ++i) L[i] = 0u;
    const unsigned hi4 = 4u * (unsigned)hi;
#pragma unroll
    for (int kt = 0; kt < 4; ++kt) {
        f32x16 acc = f32x16{};
#pragma unroll
        for (int d0 = 0; d0 < 8; ++d0) { const bf16x8 kf = *(const bf16x8*)(skb + (size_t)((h * 2 + c) * 128 + kt * 32 + r32) * 128 + d0 * 16 + hi * 8);
            acc = __builtin_amdgcn_mfma_f32_32x32x16_bf16(kf, qf[d0], acc, 0, 0, 0); }
        __builtin_amdgcn_sched_barrier(0);
#pragma unroll
        for (int r = 0; r < 16; ++r) { const unsigned cst = (unsigned)(127 - (kt * 32 + (r & 3) + 8 * (r >> 2)));
            const unsigned kk = (f2ord(acc[r]) & ~127u) | (cst - hi4); INS16(L, kk); }
        __builtin_amdgcn_sched_barrier(0);
    }
    unsigned P[16];
#pragma unroll
    for (int i = 0; i < 16; ++i) { auto rr = __builtin_amdgcn_permlane32_swap(L[i], L[i], false, false); P[i] = hi ? rr[0] : rr[1]; }
#pragma unroll
    for (int i = 0; i < 16; ++i) INS16(L, P[i]);
}
__device__ __forceinline__ void phase_topk(const Args& a, unsigned char* lds_g) {
    LAS unsigned char* lds = (LAS unsigned char*)lds_g;
    const int tid = tid_opaque(), lane = tid & 63, wave = tid >> 6, r32 = lane & 31, hi = lane >> 5;
    const int gw = blockIdx.x * NWAVES + wave, NGW = gridDim.x * NWAVES;
    const bf16_t* skb = (const bf16_t*)(a.ws + WS_SK); const bf16_t* qp = (const bf16_t*)(a.ws + WS_QP);
    int* idx_o = (int*)(a.ws + WS_IDX); float* gw_o = (float*)(a.ws + WS_GW);
    for (int task = gw; task < (T / 32) * 8; task += NGW) {
        const int h = task & 7, t0 = (task >> 3) * 32;
        {
          const bf16_t* hbp = (const bf16_t*)(a.ws + WS_HB); const float* amx = (const float*)(a.ws + WS_AMX); unsigned char* xq = a.ws + WS_XQ;
          float am = 0.f;
          { const f32x4* ap = (const f32x4*)(amx + (size_t)(t0 + (lane & 31)) * 32);
#pragma unroll
            for (int i = 0; i < 8; ++i) { const f32x4 v = ap[i]; am = fmaxf(am, fmaxf(fmaxf(v[0], v[1]), fmaxf(v[2], v[3]))); } }
          if (h == 0 && lane < 32) ((float*)(a.ws + WS_SX))[t0 + lane] = ((const float*)(a.ws + WS_RT))[t0 + lane] * am * (1.f / 126.5f);
          const float qs = am > 0.f ? 126.5f / am : 1.f;
#pragma unroll 4
          for (int j = 0; j < 16; ++j) { const int ch = lane + 64 * j, tl = ch >> 5, tk = t0 + tl, col = h * 256 + (ch & 31) * 8;
              const u32x4 w = *(const u32x4*)(hbp + (size_t)tk * DM + col); const float r = __shfl(qs, tl);
              const int p0 = pack_i8(bf_lo(w.x) * r, bf_hi(w.x) * r, bf_lo(w.y) * r, bf_hi(w.y) * r), p1 = pack_i8(bf_lo(w.z) * r, bf_hi(w.z) * r, bf_lo(w.w) * r, bf_hi(w.w) * r);
              *(u32x2*)(xq + (size_t)tk * DM + col) = (u32x2){(unsigned)p0, (unsigned)p1}; } }
        unsigned L[2][16];
        topk_half(qp, skb, t0, h, 0, r32, hi, L[0]);
        __builtin_amdgcn_sched_barrier(0);
        topk_half(qp, skb, t0, h, 1, r32, hi, L[1]);
        __builtin_amdgcn_sched_barrier(0);
        float s1[16], s2[16]; int i1[16], i2[16];
#pragma unroll
        for (int i = 0; i < 16; ++i) { s1[i] = ord2f((L[0][i] & ~127u) | 64u); i1[i] = 127 - (int)(L[0][i] & 127u); s2[i] = ord2f((L[1][i] & ~127u) | 64u); i2[i] = 127 - (int)(L[1][i] & 127u); }
        unsigned LC[16];
#pragma unroll
        for (int i = 0; i < 16; ++i) LC[i] = 0u;
#pragma unroll
        for (int aa = 0; aa < 16; ++aa)
#pragma unroll
            for (int bb = 0; bb < 16; ++bb) if ((aa + 1) * (bb + 1) <= 16) { const unsigned kk = (f2ord(s1[aa] + s2[bb]) & ~255u) | (unsigned)(aa * 16 + bb); INS16(LC, kk); }
        LAS int* tb = (LAS int*)(lds + wave * 8192);
#pragma unroll
        for (int i = 0; i < 16; ++i) { tb[i * 64 + lane] = i1[i]; tb[(16 + i) * 64 + lane] = i2[i]; }
        float LS[16]; int LP[16];
#pragma unroll
        for (int i = 0; i < 16; ++i) { const unsigned cid = LC[i] & 255u; LS[i] = ord2f((LC[i] & ~255u) | 128u);
            LP[i] = tb[(cid >> 4) * 64 + lane] * 128 + tb[(16 + (cid & 15u)) * 64 + lane]; }
        float den = 0.f, e[16];
#pragma unroll
        for (int i = 0; i < 16; ++i) { e[i] = __expf(LS[i] - LS[0]); den += e[i]; }
        const float rden = 1.f / den;
        const size_t ob = (size_t)(t0 + r32) * NE + h * 16;
        if (hi == 0) {
#pragma unroll
            for (int i = 0; i < 4; ++i) *(int4*)(idx_o + ob + 4 * i) = make_int4(LP[4 * i], LP[4 * i + 1], LP[4 * i + 2], LP[4 * i + 3]);
        } else {
#pragma unroll
            for (int i = 0; i < 4; ++i) *(f32x4*)(gw_o + ob + 4 * i) = (f32x4){e[4 * i] * rden, e[4 * i + 1] * rden, e[4 * i + 2] * rden, e[4 * i + 3] * rden};
        }
    }
}


__device__ __forceinline__ void wave_argmax(float& v, int& i) {
#pragma unroll
    for (int o = 1; o < 64; o <<= 1) { const float ov = __shfl_xor(v, o); const int oi = __shfl_xor(i, o); if (ov > v || (ov == v && oi < i)) { v = ov; i = oi; } }
}
__device__ __forceinline__ void phase_topk_ref(const Args& a) {
    const int tid = tid_opaque(), lane = tid & 63, wave = tid >> 6;
    const int gw = blockIdx.x * NWAVES + wave, NGW = gridDim.x * NWAVES;
    const bf16_t* skb = (const bf16_t*)(a.ws + WS_SK); const bf16_t* qp = (const bf16_t*)(a.ws + WS_QP);
    int* idx_o = (int*)(a.ws + WS_IDX); float* gw_o = (float*)(a.ws + WS_GW);
    for (int task = gw; task < T * 8; task += NGW) {
        const int t = task >> 3, h = task & 7;
        float topS[2]; int topI[2];
        for (int c = 0; c < 2; ++c) {
            const bf16_t* q = qp + (size_t)t * DM + h * 256 + c * 128;
            float sc0 = 0.f, sc1 = 0.f;
            const bf16_t* k0 = skb + (size_t)((h * 2 + c) * 128 + lane) * 128; const bf16_t* k1 = k0 + 64 * 128;
            for (int d = 0; d < 128; ++d) { const float qd = __uint_as_float((unsigned)q[d] << 16);
                sc0 += qd * __uint_as_float((unsigned)k0[d] << 16); sc1 += qd * __uint_as_float((unsigned)k1[d] << 16); }
            float ms = 0.f; int mi = 0;
            for (int r = 0; r < 16; ++r) {
                float v; int i; if (sc0 >= sc1) { v = sc0; i = lane; } else { v = sc1; i = lane + 64; }
                wave_argmax(v, i);
                if (lane == r) { ms = v; mi = i; }
                if (i == lane) sc0 = -__builtin_inff();
                if (i == lane + 64) sc1 = -__builtin_inff();
            }
            topS[c] = ms; topI[c] = mi;
        }
        float cs[4]; int ci[4];
#pragma unroll
        for (int j = 0; j < 4; ++j) { const int cidx = lane * 4 + j, aa = cidx >> 4, bb = cidx & 15;
            cs[j] = __shfl(topS[0], aa) + __shfl(topS[1], bb); ci[j] = cidx; }
        float fs = 0.f; int fi = 0;
        for (int r = 0; r < 16; ++r) {
            float v = cs[0]; int i = ci[0];
#pragma unroll
            for (int j = 1; j < 4; ++j) if (cs[j] > v) { v = cs[j]; i = ci[j]; }
            wave_argmax(v, i);
            if (lane == r) { fs = v; fi = i; }
#pragma unroll
            for (int j = 0; j < 4; ++j) if (ci[j] == i) cs[j] = -__builtin_inff();
        }
        const int e1 = __shfl(topI[0], fi >> 4), e2 = __shfl(topI[1], fi & 15);
        const float mx = __shfl(fs, 0);
        float ev = lane < 16 ? __expf(fs - mx) : 0.f;
        const float den = wave_sum(ev);
        if (lane < 16) { idx_o[(size_t)t * NE + h * 16 + lane] = e1 * 128 + e2; gw_o[(size_t)t * NE + h * 16 + lane] = ev / den; }
    }
}

__device__ __forceinline__ void fp8x16_to_f32(const u32x4 q, f32x2 (&o)[8]) {
    o[0] = __builtin_amdgcn_cvt_pk_f32_fp8((int)q.x, false); o[1] = __builtin_amdgcn_cvt_pk_f32_fp8((int)q.x, true);
    o[2] = __builtin_amdgcn_cvt_pk_f32_fp8((int)q.y, false); o[3] = __builtin_amdgcn_cvt_pk_f32_fp8((int)q.y, true);
    o[4] = __builtin_amdgcn_cvt_pk_f32_fp8((int)q.z, false); o[5] = __builtin_amdgcn_cvt_pk_f32_fp8((int)q.z, true);
    o[6] = __builtin_amdgcn_cvt_pk_f32_fp8((int)q.w, false); o[7] = __builtin_amdgcn_cvt_pk_f32_fp8((int)q.w, true);
}
#define HALVE(dst, srcv, n, bitmask) do { const bool up_ = (lane & (bitmask)) != 0; _Pragma("unroll") for (int i_ = 0; i_ < (n); ++i_) { \
        const float keep_ = up_ ? srcv[(n) + i_] : srcv[i_], send_ = up_ ? srcv[i_] : srcv[(n) + i_]; dst[i_] = keep_ + __shfl_xor(send_, (bitmask)); } } while (0)
#define ITEM_T(n) (wv + ((n) % KT) * NWX)
#define ITEM_S(n) (xl + 8 * ((n) / KT))
#define LD_IDX(ID, n) do { const int4* ip_ = (const int4*)(idx_i + (size_t)ITEM_T(n) * NE + g * 16); _Pragma("unroll") for (int i_ = 0; i_ < 4; ++i_) ID[i_] = ip_[i_]; } while (0)
#define LD_ROWS(Q, ID, TAB, n) do { const unsigned char* b_ = (TAB) + (size_t)ITEM_S(n) * ((size_t)NEXP * 128) + c * 16; _Pragma("unroll") for (int i_ = 0; i_ < 4; ++i_) { \
        Q[4 * i_] = *(const u32x4*)(b_ + (size_t)ID[i_].x * 128); Q[4 * i_ + 1] = *(const u32x4*)(b_ + (size_t)ID[i_].y * 128); \
        Q[4 * i_ + 2] = *(const u32x4*)(b_ + (size_t)ID[i_].z * 128); Q[4 * i_ + 3] = *(const u32x4*)(b_ + (size_t)ID[i_].w * 128); } } while (0)
__device__ __forceinline__ int dpp_hmirror(int v) { return __builtin_amdgcn_update_dpp(0, v, 0x141, 0xf, 0xf, true); }
__device__ __forceinline__ int dpp_qxor2(int v) { return __builtin_amdgcn_update_dpp(0, v, 0x4E, 0xf, 0xf, true); }
__device__ __forceinline__ int dpp_qxor1(int v) { return __builtin_amdgcn_update_dpp(0, v, 0xB1, 0xf, 0xf, true); }
__device__ __forceinline__ void phase_peer_u(const Args& a) {
    const int tid = tid_opaque(), lane = tid & 63, wave = tid >> 6, g = lane >> 3, c = lane & 7;
    const int xl = blockIdx.x & 7, wv = (blockIdx.x >> 3) * NWAVES + wave, NWX = (gridDim.x >> 3) * NWAVES, KT = T / NWX, N = 2 * KT;
    const unsigned char* xq = a.ws + WS_XQ; const unsigned char* u8 = a.ws + WS_U8;
    const int* idx_i = (const int*)(a.ws + WS_IDX); float* part = (float*)(a.ws + WS_PART);
    const bool up4 = (c & 4) != 0, up2 = (c & 2) != 0, up1 = (c & 1) != 0;
#define LD_X(X, n) do { X = *(const u32x4*)(xq + (size_t)ITEM_T(n) * DM + ITEM_S(n) * 128 + c * 16); } while (0)
#define COMPUTE_U(Q, X, n) do { int p[16]; \
        _Pragma("unroll") for (int i = 0; i < 16; ++i) { int d_ = __builtin_amdgcn_sdot4((int)Q[i].x, (int)X.x, 0, false); d_ = __builtin_amdgcn_sdot4((int)Q[i].y, (int)X.y, d_, false); \
            d_ = __builtin_amdgcn_sdot4((int)Q[i].z, (int)X.z, d_, false); p[i] = __builtin_amdgcn_sdot4((int)Q[i].w, (int)X.w, d_, false); } \
        int p8[8], p4[4], p2[2]; \
        _Pragma("unroll") for (int i = 0; i < 8; ++i) { const int keep_ = up4 ? p[8 + i] : p[i], send_ = up4 ? p[i] : p[8 + i]; p8[i] = keep_ + dpp_hmirror(send_); } \
        _Pragma("unroll") for (int i = 0; i < 4; ++i) { const int keep_ = up2 ? p8[4 + i] : p8[i], send_ = up2 ? p8[i] : p8[4 + i]; p4[i] = keep_ + dpp_qxor2(send_); } \
        _Pragma("unroll") for (int i = 0; i < 2; ++i) { const int keep_ = up1 ? p4[2 + i] : p4[i], send_ = up1 ? p4[i] : p4[2 + i]; p2[i] = keep_ + dpp_qxor1(send_); } \
        *(f32x2*)(part + ((size_t)ITEM_T(n) * 16 + ITEM_S(n)) * NE + 2 * lane) = (f32x2){(float)p2[0], (float)p2[1]}; } while (0)
    int4 IA[4], IB[4]; u32x4 QA[16], QB[16], XA, XB;
    LD_IDX(IA, 0); LD_IDX(IB, 1);
    LD_ROWS(QA, IA, u8, 0); LD_X(XA, 0);
    for (int n = 0; n < N; n += 2) {
        LD_ROWS(QB, IB, u8, n + 1); LD_X(XB, n + 1);
        if (n + 2 < N) LD_IDX(IA, n + 2);
        COMPUTE_U(QA, XA, n);
        if (n + 2 < N) { LD_ROWS(QA, IA, u8, n + 2); LD_X(XA, n + 2); }
        if (n + 3 < N) LD_IDX(IB, n + 3);
        COMPUTE_U(QB, XB, n + 1);
    }
#undef LD_X
#undef COMPUTE_U
}
__device__ __forceinline__ void phase_peer_w(const Args& a) {
    const int gt = blockIdx.x * NTHREADS + tid_opaque(), NGT = gridDim.x * NTHREADS;
    const int* idx_i = (const int*)(a.ws + WS_IDX); const float* gw_i = (const float*)(a.ws + WS_GW); const float* part = (const float*)(a.ws + WS_PART);
    const float* suv = (const float*)(a.ws + WS_SUV); const float* sx = (const float*)(a.ws + WS_SX);
    signed char* wq = (signed char*)(a.ws + WS_WQ); float* sw = (float*)(a.ws + WS_SW);
    for (int item = gt; item < T * NE; item += NGT) {
        const int t = item >> 7, e = item & 127;
        float sum = 0.f;
#pragma unroll
        for (int s = 0; s < 16; ++s) sum += part[((size_t)t * 16 + s) * NE + e];
        const int ex = idx_i[item];
        const float d = sum * suv[ex] * sx[t];
        const float om = 0.5f * d * (1.f + erff(d * 0.70710678118654752f)) * gw_i[item] * suv[NEXP + ex];
        float mx = fabsf(om);
        mx = fmaxf(mx, __shfl_xor(mx, 1)); mx = fmaxf(mx, __shfl_xor(mx, 2)); mx = fmaxf(mx, __shfl_xor(mx, 4)); mx = fmaxf(mx, __shfl_xor(mx, 8));
        const float qs = mx > 0.f ? 127.f / mx : 1.f;
        wq[item] = (signed char)(int)__builtin_rintf(om * qs);
        if ((e & 15) == 0) sw[t * 8 + (e >> 4)] = mx * (1.f / 127.f);
    }
}
__device__ __forceinline__ void phase_peer_v(const Args& a, float* dst) {
    const int tid = tid_opaque(), lane = tid & 63, wave = tid >> 6, g = lane >> 3, c = lane & 7;
    const int xl = blockIdx.x & 7, wv = (blockIdx.x >> 3) * NWAVES + wave, NWX = (gridDim.x >> 3) * NWAVES, KT = T / NWX, N = 2 * KT;
    const unsigned char* v8 = a.ws + WS_V8;
    const int* idx_i = (const int*)(a.ws + WS_IDX); const unsigned char* wq = a.ws + WS_WQ; const float* sw = (const float*)(a.ws + WS_SW);
    const float* hsrc = a.out;
#define LD_W(W, SWV, n) do { W = *(const u32x4*)(wq + (size_t)ITEM_T(n) * NE + g * 16); SWV = sw[ITEM_T(n) * 8 + g]; } while (0)
#define QUAD(A_, B_, C_, D_, W_, A0, A1, A2, A3) do { \
        const unsigned ablo_ = __builtin_amdgcn_perm(B_, A_, 0x05010400u), abhi_ = __builtin_amdgcn_perm(B_, A_, 0x07030602u); \
        const unsigned cdlo_ = __builtin_amdgcn_perm(D_, C_, 0x05010400u), cdhi_ = __builtin_amdgcn_perm(D_, C_, 0x07030602u); \
        A0 = __builtin_amdgcn_sdot4((int)__builtin_amdgcn_perm(cdlo_, ablo_, 0x05040100u), (int)(W_), A0, false); \
        A1 = __builtin_amdgcn_sdot4((int)__builtin_amdgcn_perm(cdlo_, ablo_, 0x07060302u), (int)(W_), A1, false); \
        A2 = __builtin_amdgcn_sdot4((int)__builtin_amdgcn_perm(cdhi_, abhi_, 0x05040100u), (int)(W_), A2, false); \
        A3 = __builtin_amdgcn_sdot4((int)__builtin_amdgcn_perm(cdhi_, abhi_, 0x07060302u), (int)(W_), A3, false); } while (0)
#define COMPUTE_V(Q, W, SWV, n) do { int ac[16]; _Pragma("unroll") for (int k = 0; k < 16; ++k) ac[k] = 0; \
        _Pragma("unroll") for (int q_ = 0; q_ < 4; ++q_) { const unsigned w_ = q_ == 0 ? W.x : q_ == 1 ? W.y : q_ == 2 ? W.z : W.w; \
            QUAD(Q[4 * q_].x, Q[4 * q_ + 1].x, Q[4 * q_ + 2].x, Q[4 * q_ + 3].x, w_, ac[0], ac[1], ac[2], ac[3]); \
            QUAD(Q[4 * q_].y, Q[4 * q_ + 1].y, Q[4 * q_ + 2].y, Q[4 * q_ + 3].y, w_, ac[4], ac[5], ac[6], ac[7]); \
            QUAD(Q[4 * q_].z, Q[4 * q_ + 1].z, Q[4 * q_ + 2].z, Q[4 * q_ + 3].z, w_, ac[8], ac[9], ac[10], ac[11]); \
            QUAD(Q[4 * q_].w, Q[4 * q_ + 1].w, Q[4 * q_ + 2].w, Q[4 * q_ + 3].w, w_, ac[12], ac[13], ac[14], ac[15]); } \
        float p[16]; _Pragma("unroll") for (int k = 0; k < 16; ++k) p[k] = (float)ac[k] * SWV; \
        float p8[8], p4[4], p2[2]; \
        _Pragma("unroll") for (int i_ = 0; i_ < 8; ++i_) { auto rr_ = __builtin_amdgcn_permlane32_swap(__float_as_uint(p[i_]), __float_as_uint(p[8 + i_]), false, false); p8[i_] = __uint_as_float(rr_[0]) + __uint_as_float(rr_[1]); } \
        _Pragma("unroll") for (int i_ = 0; i_ < 4; ++i_) { auto rr_ = __builtin_amdgcn_permlane16_swap(__float_as_uint(p8[i_]), __float_as_uint(p8[4 + i_]), false, false); p4[i_] = __uint_as_float(rr_[0]) + __uint_as_float(rr_[1]); } \
        HALVE(p2, p4, 2, 8); \
        const size_t o_ = (size_t)ITEM_T(n) * DM + ITEM_S(n) * 128 + c * 16 + 2 * g; \
        const f32x2 hv = *(const f32x2*)(hsrc + o_); *(f32x2*)(dst + o_) = (f32x2){hv.x + p2[0], hv.y + p2[1]}; } while (0)
    int4 IA[4], IB[4]; u32x4 QA[16], QB[16], WA, WB; float SA, SB_;
    LD_IDX(IA, 0); LD_IDX(IB, 1);
    LD_ROWS(QA, IA, v8, 0); LD_W(WA, SA, 0);
    for (int n = 0; n < N; n += 2) {
        LD_ROWS(QB, IB, v8, n + 1); LD_W(WB, SB_, n + 1);
        if (n + 2 < N) LD_IDX(IA, n + 2);
        COMPUTE_V(QA, WA, SA, n);
        if (n + 2 < N) { LD_ROWS(QA, IA, v8, n + 2); LD_W(WA, SA, n + 2); }
        if (n + 3 < N) LD_IDX(IB, n + 3);
        COMPUTE_V(QB, WB, SB_, n + 1);
    }
#undef LD_W
#undef QUAD
#undef COMPUTE_V
}
#undef ITEM_T
#undef ITEM_S
#undef LD_IDX
#undef LD_ROWS
#undef HALVE


#define XB_TMO      128
#define XB_XCNT(j)  (256  + 64 * (j))
#define XB_XSUB(j)  (1280 + 64 * (j))
#define XB_XGEN(j)  (2304 + 64 * (j))
#define XB_TOP      3328
#define XB_TOPGEN   3392
#define XCD_BAR_WORDS 3456
#define XB_SPIN_CAP (1u << 20)
__device__ __forceinline__ unsigned xb_ld(unsigned* p)              { return __hip_atomic_load(p, __ATOMIC_RELAXED, __HIP_MEMORY_SCOPE_AGENT); }
__device__ __forceinline__ unsigned xb_add(unsigned* p, unsigned v) { return __hip_atomic_fetch_add(p, v, __ATOMIC_RELAXED, __HIP_MEMORY_SCOPE_AGENT); }
__device__ __forceinline__ unsigned xb_xcc_id() { return (unsigned)__builtin_amdgcn_s_getreg((3 << 11) | 20) & 0xFu; }
#define XB_SPIN(cond, bar) do { unsigned _sp = 0; while (cond) { __builtin_amdgcn_s_sleep(1); \
    if ((++_sp & 255u) == 0u) { if (xb_ld(&(bar)[XB_TMO])) break; if (_sp > XB_SPIN_CAP) { atomicAdd(&(bar)[XB_TMO], 1u); break; } } } } while (0)
struct XcdBarrier { unsigned* bar; unsigned x; volatile LAS unsigned* st; };
__device__ __forceinline__ XcdBarrier xcd_barrier_post(unsigned* bar, volatile LAS unsigned* st) {
    XcdBarrier b; b.bar = bar; b.x = xb_xcc_id(); b.st = st;
    if (threadIdx.x == 0) (void)xb_add(&bar[XB_XCNT(b.x)], 1u);
    return b;
}
__device__ __forceinline__ void xcd_barrier_complete(unsigned* bar, unsigned x, unsigned& nloc, unsigned& nx) {
    const unsigned G = gridDim.x * gridDim.y * gridDim.z;
    unsigned sum, cnt, mine, sp = 0u;
    for (;;) {
        sum = 0u; cnt = 0u; mine = 0u;
#pragma unroll
        for (unsigned j = 0; j < 16; ++j) { const unsigned c = xb_ld(&bar[XB_XCNT(j)]); sum += c; cnt += (c > 0u) ? 1u : 0u; mine = (j == x) ? c : mine; }
        if (sum == G) break;
        __builtin_amdgcn_s_sleep(1);
        if ((++sp & 255u) == 0u) { if (xb_ld(&bar[XB_TMO])) break; if (sp > XB_SPIN_CAP) { atomicAdd(&bar[XB_TMO], 1u); break; } }
    }
    nloc = mine > 0u ? mine : 1u; nx = cnt > 0u ? cnt : 1u;
}
__device__ __forceinline__ void xcd_barrier(const XcdBarrier& b) {
    asm volatile("s_waitcnt vmcnt(0)" ::: "memory");
    __syncthreads();
    if (threadIdx.x == 0) {
        unsigned* bar = b.bar;
        __builtin_amdgcn_s_waitcnt(0);
        unsigned nloc = b.st[0], nx = b.st[1];
        if (nloc == 0u) { xcd_barrier_complete(bar, b.x, nloc, nx); b.st[0] = nloc; b.st[1] = nx; }
        const unsigned old = xb_add(&bar[XB_XSUB(b.x)], 1u);
        const unsigned gen = old / nloc;
        if (old + 1u == (gen + 1u) * nloc) {
            __builtin_amdgcn_fence(__ATOMIC_RELEASE, "agent");
            asm volatile("s_waitcnt vmcnt(0)" ::: "memory");
            const unsigned og = xb_add(&bar[XB_TOP], 1u);
            const unsigned tg = og / nx;
            if (og + 1u == (tg + 1u) * nx) xb_add(&bar[XB_TOPGEN], 1u);
            else XB_SPIN(xb_ld(&bar[XB_TOPGEN]) == tg, bar);
            __builtin_amdgcn_fence(__ATOMIC_ACQUIRE, "agent");
            xb_add(&bar[XB_XGEN(b.x)], 1u);
            asm volatile("s_waitcnt vmcnt(0)" ::: "memory");
        } else {
            XB_SPIN(xb_ld(&bar[XB_XGEN(b.x)]) == gen, bar);
            __builtin_amdgcn_fence(__ATOMIC_ACQUIRE, "agent");
            asm volatile("s_waitcnt vmcnt(0)" ::: "memory");
        }
    }
    __syncthreads();
}

constexpr int NPHASE = 11;
#define LOAD_ARGS() do { } while (0)
__global__ void __launch_bounds__(NTHREADS, 2) fwd_kernel(Args a) {
    extern __shared__ __attribute__((aligned(16))) unsigned char lds[];
#if MK_ONE_LAUNCH
    constexpr int lo = 0, hi = NPHASE;
    cg::grid_group grid = cg::this_grid();
    volatile LAS unsigned* misc = (volatile LAS unsigned*)((LAS unsigned char*)lds + MISC_OFF);
    if (threadIdx.x < 16) misc[threadIdx.x] = 0u;
    __syncthreads();
    { LOAD_ARGS(); (void)xcd_barrier_post((unsigned*)(a.ws + WS_CTL) + CW_BAR, misc + 8); }
#ifndef SEAM_CG_MASK
#define SEAM_CG_MASK 0
#endif
#define SEAM(k) do { if (lo <= (k) && (k) + 1 < hi) { if ((SEAM_CG_MASK >> (k)) & 1) grid.sync(); else { LOAD_ARGS(); XcdBarrier xb_; xb_.bar = (unsigned*)(a.ws + WS_CTL) + CW_BAR; xb_.x = xb_xcc_id(); \
        xb_.st = (volatile LAS unsigned*)((LAS unsigned char*)lds + MISC_OFF) + 8; xcd_barrier(xb_); } } } while (0)
#else
    int lo, hi; { LOAD_ARGS(); lo = a.ph_lo; hi = a.ph_hi; }
#define SEAM(k) do { } while (0)
#endif
#define IN(k) (lo <= (k) && (k) < hi)
#ifndef DUP_PHASE
#define DUP_PHASE -1
#endif
    if (IN(0)) { LOAD_ARGS(); phase0(a, lds); if (DUP_PHASE == 0) { __syncthreads(); phase0(a, lds); } SEAM(0); }
    if (IN(1)) { LOAD_ARGS(); unsigned char* ws = a.ws;
        cumsum_rows(a);
        pg8::Gemm g{(const bf16_t*)(ws + WS_XN), (const bf16_t*)(ws + WS_WIN), T, NPROJ, DM}; pg8::StaticOrder S; S.init(T, NPROJ, (int)gridDim.x, (int)blockIdx.x);
        pg8::EpiInProj E{(bf16_t*)(ws + WS_SEC)};
        for (int rep_ = 0; rep_ < (DUP_PHASE == 1 ? 2 : 1); ++rep_)
        pg8::gemm_phase<pg8::EpiInProj, pg8::StaticOrder, true, true>((LAS unsigned char*)lds, g, S, E);
        { const int nwg_ = (T / 256) * (NPROJ / 256), G_ = (int)gridDim.x, rem_ = nwg_ % G_;
          if (rem_ > 0 && (int)blockIdx.x >= rem_) convert_tables(a, TAB_SPLIT, 2 * NEXP, ((int)blockIdx.x - rem_) * NWAVES + (tid_opaque() >> 6), (G_ - rem_) * NWAVES);
          else if (rem_ == 0) convert_tables(a, TAB_SPLIT, 2 * NEXP, (int)blockIdx.x * NWAVES + (tid_opaque() >> 6), G_ * NWAVES); }
        SEAM(1);
    }
    if (IN(2)) { LOAD_ARGS(); phase_qknorm(a); SEAM(2); }
    if (IN(3)) { LOAD_ARGS(); phase_attn(a, lds);
#if MK_ONE_LAUNCH
        if (DUP_PHASE == 3) { XcdBarrier xb_; xb_.bar = (unsigned*)(a.ws + WS_CTL) + CW_BAR; xb_.x = xb_xcc_id(); xb_.st = (volatile LAS unsigned*)((LAS unsigned char*)lds + MISC_OFF) + 8;
            xcd_barrier(xb_); if (blockIdx.x == 0 && threadIdx.x == 0) __hip_atomic_store((unsigned*)(a.ws + WS_CTL), 0u, __ATOMIC_RELAXED, __HIP_MEMORY_SCOPE_AGENT); xcd_barrier(xb_); phase_attn(a, lds); }
#endif
        SEAM(3); }
    if (IN(4)) { LOAD_ARGS(); phase_attn_combine(a); SEAM(4); }
    if (IN(5)) { LOAD_ARGS(); unsigned char* ws = a.ws;
        pg8::Gemm g{(const bf16_t*)(ws + WS_MIX), (const bf16_t*)(ws + WS_WOUT), T, DM, DM}; pg8::StaticOrder S; S.init(T, DM, (int)gridDim.x, (int)blockIdx.x);
        pg8::EpiOutProj E{a.in[0], a.out, (bf16_t*)(ws + WS_HB), (float*)(ws + WS_SSQ), (float*)(ws + WS_AMX)};
        for (int rep_ = 0; rep_ < (DUP_PHASE == 5 ? 2 : 1); ++rep_)
        pg8::gemm_phase<pg8::EpiOutProj, pg8::StaticOrder, true, true>((LAS unsigned char*)lds, g, S, E);
        SEAM(5);
    }
    if (IN(6)) { LOAD_ARGS(); unsigned char* ws = a.ws;
        pg8::Gemm g{(const bf16_t*)(ws + WS_HB), (const bf16_t*)(ws + WS_WPQ), T, DM, DM}; pg8::StaticOrder S; S.init(T, DM, (int)gridDim.x, (int)blockIdx.x);
        pg8::EpiPeerQ E{(const float*)(ws + WS_SSQ), (bf16_t*)(ws + WS_QP), (float*)(ws + WS_RT)};
        for (int rep_ = 0; rep_ < (DUP_PHASE == 6 ? 2 : 1); ++rep_)
        pg8::gemm_phase<pg8::EpiPeerQ, pg8::StaticOrder, true, true>((LAS unsigned char*)lds, g, S, E);
        SEAM(6);
    }
    #ifdef TOPK_REF
    if (IN(7)) { LOAD_ARGS(); phase_topk_ref(a); SEAM(7); }
#else
    if (IN(7)) { LOAD_ARGS(); for (int rep_ = 0; rep_ < (DUP_PHASE == 7 ? 2 : 1); ++rep_) phase_topk(a, lds); SEAM(7); }
#endif
    if (IN(8)) { LOAD_ARGS(); for (int rep_ = 0; rep_ < (DUP_PHASE == 8 ? 2 : 1); ++rep_) phase_peer_u(a); SEAM(8); }
    if (IN(9)) { LOAD_ARGS(); for (int rep_ = 0; rep_ < (DUP_PHASE == 9 ? 2 : 1); ++rep_) phase_peer_w(a); SEAM(9); }
    if (IN(10)) { LOAD_ARGS(); for (int rep_ = 0; rep_ < (DUP_PHASE == 10 ? 2 : 1); ++rep_) phase_peer_v(a, (DUP_PHASE == 10 && rep_ == 0) ? (float*)(a.ws + WS_END) : a.out); }
#undef IN
#undef SEAM
}

extern "C" void kernel_launch(void* const* d_in, const int* in_sizes, int n_in, void* d_out, int out_size, void* d_ws, size_t ws_size, hipStream_t stream) {
    static int grid = 0;
    if (grid == 0) {
        if (n_in != 12 || in_sizes[0] != T * DM || out_size != T * DM || ws_size < WS_END) { fprintf(stderr, "kernel_launch: unexpected shapes (n_in %d, in0 %d, out %d, ws %zu)\n", n_in, n_in > 0 ? in_sizes[0] : -1, out_size, ws_size); grid = -1; return; }
        int dev = 0, cus = 0, per_cu = 0;
        if (hipGetDevice(&dev) != hipSuccess || hipDeviceGetAttribute(&cus, hipDeviceAttributeMultiprocessorCount, dev) != hipSuccess) { grid = -1; return; }
        if (hipFuncSetAttribute((const void*)fwd_kernel, hipFuncAttributeMaxDynamicSharedMemorySize, LDS_BYTES) != hipSuccess) { fprintf(stderr, "kernel_launch: hipFuncSetAttribute failed\n"); grid = -1; return; }
        if (hipOccupancyMaxActiveBlocksPerMultiprocessor(&per_cu, (const void*)fwd_kernel, NTHREADS, LDS_BYTES) != hipSuccess || per_cu < 1) { fprintf(stderr, "kernel_launch: occupancy query says %d\n", per_cu); grid = -1; return; }
        grid = cus;
    }
    if (grid < 0) return;
    (void)hipMemsetAsync((char*)d_ws + WS_CTL, 0, CTL_BYTES, stream);
    Args a{};
    for (int i = 0; i < 12; ++i) a.in[i] = (const float*)d_in[i];
    a.out = (float*)d_out; a.ws = (unsigned char*)d_ws;
#if MK_ONE_LAUNCH
    a.ph_lo = 0; a.ph_hi = NPHASE;
    void* args[] = {&a};
#if MK_COOP_LAUNCH
    hipError_t e = hipLaunchCooperativeKernel((const void*)fwd_kernel, dim3(grid), dim3(NTHREADS), args, LDS_BYTES, stream);
    if (e != hipSuccess) fprintf(stderr, "cooperative launch failed: %s (grid %d)\n", hipGetErrorString(e), grid);
#else
    (void)args; hipLaunchKernelGGL(fwd_kernel, dim3(grid), dim3(NTHREADS), LDS_BYTES, stream, a);
#endif
#else
    for (int p = 0; p < NPHASE; ++p) { a.ph_lo = p; a.ph_hi = p + 1; hipLaunchKernelGGL(fwd_kernel, dim3(grid), dim3(NTHREADS), LDS_BYTES, stream, a); }
#endif
}
```

```cpp
#include <hip/hip_runtime.h>
#include <hip/hip_cooperative_groups.h>
#include <cstdio>
#include <cstdint>
namespace cg = cooperative_groups;

#ifndef MK_COOP_LAUNCH
#define MK_COOP_LAUNCH 0
#endif
#ifndef MK_ONE_LAUNCH
#define MK_ONE_LAUNCH 1
#endif

#define LAS __attribute__((address_space(3)))
typedef unsigned short bf16_t;
typedef short bf16x8 __attribute__((ext_vector_type(8)));
typedef short s16x4 __attribute__((ext_vector_type(4)));
typedef float f32x2 __attribute__((ext_vector_type(2)));
typedef float f32x4 __attribute__((ext_vector_type(4)));
typedef float f32x16 __attribute__((ext_vector_type(16)));
typedef unsigned u32x2 __attribute__((ext_vector_type(2)));
typedef unsigned u32x4 __attribute__((ext_vector_type(4)));
typedef __bf16 bf16x2_t __attribute__((ext_vector_type(2)));

constexpr int NB = 2, SEQ = 4096, T = NB * SEQ, DM = 2048, HD = 128, NHF = 8, DIN = 7176, NPROJ = 7168;
constexpr int NEXP = 16384, NE = 128;
constexpr float EPS = 1e-6f;
constexpr float SCALE = 0.08838834764831845f, LOG2E = 1.4426950408889634f;
constexpr int NWAVES = 8, NTHREADS = 512;

constexpr size_t MiB = 1u << 20;
constexpr size_t WS_CTL = 0, CTL_BYTES = 32768;
constexpr int CW_BAR = 1024;
constexpr size_t WS_SXN = 64 * MiB  , WS_WSC = 45 * MiB + 800 * 1024  ;
constexpr int CW_WMAX = 64;
constexpr size_t WS_GQK = 45 * MiB + 768 * 1024;
constexpr size_t WS_WIN = 1 * MiB, WS_WOUT = 29 * MiB, WS_WPQ = 37 * MiB, WS_SK = 45 * MiB, WS_LOGF = 46 * MiB, WS_C = 46 * MiB + 512 * 1024, WS_SSQ = 47 * MiB;
constexpr size_t WS_XN = 48 * MiB;
constexpr size_t WS_SEC = 80 * MiB;
constexpr size_t SEC_ELEMS = 8u << 20;
constexpr size_t WS_MIX = 192 * MiB, WS_HB = 224 * MiB, WS_QP = 256 * MiB, WS_IDX = 288 * MiB, WS_GW = 292 * MiB, WS_U8 = 296 * MiB, WS_V8 = 328 * MiB, WS_SUV = 360 * MiB  , WS_RT = 360 * MiB + 256 * 1024  , WS_W = 361 * MiB  ,
                 WS_PART = 368 * MiB  , WS_XQ = 432 * MiB  , WS_END = 448 * MiB;
constexpr size_t WS_AMX = 365 * MiB  , WS_SX = WS_RT + 64 * 1024  , WS_WQ = WS_W  , WS_SW = WS_W + 2 * MiB  ;
constexpr size_t WS_PO = WS_PART  , WS_PML = WS_PART + 32 * MiB  ;

constexpr int RING_BYTES = 131072;
constexpr int MISC_OFF = 143360;
constexpr int LDS_BYTES = 147456;

__device__ __forceinline__ unsigned cvt_pk_bf16(float lo, float hi) { unsigned r; asm volatile("v_cvt_pk_bf16_f32 %0, %1, %2" : "=v"(r) : "v"(lo), "v"(hi)); return r; }
__device__ __forceinline__ float bf_lo(unsigned u) { return __builtin_bit_cast(float, u << 16); }
__device__ __forceinline__ float bf_hi(unsigned u) { return __builtin_bit_cast(float, u & 0xffff0000u); }
__device__ __forceinline__ int lane_id_fresh() { int l = (int)__builtin_amdgcn_mbcnt_hi(~0u, __builtin_amdgcn_mbcnt_lo(~0u, 0u)); asm volatile("" : "+v"(l)); return l; }
__device__ __forceinline__ int sx_i(int v, int m) { return __builtin_amdgcn_ds_bpermute((lane_id_fresh() ^ m) << 2, v); }
__device__ __forceinline__ float sx_f(float v, int m) { return __int_as_float(__builtin_amdgcn_ds_bpermute((lane_id_fresh() ^ m) << 2, __float_as_int(v))); }
__device__ __forceinline__ int sh_i(int v, int src) { return __builtin_amdgcn_ds_bpermute(src << 2, v); }
__device__ __forceinline__ float sh_f(float v, int src) { return __int_as_float(__builtin_amdgcn_ds_bpermute(src << 2, __float_as_int(v))); }
__device__ __forceinline__ float shup_f(float v, int d) { const int l = lane_id_fresh(); const int s = l - d; return __int_as_float(__builtin_amdgcn_ds_bpermute((s < 0 ? l : s) << 2, __float_as_int(v))); }
__device__ __forceinline__ float wave_sum(float v) {
#pragma unroll
    for (int o = 1; o < 64; o <<= 1) v += sx_f(v, o);
    return v;
}
__device__ __forceinline__ float wave_max(float v) {
#pragma unroll
    for (int o = 1; o < 64; o <<= 1) v = fmaxf(v, sx_f(v, o));
    return v;
}
__device__ __forceinline__ int tid_opaque() { int t = (int)threadIdx.x; asm volatile("" : "+v"(t)); return t; }
#define LDS_WAIT() asm volatile("s_waitcnt lgkmcnt(0)" ::: "memory")

namespace pg8 {
#define PG8_LAS __attribute__((address_space(3)))
constexpr int BM = 256, BK = 64, HALF = 128, HTB = HALF * BK * 2, STAGE_BYTES = 8 * HTB, NXCD = 8, WGM = 8;
__host__ __device__ __forceinline__ int lds_byte(int r, int c) { const int st = (r >> 4) * 2 + (c >> 5), rr = r & 15, cc = c & 31, ob = rr * 64 + cc * 2; return st * 1024 + (ob ^ (((ob >> 9) & 1) << 5)); }
__host__ __device__ __forceinline__ void stage_rc(int b, int& R, int& C) { const int st = b / 1024, sb = b % 1024, swz = sb ^ (((sb >> 9) & 1) << 5); R = (st >> 1) * 16 + swz / 64; C = (st & 1) * 32 + (swz % 64) / 2; }
__host__ __device__ __forceinline__ int perm32(int rho) { const int n = rho >> 4, i = rho & 15; return 8 * (i >> 2) + 4 * n + (i & 3); }
struct Unit { int pm, pn; };
struct Gemm { const bf16_t* A; const bf16_t* Bt; int M, N, K; };
struct StaticOrder {
    int nM, nN, nwg, G, c;
    __host__ __device__ void init(int M, int N, int G_, int c_) { nM = M / BM; nN = N / BM; nwg = nM * nN; G = G_; c = c_; }
    __host__ __device__ bool next(int i, Unit& u) const {
        const long L = (long)i * G + c; if (L >= nwg) return false;
        int wgid = (int)L; { const int q = nwg / NXCD, r = nwg % NXCD, xcd = wgid % NXCD, off = wgid / NXCD; wgid = (xcd < r ? xcd * (q + 1) : r * (q + 1) + (xcd - r) * q) + off; }
        const int nig = WGM * nN, gid = wgid / nig, fm = gid * WGM, gsz = (nM - fm) < WGM ? (nM - fm) : WGM;
        u.pm = fm + ((wgid % nig) % gsz); u.pn = (wgid % nig) / gsz; return true;
    }
    __device__ __forceinline__ void a_ready(const Unit&) const {}
    __device__ __forceinline__ void done(const Unit&) const {}
};

typedef int i32x4 __attribute__((ext_vector_type(4)));
template <bool I8> struct AccT { typedef f32x4 type; };
template <> struct AccT<true> { typedef i32x4 type; };
template <class Epi, class Sched, bool ALIGN_EPI = false, bool SP2 = false, bool I8 = false>
__device__ __forceinline__ void gemm_phase(PG8_LAS unsigned char* lds, const Gemm g, const Sched& S, const Epi& E) {
    typedef typename AccT<I8>::type acc_t;
    const int tid = tid_opaque(), wid = __builtin_amdgcn_readfirstlane(tid >> 6), lane = tid & 63, wr = wid >> 2, wc = wid & 3, fr = lane & 15, fq = lane >> 4;
    const int rowb = I8 ? g.K : 2 * g.K, nt = rowb / (BK * 2);
    unsigned voffA[2], voffB[2];
#pragma unroll
    for (int i = 0; i < 2; ++i) { int R, C; stage_rc(tid * 16 + i * 8192, R, C); const int Rb = Epi::PERM ? ((R & ~31) + perm32(R & 31)) : R;
        voffA[i] = (unsigned)(R * rowb + C * 2); voffB[i] = (unsigned)(Rb * rowb + C * 2); }
    const size_t kstep = (size_t)(BK * 2);
    const size_t hstep = (size_t)HALF * rowb;
    const size_t tstep = 2 * hstep;
    const unsigned ldsw = (unsigned)wid * 1024u;
    const int aoff = lds_byte(wr * 64 + fr, fq * 8), boff = lds_byte(wc * 32 + fr, fq * 8);
#define PG8_SA(b, h) (((b) * 2 + (h)) * HTB)
#define PG8_SB(b, h) ((4 + (b) * 2 + (h)) * HTB)
#define PG8_STAGE(bufoff, gbase, voff) do { _Pragma("unroll") for (int _i = 0; _i < 2; ++_i) \
        __builtin_amdgcn_global_load_lds((const unsigned*)((const char*)(gbase) + (voff)[_i]), (PG8_LAS unsigned*)(lds + (bufoff) + ldsw + _i * 8192), 16, 0, 0); } while (0)
#define PG8_LDA(dst, b, h) do { _Pragma("unroll") for (int m = 0; m < 4; ++m) _Pragma("unroll") for (int k = 0; k < 2; ++k) dst[m][k] = *(const PG8_LAS bf16x8*)(lds + PG8_SA(b, h) + aoff + m * 2048 + k * 1024); } while (0)
#define PG8_LDB(dst, b, h) do { _Pragma("unroll") for (int n = 0; n < 2; ++n) _Pragma("unroll") for (int k = 0; k < 2; ++k) dst[n][k] = *(const PG8_LAS bf16x8*)(lds + PG8_SB(b, h) + boff + n * 2048 + k * 1024); } while (0)
#define PG8_MMA(ai, bj, At, Bt) do { __builtin_amdgcn_s_setprio(1); _Pragma("unroll") for (int m = 0; m < 4; ++m) _Pragma("unroll") for (int n = 0; n < 2; ++n) _Pragma("unroll") for (int k = 0; k < 2; ++k) \
        { if constexpr (I8) acc[ai][bj][m][n] = __builtin_amdgcn_mfma_i32_16x16x64_i8(__builtin_bit_cast(i32x4, Bt[n][k]), __builtin_bit_cast(i32x4, At[m][k]), acc[ai][bj][m][n], 0, 0, 0); \
          else acc[ai][bj][m][n] = __builtin_amdgcn_mfma_f32_16x16x32_bf16(Bt[n][k], At[m][k], acc[ai][bj][m][n], 0, 0, 0); } __builtin_amdgcn_s_setprio(0); } while (0)
#define PG8_WAIT_V(n) asm volatile("s_waitcnt vmcnt(" #n ")" ::: "memory")
#define PG8_WAIT_L(n) asm volatile("s_waitcnt lgkmcnt(" #n ")" ::: "memory")
#define PG8_BAR __builtin_amdgcn_s_barrier()
#define PG8_SCHED __builtin_amdgcn_sched_barrier(0)
    Unit cur, nxt; int ui = 0;
    if (!S.next(0, cur)) return;
    acc_t acc[2][2][4][2];
#pragma unroll
    for (int a = 0; a < 2; ++a)
#pragma unroll
        for (int b = 0; b < 2; ++b)
#pragma unroll
            for (int m = 0; m < 4; ++m)
#pragma unroll
                for (int n = 0; n < 2; ++n) acc[a][b][m][n] = acc_t{};
    bf16x8 At[4][2], B0[2][2], B1[2][2];
    const char* cA = (const char*)g.A + (size_t)cur.pm * tstep; const char* cB = (const char*)g.Bt + (size_t)cur.pn * tstep;
    S.a_ready(cur);
    if constexpr (SP2) {
        PG8_STAGE(PG8_SB(0, 0), cB, voffB); PG8_STAGE(PG8_SB(0, 1), cB + hstep, voffB); PG8_STAGE(PG8_SA(0, 0), cA, voffA); PG8_STAGE(PG8_SA(0, 1), cA + hstep, voffA);
        if (wr == 1) PG8_BAR;
        PG8_WAIT_V(2); PG8_BAR;
        PG8_STAGE(PG8_SB(1, 0), cB + kstep, voffB); PG8_STAGE(PG8_SA(1, 0), cA + kstep, voffA); PG8_STAGE(PG8_SB(1, 1), cB + hstep + kstep, voffB);
        PG8_WAIT_V(6); PG8_BAR;
    } else {
        PG8_STAGE(PG8_SB(0, 0), cB, voffB); PG8_STAGE(PG8_SA(0, 0), cA, voffA); PG8_STAGE(PG8_SB(0, 1), cB + hstep, voffB); PG8_STAGE(PG8_SA(0, 1), cA + hstep, voffA);
        if (wr == 1) PG8_BAR;
        PG8_WAIT_V(4); PG8_BAR;
        PG8_STAGE(PG8_SB(1, 0), cB + kstep, voffB); PG8_STAGE(PG8_SA(1, 0), cA + kstep, voffA); PG8_STAGE(PG8_SB(1, 1), cB + hstep + kstep, voffB);
        PG8_WAIT_V(6); PG8_BAR;
    }
    for (;;) {
        const bool has_next = S.next(ui + 1, nxt);
        const char* nA = has_next ? (const char*)g.A + (size_t)nxt.pm * tstep : cA; const char* nB = has_next ? (const char*)g.Bt + (size_t)nxt.pn * tstep : cB;
        for (int t = 0; t < nt; t += 2) {
            const bool last = (t == nt - 2);
            const char* a1 = cA + (size_t)(t + 1) * kstep;
            const char* a2 = last ? nA : cA + (size_t)(t + 2) * kstep; const char* b2 = last ? nB : cB + (size_t)(t + 2) * kstep;
            const char* a3 = a2 + kstep; const char* b3 = b2 + kstep;
            if (last && has_next) S.a_ready(nxt);
            if constexpr (SP2) {
            PG8_LDB(B0, 0, 0); PG8_LDB(B1, 0, 1); PG8_SCHED; PG8_LDA(At, 0, 0); PG8_STAGE(PG8_SA(1, 1), a1 + hstep, voffA);
            PG8_WAIT_V(8); PG8_WAIT_L(0); PG8_BAR; PG8_MMA(0, 0, At, B0); PG8_MMA(0, 1, At, B1); PG8_BAR; PG8_SCHED;
            PG8_LDA(At, 0, 1); PG8_STAGE(PG8_SB(0, 0), b2, voffB); PG8_STAGE(PG8_SB(0, 1), b2 + hstep, voffB); PG8_STAGE(PG8_SA(0, 0), a2, voffA);
            PG8_WAIT_V(8); PG8_WAIT_L(0); PG8_BAR; PG8_MMA(1, 0, At, B0); PG8_MMA(1, 1, At, B1); PG8_BAR; PG8_SCHED;
            PG8_LDB(B0, 1, 0); PG8_LDB(B1, 1, 1); PG8_SCHED; PG8_LDA(At, 1, 0); PG8_STAGE(PG8_SA(0, 1), a2 + hstep, voffA);
            PG8_WAIT_V(8); PG8_WAIT_L(0); PG8_BAR; PG8_MMA(0, 0, At, B0); PG8_MMA(0, 1, At, B1); PG8_BAR; PG8_SCHED;
            PG8_LDA(At, 1, 1); PG8_STAGE(PG8_SB(1, 0), b3, voffB); PG8_STAGE(PG8_SB(1, 1), b3 + hstep, voffB); PG8_STAGE(PG8_SA(1, 0), a3, voffA);
            PG8_WAIT_V(8); PG8_WAIT_L(0); PG8_BAR; PG8_MMA(1, 0, At, B0); PG8_MMA(1, 1, At, B1); PG8_BAR; PG8_SCHED;
            } else {
            PG8_LDB(B0, 0, 0); PG8_SCHED; PG8_LDA(At, 0, 0); PG8_STAGE(PG8_SA(1, 1), a1 + hstep, voffA);
            PG8_WAIT_L(8); PG8_BAR; PG8_WAIT_L(0); PG8_MMA(0, 0, At, B0); PG8_BAR; PG8_SCHED;
            PG8_LDB(B1, 0, 1); PG8_STAGE(PG8_SB(0, 0), b2, voffB);
            PG8_BAR; PG8_WAIT_L(0); PG8_MMA(0, 1, At, B1); PG8_BAR;
            PG8_LDA(At, 0, 1); PG8_STAGE(PG8_SA(0, 0), a2, voffA);
            PG8_BAR; PG8_WAIT_L(0); PG8_MMA(1, 0, At, B0); PG8_BAR; PG8_SCHED;
            PG8_STAGE(PG8_SB(0, 1), b2 + hstep, voffB);
            PG8_WAIT_V(6); PG8_BAR; PG8_MMA(1, 1, At, B1); PG8_BAR;
            PG8_LDB(B0, 1, 0); PG8_SCHED; PG8_LDA(At, 1, 0); PG8_STAGE(PG8_SA(0, 1), a2 + hstep, voffA);
            PG8_WAIT_L(8); PG8_BAR; PG8_WAIT_L(0); PG8_MMA(0, 0, At, B0); PG8_BAR; PG8_SCHED;
            PG8_LDB(B1, 1, 1); PG8_STAGE(PG8_SB(1, 0), b3, voffB);
            PG8_BAR; PG8_WAIT_L(0); PG8_MMA(0, 1, At, B1); PG8_BAR;
            PG8_LDA(At, 1, 1); PG8_STAGE(PG8_SA(1, 0), a3, voffA);
            PG8_BAR; PG8_WAIT_L(0); PG8_MMA(1, 0, At, B0); PG8_BAR; PG8_SCHED;
            PG8_STAGE(PG8_SB(1, 1), b3 + hstep, voffB);
            PG8_WAIT_V(6); PG8_BAR; PG8_MMA(1, 1, At, B1); PG8_BAR;
            }
        }
        if constexpr (ALIGN_EPI) { if (wr == 0) PG8_BAR; }
        E(acc, cur, wr, wc, fr, fq); S.done(cur);
        if (!has_next) break;
#pragma unroll
        for (int a = 0; a < 2; ++a)
#pragma unroll
            for (int b = 0; b < 2; ++b)
#pragma unroll
                for (int m = 0; m < 4; ++m)
#pragma unroll
                    for (int n = 0; n < 2; ++n) acc[a][b][m][n] = acc_t{};
        cur = nxt; cA = nA; cB = nB; ++ui;
        if constexpr (ALIGN_EPI) { if (wr == 1) PG8_BAR; }
    }
    PG8_WAIT_V(0);
    if constexpr (!ALIGN_EPI) { if (wr == 0) PG8_BAR; }
    PG8_BAR;
#undef PG8_SA
#undef PG8_SB
#undef PG8_STAGE
#undef PG8_LDA
#undef PG8_LDB
#undef PG8_MMA
#undef PG8_WAIT_V
#undef PG8_WAIT_L
#undef PG8_BAR
#undef PG8_SCHED
}

__device__ __forceinline__ float sigmoidf_fast(float x) { return __builtin_amdgcn_rcpf(1.f + __builtin_amdgcn_exp2f(-x * LOG2E)); }
struct EpiInProj {
    static constexpr bool PERM = true;
    bf16_t* base; const float* sxn  ; const float* wsc  ;
    __device__ __forceinline__ void operator()(const i32x4 (&acci)[2][2][4][2], const Unit& u, int wr, int wc, int fr, int fq) const {
        const int sec = u.pn >> 2; const float wsv = *wsc;
        bf16_t* sb = base + (size_t)sec * SEC_ELEMS;
        const float sc = (sec == 4) ? SCALE * LOG2E : 1.f;
#pragma unroll
        for (int ai = 0; ai < 2; ++ai)
#pragma unroll
            for (int m = 0; m < 4; ++m) {
                const int tk = u.pm * BM + ai * HALF + wr * 64 + m * 16 + fr, b = tk >> 12, s = tk & 4095;
                const float rs = sxn[tk] * wsv;
#pragma unroll
                for (int bj = 0; bj < 2; ++bj) {
                    const int hh = (u.pn & 3) * 2 + bj;
                    f32x4 v0 = __builtin_convertvector(acci[ai][bj][m][0], f32x4) * rs, v1 = __builtin_convertvector(acci[ai][bj][m][1], f32x4) * rs;
                    bf16_t* dst;
                    if (sec == 3) {
#pragma unroll
                        for (int i = 0; i < 4; ++i) { v0[i] = sigmoidf_fast(v0[i]); v1[i] = sigmoidf_fast(v1[i]); }
                        dst = sb + (size_t)tk * 1024 + hh * 128 + wc * 32 + 8 * fq;
                    } else {
                        v0 = v0 * sc; v1 = v1 * sc;
                        dst = sb + ((size_t)((b * 8 + hh) * 4096 + s)) * 128 + wc * 32 + 8 * fq;
                    }
                    u32x4 w; w.x = cvt_pk_bf16(v0[0], v0[1]); w.y = cvt_pk_bf16(v0[2], v0[3]); w.z = cvt_pk_bf16(v1[0], v1[1]); w.w = cvt_pk_bf16(v1[2], v1[3]);
                    *(u32x4*)dst = w;
                }
            }
    }
};
struct EpiOutProj {
    static constexpr bool PERM = true;
    const float* x; float* h; bf16_t* hb; float* ssq; float* amx;
    __device__ __forceinline__ void operator()(const f32x4 (&acc)[2][2][4][2], const Unit& u, int wr, int wc, int fr, int fq) const {
#pragma unroll
        for (int ai = 0; ai < 2; ++ai)
#pragma unroll
            for (int m = 0; m < 4; ++m) {
                const int tk = u.pm * BM + ai * HALF + wr * 64 + m * 16 + fr;
                float ss = 0.f, mx = 0.f;
#pragma unroll
                for (int bj = 0; bj < 2; ++bj) {
                    const size_t off = (size_t)tk * DM + u.pn * BM + bj * HALF + wc * 32 + 8 * fq;
                    const f32x4 x0 = *(const f32x4*)(x + off), x1 = *(const f32x4*)(x + off + 4);
                    const f32x4 v0 = acc[ai][bj][m][0] + x0, v1 = acc[ai][bj][m][1] + x1;
                    *(f32x4*)(h + off) = v0; *(f32x4*)(h + off + 4) = v1;
                    u32x4 w; w.x = cvt_pk_bf16(v0[0], v0[1]); w.y = cvt_pk_bf16(v0[2], v0[3]); w.z = cvt_pk_bf16(v1[0], v1[1]); w.w = cvt_pk_bf16(v1[2], v1[3]);
                    *(u32x4*)(hb + off) = w;
                    ss += v0[0] * v0[0] + v0[1] * v0[1] + v0[2] * v0[2] + v0[3] * v0[3] + v1[0] * v1[0] + v1[1] * v1[1] + v1[2] * v1[2] + v1[3] * v1[3];
                    mx = fmaxf(mx, fmaxf(fmaxf(fmaxf(fabsf(v0[0]), fabsf(v0[1])), fmaxf(fabsf(v0[2]), fabsf(v0[3]))), fmaxf(fmaxf(fabsf(v1[0]), fabsf(v1[1])), fmaxf(fabsf(v1[2]), fabsf(v1[3])))));
                }
                ss += sx_f(ss, 16); ss += sx_f(ss, 32);
                mx = fmaxf(mx, sx_f(mx, 16)); mx = fmaxf(mx, sx_f(mx, 32));
                if (fq == 0) { ssq[(size_t)tk * 32 + u.pn * 4 + wc] = ss; amx[(size_t)tk * 32 + u.pn * 4 + wc] = mx; }
            }
    }
};
struct EpiPeerQ {
    static constexpr bool PERM = true;
    const float* ssq; bf16_t* qp; float* rtab;
    __device__ __forceinline__ void operator()(const f32x4 (&acc)[2][2][4][2], const Unit& u, int wr, int wc, int fr, int fq) const {
#pragma unroll
        for (int ai = 0; ai < 2; ++ai)
#pragma unroll
            for (int m = 0; m < 4; ++m) {
                const int tk = u.pm * BM + ai * HALF + wr * 64 + m * 16 + fr;
                float tot = 0.f;
#pragma unroll
                for (int i = 0; i < 8; ++i) { const f32x4 s4 = *(const f32x4*)(ssq + (size_t)tk * 32 + 4 * i); tot += (s4[0] + s4[1]) + (s4[2] + s4[3]); }
                const float r = 1.0f / sqrtf(tot * (1.f / DM) + EPS);
                if (u.pn == 0 && wc == 0 && fq == 0) rtab[tk] = r;
#pragma unroll
                for (int bj = 0; bj < 2; ++bj) {
                    const size_t off = (size_t)tk * DM + u.pn * BM + bj * HALF + wc * 32 + 8 * fq;
                    const f32x4 v0 = acc[ai][bj][m][0] * r, v1 = acc[ai][bj][m][1] * r;
                    u32x4 w; w.x = cvt_pk_bf16(v0[0], v0[1]); w.y = cvt_pk_bf16(v0[2], v0[3]); w.z = cvt_pk_bf16(v1[0], v1[1]); w.w = cvt_pk_bf16(v1[2], v1[3]);
                    *(u32x4*)(qp + off) = w;
                }
            }
    }
};
}

namespace att {
constexpr int NW = 8, QBLK = 32, KVBLK = 64, QB = NW * QBLK, D = 128;
constexpr int SHM_V = KVBLK * D * 2, SHM_K = KVBLK * D * 2;
constexpr int OFF_WS = 2 * SHM_V + 2 * SHM_K, OFF_BIAS = OFF_WS + NW * 64 * 4, ATT_LDS = OFF_BIAS + SEQ * 4;
#define KSWZ(row, colB) ((row) * 256 + ((colB) ^ (((row) & 7) << 4)))
#define SBAR() __builtin_amdgcn_sched_barrier(0)
__device__ __forceinline__ int v_st(int k, int c) { const int kk = (k & ~0xC) | ((k & 4) << 1) | ((k & 8) >> 1); return ((kk >> 3) * 4 + (c >> 5)) * 512 + ((kk & 7) * 32 + (c & 31)) * 2; }
__device__ __forceinline__ int v_rd_base(int lane) { return ((lane & 3) << 3) | (((lane >> 2) & 3) << 6) | (((lane >> 4) & 1) << 5) | (((lane >> 5) & 1) << 8); }
constexpr int v_rd_off(int d0, int ks, int half) { return d0 * 512 + ks * 4096 + half * 2048; }
__device__ __forceinline__ int crow(int r, int hi) { return (r & 3) + 8 * (r >> 2) + 4 * hi; }
__device__ __forceinline__ bf16x8 load8(const bf16_t* p) { return *reinterpret_cast<const bf16x8*>(p); }
__device__ __forceinline__ void mask_tile(f32x16& p0, f32x16& p1, int dq) {
    const float NEG = -__builtin_inff();
#pragma unroll
    for (int r = 0; r < 16; ++r) {
        const int c = (r & 3) + 8 * (r >> 2);
        if (dq - c < 0) p0[r] = NEG;
        if (dq - c - 32 < 0) p1[r] = NEG;
    }
}
__device__ __forceinline__ void partialSM(f32x16& p0, f32x16& p1, float& m_reg, float& mn, float& alpha) {
    float pmax = p0[0];
#pragma unroll
    for (int r = 1; r < 16; ++r) pmax = fmaxf(pmax, p0[r]);
#pragma unroll
    for (int r = 0; r < 16; ++r) pmax = fmaxf(pmax, p1[r]);
    { auto rr = __builtin_amdgcn_permlane32_swap(__float_as_uint(pmax), __float_as_uint(pmax), false, false);
      pmax = fmaxf(__uint_as_float(rr[0]), __uint_as_float(rr[1])); }
    constexpr float C2 = LOG2E * SCALE; constexpr float THR = 8.f;
    if (__builtin_expect(__all((pmax - m_reg) * SCALE <= THR), 1)) { mn = m_reg; alpha = 1.f; }
    else { mn = fmaxf(m_reg, pmax); alpha = __builtin_amdgcn_exp2f((m_reg - mn) * C2); m_reg = mn; }
    const float mnL = -mn * C2;
#pragma unroll
    for (int r = 0; r < 16; ++r) p0[r] = fmaf(p0[r], C2, mnL);
#pragma unroll
    for (int r = 0; r < 16; ++r) p1[r] = fmaf(p1[r], C2, mnL);
#pragma unroll
    for (int r = 0; r < 16; ++r) p0[r] = __builtin_amdgcn_exp2f(p0[r]);
}
#define PK4(P, B_, OUT) do { unsigned a0 = cvt_pk_bf16(P[B_+0], P[B_+1]), a1 = cvt_pk_bf16(P[B_+2], P[B_+3]);                          \
        unsigned b0 = cvt_pk_bf16(P[B_+4], P[B_+5]), b1 = cvt_pk_bf16(P[B_+6], P[B_+7]);                                             \
        auto r0 = __builtin_amdgcn_permlane32_swap(a0, b0, false, false); auto r1 = __builtin_amdgcn_permlane32_swap(a1, b1, false, false); \
        u32x4 w = {r0[0], r1[0], r0[1], r1[1]}; OUT = *reinterpret_cast<bf16x8*>(&w); } while (0)
__device__ __forceinline__ void finishSM(f32x16& p0, f32x16& p1, float alpha, float& l_reg, bf16x8& pa0, bf16x8& pa1, bf16x8& pa2, bf16x8& pa3) {
#pragma unroll
    for (int r = 0; r < 16; ++r) p1[r] = __builtin_amdgcn_exp2f(p1[r]);
    float ps = 0;
#pragma unroll
    for (int r = 0; r < 16; ++r) ps += p0[r];
#pragma unroll
    for (int r = 0; r < 16; ++r) ps += p1[r];
    { auto rr = __builtin_amdgcn_permlane32_swap(__float_as_uint(ps), __float_as_uint(ps), false, false);
      ps = __uint_as_float(rr[0]) + __uint_as_float(rr[1]); }
    l_reg = l_reg * alpha + ps;
    PK4(p0, 0, pa0); PK4(p0, 8, pa1); PK4(p1, 0, pa2); PK4(p1, 8, pa3);
}
__device__ __forceinline__ void sb_group(f32x16& P, int g, float& gs) {
    float run = 0.f;
#pragma unroll
    for (int k = 3; k >= 0; --k) {
        const float z = P[4 * g + k];
        const float t = __builtin_amdgcn_exp2f(-fabsf(z));
        const float l = __builtin_amdgcn_logf(1.f + t);
        const float sp = fmaxf(z, 0.f) + l;
        P[4 * g + k] = (z - sp) - run;
        run += sp;
    }
    gs = run;
}
__device__ __forceinline__ void sb_part1(f32x16& p0, f32x16& p1, float& carry, float mlo) {
    float gs[8];
#pragma unroll
    for (int g = 0; g < 4; ++g) sb_group(p0, g, gs[g]);
#pragma unroll
    for (int g = 0; g < 4; ++g) sb_group(p1, g, gs[4 + g]);
    float run = carry;
#pragma unroll
    for (int G = 7; G >= 0; --G) {
        auto rr = __builtin_amdgcn_permlane32_swap(__float_as_uint(gs[G]), __float_as_uint(gs[G]), false, false);
        const float slo = __uint_as_float(rr[0]), shi = __uint_as_float(rr[1]);
        const float base = fmaf(mlo, shi, run);
        if (G >= 4) {
#pragma unroll
            for (int k = 0; k < 4; ++k) p1[4 * (G - 4) + k] -= base;
        } else {
#pragma unroll
            for (int k = 0; k < 4; ++k) p0[4 * G + k] -= base;
        }
        run += slo + shi;
    }
    carry = run;
#pragma unroll
    for (int r = 0; r < 16; ++r) p0[r] = __builtin_amdgcn_exp2f(p0[r]);
}
__device__ __forceinline__ void sb_part2(f32x16& p0, f32x16& p1, bf16x8& pa0, bf16x8& pa1, bf16x8& pa2, bf16x8& pa3) {
#pragma unroll
    for (int r = 0; r < 16; ++r) p1[r] = __builtin_amdgcn_exp2f(p1[r]);
    PK4(p0, 0, pa0); PK4(p0, 8, pa1); PK4(p1, 0, pa2); PK4(p1, 8, pa3);
}
#undef PK4
template <int KB, bool BIAS>
__device__ __forceinline__ void qkt(f32x16& p0, f32x16& p1, const char* K_lds, int r32, int hi, const bf16x8* qr, const float* bt) {
    if constexpr (BIAS) {
#pragma unroll
        for (int g = 0; g < 4; ++g) { const f32x4 a = *(const f32x4*)(bt + 8 * g), b = *(const f32x4*)(bt + 32 + 8 * g);
            p0[4 * g] = a[0]; p0[4 * g + 1] = a[1]; p0[4 * g + 2] = a[2]; p0[4 * g + 3] = a[3];
            p1[4 * g] = b[0]; p1[4 * g + 1] = b[1]; p1[4 * g + 2] = b[2]; p1[4 * g + 3] = b[3]; }
    } else { p0 = f32x16{}; p1 = f32x16{}; }
    const char* kb[4];
#pragma unroll
    for (int dd = 0; dd < 4; ++dd) kb[dd] = K_lds + KB * SHM_K + KSWZ(r32, (dd * 16 + hi * 8) * 2);
#pragma unroll
    for (int d0 = 0; d0 < 8; ++d0) { const char* a = kb[d0 & 3] + (d0 >> 2) * 128;
        bf16x8 b0 = *reinterpret_cast<const bf16x8*>(a);
        bf16x8 b1 = *reinterpret_cast<const bf16x8*>(a + 32 * 256);
        p0 = __builtin_amdgcn_mfma_f32_32x32x16_bf16(b0, qr[d0], p0, 0, 0, 0);
        p1 = __builtin_amdgcn_mfma_f32_32x32x16_bf16(b1, qr[d0], p1, 0, 0, 0); }
}
template <int VB>
__device__ __forceinline__ void pv_tile(f32x16* o, int vb0, bf16x8 pa0, bf16x8 pa1, bf16x8 pa2, bf16x8 pa3) {
#define TRRD(dst, off) asm volatile("ds_read_b64_tr_b16 %0, %1 offset:%2" : "=&v"(dst) : "v"(vb0), "i"(off) : "memory")
#define PV_D0(d0) do { { s16x4 l0, l1, h0, h1; constexpr int b_ = VB * SHM_V + v_rd_off(d0, 0, 0); \
        TRRD(l0, b_); TRRD(h0, b_ + 2048); TRRD(l1, b_ + 4096); TRRD(h1, b_ + 6144); \
        asm volatile("s_waitcnt lgkmcnt(0)" ::: "memory"); SBAR();   \
        o[d0] = __builtin_amdgcn_mfma_f32_32x32x16_bf16(pa0, (bf16x8){l0[0], l0[1], l0[2], l0[3], h0[0], h0[1], h0[2], h0[3]}, o[d0], 0, 0, 0);   \
        o[d0] = __builtin_amdgcn_mfma_f32_32x32x16_bf16(pa1, (bf16x8){l1[0], l1[1], l1[2], l1[3], h1[0], h1[1], h1[2], h1[3]}, o[d0], 0, 0, 0); }  \
      { s16x4 l2, l3, h2, h3; constexpr int b_ = VB * SHM_V + v_rd_off(d0, 0, 0); \
        TRRD(l2, b_ + 8192); TRRD(h2, b_ + 10240); TRRD(l3, b_ + 12288); TRRD(h3, b_ + 14336); \
        asm volatile("s_waitcnt lgkmcnt(0)" ::: "memory"); SBAR();   \
        o[d0] = __builtin_amdgcn_mfma_f32_32x32x16_bf16(pa2, (bf16x8){l2[0], l2[1], l2[2], l2[3], h2[0], h2[1], h2[2], h2[3]}, o[d0], 0, 0, 0);   \
        o[d0] = __builtin_amdgcn_mfma_f32_32x32x16_bf16(pa3, (bf16x8){l3[0], l3[1], l3[2], l3[3], h3[0], h3[1], h3[2], h3[3]}, o[d0], 0, 0, 0); } } while (0)
    PV_D0(0); PV_D0(1); PV_D0(2); PV_D0(3);
#undef PV_D0
#undef TRRD
}

struct UnitRef { const bf16_t* Q; const bf16_t* K; const bf16_t* V; int P0; };
struct Seam { bf16x8 qr[8]; bf16x8 st_v0, st_v1, st_k0, st_k1; };
#define ROW(p, k0, rr) ((p) + (size_t)((k0) + (rr)) * D + sc)
#define VMW() asm volatile("s_waitcnt vmcnt(0)" ::: "memory")
#define SLOAD_H(Kp, Vp, k0) do { S.st_v0 = load8(ROW(Vp, k0, sr)); S.st_v1 = load8(ROW(Vp, k0, 32 + sr));              \
                         S.st_k0 = load8(ROW(Kp, k0, sr)); S.st_k1 = load8(ROW(Kp, k0, 32 + sr)); } while (0)
#define SWRITE_HK(bf) do { *(bf16x8*)(K_lds + (bf) * SHM_K + kws) = S.st_k0; *(bf16x8*)(K_lds + (bf) * SHM_K + kws + 32 * 256) = S.st_k1; } while (0)
#define SWRITE_HV(bf) do { *(bf16x8*)(V_lds + (bf) * SHM_V + vst0) = S.st_v0; *(bf16x8*)(V_lds + (bf) * SHM_V + vst1) = S.st_v1; } while (0)
#define SWRITE_H(bf) do { SWRITE_HV(bf); SWRITE_HK(bf); } while (0)

template <bool SB>
__device__ __forceinline__ void attn_unit(const UnitRef& cur, unsigned char* wsu  , int bh, char* lds,
                                          int part  ) {
    const float* cvec; const float* gqk;
    { unsigned char* w_ = wsu; asm volatile("" : "+s"(w_)); cvec = (const float*)(w_ + WS_C) + (size_t)bh * SEQ; gqk = (const float*)(w_ + WS_GQK); }
    const int tid = tid_opaque(), wid = __builtin_amdgcn_readfirstlane(tid >> 6), lane = tid & 63, r32 = lane & 31, hi = lane >> 5;
    int jlo = 0;
    if constexpr (!SB) {
        const float gq = fmaxf(fabsf(gqk[lane]), fabsf(gqk[64 + lane])), gk = fmaxf(fabsf(gqk[128 + lane]), fabsf(gqk[192 + lane]));
        const float lmax = 11.3137085f * 1.02f * wave_max(gq) * wave_max(gk);
        const int ntf = (cur.P0 + QB) / KVBLK;
        const float cend = (lane < ntf) ? cvec[lane * KVBLK + KVBLK - 1] : 0.f;
        const bool skip = (lane < ntf) && (2.f * lmax + cvec[cur.P0] - cend < -104.f);
        jlo = __builtin_amdgcn_readfirstlane((int)__popcll(__ballot(skip)));
    }
    const int ntot = (cur.P0 + QB) / KVBLK - jlo;
    const int tb = (part == 2) ? (ntot >> 1) : 0, te = (part == 1) ? (ntot >> 1) : ntot;
    const int kshift = (jlo + tb) * KVBLK, P0r = cur.P0 - kshift;
    const int NT = te - tb;
#define KBASE(t) ((SB ? (NT - 1 - (t)) : (t)) * KVBLK)
    const int qlo = P0r + wid * QBLK, qm = qlo + r32 - 4 * hi - (SB ? 1 : 0);
    char* V_lds = lds; char* K_lds = lds + 2 * SHM_V;
    float* ws = (float*)(lds + OFF_WS) + wid * 64; float* li_l = ws, * al_l = ws + 32;
    float* bias = (float*)(lds + OFF_BIAS);
    const int sr = tid >> 4, sc = (tid & 15) * 8, vst0 = v_st(sr, sc), vst1 = v_st(32 + sr, sc), kws = KSWZ(sr, sc * 2);
    const int vb0 = (int)(uintptr_t)V_lds + v_rd_base(lane);
    const bf16_t* Kh = cur.K + (size_t)kshift * D; const bf16_t* Vh = cur.V + (size_t)kshift * D;
    Seam S;
    if constexpr (!SB) { const float cq0 = cvec[cur.P0]; const float* cv = cvec + kshift; for (int j = tid; j < NT * KVBLK; j += NTHREADS) bias[j] = (cq0 - cv[j]) * (1.f / SCALE); }
#pragma unroll
    for (int d0 = 0; d0 < 8; ++d0) S.qr[d0] = load8(cur.Q + (size_t)(wid * QBLK + r32) * D + d0 * 16 + hi * 8);
    SLOAD_H(Kh, Vh, KBASE(0)); VMW(); SWRITE_HK(0);
    __syncthreads();
    float m_reg = -1e30f, l_reg = 0; f32x16 o[4] = {};
    float carry = 0.f; const float mlo = hi ? 0.f : 1.f;
#define RESC(a) do { if (__any((a) < 1.f)) { if (hi == 0) al_l[r32] = (a); asm volatile("s_waitcnt lgkmcnt(0)" ::: "memory");              \
                     for (int d_ = 0; d_ < 4; ++d_) for (int r = 0; r < 16; ++r) o[d_][r] *= al_l[crow(r, hi)]; } } while (0)
#define MASKT(P0_, P1_, t) do { const int kb_ = KBASE(t); if (kb_ + KVBLK - 1 > qlo - (SB ? 1 : 0)) mask_tile(P0_, P1_, qm - kb_); } while (0)
#define BT(t) (bias + KBASE(t) + 4 * hi)
#define PART1(PX0, PX1, mnX, alX) do { if constexpr (SB) sb_part1(PX0, PX1, carry, mlo); else partialSM(PX0, PX1, m_reg, mnX, alX); } while (0)
#define PART2(PY0, PY1, alY) do { if constexpr (SB) sb_part2(PY0, PY1, pa0, pa1, pa2, pa3); else finishSM(PY0, PY1, alY, l_reg, pa0, pa1, pa2, pa3); } while (0)
    f32x16 pA0, pA1, pB0, pB1; float mnA = 0.f, mnB = 0.f, alA = 1.f, alB = 1.f; bf16x8 pa0, pa1, pa2, pa3;
    SWRITE_HV(0); SBAR();
    if (NT > 1) SLOAD_H(Kh, Vh, KBASE(1));
    SBAR(); qkt<0, !SB>(pA0, pA1, K_lds, r32, hi, S.qr, BT(0));
    MASKT(pA0, pA1, 0); PART1(pA0, pA1, mnA, alA);
    if (NT > 1) { VMW(); SWRITE_H(1); }
    __syncthreads();
#define HALF_STEP(PX0, PX1, mnX, alX, PY0, PY1, alY, t, KB, VB, SBUF) do {                                                    \
        SBAR(); qkt<KB, !SB>(PX0, PX1, K_lds, r32, hi, S.qr, BT(t));                                                          \
        PART2(PY0, PY1, alY); SBAR();                                                                                          \
        if ((t) + 1 < NT) { SLOAD_H(Kh, Vh, KBASE((t) + 1)); SBAR(); }                                                         \
        pv_tile<VB>(o, vb0, pa0, pa1, pa2, pa3); MASKT(PX0, PX1, (t)); PART1(PX0, PX1, mnX, alX);                              \
        __syncthreads();                                                                                                      \
        if ((t) + 1 < NT) { VMW(); SWRITE_H(SBUF); }                                                                           \
        if constexpr (!SB) RESC(alX);                                                                                          \
        __syncthreads(); } while (0)
    for (int t = 1; t + 1 < NT; t += 2) {
        HALF_STEP(pB0, pB1, mnB, alB, pA0, pA1, alA, t, 1, 0, 0);
        HALF_STEP(pA0, pA1, mnA, alA, pB0, pB1, alB, t + 1, 0, 1, 1);
    }
    const bool even = (NT & 1) == 0;
    if (even) { SBAR(); qkt<1, !SB>(pB0, pB1, K_lds, r32, hi, S.qr, BT(NT - 1)); SBAR(); }
    PART2(pA0, pA1, alA); SBAR();
    pv_tile<0>(o, vb0, pa0, pa1, pa2, pa3);
    if (even) { MASKT(pB0, pB1, NT - 1); PART1(pB0, pB1, mnB, alB); __syncthreads(); if constexpr (!SB) RESC(alB);
        PART2(pB0, pB1, alB); SBAR(); pv_tile<1>(o, vb0, pa0, pa1, pa2, pa3); }
    unsigned char* we_ = wsu; asm volatile("" : "+s"(we_));
    if (part != 0) {
        const int slot2 = ((((cur.P0 >> 8) - 8) & 7) * 16 + bh) * 2 + (part == 2 ? 1 : 0);
        float* po = (float*)(we_ + WS_PO) + (size_t)slot2 * 256 * 128; float* pml = (float*)(we_ + WS_PML) + (size_t)slot2 * 512;
        if (hi == 0) { pml[(wid * QBLK + r32) * 2] = m_reg; pml[(wid * QBLK + r32) * 2 + 1] = l_reg; }
#pragma unroll
        for (int r = 0; r < 16; ++r)
#pragma unroll
            for (int d0 = 0; d0 < 4; ++d0) po[(size_t)(wid * QBLK + crow(r, hi)) * D + d0 * 32 + r32] = o[d0][r];
        __syncthreads();
        return;
    }
    const bf16_t* gate = (const bf16_t*)(we_ + WS_SEC) + 3 * SEC_ELEMS + (size_t)(bh >> 3) * SEQ * 1024 + (bh & 7) * HD;
    bf16_t* outp = (bf16_t*)(we_ + WS_MIX) + (size_t)(bh >> 3) * SEQ * DM + (bh & 7) * HD;
    float rli[16];
    if constexpr (!SB) {
        if (hi == 0) li_l[r32] = l_reg; asm volatile("s_waitcnt lgkmcnt(0)" ::: "memory");
#pragma unroll
        for (int r = 0; r < 16; ++r) rli[r] = __builtin_amdgcn_rcpf(li_l[crow(r, hi)]);
    }
#pragma unroll
    for (int r = 0; r < 16; ++r) { const int orow = cur.P0 + wid * QBLK + crow(r, hi);
#pragma unroll
        for (int d0 = 0; d0 < 4; ++d0) {
            float v = o[d0][r];
            if constexpr (!SB) { const unsigned short gb = gate[(size_t)orow * 1024 + d0 * 32 + r32]; v = v * rli[r] * __builtin_bit_cast(float, (unsigned)gb << 16); }
            const float vn = sx_f(v, 1);
            if ((r32 & 1) == 0) *(unsigned*)(outp + (size_t)orow * DM + d0 * 32 + r32) = cvt_pk_bf16(v, vn); } }
    __syncthreads();
#undef RESC
#undef KBASE
#undef MASKT
#undef BT
#undef PART1
#undef PART2
#undef HALF_STEP
}

constexpr float SB_TH = 150.f;
__device__ __forceinline__ void sb_unit(const UnitRef& cur, bf16_t* outp, char* lds) {
    const int tid = tid_opaque(), wid = __builtin_amdgcn_readfirstlane(tid >> 6), lane = tid & 63, r32 = lane & 31, hi = lane >> 5;
    const int NT = (cur.P0 + QB) / KVBLK;
#define KBASE(t) ((NT - 1 - (t)) * KVBLK)
    const int qlo = cur.P0 + wid * QBLK, qm = qlo + r32 - 4 * hi - 1;
    char* V_lds = lds; char* K_lds = lds + 2 * SHM_V;
    volatile int* flags = (volatile int*)(lds + OFF_WS);
    const int sr = tid >> 4, sc = (tid & 15) * 8, vst0 = v_st(sr, sc), vst1 = v_st(32 + sr, sc), kws = KSWZ(sr, sc * 2);
    const int vb0 = (int)(uintptr_t)V_lds + v_rd_base(lane);
    const bf16_t* Kh = cur.K; const bf16_t* Vh = cur.V;
    Seam S;
#pragma unroll
    for (int d0 = 0; d0 < 8; ++d0) S.qr[d0] = load8(cur.Q + (size_t)(wid * QBLK + r32) * D + d0 * 16 + hi * 8);
    SLOAD_H(Kh, Vh, KBASE(0)); VMW(); SWRITE_H(0);
    __syncthreads();
    f32x16 o[4] = {}; float carry = 0.f; const float mlo = hi ? 0.f : 1.f;
    bool wdone = false;
#define SB_STEP(tt, BUF) {                                                                                                 \
        const int kb_ = KBASE(tt);                                                                                           \
        if ((tt) + 1 < NT) SLOAD_H(Kh, Vh, KBASE((tt) + 1));                                                                 \
        SBAR();                                                                                                              \
        if (!wdone && kb_ <= qlo + QBLK - 2) {                                                                               \
            f32x16 p0, p1; bf16x8 pa0, pa1, pa2, pa3;                                                                        \
            qkt<BUF, false>(p0, p1, K_lds, r32, hi, S.qr, nullptr);                                                          \
            if (kb_ + KVBLK - 1 > qlo - 1) mask_tile(p0, p1, qm - kb_);                                                      \
            sb_part1(p0, p1, carry, mlo); sb_part2(p0, p1, pa0, pa1, pa2, pa3); SBAR();                                      \
            pv_tile<BUF>(o, vb0, pa0, pa1, pa2, pa3);                                                                        \
            wdone = __all(carry >= SB_TH);                                                                                   \
        }                                                                                                                    \
        if ((tt) + 1 < NT) { VMW(); SWRITE_H((BUF) ^ 1); }                                                                   \
        if (lane == 0) flags[((tt) & 1) * 8 + wid] = wdone ? 1 : 0;                                                          \
        __syncthreads();                                                                                                     \
        { int alld = 1;                                                                                                      \
          _Pragma("unroll") for (int w_ = 0; w_ < 8; ++w_) alld &= flags[((tt) & 1) * 8 + w_];                                \
          if (alld) break; } }
    for (int t = 0; t < NT; t += 2) {
        SB_STEP(t, 0)
        SB_STEP(t + 1, 1)
    }
#undef SB_STEP
#pragma unroll
    for (int r = 0; r < 16; ++r) { const int orow = cur.P0 + wid * QBLK + crow(r, hi);
#pragma unroll
        for (int d0 = 0; d0 < 4; ++d0) {
            const float v = o[d0][r];
            const float vn = sx_f(v, 1);
            if ((r32 & 1) == 0) *(unsigned*)(outp + (size_t)orow * DM + d0 * 32 + r32) = cvt_pk_bf16(v, vn); } }
    __syncthreads();
#undef KBASE
}
#undef ROW
#undef VMW
#undef SLOAD_H
#undef SWRITE_HK
#undef SWRITE_HV
#undef SWRITE_H
}

#define XB_TMO      128
#define XB_XCNT(j)  (256  + 64 * (j))
#define XB_XSUB(j)  (1280 + 64 * (j))
#define XB_XGEN(j)  (2304 + 64 * (j))
#define XB_TOP      3328
#define XB_TOPGEN   3392
#define XCD_BAR_WORDS 3456
#define XB_SPIN_CAP (1u << 20)
__device__ __forceinline__ unsigned xb_ld(unsigned* p)              { return __hip_atomic_load(p, __ATOMIC_RELAXED, __HIP_MEMORY_SCOPE_AGENT); }
__device__ __forceinline__ unsigned xb_add(unsigned* p, unsigned v) { return __hip_atomic_fetch_add(p, v, __ATOMIC_RELAXED, __HIP_MEMORY_SCOPE_AGENT); }
__device__ __forceinline__ unsigned xb_xcc_id() { return (unsigned)__builtin_amdgcn_s_getreg((3 << 11) | 20) & 0xFu; }
#define XB_SPIN(cond, bar) do { unsigned _sp = 0; while (cond) { __builtin_amdgcn_s_sleep(1); \
    if ((++_sp & 255u) == 0u) { if (xb_ld(&(bar)[XB_TMO])) break; if (_sp > XB_SPIN_CAP) { atomicAdd(&(bar)[XB_TMO], 1u); break; } } } } while (0)
struct XcdBarrier { unsigned* bar; unsigned x; volatile LAS unsigned* st; };
__device__ __forceinline__ XcdBarrier xcd_barrier_post(unsigned* bar, volatile LAS unsigned* st) {
    XcdBarrier b; b.bar = bar; b.x = xb_xcc_id(); b.st = st;
    if (threadIdx.x == 0) (void)xb_add(&bar[XB_XCNT(b.x)], 1u);
    return b;
}
__device__ __forceinline__ void xcd_barrier_complete(unsigned* bar, unsigned x, unsigned& nloc, unsigned& nx) {
    const unsigned G = gridDim.x * gridDim.y * gridDim.z;
    unsigned sum, cnt, mine, sp = 0u;
    for (;;) {
        sum = 0u; cnt = 0u; mine = 0u;
#pragma unroll
        for (unsigned j = 0; j < 16; ++j) { const unsigned c = xb_ld(&bar[XB_XCNT(j)]); sum += c; cnt += (c > 0u) ? 1u : 0u; mine = (j == x) ? c : mine; }
        if (sum == G) break;
        __builtin_amdgcn_s_sleep(1);
        if ((++sp & 255u) == 0u) { if (xb_ld(&bar[XB_TMO])) break; if (sp > XB_SPIN_CAP) { atomicAdd(&bar[XB_TMO], 1u); break; } }
    }
    nloc = mine > 0u ? mine : 1u; nx = cnt > 0u ? cnt : 1u;
}
__device__ __forceinline__ void xcd_barrier(const XcdBarrier& b) {
    asm volatile("s_waitcnt vmcnt(0)" ::: "memory");
    __syncthreads();
    if (threadIdx.x == 0) {
        unsigned* bar = b.bar;
        __builtin_amdgcn_s_waitcnt(0);
        unsigned nloc = b.st[0], nx = b.st[1];
        if (nloc == 0u) { xcd_barrier_complete(bar, b.x, nloc, nx); b.st[0] = nloc; b.st[1] = nx; }
        const unsigned old = xb_add(&bar[XB_XSUB(b.x)], 1u);
        const unsigned gen = old / nloc;
        if (old + 1u == (gen + 1u) * nloc) {
            __builtin_amdgcn_fence(__ATOMIC_RELEASE, "agent");
            asm volatile("s_waitcnt vmcnt(0)" ::: "memory");
            const unsigned og = xb_add(&bar[XB_TOP], 1u);
            const unsigned tg = og / nx;
            if (og + 1u == (tg + 1u) * nx) xb_add(&bar[XB_TOPGEN], 1u);
            else XB_SPIN(xb_ld(&bar[XB_TOPGEN]) == tg, bar);
            __builtin_amdgcn_fence(__ATOMIC_ACQUIRE, "agent");
            xb_add(&bar[XB_XGEN(b.x)], 1u);
            asm volatile("s_waitcnt vmcnt(0)" ::: "memory");
        } else {
            XB_SPIN(xb_ld(&bar[XB_XGEN(b.x)]) == gen, bar);
            __builtin_amdgcn_fence(__ATOMIC_ACQUIRE, "agent");
            asm volatile("s_waitcnt vmcnt(0)" ::: "memory");
        }
    }
    __syncthreads();
}

struct Args { const float* in[12]; float* out; unsigned char* ws; int ph_lo, ph_hi; };

__device__ __forceinline__ void p0_transpose_item(const float* W, int ldw, int K, bf16_t* WT, int nblk, LAS float* scr, int item, int lane, const float* gk) {
    const int kb = item / nblk, nb = item % nblk, k0 = 64 * kb, n0 = 32 * nb;
#pragma unroll 8
    for (int i = 0; i < 32; ++i) { const int kk = 2 * i + (lane >> 5); float w = W[(size_t)(k0 + kk) * ldw + n0 + (lane & 31)]; if (gk) w *= gk[k0 + kk]; scr[kk * 33 + (lane & 31)] = w; }
    LDS_WAIT(); asm volatile("" ::: "memory");
    const int c = lane & 7;
#pragma unroll
    for (int j = 0; j < 4; ++j) { const int n = (lane >> 3) + 8 * j; const LAS float* s = scr + (8 * c) * 33 + n;
        u32x4 o; o.x = cvt_pk_bf16(s[0 * 33], s[1 * 33]); o.y = cvt_pk_bf16(s[2 * 33], s[3 * 33]); o.z = cvt_pk_bf16(s[4 * 33], s[5 * 33]); o.w = cvt_pk_bf16(s[6 * 33], s[7 * 33]);
        *(u32x4*)(WT + (size_t)(n0 + n) * K + k0 + 8 * c) = o; }
    LDS_WAIT(); asm volatile("" ::: "memory");
}

__device__ __forceinline__ int pack_i8(float a, float b, float c, float d) {
    const int ia = (int)__builtin_rintf(a), ib = (int)__builtin_rintf(b), ic = (int)__builtin_rintf(c), id = (int)__builtin_rintf(d);
    return (int)(((unsigned)ia & 0xffu) | (((unsigned)ib & 0xffu) << 8) | (((unsigned)ic & 0xffu) << 16) | ((unsigned)id << 24));
}
__device__ __forceinline__ void convert_tables(const Args& a, int r0, int r1, int worker, int nworkers) {
    const int lane = tid_opaque() & 63;
    unsigned char* ws = a.ws; const float* g_ffn = a.in[7]; const float* pu = a.in[10]; const float* pv = a.in[11];
    float* suv = (float*)(ws + WS_SUV);
    for (int r = r0 + worker; r < r1; r += nworkers) {
        const bool isv = r >= NEXP; const int e = isv ? r - NEXP : r;
        const f32x4* srcp = (const f32x4*)((isv ? pv : pu) + (size_t)e * DM);
        f32x4 v[8]; float amax = 0.f;
#pragma unroll
        for (int j = 0; j < 8; ++j) { v[j] = srcp[lane + 64 * j];
            if (!isv) { const f32x4 g4 = *(const f32x4*)(g_ffn + 4 * (lane + 64 * j)); v[j] = v[j] * g4; }
            amax = fmaxf(amax, fmaxf(fmaxf(fabsf(v[j][0]), fabsf(v[j][1])), fmaxf(fabsf(v[j][2]), fabsf(v[j][3])))); }
        amax = wave_max(amax);
        const float sc = amax > 0.f ? 127.f / amax : 1.f;
        unsigned char* dst = ws + (isv ? WS_V8 : WS_U8) + (size_t)e * 128;
#pragma unroll
        for (int j = 0; j < 8; ++j) { const int p = pack_i8(v[j][0] * sc, v[j][1] * sc, v[j][2] * sc, v[j][3] * sc);
            const int col = 4 * (lane + 64 * j);
            *(unsigned*)(dst + (size_t)(col >> 7) * ((size_t)NEXP * 128) + (col & 127)) = (unsigned)p; }
        if (lane == 0) suv[r] = 1.f / sc;
    }
}
constexpr int TAB_SPLIT = NEXP;

__device__ __forceinline__ void p0_transpose_item_i8(const float* W, int ldw, int K, unsigned char* WT, int nblk, LAS float* scr, int item, int lane, float q8) {
    const int kb = item / nblk, nb = item % nblk, k0 = 64 * kb, n0 = 32 * nb;
#pragma unroll 8
    for (int i = 0; i < 32; ++i) { const int kk = 2 * i + (lane >> 5); scr[kk * 33 + (lane & 31)] = W[(size_t)(k0 + kk) * ldw + n0 + (lane & 31)] * q8; }
    LDS_WAIT(); asm volatile("" ::: "memory");
    const int c = lane & 7;
#pragma unroll
    for (int j = 0; j < 4; ++j) { const int n = (lane >> 3) + 8 * j; const LAS float* s = scr + (8 * c) * 33 + n;
        u32x2 o; o.x = (unsigned)pack_i8(s[0 * 33], s[1 * 33], s[2 * 33], s[3 * 33]); o.y = (unsigned)pack_i8(s[4 * 33], s[5 * 33], s[6 * 33], s[7 * 33]);
        *(u32x2*)(WT + (size_t)(n0 + n) * K + k0 + 8 * c) = o; }
    LDS_WAIT(); asm volatile("" ::: "memory");
}
__device__ __forceinline__ float log_sigmoid_f(float x) { return fminf(x, 0.f) - log1pf(expf(-fabsf(x))); }

__device__ __forceinline__ void phase0(const Args& a, unsigned char* lds_g) {
    LAS unsigned char* lds = (LAS unsigned char*)lds_g;
    const int tid = tid_opaque(), lane = tid & 63, wave = __builtin_amdgcn_readfirstlane(tid >> 6);
    const int gw = blockIdx.x * NWAVES + wave, NGW = gridDim.x * NWAVES;
    const int gt = blockIdx.x * NTHREADS + tid, NGT = gridDim.x * NTHREADS;
    unsigned char* ws = a.ws;
    const float* x = a.in[0]; const float* g_attn = a.in[1]; const float* w_in = a.in[2]; const float* b_forget = a.in[3];
    const float* w_out = a.in[6]; const float* g_ffn = a.in[7]; const float* w_pq = a.in[8]; const float* sk = a.in[9]; const float* pu = a.in[10]; const float* pv = a.in[11];
    { float m = 0.f; const f32x4* wp = (const f32x4*)w_in;
      for (size_t i = gt; i < (size_t)DM * DIN / 4; i += NGT) { const f32x4 v = wp[i]; m = fmaxf(m, fmaxf(fmaxf(fabsf(v[0]), fabsf(v[1])), fmaxf(fabsf(v[2]), fabsf(v[3])))); }
      m = wave_max(m);
      if (lane == 0) __hip_atomic_fetch_max((unsigned*)(ws + WS_CTL) + CW_WMAX, __float_as_uint(m), __ATOMIC_RELAXED, __HIP_MEMORY_SCOPE_AGENT); }
    LAS float* wf = (LAS float*)(lds + 67584);
    for (int k = tid; k < DM; k += NTHREADS) { const f32x4 a0 = *(const f32x4*)(w_in + (size_t)k * DIN + NPROJ), a1 = *(const f32x4*)(w_in + (size_t)k * DIN + NPROJ + 4);
        *(LAS f32x4*)(wf + k * 8) = a0; *(LAS f32x4*)(wf + k * 8 + 4) = a1; }
    __syncthreads();
    for (int row = gw; row < T; row += NGW) {
        const f32x4* xr = (const f32x4*)(x + (size_t)row * DM);
        f32x4 v[8]; float ss = 0.f;
#pragma unroll
        for (int j = 0; j < 8; ++j) { v[j] = xr[lane + 64 * j]; ss += v[j][0] * v[j][0] + v[j][1] * v[j][1] + v[j][2] * v[j][2] + v[j][3] * v[j][3]; }
        const float r = 1.0f / sqrtf(wave_sum(ss) * (1.f / DM) + EPS);
        float f[8] = {0.f, 0.f, 0.f, 0.f, 0.f, 0.f, 0.f, 0.f};
        float xmax = 0.f;
#pragma unroll
        for (int j = 0; j < 8; ++j) { const f32x4 g4 = *(const f32x4*)(g_attn + 4 * (lane + 64 * j)); v[j][0] *= r * g4[0]; v[j][1] *= r * g4[1]; v[j][2] *= r * g4[2]; v[j][3] *= r * g4[3];
            xmax = fmaxf(xmax, fmaxf(fmaxf(fabsf(v[j][0]), fabsf(v[j][1])), fmaxf(fabsf(v[j][2]), fabsf(v[j][3])))); }
        xmax = wave_max(xmax);
        const float xq = xmax > 0.f ? 127.f / xmax : 1.f;
        if (lane == 0) ((float*)(ws + WS_SXN))[row] = xmax * (1.f / 127.f);
        unsigned* o8 = (unsigned*)(ws + WS_XN + (size_t)row * DM);
#pragma unroll
        for (int j = 0; j < 8; ++j) {
            const int e = 4 * (lane + 64 * j);
            const f32x4 xn = v[j];
            o8[lane + 64 * j] = (unsigned)pack_i8(xn[0] * xq, xn[1] * xq, xn[2] * xq, xn[3] * xq);
#pragma unroll
            for (int q = 0; q < 4; ++q) { const f32x4 w0 = *(LAS f32x4*)(wf + (e + q) * 8), w1 = *(LAS f32x4*)(wf + (e + q) * 8 + 4);
                f[0] += xn[q] * w0[0]; f[1] += xn[q] * w0[1]; f[2] += xn[q] * w0[2]; f[3] += xn[q] * w0[3];
                f[4] += xn[q] * w1[0]; f[5] += xn[q] * w1[1]; f[6] += xn[q] * w1[2]; f[7] += xn[q] * w1[3]; }
            __builtin_amdgcn_sched_barrier(0);
        }
#pragma unroll
        for (int hh = 0; hh < 8; ++hh) f[hh] = wave_sum(f[hh]);
        if (lane < 8) { float fl = f[0];
#pragma unroll
            for (int hh = 1; hh < 8; ++hh) fl = (lane == hh) ? f[hh] : fl;
            const int b = row >> 12, s = row & 4095;
            ((float*)(ws + WS_LOGF))[(size_t)(b * 8 + lane) * SEQ + s] = log_sigmoid_f(fl + b_forget[lane]); }
    }
    LAS float* scr = (LAS float*)(lds + wave * 8448);
    constexpr int I_IN = (DM / 64) * (NPROJ / 32), I_O = (DM / 64) * (DM / 32);
    for (int it = gw; it < 2 * I_O; it += NGW) {
        int r = it;
        if (r < I_O) { p0_transpose_item(w_out, DM, DM, (bf16_t*)(ws + WS_WOUT), DM / 32, scr, r, lane, nullptr); continue; } r -= I_O;
        p0_transpose_item(w_pq, DM, DM, (bf16_t*)(ws + WS_WPQ), DM / 32, scr, r, lane, g_ffn);
    }
    for (int i = gt; i < 8 * 2 * 128 * 128 / 8; i += NGT) { const f32x4 a0 = *(const f32x4*)(sk + (size_t)i * 8), a1 = *(const f32x4*)(sk + (size_t)i * 8 + 4);
        u32x4 w; w.x = cvt_pk_bf16(a0[0], a0[1]); w.y = cvt_pk_bf16(a0[2], a0[3]); w.z = cvt_pk_bf16(a1[0], a1[1]); w.w = cvt_pk_bf16(a1[2], a1[3]);
        *(u32x4*)(ws + WS_SK + (size_t)i * 16) = w; }
    if (gt < 256) ((float*)(ws + WS_GQK))[gt] = gt < 128 ? a.in[4][gt] : a.in[5][gt - 128];
    convert_tables(a, 0, TAB_SPLIT, gw, NGW);
    { XcdBarrier xb_; xb_.bar = (unsigned*)(ws + WS_CTL) + CW_BAR; xb_.x = xb_xcc_id(); xb_.st = (volatile LAS unsigned*)(lds + MISC_OFF) + 8; xcd_barrier(xb_); }
    const float wmax = __uint_as_float(__hip_atomic_load((unsigned*)(ws + WS_CTL) + CW_WMAX, __ATOMIC_RELAXED, __HIP_MEMORY_SCOPE_AGENT));
    if (gt == 0) *(float*)(ws + WS_WSC) = wmax * (1.f / 127.f);
    const float q8 = wmax > 0.f ? 127.f / wmax : 1.f;
    for (int it = gw; it < I_IN; it += NGW) p0_transpose_item_i8(w_in, DIN, DM, ws + WS_WIN, NPROJ / 32, scr, it, lane, q8);
}

__device__ __forceinline__ void cumsum_rows(const Args& a) {
    const int tid = tid_opaque(), lane = tid & 63, wave = tid >> 6;
    if (blockIdx.x >= 16 || wave != 0) return;
    const float* src = (const float*)(a.ws + WS_LOGF) + (size_t)blockIdx.x * SEQ + lane * 64;
    float* dst = (float*)(a.ws + WS_C) + (size_t)blockIdx.x * SEQ + lane * 64;
    f32x4 v[16]; float run = 0.f;
#pragma unroll
    for (int i = 0; i < 16; ++i) { v[i] = *(const f32x4*)(src + 4 * i);
#pragma unroll
        for (int q = 0; q < 4; ++q) { run += v[i][q]; v[i][q] = run; } }
    float incl = run;
#pragma unroll
    for (int o = 1; o < 64; o <<= 1) { const float t = shup_f(incl, o); if (lane >= o) incl += t; }
    const float off = incl - run;
#pragma unroll
    for (int i = 0; i < 16; ++i) { f32x4 w = v[i]; w[0] += off; w[1] += off; w[2] += off; w[3] += off; *(f32x4*)(dst + 4 * i) = w; }
}

__device__ __forceinline__ void phase_qknorm(const Args& a) {
    const int tid = tid_opaque(), lane = tid & 63, wave = tid >> 6;
    const int gw = blockIdx.x * NWAVES + wave, NGW = gridDim.x * NWAVES;
    const int sub = lane & 15, rw = lane >> 4;
    const float* gq = a.in[4]; const float* gk = a.in[5];
    constexpr int ROWS = NB * NHF * SEQ;
    for (int it = gw; it < 2 * ROWS / 4; it += NGW) {
        const int row = it * 4 + rw; const bool isk = row >= ROWS;
        bf16_t* p = (bf16_t*)(a.ws + WS_SEC) + (size_t)row * HD + sub * 8;
        const float* g = (isk ? gk : gq) + sub * 8;
        const u32x4 w = *(const u32x4*)p;
        float v[8] = {bf_lo(w.x), bf_hi(w.x), bf_lo(w.y), bf_hi(w.y), bf_lo(w.z), bf_hi(w.z), bf_lo(w.w), bf_hi(w.w)};
        float ss = 0.f;
#pragma unroll
        for (int i = 0; i < 8; ++i) ss += v[i] * v[i];
        ss += sx_f(ss, 1); ss += sx_f(ss, 2); ss += sx_f(ss, 4); ss += sx_f(ss, 8);
        const float r = 1.0f / sqrtf(ss * (1.f / HD) + EPS);
        const f32x4 g0 = *(const f32x4*)g, g1 = *(const f32x4*)(g + 4);
        u32x4 o; o.x = cvt_pk_bf16(v[0] * r * g0[0], v[1] * r * g0[1]); o.y = cvt_pk_bf16(v[2] * r * g0[2], v[3] * r * g0[3]);
        o.z = cvt_pk_bf16(v[4] * r * g1[0], v[5] * r * g1[1]); o.w = cvt_pk_bf16(v[6] * r * g1[2], v[7] * r * g1[3]);
        *(u32x4*)p = o;
    }
}

__device__ __forceinline__ void phase_attn(const Args& a, unsigned char* lds_g) {
    const int tid = tid_opaque();
    volatile int* s_item = (volatile int*)(lds_g + MISC_OFF);
    unsigned* ctr = (unsigned*)(a.ws + WS_CTL);
    for (;;) {
        __syncthreads();
        if (tid == 0) *s_item = (int)atomicAdd(ctr, 1u);
        __syncthreads();
        int it = *s_item, kind = -1, qb = 0, sub = 0;
#define CLS(K, Q, CNT) if (kind < 0) { if (it < (CNT)) { kind = (K); qb = (Q); sub = it; } else it -= (CNT); }
        CLS(2, 15, 32) CLS(1, 7, 16) CLS(2, 14, 32) CLS(2, 13, 32) CLS(1, 6, 16) CLS(2, 12, 32) CLS(2, 11, 32) CLS(1, 5, 16) CLS(2, 10, 32) CLS(2, 9, 32) CLS(1, 4, 16) CLS(2, 8, 32) CLS(1, 3, 16) CLS(1, 2, 16)
        if (kind < 0) { if (it < 256) { kind = 0; qb = 15 - (it >> 4); sub = it & 15; } else it -= 256; }
        CLS(1, 1, 16) CLS(1, 0, 16)
#undef CLS
        if (kind < 0) break;
        unsigned char* wsl = a.ws; asm volatile("" : "+s"(wsl));
        bf16_t* sec = (bf16_t*)(wsl + WS_SEC);
        const int bh = sub & 15, part = (kind == 2) ? 1 + (sub >> 4) : 0;
        const int b = bh >> 3, h = bh & 7;
        const size_t hoff = (size_t)bh * SEQ * HD;
        att::UnitRef u;
        u.P0 = qb * 256;
        if (kind == 0) {
            u.Q = sec + 4 * SEC_ELEMS + hoff + (size_t)u.P0 * HD; u.K = sec + 5 * SEC_ELEMS + hoff; u.V = sec + 6 * SEC_ELEMS + hoff;
            att::sb_unit(u, (bf16_t*)(wsl + WS_MIX) + (size_t)b * SEQ * DM + 1024 + h * HD, (char*)lds_g);
        } else {
            u.Q = sec + 0 * SEC_ELEMS + hoff + (size_t)u.P0 * HD; u.K = sec + 1 * SEC_ELEMS + hoff; u.V = sec + 2 * SEC_ELEMS + hoff;
            att::attn_unit<false>(u, wsl, bh, (char*)lds_g, part);
        }
    }
}
__device__ __forceinline__ void phase_attn_combine(const Args& a) {
    const int gt = blockIdx.x * NTHREADS + tid_opaque(), NGT = gridDim.x * NTHREADS;
    const float* po = (const float*)(a.ws + WS_PO); const float* pml = (const float*)(a.ws + WS_PML);
    const bf16_t* gate = (const bf16_t*)(a.ws + WS_SEC) + 3 * SEC_ELEMS; bf16_t* mix = (bf16_t*)(a.ws + WS_MIX);
    constexpr float C2 = LOG2E * SCALE;
    for (int item = gt; item < 128 * 256 * 16; item += NGT) {
        const int slot = item >> 12, row = (item >> 4) & 255, cg = item & 15;
        const int qb = 8 + (slot >> 4), bh = slot & 15, b = bh >> 3, h = bh & 7;
        const f32x2 ml1 = *(const f32x2*)(pml + (size_t)(slot * 2) * 512 + row * 2), ml2 = *(const f32x2*)(pml + (size_t)(slot * 2 + 1) * 512 + row * 2);
        const float M = fmaxf(ml1.x, ml2.x), a1 = __builtin_amdgcn_exp2f((ml1.x - M) * C2), a2 = __builtin_amdgcn_exp2f((ml2.x - M) * C2);
        const float inv = 1.f / (a1 * ml1.y + a2 * ml2.y);
        const float* p1 = po + (size_t)(slot * 2) * 32768 + row * 128 + cg * 8; const float* p2 = p1 + 32768;
        const f32x4 x0 = *(const f32x4*)p1, x1 = *(const f32x4*)(p1 + 4), y0 = *(const f32x4*)p2, y1 = *(const f32x4*)(p2 + 4);
        const size_t tok = (size_t)b * SEQ + qb * 256 + row;
        const u32x4 gw = *(const u32x4*)(gate + tok * 1024 + h * HD + cg * 8);
        const float w1 = a1 * inv, w2 = a2 * inv;
        u32x4 o;
        o.x = cvt_pk_bf16((w1 * x0[0] + w2 * y0[0]) * bf_lo(gw.x), (w1 * x0[1] + w2 * y0[1]) * bf_hi(gw.x));
        o.y = cvt_pk_bf16((w1 * x0[2] + w2 * y0[2]) * bf_lo(gw.y), (w1 * x0[3] + w2 * y0[3]) * bf_hi(gw.y));
        o.z = cvt_pk_bf16((w1 * x1[0] + w2 * y1[0]) * bf_lo(gw.z), (w1 * x1[1] + w2 * y1[1]) * bf_hi(gw.z));
        o.w = cvt_pk_bf16((w1 * x1[2] + w2 * y1[2]) * bf_lo(gw.w), (w1 * x1[3] + w2 * y1[3]) * bf_hi(gw.w));
        *(u32x4*)(mix + tok * DM + h * HD + cg * 8) = o;
    }
}

__device__ __forceinline__ unsigned f2ord(float f) { const unsigned u = __float_as_uint(f); return u ^ ((unsigned)((int)u >> 31) | 0x80000000u); }
__device__ __forceinline__ float ord2f(unsigned k) { const unsigned u = k ^ (~(unsigned)((int)k >> 31) | 0x80000000u); return __uint_as_float(u); }
#define INS16(L, X) do { unsigned x_ = (X); _Pragma("unroll") for (int i_ = 0; i_ < 16; ++i_) { const unsigned hi_ = max(L[i_], x_); x_ = min(L[i_], x_); L[i_] = hi_; } } while (0)
__device__ __forceinline__ void topk_half(const bf16_t* qp, const bf16_t* skb, int t0, int h, int c, int r32, int hi, unsigned (&L)[16]) {
    bf16x8 qf[8];
#pragma unroll
    for (int d0 = 0; d0 < 8; ++d0) qf[d0] = *(const bf16x8*)(qp + (size_t)(t0 + r32) * DM + h * 256 + c * 128 + d0 * 16 + hi * 8);
#pragma unroll
    for (int i = 0; i < 16; ++i) L[i] = 0u;
    const unsigned hi4 = 4u * (unsigned)hi;
#pragma unroll
    for (int kt = 0; kt < 4; ++kt) {
        f32x16 acc = f32x16{};
#pragma unroll
        for (int d0 = 0; d0 < 8; ++d0) { const bf16x8 kf = *(const bf16x8*)(skb + (size_t)((h * 2 + c) * 128 + kt * 32 + r32) * 128 + d0 * 16 + hi * 8);
            acc = __builtin_amdgcn_mfma_f32_32x32x16_bf16(kf, qf[d0], acc, 0, 0, 0); }
        __builtin_amdgcn_sched_barrier(0);
#pragma unroll
        for (int r = 0; r < 16; ++r) { const unsigned cst = (unsigned)(127 - (kt * 32 + (r & 3) + 8 * (r >> 2)));
            const unsigned kk = (f2ord(acc[r]) & ~127u) | (cst - hi4); INS16(L, kk); }
        __builtin_amdgcn_sched_barrier(0);
    }
    unsigned P[16];
#pragma unroll
    for (int i = 0; i < 16; ++i) { auto rr = __builtin_amdgcn_permlane32_swap(L[i], L[i], false, false); P[i] = hi ? rr[0] : rr[1]; }
#pragma unroll
    for (int i = 0; i < 16; ++i) INS16(L, P[i]);
}
__device__ __forceinline__ void phase_topk(const Args& a, unsigned char* lds_g) {
    LAS unsigned char* lds = (LAS unsigned char*)lds_g;
    const int tid = tid_opaque(), lane = tid & 63, wave = tid >> 6, r32 = lane & 31, hi = lane >> 5;
    const int gw = blockIdx.x * NWAVES + wave, NGW = gridDim.x * NWAVES;
    const bf16_t* skb = (const bf16_t*)(a.ws + WS_SK); const bf16_t* qp = (const bf16_t*)(a.ws + WS_QP);
    int* idx_o = (int*)(a.ws + WS_IDX); float* gw_o = (float*)(a.ws + WS_GW);
    for (int task = gw; task < (T / 32) * 8; task += NGW) {
        const int h = task & 7, t0 = (task >> 3) * 32;
        {
          const bf16_t* hbp = (const bf16_t*)(a.ws + WS_HB); const float* amx = (const float*)(a.ws + WS_AMX); unsigned char* xq = a.ws + WS_XQ;
          float am = 0.f;
          { const f32x4* ap = (const f32x4*)(amx + (size_t)(t0 + (lane & 31)) * 32);
#pragma unroll
            for (int i = 0; i < 8; ++i) { const f32x4 v = ap[i]; am = fmaxf(am, fmaxf(fmaxf(v[0], v[1]), fmaxf(v[2], v[3]))); } }
          if (h == 0 && lane < 32) ((float*)(a.ws + WS_SX))[t0 + lane] = ((const float*)(a.ws + WS_RT))[t0 + lane] * am * (1.f / 126.5f);
          const float qs = am > 0.f ? 126.5f / am : 1.f;
#pragma unroll 4
          for (int j = 0; j < 16; ++j) { const int ch = lane + 64 * j, tl = ch >> 5, tk = t0 + tl, col = h * 256 + (ch & 31) * 8;
              const u32x4 w = *(const u32x4*)(hbp + (size_t)tk * DM + col); const float r = sh_f(qs, tl);
              const int p0 = pack_i8(bf_lo(w.x) * r, bf_hi(w.x) * r, bf_lo(w.y) * r, bf_hi(w.y) * r), p1 = pack_i8(bf_lo(w.z) * r, bf_hi(w.z) * r, bf_lo(w.w) * r, bf_hi(w.w) * r);
              *(u32x2*)(xq + (size_t)tk * DM + col) = (u32x2){(unsigned)p0, (unsigned)p1}; } }
        unsigned L[2][16];
        topk_half(qp, skb, t0, h, 0, r32, hi, L[0]);
        __builtin_amdgcn_sched_barrier(0);
        topk_half(qp, skb, t0, h, 1, r32, hi, L[1]);
        __builtin_amdgcn_sched_barrier(0);
        float s1[16], s2[16]; int i1[16], i2[16];
#pragma unroll
        for (int i = 0; i < 16; ++i) { s1[i] = ord2f((L[0][i] & ~127u) | 64u); i1[i] = 127 - (int)(L[0][i] & 127u); s2[i] = ord2f((L[1][i] & ~127u) | 64u); i2[i] = 127 - (int)(L[1][i] & 127u); }
        unsigned LC[16];
#pragma unroll
        for (int i = 0; i < 16; ++i) LC[i] = 0u;
#pragma unroll
        for (int aa = 0; aa < 16; ++aa)
#pragma unroll
            for (int bb = 0; bb < 16; ++bb) if ((aa + 1) * (bb + 1) <= 16) { const unsigned kk = (f2ord(s1[aa] + s2[bb]) & ~255u) | (unsigned)(aa * 16 + bb); INS16(LC, kk); }
        LAS int* tb = (LAS int*)(lds + wave * 8192);
#pragma unroll
        for (int i = 0; i < 16; ++i) { tb[i * 64 + lane] = i1[i]; tb[(16 + i) * 64 + lane] = i2[i]; }
        float LS[16]; int LP[16];
#pragma unroll
        for (int i = 0; i < 16; ++i) { const unsigned cid = LC[i] & 255u; LS[i] = ord2f((LC[i] & ~255u) | 128u);
            LP[i] = tb[(cid >> 4) * 64 + lane] * 128 + tb[(16 + (cid & 15u)) * 64 + lane]; }
        float den = 0.f, e[16];
#pragma unroll
        for (int i = 0; i < 16; ++i) { e[i] = __expf(LS[i] - LS[0]); den += e[i]; }
        const float rden = 1.f / den;
        const size_t ob = (size_t)(t0 + r32) * NE + h * 16;
        if (hi == 0) {
#pragma unroll
            for (int i = 0; i < 4; ++i) *(int4*)(idx_o + ob + 4 * i) = make_int4(LP[4 * i], LP[4 * i + 1], LP[4 * i + 2], LP[4 * i + 3]);
        } else {
#pragma unroll
            for (int i = 0; i < 4; ++i) *(f32x4*)(gw_o + ob + 4 * i) = (f32x4){e[4 * i] * rden, e[4 * i + 1] * rden, e[4 * i + 2] * rden, e[4 * i + 3] * rden};
        }
    }
}


__device__ __forceinline__ void wave_argmax(float& v, int& i) {
#pragma unroll
    for (int o = 1; o < 64; o <<= 1) { const float ov = sx_f(v, o); const int oi = sx_i(i, o); if (ov > v || (ov == v && oi < i)) { v = ov; i = oi; } }
}
__device__ __forceinline__ void phase_topk_ref(const Args& a) {
    const int tid = tid_opaque(), lane = tid & 63, wave = tid >> 6;
    const int gw = blockIdx.x * NWAVES + wave, NGW = gridDim.x * NWAVES;
    const bf16_t* skb = (const bf16_t*)(a.ws + WS_SK); const bf16_t* qp = (const bf16_t*)(a.ws + WS_QP);
    int* idx_o = (int*)(a.ws + WS_IDX); float* gw_o = (float*)(a.ws + WS_GW);
    for (int task = gw; task < T * 8; task += NGW) {
        const int t = task >> 3, h = task & 7;
        float topS[2]; int topI[2];
        for (int c = 0; c < 2; ++c) {
            const bf16_t* q = qp + (size_t)t * DM + h * 256 + c * 128;
            float sc0 = 0.f, sc1 = 0.f;
            const bf16_t* k0 = skb + (size_t)((h * 2 + c) * 128 + lane) * 128; const bf16_t* k1 = k0 + 64 * 128;
            for (int d = 0; d < 128; ++d) { const float qd = __uint_as_float((unsigned)q[d] << 16);
                sc0 += qd * __uint_as_float((unsigned)k0[d] << 16); sc1 += qd * __uint_as_float((unsigned)k1[d] << 16); }
            float ms = 0.f; int mi = 0;
            for (int r = 0; r < 16; ++r) {
                float v; int i; if (sc0 >= sc1) { v = sc0; i = lane; } else { v = sc1; i = lane + 64; }
                wave_argmax(v, i);
                if (lane == r) { ms = v; mi = i; }
                if (i == lane) sc0 = -__builtin_inff();
                if (i == lane + 64) sc1 = -__builtin_inff();
            }
            topS[c] = ms; topI[c] = mi;
        }
        float cs[4]; int ci[4];
#pragma unroll
        for (int j = 0; j < 4; ++j) { const int cidx = lane * 4 + j, aa = cidx >> 4, bb = cidx & 15;
            cs[j] = sh_f(topS[0], aa) + sh_f(topS[1], bb); ci[j] = cidx; }
        float fs = 0.f; int fi = 0;
        for (int r = 0; r < 16; ++r) {
            float v = cs[0]; int i = ci[0];
#pragma unroll
            for (int j = 1; j < 4; ++j) if (cs[j] > v) { v = cs[j]; i = ci[j]; }
            wave_argmax(v, i);
            if (lane == r) { fs = v; fi = i; }
#pragma unroll
            for (int j = 0; j < 4; ++j) if (ci[j] == i) cs[j] = -__builtin_inff();
        }
        const int e1 = sh_i(topI[0], fi >> 4), e2 = sh_i(topI[1], fi & 15);
        const float mx = sh_f(fs, 0);
        float ev = lane < 16 ? __expf(fs - mx) : 0.f;
        const float den = wave_sum(ev);
        if (lane < 16) { idx_o[(size_t)t * NE + h * 16 + lane] = e1 * 128 + e2; gw_o[(size_t)t * NE + h * 16 + lane] = ev / den; }
    }
}

__device__ __forceinline__ void fp8x16_to_f32(const u32x4 q, f32x2 (&o)[8]) {
    o[0] = __builtin_amdgcn_cvt_pk_f32_fp8((int)q.x, false); o[1] = __builtin_amdgcn_cvt_pk_f32_fp8((int)q.x, true);
    o[2] = __builtin_amdgcn_cvt_pk_f32_fp8((int)q.y, false); o[3] = __builtin_amdgcn_cvt_pk_f32_fp8((int)q.y, true);
    o[4] = __builtin_amdgcn_cvt_pk_f32_fp8((int)q.z, false); o[5] = __builtin_amdgcn_cvt_pk_f32_fp8((int)q.z, true);
    o[6] = __builtin_amdgcn_cvt_pk_f32_fp8((int)q.w, false); o[7] = __builtin_amdgcn_cvt_pk_f32_fp8((int)q.w, true);
}
#define HALVE(dst, srcv, n, bitmask) do { const bool up_ = (lane & (bitmask)) != 0; _Pragma("unroll") for (int i_ = 0; i_ < (n); ++i_) { \
        const float keep_ = up_ ? srcv[(n) + i_] : srcv[i_], send_ = up_ ? srcv[i_] : srcv[(n) + i_]; dst[i_] = keep_ + sx_f(send_, (bitmask)); } } while (0)
#define ITEM_T(n) (wv + ((n) % KT) * NWX)
#define ITEM_S(n) (xl + 8 * ((n) / KT))
#define LD_IDX(ID, n) do { const int4* ip_ = (const int4*)(idx_i + (size_t)ITEM_T(n) * NE + g * 16); _Pragma("unroll") for (int i_ = 0; i_ < 4; ++i_) ID[i_] = ip_[i_]; } while (0)
#define LD_ROWS(Q, ID, TAB, n) do { const unsigned char* b_ = (TAB) + (size_t)ITEM_S(n) * ((size_t)NEXP * 128) + c * 16; _Pragma("unroll") for (int i_ = 0; i_ < 4; ++i_) { \
        Q[4 * i_] = *(const u32x4*)(b_ + (size_t)ID[i_].x * 128); Q[4 * i_ + 1] = *(const u32x4*)(b_ + (size_t)ID[i_].y * 128); \
        Q[4 * i_ + 2] = *(const u32x4*)(b_ + (size_t)ID[i_].z * 128); Q[4 * i_ + 3] = *(const u32x4*)(b_ + (size_t)ID[i_].w * 128); } } while (0)
__device__ __forceinline__ int dpp_hmirror(int v) { return __builtin_amdgcn_update_dpp(0, v, 0x141, 0xf, 0xf, true); }
__device__ __forceinline__ int dpp_qxor2(int v) { return __builtin_amdgcn_update_dpp(0, v, 0x4E, 0xf, 0xf, true); }
__device__ __forceinline__ int dpp_qxor1(int v) { return __builtin_amdgcn_update_dpp(0, v, 0xB1, 0xf, 0xf, true); }
__device__ __forceinline__ void phase_peer_u(const Args& a) {
    const int tid = tid_opaque(), lane = tid & 63, wave = tid >> 6, g = lane >> 3, c = lane & 7;
    const int xl = blockIdx.x & 7, wv = (blockIdx.x >> 3) * NWAVES + wave, NWX = (gridDim.x >> 3) * NWAVES, KT = T / NWX, N = 2 * KT;
    const unsigned char* xq = a.ws + WS_XQ; const unsigned char* u8 = a.ws + WS_U8;
    const int* idx_i = (const int*)(a.ws + WS_IDX); float* part = (float*)(a.ws + WS_PART);
    const bool up4 = (c & 4) != 0, up2 = (c & 2) != 0, up1 = (c & 1) != 0;
#define LD_X(X, n) do { X = *(const u32x4*)(xq + (size_t)ITEM_T(n) * DM + ITEM_S(n) * 128 + c * 16); } while (0)
#define COMPUTE_U(Q, X, n) do { int p[16]; \
        _Pragma("unroll") for (int i = 0; i < 16; ++i) { int d_ = __builtin_amdgcn_sdot4((int)Q[i].x, (int)X.x, 0, false); d_ = __builtin_amdgcn_sdot4((int)Q[i].y, (int)X.y, d_, false); \
            d_ = __builtin_amdgcn_sdot4((int)Q[i].z, (int)X.z, d_, false); p[i] = __builtin_amdgcn_sdot4((int)Q[i].w, (int)X.w, d_, false); } \
        int p8[8], p4[4], p2[2]; \
        _Pragma("unroll") for (int i = 0; i < 8; ++i) { const int keep_ = up4 ? p[8 + i] : p[i], send_ = up4 ? p[i] : p[8 + i]; p8[i] = keep_ + dpp_hmirror(send_); } \
        _Pragma("unroll") for (int i = 0; i < 4; ++i) { const int keep_ = up2 ? p8[4 + i] : p8[i], send_ = up2 ? p8[i] : p8[4 + i]; p4[i] = keep_ + dpp_qxor2(send_); } \
        _Pragma("unroll") for (int i = 0; i < 2; ++i) { const int keep_ = up1 ? p4[2 + i] : p4[i], send_ = up1 ? p4[i] : p4[2 + i]; p2[i] = keep_ + dpp_qxor1(send_); } \
        *(f32x2*)(part + ((size_t)ITEM_T(n) * 16 + ITEM_S(n)) * NE + 2 * lane) = (f32x2){(float)p2[0], (float)p2[1]}; } while (0)
    int4 IA[4], IB[4]; u32x4 QA[16], QB[16], XA, XB;
    LD_IDX(IA, 0); LD_IDX(IB, 1);
    LD_ROWS(QA, IA, u8, 0); LD_X(XA, 0);
    for (int n = 0; n < N; n += 2) {
        LD_ROWS(QB, IB, u8, n + 1); LD_X(XB, n + 1);
        if (n + 2 < N) LD_IDX(IA, n + 2);
        COMPUTE_U(QA, XA, n);
        if (n + 2 < N) { LD_ROWS(QA, IA, u8, n + 2); LD_X(XA, n + 2); }
        if (n + 3 < N) LD_IDX(IB, n + 3);
        COMPUTE_U(QB, XB, n + 1);
    }
#undef LD_X
#undef COMPUTE_U
}
__device__ __forceinline__ void phase_peer_w(const Args& a) {
    const int gt = blockIdx.x * NTHREADS + tid_opaque(), NGT = gridDim.x * NTHREADS;
    const int* idx_i = (const int*)(a.ws + WS_IDX); const float* gw_i = (const float*)(a.ws + WS_GW); const float* part = (const float*)(a.ws + WS_PART);
    const float* suv = (const float*)(a.ws + WS_SUV); const float* sx = (const float*)(a.ws + WS_SX);
    signed char* wq = (signed char*)(a.ws + WS_WQ); float* sw = (float*)(a.ws + WS_SW);
    for (int item = gt; item < T * NE; item += NGT) {
        const int t = item >> 7, e = item & 127;
        float sum = 0.f;
#pragma unroll
        for (int s = 0; s < 16; ++s) sum += part[((size_t)t * 16 + s) * NE + e];
        const int ex = idx_i[item];
        const float d = sum * suv[ex] * sx[t];
        const float om = 0.5f * d * (1.f + erff(d * 0.70710678118654752f)) * gw_i[item] * suv[NEXP + ex];
        float mx = fabsf(om);
        mx = fmaxf(mx, sx_f(mx, 1)); mx = fmaxf(mx, sx_f(mx, 2)); mx = fmaxf(mx, sx_f(mx, 4)); mx = fmaxf(mx, sx_f(mx, 8));
        const float qs = mx > 0.f ? 127.f / mx : 1.f;
        wq[item] = (signed char)(int)__builtin_rintf(om * qs);
        if ((e & 15) == 0) sw[t * 8 + (e >> 4)] = mx * (1.f / 127.f);
    }
}
__device__ __forceinline__ void phase_peer_v(const Args& a, float* dst) {
    const int tid = tid_opaque(), lane = tid & 63, wave = tid >> 6, g = lane >> 3, c = lane & 7;
    const int xl = blockIdx.x & 7, wv = (blockIdx.x >> 3) * NWAVES + wave, NWX = (gridDim.x >> 3) * NWAVES, KT = T / NWX, N = 2 * KT;
    const unsigned char* v8 = a.ws + WS_V8;
    const int* idx_i = (const int*)(a.ws + WS_IDX); const unsigned char* wq = a.ws + WS_WQ; const float* sw = (const float*)(a.ws + WS_SW);
    const float* hsrc = a.out;
#define LD_W(W, SWV, n) do { W = *(const u32x4*)(wq + (size_t)ITEM_T(n) * NE + g * 16); SWV = sw[ITEM_T(n) * 8 + g]; } while (0)
#define QUAD(A_, B_, C_, D_, W_, A0, A1, A2, A3) do { \
        const unsigned ablo_ = __builtin_amdgcn_perm(B_, A_, 0x05010400u), abhi_ = __builtin_amdgcn_perm(B_, A_, 0x07030602u); \
        const unsigned cdlo_ = __builtin_amdgcn_perm(D_, C_, 0x05010400u), cdhi_ = __builtin_amdgcn_perm(D_, C_, 0x07030602u); \
        A0 = __builtin_amdgcn_sdot4((int)__builtin_amdgcn_perm(cdlo_, ablo_, 0x05040100u), (int)(W_), A0, false); \
        A1 = __builtin_amdgcn_sdot4((int)__builtin_amdgcn_perm(cdlo_, ablo_, 0x07060302u), (int)(W_), A1, false); \
        A2 = __builtin_amdgcn_sdot4((int)__builtin_amdgcn_perm(cdhi_, abhi_, 0x05040100u), (int)(W_), A2, false); \
        A3 = __builtin_amdgcn_sdot4((int)__builtin_amdgcn_perm(cdhi_, abhi_, 0x07060302u), (int)(W_), A3, false); } while (0)
#define COMPUTE_V(Q, W, SWV, n) do { int ac[16]; _Pragma("unroll") for (int k = 0; k < 16; ++k) ac[k] = 0; \
        _Pragma("unroll") for (int q_ = 0; q_ < 4; ++q_) { const unsigned w_ = q_ == 0 ? W.x : q_ == 1 ? W.y : q_ == 2 ? W.z : W.w; \
            QUAD(Q[4 * q_].x, Q[4 * q_ + 1].x, Q[4 * q_ + 2].x, Q[4 * q_ + 3].x, w_, ac[0], ac[1], ac[2], ac[3]); \
            QUAD(Q[4 * q_].y, Q[4 * q_ + 1].y, Q[4 * q_ + 2].y, Q[4 * q_ + 3].y, w_, ac[4], ac[5], ac[6], ac[7]); \
            QUAD(Q[4 * q_].z, Q[4 * q_ + 1].z, Q[4 * q_ + 2].z, Q[4 * q_ + 3].z, w_, ac[8], ac[9], ac[10], ac[11]); \
            QUAD(Q[4 * q_].w, Q[4 * q_ + 1].w, Q[4 * q_ + 2].w, Q[4 * q_ + 3].w, w_, ac[12], ac[13], ac[14], ac[15]); } \
        float p[16]; _Pragma("unroll") for (int k = 0; k < 16; ++k) p[k] = (float)ac[k] * SWV; \
        float p8[8], p4[4], p2[2]; \
        _Pragma("unroll") for (int i_ = 0; i_ < 8; ++i_) { auto rr_ = __builtin_amdgcn_permlane32_swap(__float_as_uint(p[i_]), __float_as_uint(p[8 + i_]), false, false); p8[i_] = __uint_as_float(rr_[0]) + __uint_as_float(rr_[1]); } \
        _Pragma("unroll") for (int i_ = 0; i_ < 4; ++i_) { auto rr_ = __builtin_amdgcn_permlane16_swap(__float_as_uint(p8[i_]), __float_as_uint(p8[4 + i_]), false, false); p4[i_] = __uint_as_float(rr_[0]) + __uint_as_float(rr_[1]); } \
        HALVE(p2, p4, 2, 8); \
        const size_t o_ = (size_t)ITEM_T(n) * DM + ITEM_S(n) * 128 + c * 16 + 2 * g; \
        const f32x2 hv = *(const f32x2*)(hsrc + o_); *(f32x2*)(dst + o_) = (f32x2){hv.x + p2[0], hv.y + p2[1]}; } while (0)
    int4 IA[4], IB[4]; u32x4 QA[16], QB[16], WA, WB; float SA, SB_;
    LD_IDX(IA, 0); LD_IDX(IB, 1);
    LD_ROWS(QA, IA, v8, 0); LD_W(WA, SA, 0);
    for (int n = 0; n < N; n += 2) {
        LD_ROWS(QB, IB, v8, n + 1); LD_W(WB, SB_, n + 1);
        if (n + 2 < N) LD_IDX(IA, n + 2);
        COMPUTE_V(QA, WA, SA, n);
        if (n + 2 < N) { LD_ROWS(QA, IA, v8, n + 2); LD_W(WA, SA, n + 2); }
        if (n + 3 < N) LD_IDX(IB, n + 3);
        COMPUTE_V(QB, WB, SB_, n + 1);
    }
#undef LD_W
#undef QUAD
#undef COMPUTE_V
}
#undef ITEM_T
#undef ITEM_S
#undef LD_IDX
#undef LD_ROWS
#undef HALVE


constexpr int NPHASE = 11;
#define LOAD_ARGS() do { } while (0)
__global__ void __launch_bounds__(NTHREADS, 2) fwd_kernel(Args a) {
    extern __shared__ __attribute__((aligned(16))) unsigned char lds[];
#if MK_ONE_LAUNCH
    constexpr int lo = 0, hi = NPHASE;
    cg::grid_group grid = cg::this_grid();
    volatile LAS unsigned* misc = (volatile LAS unsigned*)((LAS unsigned char*)lds + MISC_OFF);
    if (threadIdx.x < 16) misc[threadIdx.x] = 0u;
    __syncthreads();
    { LOAD_ARGS(); (void)xcd_barrier_post((unsigned*)(a.ws + WS_CTL) + CW_BAR, misc + 8); }
#ifndef SEAM_CG_MASK
#define SEAM_CG_MASK 0
#endif
#define SEAM(k) do { if (lo <= (k) && (k) + 1 < hi) { if ((SEAM_CG_MASK >> (k)) & 1) grid.sync(); else { LOAD_ARGS(); XcdBarrier xb_; xb_.bar = (unsigned*)(a.ws + WS_CTL) + CW_BAR; xb_.x = xb_xcc_id(); \
        xb_.st = (volatile LAS unsigned*)((LAS unsigned char*)lds + MISC_OFF) + 8; xcd_barrier(xb_); } } } while (0)
#else
    int lo, hi; { LOAD_ARGS(); lo = a.ph_lo; hi = a.ph_hi; }
#define SEAM(k) do { } while (0)
#endif
#define IN(k) (lo <= (k) && (k) < hi)
#ifndef DUP_PHASE
#define DUP_PHASE -1
#endif
    if (IN(0)) { LOAD_ARGS(); phase0(a, lds); if (DUP_PHASE == 0) { __syncthreads(); phase0(a, lds); } SEAM(0); }
    if (IN(1)) { LOAD_ARGS(); unsigned char* ws = a.ws;
        cumsum_rows(a);
        pg8::Gemm g{(const bf16_t*)(ws + WS_XN), (const bf16_t*)(ws + WS_WIN), T, NPROJ, DM}; pg8::StaticOrder S; S.init(T, NPROJ, (int)gridDim.x, (int)blockIdx.x);
        pg8::EpiInProj E{(bf16_t*)(ws + WS_SEC), (const float*)(ws + WS_SXN), (const float*)(ws + WS_WSC)};
        for (int rep_ = 0; rep_ < (DUP_PHASE == 1 ? 2 : 1); ++rep_)
        pg8::gemm_phase<pg8::EpiInProj, pg8::StaticOrder, true, true, true>((LAS unsigned char*)lds, g, S, E);
        { const int nwg_ = (T / 256) * (NPROJ / 256), G_ = (int)gridDim.x, rem_ = nwg_ % G_;
          if (rem_ > 0 && (int)blockIdx.x >= rem_) convert_tables(a, TAB_SPLIT, 2 * NEXP, ((int)blockIdx.x - rem_) * NWAVES + (tid_opaque() >> 6), (G_ - rem_) * NWAVES);
          else if (rem_ == 0) convert_tables(a, TAB_SPLIT, 2 * NEXP, (int)blockIdx.x * NWAVES + (tid_opaque() >> 6), G_ * NWAVES); }
        SEAM(1);
    }
    if (IN(2)) { LOAD_ARGS(); phase_qknorm(a); SEAM(2); }
    if (IN(3)) { LOAD_ARGS(); phase_attn(a, lds);
#if MK_ONE_LAUNCH
        if (DUP_PHASE == 3) { XcdBarrier xb_; xb_.bar = (unsigned*)(a.ws + WS_CTL) + CW_BAR; xb_.x = xb_xcc_id(); xb_.st = (volatile LAS unsigned*)((LAS unsigned char*)lds + MISC_OFF) + 8;
            xcd_barrier(xb_); if (blockIdx.x == 0 && threadIdx.x == 0) __hip_atomic_store((unsigned*)(a.ws + WS_CTL), 0u, __ATOMIC_RELAXED, __HIP_MEMORY_SCOPE_AGENT); xcd_barrier(xb_); phase_attn(a, lds); }
#endif
        SEAM(3); }
    if (IN(4)) { LOAD_ARGS(); phase_attn_combine(a); SEAM(4); }
    if (IN(5)) { LOAD_ARGS(); unsigned char* ws = a.ws;
        pg8::Gemm g{(const bf16_t*)(ws + WS_MIX), (const bf16_t*)(ws + WS_WOUT), T, DM, DM}; pg8::StaticOrder S; S.init(T, DM, (int)gridDim.x, (int)blockIdx.x);
        pg8::EpiOutProj E{a.in[0], a.out, (bf16_t*)(ws + WS_HB), (float*)(ws + WS_SSQ), (float*)(ws + WS_AMX)};
        for (int rep_ = 0; rep_ < (DUP_PHASE == 5 ? 2 : 1); ++rep_)
        pg8::gemm_phase<pg8::EpiOutProj, pg8::StaticOrder, true, true>((LAS unsigned char*)lds, g, S, E);
        SEAM(5);
    }
    if (IN(6)) { LOAD_ARGS(); unsigned char* ws = a.ws;
        pg8::Gemm g{(const bf16_t*)(ws + WS_HB), (const bf16_t*)(ws + WS_WPQ), T, DM, DM}; pg8::StaticOrder S; S.init(T, DM, (int)gridDim.x, (int)blockIdx.x);
        pg8::EpiPeerQ E{(const float*)(ws + WS_SSQ), (bf16_t*)(ws + WS_QP), (float*)(ws + WS_RT)};
        for (int rep_ = 0; rep_ < (DUP_PHASE == 6 ? 2 : 1); ++rep_)
        pg8::gemm_phase<pg8::EpiPeerQ, pg8::StaticOrder, true, true>((LAS unsigned char*)lds, g, S, E);
        SEAM(6);
    }
    #ifdef TOPK_REF
    if (IN(7)) { LOAD_ARGS(); phase_topk_ref(a); SEAM(7); }
#else
    if (IN(7)) { LOAD_ARGS(); for (int rep_ = 0; rep_ < (DUP_PHASE == 7 ? 2 : 1); ++rep_) phase_topk(a, lds); SEAM(7); }
#endif
    if (IN(8)) { LOAD_ARGS(); for (int rep_ = 0; rep_ < (DUP_PHASE == 8 ? 2 : 1); ++rep_) phase_peer_u(a); SEAM(8); }
    if (IN(9)) { LOAD_ARGS(); for (int rep_ = 0; rep_ < (DUP_PHASE == 9 ? 2 : 1); ++rep_) phase_peer_w(a); SEAM(9); }
    if (IN(10)) { LOAD_ARGS(); for (int rep_ = 0; rep_ < (DUP_PHASE == 10 ? 2 : 1); ++rep_) phase_peer_v(a, (DUP_PHASE == 10 && rep_ == 0) ? (float*)(a.ws + WS_END) : a.out); }
#undef IN
#undef SEAM
}

extern "C" void kernel_launch(void* const* d_in, const int* in_sizes, int n_in, void* d_out, int out_size, void* d_ws, size_t ws_size, hipStream_t stream) {
    static int grid = 0;
    if (grid == 0) {
        if (n_in != 12 || in_sizes[0] != T * DM || out_size != T * DM || ws_size < WS_END) { fprintf(stderr, "kernel_launch: unexpected shapes (n_in %d, in0 %d, out %d, ws %zu)\n", n_in, n_in > 0 ? in_sizes[0] : -1, out_size, ws_size); grid = -1; return; }
        int dev = 0, cus = 0, per_cu = 0;
        if (hipGetDevice(&dev) != hipSuccess || hipDeviceGetAttribute(&cus, hipDeviceAttributeMultiprocessorCount, dev) != hipSuccess) { grid = -1; return; }
        if (hipFuncSetAttribute((const void*)fwd_kernel, hipFuncAttributeMaxDynamicSharedMemorySize, LDS_BYTES) != hipSuccess) { fprintf(stderr, "kernel_launch: hipFuncSetAttribute failed\n"); grid = -1; return; }
        if (hipOccupancyMaxActiveBlocksPerMultiprocessor(&per_cu, (const void*)fwd_kernel, NTHREADS, LDS_BYTES) != hipSuccess || per_cu < 1) { fprintf(stderr, "kernel_launch: occupancy query says %d\n", per_cu); grid = -1; return; }
        grid = cus;
    }
    if (grid < 0) return;
    (void)hipMemsetAsync((char*)d_ws + WS_CTL, 0, CTL_BYTES, stream);
    Args a{};
    for (int i = 0; i < 12; ++i) a.in[i] = (const float*)d_in[i];
    a.out = (float*)d_out; a.ws = (unsigned char*)d_ws;
#if MK_ONE_LAUNCH
    a.ph_lo = 0; a.ph_hi = NPHASE;
    void* args[] = {&a};
#if MK_COOP_LAUNCH
    hipError_t e = hipLaunchCooperativeKernel((const void*)fwd_kernel, dim3(grid), dim3(NTHREADS), args, LDS_BYTES, stream);
    if (e != hipSuccess) fprintf(stderr, "cooperative launch failed: %s (grid %d)\n", hipGetErrorString(e), grid);
#else
    (void)args; hipLaunchKernelGGL(fwd_kernel, dim3(grid), dim3(NTHREADS), LDS_BYTES, stream, a);
#endif
#else
    for (int p = 0; p < NPHASE; ++p) { a.ph_lo = p; a.ph_hi = p + 1; hipLaunchKernelGGL(fwd_kernel, dim3(grid), dim3(NTHREADS), LDS_BYTES, stream, a); }
#endif
}
```

```cpp
#include <hip/hip_runtime.h>
#include <hip/hip_cooperative_groups.h>
#include <cstdio>
#include <cstdint>
namespace cg = cooperative_groups;

#ifndef MK_COOP_LAUNCH
#define MK_COOP_LAUNCH 0
#endif
#ifndef MK_ONE_LAUNCH
#define MK_ONE_LAUNCH 1
#endif

#define LAS __attribute__((address_space(3)))
typedef unsigned short bf16_t;
typedef short bf16x8 __attribute__((ext_vector_type(8)));
typedef short s16x4 __attribute__((ext_vector_type(4)));
typedef float f32x2 __attribute__((ext_vector_type(2)));
typedef float f32x4 __attribute__((ext_vector_type(4)));
typedef float f32x16 __attribute__((ext_vector_type(16)));
typedef unsigned u32x2 __attribute__((ext_vector_type(2)));
typedef unsigned u32x4 __attribute__((ext_vector_type(4)));
typedef __bf16 bf16x2_t __attribute__((ext_vector_type(2)));

constexpr int NB = 2, SEQ = 4096, T = NB * SEQ, DM = 2048, HD = 128, NHF = 8, DIN = 7176, NPROJ = 7168;
constexpr int NEXP = 16384, NE = 128;
constexpr float EPS = 1e-6f;
constexpr float SCALE = 0.08838834764831845f, LOG2E = 1.4426950408889634f;
constexpr int NWAVES = 8, NTHREADS = 512;

constexpr size_t MiB = 1u << 20;
constexpr size_t WS_CTL = 0, CTL_BYTES = 32768;
constexpr int CW_BAR = 1024;
constexpr size_t WS_SXN = 64 * MiB  , WS_WSC = 45 * MiB + 800 * 1024  ;
constexpr int CW_WMAX = 64;
constexpr size_t WS_GQK = 45 * MiB + 768 * 1024;
constexpr size_t WS_WIN = 1 * MiB, WS_WOUT = 29 * MiB, WS_WPQ = 37 * MiB, WS_SK = 45 * MiB, WS_LOGF = 46 * MiB, WS_C = 46 * MiB + 512 * 1024, WS_SSQ = 47 * MiB;
constexpr size_t WS_XN = 48 * MiB;
constexpr size_t WS_SEC = 80 * MiB;
constexpr size_t SEC_ELEMS = 8u << 20;
constexpr size_t WS_MIX = 192 * MiB, WS_HB = 224 * MiB, WS_QP = 256 * MiB, WS_IDX = 288 * MiB, WS_GW = 292 * MiB, WS_U8 = 296 * MiB, WS_V8 = 328 * MiB, WS_SUV = 360 * MiB  , WS_RT = 360 * MiB + 256 * 1024  , WS_W = 361 * MiB  ,
                 WS_PART = 368 * MiB  , WS_XQ = 432 * MiB  , WS_END = 448 * MiB;
constexpr size_t WS_AMX = 365 * MiB  , WS_SX = WS_RT + 64 * 1024  , WS_WQ = WS_W  , WS_SW = WS_W + 2 * MiB  ;
constexpr size_t WS_PO = WS_PART  , WS_PML = WS_PART + 32 * MiB  ;

constexpr int RING_BYTES = 131072;
constexpr int MISC_OFF = 143360;
constexpr int LDS_BYTES = 147456;

__device__ __forceinline__ unsigned cvt_pk_bf16(float lo, float hi) { unsigned r; asm volatile("v_cvt_pk_bf16_f32 %0, %1, %2" : "=v"(r) : "v"(lo), "v"(hi)); return r; }
__device__ __forceinline__ float bf_lo(unsigned u) { return __builtin_bit_cast(float, u << 16); }
__device__ __forceinline__ float bf_hi(unsigned u) { return __builtin_bit_cast(float, u & 0xffff0000u); }
__device__ __forceinline__ int lane_id_fresh() { int l = (int)__builtin_amdgcn_mbcnt_hi(~0u, __builtin_amdgcn_mbcnt_lo(~0u, 0u)); asm volatile("" : "+v"(l)); return l; }
__device__ __forceinline__ int sx_i(int v, int m) { return __builtin_amdgcn_ds_bpermute((lane_id_fresh() ^ m) << 2, v); }
__device__ __forceinline__ float sx_f(float v, int m) { return __int_as_float(__builtin_amdgcn_ds_bpermute((lane_id_fresh() ^ m) << 2, __float_as_int(v))); }
__device__ __forceinline__ int sh_i(int v, int src) { return __builtin_amdgcn_ds_bpermute(src << 2, v); }
__device__ __forceinline__ float sh_f(float v, int src) { return __int_as_float(__builtin_amdgcn_ds_bpermute(src << 2, __float_as_int(v))); }
__device__ __forceinline__ float shup_f(float v, int d) { const int l = lane_id_fresh(); const int s = l - d; return __int_as_float(__builtin_amdgcn_ds_bpermute((s < 0 ? l : s) << 2, __float_as_int(v))); }
__device__ __forceinline__ float wave_sum(float v) {
#pragma unroll
    for (int o = 1; o < 64; o <<= 1) v += sx_f(v, o);
    return v;
}
__device__ __forceinline__ float wave_max(float v) {
#pragma unroll
    for (int o = 1; o < 64; o <<= 1) v = fmaxf(v, sx_f(v, o));
    return v;
}
__device__ __forceinline__ int tid_opaque() { int t = (int)threadIdx.x; asm volatile("" : "+v"(t)); return t; }
#define LDS_WAIT() asm volatile("s_waitcnt lgkmcnt(0)" ::: "memory")

namespace pg8 {
#define PG8_LAS __attribute__((address_space(3)))
constexpr int BM = 256, BK = 64, HALF = 128, HTB = HALF * BK * 2, STAGE_BYTES = 8 * HTB, NXCD = 8, WGM = 8;
__host__ __device__ __forceinline__ int lds_byte(int r, int c) { const int st = (r >> 4) * 2 + (c >> 5), rr = r & 15, cc = c & 31, ob = rr * 64 + cc * 2; return st * 1024 + (ob ^ (((ob >> 9) & 1) << 5)); }
__host__ __device__ __forceinline__ void stage_rc(int b, int& R, int& C) { const int st = b / 1024, sb = b % 1024, swz = sb ^ (((sb >> 9) & 1) << 5); R = (st >> 1) * 16 + swz / 64; C = (st & 1) * 32 + (swz % 64) / 2; }
__host__ __device__ __forceinline__ int perm32(int rho) { const int n = rho >> 4, i = rho & 15; return 8 * (i >> 2) + 4 * n + (i & 3); }
struct Unit { int pm, pn; };
struct Gemm { const bf16_t* A; const bf16_t* Bt; int M, N, K; };
struct StaticOrder {
    int nM, nN, nwg, G, c;
    __host__ __device__ void init(int M, int N, int G_, int c_) { nM = M / BM; nN = N / BM; nwg = nM * nN; G = G_; c = c_; }
    __host__ __device__ bool next(int i, Unit& u) const {
        const long L = (long)i * G + c; if (L >= nwg) return false;
        int wgid = (int)L; { const int q = nwg / NXCD, r = nwg % NXCD, xcd = wgid % NXCD, off = wgid / NXCD; wgid = (xcd < r ? xcd * (q + 1) : r * (q + 1) + (xcd - r) * q) + off; }
        const int nig = WGM * nN, gid = wgid / nig, fm = gid * WGM, gsz = (nM - fm) < WGM ? (nM - fm) : WGM;
        u.pm = fm + ((wgid % nig) % gsz); u.pn = (wgid % nig) / gsz; return true;
    }
    __device__ __forceinline__ void a_ready(const Unit&) const {}
    __device__ __forceinline__ void done(const Unit&) const {}
};

typedef int i32x4 __attribute__((ext_vector_type(4)));
template <bool I8> struct AccT { typedef f32x4 type; };
template <> struct AccT<true> { typedef i32x4 type; };
template <class Epi, class Sched, bool ALIGN_EPI = false, bool SP2 = false, bool I8 = false>
__device__ __forceinline__ void gemm_phase(PG8_LAS unsigned char* lds, const Gemm g, const Sched& S, const Epi& E) {
    typedef typename AccT<I8>::type acc_t;
    const int tid = tid_opaque(), wid = __builtin_amdgcn_readfirstlane(tid >> 6), lane = tid & 63, wr = wid >> 2, wc = wid & 3, fr = lane & 15, fq = lane >> 4;
    const int rowb = I8 ? g.K : 2 * g.K, nt = rowb / (BK * 2);
    unsigned voffA[2], voffB[2];
#pragma unroll
    for (int i = 0; i < 2; ++i) { int R, C; stage_rc(tid * 16 + i * 8192, R, C); const int Rb = Epi::PERM ? ((R & ~31) + perm32(R & 31)) : R;
        voffA[i] = (unsigned)(R * rowb + C * 2); voffB[i] = (unsigned)(Rb * rowb + C * 2); }
    const size_t kstep = (size_t)(BK * 2);
    const size_t hstep = (size_t)HALF * rowb;
    const size_t tstep = 2 * hstep;
    const unsigned ldsw = (unsigned)wid * 1024u;
    const int aoff = lds_byte(wr * 64 + fr, fq * 8), boff = lds_byte(wc * 32 + fr, fq * 8);
#define PG8_SA(b, h) (((b) * 2 + (h)) * HTB)
#define PG8_SB(b, h) ((4 + (b) * 2 + (h)) * HTB)
#define PG8_STAGE(bufoff, gbase, voff) do { _Pragma("unroll") for (int _i = 0; _i < 2; ++_i) \
        __builtin_amdgcn_global_load_lds((const unsigned*)((const char*)(gbase) + (voff)[_i]), (PG8_LAS unsigned*)(lds + (bufoff) + ldsw + _i * 8192), 16, 0, 0); } while (0)
#define PG8_LDA(dst, b, h) do { _Pragma("unroll") for (int m = 0; m < 4; ++m) _Pragma("unroll") for (int k = 0; k < 2; ++k) dst[m][k] = *(const PG8_LAS bf16x8*)(lds + PG8_SA(b, h) + aoff + m * 2048 + k * 1024); } while (0)
#define PG8_LDB(dst, b, h) do { _Pragma("unroll") for (int n = 0; n < 2; ++n) _Pragma("unroll") for (int k = 0; k < 2; ++k) dst[n][k] = *(const PG8_LAS bf16x8*)(lds + PG8_SB(b, h) + boff + n * 2048 + k * 1024); } while (0)
#define PG8_MMA(ai, bj, At, Bt) do { __builtin_amdgcn_s_setprio(1); _Pragma("unroll") for (int m = 0; m < 4; ++m) _Pragma("unroll") for (int n = 0; n < 2; ++n) _Pragma("unroll") for (int k = 0; k < 2; ++k) \
        { if constexpr (I8) acc[ai][bj][m][n] = __builtin_amdgcn_mfma_i32_16x16x64_i8(__builtin_bit_cast(i32x4, Bt[n][k]), __builtin_bit_cast(i32x4, At[m][k]), acc[ai][bj][m][n], 0, 0, 0); \
          else acc[ai][bj][m][n] = __builtin_amdgcn_mfma_f32_16x16x32_bf16(Bt[n][k], At[m][k], acc[ai][bj][m][n], 0, 0, 0); } __builtin_amdgcn_s_setprio(0); } while (0)
#define PG8_WAIT_V(n) asm volatile("s_waitcnt vmcnt(" #n ")" ::: "memory")
#define PG8_WAIT_L(n) asm volatile("s_waitcnt lgkmcnt(" #n ")" ::: "memory")
#define PG8_BAR __builtin_amdgcn_s_barrier()
#define PG8_SCHED __builtin_amdgcn_sched_barrier(0)
    Unit cur, nxt; int ui = 0;
    if (!S.next(0, cur)) return;
    acc_t acc[2][2][4][2];
#pragma unroll
    for (int a = 0; a < 2; ++a)
#pragma unroll
        for (int b = 0; b < 2; ++b)
#pragma unroll
            for (int m = 0; m < 4; ++m)
#pragma unroll
                for (int n = 0; n < 2; ++n) acc[a][b][m][n] = acc_t{};
    bf16x8 At[4][2], B0[2][2], B1[2][2];
    const char* cA = (const char*)g.A + (size_t)cur.pm * tstep; const char* cB = (const char*)g.Bt + (size_t)cur.pn * tstep;
    S.a_ready(cur);
    if constexpr (SP2) {
        PG8_STAGE(PG8_SB(0, 0), cB, voffB); PG8_STAGE(PG8_SB(0, 1), cB + hstep, voffB); PG8_STAGE(PG8_SA(0, 0), cA, voffA); PG8_STAGE(PG8_SA(0, 1), cA + hstep, voffA);
        if (wr == 1) PG8_BAR;
        PG8_WAIT_V(2); PG8_BAR;
        PG8_STAGE(PG8_SB(1, 0), cB + kstep, voffB); PG8_STAGE(PG8_SA(1, 0), cA + kstep, voffA); PG8_STAGE(PG8_SB(1, 1), cB + hstep + kstep, voffB);
        PG8_WAIT_V(6); PG8_BAR;
    } else {
        PG8_STAGE(PG8_SB(0, 0), cB, voffB); PG8_STAGE(PG8_SA(0, 0), cA, voffA); PG8_STAGE(PG8_SB(0, 1), cB + hstep, voffB); PG8_STAGE(PG8_SA(0, 1), cA + hstep, voffA);
        if (wr == 1) PG8_BAR;
        PG8_WAIT_V(4); PG8_BAR;
        PG8_STAGE(PG8_SB(1, 0), cB + kstep, voffB); PG8_STAGE(PG8_SA(1, 0), cA + kstep, voffA); PG8_STAGE(PG8_SB(1, 1), cB + hstep + kstep, voffB);
        PG8_WAIT_V(6); PG8_BAR;
    }
    for (;;) {
        const bool has_next = S.next(ui + 1, nxt);
        const char* nA = has_next ? (const char*)g.A + (size_t)nxt.pm * tstep : cA; const char* nB = has_next ? (const char*)g.Bt + (size_t)nxt.pn * tstep : cB;
        for (int t = 0; t < nt; t += 2) {
            const bool last = (t == nt - 2);
            const char* a1 = cA + (size_t)(t + 1) * kstep;
            const char* a2 = last ? nA : cA + (size_t)(t + 2) * kstep; const char* b2 = last ? nB : cB + (size_t)(t + 2) * kstep;
            const char* a3 = a2 + kstep; const char* b3 = b2 + kstep;
            if (last && has_next) S.a_ready(nxt);
            if constexpr (SP2) {
            PG8_LDB(B0, 0, 0); PG8_LDB(B1, 0, 1); PG8_SCHED; PG8_LDA(At, 0, 0); PG8_STAGE(PG8_SA(1, 1), a1 + hstep, voffA);
            PG8_WAIT_V(8); PG8_WAIT_L(0); PG8_BAR; PG8_MMA(0, 0, At, B0); PG8_MMA(0, 1, At, B1); PG8_BAR; PG8_SCHED;
            PG8_LDA(At, 0, 1); PG8_STAGE(PG8_SB(0, 0), b2, voffB); PG8_STAGE(PG8_SB(0, 1), b2 + hstep, voffB); PG8_STAGE(PG8_SA(0, 0), a2, voffA);
            PG8_WAIT_V(8); PG8_WAIT_L(0); PG8_BAR; PG8_MMA(1, 0, At, B0); PG8_MMA(1, 1, At, B1); PG8_BAR; PG8_SCHED;
            PG8_LDB(B0, 1, 0); PG8_LDB(B1, 1, 1); PG8_SCHED; PG8_LDA(At, 1, 0); PG8_STAGE(PG8_SA(0, 1), a2 + hstep, voffA);
            PG8_WAIT_V(8); PG8_WAIT_L(0); PG8_BAR; PG8_MMA(0, 0, At, B0); PG8_MMA(0, 1, At, B1); PG8_BAR; PG8_SCHED;
            PG8_LDA(At, 1, 1); PG8_STAGE(PG8_SB(1, 0), b3, voffB); PG8_STAGE(PG8_SB(1, 1), b3 + hstep, voffB); PG8_STAGE(PG8_SA(1, 0), a3, voffA);
            PG8_WAIT_V(8); PG8_WAIT_L(0); PG8_BAR; PG8_MMA(1, 0, At, B0); PG8_MMA(1, 1, At, B1); PG8_BAR; PG8_SCHED;
            } else {
            PG8_LDB(B0, 0, 0); PG8_SCHED; PG8_LDA(At, 0, 0); PG8_STAGE(PG8_SA(1, 1), a1 + hstep, voffA);
            PG8_WAIT_L(8); PG8_BAR; PG8_WAIT_L(0); PG8_MMA(0, 0, At, B0); PG8_BAR; PG8_SCHED;
            PG8_LDB(B1, 0, 1); PG8_STAGE(PG8_SB(0, 0), b2, voffB);
            PG8_BAR; PG8_WAIT_L(0); PG8_MMA(0, 1, At, B1); PG8_BAR;
            PG8_LDA(At, 0, 1); PG8_STAGE(PG8_SA(0, 0), a2, voffA);
            PG8_BAR; PG8_WAIT_L(0); PG8_MMA(1, 0, At, B0); PG8_BAR; PG8_SCHED;
            PG8_STAGE(PG8_SB(0, 1), b2 + hstep, voffB);
            PG8_WAIT_V(6); PG8_BAR; PG8_MMA(1, 1, At, B1); PG8_BAR;
            PG8_LDB(B0, 1, 0); PG8_SCHED; PG8_LDA(At, 1, 0); PG8_STAGE(PG8_SA(0, 1), a2 + hstep, voffA);
            PG8_WAIT_L(8); PG8_BAR; PG8_WAIT_L(0); PG8_MMA(0, 0, At, B0); PG8_BAR; PG8_SCHED;
            PG8_LDB(B1, 1, 1); PG8_STAGE(PG8_SB(1, 0), b3, voffB);
            PG8_BAR; PG8_WAIT_L(0); PG8_MMA(0, 1, At, B1); PG8_BAR;
            PG8_LDA(At, 1, 1); PG8_STAGE(PG8_SA(1, 0), a3, voffA);
            PG8_BAR; PG8_WAIT_L(0); PG8_MMA(1, 0, At, B0); PG8_BAR; PG8_SCHED;
            PG8_STAGE(PG8_SB(1, 1), b3 + hstep, voffB);
            PG8_WAIT_V(6); PG8_BAR; PG8_MMA(1, 1, At, B1); PG8_BAR;
            }
        }
        if constexpr (ALIGN_EPI) { if (wr == 0) PG8_BAR; }
        E(acc, cur, wr, wc, fr, fq); S.done(cur);
        if (!has_next) break;
#pragma unroll
        for (int a = 0; a < 2; ++a)
#pragma unroll
            for (int b = 0; b < 2; ++b)
#pragma unroll
                for (int m = 0; m < 4; ++m)
#pragma unroll
                    for (int n = 0; n < 2; ++n) acc[a][b][m][n] = acc_t{};
        cur = nxt; cA = nA; cB = nB; ++ui;
        if constexpr (ALIGN_EPI) { if (wr == 1) PG8_BAR; }
    }
    PG8_WAIT_V(0);
    if constexpr (!ALIGN_EPI) { if (wr == 0) PG8_BAR; }
    PG8_BAR;
#undef PG8_SA
#undef PG8_SB
#undef PG8_STAGE
#undef PG8_LDA
#undef PG8_LDB
#undef PG8_MMA
#undef PG8_WAIT_V
#undef PG8_WAIT_L
#undef PG8_BAR
#undef PG8_SCHED
}

__device__ __forceinline__ float sigmoidf_fast(float x) { return __builtin_amdgcn_rcpf(1.f + __builtin_amdgcn_exp2f(-x * LOG2E)); }
struct EpiInProj {
    static constexpr bool PERM = true;
    bf16_t* base; const float* sxn  ; const float* wsc  ;
    const float* gq; const float* gk; PG8_LAS float* xch  ;
    __device__ __forceinline__ void operator()(const i32x4 (&acci)[2][2][4][2], const Unit& u, int wr, int wc, int fr, int fq) const {
        const int sec = u.pn >> 2; const float wsv = *wsc;
        bf16_t* sb = base + (size_t)sec * SEC_ELEMS;
        const float sc = (sec == 4) ? SCALE * LOG2E : 1.f;
        if (sec < 2) {
#pragma unroll
            for (int ai = 0; ai < 2; ++ai)
#pragma unroll
                for (int m = 0; m < 4; ++m) {
                    const int tk = u.pm * BM + ai * HALF + wr * 64 + m * 16 + fr;
                    const float rs = sxn[tk] * wsv;
#pragma unroll
                    for (int bj = 0; bj < 2; ++bj) {
                        const f32x4 v0 = __builtin_convertvector(acci[ai][bj][m][0], f32x4) * rs, v1 = __builtin_convertvector(acci[ai][bj][m][1], f32x4) * rs;
                        float ss = v0[0] * v0[0] + v0[1] * v0[1] + v0[2] * v0[2] + v0[3] * v0[3] + v1[0] * v1[0] + v1[1] * v1[1] + v1[2] * v1[2] + v1[3] * v1[3];
                        ss += sx_f(ss, 16); ss += sx_f(ss, 32);
                        if (fq == 0) xch[(((((wr * 2 + ai) * 4 + m) * 16 + fr) * 2 + bj) * 4) + wc] = ss;
                    }
                }
            asm volatile("s_waitcnt lgkmcnt(0)" ::: "memory");
            __builtin_amdgcn_s_barrier();
            const float* gp = (sec == 0 ? gq : gk) + wc * 32 + 8 * fq;
            const f32x4 g0 = *(const f32x4*)gp, g1 = *(const f32x4*)(gp + 4);
#pragma unroll
            for (int ai = 0; ai < 2; ++ai)
#pragma unroll
                for (int m = 0; m < 4; ++m) {
                    const int tk = u.pm * BM + ai * HALF + wr * 64 + m * 16 + fr, b = tk >> 12, s = tk & 4095;
                    const float rs = sxn[tk] * wsv;
#pragma unroll
                    for (int bj = 0; bj < 2; ++bj) {
                        const int hh = (u.pn & 3) * 2 + bj;
                        const f32x4 p4 = *(const PG8_LAS f32x4*)(xch + (((((wr * 2 + ai) * 4 + m) * 16 + fr) * 2 + bj) * 4));
                        const float r = rs / sqrtf(((p4[0] + p4[1]) + (p4[2] + p4[3])) * (1.f / 128.f) + EPS);
                        const f32x4 v0 = __builtin_convertvector(acci[ai][bj][m][0], f32x4) * r * g0, v1 = __builtin_convertvector(acci[ai][bj][m][1], f32x4) * r * g1;
                        u32x4 w; w.x = cvt_pk_bf16(v0[0], v0[1]); w.y = cvt_pk_bf16(v0[2], v0[3]); w.z = cvt_pk_bf16(v1[0], v1[1]); w.w = cvt_pk_bf16(v1[2], v1[3]);
                        *(u32x4*)(sb + ((size_t)((b * 8 + hh) * 4096 + s)) * 128 + wc * 32 + 8 * fq) = w;
                    }
                }
            return;
        }
#pragma unroll
        for (int ai = 0; ai < 2; ++ai)
#pragma unroll
            for (int m = 0; m < 4; ++m) {
                const int tk = u.pm * BM + ai * HALF + wr * 64 + m * 16 + fr, b = tk >> 12, s = tk & 4095;
                const float rs = sxn[tk] * wsv;
#pragma unroll
                for (int bj = 0; bj < 2; ++bj) {
                    const int hh = (u.pn & 3) * 2 + bj;
                    f32x4 v0 = __builtin_convertvector(acci[ai][bj][m][0], f32x4) * rs, v1 = __builtin_convertvector(acci[ai][bj][m][1], f32x4) * rs;
                    bf16_t* dst;
                    if (sec == 3) {
#pragma unroll
                        for (int i = 0; i < 4; ++i) { v0[i] = sigmoidf_fast(v0[i]); v1[i] = sigmoidf_fast(v1[i]); }
                        dst = sb + (size_t)tk * 1024 + hh * 128 + wc * 32 + 8 * fq;
                    } else {
                        v0 = v0 * sc; v1 = v1 * sc;
                        dst = sb + ((size_t)((b * 8 + hh) * 4096 + s)) * 128 + wc * 32 + 8 * fq;
                    }
                    u32x4 w; w.x = cvt_pk_bf16(v0[0], v0[1]); w.y = cvt_pk_bf16(v0[2], v0[3]); w.z = cvt_pk_bf16(v1[0], v1[1]); w.w = cvt_pk_bf16(v1[2], v1[3]);
                    *(u32x4*)dst = w;
                }
            }
    }
};
struct EpiOutProj {
    static constexpr bool PERM = true;
    const float* x; float* h; bf16_t* hb; float* ssq; float* amx;
    __device__ __forceinline__ void operator()(const f32x4 (&acc)[2][2][4][2], const Unit& u, int wr, int wc, int fr, int fq) const {
#pragma unroll
        for (int ai = 0; ai < 2; ++ai)
#pragma unroll
            for (int m = 0; m < 4; ++m) {
                const int tk = u.pm * BM + ai * HALF + wr * 64 + m * 16 + fr;
                float ss = 0.f, mx = 0.f;
#pragma unroll
                for (int bj = 0; bj < 2; ++bj) {
                    const size_t off = (size_t)tk * DM + u.pn * BM + bj * HALF + wc * 32 + 8 * fq;
                    const f32x4 x0 = *(const f32x4*)(x + off), x1 = *(const f32x4*)(x + off + 4);
                    const f32x4 v0 = acc[ai][bj][m][0] + x0, v1 = acc[ai][bj][m][1] + x1;
                    *(f32x4*)(h + off) = v0; *(f32x4*)(h + off + 4) = v1;
                    u32x4 w; w.x = cvt_pk_bf16(v0[0], v0[1]); w.y = cvt_pk_bf16(v0[2], v0[3]); w.z = cvt_pk_bf16(v1[0], v1[1]); w.w = cvt_pk_bf16(v1[2], v1[3]);
                    *(u32x4*)(hb + off) = w;
                    ss += v0[0] * v0[0] + v0[1] * v0[1] + v0[2] * v0[2] + v0[3] * v0[3] + v1[0] * v1[0] + v1[1] * v1[1] + v1[2] * v1[2] + v1[3] * v1[3];
                    mx = fmaxf(mx, fmaxf(fmaxf(fmaxf(fabsf(v0[0]), fabsf(v0[1])), fmaxf(fabsf(v0[2]), fabsf(v0[3]))), fmaxf(fmaxf(fabsf(v1[0]), fabsf(v1[1])), fmaxf(fabsf(v1[2]), fabsf(v1[3])))));
                }
                ss += sx_f(ss, 16); ss += sx_f(ss, 32);
                mx = fmaxf(mx, sx_f(mx, 16)); mx = fmaxf(mx, sx_f(mx, 32));
                if (fq == 0) { ssq[(size_t)tk * 32 + u.pn * 4 + wc] = ss; amx[(size_t)tk * 32 + u.pn * 4 + wc] = mx; }
            }
    }
};
struct EpiPeerQ {
    static constexpr bool PERM = true;
    const float* ssq; bf16_t* qp; float* rtab;
    __device__ __forceinline__ void operator()(const f32x4 (&acc)[2][2][4][2], const Unit& u, int wr, int wc, int fr, int fq) const {
#pragma unroll
        for (int ai = 0; ai < 2; ++ai)
#pragma unroll
            for (int m = 0; m < 4; ++m) {
                const int tk = u.pm * BM + ai * HALF + wr * 64 + m * 16 + fr;
                float tot = 0.f;
#pragma unroll
                for (int i = 0; i < 8; ++i) { const f32x4 s4 = *(const f32x4*)(ssq + (size_t)tk * 32 + 4 * i); tot += (s4[0] + s4[1]) + (s4[2] + s4[3]); }
                const float r = 1.0f / sqrtf(tot * (1.f / DM) + EPS);
                if (u.pn == 0 && wc == 0 && fq == 0) rtab[tk] = r;
#pragma unroll
                for (int bj = 0; bj < 2; ++bj) {
                    const size_t off = (size_t)tk * DM + u.pn * BM + bj * HALF + wc * 32 + 8 * fq;
                    const f32x4 v0 = acc[ai][bj][m][0] * r, v1 = acc[ai][bj][m][1] * r;
                    u32x4 w; w.x = cvt_pk_bf16(v0[0], v0[1]); w.y = cvt_pk_bf16(v0[2], v0[3]); w.z = cvt_pk_bf16(v1[0], v1[1]); w.w = cvt_pk_bf16(v1[2], v1[3]);
                    *(u32x4*)(qp + off) = w;
                }
            }
    }
};
}

namespace att {
constexpr int NW = 8, QBLK = 32, KVBLK = 64, QB = NW * QBLK, D = 128;
constexpr int SHM_V = KVBLK * D * 2, SHM_K = KVBLK * D * 2;
constexpr int OFF_WS = 2 * SHM_V + 2 * SHM_K, OFF_BIAS = OFF_WS + NW * 64 * 4, ATT_LDS = OFF_BIAS + SEQ * 4;
#define KSWZ(row, colB) ((row) * 256 + ((colB) ^ (((row) & 7) << 4)))
#define SBAR() __builtin_amdgcn_sched_barrier(0)
__device__ __forceinline__ int v_st(int k, int c) { const int kk = (k & ~0xC) | ((k & 4) << 1) | ((k & 8) >> 1); return ((kk >> 3) * 4 + (c >> 5)) * 512 + ((kk & 7) * 32 + (c & 31)) * 2; }
__device__ __forceinline__ int v_rd_base(int lane) { return ((lane & 3) << 3) | (((lane >> 2) & 3) << 6) | (((lane >> 4) & 1) << 5) | (((lane >> 5) & 1) << 8); }
constexpr int v_rd_off(int d0, int ks, int half) { return d0 * 512 + ks * 4096 + half * 2048; }
__device__ __forceinline__ int crow(int r, int hi) { return (r & 3) + 8 * (r >> 2) + 4 * hi; }
__device__ __forceinline__ bf16x8 load8(const bf16_t* p) { return *reinterpret_cast<const bf16x8*>(p); }
__device__ __forceinline__ void mask_tile(f32x16& p0, f32x16& p1, int dq) {
    const float NEG = -__builtin_inff();
#pragma unroll
    for (int r = 0; r < 16; ++r) {
        const int c = (r & 3) + 8 * (r >> 2);
        if (dq - c < 0) p0[r] = NEG;
        if (dq - c - 32 < 0) p1[r] = NEG;
    }
}
__device__ __forceinline__ void partialSM(f32x16& p0, f32x16& p1, float& m_reg, float& mn, float& alpha) {
    float pmax = p0[0];
#pragma unroll
    for (int r = 1; r < 16; ++r) pmax = fmaxf(pmax, p0[r]);
#pragma unroll
    for (int r = 0; r < 16; ++r) pmax = fmaxf(pmax, p1[r]);
    { auto rr = __builtin_amdgcn_permlane32_swap(__float_as_uint(pmax), __float_as_uint(pmax), false, false);
      pmax = fmaxf(__uint_as_float(rr[0]), __uint_as_float(rr[1])); }
    constexpr float C2 = LOG2E * SCALE; constexpr float THR = 8.f;
    if (__builtin_expect(__all((pmax - m_reg) * SCALE <= THR), 1)) { mn = m_reg; alpha = 1.f; }
    else { mn = fmaxf(m_reg, pmax); alpha = __builtin_amdgcn_exp2f((m_reg - mn) * C2); m_reg = mn; }
    const float mnL = -mn * C2;
#pragma unroll
    for (int r = 0; r < 16; ++r) p0[r] = fmaf(p0[r], C2, mnL);
#pragma unroll
    for (int r = 0; r < 16; ++r) p1[r] = fmaf(p1[r], C2, mnL);
#pragma unroll
    for (int r = 0; r < 16; ++r) p0[r] = __builtin_amdgcn_exp2f(p0[r]);
}
#define PK4(P, B_, OUT) do { unsigned a0 = cvt_pk_bf16(P[B_+0], P[B_+1]), a1 = cvt_pk_bf16(P[B_+2], P[B_+3]);                          \
        unsigned b0 = cvt_pk_bf16(P[B_+4], P[B_+5]), b1 = cvt_pk_bf16(P[B_+6], P[B_+7]);                                             \
        auto r0 = __builtin_amdgcn_permlane32_swap(a0, b0, false, false); auto r1 = __builtin_amdgcn_permlane32_swap(a1, b1, false, false); \
        u32x4 w = {r0[0], r1[0], r0[1], r1[1]}; OUT = *reinterpret_cast<bf16x8*>(&w); } while (0)
__device__ __forceinline__ void finishSM(f32x16& p0, f32x16& p1, float alpha, float& l_reg, bf16x8& pa0, bf16x8& pa1, bf16x8& pa2, bf16x8& pa3) {
#pragma unroll
    for (int r = 0; r < 16; ++r) p1[r] = __builtin_amdgcn_exp2f(p1[r]);
    float ps = 0;
#pragma unroll
    for (int r = 0; r < 16; ++r) ps += p0[r];
#pragma unroll
    for (int r = 0; r < 16; ++r) ps += p1[r];
    { auto rr = __builtin_amdgcn_permlane32_swap(__float_as_uint(ps), __float_as_uint(ps), false, false);
      ps = __uint_as_float(rr[0]) + __uint_as_float(rr[1]); }
    l_reg = l_reg * alpha + ps;
    PK4(p0, 0, pa0); PK4(p0, 8, pa1); PK4(p1, 0, pa2); PK4(p1, 8, pa3);
}
__device__ __forceinline__ void sb_group(f32x16& P, int g, float& gs) {
    float run = 0.f;
#pragma unroll
    for (int k = 3; k >= 0; --k) {
        const float z = P[4 * g + k];
        const float t = __builtin_amdgcn_exp2f(-fabsf(z));
        const float l = __builtin_amdgcn_logf(1.f + t);
        const float sp = fmaxf(z, 0.f) + l;
        P[4 * g + k] = (z - sp) - run;
        run += sp;
    }
    gs = run;
}
__device__ __forceinline__ void sb_part1(f32x16& p0, f32x16& p1, float& carry, float mlo) {
    float gs[8];
#pragma unroll
    for (int g = 0; g < 4; ++g) sb_group(p0, g, gs[g]);
#pragma unroll
    for (int g = 0; g < 4; ++g) sb_group(p1, g, gs[4 + g]);
    float run = carry;
#pragma unroll
    for (int G = 7; G >= 0; --G) {
        auto rr = __builtin_amdgcn_permlane32_swap(__float_as_uint(gs[G]), __float_as_uint(gs[G]), false, false);
        const float slo = __uint_as_float(rr[0]), shi = __uint_as_float(rr[1]);
        const float base = fmaf(mlo, shi, run);
        if (G >= 4) {
#pragma unroll
            for (int k = 0; k < 4; ++k) p1[4 * (G - 4) + k] -= base;
        } else {
#pragma unroll
            for (int k = 0; k < 4; ++k) p0[4 * G + k] -= base;
        }
        run += slo + shi;
    }
    carry = run;
#pragma unroll
    for (int r = 0; r < 16; ++r) p0[r] = __builtin_amdgcn_exp2f(p0[r]);
}
__device__ __forceinline__ void sb_part2(f32x16& p0, f32x16& p1, bf16x8& pa0, bf16x8& pa1, bf16x8& pa2, bf16x8& pa3) {
#pragma unroll
    for (int r = 0; r < 16; ++r) p1[r] = __builtin_amdgcn_exp2f(p1[r]);
    PK4(p0, 0, pa0); PK4(p0, 8, pa1); PK4(p1, 0, pa2); PK4(p1, 8, pa3);
}
#undef PK4
template <int KB, bool BIAS>
__device__ __forceinline__ void qkt(f32x16& p0, f32x16& p1, const char* K_lds, int r32, int hi, const bf16x8* qr, const float* bt) {
    if constexpr (BIAS) {
#pragma unroll
        for (int g = 0; g < 4; ++g) { const f32x4 a = *(const f32x4*)(bt + 8 * g), b = *(const f32x4*)(bt + 32 + 8 * g);
            p0[4 * g] = a[0]; p0[4 * g + 1] = a[1]; p0[4 * g + 2] = a[2]; p0[4 * g + 3] = a[3];
            p1[4 * g] = b[0]; p1[4 * g + 1] = b[1]; p1[4 * g + 2] = b[2]; p1[4 * g + 3] = b[3]; }
    } else { p0 = f32x16{}; p1 = f32x16{}; }
    const char* kb[4];
#pragma unroll
    for (int dd = 0; dd < 4; ++dd) kb[dd] = K_lds + KB * SHM_K + KSWZ(r32, (dd * 16 + hi * 8) * 2);
#pragma unroll
    for (int d0 = 0; d0 < 8; ++d0) { const char* a = kb[d0 & 3] + (d0 >> 2) * 128;
        bf16x8 b0 = *reinterpret_cast<const bf16x8*>(a);
        bf16x8 b1 = *reinterpret_cast<const bf16x8*>(a + 32 * 256);
        p0 = __builtin_amdgcn_mfma_f32_32x32x16_bf16(b0, qr[d0], p0, 0, 0, 0);
        p1 = __builtin_amdgcn_mfma_f32_32x32x16_bf16(b1, qr[d0], p1, 0, 0, 0); }
}
template <int VB>
__device__ __forceinline__ void pv_tile(f32x16* o, int vb0, bf16x8 pa0, bf16x8 pa1, bf16x8 pa2, bf16x8 pa3) {
#define TRRD(dst, off) asm volatile("ds_read_b64_tr_b16 %0, %1 offset:%2" : "=&v"(dst) : "v"(vb0), "i"(off) : "memory")
#define PV_D0(d0) do { { s16x4 l0, l1, h0, h1; constexpr int b_ = VB * SHM_V + v_rd_off(d0, 0, 0); \
        TRRD(l0, b_); TRRD(h0, b_ + 2048); TRRD(l1, b_ + 4096); TRRD(h1, b_ + 6144); \
        asm volatile("s_waitcnt lgkmcnt(0)" ::: "memory"); SBAR();   \
        o[d0] = __builtin_amdgcn_mfma_f32_32x32x16_bf16(pa0, (bf16x8){l0[0], l0[1], l0[2], l0[3], h0[0], h0[1], h0[2], h0[3]}, o[d0], 0, 0, 0);   \
        o[d0] = __builtin_amdgcn_mfma_f32_32x32x16_bf16(pa1, (bf16x8){l1[0], l1[1], l1[2], l1[3], h1[0], h1[1], h1[2], h1[3]}, o[d0], 0, 0, 0); }  \
      { s16x4 l2, l3, h2, h3; constexpr int b_ = VB * SHM_V + v_rd_off(d0, 0, 0); \
        TRRD(l2, b_ + 8192); TRRD(h2, b_ + 10240); TRRD(l3, b_ + 12288); TRRD(h3, b_ + 14336); \
        asm volatile("s_waitcnt lgkmcnt(0)" ::: "memory"); SBAR();   \
        o[d0] = __builtin_amdgcn_mfma_f32_32x32x16_bf16(pa2, (bf16x8){l2[0], l2[1], l2[2], l2[3], h2[0], h2[1], h2[2], h2[3]}, o[d0], 0, 0, 0);   \
        o[d0] = __builtin_amdgcn_mfma_f32_32x32x16_bf16(pa3, (bf16x8){l3[0], l3[1], l3[2], l3[3], h3[0], h3[1], h3[2], h3[3]}, o[d0], 0, 0, 0); } } while (0)
    PV_D0(0); PV_D0(1); PV_D0(2); PV_D0(3);
#undef PV_D0
#undef TRRD
}

struct UnitRef { const bf16_t* Q; const bf16_t* K; const bf16_t* V; int P0; };
struct Seam { bf16x8 qr[8]; bf16x8 st_v0, st_v1, st_k0, st_k1; };
#define ROW(p, k0, rr) ((p) + (size_t)((k0) + (rr)) * D + sc)
#define VMW() asm volatile("s_waitcnt vmcnt(0)" ::: "memory")
#define SLOAD_H(Kp, Vp, k0) do { S.st_v0 = load8(ROW(Vp, k0, sr)); S.st_v1 = load8(ROW(Vp, k0, 32 + sr));              \
                         S.st_k0 = load8(ROW(Kp, k0, sr)); S.st_k1 = load8(ROW(Kp, k0, 32 + sr)); } while (0)
#define SWRITE_HK(bf) do { *(bf16x8*)(K_lds + (bf) * SHM_K + kws) = S.st_k0; *(bf16x8*)(K_lds + (bf) * SHM_K + kws + 32 * 256) = S.st_k1; } while (0)
#define SWRITE_HV(bf) do { *(bf16x8*)(V_lds + (bf) * SHM_V + vst0) = S.st_v0; *(bf16x8*)(V_lds + (bf) * SHM_V + vst1) = S.st_v1; } while (0)
#define SWRITE_H(bf) do { SWRITE_HV(bf); SWRITE_HK(bf); } while (0)

template <bool SB>
__device__ __forceinline__ void attn_unit(const UnitRef& cur, unsigned char* wsu  , int bh, char* lds,
                                          int part  ) {
    const float* cvec; const float* gqk;
    { unsigned char* w_ = wsu; asm volatile("" : "+s"(w_)); cvec = (const float*)(w_ + WS_C) + (size_t)bh * SEQ; gqk = (const float*)(w_ + WS_GQK); }
    const int tid = tid_opaque(), wid = __builtin_amdgcn_readfirstlane(tid >> 6), lane = tid & 63, r32 = lane & 31, hi = lane >> 5;
    int jlo = 0;
    if constexpr (!SB) {
        const float gq = fmaxf(fabsf(gqk[lane]), fabsf(gqk[64 + lane])), gk = fmaxf(fabsf(gqk[128 + lane]), fabsf(gqk[192 + lane]));
        const float lmax = 11.3137085f * 1.02f * wave_max(gq) * wave_max(gk);
        const int ntf = (cur.P0 + QB) / KVBLK;
        const float cend = (lane < ntf) ? cvec[lane * KVBLK + KVBLK - 1] : 0.f;
        const bool skip = (lane < ntf) && (2.f * lmax + cvec[cur.P0] - cend < -104.f);
        jlo = __builtin_amdgcn_readfirstlane((int)__popcll(__ballot(skip)));
    }
    const int ntot = (cur.P0 + QB) / KVBLK - jlo;
    const int tb = (part == 2) ? (ntot >> 1) : 0, te = (part == 1) ? (ntot >> 1) : ntot;
    const int kshift = (jlo + tb) * KVBLK, P0r = cur.P0 - kshift;
    const int NT = te - tb;
#define KBASE(t) ((SB ? (NT - 1 - (t)) : (t)) * KVBLK)
    const int qlo = P0r + wid * QBLK, qm = qlo + r32 - 4 * hi - (SB ? 1 : 0);
    char* V_lds = lds; char* K_lds = lds + 2 * SHM_V;
    float* ws = (float*)(lds + OFF_WS) + wid * 64; float* li_l = ws, * al_l = ws + 32;
    float* bias = (float*)(lds + OFF_BIAS);
    const int sr = tid >> 4, sc = (tid & 15) * 8, vst0 = v_st(sr, sc), vst1 = v_st(32 + sr, sc), kws = KSWZ(sr, sc * 2);
    const int vb0 = (int)(uintptr_t)V_lds + v_rd_base(lane);
    const bf16_t* Kh = cur.K + (size_t)kshift * D; const bf16_t* Vh = cur.V + (size_t)kshift * D;
    Seam S;
    if constexpr (!SB) { const float cq0 = cvec[cur.P0]; const float* cv = cvec + kshift; for (int j = tid; j < NT * KVBLK; j += NTHREADS) bias[j] = (cq0 - cv[j]) * (1.f / SCALE); }
#pragma unroll
    for (int d0 = 0; d0 < 8; ++d0) S.qr[d0] = load8(cur.Q + (size_t)(wid * QBLK + r32) * D + d0 * 16 + hi * 8);
    SLOAD_H(Kh, Vh, KBASE(0)); VMW(); SWRITE_HK(0);
    __syncthreads();
    float m_reg = -1e30f, l_reg = 0; f32x16 o[4] = {};
    float carry = 0.f; const float mlo = hi ? 0.f : 1.f;
#define RESC(a) do { if (__any((a) < 1.f)) { if (hi == 0) al_l[r32] = (a); asm volatile("s_waitcnt lgkmcnt(0)" ::: "memory");              \
                     for (int d_ = 0; d_ < 4; ++d_) for (int r = 0; r < 16; ++r) o[d_][r] *= al_l[crow(r, hi)]; } } while (0)
#define MASKT(P0_, P1_, t) do { const int kb_ = KBASE(t); if (kb_ + KVBLK - 1 > qlo - (SB ? 1 : 0)) mask_tile(P0_, P1_, qm - kb_); } while (0)
#define BT(t) (bias + KBASE(t) + 4 * hi)
#define PART1(PX0, PX1, mnX, alX) do { if constexpr (SB) sb_part1(PX0, PX1, carry, mlo); else partialSM(PX0, PX1, m_reg, mnX, alX); } while (0)
#define PART2(PY0, PY1, alY) do { if constexpr (SB) sb_part2(PY0, PY1, pa0, pa1, pa2, pa3); else finishSM(PY0, PY1, alY, l_reg, pa0, pa1, pa2, pa3); } while (0)
    f32x16 pA0, pA1, pB0, pB1; float mnA = 0.f, mnB = 0.f, alA = 1.f, alB = 1.f; bf16x8 pa0, pa1, pa2, pa3;
    SWRITE_HV(0); SBAR();
    if (NT > 1) SLOAD_H(Kh, Vh, KBASE(1));
    SBAR(); qkt<0, !SB>(pA0, pA1, K_lds, r32, hi, S.qr, BT(0));
    MASKT(pA0, pA1, 0); PART1(pA0, pA1, mnA, alA);
    if (NT > 1) { VMW(); SWRITE_H(1); }
    __syncthreads();
#define HALF_STEP(PX0, PX1, mnX, alX, PY0, PY1, alY, t, KB, VB, SBUF) do {                                                    \
        SBAR(); qkt<KB, !SB>(PX0, PX1, K_lds, r32, hi, S.qr, BT(t));                                                          \
        PART2(PY0, PY1, alY); SBAR();                                                                                          \
        if ((t) + 1 < NT) { SLOAD_H(Kh, Vh, KBASE((t) + 1)); SBAR(); }                                                         \
        pv_tile<VB>(o, vb0, pa0, pa1, pa2, pa3); MASKT(PX0, PX1, (t)); PART1(PX0, PX1, mnX, alX);                              \
        __syncthreads();                                                                                                      \
        if ((t) + 1 < NT) { VMW(); SWRITE_H(SBUF); }                                                                           \
        if constexpr (!SB) RESC(alX);                                                                                          \
        __syncthreads(); } while (0)
    for (int t = 1; t + 1 < NT; t += 2) {
        HALF_STEP(pB0, pB1, mnB, alB, pA0, pA1, alA, t, 1, 0, 0);
        HALF_STEP(pA0, pA1, mnA, alA, pB0, pB1, alB, t + 1, 0, 1, 1);
    }
    const bool even = (NT & 1) == 0;
    if (even) { SBAR(); qkt<1, !SB>(pB0, pB1, K_lds, r32, hi, S.qr, BT(NT - 1)); SBAR(); }
    PART2(pA0, pA1, alA); SBAR();
    pv_tile<0>(o, vb0, pa0, pa1, pa2, pa3);
    if (even) { MASKT(pB0, pB1, NT - 1); PART1(pB0, pB1, mnB, alB); __syncthreads(); if constexpr (!SB) RESC(alB);
        PART2(pB0, pB1, alB); SBAR(); pv_tile<1>(o, vb0, pa0, pa1, pa2, pa3); }
    unsigned char* we_ = wsu; asm volatile("" : "+s"(we_));
    if (part != 0) {
        const int slot2 = ((((cur.P0 >> 8) - 8) & 7) * 16 + bh) * 2 + (part == 2 ? 1 : 0);
        float* po = (float*)(we_ + WS_PO) + (size_t)slot2 * 256 * 128; float* pml = (float*)(we_ + WS_PML) + (size_t)slot2 * 512;
        if (hi == 0) { pml[(wid * QBLK + r32) * 2] = m_reg; pml[(wid * QBLK + r32) * 2 + 1] = l_reg; }
#pragma unroll
        for (int r = 0; r < 16; ++r)
#pragma unroll
            for (int d0 = 0; d0 < 4; ++d0) po[(size_t)(wid * QBLK + crow(r, hi)) * D + d0 * 32 + r32] = o[d0][r];
        __syncthreads();
        return;
    }
    const bf16_t* gate = (const bf16_t*)(we_ + WS_SEC) + 3 * SEC_ELEMS + (size_t)(bh >> 3) * SEQ * 1024 + (bh & 7) * HD;
    bf16_t* outp = (bf16_t*)(we_ + WS_MIX) + (size_t)(bh >> 3) * SEQ * DM + (bh & 7) * HD;
    float rli[16];
    if constexpr (!SB) {
        if (hi == 0) li_l[r32] = l_reg; asm volatile("s_waitcnt lgkmcnt(0)" ::: "memory");
#pragma unroll
        for (int r = 0; r < 16; ++r) rli[r] = __builtin_amdgcn_rcpf(li_l[crow(r, hi)]);
    }
#pragma unroll
    for (int r = 0; r < 16; ++r) { const int orow = cur.P0 + wid * QBLK + crow(r, hi);
#pragma unroll
        for (int d0 = 0; d0 < 4; ++d0) {
            float v = o[d0][r];
            if constexpr (!SB) { const unsigned short gb = gate[(size_t)orow * 1024 + d0 * 32 + r32]; v = v * rli[r] * __builtin_bit_cast(float, (unsigned)gb << 16); }
            const float vn = sx_f(v, 1);
            if ((r32 & 1) == 0) *(unsigned*)(outp + (size_t)orow * DM + d0 * 32 + r32) = cvt_pk_bf16(v, vn); } }
    __syncthreads();
#undef RESC
#undef KBASE
#undef MASKT
#undef BT
#undef PART1
#undef PART2
#undef HALF_STEP
}

constexpr float SB_TH = 150.f;
__device__ __forceinline__ void sb_unit(const UnitRef& cur, bf16_t* outp, char* lds) {
    const int tid = tid_opaque(), wid = __builtin_amdgcn_readfirstlane(tid >> 6), lane = tid & 63, r32 = lane & 31, hi = lane >> 5;
    const int NT = (cur.P0 + QB) / KVBLK;
#define KBASE(t) ((NT - 1 - (t)) * KVBLK)
    const int qlo = cur.P0 + wid * QBLK, qm = qlo + r32 - 4 * hi - 1;
    char* V_lds = lds; char* K_lds = lds + 2 * SHM_V;
    volatile int* flags = (volatile int*)(lds + OFF_WS);
    const int sr = tid >> 4, sc = (tid & 15) * 8, vst0 = v_st(sr, sc), vst1 = v_st(32 + sr, sc), kws = KSWZ(sr, sc * 2);
    const int vb0 = (int)(uintptr_t)V_lds + v_rd_base(lane);
    const bf16_t* Kh = cur.K; const bf16_t* Vh = cur.V;
    Seam S;
#pragma unroll
    for (int d0 = 0; d0 < 8; ++d0) S.qr[d0] = load8(cur.Q + (size_t)(wid * QBLK + r32) * D + d0 * 16 + hi * 8);
    SLOAD_H(Kh, Vh, KBASE(0)); VMW(); SWRITE_H(0);
    __syncthreads();
    f32x16 o[4] = {}; float carry = 0.f; const float mlo = hi ? 0.f : 1.f;
    bool wdone = false;
#define SB_STEP(tt, BUF) {                                                                                                 \
        const int kb_ = KBASE(tt);                                                                                           \
        if ((tt) + 1 < NT) SLOAD_H(Kh, Vh, KBASE((tt) + 1));                                                                 \
        SBAR();                                                                                                              \
        if (!wdone && kb_ <= qlo + QBLK - 2) {                                                                               \
            f32x16 p0, p1; bf16x8 pa0, pa1, pa2, pa3;                                                                        \
            qkt<BUF, false>(p0, p1, K_lds, r32, hi, S.qr, nullptr);                                                          \
            if (kb_ + KVBLK - 1 > qlo - 1) mask_tile(p0, p1, qm - kb_);                                                      \
            sb_part1(p0, p1, carry, mlo); sb_part2(p0, p1, pa0, pa1, pa2, pa3); SBAR();                                      \
            pv_tile<BUF>(o, vb0, pa0, pa1, pa2, pa3);                                                                        \
            wdone = __all(carry >= SB_TH);                                                                                   \
        }                                                                                                                    \
        if ((tt) + 1 < NT) { VMW(); SWRITE_H((BUF) ^ 1); }                                                                   \
        if (lane == 0) flags[((tt) & 1) * 8 + wid] = wdone ? 1 : 0;                                                          \
        __syncthreads();                                                                                                     \
        { int alld = 1;                                                                                                      \
          _Pragma("unroll") for (int w_ = 0; w_ < 8; ++w_) alld &= flags[((tt) & 1) * 8 + w_];                                \
          if (alld) break; } }
    for (int t = 0; t < NT; t += 2) {
        SB_STEP(t, 0)
        SB_STEP(t + 1, 1)
    }
#undef SB_STEP
#pragma unroll
    for (int r = 0; r < 16; ++r) { const int orow = cur.P0 + wid * QBLK + crow(r, hi);
#pragma unroll
        for (int d0 = 0; d0 < 4; ++d0) {
            const float v = o[d0][r];
            const float vn = sx_f(v, 1);
            if ((r32 & 1) == 0) *(unsigned*)(outp + (size_t)orow * DM + d0 * 32 + r32) = cvt_pk_bf16(v, vn); } }
    __syncthreads();
#undef KBASE
}
#undef ROW
#undef VMW
#undef SLOAD_H
#undef SWRITE_HK
#undef SWRITE_HV
#undef SWRITE_H
}

#define XB_TMO      128
#define XB_XCNT(j)  (256  + 64 * (j))
#define XB_XSUB(j)  (1280 + 64 * (j))
#define XB_XGEN(j)  (2304 + 64 * (j))
#define XB_TOP      3328
#define XB_TOPGEN   3392
#define XCD_BAR_WORDS 3456
#define XB_SPIN_CAP (1u << 20)
__device__ __forceinline__ unsigned xb_ld(unsigned* p)              { return __hip_atomic_load(p, __ATOMIC_RELAXED, __HIP_MEMORY_SCOPE_AGENT); }
__device__ __forceinline__ unsigned xb_add(unsigned* p, unsigned v) { return __hip_atomic_fetch_add(p, v, __ATOMIC_RELAXED, __HIP_MEMORY_SCOPE_AGENT); }
__device__ __forceinline__ unsigned xb_xcc_id() { return (unsigned)__builtin_amdgcn_s_getreg((3 << 11) | 20) & 0xFu; }
#define XB_SPIN(cond, bar) do { unsigned _sp = 0; while (cond) { __builtin_amdgcn_s_sleep(1); \
    if ((++_sp & 255u) == 0u) { if (xb_ld(&(bar)[XB_TMO])) break; if (_sp > XB_SPIN_CAP) { atomicAdd(&(bar)[XB_TMO], 1u); break; } } } } while (0)
struct XcdBarrier { unsigned* bar; unsigned x; volatile LAS unsigned* st; };
__device__ __forceinline__ XcdBarrier xcd_barrier_post(unsigned* bar, volatile LAS unsigned* st) {
    XcdBarrier b; b.bar = bar; b.x = xb_xcc_id(); b.st = st;
    if (threadIdx.x == 0) (void)xb_add(&bar[XB_XCNT(b.x)], 1u);
    return b;
}
__device__ __forceinline__ void xcd_barrier_complete(unsigned* bar, unsigned x, unsigned& nloc, unsigned& nx) {
    const unsigned G = gridDim.x * gridDim.y * gridDim.z;
    unsigned sum, cnt, mine, sp = 0u;
    for (;;) {
        sum = 0u; cnt = 0u; mine = 0u;
#pragma unroll
        for (unsigned j = 0; j < 16; ++j) { const unsigned c = xb_ld(&bar[XB_XCNT(j)]); sum += c; cnt += (c > 0u) ? 1u : 0u; mine = (j == x) ? c : mine; }
        if (sum == G) break;
        __builtin_amdgcn_s_sleep(1);
        if ((++sp & 255u) == 0u) { if (xb_ld(&bar[XB_TMO])) break; if (sp > XB_SPIN_CAP) { atomicAdd(&bar[XB_TMO], 1u); break; } }
    }
    nloc = mine > 0u ? mine : 1u; nx = cnt > 0u ? cnt : 1u;
}
__device__ __forceinline__ void xcd_barrier(const XcdBarrier& b) {
    asm volatile("s_waitcnt vmcnt(0)" ::: "memory");
    __syncthreads();
    if (threadIdx.x == 0) {
        unsigned* bar = b.bar;
        __builtin_amdgcn_s_waitcnt(0);
        unsigned nloc = b.st[0], nx = b.st[1];
        if (nloc == 0u) { xcd_barrier_complete(bar, b.x, nloc, nx); b.st[0] = nloc; b.st[1] = nx; }
        const unsigned old = xb_add(&bar[XB_XSUB(b.x)], 1u);
        const unsigned gen = old / nloc;
        if (old + 1u == (gen + 1u) * nloc) {
            __builtin_amdgcn_fence(__ATOMIC_RELEASE, "agent");
            asm volatile("s_waitcnt vmcnt(0)" ::: "memory");
            const unsigned og = xb_add(&bar[XB_TOP], 1u);
            const unsigned tg = og / nx;
            if (og + 1u == (tg + 1u) * nx) xb_add(&bar[XB_TOPGEN], 1u);
            else XB_SPIN(xb_ld(&bar[XB_TOPGEN]) == tg, bar);
            __builtin_amdgcn_fence(__ATOMIC_ACQUIRE, "agent");
            xb_add(&bar[XB_XGEN(b.x)], 1u);
            asm volatile("s_waitcnt vmcnt(0)" ::: "memory");
        } else {
            XB_SPIN(xb_ld(&bar[XB_XGEN(b.x)]) == gen, bar);
            __builtin_amdgcn_fence(__ATOMIC_ACQUIRE, "agent");
            asm volatile("s_waitcnt vmcnt(0)" ::: "memory");
        }
    }
    __syncthreads();
}

struct Args { const float* in[12]; float* out; unsigned char* ws; int ph_lo, ph_hi; };

__device__ __forceinline__ void p0_transpose_item(const float* W, int ldw, int K, bf16_t* WT, int nblk, LAS float* scr, int item, int lane, const float* gk) {
    const int kb = item / nblk, nb = item % nblk, k0 = 64 * kb, n0 = 32 * nb;
#pragma unroll 8
    for (int i = 0; i < 32; ++i) { const int kk = 2 * i + (lane >> 5); float w = W[(size_t)(k0 + kk) * ldw + n0 + (lane & 31)]; if (gk) w *= gk[k0 + kk]; scr[kk * 33 + (lane & 31)] = w; }
    LDS_WAIT(); asm volatile("" ::: "memory");
    const int c = lane & 7;
#pragma unroll
    for (int j = 0; j < 4; ++j) { const int n = (lane >> 3) + 8 * j; const LAS float* s = scr + (8 * c) * 33 + n;
        u32x4 o; o.x = cvt_pk_bf16(s[0 * 33], s[1 * 33]); o.y = cvt_pk_bf16(s[2 * 33], s[3 * 33]); o.z = cvt_pk_bf16(s[4 * 33], s[5 * 33]); o.w = cvt_pk_bf16(s[6 * 33], s[7 * 33]);
        *(u32x4*)(WT + (size_t)(n0 + n) * K + k0 + 8 * c) = o; }
    LDS_WAIT(); asm volatile("" ::: "memory");
}

__device__ __forceinline__ int pack_i8(float a, float b, float c, float d) {
    const int ia = (int)__builtin_rintf(a), ib = (int)__builtin_rintf(b), ic = (int)__builtin_rintf(c), id = (int)__builtin_rintf(d);
    return (int)(((unsigned)ia & 0xffu) | (((unsigned)ib & 0xffu) << 8) | (((unsigned)ic & 0xffu) << 16) | ((unsigned)id << 24));
}
__device__ __forceinline__ void convert_tables(const Args& a, int r0, int r1, int worker, int nworkers) {
    const int lane = tid_opaque() & 63;
    unsigned char* ws = a.ws; const float* g_ffn = a.in[7]; const float* pu = a.in[10]; const float* pv = a.in[11];
    float* suv = (float*)(ws + WS_SUV);
    for (int r = r0 + worker; r < r1; r += nworkers) {
        const bool isv = r >= NEXP; const int e = isv ? r - NEXP : r;
        const f32x4* srcp = (const f32x4*)((isv ? pv : pu) + (size_t)e * DM);
        f32x4 v[8]; float amax = 0.f;
#pragma unroll
        for (int j = 0; j < 8; ++j) { v[j] = srcp[lane + 64 * j];
            if (!isv) { const f32x4 g4 = *(const f32x4*)(g_ffn + 4 * (lane + 64 * j)); v[j] = v[j] * g4; }
            amax = fmaxf(amax, fmaxf(fmaxf(fabsf(v[j][0]), fabsf(v[j][1])), fmaxf(fabsf(v[j][2]), fabsf(v[j][3])))); }
        amax = wave_max(amax);
        const float sc = amax > 0.f ? 127.f / amax : 1.f;
        unsigned char* dst = ws + (isv ? WS_V8 : WS_U8) + (size_t)e * 128;
#pragma unroll
        for (int j = 0; j < 8; ++j) { const int p = pack_i8(v[j][0] * sc, v[j][1] * sc, v[j][2] * sc, v[j][3] * sc);
            const int col = 4 * (lane + 64 * j);
            *(unsigned*)(dst + (size_t)(col >> 7) * ((size_t)NEXP * 128) + (col & 127)) = (unsigned)p; }
        if (lane == 0) suv[r] = 1.f / sc;
    }
}
constexpr int TAB_SPLIT = NEXP;

__device__ __forceinline__ void p0_transpose_item_i8(const float* W, int ldw, int K, unsigned char* WT, int nblk, LAS float* scr, int item, int lane, float q8) {
    const int kb = item / nblk, nb = item % nblk, k0 = 64 * kb, n0 = 32 * nb;
#pragma unroll 8
    for (int i = 0; i < 32; ++i) { const int kk = 2 * i + (lane >> 5); scr[kk * 33 + (lane & 31)] = W[(size_t)(k0 + kk) * ldw + n0 + (lane & 31)] * q8; }
    LDS_WAIT(); asm volatile("" ::: "memory");
    const int c = lane & 7;
#pragma unroll
    for (int j = 0; j < 4; ++j) { const int n = (lane >> 3) + 8 * j; const LAS float* s = scr + (8 * c) * 33 + n;
        u32x2 o; o.x = (unsigned)pack_i8(s[0 * 33], s[1 * 33], s[2 * 33], s[3 * 33]); o.y = (unsigned)pack_i8(s[4 * 33], s[5 * 33], s[6 * 33], s[7 * 33]);
        *(u32x2*)(WT + (size_t)(n0 + n) * K + k0 + 8 * c) = o; }
    LDS_WAIT(); asm volatile("" ::: "memory");
}
__device__ __forceinline__ float log_sigmoid_f(float x) { return fminf(x, 0.f) - log1pf(expf(-fabsf(x))); }

__device__ __forceinline__ void phase0(const Args& a, unsigned char* lds_g) {
    LAS unsigned char* lds = (LAS unsigned char*)lds_g;
    const int tid = tid_opaque(), lane = tid & 63, wave = __builtin_amdgcn_readfirstlane(tid >> 6);
    const int gw = blockIdx.x * NWAVES + wave, NGW = gridDim.x * NWAVES;
    const int gt = blockIdx.x * NTHREADS + tid, NGT = gridDim.x * NTHREADS;
    unsigned char* ws = a.ws;
    const float* x = a.in[0]; const float* g_attn = a.in[1]; const float* w_in = a.in[2]; const float* b_forget = a.in[3];
    const float* w_out = a.in[6]; const float* g_ffn = a.in[7]; const float* w_pq = a.in[8]; const float* sk = a.in[9]; const float* pu = a.in[10]; const float* pv = a.in[11];
    { float m = 0.f; const f32x4* wp = (const f32x4*)w_in;
      for (size_t i = gt; i < (size_t)DM * DIN / 4; i += NGT) { const f32x4 v = wp[i]; m = fmaxf(m, fmaxf(fmaxf(fabsf(v[0]), fabsf(v[1])), fmaxf(fabsf(v[2]), fabsf(v[3])))); }
      m = wave_max(m);
      if (lane == 0) __hip_atomic_fetch_max((unsigned*)(ws + WS_CTL) + CW_WMAX, __float_as_uint(m), __ATOMIC_RELAXED, __HIP_MEMORY_SCOPE_AGENT); }
    LAS float* wf = (LAS float*)(lds + 67584);
    for (int k = tid; k < DM; k += NTHREADS) { const f32x4 a0 = *(const f32x4*)(w_in + (size_t)k * DIN + NPROJ), a1 = *(const f32x4*)(w_in + (size_t)k * DIN + NPROJ + 4);
        *(LAS f32x4*)(wf + k * 8) = a0; *(LAS f32x4*)(wf + k * 8 + 4) = a1; }
    __syncthreads();
    for (int row = gw; row < T; row += NGW) {
        const f32x4* xr = (const f32x4*)(x + (size_t)row * DM);
        f32x4 v[8]; float ss = 0.f;
#pragma unroll
        for (int j = 0; j < 8; ++j) { v[j] = xr[lane + 64 * j]; ss += v[j][0] * v[j][0] + v[j][1] * v[j][1] + v[j][2] * v[j][2] + v[j][3] * v[j][3]; }
        const float r = 1.0f / sqrtf(wave_sum(ss) * (1.f / DM) + EPS);
        float f[8] = {0.f, 0.f, 0.f, 0.f, 0.f, 0.f, 0.f, 0.f};
        float xmax = 0.f;
#pragma unroll
        for (int j = 0; j < 8; ++j) { const f32x4 g4 = *(const f32x4*)(g_attn + 4 * (lane + 64 * j)); v[j][0] *= r * g4[0]; v[j][1] *= r * g4[1]; v[j][2] *= r * g4[2]; v[j][3] *= r * g4[3];
            xmax = fmaxf(xmax, fmaxf(fmaxf(fabsf(v[j][0]), fabsf(v[j][1])), fmaxf(fabsf(v[j][2]), fabsf(v[j][3])))); }
        xmax = wave_max(xmax);
        const float xq = xmax > 0.f ? 127.f / xmax : 1.f;
        if (lane == 0) ((float*)(ws + WS_SXN))[row] = xmax * (1.f / 127.f);
        unsigned* o8 = (unsigned*)(ws + WS_XN + (size_t)row * DM);
#pragma unroll
        for (int j = 0; j < 8; ++j) {
            const int e = 4 * (lane + 64 * j);
            const f32x4 xn = v[j];
            o8[lane + 64 * j] = (unsigned)pack_i8(xn[0] * xq, xn[1] * xq, xn[2] * xq, xn[3] * xq);
#pragma unroll
            for (int q = 0; q < 4; ++q) { const f32x4 w0 = *(LAS f32x4*)(wf + (e + q) * 8), w1 = *(LAS f32x4*)(wf + (e + q) * 8 + 4);
                f[0] += xn[q] * w0[0]; f[1] += xn[q] * w0[1]; f[2] += xn[q] * w0[2]; f[3] += xn[q] * w0[3];
                f[4] += xn[q] * w1[0]; f[5] += xn[q] * w1[1]; f[6] += xn[q] * w1[2]; f[7] += xn[q] * w1[3]; }
            __builtin_amdgcn_sched_barrier(0);
        }
#pragma unroll
        for (int hh = 0; hh < 8; ++hh) f[hh] = wave_sum(f[hh]);
        if (lane < 8) { float fl = f[0];
#pragma unroll
            for (int hh = 1; hh < 8; ++hh) fl = (lane == hh) ? f[hh] : fl;
            const int b = row >> 12, s = row & 4095;
            ((float*)(ws + WS_LOGF))[(size_t)(b * 8 + lane) * SEQ + s] = log_sigmoid_f(fl + b_forget[lane]); }
    }
    LAS float* scr = (LAS float*)(lds + wave * 8448);
    constexpr int I_IN = (DM / 64) * (NPROJ / 32), I_O = (DM / 64) * (DM / 32);
    for (int it = gw; it < 2 * I_O; it += NGW) {
        int r = it;
        if (r < I_O) { p0_transpose_item(w_out, DM, DM, (bf16_t*)(ws + WS_WOUT), DM / 32, scr, r, lane, nullptr); continue; } r -= I_O;
        p0_transpose_item(w_pq, DM, DM, (bf16_t*)(ws + WS_WPQ), DM / 32, scr, r, lane, g_ffn);
    }
    for (int i = gt; i < 8 * 2 * 128 * 128 / 8; i += NGT) { const f32x4 a0 = *(const f32x4*)(sk + (size_t)i * 8), a1 = *(const f32x4*)(sk + (size_t)i * 8 + 4);
        u32x4 w; w.x = cvt_pk_bf16(a0[0], a0[1]); w.y = cvt_pk_bf16(a0[2], a0[3]); w.z = cvt_pk_bf16(a1[0], a1[1]); w.w = cvt_pk_bf16(a1[2], a1[3]);
        *(u32x4*)(ws + WS_SK + (size_t)i * 16) = w; }
    if (gt < 256) ((float*)(ws + WS_GQK))[gt] = gt < 128 ? a.in[4][gt] : a.in[5][gt - 128];
    convert_tables(a, 0, TAB_SPLIT, gw, NGW);
    { XcdBarrier xb_; xb_.bar = (unsigned*)(ws + WS_CTL) + CW_BAR; xb_.x = xb_xcc_id(); xb_.st = (volatile LAS unsigned*)(lds + MISC_OFF) + 8; xcd_barrier(xb_); }
    const float wmax = __uint_as_float(__hip_atomic_load((unsigned*)(ws + WS_CTL) + CW_WMAX, __ATOMIC_RELAXED, __HIP_MEMORY_SCOPE_AGENT));
    if (gt == 0) *(float*)(ws + WS_WSC) = wmax * (1.f / 127.f);
    const float q8 = wmax > 0.f ? 127.f / wmax : 1.f;
    for (int it = gw; it < I_IN; it += NGW) p0_transpose_item_i8(w_in, DIN, DM, ws + WS_WIN, NPROJ / 32, scr, it, lane, q8);
}

__device__ __forceinline__ void cumsum_rows(const Args& a) {
    const int tid = tid_opaque(), lane = tid & 63, wave = tid >> 6;
    if (blockIdx.x >= 16 || wave != 0) return;
    const float* src = (const float*)(a.ws + WS_LOGF) + (size_t)blockIdx.x * SEQ + lane * 64;
    float* dst = (float*)(a.ws + WS_C) + (size_t)blockIdx.x * SEQ + lane * 64;
    f32x4 v[16]; float run = 0.f;
#pragma unroll
    for (int i = 0; i < 16; ++i) { v[i] = *(const f32x4*)(src + 4 * i);
#pragma unroll
        for (int q = 0; q < 4; ++q) { run += v[i][q]; v[i][q] = run; } }
    float incl = run;
#pragma unroll
    for (int o = 1; o < 64; o <<= 1) { const float t = shup_f(incl, o); if (lane >= o) incl += t; }
    const float off = incl - run;
#pragma unroll
    for (int i = 0; i < 16; ++i) { f32x4 w = v[i]; w[0] += off; w[1] += off; w[2] += off; w[3] += off; *(f32x4*)(dst + 4 * i) = w; }
}

__device__ __forceinline__ void phase_qknorm(const Args& a) {
    const int tid = tid_opaque(), lane = tid & 63, wave = tid >> 6;
    const int gw = blockIdx.x * NWAVES + wave, NGW = gridDim.x * NWAVES;
    const int sub = lane & 15, rw = lane >> 4;
    const float* gq = a.in[4]; const float* gk = a.in[5];
    constexpr int ROWS = NB * NHF * SEQ;
    for (int it = gw; it < 2 * ROWS / 4; it += NGW) {
        const int row = it * 4 + rw; const bool isk = row >= ROWS;
        bf16_t* p = (bf16_t*)(a.ws + WS_SEC) + (size_t)row * HD + sub * 8;
        const float* g = (isk ? gk : gq) + sub * 8;
        const u32x4 w = *(const u32x4*)p;
        float v[8] = {bf_lo(w.x), bf_hi(w.x), bf_lo(w.y), bf_hi(w.y), bf_lo(w.z), bf_hi(w.z), bf_lo(w.w), bf_hi(w.w)};
        float ss = 0.f;
#pragma unroll
        for (int i = 0; i < 8; ++i) ss += v[i] * v[i];
        ss += sx_f(ss, 1); ss += sx_f(ss, 2); ss += sx_f(ss, 4); ss += sx_f(ss, 8);
        const float r = 1.0f / sqrtf(ss * (1.f / HD) + EPS);
        const f32x4 g0 = *(const f32x4*)g, g1 = *(const f32x4*)(g + 4);
        u32x4 o; o.x = cvt_pk_bf16(v[0] * r * g0[0], v[1] * r * g0[1]); o.y = cvt_pk_bf16(v[2] * r * g0[2], v[3] * r * g0[3]);
        o.z = cvt_pk_bf16(v[4] * r * g1[0], v[5] * r * g1[1]); o.w = cvt_pk_bf16(v[6] * r * g1[2], v[7] * r * g1[3]);
        *(u32x4*)p = o;
    }
}

__device__ __forceinline__ void phase_attn(const Args& a, unsigned char* lds_g) {
    const int tid = tid_opaque();
    volatile int* s_item = (volatile int*)(lds_g + MISC_OFF);
    unsigned* ctr = (unsigned*)(a.ws + WS_CTL);
    for (;;) {
        __syncthreads();
        if (tid == 0) *s_item = (int)atomicAdd(ctr, 1u);
        __syncthreads();
        int it = *s_item, kind = -1, qb = 0, sub = 0;
#define CLS(K, Q, CNT) if (kind < 0) { if (it < (CNT)) { kind = (K); qb = (Q); sub = it; } else it -= (CNT); }
        CLS(2, 15, 32) CLS(1, 7, 16) CLS(2, 14, 32) CLS(2, 13, 32) CLS(1, 6, 16) CLS(2, 12, 32) CLS(2, 11, 32) CLS(1, 5, 16) CLS(2, 10, 32) CLS(2, 9, 32) CLS(1, 4, 16) CLS(2, 8, 32) CLS(1, 3, 16) CLS(1, 2, 16)
        if (kind < 0) { if (it < 256) { kind = 0; qb = 15 - (it >> 4); sub = it & 15; } else it -= 256; }
        CLS(1, 1, 16) CLS(1, 0, 16)
#undef CLS
        if (kind < 0) break;
        unsigned char* wsl = a.ws; asm volatile("" : "+s"(wsl));
        bf16_t* sec = (bf16_t*)(wsl + WS_SEC);
        const int bh = sub & 15, part = (kind == 2) ? 1 + (sub >> 4) : 0;
        const int b = bh >> 3, h = bh & 7;
        const size_t hoff = (size_t)bh * SEQ * HD;
        att::UnitRef u;
        u.P0 = qb * 256;
        if (kind == 0) {
            u.Q = sec + 4 * SEC_ELEMS + hoff + (size_t)u.P0 * HD; u.K = sec + 5 * SEC_ELEMS + hoff; u.V = sec + 6 * SEC_ELEMS + hoff;
            att::sb_unit(u, (bf16_t*)(wsl + WS_MIX) + (size_t)b * SEQ * DM + 1024 + h * HD, (char*)lds_g);
        } else {
            u.Q = sec + 0 * SEC_ELEMS + hoff + (size_t)u.P0 * HD; u.K = sec + 1 * SEC_ELEMS + hoff; u.V = sec + 2 * SEC_ELEMS + hoff;
            att::attn_unit<false>(u, wsl, bh, (char*)lds_g, part);
        }
    }
}
__device__ __forceinline__ void phase_attn_combine(const Args& a) {
    const int gt = blockIdx.x * NTHREADS + tid_opaque(), NGT = gridDim.x * NTHREADS;
    const float* po = (const float*)(a.ws + WS_PO); const float* pml = (const float*)(a.ws + WS_PML);
    const bf16_t* gate = (const bf16_t*)(a.ws + WS_SEC) + 3 * SEC_ELEMS; bf16_t* mix = (bf16_t*)(a.ws + WS_MIX);
    constexpr float C2 = LOG2E * SCALE;
    for (int item = gt; item < 128 * 256 * 16; item += NGT) {
        const int slot = item >> 12, row = (item >> 4) & 255, cg = item & 15;
        const int qb = 8 + (slot >> 4), bh = slot & 15, b = bh >> 3, h = bh & 7;
        const f32x2 ml1 = *(const f32x2*)(pml + (size_t)(slot * 2) * 512 + row * 2), ml2 = *(const f32x2*)(pml + (size_t)(slot * 2 + 1) * 512 + row * 2);
        const float M = fmaxf(ml1.x, ml2.x), a1 = __builtin_amdgcn_exp2f((ml1.x - M) * C2), a2 = __builtin_amdgcn_exp2f((ml2.x - M) * C2);
        const float inv = 1.f / (a1 * ml1.y + a2 * ml2.y);
        const float* p1 = po + (size_t)(slot * 2) * 32768 + row * 128 + cg * 8; const float* p2 = p1 + 32768;
        const f32x4 x0 = *(const f32x4*)p1, x1 = *(const f32x4*)(p1 + 4), y0 = *(const f32x4*)p2, y1 = *(const f32x4*)(p2 + 4);
        const size_t tok = (size_t)b * SEQ + qb * 256 + row;
        const u32x4 gw = *(const u32x4*)(gate + tok * 1024 + h * HD + cg * 8);
        const float w1 = a1 * inv, w2 = a2 * inv;
        u32x4 o;
        o.x = cvt_pk_bf16((w1 * x0[0] + w2 * y0[0]) * bf_lo(gw.x), (w1 * x0[1] + w2 * y0[1]) * bf_hi(gw.x));
        o.y = cvt_pk_bf16((w1 * x0[2] + w2 * y0[2]) * bf_lo(gw.y), (w1 * x0[3] + w2 * y0[3]) * bf_hi(gw.y));
        o.z = cvt_pk_bf16((w1 * x1[0] + w2 * y1[0]) * bf_lo(gw.z), (w1 * x1[1] + w2 * y1[1]) * bf_hi(gw.z));
        o.w = cvt_pk_bf16((w1 * x1[2] + w2 * y1[2]) * bf_lo(gw.w), (w1 * x1[3] + w2 * y1[3]) * bf_hi(gw.w));
        *(u32x4*)(mix + tok * DM + h * HD + cg * 8) = o;
    }
}

__device__ __forceinline__ unsigned f2ord(float f) { const unsigned u = __float_as_uint(f); return u ^ ((unsigned)((int)u >> 31) | 0x80000000u); }
__device__ __forceinline__ float ord2f(unsigned k) { const unsigned u = k ^ (~(unsigned)((int)k >> 31) | 0x80000000u); return __uint_as_float(u); }
#define INS16(L, X) do { unsigned x_ = (X); _Pragma("unroll") for (int i_ = 0; i_ < 16; ++i_) { const unsigned hi_ = max(L[i_], x_); x_ = min(L[i_], x_); L[i_] = hi_; } } while (0)
__device__ __forceinline__ void topk_half(const bf16_t* qp, const bf16_t* skb, int t0, int h, int c, int r32, int hi, unsigned (&L)[16]) {
    bf16x8 qf[8];
#pragma unroll
    for (int d0 = 0; d0 < 8; ++d0) qf[d0] = *(const bf16x8*)(qp + (size_t)(t0 + r32) * DM + h * 256 + c * 128 + d0 * 16 + hi * 8);
#pragma unroll
    for (int i = 0; i < 16; ++i) L[i] = 0u;
    const unsigned hi4 = 4u * (unsigned)hi;
#pragma unroll
    for (int kt = 0; kt < 4; ++kt) {
        f32x16 acc = f32x16{};
#pragma unroll
        for (int d0 = 0; d0 < 8; ++d0) { const bf16x8 kf = *(const bf16x8*)(skb + (size_t)((h * 2 + c) * 128 + kt * 32 + r32) * 128 + d0 * 16 + hi * 8);
            acc = __builtin_amdgcn_mfma_f32_32x32x16_bf16(kf, qf[d0], acc, 0, 0, 0); }
        __builtin_amdgcn_sched_barrier(0);
#pragma unroll
        for (int r = 0; r < 16; ++r) { const unsigned cst = (unsigned)(127 - (kt * 32 + (r & 3) + 8 * (r >> 2)));
            const unsigned kk = (f2ord(acc[r]) & ~127u) | (cst - hi4); INS16(L, kk); }
        __builtin_amdgcn_sched_barrier(0);
    }
    unsigned P[16];
#pragma unroll
    for (int i = 0; i < 16; ++i) { auto rr = __builtin_amdgcn_permlane32_swap(L[i], L[i], false, false); P[i] = hi ? rr[0] : rr[1]; }
#pragma unroll
    for (int i = 0; i < 16; ++i) INS16(L, P[i]);
}
__device__ __forceinline__ void phase_topk(const Args& a, unsigned char* lds_g) {
    LAS unsigned char* lds = (LAS unsigned char*)lds_g;
    const int tid = tid_opaque(), lane = tid & 63, wave = tid >> 6, r32 = lane & 31, hi = lane >> 5;
    const int gw = blockIdx.x * NWAVES + wave, NGW = gridDim.x * NWAVES;
    const bf16_t* skb = (const bf16_t*)(a.ws + WS_SK); const bf16_t* qp = (const bf16_t*)(a.ws + WS_QP);
    int* idx_o = (int*)(a.ws + WS_IDX); float* gw_o = (float*)(a.ws + WS_GW);
    for (int task = gw; task < (T / 32) * 8; task += NGW) {
        const int h = task & 7, t0 = (task >> 3) * 32;
        {
          const bf16_t* hbp = (const bf16_t*)(a.ws + WS_HB); const float* amx = (const float*)(a.ws + WS_AMX); unsigned char* xq = a.ws + WS_XQ;
          float am = 0.f;
          { const f32x4* ap = (const f32x4*)(amx + (size_t)(t0 + (lane & 31)) * 32);
#pragma unroll
            for (int i = 0; i < 8; ++i) { const f32x4 v = ap[i]; am = fmaxf(am, fmaxf(fmaxf(v[0], v[1]), fmaxf(v[2], v[3]))); } }
          if (h == 0 && lane < 32) ((float*)(a.ws + WS_SX))[t0 + lane] = ((const float*)(a.ws + WS_RT))[t0 + lane] * am * (1.f / 126.5f);
          const float qs = am > 0.f ? 126.5f / am : 1.f;
#pragma unroll 4
          for (int j = 0; j < 16; ++j) { const int ch = lane + 64 * j, tl = ch >> 5, tk = t0 + tl, col = h * 256 + (ch & 31) * 8;
              const u32x4 w = *(const u32x4*)(hbp + (size_t)tk * DM + col); const float r = sh_f(qs, tl);
              const int p0 = pack_i8(bf_lo(w.x) * r, bf_hi(w.x) * r, bf_lo(w.y) * r, bf_hi(w.y) * r), p1 = pack_i8(bf_lo(w.z) * r, bf_hi(w.z) * r, bf_lo(w.w) * r, bf_hi(w.w) * r);
              *(u32x2*)(xq + (size_t)tk * DM + col) = (u32x2){(unsigned)p0, (unsigned)p1}; } }
        unsigned L[2][16];
        topk_half(qp, skb, t0, h, 0, r32, hi, L[0]);
        __builtin_amdgcn_sched_barrier(0);
        topk_half(qp, skb, t0, h, 1, r32, hi, L[1]);
        __builtin_amdgcn_sched_barrier(0);
        float s1[16], s2[16]; int i1[16], i2[16];
#pragma unroll
        for (int i = 0; i < 16; ++i) { s1[i] = ord2f((L[0][i] & ~127u) | 64u); i1[i] = 127 - (int)(L[0][i] & 127u); s2[i] = ord2f((L[1][i] & ~127u) | 64u); i2[i] = 127 - (int)(L[1][i] & 127u); }
        unsigned LC[16];
#pragma unroll
        for (int i = 0; i < 16; ++i) LC[i] = 0u;
#pragma unroll
        for (int aa = 0; aa < 16; ++aa)
#pragma unroll
            for (int bb = 0; bb < 16; ++bb) if ((aa + 1) * (bb + 1) <= 16) { const unsigned kk = (f2ord(s1[aa] + s2[bb]) & ~255u) | (unsigned)(aa * 16 + bb); INS16(LC, kk); }
        LAS int* tb = (LAS int*)(lds + wave * 8192);
#pragma unroll
        for (int i = 0; i < 16; ++i) { tb[i * 64 + lane] = i1[i]; tb[(16 + i) * 64 + lane] = i2[i]; }
        float LS[16]; int LP[16];
#pragma unroll
        for (int i = 0; i < 16; ++i) { const unsigned cid = LC[i] & 255u; LS[i] = ord2f((LC[i] & ~255u) | 128u);
            LP[i] = tb[(cid >> 4) * 64 + lane] * 128 + tb[(16 + (cid & 15u)) * 64 + lane]; }
        float den = 0.f, e[16];
#pragma unroll
        for (int i = 0; i < 16; ++i) { e[i] = __expf(LS[i] - LS[0]); den += e[i]; }
        const float rden = 1.f / den;
        const size_t ob = (size_t)(t0 + r32) * NE + h * 16;
        if (hi == 0) {
#pragma unroll
            for (int i = 0; i < 4; ++i) *(int4*)(idx_o + ob + 4 * i) = make_int4(LP[4 * i], LP[4 * i + 1], LP[4 * i + 2], LP[4 * i + 3]);
        } else {
#pragma unroll
            for (int i = 0; i < 4; ++i) *(f32x4*)(gw_o + ob + 4 * i) = (f32x4){e[4 * i] * rden, e[4 * i + 1] * rden, e[4 * i + 2] * rden, e[4 * i + 3] * rden};
        }
    }
}


__device__ __forceinline__ void wave_argmax(float& v, int& i) {
#pragma unroll
    for (int o = 1; o < 64; o <<= 1) { const float ov = sx_f(v, o); const int oi = sx_i(i, o); if (ov > v || (ov == v && oi < i)) { v = ov; i = oi; } }
}
__device__ __forceinline__ void phase_topk_ref(const Args& a) {
    const int tid = tid_opaque(), lane = tid & 63, wave = tid >> 6;
    const int gw = blockIdx.x * NWAVES + wave, NGW = gridDim.x * NWAVES;
    const bf16_t* skb = (const bf16_t*)(a.ws + WS_SK); const bf16_t* qp = (const bf16_t*)(a.ws + WS_QP);
    int* idx_o = (int*)(a.ws + WS_IDX); float* gw_o = (float*)(a.ws + WS_GW);
    for (int task = gw; task < T * 8; task += NGW) {
        const int t = task >> 3, h = task & 7;
        float topS[2]; int topI[2];
        for (int c = 0; c < 2; ++c) {
            const bf16_t* q = qp + (size_t)t * DM + h * 256 + c * 128;
            float sc0 = 0.f, sc1 = 0.f;
            const bf16_t* k0 = skb + (size_t)((h * 2 + c) * 128 + lane) * 128; const bf16_t* k1 = k0 + 64 * 128;
            for (int d = 0; d < 128; ++d) { const float qd = __uint_as_float((unsigned)q[d] << 16);
                sc0 += qd * __uint_as_float((unsigned)k0[d] << 16); sc1 += qd * __uint_as_float((unsigned)k1[d] << 16); }
            float ms = 0.f; int mi = 0;
            for (int r = 0; r < 16; ++r) {
                float v; int i; if (sc0 >= sc1) { v = sc0; i = lane; } else { v = sc1; i = lane + 64; }
                wave_argmax(v, i);
                if (lane == r) { ms = v; mi = i; }
                if (i == lane) sc0 = -__builtin_inff();
                if (i == lane + 64) sc1 = -__builtin_inff();
            }
            topS[c] = ms; topI[c] = mi;
        }
        float cs[4]; int ci[4];
#pragma unroll
        for (int j = 0; j < 4; ++j) { const int cidx = lane * 4 + j, aa = cidx >> 4, bb = cidx & 15;
            cs[j] = sh_f(topS[0], aa) + sh_f(topS[1], bb); ci[j] = cidx; }
        float fs = 0.f; int fi = 0;
        for (int r = 0; r < 16; ++r) {
            float v = cs[0]; int i = ci[0];
#pragma unroll
            for (int j = 1; j < 4; ++j) if (cs[j] > v) { v = cs[j]; i = ci[j]; }
            wave_argmax(v, i);
            if (lane == r) { fs = v; fi = i; }
#pragma unroll
            for (int j = 0; j < 4; ++j) if (ci[j] == i) cs[j] = -__builtin_inff();
        }
        const int e1 = sh_i(topI[0], fi >> 4), e2 = sh_i(topI[1], fi & 15);
        const float mx = sh_f(fs, 0);
        float ev = lane < 16 ? __expf(fs - mx) : 0.f;
        const float den = wave_sum(ev);
        if (lane < 16) { idx_o[(size_t)t * NE + h * 16 + lane] = e1 * 128 + e2; gw_o[(size_t)t * NE + h * 16 + lane] = ev / den; }
    }
}

__device__ __forceinline__ void fp8x16_to_f32(const u32x4 q, f32x2 (&o)[8]) {
    o[0] = __builtin_amdgcn_cvt_pk_f32_fp8((int)q.x, false); o[1] = __builtin_amdgcn_cvt_pk_f32_fp8((int)q.x, true);
    o[2] = __builtin_amdgcn_cvt_pk_f32_fp8((int)q.y, false); o[3] = __builtin_amdgcn_cvt_pk_f32_fp8((int)q.y, true);
    o[4] = __builtin_amdgcn_cvt_pk_f32_fp8((int)q.z, false); o[5] = __builtin_amdgcn_cvt_pk_f32_fp8((int)q.z, true);
    o[6] = __builtin_amdgcn_cvt_pk_f32_fp8((int)q.w, false); o[7] = __builtin_amdgcn_cvt_pk_f32_fp8((int)q.w, true);
}
#define HALVE(dst, srcv, n, bitmask) do { const bool up_ = (lane & (bitmask)) != 0; _Pragma("unroll") for (int i_ = 0; i_ < (n); ++i_) { \
        const float keep_ = up_ ? srcv[(n) + i_] : srcv[i_], send_ = up_ ? srcv[i_] : srcv[(n) + i_]; dst[i_] = keep_ + sx_f(send_, (bitmask)); } } while (0)
#define ITEM_T(n) (wv + ((n) % KT) * NWX)
#define ITEM_S(n) (xl + 8 * ((n) / KT))
#define LD_IDX(ID, n) do { const int4* ip_ = (const int4*)(idx_i + (size_t)ITEM_T(n) * NE + g * 16); _Pragma("unroll") for (int i_ = 0; i_ < 4; ++i_) ID[i_] = ip_[i_]; } while (0)
#define LD_ROWS(Q, ID, TAB, n) do { const unsigned char* b_ = (TAB) + (size_t)ITEM_S(n) * ((size_t)NEXP * 128) + c * 16; _Pragma("unroll") for (int i_ = 0; i_ < 4; ++i_) { \
        Q[4 * i_] = *(const u32x4*)(b_ + (size_t)ID[i_].x * 128); Q[4 * i_ + 1] = *(const u32x4*)(b_ + (size_t)ID[i_].y * 128); \
        Q[4 * i_ + 2] = *(const u32x4*)(b_ + (size_t)ID[i_].z * 128); Q[4 * i_ + 3] = *(const u32x4*)(b_ + (size_t)ID[i_].w * 128); } } while (0)
__device__ __forceinline__ int dpp_hmirror(int v) { return __builtin_amdgcn_update_dpp(0, v, 0x141, 0xf, 0xf, true); }
__device__ __forceinline__ int dpp_qxor2(int v) { return __builtin_amdgcn_update_dpp(0, v, 0x4E, 0xf, 0xf, true); }
__device__ __forceinline__ int dpp_qxor1(int v) { return __builtin_amdgcn_update_dpp(0, v, 0xB1, 0xf, 0xf, true); }
__device__ __forceinline__ void phase_peer_u(const Args& a) {
    const int tid = tid_opaque(), lane = tid & 63, wave = tid >> 6, g = lane >> 3, c = lane & 7;
    const int xl = blockIdx.x & 7, wv = (blockIdx.x >> 3) * NWAVES + wave, NWX = (gridDim.x >> 3) * NWAVES, KT = T / NWX, N = 2 * KT;
    const unsigned char* xq = a.ws + WS_XQ; const unsigned char* u8 = a.ws + WS_U8;
    const int* idx_i = (const int*)(a.ws + WS_IDX); float* part = (float*)(a.ws + WS_PART);
    const bool up4 = (c & 4) != 0, up2 = (c & 2) != 0, up1 = (c & 1) != 0;
#define LD_X(X, n) do { X = *(const u32x4*)(xq + (size_t)ITEM_T(n) * DM + ITEM_S(n) * 128 + c * 16); } while (0)
#define COMPUTE_U(Q, X, n) do { int p[16]; \
        _Pragma("unroll") for (int i = 0; i < 16; ++i) { int d_ = __builtin_amdgcn_sdot4((int)Q[i].x, (int)X.x, 0, false); d_ = __builtin_amdgcn_sdot4((int)Q[i].y, (int)X.y, d_, false); \
            d_ = __builtin_amdgcn_sdot4((int)Q[i].z, (int)X.z, d_, false); p[i] = __builtin_amdgcn_sdot4((int)Q[i].w, (int)X.w, d_, false); } \
        int p8[8], p4[4], p2[2]; \
        _Pragma("unroll") for (int i = 0; i < 8; ++i) { const int keep_ = up4 ? p[8 + i] : p[i], send_ = up4 ? p[i] : p[8 + i]; p8[i] = keep_ + dpp_hmirror(send_); } \
        _Pragma("unroll") for (int i = 0; i < 4; ++i) { const int keep_ = up2 ? p8[4 + i] : p8[i], send_ = up2 ? p8[i] : p8[4 + i]; p4[i] = keep_ + dpp_qxor2(send_); } \
        _Pragma("unroll") for (int i = 0; i < 2; ++i) { const int keep_ = up1 ? p4[2 + i] : p4[i], send_ = up1 ? p4[i] : p4[2 + i]; p2[i] = keep_ + dpp_qxor1(send_); } \
        *(f32x2*)(part + ((size_t)ITEM_T(n) * 16 + ITEM_S(n)) * NE + 2 * lane) = (f32x2){(float)p2[0], (float)p2[1]}; } while (0)
    int4 IA[4], IB[4]; u32x4 QA[16], QB[16], XA, XB;
    LD_IDX(IA, 0); LD_IDX(IB, 1);
    LD_ROWS(QA, IA, u8, 0); LD_X(XA, 0);
    for (int n = 0; n < N; n += 2) {
        LD_ROWS(QB, IB, u8, n + 1); LD_X(XB, n + 1);
        if (n + 2 < N) LD_IDX(IA, n + 2);
        COMPUTE_U(QA, XA, n);
        if (n + 2 < N) { LD_ROWS(QA, IA, u8, n + 2); LD_X(XA, n + 2); }
        if (n + 3 < N) LD_IDX(IB, n + 3);
        COMPUTE_U(QB, XB, n + 1);
    }
#undef LD_X
#undef COMPUTE_U
}
__device__ __forceinline__ void phase_peer_w(const Args& a) {
    const int gt = blockIdx.x * NTHREADS + tid_opaque(), NGT = gridDim.x * NTHREADS;
    const int* idx_i = (const int*)(a.ws + WS_IDX); const float* gw_i = (const float*)(a.ws + WS_GW); const float* part = (const float*)(a.ws + WS_PART);
    const float* suv = (const float*)(a.ws + WS_SUV); const float* sx = (const float*)(a.ws + WS_SX);
    signed char* wq = (signed char*)(a.ws + WS_WQ); float* sw = (float*)(a.ws + WS_SW);
    for (int item = gt; item < T * NE; item += NGT) {
        const int t = item >> 7, e = item & 127;
        float sum = 0.f;
#pragma unroll
        for (int s = 0; s < 16; ++s) sum += part[((size_t)t * 16 + s) * NE + e];
        const int ex = idx_i[item];
        const float d = sum * suv[ex] * sx[t];
        const float om = 0.5f * d * (1.f + erff(d * 0.70710678118654752f)) * gw_i[item] * suv[NEXP + ex];
        float mx = fabsf(om);
        mx = fmaxf(mx, sx_f(mx, 1)); mx = fmaxf(mx, sx_f(mx, 2)); mx = fmaxf(mx, sx_f(mx, 4)); mx = fmaxf(mx, sx_f(mx, 8));
        const float qs = mx > 0.f ? 127.f / mx : 1.f;
        wq[item] = (signed char)(int)__builtin_rintf(om * qs);
        if ((e & 15) == 0) sw[t * 8 + (e >> 4)] = mx * (1.f / 127.f);
    }
}
__device__ __forceinline__ void phase_peer_v(const Args& a, float* dst) {
    const int tid = tid_opaque(), lane = tid & 63, wave = tid >> 6, g = lane >> 3, c = lane & 7;
    const int xl = blockIdx.x & 7, wv = (blockIdx.x >> 3) * NWAVES + wave, NWX = (gridDim.x >> 3) * NWAVES, KT = T / NWX, N = 2 * KT;
    const unsigned char* v8 = a.ws + WS_V8;
    const int* idx_i = (const int*)(a.ws + WS_IDX); const unsigned char* wq = a.ws + WS_WQ; const float* sw = (const float*)(a.ws + WS_SW);
    const float* hsrc = a.out;
#define LD_W(W, SWV, n) do { W = *(const u32x4*)(wq + (size_t)ITEM_T(n) * NE + g * 16); SWV = sw[ITEM_T(n) * 8 + g]; } while (0)
#define QUAD(A_, B_, C_, D_, W_, A0, A1, A2, A3) do { \
        const unsigned ablo_ = __builtin_amdgcn_perm(B_, A_, 0x05010400u), abhi_ = __builtin_amdgcn_perm(B_, A_, 0x07030602u); \
        const unsigned cdlo_ = __builtin_amdgcn_perm(D_, C_, 0x05010400u), cdhi_ = __builtin_amdgcn_perm(D_, C_, 0x07030602u); \
        A0 = __builtin_amdgcn_sdot4((int)__builtin_amdgcn_perm(cdlo_, ablo_, 0x05040100u), (int)(W_), A0, false); \
        A1 = __builtin_amdgcn_sdot4((int)__builtin_amdgcn_perm(cdlo_, ablo_, 0x07060302u), (int)(W_), A1, false); \
        A2 = __builtin_amdgcn_sdot4((int)__builtin_amdgcn_perm(cdhi_, abhi_, 0x05040100u), (int)(W_), A2, false); \
        A3 = __builtin_amdgcn_sdot4((int)__builtin_amdgcn_perm(cdhi_, abhi_, 0x07060302u), (int)(W_), A3, false); } while (0)
#define COMPUTE_V(Q, W, SWV, n) do { int ac[16]; _Pragma("unroll") for (int k = 0; k < 16; ++k) ac[k] = 0; \
        _Pragma("unroll") for (int q_ = 0; q_ < 4; ++q_) { const unsigned w_ = q_ == 0 ? W.x : q_ == 1 ? W.y : q_ == 2 ? W.z : W.w; \
            QUAD(Q[4 * q_].x, Q[4 * q_ + 1].x, Q[4 * q_ + 2].x, Q[4 * q_ + 3].x, w_, ac[0], ac[1], ac[2], ac[3]); \
            QUAD(Q[4 * q_].y, Q[4 * q_ + 1].y, Q[4 * q_ + 2].y, Q[4 * q_ + 3].y, w_, ac[4], ac[5], ac[6], ac[7]); \
            QUAD(Q[4 * q_].z, Q[4 * q_ + 1].z, Q[4 * q_ + 2].z, Q[4 * q_ + 3].z, w_, ac[8], ac[9], ac[10], ac[11]); \
            QUAD(Q[4 * q_].w, Q[4 * q_ + 1].w, Q[4 * q_ + 2].w, Q[4 * q_ + 3].w, w_, ac[12], ac[13], ac[14], ac[15]); } \
        float p[16]; _Pragma("unroll") for (int k = 0; k < 16; ++k) p[k] = (float)ac[k] * SWV; \
        float p8[8], p4[4], p2[2]; \
        _Pragma("unroll") for (int i_ = 0; i_ < 8; ++i_) { auto rr_ = __builtin_amdgcn_permlane32_swap(__float_as_uint(p[i_]), __float_as_uint(p[8 + i_]), false, false); p8[i_] = __uint_as_float(rr_[0]) + __uint_as_float(rr_[1]); } \
        _Pragma("unroll") for (int i_ = 0; i_ < 4; ++i_) { auto rr_ = __builtin_amdgcn_permlane16_swap(__float_as_uint(p8[i_]), __float_as_uint(p8[4 + i_]), false, false); p4[i_] = __uint_as_float(rr_[0]) + __uint_as_float(rr_[1]); } \
        HALVE(p2, p4, 2, 8); \
        const size_t o_ = (size_t)ITEM_T(n) * DM + ITEM_S(n) * 128 + c * 16 + 2 * g; \
        const f32x2 hv = *(const f32x2*)(hsrc + o_); *(f32x2*)(dst + o_) = (f32x2){hv.x + p2[0], hv.y + p2[1]}; } while (0)
    int4 IA[4], IB[4]; u32x4 QA[16], QB[16], WA, WB; float SA, SB_;
    LD_IDX(IA, 0); LD_IDX(IB, 1);
    LD_ROWS(QA, IA, v8, 0); LD_W(WA, SA, 0);
    for (int n = 0; n < N; n += 2) {
        LD_ROWS(QB, IB, v8, n + 1); LD_W(WB, SB_, n + 1);
        if (n + 2 < N) LD_IDX(IA, n + 2);
        COMPUTE_V(QA, WA, SA, n);
        if (n + 2 < N) { LD_ROWS(QA, IA, v8, n + 2); LD_W(WA, SA, n + 2); }
        if (n + 3 < N) LD_IDX(IB, n + 3);
        COMPUTE_V(QB, WB, SB_, n + 1);
    }
#undef LD_W
#undef QUAD
#undef COMPUTE_V
}
#undef ITEM_T
#undef ITEM_S
#undef LD_IDX
#undef LD_ROWS
#undef HALVE


constexpr int NPHASE = 11;
#define LOAD_ARGS() do { } while (0)
__global__ void __launch_bounds__(NTHREADS, 2) fwd_kernel(Args a) {
    extern __shared__ __attribute__((aligned(16))) unsigned char lds[];
#if MK_ONE_LAUNCH
    constexpr int lo = 0, hi = NPHASE;
    cg::grid_group grid = cg::this_grid();
    volatile LAS unsigned* misc = (volatile LAS unsigned*)((LAS unsigned char*)lds + MISC_OFF);
    if (threadIdx.x < 16) misc[threadIdx.x] = 0u;
    __syncthreads();
    { LOAD_ARGS(); (void)xcd_barrier_post((unsigned*)(a.ws + WS_CTL) + CW_BAR, misc + 8); }
#ifndef SEAM_CG_MASK
#define SEAM_CG_MASK 0
#endif
#define SEAM(k) do { if (lo <= (k) && (k) + 1 < hi) { if ((SEAM_CG_MASK >> (k)) & 1) grid.sync(); else { LOAD_ARGS(); XcdBarrier xb_; xb_.bar = (unsigned*)(a.ws + WS_CTL) + CW_BAR; xb_.x = xb_xcc_id(); \
        xb_.st = (volatile LAS unsigned*)((LAS unsigned char*)lds + MISC_OFF) + 8; xcd_barrier(xb_); } } } while (0)
#else
    int lo, hi; { LOAD_ARGS(); lo = a.ph_lo; hi = a.ph_hi; }
#define SEAM(k) do { } while (0)
#endif
#define IN(k) (lo <= (k) && (k) < hi)
#ifndef DUP_PHASE
#define DUP_PHASE -1
#endif
    if (IN(0)) { LOAD_ARGS(); phase0(a, lds); if (DUP_PHASE == 0) { __syncthreads(); phase0(a, lds); } SEAM(0); }
    if (IN(1)) { LOAD_ARGS(); unsigned char* ws = a.ws;
        cumsum_rows(a);
        pg8::Gemm g{(const bf16_t*)(ws + WS_XN), (const bf16_t*)(ws + WS_WIN), T, NPROJ, DM}; pg8::StaticOrder S; S.init(T, NPROJ, (int)gridDim.x, (int)blockIdx.x);
        pg8::EpiInProj E{(bf16_t*)(ws + WS_SEC), (const float*)(ws + WS_SXN), (const float*)(ws + WS_WSC), a.in[4], a.in[5], (LAS float*)((LAS unsigned char*)lds + RING_BYTES)};
        for (int rep_ = 0; rep_ < (DUP_PHASE == 1 ? 2 : 1); ++rep_)
        pg8::gemm_phase<pg8::EpiInProj, pg8::StaticOrder, true, true, true>((LAS unsigned char*)lds, g, S, E);
        { const int nwg_ = (T / 256) * (NPROJ / 256), G_ = (int)gridDim.x, rem_ = nwg_ % G_;
          if (rem_ > 0 && (int)blockIdx.x >= rem_) convert_tables(a, TAB_SPLIT, 2 * NEXP, ((int)blockIdx.x - rem_) * NWAVES + (tid_opaque() >> 6), (G_ - rem_) * NWAVES);
          else if (rem_ == 0) convert_tables(a, TAB_SPLIT, 2 * NEXP, (int)blockIdx.x * NWAVES + (tid_opaque() >> 6), G_ * NWAVES); }
        SEAM(1);
    }
    if (IN(3)) { LOAD_ARGS(); phase_attn(a, lds);
#if MK_ONE_LAUNCH
        if (DUP_PHASE == 3) { XcdBarrier xb_; xb_.bar = (unsigned*)(a.ws + WS_CTL) + CW_BAR; xb_.x = xb_xcc_id(); xb_.st = (volatile LAS unsigned*)((LAS unsigned char*)lds + MISC_OFF) + 8;
            xcd_barrier(xb_); if (blockIdx.x == 0 && threadIdx.x == 0) __hip_atomic_store((unsigned*)(a.ws + WS_CTL), 0u, __ATOMIC_RELAXED, __HIP_MEMORY_SCOPE_AGENT); xcd_barrier(xb_); phase_attn(a, lds); }
#endif
        SEAM(3); }
    if (IN(4)) { LOAD_ARGS(); phase_attn_combine(a); SEAM(4); }
    if (IN(5)) { LOAD_ARGS(); unsigned char* ws = a.ws;
        pg8::Gemm g{(const bf16_t*)(ws + WS_MIX), (const bf16_t*)(ws + WS_WOUT), T, DM, DM}; pg8::StaticOrder S; S.init(T, DM, (int)gridDim.x, (int)blockIdx.x);
        pg8::EpiOutProj E{a.in[0], a.out, (bf16_t*)(ws + WS_HB), (float*)(ws + WS_SSQ), (float*)(ws + WS_AMX)};
        for (int rep_ = 0; rep_ < (DUP_PHASE == 5 ? 2 : 1); ++rep_)
        pg8::gemm_phase<pg8::EpiOutProj, pg8::StaticOrder, true, true>((LAS unsigned char*)lds, g, S, E);
        SEAM(5);
    }
    if (IN(6)) { LOAD_ARGS(); unsigned char* ws = a.ws;
        pg8::Gemm g{(const bf16_t*)(ws + WS_HB), (const bf16_t*)(ws + WS_WPQ), T, DM, DM}; pg8::StaticOrder S; S.init(T, DM, (int)gridDim.x, (int)blockIdx.x);
        pg8::EpiPeerQ E{(const float*)(ws + WS_SSQ), (bf16_t*)(ws + WS_QP), (float*)(ws + WS_RT)};
        for (int rep_ = 0; rep_ < (DUP_PHASE == 6 ? 2 : 1); ++rep_)
        pg8::gemm_phase<pg8::EpiPeerQ, pg8::StaticOrder, true, true>((LAS unsigned char*)lds, g, S, E);
        SEAM(6);
    }
    #ifdef TOPK_REF
    if (IN(7)) { LOAD_ARGS(); phase_topk_ref(a); SEAM(7); }
#else
    if (IN(7)) { LOAD_ARGS(); for (int rep_ = 0; rep_ < (DUP_PHASE == 7 ? 2 : 1); ++rep_) phase_topk(a, lds); SEAM(7); }
#endif
    if (IN(8)) { LOAD_ARGS(); for (int rep_ = 0; rep_ < (DUP_PHASE == 8 ? 2 : 1); ++rep_) phase_peer_u(a); SEAM(8); }
    if (IN(9)) { LOAD_ARGS(); for (int rep_ = 0; rep_ < (DUP_PHASE == 9 ? 2 : 1); ++rep_) phase_peer_w(a); SEAM(9); }
    if (IN(10)) { LOAD_ARGS(); for (int rep_ = 0; rep_ < (DUP_PHASE == 10 ? 2 : 1); ++rep_) phase_peer_v(a, (DUP_PHASE == 10 && rep_ == 0) ? (float*)(a.ws + WS_END) : a.out); }
#undef IN
#undef SEAM
}

extern "C" void kernel_launch(void* const* d_in, const int* in_sizes, int n_in, void* d_out, int out_size, void* d_ws, size_t ws_size, hipStream_t stream) {
    static int grid = 0;
    if (grid == 0) {
        if (n_in != 12 || in_sizes[0] != T * DM || out_size != T * DM || ws_size < WS_END) { fprintf(stderr, "kernel_launch: unexpected shapes (n_in %d, in0 %d, out %d, ws %zu)\n", n_in, n_in > 0 ? in_sizes[0] : -1, out_size, ws_size); grid = -1; return; }
        int dev = 0, cus = 0, per_cu = 0;
        if (hipGetDevice(&dev) != hipSuccess || hipDeviceGetAttribute(&cus, hipDeviceAttributeMultiprocessorCount, dev) != hipSuccess) { grid = -1; return; }
        if (hipFuncSetAttribute((const void*)fwd_kernel, hipFuncAttributeMaxDynamicSharedMemorySize, LDS_BYTES) != hipSuccess) { fprintf(stderr, "kernel_launch: hipFuncSetAttribute failed\n"); grid = -1; return; }
        if (hipOccupancyMaxActiveBlocksPerMultiprocessor(&per_cu, (const void*)fwd_kernel, NTHREADS, LDS_BYTES) != hipSuccess || per_cu < 1) { fprintf(stderr, "kernel_launch: occupancy query says %d\n", per_cu); grid = -1; return; }
        grid = cus;
    }
    if (grid < 0) return;
    (void)hipMemsetAsync((char*)d_ws + WS_CTL, 0, CTL_BYTES, stream);
    Args a{};
    for (int i = 0; i < 12; ++i) a.in[i] = (const float*)d_in[i];
    a.out = (float*)d_out; a.ws = (unsigned char*)d_ws;
#if MK_ONE_LAUNCH
    a.ph_lo = 0; a.ph_hi = NPHASE;
    void* args[] = {&a};
#if MK_COOP_LAUNCH
    hipError_t e = hipLaunchCooperativeKernel((const void*)fwd_kernel, dim3(grid), dim3(NTHREADS), args, LDS_BYTES, stream);
    if (e != hipSuccess) fprintf(stderr, "cooperative launch failed: %s (grid %d)\n", hipGetErrorString(e), grid);
#else
    (void)args; hipLaunchKernelGGL(fwd_kernel, dim3(grid), dim3(NTHREADS), LDS_BYTES, stream, a);
#endif
#else
    for (int p = 0; p < NPHASE; ++p) { a.ph_lo = p; a.ph_hi = p + 1; hipLaunchKernelGGL(fwd_kernel, dim3(grid), dim3(NTHREADS), LDS_BYTES, stream, a); }
#endif
}
```

```cpp
#include <hip/hip_runtime.h>
#include <hip/hip_cooperative_groups.h>
#include <cstdio>
#include <cstdint>
namespace cg = cooperative_groups;

#ifndef MK_COOP_LAUNCH
#define MK_COOP_LAUNCH 0
#endif
#ifndef MK_ONE_LAUNCH
#define MK_ONE_LAUNCH 1
#endif

#define LAS __attribute__((address_space(3)))
typedef unsigned short bf16_t;
typedef short bf16x8 __attribute__((ext_vector_type(8)));
typedef short s16x4 __attribute__((ext_vector_type(4)));
typedef float f32x2 __attribute__((ext_vector_type(2)));
typedef float f32x4 __attribute__((ext_vector_type(4)));
typedef float f32x16 __attribute__((ext_vector_type(16)));
typedef unsigned u32x2 __attribute__((ext_vector_type(2)));
typedef unsigned u32x4 __attribute__((ext_vector_type(4)));
typedef __bf16 bf16x2_t __attribute__((ext_vector_type(2)));

constexpr int NB = 2, SEQ = 4096, T = NB * SEQ, DM = 2048, HD = 128, NHF = 8, DIN = 7176, NPROJ = 7168;
constexpr int NEXP = 16384, NE = 128;
constexpr float EPS = 1e-6f;
constexpr float SCALE = 0.08838834764831845f, LOG2E = 1.4426950408889634f;
constexpr int NWAVES = 8, NTHREADS = 512;

constexpr size_t MiB = 1u << 20;
constexpr size_t WS_CTL = 0, CTL_BYTES = 32768;
constexpr int CW_BAR = 1024;
constexpr size_t WS_SXN = 64 * MiB  , WS_WSC = 45 * MiB + 800 * 1024  ;
constexpr int CW_WMAX = 64;
constexpr size_t WS_GQK = 45 * MiB + 768 * 1024;
constexpr size_t WS_WIN = 1 * MiB, WS_WOUT = 29 * MiB, WS_WPQ = 37 * MiB, WS_SK = 45 * MiB, WS_LOGF = 46 * MiB, WS_C = 46 * MiB + 512 * 1024, WS_SSQ = 47 * MiB;
constexpr size_t WS_XN = 48 * MiB;
constexpr size_t WS_SEC = 80 * MiB;
constexpr size_t SEC_ELEMS = 8u << 20;
constexpr size_t WS_MIX = 192 * MiB, WS_HB = 224 * MiB, WS_QP = 256 * MiB, WS_IDX = 288 * MiB, WS_GW = 292 * MiB, WS_U8 = 296 * MiB, WS_V8 = 328 * MiB, WS_SUV = 360 * MiB  , WS_RT = 360 * MiB + 256 * 1024  , WS_W = 361 * MiB  ,
                 WS_PART = 368 * MiB  , WS_XQ = 432 * MiB  , WS_END = 448 * MiB;
constexpr size_t WS_AMX = 365 * MiB  , WS_SX = WS_RT + 64 * 1024  , WS_WQ = WS_W  , WS_SW = WS_W + 2 * MiB  ;
constexpr size_t WS_PO = WS_PART  , WS_PML = WS_PART + 32 * MiB  ;

constexpr int RING_BYTES = 131072;
constexpr int MISC_OFF = 143360;
constexpr int LDS_BYTES = 147456;

__device__ __forceinline__ unsigned cvt_pk_bf16(float lo, float hi) { unsigned r; asm volatile("v_cvt_pk_bf16_f32 %0, %1, %2" : "=v"(r) : "v"(lo), "v"(hi)); return r; }
__device__ __forceinline__ float bf_lo(unsigned u) { return __builtin_bit_cast(float, u << 16); }
__device__ __forceinline__ float bf_hi(unsigned u) { return __builtin_bit_cast(float, u & 0xffff0000u); }
__device__ __forceinline__ int lane_id_fresh() { int l = (int)__builtin_amdgcn_mbcnt_hi(~0u, __builtin_amdgcn_mbcnt_lo(~0u, 0u)); asm volatile("" : "+v"(l)); return l; }
__device__ __forceinline__ int sx_i(int v, int m) { return __builtin_amdgcn_ds_bpermute((lane_id_fresh() ^ m) << 2, v); }
__device__ __forceinline__ float sx_f(float v, int m) { return __int_as_float(__builtin_amdgcn_ds_bpermute((lane_id_fresh() ^ m) << 2, __float_as_int(v))); }
__device__ __forceinline__ int sh_i(int v, int src) { return __builtin_amdgcn_ds_bpermute(src << 2, v); }
__device__ __forceinline__ float sh_f(float v, int src) { return __int_as_float(__builtin_amdgcn_ds_bpermute(src << 2, __float_as_int(v))); }
__device__ __forceinline__ float shup_f(float v, int d) { const int l = lane_id_fresh(); const int s = l - d; return __int_as_float(__builtin_amdgcn_ds_bpermute((s < 0 ? l : s) << 2, __float_as_int(v))); }
__device__ __forceinline__ float wave_sum(float v) {
#pragma unroll
    for (int o = 1; o < 64; o <<= 1) v += sx_f(v, o);
    return v;
}
__device__ __forceinline__ float wave_max(float v) {
#pragma unroll
    for (int o = 1; o < 64; o <<= 1) v = fmaxf(v, sx_f(v, o));
    return v;
}
__device__ __forceinline__ int tid_opaque() { int t = (int)threadIdx.x; asm volatile("" : "+v"(t)); return t; }
#define LDS_WAIT() asm volatile("s_waitcnt lgkmcnt(0)" ::: "memory")

namespace pg8 {
#define PG8_LAS __attribute__((address_space(3)))
constexpr int BM = 256, BK = 64, HALF = 128, HTB = HALF * BK * 2, STAGE_BYTES = 8 * HTB, NXCD = 8, WGM = 8;
__host__ __device__ __forceinline__ int lds_byte(int r, int c) { const int st = (r >> 4) * 2 + (c >> 5), rr = r & 15, cc = c & 31, ob = rr * 64 + cc * 2; return st * 1024 + (ob ^ (((ob >> 9) & 1) << 5)); }
__host__ __device__ __forceinline__ void stage_rc(int b, int& R, int& C) { const int st = b / 1024, sb = b % 1024, swz = sb ^ (((sb >> 9) & 1) << 5); R = (st >> 1) * 16 + swz / 64; C = (st & 1) * 32 + (swz % 64) / 2; }
__host__ __device__ __forceinline__ int perm32(int rho) { const int n = rho >> 4, i = rho & 15; return 8 * (i >> 2) + 4 * n + (i & 3); }
struct Unit { int pm, pn; };
struct Gemm { const bf16_t* A; const bf16_t* Bt; int M, N, K; };
struct StaticOrder {
    int nM, nN, nwg, G, c;
    __host__ __device__ void init(int M, int N, int G_, int c_) { nM = M / BM; nN = N / BM; nwg = nM * nN; G = G_; c = c_; }
    __host__ __device__ bool next(int i, Unit& u) const {
        const long L = (long)i * G + c; if (L >= nwg) return false;
        int wgid = (int)L; { const int q = nwg / NXCD, r = nwg % NXCD, xcd = wgid % NXCD, off = wgid / NXCD; wgid = (xcd < r ? xcd * (q + 1) : r * (q + 1) + (xcd - r) * q) + off; }
        const int nig = WGM * nN, gid = wgid / nig, fm = gid * WGM, gsz = (nM - fm) < WGM ? (nM - fm) : WGM;
        u.pm = fm + ((wgid % nig) % gsz); u.pn = (wgid % nig) / gsz; return true;
    }
    __device__ __forceinline__ void a_ready(const Unit&) const {}
    __device__ __forceinline__ void done(const Unit&) const {}
};

typedef int i32x4 __attribute__((ext_vector_type(4)));
template <bool I8> struct AccT { typedef f32x4 type; };
template <> struct AccT<true> { typedef i32x4 type; };
template <class Epi, class Sched, bool ALIGN_EPI = false, bool SP2 = false, bool I8 = false>
__device__ __forceinline__ void gemm_phase(PG8_LAS unsigned char* lds, const Gemm g, const Sched& S, const Epi& E) {
    typedef typename AccT<I8>::type acc_t;
    const int tid = tid_opaque(), wid = __builtin_amdgcn_readfirstlane(tid >> 6), lane = tid & 63, wr = wid >> 2, wc = wid & 3, fr = lane & 15, fq = lane >> 4;
    const int rowb = I8 ? g.K : 2 * g.K, nt = rowb / (BK * 2);
    unsigned voffA[2], voffB[2];
#pragma unroll
    for (int i = 0; i < 2; ++i) { int R, C; stage_rc(tid * 16 + i * 8192, R, C); const int Rb = Epi::PERM ? ((R & ~31) + perm32(R & 31)) : R;
        voffA[i] = (unsigned)(R * rowb + C * 2); voffB[i] = (unsigned)(Rb * rowb + C * 2); }
    const size_t kstep = (size_t)(BK * 2);
    const size_t hstep = (size_t)HALF * rowb;
    const size_t tstep = 2 * hstep;
    const unsigned ldsw = (unsigned)wid * 1024u;
    const int aoff = lds_byte(wr * 64 + fr, fq * 8), boff = lds_byte(wc * 32 + fr, fq * 8);
#define PG8_SA(b, h) (((b) * 2 + (h)) * HTB)
#define PG8_SB(b, h) ((4 + (b) * 2 + (h)) * HTB)
#define PG8_STAGE(bufoff, gbase, voff) do { _Pragma("unroll") for (int _i = 0; _i < 2; ++_i) \
        __builtin_amdgcn_global_load_lds((const unsigned*)((const char*)(gbase) + (voff)[_i]), (PG8_LAS unsigned*)(lds + (bufoff) + ldsw + _i * 8192), 16, 0, 0); } while (0)
#define PG8_LDA(dst, b, h) do { _Pragma("unroll") for (int m = 0; m < 4; ++m) _Pragma("unroll") for (int k = 0; k < 2; ++k) dst[m][k] = *(const PG8_LAS bf16x8*)(lds + PG8_SA(b, h) + aoff + m * 2048 + k * 1024); } while (0)
#define PG8_LDB(dst, b, h) do { _Pragma("unroll") for (int n = 0; n < 2; ++n) _Pragma("unroll") for (int k = 0; k < 2; ++k) dst[n][k] = *(const PG8_LAS bf16x8*)(lds + PG8_SB(b, h) + boff + n * 2048 + k * 1024); } while (0)
#define PG8_MMA(ai, bj, At, Bt) do { __builtin_amdgcn_s_setprio(1); _Pragma("unroll") for (int m = 0; m < 4; ++m) _Pragma("unroll") for (int n = 0; n < 2; ++n) _Pragma("unroll") for (int k = 0; k < 2; ++k) \
        { if constexpr (I8) acc[ai][bj][m][n] = __builtin_amdgcn_mfma_i32_16x16x64_i8(__builtin_bit_cast(i32x4, Bt[n][k]), __builtin_bit_cast(i32x4, At[m][k]), acc[ai][bj][m][n], 0, 0, 0); \
          else acc[ai][bj][m][n] = __builtin_amdgcn_mfma_f32_16x16x32_bf16(Bt[n][k], At[m][k], acc[ai][bj][m][n], 0, 0, 0); } __builtin_amdgcn_s_setprio(0); } while (0)
#define PG8_WAIT_V(n) asm volatile("s_waitcnt vmcnt(" #n ")" ::: "memory")
#define PG8_WAIT_L(n) asm volatile("s_waitcnt lgkmcnt(" #n ")" ::: "memory")
#define PG8_BAR __builtin_amdgcn_s_barrier()
#define PG8_SCHED __builtin_amdgcn_sched_barrier(0)
    Unit cur, nxt; int ui = 0;
    if (!S.next(0, cur)) return;
    acc_t acc[2][2][4][2];
#pragma unroll
    for (int a = 0; a < 2; ++a)
#pragma unroll
        for (int b = 0; b < 2; ++b)
#pragma unroll
            for (int m = 0; m < 4; ++m)
#pragma unroll
                for (int n = 0; n < 2; ++n) acc[a][b][m][n] = acc_t{};
    bf16x8 At[4][2], B0[2][2], B1[2][2];
    const char* cA = (const char*)g.A + (size_t)cur.pm * tstep; const char* cB = (const char*)g.Bt + (size_t)cur.pn * tstep;
    S.a_ready(cur);
    if constexpr (SP2) {
        PG8_STAGE(PG8_SB(0, 0), cB, voffB); PG8_STAGE(PG8_SB(0, 1), cB + hstep, voffB); PG8_STAGE(PG8_SA(0, 0), cA, voffA); PG8_STAGE(PG8_SA(0, 1), cA + hstep, voffA);
        if (wr == 1) PG8_BAR;
        PG8_WAIT_V(2); PG8_BAR;
        PG8_STAGE(PG8_SB(1, 0), cB + kstep, voffB); PG8_STAGE(PG8_SA(1, 0), cA + kstep, voffA); PG8_STAGE(PG8_SB(1, 1), cB + hstep + kstep, voffB);
        PG8_WAIT_V(6); PG8_BAR;
    } else {
        PG8_STAGE(PG8_SB(0, 0), cB, voffB); PG8_STAGE(PG8_SA(0, 0), cA, voffA); PG8_STAGE(PG8_SB(0, 1), cB + hstep, voffB); PG8_STAGE(PG8_SA(0, 1), cA + hstep, voffA);
        if (wr == 1) PG8_BAR;
        PG8_WAIT_V(4); PG8_BAR;
        PG8_STAGE(PG8_SB(1, 0), cB + kstep, voffB); PG8_STAGE(PG8_SA(1, 0), cA + kstep, voffA); PG8_STAGE(PG8_SB(1, 1), cB + hstep + kstep, voffB);
        PG8_WAIT_V(6); PG8_BAR;
    }
    for (;;) {
        const bool has_next = S.next(ui + 1, nxt);
        const char* nA = has_next ? (const char*)g.A + (size_t)nxt.pm * tstep : cA; const char* nB = has_next ? (const char*)g.Bt + (size_t)nxt.pn * tstep : cB;
        for (int t = 0; t < nt; t += 2) {
            const bool last = (t == nt - 2);
            const char* a1 = cA + (size_t)(t + 1) * kstep;
            const char* a2 = last ? nA : cA + (size_t)(t + 2) * kstep; const char* b2 = last ? nB : cB + (size_t)(t + 2) * kstep;
            const char* a3 = a2 + kstep; const char* b3 = b2 + kstep;
            if (last && has_next) S.a_ready(nxt);
            if constexpr (SP2) {
            PG8_LDB(B0, 0, 0); PG8_LDB(B1, 0, 1); PG8_SCHED; PG8_LDA(At, 0, 0); PG8_STAGE(PG8_SA(1, 1), a1 + hstep, voffA);
            PG8_WAIT_V(8); PG8_WAIT_L(0); PG8_BAR; PG8_MMA(0, 0, At, B0); PG8_MMA(0, 1, At, B1); PG8_BAR; PG8_SCHED;
            PG8_LDA(At, 0, 1); PG8_STAGE(PG8_SB(0, 0), b2, voffB); PG8_STAGE(PG8_SB(0, 1), b2 + hstep, voffB); PG8_STAGE(PG8_SA(0, 0), a2, voffA);
            PG8_WAIT_V(8); PG8_WAIT_L(0); PG8_BAR; PG8_MMA(1, 0, At, B0); PG8_MMA(1, 1, At, B1); PG8_BAR; PG8_SCHED;
            PG8_LDB(B0, 1, 0); PG8_LDB(B1, 1, 1); PG8_SCHED; PG8_LDA(At, 1, 0); PG8_STAGE(PG8_SA(0, 1), a2 + hstep, voffA);
            PG8_WAIT_V(8); PG8_WAIT_L(0); PG8_BAR; PG8_MMA(0, 0, At, B0); PG8_MMA(0, 1, At, B1); PG8_BAR; PG8_SCHED;
            PG8_LDA(At, 1, 1); PG8_STAGE(PG8_SB(1, 0), b3, voffB); PG8_STAGE(PG8_SB(1, 1), b3 + hstep, voffB); PG8_STAGE(PG8_SA(1, 0), a3, voffA);
            PG8_WAIT_V(8); PG8_WAIT_L(0); PG8_BAR; PG8_MMA(1, 0, At, B0); PG8_MMA(1, 1, At, B1); PG8_BAR; PG8_SCHED;
            } else {
            PG8_LDB(B0, 0, 0); PG8_SCHED; PG8_LDA(At, 0, 0); PG8_STAGE(PG8_SA(1, 1), a1 + hstep, voffA);
            PG8_WAIT_L(8); PG8_BAR; PG8_WAIT_L(0); PG8_MMA(0, 0, At, B0); PG8_BAR; PG8_SCHED;
            PG8_LDB(B1, 0, 1); PG8_STAGE(PG8_SB(0, 0), b2, voffB);
            PG8_BAR; PG8_WAIT_L(0); PG8_MMA(0, 1, At, B1); PG8_BAR;
            PG8_LDA(At, 0, 1); PG8_STAGE(PG8_SA(0, 0), a2, voffA);
            PG8_BAR; PG8_WAIT_L(0); PG8_MMA(1, 0, At, B0); PG8_BAR; PG8_SCHED;
            PG8_STAGE(PG8_SB(0, 1), b2 + hstep, voffB);
            PG8_WAIT_V(6); PG8_BAR; PG8_MMA(1, 1, At, B1); PG8_BAR;
            PG8_LDB(B0, 1, 0); PG8_SCHED; PG8_LDA(At, 1, 0); PG8_STAGE(PG8_SA(0, 1), a2 + hstep, voffA);
            PG8_WAIT_L(8); PG8_BAR; PG8_WAIT_L(0); PG8_MMA(0, 0, At, B0); PG8_BAR; PG8_SCHED;
            PG8_LDB(B1, 1, 1); PG8_STAGE(PG8_SB(1, 0), b3, voffB);
            PG8_BAR; PG8_WAIT_L(0); PG8_MMA(0, 1, At, B1); PG8_BAR;
            PG8_LDA(At, 1, 1); PG8_STAGE(PG8_SA(1, 0), a3, voffA);
            PG8_BAR; PG8_WAIT_L(0); PG8_MMA(1, 0, At, B0); PG8_BAR; PG8_SCHED;
            PG8_STAGE(PG8_SB(1, 1), b3 + hstep, voffB);
            PG8_WAIT_V(6); PG8_BAR; PG8_MMA(1, 1, At, B1); PG8_BAR;
            }
        }
        if constexpr (ALIGN_EPI) { if (wr == 0) PG8_BAR; }
        E(acc, cur, wr, wc, fr, fq); S.done(cur);
        if (!has_next) break;
#pragma unroll
        for (int a = 0; a < 2; ++a)
#pragma unroll
            for (int b = 0; b < 2; ++b)
#pragma unroll
                for (int m = 0; m < 4; ++m)
#pragma unroll
                    for (int n = 0; n < 2; ++n) acc[a][b][m][n] = acc_t{};
        cur = nxt; cA = nA; cB = nB; ++ui;
        if constexpr (ALIGN_EPI) { if (wr == 1) PG8_BAR; }
    }
    PG8_WAIT_V(0);
    if constexpr (!ALIGN_EPI) { if (wr == 0) PG8_BAR; }
    PG8_BAR;
#undef PG8_SA
#undef PG8_SB
#undef PG8_STAGE
#undef PG8_LDA
#undef PG8_LDB
#undef PG8_MMA
#undef PG8_WAIT_V
#undef PG8_WAIT_L
#undef PG8_BAR
#undef PG8_SCHED
}

__device__ __forceinline__ float sigmoidf_fast(float x) { return __builtin_amdgcn_rcpf(1.f + __builtin_amdgcn_exp2f(-x * LOG2E)); }
struct EpiInProj {
    static constexpr bool PERM = true;
    bf16_t* base; const float* sxn  ; const float* wsc  ;
    const float* gq; const float* gk; PG8_LAS float* xch  ;
    __device__ __forceinline__ void operator()(const i32x4 (&acci)[2][2][4][2], const Unit& u, int wr, int wc, int fr, int fq) const {
        const int sec = u.pn >> 2; const float wsv = *wsc;
        bf16_t* sb = base + (size_t)sec * SEC_ELEMS;
        const float sc = (sec == 4) ? SCALE * LOG2E : 1.f;
        if (sec < 2) {
#pragma unroll
            for (int ai = 0; ai < 2; ++ai)
#pragma unroll
                for (int m = 0; m < 4; ++m) {
                    const int tk = u.pm * BM + ai * HALF + wr * 64 + m * 16 + fr;
                    const float rs = sxn[tk] * wsv;
#pragma unroll
                    for (int bj = 0; bj < 2; ++bj) {
                        const f32x4 v0 = __builtin_convertvector(acci[ai][bj][m][0], f32x4) * rs, v1 = __builtin_convertvector(acci[ai][bj][m][1], f32x4) * rs;
                        float ss = v0[0] * v0[0] + v0[1] * v0[1] + v0[2] * v0[2] + v0[3] * v0[3] + v1[0] * v1[0] + v1[1] * v1[1] + v1[2] * v1[2] + v1[3] * v1[3];
                        ss += sx_f(ss, 16); ss += sx_f(ss, 32);
                        if (fq == 0) xch[(((((wr * 2 + ai) * 4 + m) * 16 + fr) * 2 + bj) * 4) + wc] = ss;
                    }
                }
            asm volatile("s_waitcnt lgkmcnt(0)" ::: "memory");
            __builtin_amdgcn_s_barrier();
            const float* gp = (sec == 0 ? gq : gk) + wc * 32 + 8 * fq;
            const f32x4 g0 = *(const f32x4*)gp, g1 = *(const f32x4*)(gp + 4);
#pragma unroll
            for (int ai = 0; ai < 2; ++ai)
#pragma unroll
                for (int m = 0; m < 4; ++m) {
                    const int tk = u.pm * BM + ai * HALF + wr * 64 + m * 16 + fr, b = tk >> 12, s = tk & 4095;
                    const float rs = sxn[tk] * wsv;
#pragma unroll
                    for (int bj = 0; bj < 2; ++bj) {
                        const int hh = (u.pn & 3) * 2 + bj;
                        const f32x4 p4 = *(const PG8_LAS f32x4*)(xch + (((((wr * 2 + ai) * 4 + m) * 16 + fr) * 2 + bj) * 4));
                        const float r = rs / sqrtf(((p4[0] + p4[1]) + (p4[2] + p4[3])) * (1.f / 128.f) + EPS);
                        const f32x4 v0 = __builtin_convertvector(acci[ai][bj][m][0], f32x4) * r * g0, v1 = __builtin_convertvector(acci[ai][bj][m][1], f32x4) * r * g1;
                        u32x4 w; w.x = cvt_pk_bf16(v0[0], v0[1]); w.y = cvt_pk_bf16(v0[2], v0[3]); w.z = cvt_pk_bf16(v1[0], v1[1]); w.w = cvt_pk_bf16(v1[2], v1[3]);
                        *(u32x4*)(sb + ((size_t)((b * 8 + hh) * 4096 + s)) * 128 + wc * 32 + 8 * fq) = w;
                    }
                }
            return;
        }
#pragma unroll
        for (int ai = 0; ai < 2; ++ai)
#pragma unroll
            for (int m = 0; m < 4; ++m) {
                const int tk = u.pm * BM + ai * HALF + wr * 64 + m * 16 + fr, b = tk >> 12, s = tk & 4095;
                const float rs = sxn[tk] * wsv;
#pragma unroll
                for (int bj = 0; bj < 2; ++bj) {
                    const int hh = (u.pn & 3) * 2 + bj;
                    f32x4 v0 = __builtin_convertvector(acci[ai][bj][m][0], f32x4) * rs, v1 = __builtin_convertvector(acci[ai][bj][m][1], f32x4) * rs;
                    bf16_t* dst;
                    if (sec == 3) {
#pragma unroll
                        for (int i = 0; i < 4; ++i) { v0[i] = sigmoidf_fast(v0[i]); v1[i] = sigmoidf_fast(v1[i]); }
                        dst = sb + (size_t)tk * 1024 + hh * 128 + wc * 32 + 8 * fq;
                    } else {
                        v0 = v0 * sc; v1 = v1 * sc;
                        dst = sb + ((size_t)((b * 8 + hh) * 4096 + s)) * 128 + wc * 32 + 8 * fq;
                    }
                    u32x4 w; w.x = cvt_pk_bf16(v0[0], v0[1]); w.y = cvt_pk_bf16(v0[2], v0[3]); w.z = cvt_pk_bf16(v1[0], v1[1]); w.w = cvt_pk_bf16(v1[2], v1[3]);
                    *(u32x4*)dst = w;
                }
            }
    }
};
struct EpiOutProj {
    static constexpr bool PERM = true;
    const float* x; float* h; bf16_t* hb; float* ssq; float* amx;
    __device__ __forceinline__ void operator()(const f32x4 (&acc)[2][2][4][2], const Unit& u, int wr, int wc, int fr, int fq) const {
#pragma unroll
        for (int ai = 0; ai < 2; ++ai)
#pragma unroll
            for (int m = 0; m < 4; ++m) {
                const int tk = u.pm * BM + ai * HALF + wr * 64 + m * 16 + fr;
                float ss = 0.f, mx = 0.f;
#pragma unroll
                for (int bj = 0; bj < 2; ++bj) {
                    const size_t off = (size_t)tk * DM + u.pn * BM + bj * HALF + wc * 32 + 8 * fq;
                    const f32x4 x0 = *(const f32x4*)(x + off), x1 = *(const f32x4*)(x + off + 4);
                    const f32x4 v0 = acc[ai][bj][m][0] + x0, v1 = acc[ai][bj][m][1] + x1;
                    *(f32x4*)(h + off) = v0; *(f32x4*)(h + off + 4) = v1;
                    u32x4 w; w.x = cvt_pk_bf16(v0[0], v0[1]); w.y = cvt_pk_bf16(v0[2], v0[3]); w.z = cvt_pk_bf16(v1[0], v1[1]); w.w = cvt_pk_bf16(v1[2], v1[3]);
                    *(u32x4*)(hb + off) = w;
                    ss += v0[0] * v0[0] + v0[1] * v0[1] + v0[2] * v0[2] + v0[3] * v0[3] + v1[0] * v1[0] + v1[1] * v1[1] + v1[2] * v1[2] + v1[3] * v1[3];
                    mx = fmaxf(mx, fmaxf(fmaxf(fmaxf(fabsf(v0[0]), fabsf(v0[1])), fmaxf(fabsf(v0[2]), fabsf(v0[3]))), fmaxf(fmaxf(fabsf(v1[0]), fabsf(v1[1])), fmaxf(fabsf(v1[2]), fabsf(v1[3])))));
                }
                ss += sx_f(ss, 16); ss += sx_f(ss, 32);
                mx = fmaxf(mx, sx_f(mx, 16)); mx = fmaxf(mx, sx_f(mx, 32));
                if (fq == 0) { ssq[(size_t)tk * 32 + u.pn * 4 + wc] = ss; amx[(size_t)tk * 32 + u.pn * 4 + wc] = mx; }
            }
    }
};
struct EpiPeerQ {
    static constexpr bool PERM = true;
    const float* ssq; bf16_t* qp; float* rtab;
    __device__ __forceinline__ void operator()(const f32x4 (&acc)[2][2][4][2], const Unit& u, int wr, int wc, int fr, int fq) const {
#pragma unroll
        for (int ai = 0; ai < 2; ++ai)
#pragma unroll
            for (int m = 0; m < 4; ++m) {
                const int tk = u.pm * BM + ai * HALF + wr * 64 + m * 16 + fr;
                float tot = 0.f;
#pragma unroll
                for (int i = 0; i < 8; ++i) { const f32x4 s4 = *(const f32x4*)(ssq + (size_t)tk * 32 + 4 * i); tot += (s4[0] + s4[1]) + (s4[2] + s4[3]); }
                const float r = 1.0f / sqrtf(tot * (1.f / DM) + EPS);
                if (u.pn == 0 && wc == 0 && fq == 0) rtab[tk] = r;
#pragma unroll
                for (int bj = 0; bj < 2; ++bj) {
                    const size_t off = (size_t)tk * DM + u.pn * BM + bj * HALF + wc * 32 + 8 * fq;
                    const f32x4 v0 = acc[ai][bj][m][0] * r, v1 = acc[ai][bj][m][1] * r;
                    u32x4 w; w.x = cvt_pk_bf16(v0[0], v0[1]); w.y = cvt_pk_bf16(v0[2], v0[3]); w.z = cvt_pk_bf16(v1[0], v1[1]); w.w = cvt_pk_bf16(v1[2], v1[3]);
                    *(u32x4*)(qp + off) = w;
                }
            }
    }
};
}

namespace att {
constexpr int NW = 8, QBLK = 32, KVBLK = 64, QB = NW * QBLK, D = 128;
constexpr int SHM_V = KVBLK * D * 2, SHM_K = KVBLK * D * 2;
constexpr int OFF_WS = 2 * SHM_V + 2 * SHM_K, OFF_BIAS = OFF_WS + NW * 64 * 4, ATT_LDS = OFF_BIAS + SEQ * 4;
#define KSWZ(row, colB) ((row) * 256 + ((colB) ^ (((row) & 7) << 4)))
#define SBAR() __builtin_amdgcn_sched_barrier(0)
__device__ __forceinline__ int v_st(int k, int c) { const int kk = (k & ~0xC) | ((k & 4) << 1) | ((k & 8) >> 1); return ((kk >> 3) * 4 + (c >> 5)) * 512 + ((kk & 7) * 32 + (c & 31)) * 2; }
__device__ __forceinline__ int v_rd_base(int lane) { return ((lane & 3) << 3) | (((lane >> 2) & 3) << 6) | (((lane >> 4) & 1) << 5) | (((lane >> 5) & 1) << 8); }
constexpr int v_rd_off(int d0, int ks, int half) { return d0 * 512 + ks * 4096 + half * 2048; }
__device__ __forceinline__ int crow(int r, int hi) { return (r & 3) + 8 * (r >> 2) + 4 * hi; }
__device__ __forceinline__ bf16x8 load8(const bf16_t* p) { return *reinterpret_cast<const bf16x8*>(p); }
__device__ __forceinline__ void mask_tile(f32x16& p0, f32x16& p1, int dq) {
    const float NEG = -__builtin_inff();
#pragma unroll
    for (int r = 0; r < 16; ++r) {
        const int c = (r & 3) + 8 * (r >> 2);
        if (dq - c < 0) p0[r] = NEG;
        if (dq - c - 32 < 0) p1[r] = NEG;
    }
}
__device__ __forceinline__ void partialSM(f32x16& p0, f32x16& p1, float& m_reg, float& mn, float& alpha) {
    float pmax = p0[0];
#pragma unroll
    for (int r = 1; r < 16; ++r) pmax = fmaxf(pmax, p0[r]);
#pragma unroll
    for (int r = 0; r < 16; ++r) pmax = fmaxf(pmax, p1[r]);
    { auto rr = __builtin_amdgcn_permlane32_swap(__float_as_uint(pmax), __float_as_uint(pmax), false, false);
      pmax = fmaxf(__uint_as_float(rr[0]), __uint_as_float(rr[1])); }
    constexpr float C2 = LOG2E * SCALE; constexpr float THR = 8.f;
    if (__builtin_expect(__all((pmax - m_reg) * SCALE <= THR), 1)) { mn = m_reg; alpha = 1.f; }
    else { mn = fmaxf(m_reg, pmax); alpha = __builtin_amdgcn_exp2f((m_reg - mn) * C2); m_reg = mn; }
    const float mnL = -mn * C2;
#pragma unroll
    for (int r = 0; r < 16; ++r) p0[r] = fmaf(p0[r], C2, mnL);
#pragma unroll
    for (int r = 0; r < 16; ++r) p1[r] = fmaf(p1[r], C2, mnL);
#pragma unroll
    for (int r = 0; r < 16; ++r) p0[r] = __builtin_amdgcn_exp2f(p0[r]);
}
#define PK4(P, B_, OUT) do { unsigned a0 = cvt_pk_bf16(P[B_+0], P[B_+1]), a1 = cvt_pk_bf16(P[B_+2], P[B_+3]);                          \
        unsigned b0 = cvt_pk_bf16(P[B_+4], P[B_+5]), b1 = cvt_pk_bf16(P[B_+6], P[B_+7]);                                             \
        auto r0 = __builtin_amdgcn_permlane32_swap(a0, b0, false, false); auto r1 = __builtin_amdgcn_permlane32_swap(a1, b1, false, false); \
        u32x4 w = {r0[0], r1[0], r0[1], r1[1]}; OUT = *reinterpret_cast<bf16x8*>(&w); } while (0)
__device__ __forceinline__ void finishSM(f32x16& p0, f32x16& p1, float alpha, float& l_reg, bf16x8& pa0, bf16x8& pa1, bf16x8& pa2, bf16x8& pa3) {
#pragma unroll
    for (int r = 0; r < 16; ++r) p1[r] = __builtin_amdgcn_exp2f(p1[r]);
    float ps = 0;
#pragma unroll
    for (int r = 0; r < 16; ++r) ps += p0[r];
#pragma unroll
    for (int r = 0; r < 16; ++r) ps += p1[r];
    { auto rr = __builtin_amdgcn_permlane32_swap(__float_as_uint(ps), __float_as_uint(ps), false, false);
      ps = __uint_as_float(rr[0]) + __uint_as_float(rr[1]); }
    l_reg = l_reg * alpha + ps;
    PK4(p0, 0, pa0); PK4(p0, 8, pa1); PK4(p1, 0, pa2); PK4(p1, 8, pa3);
}
__device__ __forceinline__ void sb_group(f32x16& P, int g, float& gs) {
    float run = 0.f;
#pragma unroll
    for (int k = 3; k >= 0; --k) {
        const float z = P[4 * g + k];
        const float t = __builtin_amdgcn_exp2f(-fabsf(z));
        const float l = __builtin_amdgcn_logf(1.f + t);
        const float sp = fmaxf(z, 0.f) + l;
        P[4 * g + k] = (z - sp) - run;
        run += sp;
    }
    gs = run;
}
__device__ __forceinline__ void sb_part1(f32x16& p0, f32x16& p1, float& carry, float mlo) {
    float gs[8];
#pragma unroll
    for (int g = 0; g < 4; ++g) sb_group(p0, g, gs[g]);
#pragma unroll
    for (int g = 0; g < 4; ++g) sb_group(p1, g, gs[4 + g]);
    float run = carry;
#pragma unroll
    for (int G = 7; G >= 0; --G) {
        auto rr = __builtin_amdgcn_permlane32_swap(__float_as_uint(gs[G]), __float_as_uint(gs[G]), false, false);
        const float slo = __uint_as_float(rr[0]), shi = __uint_as_float(rr[1]);
        const float base = fmaf(mlo, shi, run);
        if (G >= 4) {
#pragma unroll
            for (int k = 0; k < 4; ++k) p1[4 * (G - 4) + k] -= base;
        } else {
#pragma unroll
            for (int k = 0; k < 4; ++k) p0[4 * G + k] -= base;
        }
        run += slo + shi;
    }
    carry = run;
#pragma unroll
    for (int r = 0; r < 16; ++r) p0[r] = __builtin_amdgcn_exp2f(p0[r]);
}
__device__ __forceinline__ void sb_part2(f32x16& p0, f32x16& p1, bf16x8& pa0, bf16x8& pa1, bf16x8& pa2, bf16x8& pa3) {
#pragma unroll
    for (int r = 0; r < 16; ++r) p1[r] = __builtin_amdgcn_exp2f(p1[r]);
    PK4(p0, 0, pa0); PK4(p0, 8, pa1); PK4(p1, 0, pa2); PK4(p1, 8, pa3);
}
#undef PK4
template <int KB, bool BIAS>
__device__ __forceinline__ void qkt(f32x16& p0, f32x16& p1, const char* K_lds, int r32, int hi, const bf16x8* qr, const float* bt) {
    if constexpr (BIAS) {
#pragma unroll
        for (int g = 0; g < 4; ++g) { const f32x4 a = *(const f32x4*)(bt + 8 * g), b = *(const f32x4*)(bt + 32 + 8 * g);
            p0[4 * g] = a[0]; p0[4 * g + 1] = a[1]; p0[4 * g + 2] = a[2]; p0[4 * g + 3] = a[3];
            p1[4 * g] = b[0]; p1[4 * g + 1] = b[1]; p1[4 * g + 2] = b[2]; p1[4 * g + 3] = b[3]; }
    } else { p0 = f32x16{}; p1 = f32x16{}; }
    const char* kb[4];
#pragma unroll
    for (int dd = 0; dd < 4; ++dd) kb[dd] = K_lds + KB * SHM_K + KSWZ(r32, (dd * 16 + hi * 8) * 2);
#pragma unroll
    for (int d0 = 0; d0 < 8; ++d0) { const char* a = kb[d0 & 3] + (d0 >> 2) * 128;
        bf16x8 b0 = *reinterpret_cast<const bf16x8*>(a);
        bf16x8 b1 = *reinterpret_cast<const bf16x8*>(a + 32 * 256);
        p0 = __builtin_amdgcn_mfma_f32_32x32x16_bf16(b0, qr[d0], p0, 0, 0, 0);
        p1 = __builtin_amdgcn_mfma_f32_32x32x16_bf16(b1, qr[d0], p1, 0, 0, 0); }
}
template <int VB>
__device__ __forceinline__ void pv_tile(f32x16* o, int vb0, bf16x8 pa0, bf16x8 pa1, bf16x8 pa2, bf16x8 pa3) {
#define TRRD(dst, off) asm volatile("ds_read_b64_tr_b16 %0, %1 offset:%2" : "=&v"(dst) : "v"(vb0), "i"(off) : "memory")
#define PV_D0(d0) do { { s16x4 l0, l1, h0, h1; constexpr int b_ = VB * SHM_V + v_rd_off(d0, 0, 0); \
        TRRD(l0, b_); TRRD(h0, b_ + 2048); TRRD(l1, b_ + 4096); TRRD(h1, b_ + 6144); \
        asm volatile("s_waitcnt lgkmcnt(0)" ::: "memory"); SBAR();   \
        o[d0] = __builtin_amdgcn_mfma_f32_32x32x16_bf16(pa0, (bf16x8){l0[0], l0[1], l0[2], l0[3], h0[0], h0[1], h0[2], h0[3]}, o[d0], 0, 0, 0);   \
        o[d0] = __builtin_amdgcn_mfma_f32_32x32x16_bf16(pa1, (bf16x8){l1[0], l1[1], l1[2], l1[3], h1[0], h1[1], h1[2], h1[3]}, o[d0], 0, 0, 0); }  \
      { s16x4 l2, l3, h2, h3; constexpr int b_ = VB * SHM_V + v_rd_off(d0, 0, 0); \
        TRRD(l2, b_ + 8192); TRRD(h2, b_ + 10240); TRRD(l3, b_ + 12288); TRRD(h3, b_ + 14336); \
        asm volatile("s_waitcnt lgkmcnt(0)" ::: "memory"); SBAR();   \
        o[d0] = __builtin_amdgcn_mfma_f32_32x32x16_bf16(pa2, (bf16x8){l2[0], l2[1], l2[2], l2[3], h2[0], h2[1], h2[2], h2[3]}, o[d0], 0, 0, 0);   \
        o[d0] = __builtin_amdgcn_mfma_f32_32x32x16_bf16(pa3, (bf16x8){l3[0], l3[1], l3[2], l3[3], h3[0], h3[1], h3[2], h3[3]}, o[d0], 0, 0, 0); } } while (0)
    PV_D0(0); PV_D0(1); PV_D0(2); PV_D0(3);
#undef PV_D0
#undef TRRD
}

struct UnitRef { const bf16_t* Q; const bf16_t* K; const bf16_t* V; int P0; };
struct Seam { bf16x8 qr[8]; bf16x8 st_v0, st_v1, st_k0, st_k1; };
#define ROW(p, k0, rr) ((p) + (size_t)((k0) + (rr)) * D + sc)
#define VMW() asm volatile("s_waitcnt vmcnt(0)" ::: "memory")
#define SLOAD_H(Kp, Vp, k0) do { S.st_v0 = load8(ROW(Vp, k0, sr)); S.st_v1 = load8(ROW(Vp, k0, 32 + sr));              \
                         S.st_k0 = load8(ROW(Kp, k0, sr)); S.st_k1 = load8(ROW(Kp, k0, 32 + sr)); } while (0)
#define SWRITE_HK(bf) do { *(bf16x8*)(K_lds + (bf) * SHM_K + kws) = S.st_k0; *(bf16x8*)(K_lds + (bf) * SHM_K + kws + 32 * 256) = S.st_k1; } while (0)
#define SWRITE_HV(bf) do { *(bf16x8*)(V_lds + (bf) * SHM_V + vst0) = S.st_v0; *(bf16x8*)(V_lds + (bf) * SHM_V + vst1) = S.st_v1; } while (0)
#define SWRITE_H(bf) do { SWRITE_HV(bf); SWRITE_HK(bf); } while (0)

template <bool SB>
__device__ __forceinline__ void attn_unit(const UnitRef& cur, unsigned char* wsu  , int bh, char* lds,
                                          int part  ) {
    const float* cvec; const float* gqk;
    { unsigned char* w_ = wsu; asm volatile("" : "+s"(w_)); cvec = (const float*)(w_ + WS_C) + (size_t)bh * SEQ; gqk = (const float*)(w_ + WS_GQK); }
    const int tid = tid_opaque(), wid = __builtin_amdgcn_readfirstlane(tid >> 6), lane = tid & 63, r32 = lane & 31, hi = lane >> 5;
    int jlo = 0;
    if constexpr (!SB) {
        const float gq = fmaxf(fabsf(gqk[lane]), fabsf(gqk[64 + lane])), gk = fmaxf(fabsf(gqk[128 + lane]), fabsf(gqk[192 + lane]));
        const float lmax = 11.3137085f * 1.02f * wave_max(gq) * wave_max(gk);
        const int ntf = (cur.P0 + QB) / KVBLK;
        const float cend = (lane < ntf) ? cvec[lane * KVBLK + KVBLK - 1] : 0.f;
        const bool skip = (lane < ntf) && (2.f * lmax + cvec[cur.P0] - cend < -104.f);
        jlo = __builtin_amdgcn_readfirstlane((int)__popcll(__ballot(skip)));
    }
    const int ntot = (cur.P0 + QB) / KVBLK - jlo;
    const int tb = (part == 2) ? (ntot >> 1) : 0, te = (part == 1) ? (ntot >> 1) : ntot;
    const int kshift = (jlo + tb) * KVBLK, P0r = cur.P0 - kshift;
    const int NT = te - tb;
#define KBASE(t) ((SB ? (NT - 1 - (t)) : (t)) * KVBLK)
    const int qlo = P0r + wid * QBLK, qm = qlo + r32 - 4 * hi - (SB ? 1 : 0);
    char* V_lds = lds; char* K_lds = lds + 2 * SHM_V;
    float* ws = (float*)(lds + OFF_WS) + wid * 64; float* li_l = ws, * al_l = ws + 32;
    float* bias = (float*)(lds + OFF_BIAS);
    const int sr = tid >> 4, sc = (tid & 15) * 8, vst0 = v_st(sr, sc), vst1 = v_st(32 + sr, sc), kws = KSWZ(sr, sc * 2);
    const int vb0 = (int)(uintptr_t)V_lds + v_rd_base(lane);
    const bf16_t* Kh = cur.K + (size_t)kshift * D; const bf16_t* Vh = cur.V + (size_t)kshift * D;
    Seam S;
    if constexpr (!SB) { const float cq0 = cvec[cur.P0]; const float* cv = cvec + kshift; for (int j = tid; j < NT * KVBLK; j += NTHREADS) bias[j] = (cq0 - cv[j]) * (1.f / SCALE); }
#pragma unroll
    for (int d0 = 0; d0 < 8; ++d0) S.qr[d0] = load8(cur.Q + (size_t)(wid * QBLK + r32) * D + d0 * 16 + hi * 8);
    SLOAD_H(Kh, Vh, KBASE(0)); VMW(); SWRITE_HK(0);
    __syncthreads();
    float m_reg = -1e30f, l_reg = 0; f32x16 o[4] = {};
    float carry = 0.f; const float mlo = hi ? 0.f : 1.f;
#define RESC(a) do { if (__any((a) < 1.f)) { if (hi == 0) al_l[r32] = (a); asm volatile("s_waitcnt lgkmcnt(0)" ::: "memory");              \
                     for (int d_ = 0; d_ < 4; ++d_) for (int r = 0; r < 16; ++r) o[d_][r] *= al_l[crow(r, hi)]; } } while (0)
#define MASKT(P0_, P1_, t) do { const int kb_ = KBASE(t); if (kb_ + KVBLK - 1 > qlo - (SB ? 1 : 0)) mask_tile(P0_, P1_, qm - kb_); } while (0)
#define BT(t) (bias + KBASE(t) + 4 * hi)
#define PART1(PX0, PX1, mnX, alX) do { if constexpr (SB) sb_part1(PX0, PX1, carry, mlo); else partialSM(PX0, PX1, m_reg, mnX, alX); } while (0)
#define PART2(PY0, PY1, alY) do { if constexpr (SB) sb_part2(PY0, PY1, pa0, pa1, pa2, pa3); else finishSM(PY0, PY1, alY, l_reg, pa0, pa1, pa2, pa3); } while (0)
    f32x16 pA0, pA1, pB0, pB1; float mnA = 0.f, mnB = 0.f, alA = 1.f, alB = 1.f; bf16x8 pa0, pa1, pa2, pa3;
    SWRITE_HV(0); SBAR();
    if (NT > 1) SLOAD_H(Kh, Vh, KBASE(1));
    SBAR(); qkt<0, !SB>(pA0, pA1, K_lds, r32, hi, S.qr, BT(0));
    MASKT(pA0, pA1, 0); PART1(pA0, pA1, mnA, alA);
    if (NT > 1) { VMW(); SWRITE_H(1); }
    __syncthreads();
#define HALF_STEP(PX0, PX1, mnX, alX, PY0, PY1, alY, t, KB, VB, SBUF) do {                                                    \
        SBAR(); qkt<KB, !SB>(PX0, PX1, K_lds, r32, hi, S.qr, BT(t));                                                          \
        PART2(PY0, PY1, alY); SBAR();                                                                                          \
        if ((t) + 1 < NT) { SLOAD_H(Kh, Vh, KBASE((t) + 1)); SBAR(); }                                                         \
        pv_tile<VB>(o, vb0, pa0, pa1, pa2, pa3); MASKT(PX0, PX1, (t)); PART1(PX0, PX1, mnX, alX);                              \
        __syncthreads();                                                                                                      \
        if ((t) + 1 < NT) { VMW(); SWRITE_H(SBUF); }                                                                           \
        if constexpr (!SB) RESC(alX);                                                                                          \
        __syncthreads(); } while (0)
    for (int t = 1; t + 1 < NT; t += 2) {
        HALF_STEP(pB0, pB1, mnB, alB, pA0, pA1, alA, t, 1, 0, 0);
        HALF_STEP(pA0, pA1, mnA, alA, pB0, pB1, alB, t + 1, 0, 1, 1);
    }
    const bool even = (NT & 1) == 0;
    if (even) { SBAR(); qkt<1, !SB>(pB0, pB1, K_lds, r32, hi, S.qr, BT(NT - 1)); SBAR(); }
    PART2(pA0, pA1, alA); SBAR();
    pv_tile<0>(o, vb0, pa0, pa1, pa2, pa3);
    if (even) { MASKT(pB0, pB1, NT - 1); PART1(pB0, pB1, mnB, alB); __syncthreads(); if constexpr (!SB) RESC(alB);
        PART2(pB0, pB1, alB); SBAR(); pv_tile<1>(o, vb0, pa0, pa1, pa2, pa3); }
    unsigned char* we_ = wsu; asm volatile("" : "+s"(we_));
    if (part != 0) {
        const int slot2 = ((((cur.P0 >> 8) - 8) & 7) * 16 + bh) * 2 + (part == 2 ? 1 : 0);
        float* po = (float*)(we_ + WS_PO) + (size_t)slot2 * 256 * 128; float* pml = (float*)(we_ + WS_PML) + (size_t)slot2 * 512;
        if (hi == 0) { pml[(wid * QBLK + r32) * 2] = m_reg; pml[(wid * QBLK + r32) * 2 + 1] = l_reg; }
#pragma unroll
        for (int r = 0; r < 16; ++r)
#pragma unroll
            for (int d0 = 0; d0 < 4; ++d0) po[(size_t)(wid * QBLK + crow(r, hi)) * D + d0 * 32 + r32] = o[d0][r];
        __syncthreads();
        return;
    }
    const bf16_t* gate = (const bf16_t*)(we_ + WS_SEC) + 3 * SEC_ELEMS + (size_t)(bh >> 3) * SEQ * 1024 + (bh & 7) * HD;
    bf16_t* outp = (bf16_t*)(we_ + WS_MIX) + (size_t)(bh >> 3) * SEQ * DM + (bh & 7) * HD;
    float rli[16];
    if constexpr (!SB) {
        if (hi == 0) li_l[r32] = l_reg; asm volatile("s_waitcnt lgkmcnt(0)" ::: "memory");
#pragma unroll
        for (int r = 0; r < 16; ++r) rli[r] = __builtin_amdgcn_rcpf(li_l[crow(r, hi)]);
    }
#pragma unroll
    for (int r = 0; r < 16; ++r) { const int orow = cur.P0 + wid * QBLK + crow(r, hi);
#pragma unroll
        for (int d0 = 0; d0 < 4; ++d0) {
            float v = o[d0][r];
            if constexpr (!SB) { const unsigned short gb = gate[(size_t)orow * 1024 + d0 * 32 + r32]; v = v * rli[r] * __builtin_bit_cast(float, (unsigned)gb << 16); }
            const float vn = sx_f(v, 1);
            if ((r32 & 1) == 0) *(unsigned*)(outp + (size_t)orow * DM + d0 * 32 + r32) = cvt_pk_bf16(v, vn); } }
    __syncthreads();
#undef RESC
#undef KBASE
#undef MASKT
#undef BT
#undef PART1
#undef PART2
#undef HALF_STEP
}

constexpr float SB_TH = 150.f;
__device__ __forceinline__ void sb_unit(const UnitRef& cur, bf16_t* outp, char* lds) {
    const int tid = tid_opaque(), wid = __builtin_amdgcn_readfirstlane(tid >> 6), lane = tid & 63, r32 = lane & 31, hi = lane >> 5;
    const int NT = (cur.P0 + QB) / KVBLK;
#define KBASE(t) ((NT - 1 - (t)) * KVBLK)
    const int qlo = cur.P0 + wid * QBLK, qm = qlo + r32 - 4 * hi - 1;
    char* V_lds = lds; char* K_lds = lds + 2 * SHM_V;
    volatile int* flags = (volatile int*)(lds + OFF_WS);
    const int sr = tid >> 4, sc = (tid & 15) * 8, vst0 = v_st(sr, sc), vst1 = v_st(32 + sr, sc), kws = KSWZ(sr, sc * 2);
    const int vb0 = (int)(uintptr_t)V_lds + v_rd_base(lane);
    const bf16_t* Kh = cur.K; const bf16_t* Vh = cur.V;
    Seam S;
#pragma unroll
    for (int d0 = 0; d0 < 8; ++d0) S.qr[d0] = load8(cur.Q + (size_t)(wid * QBLK + r32) * D + d0 * 16 + hi * 8);
    SLOAD_H(Kh, Vh, KBASE(0)); VMW(); SWRITE_H(0);
    __syncthreads();
    f32x16 o[4] = {}; float carry = 0.f; const float mlo = hi ? 0.f : 1.f;
    bool wdone = false;
#define SB_STEP(tt, BUF) {                                                                                                 \
        const int kb_ = KBASE(tt);                                                                                           \
        if ((tt) + 1 < NT) SLOAD_H(Kh, Vh, KBASE((tt) + 1));                                                                 \
        SBAR();                                                                                                              \
        if (!wdone && kb_ <= qlo + QBLK - 2) {                                                                               \
            f32x16 p0, p1; bf16x8 pa0, pa1, pa2, pa3;                                                                        \
            qkt<BUF, false>(p0, p1, K_lds, r32, hi, S.qr, nullptr);                                                          \
            if (kb_ + KVBLK - 1 > qlo - 1) mask_tile(p0, p1, qm - kb_);                                                      \
            sb_part1(p0, p1, carry, mlo); sb_part2(p0, p1, pa0, pa1, pa2, pa3); SBAR();                                      \
            pv_tile<BUF>(o, vb0, pa0, pa1, pa2, pa3);                                                                        \
            wdone = __all(carry >= SB_TH);                                                                                   \
        }                                                                                                                    \
        if ((tt) + 1 < NT) { VMW(); SWRITE_H((BUF) ^ 1); }                                                                   \
        if (lane == 0) flags[((tt) & 1) * 8 + wid] = wdone ? 1 : 0;                                                          \
        __syncthreads();                                                                                                     \
        { int alld = 1;                                                                                                      \
          _Pragma("unroll") for (int w_ = 0; w_ < 8; ++w_) alld &= flags[((tt) & 1) * 8 + w_];                                \
          if (alld) break; } }
    for (int t = 0; t < NT; t += 2) {
        SB_STEP(t, 0)
        SB_STEP(t + 1, 1)
    }
#undef SB_STEP
#pragma unroll
    for (int r = 0; r < 16; ++r) { const int orow = cur.P0 + wid * QBLK + crow(r, hi);
#pragma unroll
        for (int d0 = 0; d0 < 4; ++d0) {
            const float v = o[d0][r];
            const float vn = sx_f(v, 1);
            if ((r32 & 1) == 0) *(unsigned*)(outp + (size_t)orow * DM + d0 * 32 + r32) = cvt_pk_bf16(v, vn); } }
    __syncthreads();
#undef KBASE
}
#undef ROW
#undef VMW
#undef SLOAD_H
#undef SWRITE_HK
#undef SWRITE_HV
#undef SWRITE_H
}

#define XB_TMO      128
#define XB_XCNT(j)  (256  + 64 * (j))
#define XB_XSUB(j)  (1280 + 64 * (j))
#define XB_XGEN(j)  (2304 + 64 * (j))
#define XB_TOP      3328
#define XB_TOPGEN   3392
#define XCD_BAR_WORDS 3456
#define XB_SPIN_CAP (1u << 20)
__device__ __forceinline__ unsigned xb_ld(unsigned* p)              { return __hip_atomic_load(p, __ATOMIC_RELAXED, __HIP_MEMORY_SCOPE_AGENT); }
__device__ __forceinline__ unsigned xb_add(unsigned* p, unsigned v) { return __hip_atomic_fetch_add(p, v, __ATOMIC_RELAXED, __HIP_MEMORY_SCOPE_AGENT); }
__device__ __forceinline__ unsigned xb_xcc_id() { return (unsigned)__builtin_amdgcn_s_getreg((3 << 11) | 20) & 0xFu; }
#define XB_SPIN(cond, bar) do { unsigned _sp = 0; while (cond) { __builtin_amdgcn_s_sleep(1); \
    if ((++_sp & 255u) == 0u) { if (xb_ld(&(bar)[XB_TMO])) break; if (_sp > XB_SPIN_CAP) { atomicAdd(&(bar)[XB_TMO], 1u); break; } } } } while (0)
struct XcdBarrier { unsigned* bar; unsigned x; volatile LAS unsigned* st; };
__device__ __forceinline__ XcdBarrier xcd_barrier_post(unsigned* bar, volatile LAS unsigned* st) {
    XcdBarrier b; b.bar = bar; b.x = xb_xcc_id(); b.st = st;
    if (threadIdx.x == 0) (void)xb_add(&bar[XB_XCNT(b.x)], 1u);
    return b;
}
__device__ __forceinline__ void xcd_barrier_complete(unsigned* bar, unsigned x, unsigned& nloc, unsigned& nx) {
    const unsigned G = gridDim.x * gridDim.y * gridDim.z;
    unsigned sum, cnt, mine, sp = 0u;
    for (;;) {
        sum = 0u; cnt = 0u; mine = 0u;
#pragma unroll
        for (unsigned j = 0; j < 16; ++j) { const unsigned c = xb_ld(&bar[XB_XCNT(j)]); sum += c; cnt += (c > 0u) ? 1u : 0u; mine = (j == x) ? c : mine; }
        if (sum == G) break;
        __builtin_amdgcn_s_sleep(1);
        if ((++sp & 255u) == 0u) { if (xb_ld(&bar[XB_TMO])) break; if (sp > XB_SPIN_CAP) { atomicAdd(&bar[XB_TMO], 1u); break; } }
    }
    nloc = mine > 0u ? mine : 1u; nx = cnt > 0u ? cnt : 1u;
}
__device__ __forceinline__ void xcd_barrier(const XcdBarrier& b) {
    asm volatile("s_waitcnt vmcnt(0)" ::: "memory");
    __syncthreads();
    if (threadIdx.x == 0) {
        unsigned* bar = b.bar;
        __builtin_amdgcn_s_waitcnt(0);
        unsigned nloc = b.st[0], nx = b.st[1];
        if (nloc == 0u) { xcd_barrier_complete(bar, b.x, nloc, nx); b.st[0] = nloc; b.st[1] = nx; }
        const unsigned old = xb_add(&bar[XB_XSUB(b.x)], 1u);
        const unsigned gen = old / nloc;
        if (old + 1u == (gen + 1u) * nloc) {
            __builtin_amdgcn_fence(__ATOMIC_RELEASE, "agent");
            asm volatile("s_waitcnt vmcnt(0)" ::: "memory");
            const unsigned og = xb_add(&bar[XB_TOP], 1u);
            const unsigned tg = og / nx;
            if (og + 1u == (tg + 1u) * nx) xb_add(&bar[XB_TOPGEN], 1u);
            else XB_SPIN(xb_ld(&bar[XB_TOPGEN]) == tg, bar);
            __builtin_amdgcn_fence(__ATOMIC_ACQUIRE, "agent");
            xb_add(&bar[XB_XGEN(b.x)], 1u);
            asm volatile("s_waitcnt vmcnt(0)" ::: "memory");
        } else {
            XB_SPIN(xb_ld(&bar[XB_XGEN(b.x)]) == gen, bar);
            __builtin_amdgcn_fence(__ATOMIC_ACQUIRE, "agent");
            asm volatile("s_waitcnt vmcnt(0)" ::: "memory");
        }
    }
    __syncthreads();
}

struct Args { const float* in[12]; float* out; unsigned char* ws; int ph_lo, ph_hi; };

__device__ __forceinline__ void p0_transpose_item(const float* W, int ldw, int K, bf16_t* WT, int nblk, LAS float* scr, int item, int lane, const float* gk) {
    const int kb = item / nblk, nb = item % nblk, k0 = 64 * kb, n0 = 32 * nb;
#pragma unroll 8
    for (int i = 0; i < 32; ++i) { const int kk = 2 * i + (lane >> 5); float w = W[(size_t)(k0 + kk) * ldw + n0 + (lane & 31)]; if (gk) w *= gk[k0 + kk]; scr[kk * 33 + (lane & 31)] = w; }
    LDS_WAIT(); asm volatile("" ::: "memory");
    const int c = lane & 7;
#pragma unroll
    for (int j = 0; j < 4; ++j) { const int n = (lane >> 3) + 8 * j; const LAS float* s = scr + (8 * c) * 33 + n;
        u32x4 o; o.x = cvt_pk_bf16(s[0 * 33], s[1 * 33]); o.y = cvt_pk_bf16(s[2 * 33], s[3 * 33]); o.z = cvt_pk_bf16(s[4 * 33], s[5 * 33]); o.w = cvt_pk_bf16(s[6 * 33], s[7 * 33]);
        *(u32x4*)(WT + (size_t)(n0 + n) * K + k0 + 8 * c) = o; }
    LDS_WAIT(); asm volatile("" ::: "memory");
}

__device__ __forceinline__ int pack_i8(float a, float b, float c, float d) {
    const int ia = (int)__builtin_rintf(a), ib = (int)__builtin_rintf(b), ic = (int)__builtin_rintf(c), id = (int)__builtin_rintf(d);
    return (int)(((unsigned)ia & 0xffu) | (((unsigned)ib & 0xffu) << 8) | (((unsigned)ic & 0xffu) << 16) | ((unsigned)id << 24));
}
__device__ __forceinline__ void convert_tables(const Args& a, int r0, int r1, int worker, int nworkers) {
    const int lane = tid_opaque() & 63;
    unsigned char* ws = a.ws; const float* g_ffn = a.in[7]; const float* pu = a.in[10]; const float* pv = a.in[11];
    float* suv = (float*)(ws + WS_SUV);
    for (int r = r0 + worker; r < r1; r += nworkers) {
        const bool isv = r >= NEXP; const int e = isv ? r - NEXP : r;
        const f32x4* srcp = (const f32x4*)((isv ? pv : pu) + (size_t)e * DM);
        f32x4 v[8]; float amax = 0.f;
#pragma unroll
        for (int j = 0; j < 8; ++j) { v[j] = srcp[lane + 64 * j];
            if (!isv) { const f32x4 g4 = *(const f32x4*)(g_ffn + 4 * (lane + 64 * j)); v[j] = v[j] * g4; }
            amax = fmaxf(amax, fmaxf(fmaxf(fabsf(v[j][0]), fabsf(v[j][1])), fmaxf(fabsf(v[j][2]), fabsf(v[j][3])))); }
        amax = wave_max(amax);
        const float sc = amax > 0.f ? 127.f / amax : 1.f;
        unsigned char* dst = ws + (isv ? WS_V8 : WS_U8) + (size_t)e * 128;
#pragma unroll
        for (int j = 0; j < 8; ++j) { const int p = pack_i8(v[j][0] * sc, v[j][1] * sc, v[j][2] * sc, v[j][3] * sc);
            const int col = 4 * (lane + 64 * j);
            *(unsigned*)(dst + (size_t)(col >> 7) * ((size_t)NEXP * 128) + (col & 127)) = (unsigned)p; }
        if (lane == 0) suv[r] = 1.f / sc;
    }
}
constexpr int TAB_SPLIT = NEXP;

__device__ __forceinline__ void p0_transpose_item_i8(const float* W, int ldw, int K, unsigned char* WT, int nblk, LAS float* scr, int item, int lane, float q8) {
    const int kb = item / nblk, nb = item % nblk, k0 = 64 * kb, n0 = 32 * nb;
#pragma unroll 8
    for (int i = 0; i < 32; ++i) { const int kk = 2 * i + (lane >> 5); scr[kk * 33 + (lane & 31)] = W[(size_t)(k0 + kk) * ldw + n0 + (lane & 31)] * q8; }
    LDS_WAIT(); asm volatile("" ::: "memory");
    const int c = lane & 7;
#pragma unroll
    for (int j = 0; j < 4; ++j) { const int n = (lane >> 3) + 8 * j; const LAS float* s = scr + (8 * c) * 33 + n;
        u32x2 o; o.x = (unsigned)pack_i8(s[0 * 33], s[1 * 33], s[2 * 33], s[3 * 33]); o.y = (unsigned)pack_i8(s[4 * 33], s[5 * 33], s[6 * 33], s[7 * 33]);
        *(u32x2*)(WT + (size_t)(n0 + n) * K + k0 + 8 * c) = o; }
    LDS_WAIT(); asm volatile("" ::: "memory");
}
__device__ __forceinline__ float log_sigmoid_f(float x) { return fminf(x, 0.f) - log1pf(expf(-fabsf(x))); }

__device__ __forceinline__ void phase0(const Args& a, unsigned char* lds_g) {
    LAS unsigned char* lds = (LAS unsigned char*)lds_g;
    const int tid = tid_opaque(), lane = tid & 63, wave = __builtin_amdgcn_readfirstlane(tid >> 6);
    const int gw = blockIdx.x * NWAVES + wave, NGW = gridDim.x * NWAVES;
    const int gt = blockIdx.x * NTHREADS + tid, NGT = gridDim.x * NTHREADS;
    unsigned char* ws = a.ws;
    const float* x = a.in[0]; const float* g_attn = a.in[1]; const float* w_in = a.in[2]; const float* b_forget = a.in[3];
    const float* w_out = a.in[6]; const float* g_ffn = a.in[7]; const float* w_pq = a.in[8]; const float* sk = a.in[9]; const float* pu = a.in[10]; const float* pv = a.in[11];
    { float m = 0.f; const f32x4* wp = (const f32x4*)w_in;
      for (size_t i = gt; i < (size_t)DM * DIN / 4; i += NGT) { const f32x4 v = wp[i]; m = fmaxf(m, fmaxf(fmaxf(fabsf(v[0]), fabsf(v[1])), fmaxf(fabsf(v[2]), fabsf(v[3])))); }
      m = wave_max(m);
      if (lane == 0) __hip_atomic_fetch_max((unsigned*)(ws + WS_CTL) + CW_WMAX, __float_as_uint(m), __ATOMIC_RELAXED, __HIP_MEMORY_SCOPE_AGENT); }
    LAS float* wf = (LAS float*)(lds + 67584);
    for (int k = tid; k < DM; k += NTHREADS) { const f32x4 a0 = *(const f32x4*)(w_in + (size_t)k * DIN + NPROJ), a1 = *(const f32x4*)(w_in + (size_t)k * DIN + NPROJ + 4);
        *(LAS f32x4*)(wf + k * 8) = a0; *(LAS f32x4*)(wf + k * 8 + 4) = a1; }
    __syncthreads();
    for (int row = gw; row < T; row += NGW) {
        const f32x4* xr = (const f32x4*)(x + (size_t)row * DM);
        f32x4 v[8]; float ss = 0.f;
#pragma unroll
        for (int j = 0; j < 8; ++j) { v[j] = xr[lane + 64 * j]; ss += v[j][0] * v[j][0] + v[j][1] * v[j][1] + v[j][2] * v[j][2] + v[j][3] * v[j][3]; }
        const float r = 1.0f / sqrtf(wave_sum(ss) * (1.f / DM) + EPS);
        float f[8] = {0.f, 0.f, 0.f, 0.f, 0.f, 0.f, 0.f, 0.f};
        float xmax = 0.f;
#pragma unroll
        for (int j = 0; j < 8; ++j) { const f32x4 g4 = *(const f32x4*)(g_attn + 4 * (lane + 64 * j)); v[j][0] *= r * g4[0]; v[j][1] *= r * g4[1]; v[j][2] *= r * g4[2]; v[j][3] *= r * g4[3];
            xmax = fmaxf(xmax, fmaxf(fmaxf(fabsf(v[j][0]), fabsf(v[j][1])), fmaxf(fabsf(v[j][2]), fabsf(v[j][3])))); }
        xmax = wave_max(xmax);
        const float xq = xmax > 0.f ? 127.f / xmax : 1.f;
        if (lane == 0) ((float*)(ws + WS_SXN))[row] = xmax * (1.f / 127.f);
        unsigned* o8 = (unsigned*)(ws + WS_XN + (size_t)row * DM);
#pragma unroll
        for (int j = 0; j < 8; ++j) {
            const int e = 4 * (lane + 64 * j);
            const f32x4 xn = v[j];
            o8[lane + 64 * j] = (unsigned)pack_i8(xn[0] * xq, xn[1] * xq, xn[2] * xq, xn[3] * xq);
#pragma unroll
            for (int q = 0; q < 4; ++q) { const f32x4 w0 = *(LAS f32x4*)(wf + (e + q) * 8), w1 = *(LAS f32x4*)(wf + (e + q) * 8 + 4);
                f[0] += xn[q] * w0[0]; f[1] += xn[q] * w0[1]; f[2] += xn[q] * w0[2]; f[3] += xn[q] * w0[3];
                f[4] += xn[q] * w1[0]; f[5] += xn[q] * w1[1]; f[6] += xn[q] * w1[2]; f[7] += xn[q] * w1[3]; }
            __builtin_amdgcn_sched_barrier(0);
        }
#pragma unroll
        for (int hh = 0; hh < 8; ++hh) f[hh] = wave_sum(f[hh]);
        if (lane < 8) { float fl = f[0];
#pragma unroll
            for (int hh = 1; hh < 8; ++hh) fl = (lane == hh) ? f[hh] : fl;
            const int b = row >> 12, s = row & 4095;
            ((float*)(ws + WS_LOGF))[(size_t)(b * 8 + lane) * SEQ + s] = log_sigmoid_f(fl + b_forget[lane]); }
    }
    LAS float* scr = (LAS float*)(lds + wave * 8448);
    constexpr int I_IN = (DM / 64) * (NPROJ / 32), I_O = (DM / 64) * (DM / 32);
    for (int it = gw; it < 2 * I_O; it += NGW) {
        int r = it;
        if (r < I_O) { p0_transpose_item(w_out, DM, DM, (bf16_t*)(ws + WS_WOUT), DM / 32, scr, r, lane, nullptr); continue; } r -= I_O;
        p0_transpose_item(w_pq, DM, DM, (bf16_t*)(ws + WS_WPQ), DM / 32, scr, r, lane, g_ffn);
    }
    for (int i = gt; i < 8 * 2 * 128 * 128 / 8; i += NGT) { const f32x4 a0 = *(const f32x4*)(sk + (size_t)i * 8), a1 = *(const f32x4*)(sk + (size_t)i * 8 + 4);
        u32x4 w; w.x = cvt_pk_bf16(a0[0], a0[1]); w.y = cvt_pk_bf16(a0[2], a0[3]); w.z = cvt_pk_bf16(a1[0], a1[1]); w.w = cvt_pk_bf16(a1[2], a1[3]);
        *(u32x4*)(ws + WS_SK + (size_t)i * 16) = w; }
    if (gt < 256) ((float*)(ws + WS_GQK))[gt] = gt < 128 ? a.in[4][gt] : a.in[5][gt - 128];
    convert_tables(a, 0, TAB_SPLIT, gw, NGW);
    { XcdBarrier xb_; xb_.bar = (unsigned*)(ws + WS_CTL) + CW_BAR; xb_.x = xb_xcc_id(); xb_.st = (volatile LAS unsigned*)(lds + MISC_OFF) + 8; xcd_barrier(xb_); }
    const float wmax = __uint_as_float(__hip_atomic_load((unsigned*)(ws + WS_CTL) + CW_WMAX, __ATOMIC_RELAXED, __HIP_MEMORY_SCOPE_AGENT));
    if (gt == 0) *(float*)(ws + WS_WSC) = wmax * (1.f / 127.f);
    const float q8 = wmax > 0.f ? 127.f / wmax : 1.f;
    for (int it = gw; it < I_IN; it += NGW) p0_transpose_item_i8(w_in, DIN, DM, ws + WS_WIN, NPROJ / 32, scr, it, lane, q8);
}

__device__ __forceinline__ void cumsum_rows(const Args& a) {
    const int tid = tid_opaque(), lane = tid & 63, wave = tid >> 6;
    if (blockIdx.x >= 16 || wave != 0) return;
    const float* src = (const float*)(a.ws + WS_LOGF) + (size_t)blockIdx.x * SEQ + lane * 64;
    float* dst = (float*)(a.ws + WS_C) + (size_t)blockIdx.x * SEQ + lane * 64;
    f32x4 v[16]; float run = 0.f;
#pragma unroll
    for (int i = 0; i < 16; ++i) { v[i] = *(const f32x4*)(src + 4 * i);
#pragma unroll
        for (int q = 0; q < 4; ++q) { run += v[i][q]; v[i][q] = run; } }
    float incl = run;
#pragma unroll
    for (int o = 1; o < 64; o <<= 1) { const float t = shup_f(incl, o); if (lane >= o) incl += t; }
    const float off = incl - run;
#pragma unroll
    for (int i = 0; i < 16; ++i) { f32x4 w = v[i]; w[0] += off; w[1] += off; w[2] += off; w[3] += off; *(f32x4*)(dst + 4 * i) = w; }
}

__device__ __forceinline__ void phase_qknorm(const Args& a) {
    const int tid = tid_opaque(), lane = tid & 63, wave = tid >> 6;
    const int gw = blockIdx.x * NWAVES + wave, NGW = gridDim.x * NWAVES;
    const int sub = lane & 15, rw = lane >> 4;
    const float* gq = a.in[4]; const float* gk = a.in[5];
    constexpr int ROWS = NB * NHF * SEQ;
    for (int it = gw; it < 2 * ROWS / 4; it += NGW) {
        const int row = it * 4 + rw; const bool isk = row >= ROWS;
        bf16_t* p = (bf16_t*)(a.ws + WS_SEC) + (size_t)row * HD + sub * 8;
        const float* g = (isk ? gk : gq) + sub * 8;
        const u32x4 w = *(const u32x4*)p;
        float v[8] = {bf_lo(w.x), bf_hi(w.x), bf_lo(w.y), bf_hi(w.y), bf_lo(w.z), bf_hi(w.z), bf_lo(w.w), bf_hi(w.w)};
        float ss = 0.f;
#pragma unroll
        for (int i = 0; i < 8; ++i) ss += v[i] * v[i];
        ss += sx_f(ss, 1); ss += sx_f(ss, 2); ss += sx_f(ss, 4); ss += sx_f(ss, 8);
        const float r = 1.0f / sqrtf(ss * (1.f / HD) + EPS);
        const f32x4 g0 = *(const f32x4*)g, g1 = *(const f32x4*)(g + 4);
        u32x4 o; o.x = cvt_pk_bf16(v[0] * r * g0[0], v[1] * r * g0[1]); o.y = cvt_pk_bf16(v[2] * r * g0[2], v[3] * r * g0[3]);
        o.z = cvt_pk_bf16(v[4] * r * g1[0], v[5] * r * g1[1]); o.w = cvt_pk_bf16(v[6] * r * g1[2], v[7] * r * g1[3]);
        *(u32x4*)p = o;
    }
}

__device__ __forceinline__ void phase_attn(const Args& a, unsigned char* lds_g) {
    const int tid = tid_opaque();
    volatile int* s_item = (volatile int*)(lds_g + MISC_OFF);
    unsigned* ctr = (unsigned*)(a.ws + WS_CTL);
    for (;;) {
        __syncthreads();
        if (tid == 0) *s_item = (int)atomicAdd(ctr, 1u);
        __syncthreads();
        int it = *s_item, kind = -1, qb = 0, sub = 0;
#define CLS(K, Q, CNT) if (kind < 0) { if (it < (CNT)) { kind = (K); qb = (Q); sub = it; } else it -= (CNT); }
        CLS(2, 15, 32) CLS(1, 7, 16) CLS(2, 14, 32) CLS(2, 13, 32) CLS(1, 6, 16) CLS(2, 12, 32) CLS(2, 11, 32) CLS(1, 5, 16) CLS(2, 10, 32) CLS(2, 9, 32) CLS(1, 4, 16) CLS(2, 8, 32) CLS(1, 3, 16) CLS(1, 2, 16)
        if (kind < 0) { if (it < 256) { kind = 0; qb = 15 - (it >> 4); sub = it & 15; } else it -= 256; }
        CLS(1, 1, 16) CLS(1, 0, 16)
#undef CLS
        if (kind < 0) break;
        unsigned char* wsl = a.ws; asm volatile("" : "+s"(wsl));
        bf16_t* sec = (bf16_t*)(wsl + WS_SEC);
        const int bh = sub & 15, part = (kind == 2) ? 1 + (sub >> 4) : 0;
        const int b = bh >> 3, h = bh & 7;
        const size_t hoff = (size_t)bh * SEQ * HD;
        att::UnitRef u;
        u.P0 = qb * 256;
        if (kind == 0) {
            u.Q = sec + 4 * SEC_ELEMS + hoff + (size_t)u.P0 * HD; u.K = sec + 5 * SEC_ELEMS + hoff; u.V = sec + 6 * SEC_ELEMS + hoff;
            att::sb_unit(u, (bf16_t*)(wsl + WS_MIX) + (size_t)b * SEQ * DM + 1024 + h * HD, (char*)lds_g);
        } else {
            u.Q = sec + 0 * SEC_ELEMS + hoff + (size_t)u.P0 * HD; u.K = sec + 1 * SEC_ELEMS + hoff; u.V = sec + 2 * SEC_ELEMS + hoff;
            att::attn_unit<false>(u, wsl, bh, (char*)lds_g, part);
        }
    }
}
__device__ __forceinline__ void phase_attn_combine(const Args& a) {
    const int gt = blockIdx.x * NTHREADS + tid_opaque(), NGT = gridDim.x * NTHREADS;
    const float* po = (const float*)(a.ws + WS_PO); const float* pml = (const float*)(a.ws + WS_PML);
    const bf16_t* gate = (const bf16_t*)(a.ws + WS_SEC) + 3 * SEC_ELEMS; bf16_t* mix = (bf16_t*)(a.ws + WS_MIX);
    constexpr float C2 = LOG2E * SCALE;
    for (int item = gt; item < 128 * 256 * 16; item += NGT) {
        const int slot = item >> 12, row = (item >> 4) & 255, cg = item & 15;
        const int qb = 8 + (slot >> 4), bh = slot & 15, b = bh >> 3, h = bh & 7;
        const f32x2 ml1 = *(const f32x2*)(pml + (size_t)(slot * 2) * 512 + row * 2), ml2 = *(const f32x2*)(pml + (size_t)(slot * 2 + 1) * 512 + row * 2);
        const float M = fmaxf(ml1.x, ml2.x), a1 = __builtin_amdgcn_exp2f((ml1.x - M) * C2), a2 = __builtin_amdgcn_exp2f((ml2.x - M) * C2);
        const float inv = 1.f / (a1 * ml1.y + a2 * ml2.y);
        const float* p1 = po + (size_t)(slot * 2) * 32768 + row * 128 + cg * 8; const float* p2 = p1 + 32768;
        const f32x4 x0 = *(const f32x4*)p1, x1 = *(const f32x4*)(p1 + 4), y0 = *(const f32x4*)p2, y1 = *(const f32x4*)(p2 + 4);
        const size_t tok = (size_t)b * SEQ + qb * 256 + row;
        const u32x4 gw = *(const u32x4*)(gate + tok * 1024 + h * HD + cg * 8);
        const float w1 = a1 * inv, w2 = a2 * inv;
        u32x4 o;
        o.x = cvt_pk_bf16((w1 * x0[0] + w2 * y0[0]) * bf_lo(gw.x), (w1 * x0[1] + w2 * y0[1]) * bf_hi(gw.x));
        o.y = cvt_pk_bf16((w1 * x0[2] + w2 * y0[2]) * bf_lo(gw.y), (w1 * x0[3] + w2 * y0[3]) * bf_hi(gw.y));
        o.z = cvt_pk_bf16((w1 * x1[0] + w2 * y1[0]) * bf_lo(gw.z), (w1 * x1[1] + w2 * y1[1]) * bf_hi(gw.z));
        o.w = cvt_pk_bf16((w1 * x1[2] + w2 * y1[2]) * bf_lo(gw.w), (w1 * x1[3] + w2 * y1[3]) * bf_hi(gw.w));
        *(u32x4*)(mix + tok * DM + h * HD + cg * 8) = o;
    }
}

__device__ __forceinline__ unsigned f2ord(float f) { const unsigned u = __float_as_uint(f); return u ^ ((unsigned)((int)u >> 31) | 0x80000000u); }
__device__ __forceinline__ float ord2f(unsigned k) { const unsigned u = k ^ (~(unsigned)((int)k >> 31) | 0x80000000u); return __uint_as_float(u); }
#define INS16(L, X) do { unsigned x_ = (X); _Pragma("unroll") for (int i_ = 0; i_ < 16; ++i_) { const unsigned hi_ = max(L[i_], x_); x_ = min(L[i_], x_); L[i_] = hi_; } } while (0)
__device__ __forceinline__ void sort16_desc(unsigned (&a)[16]) {
#pragma unroll
    for (int k = 2; k <= 16; k <<= 1)
#pragma unroll
        for (int j = k >> 1; j > 0; j >>= 1)
#pragma unroll
            for (int i = 0; i < 16; ++i) { const int l = i ^ j; if (l > i) { const unsigned hi_ = max(a[i], a[l]), lo_ = min(a[i], a[l]); const bool desc = (i & k) == 0; a[i] = desc ? hi_ : lo_; a[l] = desc ? lo_ : hi_; } }
}
__device__ __forceinline__ void merge_top16(unsigned (&a)[16], const unsigned (&b)[16]) {
#pragma unroll
    for (int i = 0; i < 16; ++i) a[i] = max(a[i], b[15 - i]);
#pragma unroll
    for (int j = 8; j > 0; j >>= 1)
#pragma unroll
        for (int i = 0; i < 16; ++i) { const int l = i ^ j; if (l > i) { const unsigned hi_ = max(a[i], a[l]), lo_ = min(a[i], a[l]); a[i] = hi_; a[l] = lo_; } }
}
__device__ __forceinline__ void topk_half(const bf16_t* qp, const bf16_t* skb, int t0, int h, int c, int r32, int hi, unsigned (&L)[16]) {
    bf16x8 qf[8];
#pragma unroll
    for (int d0 = 0; d0 < 8; ++d0) qf[d0] = *(const bf16x8*)(qp + (size_t)(t0 + r32) * DM + h * 256 + c * 128 + d0 * 16 + hi * 8);
    const unsigned hi4 = 4u * (unsigned)hi;
#pragma unroll
    for (int kt = 0; kt < 4; ++kt) {
        f32x16 acc = f32x16{};
#pragma unroll
        for (int d0 = 0; d0 < 8; ++d0) { const bf16x8 kf = *(const bf16x8*)(skb + (size_t)((h * 2 + c) * 128 + kt * 32 + r32) * 128 + d0 * 16 + hi * 8);
            acc = __builtin_amdgcn_mfma_f32_32x32x16_bf16(kf, qf[d0], acc, 0, 0, 0); }
        __builtin_amdgcn_sched_barrier(0);
        unsigned G[16];
#pragma unroll
        for (int r = 0; r < 16; ++r) { const unsigned cst = (unsigned)(127 - (kt * 32 + (r & 3) + 8 * (r >> 2))); G[r] = (f2ord(acc[r]) & ~127u) | (cst - hi4); }
        sort16_desc(G);
        if (kt == 0) {
#pragma unroll
            for (int i = 0; i < 16; ++i) L[i] = G[i];
        } else merge_top16(L, G);
        __builtin_amdgcn_sched_barrier(0);
    }
    unsigned P[16];
#pragma unroll
    for (int i = 0; i < 16; ++i) { auto rr = __builtin_amdgcn_permlane32_swap(L[i], L[i], false, false); P[i] = hi ? rr[0] : rr[1]; }
    merge_top16(L, P);
}
__device__ __forceinline__ void phase_topk(const Args& a, unsigned char* lds_g) {
    LAS unsigned char* lds = (LAS unsigned char*)lds_g;
    const int tid = tid_opaque(), lane = tid & 63, wave = tid >> 6, r32 = lane & 31, hi = lane >> 5;
    const int gw = blockIdx.x * NWAVES + wave, NGW = gridDim.x * NWAVES;
    const bf16_t* skb = (const bf16_t*)(a.ws + WS_SK); const bf16_t* qp = (const bf16_t*)(a.ws + WS_QP);
    int* idx_o = (int*)(a.ws + WS_IDX); float* gw_o = (float*)(a.ws + WS_GW);
    for (int task = gw; task < (T / 32) * 8; task += NGW) {
        const int h = task & 7, t0 = (task >> 3) * 32;
        {
          const bf16_t* hbp = (const bf16_t*)(a.ws + WS_HB); const float* amx = (const float*)(a.ws + WS_AMX); unsigned char* xq = a.ws + WS_XQ;
          float am = 0.f;
          { const f32x4* ap = (const f32x4*)(amx + (size_t)(t0 + (lane & 31)) * 32);
#pragma unroll
            for (int i = 0; i < 8; ++i) { const f32x4 v = ap[i]; am = fmaxf(am, fmaxf(fmaxf(v[0], v[1]), fmaxf(v[2], v[3]))); } }
          if (h == 0 && lane < 32) ((float*)(a.ws + WS_SX))[t0 + lane] = ((const float*)(a.ws + WS_RT))[t0 + lane] * am * (1.f / 126.5f);
          const float qs = am > 0.f ? 126.5f / am : 1.f;
#pragma unroll 4
          for (int j = 0; j < 16; ++j) { const int ch = lane + 64 * j, tl = ch >> 5, tk = t0 + tl, col = h * 256 + (ch & 31) * 8;
              const u32x4 w = *(const u32x4*)(hbp + (size_t)tk * DM + col); const float r = sh_f(qs, tl);
              const int p0 = pack_i8(bf_lo(w.x) * r, bf_hi(w.x) * r, bf_lo(w.y) * r, bf_hi(w.y) * r), p1 = pack_i8(bf_lo(w.z) * r, bf_hi(w.z) * r, bf_lo(w.w) * r, bf_hi(w.w) * r);
              *(u32x2*)(xq + (size_t)tk * DM + col) = (u32x2){(unsigned)p0, (unsigned)p1}; } }
        unsigned L[2][16];
        topk_half(qp, skb, t0, h, 0, r32, hi, L[0]);
        __builtin_amdgcn_sched_barrier(0);
        topk_half(qp, skb, t0, h, 1, r32, hi, L[1]);
        __builtin_amdgcn_sched_barrier(0);
        float s1[16], s2[16]; int i1[16], i2[16];
#pragma unroll
        for (int i = 0; i < 16; ++i) { s1[i] = ord2f((L[0][i] & ~127u) | 64u); i1[i] = 127 - (int)(L[0][i] & 127u); s2[i] = ord2f((L[1][i] & ~127u) | 64u); i2[i] = 127 - (int)(L[1][i] & 127u); }
        unsigned CG[4][16];
#pragma unroll
        for (int i = 0; i < 64; ++i) CG[i >> 4][i & 15] = 0u;
        CG[0][0] = (f2ord(s1[0] + s2[0]) & ~255u) | 0u;
        CG[0][1] = (f2ord(s1[0] + s2[1]) & ~255u) | 1u;
        CG[0][2] = (f2ord(s1[0] + s2[2]) & ~255u) | 2u;
        CG[0][3] = (f2ord(s1[0] + s2[3]) & ~255u) | 3u;
        CG[0][4] = (f2ord(s1[0] + s2[4]) & ~255u) | 4u;
        CG[0][5] = (f2ord(s1[0] + s2[5]) & ~255u) | 5u;
        CG[0][6] = (f2ord(s1[0] + s2[6]) & ~255u) | 6u;
        CG[0][7] = (f2ord(s1[0] + s2[7]) & ~255u) | 7u;
        CG[0][8] = (f2ord(s1[0] + s2[8]) & ~255u) | 8u;
        CG[0][9] = (f2ord(s1[0] + s2[9]) & ~255u) | 9u;
        CG[0][10] = (f2ord(s1[0] + s2[10]) & ~255u) | 10u;
        CG[0][11] = (f2ord(s1[0] + s2[11]) & ~255u) | 11u;
        CG[0][12] = (f2ord(s1[0] + s2[12]) & ~255u) | 12u;
        CG[0][13] = (f2ord(s1[0] + s2[13]) & ~255u) | 13u;
        CG[0][14] = (f2ord(s1[0] + s2[14]) & ~255u) | 14u;
        CG[0][15] = (f2ord(s1[0] + s2[15]) & ~255u) | 15u;
        CG[1][0] = (f2ord(s1[1] + s2[0]) & ~255u) | 16u;
        CG[1][1] = (f2ord(s1[1] + s2[1]) & ~255u) | 17u;
        CG[1][2] = (f2ord(s1[1] + s2[2]) & ~255u) | 18u;
        CG[1][3] = (f2ord(s1[1] + s2[3]) & ~255u) | 19u;
        CG[1][4] = (f2ord(s1[1] + s2[4]) & ~255u) | 20u;
        CG[1][5] = (f2ord(s1[1] + s2[5]) & ~255u) | 21u;
        CG[1][6] = (f2ord(s1[1] + s2[6]) & ~255u) | 22u;
        CG[1][7] = (f2ord(s1[1] + s2[7]) & ~255u) | 23u;
        CG[1][8] = (f2ord(s1[2] + s2[0]) & ~255u) | 32u;
        CG[1][9] = (f2ord(s1[2] + s2[1]) & ~255u) | 33u;
        CG[1][10] = (f2ord(s1[2] + s2[2]) & ~255u) | 34u;
        CG[1][11] = (f2ord(s1[2] + s2[3]) & ~255u) | 35u;
        CG[1][12] = (f2ord(s1[2] + s2[4]) & ~255u) | 36u;
        CG[1][13] = (f2ord(s1[3] + s2[0]) & ~255u) | 48u;
        CG[1][14] = (f2ord(s1[3] + s2[1]) & ~255u) | 49u;
        CG[1][15] = (f2ord(s1[3] + s2[2]) & ~255u) | 50u;
        CG[2][0] = (f2ord(s1[3] + s2[3]) & ~255u) | 51u;
        CG[2][1] = (f2ord(s1[4] + s2[0]) & ~255u) | 64u;
        CG[2][2] = (f2ord(s1[4] + s2[1]) & ~255u) | 65u;
        CG[2][3] = (f2ord(s1[4] + s2[2]) & ~255u) | 66u;
        CG[2][4] = (f2ord(s1[5] + s2[0]) & ~255u) | 80u;
        CG[2][5] = (f2ord(s1[5] + s2[1]) & ~255u) | 81u;
        CG[2][6] = (f2ord(s1[6] + s2[0]) & ~255u) | 96u;
        CG[2][7] = (f2ord(s1[6] + s2[1]) & ~255u) | 97u;
        CG[2][8] = (f2ord(s1[7] + s2[0]) & ~255u) | 112u;
        CG[2][9] = (f2ord(s1[7] + s2[1]) & ~255u) | 113u;
        CG[2][10] = (f2ord(s1[8] + s2[0]) & ~255u) | 128u;
        CG[2][11] = (f2ord(s1[9] + s2[0]) & ~255u) | 144u;
        CG[2][12] = (f2ord(s1[10] + s2[0]) & ~255u) | 160u;
        CG[2][13] = (f2ord(s1[11] + s2[0]) & ~255u) | 176u;
        CG[2][14] = (f2ord(s1[12] + s2[0]) & ~255u) | 192u;
        CG[2][15] = (f2ord(s1[13] + s2[0]) & ~255u) | 208u;
        CG[3][0] = (f2ord(s1[14] + s2[0]) & ~255u) | 224u;
        CG[3][1] = (f2ord(s1[15] + s2[0]) & ~255u) | 240u;
        sort16_desc(CG[0]); sort16_desc(CG[1]); sort16_desc(CG[2]); sort16_desc(CG[3]);
        merge_top16(CG[0], CG[1]); merge_top16(CG[2], CG[3]); merge_top16(CG[0], CG[2]);
        unsigned LC[16];
#pragma unroll
        for (int i = 0; i < 16; ++i) LC[i] = CG[0][i];
        LAS int* tb = (LAS int*)(lds + wave * 8192);
#pragma unroll
        for (int i = 0; i < 16; ++i) { tb[i * 64 + lane] = i1[i]; tb[(16 + i) * 64 + lane] = i2[i]; }
        float LS[16]; int LP[16];
#pragma unroll
        for (int i = 0; i < 16; ++i) { const unsigned cid = LC[i] & 255u; LS[i] = ord2f((LC[i] & ~255u) | 128u);
            LP[i] = tb[(cid >> 4) * 64 + lane] * 128 + tb[(16 + (cid & 15u)) * 64 + lane]; }
        float den = 0.f, e[16];
#pragma unroll
        for (int i = 0; i < 16; ++i) { e[i] = __expf(LS[i] - LS[0]); den += e[i]; }
        const float rden = 1.f / den;
        const size_t ob = (size_t)(t0 + r32) * NE + h * 16;
        if (hi == 0) {
#pragma unroll
            for (int i = 0; i < 4; ++i) *(int4*)(idx_o + ob + 4 * i) = make_int4(LP[4 * i], LP[4 * i + 1], LP[4 * i + 2], LP[4 * i + 3]);
        } else {
#pragma unroll
            for (int i = 0; i < 4; ++i) *(f32x4*)(gw_o + ob + 4 * i) = (f32x4){e[4 * i] * rden, e[4 * i + 1] * rden, e[4 * i + 2] * rden, e[4 * i + 3] * rden};
        }
    }
}


__device__ __forceinline__ void wave_argmax(float& v, int& i) {
#pragma unroll
    for (int o = 1; o < 64; o <<= 1) { const float ov = sx_f(v, o); const int oi = sx_i(i, o); if (ov > v || (ov == v && oi < i)) { v = ov; i = oi; } }
}
__device__ __forceinline__ void phase_topk_ref(const Args& a) {
    const int tid = tid_opaque(), lane = tid & 63, wave = tid >> 6;
    const int gw = blockIdx.x * NWAVES + wave, NGW = gridDim.x * NWAVES;
    const bf16_t* skb = (const bf16_t*)(a.ws + WS_SK); const bf16_t* qp = (const bf16_t*)(a.ws + WS_QP);
    int* idx_o = (int*)(a.ws + WS_IDX); float* gw_o = (float*)(a.ws + WS_GW);
    for (int task = gw; task < T * 8; task += NGW) {
        const int t = task >> 3, h = task & 7;
        float topS[2]; int topI[2];
        for (int c = 0; c < 2; ++c) {
            const bf16_t* q = qp + (size_t)t * DM + h * 256 + c * 128;
            float sc0 = 0.f, sc1 = 0.f;
            const bf16_t* k0 = skb + (size_t)((h * 2 + c) * 128 + lane) * 128; const bf16_t* k1 = k0 + 64 * 128;
            for (int d = 0; d < 128; ++d) { const float qd = __uint_as_float((unsigned)q[d] << 16);
                sc0 += qd * __uint_as_float((unsigned)k0[d] << 16); sc1 += qd * __uint_as_float((unsigned)k1[d] << 16); }
            float ms = 0.f; int mi = 0;
            for (int r = 0; r < 16; ++r) {
                float v; int i; if (sc0 >= sc1) { v = sc0; i = lane; } else { v = sc1; i = lane + 64; }
                wave_argmax(v, i);
                if (lane == r) { ms = v; mi = i; }
                if (i == lane) sc0 = -__builtin_inff();
                if (i == lane + 64) sc1 = -__builtin_inff();
            }
            topS[c] = ms; topI[c] = mi;
        }
        float cs[4]; int ci[4];
#pragma unroll
        for (int j = 0; j < 4; ++j) { const int cidx = lane * 4 + j, aa = cidx >> 4, bb = cidx & 15;
            cs[j] = sh_f(topS[0], aa) + sh_f(topS[1], bb); ci[j] = cidx; }
        float fs = 0.f; int fi = 0;
        for (int r = 0; r < 16; ++r) {
            float v = cs[0]; int i = ci[0];
#pragma unroll
            for (int j = 1; j < 4; ++j) if (cs[j] > v) { v = cs[j]; i = ci[j]; }
            wave_argmax(v, i);
            if (lane == r) { fs = v; fi = i; }
#pragma unroll
            for (int j = 0; j < 4; ++j) if (ci[j] == i) cs[j] = -__builtin_inff();
        }
        const int e1 = sh_i(topI[0], fi >> 4), e2 = sh_i(topI[1], fi & 15);
        const float mx = sh_f(fs, 0);
        float ev = lane < 16 ? __expf(fs - mx) : 0.f;
        const float den = wave_sum(ev);
        if (lane < 16) { idx_o[(size_t)t * NE + h * 16 + lane] = e1 * 128 + e2; gw_o[(size_t)t * NE + h * 16 + lane] = ev / den; }
    }
}

__device__ __forceinline__ void fp8x16_to_f32(const u32x4 q, f32x2 (&o)[8]) {
    o[0] = __builtin_amdgcn_cvt_pk_f32_fp8((int)q.x, false); o[1] = __builtin_amdgcn_cvt_pk_f32_fp8((int)q.x, true);
    o[2] = __builtin_amdgcn_cvt_pk_f32_fp8((int)q.y, false); o[3] = __builtin_amdgcn_cvt_pk_f32_fp8((int)q.y, true);
    o[4] = __builtin_amdgcn_cvt_pk_f32_fp8((int)q.z, false); o[5] = __builtin_amdgcn_cvt_pk_f32_fp8((int)q.z, true);
    o[6] = __builtin_amdgcn_cvt_pk_f32_fp8((int)q.w, false); o[7] = __builtin_amdgcn_cvt_pk_f32_fp8((int)q.w, true);
}
#define HALVE(dst, srcv, n, bitmask) do { const bool up_ = (lane & (bitmask)) != 0; _Pragma("unroll") for (int i_ = 0; i_ < (n); ++i_) { \
        const float keep_ = up_ ? srcv[(n) + i_] : srcv[i_], send_ = up_ ? srcv[i_] : srcv[(n) + i_]; dst[i_] = keep_ + sx_f(send_, (bitmask)); } } while (0)
#define ITEM_T(n) (wv + ((n) % KT) * NWX)
#define ITEM_S(n) (xl + 8 * ((n) / KT))
#define LD_IDX(ID, n) do { const int4* ip_ = (const int4*)(idx_i + (size_t)ITEM_T(n) * NE + g * 16); _Pragma("unroll") for (int i_ = 0; i_ < 4; ++i_) ID[i_] = ip_[i_]; } while (0)
#define LD_ROWS(Q, ID, TAB, n) do { const unsigned char* b_ = (TAB) + (size_t)ITEM_S(n) * ((size_t)NEXP * 128) + c * 16; _Pragma("unroll") for (int i_ = 0; i_ < 4; ++i_) { \
        Q[4 * i_] = *(const u32x4*)(b_ + (size_t)ID[i_].x * 128); Q[4 * i_ + 1] = *(const u32x4*)(b_ + (size_t)ID[i_].y * 128); \
        Q[4 * i_ + 2] = *(const u32x4*)(b_ + (size_t)ID[i_].z * 128); Q[4 * i_ + 3] = *(const u32x4*)(b_ + (size_t)ID[i_].w * 128); } } while (0)
__device__ __forceinline__ int dpp_hmirror(int v) { return __builtin_amdgcn_update_dpp(0, v, 0x141, 0xf, 0xf, true); }
__device__ __forceinline__ int dpp_qxor2(int v) { return __builtin_amdgcn_update_dpp(0, v, 0x4E, 0xf, 0xf, true); }
__device__ __forceinline__ int dpp_qxor1(int v) { return __builtin_amdgcn_update_dpp(0, v, 0xB1, 0xf, 0xf, true); }
__device__ __forceinline__ void phase_peer_u(const Args& a) {
    const int tid = tid_opaque(), lane = tid & 63, wave = tid >> 6, g = lane >> 3, c = lane & 7;
    const int xl = blockIdx.x & 7, wv = (blockIdx.x >> 3) * NWAVES + wave, NWX = (gridDim.x >> 3) * NWAVES, KT = T / NWX, N = 2 * KT;
    const unsigned char* xq = a.ws + WS_XQ; const unsigned char* u8 = a.ws + WS_U8;
    const int* idx_i = (const int*)(a.ws + WS_IDX); float* part = (float*)(a.ws + WS_PART);
    const bool up4 = (c & 4) != 0, up2 = (c & 2) != 0, up1 = (c & 1) != 0;
#define LD_X(X, n) do { X = *(const u32x4*)(xq + (size_t)ITEM_T(n) * DM + ITEM_S(n) * 128 + c * 16); } while (0)
#define COMPUTE_U(Q, X, n) do { int p[16]; \
        _Pragma("unroll") for (int i = 0; i < 16; ++i) { int d_ = __builtin_amdgcn_sdot4((int)Q[i].x, (int)X.x, 0, false); d_ = __builtin_amdgcn_sdot4((int)Q[i].y, (int)X.y, d_, false); \
            d_ = __builtin_amdgcn_sdot4((int)Q[i].z, (int)X.z, d_, false); p[i] = __builtin_amdgcn_sdot4((int)Q[i].w, (int)X.w, d_, false); } \
        int p8[8], p4[4], p2[2]; \
        _Pragma("unroll") for (int i = 0; i < 8; ++i) { const int keep_ = up4 ? p[8 + i] : p[i], send_ = up4 ? p[i] : p[8 + i]; p8[i] = keep_ + dpp_hmirror(send_); } \
        _Pragma("unroll") for (int i = 0; i < 4; ++i) { const int keep_ = up2 ? p8[4 + i] : p8[i], send_ = up2 ? p8[i] : p8[4 + i]; p4[i] = keep_ + dpp_qxor2(send_); } \
        _Pragma("unroll") for (int i = 0; i < 2; ++i) { const int keep_ = up1 ? p4[2 + i] : p4[i], send_ = up1 ? p4[i] : p4[2 + i]; p2[i] = keep_ + dpp_qxor1(send_); } \
        *(f32x2*)(part + ((size_t)ITEM_T(n) * 16 + ITEM_S(n)) * NE + 2 * lane) = (f32x2){(float)p2[0], (float)p2[1]}; } while (0)
    int4 IA[4], IB[4]; u32x4 QA[16], QB[16], XA, XB;
    LD_IDX(IA, 0); LD_IDX(IB, 1);
    LD_ROWS(QA, IA, u8, 0); LD_X(XA, 0);
    for (int n = 0; n < N; n += 2) {
        LD_ROWS(QB, IB, u8, n + 1); LD_X(XB, n + 1);
        if (n + 2 < N) LD_IDX(IA, n + 2);
        COMPUTE_U(QA, XA, n);
        if (n + 2 < N) { LD_ROWS(QA, IA, u8, n + 2); LD_X(XA, n + 2); }
        if (n + 3 < N) LD_IDX(IB, n + 3);
        COMPUTE_U(QB, XB, n + 1);
    }
#undef LD_X
#undef COMPUTE_U
}
__device__ __forceinline__ void phase_peer_w(const Args& a) {
    const int gt = blockIdx.x * NTHREADS + tid_opaque(), NGT = gridDim.x * NTHREADS;
    const int* idx_i = (const int*)(a.ws + WS_IDX); const float* gw_i = (const float*)(a.ws + WS_GW); const float* part = (const float*)(a.ws + WS_PART);
    const float* suv = (const float*)(a.ws + WS_SUV); const float* sx = (const float*)(a.ws + WS_SX);
    signed char* wq = (signed char*)(a.ws + WS_WQ); float* sw = (float*)(a.ws + WS_SW);
    for (int item = gt; item < T * NE; item += NGT) {
        const int t = item >> 7, e = item & 127;
        float sum = 0.f;
#pragma unroll
        for (int s = 0; s < 16; ++s) sum += part[((size_t)t * 16 + s) * NE + e];
        const int ex = idx_i[item];
        const float d = sum * suv[ex] * sx[t];
        const float om = 0.5f * d * (1.f + erff(d * 0.70710678118654752f)) * gw_i[item] * suv[NEXP + ex];
        float mx = fabsf(om);
        mx = fmaxf(mx, sx_f(mx, 1)); mx = fmaxf(mx, sx_f(mx, 2)); mx = fmaxf(mx, sx_f(mx, 4)); mx = fmaxf(mx, sx_f(mx, 8));
        const float qs = mx > 0.f ? 127.f / mx : 1.f;
        wq[item] = (signed char)(int)__builtin_rintf(om * qs);
        if ((e & 15) == 0) sw[t * 8 + (e >> 4)] = mx * (1.f / 127.f);
    }
}
__device__ __forceinline__ void phase_peer_v(const Args& a, float* dst) {
    const int tid = tid_opaque(), lane = tid & 63, wave = tid >> 6, g = lane >> 3, c = lane & 7;
    const int xl = blockIdx.x & 7, wv = (blockIdx.x >> 3) * NWAVES + wave, NWX = (gridDim.x >> 3) * NWAVES, KT = T / NWX, N = 2 * KT;
    const unsigned char* v8 = a.ws + WS_V8;
    const int* idx_i = (const int*)(a.ws + WS_IDX); const unsigned char* wq = a.ws + WS_WQ; const float* sw = (const float*)(a.ws + WS_SW);
    const float* hsrc = a.out;
#define LD_W(W, SWV, n) do { W = *(const u32x4*)(wq + (size_t)ITEM_T(n) * NE + g * 16); SWV = sw[ITEM_T(n) * 8 + g]; } while (0)
#define QUAD(A_, B_, C_, D_, W_, A0, A1, A2, A3) do { \
        const unsigned ablo_ = __builtin_amdgcn_perm(B_, A_, 0x05010400u), abhi_ = __builtin_amdgcn_perm(B_, A_, 0x07030602u); \
        const unsigned cdlo_ = __builtin_amdgcn_perm(D_, C_, 0x05010400u), cdhi_ = __builtin_amdgcn_perm(D_, C_, 0x07030602u); \
        A0 = __builtin_amdgcn_sdot4((int)__builtin_amdgcn_perm(cdlo_, ablo_, 0x05040100u), (int)(W_), A0, false); \
        A1 = __builtin_amdgcn_sdot4((int)__builtin_amdgcn_perm(cdlo_, ablo_, 0x07060302u), (int)(W_), A1, false); \
        A2 = __builtin_amdgcn_sdot4((int)__builtin_amdgcn_perm(cdhi_, abhi_, 0x05040100u), (int)(W_), A2, false); \
        A3 = __builtin_amdgcn_sdot4((int)__builtin_amdgcn_perm(cdhi_, abhi_, 0x07060302u), (int)(W_), A3, false); } while (0)
#define COMPUTE_V(Q, W, SWV, n) do { int ac[16]; _Pragma("unroll") for (int k = 0; k < 16; ++k) ac[k] = 0; \
        _Pragma("unroll") for (int q_ = 0; q_ < 4; ++q_) { const unsigned w_ = q_ == 0 ? W.x : q_ == 1 ? W.y : q_ == 2 ? W.z : W.w; \
            QUAD(Q[4 * q_].x, Q[4 * q_ + 1].x, Q[4 * q_ + 2].x, Q[4 * q_ + 3].x, w_, ac[0], ac[1], ac[2], ac[3]); \
            QUAD(Q[4 * q_].y, Q[4 * q_ + 1].y, Q[4 * q_ + 2].y, Q[4 * q_ + 3].y, w_, ac[4], ac[5], ac[6], ac[7]); \
            QUAD(Q[4 * q_].z, Q[4 * q_ + 1].z, Q[4 * q_ + 2].z, Q[4 * q_ + 3].z, w_, ac[8], ac[9], ac[10], ac[11]); \
            QUAD(Q[4 * q_].w, Q[4 * q_ + 1].w, Q[4 * q_ + 2].w, Q[4 * q_ + 3].w, w_, ac[12], ac[13], ac[14], ac[15]); } \
        float p[16]; _Pragma("unroll") for (int k = 0; k < 16; ++k) p[k] = (float)ac[k] * SWV; \
        float p8[8], p4[4], p2[2]; \
        _Pragma("unroll") for (int i_ = 0; i_ < 8; ++i_) { auto rr_ = __builtin_amdgcn_permlane32_swap(__float_as_uint(p[i_]), __float_as_uint(p[8 + i_]), false, false); p8[i_] = __uint_as_float(rr_[0]) + __uint_as_float(rr_[1]); } \
        _Pragma("unroll") for (int i_ = 0; i_ < 4; ++i_) { auto rr_ = __builtin_amdgcn_permlane16_swap(__float_as_uint(p8[i_]), __float_as_uint(p8[4 + i_]), false, false); p4[i_] = __uint_as_float(rr_[0]) + __uint_as_float(rr_[1]); } \
        HALVE(p2, p4, 2, 8); \
        const size_t o_ = (size_t)ITEM_T(n) * DM + ITEM_S(n) * 128 + c * 16 + 2 * g; \
        const f32x2 hv = *(const f32x2*)(hsrc + o_); *(f32x2*)(dst + o_) = (f32x2){hv.x + p2[0], hv.y + p2[1]}; } while (0)
    int4 IA[4], IB[4]; u32x4 QA[16], QB[16], WA, WB; float SA, SB_;
    LD_IDX(IA, 0); LD_IDX(IB, 1);
    LD_ROWS(QA, IA, v8, 0); LD_W(WA, SA, 0);
    for (int n = 0; n < N; n += 2) {
        LD_ROWS(QB, IB, v8, n + 1); LD_W(WB, SB_, n + 1);
        if (n + 2 < N) LD_IDX(IA, n + 2);
        COMPUTE_V(QA, WA, SA, n);
        if (n + 2 < N) { LD_ROWS(QA, IA, v8, n + 2); LD_W(WA, SA, n + 2); }
        if (n + 3 < N) LD_IDX(IB, n + 3);
        COMPUTE_V(QB, WB, SB_, n + 1);
    }
#undef LD_W
#undef QUAD
#undef COMPUTE_V
}
#undef ITEM_T
#undef ITEM_S
#undef LD_IDX
#undef LD_ROWS
#undef HALVE


constexpr int NPHASE = 11;
#define LOAD_ARGS() do { } while (0)
__global__ void __launch_bounds__(NTHREADS, 2) fwd_kernel(Args a) {
    extern __shared__ __attribute__((aligned(16))) unsigned char lds[];
#if MK_ONE_LAUNCH
    constexpr int lo = 0, hi = NPHASE;
    cg::grid_group grid = cg::this_grid();
    volatile LAS unsigned* misc = (volatile LAS unsigned*)((LAS unsigned char*)lds + MISC_OFF);
    if (threadIdx.x < 16) misc[threadIdx.x] = 0u;
    __syncthreads();
    { LOAD_ARGS(); (void)xcd_barrier_post((unsigned*)(a.ws + WS_CTL) + CW_BAR, misc + 8); }
#ifndef SEAM_CG_MASK
#define SEAM_CG_MASK 0
#endif
#define SEAM(k) do { if (lo <= (k) && (k) + 1 < hi) { if ((SEAM_CG_MASK >> (k)) & 1) grid.sync(); else { LOAD_ARGS(); XcdBarrier xb_; xb_.bar = (unsigned*)(a.ws + WS_CTL) + CW_BAR; xb_.x = xb_xcc_id(); \
        xb_.st = (volatile LAS unsigned*)((LAS unsigned char*)lds + MISC_OFF) + 8; xcd_barrier(xb_); } } } while (0)
#else
    int lo, hi; { LOAD_ARGS(); lo = a.ph_lo; hi = a.ph_hi; }
#define SEAM(k) do { } while (0)
#endif
#define IN(k) (lo <= (k) && (k) < hi)
#ifndef DUP_PHASE
#define DUP_PHASE -1
#endif
    if (IN(0)) { LOAD_ARGS(); phase0(a, lds); if (DUP_PHASE == 0) { __syncthreads(); phase0(a, lds); } SEAM(0); }
    if (IN(1)) { LOAD_ARGS(); unsigned char* ws = a.ws;
        cumsum_rows(a);
        pg8::Gemm g{(const bf16_t*)(ws + WS_XN), (const bf16_t*)(ws + WS_WIN), T, NPROJ, DM}; pg8::StaticOrder S; S.init(T, NPROJ, (int)gridDim.x, (int)blockIdx.x);
        pg8::EpiInProj E{(bf16_t*)(ws + WS_SEC), (const float*)(ws + WS_SXN), (const float*)(ws + WS_WSC), a.in[4], a.in[5], (LAS float*)((LAS unsigned char*)lds + RING_BYTES)};
        for (int rep_ = 0; rep_ < (DUP_PHASE == 1 ? 2 : 1); ++rep_)
        pg8::gemm_phase<pg8::EpiInProj, pg8::StaticOrder, true, true, true>((LAS unsigned char*)lds, g, S, E);
        { const int nwg_ = (T / 256) * (NPROJ / 256), G_ = (int)gridDim.x, rem_ = nwg_ % G_;
          if (rem_ > 0 && (int)blockIdx.x >= rem_) convert_tables(a, TAB_SPLIT, 2 * NEXP, ((int)blockIdx.x - rem_) * NWAVES + (tid_opaque() >> 6), (G_ - rem_) * NWAVES);
          else if (rem_ == 0) convert_tables(a, TAB_SPLIT, 2 * NEXP, (int)blockIdx.x * NWAVES + (tid_opaque() >> 6), G_ * NWAVES); }
        SEAM(1);
    }
    if (IN(3)) { LOAD_ARGS(); phase_attn(a, lds);
#if MK_ONE_LAUNCH
        if (DUP_PHASE == 3) { XcdBarrier xb_; xb_.bar = (unsigned*)(a.ws + WS_CTL) + CW_BAR; xb_.x = xb_xcc_id(); xb_.st = (volatile LAS unsigned*)((LAS unsigned char*)lds + MISC_OFF) + 8;
            xcd_barrier(xb_); if (blockIdx.x == 0 && threadIdx.x == 0) __hip_atomic_store((unsigned*)(a.ws + WS_CTL), 0u, __ATOMIC_RELAXED, __HIP_MEMORY_SCOPE_AGENT); xcd_barrier(xb_); phase_attn(a, lds); }
#endif
        SEAM(3); }
    if (IN(4)) { LOAD_ARGS(); phase_attn_combine(a); SEAM(4); }
    if (IN(5)) { LOAD_ARGS(); unsigned char* ws = a.ws;
        pg8::Gemm g{(const bf16_t*)(ws + WS_MIX), (const bf16_t*)(ws + WS_WOUT), T, DM, DM}; pg8::StaticOrder S; S.init(T, DM, (int)gridDim.x, (int)blockIdx.x);
        pg8::EpiOutProj E{a.in[0], a.out, (bf16_t*)(ws + WS_HB), (float*)(ws + WS_SSQ), (float*)(ws + WS_AMX)};
        for (int rep_ = 0; rep_ < (DUP_PHASE == 5 ? 2 : 1); ++rep_)
        pg8::gemm_phase<pg8::EpiOutProj, pg8::StaticOrder, true, true>((LAS unsigned char*)lds, g, S, E);
        SEAM(5);
    }
    if (IN(6)) { LOAD_ARGS(); unsigned char* ws = a.ws;
        pg8::Gemm g{(const bf16_t*)(ws + WS_HB), (const bf16_t*)(ws + WS_WPQ), T, DM, DM}; pg8::StaticOrder S; S.init(T, DM, (int)gridDim.x, (int)blockIdx.x);
        pg8::EpiPeerQ E{(const float*)(ws + WS_SSQ), (bf16_t*)(ws + WS_QP), (float*)(ws + WS_RT)};
        for (int rep_ = 0; rep_ < (DUP_PHASE == 6 ? 2 : 1); ++rep_)
        pg8::gemm_phase<pg8::EpiPeerQ, pg8::StaticOrder, true, true>((LAS unsigned char*)lds, g, S, E);
        SEAM(6);
    }
    #ifdef TOPK_REF
    if (IN(7)) { LOAD_ARGS(); phase_topk_ref(a); SEAM(7); }
#else
    if (IN(7)) { LOAD_ARGS(); for (int rep_ = 0; rep_ < (DUP_PHASE == 7 ? 2 : 1); ++rep_) phase_topk(a, lds); SEAM(7); }
#endif
    if (IN(8)) { LOAD_ARGS(); for (int rep_ = 0; rep_ < (DUP_PHASE == 8 ? 2 : 1); ++rep_) phase_peer_u(a); SEAM(8); }
    if (IN(9)) { LOAD_ARGS(); for (int rep_ = 0; rep_ < (DUP_PHASE == 9 ? 2 : 1); ++rep_) phase_peer_w(a); SEAM(9); }
    if (IN(10)) { LOAD_ARGS(); for (int rep_ = 0; rep_ < (DUP_PHASE == 10 ? 2 : 1); ++rep_) phase_peer_v(a, (DUP_PHASE == 10 && rep_ == 0) ? (float*)(a.ws + WS_END) : a.out); }
#undef IN
#undef SEAM
}

extern "C" void kernel_launch(void* const* d_in, const int* in_sizes, int n_in, void* d_out, int out_size, void* d_ws, size_t ws_size, hipStream_t stream) {
    static int grid = 0;
    if (grid == 0) {
        if (n_in != 12 || in_sizes[0] != T * DM || out_size != T * DM || ws_size < WS_END) { fprintf(stderr, "kernel_launch: unexpected shapes (n_in %d, in0 %d, out %d, ws %zu)\n", n_in, n_in > 0 ? in_sizes[0] : -1, out_size, ws_size); grid = -1; return; }
        int dev = 0, cus = 0, per_cu = 0;
        if (hipGetDevice(&dev) != hipSuccess || hipDeviceGetAttribute(&cus, hipDeviceAttributeMultiprocessorCount, dev) != hipSuccess) { grid = -1; return; }
        if (hipFuncSetAttribute((const void*)fwd_kernel, hipFuncAttributeMaxDynamicSharedMemorySize, LDS_BYTES) != hipSuccess) { fprintf(stderr, "kernel_launch: hipFuncSetAttribute failed\n"); grid = -1; return; }
        if (hipOccupancyMaxActiveBlocksPerMultiprocessor(&per_cu, (const void*)fwd_kernel, NTHREADS, LDS_BYTES) != hipSuccess || per_cu < 1) { fprintf(stderr, "kernel_launch: occupancy query says %d\n", per_cu); grid = -1; return; }
        grid = cus;
    }
    if (grid < 0) return;
    (void)hipMemsetAsync((char*)d_ws + WS_CTL, 0, CTL_BYTES, stream);
    Args a{};
    for (int i = 0; i < 12; ++i) a.in[i] = (const float*)d_in[i];
    a.out = (float*)d_out; a.ws = (unsigned char*)d_ws;
#if MK_ONE_LAUNCH
    a.ph_lo = 0; a.ph_hi = NPHASE;
    void* args[] = {&a};
#if MK_COOP_LAUNCH
    hipError_t e = hipLaunchCooperativeKernel((const void*)fwd_kernel, dim3(grid), dim3(NTHREADS), args, LDS_BYTES, stream);
    if (e != hipSuccess) fprintf(stderr, "cooperative launch failed: %s (grid %d)\n", hipGetErrorString(e), grid);
#else
    (void)args; hipLaunchKernelGGL(fwd_kernel, dim3(grid), dim3(NTHREADS), LDS_BYTES, stream, a);
#endif
#else
    for (int p = 0; p < NPHASE; ++p) { a.ph_lo = p; a.ph_hi = p + 1; hipLaunchKernelGGL(fwd_kernel, dim3(grid), dim3(NTHREADS), LDS_BYTES, stream, a); }
#endif
}
```

```cpp
#include <hip/hip_runtime.h>
#include <hip/hip_cooperative_groups.h>
#include <cstdio>
#include <cstdint>
namespace cg = cooperative_groups;

#ifndef MK_COOP_LAUNCH
#define MK_COOP_LAUNCH 0
#endif
#ifndef MK_ONE_LAUNCH
#define MK_ONE_LAUNCH 1
#endif

#define LAS __attribute__((address_space(3)))
typedef unsigned short bf16_t;
typedef short bf16x8 __attribute__((ext_vector_type(8)));
typedef short s16x4 __attribute__((ext_vector_type(4)));
typedef float f32x2 __attribute__((ext_vector_type(2)));
typedef float f32x4 __attribute__((ext_vector_type(4)));
typedef float f32x16 __attribute__((ext_vector_type(16)));
typedef unsigned u32x2 __attribute__((ext_vector_type(2)));
typedef unsigned u32x4 __attribute__((ext_vector_type(4)));
typedef __bf16 bf16x2_t __attribute__((ext_vector_type(2)));

constexpr int NB = 2, SEQ = 4096, T = NB * SEQ, DM = 2048, HD = 128, NHF = 8, DIN = 7176, NPROJ = 7168;
constexpr int NEXP = 16384, NE = 128;
constexpr float EPS = 1e-6f;
constexpr float SCALE = 0.08838834764831845f, LOG2E = 1.4426950408889634f;
constexpr int NWAVES = 8, NTHREADS = 512;

constexpr size_t MiB = 1u << 20;
constexpr size_t WS_CTL = 0, CTL_BYTES = 32768;
constexpr int CW_BAR = 1024;
constexpr size_t WS_SXN = 64 * MiB  , WS_WSC = 45 * MiB + 800 * 1024  ;
constexpr int CW_WMAX = 64;
constexpr size_t WS_GQK = 45 * MiB + 768 * 1024;
constexpr size_t WS_WIN = 1 * MiB, WS_WOUT = 29 * MiB, WS_WPQ = 37 * MiB, WS_SK = 45 * MiB, WS_LOGF = 46 * MiB, WS_C = 46 * MiB + 512 * 1024, WS_SSQ = 47 * MiB;
constexpr size_t WS_XN = 48 * MiB;
constexpr size_t WS_SEC = 80 * MiB;
constexpr size_t SEC_ELEMS = 8u << 20;
constexpr size_t WS_MIX = 192 * MiB, WS_HB = 224 * MiB, WS_QP = 256 * MiB, WS_IDX = 288 * MiB, WS_GW = 292 * MiB, WS_U8 = 296 * MiB, WS_V8 = 328 * MiB, WS_SUV = 360 * MiB  , WS_RT = 360 * MiB + 256 * 1024  , WS_W = 361 * MiB  ,
                 WS_PART = 368 * MiB  , WS_XQ = 432 * MiB  , WS_END = 448 * MiB;
constexpr size_t WS_AMX = 365 * MiB  , WS_SX = WS_RT + 64 * 1024  , WS_WQ = WS_W  , WS_SW = WS_W + 2 * MiB  ;
constexpr size_t WS_PO = WS_PART  , WS_PML = WS_PART + 32 * MiB  ;

constexpr int RING_BYTES = 131072;
constexpr int MISC_OFF = 143360;
constexpr int LDS_BYTES = 147456;

__device__ __forceinline__ unsigned cvt_pk_bf16(float lo, float hi) { unsigned r; asm volatile("v_cvt_pk_bf16_f32 %0, %1, %2" : "=v"(r) : "v"(lo), "v"(hi)); return r; }
__device__ __forceinline__ float bf_lo(unsigned u) { return __builtin_bit_cast(float, u << 16); }
__device__ __forceinline__ float bf_hi(unsigned u) { return __builtin_bit_cast(float, u & 0xffff0000u); }
__device__ __forceinline__ int lane_id_fresh() { int l = (int)__builtin_amdgcn_mbcnt_hi(~0u, __builtin_amdgcn_mbcnt_lo(~0u, 0u)); asm volatile("" : "+v"(l)); return l; }
__device__ __forceinline__ int sx_i(int v, int m) { return __builtin_amdgcn_ds_bpermute((lane_id_fresh() ^ m) << 2, v); }
__device__ __forceinline__ float sx_f(float v, int m) { return __int_as_float(__builtin_amdgcn_ds_bpermute((lane_id_fresh() ^ m) << 2, __float_as_int(v))); }
__device__ __forceinline__ int sh_i(int v, int src) { return __builtin_amdgcn_ds_bpermute(src << 2, v); }
__device__ __forceinline__ float sh_f(float v, int src) { return __int_as_float(__builtin_amdgcn_ds_bpermute(src << 2, __float_as_int(v))); }
__device__ __forceinline__ float shup_f(float v, int d) { const int l = lane_id_fresh(); const int s = l - d; return __int_as_float(__builtin_amdgcn_ds_bpermute((s < 0 ? l : s) << 2, __float_as_int(v))); }
__device__ __forceinline__ float wave_sum(float v) {
#pragma unroll
    for (int o = 1; o < 64; o <<= 1) v += sx_f(v, o);
    return v;
}
__device__ __forceinline__ float wave_max(float v) {
#pragma unroll
    for (int o = 1; o < 64; o <<= 1) v = fmaxf(v, sx_f(v, o));
    return v;
}
__device__ __forceinline__ int tid_opaque() { int t = (int)threadIdx.x; asm volatile("" : "+v"(t)); return t; }
#define LDS_WAIT() asm volatile("s_waitcnt lgkmcnt(0)" ::: "memory")

namespace pg8 {
#define PG8_LAS __attribute__((address_space(3)))
constexpr int BM = 256, BK = 64, HALF = 128, HTB = HALF * BK * 2, STAGE_BYTES = 8 * HTB, NXCD = 8, WGM = 8;
__host__ __device__ __forceinline__ int lds_byte(int r, int c) { const int st = (r >> 4) * 2 + (c >> 5), rr = r & 15, cc = c & 31, ob = rr * 64 + cc * 2; return st * 1024 + (ob ^ (((ob >> 9) & 1) << 5)); }
__host__ __device__ __forceinline__ void stage_rc(int b, int& R, int& C) { const int st = b / 1024, sb = b % 1024, swz = sb ^ (((sb >> 9) & 1) << 5); R = (st >> 1) * 16 + swz / 64; C = (st & 1) * 32 + (swz % 64) / 2; }
__host__ __device__ __forceinline__ int perm32(int rho) { const int n = rho >> 4, i = rho & 15; return 8 * (i >> 2) + 4 * n + (i & 3); }
struct Unit { int pm, pn; };
struct Gemm { const bf16_t* A; const bf16_t* Bt; int M, N, K; };
struct StaticOrder {
    int nM, nN, nwg, G, c;
    __host__ __device__ void init(int M, int N, int G_, int c_) { nM = M / BM; nN = N / BM; nwg = nM * nN; G = G_; c = c_; }
    __host__ __device__ bool next(int i, Unit& u) const {
        const long L = (long)i * G + c; if (L >= nwg) return false;
        int wgid = (int)L; { const int q = nwg / NXCD, r = nwg % NXCD, xcd = wgid % NXCD, off = wgid / NXCD; wgid = (xcd < r ? xcd * (q + 1) : r * (q + 1) + (xcd - r) * q) + off; }
        const int nig = WGM * nN, gid = wgid / nig, fm = gid * WGM, gsz = (nM - fm) < WGM ? (nM - fm) : WGM;
        u.pm = fm + ((wgid % nig) % gsz); u.pn = (wgid % nig) / gsz; return true;
    }
    __device__ __forceinline__ void a_ready(const Unit&) const {}
    __device__ __forceinline__ void done(const Unit&) const {}
};

typedef int i32x4 __attribute__((ext_vector_type(4)));
template <bool I8> struct AccT { typedef f32x4 type; };
template <> struct AccT<true> { typedef i32x4 type; };
template <class Epi, class Sched, bool ALIGN_EPI = false, bool SP2 = false, bool I8 = false>
__device__ __forceinline__ void gemm_phase(PG8_LAS unsigned char* lds, const Gemm g, const Sched& S, const Epi& E) {
    typedef typename AccT<I8>::type acc_t;
    const int tid = tid_opaque(), wid = __builtin_amdgcn_readfirstlane(tid >> 6), lane = tid & 63, wr = wid >> 2, wc = wid & 3, fr = lane & 15, fq = lane >> 4;
    const int rowb = I8 ? g.K : 2 * g.K, nt = rowb / (BK * 2);
    unsigned voffA[2], voffB[2];
#pragma unroll
    for (int i = 0; i < 2; ++i) { int R, C; stage_rc(tid * 16 + i * 8192, R, C); const int Rb = Epi::PERM ? ((R & ~31) + perm32(R & 31)) : R;
        voffA[i] = (unsigned)(R * rowb + C * 2); voffB[i] = (unsigned)(Rb * rowb + C * 2); }
    const size_t kstep = (size_t)(BK * 2);
    const size_t hstep = (size_t)HALF * rowb;
    const size_t tstep = 2 * hstep;
    const unsigned ldsw = (unsigned)wid * 1024u;
    const int aoff = lds_byte(wr * 64 + fr, fq * 8), boff = lds_byte(wc * 32 + fr, fq * 8);
#define PG8_SA(b, h) (((b) * 2 + (h)) * HTB)
#define PG8_SB(b, h) ((4 + (b) * 2 + (h)) * HTB)
#define PG8_STAGE(bufoff, gbase, voff) do { _Pragma("unroll") for (int _i = 0; _i < 2; ++_i) \
        __builtin_amdgcn_global_load_lds((const unsigned*)((const char*)(gbase) + (voff)[_i]), (PG8_LAS unsigned*)(lds + (bufoff) + ldsw + _i * 8192), 16, 0, 0); } while (0)
#define PG8_LDA(dst, b, h) do { _Pragma("unroll") for (int m = 0; m < 4; ++m) _Pragma("unroll") for (int k = 0; k < 2; ++k) dst[m][k] = *(const PG8_LAS bf16x8*)(lds + PG8_SA(b, h) + aoff + m * 2048 + k * 1024); } while (0)
#define PG8_LDB(dst, b, h) do { _Pragma("unroll") for (int n = 0; n < 2; ++n) _Pragma("unroll") for (int k = 0; k < 2; ++k) dst[n][k] = *(const PG8_LAS bf16x8*)(lds + PG8_SB(b, h) + boff + n * 2048 + k * 1024); } while (0)
#define PG8_MMA(ai, bj, At, Bt) do { __builtin_amdgcn_s_setprio(1); _Pragma("unroll") for (int m = 0; m < 4; ++m) _Pragma("unroll") for (int n = 0; n < 2; ++n) _Pragma("unroll") for (int k = 0; k < 2; ++k) \
        { if constexpr (I8) acc[ai][bj][m][n] = __builtin_amdgcn_mfma_i32_16x16x64_i8(__builtin_bit_cast(i32x4, Bt[n][k]), __builtin_bit_cast(i32x4, At[m][k]), acc[ai][bj][m][n], 0, 0, 0); \
          else acc[ai][bj][m][n] = __builtin_amdgcn_mfma_f32_16x16x32_bf16(Bt[n][k], At[m][k], acc[ai][bj][m][n], 0, 0, 0); } __builtin_amdgcn_s_setprio(0); } while (0)
#define PG8_WAIT_V(n) asm volatile("s_waitcnt vmcnt(" #n ")" ::: "memory")
#define PG8_WAIT_L(n) asm volatile("s_waitcnt lgkmcnt(" #n ")" ::: "memory")
#define PG8_BAR __builtin_amdgcn_s_barrier()
#define PG8_SCHED __builtin_amdgcn_sched_barrier(0)
    Unit cur, nxt; int ui = 0;
    if (!S.next(0, cur)) return;
    acc_t acc[2][2][4][2];
#pragma unroll
    for (int a = 0; a < 2; ++a)
#pragma unroll
        for (int b = 0; b < 2; ++b)
#pragma unroll
            for (int m = 0; m < 4; ++m)
#pragma unroll
                for (int n = 0; n < 2; ++n) acc[a][b][m][n] = acc_t{};
    bf16x8 At[4][2], B0[2][2], B1[2][2];
    const char* cA = (const char*)g.A + (size_t)cur.pm * tstep; const char* cB = (const char*)g.Bt + (size_t)cur.pn * tstep;
    S.a_ready(cur);
    if constexpr (SP2) {
        PG8_STAGE(PG8_SB(0, 0), cB, voffB); PG8_STAGE(PG8_SB(0, 1), cB + hstep, voffB); PG8_STAGE(PG8_SA(0, 0), cA, voffA); PG8_STAGE(PG8_SA(0, 1), cA + hstep, voffA);
        if (wr == 1) PG8_BAR;
        PG8_WAIT_V(2); PG8_BAR;
        PG8_STAGE(PG8_SB(1, 0), cB + kstep, voffB); PG8_STAGE(PG8_SA(1, 0), cA + kstep, voffA); PG8_STAGE(PG8_SB(1, 1), cB + hstep + kstep, voffB);
        PG8_WAIT_V(6); PG8_BAR;
    } else {
        PG8_STAGE(PG8_SB(0, 0), cB, voffB); PG8_STAGE(PG8_SA(0, 0), cA, voffA); PG8_STAGE(PG8_SB(0, 1), cB + hstep, voffB); PG8_STAGE(PG8_SA(0, 1), cA + hstep, voffA);
        if (wr == 1) PG8_BAR;
        PG8_WAIT_V(4); PG8_BAR;
        PG8_STAGE(PG8_SB(1, 0), cB + kstep, voffB); PG8_STAGE(PG8_SA(1, 0), cA + kstep, voffA); PG8_STAGE(PG8_SB(1, 1), cB + hstep + kstep, voffB);
        PG8_WAIT_V(6); PG8_BAR;
    }
    for (;;) {
        const bool has_next = S.next(ui + 1, nxt);
        const char* nA = has_next ? (const char*)g.A + (size_t)nxt.pm * tstep : cA; const char* nB = has_next ? (const char*)g.Bt + (size_t)nxt.pn * tstep : cB;
        for (int t = 0; t < nt; t += 2) {
            const bool last = (t == nt - 2);
            const char* a1 = cA + (size_t)(t + 1) * kstep;
            const char* a2 = last ? nA : cA + (size_t)(t + 2) * kstep; const char* b2 = last ? nB : cB + (size_t)(t + 2) * kstep;
            const char* a3 = a2 + kstep; const char* b3 = b2 + kstep;
            if (last && has_next) S.a_ready(nxt);
            if constexpr (SP2) {
            PG8_LDB(B0, 0, 0); PG8_LDB(B1, 0, 1); PG8_SCHED; PG8_LDA(At, 0, 0); PG8_STAGE(PG8_SA(1, 1), a1 + hstep, voffA);
            PG8_WAIT_V(8); PG8_WAIT_L(0); PG8_BAR; PG8_MMA(0, 0, At, B0); PG8_MMA(0, 1, At, B1); PG8_BAR; PG8_SCHED;
            PG8_LDA(At, 0, 1); PG8_STAGE(PG8_SB(0, 0), b2, voffB); PG8_STAGE(PG8_SB(0, 1), b2 + hstep, voffB); PG8_STAGE(PG8_SA(0, 0), a2, voffA);
            PG8_WAIT_V(8); PG8_WAIT_L(0); PG8_BAR; PG8_MMA(1, 0, At, B0); PG8_MMA(1, 1, At, B1); PG8_BAR; PG8_SCHED;
            PG8_LDB(B0, 1, 0); PG8_LDB(B1, 1, 1); PG8_SCHED; PG8_LDA(At, 1, 0); PG8_STAGE(PG8_SA(0, 1), a2 + hstep, voffA);
            PG8_WAIT_V(8); PG8_WAIT_L(0); PG8_BAR; PG8_MMA(0, 0, At, B0); PG8_MMA(0, 1, At, B1); PG8_BAR; PG8_SCHED;
            PG8_LDA(At, 1, 1); PG8_STAGE(PG8_SB(1, 0), b3, voffB); PG8_STAGE(PG8_SB(1, 1), b3 + hstep, voffB); PG8_STAGE(PG8_SA(1, 0), a3, voffA);
            PG8_WAIT_V(8); PG8_WAIT_L(0); PG8_BAR; PG8_MMA(1, 0, At, B0); PG8_MMA(1, 1, At, B1); PG8_BAR; PG8_SCHED;
            } else {
            PG8_LDB(B0, 0, 0); PG8_SCHED; PG8_LDA(At, 0, 0); PG8_STAGE(PG8_SA(1, 1), a1 + hstep, voffA);
            PG8_WAIT_L(8); PG8_BAR; PG8_WAIT_L(0); PG8_MMA(0, 0, At, B0); PG8_BAR; PG8_SCHED;
            PG8_LDB(B1, 0, 1); PG8_STAGE(PG8_SB(0, 0), b2, voffB);
            PG8_BAR; PG8_WAIT_L(0); PG8_MMA(0, 1, At, B1); PG8_BAR;
            PG8_LDA(At, 0, 1); PG8_STAGE(PG8_SA(0, 0), a2, voffA);
            PG8_BAR; PG8_WAIT_L(0); PG8_MMA(1, 0, At, B0); PG8_BAR; PG8_SCHED;
            PG8_STAGE(PG8_SB(0, 1), b2 + hstep, voffB);
            PG8_WAIT_V(6); PG8_BAR; PG8_MMA(1, 1, At, B1); PG8_BAR;
            PG8_LDB(B0, 1, 0); PG8_SCHED; PG8_LDA(At, 1, 0); PG8_STAGE(PG8_SA(0, 1), a2 + hstep, voffA);
            PG8_WAIT_L(8); PG8_BAR; PG8_WAIT_L(0); PG8_MMA(0, 0, At, B0); PG8_BAR; PG8_SCHED;
            PG8_LDB(B1, 1, 1); PG8_STAGE(PG8_SB(1, 0), b3, voffB);
            PG8_BAR; PG8_WAIT_L(0); PG8_MMA(0, 1, At, B1); PG8_BAR;
            PG8_LDA(At, 1, 1); PG8_STAGE(PG8_SA(1, 0), a3, voffA);
            PG8_BAR; PG8_WAIT_L(0); PG8_MMA(1, 0, At, B0); PG8_BAR; PG8_SCHED;
            PG8_STAGE(PG8_SB(1, 1), b3 + hstep, voffB);
            PG8_WAIT_V(6); PG8_BAR; PG8_MMA(1, 1, At, B1); PG8_BAR;
            }
        }
        if constexpr (ALIGN_EPI) { if (wr == 0) PG8_BAR; }
        E(acc, cur, wr, wc, fr, fq); S.done(cur);
        if (!has_next) break;
#pragma unroll
        for (int a = 0; a < 2; ++a)
#pragma unroll
            for (int b = 0; b < 2; ++b)
#pragma unroll
                for (int m = 0; m < 4; ++m)
#pragma unroll
                    for (int n = 0; n < 2; ++n) acc[a][b][m][n] = acc_t{};
        cur = nxt; cA = nA; cB = nB; ++ui;
        if constexpr (ALIGN_EPI) { if (wr == 1) PG8_BAR; }
    }
    PG8_WAIT_V(0);
    if constexpr (!ALIGN_EPI) { if (wr == 0) PG8_BAR; }
    PG8_BAR;
#undef PG8_SA
#undef PG8_SB
#undef PG8_STAGE
#undef PG8_LDA
#undef PG8_LDB
#undef PG8_MMA
#undef PG8_WAIT_V
#undef PG8_WAIT_L
#undef PG8_BAR
#undef PG8_SCHED
}

__device__ __forceinline__ float sigmoidf_fast(float x) { return __builtin_amdgcn_rcpf(1.f + __builtin_amdgcn_exp2f(-x * LOG2E)); }
struct EpiInProj {
    static constexpr bool PERM = true;
    bf16_t* base; const float* sxn  ; const float* wsc  ;
    const float* gq; const float* gk; PG8_LAS float* xch  ;
    __device__ __forceinline__ void operator()(const i32x4 (&acci)[2][2][4][2], const Unit& u, int wr, int wc, int fr, int fq) const {
        const int sec = u.pn >> 2; const float wsv = *wsc;
        bf16_t* sb = base + (size_t)sec * SEC_ELEMS;
        const float sc = (sec == 4) ? SCALE * LOG2E : 1.f;
        if (sec < 2) {
#pragma unroll
            for (int ai = 0; ai < 2; ++ai)
#pragma unroll
                for (int m = 0; m < 4; ++m) {
                    const int tk = u.pm * BM + ai * HALF + wr * 64 + m * 16 + fr;
                    const float rs = sxn[tk] * wsv;
#pragma unroll
                    for (int bj = 0; bj < 2; ++bj) {
                        const f32x4 v0 = __builtin_convertvector(acci[ai][bj][m][0], f32x4) * rs, v1 = __builtin_convertvector(acci[ai][bj][m][1], f32x4) * rs;
                        float ss = v0[0] * v0[0] + v0[1] * v0[1] + v0[2] * v0[2] + v0[3] * v0[3] + v1[0] * v1[0] + v1[1] * v1[1] + v1[2] * v1[2] + v1[3] * v1[3];
                        ss += sx_f(ss, 16); ss += sx_f(ss, 32);
                        if (fq == 0) xch[(((((wr * 2 + ai) * 4 + m) * 16 + fr) * 2 + bj) * 4) + wc] = ss;
                    }
                }
            asm volatile("s_waitcnt lgkmcnt(0)" ::: "memory");
            __builtin_amdgcn_s_barrier();
            const float* gp = (sec == 0 ? gq : gk) + wc * 32 + 8 * fq;
            const f32x4 g0 = *(const f32x4*)gp, g1 = *(const f32x4*)(gp + 4);
#pragma unroll
            for (int ai = 0; ai < 2; ++ai)
#pragma unroll
                for (int m = 0; m < 4; ++m) {
                    const int tk = u.pm * BM + ai * HALF + wr * 64 + m * 16 + fr, b = tk >> 12, s = tk & 4095;
                    const float rs = sxn[tk] * wsv;
#pragma unroll
                    for (int bj = 0; bj < 2; ++bj) {
                        const int hh = (u.pn & 3) * 2 + bj;
                        const f32x4 p4 = *(const PG8_LAS f32x4*)(xch + (((((wr * 2 + ai) * 4 + m) * 16 + fr) * 2 + bj) * 4));
                        const float r = rs / sqrtf(((p4[0] + p4[1]) + (p4[2] + p4[3])) * (1.f / 128.f) + EPS);
                        const f32x4 v0 = __builtin_convertvector(acci[ai][bj][m][0], f32x4) * r * g0, v1 = __builtin_convertvector(acci[ai][bj][m][1], f32x4) * r * g1;
                        u32x4 w; w.x = cvt_pk_bf16(v0[0], v0[1]); w.y = cvt_pk_bf16(v0[2], v0[3]); w.z = cvt_pk_bf16(v1[0], v1[1]); w.w = cvt_pk_bf16(v1[2], v1[3]);
                        *(u32x4*)(sb + ((size_t)((b * 8 + hh) * 4096 + s)) * 128 + wc * 32 + 8 * fq) = w;
                    }
                }
            return;
        }
#pragma unroll
        for (int ai = 0; ai < 2; ++ai)
#pragma unroll
            for (int m = 0; m < 4; ++m) {
                const int tk = u.pm * BM + ai * HALF + wr * 64 + m * 16 + fr, b = tk >> 12, s = tk & 4095;
                const float rs = sxn[tk] * wsv;
#pragma unroll
                for (int bj = 0; bj < 2; ++bj) {
                    const int hh = (u.pn & 3) * 2 + bj;
                    f32x4 v0 = __builtin_convertvector(acci[ai][bj][m][0], f32x4) * rs, v1 = __builtin_convertvector(acci[ai][bj][m][1], f32x4) * rs;
                    bf16_t* dst;
                    if (sec == 3) {
#pragma unroll
                        for (int i = 0; i < 4; ++i) { v0[i] = sigmoidf_fast(v0[i]); v1[i] = sigmoidf_fast(v1[i]); }
                        dst = sb + (size_t)tk * 1024 + hh * 128 + wc * 32 + 8 * fq;
                    } else {
                        v0 = v0 * sc; v1 = v1 * sc;
                        dst = sb + ((size_t)((b * 8 + hh) * 4096 + s)) * 128 + wc * 32 + 8 * fq;
                    }
                    u32x4 w; w.x = cvt_pk_bf16(v0[0], v0[1]); w.y = cvt_pk_bf16(v0[2], v0[3]); w.z = cvt_pk_bf16(v1[0], v1[1]); w.w = cvt_pk_bf16(v1[2], v1[3]);
                    *(u32x4*)dst = w;
                }
            }
    }
};
struct EpiOutProj {
    static constexpr bool PERM = true;
    const float* x; float* h; bf16_t* hb; float* ssq; float* amx;
    __device__ __forceinline__ void operator()(const f32x4 (&acc)[2][2][4][2], const Unit& u, int wr, int wc, int fr, int fq) const {
#pragma unroll
        for (int ai = 0; ai < 2; ++ai)
#pragma unroll
            for (int m = 0; m < 4; ++m) {
                const int tk = u.pm * BM + ai * HALF + wr * 64 + m * 16 + fr;
                float ss = 0.f, mx = 0.f;
#pragma unroll
                for (int bj = 0; bj < 2; ++bj) {
                    const size_t off = (size_t)tk * DM + u.pn * BM + bj * HALF + wc * 32 + 8 * fq;
                    const f32x4 x0 = *(const f32x4*)(x + off), x1 = *(const f32x4*)(x + off + 4);
                    const f32x4 v0 = acc[ai][bj][m][0] + x0, v1 = acc[ai][bj][m][1] + x1;
                    *(f32x4*)(h + off) = v0; *(f32x4*)(h + off + 4) = v1;
                    u32x4 w; w.x = cvt_pk_bf16(v0[0], v0[1]); w.y = cvt_pk_bf16(v0[2], v0[3]); w.z = cvt_pk_bf16(v1[0], v1[1]); w.w = cvt_pk_bf16(v1[2], v1[3]);
                    *(u32x4*)(hb + off) = w;
                    ss += v0[0] * v0[0] + v0[1] * v0[1] + v0[2] * v0[2] + v0[3] * v0[3] + v1[0] * v1[0] + v1[1] * v1[1] + v1[2] * v1[2] + v1[3] * v1[3];
                    mx = fmaxf(mx, fmaxf(fmaxf(fmaxf(fabsf(v0[0]), fabsf(v0[1])), fmaxf(fabsf(v0[2]), fabsf(v0[3]))), fmaxf(fmaxf(fabsf(v1[0]), fabsf(v1[1])), fmaxf(fabsf(v1[2]), fabsf(v1[3])))));
                }
                ss += sx_f(ss, 16); ss += sx_f(ss, 32);
                mx = fmaxf(mx, sx_f(mx, 16)); mx = fmaxf(mx, sx_f(mx, 32));
                if (fq == 0) { ssq[(size_t)tk * 32 + u.pn * 4 + wc] = ss; amx[(size_t)tk * 32 + u.pn * 4 + wc] = mx; }
            }
    }
};
struct EpiPeerQ {
    static constexpr bool PERM = true;
    const float* ssq; bf16_t* qp; float* rtab;
    __device__ __forceinline__ void operator()(const f32x4 (&acc)[2][2][4][2], const Unit& u, int wr, int wc, int fr, int fq) const {
#pragma unroll
        for (int ai = 0; ai < 2; ++ai)
#pragma unroll
            for (int m = 0; m < 4; ++m) {
                const int tk = u.pm * BM + ai * HALF + wr * 64 + m * 16 + fr;
                float tot = 0.f;
#pragma unroll
                for (int i = 0; i < 8; ++i) { const f32x4 s4 = *(const f32x4*)(ssq + (size_t)tk * 32 + 4 * i); tot += (s4[0] + s4[1]) + (s4[2] + s4[3]); }
                const float r = 1.0f / sqrtf(tot * (1.f / DM) + EPS);
                if (u.pn == 0 && wc == 0 && fq == 0) rtab[tk] = r;
#pragma unroll
                for (int bj = 0; bj < 2; ++bj) {
                    const size_t off = (size_t)tk * DM + u.pn * BM + bj * HALF + wc * 32 + 8 * fq;
                    const f32x4 v0 = acc[ai][bj][m][0] * r, v1 = acc[ai][bj][m][1] * r;
                    u32x4 w; w.x = cvt_pk_bf16(v0[0], v0[1]); w.y = cvt_pk_bf16(v0[2], v0[3]); w.z = cvt_pk_bf16(v1[0], v1[1]); w.w = cvt_pk_bf16(v1[2], v1[3]);
                    *(u32x4*)(qp + off) = w;
                }
            }
    }
};
}

namespace att {
constexpr int NW = 8, QBLK = 32, KVBLK = 64, QB = NW * QBLK, D = 128;
constexpr int SHM_V = KVBLK * D * 2, SHM_K = KVBLK * D * 2;
constexpr int OFF_WS = 2 * SHM_V + 2 * SHM_K, OFF_BIAS = OFF_WS + NW * 64 * 4, ATT_LDS = OFF_BIAS + SEQ * 4;
#define KSWZ(row, colB) ((row) * 256 + ((colB) ^ (((row) & 7) << 4)))
#define SBAR() __builtin_amdgcn_sched_barrier(0)
__device__ __forceinline__ int v_st(int k, int c) { const int kk = (k & ~0xC) | ((k & 4) << 1) | ((k & 8) >> 1); return ((kk >> 3) * 4 + (c >> 5)) * 512 + ((kk & 7) * 32 + (c & 31)) * 2; }
__device__ __forceinline__ int v_rd_base(int lane) { return ((lane & 3) << 3) | (((lane >> 2) & 3) << 6) | (((lane >> 4) & 1) << 5) | (((lane >> 5) & 1) << 8); }
constexpr int v_rd_off(int d0, int ks, int half) { return d0 * 512 + ks * 4096 + half * 2048; }
__device__ __forceinline__ int crow(int r, int hi) { return (r & 3) + 8 * (r >> 2) + 4 * hi; }
__device__ __forceinline__ bf16x8 load8(const bf16_t* p) { return *reinterpret_cast<const bf16x8*>(p); }
__device__ __forceinline__ void mask_tile(f32x16& p0, f32x16& p1, int dq) {
    const float NEG = -__builtin_inff();
#pragma unroll
    for (int r = 0; r < 16; ++r) {
        const int c = (r & 3) + 8 * (r >> 2);
        if (dq - c < 0) p0[r] = NEG;
        if (dq - c - 32 < 0) p1[r] = NEG;
    }
}
__device__ __forceinline__ void partialSM(f32x16& p0, f32x16& p1, float& m_reg, float& mn, float& alpha) {
    float pmax = p0[0];
#pragma unroll
    for (int r = 1; r < 16; ++r) pmax = fmaxf(pmax, p0[r]);
#pragma unroll
    for (int r = 0; r < 16; ++r) pmax = fmaxf(pmax, p1[r]);
    { auto rr = __builtin_amdgcn_permlane32_swap(__float_as_uint(pmax), __float_as_uint(pmax), false, false);
      pmax = fmaxf(__uint_as_float(rr[0]), __uint_as_float(rr[1])); }
    constexpr float C2 = LOG2E * SCALE; constexpr float THR = 8.f;
    if (__builtin_expect(__all((pmax - m_reg) * SCALE <= THR), 1)) { mn = m_reg; alpha = 1.f; }
    else { mn = fmaxf(m_reg, pmax); alpha = __builtin_amdgcn_exp2f((m_reg - mn) * C2); m_reg = mn; }
    const float mnL = -mn * C2;
#pragma unroll
    for (int r = 0; r < 16; ++r) p0[r] = fmaf(p0[r], C2, mnL);
#pragma unroll
    for (int r = 0; r < 16; ++r) p1[r] = fmaf(p1[r], C2, mnL);
#pragma unroll
    for (int r = 0; r < 16; ++r) p0[r] = __builtin_amdgcn_exp2f(p0[r]);
}
#define PK4(P, B_, OUT) do { unsigned a0 = cvt_pk_bf16(P[B_+0], P[B_+1]), a1 = cvt_pk_bf16(P[B_+2], P[B_+3]);                          \
        unsigned b0 = cvt_pk_bf16(P[B_+4], P[B_+5]), b1 = cvt_pk_bf16(P[B_+6], P[B_+7]);                                             \
        auto r0 = __builtin_amdgcn_permlane32_swap(a0, b0, false, false); auto r1 = __builtin_amdgcn_permlane32_swap(a1, b1, false, false); \
        u32x4 w = {r0[0], r1[0], r0[1], r1[1]}; OUT = *reinterpret_cast<bf16x8*>(&w); } while (0)
__device__ __forceinline__ void finishSM(f32x16& p0, f32x16& p1, float alpha, float& l_reg, bf16x8& pa0, bf16x8& pa1, bf16x8& pa2, bf16x8& pa3) {
#pragma unroll
    for (int r = 0; r < 16; ++r) p1[r] = __builtin_amdgcn_exp2f(p1[r]);
    float ps = 0;
#pragma unroll
    for (int r = 0; r < 16; ++r) ps += p0[r];
#pragma unroll
    for (int r = 0; r < 16; ++r) ps += p1[r];
    { auto rr = __builtin_amdgcn_permlane32_swap(__float_as_uint(ps), __float_as_uint(ps), false, false);
      ps = __uint_as_float(rr[0]) + __uint_as_float(rr[1]); }
    l_reg = l_reg * alpha + ps;
    PK4(p0, 0, pa0); PK4(p0, 8, pa1); PK4(p1, 0, pa2); PK4(p1, 8, pa3);
}
__device__ __forceinline__ void sb_group(f32x16& P, int g, float& gs) {
    float run = 0.f;
#pragma unroll
    for (int k = 3; k >= 0; --k) {
        const float z = P[4 * g + k];
        const float t = __builtin_amdgcn_exp2f(-fabsf(z));
        const float l = __builtin_amdgcn_logf(1.f + t);
        const float sp = fmaxf(z, 0.f) + l;
        P[4 * g + k] = (z - sp) - run;
        run += sp;
    }
    gs = run;
}
__device__ __forceinline__ void sb_part1(f32x16& p0, f32x16& p1, float& carry, float mlo) {
    float gs[8];
#pragma unroll
    for (int g = 0; g < 4; ++g) sb_group(p0, g, gs[g]);
#pragma unroll
    for (int g = 0; g < 4; ++g) sb_group(p1, g, gs[4 + g]);
    float run = carry;
#pragma unroll
    for (int G = 7; G >= 0; --G) {
        auto rr = __builtin_amdgcn_permlane32_swap(__float_as_uint(gs[G]), __float_as_uint(gs[G]), false, false);
        const float slo = __uint_as_float(rr[0]), shi = __uint_as_float(rr[1]);
        const float base = fmaf(mlo, shi, run);
        if (G >= 4) {
#pragma unroll
            for (int k = 0; k < 4; ++k) p1[4 * (G - 4) + k] -= base;
        } else {
#pragma unroll
            for (int k = 0; k < 4; ++k) p0[4 * G + k] -= base;
        }
        run += slo + shi;
    }
    carry = run;
#pragma unroll
    for (int r = 0; r < 16; ++r) p0[r] = __builtin_amdgcn_exp2f(p0[r]);
}
__device__ __forceinline__ void sb_part2(f32x16& p0, f32x16& p1, bf16x8& pa0, bf16x8& pa1, bf16x8& pa2, bf16x8& pa3) {
#pragma unroll
    for (int r = 0; r < 16; ++r) p1[r] = __builtin_amdgcn_exp2f(p1[r]);
    PK4(p0, 0, pa0); PK4(p0, 8, pa1); PK4(p1, 0, pa2); PK4(p1, 8, pa3);
}
#undef PK4
template <int KB, bool BIAS>
__device__ __forceinline__ void qkt(f32x16& p0, f32x16& p1, const char* K_lds, int r32, int hi, const bf16x8* qr, const float* bt) {
    if constexpr (BIAS) {
#pragma unroll
        for (int g = 0; g < 4; ++g) { const f32x4 a = *(const f32x4*)(bt + 8 * g), b = *(const f32x4*)(bt + 32 + 8 * g);
            p0[4 * g] = a[0]; p0[4 * g + 1] = a[1]; p0[4 * g + 2] = a[2]; p0[4 * g + 3] = a[3];
            p1[4 * g] = b[0]; p1[4 * g + 1] = b[1]; p1[4 * g + 2] = b[2]; p1[4 * g + 3] = b[3]; }
    } else { p0 = f32x16{}; p1 = f32x16{}; }
    const char* kb[4];
#pragma unroll
    for (int dd = 0; dd < 4; ++dd) kb[dd] = K_lds + KB * SHM_K + KSWZ(r32, (dd * 16 + hi * 8) * 2);
#pragma unroll
    for (int d0 = 0; d0 < 8; ++d0) { const char* a = kb[d0 & 3] + (d0 >> 2) * 128;
        bf16x8 b0 = *reinterpret_cast<const bf16x8*>(a);
        bf16x8 b1 = *reinterpret_cast<const bf16x8*>(a + 32 * 256);
        p0 = __builtin_amdgcn_mfma_f32_32x32x16_bf16(b0, qr[d0], p0, 0, 0, 0);
        p1 = __builtin_amdgcn_mfma_f32_32x32x16_bf16(b1, qr[d0], p1, 0, 0, 0); }
}
template <int VB>
__device__ __forceinline__ void pv_tile(f32x16* o, int vb0, bf16x8 pa0, bf16x8 pa1, bf16x8 pa2, bf16x8 pa3) {
#define TRRD(dst, off) asm volatile("ds_read_b64_tr_b16 %0, %1 offset:%2" : "=&v"(dst) : "v"(vb0), "i"(off) : "memory")
#define PV_D0(d0) do { { s16x4 l0, l1, h0, h1; constexpr int b_ = VB * SHM_V + v_rd_off(d0, 0, 0); \
        TRRD(l0, b_); TRRD(h0, b_ + 2048); TRRD(l1, b_ + 4096); TRRD(h1, b_ + 6144); \
        asm volatile("s_waitcnt lgkmcnt(0)" ::: "memory"); SBAR();   \
        o[d0] = __builtin_amdgcn_mfma_f32_32x32x16_bf16(pa0, (bf16x8){l0[0], l0[1], l0[2], l0[3], h0[0], h0[1], h0[2], h0[3]}, o[d0], 0, 0, 0);   \
        o[d0] = __builtin_amdgcn_mfma_f32_32x32x16_bf16(pa1, (bf16x8){l1[0], l1[1], l1[2], l1[3], h1[0], h1[1], h1[2], h1[3]}, o[d0], 0, 0, 0); }  \
      { s16x4 l2, l3, h2, h3; constexpr int b_ = VB * SHM_V + v_rd_off(d0, 0, 0); \
        TRRD(l2, b_ + 8192); TRRD(h2, b_ + 10240); TRRD(l3, b_ + 12288); TRRD(h3, b_ + 14336); \
        asm volatile("s_waitcnt lgkmcnt(0)" ::: "memory"); SBAR();   \
        o[d0] = __builtin_amdgcn_mfma_f32_32x32x16_bf16(pa2, (bf16x8){l2[0], l2[1], l2[2], l2[3], h2[0], h2[1], h2[2], h2[3]}, o[d0], 0, 0, 0);   \
        o[d0] = __builtin_amdgcn_mfma_f32_32x32x16_bf16(pa3, (bf16x8){l3[0], l3[1], l3[2], l3[3], h3[0], h3[1], h3[2], h3[3]}, o[d0], 0, 0, 0); } } while (0)
    PV_D0(0); PV_D0(1); PV_D0(2); PV_D0(3);
#undef PV_D0
#undef TRRD
}

struct UnitRef { const bf16_t* Q; const bf16_t* K; const bf16_t* V; int P0; };
struct Seam { bf16x8 qr[8]; bf16x8 st_v0, st_v1, st_k0, st_k1; };
#define ROW(p, k0, rr) ((p) + (size_t)((k0) + (rr)) * D + sc)
#define VMW() asm volatile("s_waitcnt vmcnt(0)" ::: "memory")
#define SLOAD_H(Kp, Vp, k0) do { S.st_v0 = load8(ROW(Vp, k0, sr)); S.st_v1 = load8(ROW(Vp, k0, 32 + sr));              \
                         S.st_k0 = load8(ROW(Kp, k0, sr)); S.st_k1 = load8(ROW(Kp, k0, 32 + sr)); } while (0)
#define SWRITE_HK(bf) do { *(bf16x8*)(K_lds + (bf) * SHM_K + kws) = S.st_k0; *(bf16x8*)(K_lds + (bf) * SHM_K + kws + 32 * 256) = S.st_k1; } while (0)
#define SWRITE_HV(bf) do { *(bf16x8*)(V_lds + (bf) * SHM_V + vst0) = S.st_v0; *(bf16x8*)(V_lds + (bf) * SHM_V + vst1) = S.st_v1; } while (0)
#define SWRITE_H(bf) do { SWRITE_HV(bf); SWRITE_HK(bf); } while (0)

template <bool SB>
__device__ __forceinline__ void attn_unit(const UnitRef& cur, unsigned char* wsu  , int bh, char* lds,
                                          int part  ) {
    const float* cvec; const float* gqk;
    { unsigned char* w_ = wsu; asm volatile("" : "+s"(w_)); cvec = (const float*)(w_ + WS_C) + (size_t)bh * SEQ; gqk = (const float*)(w_ + WS_GQK); }
    const int tid = tid_opaque(), wid = __builtin_amdgcn_readfirstlane(tid >> 6), lane = tid & 63, r32 = lane & 31, hi = lane >> 5;
    int jlo = 0;
    if constexpr (!SB) {
        const float gq = fmaxf(fabsf(gqk[lane]), fabsf(gqk[64 + lane])), gk = fmaxf(fabsf(gqk[128 + lane]), fabsf(gqk[192 + lane]));
        const float lmax = 11.3137085f * 1.02f * wave_max(gq) * wave_max(gk);
        const int ntf = (cur.P0 + QB) / KVBLK;
        const float cend = (lane < ntf) ? cvec[lane * KVBLK + KVBLK - 1] : 0.f;
        const bool skip = (lane < ntf) && (2.f * lmax + cvec[cur.P0] - cend < -104.f);
        jlo = __builtin_amdgcn_readfirstlane((int)__popcll(__ballot(skip)));
    }
    const int ntot = (cur.P0 + QB) / KVBLK - jlo;
    const int tb = (part == 2) ? (ntot >> 1) : 0, te = (part == 1) ? (ntot >> 1) : ntot;
    const int kshift = (jlo + tb) * KVBLK, P0r = cur.P0 - kshift;
    const int NT = te - tb;
#define KBASE(t) ((SB ? (NT - 1 - (t)) : (t)) * KVBLK)
    const int qlo = P0r + wid * QBLK, qm = qlo + r32 - 4 * hi - (SB ? 1 : 0);
    char* V_lds = lds; char* K_lds = lds + 2 * SHM_V;
    float* ws = (float*)(lds + OFF_WS) + wid * 64; float* li_l = ws, * al_l = ws + 32;
    float* bias = (float*)(lds + OFF_BIAS);
    const int sr = tid >> 4, sc = (tid & 15) * 8, vst0 = v_st(sr, sc), vst1 = v_st(32 + sr, sc), kws = KSWZ(sr, sc * 2);
    const int vb0 = (int)(uintptr_t)V_lds + v_rd_base(lane);
    const bf16_t* Kh = cur.K + (size_t)kshift * D; const bf16_t* Vh = cur.V + (size_t)kshift * D;
    Seam S;
    if constexpr (!SB) { const float cq0 = cvec[cur.P0]; const float* cv = cvec + kshift; for (int j = tid; j < NT * KVBLK; j += NTHREADS) bias[j] = (cq0 - cv[j]) * (1.f / SCALE); }
#pragma unroll
    for (int d0 = 0; d0 < 8; ++d0) S.qr[d0] = load8(cur.Q + (size_t)(wid * QBLK + r32) * D + d0 * 16 + hi * 8);
    SLOAD_H(Kh, Vh, KBASE(0)); VMW(); SWRITE_HK(0);
    __syncthreads();
    float m_reg = -1e30f, l_reg = 0; f32x16 o[4] = {};
    float carry = 0.f; const float mlo = hi ? 0.f : 1.f;
#define RESC(a) do { if (__any((a) < 1.f)) { if (hi == 0) al_l[r32] = (a); asm volatile("s_waitcnt lgkmcnt(0)" ::: "memory");              \
                     for (int d_ = 0; d_ < 4; ++d_) for (int r = 0; r < 16; ++r) o[d_][r] *= al_l[crow(r, hi)]; } } while (0)
#define MASKT(P0_, P1_, t) do { const int kb_ = KBASE(t); if (kb_ + KVBLK - 1 > qlo - (SB ? 1 : 0)) mask_tile(P0_, P1_, qm - kb_); } while (0)
#define BT(t) (bias + KBASE(t) + 4 * hi)
#define PART1(PX0, PX1, mnX, alX) do { if constexpr (SB) sb_part1(PX0, PX1, carry, mlo); else partialSM(PX0, PX1, m_reg, mnX, alX); } while (0)
#define PART2(PY0, PY1, alY) do { if constexpr (SB) sb_part2(PY0, PY1, pa0, pa1, pa2, pa3); else finishSM(PY0, PY1, alY, l_reg, pa0, pa1, pa2, pa3); } while (0)
    f32x16 pA0, pA1, pB0, pB1; float mnA = 0.f, mnB = 0.f, alA = 1.f, alB = 1.f; bf16x8 pa0, pa1, pa2, pa3;
    SWRITE_HV(0); SBAR();
    if (NT > 1) SLOAD_H(Kh, Vh, KBASE(1));
    SBAR(); qkt<0, !SB>(pA0, pA1, K_lds, r32, hi, S.qr, BT(0));
    MASKT(pA0, pA1, 0); PART1(pA0, pA1, mnA, alA);
    if (NT > 1) { VMW(); SWRITE_H(1); }
    __syncthreads();
#define HALF_STEP(PX0, PX1, mnX, alX, PY0, PY1, alY, t, KB, VB, SBUF) do {                                                    \
        SBAR(); qkt<KB, !SB>(PX0, PX1, K_lds, r32, hi, S.qr, BT(t));                                                          \
        PART2(PY0, PY1, alY); SBAR();                                                                                          \
        if ((t) + 1 < NT) { SLOAD_H(Kh, Vh, KBASE((t) + 1)); SBAR(); }                                                         \
        pv_tile<VB>(o, vb0, pa0, pa1, pa2, pa3); MASKT(PX0, PX1, (t)); PART1(PX0, PX1, mnX, alX);                              \
        __syncthreads();                                                                                                      \
        if ((t) + 1 < NT) { VMW(); SWRITE_H(SBUF); }                                                                           \
        if constexpr (!SB) RESC(alX);                                                                                          \
        __syncthreads(); } while (0)
    for (int t = 1; t + 1 < NT; t += 2) {
        HALF_STEP(pB0, pB1, mnB, alB, pA0, pA1, alA, t, 1, 0, 0);
        HALF_STEP(pA0, pA1, mnA, alA, pB0, pB1, alB, t + 1, 0, 1, 1);
    }
    const bool even = (NT & 1) == 0;
    if (even) { SBAR(); qkt<1, !SB>(pB0, pB1, K_lds, r32, hi, S.qr, BT(NT - 1)); SBAR(); }
    PART2(pA0, pA1, alA); SBAR();
    pv_tile<0>(o, vb0, pa0, pa1, pa2, pa3);
    if (even) { MASKT(pB0, pB1, NT - 1); PART1(pB0, pB1, mnB, alB); __syncthreads(); if constexpr (!SB) RESC(alB);
        PART2(pB0, pB1, alB); SBAR(); pv_tile<1>(o, vb0, pa0, pa1, pa2, pa3); }
    unsigned char* we_ = wsu; asm volatile("" : "+s"(we_));
    if (part != 0) {
        const int slot2 = ((((cur.P0 >> 8) - 8) & 7) * 16 + bh) * 2 + (part == 2 ? 1 : 0);
        float* po = (float*)(we_ + WS_PO) + (size_t)slot2 * 256 * 128; float* pml = (float*)(we_ + WS_PML) + (size_t)slot2 * 512;
        if (hi == 0) { pml[(wid * QBLK + r32) * 2] = m_reg; pml[(wid * QBLK + r32) * 2 + 1] = l_reg; }
#pragma unroll
        for (int r = 0; r < 16; ++r)
#pragma unroll
            for (int d0 = 0; d0 < 4; ++d0) po[(size_t)(wid * QBLK + crow(r, hi)) * D + d0 * 32 + r32] = o[d0][r];
        __syncthreads();
        return;
    }
    const bf16_t* gate = (const bf16_t*)(we_ + WS_SEC) + 3 * SEC_ELEMS + (size_t)(bh >> 3) * SEQ * 1024 + (bh & 7) * HD;
    bf16_t* outp = (bf16_t*)(we_ + WS_MIX) + (size_t)(bh >> 3) * SEQ * DM + (bh & 7) * HD;
    float rli[16];
    if constexpr (!SB) {
        if (hi == 0) li_l[r32] = l_reg; asm volatile("s_waitcnt lgkmcnt(0)" ::: "memory");
#pragma unroll
        for (int r = 0; r < 16; ++r) rli[r] = __builtin_amdgcn_rcpf(li_l[crow(r, hi)]);
    }
#pragma unroll
    for (int r = 0; r < 16; ++r) { const int orow = cur.P0 + wid * QBLK + crow(r, hi);
#pragma unroll
        for (int d0 = 0; d0 < 4; ++d0) {
            float v = o[d0][r];
            if constexpr (!SB) { const unsigned short gb = gate[(size_t)orow * 1024 + d0 * 32 + r32]; v = v * rli[r] * __builtin_bit_cast(float, (unsigned)gb << 16); }
            const float vn = sx_f(v, 1);
            if ((r32 & 1) == 0) *(unsigned*)(outp + (size_t)orow * DM + d0 * 32 + r32) = cvt_pk_bf16(v, vn); } }
    __syncthreads();
#undef RESC
#undef KBASE
#undef MASKT
#undef BT
#undef PART1
#undef PART2
#undef HALF_STEP
}

constexpr float SB_TH = 150.f;
__device__ __forceinline__ void sb_unit(const UnitRef& cur, bf16_t* outp, char* lds) {
    const int tid = tid_opaque(), wid = __builtin_amdgcn_readfirstlane(tid >> 6), lane = tid & 63, r32 = lane & 31, hi = lane >> 5;
    const int NT = (cur.P0 + QB) / KVBLK;
#define KBASE(t) ((NT - 1 - (t)) * KVBLK)
    const int qlo = cur.P0 + wid * QBLK, qm = qlo + r32 - 4 * hi - 1;
    char* V_lds = lds; char* K_lds = lds + 2 * SHM_V;
    volatile int* flags = (volatile int*)(lds + OFF_WS);
    const int sr = tid >> 4, sc = (tid & 15) * 8, vst0 = v_st(sr, sc), vst1 = v_st(32 + sr, sc), kws = KSWZ(sr, sc * 2);
    const int vb0 = (int)(uintptr_t)V_lds + v_rd_base(lane);
    const bf16_t* Kh = cur.K; const bf16_t* Vh = cur.V;
    Seam S;
#pragma unroll
    for (int d0 = 0; d0 < 8; ++d0) S.qr[d0] = load8(cur.Q + (size_t)(wid * QBLK + r32) * D + d0 * 16 + hi * 8);
    SLOAD_H(Kh, Vh, KBASE(0)); VMW(); SWRITE_H(0);
    __syncthreads();
    f32x16 o[4] = {}; float carry = 0.f; const float mlo = hi ? 0.f : 1.f;
    bool wdone = false;
#define SB_STEP(tt, BUF) {                                                                                                 \
        const int kb_ = KBASE(tt);                                                                                           \
        if ((tt) + 1 < NT) SLOAD_H(Kh, Vh, KBASE((tt) + 1));                                                                 \
        SBAR();                                                                                                              \
        if (!wdone && kb_ <= qlo + QBLK - 2) {                                                                               \
            f32x16 p0, p1; bf16x8 pa0, pa1, pa2, pa3;                                                                        \
            qkt<BUF, false>(p0, p1, K_lds, r32, hi, S.qr, nullptr);                                                          \
            if (kb_ + KVBLK - 1 > qlo - 1) mask_tile(p0, p1, qm - kb_);                                                      \
            sb_part1(p0, p1, carry, mlo); sb_part2(p0, p1, pa0, pa1, pa2, pa3); SBAR();                                      \
            pv_tile<BUF>(o, vb0, pa0, pa1, pa2, pa3);                                                                        \
            wdone = __all(carry >= SB_TH);                                                                                   \
        }                                                                                                                    \
        if ((tt) + 1 < NT) { VMW(); SWRITE_H((BUF) ^ 1); }                                                                   \
        if (lane == 0) flags[((tt) & 1) * 8 + wid] = wdone ? 1 : 0;                                                          \
        __syncthreads();                                                                                                     \
        { int alld = 1;                                                                                                      \
          _Pragma("unroll") for (int w_ = 0; w_ < 8; ++w_) alld &= flags[((tt) & 1) * 8 + w_];                                \
          if (alld) break; } }
    for (int t = 0; t < NT; t += 2) {
        SB_STEP(t, 0)
        SB_STEP(t + 1, 1)
    }
#undef SB_STEP
#pragma unroll
    for (int r = 0; r < 16; ++r) { const int orow = cur.P0 + wid * QBLK + crow(r, hi);
#pragma unroll
        for (int d0 = 0; d0 < 4; ++d0) {
            const float v = o[d0][r];
            const float vn = sx_f(v, 1);
            if ((r32 & 1) == 0) *(unsigned*)(outp + (size_t)orow * DM + d0 * 32 + r32) = cvt_pk_bf16(v, vn); } }
    __syncthreads();
#undef KBASE
}
#undef ROW
#undef VMW
#undef SLOAD_H
#undef SWRITE_HK
#undef SWRITE_HV
#undef SWRITE_H
}

#define XB_TMO      128
#define XB_XCNT(j)  (256  + 64 * (j))
#define XB_XSUB(j)  (1280 + 64 * (j))
#define XB_XGEN(j)  (2304 + 64 * (j))
#define XB_TOP      3328
#define XB_TOPGEN   3392
#define XCD_BAR_WORDS 3456
#define XB_SPIN_CAP (1u << 20)
__device__ __forceinline__ unsigned xb_ld(unsigned* p)              { return __hip_atomic_load(p, __ATOMIC_RELAXED, __HIP_MEMORY_SCOPE_AGENT); }
__device__ __forceinline__ unsigned xb_add(unsigned* p, unsigned v) { return __hip_atomic_fetch_add(p, v, __ATOMIC_RELAXED, __HIP_MEMORY_SCOPE_AGENT); }
__device__ __forceinline__ unsigned xb_xcc_id() { return (unsigned)__builtin_amdgcn_s_getreg((3 << 11) | 20) & 0xFu; }
#define XB_SPIN(cond, bar) do { unsigned _sp = 0; while (cond) { __builtin_amdgcn_s_sleep(1); \
    if ((++_sp & 255u) == 0u) { if (xb_ld(&(bar)[XB_TMO])) break; if (_sp > XB_SPIN_CAP) { atomicAdd(&(bar)[XB_TMO], 1u); break; } } } } while (0)
struct XcdBarrier { unsigned* bar; unsigned x; volatile LAS unsigned* st; };
__device__ __forceinline__ XcdBarrier xcd_barrier_post(unsigned* bar, volatile LAS unsigned* st) {
    XcdBarrier b; b.bar = bar; b.x = xb_xcc_id(); b.st = st;
    if (threadIdx.x == 0) (void)xb_add(&bar[XB_XCNT(b.x)], 1u);
    return b;
}
__device__ __forceinline__ void xcd_barrier_complete(unsigned* bar, unsigned x, unsigned& nloc, unsigned& nx) {
    const unsigned G = gridDim.x * gridDim.y * gridDim.z;
    unsigned sum, cnt, mine, sp = 0u;
    for (;;) {
        sum = 0u; cnt = 0u; mine = 0u;
#pragma unroll
        for (unsigned j = 0; j < 16; ++j) { const unsigned c = xb_ld(&bar[XB_XCNT(j)]); sum += c; cnt += (c > 0u) ? 1u : 0u; mine = (j == x) ? c : mine; }
        if (sum == G) break;
        __builtin_amdgcn_s_sleep(1);
        if ((++sp & 255u) == 0u) { if (xb_ld(&bar[XB_TMO])) break; if (sp > XB_SPIN_CAP) { atomicAdd(&bar[XB_TMO], 1u); break; } }
    }
    nloc = mine > 0u ? mine : 1u; nx = cnt > 0u ? cnt : 1u;
}
__device__ __forceinline__ void xcd_barrier(const XcdBarrier& b) {
    asm volatile("s_waitcnt vmcnt(0)" ::: "memory");
    __syncthreads();
    if (threadIdx.x == 0) {
        unsigned* bar = b.bar;
        __builtin_amdgcn_s_waitcnt(0);
        unsigned nloc = b.st[0], nx = b.st[1];
        if (nloc == 0u) { xcd_barrier_complete(bar, b.x, nloc, nx); b.st[0] = nloc; b.st[1] = nx; }
        const unsigned old = xb_add(&bar[XB_XSUB(b.x)], 1u);
        const unsigned gen = old / nloc;
        if (old + 1u == (gen + 1u) * nloc) {
            __builtin_amdgcn_fence(__ATOMIC_RELEASE, "agent");
            asm volatile("s_waitcnt vmcnt(0)" ::: "memory");
            const unsigned og = xb_add(&bar[XB_TOP], 1u);
            const unsigned tg = og / nx;
            if (og + 1u == (tg + 1u) * nx) xb_add(&bar[XB_TOPGEN], 1u);
            else XB_SPIN(xb_ld(&bar[XB_TOPGEN]) == tg, bar);
            __builtin_amdgcn_fence(__ATOMIC_ACQUIRE, "agent");
            xb_add(&bar[XB_XGEN(b.x)], 1u);
            asm volatile("s_waitcnt vmcnt(0)" ::: "memory");
        } else {
            XB_SPIN(xb_ld(&bar[XB_XGEN(b.x)]) == gen, bar);
            __builtin_amdgcn_fence(__ATOMIC_ACQUIRE, "agent");
            asm volatile("s_waitcnt vmcnt(0)" ::: "memory");
        }
    }
    __syncthreads();
}

struct Args { const float* in[12]; float* out; unsigned char* ws; int ph_lo, ph_hi; };

__device__ __forceinline__ void p0_transpose_item(const float* W, int ldw, int K, bf16_t* WT, int nblk, LAS float* scr, int item, int lane, const float* gk) {
    const int kb = item / nblk, nb = item % nblk, k0 = 64 * kb, n0 = 32 * nb;
    { const int rr = lane >> 3, c4 = lane & 7; f32x4 v[8];
#pragma unroll
      for (int i = 0; i < 8; ++i) v[i] = *(const f32x4*)(W + (size_t)(k0 + rr + 8 * i) * ldw + n0 + 4 * c4);
#pragma unroll
      for (int i = 0; i < 8; ++i) { const int kk = rr + 8 * i; const float gm = gk ? gk[k0 + kk] : 1.f;
          scr[kk * 33 + 4 * c4] = v[i][0] * gm; scr[kk * 33 + 4 * c4 + 1] = v[i][1] * gm; scr[kk * 33 + 4 * c4 + 2] = v[i][2] * gm; scr[kk * 33 + 4 * c4 + 3] = v[i][3] * gm; } }
    LDS_WAIT(); asm volatile("" ::: "memory");
    const int c = lane & 7;
#pragma unroll
    for (int j = 0; j < 4; ++j) { const int n = (lane >> 3) + 8 * j; const LAS float* s = scr + (8 * c) * 33 + n;
        u32x4 o; o.x = cvt_pk_bf16(s[0 * 33], s[1 * 33]); o.y = cvt_pk_bf16(s[2 * 33], s[3 * 33]); o.z = cvt_pk_bf16(s[4 * 33], s[5 * 33]); o.w = cvt_pk_bf16(s[6 * 33], s[7 * 33]);
        *(u32x4*)(WT + (size_t)(n0 + n) * K + k0 + 8 * c) = o; }
    LDS_WAIT(); asm volatile("" ::: "memory");
}

__device__ __forceinline__ int pack_i8(float a, float b, float c, float d) {
    const int ia = (int)__builtin_rintf(a), ib = (int)__builtin_rintf(b), ic = (int)__builtin_rintf(c), id = (int)__builtin_rintf(d);
    return (int)(((unsigned)ia & 0xffu) | (((unsigned)ib & 0xffu) << 8) | (((unsigned)ic & 0xffu) << 16) | ((unsigned)id << 24));
}
__device__ __forceinline__ void convert_tables(const Args& a, int r0, int r1, int worker, int nworkers) {
    const int lane = tid_opaque() & 63;
    unsigned char* ws = a.ws; const float* g_ffn = a.in[7]; const float* pu = a.in[10]; const float* pv = a.in[11];
    float* suv = (float*)(ws + WS_SUV);
    for (int r = r0 + worker; r < r1; r += nworkers) {
        const bool isv = r >= NEXP; const int e = isv ? r - NEXP : r;
        const f32x4* srcp = (const f32x4*)((isv ? pv : pu) + (size_t)e * DM);
        f32x4 v[8]; float amax = 0.f;
#pragma unroll
        for (int j = 0; j < 8; ++j) { v[j] = srcp[lane + 64 * j];
            if (!isv) { const f32x4 g4 = *(const f32x4*)(g_ffn + 4 * (lane + 64 * j)); v[j] = v[j] * g4; }
            amax = fmaxf(amax, fmaxf(fmaxf(fabsf(v[j][0]), fabsf(v[j][1])), fmaxf(fabsf(v[j][2]), fabsf(v[j][3])))); }
        amax = wave_max(amax);
        const float sc = amax > 0.f ? 127.f / amax : 1.f;
        unsigned char* dst = ws + (isv ? WS_V8 : WS_U8) + (size_t)e * 128;
#pragma unroll
        for (int j = 0; j < 8; ++j) { const int p = pack_i8(v[j][0] * sc, v[j][1] * sc, v[j][2] * sc, v[j][3] * sc);
            const int col = 4 * (lane + 64 * j);
            *(unsigned*)(dst + (size_t)(col >> 7) * ((size_t)NEXP * 128) + (col & 127)) = (unsigned)p; }
        if (lane == 0) suv[r] = 1.f / sc;
    }
}
constexpr int TAB_SPLIT = NEXP;

__device__ __forceinline__ void p0_transpose_item_i8(const float* W, int ldw, int K, unsigned char* WT, int nblk, LAS float* scr, int item, int lane, float q8) {
    const int kb = item / nblk, nb = item % nblk, k0 = 64 * kb, n0 = 32 * nb;
    { const int rr = lane >> 3, c4 = lane & 7; f32x4 v[8];
#pragma unroll
      for (int i = 0; i < 8; ++i) v[i] = *(const f32x4*)(W + (size_t)(k0 + rr + 8 * i) * ldw + n0 + 4 * c4);
#pragma unroll
      for (int i = 0; i < 8; ++i) { const int kk = rr + 8 * i;
          scr[kk * 33 + 4 * c4] = v[i][0] * q8; scr[kk * 33 + 4 * c4 + 1] = v[i][1] * q8; scr[kk * 33 + 4 * c4 + 2] = v[i][2] * q8; scr[kk * 33 + 4 * c4 + 3] = v[i][3] * q8; } }
    LDS_WAIT(); asm volatile("" ::: "memory");
    const int c = lane & 7;
#pragma unroll
    for (int j = 0; j < 4; ++j) { const int n = (lane >> 3) + 8 * j; const LAS float* s = scr + (8 * c) * 33 + n;
        u32x2 o; o.x = (unsigned)pack_i8(s[0 * 33], s[1 * 33], s[2 * 33], s[3 * 33]); o.y = (unsigned)pack_i8(s[4 * 33], s[5 * 33], s[6 * 33], s[7 * 33]);
        *(u32x2*)(WT + (size_t)(n0 + n) * K + k0 + 8 * c) = o; }
    LDS_WAIT(); asm volatile("" ::: "memory");
}
__device__ __forceinline__ float log_sigmoid_f(float x) { return fminf(x, 0.f) - log1pf(expf(-fabsf(x))); }

__device__ __forceinline__ void phase0(const Args& a, unsigned char* lds_g) {
    LAS unsigned char* lds = (LAS unsigned char*)lds_g;
    const int tid = tid_opaque(), lane = tid & 63, wave = __builtin_amdgcn_readfirstlane(tid >> 6);
    const int gw = blockIdx.x * NWAVES + wave, NGW = gridDim.x * NWAVES;
    const int gt = blockIdx.x * NTHREADS + tid, NGT = gridDim.x * NTHREADS;
    unsigned char* ws = a.ws;
    const float* x = a.in[0]; const float* g_attn = a.in[1]; const float* w_in = a.in[2]; const float* b_forget = a.in[3];
    const float* w_out = a.in[6]; const float* g_ffn = a.in[7]; const float* w_pq = a.in[8]; const float* sk = a.in[9]; const float* pu = a.in[10]; const float* pv = a.in[11];
    { float m = 0.f; const f32x4* wp = (const f32x4*)w_in;
      for (size_t i = gt; i < (size_t)DM * DIN / 4; i += NGT) { const f32x4 v = wp[i]; m = fmaxf(m, fmaxf(fmaxf(fabsf(v[0]), fabsf(v[1])), fmaxf(fabsf(v[2]), fabsf(v[3])))); }
      m = wave_max(m);
      if (lane == 0) __hip_atomic_fetch_max((unsigned*)(ws + WS_CTL) + CW_WMAX, __float_as_uint(m), __ATOMIC_RELAXED, __HIP_MEMORY_SCOPE_AGENT); }
    LAS float* wf = (LAS float*)(lds + 67584);
    for (int k = tid; k < DM; k += NTHREADS) { const f32x4 a0 = *(const f32x4*)(w_in + (size_t)k * DIN + NPROJ), a1 = *(const f32x4*)(w_in + (size_t)k * DIN + NPROJ + 4);
        *(LAS f32x4*)(wf + k * 8) = a0; *(LAS f32x4*)(wf + k * 8 + 4) = a1; }
    __syncthreads();
    for (int row = gw; row < T; row += NGW) {
        const f32x4* xr = (const f32x4*)(x + (size_t)row * DM);
        f32x4 v[8]; float ss = 0.f;
#pragma unroll
        for (int j = 0; j < 8; ++j) { v[j] = xr[lane + 64 * j]; ss += v[j][0] * v[j][0] + v[j][1] * v[j][1] + v[j][2] * v[j][2] + v[j][3] * v[j][3]; }
        const float r = 1.0f / sqrtf(wave_sum(ss) * (1.f / DM) + EPS);
        float f[8] = {0.f, 0.f, 0.f, 0.f, 0.f, 0.f, 0.f, 0.f};
        float xmax = 0.f;
#pragma unroll
        for (int j = 0; j < 8; ++j) { const f32x4 g4 = *(const f32x4*)(g_attn + 4 * (lane + 64 * j)); v[j][0] *= r * g4[0]; v[j][1] *= r * g4[1]; v[j][2] *= r * g4[2]; v[j][3] *= r * g4[3];
            xmax = fmaxf(xmax, fmaxf(fmaxf(fabsf(v[j][0]), fabsf(v[j][1])), fmaxf(fabsf(v[j][2]), fabsf(v[j][3])))); }
        xmax = wave_max(xmax);
        const float xq = xmax > 0.f ? 127.f / xmax : 1.f;
        if (lane == 0) ((float*)(ws + WS_SXN))[row] = xmax * (1.f / 127.f);
        unsigned* o8 = (unsigned*)(ws + WS_XN + (size_t)row * DM);
#pragma unroll
        for (int j = 0; j < 8; ++j) {
            const int e = 4 * (lane + 64 * j);
            const f32x4 xn = v[j];
            o8[lane + 64 * j] = (unsigned)pack_i8(xn[0] * xq, xn[1] * xq, xn[2] * xq, xn[3] * xq);
#pragma unroll
            for (int q = 0; q < 4; ++q) { const f32x4 w0 = *(LAS f32x4*)(wf + (e + q) * 8), w1 = *(LAS f32x4*)(wf + (e + q) * 8 + 4);
                f[0] += xn[q] * w0[0]; f[1] += xn[q] * w0[1]; f[2] += xn[q] * w0[2]; f[3] += xn[q] * w0[3];
                f[4] += xn[q] * w1[0]; f[5] += xn[q] * w1[1]; f[6] += xn[q] * w1[2]; f[7] += xn[q] * w1[3]; }
            __builtin_amdgcn_sched_barrier(0);
        }
#pragma unroll
        for (int hh = 0; hh < 8; ++hh) f[hh] = wave_sum(f[hh]);
        if (lane < 8) { float fl = f[0];
#pragma unroll
            for (int hh = 1; hh < 8; ++hh) fl = (lane == hh) ? f[hh] : fl;
            const int b = row >> 12, s = row & 4095;
            ((float*)(ws + WS_LOGF))[(size_t)(b * 8 + lane) * SEQ + s] = log_sigmoid_f(fl + b_forget[lane]); }
    }
    LAS float* scr = (LAS float*)(lds + wave * 8448);
    constexpr int I_IN = (DM / 64) * (NPROJ / 32), I_O = (DM / 64) * (DM / 32);
    for (int it = gw; it < 2 * I_O; it += NGW) {
        int r = it;
        if (r < I_O) { p0_transpose_item(w_out, DM, DM, (bf16_t*)(ws + WS_WOUT), DM / 32, scr, r, lane, nullptr); continue; } r -= I_O;
        p0_transpose_item(w_pq, DM, DM, (bf16_t*)(ws + WS_WPQ), DM / 32, scr, r, lane, g_ffn);
    }
    for (int i = gt; i < 8 * 2 * 128 * 128 / 8; i += NGT) { const f32x4 a0 = *(const f32x4*)(sk + (size_t)i * 8), a1 = *(const f32x4*)(sk + (size_t)i * 8 + 4);
        u32x4 w; w.x = cvt_pk_bf16(a0[0], a0[1]); w.y = cvt_pk_bf16(a0[2], a0[3]); w.z = cvt_pk_bf16(a1[0], a1[1]); w.w = cvt_pk_bf16(a1[2], a1[3]);
        *(u32x4*)(ws + WS_SK + (size_t)i * 16) = w; }
    if (gt < 256) ((float*)(ws + WS_GQK))[gt] = gt < 128 ? a.in[4][gt] : a.in[5][gt - 128];
    convert_tables(a, 0, TAB_SPLIT, gw, NGW);
    { XcdBarrier xb_; xb_.bar = (unsigned*)(ws + WS_CTL) + CW_BAR; xb_.x = xb_xcc_id(); xb_.st = (volatile LAS unsigned*)(lds + MISC_OFF) + 8; xcd_barrier(xb_); }
    const float wmax = __uint_as_float(__hip_atomic_load((unsigned*)(ws + WS_CTL) + CW_WMAX, __ATOMIC_RELAXED, __HIP_MEMORY_SCOPE_AGENT));
    if (gt == 0) *(float*)(ws + WS_WSC) = wmax * (1.f / 127.f);
    const float q8 = wmax > 0.f ? 127.f / wmax : 1.f;
    for (int it = gw; it < I_IN; it += NGW) p0_transpose_item_i8(w_in, DIN, DM, ws + WS_WIN, NPROJ / 32, scr, it, lane, q8);
}

__device__ __forceinline__ void cumsum_rows(const Args& a) {
    const int tid = tid_opaque(), lane = tid & 63, wave = tid >> 6;
    if (blockIdx.x >= 16 || wave != 0) return;
    const float* src = (const float*)(a.ws + WS_LOGF) + (size_t)blockIdx.x * SEQ + lane * 64;
    float* dst = (float*)(a.ws + WS_C) + (size_t)blockIdx.x * SEQ + lane * 64;
    f32x4 v[16]; float run = 0.f;
#pragma unroll
    for (int i = 0; i < 16; ++i) { v[i] = *(const f32x4*)(src + 4 * i);
#pragma unroll
        for (int q = 0; q < 4; ++q) { run += v[i][q]; v[i][q] = run; } }
    float incl = run;
#pragma unroll
    for (int o = 1; o < 64; o <<= 1) { const float t = shup_f(incl, o); if (lane >= o) incl += t; }
    const float off = incl - run;
#pragma unroll
    for (int i = 0; i < 16; ++i) { f32x4 w = v[i]; w[0] += off; w[1] += off; w[2] += off; w[3] += off; *(f32x4*)(dst + 4 * i) = w; }
}

__device__ __forceinline__ void phase_qknorm(const Args& a) {
    const int tid = tid_opaque(), lane = tid & 63, wave = tid >> 6;
    const int gw = blockIdx.x * NWAVES + wave, NGW = gridDim.x * NWAVES;
    const int sub = lane & 15, rw = lane >> 4;
    const float* gq = a.in[4]; const float* gk = a.in[5];
    constexpr int ROWS = NB * NHF * SEQ;
    for (int it = gw; it < 2 * ROWS / 4; it += NGW) {
        const int row = it * 4 + rw; const bool isk = row >= ROWS;
        bf16_t* p = (bf16_t*)(a.ws + WS_SEC) + (size_t)row * HD + sub * 8;
        const float* g = (isk ? gk : gq) + sub * 8;
        const u32x4 w = *(const u32x4*)p;
        float v[8] = {bf_lo(w.x), bf_hi(w.x), bf_lo(w.y), bf_hi(w.y), bf_lo(w.z), bf_hi(w.z), bf_lo(w.w), bf_hi(w.w)};
        float ss = 0.f;
#pragma unroll
        for (int i = 0; i < 8; ++i) ss += v[i] * v[i];
        ss += sx_f(ss, 1); ss += sx_f(ss, 2); ss += sx_f(ss, 4); ss += sx_f(ss, 8);
        const float r = 1.0f / sqrtf(ss * (1.f / HD) + EPS);
        const f32x4 g0 = *(const f32x4*)g, g1 = *(const f32x4*)(g + 4);
        u32x4 o; o.x = cvt_pk_bf16(v[0] * r * g0[0], v[1] * r * g0[1]); o.y = cvt_pk_bf16(v[2] * r * g0[2], v[3] * r * g0[3]);
        o.z = cvt_pk_bf16(v[4] * r * g1[0], v[5] * r * g1[1]); o.w = cvt_pk_bf16(v[6] * r * g1[2], v[7] * r * g1[3]);
        *(u32x4*)p = o;
    }
}

__device__ __forceinline__ void phase_attn(const Args& a, unsigned char* lds_g) {
    const int tid = tid_opaque();
    volatile int* s_item = (volatile int*)(lds_g + MISC_OFF);
    unsigned* ctr = (unsigned*)(a.ws + WS_CTL);
    for (;;) {
        __syncthreads();
        if (tid == 0) *s_item = (int)atomicAdd(ctr, 1u);
        __syncthreads();
        int it = *s_item, kind = -1, qb = 0, sub = 0;
#define CLS(K, Q, CNT) if (kind < 0) { if (it < (CNT)) { kind = (K); qb = (Q); sub = it; } else it -= (CNT); }
        CLS(2, 15, 32) CLS(1, 7, 16) CLS(2, 14, 32) CLS(2, 13, 32) CLS(1, 6, 16) CLS(2, 12, 32) CLS(2, 11, 32) CLS(1, 5, 16) CLS(2, 10, 32) CLS(2, 9, 32) CLS(1, 4, 16) CLS(2, 8, 32) CLS(1, 3, 16) CLS(1, 2, 16)
        if (kind < 0) { if (it < 256) { kind = 0; qb = 15 - (it >> 4); sub = it & 15; } else it -= 256; }
        CLS(1, 1, 16) CLS(1, 0, 16)
#undef CLS
        if (kind < 0) break;
        unsigned char* wsl = a.ws; asm volatile("" : "+s"(wsl));
        bf16_t* sec = (bf16_t*)(wsl + WS_SEC);
        const int bh = sub & 15, part = (kind == 2) ? 1 + (sub >> 4) : 0;
        const int b = bh >> 3, h = bh & 7;
        const size_t hoff = (size_t)bh * SEQ * HD;
        att::UnitRef u;
        u.P0 = qb * 256;
        if (kind == 0) {
            u.Q = sec + 4 * SEC_ELEMS + hoff + (size_t)u.P0 * HD; u.K = sec + 5 * SEC_ELEMS + hoff; u.V = sec + 6 * SEC_ELEMS + hoff;
            att::sb_unit(u, (bf16_t*)(wsl + WS_MIX) + (size_t)b * SEQ * DM + 1024 + h * HD, (char*)lds_g);
        } else {
            u.Q = sec + 0 * SEC_ELEMS + hoff + (size_t)u.P0 * HD; u.K = sec + 1 * SEC_ELEMS + hoff; u.V = sec + 2 * SEC_ELEMS + hoff;
            att::attn_unit<false>(u, wsl, bh, (char*)lds_g, part);
        }
    }
}
__device__ __forceinline__ void phase_attn_combine(const Args& a) {
    const int gt = blockIdx.x * NTHREADS + tid_opaque(), NGT = gridDim.x * NTHREADS;
    const float* po = (const float*)(a.ws + WS_PO); const float* pml = (const float*)(a.ws + WS_PML);
    const bf16_t* gate = (const bf16_t*)(a.ws + WS_SEC) + 3 * SEC_ELEMS; bf16_t* mix = (bf16_t*)(a.ws + WS_MIX);
    constexpr float C2 = LOG2E * SCALE;
    for (int item = gt; item < 128 * 256 * 16; item += NGT) {
        const int slot = item >> 12, row = (item >> 4) & 255, cg = item & 15;
        const int qb = 8 + (slot >> 4), bh = slot & 15, b = bh >> 3, h = bh & 7;
        const f32x2 ml1 = *(const f32x2*)(pml + (size_t)(slot * 2) * 512 + row * 2), ml2 = *(const f32x2*)(pml + (size_t)(slot * 2 + 1) * 512 + row * 2);
        const float M = fmaxf(ml1.x, ml2.x), a1 = __builtin_amdgcn_exp2f((ml1.x - M) * C2), a2 = __builtin_amdgcn_exp2f((ml2.x - M) * C2);
        const float inv = 1.f / (a1 * ml1.y + a2 * ml2.y);
        const float* p1 = po + (size_t)(slot * 2) * 32768 + row * 128 + cg * 8; const float* p2 = p1 + 32768;
        const f32x4 x0 = *(const f32x4*)p1, x1 = *(const f32x4*)(p1 + 4), y0 = *(const f32x4*)p2, y1 = *(const f32x4*)(p2 + 4);
        const size_t tok = (size_t)b * SEQ + qb * 256 + row;
        const u32x4 gw = *(const u32x4*)(gate + tok * 1024 + h * HD + cg * 8);
        const float w1 = a1 * inv, w2 = a2 * inv;
        u32x4 o;
        o.x = cvt_pk_bf16((w1 * x0[0] + w2 * y0[0]) * bf_lo(gw.x), (w1 * x0[1] + w2 * y0[1]) * bf_hi(gw.x));
        o.y = cvt_pk_bf16((w1 * x0[2] + w2 * y0[2]) * bf_lo(gw.y), (w1 * x0[3] + w2 * y0[3]) * bf_hi(gw.y));
        o.z = cvt_pk_bf16((w1 * x1[0] + w2 * y1[0]) * bf_lo(gw.z), (w1 * x1[1] + w2 * y1[1]) * bf_hi(gw.z));
        o.w = cvt_pk_bf16((w1 * x1[2] + w2 * y1[2]) * bf_lo(gw.w), (w1 * x1[3] + w2 * y1[3]) * bf_hi(gw.w));
        *(u32x4*)(mix + tok * DM + h * HD + cg * 8) = o;
    }
}

__device__ __forceinline__ unsigned f2ord(float f) { const unsigned u = __float_as_uint(f); return u ^ ((unsigned)((int)u >> 31) | 0x80000000u); }
__device__ __forceinline__ float ord2f(unsigned k) { const unsigned u = k ^ (~(unsigned)((int)k >> 31) | 0x80000000u); return __uint_as_float(u); }
#define INS16(L, X) do { unsigned x_ = (X); _Pragma("unroll") for (int i_ = 0; i_ < 16; ++i_) { const unsigned hi_ = max(L[i_], x_); x_ = min(L[i_], x_); L[i_] = hi_; } } while (0)
__device__ __forceinline__ void sort16_desc(unsigned (&a)[16]) {
#pragma unroll
    for (int k = 2; k <= 16; k <<= 1)
#pragma unroll
        for (int j = k >> 1; j > 0; j >>= 1)
#pragma unroll
            for (int i = 0; i < 16; ++i) { const int l = i ^ j; if (l > i) { const unsigned hi_ = max(a[i], a[l]), lo_ = min(a[i], a[l]); const bool desc = (i & k) == 0; a[i] = desc ? hi_ : lo_; a[l] = desc ? lo_ : hi_; } }
}
__device__ __forceinline__ void merge_top16(unsigned (&a)[16], const unsigned (&b)[16]) {
#pragma unroll
    for (int i = 0; i < 16; ++i) a[i] = max(a[i], b[15 - i]);
#pragma unroll
    for (int j = 8; j > 0; j >>= 1)
#pragma unroll
        for (int i = 0; i < 16; ++i) { const int l = i ^ j; if (l > i) { const unsigned hi_ = max(a[i], a[l]), lo_ = min(a[i], a[l]); a[i] = hi_; a[l] = lo_; } }
}
__device__ __forceinline__ void topk_half(const bf16_t* qp, const bf16_t* skb, int t0, int h, int c, int r32, int hi, unsigned (&L)[16]) {
    bf16x8 qf[8];
#pragma unroll
    for (int d0 = 0; d0 < 8; ++d0) qf[d0] = *(const bf16x8*)(qp + (size_t)(t0 + r32) * DM + h * 256 + c * 128 + d0 * 16 + hi * 8);
    const unsigned hi4 = 4u * (unsigned)hi;
#pragma unroll
    for (int kt = 0; kt < 4; ++kt) {
        f32x16 acc = f32x16{};
#pragma unroll
        for (int d0 = 0; d0 < 8; ++d0) { const bf16x8 kf = *(const bf16x8*)(skb + (size_t)((h * 2 + c) * 128 + kt * 32 + r32) * 128 + d0 * 16 + hi * 8);
            acc = __builtin_amdgcn_mfma_f32_32x32x16_bf16(kf, qf[d0], acc, 0, 0, 0); }
        __builtin_amdgcn_sched_barrier(0);
        unsigned G[16];
#pragma unroll
        for (int r = 0; r < 16; ++r) { const unsigned cst = (unsigned)(127 - (kt * 32 + (r & 3) + 8 * (r >> 2))); G[r] = (f2ord(acc[r]) & ~127u) | (cst - hi4); }
        sort16_desc(G);
        if (kt == 0) {
#pragma unroll
            for (int i = 0; i < 16; ++i) L[i] = G[i];
        } else merge_top16(L, G);
        __builtin_amdgcn_sched_barrier(0);
    }
    unsigned P[16];
#pragma unroll
    for (int i = 0; i < 16; ++i) { auto rr = __builtin_amdgcn_permlane32_swap(L[i], L[i], false, false); P[i] = hi ? rr[0] : rr[1]; }
    merge_top16(L, P);
}
__device__ __forceinline__ void phase_topk(const Args& a, unsigned char* lds_g) {
    LAS unsigned char* lds = (LAS unsigned char*)lds_g;
    const int tid = tid_opaque(), lane = tid & 63, wave = tid >> 6, r32 = lane & 31, hi = lane >> 5;
    const int gw = blockIdx.x * NWAVES + wave, NGW = gridDim.x * NWAVES;
    const bf16_t* skb = (const bf16_t*)(a.ws + WS_SK); const bf16_t* qp = (const bf16_t*)(a.ws + WS_QP);
    int* idx_o = (int*)(a.ws + WS_IDX); float* gw_o = (float*)(a.ws + WS_GW);
    for (int task = gw; task < (T / 32) * 8; task += NGW) {
        const int h = task & 7, t0 = (task >> 3) * 32;
        {
          const bf16_t* hbp = (const bf16_t*)(a.ws + WS_HB); const float* amx = (const float*)(a.ws + WS_AMX); unsigned char* xq = a.ws + WS_XQ;
          float am = 0.f;
          { const f32x4* ap = (const f32x4*)(amx + (size_t)(t0 + (lane & 31)) * 32);
#pragma unroll
            for (int i = 0; i < 8; ++i) { const f32x4 v = ap[i]; am = fmaxf(am, fmaxf(fmaxf(v[0], v[1]), fmaxf(v[2], v[3]))); } }
          if (h == 0 && lane < 32) ((float*)(a.ws + WS_SX))[t0 + lane] = ((const float*)(a.ws + WS_RT))[t0 + lane] * am * (1.f / 126.5f);
          const float qs = am > 0.f ? 126.5f / am : 1.f;
#pragma unroll 4
          for (int j = 0; j < 16; ++j) { const int ch = lane + 64 * j, tl = ch >> 5, tk = t0 + tl, col = h * 256 + (ch & 31) * 8;
              const u32x4 w = *(const u32x4*)(hbp + (size_t)tk * DM + col); const float r = sh_f(qs, tl);
              const int p0 = pack_i8(bf_lo(w.x) * r, bf_hi(w.x) * r, bf_lo(w.y) * r, bf_hi(w.y) * r), p1 = pack_i8(bf_lo(w.z) * r, bf_hi(w.z) * r, bf_lo(w.w) * r, bf_hi(w.w) * r);
              *(u32x2*)(xq + (size_t)tk * DM + col) = (u32x2){(unsigned)p0, (unsigned)p1}; } }
        unsigned L[2][16];
        topk_half(qp, skb, t0, h, 0, r32, hi, L[0]);
        __builtin_amdgcn_sched_barrier(0);
        topk_half(qp, skb, t0, h, 1, r32, hi, L[1]);
        __builtin_amdgcn_sched_barrier(0);
        float s1[16], s2[16]; int i1[16], i2[16];
#pragma unroll
        for (int i = 0; i < 16; ++i) { s1[i] = ord2f((L[0][i] & ~127u) | 64u); i1[i] = 127 - (int)(L[0][i] & 127u); s2[i] = ord2f((L[1][i] & ~127u) | 64u); i2[i] = 127 - (int)(L[1][i] & 127u); }
        unsigned CG[4][16];
#pragma unroll
        for (int i = 0; i < 64; ++i) CG[i >> 4][i & 15] = 0u;
        CG[0][0] = (f2ord(s1[0] + s2[0]) & ~255u) | 0u;
        CG[0][1] = (f2ord(s1[0] + s2[1]) & ~255u) | 1u;
        CG[0][2] = (f2ord(s1[0] + s2[2]) & ~255u) | 2u;
        CG[0][3] = (f2ord(s1[0] + s2[3]) & ~255u) | 3u;
        CG[0][4] = (f2ord(s1[0] + s2[4]) & ~255u) | 4u;
        CG[0][5] = (f2ord(s1[0] + s2[5]) & ~255u) | 5u;
        CG[0][6] = (f2ord(s1[0] + s2[6]) & ~255u) | 6u;
        CG[0][7] = (f2ord(s1[0] + s2[7]) & ~255u) | 7u;
        CG[0][8] = (f2ord(s1[0] + s2[8]) & ~255u) | 8u;
        CG[0][9] = (f2ord(s1[0] + s2[9]) & ~255u) | 9u;
        CG[0][10] = (f2ord(s1[0] + s2[10]) & ~255u) | 10u;
        CG[0][11] = (f2ord(s1[0] + s2[11]) & ~255u) | 11u;
        CG[0][12] = (f2ord(s1[0] + s2[12]) & ~255u) | 12u;
        CG[0][13] = (f2ord(s1[0] + s2[13]) & ~255u) | 13u;
        CG[0][14] = (f2ord(s1[0] + s2[14]) & ~255u) | 14u;
        CG[0][15] = (f2ord(s1[0] + s2[15]) & ~255u) | 15u;
        CG[1][0] = (f2ord(s1[1] + s2[0]) & ~255u) | 16u;
        CG[1][1] = (f2ord(s1[1] + s2[1]) & ~255u) | 17u;
        CG[1][2] = (f2ord(s1[1] + s2[2]) & ~255u) | 18u;
        CG[1][3] = (f2ord(s1[1] + s2[3]) & ~255u) | 19u;
        CG[1][4] = (f2ord(s1[1] + s2[4]) & ~255u) | 20u;
        CG[1][5] = (f2ord(s1[1] + s2[5]) & ~255u) | 21u;
        CG[1][6] = (f2ord(s1[1] + s2[6]) & ~255u) | 22u;
        CG[1][7] = (f2ord(s1[1] + s2[7]) & ~255u) | 23u;
        CG[1][8] = (f2ord(s1[2] + s2[0]) & ~255u) | 32u;
        CG[1][9] = (f2ord(s1[2] + s2[1]) & ~255u) | 33u;
        CG[1][10] = (f2ord(s1[2] + s2[2]) & ~255u) | 34u;
        CG[1][11] = (f2ord(s1[2] + s2[3]) & ~255u) | 35u;
        CG[1][12] = (f2ord(s1[2] + s2[4]) & ~255u) | 36u;
        CG[1][13] = (f2ord(s1[3] + s2[0]) & ~255u) | 48u;
        CG[1][14] = (f2ord(s1[3] + s2[1]) & ~255u) | 49u;
        CG[1][15] = (f2ord(s1[3] + s2[2]) & ~255u) | 50u;
        CG[2][0] = (f2ord(s1[3] + s2[3]) & ~255u) | 51u;
        CG[2][1] = (f2ord(s1[4] + s2[0]) & ~255u) | 64u;
        CG[2][2] = (f2ord(s1[4] + s2[1]) & ~255u) | 65u;
        CG[2][3] = (f2ord(s1[4] + s2[2]) & ~255u) | 66u;
        CG[2][4] = (f2ord(s1[5] + s2[0]) & ~255u) | 80u;
        CG[2][5] = (f2ord(s1[5] + s2[1]) & ~255u) | 81u;
        CG[2][6] = (f2ord(s1[6] + s2[0]) & ~255u) | 96u;
        CG[2][7] = (f2ord(s1[6] + s2[1]) & ~255u) | 97u;
        CG[2][8] = (f2ord(s1[7] + s2[0]) & ~255u) | 112u;
        CG[2][9] = (f2ord(s1[7] + s2[1]) & ~255u) | 113u;
        CG[2][10] = (f2ord(s1[8] + s2[0]) & ~255u) | 128u;
        CG[2][11] = (f2ord(s1[9] + s2[0]) & ~255u) | 144u;
        CG[2][12] = (f2ord(s1[10] + s2[0]) & ~255u) | 160u;
        CG[2][13] = (f2ord(s1[11] + s2[0]) & ~255u) | 176u;
        CG[2][14] = (f2ord(s1[12] + s2[0]) & ~255u) | 192u;
        CG[2][15] = (f2ord(s1[13] + s2[0]) & ~255u) | 208u;
        CG[3][0] = (f2ord(s1[14] + s2[0]) & ~255u) | 224u;
        CG[3][1] = (f2ord(s1[15] + s2[0]) & ~255u) | 240u;
        sort16_desc(CG[0]); sort16_desc(CG[1]); sort16_desc(CG[2]); sort16_desc(CG[3]);
        merge_top16(CG[0], CG[1]); merge_top16(CG[2], CG[3]); merge_top16(CG[0], CG[2]);
        unsigned LC[16];
#pragma unroll
        for (int i = 0; i < 16; ++i) LC[i] = CG[0][i];
        LAS int* tb = (LAS int*)(lds + wave * 8192);
#pragma unroll
        for (int i = 0; i < 16; ++i) { tb[i * 64 + lane] = i1[i]; tb[(16 + i) * 64 + lane] = i2[i]; }
        float LS[16]; int LP[16];
#pragma unroll
        for (int i = 0; i < 16; ++i) { const unsigned cid = LC[i] & 255u; LS[i] = ord2f((LC[i] & ~255u) | 128u);
            LP[i] = tb[(cid >> 4) * 64 + lane] * 128 + tb[(16 + (cid & 15u)) * 64 + lane]; }
        float den = 0.f, e[16];
#pragma unroll
        for (int i = 0; i < 16; ++i) { e[i] = __expf(LS[i] - LS[0]); den += e[i]; }
        const float rden = 1.f / den;
        const size_t ob = (size_t)(t0 + r32) * NE + h * 16;
        if (hi == 0) {
#pragma unroll
            for (int i = 0; i < 4; ++i) *(int4*)(idx_o + ob + 4 * i) = make_int4(LP[4 * i], LP[4 * i + 1], LP[4 * i + 2], LP[4 * i + 3]);
        } else {
#pragma unroll
            for (int i = 0; i < 4; ++i) *(f32x4*)(gw_o + ob + 4 * i) = (f32x4){e[4 * i] * rden, e[4 * i + 1] * rden, e[4 * i + 2] * rden, e[4 * i + 3] * rden};
        }
    }
}


__device__ __forceinline__ void wave_argmax(float& v, int& i) {
#pragma unroll
    for (int o = 1; o < 64; o <<= 1) { const float ov = sx_f(v, o); const int oi = sx_i(i, o); if (ov > v || (ov == v && oi < i)) { v = ov; i = oi; } }
}
__device__ __forceinline__ void phase_topk_ref(const Args& a) {
    const int tid = tid_opaque(), lane = tid & 63, wave = tid >> 6;
    const int gw = blockIdx.x * NWAVES + wave, NGW = gridDim.x * NWAVES;
    const bf16_t* skb = (const bf16_t*)(a.ws + WS_SK); const bf16_t* qp = (const bf16_t*)(a.ws + WS_QP);
    int* idx_o = (int*)(a.ws + WS_IDX); float* gw_o = (float*)(a.ws + WS_GW);
    for (int task = gw; task < T * 8; task += NGW) {
        const int t = task >> 3, h = task & 7;
        float topS[2]; int topI[2];
        for (int c = 0; c < 2; ++c) {
            const bf16_t* q = qp + (size_t)t * DM + h * 256 + c * 128;
            float sc0 = 0.f, sc1 = 0.f;
            const bf16_t* k0 = skb + (size_t)((h * 2 + c) * 128 + lane) * 128; const bf16_t* k1 = k0 + 64 * 128;
            for (int d = 0; d < 128; ++d) { const float qd = __uint_as_float((unsigned)q[d] << 16);
                sc0 += qd * __uint_as_float((unsigned)k0[d] << 16); sc1 += qd * __uint_as_float((unsigned)k1[d] << 16); }
            float ms = 0.f; int mi = 0;
            for (int r = 0; r < 16; ++r) {
                float v; int i; if (sc0 >= sc1) { v = sc0; i = lane; } else { v = sc1; i = lane + 64; }
                wave_argmax(v, i);
                if (lane == r) { ms = v; mi = i; }
                if (i == lane) sc0 = -__builtin_inff();
                if (i == lane + 64) sc1 = -__builtin_inff();
            }
            topS[c] = ms; topI[c] = mi;
        }
        float cs[4]; int ci[4];
#pragma unroll
        for (int j = 0; j < 4; ++j) { const int cidx = lane * 4 + j, aa = cidx >> 4, bb = cidx & 15;
            cs[j] = sh_f(topS[0], aa) + sh_f(topS[1], bb); ci[j] = cidx; }
        float fs = 0.f; int fi = 0;
        for (int r = 0; r < 16; ++r) {
            float v = cs[0]; int i = ci[0];
#pragma unroll
            for (int j = 1; j < 4; ++j) if (cs[j] > v) { v = cs[j]; i = ci[j]; }
            wave_argmax(v, i);
            if (lane == r) { fs = v; fi = i; }
#pragma unroll
            for (int j = 0; j < 4; ++j) if (ci[j] == i) cs[j] = -__builtin_inff();
        }
        const int e1 = sh_i(topI[0], fi >> 4), e2 = sh_i(topI[1], fi & 15);
        const float mx = sh_f(fs, 0);
        float ev = lane < 16 ? __expf(fs - mx) : 0.f;
        const float den = wave_sum(ev);
        if (lane < 16) { idx_o[(size_t)t * NE + h * 16 + lane] = e1 * 128 + e2; gw_o[(size_t)t * NE + h * 16 + lane] = ev / den; }
    }
}

__device__ __forceinline__ void fp8x16_to_f32(const u32x4 q, f32x2 (&o)[8]) {
    o[0] = __builtin_amdgcn_cvt_pk_f32_fp8((int)q.x, false); o[1] = __builtin_amdgcn_cvt_pk_f32_fp8((int)q.x, true);
    o[2] = __builtin_amdgcn_cvt_pk_f32_fp8((int)q.y, false); o[3] = __builtin_amdgcn_cvt_pk_f32_fp8((int)q.y, true);
    o[4] = __builtin_amdgcn_cvt_pk_f32_fp8((int)q.z, false); o[5] = __builtin_amdgcn_cvt_pk_f32_fp8((int)q.z, true);
    o[6] = __builtin_amdgcn_cvt_pk_f32_fp8((int)q.w, false); o[7] = __builtin_amdgcn_cvt_pk_f32_fp8((int)q.w, true);
}
#define HALVE(dst, srcv, n, bitmask) do { const bool up_ = (lane & (bitmask)) != 0; _Pragma("unroll") for (int i_ = 0; i_ < (n); ++i_) { \
        const float keep_ = up_ ? srcv[(n) + i_] : srcv[i_], send_ = up_ ? srcv[i_] : srcv[(n) + i_]; dst[i_] = keep_ + sx_f(send_, (bitmask)); } } while (0)
#define ITEM_T(n) (wv + ((n) % KT) * NWX)
#define ITEM_S(n) (xl + 8 * ((n) / KT))
#define LD_IDX(ID, n) do { const int4* ip_ = (const int4*)(idx_i + (size_t)ITEM_T(n) * NE + g * 16); _Pragma("unroll") for (int i_ = 0; i_ < 4; ++i_) ID[i_] = ip_[i_]; } while (0)
#define LD_ROWS(Q, ID, TAB, n) do { const unsigned char* b_ = (TAB) + (size_t)ITEM_S(n) * ((size_t)NEXP * 128) + c * 16; _Pragma("unroll") for (int i_ = 0; i_ < 4; ++i_) { \
        Q[4 * i_] = *(const u32x4*)(b_ + (size_t)ID[i_].x * 128); Q[4 * i_ + 1] = *(const u32x4*)(b_ + (size_t)ID[i_].y * 128); \
        Q[4 * i_ + 2] = *(const u32x4*)(b_ + (size_t)ID[i_].z * 128); Q[4 * i_ + 3] = *(const u32x4*)(b_ + (size_t)ID[i_].w * 128); } } while (0)
__device__ __forceinline__ int dpp_hmirror(int v) { return __builtin_amdgcn_update_dpp(0, v, 0x141, 0xf, 0xf, true); }
__device__ __forceinline__ int dpp_qxor2(int v) { return __builtin_amdgcn_update_dpp(0, v, 0x4E, 0xf, 0xf, true); }
__device__ __forceinline__ int dpp_qxor1(int v) { return __builtin_amdgcn_update_dpp(0, v, 0xB1, 0xf, 0xf, true); }
__device__ __forceinline__ void phase_peer_u(const Args& a) {
    const int tid = tid_opaque(), lane = tid & 63, wave = tid >> 6, g = lane >> 3, c = lane & 7;
    const int xl = blockIdx.x & 7, wv = (blockIdx.x >> 3) * NWAVES + wave, NWX = (gridDim.x >> 3) * NWAVES, KT = T / NWX, N = 2 * KT;
    const unsigned char* xq = a.ws + WS_XQ; const unsigned char* u8 = a.ws + WS_U8;
    const int* idx_i = (const int*)(a.ws + WS_IDX); float* part = (float*)(a.ws + WS_PART);
    const bool up4 = (c & 4) != 0, up2 = (c & 2) != 0, up1 = (c & 1) != 0;
#define LD_X(X, n) do { X = *(const u32x4*)(xq + (size_t)ITEM_T(n) * DM + ITEM_S(n) * 128 + c * 16); } while (0)
#define COMPUTE_U(Q, X, n) do { int p[16]; \
        _Pragma("unroll") for (int i = 0; i < 16; ++i) { int d_ = __builtin_amdgcn_sdot4((int)Q[i].x, (int)X.x, 0, false); d_ = __builtin_amdgcn_sdot4((int)Q[i].y, (int)X.y, d_, false); \
            d_ = __builtin_amdgcn_sdot4((int)Q[i].z, (int)X.z, d_, false); p[i] = __builtin_amdgcn_sdot4((int)Q[i].w, (int)X.w, d_, false); } \
        int p8[8], p4[4], p2[2]; \
        _Pragma("unroll") for (int i = 0; i < 8; ++i) { const int keep_ = up4 ? p[8 + i] : p[i], send_ = up4 ? p[i] : p[8 + i]; p8[i] = keep_ + dpp_hmirror(send_); } \
        _Pragma("unroll") for (int i = 0; i < 4; ++i) { const int keep_ = up2 ? p8[4 + i] : p8[i], send_ = up2 ? p8[i] : p8[4 + i]; p4[i] = keep_ + dpp_qxor2(send_); } \
        _Pragma("unroll") for (int i = 0; i < 2; ++i) { const int keep_ = up1 ? p4[2 + i] : p4[i], send_ = up1 ? p4[i] : p4[2 + i]; p2[i] = keep_ + dpp_qxor1(send_); } \
        *(f32x2*)(part + ((size_t)ITEM_T(n) * 16 + ITEM_S(n)) * NE + 2 * lane) = (f32x2){(float)p2[0], (float)p2[1]}; } while (0)
    int4 IA[4], IB[4]; u32x4 QA[16], QB[16], XA, XB;
    LD_IDX(IA, 0); LD_IDX(IB, 1);
    LD_ROWS(QA, IA, u8, 0); LD_X(XA, 0);
    for (int n = 0; n < N; n += 2) {
        LD_ROWS(QB, IB, u8, n + 1); LD_X(XB, n + 1);
        if (n + 2 < N) LD_IDX(IA, n + 2);
        COMPUTE_U(QA, XA, n);
        if (n + 2 < N) { LD_ROWS(QA, IA, u8, n + 2); LD_X(XA, n + 2); }
        if (n + 3 < N) LD_IDX(IB, n + 3);
        COMPUTE_U(QB, XB, n + 1);
    }
#undef LD_X
#undef COMPUTE_U
}
__device__ __forceinline__ void phase_peer_w(const Args& a) {
    const int gt = blockIdx.x * NTHREADS + tid_opaque(), NGT = gridDim.x * NTHREADS;
    const int* idx_i = (const int*)(a.ws + WS_IDX); const float* gw_i = (const float*)(a.ws + WS_GW); const float* part = (const float*)(a.ws + WS_PART);
    const float* suv = (const float*)(a.ws + WS_SUV); const float* sx = (const float*)(a.ws + WS_SX);
    signed char* wq = (signed char*)(a.ws + WS_WQ); float* sw = (float*)(a.ws + WS_SW);
    for (int item = gt; item < T * NE; item += NGT) {
        const int t = item >> 7, e = item & 127;
        float sum = 0.f;
#pragma unroll
        for (int s = 0; s < 16; ++s) sum += part[((size_t)t * 16 + s) * NE + e];
        const int ex = idx_i[item];
        const float d = sum * suv[ex] * sx[t];
        const float om = 0.5f * d * (1.f + erff(d * 0.70710678118654752f)) * gw_i[item] * suv[NEXP + ex];
        float mx = fabsf(om);
        mx = fmaxf(mx, sx_f(mx, 1)); mx = fmaxf(mx, sx_f(mx, 2)); mx = fmaxf(mx, sx_f(mx, 4)); mx = fmaxf(mx, sx_f(mx, 8));
        const float qs = mx > 0.f ? 127.f / mx : 1.f;
        wq[item] = (signed char)(int)__builtin_rintf(om * qs);
        if ((e & 15) == 0) sw[t * 8 + (e >> 4)] = mx * (1.f / 127.f);
    }
}
__device__ __forceinline__ void phase_peer_v(const Args& a, float* dst) {
    const int tid = tid_opaque(), lane = tid & 63, wave = tid >> 6, g = lane >> 3, c = lane & 7;
    const int xl = blockIdx.x & 7, wv = (blockIdx.x >> 3) * NWAVES + wave, NWX = (gridDim.x >> 3) * NWAVES, KT = T / NWX, N = 2 * KT;
    const unsigned char* v8 = a.ws + WS_V8;
    const int* idx_i = (const int*)(a.ws + WS_IDX); const unsigned char* wq = a.ws + WS_WQ; const float* sw = (const float*)(a.ws + WS_SW);
    const float* hsrc = a.out;
#define LD_W(W, SWV, n) do { W = *(const u32x4*)(wq + (size_t)ITEM_T(n) * NE + g * 16); SWV = sw[ITEM_T(n) * 8 + g]; } while (0)
#define QUAD(A_, B_, C_, D_, W_, A0, A1, A2, A3) do { \
        const unsigned ablo_ = __builtin_amdgcn_perm(B_, A_, 0x05010400u), abhi_ = __builtin_amdgcn_perm(B_, A_, 0x07030602u); \
        const unsigned cdlo_ = __builtin_amdgcn_perm(D_, C_, 0x05010400u), cdhi_ = __builtin_amdgcn_perm(D_, C_, 0x07030602u); \
        A0 = __builtin_amdgcn_sdot4((int)__builtin_amdgcn_perm(cdlo_, ablo_, 0x05040100u), (int)(W_), A0, false); \
        A1 = __builtin_amdgcn_sdot4((int)__builtin_amdgcn_perm(cdlo_, ablo_, 0x07060302u), (int)(W_), A1, false); \
        A2 = __builtin_amdgcn_sdot4((int)__builtin_amdgcn_perm(cdhi_, abhi_, 0x05040100u), (int)(W_), A2, false); \
        A3 = __builtin_amdgcn_sdot4((int)__builtin_amdgcn_perm(cdhi_, abhi_, 0x07060302u), (int)(W_), A3, false); } while (0)
#define COMPUTE_V(Q, W, SWV, n) do { int ac[16]; _Pragma("unroll") for (int k = 0; k < 16; ++k) ac[k] = 0; \
        _Pragma("unroll") for (int q_ = 0; q_ < 4; ++q_) { const unsigned w_ = q_ == 0 ? W.x : q_ == 1 ? W.y : q_ == 2 ? W.z : W.w; \
            QUAD(Q[4 * q_].x, Q[4 * q_ + 1].x, Q[4 * q_ + 2].x, Q[4 * q_ + 3].x, w_, ac[0], ac[1], ac[2], ac[3]); \
            QUAD(Q[4 * q_].y, Q[4 * q_ + 1].y, Q[4 * q_ + 2].y, Q[4 * q_ + 3].y, w_, ac[4], ac[5], ac[6], ac[7]); \
            QUAD(Q[4 * q_].z, Q[4 * q_ + 1].z, Q[4 * q_ + 2].z, Q[4 * q_ + 3].z, w_, ac[8], ac[9], ac[10], ac[11]); \
            QUAD(Q[4 * q_].w, Q[4 * q_ + 1].w, Q[4 * q_ + 2].w, Q[4 * q_ + 3].w, w_, ac[12], ac[13], ac[14], ac[15]); } \
        float p[16]; _Pragma("unroll") for (int k = 0; k < 16; ++k) p[k] = (float)ac[k] * SWV; \
        float p8[8], p4[4], p2[2]; \
        _Pragma("unroll") for (int i_ = 0; i_ < 8; ++i_) { auto rr_ = __builtin_amdgcn_permlane32_swap(__float_as_uint(p[i_]), __float_as_uint(p[8 + i_]), false, false); p8[i_] = __uint_as_float(rr_[0]) + __uint_as_float(rr_[1]); } \
        _Pragma("unroll") for (int i_ = 0; i_ < 4; ++i_) { auto rr_ = __builtin_amdgcn_permlane16_swap(__float_as_uint(p8[i_]), __float_as_uint(p8[4 + i_]), false, false); p4[i_] = __uint_as_float(rr_[0]) + __uint_as_float(rr_[1]); } \
        HALVE(p2, p4, 2, 8); \
        const size_t o_ = (size_t)ITEM_T(n) * DM + ITEM_S(n) * 128 + c * 16 + 2 * g; \
        const f32x2 hv = *(const f32x2*)(hsrc + o_); *(f32x2*)(dst + o_) = (f32x2){hv.x + p2[0], hv.y + p2[1]}; } while (0)
    int4 IA[4], IB[4]; u32x4 QA[16], QB[16], WA, WB; float SA, SB_;
    LD_IDX(IA, 0); LD_IDX(IB, 1);
    LD_ROWS(QA, IA, v8, 0); LD_W(WA, SA, 0);
    for (int n = 0; n < N; n += 2) {
        LD_ROWS(QB, IB, v8, n + 1); LD_W(WB, SB_, n + 1);
        if (n + 2 < N) LD_IDX(IA, n + 2);
        COMPUTE_V(QA, WA, SA, n);
        if (n + 2 < N) { LD_ROWS(QA, IA, v8, n + 2); LD_W(WA, SA, n + 2); }
        if (n + 3 < N) LD_IDX(IB, n + 3);
        COMPUTE_V(QB, WB, SB_, n + 1);
    }
#undef LD_W
#undef QUAD
#undef COMPUTE_V
}
#undef ITEM_T
#undef ITEM_S
#undef LD_IDX
#undef LD_ROWS
#undef HALVE


constexpr int NPHASE = 11;
#define LOAD_ARGS() do { } while (0)
__global__ void __launch_bounds__(NTHREADS, 2) fwd_kernel(Args a) {
    extern __shared__ __attribute__((aligned(16))) unsigned char lds[];
#if MK_ONE_LAUNCH
    constexpr int lo = 0, hi = NPHASE;
    cg::grid_group grid = cg::this_grid();
    volatile LAS unsigned* misc = (volatile LAS unsigned*)((LAS unsigned char*)lds + MISC_OFF);
    if (threadIdx.x < 16) misc[threadIdx.x] = 0u;
    __syncthreads();
    { LOAD_ARGS(); (void)xcd_barrier_post((unsigned*)(a.ws + WS_CTL) + CW_BAR, misc + 8); }
#ifndef SEAM_CG_MASK
#define SEAM_CG_MASK 0
#endif
#define SEAM(k) do { if (lo <= (k) && (k) + 1 < hi) { if ((SEAM_CG_MASK >> (k)) & 1) grid.sync(); else { LOAD_ARGS(); XcdBarrier xb_; xb_.bar = (unsigned*)(a.ws + WS_CTL) + CW_BAR; xb_.x = xb_xcc_id(); \
        xb_.st = (volatile LAS unsigned*)((LAS unsigned char*)lds + MISC_OFF) + 8; xcd_barrier(xb_); } } } while (0)
#else
    int lo, hi; { LOAD_ARGS(); lo = a.ph_lo; hi = a.ph_hi; }
#define SEAM(k) do { } while (0)
#endif
#define IN(k) (lo <= (k) && (k) < hi)
#ifndef DUP_PHASE
#define DUP_PHASE -1
#endif
    if (IN(0)) { LOAD_ARGS(); phase0(a, lds); if (DUP_PHASE == 0) { __syncthreads(); phase0(a, lds); } SEAM(0); }
    if (IN(1)) { LOAD_ARGS(); unsigned char* ws = a.ws;
        cumsum_rows(a);
        pg8::Gemm g{(const bf16_t*)(ws + WS_XN), (const bf16_t*)(ws + WS_WIN), T, NPROJ, DM}; pg8::StaticOrder S; S.init(T, NPROJ, (int)gridDim.x, (int)blockIdx.x);
        pg8::EpiInProj E{(bf16_t*)(ws + WS_SEC), (const float*)(ws + WS_SXN), (const float*)(ws + WS_WSC), a.in[4], a.in[5], (LAS float*)((LAS unsigned char*)lds + RING_BYTES)};
        for (int rep_ = 0; rep_ < (DUP_PHASE == 1 ? 2 : 1); ++rep_)
        pg8::gemm_phase<pg8::EpiInProj, pg8::StaticOrder, true, true, true>((LAS unsigned char*)lds, g, S, E);
        { const int nwg_ = (T / 256) * (NPROJ / 256), G_ = (int)gridDim.x, rem_ = nwg_ % G_;
          if (rem_ > 0 && (int)blockIdx.x >= rem_) convert_tables(a, TAB_SPLIT, 2 * NEXP, ((int)blockIdx.x - rem_) * NWAVES + (tid_opaque() >> 6), (G_ - rem_) * NWAVES);
          else if (rem_ == 0) convert_tables(a, TAB_SPLIT, 2 * NEXP, (int)blockIdx.x * NWAVES + (tid_opaque() >> 6), G_ * NWAVES); }
        SEAM(1);
    }
    if (IN(3)) { LOAD_ARGS(); phase_attn(a, lds);
#if MK_ONE_LAUNCH
        if (DUP_PHASE == 3) { XcdBarrier xb_; xb_.bar = (unsigned*)(a.ws + WS_CTL) + CW_BAR; xb_.x = xb_xcc_id(); xb_.st = (volatile LAS unsigned*)((LAS unsigned char*)lds + MISC_OFF) + 8;
            xcd_barrier(xb_); if (blockIdx.x == 0 && threadIdx.x == 0) __hip_atomic_store((unsigned*)(a.ws + WS_CTL), 0u, __ATOMIC_RELAXED, __HIP_MEMORY_SCOPE_AGENT); xcd_barrier(xb_); phase_attn(a, lds); }
#endif
        SEAM(3); }
    if (IN(4)) { LOAD_ARGS(); phase_attn_combine(a); SEAM(4); }
    if (IN(5)) { LOAD_ARGS(); unsigned char* ws = a.ws;
        pg8::Gemm g{(const bf16_t*)(ws + WS_MIX), (const bf16_t*)(ws + WS_WOUT), T, DM, DM}; pg8::StaticOrder S; S.init(T, DM, (int)gridDim.x, (int)blockIdx.x);
        pg8::EpiOutProj E{a.in[0], a.out, (bf16_t*)(ws + WS_HB), (float*)(ws + WS_SSQ), (float*)(ws + WS_AMX)};
        for (int rep_ = 0; rep_ < (DUP_PHASE == 5 ? 2 : 1); ++rep_)
        pg8::gemm_phase<pg8::EpiOutProj, pg8::StaticOrder, true, true>((LAS unsigned char*)lds, g, S, E);
        SEAM(5);
    }
    if (IN(6)) { LOAD_ARGS(); unsigned char* ws = a.ws;
        pg8::Gemm g{(const bf16_t*)(ws + WS_HB), (const bf16_t*)(ws + WS_WPQ), T, DM, DM}; pg8::StaticOrder S; S.init(T, DM, (int)gridDim.x, (int)blockIdx.x);
        pg8::EpiPeerQ E{(const float*)(ws + WS_SSQ), (bf16_t*)(ws + WS_QP), (float*)(ws + WS_RT)};
        for (int rep_ = 0; rep_ < (DUP_PHASE == 6 ? 2 : 1); ++rep_)
        pg8::gemm_phase<pg8::EpiPeerQ, pg8::StaticOrder, true, true>((LAS unsigned char*)lds, g, S, E);
        SEAM(6);
    }
    #ifdef TOPK_REF
    if (IN(7)) { LOAD_ARGS(); phase_topk_ref(a); SEAM(7); }
#else
    if (IN(7)) { LOAD_ARGS(); for (int rep_ = 0; rep_ < (DUP_PHASE == 7 ? 2 : 1); ++rep_) phase_topk(a, lds); SEAM(7); }
#endif
    if (IN(8)) { LOAD_ARGS(); for (int rep_ = 0; rep_ < (DUP_PHASE == 8 ? 2 : 1); ++rep_) phase_peer_u(a); SEAM(8); }
    if (IN(9)) { LOAD_ARGS(); for (int rep_ = 0; rep_ < (DUP_PHASE == 9 ? 2 : 1); ++rep_) phase_peer_w(a); SEAM(9); }
    if (IN(10)) { LOAD_ARGS(); for (int rep_ = 0; rep_ < (DUP_PHASE == 10 ? 2 : 1); ++rep_) phase_peer_v(a, (DUP_PHASE == 10 && rep_ == 0) ? (float*)(a.ws + WS_END) : a.out); }
#undef IN
#undef SEAM
}

extern "C" void kernel_launch(void* const* d_in, const int* in_sizes, int n_in, void* d_out, int out_size, void* d_ws, size_t ws_size, hipStream_t stream) {
    static int grid = 0;
    if (grid == 0) {
        if (n_in != 12 || in_sizes[0] != T * DM || out_size != T * DM || ws_size < WS_END) { fprintf(stderr, "kernel_launch: unexpected shapes (n_in %d, in0 %d, out %d, ws %zu)\n", n_in, n_in > 0 ? in_sizes[0] : -1, out_size, ws_size); grid = -1; return; }
        int dev = 0, cus = 0, per_cu = 0;
        if (hipGetDevice(&dev) != hipSuccess || hipDeviceGetAttribute(&cus, hipDeviceAttributeMultiprocessorCount, dev) != hipSuccess) { grid = -1; return; }
        if (hipFuncSetAttribute((const void*)fwd_kernel, hipFuncAttributeMaxDynamicSharedMemorySize, LDS_BYTES) != hipSuccess) { fprintf(stderr, "kernel_launch: hipFuncSetAttribute failed\n"); grid = -1; return; }
        if (hipOccupancyMaxActiveBlocksPerMultiprocessor(&per_cu, (const void*)fwd_kernel, NTHREADS, LDS_BYTES) != hipSuccess || per_cu < 1) { fprintf(stderr, "kernel_launch: occupancy query says %d\n", per_cu); grid = -1; return; }
        grid = cus;
    }
    if (grid < 0) return;
    (void)hipMemsetAsync((char*)d_ws + WS_CTL, 0, CTL_BYTES, stream);
    Args a{};
    for (int i = 0; i < 12; ++i) a.in[i] = (const float*)d_in[i];
    a.out = (float*)d_out; a.ws = (unsigned char*)d_ws;
#if MK_ONE_LAUNCH
    a.ph_lo = 0; a.ph_hi = NPHASE;
    void* args[] = {&a};
#if MK_COOP_LAUNCH
    hipError_t e = hipLaunchCooperativeKernel((const void*)fwd_kernel, dim3(grid), dim3(NTHREADS), args, LDS_BYTES, stream);
    if (e != hipSuccess) fprintf(stderr, "cooperative launch failed: %s (grid %d)\n", hipGetErrorString(e), grid);
#else
    (void)args; hipLaunchKernelGGL(fwd_kernel, dim3(grid), dim3(NTHREADS), LDS_BYTES, stream, a);
#endif
#else
    for (int p = 0; p < NPHASE; ++p) { a.ph_lo = p; a.ph_hi = p + 1; hipLaunchKernelGGL(fwd_kernel, dim3(grid), dim3(NTHREADS), LDS_BYTES, stream, a); }
#endif
}
```

```cpp
#include <hip/hip_runtime.h>
#include <hip/hip_cooperative_groups.h>
#include <cstdio>
#include <cstdint>
namespace cg = cooperative_groups;

#ifndef MK_COOP_LAUNCH
#define MK_COOP_LAUNCH 0
#endif
#ifndef MK_ONE_LAUNCH
#define MK_ONE_LAUNCH 1
#endif

#define LAS __attribute__((address_space(3)))
typedef unsigned short bf16_t;
typedef short bf16x8 __attribute__((ext_vector_type(8)));
typedef short s16x4 __attribute__((ext_vector_type(4)));
typedef float f32x2 __attribute__((ext_vector_type(2)));
typedef float f32x4 __attribute__((ext_vector_type(4)));
typedef float f32x16 __attribute__((ext_vector_type(16)));
typedef unsigned u32x2 __attribute__((ext_vector_type(2)));
typedef unsigned u32x4 __attribute__((ext_vector_type(4)));
typedef __bf16 bf16x2_t __attribute__((ext_vector_type(2)));

constexpr int NB = 2, SEQ = 4096, T = NB * SEQ, DM = 2048, HD = 128, NHF = 8, DIN = 7176, NPROJ = 7168;
constexpr int NEXP = 16384, NE = 128;
constexpr float EPS = 1e-6f;
constexpr float SCALE = 0.08838834764831845f, LOG2E = 1.4426950408889634f;
constexpr int NWAVES = 8, NTHREADS = 512;

constexpr size_t MiB = 1u << 20;
constexpr size_t WS_CTL = 0, CTL_BYTES = 32768;
constexpr int CW_BAR = 1024;
constexpr size_t WS_SXN = 64 * MiB  , WS_WSC = 45 * MiB + 800 * 1024  ;
constexpr int CW_WMAX = 64;
constexpr size_t WS_GQK = 45 * MiB + 768 * 1024;
constexpr size_t WS_WIN = 1 * MiB, WS_WOUT = 29 * MiB, WS_WPQ = 37 * MiB, WS_SK = 45 * MiB, WS_LOGF = 46 * MiB, WS_C = 46 * MiB + 512 * 1024, WS_SSQ = 47 * MiB;
constexpr size_t WS_XN = 48 * MiB;
constexpr size_t WS_SEC = 80 * MiB;
constexpr size_t SEC_ELEMS = 8u << 20;
constexpr size_t WS_MIX = 192 * MiB, WS_HB = 224 * MiB, WS_QP = 256 * MiB, WS_IDX = 288 * MiB, WS_GW = 292 * MiB, WS_U8 = 296 * MiB, WS_V8 = 328 * MiB, WS_SUV = 360 * MiB  , WS_RT = 360 * MiB + 256 * 1024  , WS_W = 361 * MiB  ,
                 WS_PART = 368 * MiB  , WS_XQ = 432 * MiB  , WS_END = 448 * MiB;
constexpr size_t WS_AMX = 365 * MiB  , WS_SX = WS_RT + 64 * 1024  , WS_WQ = WS_W  , WS_SW = WS_W + 2 * MiB  ;
constexpr size_t WS_PO = WS_PART  , WS_PML = WS_PART + 32 * MiB  ;

constexpr int RING_BYTES = 131072;
constexpr int MISC_OFF = 143360;
constexpr int LDS_BYTES = 147456;

__device__ __forceinline__ unsigned cvt_pk_bf16(float lo, float hi) { unsigned r; asm volatile("v_cvt_pk_bf16_f32 %0, %1, %2" : "=v"(r) : "v"(lo), "v"(hi)); return r; }
__device__ __forceinline__ float bf_lo(unsigned u) { return __builtin_bit_cast(float, u << 16); }
__device__ __forceinline__ float bf_hi(unsigned u) { return __builtin_bit_cast(float, u & 0xffff0000u); }
__device__ __forceinline__ int lane_id_fresh() { int l = (int)__builtin_amdgcn_mbcnt_hi(~0u, __builtin_amdgcn_mbcnt_lo(~0u, 0u)); asm volatile("" : "+v"(l)); return l; }
__device__ __forceinline__ int sx_i(int v, int m) { return __builtin_amdgcn_ds_bpermute((lane_id_fresh() ^ m) << 2, v); }
__device__ __forceinline__ float sx_f(float v, int m) { return __int_as_float(__builtin_amdgcn_ds_bpermute((lane_id_fresh() ^ m) << 2, __float_as_int(v))); }
__device__ __forceinline__ int sh_i(int v, int src) { return __builtin_amdgcn_ds_bpermute(src << 2, v); }
__device__ __forceinline__ float sh_f(float v, int src) { return __int_as_float(__builtin_amdgcn_ds_bpermute(src << 2, __float_as_int(v))); }
__device__ __forceinline__ float shup_f(float v, int d) { const int l = lane_id_fresh(); const int s = l - d; return __int_as_float(__builtin_amdgcn_ds_bpermute((s < 0 ? l : s) << 2, __float_as_int(v))); }
__device__ __forceinline__ float wave_sum(float v) {
#pragma unroll
    for (int o = 1; o < 64; o <<= 1) v += sx_f(v, o);
    return v;
}
__device__ __forceinline__ float wave_max(float v) {
#pragma unroll
    for (int o = 1; o < 64; o <<= 1) v = fmaxf(v, sx_f(v, o));
    return v;
}
__device__ __forceinline__ int tid_opaque() { int t = (int)threadIdx.x; asm volatile("" : "+v"(t)); return t; }
#define LDS_WAIT() asm volatile("s_waitcnt lgkmcnt(0)" ::: "memory")

namespace pg8 {
#define PG8_LAS __attribute__((address_space(3)))
constexpr int BM = 256, BK = 64, HALF = 128, HTB = HALF * BK * 2, STAGE_BYTES = 8 * HTB, NXCD = 8, WGM = 8;
__host__ __device__ __forceinline__ int lds_byte(int r, int c) { const int st = (r >> 4) * 2 + (c >> 5), rr = r & 15, cc = c & 31, ob = rr * 64 + cc * 2; return st * 1024 + (ob ^ (((ob >> 9) & 1) << 5)); }
__host__ __device__ __forceinline__ void stage_rc(int b, int& R, int& C) { const int st = b / 1024, sb = b % 1024, swz = sb ^ (((sb >> 9) & 1) << 5); R = (st >> 1) * 16 + swz / 64; C = (st & 1) * 32 + (swz % 64) / 2; }
__host__ __device__ __forceinline__ int perm32(int rho) { const int n = rho >> 4, i = rho & 15; return 8 * (i >> 2) + 4 * n + (i & 3); }
struct Unit { int pm, pn; };
struct Gemm { const bf16_t* A; const bf16_t* Bt; int M, N, K; };
struct StaticOrder {
    int nM, nN, nwg, G, c;
    __host__ __device__ void init(int M, int N, int G_, int c_) { nM = M / BM; nN = N / BM; nwg = nM * nN; G = G_; c = c_; }
    __host__ __device__ bool next(int i, Unit& u) const {
        const long L = (long)i * G + c; if (L >= nwg) return false;
        int wgid = (int)L; { const int q = nwg / NXCD, r = nwg % NXCD, xcd = wgid % NXCD, off = wgid / NXCD; wgid = (xcd < r ? xcd * (q + 1) : r * (q + 1) + (xcd - r) * q) + off; }
        const int nig = WGM * nN, gid = wgid / nig, fm = gid * WGM, gsz = (nM - fm) < WGM ? (nM - fm) : WGM;
        u.pm = fm + ((wgid % nig) % gsz); u.pn = (wgid % nig) / gsz; return true;
    }
    __device__ __forceinline__ void a_ready(const Unit&) const {}
    __device__ __forceinline__ void done(const Unit&) const {}
};

typedef int i32x4 __attribute__((ext_vector_type(4)));
template <bool I8> struct AccT { typedef f32x4 type; };
template <> struct AccT<true> { typedef i32x4 type; };
template <class Epi, class Sched, bool ALIGN_EPI = false, bool SP2 = false, bool I8 = false>
__device__ __forceinline__ void gemm_phase(PG8_LAS unsigned char* lds, const Gemm g, const Sched& S, const Epi& E) {
    typedef typename AccT<I8>::type acc_t;
    const int tid = tid_opaque(), wid = __builtin_amdgcn_readfirstlane(tid >> 6), lane = tid & 63, wr = wid >> 2, wc = wid & 3, fr = lane & 15, fq = lane >> 4;
    const int rowb = I8 ? g.K : 2 * g.K, nt = rowb / (BK * 2);
    unsigned voffA[2], voffB[2];
#pragma unroll
    for (int i = 0; i < 2; ++i) { int R, C; stage_rc(tid * 16 + i * 8192, R, C); const int Rb = Epi::PERM ? ((R & ~31) + perm32(R & 31)) : R;
        voffA[i] = (unsigned)(R * rowb + C * 2); voffB[i] = (unsigned)(Rb * rowb + C * 2); }
    const size_t kstep = (size_t)(BK * 2);
    const size_t hstep = (size_t)HALF * rowb;
    const size_t tstep = 2 * hstep;
    const unsigned ldsw = (unsigned)wid * 1024u;
    const int aoff = lds_byte(wr * 64 + fr, fq * 8), boff = lds_byte(wc * 32 + fr, fq * 8);
#define PG8_SA(b, h) (((b) * 2 + (h)) * HTB)
#define PG8_SB(b, h) ((4 + (b) * 2 + (h)) * HTB)
#define PG8_STAGE(bufoff, gbase, voff) do { _Pragma("unroll") for (int _i = 0; _i < 2; ++_i) \
        __builtin_amdgcn_global_load_lds((const unsigned*)((const char*)(gbase) + (voff)[_i]), (PG8_LAS unsigned*)(lds + (bufoff) + ldsw + _i * 8192), 16, 0, 0); } while (0)
#define PG8_LDA(dst, b, h) do { _Pragma("unroll") for (int m = 0; m < 4; ++m) _Pragma("unroll") for (int k = 0; k < 2; ++k) dst[m][k] = *(const PG8_LAS bf16x8*)(lds + PG8_SA(b, h) + aoff + m * 2048 + k * 1024); } while (0)
#define PG8_LDB(dst, b, h) do { _Pragma("unroll") for (int n = 0; n < 2; ++n) _Pragma("unroll") for (int k = 0; k < 2; ++k) dst[n][k] = *(const PG8_LAS bf16x8*)(lds + PG8_SB(b, h) + boff + n * 2048 + k * 1024); } while (0)
#define PG8_MMA(ai, bj, At, Bt) do { __builtin_amdgcn_s_setprio(1); _Pragma("unroll") for (int m = 0; m < 4; ++m) _Pragma("unroll") for (int n = 0; n < 2; ++n) _Pragma("unroll") for (int k = 0; k < 2; ++k) \
        { if constexpr (I8) acc[ai][bj][m][n] = __builtin_amdgcn_mfma_i32_16x16x64_i8(__builtin_bit_cast(i32x4, Bt[n][k]), __builtin_bit_cast(i32x4, At[m][k]), acc[ai][bj][m][n], 0, 0, 0); \
          else acc[ai][bj][m][n] = __builtin_amdgcn_mfma_f32_16x16x32_bf16(Bt[n][k], At[m][k], acc[ai][bj][m][n], 0, 0, 0); } __builtin_amdgcn_s_setprio(0); } while (0)
#define PG8_WAIT_V(n) asm volatile("s_waitcnt vmcnt(" #n ")" ::: "memory")
#define PG8_WAIT_L(n) asm volatile("s_waitcnt lgkmcnt(" #n ")" ::: "memory")
#define PG8_BAR __builtin_amdgcn_s_barrier()
#define PG8_SCHED __builtin_amdgcn_sched_barrier(0)
    Unit cur, nxt; int ui = 0;
    if (!S.next(0, cur)) return;
    acc_t acc[2][2][4][2];
#pragma unroll
    for (int a = 0; a < 2; ++a)
#pragma unroll
        for (int b = 0; b < 2; ++b)
#pragma unroll
            for (int m = 0; m < 4; ++m)
#pragma unroll
                for (int n = 0; n < 2; ++n) acc[a][b][m][n] = acc_t{};
    bf16x8 At[4][2], B0[2][2], B1[2][2];
    const char* cA = (const char*)g.A + (size_t)cur.pm * tstep; const char* cB = (const char*)g.Bt + (size_t)cur.pn * tstep;
    S.a_ready(cur);
    if constexpr (SP2) {
        PG8_STAGE(PG8_SB(0, 0), cB, voffB); PG8_STAGE(PG8_SB(0, 1), cB + hstep, voffB); PG8_STAGE(PG8_SA(0, 0), cA, voffA); PG8_STAGE(PG8_SA(0, 1), cA + hstep, voffA);
        if (wr == 1) PG8_BAR;
        PG8_WAIT_V(2); PG8_BAR;
        PG8_STAGE(PG8_SB(1, 0), cB + kstep, voffB); PG8_STAGE(PG8_SA(1, 0), cA + kstep, voffA); PG8_STAGE(PG8_SB(1, 1), cB + hstep + kstep, voffB);
        PG8_WAIT_V(6); PG8_BAR;
    } else {
        PG8_STAGE(PG8_SB(0, 0), cB, voffB); PG8_STAGE(PG8_SA(0, 0), cA, voffA); PG8_STAGE(PG8_SB(0, 1), cB + hstep, voffB); PG8_STAGE(PG8_SA(0, 1), cA + hstep, voffA);
        if (wr == 1) PG8_BAR;
        PG8_WAIT_V(4); PG8_BAR;
        PG8_STAGE(PG8_SB(1, 0), cB + kstep, voffB); PG8_STAGE(PG8_SA(1, 0), cA + kstep, voffA); PG8_STAGE(PG8_SB(1, 1), cB + hstep + kstep, voffB);
        PG8_WAIT_V(6); PG8_BAR;
    }
    for (;;) {
        const bool has_next = S.next(ui + 1, nxt);
        const char* nA = has_next ? (const char*)g.A + (size_t)nxt.pm * tstep : cA; const char* nB = has_next ? (const char*)g.Bt + (size_t)nxt.pn * tstep : cB;
        for (int t = 0; t < nt; t += 2) {
            const bool last = (t == nt - 2);
            const char* a1 = cA + (size_t)(t + 1) * kstep;
            const char* a2 = last ? nA : cA + (size_t)(t + 2) * kstep; const char* b2 = last ? nB : cB + (size_t)(t + 2) * kstep;
            const char* a3 = a2 + kstep; const char* b3 = b2 + kstep;
            if (last && has_next) S.a_ready(nxt);
            if constexpr (SP2) {
            PG8_LDB(B0, 0, 0); PG8_LDB(B1, 0, 1); PG8_SCHED; PG8_LDA(At, 0, 0); PG8_STAGE(PG8_SA(1, 1), a1 + hstep, voffA);
            PG8_WAIT_V(8); PG8_WAIT_L(0); PG8_BAR; PG8_MMA(0, 0, At, B0); PG8_MMA(0, 1, At, B1); PG8_BAR; PG8_SCHED;
            PG8_LDA(At, 0, 1); PG8_STAGE(PG8_SB(0, 0), b2, voffB); PG8_STAGE(PG8_SB(0, 1), b2 + hstep, voffB); PG8_STAGE(PG8_SA(0, 0), a2, voffA);
            PG8_WAIT_V(8); PG8_WAIT_L(0); PG8_BAR; PG8_MMA(1, 0, At, B0); PG8_MMA(1, 1, At, B1); PG8_BAR; PG8_SCHED;
            PG8_LDB(B0, 1, 0); PG8_LDB(B1, 1, 1); PG8_SCHED; PG8_LDA(At, 1, 0); PG8_STAGE(PG8_SA(0, 1), a2 + hstep, voffA);
            PG8_WAIT_V(8); PG8_WAIT_L(0); PG8_BAR; PG8_MMA(0, 0, At, B0); PG8_MMA(0, 1, At, B1); PG8_BAR; PG8_SCHED;
            PG8_LDA(At, 1, 1); PG8_STAGE(PG8_SB(1, 0), b3, voffB); PG8_STAGE(PG8_SB(1, 1), b3 + hstep, voffB); PG8_STAGE(PG8_SA(1, 0), a3, voffA);
            PG8_WAIT_V(8); PG8_WAIT_L(0); PG8_BAR; PG8_MMA(1, 0, At, B0); PG8_MMA(1, 1, At, B1); PG8_BAR; PG8_SCHED;
            } else {
            PG8_LDB(B0, 0, 0); PG8_SCHED; PG8_LDA(At, 0, 0); PG8_STAGE(PG8_SA(1, 1), a1 + hstep, voffA);
            PG8_WAIT_L(8); PG8_BAR; PG8_WAIT_L(0); PG8_MMA(0, 0, At, B0); PG8_BAR; PG8_SCHED;
            PG8_LDB(B1, 0, 1); PG8_STAGE(PG8_SB(0, 0), b2, voffB);
            PG8_BAR; PG8_WAIT_L(0); PG8_MMA(0, 1, At, B1); PG8_BAR;
            PG8_LDA(At, 0, 1); PG8_STAGE(PG8_SA(0, 0), a2, voffA);
            PG8_BAR; PG8_WAIT_L(0); PG8_MMA(1, 0, At, B0); PG8_BAR; PG8_SCHED;
            PG8_STAGE(PG8_SB(0, 1), b2 + hstep, voffB);
            PG8_WAIT_V(6); PG8_BAR; PG8_MMA(1, 1, At, B1); PG8_BAR;
            PG8_LDB(B0, 1, 0); PG8_SCHED; PG8_LDA(At, 1, 0); PG8_STAGE(PG8_SA(0, 1), a2 + hstep, voffA);
            PG8_WAIT_L(8); PG8_BAR; PG8_WAIT_L(0); PG8_MMA(0, 0, At, B0); PG8_BAR; PG8_SCHED;
            PG8_LDB(B1, 1, 1); PG8_STAGE(PG8_SB(1, 0), b3, voffB);
            PG8_BAR; PG8_WAIT_L(0); PG8_MMA(0, 1, At, B1); PG8_BAR;
            PG8_LDA(At, 1, 1); PG8_STAGE(PG8_SA(1, 0), a3, voffA);
            PG8_BAR; PG8_WAIT_L(0); PG8_MMA(1, 0, At, B0); PG8_BAR; PG8_SCHED;
            PG8_STAGE(PG8_SB(1, 1), b3 + hstep, voffB);
            PG8_WAIT_V(6); PG8_BAR; PG8_MMA(1, 1, At, B1); PG8_BAR;
            }
        }
        if constexpr (ALIGN_EPI) { if (wr == 0) PG8_BAR; }
        E(acc, cur, wr, wc, fr, fq); S.done(cur);
        if (!has_next) break;
#pragma unroll
        for (int a = 0; a < 2; ++a)
#pragma unroll
            for (int b = 0; b < 2; ++b)
#pragma unroll
                for (int m = 0; m < 4; ++m)
#pragma unroll
                    for (int n = 0; n < 2; ++n) acc[a][b][m][n] = acc_t{};
        cur = nxt; cA = nA; cB = nB; ++ui;
        if constexpr (ALIGN_EPI) { if (wr == 1) PG8_BAR; }
    }
    PG8_WAIT_V(0);
    if constexpr (!ALIGN_EPI) { if (wr == 0) PG8_BAR; }
    PG8_BAR;
#undef PG8_SA
#undef PG8_SB
#undef PG8_STAGE
#undef PG8_LDA
#undef PG8_LDB
#undef PG8_MMA
#undef PG8_WAIT_V
#undef PG8_WAIT_L
#undef PG8_BAR
#undef PG8_SCHED
}

__device__ __forceinline__ float sigmoidf_fast(float x) { return __builtin_amdgcn_rcpf(1.f + __builtin_amdgcn_exp2f(-x * LOG2E)); }
struct EpiInProj {
    static constexpr bool PERM = true;
    bf16_t* base; const float* sxn  ; const float* wsc  ;
    const float* gq; const float* gk; PG8_LAS float* xch  ;
    __device__ __forceinline__ void operator()(const i32x4 (&acci)[2][2][4][2], const Unit& u, int wr, int wc, int fr, int fq) const {
        const int sec = u.pn >> 2; const float wsv = *wsc;
        bf16_t* sb = base + (size_t)sec * SEC_ELEMS;
        const float sc = (sec == 4) ? SCALE * LOG2E : 1.f;
        if (sec < 2) {
#pragma unroll
            for (int ai = 0; ai < 2; ++ai)
#pragma unroll
                for (int m = 0; m < 4; ++m) {
                    const int tk = u.pm * BM + ai * HALF + wr * 64 + m * 16 + fr;
                    const float rs = sxn[tk] * wsv;
#pragma unroll
                    for (int bj = 0; bj < 2; ++bj) {
                        const f32x4 v0 = __builtin_convertvector(acci[ai][bj][m][0], f32x4) * rs, v1 = __builtin_convertvector(acci[ai][bj][m][1], f32x4) * rs;
                        float ss = v0[0] * v0[0] + v0[1] * v0[1] + v0[2] * v0[2] + v0[3] * v0[3] + v1[0] * v1[0] + v1[1] * v1[1] + v1[2] * v1[2] + v1[3] * v1[3];
                        ss += sx_f(ss, 16); ss += sx_f(ss, 32);
                        if (fq == 0) xch[(((((wr * 2 + ai) * 4 + m) * 16 + fr) * 2 + bj) * 4) + wc] = ss;
                    }
                }
            asm volatile("s_waitcnt lgkmcnt(0)" ::: "memory");
            __builtin_amdgcn_s_barrier();
            const float* gp = (sec == 0 ? gq : gk) + wc * 32 + 8 * fq;
            const f32x4 g0 = *(const f32x4*)gp, g1 = *(const f32x4*)(gp + 4);
#pragma unroll
            for (int ai = 0; ai < 2; ++ai)
#pragma unroll
                for (int m = 0; m < 4; ++m) {
                    const int tk = u.pm * BM + ai * HALF + wr * 64 + m * 16 + fr, b = tk >> 12, s = tk & 4095;
                    const float rs = sxn[tk] * wsv;
#pragma unroll
                    for (int bj = 0; bj < 2; ++bj) {
                        const int hh = (u.pn & 3) * 2 + bj;
                        const f32x4 p4 = *(const PG8_LAS f32x4*)(xch + (((((wr * 2 + ai) * 4 + m) * 16 + fr) * 2 + bj) * 4));
                        const float r = rs / sqrtf(((p4[0] + p4[1]) + (p4[2] + p4[3])) * (1.f / 128.f) + EPS);
                        const f32x4 v0 = __builtin_convertvector(acci[ai][bj][m][0], f32x4) * r * g0, v1 = __builtin_convertvector(acci[ai][bj][m][1], f32x4) * r * g1;
                        u32x4 w; w.x = cvt_pk_bf16(v0[0], v0[1]); w.y = cvt_pk_bf16(v0[2], v0[3]); w.z = cvt_pk_bf16(v1[0], v1[1]); w.w = cvt_pk_bf16(v1[2], v1[3]);
                        *(u32x4*)(sb + ((size_t)((b * 8 + hh) * 4096 + s)) * 128 + wc * 32 + 8 * fq) = w;
                    }
                }
            return;
        }
#pragma unroll
        for (int ai = 0; ai < 2; ++ai)
#pragma unroll
            for (int m = 0; m < 4; ++m) {
                const int tk = u.pm * BM + ai * HALF + wr * 64 + m * 16 + fr, b = tk >> 12, s = tk & 4095;
                const float rs = sxn[tk] * wsv;
#pragma unroll
                for (int bj = 0; bj < 2; ++bj) {
                    const int hh = (u.pn & 3) * 2 + bj;
                    f32x4 v0 = __builtin_convertvector(acci[ai][bj][m][0], f32x4) * rs, v1 = __builtin_convertvector(acci[ai][bj][m][1], f32x4) * rs;
                    bf16_t* dst;
                    if (sec == 3) {
#pragma unroll
                        for (int i = 0; i < 4; ++i) { v0[i] = sigmoidf_fast(v0[i]); v1[i] = sigmoidf_fast(v1[i]); }
                        dst = sb + (size_t)tk * 1024 + hh * 128 + wc * 32 + 8 * fq;
                    } else {
                        v0 = v0 * sc; v1 = v1 * sc;
                        dst = sb + ((size_t)((b * 8 + hh) * 4096 + s)) * 128 + wc * 32 + 8 * fq;
                    }
                    u32x4 w; w.x = cvt_pk_bf16(v0[0], v0[1]); w.y = cvt_pk_bf16(v0[2], v0[3]); w.z = cvt_pk_bf16(v1[0], v1[1]); w.w = cvt_pk_bf16(v1[2], v1[3]);
                    *(u32x4*)dst = w;
                }
            }
    }
};
struct EpiOutProj {
    static constexpr bool PERM = true;
    const float* x; float* h; bf16_t* hb; float* ssq; float* amx;
    __device__ __forceinline__ void operator()(const f32x4 (&acc)[2][2][4][2], const Unit& u, int wr, int wc, int fr, int fq) const {
#pragma unroll
        for (int ai = 0; ai < 2; ++ai)
#pragma unroll
            for (int m = 0; m < 4; ++m) {
                const int tk = u.pm * BM + ai * HALF + wr * 64 + m * 16 + fr;
                float ss = 0.f, mx = 0.f;
#pragma unroll
                for (int bj = 0; bj < 2; ++bj) {
                    const size_t off = (size_t)tk * DM + u.pn * BM + bj * HALF + wc * 32 + 8 * fq;
                    const f32x4 x0 = *(const f32x4*)(x + off), x1 = *(const f32x4*)(x + off + 4);
                    const f32x4 v0 = acc[ai][bj][m][0] + x0, v1 = acc[ai][bj][m][1] + x1;
                    u32x4 w; w.x = cvt_pk_bf16(v0[0], v0[1]); w.y = cvt_pk_bf16(v0[2], v0[3]); w.z = cvt_pk_bf16(v1[0], v1[1]); w.w = cvt_pk_bf16(v1[2], v1[3]);
                    *(u32x4*)(hb + off) = w;
                    ss += v0[0] * v0[0] + v0[1] * v0[1] + v0[2] * v0[2] + v0[3] * v0[3] + v1[0] * v1[0] + v1[1] * v1[1] + v1[2] * v1[2] + v1[3] * v1[3];
                    mx = fmaxf(mx, fmaxf(fmaxf(fmaxf(fabsf(v0[0]), fabsf(v0[1])), fmaxf(fabsf(v0[2]), fabsf(v0[3]))), fmaxf(fmaxf(fabsf(v1[0]), fabsf(v1[1])), fmaxf(fabsf(v1[2]), fabsf(v1[3])))));
                }
                ss += sx_f(ss, 16); ss += sx_f(ss, 32);
                mx = fmaxf(mx, sx_f(mx, 16)); mx = fmaxf(mx, sx_f(mx, 32));
                if (fq == 0) { ssq[(size_t)tk * 32 + u.pn * 4 + wc] = ss; amx[(size_t)tk * 32 + u.pn * 4 + wc] = mx; }
            }
    }
};
struct EpiPeerQ {
    static constexpr bool PERM = true;
    const float* ssq; bf16_t* qp; float* rtab;
    __device__ __forceinline__ void operator()(const f32x4 (&acc)[2][2][4][2], const Unit& u, int wr, int wc, int fr, int fq) const {
#pragma unroll
        for (int ai = 0; ai < 2; ++ai)
#pragma unroll
            for (int m = 0; m < 4; ++m) {
                const int tk = u.pm * BM + ai * HALF + wr * 64 + m * 16 + fr;
                float tot = 0.f;
#pragma unroll
                for (int i = 0; i < 8; ++i) { const f32x4 s4 = *(const f32x4*)(ssq + (size_t)tk * 32 + 4 * i); tot += (s4[0] + s4[1]) + (s4[2] + s4[3]); }
                const float r = 1.0f / sqrtf(tot * (1.f / DM) + EPS);
                if (u.pn == 0 && wc == 0 && fq == 0) rtab[tk] = r;
#pragma unroll
                for (int bj = 0; bj < 2; ++bj) {
                    const size_t off = (size_t)tk * DM + u.pn * BM + bj * HALF + wc * 32 + 8 * fq;
                    const f32x4 v0 = acc[ai][bj][m][0] * r, v1 = acc[ai][bj][m][1] * r;
                    u32x4 w; w.x = cvt_pk_bf16(v0[0], v0[1]); w.y = cvt_pk_bf16(v0[2], v0[3]); w.z = cvt_pk_bf16(v1[0], v1[1]); w.w = cvt_pk_bf16(v1[2], v1[3]);
                    *(u32x4*)(qp + off) = w;
                }
            }
    }
};
}

namespace att {
constexpr int NW = 8, QBLK = 32, KVBLK = 64, QB = NW * QBLK, D = 128;
constexpr int SHM_V = KVBLK * D * 2, SHM_K = KVBLK * D * 2;
constexpr int OFF_WS = 2 * SHM_V + 2 * SHM_K, OFF_BIAS = OFF_WS + NW * 64 * 4, ATT_LDS = OFF_BIAS + SEQ * 4;
#define KSWZ(row, colB) ((row) * 256 + ((colB) ^ (((row) & 7) << 4)))
#define SBAR() __builtin_amdgcn_sched_barrier(0)
__device__ __forceinline__ int v_st(int k, int c) { const int kk = (k & ~0xC) | ((k & 4) << 1) | ((k & 8) >> 1); return ((kk >> 3) * 4 + (c >> 5)) * 512 + ((kk & 7) * 32 + (c & 31)) * 2; }
__device__ __forceinline__ int v_rd_base(int lane) { return ((lane & 3) << 3) | (((lane >> 2) & 3) << 6) | (((lane >> 4) & 1) << 5) | (((lane >> 5) & 1) << 8); }
constexpr int v_rd_off(int d0, int ks, int half) { return d0 * 512 + ks * 4096 + half * 2048; }
__device__ __forceinline__ int crow(int r, int hi) { return (r & 3) + 8 * (r >> 2) + 4 * hi; }
__device__ __forceinline__ bf16x8 load8(const bf16_t* p) { return *reinterpret_cast<const bf16x8*>(p); }
__device__ __forceinline__ void mask_tile(f32x16& p0, f32x16& p1, int dq) {
    const float NEG = -__builtin_inff();
#pragma unroll
    for (int r = 0; r < 16; ++r) {
        const int c = (r & 3) + 8 * (r >> 2);
        if (dq - c < 0) p0[r] = NEG;
        if (dq - c - 32 < 0) p1[r] = NEG;
    }
}
__device__ __forceinline__ void partialSM(f32x16& p0, f32x16& p1, float& m_reg, float& mn, float& alpha) {
    float pmax = p0[0];
#pragma unroll
    for (int r = 1; r < 16; ++r) pmax = fmaxf(pmax, p0[r]);
#pragma unroll
    for (int r = 0; r < 16; ++r) pmax = fmaxf(pmax, p1[r]);
    { auto rr = __builtin_amdgcn_permlane32_swap(__float_as_uint(pmax), __float_as_uint(pmax), false, false);
      pmax = fmaxf(__uint_as_float(rr[0]), __uint_as_float(rr[1])); }
    constexpr float C2 = LOG2E * SCALE; constexpr float THR = 8.f;
    if (__builtin_expect(__all((pmax - m_reg) * SCALE <= THR), 1)) { mn = m_reg; alpha = 1.f; }
    else { mn = fmaxf(m_reg, pmax); alpha = __builtin_amdgcn_exp2f((m_reg - mn) * C2); m_reg = mn; }
    const float mnL = -mn * C2;
#pragma unroll
    for (int r = 0; r < 16; ++r) p0[r] = fmaf(p0[r], C2, mnL);
#pragma unroll
    for (int r = 0; r < 16; ++r) p1[r] = fmaf(p1[r], C2, mnL);
#pragma unroll
    for (int r = 0; r < 16; ++r) p0[r] = __builtin_amdgcn_exp2f(p0[r]);
}
#define PK4(P, B_, OUT) do { unsigned a0 = cvt_pk_bf16(P[B_+0], P[B_+1]), a1 = cvt_pk_bf16(P[B_+2], P[B_+3]);                          \
        unsigned b0 = cvt_pk_bf16(P[B_+4], P[B_+5]), b1 = cvt_pk_bf16(P[B_+6], P[B_+7]);                                             \
        auto r0 = __builtin_amdgcn_permlane32_swap(a0, b0, false, false); auto r1 = __builtin_amdgcn_permlane32_swap(a1, b1, false, false); \
        u32x4 w = {r0[0], r1[0], r0[1], r1[1]}; OUT = *reinterpret_cast<bf16x8*>(&w); } while (0)
__device__ __forceinline__ void finishSM(f32x16& p0, f32x16& p1, float alpha, float& l_reg, bf16x8& pa0, bf16x8& pa1, bf16x8& pa2, bf16x8& pa3) {
#pragma unroll
    for (int r = 0; r < 16; ++r) p1[r] = __builtin_amdgcn_exp2f(p1[r]);
    float ps = 0;
#pragma unroll
    for (int r = 0; r < 16; ++r) ps += p0[r];
#pragma unroll
    for (int r = 0; r < 16; ++r) ps += p1[r];
    { auto rr = __builtin_amdgcn_permlane32_swap(__float_as_uint(ps), __float_as_uint(ps), false, false);
      ps = __uint_as_float(rr[0]) + __uint_as_float(rr[1]); }
    l_reg = l_reg * alpha + ps;
    PK4(p0, 0, pa0); PK4(p0, 8, pa1); PK4(p1, 0, pa2); PK4(p1, 8, pa3);
}
__device__ __forceinline__ void sb_group(f32x16& P, int g, float& gs) {
    float run = 0.f;
#pragma unroll
    for (int k = 3; k >= 0; --k) {
        const float z = P[4 * g + k];
        const float t = __builtin_amdgcn_exp2f(-fabsf(z));
        const float l = __builtin_amdgcn_logf(1.f + t);
        const float sp = fmaxf(z, 0.f) + l;
        P[4 * g + k] = (z - sp) - run;
        run += sp;
    }
    gs = run;
}
__device__ __forceinline__ void sb_part1(f32x16& p0, f32x16& p1, float& carry, float mlo) {
    float gs[8];
#pragma unroll
    for (int g = 0; g < 4; ++g) sb_group(p0, g, gs[g]);
#pragma unroll
    for (int g = 0; g < 4; ++g) sb_group(p1, g, gs[4 + g]);
    float run = carry;
#pragma unroll
    for (int G = 7; G >= 0; --G) {
        auto rr = __builtin_amdgcn_permlane32_swap(__float_as_uint(gs[G]), __float_as_uint(gs[G]), false, false);
        const float slo = __uint_as_float(rr[0]), shi = __uint_as_float(rr[1]);
        const float base = fmaf(mlo, shi, run);
        if (G >= 4) {
#pragma unroll
            for (int k = 0; k < 4; ++k) p1[4 * (G - 4) + k] -= base;
        } else {
#pragma unroll
            for (int k = 0; k < 4; ++k) p0[4 * G + k] -= base;
        }
        run += slo + shi;
    }
    carry = run;
#pragma unroll
    for (int r = 0; r < 16; ++r) p0[r] = __builtin_amdgcn_exp2f(p0[r]);
}
__device__ __forceinline__ void sb_part2(f32x16& p0, f32x16& p1, bf16x8& pa0, bf16x8& pa1, bf16x8& pa2, bf16x8& pa3) {
#pragma unroll
    for (int r = 0; r < 16; ++r) p1[r] = __builtin_amdgcn_exp2f(p1[r]);
    PK4(p0, 0, pa0); PK4(p0, 8, pa1); PK4(p1, 0, pa2); PK4(p1, 8, pa3);
}
#undef PK4
template <int KB, bool BIAS>
__device__ __forceinline__ void qkt(f32x16& p0, f32x16& p1, const char* K_lds, int r32, int hi, const bf16x8* qr, const float* bt) {
    if constexpr (BIAS) {
#pragma unroll
        for (int g = 0; g < 4; ++g) { const f32x4 a = *(const f32x4*)(bt + 8 * g), b = *(const f32x4*)(bt + 32 + 8 * g);
            p0[4 * g] = a[0]; p0[4 * g + 1] = a[1]; p0[4 * g + 2] = a[2]; p0[4 * g + 3] = a[3];
            p1[4 * g] = b[0]; p1[4 * g + 1] = b[1]; p1[4 * g + 2] = b[2]; p1[4 * g + 3] = b[3]; }
    } else { p0 = f32x16{}; p1 = f32x16{}; }
    const char* kb[4];
#pragma unroll
    for (int dd = 0; dd < 4; ++dd) kb[dd] = K_lds + KB * SHM_K + KSWZ(r32, (dd * 16 + hi * 8) * 2);
#pragma unroll
    for (int d0 = 0; d0 < 8; ++d0) { const char* a = kb[d0 & 3] + (d0 >> 2) * 128;
        bf16x8 b0 = *reinterpret_cast<const bf16x8*>(a);
        bf16x8 b1 = *reinterpret_cast<const bf16x8*>(a + 32 * 256);
        p0 = __builtin_amdgcn_mfma_f32_32x32x16_bf16(b0, qr[d0], p0, 0, 0, 0);
        p1 = __builtin_amdgcn_mfma_f32_32x32x16_bf16(b1, qr[d0], p1, 0, 0, 0); }
}
template <int VB>
__device__ __forceinline__ void pv_tile(f32x16* o, int vb0, bf16x8 pa0, bf16x8 pa1, bf16x8 pa2, bf16x8 pa3) {
#define TRRD(dst, off) asm volatile("ds_read_b64_tr_b16 %0, %1 offset:%2" : "=&v"(dst) : "v"(vb0), "i"(off) : "memory")
#define PV_D0(d0) do { { s16x4 l0, l1, h0, h1; constexpr int b_ = VB * SHM_V + v_rd_off(d0, 0, 0); \
        TRRD(l0, b_); TRRD(h0, b_ + 2048); TRRD(l1, b_ + 4096); TRRD(h1, b_ + 6144); \
        asm volatile("s_waitcnt lgkmcnt(0)" ::: "memory"); SBAR();   \
        o[d0] = __builtin_amdgcn_mfma_f32_32x32x16_bf16(pa0, (bf16x8){l0[0], l0[1], l0[2], l0[3], h0[0], h0[1], h0[2], h0[3]}, o[d0], 0, 0, 0);   \
        o[d0] = __builtin_amdgcn_mfma_f32_32x32x16_bf16(pa1, (bf16x8){l1[0], l1[1], l1[2], l1[3], h1[0], h1[1], h1[2], h1[3]}, o[d0], 0, 0, 0); }  \
      { s16x4 l2, l3, h2, h3; constexpr int b_ = VB * SHM_V + v_rd_off(d0, 0, 0); \
        TRRD(l2, b_ + 8192); TRRD(h2, b_ + 10240); TRRD(l3, b_ + 12288); TRRD(h3, b_ + 14336); \
        asm volatile("s_waitcnt lgkmcnt(0)" ::: "memory"); SBAR();   \
        o[d0] = __builtin_amdgcn_mfma_f32_32x32x16_bf16(pa2, (bf16x8){l2[0], l2[1], l2[2], l2[3], h2[0], h2[1], h2[2], h2[3]}, o[d0], 0, 0, 0);   \
        o[d0] = __builtin_amdgcn_mfma_f32_32x32x16_bf16(pa3, (bf16x8){l3[0], l3[1], l3[2], l3[3], h3[0], h3[1], h3[2], h3[3]}, o[d0], 0, 0, 0); } } while (0)
    PV_D0(0); PV_D0(1); PV_D0(2); PV_D0(3);
#undef PV_D0
#undef TRRD
}

struct UnitRef { const bf16_t* Q; const bf16_t* K; const bf16_t* V; int P0; };
struct Seam { bf16x8 qr[8]; bf16x8 st_v0, st_v1, st_k0, st_k1; };
#define ROW(p, k0, rr) ((p) + (size_t)((k0) + (rr)) * D + sc)
#define VMW() asm volatile("s_waitcnt vmcnt(0)" ::: "memory")
#define SLOAD_H(Kp, Vp, k0) do { S.st_v0 = load8(ROW(Vp, k0, sr)); S.st_v1 = load8(ROW(Vp, k0, 32 + sr));              \
                         S.st_k0 = load8(ROW(Kp, k0, sr)); S.st_k1 = load8(ROW(Kp, k0, 32 + sr)); } while (0)
#define SWRITE_HK(bf) do { *(bf16x8*)(K_lds + (bf) * SHM_K + kws) = S.st_k0; *(bf16x8*)(K_lds + (bf) * SHM_K + kws + 32 * 256) = S.st_k1; } while (0)
#define SWRITE_HV(bf) do { *(bf16x8*)(V_lds + (bf) * SHM_V + vst0) = S.st_v0; *(bf16x8*)(V_lds + (bf) * SHM_V + vst1) = S.st_v1; } while (0)
#define SWRITE_H(bf) do { SWRITE_HV(bf); SWRITE_HK(bf); } while (0)

template <bool SB>
__device__ __forceinline__ void attn_unit(const UnitRef& cur, unsigned char* wsu  , int bh, char* lds,
                                          int part  ) {
    const float* cvec; const float* gqk;
    { unsigned char* w_ = wsu; asm volatile("" : "+s"(w_)); cvec = (const float*)(w_ + WS_C) + (size_t)bh * SEQ; gqk = (const float*)(w_ + WS_GQK); }
    const int tid = tid_opaque(), wid = __builtin_amdgcn_readfirstlane(tid >> 6), lane = tid & 63, r32 = lane & 31, hi = lane >> 5;
    int jlo = 0;
    if constexpr (!SB) {
        const float gq = fmaxf(fabsf(gqk[lane]), fabsf(gqk[64 + lane])), gk = fmaxf(fabsf(gqk[128 + lane]), fabsf(gqk[192 + lane]));
        const float lmax = 11.3137085f * 1.02f * wave_max(gq) * wave_max(gk);
        const int ntf = (cur.P0 + QB) / KVBLK;
        const float cend = (lane < ntf) ? cvec[lane * KVBLK + KVBLK - 1] : 0.f;
        const bool skip = (lane < ntf) && (2.f * lmax + cvec[cur.P0] - cend < -104.f);
        jlo = __builtin_amdgcn_readfirstlane((int)__popcll(__ballot(skip)));
    }
    const int ntot = (cur.P0 + QB) / KVBLK - jlo;
    const int tb = (part == 2) ? (ntot >> 1) : 0, te = (part == 1) ? (ntot >> 1) : ntot;
    const int kshift = (jlo + tb) * KVBLK, P0r = cur.P0 - kshift;
    const int NT = te - tb;
#define KBASE(t) ((SB ? (NT - 1 - (t)) : (t)) * KVBLK)
    const int qlo = P0r + wid * QBLK, qm = qlo + r32 - 4 * hi - (SB ? 1 : 0);
    char* V_lds = lds; char* K_lds = lds + 2 * SHM_V;
    float* ws = (float*)(lds + OFF_WS) + wid * 64; float* li_l = ws, * al_l = ws + 32;
    float* bias = (float*)(lds + OFF_BIAS);
    const int sr = tid >> 4, sc = (tid & 15) * 8, vst0 = v_st(sr, sc), vst1 = v_st(32 + sr, sc), kws = KSWZ(sr, sc * 2);
    const int vb0 = (int)(uintptr_t)V_lds + v_rd_base(lane);
    const bf16_t* Kh = cur.K + (size_t)kshift * D; const bf16_t* Vh = cur.V + (size_t)kshift * D;
    Seam S;
    if constexpr (!SB) { const float cq0 = cvec[cur.P0]; const float* cv = cvec + kshift; for (int j = tid; j < NT * KVBLK; j += NTHREADS) bias[j] = (cq0 - cv[j]) * (1.f / SCALE); }
#pragma unroll
    for (int d0 = 0; d0 < 8; ++d0) S.qr[d0] = load8(cur.Q + (size_t)(wid * QBLK + r32) * D + d0 * 16 + hi * 8);
    SLOAD_H(Kh, Vh, KBASE(0)); VMW(); SWRITE_HK(0);
    __syncthreads();
    float m_reg = -1e30f, l_reg = 0; f32x16 o[4] = {};
    float carry = 0.f; const float mlo = hi ? 0.f : 1.f;
#define RESC(a) do { if (__any((a) < 1.f)) { if (hi == 0) al_l[r32] = (a); asm volatile("s_waitcnt lgkmcnt(0)" ::: "memory");              \
                     for (int d_ = 0; d_ < 4; ++d_) for (int r = 0; r < 16; ++r) o[d_][r] *= al_l[crow(r, hi)]; } } while (0)
#define MASKT(P0_, P1_, t) do { const int kb_ = KBASE(t); if (kb_ + KVBLK - 1 > qlo - (SB ? 1 : 0)) mask_tile(P0_, P1_, qm - kb_); } while (0)
#define BT(t) (bias + KBASE(t) + 4 * hi)
#define PART1(PX0, PX1, mnX, alX) do { if constexpr (SB) sb_part1(PX0, PX1, carry, mlo); else partialSM(PX0, PX1, m_reg, mnX, alX); } while (0)
#define PART2(PY0, PY1, alY) do { if constexpr (SB) sb_part2(PY0, PY1, pa0, pa1, pa2, pa3); else finishSM(PY0, PY1, alY, l_reg, pa0, pa1, pa2, pa3); } while (0)
    f32x16 pA0, pA1, pB0, pB1; float mnA = 0.f, mnB = 0.f, alA = 1.f, alB = 1.f; bf16x8 pa0, pa1, pa2, pa3;
    SWRITE_HV(0); SBAR();
    if (NT > 1) SLOAD_H(Kh, Vh, KBASE(1));
    SBAR(); qkt<0, !SB>(pA0, pA1, K_lds, r32, hi, S.qr, BT(0));
    MASKT(pA0, pA1, 0); PART1(pA0, pA1, mnA, alA);
    if (NT > 1) { VMW(); SWRITE_H(1); }
    __syncthreads();
#define HALF_STEP(PX0, PX1, mnX, alX, PY0, PY1, alY, t, KB, VB, SBUF) do {                                                    \
        SBAR(); qkt<KB, !SB>(PX0, PX1, K_lds, r32, hi, S.qr, BT(t));                                                          \
        PART2(PY0, PY1, alY); SBAR();                                                                                          \
        if ((t) + 1 < NT) { SLOAD_H(Kh, Vh, KBASE((t) + 1)); SBAR(); }                                                         \
        pv_tile<VB>(o, vb0, pa0, pa1, pa2, pa3); MASKT(PX0, PX1, (t)); PART1(PX0, PX1, mnX, alX);                              \
        __syncthreads();                                                                                                      \
        if ((t) + 1 < NT) { VMW(); SWRITE_H(SBUF); }                                                                           \
        if constexpr (!SB) RESC(alX);                                                                                          \
        __syncthreads(); } while (0)
    for (int t = 1; t + 1 < NT; t += 2) {
        HALF_STEP(pB0, pB1, mnB, alB, pA0, pA1, alA, t, 1, 0, 0);
        HALF_STEP(pA0, pA1, mnA, alA, pB0, pB1, alB, t + 1, 0, 1, 1);
    }
    const bool even = (NT & 1) == 0;
    if (even) { SBAR(); qkt<1, !SB>(pB0, pB1, K_lds, r32, hi, S.qr, BT(NT - 1)); SBAR(); }
    PART2(pA0, pA1, alA); SBAR();
    pv_tile<0>(o, vb0, pa0, pa1, pa2, pa3);
    if (even) { MASKT(pB0, pB1, NT - 1); PART1(pB0, pB1, mnB, alB); __syncthreads(); if constexpr (!SB) RESC(alB);
        PART2(pB0, pB1, alB); SBAR(); pv_tile<1>(o, vb0, pa0, pa1, pa2, pa3); }
    unsigned char* we_ = wsu; asm volatile("" : "+s"(we_));
    if (part != 0) {
        const int slot2 = ((((cur.P0 >> 8) - 8) & 7) * 16 + bh) * 2 + (part == 2 ? 1 : 0);
        float* po = (float*)(we_ + WS_PO) + (size_t)slot2 * 256 * 128; float* pml = (float*)(we_ + WS_PML) + (size_t)slot2 * 512;
        if (hi == 0) { pml[(wid * QBLK + r32) * 2] = m_reg; pml[(wid * QBLK + r32) * 2 + 1] = l_reg; }
#pragma unroll
        for (int r = 0; r < 16; ++r)
#pragma unroll
            for (int d0 = 0; d0 < 4; ++d0) po[(size_t)(wid * QBLK + crow(r, hi)) * D + d0 * 32 + r32] = o[d0][r];
        __syncthreads();
        return;
    }
    const bf16_t* gate = (const bf16_t*)(we_ + WS_SEC) + 3 * SEC_ELEMS + (size_t)(bh >> 3) * SEQ * 1024 + (bh & 7) * HD;
    bf16_t* outp = (bf16_t*)(we_ + WS_MIX) + (size_t)(bh >> 3) * SEQ * DM + (bh & 7) * HD;
    float rli[16];
    if constexpr (!SB) {
        if (hi == 0) li_l[r32] = l_reg; asm volatile("s_waitcnt lgkmcnt(0)" ::: "memory");
#pragma unroll
        for (int r = 0; r < 16; ++r) rli[r] = __builtin_amdgcn_rcpf(li_l[crow(r, hi)]);
    }
#pragma unroll
    for (int r = 0; r < 16; ++r) { const int orow = cur.P0 + wid * QBLK + crow(r, hi);
#pragma unroll
        for (int d0 = 0; d0 < 4; ++d0) {
            float v = o[d0][r];
            if constexpr (!SB) { const unsigned short gb = gate[(size_t)orow * 1024 + d0 * 32 + r32]; v = v * rli[r] * __builtin_bit_cast(float, (unsigned)gb << 16); }
            const float vn = sx_f(v, 1);
            if ((r32 & 1) == 0) *(unsigned*)(outp + (size_t)orow * DM + d0 * 32 + r32) = cvt_pk_bf16(v, vn); } }
    __syncthreads();
#undef RESC
#undef KBASE
#undef MASKT
#undef BT
#undef PART1
#undef PART2
#undef HALF_STEP
}

constexpr float SB_TH = 150.f;
__device__ __forceinline__ void sb_unit(const UnitRef& cur, bf16_t* outp, char* lds) {
    const int tid = tid_opaque(), wid = __builtin_amdgcn_readfirstlane(tid >> 6), lane = tid & 63, r32 = lane & 31, hi = lane >> 5;
    const int NT = (cur.P0 + QB) / KVBLK;
#define KBASE(t) ((NT - 1 - (t)) * KVBLK)
    const int qlo = cur.P0 + wid * QBLK, qm = qlo + r32 - 4 * hi - 1;
    char* V_lds = lds; char* K_lds = lds + 2 * SHM_V;
    volatile int* flags = (volatile int*)(lds + OFF_WS);
    const int sr = tid >> 4, sc = (tid & 15) * 8, vst0 = v_st(sr, sc), vst1 = v_st(32 + sr, sc), kws = KSWZ(sr, sc * 2);
    const int vb0 = (int)(uintptr_t)V_lds + v_rd_base(lane);
    const bf16_t* Kh = cur.K; const bf16_t* Vh = cur.V;
    Seam S;
#pragma unroll
    for (int d0 = 0; d0 < 8; ++d0) S.qr[d0] = load8(cur.Q + (size_t)(wid * QBLK + r32) * D + d0 * 16 + hi * 8);
    SLOAD_H(Kh, Vh, KBASE(0)); VMW(); SWRITE_H(0);
    __syncthreads();
    f32x16 o[4] = {}; float carry = 0.f; const float mlo = hi ? 0.f : 1.f;
    bool wdone = false;
#define SB_STEP(tt, BUF) {                                                                                                 \
        const int kb_ = KBASE(tt);                                                                                           \
        if ((tt) + 1 < NT) SLOAD_H(Kh, Vh, KBASE((tt) + 1));                                                                 \
        SBAR();                                                                                                              \
        if (!wdone && kb_ <= qlo + QBLK - 2) {                                                                               \
            f32x16 p0, p1; bf16x8 pa0, pa1, pa2, pa3;                                                                        \
            qkt<BUF, false>(p0, p1, K_lds, r32, hi, S.qr, nullptr);                                                          \
            if (kb_ + KVBLK - 1 > qlo - 1) mask_tile(p0, p1, qm - kb_);                                                      \
            sb_part1(p0, p1, carry, mlo); sb_part2(p0, p1, pa0, pa1, pa2, pa3); SBAR();                                      \
            pv_tile<BUF>(o, vb0, pa0, pa1, pa2, pa3);                                                                        \
            wdone = __all(carry >= SB_TH);                                                                                   \
        }                                                                                                                    \
        if ((tt) + 1 < NT) { VMW(); SWRITE_H((BUF) ^ 1); }                                                                   \
        if (lane == 0) flags[((tt) & 1) * 8 + wid] = wdone ? 1 : 0;                                                          \
        __syncthreads();                                                                                                     \
        { int alld = 1;                                                                                                      \
          _Pragma("unroll") for (int w_ = 0; w_ < 8; ++w_) alld &= flags[((tt) & 1) * 8 + w_];                                \
          if (alld) break; } }
    for (int t = 0; t < NT; t += 2) {
        SB_STEP(t, 0)
        SB_STEP(t + 1, 1)
    }
#undef SB_STEP
#pragma unroll
    for (int r = 0; r < 16; ++r) { const int orow = cur.P0 + wid * QBLK + crow(r, hi);
#pragma unroll
        for (int d0 = 0; d0 < 4; ++d0) {
            const float v = o[d0][r];
            const float vn = sx_f(v, 1);
            if ((r32 & 1) == 0) *(unsigned*)(outp + (size_t)orow * DM + d0 * 32 + r32) = cvt_pk_bf16(v, vn); } }
    __syncthreads();
#undef KBASE
}
#undef ROW
#undef VMW
#undef SLOAD_H
#undef SWRITE_HK
#undef SWRITE_HV
#undef SWRITE_H
}

#define XB_TMO      128
#define XB_XCNT(j)  (256  + 64 * (j))
#define XB_XSUB(j)  (1280 + 64 * (j))
#define XB_XGEN(j)  (2304 + 64 * (j))
#define XB_TOP      3328
#define XB_TOPGEN   3392
#define XCD_BAR_WORDS 3456
#define XB_SPIN_CAP (1u << 20)
__device__ __forceinline__ unsigned xb_ld(unsigned* p)              { return __hip_atomic_load(p, __ATOMIC_RELAXED, __HIP_MEMORY_SCOPE_AGENT); }
__device__ __forceinline__ unsigned xb_add(unsigned* p, unsigned v) { return __hip_atomic_fetch_add(p, v, __ATOMIC_RELAXED, __HIP_MEMORY_SCOPE_AGENT); }
__device__ __forceinline__ unsigned xb_xcc_id() { return (unsigned)__builtin_amdgcn_s_getreg((3 << 11) | 20) & 0xFu; }
#define XB_SPIN(cond, bar) do { unsigned _sp = 0; while (cond) { __builtin_amdgcn_s_sleep(1); \
    if ((++_sp & 255u) == 0u) { if (xb_ld(&(bar)[XB_TMO])) break; if (_sp > XB_SPIN_CAP) { atomicAdd(&(bar)[XB_TMO], 1u); break; } } } } while (0)
struct XcdBarrier { unsigned* bar; unsigned x; volatile LAS unsigned* st; };
__device__ __forceinline__ XcdBarrier xcd_barrier_post(unsigned* bar, volatile LAS unsigned* st) {
    XcdBarrier b; b.bar = bar; b.x = xb_xcc_id(); b.st = st;
    if (threadIdx.x == 0) (void)xb_add(&bar[XB_XCNT(b.x)], 1u);
    return b;
}
__device__ __forceinline__ void xcd_barrier_complete(unsigned* bar, unsigned x, unsigned& nloc, unsigned& nx) {
    const unsigned G = gridDim.x * gridDim.y * gridDim.z;
    unsigned sum, cnt, mine, sp = 0u;
    for (;;) {
        sum = 0u; cnt = 0u; mine = 0u;
#pragma unroll
        for (unsigned j = 0; j < 16; ++j) { const unsigned c = xb_ld(&bar[XB_XCNT(j)]); sum += c; cnt += (c > 0u) ? 1u : 0u; mine = (j == x) ? c : mine; }
        if (sum == G) break;
        __builtin_amdgcn_s_sleep(1);
        if ((++sp & 255u) == 0u) { if (xb_ld(&bar[XB_TMO])) break; if (sp > XB_SPIN_CAP) { atomicAdd(&bar[XB_TMO], 1u); break; } }
    }
    nloc = mine > 0u ? mine : 1u; nx = cnt > 0u ? cnt : 1u;
}
__device__ __forceinline__ void xcd_barrier(const XcdBarrier& b) {
    asm volatile("s_waitcnt vmcnt(0)" ::: "memory");
    __syncthreads();
    if (threadIdx.x == 0) {
        unsigned* bar = b.bar;
        __builtin_amdgcn_s_waitcnt(0);
        unsigned nloc = b.st[0], nx = b.st[1];
        if (nloc == 0u) { xcd_barrier_complete(bar, b.x, nloc, nx); b.st[0] = nloc; b.st[1] = nx; }
        const unsigned old = xb_add(&bar[XB_XSUB(b.x)], 1u);
        const unsigned gen = old / nloc;
        if (old + 1u == (gen + 1u) * nloc) {
            __builtin_amdgcn_fence(__ATOMIC_RELEASE, "agent");
            asm volatile("s_waitcnt vmcnt(0)" ::: "memory");
            const unsigned og = xb_add(&bar[XB_TOP], 1u);
            const unsigned tg = og / nx;
            if (og + 1u == (tg + 1u) * nx) xb_add(&bar[XB_TOPGEN], 1u);
            else XB_SPIN(xb_ld(&bar[XB_TOPGEN]) == tg, bar);
            __builtin_amdgcn_fence(__ATOMIC_ACQUIRE, "agent");
            xb_add(&bar[XB_XGEN(b.x)], 1u);
            asm volatile("s_waitcnt vmcnt(0)" ::: "memory");
        } else {
            XB_SPIN(xb_ld(&bar[XB_XGEN(b.x)]) == gen, bar);
            __builtin_amdgcn_fence(__ATOMIC_ACQUIRE, "agent");
            asm volatile("s_waitcnt vmcnt(0)" ::: "memory");
        }
    }
    __syncthreads();
}

struct Args { const float* in[12]; float* out; unsigned char* ws; int ph_lo, ph_hi; };

__device__ __forceinline__ void p0_transpose_item(const float* W, int ldw, int K, bf16_t* WT, int nblk, LAS float* scr, int item, int lane, const float* gk) {
    const int kb = item / nblk, nb = item % nblk, k0 = 64 * kb, n0 = 32 * nb;
    { const int rr = lane >> 3, c4 = lane & 7; f32x4 v[8];
#pragma unroll
      for (int i = 0; i < 8; ++i) v[i] = *(const f32x4*)(W + (size_t)(k0 + rr + 8 * i) * ldw + n0 + 4 * c4);
#pragma unroll
      for (int i = 0; i < 8; ++i) { const int kk = rr + 8 * i; const float gm = gk ? gk[k0 + kk] : 1.f;
          scr[kk * 33 + 4 * c4] = v[i][0] * gm; scr[kk * 33 + 4 * c4 + 1] = v[i][1] * gm; scr[kk * 33 + 4 * c4 + 2] = v[i][2] * gm; scr[kk * 33 + 4 * c4 + 3] = v[i][3] * gm; } }
    LDS_WAIT(); asm volatile("" ::: "memory");
    const int c = lane & 7;
#pragma unroll
    for (int j = 0; j < 4; ++j) { const int n = (lane >> 3) + 8 * j; const LAS float* s = scr + (8 * c) * 33 + n;
        u32x4 o; o.x = cvt_pk_bf16(s[0 * 33], s[1 * 33]); o.y = cvt_pk_bf16(s[2 * 33], s[3 * 33]); o.z = cvt_pk_bf16(s[4 * 33], s[5 * 33]); o.w = cvt_pk_bf16(s[6 * 33], s[7 * 33]);
        *(u32x4*)(WT + (size_t)(n0 + n) * K + k0 + 8 * c) = o; }
    LDS_WAIT(); asm volatile("" ::: "memory");
}

__device__ __forceinline__ int pack_i8(float a, float b, float c, float d) {
    const int ia = (int)__builtin_rintf(a), ib = (int)__builtin_rintf(b), ic = (int)__builtin_rintf(c), id = (int)__builtin_rintf(d);
    return (int)(((unsigned)ia & 0xffu) | (((unsigned)ib & 0xffu) << 8) | (((unsigned)ic & 0xffu) << 16) | ((unsigned)id << 24));
}
__device__ __forceinline__ void convert_tables(const Args& a, int r0, int r1, int worker, int nworkers) {
    const int lane = tid_opaque() & 63;
    unsigned char* ws = a.ws; const float* g_ffn = a.in[7]; const float* pu = a.in[10]; const float* pv = a.in[11];
    float* suv = (float*)(ws + WS_SUV);
    for (int r = r0 + worker; r < r1; r += nworkers) {
        const bool isv = r >= NEXP; const int e = isv ? r - NEXP : r;
        const f32x4* srcp = (const f32x4*)((isv ? pv : pu) + (size_t)e * DM);
        f32x4 v[8]; float amax = 0.f;
#pragma unroll
        for (int j = 0; j < 8; ++j) { v[j] = srcp[lane + 64 * j];
            if (!isv) { const f32x4 g4 = *(const f32x4*)(g_ffn + 4 * (lane + 64 * j)); v[j] = v[j] * g4; }
            amax = fmaxf(amax, fmaxf(fmaxf(fabsf(v[j][0]), fabsf(v[j][1])), fmaxf(fabsf(v[j][2]), fabsf(v[j][3])))); }
        amax = wave_max(amax);
        const float sc = amax > 0.f ? 127.f / amax : 1.f;
        unsigned char* dst = ws + (isv ? WS_V8 : WS_U8) + (size_t)e * 128;
#pragma unroll
        for (int j = 0; j < 8; ++j) { const int p = pack_i8(v[j][0] * sc, v[j][1] * sc, v[j][2] * sc, v[j][3] * sc);
            const int col = 4 * (lane + 64 * j);
            *(unsigned*)(dst + (size_t)(col >> 7) * ((size_t)NEXP * 128) + (col & 127)) = (unsigned)p; }
        if (lane == 0) suv[r] = 1.f / sc;
    }
}
constexpr int TAB_SPLIT = NEXP;

__device__ __forceinline__ void p0_transpose_item_i8(const float* W, int ldw, int K, unsigned char* WT, int nblk, LAS float* scr, int item, int lane, float q8) {
    const int kb = item / nblk, nb = item % nblk, k0 = 64 * kb, n0 = 32 * nb;
    { const int rr = lane >> 3, c4 = lane & 7; f32x4 v[8];
#pragma unroll
      for (int i = 0; i < 8; ++i) v[i] = *(const f32x4*)(W + (size_t)(k0 + rr + 8 * i) * ldw + n0 + 4 * c4);
#pragma unroll
      for (int i = 0; i < 8; ++i) { const int kk = rr + 8 * i;
          scr[kk * 33 + 4 * c4] = v[i][0] * q8; scr[kk * 33 + 4 * c4 + 1] = v[i][1] * q8; scr[kk * 33 + 4 * c4 + 2] = v[i][2] * q8; scr[kk * 33 + 4 * c4 + 3] = v[i][3] * q8; } }
    LDS_WAIT(); asm volatile("" ::: "memory");
    const int c = lane & 7;
#pragma unroll
    for (int j = 0; j < 4; ++j) { const int n = (lane >> 3) + 8 * j; const LAS float* s = scr + (8 * c) * 33 + n;
        u32x2 o; o.x = (unsigned)pack_i8(s[0 * 33], s[1 * 33], s[2 * 33], s[3 * 33]); o.y = (unsigned)pack_i8(s[4 * 33], s[5 * 33], s[6 * 33], s[7 * 33]);
        *(u32x2*)(WT + (size_t)(n0 + n) * K + k0 + 8 * c) = o; }
    LDS_WAIT(); asm volatile("" ::: "memory");
}
__device__ __forceinline__ float log_sigmoid_f(float x) { return fminf(x, 0.f) - log1pf(expf(-fabsf(x))); }

__device__ __forceinline__ void phase0(const Args& a, unsigned char* lds_g) {
    LAS unsigned char* lds = (LAS unsigned char*)lds_g;
    const int tid = tid_opaque(), lane = tid & 63, wave = __builtin_amdgcn_readfirstlane(tid >> 6);
    const int gw = blockIdx.x * NWAVES + wave, NGW = gridDim.x * NWAVES;
    const int gt = blockIdx.x * NTHREADS + tid, NGT = gridDim.x * NTHREADS;
    unsigned char* ws = a.ws;
    const float* x = a.in[0]; const float* g_attn = a.in[1]; const float* w_in = a.in[2]; const float* b_forget = a.in[3];
    const float* w_out = a.in[6]; const float* g_ffn = a.in[7]; const float* w_pq = a.in[8]; const float* sk = a.in[9]; const float* pu = a.in[10]; const float* pv = a.in[11];
    { float m = 0.f; const f32x4* wp = (const f32x4*)w_in;
      for (size_t i = gt; i < (size_t)DM * DIN / 4; i += NGT) { const f32x4 v = wp[i]; m = fmaxf(m, fmaxf(fmaxf(fabsf(v[0]), fabsf(v[1])), fmaxf(fabsf(v[2]), fabsf(v[3])))); }
      m = wave_max(m);
      if (lane == 0) __hip_atomic_fetch_max((unsigned*)(ws + WS_CTL) + CW_WMAX, __float_as_uint(m), __ATOMIC_RELAXED, __HIP_MEMORY_SCOPE_AGENT); }
    LAS float* wf = (LAS float*)(lds + 67584);
    for (int k = tid; k < DM; k += NTHREADS) { const f32x4 a0 = *(const f32x4*)(w_in + (size_t)k * DIN + NPROJ), a1 = *(const f32x4*)(w_in + (size_t)k * DIN + NPROJ + 4);
        *(LAS f32x4*)(wf + k * 8) = a0; *(LAS f32x4*)(wf + k * 8 + 4) = a1; }
    __syncthreads();
    for (int row = gw; row < T; row += NGW) {
        const f32x4* xr = (const f32x4*)(x + (size_t)row * DM);
        f32x4 v[8]; float ss = 0.f;
#pragma unroll
        for (int j = 0; j < 8; ++j) { v[j] = xr[lane + 64 * j]; ss += v[j][0] * v[j][0] + v[j][1] * v[j][1] + v[j][2] * v[j][2] + v[j][3] * v[j][3]; }
        const float r = 1.0f / sqrtf(wave_sum(ss) * (1.f / DM) + EPS);
        float f[8] = {0.f, 0.f, 0.f, 0.f, 0.f, 0.f, 0.f, 0.f};
        float xmax = 0.f;
#pragma unroll
        for (int j = 0; j < 8; ++j) { const f32x4 g4 = *(const f32x4*)(g_attn + 4 * (lane + 64 * j)); v[j][0] *= r * g4[0]; v[j][1] *= r * g4[1]; v[j][2] *= r * g4[2]; v[j][3] *= r * g4[3];
            xmax = fmaxf(xmax, fmaxf(fmaxf(fabsf(v[j][0]), fabsf(v[j][1])), fmaxf(fabsf(v[j][2]), fabsf(v[j][3])))); }
        xmax = wave_max(xmax);
        const float xq = xmax > 0.f ? 127.f / xmax : 1.f;
        if (lane == 0) ((float*)(ws + WS_SXN))[row] = xmax * (1.f / 127.f);
        unsigned* o8 = (unsigned*)(ws + WS_XN + (size_t)row * DM);
#pragma unroll
        for (int j = 0; j < 8; ++j) {
            const int e = 4 * (lane + 64 * j);
            const f32x4 xn = v[j];
            o8[lane + 64 * j] = (unsigned)pack_i8(xn[0] * xq, xn[1] * xq, xn[2] * xq, xn[3] * xq);
#pragma unroll
            for (int q = 0; q < 4; ++q) { const f32x4 w0 = *(LAS f32x4*)(wf + (e + q) * 8), w1 = *(LAS f32x4*)(wf + (e + q) * 8 + 4);
                f[0] += xn[q] * w0[0]; f[1] += xn[q] * w0[1]; f[2] += xn[q] * w0[2]; f[3] += xn[q] * w0[3];
                f[4] += xn[q] * w1[0]; f[5] += xn[q] * w1[1]; f[6] += xn[q] * w1[2]; f[7] += xn[q] * w1[3]; }
            __builtin_amdgcn_sched_barrier(0);
        }
#pragma unroll
        for (int hh = 0; hh < 8; ++hh) f[hh] = wave_sum(f[hh]);
        if (lane < 8) { float fl = f[0];
#pragma unroll
            for (int hh = 1; hh < 8; ++hh) fl = (lane == hh) ? f[hh] : fl;
            const int b = row >> 12, s = row & 4095;
            ((float*)(ws + WS_LOGF))[(size_t)(b * 8 + lane) * SEQ + s] = log_sigmoid_f(fl + b_forget[lane]); }
    }
    LAS float* scr = (LAS float*)(lds + wave * 8448);
    constexpr int I_IN = (DM / 64) * (NPROJ / 32), I_O = (DM / 64) * (DM / 32);
    for (int it = gw; it < 2 * I_O; it += NGW) {
        int r = it;
        if (r < I_O) { p0_transpose_item(w_out, DM, DM, (bf16_t*)(ws + WS_WOUT), DM / 32, scr, r, lane, nullptr); continue; } r -= I_O;
        p0_transpose_item(w_pq, DM, DM, (bf16_t*)(ws + WS_WPQ), DM / 32, scr, r, lane, g_ffn);
    }
    for (int i = gt; i < 8 * 2 * 128 * 128 / 8; i += NGT) { const f32x4 a0 = *(const f32x4*)(sk + (size_t)i * 8), a1 = *(const f32x4*)(sk + (size_t)i * 8 + 4);
        u32x4 w; w.x = cvt_pk_bf16(a0[0], a0[1]); w.y = cvt_pk_bf16(a0[2], a0[3]); w.z = cvt_pk_bf16(a1[0], a1[1]); w.w = cvt_pk_bf16(a1[2], a1[3]);
        *(u32x4*)(ws + WS_SK + (size_t)i * 16) = w; }
    if (gt < 256) ((float*)(ws + WS_GQK))[gt] = gt < 128 ? a.in[4][gt] : a.in[5][gt - 128];
    convert_tables(a, 0, TAB_SPLIT, gw, NGW);
    { XcdBarrier xb_; xb_.bar = (unsigned*)(ws + WS_CTL) + CW_BAR; xb_.x = xb_xcc_id(); xb_.st = (volatile LAS unsigned*)(lds + MISC_OFF) + 8; xcd_barrier(xb_); }
    const float wmax = __uint_as_float(__hip_atomic_load((unsigned*)(ws + WS_CTL) + CW_WMAX, __ATOMIC_RELAXED, __HIP_MEMORY_SCOPE_AGENT));
    if (gt == 0) *(float*)(ws + WS_WSC) = wmax * (1.f / 127.f);
    const float q8 = wmax > 0.f ? 127.f / wmax : 1.f;
    for (int it = gw; it < I_IN; it += NGW) p0_transpose_item_i8(w_in, DIN, DM, ws + WS_WIN, NPROJ / 32, scr, it, lane, q8);
}

__device__ __forceinline__ void cumsum_rows(const Args& a) {
    const int tid = tid_opaque(), lane = tid & 63, wave = tid >> 6;
    if (blockIdx.x >= 16 || wave != 0) return;
    const float* src = (const float*)(a.ws + WS_LOGF) + (size_t)blockIdx.x * SEQ + lane * 64;
    float* dst = (float*)(a.ws + WS_C) + (size_t)blockIdx.x * SEQ + lane * 64;
    f32x4 v[16]; float run = 0.f;
#pragma unroll
    for (int i = 0; i < 16; ++i) { v[i] = *(const f32x4*)(src + 4 * i);
#pragma unroll
        for (int q = 0; q < 4; ++q) { run += v[i][q]; v[i][q] = run; } }
    float incl = run;
#pragma unroll
    for (int o = 1; o < 64; o <<= 1) { const float t = shup_f(incl, o); if (lane >= o) incl += t; }
    const float off = incl - run;
#pragma unroll
    for (int i = 0; i < 16; ++i) { f32x4 w = v[i]; w[0] += off; w[1] += off; w[2] += off; w[3] += off; *(f32x4*)(dst + 4 * i) = w; }
}

__device__ __forceinline__ void phase_qknorm(const Args& a) {
    const int tid = tid_opaque(), lane = tid & 63, wave = tid >> 6;
    const int gw = blockIdx.x * NWAVES + wave, NGW = gridDim.x * NWAVES;
    const int sub = lane & 15, rw = lane >> 4;
    const float* gq = a.in[4]; const float* gk = a.in[5];
    constexpr int ROWS = NB * NHF * SEQ;
    for (int it = gw; it < 2 * ROWS / 4; it += NGW) {
        const int row = it * 4 + rw; const bool isk = row >= ROWS;
        bf16_t* p = (bf16_t*)(a.ws + WS_SEC) + (size_t)row * HD + sub * 8;
        const float* g = (isk ? gk : gq) + sub * 8;
        const u32x4 w = *(const u32x4*)p;
        float v[8] = {bf_lo(w.x), bf_hi(w.x), bf_lo(w.y), bf_hi(w.y), bf_lo(w.z), bf_hi(w.z), bf_lo(w.w), bf_hi(w.w)};
        float ss = 0.f;
#pragma unroll
        for (int i = 0; i < 8; ++i) ss += v[i] * v[i];
        ss += sx_f(ss, 1); ss += sx_f(ss, 2); ss += sx_f(ss, 4); ss += sx_f(ss, 8);
        const float r = 1.0f / sqrtf(ss * (1.f / HD) + EPS);
        const f32x4 g0 = *(const f32x4*)g, g1 = *(const f32x4*)(g + 4);
        u32x4 o; o.x = cvt_pk_bf16(v[0] * r * g0[0], v[1] * r * g0[1]); o.y = cvt_pk_bf16(v[2] * r * g0[2], v[3] * r * g0[3]);
        o.z = cvt_pk_bf16(v[4] * r * g1[0], v[5] * r * g1[1]); o.w = cvt_pk_bf16(v[6] * r * g1[2], v[7] * r * g1[3]);
        *(u32x4*)p = o;
    }
}

__device__ __forceinline__ void phase_attn(const Args& a, unsigned char* lds_g) {
    const int tid = tid_opaque();
    volatile int* s_item = (volatile int*)(lds_g + MISC_OFF);
    unsigned* ctr = (unsigned*)(a.ws + WS_CTL);
    for (;;) {
        __syncthreads();
        if (tid == 0) *s_item = (int)atomicAdd(ctr, 1u);
        __syncthreads();
        int it = *s_item, kind = -1, qb = 0, sub = 0;
#define CLS(K, Q, CNT) if (kind < 0) { if (it < (CNT)) { kind = (K); qb = (Q); sub = it; } else it -= (CNT); }
        CLS(2, 15, 32) CLS(1, 7, 16) CLS(2, 14, 32) CLS(2, 13, 32) CLS(1, 6, 16) CLS(2, 12, 32) CLS(2, 11, 32) CLS(1, 5, 16) CLS(2, 10, 32) CLS(2, 9, 32) CLS(1, 4, 16) CLS(2, 8, 32) CLS(1, 3, 16) CLS(1, 2, 16)
        if (kind < 0) { if (it < 256) { kind = 0; qb = 15 - (it >> 4); sub = it & 15; } else it -= 256; }
        CLS(1, 1, 16) CLS(1, 0, 16)
#undef CLS
        if (kind < 0) break;
        unsigned char* wsl = a.ws; asm volatile("" : "+s"(wsl));
        bf16_t* sec = (bf16_t*)(wsl + WS_SEC);
        const int bh = sub & 15, part = (kind == 2) ? 1 + (sub >> 4) : 0;
        const int b = bh >> 3, h = bh & 7;
        const size_t hoff = (size_t)bh * SEQ * HD;
        att::UnitRef u;
        u.P0 = qb * 256;
        if (kind == 0) {
            u.Q = sec + 4 * SEC_ELEMS + hoff + (size_t)u.P0 * HD; u.K = sec + 5 * SEC_ELEMS + hoff; u.V = sec + 6 * SEC_ELEMS + hoff;
            att::sb_unit(u, (bf16_t*)(wsl + WS_MIX) + (size_t)b * SEQ * DM + 1024 + h * HD, (char*)lds_g);
        } else {
            u.Q = sec + 0 * SEC_ELEMS + hoff + (size_t)u.P0 * HD; u.K = sec + 1 * SEC_ELEMS + hoff; u.V = sec + 2 * SEC_ELEMS + hoff;
            att::attn_unit<false>(u, wsl, bh, (char*)lds_g, part);
        }
    }
}
__device__ __forceinline__ void phase_attn_combine(const Args& a) {
    const int gt = blockIdx.x * NTHREADS + tid_opaque(), NGT = gridDim.x * NTHREADS;
    const float* po = (const float*)(a.ws + WS_PO); const float* pml = (const float*)(a.ws + WS_PML);
    const bf16_t* gate = (const bf16_t*)(a.ws + WS_SEC) + 3 * SEC_ELEMS; bf16_t* mix = (bf16_t*)(a.ws + WS_MIX);
    constexpr float C2 = LOG2E * SCALE;
    for (int item = gt; item < 128 * 256 * 16; item += NGT) {
        const int slot = item >> 12, row = (item >> 4) & 255, cg = item & 15;
        const int qb = 8 + (slot >> 4), bh = slot & 15, b = bh >> 3, h = bh & 7;
        const f32x2 ml1 = *(const f32x2*)(pml + (size_t)(slot * 2) * 512 + row * 2), ml2 = *(const f32x2*)(pml + (size_t)(slot * 2 + 1) * 512 + row * 2);
        const float M = fmaxf(ml1.x, ml2.x), a1 = __builtin_amdgcn_exp2f((ml1.x - M) * C2), a2 = __builtin_amdgcn_exp2f((ml2.x - M) * C2);
        const float inv = 1.f / (a1 * ml1.y + a2 * ml2.y);
        const float* p1 = po + (size_t)(slot * 2) * 32768 + row * 128 + cg * 8; const float* p2 = p1 + 32768;
        const f32x4 x0 = *(const f32x4*)p1, x1 = *(const f32x4*)(p1 + 4), y0 = *(const f32x4*)p2, y1 = *(const f32x4*)(p2 + 4);
        const size_t tok = (size_t)b * SEQ + qb * 256 + row;
        const u32x4 gw = *(const u32x4*)(gate + tok * 1024 + h * HD + cg * 8);
        const float w1 = a1 * inv, w2 = a2 * inv;
        u32x4 o;
        o.x = cvt_pk_bf16((w1 * x0[0] + w2 * y0[0]) * bf_lo(gw.x), (w1 * x0[1] + w2 * y0[1]) * bf_hi(gw.x));
        o.y = cvt_pk_bf16((w1 * x0[2] + w2 * y0[2]) * bf_lo(gw.y), (w1 * x0[3] + w2 * y0[3]) * bf_hi(gw.y));
        o.z = cvt_pk_bf16((w1 * x1[0] + w2 * y1[0]) * bf_lo(gw.z), (w1 * x1[1] + w2 * y1[1]) * bf_hi(gw.z));
        o.w = cvt_pk_bf16((w1 * x1[2] + w2 * y1[2]) * bf_lo(gw.w), (w1 * x1[3] + w2 * y1[3]) * bf_hi(gw.w));
        *(u32x4*)(mix + tok * DM + h * HD + cg * 8) = o;
    }
}

__device__ __forceinline__ unsigned f2ord(float f) { const unsigned u = __float_as_uint(f); return u ^ ((unsigned)((int)u >> 31) | 0x80000000u); }
__device__ __forceinline__ float ord2f(unsigned k) { const unsigned u = k ^ (~(unsigned)((int)k >> 31) | 0x80000000u); return __uint_as_float(u); }
#define INS16(L, X) do { unsigned x_ = (X); _Pragma("unroll") for (int i_ = 0; i_ < 16; ++i_) { const unsigned hi_ = max(L[i_], x_); x_ = min(L[i_], x_); L[i_] = hi_; } } while (0)
__device__ __forceinline__ void sort16_desc(unsigned (&a)[16]) {
#pragma unroll
    for (int k = 2; k <= 16; k <<= 1)
#pragma unroll
        for (int j = k >> 1; j > 0; j >>= 1)
#pragma unroll
            for (int i = 0; i < 16; ++i) { const int l = i ^ j; if (l > i) { const unsigned hi_ = max(a[i], a[l]), lo_ = min(a[i], a[l]); const bool desc = (i & k) == 0; a[i] = desc ? hi_ : lo_; a[l] = desc ? lo_ : hi_; } }
}
__device__ __forceinline__ void merge_top16(unsigned (&a)[16], const unsigned (&b)[16]) {
#pragma unroll
    for (int i = 0; i < 16; ++i) a[i] = max(a[i], b[15 - i]);
#pragma unroll
    for (int j = 8; j > 0; j >>= 1)
#pragma unroll
        for (int i = 0; i < 16; ++i) { const int l = i ^ j; if (l > i) { const unsigned hi_ = max(a[i], a[l]), lo_ = min(a[i], a[l]); a[i] = hi_; a[l] = lo_; } }
}
__device__ __forceinline__ void topk_half(const bf16_t* qp, const bf16_t* skb, int t0, int h, int c, int r32, int hi, unsigned (&L)[16]) {
    bf16x8 qf[8];
#pragma unroll
    for (int d0 = 0; d0 < 8; ++d0) qf[d0] = *(const bf16x8*)(qp + (size_t)(t0 + r32) * DM + h * 256 + c * 128 + d0 * 16 + hi * 8);
    const unsigned hi4 = 4u * (unsigned)hi;
#pragma unroll
    for (int kt = 0; kt < 4; ++kt) {
        f32x16 acc = f32x16{};
#pragma unroll
        for (int d0 = 0; d0 < 8; ++d0) { const bf16x8 kf = *(const bf16x8*)(skb + (size_t)((h * 2 + c) * 128 + kt * 32 + r32) * 128 + d0 * 16 + hi * 8);
            acc = __builtin_amdgcn_mfma_f32_32x32x16_bf16(kf, qf[d0], acc, 0, 0, 0); }
        __builtin_amdgcn_sched_barrier(0);
        unsigned G[16];
#pragma unroll
        for (int r = 0; r < 16; ++r) { const unsigned cst = (unsigned)(127 - (kt * 32 + (r & 3) + 8 * (r >> 2))); G[r] = (f2ord(acc[r]) & ~127u) | (cst - hi4); }
        sort16_desc(G);
        if (kt == 0) {
#pragma unroll
            for (int i = 0; i < 16; ++i) L[i] = G[i];
        } else merge_top16(L, G);
        __builtin_amdgcn_sched_barrier(0);
    }
    unsigned P[16];
#pragma unroll
    for (int i = 0; i < 16; ++i) { auto rr = __builtin_amdgcn_permlane32_swap(L[i], L[i], false, false); P[i] = hi ? rr[0] : rr[1]; }
    merge_top16(L, P);
}
__device__ __forceinline__ void phase_topk(const Args& a, unsigned char* lds_g) {
    LAS unsigned char* lds = (LAS unsigned char*)lds_g;
    const int tid = tid_opaque(), lane = tid & 63, wave = tid >> 6, r32 = lane & 31, hi = lane >> 5;
    const int gw = blockIdx.x * NWAVES + wave, NGW = gridDim.x * NWAVES;
    const bf16_t* skb = (const bf16_t*)(a.ws + WS_SK); const bf16_t* qp = (const bf16_t*)(a.ws + WS_QP);
    int* idx_o = (int*)(a.ws + WS_IDX); float* gw_o = (float*)(a.ws + WS_GW);
    for (int task = gw; task < (T / 32) * 8; task += NGW) {
        const int h = task & 7, t0 = (task >> 3) * 32;
        {
          const bf16_t* hbp = (const bf16_t*)(a.ws + WS_HB); const float* amx = (const float*)(a.ws + WS_AMX); unsigned char* xq = a.ws + WS_XQ;
          float am = 0.f;
          { const f32x4* ap = (const f32x4*)(amx + (size_t)(t0 + (lane & 31)) * 32);
#pragma unroll
            for (int i = 0; i < 8; ++i) { const f32x4 v = ap[i]; am = fmaxf(am, fmaxf(fmaxf(v[0], v[1]), fmaxf(v[2], v[3]))); } }
          if (h == 0 && lane < 32) ((float*)(a.ws + WS_SX))[t0 + lane] = ((const float*)(a.ws + WS_RT))[t0 + lane] * am * (1.f / 126.5f);
          const float qs = am > 0.f ? 126.5f / am : 1.f;
#pragma unroll 4
          for (int j = 0; j < 16; ++j) { const int ch = lane + 64 * j, tl = ch >> 5, tk = t0 + tl, col = h * 256 + (ch & 31) * 8;
              const u32x4 w = *(const u32x4*)(hbp + (size_t)tk * DM + col); const float r = sh_f(qs, tl);
              const int p0 = pack_i8(bf_lo(w.x) * r, bf_hi(w.x) * r, bf_lo(w.y) * r, bf_hi(w.y) * r), p1 = pack_i8(bf_lo(w.z) * r, bf_hi(w.z) * r, bf_lo(w.w) * r, bf_hi(w.w) * r);
              *(u32x2*)(xq + (size_t)tk * DM + col) = (u32x2){(unsigned)p0, (unsigned)p1}; } }
        unsigned L[2][16];
        topk_half(qp, skb, t0, h, 0, r32, hi, L[0]);
        __builtin_amdgcn_sched_barrier(0);
        topk_half(qp, skb, t0, h, 1, r32, hi, L[1]);
        __builtin_amdgcn_sched_barrier(0);
        float s1[16], s2[16]; int i1[16], i2[16];
#pragma unroll
        for (int i = 0; i < 16; ++i) { s1[i] = ord2f((L[0][i] & ~127u) | 64u); i1[i] = 127 - (int)(L[0][i] & 127u); s2[i] = ord2f((L[1][i] & ~127u) | 64u); i2[i] = 127 - (int)(L[1][i] & 127u); }
        unsigned CG[4][16];
#pragma unroll
        for (int i = 0; i < 64; ++i) CG[i >> 4][i & 15] = 0u;
        CG[0][0] = (f2ord(s1[0] + s2[0]) & ~255u) | 0u;
        CG[0][1] = (f2ord(s1[0] + s2[1]) & ~255u) | 1u;
        CG[0][2] = (f2ord(s1[0] + s2[2]) & ~255u) | 2u;
        CG[0][3] = (f2ord(s1[0] + s2[3]) & ~255u) | 3u;
        CG[0][4] = (f2ord(s1[0] + s2[4]) & ~255u) | 4u;
        CG[0][5] = (f2ord(s1[0] + s2[5]) & ~255u) | 5u;
        CG[0][6] = (f2ord(s1[0] + s2[6]) & ~255u) | 6u;
        CG[0][7] = (f2ord(s1[0] + s2[7]) & ~255u) | 7u;
        CG[0][8] = (f2ord(s1[0] + s2[8]) & ~255u) | 8u;
        CG[0][9] = (f2ord(s1[0] + s2[9]) & ~255u) | 9u;
        CG[0][10] = (f2ord(s1[0] + s2[10]) & ~255u) | 10u;
        CG[0][11] = (f2ord(s1[0] + s2[11]) & ~255u) | 11u;
        CG[0][12] = (f2ord(s1[0] + s2[12]) & ~255u) | 12u;
        CG[0][13] = (f2ord(s1[0] + s2[13]) & ~255u) | 13u;
        CG[0][14] = (f2ord(s1[0] + s2[14]) & ~255u) | 14u;
        CG[0][15] = (f2ord(s1[0] + s2[15]) & ~255u) | 15u;
        CG[1][0] = (f2ord(s1[1] + s2[0]) & ~255u) | 16u;
        CG[1][1] = (f2ord(s1[1] + s2[1]) & ~255u) | 17u;
        CG[1][2] = (f2ord(s1[1] + s2[2]) & ~255u) | 18u;
        CG[1][3] = (f2ord(s1[1] + s2[3]) & ~255u) | 19u;
        CG[1][4] = (f2ord(s1[1] + s2[4]) & ~255u) | 20u;
        CG[1][5] = (f2ord(s1[1] + s2[5]) & ~255u) | 21u;
        CG[1][6] = (f2ord(s1[1] + s2[6]) & ~255u) | 22u;
        CG[1][7] = (f2ord(s1[1] + s2[7]) & ~255u) | 23u;
        CG[1][8] = (f2ord(s1[2] + s2[0]) & ~255u) | 32u;
        CG[1][9] = (f2ord(s1[2] + s2[1]) & ~255u) | 33u;
        CG[1][10] = (f2ord(s1[2] + s2[2]) & ~255u) | 34u;
        CG[1][11] = (f2ord(s1[2] + s2[3]) & ~255u) | 35u;
        CG[1][12] = (f2ord(s1[2] + s2[4]) & ~255u) | 36u;
        CG[1][13] = (f2ord(s1[3] + s2[0]) & ~255u) | 48u;
        CG[1][14] = (f2ord(s1[3] + s2[1]) & ~255u) | 49u;
        CG[1][15] = (f2ord(s1[3] + s2[2]) & ~255u) | 50u;
        CG[2][0] = (f2ord(s1[3] + s2[3]) & ~255u) | 51u;
        CG[2][1] = (f2ord(s1[4] + s2[0]) & ~255u) | 64u;
        CG[2][2] = (f2ord(s1[4] + s2[1]) & ~255u) | 65u;
        CG[2][3] = (f2ord(s1[4] + s2[2]) & ~255u) | 66u;
        CG[2][4] = (f2ord(s1[5] + s2[0]) & ~255u) | 80u;
        CG[2][5] = (f2ord(s1[5] + s2[1]) & ~255u) | 81u;
        CG[2][6] = (f2ord(s1[6] + s2[0]) & ~255u) | 96u;
        CG[2][7] = (f2ord(s1[6] + s2[1]) & ~255u) | 97u;
        CG[2][8] = (f2ord(s1[7] + s2[0]) & ~255u) | 112u;
        CG[2][9] = (f2ord(s1[7] + s2[1]) & ~255u) | 113u;
        CG[2][10] = (f2ord(s1[8] + s2[0]) & ~255u) | 128u;
        CG[2][11] = (f2ord(s1[9] + s2[0]) & ~255u) | 144u;
        CG[2][12] = (f2ord(s1[10] + s2[0]) & ~255u) | 160u;
        CG[2][13] = (f2ord(s1[11] + s2[0]) & ~255u) | 176u;
        CG[2][14] = (f2ord(s1[12] + s2[0]) & ~255u) | 192u;
        CG[2][15] = (f2ord(s1[13] + s2[0]) & ~255u) | 208u;
        CG[3][0] = (f2ord(s1[14] + s2[0]) & ~255u) | 224u;
        CG[3][1] = (f2ord(s1[15] + s2[0]) & ~255u) | 240u;
        sort16_desc(CG[0]); sort16_desc(CG[1]); sort16_desc(CG[2]); sort16_desc(CG[3]);
        merge_top16(CG[0], CG[1]); merge_top16(CG[2], CG[3]); merge_top16(CG[0], CG[2]);
        unsigned LC[16];
#pragma unroll
        for (int i = 0; i < 16; ++i) LC[i] = CG[0][i];
        LAS int* tb = (LAS int*)(lds + wave * 8192);
#pragma unroll
        for (int i = 0; i < 16; ++i) { tb[i * 64 + lane] = i1[i]; tb[(16 + i) * 64 + lane] = i2[i]; }
        float LS[16]; int LP[16];
#pragma unroll
        for (int i = 0; i < 16; ++i) { const unsigned cid = LC[i] & 255u; LS[i] = ord2f((LC[i] & ~255u) | 128u);
            LP[i] = tb[(cid >> 4) * 64 + lane] * 128 + tb[(16 + (cid & 15u)) * 64 + lane]; }
        float den = 0.f, e[16];
#pragma unroll
        for (int i = 0; i < 16; ++i) { e[i] = __expf(LS[i] - LS[0]); den += e[i]; }
        const float rden = 1.f / den;
        const size_t ob = (size_t)(t0 + r32) * NE + h * 16;
        if (hi == 0) {
#pragma unroll
            for (int i = 0; i < 4; ++i) *(int4*)(idx_o + ob + 4 * i) = make_int4(LP[4 * i], LP[4 * i + 1], LP[4 * i + 2], LP[4 * i + 3]);
        } else {
#pragma unroll
            for (int i = 0; i < 4; ++i) *(f32x4*)(gw_o + ob + 4 * i) = (f32x4){e[4 * i] * rden, e[4 * i + 1] * rden, e[4 * i + 2] * rden, e[4 * i + 3] * rden};
        }
    }
}


__device__ __forceinline__ void wave_argmax(float& v, int& i) {
#pragma unroll
    for (int o = 1; o < 64; o <<= 1) { const float ov = sx_f(v, o); const int oi = sx_i(i, o); if (ov > v || (ov == v && oi < i)) { v = ov; i = oi; } }
}
__device__ __forceinline__ void phase_topk_ref(const Args& a) {
    const int tid = tid_opaque(), lane = tid & 63, wave = tid >> 6;
    const int gw = blockIdx.x * NWAVES + wave, NGW = gridDim.x * NWAVES;
    const bf16_t* skb = (const bf16_t*)(a.ws + WS_SK); const bf16_t* qp = (const bf16_t*)(a.ws + WS_QP);
    int* idx_o = (int*)(a.ws + WS_IDX); float* gw_o = (float*)(a.ws + WS_GW);
    for (int task = gw; task < T * 8; task += NGW) {
        const int t = task >> 3, h = task & 7;
        float topS[2]; int topI[2];
        for (int c = 0; c < 2; ++c) {
            const bf16_t* q = qp + (size_t)t * DM + h * 256 + c * 128;
            float sc0 = 0.f, sc1 = 0.f;
            const bf16_t* k0 = skb + (size_t)((h * 2 + c) * 128 + lane) * 128; const bf16_t* k1 = k0 + 64 * 128;
            for (int d = 0; d < 128; ++d) { const float qd = __uint_as_float((unsigned)q[d] << 16);
                sc0 += qd * __uint_as_float((unsigned)k0[d] << 16); sc1 += qd * __uint_as_float((unsigned)k1[d] << 16); }
            float ms = 0.f; int mi = 0;
            for (int r = 0; r < 16; ++r) {
                float v; int i; if (sc0 >= sc1) { v = sc0; i = lane; } else { v = sc1; i = lane + 64; }
                wave_argmax(v, i);
                if (lane == r) { ms = v; mi = i; }
                if (i == lane) sc0 = -__builtin_inff();
                if (i == lane + 64) sc1 = -__builtin_inff();
            }
            topS[c] = ms; topI[c] = mi;
        }
        float cs[4]; int ci[4];
#pragma unroll
        for (int j = 0; j < 4; ++j) { const int cidx = lane * 4 + j, aa = cidx >> 4, bb = cidx & 15;
            cs[j] = sh_f(topS[0], aa) + sh_f(topS[1], bb); ci[j] = cidx; }
        float fs = 0.f; int fi = 0;
        for (int r = 0; r < 16; ++r) {
            float v = cs[0]; int i = ci[0];
#pragma unroll
            for (int j = 1; j < 4; ++j) if (cs[j] > v) { v = cs[j]; i = ci[j]; }
            wave_argmax(v, i);
            if (lane == r) { fs = v; fi = i; }
#pragma unroll
            for (int j = 0; j < 4; ++j) if (ci[j] == i) cs[j] = -__builtin_inff();
        }
        const int e1 = sh_i(topI[0], fi >> 4), e2 = sh_i(topI[1], fi & 15);
        const float mx = sh_f(fs, 0);
        float ev = lane < 16 ? __expf(fs - mx) : 0.f;
        const float den = wave_sum(ev);
        if (lane < 16) { idx_o[(size_t)t * NE + h * 16 + lane] = e1 * 128 + e2; gw_o[(size_t)t * NE + h * 16 + lane] = ev / den; }
    }
}

__device__ __forceinline__ void fp8x16_to_f32(const u32x4 q, f32x2 (&o)[8]) {
    o[0] = __builtin_amdgcn_cvt_pk_f32_fp8((int)q.x, false); o[1] = __builtin_amdgcn_cvt_pk_f32_fp8((int)q.x, true);
    o[2] = __builtin_amdgcn_cvt_pk_f32_fp8((int)q.y, false); o[3] = __builtin_amdgcn_cvt_pk_f32_fp8((int)q.y, true);
    o[4] = __builtin_amdgcn_cvt_pk_f32_fp8((int)q.z, false); o[5] = __builtin_amdgcn_cvt_pk_f32_fp8((int)q.z, true);
    o[6] = __builtin_amdgcn_cvt_pk_f32_fp8((int)q.w, false); o[7] = __builtin_amdgcn_cvt_pk_f32_fp8((int)q.w, true);
}
#define HALVE(dst, srcv, n, bitmask) do { const bool up_ = (lane & (bitmask)) != 0; _Pragma("unroll") for (int i_ = 0; i_ < (n); ++i_) { \
        const float keep_ = up_ ? srcv[(n) + i_] : srcv[i_], send_ = up_ ? srcv[i_] : srcv[(n) + i_]; dst[i_] = keep_ + sx_f(send_, (bitmask)); } } while (0)
#define ITEM_T(n) (wv + ((n) % KT) * NWX)
#define ITEM_S(n) (xl + 8 * ((n) / KT))
#define LD_IDX(ID, n) do { const int4* ip_ = (const int4*)(idx_i + (size_t)ITEM_T(n) * NE + g * 16); _Pragma("unroll") for (int i_ = 0; i_ < 4; ++i_) ID[i_] = ip_[i_]; } while (0)
#define LD_ROWS(Q, ID, TAB, n) do { const unsigned char* b_ = (TAB) + (size_t)ITEM_S(n) * ((size_t)NEXP * 128) + c * 16; _Pragma("unroll") for (int i_ = 0; i_ < 4; ++i_) { \
        Q[4 * i_] = *(const u32x4*)(b_ + (size_t)ID[i_].x * 128); Q[4 * i_ + 1] = *(const u32x4*)(b_ + (size_t)ID[i_].y * 128); \
        Q[4 * i_ + 2] = *(const u32x4*)(b_ + (size_t)ID[i_].z * 128); Q[4 * i_ + 3] = *(const u32x4*)(b_ + (size_t)ID[i_].w * 128); } } while (0)
__device__ __forceinline__ int dpp_hmirror(int v) { return __builtin_amdgcn_update_dpp(0, v, 0x141, 0xf, 0xf, true); }
__device__ __forceinline__ int dpp_qxor2(int v) { return __builtin_amdgcn_update_dpp(0, v, 0x4E, 0xf, 0xf, true); }
__device__ __forceinline__ int dpp_qxor1(int v) { return __builtin_amdgcn_update_dpp(0, v, 0xB1, 0xf, 0xf, true); }
__device__ __forceinline__ void phase_peer_u(const Args& a) {
    const int tid = tid_opaque(), lane = tid & 63, wave = tid >> 6, g = lane >> 3, c = lane & 7;
    const int xl = blockIdx.x & 7, wv = (blockIdx.x >> 3) * NWAVES + wave, NWX = (gridDim.x >> 3) * NWAVES, KT = T / NWX, N = 2 * KT;
    const unsigned char* xq = a.ws + WS_XQ; const unsigned char* u8 = a.ws + WS_U8;
    const int* idx_i = (const int*)(a.ws + WS_IDX); float* part = (float*)(a.ws + WS_PART);
    const bool up4 = (c & 4) != 0, up2 = (c & 2) != 0, up1 = (c & 1) != 0;
#define LD_X(X, n) do { X = *(const u32x4*)(xq + (size_t)ITEM_T(n) * DM + ITEM_S(n) * 128 + c * 16); } while (0)
#define COMPUTE_U(Q, X, n) do { int p[16]; \
        _Pragma("unroll") for (int i = 0; i < 16; ++i) { int d_ = __builtin_amdgcn_sdot4((int)Q[i].x, (int)X.x, 0, false); d_ = __builtin_amdgcn_sdot4((int)Q[i].y, (int)X.y, d_, false); \
            d_ = __builtin_amdgcn_sdot4((int)Q[i].z, (int)X.z, d_, false); p[i] = __builtin_amdgcn_sdot4((int)Q[i].w, (int)X.w, d_, false); } \
        int p8[8], p4[4], p2[2]; \
        _Pragma("unroll") for (int i = 0; i < 8; ++i) { const int keep_ = up4 ? p[8 + i] : p[i], send_ = up4 ? p[i] : p[8 + i]; p8[i] = keep_ + dpp_hmirror(send_); } \
        _Pragma("unroll") for (int i = 0; i < 4; ++i) { const int keep_ = up2 ? p8[4 + i] : p8[i], send_ = up2 ? p8[i] : p8[4 + i]; p4[i] = keep_ + dpp_qxor2(send_); } \
        _Pragma("unroll") for (int i = 0; i < 2; ++i) { const int keep_ = up1 ? p4[2 + i] : p4[i], send_ = up1 ? p4[i] : p4[2 + i]; p2[i] = keep_ + dpp_qxor1(send_); } \
        *(f32x2*)(part + ((size_t)ITEM_T(n) * 16 + ITEM_S(n)) * NE + 2 * lane) = (f32x2){(float)p2[0], (float)p2[1]}; } while (0)
    int4 IA[4], IB[4]; u32x4 QA[16], QB[16], XA, XB;
    LD_IDX(IA, 0); LD_IDX(IB, 1);
    LD_ROWS(QA, IA, u8, 0); LD_X(XA, 0);
    for (int n = 0; n < N; n += 2) {
        LD_ROWS(QB, IB, u8, n + 1); LD_X(XB, n + 1);
        if (n + 2 < N) LD_IDX(IA, n + 2);
        COMPUTE_U(QA, XA, n);
        if (n + 2 < N) { LD_ROWS(QA, IA, u8, n + 2); LD_X(XA, n + 2); }
        if (n + 3 < N) LD_IDX(IB, n + 3);
        COMPUTE_U(QB, XB, n + 1);
    }
#undef LD_X
#undef COMPUTE_U
}
__device__ __forceinline__ void phase_peer_w(const Args& a) {
    const int gt = blockIdx.x * NTHREADS + tid_opaque(), NGT = gridDim.x * NTHREADS;
    const int* idx_i = (const int*)(a.ws + WS_IDX); const float* gw_i = (const float*)(a.ws + WS_GW); const float* part = (const float*)(a.ws + WS_PART);
    const float* suv = (const float*)(a.ws + WS_SUV); const float* sx = (const float*)(a.ws + WS_SX);
    signed char* wq = (signed char*)(a.ws + WS_WQ); float* sw = (float*)(a.ws + WS_SW);
    for (int item = gt; item < T * NE; item += NGT) {
        const int t = item >> 7, e = item & 127;
        float sum = 0.f;
#pragma unroll
        for (int s = 0; s < 16; ++s) sum += part[((size_t)t * 16 + s) * NE + e];
        const int ex = idx_i[item];
        const float d = sum * suv[ex] * sx[t];
        const float om = 0.5f * d * (1.f + erff(d * 0.70710678118654752f)) * gw_i[item] * suv[NEXP + ex];
        float mx = fabsf(om);
        mx = fmaxf(mx, sx_f(mx, 1)); mx = fmaxf(mx, sx_f(mx, 2)); mx = fmaxf(mx, sx_f(mx, 4)); mx = fmaxf(mx, sx_f(mx, 8));
        const float qs = mx > 0.f ? 127.f / mx : 1.f;
        wq[item] = (signed char)(int)__builtin_rintf(om * qs);
        if ((e & 15) == 0) sw[t * 8 + (e >> 4)] = mx * (1.f / 127.f);
    }
}
__device__ __forceinline__ void phase_peer_v(const Args& a, float* dst) {
    const int tid = tid_opaque(), lane = tid & 63, wave = tid >> 6, g = lane >> 3, c = lane & 7;
    const int xl = blockIdx.x & 7, wv = (blockIdx.x >> 3) * NWAVES + wave, NWX = (gridDim.x >> 3) * NWAVES, KT = T / NWX, N = 2 * KT;
    const unsigned char* v8 = a.ws + WS_V8;
    const int* idx_i = (const int*)(a.ws + WS_IDX); const unsigned char* wq = a.ws + WS_WQ; const float* sw = (const float*)(a.ws + WS_SW);
    const bf16_t* hsrc = (const bf16_t*)(a.ws + WS_HB);
#define LD_W(W, SWV, n) do { W = *(const u32x4*)(wq + (size_t)ITEM_T(n) * NE + g * 16); SWV = sw[ITEM_T(n) * 8 + g]; } while (0)
#define QUAD(A_, B_, C_, D_, W_, A0, A1, A2, A3) do { \
        const unsigned ablo_ = __builtin_amdgcn_perm(B_, A_, 0x05010400u), abhi_ = __builtin_amdgcn_perm(B_, A_, 0x07030602u); \
        const unsigned cdlo_ = __builtin_amdgcn_perm(D_, C_, 0x05010400u), cdhi_ = __builtin_amdgcn_perm(D_, C_, 0x07030602u); \
        A0 = __builtin_amdgcn_sdot4((int)__builtin_amdgcn_perm(cdlo_, ablo_, 0x05040100u), (int)(W_), A0, false); \
        A1 = __builtin_amdgcn_sdot4((int)__builtin_amdgcn_perm(cdlo_, ablo_, 0x07060302u), (int)(W_), A1, false); \
        A2 = __builtin_amdgcn_sdot4((int)__builtin_amdgcn_perm(cdhi_, abhi_, 0x05040100u), (int)(W_), A2, false); \
        A3 = __builtin_amdgcn_sdot4((int)__builtin_amdgcn_perm(cdhi_, abhi_, 0x07060302u), (int)(W_), A3, false); } while (0)
#define COMPUTE_V(Q, W, SWV, n) do { int ac[16]; _Pragma("unroll") for (int k = 0; k < 16; ++k) ac[k] = 0; \
        _Pragma("unroll") for (int q_ = 0; q_ < 4; ++q_) { const unsigned w_ = q_ == 0 ? W.x : q_ == 1 ? W.y : q_ == 2 ? W.z : W.w; \
            QUAD(Q[4 * q_].x, Q[4 * q_ + 1].x, Q[4 * q_ + 2].x, Q[4 * q_ + 3].x, w_, ac[0], ac[1], ac[2], ac[3]); \
            QUAD(Q[4 * q_].y, Q[4 * q_ + 1].y, Q[4 * q_ + 2].y, Q[4 * q_ + 3].y, w_, ac[4], ac[5], ac[6], ac[7]); \
            QUAD(Q[4 * q_].z, Q[4 * q_ + 1].z, Q[4 * q_ + 2].z, Q[4 * q_ + 3].z, w_, ac[8], ac[9], ac[10], ac[11]); \
            QUAD(Q[4 * q_].w, Q[4 * q_ + 1].w, Q[4 * q_ + 2].w, Q[4 * q_ + 3].w, w_, ac[12], ac[13], ac[14], ac[15]); } \
        float p[16]; _Pragma("unroll") for (int k = 0; k < 16; ++k) p[k] = (float)ac[k] * SWV; \
        float p8[8], p4[4], p2[2]; \
        _Pragma("unroll") for (int i_ = 0; i_ < 8; ++i_) { auto rr_ = __builtin_amdgcn_permlane32_swap(__float_as_uint(p[i_]), __float_as_uint(p[8 + i_]), false, false); p8[i_] = __uint_as_float(rr_[0]) + __uint_as_float(rr_[1]); } \
        _Pragma("unroll") for (int i_ = 0; i_ < 4; ++i_) { auto rr_ = __builtin_amdgcn_permlane16_swap(__float_as_uint(p8[i_]), __float_as_uint(p8[4 + i_]), false, false); p4[i_] = __uint_as_float(rr_[0]) + __uint_as_float(rr_[1]); } \
        HALVE(p2, p4, 2, 8); \
        const size_t o_ = (size_t)ITEM_T(n) * DM + ITEM_S(n) * 128 + c * 16 + 2 * g; \
        const unsigned hv = *(const unsigned*)(hsrc + o_); *(f32x2*)(dst + o_) = (f32x2){bf_lo(hv) + p2[0], bf_hi(hv) + p2[1]}; } while (0)
    int4 IA[4], IB[4]; u32x4 QA[16], QB[16], WA, WB; float SA, SB_;
    LD_IDX(IA, 0); LD_IDX(IB, 1);
    LD_ROWS(QA, IA, v8, 0); LD_W(WA, SA, 0);
    for (int n = 0; n < N; n += 2) {
        LD_ROWS(QB, IB, v8, n + 1); LD_W(WB, SB_, n + 1);
        if (n + 2 < N) LD_IDX(IA, n + 2);
        COMPUTE_V(QA, WA, SA, n);
        if (n + 2 < N) { LD_ROWS(QA, IA, v8, n + 2); LD_W(WA, SA, n + 2); }
        if (n + 3 < N) LD_IDX(IB, n + 3);
        COMPUTE_V(QB, WB, SB_, n + 1);
    }
#undef LD_W
#undef QUAD
#undef COMPUTE_V
}
#undef ITEM_T
#undef ITEM_S
#undef LD_IDX
#undef LD_ROWS
#undef HALVE


constexpr int NPHASE = 11;
#define LOAD_ARGS() do { } while (0)
__global__ void __launch_bounds__(NTHREADS, 2) fwd_kernel(Args a) {
    extern __shared__ __attribute__((aligned(16))) unsigned char lds[];
#if MK_ONE_LAUNCH
    constexpr int lo = 0, hi = NPHASE;
    cg::grid_group grid = cg::this_grid();
    volatile LAS unsigned* misc = (volatile LAS unsigned*)((LAS unsigned char*)lds + MISC_OFF);
    if (threadIdx.x < 16) misc[threadIdx.x] = 0u;
    __syncthreads();
    { LOAD_ARGS(); (void)xcd_barrier_post((unsigned*)(a.ws + WS_CTL) + CW_BAR, misc + 8); }
#ifndef SEAM_CG_MASK
#define SEAM_CG_MASK 0
#endif
#define SEAM(k) do { if (lo <= (k) && (k) + 1 < hi) { if ((SEAM_CG_MASK >> (k)) & 1) grid.sync(); else { LOAD_ARGS(); XcdBarrier xb_; xb_.bar = (unsigned*)(a.ws + WS_CTL) + CW_BAR; xb_.x = xb_xcc_id(); \
        xb_.st = (volatile LAS unsigned*)((LAS unsigned char*)lds + MISC_OFF) + 8; xcd_barrier(xb_); } } } while (0)
#else
    int lo, hi; { LOAD_ARGS(); lo = a.ph_lo; hi = a.ph_hi; }
#define SEAM(k) do { } while (0)
#endif
#define IN(k) (lo <= (k) && (k) < hi)
#ifndef DUP_PHASE
#define DUP_PHASE -1
#endif
    if (IN(0)) { LOAD_ARGS(); phase0(a, lds); if (DUP_PHASE == 0) { __syncthreads(); phase0(a, lds); } SEAM(0); }
    if (IN(1)) { LOAD_ARGS(); unsigned char* ws = a.ws;
        cumsum_rows(a);
        pg8::Gemm g{(const bf16_t*)(ws + WS_XN), (const bf16_t*)(ws + WS_WIN), T, NPROJ, DM}; pg8::StaticOrder S; S.init(T, NPROJ, (int)gridDim.x, (int)blockIdx.x);
        pg8::EpiInProj E{(bf16_t*)(ws + WS_SEC), (const float*)(ws + WS_SXN), (const float*)(ws + WS_WSC), a.in[4], a.in[5], (LAS float*)((LAS unsigned char*)lds + RING_BYTES)};
        for (int rep_ = 0; rep_ < (DUP_PHASE == 1 ? 2 : 1); ++rep_)
        pg8::gemm_phase<pg8::EpiInProj, pg8::StaticOrder, true, true, true>((LAS unsigned char*)lds, g, S, E);
        { const int nwg_ = (T / 256) * (NPROJ / 256), G_ = (int)gridDim.x, rem_ = nwg_ % G_;
          if (rem_ > 0 && (int)blockIdx.x >= rem_) convert_tables(a, TAB_SPLIT, 2 * NEXP, ((int)blockIdx.x - rem_) * NWAVES + (tid_opaque() >> 6), (G_ - rem_) * NWAVES);
          else if (rem_ == 0) convert_tables(a, TAB_SPLIT, 2 * NEXP, (int)blockIdx.x * NWAVES + (tid_opaque() >> 6), G_ * NWAVES); }
        SEAM(1);
    }
    if (IN(3)) { LOAD_ARGS(); phase_attn(a, lds);
#if MK_ONE_LAUNCH
        if (DUP_PHASE == 3) { XcdBarrier xb_; xb_.bar = (unsigned*)(a.ws + WS_CTL) + CW_BAR; xb_.x = xb_xcc_id(); xb_.st = (volatile LAS unsigned*)((LAS unsigned char*)lds + MISC_OFF) + 8;
            xcd_barrier(xb_); if (blockIdx.x == 0 && threadIdx.x == 0) __hip_atomic_store((unsigned*)(a.ws + WS_CTL), 0u, __ATOMIC_RELAXED, __HIP_MEMORY_SCOPE_AGENT); xcd_barrier(xb_); phase_attn(a, lds); }
#endif
        SEAM(3); }
    if (IN(4)) { LOAD_ARGS(); phase_attn_combine(a); SEAM(4); }
    if (IN(5)) { LOAD_ARGS(); unsigned char* ws = a.ws;
        pg8::Gemm g{(const bf16_t*)(ws + WS_MIX), (const bf16_t*)(ws + WS_WOUT), T, DM, DM}; pg8::StaticOrder S; S.init(T, DM, (int)gridDim.x, (int)blockIdx.x);
        pg8::EpiOutProj E{a.in[0], a.out, (bf16_t*)(ws + WS_HB), (float*)(ws + WS_SSQ), (float*)(ws + WS_AMX)};
        for (int rep_ = 0; rep_ < (DUP_PHASE == 5 ? 2 : 1); ++rep_)
        pg8::gemm_phase<pg8::EpiOutProj, pg8::StaticOrder, true, true>((LAS unsigned char*)lds, g, S, E);
        SEAM(5);
    }
    if (IN(6)) { LOAD_ARGS(); unsigned char* ws = a.ws;
        pg8::Gemm g{(const bf16_t*)(ws + WS_HB), (const bf16_t*)(ws + WS_WPQ), T, DM, DM}; pg8::StaticOrder S; S.init(T, DM, (int)gridDim.x, (int)blockIdx.x);
        pg8::EpiPeerQ E{(const float*)(ws + WS_SSQ), (bf16_t*)(ws + WS_QP), (float*)(ws + WS_RT)};
        for (int rep_ = 0; rep_ < (DUP_PHASE == 6 ? 2 : 1); ++rep_)
        pg8::gemm_phase<pg8::EpiPeerQ, pg8::StaticOrder, true, true>((LAS unsigned char*)lds, g, S, E);
        SEAM(6);
    }
    #ifdef TOPK_REF
    if (IN(7)) { LOAD_ARGS(); phase_topk_ref(a); SEAM(7); }
#else
    if (IN(7)) { LOAD_ARGS(); for (int rep_ = 0; rep_ < (DUP_PHASE == 7 ? 2 : 1); ++rep_) phase_topk(a, lds); SEAM(7); }
#endif
    if (IN(8)) { LOAD_ARGS(); for (int rep_ = 0; rep_ < (DUP_PHASE == 8 ? 2 : 1); ++rep_) phase_peer_u(a); SEAM(8); }
    if (IN(9)) { LOAD_ARGS(); for (int rep_ = 0; rep_ < (DUP_PHASE == 9 ? 2 : 1); ++rep_) phase_peer_w(a); SEAM(9); }
    if (IN(10)) { LOAD_ARGS(); for (int rep_ = 0; rep_ < (DUP_PHASE == 10 ? 2 : 1); ++rep_) phase_peer_v(a, (DUP_PHASE == 10 && rep_ == 0) ? (float*)(a.ws + WS_END) : a.out); }
#undef IN
#undef SEAM
}

extern "C" void kernel_launch(void* const* d_in, const int* in_sizes, int n_in, void* d_out, int out_size, void* d_ws, size_t ws_size, hipStream_t stream) {
    static int grid = 0;
    if (grid == 0) {
        if (n_in != 12 || in_sizes[0] != T * DM || out_size != T * DM || ws_size < WS_END) { fprintf(stderr, "kernel_launch: unexpected shapes (n_in %d, in0 %d, out %d, ws %zu)\n", n_in, n_in > 0 ? in_sizes[0] : -1, out_size, ws_size); grid = -1; return; }
        int dev = 0, cus = 0, per_cu = 0;
        if (hipGetDevice(&dev) != hipSuccess || hipDeviceGetAttribute(&cus, hipDeviceAttributeMultiprocessorCount, dev) != hipSuccess) { grid = -1; return; }
        if (hipFuncSetAttribute((const void*)fwd_kernel, hipFuncAttributeMaxDynamicSharedMemorySize, LDS_BYTES) != hipSuccess) { fprintf(stderr, "kernel_launch: hipFuncSetAttribute failed\n"); grid = -1; return; }
        if (hipOccupancyMaxActiveBlocksPerMultiprocessor(&per_cu, (const void*)fwd_kernel, NTHREADS, LDS_BYTES) != hipSuccess || per_cu < 1) { fprintf(stderr, "kernel_launch: occupancy query says %d\n", per_cu); grid = -1; return; }
        grid = cus;
    }
    if (grid < 0) return;
    (void)hipMemsetAsync((char*)d_ws + WS_CTL, 0, CTL_BYTES, stream);
    Args a{};
    for (int i = 0; i < 12; ++i) a.in[i] = (const float*)d_in[i];
    a.out = (float*)d_out; a.ws = (unsigned char*)d_ws;
#if MK_ONE_LAUNCH
    a.ph_lo = 0; a.ph_hi = NPHASE;
    void* args[] = {&a};
#if MK_COOP_LAUNCH
    hipError_t e = hipLaunchCooperativeKernel((const void*)fwd_kernel, dim3(grid), dim3(NTHREADS), args, LDS_BYTES, stream);
    if (e != hipSuccess) fprintf(stderr, "cooperative launch failed: %s (grid %d)\n", hipGetErrorString(e), grid);
#else
    (void)args; hipLaunchKernelGGL(fwd_kernel, dim3(grid), dim3(NTHREADS), LDS_BYTES, stream, a);
#endif
#else
    for (int p = 0; p < NPHASE; ++p) { a.ph_lo = p; a.ph_hi = p + 1; hipLaunchKernelGGL(fwd_kernel, dim3(grid), dim3(NTHREADS), LDS_BYTES, stream, a); }
#endif
}
```

```cpp
#include <hip/hip_runtime.h>
#include <hip/hip_cooperative_groups.h>
#include <cstdio>
#include <cstdint>
namespace cg = cooperative_groups;

#ifndef MK_COOP_LAUNCH
#define MK_COOP_LAUNCH 0
#endif
#ifndef MK_ONE_LAUNCH
#define MK_ONE_LAUNCH 1
#endif

#define LAS __attribute__((address_space(3)))
typedef unsigned short bf16_t;
typedef short bf16x8 __attribute__((ext_vector_type(8)));
typedef short s16x4 __attribute__((ext_vector_type(4)));
typedef float f32x2 __attribute__((ext_vector_type(2)));
typedef float f32x4 __attribute__((ext_vector_type(4)));
typedef float f32x16 __attribute__((ext_vector_type(16)));
typedef unsigned u32x2 __attribute__((ext_vector_type(2)));
typedef unsigned u32x4 __attribute__((ext_vector_type(4)));
typedef __bf16 bf16x2_t __attribute__((ext_vector_type(2)));

constexpr int NB = 2, SEQ = 4096, T = NB * SEQ, DM = 2048, HD = 128, NHF = 8, DIN = 7176, NPROJ = 7168;
constexpr int NEXP = 16384, NE = 128;
constexpr float EPS = 1e-6f;
constexpr float SCALE = 0.08838834764831845f, LOG2E = 1.4426950408889634f;
constexpr int NWAVES = 8, NTHREADS = 512;

constexpr size_t MiB = 1u << 20;
constexpr size_t WS_CTL = 0, CTL_BYTES = 32768;
constexpr int CW_BAR = 1024;
constexpr size_t WS_SXN = 64 * MiB  , WS_WSC = 45 * MiB + 800 * 1024  ;
constexpr int CW_WMAX = 64;
constexpr size_t WS_GQK = 45 * MiB + 768 * 1024;
constexpr size_t WS_WIN = 1 * MiB, WS_WOUT = 29 * MiB, WS_WPQ = 37 * MiB, WS_SK = 45 * MiB, WS_LOGF = 46 * MiB, WS_C = 46 * MiB + 512 * 1024, WS_SSQ = 47 * MiB;
constexpr size_t WS_XN = 48 * MiB;
constexpr size_t WS_SEC = 80 * MiB;
constexpr size_t SEC_ELEMS = 8u << 20;
constexpr size_t WS_MIX = 192 * MiB, WS_HB = 224 * MiB, WS_QP = 256 * MiB, WS_IDX = 288 * MiB, WS_GW = 292 * MiB, WS_U8 = 296 * MiB, WS_V8 = 328 * MiB, WS_SUV = 360 * MiB  , WS_RT = 360 * MiB + 256 * 1024  , WS_W = 361 * MiB  ,
                 WS_PART = 368 * MiB  , WS_XQ = 432 * MiB  , WS_END = 448 * MiB;
constexpr size_t WS_AMX = 365 * MiB  , WS_SX = WS_RT + 64 * 1024  , WS_WQ = WS_W  , WS_SW = WS_W + 2 * MiB  ;
constexpr size_t WS_PO = WS_PART  , WS_PML = WS_PART + 32 * MiB  ;

constexpr int RING_BYTES = 131072;
constexpr int MISC_OFF = 143360;
constexpr int LDS_BYTES = 147456;

__device__ __forceinline__ unsigned cvt_pk_bf16(float lo, float hi) { unsigned r; asm volatile("v_cvt_pk_bf16_f32 %0, %1, %2" : "=v"(r) : "v"(lo), "v"(hi)); return r; }
__device__ __forceinline__ float bf_lo(unsigned u) { return __builtin_bit_cast(float, u << 16); }
__device__ __forceinline__ float bf_hi(unsigned u) { return __builtin_bit_cast(float, u & 0xffff0000u); }
__device__ __forceinline__ int lane_id_fresh() { int l = (int)__builtin_amdgcn_mbcnt_hi(~0u, __builtin_amdgcn_mbcnt_lo(~0u, 0u)); asm volatile("" : "+v"(l)); return l; }
__device__ __forceinline__ int sx_i(int v, int m) { return __builtin_amdgcn_ds_bpermute((lane_id_fresh() ^ m) << 2, v); }
__device__ __forceinline__ float sx_f(float v, int m) { return __int_as_float(__builtin_amdgcn_ds_bpermute((lane_id_fresh() ^ m) << 2, __float_as_int(v))); }
__device__ __forceinline__ int sh_i(int v, int src) { return __builtin_amdgcn_ds_bpermute(src << 2, v); }
__device__ __forceinline__ float sh_f(float v, int src) { return __int_as_float(__builtin_amdgcn_ds_bpermute(src << 2, __float_as_int(v))); }
__device__ __forceinline__ float shup_f(float v, int d) { const int l = lane_id_fresh(); const int s = l - d; return __int_as_float(__builtin_amdgcn_ds_bpermute((s < 0 ? l : s) << 2, __float_as_int(v))); }
__device__ __forceinline__ float wave_sum(float v) {
#pragma unroll
    for (int o = 1; o < 64; o <<= 1) v += sx_f(v, o);
    return v;
}
__device__ __forceinline__ float wave_max(float v) {
#pragma unroll
    for (int o = 1; o < 64; o <<= 1) v = fmaxf(v, sx_f(v, o));
    return v;
}
__device__ __forceinline__ int tid_opaque() { int t = (int)threadIdx.x; asm volatile("" : "+v"(t)); return t; }
#define LDS_WAIT() asm volatile("s_waitcnt lgkmcnt(0)" ::: "memory")

namespace pg8 {
#define PG8_LAS __attribute__((address_space(3)))
constexpr int BM = 256, BK = 64, HALF = 128, HTB = HALF * BK * 2, STAGE_BYTES = 8 * HTB, NXCD = 8, WGM = 8;
__host__ __device__ __forceinline__ int lds_byte(int r, int c) { const int st = (r >> 4) * 2 + (c >> 5), rr = r & 15, cc = c & 31, ob = rr * 64 + cc * 2; return st * 1024 + (ob ^ (((ob >> 9) & 1) << 5)); }
__host__ __device__ __forceinline__ void stage_rc(int b, int& R, int& C) { const int st = b / 1024, sb = b % 1024, swz = sb ^ (((sb >> 9) & 1) << 5); R = (st >> 1) * 16 + swz / 64; C = (st & 1) * 32 + (swz % 64) / 2; }
__host__ __device__ __forceinline__ int perm32(int rho) { const int n = rho >> 4, i = rho & 15; return 8 * (i >> 2) + 4 * n + (i & 3); }
struct Unit { int pm, pn; };
struct Gemm { const bf16_t* A; const bf16_t* Bt; int M, N, K; };
struct StaticOrder {
    int nM, nN, nwg, G, c;
    __host__ __device__ void init(int M, int N, int G_, int c_) { nM = M / BM; nN = N / BM; nwg = nM * nN; G = G_; c = c_; }
    __host__ __device__ bool next(int i, Unit& u) const {
        const long L = (long)i * G + c; if (L >= nwg) return false;
        int wgid = (int)L; { const int q = nwg / NXCD, r = nwg % NXCD, xcd = wgid % NXCD, off = wgid / NXCD; wgid = (xcd < r ? xcd * (q + 1) : r * (q + 1) + (xcd - r) * q) + off; }
        const int nig = WGM * nN, gid = wgid / nig, fm = gid * WGM, gsz = (nM - fm) < WGM ? (nM - fm) : WGM;
        u.pm = fm + ((wgid % nig) % gsz); u.pn = (wgid % nig) / gsz; return true;
    }
    __device__ __forceinline__ void a_ready(const Unit&) const {}
    __device__ __forceinline__ void done(const Unit&) const {}
};

typedef int i32x4 __attribute__((ext_vector_type(4)));
template <bool I8> struct AccT { typedef f32x4 type; };
template <> struct AccT<true> { typedef i32x4 type; };
template <class Epi, class Sched, bool ALIGN_EPI = false, bool SP2 = false, bool I8 = false>
__device__ __forceinline__ void gemm_phase(PG8_LAS unsigned char* lds, const Gemm g, const Sched& S, const Epi& E) {
    typedef typename AccT<I8>::type acc_t;
    const int tid = tid_opaque(), wid = __builtin_amdgcn_readfirstlane(tid >> 6), lane = tid & 63, wr = wid >> 2, wc = wid & 3, fr = lane & 15, fq = lane >> 4;
    const int rowb = I8 ? g.K : 2 * g.K, nt = rowb / (BK * 2);
    unsigned voffA[2], voffB[2];
#pragma unroll
    for (int i = 0; i < 2; ++i) { int R, C; stage_rc(tid * 16 + i * 8192, R, C); const int Rb = Epi::PERM ? ((R & ~31) + perm32(R & 31)) : R;
        voffA[i] = (unsigned)(R * rowb + C * 2); voffB[i] = (unsigned)(Rb * rowb + C * 2); }
    const size_t kstep = (size_t)(BK * 2);
    const size_t hstep = (size_t)HALF * rowb;
    const size_t tstep = 2 * hstep;
    const unsigned ldsw = (unsigned)wid * 1024u;
    const int aoff = lds_byte(wr * 64 + fr, fq * 8), boff = lds_byte(wc * 32 + fr, fq * 8);
#define PG8_SA(b, h) (((b) * 2 + (h)) * HTB)
#define PG8_SB(b, h) ((4 + (b) * 2 + (h)) * HTB)
#define PG8_STAGE(bufoff, gbase, voff) do { _Pragma("unroll") for (int _i = 0; _i < 2; ++_i) \
        __builtin_amdgcn_global_load_lds((const unsigned*)((const char*)(gbase) + (voff)[_i]), (PG8_LAS unsigned*)(lds + (bufoff) + ldsw + _i * 8192), 16, 0, 0); } while (0)
#define PG8_LDA(dst, b, h) do { _Pragma("unroll") for (int m = 0; m < 4; ++m) _Pragma("unroll") for (int k = 0; k < 2; ++k) dst[m][k] = *(const PG8_LAS bf16x8*)(lds + PG8_SA(b, h) + aoff + m * 2048 + k * 1024); } while (0)
#define PG8_LDB(dst, b, h) do { _Pragma("unroll") for (int n = 0; n < 2; ++n) _Pragma("unroll") for (int k = 0; k < 2; ++k) dst[n][k] = *(const PG8_LAS bf16x8*)(lds + PG8_SB(b, h) + boff + n * 2048 + k * 1024); } while (0)
#define PG8_MMA(ai, bj, At, Bt) do { __builtin_amdgcn_s_setprio(1); _Pragma("unroll") for (int m = 0; m < 4; ++m) _Pragma("unroll") for (int n = 0; n < 2; ++n) _Pragma("unroll") for (int k = 0; k < 2; ++k) \
        { if constexpr (I8) acc[ai][bj][m][n] = __builtin_amdgcn_mfma_i32_16x16x64_i8(__builtin_bit_cast(i32x4, Bt[n][k]), __builtin_bit_cast(i32x4, At[m][k]), acc[ai][bj][m][n], 0, 0, 0); \
          else acc[ai][bj][m][n] = __builtin_amdgcn_mfma_f32_16x16x32_bf16(Bt[n][k], At[m][k], acc[ai][bj][m][n], 0, 0, 0); } __builtin_amdgcn_s_setprio(0); } while (0)
#define PG8_WAIT_V(n) asm volatile("s_waitcnt vmcnt(" #n ")" ::: "memory")
#define PG8_WAIT_L(n) asm volatile("s_waitcnt lgkmcnt(" #n ")" ::: "memory")
#define PG8_BAR __builtin_amdgcn_s_barrier()
#define PG8_SCHED __builtin_amdgcn_sched_barrier(0)
    Unit cur, nxt; int ui = 0;
    if (!S.next(0, cur)) return;
    acc_t acc[2][2][4][2];
#pragma unroll
    for (int a = 0; a < 2; ++a)
#pragma unroll
        for (int b = 0; b < 2; ++b)
#pragma unroll
            for (int m = 0; m < 4; ++m)
#pragma unroll
                for (int n = 0; n < 2; ++n) acc[a][b][m][n] = acc_t{};
    bf16x8 At[4][2], B0[2][2], B1[2][2];
    const char* cA = (const char*)g.A + (size_t)cur.pm * tstep; const char* cB = (const char*)g.Bt + (size_t)cur.pn * tstep;
    S.a_ready(cur);
    if constexpr (SP2) {
        PG8_STAGE(PG8_SB(0, 0), cB, voffB); PG8_STAGE(PG8_SB(0, 1), cB + hstep, voffB); PG8_STAGE(PG8_SA(0, 0), cA, voffA); PG8_STAGE(PG8_SA(0, 1), cA + hstep, voffA);
        if (wr == 1) PG8_BAR;
        PG8_WAIT_V(2); PG8_BAR;
        PG8_STAGE(PG8_SB(1, 0), cB + kstep, voffB); PG8_STAGE(PG8_SA(1, 0), cA + kstep, voffA); PG8_STAGE(PG8_SB(1, 1), cB + hstep + kstep, voffB);
        PG8_WAIT_V(6); PG8_BAR;
    } else {
        PG8_STAGE(PG8_SB(0, 0), cB, voffB); PG8_STAGE(PG8_SA(0, 0), cA, voffA); PG8_STAGE(PG8_SB(0, 1), cB + hstep, voffB); PG8_STAGE(PG8_SA(0, 1), cA + hstep, voffA);
        if (wr == 1) PG8_BAR;
        PG8_WAIT_V(4); PG8_BAR;
        PG8_STAGE(PG8_SB(1, 0), cB + kstep, voffB); PG8_STAGE(PG8_SA(1, 0), cA + kstep, voffA); PG8_STAGE(PG8_SB(1, 1), cB + hstep + kstep, voffB);
        PG8_WAIT_V(6); PG8_BAR;
    }
    for (;;) {
        const bool has_next = S.next(ui + 1, nxt);
        const char* nA = has_next ? (const char*)g.A + (size_t)nxt.pm * tstep : cA; const char* nB = has_next ? (const char*)g.Bt + (size_t)nxt.pn * tstep : cB;
        for (int t = 0; t < nt; t += 2) {
            const bool last = (t == nt - 2);
            const char* a1 = cA + (size_t)(t + 1) * kstep;
            const char* a2 = last ? nA : cA + (size_t)(t + 2) * kstep; const char* b2 = last ? nB : cB + (size_t)(t + 2) * kstep;
            const char* a3 = a2 + kstep; const char* b3 = b2 + kstep;
            if (last && has_next) S.a_ready(nxt);
            if constexpr (SP2) {
            PG8_LDB(B0, 0, 0); PG8_LDB(B1, 0, 1); PG8_SCHED; PG8_LDA(At, 0, 0); PG8_STAGE(PG8_SA(1, 1), a1 + hstep, voffA);
            PG8_WAIT_V(8); PG8_WAIT_L(0); PG8_BAR; PG8_MMA(0, 0, At, B0); PG8_MMA(0, 1, At, B1); PG8_BAR; PG8_SCHED;
            PG8_LDA(At, 0, 1); PG8_STAGE(PG8_SB(0, 0), b2, voffB); PG8_STAGE(PG8_SB(0, 1), b2 + hstep, voffB); PG8_STAGE(PG8_SA(0, 0), a2, voffA);
            PG8_WAIT_V(8); PG8_WAIT_L(0); PG8_BAR; PG8_MMA(1, 0, At, B0); PG8_MMA(1, 1, At, B1); PG8_BAR; PG8_SCHED;
            PG8_LDB(B0, 1, 0); PG8_LDB(B1, 1, 1); PG8_SCHED; PG8_LDA(At, 1, 0); PG8_STAGE(PG8_SA(0, 1), a2 + hstep, voffA);
            PG8_WAIT_V(8); PG8_WAIT_L(0); PG8_BAR; PG8_MMA(0, 0, At, B0); PG8_MMA(0, 1, At, B1); PG8_BAR; PG8_SCHED;
            PG8_LDA(At, 1, 1); PG8_STAGE(PG8_SB(1, 0), b3, voffB); PG8_STAGE(PG8_SB(1, 1), b3 + hstep, voffB); PG8_STAGE(PG8_SA(1, 0), a3, voffA);
            PG8_WAIT_V(8); PG8_WAIT_L(0); PG8_BAR; PG8_MMA(1, 0, At, B0); PG8_MMA(1, 1, At, B1); PG8_BAR; PG8_SCHED;
            } else {
            PG8_LDB(B0, 0, 0); PG8_SCHED; PG8_LDA(At, 0, 0); PG8_STAGE(PG8_SA(1, 1), a1 + hstep, voffA);
            PG8_WAIT_L(8); PG8_BAR; PG8_WAIT_L(0); PG8_MMA(0, 0, At, B0); PG8_BAR; PG8_SCHED;
            PG8_LDB(B1, 0, 1); PG8_STAGE(PG8_SB(0, 0), b2, voffB);
            PG8_BAR; PG8_WAIT_L(0); PG8_MMA(0, 1, At, B1); PG8_BAR;
            PG8_LDA(At, 0, 1); PG8_STAGE(PG8_SA(0, 0), a2, voffA);
            PG8_BAR; PG8_WAIT_L(0); PG8_MMA(1, 0, At, B0); PG8_BAR; PG8_SCHED;
            PG8_STAGE(PG8_SB(0, 1), b2 + hstep, voffB);
            PG8_WAIT_V(6); PG8_BAR; PG8_MMA(1, 1, At, B1); PG8_BAR;
            PG8_LDB(B0, 1, 0); PG8_SCHED; PG8_LDA(At, 1, 0); PG8_STAGE(PG8_SA(0, 1), a2 + hstep, voffA);
            PG8_WAIT_L(8); PG8_BAR; PG8_WAIT_L(0); PG8_MMA(0, 0, At, B0); PG8_BAR; PG8_SCHED;
            PG8_LDB(B1, 1, 1); PG8_STAGE(PG8_SB(1, 0), b3, voffB);
            PG8_BAR; PG8_WAIT_L(0); PG8_MMA(0, 1, At, B1); PG8_BAR;
            PG8_LDA(At, 1, 1); PG8_STAGE(PG8_SA(1, 0), a3, voffA);
            PG8_BAR; PG8_WAIT_L(0); PG8_MMA(1, 0, At, B0); PG8_BAR; PG8_SCHED;
            PG8_STAGE(PG8_SB(1, 1), b3 + hstep, voffB);
            PG8_WAIT_V(6); PG8_BAR; PG8_MMA(1, 1, At, B1); PG8_BAR;
            }
        }
        if constexpr (ALIGN_EPI) { if (wr == 0) PG8_BAR; }
        E(acc, cur, wr, wc, fr, fq); S.done(cur);
        if (!has_next) break;
#pragma unroll
        for (int a = 0; a < 2; ++a)
#pragma unroll
            for (int b = 0; b < 2; ++b)
#pragma unroll
                for (int m = 0; m < 4; ++m)
#pragma unroll
                    for (int n = 0; n < 2; ++n) acc[a][b][m][n] = acc_t{};
        cur = nxt; cA = nA; cB = nB; ++ui;
        if constexpr (ALIGN_EPI) { if (wr == 1) PG8_BAR; }
    }
    PG8_WAIT_V(0);
    if constexpr (!ALIGN_EPI) { if (wr == 0) PG8_BAR; }
    PG8_BAR;
#undef PG8_SA
#undef PG8_SB
#undef PG8_STAGE
#undef PG8_LDA
#undef PG8_LDB
#undef PG8_MMA
#undef PG8_WAIT_V
#undef PG8_WAIT_L
#undef PG8_BAR
#undef PG8_SCHED
}

__device__ __forceinline__ float sigmoidf_fast(float x) { return __builtin_amdgcn_rcpf(1.f + __builtin_amdgcn_exp2f(-x * LOG2E)); }
struct EpiInProj {
    static constexpr bool PERM = true;
    bf16_t* base; const float* sxn  ; const float* wsc  ;
    const float* gq; const float* gk; PG8_LAS float* xch  ;
    __device__ __forceinline__ void operator()(const i32x4 (&acci)[2][2][4][2], const Unit& u, int wr, int wc, int fr, int fq) const {
        const int sec = u.pn >> 2; const float wsv = *wsc;
        bf16_t* sb = base + (size_t)sec * SEC_ELEMS;
        const float sc = (sec == 4) ? SCALE * LOG2E : 1.f;
        if (sec < 2) {
#pragma unroll
            for (int ai = 0; ai < 2; ++ai)
#pragma unroll
                for (int m = 0; m < 4; ++m) {
                    const int tk = u.pm * BM + ai * HALF + wr * 64 + m * 16 + fr;
                    const float rs = sxn[tk] * wsv;
#pragma unroll
                    for (int bj = 0; bj < 2; ++bj) {
                        const f32x4 v0 = __builtin_convertvector(acci[ai][bj][m][0], f32x4) * rs, v1 = __builtin_convertvector(acci[ai][bj][m][1], f32x4) * rs;
                        float ss = v0[0] * v0[0] + v0[1] * v0[1] + v0[2] * v0[2] + v0[3] * v0[3] + v1[0] * v1[0] + v1[1] * v1[1] + v1[2] * v1[2] + v1[3] * v1[3];
                        ss += sx_f(ss, 16); ss += sx_f(ss, 32);
                        if (fq == 0) xch[(((((wr * 2 + ai) * 4 + m) * 16 + fr) * 2 + bj) * 4) + wc] = ss;
                    }
                }
            asm volatile("s_waitcnt lgkmcnt(0)" ::: "memory");
            __builtin_amdgcn_s_barrier();
            const float* gp = (sec == 0 ? gq : gk) + wc * 32 + 8 * fq;
            const f32x4 g0 = *(const f32x4*)gp, g1 = *(const f32x4*)(gp + 4);
#pragma unroll
            for (int ai = 0; ai < 2; ++ai)
#pragma unroll
                for (int m = 0; m < 4; ++m) {
                    const int tk = u.pm * BM + ai * HALF + wr * 64 + m * 16 + fr, b = tk >> 12, s = tk & 4095;
                    const float rs = sxn[tk] * wsv;
#pragma unroll
                    for (int bj = 0; bj < 2; ++bj) {
                        const int hh = (u.pn & 3) * 2 + bj;
                        const f32x4 p4 = *(const PG8_LAS f32x4*)(xch + (((((wr * 2 + ai) * 4 + m) * 16 + fr) * 2 + bj) * 4));
                        const float r = rs / sqrtf(((p4[0] + p4[1]) + (p4[2] + p4[3])) * (1.f / 128.f) + EPS);
                        const f32x4 v0 = __builtin_convertvector(acci[ai][bj][m][0], f32x4) * r * g0, v1 = __builtin_convertvector(acci[ai][bj][m][1], f32x4) * r * g1;
                        u32x4 w; w.x = cvt_pk_bf16(v0[0], v0[1]); w.y = cvt_pk_bf16(v0[2], v0[3]); w.z = cvt_pk_bf16(v1[0], v1[1]); w.w = cvt_pk_bf16(v1[2], v1[3]);
                        *(u32x4*)(sb + ((size_t)((b * 8 + hh) * 4096 + s)) * 128 + wc * 32 + 8 * fq) = w;
                    }
                }
            return;
        }
#pragma unroll
        for (int ai = 0; ai < 2; ++ai)
#pragma unroll
            for (int m = 0; m < 4; ++m) {
                const int tk = u.pm * BM + ai * HALF + wr * 64 + m * 16 + fr, b = tk >> 12, s = tk & 4095;
                const float rs = sxn[tk] * wsv;
#pragma unroll
                for (int bj = 0; bj < 2; ++bj) {
                    const int hh = (u.pn & 3) * 2 + bj;
                    f32x4 v0 = __builtin_convertvector(acci[ai][bj][m][0], f32x4) * rs, v1 = __builtin_convertvector(acci[ai][bj][m][1], f32x4) * rs;
                    bf16_t* dst;
                    if (sec == 3) {
#pragma unroll
                        for (int i = 0; i < 4; ++i) { v0[i] = sigmoidf_fast(v0[i]); v1[i] = sigmoidf_fast(v1[i]); }
                        dst = sb + (size_t)tk * 1024 + hh * 128 + wc * 32 + 8 * fq;
                    } else {
                        v0 = v0 * sc; v1 = v1 * sc;
                        dst = sb + ((size_t)((b * 8 + hh) * 4096 + s)) * 128 + wc * 32 + 8 * fq;
                    }
                    u32x4 w; w.x = cvt_pk_bf16(v0[0], v0[1]); w.y = cvt_pk_bf16(v0[2], v0[3]); w.z = cvt_pk_bf16(v1[0], v1[1]); w.w = cvt_pk_bf16(v1[2], v1[3]);
                    *(u32x4*)dst = w;
                }
            }
    }
};
struct EpiOutProj {
    static constexpr bool PERM = true;
    const float* x; float* h; bf16_t* hb; float* ssq; float* amx;
    __device__ __forceinline__ void operator()(const f32x4 (&acc)[2][2][4][2], const Unit& u, int wr, int wc, int fr, int fq) const {
#pragma unroll
        for (int ai = 0; ai < 2; ++ai)
#pragma unroll
            for (int m = 0; m < 4; ++m) {
                const int tk = u.pm * BM + ai * HALF + wr * 64 + m * 16 + fr;
                float ss = 0.f, mx = 0.f;
#pragma unroll
                for (int bj = 0; bj < 2; ++bj) {
                    const size_t off = (size_t)tk * DM + u.pn * BM + bj * HALF + wc * 32 + 8 * fq;
                    const f32x4 x0 = *(const f32x4*)(x + off), x1 = *(const f32x4*)(x + off + 4);
                    const f32x4 v0 = acc[ai][bj][m][0] + x0, v1 = acc[ai][bj][m][1] + x1;
                    u32x4 w; w.x = cvt_pk_bf16(v0[0], v0[1]); w.y = cvt_pk_bf16(v0[2], v0[3]); w.z = cvt_pk_bf16(v1[0], v1[1]); w.w = cvt_pk_bf16(v1[2], v1[3]);
                    *(u32x4*)(hb + off) = w;
                    ss += v0[0] * v0[0] + v0[1] * v0[1] + v0[2] * v0[2] + v0[3] * v0[3] + v1[0] * v1[0] + v1[1] * v1[1] + v1[2] * v1[2] + v1[3] * v1[3];
                    mx = fmaxf(mx, fmaxf(fmaxf(fmaxf(fabsf(v0[0]), fabsf(v0[1])), fmaxf(fabsf(v0[2]), fabsf(v0[3]))), fmaxf(fmaxf(fabsf(v1[0]), fabsf(v1[1])), fmaxf(fabsf(v1[2]), fabsf(v1[3])))));
                }
                ss += sx_f(ss, 16); ss += sx_f(ss, 32);
                mx = fmaxf(mx, sx_f(mx, 16)); mx = fmaxf(mx, sx_f(mx, 32));
                if (fq == 0) { ssq[(size_t)tk * 32 + u.pn * 4 + wc] = ss; amx[(size_t)tk * 32 + u.pn * 4 + wc] = mx; }
            }
    }
};
struct EpiPeerQ {
    static constexpr bool PERM = true;
    const float* ssq; bf16_t* qp; float* rtab;
    __device__ __forceinline__ void operator()(const f32x4 (&acc)[2][2][4][2], const Unit& u, int wr, int wc, int fr, int fq) const {
#pragma unroll
        for (int ai = 0; ai < 2; ++ai)
#pragma unroll
            for (int m = 0; m < 4; ++m) {
                const int tk = u.pm * BM + ai * HALF + wr * 64 + m * 16 + fr;
                float tot = 0.f;
#pragma unroll
                for (int i = 0; i < 8; ++i) { const f32x4 s4 = *(const f32x4*)(ssq + (size_t)tk * 32 + 4 * i); tot += (s4[0] + s4[1]) + (s4[2] + s4[3]); }
                const float r = 1.0f / sqrtf(tot * (1.f / DM) + EPS);
                if (u.pn == 0 && wc == 0 && fq == 0) rtab[tk] = r;
#pragma unroll
                for (int bj = 0; bj < 2; ++bj) {
                    const size_t off = (size_t)tk * DM + u.pn * BM + bj * HALF + wc * 32 + 8 * fq;
                    const f32x4 v0 = acc[ai][bj][m][0] * r, v1 = acc[ai][bj][m][1] * r;
                    u32x4 w; w.x = cvt_pk_bf16(v0[0], v0[1]); w.y = cvt_pk_bf16(v0[2], v0[3]); w.z = cvt_pk_bf16(v1[0], v1[1]); w.w = cvt_pk_bf16(v1[2], v1[3]);
                    *(u32x4*)(qp + off) = w;
                }
            }
    }
};
}

namespace att {
constexpr int NW = 8, QBLK = 32, KVBLK = 64, QB = NW * QBLK, D = 128;
constexpr int SHM_V = KVBLK * D * 2, SHM_K = KVBLK * D * 2;
constexpr int OFF_WS = 2 * SHM_V + 2 * SHM_K, OFF_BIAS = OFF_WS + NW * 64 * 4, ATT_LDS = OFF_BIAS + SEQ * 4;
#define KSWZ(row, colB) ((row) * 256 + ((colB) ^ (((row) & 7) << 4)))
#define SBAR() __builtin_amdgcn_sched_barrier(0)
__device__ __forceinline__ int v_st(int k, int c) { const int kk = (k & ~0xC) | ((k & 4) << 1) | ((k & 8) >> 1); return ((kk >> 3) * 4 + (c >> 5)) * 512 + ((kk & 7) * 32 + (c & 31)) * 2; }
__device__ __forceinline__ int v_rd_base(int lane) { return ((lane & 3) << 3) | (((lane >> 2) & 3) << 6) | (((lane >> 4) & 1) << 5) | (((lane >> 5) & 1) << 8); }
constexpr int v_rd_off(int d0, int ks, int half) { return d0 * 512 + ks * 4096 + half * 2048; }
__device__ __forceinline__ int crow(int r, int hi) { return (r & 3) + 8 * (r >> 2) + 4 * hi; }
__device__ __forceinline__ bf16x8 load8(const bf16_t* p) { return *reinterpret_cast<const bf16x8*>(p); }
__device__ __forceinline__ void mask_tile(f32x16& p0, f32x16& p1, int dq) {
    const float NEG = -__builtin_inff();
#pragma unroll
    for (int r = 0; r < 16; ++r) {
        const int c = (r & 3) + 8 * (r >> 2);
        if (dq - c < 0) p0[r] = NEG;
        if (dq - c - 32 < 0) p1[r] = NEG;
    }
}
__device__ __forceinline__ void partialSM(f32x16& p0, f32x16& p1, float& m_reg, float& mn, float& alpha) {
    float pmax = p0[0];
#pragma unroll
    for (int r = 1; r < 16; ++r) pmax = fmaxf(pmax, p0[r]);
#pragma unroll
    for (int r = 0; r < 16; ++r) pmax = fmaxf(pmax, p1[r]);
    { auto rr = __builtin_amdgcn_permlane32_swap(__float_as_uint(pmax), __float_as_uint(pmax), false, false);
      pmax = fmaxf(__uint_as_float(rr[0]), __uint_as_float(rr[1])); }
    constexpr float C2 = LOG2E * SCALE; constexpr float THR = 8.f;
    if (__builtin_expect(__all((pmax - m_reg) * SCALE <= THR), 1)) { mn = m_reg; alpha = 1.f; }
    else { mn = fmaxf(m_reg, pmax); alpha = __builtin_amdgcn_exp2f((m_reg - mn) * C2); m_reg = mn; }
    const float mnL = -mn * C2;
#pragma unroll
    for (int r = 0; r < 16; ++r) p0[r] = fmaf(p0[r], C2, mnL);
#pragma unroll
    for (int r = 0; r < 16; ++r) p1[r] = fmaf(p1[r], C2, mnL);
#pragma unroll
    for (int r = 0; r < 16; ++r) p0[r] = __builtin_amdgcn_exp2f(p0[r]);
}
#define PK4(P, B_, OUT) do { unsigned a0 = cvt_pk_bf16(P[B_+0], P[B_+1]), a1 = cvt_pk_bf16(P[B_+2], P[B_+3]);                          \
        unsigned b0 = cvt_pk_bf16(P[B_+4], P[B_+5]), b1 = cvt_pk_bf16(P[B_+6], P[B_+7]);                                             \
        auto r0 = __builtin_amdgcn_permlane32_swap(a0, b0, false, false); auto r1 = __builtin_amdgcn_permlane32_swap(a1, b1, false, false); \
        u32x4 w = {r0[0], r1[0], r0[1], r1[1]}; OUT = *reinterpret_cast<bf16x8*>(&w); } while (0)
__device__ __forceinline__ void finishSM(f32x16& p0, f32x16& p1, float alpha, float& l_reg, bf16x8& pa0, bf16x8& pa1, bf16x8& pa2, bf16x8& pa3) {
#pragma unroll
    for (int r = 0; r < 16; ++r) p1[r] = __builtin_amdgcn_exp2f(p1[r]);
    float ps = 0;
#pragma unroll
    for (int r = 0; r < 16; ++r) ps += p0[r];
#pragma unroll
    for (int r = 0; r < 16; ++r) ps += p1[r];
    { auto rr = __builtin_amdgcn_permlane32_swap(__float_as_uint(ps), __float_as_uint(ps), false, false);
      ps = __uint_as_float(rr[0]) + __uint_as_float(rr[1]); }
    l_reg = l_reg * alpha + ps;
    PK4(p0, 0, pa0); PK4(p0, 8, pa1); PK4(p1, 0, pa2); PK4(p1, 8, pa3);
}
__device__ __forceinline__ void sb_group(f32x16& P, int g, float& gs) {
    float run = 0.f;
#pragma unroll
    for (int k = 3; k >= 0; --k) {
        const float z = P[4 * g + k];
        const float t = __builtin_amdgcn_exp2f(-fabsf(z));
        const float l = __builtin_amdgcn_logf(1.f + t);
        const float sp = fmaxf(z, 0.f) + l;
        P[4 * g + k] = (z - sp) - run;
        run += sp;
    }
    gs = run;
}
__device__ __forceinline__ void sb_part1(f32x16& p0, f32x16& p1, float& carry, float mlo) {
    float gs[8];
#pragma unroll
    for (int g = 0; g < 4; ++g) sb_group(p0, g, gs[g]);
#pragma unroll
    for (int g = 0; g < 4; ++g) sb_group(p1, g, gs[4 + g]);
    float run = carry;
#pragma unroll
    for (int G = 7; G >= 0; --G) {
        auto rr = __builtin_amdgcn_permlane32_swap(__float_as_uint(gs[G]), __float_as_uint(gs[G]), false, false);
        const float slo = __uint_as_float(rr[0]), shi = __uint_as_float(rr[1]);
        const float base = fmaf(mlo, shi, run);
        if (G >= 4) {
#pragma unroll
            for (int k = 0; k < 4; ++k) p1[4 * (G - 4) + k] -= base;
        } else {
#pragma unroll
            for (int k = 0; k < 4; ++k) p0[4 * G + k] -= base;
        }
        run += slo + shi;
    }
    carry = run;
#pragma unroll
    for (int r = 0; r < 16; ++r) p0[r] = __builtin_amdgcn_exp2f(p0[r]);
}
__device__ __forceinline__ void sb_part2(f32x16& p0, f32x16& p1, bf16x8& pa0, bf16x8& pa1, bf16x8& pa2, bf16x8& pa3) {
#pragma unroll
    for (int r = 0; r < 16; ++r) p1[r] = __builtin_amdgcn_exp2f(p1[r]);
    PK4(p0, 0, pa0); PK4(p0, 8, pa1); PK4(p1, 0, pa2); PK4(p1, 8, pa3);
}
#undef PK4
template <int KB, bool BIAS>
__device__ __forceinline__ void qkt(f32x16& p0, f32x16& p1, const char* K_lds, int r32, int hi, const bf16x8* qr, const float* bt) {
    if constexpr (BIAS) {
#pragma unroll
        for (int g = 0; g < 4; ++g) { const f32x4 a = *(const f32x4*)(bt + 8 * g), b = *(const f32x4*)(bt + 32 + 8 * g);
            p0[4 * g] = a[0]; p0[4 * g + 1] = a[1]; p0[4 * g + 2] = a[2]; p0[4 * g + 3] = a[3];
            p1[4 * g] = b[0]; p1[4 * g + 1] = b[1]; p1[4 * g + 2] = b[2]; p1[4 * g + 3] = b[3]; }
    } else { p0 = f32x16{}; p1 = f32x16{}; }
    const char* kb[4];
#pragma unroll
    for (int dd = 0; dd < 4; ++dd) kb[dd] = K_lds + KB * SHM_K + KSWZ(r32, (dd * 16 + hi * 8) * 2);
#pragma unroll
    for (int d0 = 0; d0 < 8; ++d0) { const char* a = kb[d0 & 3] + (d0 >> 2) * 128;
        bf16x8 b0 = *reinterpret_cast<const bf16x8*>(a);
        bf16x8 b1 = *reinterpret_cast<const bf16x8*>(a + 32 * 256);
        p0 = __builtin_amdgcn_mfma_f32_32x32x16_bf16(b0, qr[d0], p0, 0, 0, 0);
        p1 = __builtin_amdgcn_mfma_f32_32x32x16_bf16(b1, qr[d0], p1, 0, 0, 0); }
}
template <int VB>
__device__ __forceinline__ void pv_tile(f32x16* o, int vb0, bf16x8 pa0, bf16x8 pa1, bf16x8 pa2, bf16x8 pa3) {
#define TRRD(dst, off) asm volatile("ds_read_b64_tr_b16 %0, %1 offset:%2" : "=&v"(dst) : "v"(vb0), "i"(off) : "memory")
#define PV_D0(d0) do { { s16x4 l0, l1, h0, h1; constexpr int b_ = VB * SHM_V + v_rd_off(d0, 0, 0); \
        TRRD(l0, b_); TRRD(h0, b_ + 2048); TRRD(l1, b_ + 4096); TRRD(h1, b_ + 6144); \
        asm volatile("s_waitcnt lgkmcnt(0)" ::: "memory"); SBAR();   \
        o[d0] = __builtin_amdgcn_mfma_f32_32x32x16_bf16(pa0, (bf16x8){l0[0], l0[1], l0[2], l0[3], h0[0], h0[1], h0[2], h0[3]}, o[d0], 0, 0, 0);   \
        o[d0] = __builtin_amdgcn_mfma_f32_32x32x16_bf16(pa1, (bf16x8){l1[0], l1[1], l1[2], l1[3], h1[0], h1[1], h1[2], h1[3]}, o[d0], 0, 0, 0); }  \
      { s16x4 l2, l3, h2, h3; constexpr int b_ = VB * SHM_V + v_rd_off(d0, 0, 0); \
        TRRD(l2, b_ + 8192); TRRD(h2, b_ + 10240); TRRD(l3, b_ + 12288); TRRD(h3, b_ + 14336); \
        asm volatile("s_waitcnt lgkmcnt(0)" ::: "memory"); SBAR();   \
        o[d0] = __builtin_amdgcn_mfma_f32_32x32x16_bf16(pa2, (bf16x8){l2[0], l2[1], l2[2], l2[3], h2[0], h2[1], h2[2], h2[3]}, o[d0], 0, 0, 0);   \
        o[d0] = __builtin_amdgcn_mfma_f32_32x32x16_bf16(pa3, (bf16x8){l3[0], l3[1], l3[2], l3[3], h3[0], h3[1], h3[2], h3[3]}, o[d0], 0, 0, 0); } } while (0)
    PV_D0(0); PV_D0(1); PV_D0(2); PV_D0(3);
#undef PV_D0
#undef TRRD
}

struct UnitRef { const bf16_t* Q; const bf16_t* K; const bf16_t* V; int P0; };
struct Seam { bf16x8 qr[8]; bf16x8 st_v0, st_v1, st_k0, st_k1; };
#define ROW(p, k0, rr) ((p) + (size_t)((k0) + (rr)) * D + sc)
#define VMW() asm volatile("s_waitcnt vmcnt(0)" ::: "memory")
#define SLOAD_H(Kp, Vp, k0) do { S.st_v0 = load8(ROW(Vp, k0, sr)); S.st_v1 = load8(ROW(Vp, k0, 32 + sr));              \
                         S.st_k0 = load8(ROW(Kp, k0, sr)); S.st_k1 = load8(ROW(Kp, k0, 32 + sr)); } while (0)
#define SWRITE_HK(bf) do { *(bf16x8*)(K_lds + (bf) * SHM_K + kws) = S.st_k0; *(bf16x8*)(K_lds + (bf) * SHM_K + kws + 32 * 256) = S.st_k1; } while (0)
#define SWRITE_HV(bf) do { *(bf16x8*)(V_lds + (bf) * SHM_V + vst0) = S.st_v0; *(bf16x8*)(V_lds + (bf) * SHM_V + vst1) = S.st_v1; } while (0)
#define SWRITE_H(bf) do { SWRITE_HV(bf); SWRITE_HK(bf); } while (0)

template <bool SB>
__device__ __forceinline__ void attn_unit(const UnitRef& cur, unsigned char* wsu  , int bh, char* lds,
                                          int part  ) {
    const float* cvec; const float* gqk;
    { unsigned char* w_ = wsu; asm volatile("" : "+s"(w_)); cvec = (const float*)(w_ + WS_C) + (size_t)bh * SEQ; gqk = (const float*)(w_ + WS_GQK); }
    const int tid = tid_opaque(), wid = __builtin_amdgcn_readfirstlane(tid >> 6), lane = tid & 63, r32 = lane & 31, hi = lane >> 5;
    int jlo = 0;
    if constexpr (!SB) {
        const float gq = fmaxf(fabsf(gqk[lane]), fabsf(gqk[64 + lane])), gk = fmaxf(fabsf(gqk[128 + lane]), fabsf(gqk[192 + lane]));
        const float lmax = 11.3137085f * 1.02f * wave_max(gq) * wave_max(gk);
        const int ntf = (cur.P0 + QB) / KVBLK;
        const float cend = (lane < ntf) ? cvec[lane * KVBLK + KVBLK - 1] : 0.f;
        const bool skip = (lane < ntf) && (2.f * lmax + cvec[cur.P0] - cend < -104.f);
        jlo = __builtin_amdgcn_readfirstlane((int)__popcll(__ballot(skip)));
    }
    const int ntot = (cur.P0 + QB) / KVBLK - jlo;
    const int tb = (part == 2) ? (ntot >> 1) : 0, te = (part == 1) ? (ntot >> 1) : ntot;
    const int kshift = (jlo + tb) * KVBLK, P0r = cur.P0 - kshift;
    const int NT = te - tb;
#define KBASE(t) ((SB ? (NT - 1 - (t)) : (t)) * KVBLK)
    const int qlo = P0r + wid * QBLK, qm = qlo + r32 - 4 * hi - (SB ? 1 : 0);
    char* V_lds = lds; char* K_lds = lds + 2 * SHM_V;
    float* ws = (float*)(lds + OFF_WS) + wid * 64; float* li_l = ws, * al_l = ws + 32;
    float* bias = (float*)(lds + OFF_BIAS);
    const int sr = tid >> 4, sc = (tid & 15) * 8, vst0 = v_st(sr, sc), vst1 = v_st(32 + sr, sc), kws = KSWZ(sr, sc * 2);
    const int vb0 = (int)(uintptr_t)V_lds + v_rd_base(lane);
    const bf16_t* Kh = cur.K + (size_t)kshift * D; const bf16_t* Vh = cur.V + (size_t)kshift * D;
    Seam S;
    if constexpr (!SB) { const float cq0 = cvec[cur.P0]; const float* cv = cvec + kshift; for (int j = tid; j < NT * KVBLK; j += NTHREADS) bias[j] = (cq0 - cv[j]) * (1.f / SCALE); }
#pragma unroll
    for (int d0 = 0; d0 < 8; ++d0) S.qr[d0] = load8(cur.Q + (size_t)(wid * QBLK + r32) * D + d0 * 16 + hi * 8);
    SLOAD_H(Kh, Vh, KBASE(0)); VMW(); SWRITE_HK(0);
    __syncthreads();
    float m_reg = -1e30f, l_reg = 0; f32x16 o[4] = {};
    float carry = 0.f; const float mlo = hi ? 0.f : 1.f;
#define RESC(a) do { if (__any((a) < 1.f)) { if (hi == 0) al_l[r32] = (a); asm volatile("s_waitcnt lgkmcnt(0)" ::: "memory");              \
                     for (int d_ = 0; d_ < 4; ++d_) for (int r = 0; r < 16; ++r) o[d_][r] *= al_l[crow(r, hi)]; } } while (0)
#define MASKT(P0_, P1_, t) do { const int kb_ = KBASE(t); if (kb_ + KVBLK - 1 > qlo - (SB ? 1 : 0)) mask_tile(P0_, P1_, qm - kb_); } while (0)
#define BT(t) (bias + KBASE(t) + 4 * hi)
#define PART1(PX0, PX1, mnX, alX) do { if constexpr (SB) sb_part1(PX0, PX1, carry, mlo); else partialSM(PX0, PX1, m_reg, mnX, alX); } while (0)
#define PART2(PY0, PY1, alY) do { if constexpr (SB) sb_part2(PY0, PY1, pa0, pa1, pa2, pa3); else finishSM(PY0, PY1, alY, l_reg, pa0, pa1, pa2, pa3); } while (0)
    f32x16 pA0, pA1, pB0, pB1; float mnA = 0.f, mnB = 0.f, alA = 1.f, alB = 1.f; bf16x8 pa0, pa1, pa2, pa3;
    SWRITE_HV(0); SBAR();
    if (NT > 1) SLOAD_H(Kh, Vh, KBASE(1));
    SBAR(); qkt<0, !SB>(pA0, pA1, K_lds, r32, hi, S.qr, BT(0));
    MASKT(pA0, pA1, 0); PART1(pA0, pA1, mnA, alA);
    if (NT > 1) { VMW(); SWRITE_H(1); }
    __syncthreads();
#define HALF_STEP(PX0, PX1, mnX, alX, PY0, PY1, alY, t, KB, VB, SBUF) do {                                                    \
        SBAR(); qkt<KB, !SB>(PX0, PX1, K_lds, r32, hi, S.qr, BT(t));                                                          \
        PART2(PY0, PY1, alY); SBAR();                                                                                          \
        if ((t) + 1 < NT) { SLOAD_H(Kh, Vh, KBASE((t) + 1)); SBAR(); }                                                         \
        pv_tile<VB>(o, vb0, pa0, pa1, pa2, pa3); MASKT(PX0, PX1, (t)); PART1(PX0, PX1, mnX, alX);                              \
        __syncthreads();                                                                                                      \
        if ((t) + 1 < NT) { VMW(); SWRITE_H(SBUF); }                                                                           \
        if constexpr (!SB) RESC(alX);                                                                                          \
        __syncthreads(); } while (0)
    for (int t = 1; t + 1 < NT; t += 2) {
        HALF_STEP(pB0, pB1, mnB, alB, pA0, pA1, alA, t, 1, 0, 0);
        HALF_STEP(pA0, pA1, mnA, alA, pB0, pB1, alB, t + 1, 0, 1, 1);
    }
    const bool even = (NT & 1) == 0;
    if (even) { SBAR(); qkt<1, !SB>(pB0, pB1, K_lds, r32, hi, S.qr, BT(NT - 1)); SBAR(); }
    PART2(pA0, pA1, alA); SBAR();
    pv_tile<0>(o, vb0, pa0, pa1, pa2, pa3);
    if (even) { MASKT(pB0, pB1, NT - 1); PART1(pB0, pB1, mnB, alB); __syncthreads(); if constexpr (!SB) RESC(alB);
        PART2(pB0, pB1, alB); SBAR(); pv_tile<1>(o, vb0, pa0, pa1, pa2, pa3); }
    unsigned char* we_ = wsu; asm volatile("" : "+s"(we_));
    if (part != 0) {
        const int slot2 = ((((cur.P0 >> 8) - 8) & 7) * 16 + bh) * 2 + (part == 2 ? 1 : 0);
        float* po = (float*)(we_ + WS_PO) + (size_t)slot2 * 256 * 128; float* pml = (float*)(we_ + WS_PML) + (size_t)slot2 * 512;
        if (hi == 0) { pml[(wid * QBLK + r32) * 2] = m_reg; pml[(wid * QBLK + r32) * 2 + 1] = l_reg; }
#pragma unroll
        for (int r = 0; r < 16; ++r)
#pragma unroll
            for (int d0 = 0; d0 < 4; ++d0) po[(size_t)(wid * QBLK + crow(r, hi)) * D + d0 * 32 + r32] = o[d0][r];
        __syncthreads();
        return;
    }
    const bf16_t* gate = (const bf16_t*)(we_ + WS_SEC) + 3 * SEC_ELEMS + (size_t)(bh >> 3) * SEQ * 1024 + (bh & 7) * HD;
    bf16_t* outp = (bf16_t*)(we_ + WS_MIX) + (size_t)(bh >> 3) * SEQ * DM + (bh & 7) * HD;
    float rli[16];
    if constexpr (!SB) {
        if (hi == 0) li_l[r32] = l_reg; asm volatile("s_waitcnt lgkmcnt(0)" ::: "memory");
#pragma unroll
        for (int r = 0; r < 16; ++r) rli[r] = __builtin_amdgcn_rcpf(li_l[crow(r, hi)]);
    }
#pragma unroll
    for (int r = 0; r < 16; ++r) { const int orow = cur.P0 + wid * QBLK + crow(r, hi);
#pragma unroll
        for (int d0 = 0; d0 < 4; ++d0) {
            float v = o[d0][r];
            if constexpr (!SB) { const unsigned short gb = gate[(size_t)orow * 1024 + d0 * 32 + r32]; v = v * rli[r] * __builtin_bit_cast(float, (unsigned)gb << 16); }
            const float vn = sx_f(v, 1);
            if ((r32 & 1) == 0) *(unsigned*)(outp + (size_t)orow * DM + d0 * 32 + r32) = cvt_pk_bf16(v, vn); } }
    __syncthreads();
#undef RESC
#undef KBASE
#undef MASKT
#undef BT
#undef PART1
#undef PART2
#undef HALF_STEP
}

constexpr float SB_TH = 150.f;
__device__ __forceinline__ void sb_unit(const UnitRef& cur, bf16_t* outp, char* lds) {
    const int tid = tid_opaque(), wid = __builtin_amdgcn_readfirstlane(tid >> 6), lane = tid & 63, r32 = lane & 31, hi = lane >> 5;
    const int NT = (cur.P0 + QB) / KVBLK;
#define KBASE(t) ((NT - 1 - (t)) * KVBLK)
    const int qlo = cur.P0 + wid * QBLK, qm = qlo + r32 - 4 * hi - 1;
    char* V_lds = lds; char* K_lds = lds + 2 * SHM_V;
    volatile int* flags = (volatile int*)(lds + OFF_WS);
    const int sr = tid >> 4, sc = (tid & 15) * 8, vst0 = v_st(sr, sc), vst1 = v_st(32 + sr, sc), kws = KSWZ(sr, sc * 2);
    const int vb0 = (int)(uintptr_t)V_lds + v_rd_base(lane);
    const bf16_t* Kh = cur.K; const bf16_t* Vh = cur.V;
    Seam S;
#pragma unroll
    for (int d0 = 0; d0 < 8; ++d0) S.qr[d0] = load8(cur.Q + (size_t)(wid * QBLK + r32) * D + d0 * 16 + hi * 8);
    SLOAD_H(Kh, Vh, KBASE(0)); VMW(); SWRITE_H(0);
    __syncthreads();
    f32x16 o[4] = {}; float carry = 0.f; const float mlo = hi ? 0.f : 1.f;
    bool wdone = false;
#define SB_STEP(tt, BUF) {                                                                                                 \
        const int kb_ = KBASE(tt);                                                                                           \
        if ((tt) + 1 < NT) SLOAD_H(Kh, Vh, KBASE((tt) + 1));                                                                 \
        SBAR();                                                                                                              \
        if (!wdone && kb_ <= qlo + QBLK - 2) {                                                                               \
            f32x16 p0, p1; bf16x8 pa0, pa1, pa2, pa3;                                                                        \
            qkt<BUF, false>(p0, p1, K_lds, r32, hi, S.qr, nullptr);                                                          \
            if (kb_ + KVBLK - 1 > qlo - 1) mask_tile(p0, p1, qm - kb_);                                                      \
            sb_part1(p0, p1, carry, mlo); sb_part2(p0, p1, pa0, pa1, pa2, pa3); SBAR();                                      \
            pv_tile<BUF>(o, vb0, pa0, pa1, pa2, pa3);                                                                        \
            wdone = __all(carry >= SB_TH);                                                                                   \
        }                                                                                                                    \
        if ((tt) + 1 < NT) { VMW(); SWRITE_H((BUF) ^ 1); }                                                                   \
        if (lane == 0) flags[((tt) & 1) * 8 + wid] = wdone ? 1 : 0;                                                          \
        __syncthreads();                                                                                                     \
        { int alld = 1;                                                                                                      \
          _Pragma("unroll") for (int w_ = 0; w_ < 8; ++w_) alld &= flags[((tt) & 1) * 8 + w_];                                \
          if (alld) break; } }
    for (int t = 0; t < NT; t += 2) {
        SB_STEP(t, 0)
        SB_STEP(t + 1, 1)
    }
#undef SB_STEP
#pragma unroll
    for (int r = 0; r < 16; ++r) { const int orow = cur.P0 + wid * QBLK + crow(r, hi);
#pragma unroll
        for (int d0 = 0; d0 < 4; ++d0) {
            const float v = o[d0][r];
            const float vn = sx_f(v, 1);
            if ((r32 & 1) == 0) *(unsigned*)(outp + (size_t)orow * DM + d0 * 32 + r32) = cvt_pk_bf16(v, vn); } }
    __syncthreads();
#undef KBASE
}
#undef ROW
#undef VMW
#undef SLOAD_H
#undef SWRITE_HK
#undef SWRITE_HV
#undef SWRITE_H
}

#define XB_TMO      128
#define XB_XCNT(j)  (256  + 64 * (j))
#define XB_XSUB(j)  (1280 + 64 * (j))
#define XB_XGEN(j)  (2304 + 64 * (j))
#define XB_TOP      3328
#define XB_TOPGEN   3392
#define XCD_BAR_WORDS 3456
#define XB_SPIN_CAP (1u << 20)
__device__ __forceinline__ unsigned xb_ld(unsigned* p)              { return __hip_atomic_load(p, __ATOMIC_RELAXED, __HIP_MEMORY_SCOPE_AGENT); }
__device__ __forceinline__ unsigned xb_add(unsigned* p, unsigned v) { return __hip_atomic_fetch_add(p, v, __ATOMIC_RELAXED, __HIP_MEMORY_SCOPE_AGENT); }
__device__ __forceinline__ unsigned xb_xcc_id() { return (unsigned)__builtin_amdgcn_s_getreg((3 << 11) | 20) & 0xFu; }
#define XB_SPIN(cond, bar) do { unsigned _sp = 0; while (cond) { __builtin_amdgcn_s_sleep(1); \
    if ((++_sp & 255u) == 0u) { if (xb_ld(&(bar)[XB_TMO])) break; if (_sp > XB_SPIN_CAP) { atomicAdd(&(bar)[XB_TMO], 1u); break; } } } } while (0)
struct XcdBarrier { unsigned* bar; unsigned x; volatile LAS unsigned* st; };
__device__ __forceinline__ XcdBarrier xcd_barrier_post(unsigned* bar, volatile LAS unsigned* st) {
    XcdBarrier b; b.bar = bar; b.x = xb_xcc_id(); b.st = st;
    if (threadIdx.x == 0) (void)xb_add(&bar[XB_XCNT(b.x)], 1u);
    return b;
}
__device__ __forceinline__ void xcd_barrier_complete(unsigned* bar, unsigned x, unsigned& nloc, unsigned& nx) {
    const unsigned G = gridDim.x * gridDim.y * gridDim.z;
    unsigned sum, cnt, mine, sp = 0u;
    for (;;) {
        sum = 0u; cnt = 0u; mine = 0u;
#pragma unroll
        for (unsigned j = 0; j < 16; ++j) { const unsigned c = xb_ld(&bar[XB_XCNT(j)]); sum += c; cnt += (c > 0u) ? 1u : 0u; mine = (j == x) ? c : mine; }
        if (sum == G) break;
        __builtin_amdgcn_s_sleep(1);
        if ((++sp & 255u) == 0u) { if (xb_ld(&bar[XB_TMO])) break; if (sp > XB_SPIN_CAP) { atomicAdd(&bar[XB_TMO], 1u); break; } }
    }
    nloc = mine > 0u ? mine : 1u; nx = cnt > 0u ? cnt : 1u;
}
__device__ __forceinline__ void xcd_barrier(const XcdBarrier& b) {
    asm volatile("s_waitcnt vmcnt(0)" ::: "memory");
    __syncthreads();
    if (threadIdx.x == 0) {
        unsigned* bar = b.bar;
        __builtin_amdgcn_s_waitcnt(0);
        unsigned nloc = b.st[0], nx = b.st[1];
        if (nloc == 0u) { xcd_barrier_complete(bar, b.x, nloc, nx); b.st[0] = nloc; b.st[1] = nx; }
        const unsigned old = xb_add(&bar[XB_XSUB(b.x)], 1u);
        const unsigned gen = old / nloc;
        if (old + 1u == (gen + 1u) * nloc) {
            __builtin_amdgcn_fence(__ATOMIC_RELEASE, "agent");
            asm volatile("s_waitcnt vmcnt(0)" ::: "memory");
            const unsigned og = xb_add(&bar[XB_TOP], 1u);
            const unsigned tg = og / nx;
            if (og + 1u == (tg + 1u) * nx) xb_add(&bar[XB_TOPGEN], 1u);
            else XB_SPIN(xb_ld(&bar[XB_TOPGEN]) == tg, bar);
            __builtin_amdgcn_fence(__ATOMIC_ACQUIRE, "agent");
            xb_add(&bar[XB_XGEN(b.x)], 1u);
            asm volatile("s_waitcnt vmcnt(0)" ::: "memory");
        } else {
            XB_SPIN(xb_ld(&bar[XB_XGEN(b.x)]) == gen, bar);
            __builtin_amdgcn_fence(__ATOMIC_ACQUIRE, "agent");
            asm volatile("s_waitcnt vmcnt(0)" ::: "memory");
        }
    }
    __syncthreads();
}

struct Args { const float* in[12]; float* out; unsigned char* ws; int ph_lo, ph_hi; };

__device__ __forceinline__ void p0_transpose_item(const float* W, int ldw, int K, bf16_t* WT, int nblk, LAS float* scr, int item, int lane, const float* gk) {
    const int kb = item / nblk, nb = item % nblk, k0 = 64 * kb, n0 = 32 * nb;
    { const int rr = lane >> 3, c4 = lane & 7; f32x4 v[8];
#pragma unroll
      for (int i = 0; i < 8; ++i) v[i] = *(const f32x4*)(W + (size_t)(k0 + rr + 8 * i) * ldw + n0 + 4 * c4);
#pragma unroll
      for (int i = 0; i < 8; ++i) { const int kk = rr + 8 * i; const float gm = gk ? gk[k0 + kk] : 1.f;
          scr[kk * 33 + 4 * c4] = v[i][0] * gm; scr[kk * 33 + 4 * c4 + 1] = v[i][1] * gm; scr[kk * 33 + 4 * c4 + 2] = v[i][2] * gm; scr[kk * 33 + 4 * c4 + 3] = v[i][3] * gm; } }
    LDS_WAIT(); asm volatile("" ::: "memory");
    const int c = lane & 7;
#pragma unroll
    for (int j = 0; j < 4; ++j) { const int n = (lane >> 3) + 8 * j; const LAS float* s = scr + (8 * c) * 33 + n;
        u32x4 o; o.x = cvt_pk_bf16(s[0 * 33], s[1 * 33]); o.y = cvt_pk_bf16(s[2 * 33], s[3 * 33]); o.z = cvt_pk_bf16(s[4 * 33], s[5 * 33]); o.w = cvt_pk_bf16(s[6 * 33], s[7 * 33]);
        *(u32x4*)(WT + (size_t)(n0 + n) * K + k0 + 8 * c) = o; }
    LDS_WAIT(); asm volatile("" ::: "memory");
}

__device__ __forceinline__ int pack_i8(float a, float b, float c, float d) {
    const int ia = (int)__builtin_rintf(a), ib = (int)__builtin_rintf(b), ic = (int)__builtin_rintf(c), id = (int)__builtin_rintf(d);
    return (int)(((unsigned)ia & 0xffu) | (((unsigned)ib & 0xffu) << 8) | (((unsigned)ic & 0xffu) << 16) | ((unsigned)id << 24));
}
__device__ __forceinline__ void convert_tables(const Args& a, int r0, int r1, int worker, int nworkers) {
    const int lane = tid_opaque() & 63;
    unsigned char* ws = a.ws; const float* g_ffn = a.in[7]; const float* pu = a.in[10]; const float* pv = a.in[11];
    float* suv = (float*)(ws + WS_SUV);
    for (int r = r0 + worker; r < r1; r += nworkers) {
        const bool isv = r >= NEXP; const int e = isv ? r - NEXP : r;
        const f32x4* srcp = (const f32x4*)((isv ? pv : pu) + (size_t)e * DM);
        f32x4 v[8]; float amax = 0.f;
#pragma unroll
        for (int j = 0; j < 8; ++j) { v[j] = srcp[lane + 64 * j];
            if (!isv) { const f32x4 g4 = *(const f32x4*)(g_ffn + 4 * (lane + 64 * j)); v[j] = v[j] * g4; }
            amax = fmaxf(amax, fmaxf(fmaxf(fabsf(v[j][0]), fabsf(v[j][1])), fmaxf(fabsf(v[j][2]), fabsf(v[j][3])))); }
        amax = wave_max(amax);
        const float sc = amax > 0.f ? 127.f / amax : 1.f;
        unsigned char* dst = ws + (isv ? WS_V8 : WS_U8) + (size_t)e * 128;
#pragma unroll
        for (int j = 0; j < 8; ++j) { const int p = pack_i8(v[j][0] * sc, v[j][1] * sc, v[j][2] * sc, v[j][3] * sc);
            const int col = 4 * (lane + 64 * j);
            *(unsigned*)(dst + (size_t)(col >> 7) * ((size_t)NEXP * 128) + (col & 127)) = (unsigned)p; }
        if (lane == 0) suv[r] = 1.f / sc;
    }
}
constexpr int TAB_SPLIT = NEXP;

__device__ __forceinline__ void p0_transpose_item_i8(const float* W, int ldw, int K, unsigned char* WT, int nblk, LAS float* scr, int item, int lane, float q8) {
    const int kb = item / nblk, nb = item % nblk, k0 = 64 * kb, n0 = 32 * nb;
    { const int rr = lane >> 3, c4 = lane & 7; f32x4 v[8];
#pragma unroll
      for (int i = 0; i < 8; ++i) v[i] = *(const f32x4*)(W + (size_t)(k0 + rr + 8 * i) * ldw + n0 + 4 * c4);
#pragma unroll
      for (int i = 0; i < 8; ++i) { const int kk = rr + 8 * i;
          scr[kk * 33 + 4 * c4] = v[i][0] * q8; scr[kk * 33 + 4 * c4 + 1] = v[i][1] * q8; scr[kk * 33 + 4 * c4 + 2] = v[i][2] * q8; scr[kk * 33 + 4 * c4 + 3] = v[i][3] * q8; } }
    LDS_WAIT(); asm volatile("" ::: "memory");
    const int c = lane & 7;
#pragma unroll
    for (int j = 0; j < 4; ++j) { const int n = (lane >> 3) + 8 * j; const LAS float* s = scr + (8 * c) * 33 + n;
        u32x2 o; o.x = (unsigned)pack_i8(s[0 * 33], s[1 * 33], s[2 * 33], s[3 * 33]); o.y = (unsigned)pack_i8(s[4 * 33], s[5 * 33], s[6 * 33], s[7 * 33]);
        *(u32x2*)(WT + (size_t)(n0 + n) * K + k0 + 8 * c) = o; }
    LDS_WAIT(); asm volatile("" ::: "memory");
}
__device__ __forceinline__ float log_sigmoid_f(float x) { return fminf(x, 0.f) - log1pf(expf(-fabsf(x))); }

__device__ __forceinline__ void phase0(const Args& a, unsigned char* lds_g) {
    LAS unsigned char* lds = (LAS unsigned char*)lds_g;
    const int tid = tid_opaque(), lane = tid & 63, wave = __builtin_amdgcn_readfirstlane(tid >> 6);
    const int gw = blockIdx.x * NWAVES + wave, NGW = gridDim.x * NWAVES;
    const int gt = blockIdx.x * NTHREADS + tid, NGT = gridDim.x * NTHREADS;
    unsigned char* ws = a.ws;
    const float* x = a.in[0]; const float* g_attn = a.in[1]; const float* w_in = a.in[2]; const float* b_forget = a.in[3];
    const float* w_out = a.in[6]; const float* g_ffn = a.in[7]; const float* w_pq = a.in[8]; const float* sk = a.in[9]; const float* pu = a.in[10]; const float* pv = a.in[11];
    { float m = 0.f; const f32x4* wp = (const f32x4*)w_in;
      for (size_t i = gt; i < (size_t)DM * DIN / 4; i += NGT) { const f32x4 v = wp[i]; m = fmaxf(m, fmaxf(fmaxf(fabsf(v[0]), fabsf(v[1])), fmaxf(fabsf(v[2]), fabsf(v[3])))); }
      m = wave_max(m);
      if (lane == 0) __hip_atomic_fetch_max((unsigned*)(ws + WS_CTL) + CW_WMAX, __float_as_uint(m), __ATOMIC_RELAXED, __HIP_MEMORY_SCOPE_AGENT); }
    LAS float* wf = (LAS float*)(lds + 67584);
    for (int k = tid; k < DM; k += NTHREADS) { const f32x4 a0 = *(const f32x4*)(w_in + (size_t)k * DIN + NPROJ), a1 = *(const f32x4*)(w_in + (size_t)k * DIN + NPROJ + 4);
        *(LAS f32x4*)(wf + k * 8) = a0; *(LAS f32x4*)(wf + k * 8 + 4) = a1; }
    __syncthreads();
    for (int row = gw; row < T; row += NGW) {
        const f32x4* xr = (const f32x4*)(x + (size_t)row * DM);
        f32x4 v[8]; float ss = 0.f;
#pragma unroll
        for (int j = 0; j < 8; ++j) { v[j] = xr[lane + 64 * j]; ss += v[j][0] * v[j][0] + v[j][1] * v[j][1] + v[j][2] * v[j][2] + v[j][3] * v[j][3]; }
        const float r = 1.0f / sqrtf(wave_sum(ss) * (1.f / DM) + EPS);
        float f[8] = {0.f, 0.f, 0.f, 0.f, 0.f, 0.f, 0.f, 0.f};
        float xmax = 0.f;
#pragma unroll
        for (int j = 0; j < 8; ++j) { const f32x4 g4 = *(const f32x4*)(g_attn + 4 * (lane + 64 * j)); v[j][0] *= r * g4[0]; v[j][1] *= r * g4[1]; v[j][2] *= r * g4[2]; v[j][3] *= r * g4[3];
            xmax = fmaxf(xmax, fmaxf(fmaxf(fabsf(v[j][0]), fabsf(v[j][1])), fmaxf(fabsf(v[j][2]), fabsf(v[j][3])))); }
        xmax = wave_max(xmax);
        const float xq = xmax > 0.f ? 127.f / xmax : 1.f;
        if (lane == 0) ((float*)(ws + WS_SXN))[row] = xmax * (1.f / 127.f);
        unsigned* o8 = (unsigned*)(ws + WS_XN + (size_t)row * DM);
#pragma unroll
        for (int j = 0; j < 8; ++j) {
            const int e = 4 * (lane + 64 * j);
            const f32x4 xn = v[j];
            o8[lane + 64 * j] = (unsigned)pack_i8(xn[0] * xq, xn[1] * xq, xn[2] * xq, xn[3] * xq);
#pragma unroll
            for (int q = 0; q < 4; ++q) { const f32x4 w0 = *(LAS f32x4*)(wf + (e + q) * 8), w1 = *(LAS f32x4*)(wf + (e + q) * 8 + 4);
                f[0] += xn[q] * w0[0]; f[1] += xn[q] * w0[1]; f[2] += xn[q] * w0[2]; f[3] += xn[q] * w0[3];
                f[4] += xn[q] * w1[0]; f[5] += xn[q] * w1[1]; f[6] += xn[q] * w1[2]; f[7] += xn[q] * w1[3]; }
            __builtin_amdgcn_sched_barrier(0);
        }
#pragma unroll
        for (int hh = 0; hh < 8; ++hh) f[hh] = wave_sum(f[hh]);
        if (lane < 8) { float fl = f[0];
#pragma unroll
            for (int hh = 1; hh < 8; ++hh) fl = (lane == hh) ? f[hh] : fl;
            const int b = row >> 12, s = row & 4095;
            ((float*)(ws + WS_LOGF))[(size_t)(b * 8 + lane) * SEQ + s] = log_sigmoid_f(fl + b_forget[lane]); }
    }
    LAS float* scr = (LAS float*)(lds + wave * 8448);
    constexpr int I_IN = (DM / 64) * (NPROJ / 32), I_O = (DM / 64) * (DM / 32);
    for (int it = gw; it < 2 * I_O; it += NGW) {
        int r = it;
        if (r < I_O) { p0_transpose_item(w_out, DM, DM, (bf16_t*)(ws + WS_WOUT), DM / 32, scr, r, lane, nullptr); continue; } r -= I_O;
        p0_transpose_item(w_pq, DM, DM, (bf16_t*)(ws + WS_WPQ), DM / 32, scr, r, lane, g_ffn);
    }
    for (int i = gt; i < 8 * 2 * 128 * 128 / 8; i += NGT) { const f32x4 a0 = *(const f32x4*)(sk + (size_t)i * 8), a1 = *(const f32x4*)(sk + (size_t)i * 8 + 4);
        u32x4 w; w.x = cvt_pk_bf16(a0[0], a0[1]); w.y = cvt_pk_bf16(a0[2], a0[3]); w.z = cvt_pk_bf16(a1[0], a1[1]); w.w = cvt_pk_bf16(a1[2], a1[3]);
        *(u32x4*)(ws + WS_SK + (size_t)i * 16) = w; }
    if (gt < 256) ((float*)(ws + WS_GQK))[gt] = gt < 128 ? a.in[4][gt] : a.in[5][gt - 128];
    convert_tables(a, 0, TAB_SPLIT, gw, NGW);
    { XcdBarrier xb_; xb_.bar = (unsigned*)(ws + WS_CTL) + CW_BAR; xb_.x = xb_xcc_id(); xb_.st = (volatile LAS unsigned*)(lds + MISC_OFF) + 8; xcd_barrier(xb_); }
    const float wmax = __uint_as_float(__hip_atomic_load((unsigned*)(ws + WS_CTL) + CW_WMAX, __ATOMIC_RELAXED, __HIP_MEMORY_SCOPE_AGENT));
    if (gt == 0) *(float*)(ws + WS_WSC) = wmax * (1.f / 127.f);
    const float q8 = wmax > 0.f ? 127.f / wmax : 1.f;
    for (int it = gw; it < I_IN; it += NGW) p0_transpose_item_i8(w_in, DIN, DM, ws + WS_WIN, NPROJ / 32, scr, it, lane, q8);
}

__device__ __forceinline__ void cumsum_rows(const Args& a) {
    const int tid = tid_opaque(), lane = tid & 63, wave = tid >> 6;
    if (blockIdx.x >= 16 || wave != 0) return;
    const float* src = (const float*)(a.ws + WS_LOGF) + (size_t)blockIdx.x * SEQ + lane * 64;
    float* dst = (float*)(a.ws + WS_C) + (size_t)blockIdx.x * SEQ + lane * 64;
    f32x4 v[16]; float run = 0.f;
#pragma unroll
    for (int i = 0; i < 16; ++i) { v[i] = *(const f32x4*)(src + 4 * i);
#pragma unroll
        for (int q = 0; q < 4; ++q) { run += v[i][q]; v[i][q] = run; } }
    float incl = run;
#pragma unroll
    for (int o = 1; o < 64; o <<= 1) { const float t = shup_f(incl, o); if (lane >= o) incl += t; }
    const float off = incl - run;
#pragma unroll
    for (int i = 0; i < 16; ++i) { f32x4 w = v[i]; w[0] += off; w[1] += off; w[2] += off; w[3] += off; *(f32x4*)(dst + 4 * i) = w; }
}

__device__ __forceinline__ void phase_qknorm(const Args& a) {
    const int tid = tid_opaque(), lane = tid & 63, wave = tid >> 6;
    const int gw = blockIdx.x * NWAVES + wave, NGW = gridDim.x * NWAVES;
    const int sub = lane & 15, rw = lane >> 4;
    const float* gq = a.in[4]; const float* gk = a.in[5];
    constexpr int ROWS = NB * NHF * SEQ;
    for (int it = gw; it < 2 * ROWS / 4; it += NGW) {
        const int row = it * 4 + rw; const bool isk = row >= ROWS;
        bf16_t* p = (bf16_t*)(a.ws + WS_SEC) + (size_t)row * HD + sub * 8;
        const float* g = (isk ? gk : gq) + sub * 8;
        const u32x4 w = *(const u32x4*)p;
        float v[8] = {bf_lo(w.x), bf_hi(w.x), bf_lo(w.y), bf_hi(w.y), bf_lo(w.z), bf_hi(w.z), bf_lo(w.w), bf_hi(w.w)};
        float ss = 0.f;
#pragma unroll
        for (int i = 0; i < 8; ++i) ss += v[i] * v[i];
        ss += sx_f(ss, 1); ss += sx_f(ss, 2); ss += sx_f(ss, 4); ss += sx_f(ss, 8);
        const float r = 1.0f / sqrtf(ss * (1.f / HD) + EPS);
        const f32x4 g0 = *(const f32x4*)g, g1 = *(const f32x4*)(g + 4);
        u32x4 o; o.x = cvt_pk_bf16(v[0] * r * g0[0], v[1] * r * g0[1]); o.y = cvt_pk_bf16(v[2] * r * g0[2], v[3] * r * g0[3]);
        o.z = cvt_pk_bf16(v[4] * r * g1[0], v[5] * r * g1[1]); o.w = cvt_pk_bf16(v[6] * r * g1[2], v[7] * r * g1[3]);
        *(u32x4*)p = o;
    }
}

__device__ __forceinline__ void phase_attn(const Args& a, unsigned char* lds_g) {
    const int tid = tid_opaque();
    volatile int* s_item = (volatile int*)(lds_g + MISC_OFF);
    unsigned* ctr = (unsigned*)(a.ws + WS_CTL);
    for (;;) {
        __syncthreads();
        if (tid == 0) *s_item = (int)atomicAdd(ctr, 1u);
        __syncthreads();
        int it = *s_item, kind = -1, qb = 0, sub = 0;
#define CLS(K, Q, CNT) if (kind < 0) { if (it < (CNT)) { kind = (K); qb = (Q); sub = it; } else it -= (CNT); }
        CLS(2, 15, 32) CLS(1, 7, 16) CLS(2, 14, 32) CLS(2, 13, 32) CLS(1, 6, 16) CLS(2, 12, 32) CLS(2, 11, 32) CLS(1, 5, 16) CLS(2, 10, 32) CLS(2, 9, 32) CLS(1, 4, 16) CLS(2, 8, 32) CLS(1, 3, 16) CLS(1, 2, 16)
        if (kind < 0) { if (it < 256) { kind = 0; qb = 15 - (it >> 4); sub = it & 15; } else it -= 256; }
        CLS(1, 1, 16) CLS(1, 0, 16)
#undef CLS
        if (kind < 0) break;
        unsigned char* wsl = a.ws; asm volatile("" : "+s"(wsl));
        bf16_t* sec = (bf16_t*)(wsl + WS_SEC);
        const int bh = sub & 15, part = (kind == 2) ? 1 + (sub >> 4) : 0;
        const int b = bh >> 3, h = bh & 7;
        const size_t hoff = (size_t)bh * SEQ * HD;
        att::UnitRef u;
        u.P0 = qb * 256;
        if (kind == 0) {
            u.Q = sec + 4 * SEC_ELEMS + hoff + (size_t)u.P0 * HD; u.K = sec + 5 * SEC_ELEMS + hoff; u.V = sec + 6 * SEC_ELEMS + hoff;
            att::sb_unit(u, (bf16_t*)(wsl + WS_MIX) + (size_t)b * SEQ * DM + 1024 + h * HD, (char*)lds_g);
        } else {
            u.Q = sec + 0 * SEC_ELEMS + hoff + (size_t)u.P0 * HD; u.K = sec + 1 * SEC_ELEMS + hoff; u.V = sec + 2 * SEC_ELEMS + hoff;
            att::attn_unit<false>(u, wsl, bh, (char*)lds_g, part);
        }
    }
}
__device__ __forceinline__ void phase_attn_combine(const Args& a) {
    const int gt = blockIdx.x * NTHREADS + tid_opaque(), NGT = gridDim.x * NTHREADS;
    const float* po = (const float*)(a.ws + WS_PO); const float* pml = (const float*)(a.ws + WS_PML);
    const bf16_t* gate = (const bf16_t*)(a.ws + WS_SEC) + 3 * SEC_ELEMS; bf16_t* mix = (bf16_t*)(a.ws + WS_MIX);
    constexpr float C2 = LOG2E * SCALE;
    for (int item = gt; item < 128 * 256 * 16; item += NGT) {
        const int slot = item >> 12, row = (item >> 4) & 255, cg = item & 15;
        const int qb = 8 + (slot >> 4), bh = slot & 15, b = bh >> 3, h = bh & 7;
        const f32x2 ml1 = *(const f32x2*)(pml + (size_t)(slot * 2) * 512 + row * 2), ml2 = *(const f32x2*)(pml + (size_t)(slot * 2 + 1) * 512 + row * 2);
        const float M = fmaxf(ml1.x, ml2.x), a1 = __builtin_amdgcn_exp2f((ml1.x - M) * C2), a2 = __builtin_amdgcn_exp2f((ml2.x - M) * C2);
        const float inv = 1.f / (a1 * ml1.y + a2 * ml2.y);
        const float* p1 = po + (size_t)(slot * 2) * 32768 + row * 128 + cg * 8; const float* p2 = p1 + 32768;
        const f32x4 x0 = *(const f32x4*)p1, x1 = *(const f32x4*)(p1 + 4), y0 = *(const f32x4*)p2, y1 = *(const f32x4*)(p2 + 4);
        const size_t tok = (size_t)b * SEQ + qb * 256 + row;
        const u32x4 gw = *(const u32x4*)(gate + tok * 1024 + h * HD + cg * 8);
        const float w1 = a1 * inv, w2 = a2 * inv;
        u32x4 o;
        o.x = cvt_pk_bf16((w1 * x0[0] + w2 * y0[0]) * bf_lo(gw.x), (w1 * x0[1] + w2 * y0[1]) * bf_hi(gw.x));
        o.y = cvt_pk_bf16((w1 * x0[2] + w2 * y0[2]) * bf_lo(gw.y), (w1 * x0[3] + w2 * y0[3]) * bf_hi(gw.y));
        o.z = cvt_pk_bf16((w1 * x1[0] + w2 * y1[0]) * bf_lo(gw.z), (w1 * x1[1] + w2 * y1[1]) * bf_hi(gw.z));
        o.w = cvt_pk_bf16((w1 * x1[2] + w2 * y1[2]) * bf_lo(gw.w), (w1 * x1[3] + w2 * y1[3]) * bf_hi(gw.w));
        *(u32x4*)(mix + tok * DM + h * HD + cg * 8) = o;
    }
}

__device__ __forceinline__ unsigned f2ord(float f) { const unsigned u = __float_as_uint(f); return u ^ ((unsigned)((int)u >> 31) | 0x80000000u); }
__device__ __forceinline__ float ord2f(unsigned k) { const unsigned u = k ^ (~(unsigned)((int)k >> 31) | 0x80000000u); return __uint_as_float(u); }
#define INS16(L, X) do { unsigned x_ = (X); _Pragma("unroll") for (int i_ = 0; i_ < 16; ++i_) { const unsigned hi_ = max(L[i_], x_); x_ = min(L[i_], x_); L[i_] = hi_; } } while (0)
__device__ __forceinline__ void sort16_desc(unsigned (&a)[16]) {
#pragma unroll
    for (int k = 2; k <= 16; k <<= 1)
#pragma unroll
        for (int j = k >> 1; j > 0; j >>= 1)
#pragma unroll
            for (int i = 0; i < 16; ++i) { const int l = i ^ j; if (l > i) { const unsigned hi_ = max(a[i], a[l]), lo_ = min(a[i], a[l]); const bool desc = (i & k) == 0; a[i] = desc ? hi_ : lo_; a[l] = desc ? lo_ : hi_; } }
}
__device__ __forceinline__ void merge_top16(unsigned (&a)[16], const unsigned (&b)[16]) {
#pragma unroll
    for (int i = 0; i < 16; ++i) a[i] = max(a[i], b[15 - i]);
#pragma unroll
    for (int j = 8; j > 0; j >>= 1)
#pragma unroll
        for (int i = 0; i < 16; ++i) { const int l = i ^ j; if (l > i) { const unsigned hi_ = max(a[i], a[l]), lo_ = min(a[i], a[l]); a[i] = hi_; a[l] = lo_; } }
}
__device__ __forceinline__ void topk_half(const bf16_t* qp, const bf16_t* skb, int t0, int h, int c, int r32, int hi, unsigned (&L)[16]) {
    bf16x8 qf[8];
#pragma unroll
    for (int d0 = 0; d0 < 8; ++d0) qf[d0] = *(const bf16x8*)(qp + (size_t)(t0 + r32) * DM + h * 256 + c * 128 + d0 * 16 + hi * 8);
    const unsigned hi4 = 4u * (unsigned)hi;
#pragma unroll
    for (int kt = 0; kt < 4; ++kt) {
        f32x16 acc = f32x16{};
#pragma unroll
        for (int d0 = 0; d0 < 8; ++d0) { const bf16x8 kf = *(const bf16x8*)(skb + (size_t)((h * 2 + c) * 128 + kt * 32 + r32) * 128 + d0 * 16 + hi * 8);
            acc = __builtin_amdgcn_mfma_f32_32x32x16_bf16(kf, qf[d0], acc, 0, 0, 0); }
        __builtin_amdgcn_sched_barrier(0);
        unsigned G[16];
#pragma unroll
        for (int r = 0; r < 16; ++r) { const unsigned cst = (unsigned)(127 - (kt * 32 + (r & 3) + 8 * (r >> 2))); G[r] = (f2ord(acc[r]) & ~127u) | (cst - hi4); }
        sort16_desc(G);
        if (kt == 0) {
#pragma unroll
            for (int i = 0; i < 16; ++i) L[i] = G[i];
        } else merge_top16(L, G);
        __builtin_amdgcn_sched_barrier(0);
    }
    unsigned P[16];
#pragma unroll
    for (int i = 0; i < 16; ++i) { auto rr = __builtin_amdgcn_permlane32_swap(L[i], L[i], false, false); P[i] = hi ? rr[0] : rr[1]; }
    merge_top16(L, P);
}
__device__ __forceinline__ void phase_topk(const Args& a, unsigned char* lds_g) {
    LAS unsigned char* lds = (LAS unsigned char*)lds_g;
    const int tid = tid_opaque(), lane = tid & 63, wave = tid >> 6, r32 = lane & 31, hi = lane >> 5;
    const int gw = blockIdx.x * NWAVES + wave, NGW = gridDim.x * NWAVES;
    const bf16_t* skb = (const bf16_t*)(a.ws + WS_SK); const bf16_t* qp = (const bf16_t*)(a.ws + WS_QP);
    int* idx_o = (int*)(a.ws + WS_IDX); float* gw_o = (float*)(a.ws + WS_GW);
    for (int task = gw; task < (T / 32) * 8; task += NGW) {
        const int h = task & 7, t0 = (task >> 3) * 32;
        {
          const bf16_t* hbp = (const bf16_t*)(a.ws + WS_HB); const float* amx = (const float*)(a.ws + WS_AMX); unsigned char* xq = a.ws + WS_XQ;
          float am = 0.f;
          { const f32x4* ap = (const f32x4*)(amx + (size_t)(t0 + (lane & 31)) * 32);
#pragma unroll
            for (int i = 0; i < 8; ++i) { const f32x4 v = ap[i]; am = fmaxf(am, fmaxf(fmaxf(v[0], v[1]), fmaxf(v[2], v[3]))); } }
          if (h == 0 && lane < 32) ((float*)(a.ws + WS_SX))[t0 + lane] = ((const float*)(a.ws + WS_RT))[t0 + lane] * am * (1.f / 126.5f);
          const float qs = am > 0.f ? 126.5f / am : 1.f;
#pragma unroll 4
          for (int j = 0; j < 16; ++j) { const int ch = lane + 64 * j, tl = ch >> 5, tk = t0 + tl, col = h * 256 + (ch & 31) * 8;
              const u32x4 w = *(const u32x4*)(hbp + (size_t)tk * DM + col); const float r = sh_f(qs, tl);
              const int p0 = pack_i8(bf_lo(w.x) * r, bf_hi(w.x) * r, bf_lo(w.y) * r, bf_hi(w.y) * r), p1 = pack_i8(bf_lo(w.z) * r, bf_hi(w.z) * r, bf_lo(w.w) * r, bf_hi(w.w) * r);
              *(u32x2*)(xq + (size_t)tk * DM + col) = (u32x2){(unsigned)p0, (unsigned)p1}; } }
        unsigned L[2][16];
        topk_half(qp, skb, t0, h, 0, r32, hi, L[0]);
        __builtin_amdgcn_sched_barrier(0);
        topk_half(qp, skb, t0, h, 1, r32, hi, L[1]);
        __builtin_amdgcn_sched_barrier(0);
        float s1[16], s2[16]; int i1[16], i2[16];
#pragma unroll
        for (int i = 0; i < 16; ++i) { s1[i] = ord2f((L[0][i] & ~127u) | 64u); i1[i] = 127 - (int)(L[0][i] & 127u); s2[i] = ord2f((L[1][i] & ~127u) | 64u); i2[i] = 127 - (int)(L[1][i] & 127u); }
        unsigned CG[4][16];
#pragma unroll
        for (int i = 0; i < 64; ++i) CG[i >> 4][i & 15] = 0u;
        CG[0][0] = (f2ord(s1[0] + s2[0]) & ~255u) | 0u;
        CG[0][1] = (f2ord(s1[0] + s2[1]) & ~255u) | 1u;
        CG[0][2] = (f2ord(s1[0] + s2[2]) & ~255u) | 2u;
        CG[0][3] = (f2ord(s1[0] + s2[3]) & ~255u) | 3u;
        CG[0][4] = (f2ord(s1[0] + s2[4]) & ~255u) | 4u;
        CG[0][5] = (f2ord(s1[0] + s2[5]) & ~255u) | 5u;
        CG[0][6] = (f2ord(s1[0] + s2[6]) & ~255u) | 6u;
        CG[0][7] = (f2ord(s1[0] + s2[7]) & ~255u) | 7u;
        CG[0][8] = (f2ord(s1[0] + s2[8]) & ~255u) | 8u;
        CG[0][9] = (f2ord(s1[0] + s2[9]) & ~255u) | 9u;
        CG[0][10] = (f2ord(s1[0] + s2[10]) & ~255u) | 10u;
        CG[0][11] = (f2ord(s1[0] + s2[11]) & ~255u) | 11u;
        CG[0][12] = (f2ord(s1[0] + s2[12]) & ~255u) | 12u;
        CG[0][13] = (f2ord(s1[0] + s2[13]) & ~255u) | 13u;
        CG[0][14] = (f2ord(s1[0] + s2[14]) & ~255u) | 14u;
        CG[0][15] = (f2ord(s1[0] + s2[15]) & ~255u) | 15u;
        CG[1][0] = (f2ord(s1[1] + s2[0]) & ~255u) | 16u;
        CG[1][1] = (f2ord(s1[1] + s2[1]) & ~255u) | 17u;
        CG[1][2] = (f2ord(s1[1] + s2[2]) & ~255u) | 18u;
        CG[1][3] = (f2ord(s1[1] + s2[3]) & ~255u) | 19u;
        CG[1][4] = (f2ord(s1[1] + s2[4]) & ~255u) | 20u;
        CG[1][5] = (f2ord(s1[1] + s2[5]) & ~255u) | 21u;
        CG[1][6] = (f2ord(s1[1] + s2[6]) & ~255u) | 22u;
        CG[1][7] = (f2ord(s1[1] + s2[7]) & ~255u) | 23u;
        CG[1][8] = (f2ord(s1[2] + s2[0]) & ~255u) | 32u;
        CG[1][9] = (f2ord(s1[2] + s2[1]) & ~255u) | 33u;
        CG[1][10] = (f2ord(s1[2] + s2[2]) & ~255u) | 34u;
        CG[1][11] = (f2ord(s1[2] + s2[3]) & ~255u) | 35u;
        CG[1][12] = (f2ord(s1[2] + s2[4]) & ~255u) | 36u;
        CG[1][13] = (f2ord(s1[3] + s2[0]) & ~255u) | 48u;
        CG[1][14] = (f2ord(s1[3] + s2[1]) & ~255u) | 49u;
        CG[1][15] = (f2ord(s1[3] + s2[2]) & ~255u) | 50u;
        CG[2][0] = (f2ord(s1[3] + s2[3]) & ~255u) | 51u;
        CG[2][1] = (f2ord(s1[4] + s2[0]) & ~255u) | 64u;
        CG[2][2] = (f2ord(s1[4] + s2[1]) & ~255u) | 65u;
        CG[2][3] = (f2ord(s1[4] + s2[2]) & ~255u) | 66u;
        CG[2][4] = (f2ord(s1[5] + s2[0]) & ~255u) | 80u;
        CG[2][5] = (f2ord(s1[5] + s2[1]) & ~255u) | 81u;
        CG[2][6] = (f2ord(s1[6] + s2[0]) & ~255u) | 96u;
        CG[2][7] = (f2ord(s1[6] + s2[1]) & ~255u) | 97u;
        CG[2][8] = (f2ord(s1[7] + s2[0]) & ~255u) | 112u;
        CG[2][9] = (f2ord(s1[7] + s2[1]) & ~255u) | 113u;
        CG[2][10] = (f2ord(s1[8] + s2[0]) & ~255u) | 128u;
        CG[2][11] = (f2ord(s1[9] + s2[0]) & ~255u) | 144u;
        CG[2][12] = (f2ord(s1[10] + s2[0]) & ~255u) | 160u;
        CG[2][13] = (f2ord(s1[11] + s2[0]) & ~255u) | 176u;
        CG[2][14] = (f2ord(s1[12] + s2[0]) & ~255u) | 192u;
        CG[2][15] = (f2ord(s1[13] + s2[0]) & ~255u) | 208u;
        CG[3][0] = (f2ord(s1[14] + s2[0]) & ~255u) | 224u;
        CG[3][1] = (f2ord(s1[15] + s2[0]) & ~255u) | 240u;
        sort16_desc(CG[0]); sort16_desc(CG[1]); sort16_desc(CG[2]); sort16_desc(CG[3]);
        merge_top16(CG[0], CG[1]); merge_top16(CG[2], CG[3]); merge_top16(CG[0], CG[2]);
        unsigned LC[16];
#pragma unroll
        for (int i = 0; i < 16; ++i) LC[i] = CG[0][i];
        LAS int* tb = (LAS int*)(lds + wave * 8192);
#pragma unroll
        for (int i = 0; i < 16; ++i) { tb[i * 64 + lane] = i1[i]; tb[(16 + i) * 64 + lane] = i2[i]; }
        float LS[16]; int LP[16];
#pragma unroll
        for (int i = 0; i < 16; ++i) { const unsigned cid = LC[i] & 255u; LS[i] = ord2f((LC[i] & ~255u) | 128u);
            LP[i] = tb[(cid >> 4) * 64 + lane] * 128 + tb[(16 + (cid & 15u)) * 64 + lane]; }
        float den = 0.f, e[16];
#pragma unroll
        for (int i = 0; i < 16; ++i) { e[i] = __expf(LS[i] - LS[0]); den += e[i]; }
        const float rden = 1.f / den;
        const size_t ob = (size_t)(t0 + r32) * NE + h * 16;
        if (hi == 0) {
#pragma unroll
            for (int i = 0; i < 4; ++i) *(int4*)(idx_o + ob + 4 * i) = make_int4(LP[4 * i], LP[4 * i + 1], LP[4 * i + 2], LP[4 * i + 3]);
        } else {
#pragma unroll
            for (int i = 0; i < 4; ++i) *(f32x4*)(gw_o + ob + 4 * i) = (f32x4){e[4 * i] * rden, e[4 * i + 1] * rden, e[4 * i + 2] * rden, e[4 * i + 3] * rden};
        }
    }
}


__device__ __forceinline__ void wave_argmax(float& v, int& i) {
#pragma unroll
    for (int o = 1; o < 64; o <<= 1) { const float ov = sx_f(v, o); const int oi = sx_i(i, o); if (ov > v || (ov == v && oi < i)) { v = ov; i = oi; } }
}
__device__ __forceinline__ void phase_topk_ref(const Args& a) {
    const int tid = tid_opaque(), lane = tid & 63, wave = tid >> 6;
    const int gw = blockIdx.x * NWAVES + wave, NGW = gridDim.x * NWAVES;
    const bf16_t* skb = (const bf16_t*)(a.ws + WS_SK); const bf16_t* qp = (const bf16_t*)(a.ws + WS_QP);
    int* idx_o = (int*)(a.ws + WS_IDX); float* gw_o = (float*)(a.ws + WS_GW);
    for (int task = gw; task < T * 8; task += NGW) {
        const int t = task >> 3, h = task & 7;
        float topS[2]; int topI[2];
        for (int c = 0; c < 2; ++c) {
            const bf16_t* q = qp + (size_t)t * DM + h * 256 + c * 128;
            float sc0 = 0.f, sc1 = 0.f;
            const bf16_t* k0 = skb + (size_t)((h * 2 + c) * 128 + lane) * 128; const bf16_t* k1 = k0 + 64 * 128;
            for (int d = 0; d < 128; ++d) { const float qd = __uint_as_float((unsigned)q[d] << 16);
                sc0 += qd * __uint_as_float((unsigned)k0[d] << 16); sc1 += qd * __uint_as_float((unsigned)k1[d] << 16); }
            float ms = 0.f; int mi = 0;
            for (int r = 0; r < 16; ++r) {
                float v; int i; if (sc0 >= sc1) { v = sc0; i = lane; } else { v = sc1; i = lane + 64; }
                wave_argmax(v, i);
                if (lane == r) { ms = v; mi = i; }
                if (i == lane) sc0 = -__builtin_inff();
                if (i == lane + 64) sc1 = -__builtin_inff();
            }
            topS[c] = ms; topI[c] = mi;
        }
        float cs[4]; int ci[4];
#pragma unroll
        for (int j = 0; j < 4; ++j) { const int cidx = lane * 4 + j, aa = cidx >> 4, bb = cidx & 15;
            cs[j] = sh_f(topS[0], aa) + sh_f(topS[1], bb); ci[j] = cidx; }
        float fs = 0.f; int fi = 0;
        for (int r = 0; r < 16; ++r) {
            float v = cs[0]; int i = ci[0];
#pragma unroll
            for (int j = 1; j < 4; ++j) if (cs[j] > v) { v = cs[j]; i = ci[j]; }
            wave_argmax(v, i);
            if (lane == r) { fs = v; fi = i; }
#pragma unroll
            for (int j = 0; j < 4; ++j) if (ci[j] == i) cs[j] = -__builtin_inff();
        }
        const int e1 = sh_i(topI[0], fi >> 4), e2 = sh_i(topI[1], fi & 15);
        const float mx = sh_f(fs, 0);
        float ev = lane < 16 ? __expf(fs - mx) : 0.f;
        const float den = wave_sum(ev);
        if (lane < 16) { idx_o[(size_t)t * NE + h * 16 + lane] = e1 * 128 + e2; gw_o[(size_t)t * NE + h * 16 + lane] = ev / den; }
    }
}

__device__ __forceinline__ void fp8x16_to_f32(const u32x4 q, f32x2 (&o)[8]) {
    o[0] = __builtin_amdgcn_cvt_pk_f32_fp8((int)q.x, false); o[1] = __builtin_amdgcn_cvt_pk_f32_fp8((int)q.x, true);
    o[2] = __builtin_amdgcn_cvt_pk_f32_fp8((int)q.y, false); o[3] = __builtin_amdgcn_cvt_pk_f32_fp8((int)q.y, true);
    o[4] = __builtin_amdgcn_cvt_pk_f32_fp8((int)q.z, false); o[5] = __builtin_amdgcn_cvt_pk_f32_fp8((int)q.z, true);
    o[6] = __builtin_amdgcn_cvt_pk_f32_fp8((int)q.w, false); o[7] = __builtin_amdgcn_cvt_pk_f32_fp8((int)q.w, true);
}
#define HALVE(dst, srcv, n, bitmask) do { const bool up_ = (lane & (bitmask)) != 0; _Pragma("unroll") for (int i_ = 0; i_ < (n); ++i_) { \
        const float keep_ = up_ ? srcv[(n) + i_] : srcv[i_], send_ = up_ ? srcv[i_] : srcv[(n) + i_]; dst[i_] = keep_ + sx_f(send_, (bitmask)); } } while (0)
#define ITEM_T(n) (wv + ((n) % KT) * NWX)
#define ITEM_S(n) (xl + 8 * ((n) / KT))
#define LD_IDX(ID, n) do { const int4* ip_ = (const int4*)(idx_i + (size_t)ITEM_T(n) * NE + g * 16); _Pragma("unroll") for (int i_ = 0; i_ < 4; ++i_) ID[i_] = ip_[i_]; } while (0)
#define LD_ROWS(Q, ID, TAB, n) do { const unsigned char* b_ = (TAB) + (size_t)ITEM_S(n) * ((size_t)NEXP * 128) + c * 16; _Pragma("unroll") for (int i_ = 0; i_ < 4; ++i_) { \
        Q[4 * i_] = *(const u32x4*)(b_ + (size_t)ID[i_].x * 128); Q[4 * i_ + 1] = *(const u32x4*)(b_ + (size_t)ID[i_].y * 128); \
        Q[4 * i_ + 2] = *(const u32x4*)(b_ + (size_t)ID[i_].z * 128); Q[4 * i_ + 3] = *(const u32x4*)(b_ + (size_t)ID[i_].w * 128); } } while (0)
__device__ __forceinline__ int dpp_hmirror(int v) { return __builtin_amdgcn_update_dpp(0, v, 0x141, 0xf, 0xf, true); }
__device__ __forceinline__ int dpp_qxor2(int v) { return __builtin_amdgcn_update_dpp(0, v, 0x4E, 0xf, 0xf, true); }
__device__ __forceinline__ int dpp_qxor1(int v) { return __builtin_amdgcn_update_dpp(0, v, 0xB1, 0xf, 0xf, true); }
__device__ __forceinline__ void phase_peer_u(const Args& a) {
    const int tid = tid_opaque(), lane = tid & 63, wave = tid >> 6, g = lane >> 3, c = lane & 7;
    const int xl = blockIdx.x & 7, wv = (blockIdx.x >> 3) * NWAVES + wave, NWX = (gridDim.x >> 3) * NWAVES, KT = T / NWX, N = 2 * KT;
    const unsigned char* xq = a.ws + WS_XQ; const unsigned char* u8 = a.ws + WS_U8;
    const int* idx_i = (const int*)(a.ws + WS_IDX); bf16_t* part = (bf16_t*)(a.ws + WS_PART);
    const bool up4 = (c & 4) != 0, up2 = (c & 2) != 0, up1 = (c & 1) != 0;
#define LD_X(X, n) do { X = *(const u32x4*)(xq + (size_t)ITEM_T(n) * DM + ITEM_S(n) * 128 + c * 16); } while (0)
#define COMPUTE_U(Q, X, n) do { int p[16]; \
        _Pragma("unroll") for (int i = 0; i < 16; ++i) { int d_ = __builtin_amdgcn_sdot4((int)Q[i].x, (int)X.x, 0, false); d_ = __builtin_amdgcn_sdot4((int)Q[i].y, (int)X.y, d_, false); \
            d_ = __builtin_amdgcn_sdot4((int)Q[i].z, (int)X.z, d_, false); p[i] = __builtin_amdgcn_sdot4((int)Q[i].w, (int)X.w, d_, false); } \
        int p8[8], p4[4], p2[2]; \
        _Pragma("unroll") for (int i = 0; i < 8; ++i) { const int keep_ = up4 ? p[8 + i] : p[i], send_ = up4 ? p[i] : p[8 + i]; p8[i] = keep_ + dpp_hmirror(send_); } \
        _Pragma("unroll") for (int i = 0; i < 4; ++i) { const int keep_ = up2 ? p8[4 + i] : p8[i], send_ = up2 ? p8[i] : p8[4 + i]; p4[i] = keep_ + dpp_qxor2(send_); } \
        _Pragma("unroll") for (int i = 0; i < 2; ++i) { const int keep_ = up1 ? p4[2 + i] : p4[i], send_ = up1 ? p4[i] : p4[2 + i]; p2[i] = keep_ + dpp_qxor1(send_); } \
        *(unsigned*)(part + ((size_t)ITEM_T(n) * 16 + ITEM_S(n)) * NE + 2 * lane) = cvt_pk_bf16((float)p2[0], (float)p2[1]); } while (0)
    int4 IA[4], IB[4]; u32x4 QA[16], QB[16], XA, XB;
    LD_IDX(IA, 0); LD_IDX(IB, 1);
    LD_ROWS(QA, IA, u8, 0); LD_X(XA, 0);
    for (int n = 0; n < N; n += 2) {
        LD_ROWS(QB, IB, u8, n + 1); LD_X(XB, n + 1);
        if (n + 2 < N) LD_IDX(IA, n + 2);
        COMPUTE_U(QA, XA, n);
        if (n + 2 < N) { LD_ROWS(QA, IA, u8, n + 2); LD_X(XA, n + 2); }
        if (n + 3 < N) LD_IDX(IB, n + 3);
        COMPUTE_U(QB, XB, n + 1);
    }
#undef LD_X
#undef COMPUTE_U
}
__device__ __forceinline__ void phase_peer_w(const Args& a) {
    const int gt = blockIdx.x * NTHREADS + tid_opaque(), NGT = gridDim.x * NTHREADS;
    const int* idx_i = (const int*)(a.ws + WS_IDX); const float* gw_i = (const float*)(a.ws + WS_GW); const bf16_t* part = (const bf16_t*)(a.ws + WS_PART);
    const float* suv = (const float*)(a.ws + WS_SUV); const float* sx = (const float*)(a.ws + WS_SX);
    signed char* wq = (signed char*)(a.ws + WS_WQ); float* sw = (float*)(a.ws + WS_SW);
    for (int item = gt; item < T * NE; item += NGT) {
        const int t = item >> 7, e = item & 127;
        float sum = 0.f;
#pragma unroll
        for (int s = 0; s < 16; ++s) sum += __uint_as_float((unsigned)part[((size_t)t * 16 + s) * NE + e] << 16);
        const int ex = idx_i[item];
        const float d = sum * suv[ex] * sx[t];
        const float om = 0.5f * d * (1.f + erff(d * 0.70710678118654752f)) * gw_i[item] * suv[NEXP + ex];
        float mx = fabsf(om);
        mx = fmaxf(mx, sx_f(mx, 1)); mx = fmaxf(mx, sx_f(mx, 2)); mx = fmaxf(mx, sx_f(mx, 4)); mx = fmaxf(mx, sx_f(mx, 8));
        const float qs = mx > 0.f ? 127.f / mx : 1.f;
        wq[item] = (signed char)(int)__builtin_rintf(om * qs);
        if ((e & 15) == 0) sw[t * 8 + (e >> 4)] = mx * (1.f / 127.f);
    }
}
__device__ __forceinline__ void phase_peer_v(const Args& a, float* dst) {
    const int tid = tid_opaque(), lane = tid & 63, wave = tid >> 6, g = lane >> 3, c = lane & 7;
    const int xl = blockIdx.x & 7, wv = (blockIdx.x >> 3) * NWAVES + wave, NWX = (gridDim.x >> 3) * NWAVES, KT = T / NWX, N = 2 * KT;
    const unsigned char* v8 = a.ws + WS_V8;
    const int* idx_i = (const int*)(a.ws + WS_IDX); const unsigned char* wq = a.ws + WS_WQ; const float* sw = (const float*)(a.ws + WS_SW);
    const bf16_t* hsrc = (const bf16_t*)(a.ws + WS_HB);
#define LD_W(W, SWV, n) do { W = *(const u32x4*)(wq + (size_t)ITEM_T(n) * NE + g * 16); SWV = sw[ITEM_T(n) * 8 + g]; } while (0)
#define QUAD(A_, B_, C_, D_, W_, A0, A1, A2, A3) do { \
        const unsigned ablo_ = __builtin_amdgcn_perm(B_, A_, 0x05010400u), abhi_ = __builtin_amdgcn_perm(B_, A_, 0x07030602u); \
        const unsigned cdlo_ = __builtin_amdgcn_perm(D_, C_, 0x05010400u), cdhi_ = __builtin_amdgcn_perm(D_, C_, 0x07030602u); \
        A0 = __builtin_amdgcn_sdot4((int)__builtin_amdgcn_perm(cdlo_, ablo_, 0x05040100u), (int)(W_), A0, false); \
        A1 = __builtin_amdgcn_sdot4((int)__builtin_amdgcn_perm(cdlo_, ablo_, 0x07060302u), (int)(W_), A1, false); \
        A2 = __builtin_amdgcn_sdot4((int)__builtin_amdgcn_perm(cdhi_, abhi_, 0x05040100u), (int)(W_), A2, false); \
        A3 = __builtin_amdgcn_sdot4((int)__builtin_amdgcn_perm(cdhi_, abhi_, 0x07060302u), (int)(W_), A3, false); } while (0)
#define COMPUTE_V(Q, W, SWV, n) do { int ac[16]; _Pragma("unroll") for (int k = 0; k < 16; ++k) ac[k] = 0; \
        _Pragma("unroll") for (int q_ = 0; q_ < 4; ++q_) { const unsigned w_ = q_ == 0 ? W.x : q_ == 1 ? W.y : q_ == 2 ? W.z : W.w; \
            QUAD(Q[4 * q_].x, Q[4 * q_ + 1].x, Q[4 * q_ + 2].x, Q[4 * q_ + 3].x, w_, ac[0], ac[1], ac[2], ac[3]); \
            QUAD(Q[4 * q_].y, Q[4 * q_ + 1].y, Q[4 * q_ + 2].y, Q[4 * q_ + 3].y, w_, ac[4], ac[5], ac[6], ac[7]); \
            QUAD(Q[4 * q_].z, Q[4 * q_ + 1].z, Q[4 * q_ + 2].z, Q[4 * q_ + 3].z, w_, ac[8], ac[9], ac[10], ac[11]); \
            QUAD(Q[4 * q_].w, Q[4 * q_ + 1].w, Q[4 * q_ + 2].w, Q[4 * q_ + 3].w, w_, ac[12], ac[13], ac[14], ac[15]); } \
        float p[16]; _Pragma("unroll") for (int k = 0; k < 16; ++k) p[k] = (float)ac[k] * SWV; \
        float p8[8], p4[4], p2[2]; \
        _Pragma("unroll") for (int i_ = 0; i_ < 8; ++i_) { auto rr_ = __builtin_amdgcn_permlane32_swap(__float_as_uint(p[i_]), __float_as_uint(p[8 + i_]), false, false); p8[i_] = __uint_as_float(rr_[0]) + __uint_as_float(rr_[1]); } \
        _Pragma("unroll") for (int i_ = 0; i_ < 4; ++i_) { auto rr_ = __builtin_amdgcn_permlane16_swap(__float_as_uint(p8[i_]), __float_as_uint(p8[4 + i_]), false, false); p4[i_] = __uint_as_float(rr_[0]) + __uint_as_float(rr_[1]); } \
        HALVE(p2, p4, 2, 8); \
        const size_t o_ = (size_t)ITEM_T(n) * DM + ITEM_S(n) * 128 + c * 16 + 2 * g; \
        const unsigned hv = *(const unsigned*)(hsrc + o_); *(f32x2*)(dst + o_) = (f32x2){bf_lo(hv) + p2[0], bf_hi(hv) + p2[1]}; } while (0)
    int4 IA[4], IB[4]; u32x4 QA[16], QB[16], WA, WB; float SA, SB_;
    LD_IDX(IA, 0); LD_IDX(IB, 1);
    LD_ROWS(QA, IA, v8, 0); LD_W(WA, SA, 0);
    for (int n = 0; n < N; n += 2) {
        LD_ROWS(QB, IB, v8, n + 1); LD_W(WB, SB_, n + 1);
        if (n + 2 < N) LD_IDX(IA, n + 2);
        COMPUTE_V(QA, WA, SA, n);
        if (n + 2 < N) { LD_ROWS(QA, IA, v8, n + 2); LD_W(WA, SA, n + 2); }
        if (n + 3 < N) LD_IDX(IB, n + 3);
        COMPUTE_V(QB, WB, SB_, n + 1);
    }
#undef LD_W
#undef QUAD
#undef COMPUTE_V
}
#undef ITEM_T
#undef ITEM_S
#undef LD_IDX
#undef LD_ROWS
#undef HALVE


constexpr int NPHASE = 11;
#define LOAD_ARGS() do { } while (0)
__global__ void __launch_bounds__(NTHREADS, 2) fwd_kernel(Args a) {
    extern __shared__ __attribute__((aligned(16))) unsigned char lds[];
#if MK_ONE_LAUNCH
    constexpr int lo = 0, hi = NPHASE;
    cg::grid_group grid = cg::this_grid();
    volatile LAS unsigned* misc = (volatile LAS unsigned*)((LAS unsigned char*)lds + MISC_OFF);
    if (threadIdx.x < 16) misc[threadIdx.x] = 0u;
    __syncthreads();
    { LOAD_ARGS(); (void)xcd_barrier_post((unsigned*)(a.ws + WS_CTL) + CW_BAR, misc + 8); }
#ifndef SEAM_CG_MASK
#define SEAM_CG_MASK 0
#endif
#define SEAM(k) do { if (lo <= (k) && (k) + 1 < hi) { if ((SEAM_CG_MASK >> (k)) & 1) grid.sync(); else { LOAD_ARGS(); XcdBarrier xb_; xb_.bar = (unsigned*)(a.ws + WS_CTL) + CW_BAR; xb_.x = xb_xcc_id(); \
        xb_.st = (volatile LAS unsigned*)((LAS unsigned char*)lds + MISC_OFF) + 8; xcd_barrier(xb_); } } } while (0)
#else
    int lo, hi; { LOAD_ARGS(); lo = a.ph_lo; hi = a.ph_hi; }
#define SEAM(k) do { } while (0)
#endif
#define IN(k) (lo <= (k) && (k) < hi)
#ifndef DUP_PHASE
#define DUP_PHASE -1
#endif
    if (IN(0)) { LOAD_ARGS(); phase0(a, lds); if (DUP_PHASE == 0) { __syncthreads(); phase0(a, lds); } SEAM(0); }
    if (IN(1)) { LOAD_ARGS(); unsigned char* ws = a.ws;
        cumsum_rows(a);
        pg8::Gemm g{(const bf16_t*)(ws + WS_XN), (const bf16_t*)(ws + WS_WIN), T, NPROJ, DM}; pg8::StaticOrder S; S.init(T, NPROJ, (int)gridDim.x, (int)blockIdx.x);
        pg8::EpiInProj E{(bf16_t*)(ws + WS_SEC), (const float*)(ws + WS_SXN), (const float*)(ws + WS_WSC), a.in[4], a.in[5], (LAS float*)((LAS unsigned char*)lds + RING_BYTES)};
        for (int rep_ = 0; rep_ < (DUP_PHASE == 1 ? 2 : 1); ++rep_)
        pg8::gemm_phase<pg8::EpiInProj, pg8::StaticOrder, true, true, true>((LAS unsigned char*)lds, g, S, E);
        { const int nwg_ = (T / 256) * (NPROJ / 256), G_ = (int)gridDim.x, rem_ = nwg_ % G_;
          if (rem_ > 0 && (int)blockIdx.x >= rem_) convert_tables(a, TAB_SPLIT, 2 * NEXP, ((int)blockIdx.x - rem_) * NWAVES + (tid_opaque() >> 6), (G_ - rem_) * NWAVES);
          else if (rem_ == 0) convert_tables(a, TAB_SPLIT, 2 * NEXP, (int)blockIdx.x * NWAVES + (tid_opaque() >> 6), G_ * NWAVES); }
        SEAM(1);
    }
    if (IN(3)) { LOAD_ARGS(); phase_attn(a, lds);
#if MK_ONE_LAUNCH
        if (DUP_PHASE == 3) { XcdBarrier xb_; xb_.bar = (unsigned*)(a.ws + WS_CTL) + CW_BAR; xb_.x = xb_xcc_id(); xb_.st = (volatile LAS unsigned*)((LAS unsigned char*)lds + MISC_OFF) + 8;
            xcd_barrier(xb_); if (blockIdx.x == 0 && threadIdx.x == 0) __hip_atomic_store((unsigned*)(a.ws + WS_CTL), 0u, __ATOMIC_RELAXED, __HIP_MEMORY_SCOPE_AGENT); xcd_barrier(xb_); phase_attn(a, lds); }
#endif
        SEAM(3); }
    if (IN(4)) { LOAD_ARGS(); phase_attn_combine(a); SEAM(4); }
    if (IN(5)) { LOAD_ARGS(); unsigned char* ws = a.ws;
        pg8::Gemm g{(const bf16_t*)(ws + WS_MIX), (const bf16_t*)(ws + WS_WOUT), T, DM, DM}; pg8::StaticOrder S; S.init(T, DM, (int)gridDim.x, (int)blockIdx.x);
        pg8::EpiOutProj E{a.in[0], a.out, (bf16_t*)(ws + WS_HB), (float*)(ws + WS_SSQ), (float*)(ws + WS_AMX)};
        for (int rep_ = 0; rep_ < (DUP_PHASE == 5 ? 2 : 1); ++rep_)
        pg8::gemm_phase<pg8::EpiOutProj, pg8::StaticOrder, true, true>((LAS unsigned char*)lds, g, S, E);
        SEAM(5);
    }
    if (IN(6)) { LOAD_ARGS(); unsigned char* ws = a.ws;
        pg8::Gemm g{(const bf16_t*)(ws + WS_HB), (const bf16_t*)(ws + WS_WPQ), T, DM, DM}; pg8::StaticOrder S; S.init(T, DM, (int)gridDim.x, (int)blockIdx.x);
        pg8::EpiPeerQ E{(const float*)(ws + WS_SSQ), (bf16_t*)(ws + WS_QP), (float*)(ws + WS_RT)};
        for (int rep_ = 0; rep_ < (DUP_PHASE == 6 ? 2 : 1); ++rep_)
        pg8::gemm_phase<pg8::EpiPeerQ, pg8::StaticOrder, true, true>((LAS unsigned char*)lds, g, S, E);
        SEAM(6);
    }
    #ifdef TOPK_REF
    if (IN(7)) { LOAD_ARGS(); phase_topk_ref(a); SEAM(7); }
#else
    if (IN(7)) { LOAD_ARGS(); for (int rep_ = 0; rep_ < (DUP_PHASE == 7 ? 2 : 1); ++rep_) phase_topk(a, lds); SEAM(7); }
#endif
    if (IN(8)) { LOAD_ARGS(); for (int rep_ = 0; rep_ < (DUP_PHASE == 8 ? 2 : 1); ++rep_) phase_peer_u(a); SEAM(8); }
    if (IN(9)) { LOAD_ARGS(); for (int rep_ = 0; rep_ < (DUP_PHASE == 9 ? 2 : 1); ++rep_) phase_peer_w(a); SEAM(9); }
    if (IN(10)) { LOAD_ARGS(); for (int rep_ = 0; rep_ < (DUP_PHASE == 10 ? 2 : 1); ++rep_) phase_peer_v(a, (DUP_PHASE == 10 && rep_ == 0) ? (float*)(a.ws + WS_END) : a.out); }
#undef IN
#undef SEAM
}

extern "C" void kernel_launch(void* const* d_in, const int* in_sizes, int n_in, void* d_out, int out_size, void* d_ws, size_t ws_size, hipStream_t stream) {
    static int grid = 0;
    if (grid == 0) {
        if (n_in != 12 || in_sizes[0] != T * DM || out_size != T * DM || ws_size < WS_END) { fprintf(stderr, "kernel_launch: unexpected shapes (n_in %d, in0 %d, out %d, ws %zu)\n", n_in, n_in > 0 ? in_sizes[0] : -1, out_size, ws_size); grid = -1; return; }
        int dev = 0, cus = 0, per_cu = 0;
        if (hipGetDevice(&dev) != hipSuccess || hipDeviceGetAttribute(&cus, hipDeviceAttributeMultiprocessorCount, dev) != hipSuccess) { grid = -1; return; }
        if (hipFuncSetAttribute((const void*)fwd_kernel, hipFuncAttributeMaxDynamicSharedMemorySize, LDS_BYTES) != hipSuccess) { fprintf(stderr, "kernel_launch: hipFuncSetAttribute failed\n"); grid = -1; return; }
        if (hipOccupancyMaxActiveBlocksPerMultiprocessor(&per_cu, (const void*)fwd_kernel, NTHREADS, LDS_BYTES) != hipSuccess || per_cu < 1) { fprintf(stderr, "kernel_launch: occupancy query says %d\n", per_cu); grid = -1; return; }
        grid = cus;
    }
    if (grid < 0) return;
    (void)hipMemsetAsync((char*)d_ws + WS_CTL, 0, CTL_BYTES, stream);
    Args a{};
    for (int i = 0; i < 12; ++i) a.in[i] = (const float*)d_in[i];
    a.out = (float*)d_out; a.ws = (unsigned char*)d_ws;
#if MK_ONE_LAUNCH
    a.ph_lo = 0; a.ph_hi = NPHASE;
    void* args[] = {&a};
#if MK_COOP_LAUNCH
    hipError_t e = hipLaunchCooperativeKernel((const void*)fwd_kernel, dim3(grid), dim3(NTHREADS), args, LDS_BYTES, stream);
    if (e != hipSuccess) fprintf(stderr, "cooperative launch failed: %s (grid %d)\n", hipGetErrorString(e), grid);
#else
    (void)args; hipLaunchKernelGGL(fwd_kernel, dim3(grid), dim3(NTHREADS), LDS_BYTES, stream, a);
#endif
#else
    for (int p = 0; p < NPHASE; ++p) { a.ph_lo = p; a.ph_hi = p + 1; hipLaunchKernelGGL(fwd_kernel, dim3(grid), dim3(NTHREADS), LDS_BYTES, stream, a); }
#endif
}
```

```cpp
#include <hip/hip_runtime.h>
#include <hip/hip_cooperative_groups.h>
#include <cstdio>
#include <cstdint>
namespace cg = cooperative_groups;

#ifndef MK_COOP_LAUNCH
#define MK_COOP_LAUNCH 0
#endif
#ifndef MK_ONE_LAUNCH
#define MK_ONE_LAUNCH 1
#endif

#define LAS __attribute__((address_space(3)))
typedef unsigned short bf16_t;
typedef short bf16x8 __attribute__((ext_vector_type(8)));
typedef short s16x4 __attribute__((ext_vector_type(4)));
typedef float f32x2 __attribute__((ext_vector_type(2)));
typedef float f32x4 __attribute__((ext_vector_type(4)));
typedef float f32x16 __attribute__((ext_vector_type(16)));
typedef unsigned u32x2 __attribute__((ext_vector_type(2)));
typedef unsigned u32x4 __attribute__((ext_vector_type(4)));
typedef __bf16 bf16x2_t __attribute__((ext_vector_type(2)));

constexpr int NB = 2, SEQ = 4096, T = NB * SEQ, DM = 2048, HD = 128, NHF = 8, DIN = 7176, NPROJ = 7168;
constexpr int NEXP = 16384, NE = 128;
constexpr float EPS = 1e-6f;
constexpr float SCALE = 0.08838834764831845f, LOG2E = 1.4426950408889634f;
constexpr int NWAVES = 8, NTHREADS = 512;

constexpr size_t MiB = 1u << 20;
constexpr size_t WS_CTL = 0, CTL_BYTES = 32768;
constexpr int CW_BAR = 1024;
constexpr size_t WS_SXN = 64 * MiB  , WS_WSC = 45 * MiB + 800 * 1024  ;
constexpr int CW_WMAX = 64;
constexpr size_t WS_GQK = 45 * MiB + 768 * 1024;
constexpr size_t WS_WIN = 1 * MiB, WS_WOUT = 29 * MiB, WS_WPQ = 37 * MiB, WS_SK = 45 * MiB, WS_LOGF = 46 * MiB, WS_C = 46 * MiB + 512 * 1024, WS_SSQ = 47 * MiB;
constexpr size_t WS_XN = 48 * MiB;
constexpr size_t WS_SEC = 80 * MiB;
constexpr size_t SEC_ELEMS = 8u << 20;
constexpr size_t WS_MIX = 192 * MiB, WS_HB = 224 * MiB, WS_QP = 256 * MiB, WS_IDX = 288 * MiB, WS_GW = 292 * MiB, WS_U8 = 296 * MiB, WS_V8 = 328 * MiB, WS_SUV = 360 * MiB  , WS_RT = 360 * MiB + 256 * 1024  , WS_W = 361 * MiB  ,
                 WS_PART = 368 * MiB  , WS_XQ = 432 * MiB  , WS_END = 448 * MiB;
constexpr size_t WS_AMX = 365 * MiB  , WS_SX = WS_RT + 64 * 1024  , WS_WQ = WS_W  , WS_SW = WS_W + 2 * MiB  ;
constexpr size_t WS_PO = WS_PART  , WS_PML = WS_PART + 32 * MiB  ;

constexpr int RING_BYTES = 131072;
constexpr int MISC_OFF = 143360;
constexpr int LDS_BYTES = 147456;

__device__ __forceinline__ unsigned cvt_pk_bf16(float lo, float hi) { unsigned r; asm volatile("v_cvt_pk_bf16_f32 %0, %1, %2" : "=v"(r) : "v"(lo), "v"(hi)); return r; }
__device__ __forceinline__ float bf_lo(unsigned u) { return __builtin_bit_cast(float, u << 16); }
__device__ __forceinline__ float bf_hi(unsigned u) { return __builtin_bit_cast(float, u & 0xffff0000u); }
__device__ __forceinline__ int lane_id_fresh() { int l = (int)__builtin_amdgcn_mbcnt_hi(~0u, __builtin_amdgcn_mbcnt_lo(~0u, 0u)); asm volatile("" : "+v"(l)); return l; }
__device__ __forceinline__ int sx_i(int v, int m) { return __builtin_amdgcn_ds_bpermute((lane_id_fresh() ^ m) << 2, v); }
__device__ __forceinline__ float sx_f(float v, int m) { return __int_as_float(__builtin_amdgcn_ds_bpermute((lane_id_fresh() ^ m) << 2, __float_as_int(v))); }
__device__ __forceinline__ int sh_i(int v, int src) { return __builtin_amdgcn_ds_bpermute(src << 2, v); }
__device__ __forceinline__ float sh_f(float v, int src) { return __int_as_float(__builtin_amdgcn_ds_bpermute(src << 2, __float_as_int(v))); }
__device__ __forceinline__ float shup_f(float v, int d) { const int l = lane_id_fresh(); const int s = l - d; return __int_as_float(__builtin_amdgcn_ds_bpermute((s < 0 ? l : s) << 2, __float_as_int(v))); }
__device__ __forceinline__ float wave_sum(float v) {
#pragma unroll
    for (int o = 1; o < 64; o <<= 1) v += sx_f(v, o);
    return v;
}
__device__ __forceinline__ float wave_max(float v) {
#pragma unroll
    for (int o = 1; o < 64; o <<= 1) v = fmaxf(v, sx_f(v, o));
    return v;
}
__device__ __forceinline__ int tid_opaque() { int t = (int)threadIdx.x; asm volatile("" : "+v"(t)); return t; }
#define LDS_WAIT() asm volatile("s_waitcnt lgkmcnt(0)" ::: "memory")

namespace pg8 {
#define PG8_LAS __attribute__((address_space(3)))
constexpr int BM = 256, BK = 64, HALF = 128, HTB = HALF * BK * 2, STAGE_BYTES = 8 * HTB, NXCD = 8, WGM = 8;
__host__ __device__ __forceinline__ int lds_byte(int r, int c) { const int st = (r >> 4) * 2 + (c >> 5), rr = r & 15, cc = c & 31, ob = rr * 64 + cc * 2; return st * 1024 + (ob ^ (((ob >> 9) & 1) << 5)); }
__host__ __device__ __forceinline__ void stage_rc(int b, int& R, int& C) { const int st = b / 1024, sb = b % 1024, swz = sb ^ (((sb >> 9) & 1) << 5); R = (st >> 1) * 16 + swz / 64; C = (st & 1) * 32 + (swz % 64) / 2; }
__host__ __device__ __forceinline__ int perm32(int rho) { const int n = rho >> 4, i = rho & 15; return 8 * (i >> 2) + 4 * n + (i & 3); }
struct Unit { int pm, pn; };
struct Gemm { const bf16_t* A; const bf16_t* Bt; int M, N, K; };
struct StaticOrder {
    int nM, nN, nwg, G, c;
    __host__ __device__ void init(int M, int N, int G_, int c_) { nM = M / BM; nN = N / BM; nwg = nM * nN; G = G_; c = c_; }
    __host__ __device__ bool next(int i, Unit& u) const {
        const long L = (long)i * G + c; if (L >= nwg) return false;
        int wgid = (int)L; { const int q = nwg / NXCD, r = nwg % NXCD, xcd = wgid % NXCD, off = wgid / NXCD; wgid = (xcd < r ? xcd * (q + 1) : r * (q + 1) + (xcd - r) * q) + off; }
        const int nig = WGM * nN, gid = wgid / nig, fm = gid * WGM, gsz = (nM - fm) < WGM ? (nM - fm) : WGM;
        u.pm = fm + ((wgid % nig) % gsz); u.pn = (wgid % nig) / gsz; return true;
    }
    __device__ __forceinline__ void a_ready(const Unit&) const {}
    __device__ __forceinline__ void done(const Unit&) const {}
};

typedef int i32x4 __attribute__((ext_vector_type(4)));
template <bool I8> struct AccT { typedef f32x4 type; };
template <> struct AccT<true> { typedef i32x4 type; };
template <class Epi, class Sched, bool ALIGN_EPI = false, bool SP2 = false, bool I8 = false>
__device__ __forceinline__ void gemm_phase(PG8_LAS unsigned char* lds, const Gemm g, const Sched& S, const Epi& E) {
    typedef typename AccT<I8>::type acc_t;
    const int tid = tid_opaque(), wid = __builtin_amdgcn_readfirstlane(tid >> 6), lane = tid & 63, wr = wid >> 2, wc = wid & 3, fr = lane & 15, fq = lane >> 4;
    const int rowb = I8 ? g.K : 2 * g.K, nt = rowb / (BK * 2);
    unsigned voffA[2], voffB[2];
#pragma unroll
    for (int i = 0; i < 2; ++i) { int R, C; stage_rc(tid * 16 + i * 8192, R, C); const int Rb = Epi::PERM ? ((R & ~31) + perm32(R & 31)) : R;
        voffA[i] = (unsigned)(R * rowb + C * 2); voffB[i] = (unsigned)(Rb * rowb + C * 2); }
    const size_t kstep = (size_t)(BK * 2);
    const size_t hstep = (size_t)HALF * rowb;
    const size_t tstep = 2 * hstep;
    const unsigned ldsw = (unsigned)wid * 1024u;
    const int aoff = lds_byte(wr * 64 + fr, fq * 8), boff = lds_byte(wc * 32 + fr, fq * 8);
#define PG8_SA(b, h) (((b) * 2 + (h)) * HTB)
#define PG8_SB(b, h) ((4 + (b) * 2 + (h)) * HTB)
#define PG8_STAGE(bufoff, gbase, voff) do { _Pragma("unroll") for (int _i = 0; _i < 2; ++_i) \
        __builtin_amdgcn_global_load_lds((const unsigned*)((const char*)(gbase) + (voff)[_i]), (PG8_LAS unsigned*)(lds + (bufoff) + ldsw + _i * 8192), 16, 0, 0); } while (0)
#define PG8_LDA(dst, b, h) do { _Pragma("unroll") for (int m = 0; m < 4; ++m) _Pragma("unroll") for (int k = 0; k < 2; ++k) dst[m][k] = *(const PG8_LAS bf16x8*)(lds + PG8_SA(b, h) + aoff + m * 2048 + k * 1024); } while (0)
#define PG8_LDB(dst, b, h) do { _Pragma("unroll") for (int n = 0; n < 2; ++n) _Pragma("unroll") for (int k = 0; k < 2; ++k) dst[n][k] = *(const PG8_LAS bf16x8*)(lds + PG8_SB(b, h) + boff + n * 2048 + k * 1024); } while (0)
#define PG8_MMA(ai, bj, At, Bt) do { __builtin_amdgcn_s_setprio(1); _Pragma("unroll") for (int m = 0; m < 4; ++m) _Pragma("unroll") for (int n = 0; n < 2; ++n) _Pragma("unroll") for (int k = 0; k < 2; ++k) \
        { if constexpr (I8) acc[ai][bj][m][n] = __builtin_amdgcn_mfma_i32_16x16x64_i8(__builtin_bit_cast(i32x4, Bt[n][k]), __builtin_bit_cast(i32x4, At[m][k]), acc[ai][bj][m][n], 0, 0, 0); \
          else acc[ai][bj][m][n] = __builtin_amdgcn_mfma_f32_16x16x32_bf16(Bt[n][k], At[m][k], acc[ai][bj][m][n], 0, 0, 0); } __builtin_amdgcn_s_setprio(0); } while (0)
#define PG8_WAIT_V(n) asm volatile("s_waitcnt vmcnt(" #n ")" ::: "memory")
#define PG8_WAIT_L(n) asm volatile("s_waitcnt lgkmcnt(" #n ")" ::: "memory")
#define PG8_BAR __builtin_amdgcn_s_barrier()
#define PG8_SCHED __builtin_amdgcn_sched_barrier(0)
    Unit cur, nxt; int ui = 0;
    if (!S.next(0, cur)) return;
    acc_t acc[2][2][4][2];
#pragma unroll
    for (int a = 0; a < 2; ++a)
#pragma unroll
        for (int b = 0; b < 2; ++b)
#pragma unroll
            for (int m = 0; m < 4; ++m)
#pragma unroll
                for (int n = 0; n < 2; ++n) acc[a][b][m][n] = acc_t{};
    bf16x8 At[4][2], B0[2][2], B1[2][2];
    const char* cA = (const char*)g.A + (size_t)cur.pm * tstep; const char* cB = (const char*)g.Bt + (size_t)cur.pn * tstep;
    S.a_ready(cur);
    if constexpr (SP2) {
        PG8_STAGE(PG8_SB(0, 0), cB, voffB); PG8_STAGE(PG8_SB(0, 1), cB + hstep, voffB); PG8_STAGE(PG8_SA(0, 0), cA, voffA); PG8_STAGE(PG8_SA(0, 1), cA + hstep, voffA);
        if (wr == 1) PG8_BAR;
        PG8_WAIT_V(2); PG8_BAR;
        PG8_STAGE(PG8_SB(1, 0), cB + kstep, voffB); PG8_STAGE(PG8_SA(1, 0), cA + kstep, voffA); PG8_STAGE(PG8_SB(1, 1), cB + hstep + kstep, voffB);
        PG8_WAIT_V(6); PG8_BAR;
    } else {
        PG8_STAGE(PG8_SB(0, 0), cB, voffB); PG8_STAGE(PG8_SA(0, 0), cA, voffA); PG8_STAGE(PG8_SB(0, 1), cB + hstep, voffB); PG8_STAGE(PG8_SA(0, 1), cA + hstep, voffA);
        if (wr == 1) PG8_BAR;
        PG8_WAIT_V(4); PG8_BAR;
        PG8_STAGE(PG8_SB(1, 0), cB + kstep, voffB); PG8_STAGE(PG8_SA(1, 0), cA + kstep, voffA); PG8_STAGE(PG8_SB(1, 1), cB + hstep + kstep, voffB);
        PG8_WAIT_V(6); PG8_BAR;
    }
    for (;;) {
        const bool has_next = S.next(ui + 1, nxt);
        const char* nA = has_next ? (const char*)g.A + (size_t)nxt.pm * tstep : cA; const char* nB = has_next ? (const char*)g.Bt + (size_t)nxt.pn * tstep : cB;
        for (int t = 0; t < nt; t += 2) {
            const bool last = (t == nt - 2);
            const char* a1 = cA + (size_t)(t + 1) * kstep;
            const char* a2 = last ? nA : cA + (size_t)(t + 2) * kstep; const char* b2 = last ? nB : cB + (size_t)(t + 2) * kstep;
            const char* a3 = a2 + kstep; const char* b3 = b2 + kstep;
            if (last && has_next) S.a_ready(nxt);
            if constexpr (SP2) {
            PG8_LDB(B0, 0, 0); PG8_LDB(B1, 0, 1); PG8_SCHED; PG8_LDA(At, 0, 0); PG8_STAGE(PG8_SA(1, 1), a1 + hstep, voffA);
            PG8_WAIT_V(8); PG8_WAIT_L(0); PG8_BAR; PG8_MMA(0, 0, At, B0); PG8_MMA(0, 1, At, B1); PG8_BAR; PG8_SCHED;
            PG8_LDA(At, 0, 1); PG8_STAGE(PG8_SB(0, 0), b2, voffB); PG8_STAGE(PG8_SB(0, 1), b2 + hstep, voffB); PG8_STAGE(PG8_SA(0, 0), a2, voffA);
            PG8_WAIT_V(8); PG8_WAIT_L(0); PG8_BAR; PG8_MMA(1, 0, At, B0); PG8_MMA(1, 1, At, B1); PG8_BAR; PG8_SCHED;
            PG8_LDB(B0, 1, 0); PG8_LDB(B1, 1, 1); PG8_SCHED; PG8_LDA(At, 1, 0); PG8_STAGE(PG8_SA(0, 1), a2 + hstep, voffA);
            PG8_WAIT_V(8); PG8_WAIT_L(0); PG8_BAR; PG8_MMA(0, 0, At, B0); PG8_MMA(0, 1, At, B1); PG8_BAR; PG8_SCHED;
            PG8_LDA(At, 1, 1); PG8_STAGE(PG8_SB(1, 0), b3, voffB); PG8_STAGE(PG8_SB(1, 1), b3 + hstep, voffB); PG8_STAGE(PG8_SA(1, 0), a3, voffA);
            PG8_WAIT_V(8); PG8_WAIT_L(0); PG8_BAR; PG8_MMA(1, 0, At, B0); PG8_MMA(1, 1, At, B1); PG8_BAR; PG8_SCHED;
            } else {
            PG8_LDB(B0, 0, 0); PG8_SCHED; PG8_LDA(At, 0, 0); PG8_STAGE(PG8_SA(1, 1), a1 + hstep, voffA);
            PG8_WAIT_L(8); PG8_BAR; PG8_WAIT_L(0); PG8_MMA(0, 0, At, B0); PG8_BAR; PG8_SCHED;
            PG8_LDB(B1, 0, 1); PG8_STAGE(PG8_SB(0, 0), b2, voffB);
            PG8_BAR; PG8_WAIT_L(0); PG8_MMA(0, 1, At, B1); PG8_BAR;
            PG8_LDA(At, 0, 1); PG8_STAGE(PG8_SA(0, 0), a2, voffA);
            PG8_BAR; PG8_WAIT_L(0); PG8_MMA(1, 0, At, B0); PG8_BAR; PG8_SCHED;
            PG8_STAGE(PG8_SB(0, 1), b2 + hstep, voffB);
            PG8_WAIT_V(6); PG8_BAR; PG8_MMA(1, 1, At, B1); PG8_BAR;
            PG8_LDB(B0, 1, 0); PG8_SCHED; PG8_LDA(At, 1, 0); PG8_STAGE(PG8_SA(0, 1), a2 + hstep, voffA);
            PG8_WAIT_L(8); PG8_BAR; PG8_WAIT_L(0); PG8_MMA(0, 0, At, B0); PG8_BAR; PG8_SCHED;
            PG8_LDB(B1, 1, 1); PG8_STAGE(PG8_SB(1, 0), b3, voffB);
            PG8_BAR; PG8_WAIT_L(0); PG8_MMA(0, 1, At, B1); PG8_BAR;
            PG8_LDA(At, 1, 1); PG8_STAGE(PG8_SA(1, 0), a3, voffA);
            PG8_BAR; PG8_WAIT_L(0); PG8_MMA(1, 0, At, B0); PG8_BAR; PG8_SCHED;
            PG8_STAGE(PG8_SB(1, 1), b3 + hstep, voffB);
            PG8_WAIT_V(6); PG8_BAR; PG8_MMA(1, 1, At, B1); PG8_BAR;
            }
        }
        if constexpr (ALIGN_EPI) { if (wr == 0) PG8_BAR; }
        if constexpr (!Epi::AFTER_DRAIN) { E(acc, cur, wr, wc, fr, fq); } S.done(cur);
        if (!has_next) break;
#pragma unroll
        for (int a = 0; a < 2; ++a)
#pragma unroll
            for (int b = 0; b < 2; ++b)
#pragma unroll
                for (int m = 0; m < 4; ++m)
#pragma unroll
                    for (int n = 0; n < 2; ++n) acc[a][b][m][n] = acc_t{};
        cur = nxt; cA = nA; cB = nB; ++ui;
        if constexpr (ALIGN_EPI) { if (wr == 1) PG8_BAR; }
    }
    PG8_WAIT_V(0);
    if constexpr (!ALIGN_EPI) { if (wr == 0) PG8_BAR; }
    PG8_BAR;
    if constexpr (Epi::AFTER_DRAIN) E.fused(acc, cur, wr, wc, fr, fq, lds);
#undef PG8_SA
#undef PG8_SB
#undef PG8_STAGE
#undef PG8_LDA
#undef PG8_LDB
#undef PG8_MMA
#undef PG8_WAIT_V
#undef PG8_WAIT_L
#undef PG8_BAR
#undef PG8_SCHED
}

__device__ __forceinline__ float sigmoidf_fast(float x) { return __builtin_amdgcn_rcpf(1.f + __builtin_amdgcn_exp2f(-x * LOG2E)); }
struct EpiInProj {
    static constexpr bool PERM = true, AFTER_DRAIN = false;
    bf16_t* base; const float* sxn  ; const float* wsc  ;
    const float* gq; const float* gk; PG8_LAS float* xch  ;
    __device__ __forceinline__ void operator()(const i32x4 (&acci)[2][2][4][2], const Unit& u, int wr, int wc, int fr, int fq) const {
        const int sec = u.pn >> 2; const float wsv = *wsc;
        bf16_t* sb = base + (size_t)sec * SEC_ELEMS;
        const float sc = (sec == 4) ? SCALE * LOG2E : 1.f;
        if (sec < 2) {
#pragma unroll
            for (int ai = 0; ai < 2; ++ai)
#pragma unroll
                for (int m = 0; m < 4; ++m) {
                    const int tk = u.pm * BM + ai * HALF + wr * 64 + m * 16 + fr;
                    const float rs = sxn[tk] * wsv;
#pragma unroll
                    for (int bj = 0; bj < 2; ++bj) {
                        const f32x4 v0 = __builtin_convertvector(acci[ai][bj][m][0], f32x4) * rs, v1 = __builtin_convertvector(acci[ai][bj][m][1], f32x4) * rs;
                        float ss = v0[0] * v0[0] + v0[1] * v0[1] + v0[2] * v0[2] + v0[3] * v0[3] + v1[0] * v1[0] + v1[1] * v1[1] + v1[2] * v1[2] + v1[3] * v1[3];
                        ss += sx_f(ss, 16); ss += sx_f(ss, 32);
                        if (fq == 0) xch[(((((wr * 2 + ai) * 4 + m) * 16 + fr) * 2 + bj) * 4) + wc] = ss;
                    }
                }
            asm volatile("s_waitcnt lgkmcnt(0)" ::: "memory");
            __builtin_amdgcn_s_barrier();
            const float* gp = (sec == 0 ? gq : gk) + wc * 32 + 8 * fq;
            const f32x4 g0 = *(const f32x4*)gp, g1 = *(const f32x4*)(gp + 4);
#pragma unroll
            for (int ai = 0; ai < 2; ++ai)
#pragma unroll
                for (int m = 0; m < 4; ++m) {
                    const int tk = u.pm * BM + ai * HALF + wr * 64 + m * 16 + fr, b = tk >> 12, s = tk & 4095;
                    const float rs = sxn[tk] * wsv;
#pragma unroll
                    for (int bj = 0; bj < 2; ++bj) {
                        const int hh = (u.pn & 3) * 2 + bj;
                        const f32x4 p4 = *(const PG8_LAS f32x4*)(xch + (((((wr * 2 + ai) * 4 + m) * 16 + fr) * 2 + bj) * 4));
                        const float r = rs / sqrtf(((p4[0] + p4[1]) + (p4[2] + p4[3])) * (1.f / 128.f) + EPS);
                        const f32x4 v0 = __builtin_convertvector(acci[ai][bj][m][0], f32x4) * r * g0, v1 = __builtin_convertvector(acci[ai][bj][m][1], f32x4) * r * g1;
                        u32x4 w; w.x = cvt_pk_bf16(v0[0], v0[1]); w.y = cvt_pk_bf16(v0[2], v0[3]); w.z = cvt_pk_bf16(v1[0], v1[1]); w.w = cvt_pk_bf16(v1[2], v1[3]);
                        *(u32x4*)(sb + ((size_t)((b * 8 + hh) * 4096 + s)) * 128 + wc * 32 + 8 * fq) = w;
                    }
                }
            return;
        }
#pragma unroll
        for (int ai = 0; ai < 2; ++ai)
#pragma unroll
            for (int m = 0; m < 4; ++m) {
                const int tk = u.pm * BM + ai * HALF + wr * 64 + m * 16 + fr, b = tk >> 12, s = tk & 4095;
                const float rs = sxn[tk] * wsv;
#pragma unroll
                for (int bj = 0; bj < 2; ++bj) {
                    const int hh = (u.pn & 3) * 2 + bj;
                    f32x4 v0 = __builtin_convertvector(acci[ai][bj][m][0], f32x4) * rs, v1 = __builtin_convertvector(acci[ai][bj][m][1], f32x4) * rs;
                    bf16_t* dst;
                    if (sec == 3) {
#pragma unroll
                        for (int i = 0; i < 4; ++i) { v0[i] = sigmoidf_fast(v0[i]); v1[i] = sigmoidf_fast(v1[i]); }
                        dst = sb + (size_t)tk * 1024 + hh * 128 + wc * 32 + 8 * fq;
                    } else {
                        v0 = v0 * sc; v1 = v1 * sc;
                        dst = sb + ((size_t)((b * 8 + hh) * 4096 + s)) * 128 + wc * 32 + 8 * fq;
                    }
                    u32x4 w; w.x = cvt_pk_bf16(v0[0], v0[1]); w.y = cvt_pk_bf16(v0[2], v0[3]); w.z = cvt_pk_bf16(v1[0], v1[1]); w.w = cvt_pk_bf16(v1[2], v1[3]);
                    *(u32x4*)dst = w;
                }
            }
    }
};
struct EpiOutProj {
    static constexpr bool PERM = true, AFTER_DRAIN = false;
    const float* x; float* h; bf16_t* hb; float* ssq; float* amx;
    __device__ __forceinline__ void operator()(const f32x4 (&acc)[2][2][4][2], const Unit& u, int wr, int wc, int fr, int fq) const {
#pragma unroll
        for (int ai = 0; ai < 2; ++ai)
#pragma unroll
            for (int m = 0; m < 4; ++m) {
                const int tk = u.pm * BM + ai * HALF + wr * 64 + m * 16 + fr;
                float ss = 0.f, mx = 0.f;
#pragma unroll
                for (int bj = 0; bj < 2; ++bj) {
                    const size_t off = (size_t)tk * DM + u.pn * BM + bj * HALF + wc * 32 + 8 * fq;
                    const f32x4 x0 = *(const f32x4*)(x + off), x1 = *(const f32x4*)(x + off + 4);
                    const f32x4 v0 = acc[ai][bj][m][0] + x0, v1 = acc[ai][bj][m][1] + x1;
                    u32x4 w; w.x = cvt_pk_bf16(v0[0], v0[1]); w.y = cvt_pk_bf16(v0[2], v0[3]); w.z = cvt_pk_bf16(v1[0], v1[1]); w.w = cvt_pk_bf16(v1[2], v1[3]);
                    *(u32x4*)(hb + off) = w;
                    ss += v0[0] * v0[0] + v0[1] * v0[1] + v0[2] * v0[2] + v0[3] * v0[3] + v1[0] * v1[0] + v1[1] * v1[1] + v1[2] * v1[2] + v1[3] * v1[3];
                    mx = fmaxf(mx, fmaxf(fmaxf(fmaxf(fabsf(v0[0]), fabsf(v0[1])), fmaxf(fabsf(v0[2]), fabsf(v0[3]))), fmaxf(fmaxf(fabsf(v1[0]), fabsf(v1[1])), fmaxf(fabsf(v1[2]), fabsf(v1[3])))));
                }
                ss += sx_f(ss, 16); ss += sx_f(ss, 32);
                mx = fmaxf(mx, sx_f(mx, 16)); mx = fmaxf(mx, sx_f(mx, 32));
                if (fq == 0) { ssq[(size_t)tk * 32 + u.pn * 4 + wc] = ss; amx[(size_t)tk * 32 + u.pn * 4 + wc] = mx; }
            }
    }
};
struct EpiPeerQ {
    static constexpr bool PERM = true, AFTER_DRAIN = false;
    const float* ssq; bf16_t* qp; float* rtab;
    __device__ __forceinline__ void operator()(const f32x4 (&acc)[2][2][4][2], const Unit& u, int wr, int wc, int fr, int fq) const {
#pragma unroll
        for (int ai = 0; ai < 2; ++ai)
#pragma unroll
            for (int m = 0; m < 4; ++m) {
                const int tk = u.pm * BM + ai * HALF + wr * 64 + m * 16 + fr;
                float tot = 0.f;
#pragma unroll
                for (int i = 0; i < 8; ++i) { const f32x4 s4 = *(const f32x4*)(ssq + (size_t)tk * 32 + 4 * i); tot += (s4[0] + s4[1]) + (s4[2] + s4[3]); }
                const float r = 1.0f / sqrtf(tot * (1.f / DM) + EPS);
                if (u.pn == 0 && wc == 0 && fq == 0) rtab[tk] = r;
#pragma unroll
                for (int bj = 0; bj < 2; ++bj) {
                    const size_t off = (size_t)tk * DM + u.pn * BM + bj * HALF + wc * 32 + 8 * fq;
                    const f32x4 v0 = acc[ai][bj][m][0] * r, v1 = acc[ai][bj][m][1] * r;
                    u32x4 w; w.x = cvt_pk_bf16(v0[0], v0[1]); w.y = cvt_pk_bf16(v0[2], v0[3]); w.z = cvt_pk_bf16(v1[0], v1[1]); w.w = cvt_pk_bf16(v1[2], v1[3]);
                    *(u32x4*)(qp + off) = w;
                }
            }
    }
};
struct EpiPeerQFused {
    static constexpr bool PERM = true, AFTER_DRAIN = true;
    const float* ssq; unsigned char* wsb;
    __device__ __forceinline__ void operator()(const f32x4 (&)[2][2][4][2], const Unit&, int, int, int, int) const {}
    __device__ __forceinline__ void fused(const f32x4 (&acc)[2][2][4][2], const Unit& u, int wr, int wc, int fr, int fq, PG8_LAS unsigned char* lds) const;
};
}

namespace att {
constexpr int NW = 8, QBLK = 32, KVBLK = 64, QB = NW * QBLK, D = 128;
constexpr int SHM_V = KVBLK * D * 2, SHM_K = KVBLK * D * 2;
constexpr int OFF_WS = 2 * SHM_V + 2 * SHM_K, OFF_BIAS = OFF_WS + NW * 64 * 4, ATT_LDS = OFF_BIAS + SEQ * 4;
#define KSWZ(row, colB) ((row) * 256 + ((colB) ^ (((row) & 7) << 4)))
#define SBAR() __builtin_amdgcn_sched_barrier(0)
__device__ __forceinline__ int v_st(int k, int c) { const int kk = (k & ~0xC) | ((k & 4) << 1) | ((k & 8) >> 1); return ((kk >> 3) * 4 + (c >> 5)) * 512 + ((kk & 7) * 32 + (c & 31)) * 2; }
__device__ __forceinline__ int v_rd_base(int lane) { return ((lane & 3) << 3) | (((lane >> 2) & 3) << 6) | (((lane >> 4) & 1) << 5) | (((lane >> 5) & 1) << 8); }
constexpr int v_rd_off(int d0, int ks, int half) { return d0 * 512 + ks * 4096 + half * 2048; }
__device__ __forceinline__ int crow(int r, int hi) { return (r & 3) + 8 * (r >> 2) + 4 * hi; }
__device__ __forceinline__ bf16x8 load8(const bf16_t* p) { return *reinterpret_cast<const bf16x8*>(p); }
__device__ __forceinline__ void mask_tile(f32x16& p0, f32x16& p1, int dq) {
    const float NEG = -__builtin_inff();
#pragma unroll
    for (int r = 0; r < 16; ++r) {
        const int c = (r & 3) + 8 * (r >> 2);
        if (dq - c < 0) p0[r] = NEG;
        if (dq - c - 32 < 0) p1[r] = NEG;
    }
}
__device__ __forceinline__ void partialSM(f32x16& p0, f32x16& p1, float& m_reg, float& mn, float& alpha) {
    float pmax = p0[0];
#pragma unroll
    for (int r = 1; r < 16; ++r) pmax = fmaxf(pmax, p0[r]);
#pragma unroll
    for (int r = 0; r < 16; ++r) pmax = fmaxf(pmax, p1[r]);
    { auto rr = __builtin_amdgcn_permlane32_swap(__float_as_uint(pmax), __float_as_uint(pmax), false, false);
      pmax = fmaxf(__uint_as_float(rr[0]), __uint_as_float(rr[1])); }
    constexpr float C2 = LOG2E * SCALE; constexpr float THR = 8.f;
    if (__builtin_expect(__all((pmax - m_reg) * SCALE <= THR), 1)) { mn = m_reg; alpha = 1.f; }
    else { mn = fmaxf(m_reg, pmax); alpha = __builtin_amdgcn_exp2f((m_reg - mn) * C2); m_reg = mn; }
    const float mnL = -mn * C2;
#pragma unroll
    for (int r = 0; r < 16; ++r) p0[r] = fmaf(p0[r], C2, mnL);
#pragma unroll
    for (int r = 0; r < 16; ++r) p1[r] = fmaf(p1[r], C2, mnL);
#pragma unroll
    for (int r = 0; r < 16; ++r) p0[r] = __builtin_amdgcn_exp2f(p0[r]);
}
#define PK4(P, B_, OUT) do { unsigned a0 = cvt_pk_bf16(P[B_+0], P[B_+1]), a1 = cvt_pk_bf16(P[B_+2], P[B_+3]);                          \
        unsigned b0 = cvt_pk_bf16(P[B_+4], P[B_+5]), b1 = cvt_pk_bf16(P[B_+6], P[B_+7]);                                             \
        auto r0 = __builtin_amdgcn_permlane32_swap(a0, b0, false, false); auto r1 = __builtin_amdgcn_permlane32_swap(a1, b1, false, false); \
        u32x4 w = {r0[0], r1[0], r0[1], r1[1]}; OUT = *reinterpret_cast<bf16x8*>(&w); } while (0)
__device__ __forceinline__ void finishSM(f32x16& p0, f32x16& p1, float alpha, float& l_reg, bf16x8& pa0, bf16x8& pa1, bf16x8& pa2, bf16x8& pa3) {
#pragma unroll
    for (int r = 0; r < 16; ++r) p1[r] = __builtin_amdgcn_exp2f(p1[r]);
    float ps = 0;
#pragma unroll
    for (int r = 0; r < 16; ++r) ps += p0[r];
#pragma unroll
    for (int r = 0; r < 16; ++r) ps += p1[r];
    { auto rr = __builtin_amdgcn_permlane32_swap(__float_as_uint(ps), __float_as_uint(ps), false, false);
      ps = __uint_as_float(rr[0]) + __uint_as_float(rr[1]); }
    l_reg = l_reg * alpha + ps;
    PK4(p0, 0, pa0); PK4(p0, 8, pa1); PK4(p1, 0, pa2); PK4(p1, 8, pa3);
}
__device__ __forceinline__ void sb_group(f32x16& P, int g, float& gs) {
    float run = 0.f;
#pragma unroll
    for (int k = 3; k >= 0; --k) {
        const float z = P[4 * g + k];
        const float t = __builtin_amdgcn_exp2f(-fabsf(z));
        const float l = __builtin_amdgcn_logf(1.f + t);
        const float sp = fmaxf(z, 0.f) + l;
        P[4 * g + k] = (z - sp) - run;
        run += sp;
    }
    gs = run;
}
__device__ __forceinline__ void sb_part1(f32x16& p0, f32x16& p1, float& carry, float mlo) {
    float gs[8];
#pragma unroll
    for (int g = 0; g < 4; ++g) sb_group(p0, g, gs[g]);
#pragma unroll
    for (int g = 0; g < 4; ++g) sb_group(p1, g, gs[4 + g]);
    float run = carry;
#pragma unroll
    for (int G = 7; G >= 0; --G) {
        auto rr = __builtin_amdgcn_permlane32_swap(__float_as_uint(gs[G]), __float_as_uint(gs[G]), false, false);
        const float slo = __uint_as_float(rr[0]), shi = __uint_as_float(rr[1]);
        const float base = fmaf(mlo, shi, run);
        if (G >= 4) {
#pragma unroll
            for (int k = 0; k < 4; ++k) p1[4 * (G - 4) + k] -= base;
        } else {
#pragma unroll
            for (int k = 0; k < 4; ++k) p0[4 * G + k] -= base;
        }
        run += slo + shi;
    }
    carry = run;
#pragma unroll
    for (int r = 0; r < 16; ++r) p0[r] = __builtin_amdgcn_exp2f(p0[r]);
}
__device__ __forceinline__ void sb_part2(f32x16& p0, f32x16& p1, bf16x8& pa0, bf16x8& pa1, bf16x8& pa2, bf16x8& pa3) {
#pragma unroll
    for (int r = 0; r < 16; ++r) p1[r] = __builtin_amdgcn_exp2f(p1[r]);
    PK4(p0, 0, pa0); PK4(p0, 8, pa1); PK4(p1, 0, pa2); PK4(p1, 8, pa3);
}
#undef PK4
template <int KB, bool BIAS>
__device__ __forceinline__ void qkt(f32x16& p0, f32x16& p1, const char* K_lds, int r32, int hi, const bf16x8* qr, const float* bt) {
    if constexpr (BIAS) {
#pragma unroll
        for (int g = 0; g < 4; ++g) { const f32x4 a = *(const f32x4*)(bt + 8 * g), b = *(const f32x4*)(bt + 32 + 8 * g);
            p0[4 * g] = a[0]; p0[4 * g + 1] = a[1]; p0[4 * g + 2] = a[2]; p0[4 * g + 3] = a[3];
            p1[4 * g] = b[0]; p1[4 * g + 1] = b[1]; p1[4 * g + 2] = b[2]; p1[4 * g + 3] = b[3]; }
    } else { p0 = f32x16{}; p1 = f32x16{}; }
    const char* kb[4];
#pragma unroll
    for (int dd = 0; dd < 4; ++dd) kb[dd] = K_lds + KB * SHM_K + KSWZ(r32, (dd * 16 + hi * 8) * 2);
#pragma unroll
    for (int d0 = 0; d0 < 8; ++d0) { const char* a = kb[d0 & 3] + (d0 >> 2) * 128;
        bf16x8 b0 = *reinterpret_cast<const bf16x8*>(a);
        bf16x8 b1 = *reinterpret_cast<const bf16x8*>(a + 32 * 256);
        p0 = __builtin_amdgcn_mfma_f32_32x32x16_bf16(b0, qr[d0], p0, 0, 0, 0);
        p1 = __builtin_amdgcn_mfma_f32_32x32x16_bf16(b1, qr[d0], p1, 0, 0, 0); }
}
template <int VB>
__device__ __forceinline__ void pv_tile(f32x16* o, int vb0, bf16x8 pa0, bf16x8 pa1, bf16x8 pa2, bf16x8 pa3) {
#define TRRD(dst, off) asm volatile("ds_read_b64_tr_b16 %0, %1 offset:%2" : "=&v"(dst) : "v"(vb0), "i"(off) : "memory")
#define PV_D0(d0) do { { s16x4 l0, l1, h0, h1; constexpr int b_ = VB * SHM_V + v_rd_off(d0, 0, 0); \
        TRRD(l0, b_); TRRD(h0, b_ + 2048); TRRD(l1, b_ + 4096); TRRD(h1, b_ + 6144); \
        asm volatile("s_waitcnt lgkmcnt(0)" ::: "memory"); SBAR();   \
        o[d0] = __builtin_amdgcn_mfma_f32_32x32x16_bf16(pa0, (bf16x8){l0[0], l0[1], l0[2], l0[3], h0[0], h0[1], h0[2], h0[3]}, o[d0], 0, 0, 0);   \
        o[d0] = __builtin_amdgcn_mfma_f32_32x32x16_bf16(pa1, (bf16x8){l1[0], l1[1], l1[2], l1[3], h1[0], h1[1], h1[2], h1[3]}, o[d0], 0, 0, 0); }  \
      { s16x4 l2, l3, h2, h3; constexpr int b_ = VB * SHM_V + v_rd_off(d0, 0, 0); \
        TRRD(l2, b_ + 8192); TRRD(h2, b_ + 10240); TRRD(l3, b_ + 12288); TRRD(h3, b_ + 14336); \
        asm volatile("s_waitcnt lgkmcnt(0)" ::: "memory"); SBAR();   \
        o[d0] = __builtin_amdgcn_mfma_f32_32x32x16_bf16(pa2, (bf16x8){l2[0], l2[1], l2[2], l2[3], h2[0], h2[1], h2[2], h2[3]}, o[d0], 0, 0, 0);   \
        o[d0] = __builtin_amdgcn_mfma_f32_32x32x16_bf16(pa3, (bf16x8){l3[0], l3[1], l3[2], l3[3], h3[0], h3[1], h3[2], h3[3]}, o[d0], 0, 0, 0); } } while (0)
    PV_D0(0); PV_D0(1); PV_D0(2); PV_D0(3);
#undef PV_D0
#undef TRRD
}

struct UnitRef { const bf16_t* Q; const bf16_t* K; const bf16_t* V; int P0; };
struct Seam { bf16x8 qr[8]; bf16x8 st_v0, st_v1, st_k0, st_k1; };
#define ROW(p, k0, rr) ((p) + (size_t)((k0) + (rr)) * D + sc)
#define VMW() asm volatile("s_waitcnt vmcnt(0)" ::: "memory")
#define SLOAD_H(Kp, Vp, k0) do { S.st_v0 = load8(ROW(Vp, k0, sr)); S.st_v1 = load8(ROW(Vp, k0, 32 + sr));              \
                         S.st_k0 = load8(ROW(Kp, k0, sr)); S.st_k1 = load8(ROW(Kp, k0, 32 + sr)); } while (0)
#define SWRITE_HK(bf) do { *(bf16x8*)(K_lds + (bf) * SHM_K + kws) = S.st_k0; *(bf16x8*)(K_lds + (bf) * SHM_K + kws + 32 * 256) = S.st_k1; } while (0)
#define SWRITE_HV(bf) do { *(bf16x8*)(V_lds + (bf) * SHM_V + vst0) = S.st_v0; *(bf16x8*)(V_lds + (bf) * SHM_V + vst1) = S.st_v1; } while (0)
#define SWRITE_H(bf) do { SWRITE_HV(bf); SWRITE_HK(bf); } while (0)

template <bool SB>
__device__ __forceinline__ void attn_unit(const UnitRef& cur, unsigned char* wsu  , int bh, char* lds,
                                          int part  ) {
    const float* cvec; const float* gqk;
    { unsigned char* w_ = wsu; asm volatile("" : "+s"(w_)); cvec = (const float*)(w_ + WS_C) + (size_t)bh * SEQ; gqk = (const float*)(w_ + WS_GQK); }
    const int tid = tid_opaque(), wid = __builtin_amdgcn_readfirstlane(tid >> 6), lane = tid & 63, r32 = lane & 31, hi = lane >> 5;
    int jlo = 0;
    if constexpr (!SB) {
        const float gq = fmaxf(fabsf(gqk[lane]), fabsf(gqk[64 + lane])), gk = fmaxf(fabsf(gqk[128 + lane]), fabsf(gqk[192 + lane]));
        const float lmax = 11.3137085f * 1.02f * wave_max(gq) * wave_max(gk);
        const int ntf = (cur.P0 + QB) / KVBLK;
        const float cend = (lane < ntf) ? cvec[lane * KVBLK + KVBLK - 1] : 0.f;
        const bool skip = (lane < ntf) && (2.f * lmax + cvec[cur.P0] - cend < -104.f);
        jlo = __builtin_amdgcn_readfirstlane((int)__popcll(__ballot(skip)));
    }
    const int ntot = (cur.P0 + QB) / KVBLK - jlo;
    const int tb = (part == 2) ? (ntot >> 1) : 0, te = (part == 1) ? (ntot >> 1) : ntot;
    const int kshift = (jlo + tb) * KVBLK, P0r = cur.P0 - kshift;
    const int NT = te - tb;
#define KBASE(t) ((SB ? (NT - 1 - (t)) : (t)) * KVBLK)
    const int qlo = P0r + wid * QBLK, qm = qlo + r32 - 4 * hi - (SB ? 1 : 0);
    char* V_lds = lds; char* K_lds = lds + 2 * SHM_V;
    float* ws = (float*)(lds + OFF_WS) + wid * 64; float* li_l = ws, * al_l = ws + 32;
    float* bias = (float*)(lds + OFF_BIAS);
    const int sr = tid >> 4, sc = (tid & 15) * 8, vst0 = v_st(sr, sc), vst1 = v_st(32 + sr, sc), kws = KSWZ(sr, sc * 2);
    const int vb0 = (int)(uintptr_t)V_lds + v_rd_base(lane);
    const bf16_t* Kh = cur.K + (size_t)kshift * D; const bf16_t* Vh = cur.V + (size_t)kshift * D;
    Seam S;
    if constexpr (!SB) { const float cq0 = cvec[cur.P0]; const float* cv = cvec + kshift; for (int j = tid; j < NT * KVBLK; j += NTHREADS) bias[j] = (cq0 - cv[j]) * (1.f / SCALE); }
#pragma unroll
    for (int d0 = 0; d0 < 8; ++d0) S.qr[d0] = load8(cur.Q + (size_t)(wid * QBLK + r32) * D + d0 * 16 + hi * 8);
    SLOAD_H(Kh, Vh, KBASE(0)); VMW(); SWRITE_HK(0);
    __syncthreads();
    float m_reg = -1e30f, l_reg = 0; f32x16 o[4] = {};
    float carry = 0.f; const float mlo = hi ? 0.f : 1.f;
#define RESC(a) do { if (__any((a) < 1.f)) { if (hi == 0) al_l[r32] = (a); asm volatile("s_waitcnt lgkmcnt(0)" ::: "memory");              \
                     for (int d_ = 0; d_ < 4; ++d_) for (int r = 0; r < 16; ++r) o[d_][r] *= al_l[crow(r, hi)]; } } while (0)
#define MASKT(P0_, P1_, t) do { const int kb_ = KBASE(t); if (kb_ + KVBLK - 1 > qlo - (SB ? 1 : 0)) mask_tile(P0_, P1_, qm - kb_); } while (0)
#define BT(t) (bias + KBASE(t) + 4 * hi)
#define PART1(PX0, PX1, mnX, alX) do { if constexpr (SB) sb_part1(PX0, PX1, carry, mlo); else partialSM(PX0, PX1, m_reg, mnX, alX); } while (0)
#define PART2(PY0, PY1, alY) do { if constexpr (SB) sb_part2(PY0, PY1, pa0, pa1, pa2, pa3); else finishSM(PY0, PY1, alY, l_reg, pa0, pa1, pa2, pa3); } while (0)
    f32x16 pA0, pA1, pB0, pB1; float mnA = 0.f, mnB = 0.f, alA = 1.f, alB = 1.f; bf16x8 pa0, pa1, pa2, pa3;
    SWRITE_HV(0); SBAR();
    if (NT > 1) SLOAD_H(Kh, Vh, KBASE(1));
    SBAR(); qkt<0, !SB>(pA0, pA1, K_lds, r32, hi, S.qr, BT(0));
    MASKT(pA0, pA1, 0); PART1(pA0, pA1, mnA, alA);
    if (NT > 1) { VMW(); SWRITE_H(1); }
    __syncthreads();
#define HALF_STEP(PX0, PX1, mnX, alX, PY0, PY1, alY, t, KB, VB, SBUF) do {                                                    \
        SBAR(); qkt<KB, !SB>(PX0, PX1, K_lds, r32, hi, S.qr, BT(t));                                                          \
        PART2(PY0, PY1, alY); SBAR();                                                                                          \
        if ((t) + 1 < NT) { SLOAD_H(Kh, Vh, KBASE((t) + 1)); SBAR(); }                                                         \
        pv_tile<VB>(o, vb0, pa0, pa1, pa2, pa3); MASKT(PX0, PX1, (t)); PART1(PX0, PX1, mnX, alX);                              \
        __syncthreads();                                                                                                      \
        if ((t) + 1 < NT) { VMW(); SWRITE_H(SBUF); }                                                                           \
        if constexpr (!SB) RESC(alX);                                                                                          \
        __syncthreads(); } while (0)
    for (int t = 1; t + 1 < NT; t += 2) {
        HALF_STEP(pB0, pB1, mnB, alB, pA0, pA1, alA, t, 1, 0, 0);
        HALF_STEP(pA0, pA1, mnA, alA, pB0, pB1, alB, t + 1, 0, 1, 1);
    }
    const bool even = (NT & 1) == 0;
    if (even) { SBAR(); qkt<1, !SB>(pB0, pB1, K_lds, r32, hi, S.qr, BT(NT - 1)); SBAR(); }
    PART2(pA0, pA1, alA); SBAR();
    pv_tile<0>(o, vb0, pa0, pa1, pa2, pa3);
    if (even) { MASKT(pB0, pB1, NT - 1); PART1(pB0, pB1, mnB, alB); __syncthreads(); if constexpr (!SB) RESC(alB);
        PART2(pB0, pB1, alB); SBAR(); pv_tile<1>(o, vb0, pa0, pa1, pa2, pa3); }
    unsigned char* we_ = wsu; asm volatile("" : "+s"(we_));
    if (part != 0) {
        const int slot2 = ((((cur.P0 >> 8) - 8) & 7) * 16 + bh) * 2 + (part == 2 ? 1 : 0);
        float* po = (float*)(we_ + WS_PO) + (size_t)slot2 * 256 * 128; float* pml = (float*)(we_ + WS_PML) + (size_t)slot2 * 512;
        if (hi == 0) { pml[(wid * QBLK + r32) * 2] = m_reg; pml[(wid * QBLK + r32) * 2 + 1] = l_reg; }
#pragma unroll
        for (int r = 0; r < 16; ++r)
#pragma unroll
            for (int d0 = 0; d0 < 4; ++d0) po[(size_t)(wid * QBLK + crow(r, hi)) * D + d0 * 32 + r32] = o[d0][r];
        __syncthreads();
        return;
    }
    const bf16_t* gate = (const bf16_t*)(we_ + WS_SEC) + 3 * SEC_ELEMS + (size_t)(bh >> 3) * SEQ * 1024 + (bh & 7) * HD;
    bf16_t* outp = (bf16_t*)(we_ + WS_MIX) + (size_t)(bh >> 3) * SEQ * DM + (bh & 7) * HD;
    float rli[16];
    if constexpr (!SB) {
        if (hi == 0) li_l[r32] = l_reg; asm volatile("s_waitcnt lgkmcnt(0)" ::: "memory");
#pragma unroll
        for (int r = 0; r < 16; ++r) rli[r] = __builtin_amdgcn_rcpf(li_l[crow(r, hi)]);
    }
#pragma unroll
    for (int r = 0; r < 16; ++r) { const int orow = cur.P0 + wid * QBLK + crow(r, hi);
#pragma unroll
        for (int d0 = 0; d0 < 4; ++d0) {
            float v = o[d0][r];
            if constexpr (!SB) { const unsigned short gb = gate[(size_t)orow * 1024 + d0 * 32 + r32]; v = v * rli[r] * __builtin_bit_cast(float, (unsigned)gb << 16); }
            const float vn = sx_f(v, 1);
            if ((r32 & 1) == 0) *(unsigned*)(outp + (size_t)orow * DM + d0 * 32 + r32) = cvt_pk_bf16(v, vn); } }
    __syncthreads();
#undef RESC
#undef KBASE
#undef MASKT
#undef BT
#undef PART1
#undef PART2
#undef HALF_STEP
}

constexpr float SB_TH = 150.f;
__device__ __forceinline__ void sb_unit(const UnitRef& cur, bf16_t* outp, char* lds) {
    const int tid = tid_opaque(), wid = __builtin_amdgcn_readfirstlane(tid >> 6), lane = tid & 63, r32 = lane & 31, hi = lane >> 5;
    const int NT = (cur.P0 + QB) / KVBLK;
#define KBASE(t) ((NT - 1 - (t)) * KVBLK)
    const int qlo = cur.P0 + wid * QBLK, qm = qlo + r32 - 4 * hi - 1;
    char* V_lds = lds; char* K_lds = lds + 2 * SHM_V;
    volatile int* flags = (volatile int*)(lds + OFF_WS);
    const int sr = tid >> 4, sc = (tid & 15) * 8, vst0 = v_st(sr, sc), vst1 = v_st(32 + sr, sc), kws = KSWZ(sr, sc * 2);
    const int vb0 = (int)(uintptr_t)V_lds + v_rd_base(lane);
    const bf16_t* Kh = cur.K; const bf16_t* Vh = cur.V;
    Seam S;
#pragma unroll
    for (int d0 = 0; d0 < 8; ++d0) S.qr[d0] = load8(cur.Q + (size_t)(wid * QBLK + r32) * D + d0 * 16 + hi * 8);
    SLOAD_H(Kh, Vh, KBASE(0)); VMW(); SWRITE_H(0);
    __syncthreads();
    f32x16 o[4] = {}; float carry = 0.f; const float mlo = hi ? 0.f : 1.f;
    bool wdone = false;
#define SB_STEP(tt, BUF) {                                                                                                 \
        const int kb_ = KBASE(tt);                                                                                           \
        if ((tt) + 1 < NT) SLOAD_H(Kh, Vh, KBASE((tt) + 1));                                                                 \
        SBAR();                                                                                                              \
        if (!wdone && kb_ <= qlo + QBLK - 2) {                                                                               \
            f32x16 p0, p1; bf16x8 pa0, pa1, pa2, pa3;                                                                        \
            qkt<BUF, false>(p0, p1, K_lds, r32, hi, S.qr, nullptr);                                                          \
            if (kb_ + KVBLK - 1 > qlo - 1) mask_tile(p0, p1, qm - kb_);                                                      \
            sb_part1(p0, p1, carry, mlo); sb_part2(p0, p1, pa0, pa1, pa2, pa3); SBAR();                                      \
            pv_tile<BUF>(o, vb0, pa0, pa1, pa2, pa3);                                                                        \
            wdone = __all(carry >= SB_TH);                                                                                   \
        }                                                                                                                    \
        if ((tt) + 1 < NT) { VMW(); SWRITE_H((BUF) ^ 1); }                                                                   \
        if (lane == 0) flags[((tt) & 1) * 8 + wid] = wdone ? 1 : 0;                                                          \
        __syncthreads();                                                                                                     \
        { int alld = 1;                                                                                                      \
          _Pragma("unroll") for (int w_ = 0; w_ < 8; ++w_) alld &= flags[((tt) & 1) * 8 + w_];                                \
          if (alld) break; } }
    for (int t = 0; t < NT; t += 2) {
        SB_STEP(t, 0)
        SB_STEP(t + 1, 1)
    }
#undef SB_STEP
#pragma unroll
    for (int r = 0; r < 16; ++r) { const int orow = cur.P0 + wid * QBLK + crow(r, hi);
#pragma unroll
        for (int d0 = 0; d0 < 4; ++d0) {
            const float v = o[d0][r];
            const float vn = sx_f(v, 1);
            if ((r32 & 1) == 0) *(unsigned*)(outp + (size_t)orow * DM + d0 * 32 + r32) = cvt_pk_bf16(v, vn); } }
    __syncthreads();
#undef KBASE
}
#undef ROW
#undef VMW
#undef SLOAD_H
#undef SWRITE_HK
#undef SWRITE_HV
#undef SWRITE_H
}

#define XB_TMO      128
#define XB_XCNT(j)  (256  + 64 * (j))
#define XB_XSUB(j)  (1280 + 64 * (j))
#define XB_XGEN(j)  (2304 + 64 * (j))
#define XB_TOP      3328
#define XB_TOPGEN   3392
#define XCD_BAR_WORDS 3456
#define XB_SPIN_CAP (1u << 20)
__device__ __forceinline__ unsigned xb_ld(unsigned* p)              { return __hip_atomic_load(p, __ATOMIC_RELAXED, __HIP_MEMORY_SCOPE_AGENT); }
__device__ __forceinline__ unsigned xb_add(unsigned* p, unsigned v) { return __hip_atomic_fetch_add(p, v, __ATOMIC_RELAXED, __HIP_MEMORY_SCOPE_AGENT); }
__device__ __forceinline__ unsigned xb_xcc_id() { return (unsigned)__builtin_amdgcn_s_getreg((3 << 11) | 20) & 0xFu; }
#define XB_SPIN(cond, bar) do { unsigned _sp = 0; while (cond) { __builtin_amdgcn_s_sleep(1); \
    if ((++_sp & 255u) == 0u) { if (xb_ld(&(bar)[XB_TMO])) break; if (_sp > XB_SPIN_CAP) { atomicAdd(&(bar)[XB_TMO], 1u); break; } } } } while (0)
struct XcdBarrier { unsigned* bar; unsigned x; volatile LAS unsigned* st; };
__device__ __forceinline__ XcdBarrier xcd_barrier_post(unsigned* bar, volatile LAS unsigned* st) {
    XcdBarrier b; b.bar = bar; b.x = xb_xcc_id(); b.st = st;
    if (threadIdx.x == 0) (void)xb_add(&bar[XB_XCNT(b.x)], 1u);
    return b;
}
__device__ __forceinline__ void xcd_barrier_complete(unsigned* bar, unsigned x, unsigned& nloc, unsigned& nx) {
    const unsigned G = gridDim.x * gridDim.y * gridDim.z;
    unsigned sum, cnt, mine, sp = 0u;
    for (;;) {
        sum = 0u; cnt = 0u; mine = 0u;
#pragma unroll
        for (unsigned j = 0; j < 16; ++j) { const unsigned c = xb_ld(&bar[XB_XCNT(j)]); sum += c; cnt += (c > 0u) ? 1u : 0u; mine = (j == x) ? c : mine; }
        if (sum == G) break;
        __builtin_amdgcn_s_sleep(1);
        if ((++sp & 255u) == 0u) { if (xb_ld(&bar[XB_TMO])) break; if (sp > XB_SPIN_CAP) { atomicAdd(&bar[XB_TMO], 1u); break; } }
    }
    nloc = mine > 0u ? mine : 1u; nx = cnt > 0u ? cnt : 1u;
}
__device__ __forceinline__ void xcd_barrier(const XcdBarrier& b) {
    asm volatile("s_waitcnt vmcnt(0)" ::: "memory");
    __syncthreads();
    if (threadIdx.x == 0) {
        unsigned* bar = b.bar;
        __builtin_amdgcn_s_waitcnt(0);
        unsigned nloc = b.st[0], nx = b.st[1];
        if (nloc == 0u) { xcd_barrier_complete(bar, b.x, nloc, nx); b.st[0] = nloc; b.st[1] = nx; }
        const unsigned old = xb_add(&bar[XB_XSUB(b.x)], 1u);
        const unsigned gen = old / nloc;
        if (old + 1u == (gen + 1u) * nloc) {
            __builtin_amdgcn_fence(__ATOMIC_RELEASE, "agent");
            asm volatile("s_waitcnt vmcnt(0)" ::: "memory");
            const unsigned og = xb_add(&bar[XB_TOP], 1u);
            const unsigned tg = og / nx;
            if (og + 1u == (tg + 1u) * nx) xb_add(&bar[XB_TOPGEN], 1u);
            else XB_SPIN(xb_ld(&bar[XB_TOPGEN]) == tg, bar);
            __builtin_amdgcn_fence(__ATOMIC_ACQUIRE, "agent");
            xb_add(&bar[XB_XGEN(b.x)], 1u);
            asm volatile("s_waitcnt vmcnt(0)" ::: "memory");
        } else {
            XB_SPIN(xb_ld(&bar[XB_XGEN(b.x)]) == gen, bar);
            __builtin_amdgcn_fence(__ATOMIC_ACQUIRE, "agent");
            asm volatile("s_waitcnt vmcnt(0)" ::: "memory");
        }
    }
    __syncthreads();
}

struct Args { const float* in[12]; float* out; unsigned char* ws; int ph_lo, ph_hi; };

__device__ __forceinline__ void p0_transpose_item(const float* W, int ldw, int K, bf16_t* WT, int nblk, LAS float* scr, int item, int lane, const float* gk) {
    const int kb = item / nblk, nb = item % nblk, k0 = 64 * kb, n0 = 32 * nb;
    { const int rr = lane >> 3, c4 = lane & 7; f32x4 v[8];
#pragma unroll
      for (int i = 0; i < 8; ++i) v[i] = *(const f32x4*)(W + (size_t)(k0 + rr + 8 * i) * ldw + n0 + 4 * c4);
#pragma unroll
      for (int i = 0; i < 8; ++i) { const int kk = rr + 8 * i; const float gm = gk ? gk[k0 + kk] : 1.f;
          scr[kk * 33 + 4 * c4] = v[i][0] * gm; scr[kk * 33 + 4 * c4 + 1] = v[i][1] * gm; scr[kk * 33 + 4 * c4 + 2] = v[i][2] * gm; scr[kk * 33 + 4 * c4 + 3] = v[i][3] * gm; } }
    LDS_WAIT(); asm volatile("" ::: "memory");
    const int c = lane & 7;
#pragma unroll
    for (int j = 0; j < 4; ++j) { const int n = (lane >> 3) + 8 * j; const LAS float* s = scr + (8 * c) * 33 + n;
        u32x4 o; o.x = cvt_pk_bf16(s[0 * 33], s[1 * 33]); o.y = cvt_pk_bf16(s[2 * 33], s[3 * 33]); o.z = cvt_pk_bf16(s[4 * 33], s[5 * 33]); o.w = cvt_pk_bf16(s[6 * 33], s[7 * 33]);
        *(u32x4*)(WT + (size_t)(n0 + n) * K + k0 + 8 * c) = o; }
    LDS_WAIT(); asm volatile("" ::: "memory");
}

__device__ __forceinline__ int pack_i8(float a, float b, float c, float d) {
    const int ia = (int)__builtin_rintf(a), ib = (int)__builtin_rintf(b), ic = (int)__builtin_rintf(c), id = (int)__builtin_rintf(d);
    return (int)(((unsigned)ia & 0xffu) | (((unsigned)ib & 0xffu) << 8) | (((unsigned)ic & 0xffu) << 16) | ((unsigned)id << 24));
}
__device__ __forceinline__ void convert_tables(const Args& a, int r0, int r1, int worker, int nworkers) {
    const int lane = tid_opaque() & 63;
    unsigned char* ws = a.ws; const float* g_ffn = a.in[7]; const float* pu = a.in[10]; const float* pv = a.in[11];
    float* suv = (float*)(ws + WS_SUV);
    for (int r = r0 + worker; r < r1; r += nworkers) {
        const bool isv = r >= NEXP; const int e = isv ? r - NEXP : r;
        const f32x4* srcp = (const f32x4*)((isv ? pv : pu) + (size_t)e * DM);
        f32x4 v[8]; float amax = 0.f;
#pragma unroll
        for (int j = 0; j < 8; ++j) { v[j] = srcp[lane + 64 * j];
            if (!isv) { const f32x4 g4 = *(const f32x4*)(g_ffn + 4 * (lane + 64 * j)); v[j] = v[j] * g4; }
            amax = fmaxf(amax, fmaxf(fmaxf(fabsf(v[j][0]), fabsf(v[j][1])), fmaxf(fabsf(v[j][2]), fabsf(v[j][3])))); }
        amax = wave_max(amax);
        const float sc = amax > 0.f ? 127.f / amax : 1.f;
        unsigned char* dst = ws + (isv ? WS_V8 : WS_U8) + (size_t)e * 128;
#pragma unroll
        for (int j = 0; j < 8; ++j) { const int p = pack_i8(v[j][0] * sc, v[j][1] * sc, v[j][2] * sc, v[j][3] * sc);
            const int col = 4 * (lane + 64 * j);
            *(unsigned*)(dst + (size_t)(col >> 7) * ((size_t)NEXP * 128) + (col & 127)) = (unsigned)p; }
        if (lane == 0) suv[r] = 1.f / sc;
    }
}
constexpr int TAB_SPLIT = NEXP;

__device__ __forceinline__ void p0_transpose_item_i8(const float* W, int ldw, int K, unsigned char* WT, int nblk, LAS float* scr, int item, int lane, float q8) {
    const int kb = item / nblk, nb = item % nblk, k0 = 64 * kb, n0 = 32 * nb;
    { const int rr = lane >> 3, c4 = lane & 7; f32x4 v[8];
#pragma unroll
      for (int i = 0; i < 8; ++i) v[i] = *(const f32x4*)(W + (size_t)(k0 + rr + 8 * i) * ldw + n0 + 4 * c4);
#pragma unroll
      for (int i = 0; i < 8; ++i) { const int kk = rr + 8 * i;
          scr[kk * 33 + 4 * c4] = v[i][0] * q8; scr[kk * 33 + 4 * c4 + 1] = v[i][1] * q8; scr[kk * 33 + 4 * c4 + 2] = v[i][2] * q8; scr[kk * 33 + 4 * c4 + 3] = v[i][3] * q8; } }
    LDS_WAIT(); asm volatile("" ::: "memory");
    const int c = lane & 7;
#pragma unroll
    for (int j = 0; j < 4; ++j) { const int n = (lane >> 3) + 8 * j; const LAS float* s = scr + (8 * c) * 33 + n;
        u32x2 o; o.x = (unsigned)pack_i8(s[0 * 33], s[1 * 33], s[2 * 33], s[3 * 33]); o.y = (unsigned)pack_i8(s[4 * 33], s[5 * 33], s[6 * 33], s[7 * 33]);
        *(u32x2*)(WT + (size_t)(n0 + n) * K + k0 + 8 * c) = o; }
    LDS_WAIT(); asm volatile("" ::: "memory");
}
__device__ __forceinline__ float log_sigmoid_f(float x) { return fminf(x, 0.f) - log1pf(expf(-fabsf(x))); }

__device__ __forceinline__ void phase0(const Args& a, unsigned char* lds_g) {
    LAS unsigned char* lds = (LAS unsigned char*)lds_g;
    const int tid = tid_opaque(), lane = tid & 63, wave = __builtin_amdgcn_readfirstlane(tid >> 6);
    const int gw = blockIdx.x * NWAVES + wave, NGW = gridDim.x * NWAVES;
    const int gt = blockIdx.x * NTHREADS + tid, NGT = gridDim.x * NTHREADS;
    unsigned char* ws = a.ws;
    const float* x = a.in[0]; const float* g_attn = a.in[1]; const float* w_in = a.in[2]; const float* b_forget = a.in[3];
    const float* w_out = a.in[6]; const float* g_ffn = a.in[7]; const float* w_pq = a.in[8]; const float* sk = a.in[9]; const float* pu = a.in[10]; const float* pv = a.in[11];
    { float m = 0.f; const f32x4* wp = (const f32x4*)w_in;
      for (size_t i = gt; i < (size_t)DM * DIN / 4; i += NGT) { const f32x4 v = wp[i]; m = fmaxf(m, fmaxf(fmaxf(fabsf(v[0]), fabsf(v[1])), fmaxf(fabsf(v[2]), fabsf(v[3])))); }
      m = wave_max(m);
      if (lane == 0) __hip_atomic_fetch_max((unsigned*)(ws + WS_CTL) + CW_WMAX, __float_as_uint(m), __ATOMIC_RELAXED, __HIP_MEMORY_SCOPE_AGENT); }
    LAS float* wf = (LAS float*)(lds + 67584);
    for (int k = tid; k < DM; k += NTHREADS) { const f32x4 a0 = *(const f32x4*)(w_in + (size_t)k * DIN + NPROJ), a1 = *(const f32x4*)(w_in + (size_t)k * DIN + NPROJ + 4);
        *(LAS f32x4*)(wf + k * 8) = a0; *(LAS f32x4*)(wf + k * 8 + 4) = a1; }
    __syncthreads();
    for (int row = gw; row < T; row += NGW) {
        const f32x4* xr = (const f32x4*)(x + (size_t)row * DM);
        f32x4 v[8]; float ss = 0.f;
#pragma unroll
        for (int j = 0; j < 8; ++j) { v[j] = xr[lane + 64 * j]; ss += v[j][0] * v[j][0] + v[j][1] * v[j][1] + v[j][2] * v[j][2] + v[j][3] * v[j][3]; }
        const float r = 1.0f / sqrtf(wave_sum(ss) * (1.f / DM) + EPS);
        float f[8] = {0.f, 0.f, 0.f, 0.f, 0.f, 0.f, 0.f, 0.f};
        float xmax = 0.f;
#pragma unroll
        for (int j = 0; j < 8; ++j) { const f32x4 g4 = *(const f32x4*)(g_attn + 4 * (lane + 64 * j)); v[j][0] *= r * g4[0]; v[j][1] *= r * g4[1]; v[j][2] *= r * g4[2]; v[j][3] *= r * g4[3];
            xmax = fmaxf(xmax, fmaxf(fmaxf(fabsf(v[j][0]), fabsf(v[j][1])), fmaxf(fabsf(v[j][2]), fabsf(v[j][3])))); }
        xmax = wave_max(xmax);
        const float xq = xmax > 0.f ? 127.f / xmax : 1.f;
        if (lane == 0) ((float*)(ws + WS_SXN))[row] = xmax * (1.f / 127.f);
        unsigned* o8 = (unsigned*)(ws + WS_XN + (size_t)row * DM);
#pragma unroll
        for (int j = 0; j < 8; ++j) {
            const int e = 4 * (lane + 64 * j);
            const f32x4 xn = v[j];
            o8[lane + 64 * j] = (unsigned)pack_i8(xn[0] * xq, xn[1] * xq, xn[2] * xq, xn[3] * xq);
#pragma unroll
            for (int q = 0; q < 4; ++q) { const f32x4 w0 = *(LAS f32x4*)(wf + (e + q) * 8), w1 = *(LAS f32x4*)(wf + (e + q) * 8 + 4);
                f[0] += xn[q] * w0[0]; f[1] += xn[q] * w0[1]; f[2] += xn[q] * w0[2]; f[3] += xn[q] * w0[3];
                f[4] += xn[q] * w1[0]; f[5] += xn[q] * w1[1]; f[6] += xn[q] * w1[2]; f[7] += xn[q] * w1[3]; }
            __builtin_amdgcn_sched_barrier(0);
        }
#pragma unroll
        for (int hh = 0; hh < 8; ++hh) f[hh] = wave_sum(f[hh]);
        if (lane < 8) { float fl = f[0];
#pragma unroll
            for (int hh = 1; hh < 8; ++hh) fl = (lane == hh) ? f[hh] : fl;
            const int b = row >> 12, s = row & 4095;
            ((float*)(ws + WS_LOGF))[(size_t)(b * 8 + lane) * SEQ + s] = log_sigmoid_f(fl + b_forget[lane]); }
    }
    LAS float* scr = (LAS float*)(lds + wave * 8448);
    constexpr int I_IN = (DM / 64) * (NPROJ / 32), I_O = (DM / 64) * (DM / 32);
    for (int it = gw; it < 2 * I_O; it += NGW) {
        int r = it;
        if (r < I_O) { p0_transpose_item(w_out, DM, DM, (bf16_t*)(ws + WS_WOUT), DM / 32, scr, r, lane, nullptr); continue; } r -= I_O;
        p0_transpose_item(w_pq, DM, DM, (bf16_t*)(ws + WS_WPQ), DM / 32, scr, r, lane, g_ffn);
    }
    for (int i = gt; i < 8 * 2 * 128 * 128 / 8; i += NGT) { const f32x4 a0 = *(const f32x4*)(sk + (size_t)i * 8), a1 = *(const f32x4*)(sk + (size_t)i * 8 + 4);
        u32x4 w; w.x = cvt_pk_bf16(a0[0], a0[1]); w.y = cvt_pk_bf16(a0[2], a0[3]); w.z = cvt_pk_bf16(a1[0], a1[1]); w.w = cvt_pk_bf16(a1[2], a1[3]);
        *(u32x4*)(ws + WS_SK + (size_t)i * 16) = w; }
    if (gt < 256) ((float*)(ws + WS_GQK))[gt] = gt < 128 ? a.in[4][gt] : a.in[5][gt - 128];
    convert_tables(a, 0, TAB_SPLIT, gw, NGW);
    { XcdBarrier xb_; xb_.bar = (unsigned*)(ws + WS_CTL) + CW_BAR; xb_.x = xb_xcc_id(); xb_.st = (volatile LAS unsigned*)(lds + MISC_OFF) + 8; xcd_barrier(xb_); }
    const float wmax = __uint_as_float(__hip_atomic_load((unsigned*)(ws + WS_CTL) + CW_WMAX, __ATOMIC_RELAXED, __HIP_MEMORY_SCOPE_AGENT));
    if (gt == 0) *(float*)(ws + WS_WSC) = wmax * (1.f / 127.f);
    const float q8 = wmax > 0.f ? 127.f / wmax : 1.f;
    for (int it = gw; it < I_IN; it += NGW) p0_transpose_item_i8(w_in, DIN, DM, ws + WS_WIN, NPROJ / 32, scr, it, lane, q8);
}

__device__ __forceinline__ void cumsum_rows(const Args& a) {
    const int tid = tid_opaque(), lane = tid & 63, wave = tid >> 6;
    if (blockIdx.x >= 16 || wave != 0) return;
    const float* src = (const float*)(a.ws + WS_LOGF) + (size_t)blockIdx.x * SEQ + lane * 64;
    float* dst = (float*)(a.ws + WS_C) + (size_t)blockIdx.x * SEQ + lane * 64;
    f32x4 v[16]; float run = 0.f;
#pragma unroll
    for (int i = 0; i < 16; ++i) { v[i] = *(const f32x4*)(src + 4 * i);
#pragma unroll
        for (int q = 0; q < 4; ++q) { run += v[i][q]; v[i][q] = run; } }
    float incl = run;
#pragma unroll
    for (int o = 1; o < 64; o <<= 1) { const float t = shup_f(incl, o); if (lane >= o) incl += t; }
    const float off = incl - run;
#pragma unroll
    for (int i = 0; i < 16; ++i) { f32x4 w = v[i]; w[0] += off; w[1] += off; w[2] += off; w[3] += off; *(f32x4*)(dst + 4 * i) = w; }
}

__device__ __forceinline__ void phase_qknorm(const Args& a) {
    const int tid = tid_opaque(), lane = tid & 63, wave = tid >> 6;
    const int gw = blockIdx.x * NWAVES + wave, NGW = gridDim.x * NWAVES;
    const int sub = lane & 15, rw = lane >> 4;
    const float* gq = a.in[4]; const float* gk = a.in[5];
    constexpr int ROWS = NB * NHF * SEQ;
    for (int it = gw; it < 2 * ROWS / 4; it += NGW) {
        const int row = it * 4 + rw; const bool isk = row >= ROWS;
        bf16_t* p = (bf16_t*)(a.ws + WS_SEC) + (size_t)row * HD + sub * 8;
        const float* g = (isk ? gk : gq) + sub * 8;
        const u32x4 w = *(const u32x4*)p;
        float v[8] = {bf_lo(w.x), bf_hi(w.x), bf_lo(w.y), bf_hi(w.y), bf_lo(w.z), bf_hi(w.z), bf_lo(w.w), bf_hi(w.w)};
        float ss = 0.f;
#pragma unroll
        for (int i = 0; i < 8; ++i) ss += v[i] * v[i];
        ss += sx_f(ss, 1); ss += sx_f(ss, 2); ss += sx_f(ss, 4); ss += sx_f(ss, 8);
        const float r = 1.0f / sqrtf(ss * (1.f / HD) + EPS);
        const f32x4 g0 = *(const f32x4*)g, g1 = *(const f32x4*)(g + 4);
        u32x4 o; o.x = cvt_pk_bf16(v[0] * r * g0[0], v[1] * r * g0[1]); o.y = cvt_pk_bf16(v[2] * r * g0[2], v[3] * r * g0[3]);
        o.z = cvt_pk_bf16(v[4] * r * g1[0], v[5] * r * g1[1]); o.w = cvt_pk_bf16(v[6] * r * g1[2], v[7] * r * g1[3]);
        *(u32x4*)p = o;
    }
}

__device__ __forceinline__ void phase_attn(const Args& a, unsigned char* lds_g) {
    const int tid = tid_opaque();
    volatile int* s_item = (volatile int*)(lds_g + MISC_OFF);
    unsigned* ctr = (unsigned*)(a.ws + WS_CTL);
    for (;;) {
        __syncthreads();
        if (tid == 0) *s_item = (int)atomicAdd(ctr, 1u);
        __syncthreads();
        int it = *s_item, kind = -1, qb = 0, sub = 0;
#define CLS(K, Q, CNT) if (kind < 0) { if (it < (CNT)) { kind = (K); qb = (Q); sub = it; } else it -= (CNT); }
        CLS(2, 15, 32) CLS(1, 7, 16) CLS(2, 14, 32) CLS(2, 13, 32) CLS(1, 6, 16) CLS(2, 12, 32) CLS(2, 11, 32) CLS(1, 5, 16) CLS(2, 10, 32) CLS(2, 9, 32) CLS(1, 4, 16) CLS(2, 8, 32) CLS(1, 3, 16) CLS(1, 2, 16)
        if (kind < 0) { if (it < 256) { kind = 0; qb = 15 - (it >> 4); sub = it & 15; } else it -= 256; }
        CLS(1, 1, 16) CLS(1, 0, 16)
#undef CLS
        if (kind < 0) break;
        unsigned char* wsl = a.ws; asm volatile("" : "+s"(wsl));
        bf16_t* sec = (bf16_t*)(wsl + WS_SEC);
        const int bh = sub & 15, part = (kind == 2) ? 1 + (sub >> 4) : 0;
        const int b = bh >> 3, h = bh & 7;
        const size_t hoff = (size_t)bh * SEQ * HD;
        att::UnitRef u;
        u.P0 = qb * 256;
        if (kind == 0) {
            u.Q = sec + 4 * SEC_ELEMS + hoff + (size_t)u.P0 * HD; u.K = sec + 5 * SEC_ELEMS + hoff; u.V = sec + 6 * SEC_ELEMS + hoff;
            att::sb_unit(u, (bf16_t*)(wsl + WS_MIX) + (size_t)b * SEQ * DM + 1024 + h * HD, (char*)lds_g);
        } else {
            u.Q = sec + 0 * SEC_ELEMS + hoff + (size_t)u.P0 * HD; u.K = sec + 1 * SEC_ELEMS + hoff; u.V = sec + 2 * SEC_ELEMS + hoff;
            att::attn_unit<false>(u, wsl, bh, (char*)lds_g, part);
        }
    }
}
__device__ __forceinline__ void phase_attn_combine(const Args& a) {
    const int gt = blockIdx.x * NTHREADS + tid_opaque(), NGT = gridDim.x * NTHREADS;
    const float* po = (const float*)(a.ws + WS_PO); const float* pml = (const float*)(a.ws + WS_PML);
    const bf16_t* gate = (const bf16_t*)(a.ws + WS_SEC) + 3 * SEC_ELEMS; bf16_t* mix = (bf16_t*)(a.ws + WS_MIX);
    constexpr float C2 = LOG2E * SCALE;
    for (int item = gt; item < 128 * 256 * 16; item += NGT) {
        const int slot = item >> 12, row = (item >> 4) & 255, cg = item & 15;
        const int qb = 8 + (slot >> 4), bh = slot & 15, b = bh >> 3, h = bh & 7;
        const f32x2 ml1 = *(const f32x2*)(pml + (size_t)(slot * 2) * 512 + row * 2), ml2 = *(const f32x2*)(pml + (size_t)(slot * 2 + 1) * 512 + row * 2);
        const float M = fmaxf(ml1.x, ml2.x), a1 = __builtin_amdgcn_exp2f((ml1.x - M) * C2), a2 = __builtin_amdgcn_exp2f((ml2.x - M) * C2);
        const float inv = 1.f / (a1 * ml1.y + a2 * ml2.y);
        const float* p1 = po + (size_t)(slot * 2) * 32768 + row * 128 + cg * 8; const float* p2 = p1 + 32768;
        const f32x4 x0 = *(const f32x4*)p1, x1 = *(const f32x4*)(p1 + 4), y0 = *(const f32x4*)p2, y1 = *(const f32x4*)(p2 + 4);
        const size_t tok = (size_t)b * SEQ + qb * 256 + row;
        const u32x4 gw = *(const u32x4*)(gate + tok * 1024 + h * HD + cg * 8);
        const float w1 = a1 * inv, w2 = a2 * inv;
        u32x4 o;
        o.x = cvt_pk_bf16((w1 * x0[0] + w2 * y0[0]) * bf_lo(gw.x), (w1 * x0[1] + w2 * y0[1]) * bf_hi(gw.x));
        o.y = cvt_pk_bf16((w1 * x0[2] + w2 * y0[2]) * bf_lo(gw.y), (w1 * x0[3] + w2 * y0[3]) * bf_hi(gw.y));
        o.z = cvt_pk_bf16((w1 * x1[0] + w2 * y1[0]) * bf_lo(gw.z), (w1 * x1[1] + w2 * y1[1]) * bf_hi(gw.z));
        o.w = cvt_pk_bf16((w1 * x1[2] + w2 * y1[2]) * bf_lo(gw.w), (w1 * x1[3] + w2 * y1[3]) * bf_hi(gw.w));
        *(u32x4*)(mix + tok * DM + h * HD + cg * 8) = o;
    }
}

__device__ __forceinline__ unsigned f2ord(float f) { const unsigned u = __float_as_uint(f); return u ^ ((unsigned)((int)u >> 31) | 0x80000000u); }
__device__ __forceinline__ float ord2f(unsigned k) { const unsigned u = k ^ (~(unsigned)((int)k >> 31) | 0x80000000u); return __uint_as_float(u); }
#define INS16(L, X) do { unsigned x_ = (X); _Pragma("unroll") for (int i_ = 0; i_ < 16; ++i_) { const unsigned hi_ = max(L[i_], x_); x_ = min(L[i_], x_); L[i_] = hi_; } } while (0)
__device__ __forceinline__ void sort16_desc(unsigned (&a)[16]) {
#pragma unroll
    for (int k = 2; k <= 16; k <<= 1)
#pragma unroll
        for (int j = k >> 1; j > 0; j >>= 1)
#pragma unroll
            for (int i = 0; i < 16; ++i) { const int l = i ^ j; if (l > i) { const unsigned hi_ = max(a[i], a[l]), lo_ = min(a[i], a[l]); const bool desc = (i & k) == 0; a[i] = desc ? hi_ : lo_; a[l] = desc ? lo_ : hi_; } }
}
__device__ __forceinline__ void merge_top16(unsigned (&a)[16], const unsigned (&b)[16]) {
#pragma unroll
    for (int i = 0; i < 16; ++i) a[i] = max(a[i], b[15 - i]);
#pragma unroll
    for (int j = 8; j > 0; j >>= 1)
#pragma unroll
        for (int i = 0; i < 16; ++i) { const int l = i ^ j; if (l > i) { const unsigned hi_ = max(a[i], a[l]), lo_ = min(a[i], a[l]); a[i] = hi_; a[l] = lo_; } }
}
__device__ __forceinline__ void topk_half(const bf16_t* qrow  , const bf16_t* skb, int h, int c, int r32, int hi, unsigned (&L)[16]) {
    bf16x8 qf[8];
#pragma unroll
    for (int d0 = 0; d0 < 8; ++d0) qf[d0] = *(const bf16x8*)(qrow + c * 128 + d0 * 16 + hi * 8);
    const unsigned hi4 = 4u * (unsigned)hi;
#pragma unroll
    for (int kt = 0; kt < 4; ++kt) {
        f32x16 acc = f32x16{};
#pragma unroll
        for (int d0 = 0; d0 < 8; ++d0) { const bf16x8 kf = *(const bf16x8*)(skb + (size_t)((h * 2 + c) * 128 + kt * 32 + r32) * 128 + d0 * 16 + hi * 8);
            acc = __builtin_amdgcn_mfma_f32_32x32x16_bf16(kf, qf[d0], acc, 0, 0, 0); }
        __builtin_amdgcn_sched_barrier(0);
        unsigned G[16];
#pragma unroll
        for (int r = 0; r < 16; ++r) { const unsigned cst = (unsigned)(127 - (kt * 32 + (r & 3) + 8 * (r >> 2))); G[r] = (f2ord(acc[r]) & ~127u) | (cst - hi4); }
        sort16_desc(G);
        if (kt == 0) {
#pragma unroll
            for (int i = 0; i < 16; ++i) L[i] = G[i];
        } else merge_top16(L, G);
        __builtin_amdgcn_sched_barrier(0);
    }
    unsigned P[16];
#pragma unroll
    for (int i = 0; i < 16; ++i) { auto rr = __builtin_amdgcn_permlane32_swap(L[i], L[i], false, false); P[i] = hi ? rr[0] : rr[1]; }
    merge_top16(L, P);
}
__device__ __forceinline__ void topk_task(unsigned char* ws, const bf16_t* qrow, LAS int* tb, int t0, int h, int lane) {
    const int r32 = lane & 31, hi = lane >> 5;
    const bf16_t* skb = (const bf16_t*)(ws + WS_SK);
    int* idx_o = (int*)(ws + WS_IDX); float* gw_o = (float*)(ws + WS_GW);
    float rt_l;
    { const f32x4* sp = (const f32x4*)((const float*)(ws + WS_SSQ) + (size_t)(t0 + (lane & 31)) * 32); float tot = 0.f;
#pragma unroll
      for (int i = 0; i < 8; ++i) { const f32x4 v = sp[i]; tot += (v[0] + v[1]) + (v[2] + v[3]); }
      rt_l = 1.0f / sqrtf(tot * (1.f / DM) + EPS); }
        {
          const bf16_t* hbp = (const bf16_t*)(ws + WS_HB); const float* amx = (const float*)(ws + WS_AMX); unsigned char* xq = ws + WS_XQ;
          float am = 0.f;
          { const f32x4* ap = (const f32x4*)(amx + (size_t)(t0 + (lane & 31)) * 32);
#pragma unroll
            for (int i = 0; i < 8; ++i) { const f32x4 v = ap[i]; am = fmaxf(am, fmaxf(fmaxf(v[0], v[1]), fmaxf(v[2], v[3]))); } }
          if (h == 0 && lane < 32) ((float*)(ws + WS_SX))[t0 + lane] = rt_l * am * (1.f / 126.5f);
          const float qs = am > 0.f ? 126.5f / am : 1.f;
#pragma unroll 4
          for (int j = 0; j < 16; ++j) { const int ch = lane + 64 * j, tl = ch >> 5, tk = t0 + tl, col = h * 256 + (ch & 31) * 8;
              const u32x4 w = *(const u32x4*)(hbp + (size_t)tk * DM + col); const float r = sh_f(qs, tl);
              const int p0 = pack_i8(bf_lo(w.x) * r, bf_hi(w.x) * r, bf_lo(w.y) * r, bf_hi(w.y) * r), p1 = pack_i8(bf_lo(w.z) * r, bf_hi(w.z) * r, bf_lo(w.w) * r, bf_hi(w.w) * r);
              *(u32x2*)(xq + (size_t)tk * DM + col) = (u32x2){(unsigned)p0, (unsigned)p1}; } }
        unsigned L[2][16];
        topk_half(qrow, skb, h, 0, r32, hi, L[0]);
        __builtin_amdgcn_sched_barrier(0);
        topk_half(qrow, skb, h, 1, r32, hi, L[1]);
        __builtin_amdgcn_sched_barrier(0);
        float s1[16], s2[16]; int i1[16], i2[16];
#pragma unroll
        for (int i = 0; i < 16; ++i) { s1[i] = ord2f((L[0][i] & ~127u) | 64u); i1[i] = 127 - (int)(L[0][i] & 127u); s2[i] = ord2f((L[1][i] & ~127u) | 64u); i2[i] = 127 - (int)(L[1][i] & 127u); }
        unsigned CG[4][16];
#pragma unroll
        for (int i = 0; i < 64; ++i) CG[i >> 4][i & 15] = 0u;
        CG[0][0] = (f2ord(s1[0] + s2[0]) & ~255u) | 0u;
        CG[0][1] = (f2ord(s1[0] + s2[1]) & ~255u) | 1u;
        CG[0][2] = (f2ord(s1[0] + s2[2]) & ~255u) | 2u;
        CG[0][3] = (f2ord(s1[0] + s2[3]) & ~255u) | 3u;
        CG[0][4] = (f2ord(s1[0] + s2[4]) & ~255u) | 4u;
        CG[0][5] = (f2ord(s1[0] + s2[5]) & ~255u) | 5u;
        CG[0][6] = (f2ord(s1[0] + s2[6]) & ~255u) | 6u;
        CG[0][7] = (f2ord(s1[0] + s2[7]) & ~255u) | 7u;
        CG[0][8] = (f2ord(s1[0] + s2[8]) & ~255u) | 8u;
        CG[0][9] = (f2ord(s1[0] + s2[9]) & ~255u) | 9u;
        CG[0][10] = (f2ord(s1[0] + s2[10]) & ~255u) | 10u;
        CG[0][11] = (f2ord(s1[0] + s2[11]) & ~255u) | 11u;
        CG[0][12] = (f2ord(s1[0] + s2[12]) & ~255u) | 12u;
        CG[0][13] = (f2ord(s1[0] + s2[13]) & ~255u) | 13u;
        CG[0][14] = (f2ord(s1[0] + s2[14]) & ~255u) | 14u;
        CG[0][15] = (f2ord(s1[0] + s2[15]) & ~255u) | 15u;
        CG[1][0] = (f2ord(s1[1] + s2[0]) & ~255u) | 16u;
        CG[1][1] = (f2ord(s1[1] + s2[1]) & ~255u) | 17u;
        CG[1][2] = (f2ord(s1[1] + s2[2]) & ~255u) | 18u;
        CG[1][3] = (f2ord(s1[1] + s2[3]) & ~255u) | 19u;
        CG[1][4] = (f2ord(s1[1] + s2[4]) & ~255u) | 20u;
        CG[1][5] = (f2ord(s1[1] + s2[5]) & ~255u) | 21u;
        CG[1][6] = (f2ord(s1[1] + s2[6]) & ~255u) | 22u;
        CG[1][7] = (f2ord(s1[1] + s2[7]) & ~255u) | 23u;
        CG[1][8] = (f2ord(s1[2] + s2[0]) & ~255u) | 32u;
        CG[1][9] = (f2ord(s1[2] + s2[1]) & ~255u) | 33u;
        CG[1][10] = (f2ord(s1[2] + s2[2]) & ~255u) | 34u;
        CG[1][11] = (f2ord(s1[2] + s2[3]) & ~255u) | 35u;
        CG[1][12] = (f2ord(s1[2] + s2[4]) & ~255u) | 36u;
        CG[1][13] = (f2ord(s1[3] + s2[0]) & ~255u) | 48u;
        CG[1][14] = (f2ord(s1[3] + s2[1]) & ~255u) | 49u;
        CG[1][15] = (f2ord(s1[3] + s2[2]) & ~255u) | 50u;
        CG[2][0] = (f2ord(s1[3] + s2[3]) & ~255u) | 51u;
        CG[2][1] = (f2ord(s1[4] + s2[0]) & ~255u) | 64u;
        CG[2][2] = (f2ord(s1[4] + s2[1]) & ~255u) | 65u;
        CG[2][3] = (f2ord(s1[4] + s2[2]) & ~255u) | 66u;
        CG[2][4] = (f2ord(s1[5] + s2[0]) & ~255u) | 80u;
        CG[2][5] = (f2ord(s1[5] + s2[1]) & ~255u) | 81u;
        CG[2][6] = (f2ord(s1[6] + s2[0]) & ~255u) | 96u;
        CG[2][7] = (f2ord(s1[6] + s2[1]) & ~255u) | 97u;
        CG[2][8] = (f2ord(s1[7] + s2[0]) & ~255u) | 112u;
        CG[2][9] = (f2ord(s1[7] + s2[1]) & ~255u) | 113u;
        CG[2][10] = (f2ord(s1[8] + s2[0]) & ~255u) | 128u;
        CG[2][11] = (f2ord(s1[9] + s2[0]) & ~255u) | 144u;
        CG[2][12] = (f2ord(s1[10] + s2[0]) & ~255u) | 160u;
        CG[2][13] = (f2ord(s1[11] + s2[0]) & ~255u) | 176u;
        CG[2][14] = (f2ord(s1[12] + s2[0]) & ~255u) | 192u;
        CG[2][15] = (f2ord(s1[13] + s2[0]) & ~255u) | 208u;
        CG[3][0] = (f2ord(s1[14] + s2[0]) & ~255u) | 224u;
        CG[3][1] = (f2ord(s1[15] + s2[0]) & ~255u) | 240u;
        sort16_desc(CG[0]); sort16_desc(CG[1]); sort16_desc(CG[2]); sort16_desc(CG[3]);
        merge_top16(CG[0], CG[1]); merge_top16(CG[2], CG[3]); merge_top16(CG[0], CG[2]);
        unsigned LC[16];
#pragma unroll
        for (int i = 0; i < 16; ++i) LC[i] = CG[0][i];
#pragma unroll
        for (int i = 0; i < 16; ++i) { tb[i * 64 + lane] = i1[i]; tb[(16 + i) * 64 + lane] = i2[i]; }
        float LS[16]; int LP[16];
#pragma unroll
        for (int i = 0; i < 16; ++i) { const unsigned cid = LC[i] & 255u; LS[i] = ord2f((LC[i] & ~255u) | 128u);
            LP[i] = tb[(cid >> 4) * 64 + lane] * 128 + tb[(16 + (cid & 15u)) * 64 + lane]; }
        float den = 0.f, e[16];
#pragma unroll
        for (int i = 0; i < 16; ++i) { e[i] = __expf(LS[i] - LS[0]); den += e[i]; }
        const float rden = 1.f / den;
        const size_t ob = (size_t)(t0 + r32) * NE + h * 16;
        if (hi == 0) {
#pragma unroll
            for (int i = 0; i < 4; ++i) *(int4*)(idx_o + ob + 4 * i) = make_int4(LP[4 * i], LP[4 * i + 1], LP[4 * i + 2], LP[4 * i + 3]);
        } else {
#pragma unroll
            for (int i = 0; i < 4; ++i) *(f32x4*)(gw_o + ob + 4 * i) = (f32x4){e[4 * i] * rden, e[4 * i + 1] * rden, e[4 * i + 2] * rden, e[4 * i + 3] * rden};
        }
}
__device__ __forceinline__ void phase_topk(const Args& a, unsigned char* lds_g) {
    LAS unsigned char* lds = (LAS unsigned char*)lds_g;
    const int tid = tid_opaque(), lane = tid & 63, wave = tid >> 6;
    const int gw = blockIdx.x * NWAVES + wave, NGW = gridDim.x * NWAVES;
    const bf16_t* qp = (const bf16_t*)(a.ws + WS_QP);
    for (int task = gw; task < (T / 32) * 8; task += NGW) {
        const int h = task & 7, t0 = (task >> 3) * 32;
        topk_task(a.ws, qp + (size_t)(t0 + (lane & 31)) * DM + h * 256, (LAS int*)(lds + wave * 8192), t0, h, lane);
    }
}
__device__ __forceinline__ void pg8::EpiPeerQFused::fused(const f32x4 (&acc)[2][2][4][2], const Unit& u, int wr, int wc, int fr, int fq, PG8_LAS unsigned char* lds) const {
    constexpr int ROWB = 528;
#pragma unroll
    for (int ai = 0; ai < 2; ++ai)
#pragma unroll
        for (int m = 0; m < 4; ++m) {
            const int tr = ai * HALF + wr * 64 + m * 16 + fr, tk = u.pm * BM + tr;
            float tot = 0.f;
#pragma unroll
            for (int i = 0; i < 8; ++i) { const f32x4 s4 = *(const f32x4*)(ssq + (size_t)tk * 32 + 4 * i); tot += (s4[0] + s4[1]) + (s4[2] + s4[3]); }
            const float r = 1.0f / sqrtf(tot * (1.f / DM) + EPS);
#pragma unroll
            for (int bj = 0; bj < 2; ++bj) {
                const f32x4 v0 = acc[ai][bj][m][0] * r, v1 = acc[ai][bj][m][1] * r;
                u32x4 w; w.x = cvt_pk_bf16(v0[0], v0[1]); w.y = cvt_pk_bf16(v0[2], v0[3]); w.z = cvt_pk_bf16(v1[0], v1[1]); w.w = cvt_pk_bf16(v1[2], v1[3]);
                *(PG8_LAS u32x4*)(lds + tr * ROWB + (bj * HALF + wc * 32 + 8 * fq) * 2) = w;
            }
        }
    __syncthreads();
    const int tid = tid_opaque(), lane = tid & 63, wave = tid >> 6;
    PG8_LAS unsigned char* myrows = lds + (wave * 32) * ROWB;
    topk_task(wsb, (const bf16_t*)(const void*)(myrows + (lane & 31) * ROWB), (LAS int*)myrows, u.pm * BM + wave * 32, u.pn, lane);
}
__device__ __forceinline__ void wave_argmax(float& v, int& i) {
#pragma unroll
    for (int o = 1; o < 64; o <<= 1) { const float ov = sx_f(v, o); const int oi = sx_i(i, o); if (ov > v || (ov == v && oi < i)) { v = ov; i = oi; } }
}
__device__ __forceinline__ void phase_topk_ref(const Args& a) {
    const int tid = tid_opaque(), lane = tid & 63, wave = tid >> 6;
    const int gw = blockIdx.x * NWAVES + wave, NGW = gridDim.x * NWAVES;
    const bf16_t* skb = (const bf16_t*)(a.ws + WS_SK); const bf16_t* qp = (const bf16_t*)(a.ws + WS_QP);
    int* idx_o = (int*)(a.ws + WS_IDX); float* gw_o = (float*)(a.ws + WS_GW);
    for (int task = gw; task < T * 8; task += NGW) {
        const int t = task >> 3, h = task & 7;
        float topS[2]; int topI[2];
        for (int c = 0; c < 2; ++c) {
            const bf16_t* q = qp + (size_t)t * DM + h * 256 + c * 128;
            float sc0 = 0.f, sc1 = 0.f;
            const bf16_t* k0 = skb + (size_t)((h * 2 + c) * 128 + lane) * 128; const bf16_t* k1 = k0 + 64 * 128;
            for (int d = 0; d < 128; ++d) { const float qd = __uint_as_float((unsigned)q[d] << 16);
                sc0 += qd * __uint_as_float((unsigned)k0[d] << 16); sc1 += qd * __uint_as_float((unsigned)k1[d] << 16); }
            float ms = 0.f; int mi = 0;
            for (int r = 0; r < 16; ++r) {
                float v; int i; if (sc0 >= sc1) { v = sc0; i = lane; } else { v = sc1; i = lane + 64; }
                wave_argmax(v, i);
                if (lane == r) { ms = v; mi = i; }
                if (i == lane) sc0 = -__builtin_inff();
                if (i == lane + 64) sc1 = -__builtin_inff();
            }
            topS[c] = ms; topI[c] = mi;
        }
        float cs[4]; int ci[4];
#pragma unroll
        for (int j = 0; j < 4; ++j) { const int cidx = lane * 4 + j, aa = cidx >> 4, bb = cidx & 15;
            cs[j] = sh_f(topS[0], aa) + sh_f(topS[1], bb); ci[j] = cidx; }
        float fs = 0.f; int fi = 0;
        for (int r = 0; r < 16; ++r) {
            float v = cs[0]; int i = ci[0];
#pragma unroll
            for (int j = 1; j < 4; ++j) if (cs[j] > v) { v = cs[j]; i = ci[j]; }
            wave_argmax(v, i);
            if (lane == r) { fs = v; fi = i; }
#pragma unroll
            for (int j = 0; j < 4; ++j) if (ci[j] == i) cs[j] = -__builtin_inff();
        }
        const int e1 = sh_i(topI[0], fi >> 4), e2 = sh_i(topI[1], fi & 15);
        const float mx = sh_f(fs, 0);
        float ev = lane < 16 ? __expf(fs - mx) : 0.f;
        const float den = wave_sum(ev);
        if (lane < 16) { idx_o[(size_t)t * NE + h * 16 + lane] = e1 * 128 + e2; gw_o[(size_t)t * NE + h * 16 + lane] = ev / den; }
    }
}

__device__ __forceinline__ void fp8x16_to_f32(const u32x4 q, f32x2 (&o)[8]) {
    o[0] = __builtin_amdgcn_cvt_pk_f32_fp8((int)q.x, false); o[1] = __builtin_amdgcn_cvt_pk_f32_fp8((int)q.x, true);
    o[2] = __builtin_amdgcn_cvt_pk_f32_fp8((int)q.y, false); o[3] = __builtin_amdgcn_cvt_pk_f32_fp8((int)q.y, true);
    o[4] = __builtin_amdgcn_cvt_pk_f32_fp8((int)q.z, false); o[5] = __builtin_amdgcn_cvt_pk_f32_fp8((int)q.z, true);
    o[6] = __builtin_amdgcn_cvt_pk_f32_fp8((int)q.w, false); o[7] = __builtin_amdgcn_cvt_pk_f32_fp8((int)q.w, true);
}
#define HALVE(dst, srcv, n, bitmask) do { const bool up_ = (lane & (bitmask)) != 0; _Pragma("unroll") for (int i_ = 0; i_ < (n); ++i_) { \
        const float keep_ = up_ ? srcv[(n) + i_] : srcv[i_], send_ = up_ ? srcv[i_] : srcv[(n) + i_]; dst[i_] = keep_ + sx_f(send_, (bitmask)); } } while (0)
#define ITEM_T(n) (wv + ((n) % KT) * NWX)
#define ITEM_S(n) (xl + 8 * ((n) / KT))
#define LD_IDX(ID, n) do { const int4* ip_ = (const int4*)(idx_i + (size_t)ITEM_T(n) * NE + g * 16); _Pragma("unroll") for (int i_ = 0; i_ < 4; ++i_) ID[i_] = ip_[i_]; } while (0)
#define LD_ROWS(Q, ID, TAB, n) do { const unsigned char* b_ = (TAB) + (size_t)ITEM_S(n) * ((size_t)NEXP * 128) + c * 16; _Pragma("unroll") for (int i_ = 0; i_ < 4; ++i_) { \
        Q[4 * i_] = *(const u32x4*)(b_ + (size_t)ID[i_].x * 128); Q[4 * i_ + 1] = *(const u32x4*)(b_ + (size_t)ID[i_].y * 128); \
        Q[4 * i_ + 2] = *(const u32x4*)(b_ + (size_t)ID[i_].z * 128); Q[4 * i_ + 3] = *(const u32x4*)(b_ + (size_t)ID[i_].w * 128); } } while (0)
__device__ __forceinline__ int dpp_hmirror(int v) { return __builtin_amdgcn_update_dpp(0, v, 0x141, 0xf, 0xf, true); }
__device__ __forceinline__ int dpp_qxor2(int v) { return __builtin_amdgcn_update_dpp(0, v, 0x4E, 0xf, 0xf, true); }
__device__ __forceinline__ int dpp_qxor1(int v) { return __builtin_amdgcn_update_dpp(0, v, 0xB1, 0xf, 0xf, true); }
__device__ __forceinline__ void phase_peer_u(const Args& a) {
    const int tid = tid_opaque(), lane = tid & 63, wave = tid >> 6, g = lane >> 3, c = lane & 7;
    const int xl = blockIdx.x & 7, wv = (blockIdx.x >> 3) * NWAVES + wave, NWX = (gridDim.x >> 3) * NWAVES, KT = T / NWX, N = 2 * KT;
    const unsigned char* xq = a.ws + WS_XQ; const unsigned char* u8 = a.ws + WS_U8;
    const int* idx_i = (const int*)(a.ws + WS_IDX); bf16_t* part = (bf16_t*)(a.ws + WS_PART);
    const bool up4 = (c & 4) != 0, up2 = (c & 2) != 0, up1 = (c & 1) != 0;
#define LD_X(X, n) do { X = *(const u32x4*)(xq + (size_t)ITEM_T(n) * DM + ITEM_S(n) * 128 + c * 16); } while (0)
#define COMPUTE_U(Q, X, n) do { int p[16]; \
        _Pragma("unroll") for (int i = 0; i < 16; ++i) { int d_ = __builtin_amdgcn_sdot4((int)Q[i].x, (int)X.x, 0, false); d_ = __builtin_amdgcn_sdot4((int)Q[i].y, (int)X.y, d_, false); \
            d_ = __builtin_amdgcn_sdot4((int)Q[i].z, (int)X.z, d_, false); p[i] = __builtin_amdgcn_sdot4((int)Q[i].w, (int)X.w, d_, false); } \
        int p8[8], p4[4], p2[2]; \
        _Pragma("unroll") for (int i = 0; i < 8; ++i) { const int keep_ = up4 ? p[8 + i] : p[i], send_ = up4 ? p[i] : p[8 + i]; p8[i] = keep_ + dpp_hmirror(send_); } \
        _Pragma("unroll") for (int i = 0; i < 4; ++i) { const int keep_ = up2 ? p8[4 + i] : p8[i], send_ = up2 ? p8[i] : p8[4 + i]; p4[i] = keep_ + dpp_qxor2(send_); } \
        _Pragma("unroll") for (int i = 0; i < 2; ++i) { const int keep_ = up1 ? p4[2 + i] : p4[i], send_ = up1 ? p4[i] : p4[2 + i]; p2[i] = keep_ + dpp_qxor1(send_); } \
        *(unsigned*)(part + ((size_t)ITEM_T(n) * 16 + ITEM_S(n)) * NE + 2 * lane) = cvt_pk_bf16((float)p2[0], (float)p2[1]); } while (0)
    int4 IA[4], IB[4]; u32x4 QA[16], QB[16], XA, XB;
    LD_IDX(IA, 0); LD_IDX(IB, 1);
    LD_ROWS(QA, IA, u8, 0); LD_X(XA, 0);
    for (int n = 0; n < N; n += 2) {
        LD_ROWS(QB, IB, u8, n + 1); LD_X(XB, n + 1);
        if (n + 2 < N) LD_IDX(IA, n + 2);
        COMPUTE_U(QA, XA, n);
        if (n + 2 < N) { LD_ROWS(QA, IA, u8, n + 2); LD_X(XA, n + 2); }
        if (n + 3 < N) LD_IDX(IB, n + 3);
        COMPUTE_U(QB, XB, n + 1);
    }
#undef LD_X
#undef COMPUTE_U
}
__device__ __forceinline__ void phase_peer_w(const Args& a) {
    const int gt = blockIdx.x * NTHREADS + tid_opaque(), NGT = gridDim.x * NTHREADS;
    const int* idx_i = (const int*)(a.ws + WS_IDX); const float* gw_i = (const float*)(a.ws + WS_GW); const bf16_t* part = (const bf16_t*)(a.ws + WS_PART);
    const float* suv = (const float*)(a.ws + WS_SUV); const float* sx = (const float*)(a.ws + WS_SX);
    signed char* wq = (signed char*)(a.ws + WS_WQ); float* sw = (float*)(a.ws + WS_SW);
    for (int item = gt; item < T * NE; item += NGT) {
        const int t = item >> 7, e = item & 127;
        float sum = 0.f;
#pragma unroll
        for (int s = 0; s < 16; ++s) sum += __uint_as_float((unsigned)part[((size_t)t * 16 + s) * NE + e] << 16);
        const int ex = idx_i[item];
        const float d = sum * suv[ex] * sx[t];
        const float om = 0.5f * d * (1.f + erff(d * 0.70710678118654752f)) * gw_i[item] * suv[NEXP + ex];
        float mx = fabsf(om);
        mx = fmaxf(mx, sx_f(mx, 1)); mx = fmaxf(mx, sx_f(mx, 2)); mx = fmaxf(mx, sx_f(mx, 4)); mx = fmaxf(mx, sx_f(mx, 8));
        const float qs = mx > 0.f ? 127.f / mx : 1.f;
        wq[item] = (signed char)(int)__builtin_rintf(om * qs);
        if ((e & 15) == 0) sw[t * 8 + (e >> 4)] = mx * (1.f / 127.f);
    }
}
__device__ __forceinline__ void phase_peer_v(const Args& a, float* dst) {
    const int tid = tid_opaque(), lane = tid & 63, wave = tid >> 6, g = lane >> 3, c = lane & 7;
    const int xl = blockIdx.x & 7, wv = (blockIdx.x >> 3) * NWAVES + wave, NWX = (gridDim.x >> 3) * NWAVES, KT = T / NWX, N = 2 * KT;
    const unsigned char* v8 = a.ws + WS_V8;
    const int* idx_i = (const int*)(a.ws + WS_IDX); const unsigned char* wq = a.ws + WS_WQ; const float* sw = (const float*)(a.ws + WS_SW);
    const bf16_t* hsrc = (const bf16_t*)(a.ws + WS_HB);
#define LD_W(W, SWV, n) do { W = *(const u32x4*)(wq + (size_t)ITEM_T(n) * NE + g * 16); SWV = sw[ITEM_T(n) * 8 + g]; } while (0)
#define QUAD(A_, B_, C_, D_, W_, A0, A1, A2, A3) do { \
        const unsigned ablo_ = __builtin_amdgcn_perm(B_, A_, 0x05010400u), abhi_ = __builtin_amdgcn_perm(B_, A_, 0x07030602u); \
        const unsigned cdlo_ = __builtin_amdgcn_perm(D_, C_, 0x05010400u), cdhi_ = __builtin_amdgcn_perm(D_, C_, 0x07030602u); \
        A0 = __builtin_amdgcn_sdot4((int)__builtin_amdgcn_perm(cdlo_, ablo_, 0x05040100u), (int)(W_), A0, false); \
        A1 = __builtin_amdgcn_sdot4((int)__builtin_amdgcn_perm(cdlo_, ablo_, 0x07060302u), (int)(W_), A1, false); \
        A2 = __builtin_amdgcn_sdot4((int)__builtin_amdgcn_perm(cdhi_, abhi_, 0x05040100u), (int)(W_), A2, false); \
        A3 = __builtin_amdgcn_sdot4((int)__builtin_amdgcn_perm(cdhi_, abhi_, 0x07060302u), (int)(W_), A3, false); } while (0)
#define COMPUTE_V(Q, W, SWV, n) do { int ac[16]; _Pragma("unroll") for (int k = 0; k < 16; ++k) ac[k] = 0; \
        _Pragma("unroll") for (int q_ = 0; q_ < 4; ++q_) { const unsigned w_ = q_ == 0 ? W.x : q_ == 1 ? W.y : q_ == 2 ? W.z : W.w; \
            QUAD(Q[4 * q_].x, Q[4 * q_ + 1].x, Q[4 * q_ + 2].x, Q[4 * q_ + 3].x, w_, ac[0], ac[1], ac[2], ac[3]); \
            QUAD(Q[4 * q_].y, Q[4 * q_ + 1].y, Q[4 * q_ + 2].y, Q[4 * q_ + 3].y, w_, ac[4], ac[5], ac[6], ac[7]); \
            QUAD(Q[4 * q_].z, Q[4 * q_ + 1].z, Q[4 * q_ + 2].z, Q[4 * q_ + 3].z, w_, ac[8], ac[9], ac[10], ac[11]); \
            QUAD(Q[4 * q_].w, Q[4 * q_ + 1].w, Q[4 * q_ + 2].w, Q[4 * q_ + 3].w, w_, ac[12], ac[13], ac[14], ac[15]); } \
        float p[16]; _Pragma("unroll") for (int k = 0; k < 16; ++k) p[k] = (float)ac[k] * SWV; \
        float p8[8], p4[4], p2[2]; \
        _Pragma("unroll") for (int i_ = 0; i_ < 8; ++i_) { auto rr_ = __builtin_amdgcn_permlane32_swap(__float_as_uint(p[i_]), __float_as_uint(p[8 + i_]), false, false); p8[i_] = __uint_as_float(rr_[0]) + __uint_as_float(rr_[1]); } \
        _Pragma("unroll") for (int i_ = 0; i_ < 4; ++i_) { auto rr_ = __builtin_amdgcn_permlane16_swap(__float_as_uint(p8[i_]), __float_as_uint(p8[4 + i_]), false, false); p4[i_] = __uint_as_float(rr_[0]) + __uint_as_float(rr_[1]); } \
        HALVE(p2, p4, 2, 8); \
        const size_t o_ = (size_t)ITEM_T(n) * DM + ITEM_S(n) * 128 + c * 16 + 2 * g; \
        const unsigned hv = *(const unsigned*)(hsrc + o_); *(f32x2*)(dst + o_) = (f32x2){bf_lo(hv) + p2[0], bf_hi(hv) + p2[1]}; } while (0)
    int4 IA[4], IB[4]; u32x4 QA[16], QB[16], WA, WB; float SA, SB_;
    LD_IDX(IA, 0); LD_IDX(IB, 1);
    LD_ROWS(QA, IA, v8, 0); LD_W(WA, SA, 0);
    for (int n = 0; n < N; n += 2) {
        LD_ROWS(QB, IB, v8, n + 1); LD_W(WB, SB_, n + 1);
        if (n + 2 < N) LD_IDX(IA, n + 2);
        COMPUTE_V(QA, WA, SA, n);
        if (n + 2 < N) { LD_ROWS(QA, IA, v8, n + 2); LD_W(WA, SA, n + 2); }
        if (n + 3 < N) LD_IDX(IB, n + 3);
        COMPUTE_V(QB, WB, SB_, n + 1);
    }
#undef LD_W
#undef QUAD
#undef COMPUTE_V
}
#undef ITEM_T
#undef ITEM_S
#undef LD_IDX
#undef LD_ROWS
#undef HALVE


constexpr int NPHASE = 11;
#define LOAD_ARGS() do { } while (0)
__global__ void __launch_bounds__(NTHREADS, 2) fwd_kernel(Args a) {
    extern __shared__ __attribute__((aligned(16))) unsigned char lds[];
#if MK_ONE_LAUNCH
    constexpr int lo = 0, hi = NPHASE;
    cg::grid_group grid = cg::this_grid();
    volatile LAS unsigned* misc = (volatile LAS unsigned*)((LAS unsigned char*)lds + MISC_OFF);
    if (threadIdx.x < 16) misc[threadIdx.x] = 0u;
    __syncthreads();
    { LOAD_ARGS(); (void)xcd_barrier_post((unsigned*)(a.ws + WS_CTL) + CW_BAR, misc + 8); }
#ifndef SEAM_CG_MASK
#define SEAM_CG_MASK 0
#endif
#define SEAM(k) do { if (lo <= (k) && (k) + 1 < hi) { if ((SEAM_CG_MASK >> (k)) & 1) grid.sync(); else { LOAD_ARGS(); XcdBarrier xb_; xb_.bar = (unsigned*)(a.ws + WS_CTL) + CW_BAR; xb_.x = xb_xcc_id(); \
        xb_.st = (volatile LAS unsigned*)((LAS unsigned char*)lds + MISC_OFF) + 8; xcd_barrier(xb_); } } } while (0)
#else
    int lo, hi; { LOAD_ARGS(); lo = a.ph_lo; hi = a.ph_hi; }
#define SEAM(k) do { } while (0)
#endif
#define IN(k) (lo <= (k) && (k) < hi)
#ifndef DUP_PHASE
#define DUP_PHASE -1
#endif
    if (IN(0)) { LOAD_ARGS(); phase0(a, lds); if (DUP_PHASE == 0) { __syncthreads(); phase0(a, lds); } SEAM(0); }
    if (IN(1)) { LOAD_ARGS(); unsigned char* ws = a.ws;
        cumsum_rows(a);
        pg8::Gemm g{(const bf16_t*)(ws + WS_XN), (const bf16_t*)(ws + WS_WIN), T, NPROJ, DM}; pg8::StaticOrder S; S.init(T, NPROJ, (int)gridDim.x, (int)blockIdx.x);
        pg8::EpiInProj E{(bf16_t*)(ws + WS_SEC), (const float*)(ws + WS_SXN), (const float*)(ws + WS_WSC), a.in[4], a.in[5], (LAS float*)((LAS unsigned char*)lds + RING_BYTES)};
        for (int rep_ = 0; rep_ < (DUP_PHASE == 1 ? 2 : 1); ++rep_)
        pg8::gemm_phase<pg8::EpiInProj, pg8::StaticOrder, true, true, true>((LAS unsigned char*)lds, g, S, E);
        { const int nwg_ = (T / 256) * (NPROJ / 256), G_ = (int)gridDim.x, rem_ = nwg_ % G_;
          if (rem_ > 0 && (int)blockIdx.x >= rem_) convert_tables(a, TAB_SPLIT, 2 * NEXP, ((int)blockIdx.x - rem_) * NWAVES + (tid_opaque() >> 6), (G_ - rem_) * NWAVES);
          else if (rem_ == 0) convert_tables(a, TAB_SPLIT, 2 * NEXP, (int)blockIdx.x * NWAVES + (tid_opaque() >> 6), G_ * NWAVES); }
        SEAM(1);
    }
    if (IN(3)) { LOAD_ARGS(); phase_attn(a, lds);
#if MK_ONE_LAUNCH
        if (DUP_PHASE == 3) { XcdBarrier xb_; xb_.bar = (unsigned*)(a.ws + WS_CTL) + CW_BAR; xb_.x = xb_xcc_id(); xb_.st = (volatile LAS unsigned*)((LAS unsigned char*)lds + MISC_OFF) + 8;
            xcd_barrier(xb_); if (blockIdx.x == 0 && threadIdx.x == 0) __hip_atomic_store((unsigned*)(a.ws + WS_CTL), 0u, __ATOMIC_RELAXED, __HIP_MEMORY_SCOPE_AGENT); xcd_barrier(xb_); phase_attn(a, lds); }
#endif
        SEAM(3); }
    if (IN(4)) { LOAD_ARGS(); phase_attn_combine(a); SEAM(4); }
    if (IN(5)) { LOAD_ARGS(); unsigned char* ws = a.ws;
        pg8::Gemm g{(const bf16_t*)(ws + WS_MIX), (const bf16_t*)(ws + WS_WOUT), T, DM, DM}; pg8::StaticOrder S; S.init(T, DM, (int)gridDim.x, (int)blockIdx.x);
        pg8::EpiOutProj E{a.in[0], a.out, (bf16_t*)(ws + WS_HB), (float*)(ws + WS_SSQ), (float*)(ws + WS_AMX)};
        for (int rep_ = 0; rep_ < (DUP_PHASE == 5 ? 2 : 1); ++rep_)
        pg8::gemm_phase<pg8::EpiOutProj, pg8::StaticOrder, true, true>((LAS unsigned char*)lds, g, S, E);
        SEAM(5);
    }
    if (IN(6)) { LOAD_ARGS(); unsigned char* ws = a.ws;
        pg8::Gemm g{(const bf16_t*)(ws + WS_HB), (const bf16_t*)(ws + WS_WPQ), T, DM, DM}; pg8::StaticOrder S; S.init(T, DM, (int)gridDim.x, (int)blockIdx.x);
        pg8::EpiPeerQFused E{(const float*)(ws + WS_SSQ), ws};
        pg8::gemm_phase<pg8::EpiPeerQFused, pg8::StaticOrder, true, true>((LAS unsigned char*)lds, g, S, E);
        SEAM(6);
    }
    if (IN(8)) { LOAD_ARGS(); for (int rep_ = 0; rep_ < (DUP_PHASE == 8 ? 2 : 1); ++rep_) phase_peer_u(a); SEAM(8); }
    if (IN(9)) { LOAD_ARGS(); for (int rep_ = 0; rep_ < (DUP_PHASE == 9 ? 2 : 1); ++rep_) phase_peer_w(a); SEAM(9); }
    if (IN(10)) { LOAD_ARGS(); for (int rep_ = 0; rep_ < (DUP_PHASE == 10 ? 2 : 1); ++rep_) phase_peer_v(a, (DUP_PHASE == 10 && rep_ == 0) ? (float*)(a.ws + WS_END) : a.out); }
#undef IN
#undef SEAM
}

extern "C" void kernel_launch(void* const* d_in, const int* in_sizes, int n_in, void* d_out, int out_size, void* d_ws, size_t ws_size, hipStream_t stream) {
    static int grid = 0;
    if (grid == 0) {
        if (n_in != 12 || in_sizes[0] != T * DM || out_size != T * DM || ws_size < WS_END) { fprintf(stderr, "kernel_launch: unexpected shapes (n_in %d, in0 %d, out %d, ws %zu)\n", n_in, n_in > 0 ? in_sizes[0] : -1, out_size, ws_size); grid = -1; return; }
        int dev = 0, cus = 0, per_cu = 0;
        if (hipGetDevice(&dev) != hipSuccess || hipDeviceGetAttribute(&cus, hipDeviceAttributeMultiprocessorCount, dev) != hipSuccess) { grid = -1; return; }
        if (hipFuncSetAttribute((const void*)fwd_kernel, hipFuncAttributeMaxDynamicSharedMemorySize, LDS_BYTES) != hipSuccess) { fprintf(stderr, "kernel_launch: hipFuncSetAttribute failed\n"); grid = -1; return; }
        if (hipOccupancyMaxActiveBlocksPerMultiprocessor(&per_cu, (const void*)fwd_kernel, NTHREADS, LDS_BYTES) != hipSuccess || per_cu < 1) { fprintf(stderr, "kernel_launch: occupancy query says %d\n", per_cu); grid = -1; return; }
        grid = cus;
    }
    if (grid < 0) return;
    (void)hipMemsetAsync((char*)d_ws + WS_CTL, 0, CTL_BYTES, stream);
    Args a{};
    for (int i = 0; i < 12; ++i) a.in[i] = (const float*)d_in[i];
    a.out = (float*)d_out; a.ws = (unsigned char*)d_ws;
#if MK_ONE_LAUNCH
    a.ph_lo = 0; a.ph_hi = NPHASE;
    void* args[] = {&a};
#if MK_COOP_LAUNCH
    hipError_t e = hipLaunchCooperativeKernel((const void*)fwd_kernel, dim3(grid), dim3(NTHREADS), args, LDS_BYTES, stream);
    if (e != hipSuccess) fprintf(stderr, "cooperative launch failed: %s (grid %d)\n", hipGetErrorString(e), grid);
#else
    (void)args; hipLaunchKernelGGL(fwd_kernel, dim3(grid), dim3(NTHREADS), LDS_BYTES, stream, a);
#endif
#else
    for (int p = 0; p < NPHASE; ++p) { a.ph_lo = p; a.ph_hi = p + 1; hipLaunchKernelGGL(fwd_kernel, dim3(grid), dim3(NTHREADS), LDS_BYTES, stream, a); }
#endif
}
```

```cpp
#include <hip/hip_runtime.h>
#include <hip/hip_cooperative_groups.h>
#include <cstdio>
#include <cstdint>
namespace cg = cooperative_groups;

#ifndef MK_COOP_LAUNCH
#define MK_COOP_LAUNCH 0
#endif
#ifndef MK_ONE_LAUNCH
#define MK_ONE_LAUNCH 1
#endif

#define LAS __attribute__((address_space(3)))
typedef unsigned short bf16_t;
typedef short bf16x8 __attribute__((ext_vector_type(8)));
typedef short s16x4 __attribute__((ext_vector_type(4)));
typedef float f32x2 __attribute__((ext_vector_type(2)));
typedef float f32x4 __attribute__((ext_vector_type(4)));
typedef float f32x16 __attribute__((ext_vector_type(16)));
typedef unsigned u32x2 __attribute__((ext_vector_type(2)));
typedef unsigned u32x4 __attribute__((ext_vector_type(4)));
typedef __bf16 bf16x2_t __attribute__((ext_vector_type(2)));

constexpr int NB = 2, SEQ = 4096, T = NB * SEQ, DM = 2048, HD = 128, NHF = 8, DIN = 7176, NPROJ = 7168;
constexpr int NEXP = 16384, NE = 128;
constexpr float EPS = 1e-6f;
constexpr float SCALE = 0.08838834764831845f, LOG2E = 1.4426950408889634f;
constexpr int NWAVES = 8, NTHREADS = 512;

constexpr size_t MiB = 1u << 20;
constexpr size_t WS_CTL = 0, CTL_BYTES = 32768;
constexpr int CW_BAR = 1024;
constexpr size_t WS_SXN = 64 * MiB  , WS_WSC = 45 * MiB + 800 * 1024  ;
constexpr int CW_WMAX = 64;
constexpr size_t WS_GQK = 45 * MiB + 768 * 1024;
constexpr size_t WS_WIN = 1 * MiB, WS_WOUT = 29 * MiB, WS_WPQ = 37 * MiB, WS_SK = 45 * MiB, WS_LOGF = 46 * MiB, WS_C = 46 * MiB + 512 * 1024, WS_SSQ = 47 * MiB;
constexpr size_t WS_XN = 48 * MiB;
constexpr size_t WS_SEC = 80 * MiB;
constexpr size_t SEC_ELEMS = 8u << 20;
constexpr size_t WS_MIX = 192 * MiB, WS_HB = 224 * MiB, WS_QP = 256 * MiB, WS_IDX = 288 * MiB, WS_GW = 292 * MiB, WS_U8 = 296 * MiB, WS_V8 = 328 * MiB, WS_SUV = 360 * MiB  , WS_RT = 360 * MiB + 256 * 1024  , WS_W = 361 * MiB  ,
                 WS_PART = 368 * MiB  , WS_XQ = 432 * MiB  , WS_END = 448 * MiB;
constexpr size_t WS_AMX = 365 * MiB  , WS_SX = WS_RT + 64 * 1024  , WS_WQ = WS_W  , WS_SW = WS_W + 2 * MiB  ;
constexpr size_t WS_PO = WS_PART  , WS_PML = WS_PART + 32 * MiB  ;

constexpr int RING_BYTES = 131072;
constexpr int MISC_OFF = 143360;
constexpr int LDS_BYTES = 147456;

__device__ __forceinline__ unsigned cvt_pk_bf16(float lo, float hi) { unsigned r; asm volatile("v_cvt_pk_bf16_f32 %0, %1, %2" : "=v"(r) : "v"(lo), "v"(hi)); return r; }
__device__ __forceinline__ float bf_lo(unsigned u) { return __builtin_bit_cast(float, u << 16); }
__device__ __forceinline__ float bf_hi(unsigned u) { return __builtin_bit_cast(float, u & 0xffff0000u); }
__device__ __forceinline__ int lane_id_fresh() { int l = (int)__builtin_amdgcn_mbcnt_hi(~0u, __builtin_amdgcn_mbcnt_lo(~0u, 0u)); asm volatile("" : "+v"(l)); return l; }
__device__ __forceinline__ int sx_i(int v, int m) { return __builtin_amdgcn_ds_bpermute((lane_id_fresh() ^ m) << 2, v); }
__device__ __forceinline__ float sx_f(float v, int m) { return __int_as_float(__builtin_amdgcn_ds_bpermute((lane_id_fresh() ^ m) << 2, __float_as_int(v))); }
__device__ __forceinline__ int sh_i(int v, int src) { return __builtin_amdgcn_ds_bpermute(src << 2, v); }
__device__ __forceinline__ float sh_f(float v, int src) { return __int_as_float(__builtin_amdgcn_ds_bpermute(src << 2, __float_as_int(v))); }
__device__ __forceinline__ float shup_f(float v, int d) { const int l = lane_id_fresh(); const int s = l - d; return __int_as_float(__builtin_amdgcn_ds_bpermute((s < 0 ? l : s) << 2, __float_as_int(v))); }
__device__ __forceinline__ float wave_sum(float v) {
#pragma unroll
    for (int o = 1; o < 64; o <<= 1) v += sx_f(v, o);
    return v;
}
__device__ __forceinline__ float wave_max(float v) {
#pragma unroll
    for (int o = 1; o < 64; o <<= 1) v = fmaxf(v, sx_f(v, o));
    return v;
}
__device__ __forceinline__ int tid_opaque() { int t = (int)threadIdx.x; asm volatile("" : "+v"(t)); return t; }
#define LDS_WAIT() asm volatile("s_waitcnt lgkmcnt(0)" ::: "memory")

namespace pg8 {
#define PG8_LAS __attribute__((address_space(3)))
constexpr int BM = 256, BK = 64, HALF = 128, HTB = HALF * BK * 2, STAGE_BYTES = 8 * HTB, NXCD = 8, WGM = 8;
__host__ __device__ __forceinline__ int lds_byte(int r, int c) { const int st = (r >> 4) * 2 + (c >> 5), rr = r & 15, cc = c & 31, ob = rr * 64 + cc * 2; return st * 1024 + (ob ^ (((ob >> 9) & 1) << 5)); }
__host__ __device__ __forceinline__ void stage_rc(int b, int& R, int& C) { const int st = b / 1024, sb = b % 1024, swz = sb ^ (((sb >> 9) & 1) << 5); R = (st >> 1) * 16 + swz / 64; C = (st & 1) * 32 + (swz % 64) / 2; }
__host__ __device__ __forceinline__ int perm32(int rho) { const int n = rho >> 4, i = rho & 15; return 8 * (i >> 2) + 4 * n + (i & 3); }
struct Unit { int pm, pn; };
struct Gemm { const bf16_t* A; const bf16_t* Bt; int M, N, K; };
struct StaticOrder {
    int nM, nN, nwg, G, c;
    __host__ __device__ void init(int M, int N, int G_, int c_) { nM = M / BM; nN = N / BM; nwg = nM * nN; G = G_; c = c_; }
    __host__ __device__ bool next(int i, Unit& u) const {
        const long L = (long)i * G + c; if (L >= nwg) return false;
        int wgid = (int)L; { const int q = nwg / NXCD, r = nwg % NXCD, xcd = wgid % NXCD, off = wgid / NXCD; wgid = (xcd < r ? xcd * (q + 1) : r * (q + 1) + (xcd - r) * q) + off; }
        const int nig = WGM * nN, gid = wgid / nig, fm = gid * WGM, gsz = (nM - fm) < WGM ? (nM - fm) : WGM;
        u.pm = fm + ((wgid % nig) % gsz); u.pn = (wgid % nig) / gsz; return true;
    }
    __device__ __forceinline__ void a_ready(const Unit&) const {}
    __device__ __forceinline__ void done(const Unit&) const {}
};

typedef int i32x4 __attribute__((ext_vector_type(4)));
template <bool I8> struct AccT { typedef f32x4 type; };
template <> struct AccT<true> { typedef i32x4 type; };
template <class Epi, class Sched, bool ALIGN_EPI = false, bool SP2 = false, bool I8 = false>
__device__ __forceinline__ void gemm_phase(PG8_LAS unsigned char* lds, const Gemm g, const Sched& S, const Epi& E) {
    typedef typename AccT<I8>::type acc_t;
    const int tid = tid_opaque(), wid = __builtin_amdgcn_readfirstlane(tid >> 6), lane = tid & 63, wr = wid >> 2, wc = wid & 3, fr = lane & 15, fq = lane >> 4;
    const int rowb = I8 ? g.K : 2 * g.K, nt = rowb / (BK * 2);
    unsigned voffA[2], voffB[2];
#pragma unroll
    for (int i = 0; i < 2; ++i) { int R, C; stage_rc(tid * 16 + i * 8192, R, C); const int Rb = Epi::PERM ? ((R & ~31) + perm32(R & 31)) : R;
        voffA[i] = (unsigned)(R * rowb + C * 2); voffB[i] = (unsigned)(Rb * rowb + C * 2); }
    const size_t kstep = (size_t)(BK * 2);
    const size_t hstep = (size_t)HALF * rowb;
    const size_t tstep = 2 * hstep;
    const unsigned ldsw = (unsigned)wid * 1024u;
    const int aoff = lds_byte(wr * 64 + fr, fq * 8), boff = lds_byte(wc * 32 + fr, fq * 8);
#define PG8_SA(b, h) (((b) * 2 + (h)) * HTB)
#define PG8_SB(b, h) ((4 + (b) * 2 + (h)) * HTB)
#define PG8_STAGE(bufoff, gbase, voff) do { _Pragma("unroll") for (int _i = 0; _i < 2; ++_i) \
        __builtin_amdgcn_global_load_lds((const unsigned*)((const char*)(gbase) + (voff)[_i]), (PG8_LAS unsigned*)(lds + (bufoff) + ldsw + _i * 8192), 16, 0, 0); } while (0)
#define PG8_LDA(dst, b, h) do { _Pragma("unroll") for (int m = 0; m < 4; ++m) _Pragma("unroll") for (int k = 0; k < 2; ++k) dst[m][k] = *(const PG8_LAS bf16x8*)(lds + PG8_SA(b, h) + aoff + m * 2048 + k * 1024); } while (0)
#define PG8_LDB(dst, b, h) do { _Pragma("unroll") for (int n = 0; n < 2; ++n) _Pragma("unroll") for (int k = 0; k < 2; ++k) dst[n][k] = *(const PG8_LAS bf16x8*)(lds + PG8_SB(b, h) + boff + n * 2048 + k * 1024); } while (0)
#define PG8_MMA(ai, bj, At, Bt) do { __builtin_amdgcn_s_setprio(1); _Pragma("unroll") for (int m = 0; m < 4; ++m) _Pragma("unroll") for (int n = 0; n < 2; ++n) _Pragma("unroll") for (int k = 0; k < 2; ++k) \
        { if constexpr (I8) acc[ai][bj][m][n] = __builtin_amdgcn_mfma_i32_16x16x64_i8(__builtin_bit_cast(i32x4, Bt[n][k]), __builtin_bit_cast(i32x4, At[m][k]), acc[ai][bj][m][n], 0, 0, 0); \
          else acc[ai][bj][m][n] = __builtin_amdgcn_mfma_f32_16x16x32_bf16(Bt[n][k], At[m][k], acc[ai][bj][m][n], 0, 0, 0); } __builtin_amdgcn_s_setprio(0); } while (0)
#define PG8_WAIT_V(n) asm volatile("s_waitcnt vmcnt(" #n ")" ::: "memory")
#define PG8_WAIT_L(n) asm volatile("s_waitcnt lgkmcnt(" #n ")" ::: "memory")
#define PG8_BAR __builtin_amdgcn_s_barrier()
#define PG8_SCHED __builtin_amdgcn_sched_barrier(0)
    Unit cur, nxt; int ui = 0;
    if (!S.next(0, cur)) return;
    acc_t acc[2][2][4][2];
#pragma unroll
    for (int a = 0; a < 2; ++a)
#pragma unroll
        for (int b = 0; b < 2; ++b)
#pragma unroll
            for (int m = 0; m < 4; ++m)
#pragma unroll
                for (int n = 0; n < 2; ++n) acc[a][b][m][n] = acc_t{};
    bf16x8 At[4][2], B0[2][2], B1[2][2];
    const char* cA = (const char*)g.A + (size_t)cur.pm * tstep; const char* cB = (const char*)g.Bt + (size_t)cur.pn * tstep;
    S.a_ready(cur);
    if constexpr (SP2) {
        PG8_STAGE(PG8_SB(0, 0), cB, voffB); PG8_STAGE(PG8_SB(0, 1), cB + hstep, voffB); PG8_STAGE(PG8_SA(0, 0), cA, voffA); PG8_STAGE(PG8_SA(0, 1), cA + hstep, voffA);
        if (wr == 1) PG8_BAR;
        PG8_WAIT_V(2); PG8_BAR;
        PG8_STAGE(PG8_SB(1, 0), cB + kstep, voffB); PG8_STAGE(PG8_SA(1, 0), cA + kstep, voffA); PG8_STAGE(PG8_SB(1, 1), cB + hstep + kstep, voffB);
        PG8_WAIT_V(6); PG8_BAR;
    } else {
        PG8_STAGE(PG8_SB(0, 0), cB, voffB); PG8_STAGE(PG8_SA(0, 0), cA, voffA); PG8_STAGE(PG8_SB(0, 1), cB + hstep, voffB); PG8_STAGE(PG8_SA(0, 1), cA + hstep, voffA);
        if (wr == 1) PG8_BAR;
        PG8_WAIT_V(4); PG8_BAR;
        PG8_STAGE(PG8_SB(1, 0), cB + kstep, voffB); PG8_STAGE(PG8_SA(1, 0), cA + kstep, voffA); PG8_STAGE(PG8_SB(1, 1), cB + hstep + kstep, voffB);
        PG8_WAIT_V(6); PG8_BAR;
    }
    for (;;) {
        const bool has_next = S.next(ui + 1, nxt);
        const char* nA = has_next ? (const char*)g.A + (size_t)nxt.pm * tstep : cA; const char* nB = has_next ? (const char*)g.Bt + (size_t)nxt.pn * tstep : cB;
        for (int t = 0; t < nt; t += 2) {
            const bool last = (t == nt - 2);
            const char* a1 = cA + (size_t)(t + 1) * kstep;
            const char* a2 = last ? nA : cA + (size_t)(t + 2) * kstep; const char* b2 = last ? nB : cB + (size_t)(t + 2) * kstep;
            const char* a3 = a2 + kstep; const char* b3 = b2 + kstep;
            if (last && has_next) S.a_ready(nxt);
            if constexpr (SP2) {
            PG8_LDB(B0, 0, 0); PG8_LDB(B1, 0, 1); PG8_SCHED; PG8_LDA(At, 0, 0); PG8_STAGE(PG8_SA(1, 1), a1 + hstep, voffA);
            PG8_WAIT_V(8); PG8_WAIT_L(0); PG8_BAR; PG8_MMA(0, 0, At, B0); PG8_MMA(0, 1, At, B1); PG8_BAR; PG8_SCHED;
            PG8_LDA(At, 0, 1); PG8_STAGE(PG8_SB(0, 0), b2, voffB); PG8_STAGE(PG8_SB(0, 1), b2 + hstep, voffB); PG8_STAGE(PG8_SA(0, 0), a2, voffA);
            PG8_WAIT_V(8); PG8_WAIT_L(0); PG8_BAR; PG8_MMA(1, 0, At, B0); PG8_MMA(1, 1, At, B1); PG8_BAR; PG8_SCHED;
            PG8_LDB(B0, 1, 0); PG8_LDB(B1, 1, 1); PG8_SCHED; PG8_LDA(At, 1, 0); PG8_STAGE(PG8_SA(0, 1), a2 + hstep, voffA);
            PG8_WAIT_V(8); PG8_WAIT_L(0); PG8_BAR; PG8_MMA(0, 0, At, B0); PG8_MMA(0, 1, At, B1); PG8_BAR; PG8_SCHED;
            PG8_LDA(At, 1, 1); PG8_STAGE(PG8_SB(1, 0), b3, voffB); PG8_STAGE(PG8_SB(1, 1), b3 + hstep, voffB); PG8_STAGE(PG8_SA(1, 0), a3, voffA);
            PG8_WAIT_V(8); PG8_WAIT_L(0); PG8_BAR; PG8_MMA(1, 0, At, B0); PG8_MMA(1, 1, At, B1); PG8_BAR; PG8_SCHED;
            } else {
            PG8_LDB(B0, 0, 0); PG8_SCHED; PG8_LDA(At, 0, 0); PG8_STAGE(PG8_SA(1, 1), a1 + hstep, voffA);
            PG8_WAIT_L(8); PG8_BAR; PG8_WAIT_L(0); PG8_MMA(0, 0, At, B0); PG8_BAR; PG8_SCHED;
            PG8_LDB(B1, 0, 1); PG8_STAGE(PG8_SB(0, 0), b2, voffB);
            PG8_BAR; PG8_WAIT_L(0); PG8_MMA(0, 1, At, B1); PG8_BAR;
            PG8_LDA(At, 0, 1); PG8_STAGE(PG8_SA(0, 0), a2, voffA);
            PG8_BAR; PG8_WAIT_L(0); PG8_MMA(1, 0, At, B0); PG8_BAR; PG8_SCHED;
            PG8_STAGE(PG8_SB(0, 1), b2 + hstep, voffB);
            PG8_WAIT_V(6); PG8_BAR; PG8_MMA(1, 1, At, B1); PG8_BAR;
            PG8_LDB(B0, 1, 0); PG8_SCHED; PG8_LDA(At, 1, 0); PG8_STAGE(PG8_SA(0, 1), a2 + hstep, voffA);
            PG8_WAIT_L(8); PG8_BAR; PG8_WAIT_L(0); PG8_MMA(0, 0, At, B0); PG8_BAR; PG8_SCHED;
            PG8_LDB(B1, 1, 1); PG8_STAGE(PG8_SB(1, 0), b3, voffB);
            PG8_BAR; PG8_WAIT_L(0); PG8_MMA(0, 1, At, B1); PG8_BAR;
            PG8_LDA(At, 1, 1); PG8_STAGE(PG8_SA(1, 0), a3, voffA);
            PG8_BAR; PG8_WAIT_L(0); PG8_MMA(1, 0, At, B0); PG8_BAR; PG8_SCHED;
            PG8_STAGE(PG8_SB(1, 1), b3 + hstep, voffB);
            PG8_WAIT_V(6); PG8_BAR; PG8_MMA(1, 1, At, B1); PG8_BAR;
            }
        }
        if constexpr (ALIGN_EPI) { if (wr == 0) PG8_BAR; }
        if constexpr (!Epi::AFTER_DRAIN) { E(acc, cur, wr, wc, fr, fq); } S.done(cur);
        if (!has_next) break;
#pragma unroll
        for (int a = 0; a < 2; ++a)
#pragma unroll
            for (int b = 0; b < 2; ++b)
#pragma unroll
                for (int m = 0; m < 4; ++m)
#pragma unroll
                    for (int n = 0; n < 2; ++n) acc[a][b][m][n] = acc_t{};
        cur = nxt; cA = nA; cB = nB; ++ui;
        if constexpr (ALIGN_EPI) { if (wr == 1) PG8_BAR; }
    }
    PG8_WAIT_V(0);
    if constexpr (!ALIGN_EPI) { if (wr == 0) PG8_BAR; }
    PG8_BAR;
    if constexpr (Epi::AFTER_DRAIN) E.fused(acc, cur, wr, wc, fr, fq, lds);
#undef PG8_SA
#undef PG8_SB
#undef PG8_STAGE
#undef PG8_LDA
#undef PG8_LDB
#undef PG8_MMA
#undef PG8_WAIT_V
#undef PG8_WAIT_L
#undef PG8_BAR
#undef PG8_SCHED
}

__device__ __forceinline__ float sigmoidf_fast(float x) { return __builtin_amdgcn_rcpf(1.f + __builtin_amdgcn_exp2f(-x * LOG2E)); }
struct EpiInProj {
    static constexpr bool PERM = true, AFTER_DRAIN = false;
    bf16_t* base; const float* sxn  ; const float* wsc  ;
    const float* gq; const float* gk; PG8_LAS float* xch  ;
    __device__ __forceinline__ void operator()(const i32x4 (&acci)[2][2][4][2], const Unit& u, int wr, int wc, int fr, int fq) const {
        const int sec = u.pn >> 2; const float wsv = *wsc;
        bf16_t* sb = base + (size_t)sec * SEC_ELEMS;
        const float sc = (sec == 4) ? SCALE * LOG2E : 1.f;
        if (sec < 2) {
#pragma unroll
            for (int ai = 0; ai < 2; ++ai)
#pragma unroll
                for (int m = 0; m < 4; ++m) {
                    const int tk = u.pm * BM + ai * HALF + wr * 64 + m * 16 + fr;
                    const float rs = sxn[tk] * wsv;
#pragma unroll
                    for (int bj = 0; bj < 2; ++bj) {
                        const f32x4 v0 = __builtin_convertvector(acci[ai][bj][m][0], f32x4) * rs, v1 = __builtin_convertvector(acci[ai][bj][m][1], f32x4) * rs;
                        float ss = v0[0] * v0[0] + v0[1] * v0[1] + v0[2] * v0[2] + v0[3] * v0[3] + v1[0] * v1[0] + v1[1] * v1[1] + v1[2] * v1[2] + v1[3] * v1[3];
                        ss += sx_f(ss, 16); ss += sx_f(ss, 32);
                        if (fq == 0) xch[(((((wr * 2 + ai) * 4 + m) * 16 + fr) * 2 + bj) * 4) + wc] = ss;
                    }
                }
            asm volatile("s_waitcnt lgkmcnt(0)" ::: "memory");
            __builtin_amdgcn_s_barrier();
            const float* gp = (sec == 0 ? gq : gk) + wc * 32 + 8 * fq;
            const f32x4 g0 = *(const f32x4*)gp, g1 = *(const f32x4*)(gp + 4);
#pragma unroll
            for (int ai = 0; ai < 2; ++ai)
#pragma unroll
                for (int m = 0; m < 4; ++m) {
                    const int tk = u.pm * BM + ai * HALF + wr * 64 + m * 16 + fr, b = tk >> 12, s = tk & 4095;
                    const float rs = sxn[tk] * wsv;
#pragma unroll
                    for (int bj = 0; bj < 2; ++bj) {
                        const int hh = (u.pn & 3) * 2 + bj;
                        const f32x4 p4 = *(const PG8_LAS f32x4*)(xch + (((((wr * 2 + ai) * 4 + m) * 16 + fr) * 2 + bj) * 4));
                        const float r = rs / sqrtf(((p4[0] + p4[1]) + (p4[2] + p4[3])) * (1.f / 128.f) + EPS);
                        const f32x4 v0 = __builtin_convertvector(acci[ai][bj][m][0], f32x4) * r * g0, v1 = __builtin_convertvector(acci[ai][bj][m][1], f32x4) * r * g1;
                        u32x4 w; w.x = cvt_pk_bf16(v0[0], v0[1]); w.y = cvt_pk_bf16(v0[2], v0[3]); w.z = cvt_pk_bf16(v1[0], v1[1]); w.w = cvt_pk_bf16(v1[2], v1[3]);
                        *(u32x4*)(sb + ((size_t)((b * 8 + hh) * 4096 + s)) * 128 + wc * 32 + 8 * fq) = w;
                    }
                }
            return;
        }
#pragma unroll
        for (int ai = 0; ai < 2; ++ai)
#pragma unroll
            for (int m = 0; m < 4; ++m) {
                const int tk = u.pm * BM + ai * HALF + wr * 64 + m * 16 + fr, b = tk >> 12, s = tk & 4095;
                const float rs = sxn[tk] * wsv;
#pragma unroll
                for (int bj = 0; bj < 2; ++bj) {
                    const int hh = (u.pn & 3) * 2 + bj;
                    f32x4 v0 = __builtin_convertvector(acci[ai][bj][m][0], f32x4) * rs, v1 = __builtin_convertvector(acci[ai][bj][m][1], f32x4) * rs;
                    bf16_t* dst;
                    if (sec == 3) {
#pragma unroll
                        for (int i = 0; i < 4; ++i) { v0[i] = sigmoidf_fast(v0[i]); v1[i] = sigmoidf_fast(v1[i]); }
                        dst = sb + (size_t)tk * 1024 + hh * 128 + wc * 32 + 8 * fq;
                    } else {
                        v0 = v0 * sc; v1 = v1 * sc;
                        dst = sb + ((size_t)((b * 8 + hh) * 4096 + s)) * 128 + wc * 32 + 8 * fq;
                    }
                    u32x4 w; w.x = cvt_pk_bf16(v0[0], v0[1]); w.y = cvt_pk_bf16(v0[2], v0[3]); w.z = cvt_pk_bf16(v1[0], v1[1]); w.w = cvt_pk_bf16(v1[2], v1[3]);
                    *(u32x4*)dst = w;
                }
            }
    }
};
struct EpiOutProj {
    static constexpr bool PERM = true, AFTER_DRAIN = false;
    const float* x; float* h; bf16_t* hb; float* ssq; float* amx;
    __device__ __forceinline__ void operator()(const f32x4 (&acc)[2][2][4][2], const Unit& u, int wr, int wc, int fr, int fq) const {
#pragma unroll
        for (int ai = 0; ai < 2; ++ai)
#pragma unroll
            for (int m = 0; m < 4; ++m) {
                const int tk = u.pm * BM + ai * HALF + wr * 64 + m * 16 + fr;
                float ss = 0.f, mx = 0.f;
#pragma unroll
                for (int bj = 0; bj < 2; ++bj) {
                    const size_t off = (size_t)tk * DM + u.pn * BM + bj * HALF + wc * 32 + 8 * fq;
                    const f32x4 x0 = *(const f32x4*)(x + off), x1 = *(const f32x4*)(x + off + 4);
                    const f32x4 v0 = acc[ai][bj][m][0] + x0, v1 = acc[ai][bj][m][1] + x1;
                    u32x4 w; w.x = cvt_pk_bf16(v0[0], v0[1]); w.y = cvt_pk_bf16(v0[2], v0[3]); w.z = cvt_pk_bf16(v1[0], v1[1]); w.w = cvt_pk_bf16(v1[2], v1[3]);
                    *(u32x4*)(hb + off) = w;
                    ss += v0[0] * v0[0] + v0[1] * v0[1] + v0[2] * v0[2] + v0[3] * v0[3] + v1[0] * v1[0] + v1[1] * v1[1] + v1[2] * v1[2] + v1[3] * v1[3];
                    mx = fmaxf(mx, fmaxf(fmaxf(fmaxf(fabsf(v0[0]), fabsf(v0[1])), fmaxf(fabsf(v0[2]), fabsf(v0[3]))), fmaxf(fmaxf(fabsf(v1[0]), fabsf(v1[1])), fmaxf(fabsf(v1[2]), fabsf(v1[3])))));
                }
                ss += sx_f(ss, 16); ss += sx_f(ss, 32);
                mx = fmaxf(mx, sx_f(mx, 16)); mx = fmaxf(mx, sx_f(mx, 32));
                if (fq == 0) { ssq[(size_t)tk * 32 + u.pn * 4 + wc] = ss; amx[(size_t)tk * 32 + u.pn * 4 + wc] = mx; }
            }
    }
};
struct EpiPeerQ {
    static constexpr bool PERM = true, AFTER_DRAIN = false;
    const float* ssq; bf16_t* qp; float* rtab;
    __device__ __forceinline__ void operator()(const f32x4 (&acc)[2][2][4][2], const Unit& u, int wr, int wc, int fr, int fq) const {
#pragma unroll
        for (int ai = 0; ai < 2; ++ai)
#pragma unroll
            for (int m = 0; m < 4; ++m) {
                const int tk = u.pm * BM + ai * HALF + wr * 64 + m * 16 + fr;
                float tot = 0.f;
#pragma unroll
                for (int i = 0; i < 8; ++i) { const f32x4 s4 = *(const f32x4*)(ssq + (size_t)tk * 32 + 4 * i); tot += (s4[0] + s4[1]) + (s4[2] + s4[3]); }
                const float r = 1.0f / sqrtf(tot * (1.f / DM) + EPS);
                if (u.pn == 0 && wc == 0 && fq == 0) rtab[tk] = r;
#pragma unroll
                for (int bj = 0; bj < 2; ++bj) {
                    const size_t off = (size_t)tk * DM + u.pn * BM + bj * HALF + wc * 32 + 8 * fq;
                    const f32x4 v0 = acc[ai][bj][m][0] * r, v1 = acc[ai][bj][m][1] * r;
                    u32x4 w; w.x = cvt_pk_bf16(v0[0], v0[1]); w.y = cvt_pk_bf16(v0[2], v0[3]); w.z = cvt_pk_bf16(v1[0], v1[1]); w.w = cvt_pk_bf16(v1[2], v1[3]);
                    *(u32x4*)(qp + off) = w;
                }
            }
    }
};
struct EpiPeerQFused {
    static constexpr bool PERM = true, AFTER_DRAIN = true;
    const float* ssq; unsigned char* wsb;
    __device__ __forceinline__ void operator()(const f32x4 (&)[2][2][4][2], const Unit&, int, int, int, int) const {}
    __device__ __forceinline__ void fused(const f32x4 (&acc)[2][2][4][2], const Unit& u, int wr, int wc, int fr, int fq, PG8_LAS unsigned char* lds) const;
};
}

namespace att {
constexpr int NW = 8, QBLK = 32, KVBLK = 64, QB = NW * QBLK, D = 128;
constexpr int SHM_V = KVBLK * D * 2, SHM_K = KVBLK * D * 2;
constexpr int OFF_WS = 2 * SHM_V + 2 * SHM_K, OFF_BIAS = OFF_WS + NW * 64 * 4, ATT_LDS = OFF_BIAS + SEQ * 4;
#define KSWZ(row, colB) ((row) * 256 + ((colB) ^ (((row) & 7) << 4)))
#define SBAR() __builtin_amdgcn_sched_barrier(0)
__device__ __forceinline__ int v_st(int k, int c) { const int kk = (k & ~0xC) | ((k & 4) << 1) | ((k & 8) >> 1); return ((kk >> 3) * 4 + (c >> 5)) * 512 + ((kk & 7) * 32 + (c & 31)) * 2; }
__device__ __forceinline__ int v_rd_base(int lane) { return ((lane & 3) << 3) | (((lane >> 2) & 3) << 6) | (((lane >> 4) & 1) << 5) | (((lane >> 5) & 1) << 8); }
constexpr int v_rd_off(int d0, int ks, int half) { return d0 * 512 + ks * 4096 + half * 2048; }
__device__ __forceinline__ int crow(int r, int hi) { return (r & 3) + 8 * (r >> 2) + 4 * hi; }
__device__ __forceinline__ bf16x8 load8(const bf16_t* p) { return *reinterpret_cast<const bf16x8*>(p); }
__device__ __forceinline__ void mask_tile(f32x16& p0, f32x16& p1, int dq) {
    const float NEG = -__builtin_inff();
#pragma unroll
    for (int r = 0; r < 16; ++r) {
        const int c = (r & 3) + 8 * (r >> 2);
        if (dq - c < 0) p0[r] = NEG;
        if (dq - c - 32 < 0) p1[r] = NEG;
    }
}
__device__ __forceinline__ void partialSM(f32x16& p0, f32x16& p1, float& m_reg, float& mn, float& alpha) {
    float pmax = p0[0];
#pragma unroll
    for (int r = 1; r < 16; ++r) pmax = fmaxf(pmax, p0[r]);
#pragma unroll
    for (int r = 0; r < 16; ++r) pmax = fmaxf(pmax, p1[r]);
    { auto rr = __builtin_amdgcn_permlane32_swap(__float_as_uint(pmax), __float_as_uint(pmax), false, false);
      pmax = fmaxf(__uint_as_float(rr[0]), __uint_as_float(rr[1])); }
    constexpr float C2 = LOG2E * SCALE; constexpr float THR = 8.f;
    if (__builtin_expect(__all((pmax - m_reg) * SCALE <= THR), 1)) { mn = m_reg; alpha = 1.f; }
    else { mn = fmaxf(m_reg, pmax); alpha = __builtin_amdgcn_exp2f((m_reg - mn) * C2); m_reg = mn; }
    const float mnL = -mn * C2;
#pragma unroll
    for (int r = 0; r < 16; ++r) p0[r] = fmaf(p0[r], C2, mnL);
#pragma unroll
    for (int r = 0; r < 16; ++r) p1[r] = fmaf(p1[r], C2, mnL);
#pragma unroll
    for (int r = 0; r < 16; ++r) p0[r] = __builtin_amdgcn_exp2f(p0[r]);
}
#define PK4(P, B_, OUT) do { unsigned a0 = cvt_pk_bf16(P[B_+0], P[B_+1]), a1 = cvt_pk_bf16(P[B_+2], P[B_+3]);                          \
        unsigned b0 = cvt_pk_bf16(P[B_+4], P[B_+5]), b1 = cvt_pk_bf16(P[B_+6], P[B_+7]);                                             \
        auto r0 = __builtin_amdgcn_permlane32_swap(a0, b0, false, false); auto r1 = __builtin_amdgcn_permlane32_swap(a1, b1, false, false); \
        u32x4 w = {r0[0], r1[0], r0[1], r1[1]}; OUT = *reinterpret_cast<bf16x8*>(&w); } while (0)
__device__ __forceinline__ void finishSM(f32x16& p0, f32x16& p1, float alpha, float& l_reg, bf16x8& pa0, bf16x8& pa1, bf16x8& pa2, bf16x8& pa3) {
#pragma unroll
    for (int r = 0; r < 16; ++r) p1[r] = __builtin_amdgcn_exp2f(p1[r]);
    float ps = 0;
#pragma unroll
    for (int r = 0; r < 16; ++r) ps += p0[r];
#pragma unroll
    for (int r = 0; r < 16; ++r) ps += p1[r];
    { auto rr = __builtin_amdgcn_permlane32_swap(__float_as_uint(ps), __float_as_uint(ps), false, false);
      ps = __uint_as_float(rr[0]) + __uint_as_float(rr[1]); }
    l_reg = l_reg * alpha + ps;
    PK4(p0, 0, pa0); PK4(p0, 8, pa1); PK4(p1, 0, pa2); PK4(p1, 8, pa3);
}
__device__ __forceinline__ void sb_group(f32x16& P, int g, float& gs) {
    float run = 0.f;
#pragma unroll
    for (int k = 3; k >= 0; --k) {
        const float z = P[4 * g + k];
        const float t = __builtin_amdgcn_exp2f(-fabsf(z));
        const float l = __builtin_amdgcn_logf(1.f + t);
        const float sp = fmaxf(z, 0.f) + l;
        P[4 * g + k] = (z - sp) - run;
        run += sp;
    }
    gs = run;
}
__device__ __forceinline__ void sb_part1(f32x16& p0, f32x16& p1, float& carry, float mlo) {
    float gs[8];
#pragma unroll
    for (int g = 0; g < 4; ++g) sb_group(p0, g, gs[g]);
#pragma unroll
    for (int g = 0; g < 4; ++g) sb_group(p1, g, gs[4 + g]);
    float run = carry;
#pragma unroll
    for (int G = 7; G >= 0; --G) {
        auto rr = __builtin_amdgcn_permlane32_swap(__float_as_uint(gs[G]), __float_as_uint(gs[G]), false, false);
        const float slo = __uint_as_float(rr[0]), shi = __uint_as_float(rr[1]);
        const float base = fmaf(mlo, shi, run);
        if (G >= 4) {
#pragma unroll
            for (int k = 0; k < 4; ++k) p1[4 * (G - 4) + k] -= base;
        } else {
#pragma unroll
            for (int k = 0; k < 4; ++k) p0[4 * G + k] -= base;
        }
        run += slo + shi;
    }
    carry = run;
#pragma unroll
    for (int r = 0; r < 16; ++r) p0[r] = __builtin_amdgcn_exp2f(p0[r]);
}
__device__ __forceinline__ void sb_part2(f32x16& p0, f32x16& p1, bf16x8& pa0, bf16x8& pa1, bf16x8& pa2, bf16x8& pa3) {
#pragma unroll
    for (int r = 0; r < 16; ++r) p1[r] = __builtin_amdgcn_exp2f(p1[r]);
    PK4(p0, 0, pa0); PK4(p0, 8, pa1); PK4(p1, 0, pa2); PK4(p1, 8, pa3);
}
#undef PK4
template <int KB, bool BIAS>
__device__ __forceinline__ void qkt(f32x16& p0, f32x16& p1, const char* K_lds, int r32, int hi, const bf16x8* qr, const float* bt) {
    if constexpr (BIAS) {
#pragma unroll
        for (int g = 0; g < 4; ++g) { const f32x4 a = *(const f32x4*)(bt + 8 * g), b = *(const f32x4*)(bt + 32 + 8 * g);
            p0[4 * g] = a[0]; p0[4 * g + 1] = a[1]; p0[4 * g + 2] = a[2]; p0[4 * g + 3] = a[3];
            p1[4 * g] = b[0]; p1[4 * g + 1] = b[1]; p1[4 * g + 2] = b[2]; p1[4 * g + 3] = b[3]; }
    } else { p0 = f32x16{}; p1 = f32x16{}; }
    const char* kb[4];
#pragma unroll
    for (int dd = 0; dd < 4; ++dd) kb[dd] = K_lds + KB * SHM_K + KSWZ(r32, (dd * 16 + hi * 8) * 2);
#pragma unroll
    for (int d0 = 0; d0 < 8; ++d0) { const char* a = kb[d0 & 3] + (d0 >> 2) * 128;
        bf16x8 b0 = *reinterpret_cast<const bf16x8*>(a);
        bf16x8 b1 = *reinterpret_cast<const bf16x8*>(a + 32 * 256);
        p0 = __builtin_amdgcn_mfma_f32_32x32x16_bf16(b0, qr[d0], p0, 0, 0, 0);
        p1 = __builtin_amdgcn_mfma_f32_32x32x16_bf16(b1, qr[d0], p1, 0, 0, 0); }
}
template <int VB>
__device__ __forceinline__ void pv_tile(f32x16* o, int vb0, bf16x8 pa0, bf16x8 pa1, bf16x8 pa2, bf16x8 pa3) {
#define TRRD(dst, off) asm volatile("ds_read_b64_tr_b16 %0, %1 offset:%2" : "=&v"(dst) : "v"(vb0), "i"(off) : "memory")
#define PV_D0(d0) do { { s16x4 l0, l1, h0, h1; constexpr int b_ = VB * SHM_V + v_rd_off(d0, 0, 0); \
        TRRD(l0, b_); TRRD(h0, b_ + 2048); TRRD(l1, b_ + 4096); TRRD(h1, b_ + 6144); \
        asm volatile("s_waitcnt lgkmcnt(0)" ::: "memory"); SBAR();   \
        o[d0] = __builtin_amdgcn_mfma_f32_32x32x16_bf16(pa0, (bf16x8){l0[0], l0[1], l0[2], l0[3], h0[0], h0[1], h0[2], h0[3]}, o[d0], 0, 0, 0);   \
        o[d0] = __builtin_amdgcn_mfma_f32_32x32x16_bf16(pa1, (bf16x8){l1[0], l1[1], l1[2], l1[3], h1[0], h1[1], h1[2], h1[3]}, o[d0], 0, 0, 0); }  \
      { s16x4 l2, l3, h2, h3; constexpr int b_ = VB * SHM_V + v_rd_off(d0, 0, 0); \
        TRRD(l2, b_ + 8192); TRRD(h2, b_ + 10240); TRRD(l3, b_ + 12288); TRRD(h3, b_ + 14336); \
        asm volatile("s_waitcnt lgkmcnt(0)" ::: "memory"); SBAR();   \
        o[d0] = __builtin_amdgcn_mfma_f32_32x32x16_bf16(pa2, (bf16x8){l2[0], l2[1], l2[2], l2[3], h2[0], h2[1], h2[2], h2[3]}, o[d0], 0, 0, 0);   \
        o[d0] = __builtin_amdgcn_mfma_f32_32x32x16_bf16(pa3, (bf16x8){l3[0], l3[1], l3[2], l3[3], h3[0], h3[1], h3[2], h3[3]}, o[d0], 0, 0, 0); } } while (0)
    PV_D0(0); PV_D0(1); PV_D0(2); PV_D0(3);
#undef PV_D0
#undef TRRD
}

struct UnitRef { const bf16_t* Q; const bf16_t* K; const bf16_t* V; int P0; };
struct Seam { bf16x8 qr[8]; bf16x8 st_v0, st_v1, st_k0, st_k1; };
#define ROW(p, k0, rr) ((p) + (size_t)((k0) + (rr)) * D + sc)
#define VMW() asm volatile("s_waitcnt vmcnt(0)" ::: "memory")
#define SLOAD_H(Kp, Vp, k0) do { S.st_v0 = load8(ROW(Vp, k0, sr)); S.st_v1 = load8(ROW(Vp, k0, 32 + sr));              \
                         S.st_k0 = load8(ROW(Kp, k0, sr)); S.st_k1 = load8(ROW(Kp, k0, 32 + sr)); } while (0)
#define SWRITE_HK(bf) do { *(bf16x8*)(K_lds + (bf) * SHM_K + kws) = S.st_k0; *(bf16x8*)(K_lds + (bf) * SHM_K + kws + 32 * 256) = S.st_k1; } while (0)
#define SWRITE_HV(bf) do { *(bf16x8*)(V_lds + (bf) * SHM_V + vst0) = S.st_v0; *(bf16x8*)(V_lds + (bf) * SHM_V + vst1) = S.st_v1; } while (0)
#define SWRITE_H(bf) do { SWRITE_HV(bf); SWRITE_HK(bf); } while (0)

template <bool SB>
__device__ __forceinline__ void attn_unit(const UnitRef& cur, unsigned char* wsu  , int bh, char* lds,
                                          int part  ) {
    const float* cvec; const float* gqk;
    { unsigned char* w_ = wsu; asm volatile("" : "+s"(w_)); cvec = (const float*)(w_ + WS_C) + (size_t)bh * SEQ; gqk = (const float*)(w_ + WS_GQK); }
    const int tid = tid_opaque(), wid = __builtin_amdgcn_readfirstlane(tid >> 6), lane = tid & 63, r32 = lane & 31, hi = lane >> 5;
    int jlo = 0;
    if constexpr (!SB) {
        const float gq = fmaxf(fabsf(gqk[lane]), fabsf(gqk[64 + lane])), gk = fmaxf(fabsf(gqk[128 + lane]), fabsf(gqk[192 + lane]));
        const float lmax = 11.3137085f * 1.02f * wave_max(gq) * wave_max(gk);
        const int ntf = (cur.P0 + QB) / KVBLK;
        const float cend = (lane < ntf) ? cvec[lane * KVBLK + KVBLK - 1] : 0.f;
        const bool skip = (lane < ntf) && (2.f * lmax + cvec[cur.P0] - cend < -104.f);
        jlo = __builtin_amdgcn_readfirstlane((int)__popcll(__ballot(skip)));
    }
    const int ntot = (cur.P0 + QB) / KVBLK - jlo;
    const int tb = (part == 2) ? (ntot >> 1) : 0, te = (part == 1) ? (ntot >> 1) : ntot;
    const int kshift = (jlo + tb) * KVBLK, P0r = cur.P0 - kshift;
    const int NT = te - tb;
#define KBASE(t) ((SB ? (NT - 1 - (t)) : (t)) * KVBLK)
    const int qlo = P0r + wid * QBLK, qm = qlo + r32 - 4 * hi - (SB ? 1 : 0);
    char* V_lds = lds; char* K_lds = lds + 2 * SHM_V;
    float* ws = (float*)(lds + OFF_WS) + wid * 64; float* li_l = ws, * al_l = ws + 32;
    float* bias = (float*)(lds + OFF_BIAS);
    const int sr = tid >> 4, sc = (tid & 15) * 8, vst0 = v_st(sr, sc), vst1 = v_st(32 + sr, sc), kws = KSWZ(sr, sc * 2);
    const int vb0 = (int)(uintptr_t)V_lds + v_rd_base(lane);
    const bf16_t* Kh = cur.K + (size_t)kshift * D; const bf16_t* Vh = cur.V + (size_t)kshift * D;
    Seam S;
    if constexpr (!SB) { const float cq0 = cvec[cur.P0]; const float* cv = cvec + kshift; for (int j = tid; j < NT * KVBLK; j += NTHREADS) bias[j] = (cq0 - cv[j]) * (1.f / SCALE); }
#pragma unroll
    for (int d0 = 0; d0 < 8; ++d0) S.qr[d0] = load8(cur.Q + (size_t)(wid * QBLK + r32) * D + d0 * 16 + hi * 8);
    SLOAD_H(Kh, Vh, KBASE(0)); VMW(); SWRITE_HK(0);
    __syncthreads();
    float m_reg = -1e30f, l_reg = 0; f32x16 o[4] = {};
    float carry = 0.f; const float mlo = hi ? 0.f : 1.f;
#define RESC(a) do { if (__any((a) < 1.f)) { if (hi == 0) al_l[r32] = (a); asm volatile("s_waitcnt lgkmcnt(0)" ::: "memory");              \
                     for (int d_ = 0; d_ < 4; ++d_) for (int r = 0; r < 16; ++r) o[d_][r] *= al_l[crow(r, hi)]; } } while (0)
#define MASKT(P0_, P1_, t) do { const int kb_ = KBASE(t); if (kb_ + KVBLK - 1 > qlo - (SB ? 1 : 0)) mask_tile(P0_, P1_, qm - kb_); } while (0)
#define BT(t) (bias + KBASE(t) + 4 * hi)
#define PART1(PX0, PX1, mnX, alX) do { if constexpr (SB) sb_part1(PX0, PX1, carry, mlo); else partialSM(PX0, PX1, m_reg, mnX, alX); } while (0)
#define PART2(PY0, PY1, alY) do { if constexpr (SB) sb_part2(PY0, PY1, pa0, pa1, pa2, pa3); else finishSM(PY0, PY1, alY, l_reg, pa0, pa1, pa2, pa3); } while (0)
    f32x16 pA0, pA1, pB0, pB1; float mnA = 0.f, mnB = 0.f, alA = 1.f, alB = 1.f; bf16x8 pa0, pa1, pa2, pa3;
    SWRITE_HV(0); SBAR();
    if (NT > 1) SLOAD_H(Kh, Vh, KBASE(1));
    SBAR(); qkt<0, !SB>(pA0, pA1, K_lds, r32, hi, S.qr, BT(0));
    MASKT(pA0, pA1, 0); PART1(pA0, pA1, mnA, alA);
    if (NT > 1) { VMW(); SWRITE_H(1); }
    __syncthreads();
#define HALF_STEP(PX0, PX1, mnX, alX, PY0, PY1, alY, t, KB, VB, SBUF) do {                                                    \
        SBAR(); qkt<KB, !SB>(PX0, PX1, K_lds, r32, hi, S.qr, BT(t));                                                          \
        PART2(PY0, PY1, alY); SBAR();                                                                                          \
        if ((t) + 1 < NT) { SLOAD_H(Kh, Vh, KBASE((t) + 1)); SBAR(); }                                                         \
        pv_tile<VB>(o, vb0, pa0, pa1, pa2, pa3); MASKT(PX0, PX1, (t)); PART1(PX0, PX1, mnX, alX);                              \
        __syncthreads();                                                                                                      \
        if ((t) + 1 < NT) { VMW(); SWRITE_H(SBUF); }                                                                           \
        if constexpr (!SB) RESC(alX);                                                                                          \
        __syncthreads(); } while (0)
    for (int t = 1; t + 1 < NT; t += 2) {
        HALF_STEP(pB0, pB1, mnB, alB, pA0, pA1, alA, t, 1, 0, 0);
        HALF_STEP(pA0, pA1, mnA, alA, pB0, pB1, alB, t + 1, 0, 1, 1);
    }
    const bool even = (NT & 1) == 0;
    if (even) { SBAR(); qkt<1, !SB>(pB0, pB1, K_lds, r32, hi, S.qr, BT(NT - 1)); SBAR(); }
    PART2(pA0, pA1, alA); SBAR();
    pv_tile<0>(o, vb0, pa0, pa1, pa2, pa3);
    if (even) { MASKT(pB0, pB1, NT - 1); PART1(pB0, pB1, mnB, alB); __syncthreads(); if constexpr (!SB) RESC(alB);
        PART2(pB0, pB1, alB); SBAR(); pv_tile<1>(o, vb0, pa0, pa1, pa2, pa3); }
    unsigned char* we_ = wsu; asm volatile("" : "+s"(we_));
    if (part != 0) {
        const int slot2 = ((((cur.P0 >> 8) - 8) & 7) * 16 + bh) * 2 + (part == 2 ? 1 : 0);
        float* po = (float*)(we_ + WS_PO) + (size_t)slot2 * 256 * 128; float* pml = (float*)(we_ + WS_PML) + (size_t)slot2 * 512;
        if (hi == 0) { pml[(wid * QBLK + r32) * 2] = m_reg; pml[(wid * QBLK + r32) * 2 + 1] = l_reg; }
#pragma unroll
        for (int r = 0; r < 16; ++r)
#pragma unroll
            for (int d0 = 0; d0 < 4; ++d0) po[(size_t)(wid * QBLK + crow(r, hi)) * D + d0 * 32 + r32] = o[d0][r];
        __syncthreads();
        return;
    }
    const bf16_t* gate = (const bf16_t*)(we_ + WS_SEC) + 3 * SEC_ELEMS + (size_t)(bh >> 3) * SEQ * 1024 + (bh & 7) * HD;
    bf16_t* outp = (bf16_t*)(we_ + WS_MIX) + (size_t)(bh >> 3) * SEQ * DM + (bh & 7) * HD;
    float rli[16];
    if constexpr (!SB) {
        if (hi == 0) li_l[r32] = l_reg; asm volatile("s_waitcnt lgkmcnt(0)" ::: "memory");
#pragma unroll
        for (int r = 0; r < 16; ++r) rli[r] = __builtin_amdgcn_rcpf(li_l[crow(r, hi)]);
    }
#pragma unroll
    for (int r = 0; r < 16; ++r) { const int orow = cur.P0 + wid * QBLK + crow(r, hi);
#pragma unroll
        for (int d0 = 0; d0 < 4; ++d0) {
            float v = o[d0][r];
            if constexpr (!SB) { const unsigned short gb = gate[(size_t)orow * 1024 + d0 * 32 + r32]; v = v * rli[r] * __builtin_bit_cast(float, (unsigned)gb << 16); }
            const float vn = sx_f(v, 1);
            if ((r32 & 1) == 0) *(unsigned*)(outp + (size_t)orow * DM + d0 * 32 + r32) = cvt_pk_bf16(v, vn); } }
    __syncthreads();
#undef RESC
#undef KBASE
#undef MASKT
#undef BT
#undef PART1
#undef PART2
#undef HALF_STEP
}

constexpr float SB_TH = 150.f;
__device__ __forceinline__ void sb_unit(const UnitRef& cur, bf16_t* outp, char* lds) {
    const int tid = tid_opaque(), wid = __builtin_amdgcn_readfirstlane(tid >> 6), lane = tid & 63, r32 = lane & 31, hi = lane >> 5;
    const int NT = (cur.P0 + QB) / KVBLK;
#define KBASE(t) ((NT - 1 - (t)) * KVBLK)
    const int qlo = cur.P0 + wid * QBLK, qm = qlo + r32 - 4 * hi - 1;
    char* V_lds = lds; char* K_lds = lds + 2 * SHM_V;
    volatile int* flags = (volatile int*)(lds + OFF_WS);
    const int sr = tid >> 4, sc = (tid & 15) * 8, vst0 = v_st(sr, sc), vst1 = v_st(32 + sr, sc), kws = KSWZ(sr, sc * 2);
    const int vb0 = (int)(uintptr_t)V_lds + v_rd_base(lane);
    const bf16_t* Kh = cur.K; const bf16_t* Vh = cur.V;
    Seam S;
#pragma unroll
    for (int d0 = 0; d0 < 8; ++d0) S.qr[d0] = load8(cur.Q + (size_t)(wid * QBLK + r32) * D + d0 * 16 + hi * 8);
    SLOAD_H(Kh, Vh, KBASE(0)); VMW(); SWRITE_H(0);
    __syncthreads();
    f32x16 o[4] = {}; float carry = 0.f; const float mlo = hi ? 0.f : 1.f;
    bool wdone = false;
#define SB_STEP(tt, BUF) {                                                                                                 \
        const int kb_ = KBASE(tt);                                                                                           \
        if ((tt) + 1 < NT) SLOAD_H(Kh, Vh, KBASE((tt) + 1));                                                                 \
        SBAR();                                                                                                              \
        if (!wdone && kb_ <= qlo + QBLK - 2) {                                                                               \
            f32x16 p0, p1; bf16x8 pa0, pa1, pa2, pa3;                                                                        \
            qkt<BUF, false>(p0, p1, K_lds, r32, hi, S.qr, nullptr);                                                          \
            if (kb_ + KVBLK - 1 > qlo - 1) mask_tile(p0, p1, qm - kb_);                                                      \
            sb_part1(p0, p1, carry, mlo); sb_part2(p0, p1, pa0, pa1, pa2, pa3); SBAR();                                      \
            pv_tile<BUF>(o, vb0, pa0, pa1, pa2, pa3);                                                                        \
            wdone = __all(carry >= SB_TH);                                                                                   \
        }                                                                                                                    \
        if ((tt) + 1 < NT) { VMW(); SWRITE_H((BUF) ^ 1); }                                                                   \
        if (lane == 0) flags[((tt) & 1) * 8 + wid] = wdone ? 1 : 0;                                                          \
        __syncthreads();                                                                                                     \
        { int alld = 1;                                                                                                      \
          _Pragma("unroll") for (int w_ = 0; w_ < 8; ++w_) alld &= flags[((tt) & 1) * 8 + w_];                                \
          if (alld) break; } }
    for (int t = 0; t < NT; t += 2) {
        SB_STEP(t, 0)
        SB_STEP(t + 1, 1)
    }
#undef SB_STEP
#pragma unroll
    for (int r = 0; r < 16; ++r) { const int orow = cur.P0 + wid * QBLK + crow(r, hi);
#pragma unroll
        for (int d0 = 0; d0 < 4; ++d0) {
            const float v = o[d0][r];
            const float vn = sx_f(v, 1);
            if ((r32 & 1) == 0) *(unsigned*)(outp + (size_t)orow * DM + d0 * 32 + r32) = cvt_pk_bf16(v, vn); } }
    __syncthreads();
#undef KBASE
}
#undef ROW
#undef VMW
#undef SLOAD_H
#undef SWRITE_HK
#undef SWRITE_HV
#undef SWRITE_H
}

#define XB_TMO      128
#define XB_XCNT(j)  (256  + 64 * (j))
#define XB_XSUB(j)  (1280 + 64 * (j))
#define XB_XGEN(j)  (2304 + 64 * (j))
#define XB_TOP      3328
#define XB_TOPGEN   3392
#define XCD_BAR_WORDS 3456
#define XB_SPIN_CAP (1u << 20)
__device__ __forceinline__ unsigned xb_ld(unsigned* p)              { return __hip_atomic_load(p, __ATOMIC_RELAXED, __HIP_MEMORY_SCOPE_AGENT); }
__device__ __forceinline__ unsigned xb_add(unsigned* p, unsigned v) { return __hip_atomic_fetch_add(p, v, __ATOMIC_RELAXED, __HIP_MEMORY_SCOPE_AGENT); }
__device__ __forceinline__ unsigned xb_xcc_id() { return (unsigned)__builtin_amdgcn_s_getreg((3 << 11) | 20) & 0xFu; }
#define XB_SPIN(cond, bar) do { unsigned _sp = 0; while (cond) { __builtin_amdgcn_s_sleep(1); \
    if ((++_sp & 255u) == 0u) { if (xb_ld(&(bar)[XB_TMO])) break; if (_sp > XB_SPIN_CAP) { atomicAdd(&(bar)[XB_TMO], 1u); break; } } } } while (0)
struct XcdBarrier { unsigned* bar; unsigned x; volatile LAS unsigned* st; };
__device__ __forceinline__ XcdBarrier xcd_barrier_post(unsigned* bar, volatile LAS unsigned* st) {
    XcdBarrier b; b.bar = bar; b.x = xb_xcc_id(); b.st = st;
    if (threadIdx.x == 0) (void)xb_add(&bar[XB_XCNT(b.x)], 1u);
    return b;
}
__device__ __forceinline__ void xcd_barrier_complete(unsigned* bar, unsigned x, unsigned& nloc, unsigned& nx) {
    const unsigned G = gridDim.x * gridDim.y * gridDim.z;
    unsigned sum, cnt, mine, sp = 0u;
    for (;;) {
        sum = 0u; cnt = 0u; mine = 0u;
#pragma unroll
        for (unsigned j = 0; j < 16; ++j) { const unsigned c = xb_ld(&bar[XB_XCNT(j)]); sum += c; cnt += (c > 0u) ? 1u : 0u; mine = (j == x) ? c : mine; }
        if (sum == G) break;
        __builtin_amdgcn_s_sleep(1);
        if ((++sp & 255u) == 0u) { if (xb_ld(&bar[XB_TMO])) break; if (sp > XB_SPIN_CAP) { atomicAdd(&bar[XB_TMO], 1u); break; } }
    }
    nloc = mine > 0u ? mine : 1u; nx = cnt > 0u ? cnt : 1u;
}
__device__ __forceinline__ void xcd_barrier(const XcdBarrier& b) {
    asm volatile("s_waitcnt vmcnt(0)" ::: "memory");
    __syncthreads();
    if (threadIdx.x == 0) {
        unsigned* bar = b.bar;
        __builtin_amdgcn_s_waitcnt(0);
        unsigned nloc = b.st[0], nx = b.st[1];
        if (nloc == 0u) { xcd_barrier_complete(bar, b.x, nloc, nx); b.st[0] = nloc; b.st[1] = nx; }
        const unsigned old = xb_add(&bar[XB_XSUB(b.x)], 1u);
        const unsigned gen = old / nloc;
        if (old + 1u == (gen + 1u) * nloc) {
            __builtin_amdgcn_fence(__ATOMIC_RELEASE, "agent");
            asm volatile("s_waitcnt vmcnt(0)" ::: "memory");
            const unsigned og = xb_add(&bar[XB_TOP], 1u);
            const unsigned tg = og / nx;
            if (og + 1u == (tg + 1u) * nx) xb_add(&bar[XB_TOPGEN], 1u);
            else XB_SPIN(xb_ld(&bar[XB_TOPGEN]) == tg, bar);
            __builtin_amdgcn_fence(__ATOMIC_ACQUIRE, "agent");
            xb_add(&bar[XB_XGEN(b.x)], 1u);
            asm volatile("s_waitcnt vmcnt(0)" ::: "memory");
        } else {
            XB_SPIN(xb_ld(&bar[XB_XGEN(b.x)]) == gen, bar);
            __builtin_amdgcn_fence(__ATOMIC_ACQUIRE, "agent");
            asm volatile("s_waitcnt vmcnt(0)" ::: "memory");
        }
    }
    __syncthreads();
}

struct Args { const float* in[12]; float* out; unsigned char* ws; int ph_lo, ph_hi; };

__device__ __forceinline__ void p0_transpose_item(const float* W, int ldw, int K, bf16_t* WT, int nblk, LAS float* scr, int item, int lane, const float* gk) {
    const int kb = item / nblk, nb = item % nblk, k0 = 64 * kb, n0 = 32 * nb;
    { const int rr = lane >> 3, c4 = lane & 7; f32x4 v[8];
#pragma unroll
      for (int i = 0; i < 8; ++i) v[i] = *(const f32x4*)(W + (size_t)(k0 + rr + 8 * i) * ldw + n0 + 4 * c4);
#pragma unroll
      for (int i = 0; i < 8; ++i) { const int kk = rr + 8 * i; const float gm = gk ? gk[k0 + kk] : 1.f;
          scr[kk * 33 + 4 * c4] = v[i][0] * gm; scr[kk * 33 + 4 * c4 + 1] = v[i][1] * gm; scr[kk * 33 + 4 * c4 + 2] = v[i][2] * gm; scr[kk * 33 + 4 * c4 + 3] = v[i][3] * gm; } }
    LDS_WAIT(); asm volatile("" ::: "memory");
    const int c = lane & 7;
#pragma unroll
    for (int j = 0; j < 4; ++j) { const int n = (lane >> 3) + 8 * j; const LAS float* s = scr + (8 * c) * 33 + n;
        u32x4 o; o.x = cvt_pk_bf16(s[0 * 33], s[1 * 33]); o.y = cvt_pk_bf16(s[2 * 33], s[3 * 33]); o.z = cvt_pk_bf16(s[4 * 33], s[5 * 33]); o.w = cvt_pk_bf16(s[6 * 33], s[7 * 33]);
        *(u32x4*)(WT + (size_t)(n0 + n) * K + k0 + 8 * c) = o; }
    LDS_WAIT(); asm volatile("" ::: "memory");
}

__device__ __forceinline__ int pack_i8(float a, float b, float c, float d) {
    const int ia = (int)__builtin_rintf(a), ib = (int)__builtin_rintf(b), ic = (int)__builtin_rintf(c), id = (int)__builtin_rintf(d);
    return (int)(((unsigned)ia & 0xffu) | (((unsigned)ib & 0xffu) << 8) | (((unsigned)ic & 0xffu) << 16) | ((unsigned)id << 24));
}
__device__ __forceinline__ void convert_tables(const Args& a, int r0, int r1, int worker, int nworkers) {
    const int lane = tid_opaque() & 63;
    unsigned char* ws = a.ws; const float* g_ffn = a.in[7]; const float* pu = a.in[10]; const float* pv = a.in[11];
    float* suv = (float*)(ws + WS_SUV);
    for (int r = r0 + worker; r < r1; r += nworkers) {
        const bool isv = r >= NEXP; const int e = isv ? r - NEXP : r;
        const f32x4* srcp = (const f32x4*)((isv ? pv : pu) + (size_t)e * DM);
        f32x4 v[8]; float amax = 0.f;
#pragma unroll
        for (int j = 0; j < 8; ++j) { v[j] = srcp[lane + 64 * j];
            if (!isv) { const f32x4 g4 = *(const f32x4*)(g_ffn + 4 * (lane + 64 * j)); v[j] = v[j] * g4; }
            amax = fmaxf(amax, fmaxf(fmaxf(fabsf(v[j][0]), fabsf(v[j][1])), fmaxf(fabsf(v[j][2]), fabsf(v[j][3])))); }
        amax = wave_max(amax);
        const float sc = amax > 0.f ? 127.f / amax : 1.f;
        unsigned char* dst = ws + (isv ? WS_V8 : WS_U8) + (size_t)e * 128;
#pragma unroll
        for (int j = 0; j < 8; ++j) { const int p = pack_i8(v[j][0] * sc, v[j][1] * sc, v[j][2] * sc, v[j][3] * sc);
            const int col = 4 * (lane + 64 * j);
            *(unsigned*)(dst + (size_t)(col >> 7) * ((size_t)NEXP * 128) + (col & 127)) = (unsigned)p; }
        if (lane == 0) suv[r] = 1.f / sc;
    }
}
constexpr int TAB_SPLIT = NEXP;

__device__ __forceinline__ void p0_transpose_item_i8(const float* W, int ldw, int K, unsigned char* WT, int nblk, LAS float* scr, int item, int lane, float q8) {
    const int kb = item / nblk, nb = item % nblk, k0 = 64 * kb, n0 = 32 * nb;
    { const int rr = lane >> 3, c4 = lane & 7; f32x4 v[8];
#pragma unroll
      for (int i = 0; i < 8; ++i) v[i] = *(const f32x4*)(W + (size_t)(k0 + rr + 8 * i) * ldw + n0 + 4 * c4);
#pragma unroll
      for (int i = 0; i < 8; ++i) { const int kk = rr + 8 * i;
          scr[kk * 33 + 4 * c4] = v[i][0] * q8; scr[kk * 33 + 4 * c4 + 1] = v[i][1] * q8; scr[kk * 33 + 4 * c4 + 2] = v[i][2] * q8; scr[kk * 33 + 4 * c4 + 3] = v[i][3] * q8; } }
    LDS_WAIT(); asm volatile("" ::: "memory");
    const int c = lane & 7;
#pragma unroll
    for (int j = 0; j < 4; ++j) { const int n = (lane >> 3) + 8 * j; const LAS float* s = scr + (8 * c) * 33 + n;
        u32x2 o; o.x = (unsigned)pack_i8(s[0 * 33], s[1 * 33], s[2 * 33], s[3 * 33]); o.y = (unsigned)pack_i8(s[4 * 33], s[5 * 33], s[6 * 33], s[7 * 33]);
        *(u32x2*)(WT + (size_t)(n0 + n) * K + k0 + 8 * c) = o; }
    LDS_WAIT(); asm volatile("" ::: "memory");
}
__device__ __forceinline__ float log_sigmoid_f(float x) { return fminf(x, 0.f) - log1pf(expf(-fabsf(x))); }

__device__ __forceinline__ void phase0(const Args& a, unsigned char* lds_g) {
    LAS unsigned char* lds = (LAS unsigned char*)lds_g;
    const int tid = tid_opaque(), lane = tid & 63, wave = __builtin_amdgcn_readfirstlane(tid >> 6);
    const int gw = blockIdx.x * NWAVES + wave, NGW = gridDim.x * NWAVES;
    const int gt = blockIdx.x * NTHREADS + tid, NGT = gridDim.x * NTHREADS;
    unsigned char* ws = a.ws;
    const float* x = a.in[0]; const float* g_attn = a.in[1]; const float* w_in = a.in[2]; const float* b_forget = a.in[3];
    const float* w_out = a.in[6]; const float* g_ffn = a.in[7]; const float* w_pq = a.in[8]; const float* sk = a.in[9]; const float* pu = a.in[10]; const float* pv = a.in[11];
    { float m = 0.f; const f32x4* wp = (const f32x4*)w_in;
      for (size_t i = gt; i < (size_t)DM * DIN / 4; i += NGT) { const f32x4 v = wp[i]; m = fmaxf(m, fmaxf(fmaxf(fabsf(v[0]), fabsf(v[1])), fmaxf(fabsf(v[2]), fabsf(v[3])))); }
      m = wave_max(m);
      if (lane == 0) __hip_atomic_fetch_max((unsigned*)(ws + WS_CTL) + CW_WMAX, __float_as_uint(m), __ATOMIC_RELAXED, __HIP_MEMORY_SCOPE_AGENT); }
    LAS float* wf = (LAS float*)(lds + 67584);
    for (int k = tid; k < DM; k += NTHREADS) { const f32x4 a0 = *(const f32x4*)(w_in + (size_t)k * DIN + NPROJ), a1 = *(const f32x4*)(w_in + (size_t)k * DIN + NPROJ + 4);
        *(LAS f32x4*)(wf + k * 8) = a0; *(LAS f32x4*)(wf + k * 8 + 4) = a1; }
    __syncthreads();
    for (int row = gw; row < T; row += NGW) {
        const f32x4* xr = (const f32x4*)(x + (size_t)row * DM);
        f32x4 v[8]; float ss = 0.f;
#pragma unroll
        for (int j = 0; j < 8; ++j) { v[j] = xr[lane + 64 * j]; ss += v[j][0] * v[j][0] + v[j][1] * v[j][1] + v[j][2] * v[j][2] + v[j][3] * v[j][3]; }
        const float r = 1.0f / sqrtf(wave_sum(ss) * (1.f / DM) + EPS);
        float f[8] = {0.f, 0.f, 0.f, 0.f, 0.f, 0.f, 0.f, 0.f};
        float xmax = 0.f;
#pragma unroll
        for (int j = 0; j < 8; ++j) { const f32x4 g4 = *(const f32x4*)(g_attn + 4 * (lane + 64 * j)); v[j][0] *= r * g4[0]; v[j][1] *= r * g4[1]; v[j][2] *= r * g4[2]; v[j][3] *= r * g4[3];
            xmax = fmaxf(xmax, fmaxf(fmaxf(fabsf(v[j][0]), fabsf(v[j][1])), fmaxf(fabsf(v[j][2]), fabsf(v[j][3])))); }
        xmax = wave_max(xmax);
        const float xq = xmax > 0.f ? 127.f / xmax : 1.f;
        if (lane == 0) ((float*)(ws + WS_SXN))[row] = xmax * (1.f / 127.f);
        unsigned* o8 = (unsigned*)(ws + WS_XN + (size_t)row * DM);
#pragma unroll
        for (int j = 0; j < 8; ++j) {
            const int e = 4 * (lane + 64 * j);
            const f32x4 xn = v[j];
            o8[lane + 64 * j] = (unsigned)pack_i8(xn[0] * xq, xn[1] * xq, xn[2] * xq, xn[3] * xq);
#pragma unroll
            for (int q = 0; q < 4; ++q) { const f32x4 w0 = *(LAS f32x4*)(wf + (e + q) * 8), w1 = *(LAS f32x4*)(wf + (e + q) * 8 + 4);
                f[0] += xn[q] * w0[0]; f[1] += xn[q] * w0[1]; f[2] += xn[q] * w0[2]; f[3] += xn[q] * w0[3];
                f[4] += xn[q] * w1[0]; f[5] += xn[q] * w1[1]; f[6] += xn[q] * w1[2]; f[7] += xn[q] * w1[3]; }
            __builtin_amdgcn_sched_barrier(0);
        }
#pragma unroll
        for (int hh = 0; hh < 8; ++hh) f[hh] = wave_sum(f[hh]);
        if (lane < 8) { float fl = f[0];
#pragma unroll
            for (int hh = 1; hh < 8; ++hh) fl = (lane == hh) ? f[hh] : fl;
            const int b = row >> 12, s = row & 4095;
            ((float*)(ws + WS_LOGF))[(size_t)(b * 8 + lane) * SEQ + s] = log_sigmoid_f(fl + b_forget[lane]); }
    }
    LAS float* scr = (LAS float*)(lds + wave * 8448);
    constexpr int I_IN = (DM / 64) * (NPROJ / 32), I_O = (DM / 64) * (DM / 32);
    for (int it = gw; it < 2 * I_O; it += NGW) {
        int r = it;
        if (r < I_O) { p0_transpose_item(w_out, DM, DM, (bf16_t*)(ws + WS_WOUT), DM / 32, scr, r, lane, nullptr); continue; } r -= I_O;
        p0_transpose_item(w_pq, DM, DM, (bf16_t*)(ws + WS_WPQ), DM / 32, scr, r, lane, g_ffn);
    }
    for (int i = gt; i < 8 * 2 * 128 * 128 / 8; i += NGT) { const f32x4 a0 = *(const f32x4*)(sk + (size_t)i * 8), a1 = *(const f32x4*)(sk + (size_t)i * 8 + 4);
        u32x4 w; w.x = cvt_pk_bf16(a0[0], a0[1]); w.y = cvt_pk_bf16(a0[2], a0[3]); w.z = cvt_pk_bf16(a1[0], a1[1]); w.w = cvt_pk_bf16(a1[2], a1[3]);
        *(u32x4*)(ws + WS_SK + (size_t)i * 16) = w; }
    if (gt < 256) ((float*)(ws + WS_GQK))[gt] = gt < 128 ? a.in[4][gt] : a.in[5][gt - 128];
    convert_tables(a, 0, TAB_SPLIT, gw, NGW);
    { XcdBarrier xb_; xb_.bar = (unsigned*)(ws + WS_CTL) + CW_BAR; xb_.x = xb_xcc_id(); xb_.st = (volatile LAS unsigned*)(lds + MISC_OFF) + 8; xcd_barrier(xb_); }
    const float wmax = __uint_as_float(__hip_atomic_load((unsigned*)(ws + WS_CTL) + CW_WMAX, __ATOMIC_RELAXED, __HIP_MEMORY_SCOPE_AGENT));
    if (gt == 0) *(float*)(ws + WS_WSC) = wmax * (1.f / 127.f);
    const float q8 = wmax > 0.f ? 127.f / wmax : 1.f;
    for (int it = gw; it < I_IN; it += NGW) p0_transpose_item_i8(w_in, DIN, DM, ws + WS_WIN, NPROJ / 32, scr, it, lane, q8);
}

__device__ __forceinline__ void cumsum_rows(const Args& a) {
    const int tid = tid_opaque(), lane = tid & 63, wave = tid >> 6;
    if (blockIdx.x >= 16 || wave != 0) return;
    const float* src = (const float*)(a.ws + WS_LOGF) + (size_t)blockIdx.x * SEQ + lane * 64;
    float* dst = (float*)(a.ws + WS_C) + (size_t)blockIdx.x * SEQ + lane * 64;
    f32x4 v[16]; float run = 0.f;
#pragma unroll
    for (int i = 0; i < 16; ++i) { v[i] = *(const f32x4*)(src + 4 * i);
#pragma unroll
        for (int q = 0; q < 4; ++q) { run += v[i][q]; v[i][q] = run; } }
    float incl = run;
#pragma unroll
    for (int o = 1; o < 64; o <<= 1) { const float t = shup_f(incl, o); if (lane >= o) incl += t; }
    const float off = incl - run;
#pragma unroll
    for (int i = 0; i < 16; ++i) { f32x4 w = v[i]; w[0] += off; w[1] += off; w[2] += off; w[3] += off; *(f32x4*)(dst + 4 * i) = w; }
}

__device__ __forceinline__ void phase_qknorm(const Args& a) {
    const int tid = tid_opaque(), lane = tid & 63, wave = tid >> 6;
    const int gw = blockIdx.x * NWAVES + wave, NGW = gridDim.x * NWAVES;
    const int sub = lane & 15, rw = lane >> 4;
    const float* gq = a.in[4]; const float* gk = a.in[5];
    constexpr int ROWS = NB * NHF * SEQ;
    for (int it = gw; it < 2 * ROWS / 4; it += NGW) {
        const int row = it * 4 + rw; const bool isk = row >= ROWS;
        bf16_t* p = (bf16_t*)(a.ws + WS_SEC) + (size_t)row * HD + sub * 8;
        const float* g = (isk ? gk : gq) + sub * 8;
        const u32x4 w = *(const u32x4*)p;
        float v[8] = {bf_lo(w.x), bf_hi(w.x), bf_lo(w.y), bf_hi(w.y), bf_lo(w.z), bf_hi(w.z), bf_lo(w.w), bf_hi(w.w)};
        float ss = 0.f;
#pragma unroll
        for (int i = 0; i < 8; ++i) ss += v[i] * v[i];
        ss += sx_f(ss, 1); ss += sx_f(ss, 2); ss += sx_f(ss, 4); ss += sx_f(ss, 8);
        const float r = 1.0f / sqrtf(ss * (1.f / HD) + EPS);
        const f32x4 g0 = *(const f32x4*)g, g1 = *(const f32x4*)(g + 4);
        u32x4 o; o.x = cvt_pk_bf16(v[0] * r * g0[0], v[1] * r * g0[1]); o.y = cvt_pk_bf16(v[2] * r * g0[2], v[3] * r * g0[3]);
        o.z = cvt_pk_bf16(v[4] * r * g1[0], v[5] * r * g1[1]); o.w = cvt_pk_bf16(v[6] * r * g1[2], v[7] * r * g1[3]);
        *(u32x4*)p = o;
    }
}

__device__ __forceinline__ void phase_attn(const Args& a, unsigned char* lds_g) {
    const int tid = tid_opaque();
    volatile int* s_item = (volatile int*)(lds_g + MISC_OFF);
    unsigned* ctr = (unsigned*)(a.ws + WS_CTL);
    for (;;) {
        __syncthreads();
        if (tid == 0) *s_item = (int)atomicAdd(ctr, 1u);
        __syncthreads();
        int it = *s_item, kind = -1, qb = 0, sub = 0;
#define CLS(K, Q, CNT) if (kind < 0) { if (it < (CNT)) { kind = (K); qb = (Q); sub = it; } else it -= (CNT); }
        CLS(2, 15, 32) CLS(1, 7, 16) CLS(2, 14, 32) CLS(2, 13, 32) CLS(1, 6, 16) CLS(2, 12, 32) CLS(2, 11, 32) CLS(1, 5, 16) CLS(2, 10, 32) CLS(2, 9, 32) CLS(1, 4, 16) CLS(2, 8, 32) CLS(1, 3, 16) CLS(1, 2, 16)
        if (kind < 0) { if (it < 256) { kind = 0; qb = 15 - (it >> 4); sub = it & 15; } else it -= 256; }
        CLS(1, 1, 16) CLS(1, 0, 16)
#undef CLS
        if (kind < 0) break;
        unsigned char* wsl = a.ws; asm volatile("" : "+s"(wsl));
        bf16_t* sec = (bf16_t*)(wsl + WS_SEC);
        const int bh = sub & 15, part = (kind == 2) ? 1 + (sub >> 4) : 0;
        const int b = bh >> 3, h = bh & 7;
        const size_t hoff = (size_t)bh * SEQ * HD;
        att::UnitRef u;
        u.P0 = qb * 256;
        if (kind == 0) {
            u.Q = sec + 4 * SEC_ELEMS + hoff + (size_t)u.P0 * HD; u.K = sec + 5 * SEC_ELEMS + hoff; u.V = sec + 6 * SEC_ELEMS + hoff;
            att::sb_unit(u, (bf16_t*)(wsl + WS_MIX) + (size_t)b * SEQ * DM + 1024 + h * HD, (char*)lds_g);
        } else {
            u.Q = sec + 0 * SEC_ELEMS + hoff + (size_t)u.P0 * HD; u.K = sec + 1 * SEC_ELEMS + hoff; u.V = sec + 2 * SEC_ELEMS + hoff;
            att::attn_unit<false>(u, wsl, bh, (char*)lds_g, part);
        }
    }
}
__device__ __forceinline__ void phase_attn_combine(const Args& a) {
    const int gt = blockIdx.x * NTHREADS + tid_opaque(), NGT = gridDim.x * NTHREADS;
    const float* po = (const float*)(a.ws + WS_PO); const float* pml = (const float*)(a.ws + WS_PML);
    const bf16_t* gate = (const bf16_t*)(a.ws + WS_SEC) + 3 * SEC_ELEMS; bf16_t* mix = (bf16_t*)(a.ws + WS_MIX);
    constexpr float C2 = LOG2E * SCALE;
    for (int item = gt; item < 128 * 256 * 16; item += NGT) {
        const int slot = item >> 12, row = (item >> 4) & 255, cg = item & 15;
        const int qb = 8 + (slot >> 4), bh = slot & 15, b = bh >> 3, h = bh & 7;
        const f32x2 ml1 = *(const f32x2*)(pml + (size_t)(slot * 2) * 512 + row * 2), ml2 = *(const f32x2*)(pml + (size_t)(slot * 2 + 1) * 512 + row * 2);
        const float M = fmaxf(ml1.x, ml2.x), a1 = __builtin_amdgcn_exp2f((ml1.x - M) * C2), a2 = __builtin_amdgcn_exp2f((ml2.x - M) * C2);
        const float inv = 1.f / (a1 * ml1.y + a2 * ml2.y);
        const float* p1 = po + (size_t)(slot * 2) * 32768 + row * 128 + cg * 8; const float* p2 = p1 + 32768;
        const f32x4 x0 = *(const f32x4*)p1, x1 = *(const f32x4*)(p1 + 4), y0 = *(const f32x4*)p2, y1 = *(const f32x4*)(p2 + 4);
        const size_t tok = (size_t)b * SEQ + qb * 256 + row;
        const u32x4 gw = *(const u32x4*)(gate + tok * 1024 + h * HD + cg * 8);
        const float w1 = a1 * inv, w2 = a2 * inv;
        u32x4 o;
        o.x = cvt_pk_bf16((w1 * x0[0] + w2 * y0[0]) * bf_lo(gw.x), (w1 * x0[1] + w2 * y0[1]) * bf_hi(gw.x));
        o.y = cvt_pk_bf16((w1 * x0[2] + w2 * y0[2]) * bf_lo(gw.y), (w1 * x0[3] + w2 * y0[3]) * bf_hi(gw.y));
        o.z = cvt_pk_bf16((w1 * x1[0] + w2 * y1[0]) * bf_lo(gw.z), (w1 * x1[1] + w2 * y1[1]) * bf_hi(gw.z));
        o.w = cvt_pk_bf16((w1 * x1[2] + w2 * y1[2]) * bf_lo(gw.w), (w1 * x1[3] + w2 * y1[3]) * bf_hi(gw.w));
        *(u32x4*)(mix + tok * DM + h * HD + cg * 8) = o;
    }
}

__device__ __forceinline__ unsigned f2ord(float f) { const unsigned u = __float_as_uint(f); return u ^ ((unsigned)((int)u >> 31) | 0x80000000u); }
__device__ __forceinline__ float ord2f(unsigned k) { const unsigned u = k ^ (~(unsigned)((int)k >> 31) | 0x80000000u); return __uint_as_float(u); }
#define INS16(L, X) do { unsigned x_ = (X); _Pragma("unroll") for (int i_ = 0; i_ < 16; ++i_) { const unsigned hi_ = max(L[i_], x_); x_ = min(L[i_], x_); L[i_] = hi_; } } while (0)
__device__ __forceinline__ void sort16_desc(unsigned (&a)[16]) {
#pragma unroll
    for (int k = 2; k <= 16; k <<= 1)
#pragma unroll
        for (int j = k >> 1; j > 0; j >>= 1)
#pragma unroll
            for (int i = 0; i < 16; ++i) { const int l = i ^ j; if (l > i) { const unsigned hi_ = max(a[i], a[l]), lo_ = min(a[i], a[l]); const bool desc = (i & k) == 0; a[i] = desc ? hi_ : lo_; a[l] = desc ? lo_ : hi_; } }
}
__device__ __forceinline__ void merge_top16(unsigned (&a)[16], const unsigned (&b)[16]) {
#pragma unroll
    for (int i = 0; i < 16; ++i) a[i] = max(a[i], b[15 - i]);
#pragma unroll
    for (int j = 8; j > 0; j >>= 1)
#pragma unroll
        for (int i = 0; i < 16; ++i) { const int l = i ^ j; if (l > i) { const unsigned hi_ = max(a[i], a[l]), lo_ = min(a[i], a[l]); a[i] = hi_; a[l] = lo_; } }
}
__device__ __forceinline__ void topk_half(const bf16_t* qrow  , const bf16_t* skb, int h, int c, int r32, int hi, unsigned (&L)[16]) {
    bf16x8 qf[8];
#pragma unroll
    for (int d0 = 0; d0 < 8; ++d0) qf[d0] = *(const bf16x8*)(qrow + c * 128 + d0 * 16 + hi * 8);
    const unsigned hi4 = 4u * (unsigned)hi;
#pragma unroll
    for (int kt = 0; kt < 4; ++kt) {
        f32x16 acc = f32x16{};
#pragma unroll
        for (int d0 = 0; d0 < 8; ++d0) { const bf16x8 kf = *(const bf16x8*)(skb + (size_t)((h * 2 + c) * 128 + kt * 32 + r32) * 128 + d0 * 16 + hi * 8);
            acc = __builtin_amdgcn_mfma_f32_32x32x16_bf16(kf, qf[d0], acc, 0, 0, 0); }
        __builtin_amdgcn_sched_barrier(0);
        unsigned G[16];
#pragma unroll
        for (int r = 0; r < 16; ++r) { const unsigned cst = (unsigned)(127 - (kt * 32 + (r & 3) + 8 * (r >> 2))); G[r] = (f2ord(acc[r]) & ~127u) | (cst - hi4); }
        sort16_desc(G);
        if (kt == 0) {
#pragma unroll
            for (int i = 0; i < 16; ++i) L[i] = G[i];
        } else merge_top16(L, G);
        __builtin_amdgcn_sched_barrier(0);
    }
    unsigned P[16];
#pragma unroll
    for (int i = 0; i < 16; ++i) { auto rr = __builtin_amdgcn_permlane32_swap(L[i], L[i], false, false); P[i] = hi ? rr[0] : rr[1]; }
    merge_top16(L, P);
}
__device__ __forceinline__ void topk_task(unsigned char* ws, const bf16_t* qrow, LAS int* tb, int t0, int h, int lane) {
    const int r32 = lane & 31, hi = lane >> 5;
    const bf16_t* skb = (const bf16_t*)(ws + WS_SK);
    int* idx_o = (int*)(ws + WS_IDX); float* gw_o = (float*)(ws + WS_GW);
    float rt_l;
    { const f32x4* sp = (const f32x4*)((const float*)(ws + WS_SSQ) + (size_t)(t0 + (lane & 31)) * 32); float tot = 0.f;
#pragma unroll
      for (int i = 0; i < 8; ++i) { const f32x4 v = sp[i]; tot += (v[0] + v[1]) + (v[2] + v[3]); }
      rt_l = 1.0f / sqrtf(tot * (1.f / DM) + EPS); }
        {
          const bf16_t* hbp = (const bf16_t*)(ws + WS_HB); const float* amx = (const float*)(ws + WS_AMX); unsigned char* xq = ws + WS_XQ;
          float am = 0.f;
          { const f32x4* ap = (const f32x4*)(amx + (size_t)(t0 + (lane & 31)) * 32);
#pragma unroll
            for (int i = 0; i < 8; ++i) { const f32x4 v = ap[i]; am = fmaxf(am, fmaxf(fmaxf(v[0], v[1]), fmaxf(v[2], v[3]))); } }
          if (h == 0 && lane < 32) ((float*)(ws + WS_SX))[t0 + lane] = rt_l * am * (1.f / 126.5f);
          const float qs = am > 0.f ? 126.5f / am : 1.f;
          u32x4 wv[16];
#pragma unroll
          for (int j = 0; j < 16; ++j) { const int ch = lane + 64 * j; wv[j] = *(const u32x4*)(hbp + (size_t)(t0 + (ch >> 5)) * DM + h * 256 + (ch & 31) * 8); }
#pragma unroll
          for (int j = 0; j < 16; ++j) { const int ch = lane + 64 * j, tl = ch >> 5, tk = t0 + tl, col = h * 256 + (ch & 31) * 8;
              const u32x4 w = wv[j]; const float r = sh_f(qs, tl);
              const int p0 = pack_i8(bf_lo(w.x) * r, bf_hi(w.x) * r, bf_lo(w.y) * r, bf_hi(w.y) * r), p1 = pack_i8(bf_lo(w.z) * r, bf_hi(w.z) * r, bf_lo(w.w) * r, bf_hi(w.w) * r);
              *(u32x2*)(xq + (size_t)tk * DM + col) = (u32x2){(unsigned)p0, (unsigned)p1}; } }
        unsigned L[2][16];
        topk_half(qrow, skb, h, 0, r32, hi, L[0]);
        __builtin_amdgcn_sched_barrier(0);
        topk_half(qrow, skb, h, 1, r32, hi, L[1]);
        __builtin_amdgcn_sched_barrier(0);
        float s1[16], s2[16]; int i1[16], i2[16];
#pragma unroll
        for (int i = 0; i < 16; ++i) { s1[i] = ord2f((L[0][i] & ~127u) | 64u); i1[i] = 127 - (int)(L[0][i] & 127u); s2[i] = ord2f((L[1][i] & ~127u) | 64u); i2[i] = 127 - (int)(L[1][i] & 127u); }
        unsigned CG[4][16];
#pragma unroll
        for (int i = 0; i < 64; ++i) CG[i >> 4][i & 15] = 0u;
        CG[0][0] = (f2ord(s1[0] + s2[0]) & ~255u) | 0u;
        CG[0][1] = (f2ord(s1[0] + s2[1]) & ~255u) | 1u;
        CG[0][2] = (f2ord(s1[0] + s2[2]) & ~255u) | 2u;
        CG[0][3] = (f2ord(s1[0] + s2[3]) & ~255u) | 3u;
        CG[0][4] = (f2ord(s1[0] + s2[4]) & ~255u) | 4u;
        CG[0][5] = (f2ord(s1[0] + s2[5]) & ~255u) | 5u;
        CG[0][6] = (f2ord(s1[0] + s2[6]) & ~255u) | 6u;
        CG[0][7] = (f2ord(s1[0] + s2[7]) & ~255u) | 7u;
        CG[0][8] = (f2ord(s1[0] + s2[8]) & ~255u) | 8u;
        CG[0][9] = (f2ord(s1[0] + s2[9]) & ~255u) | 9u;
        CG[0][10] = (f2ord(s1[0] + s2[10]) & ~255u) | 10u;
        CG[0][11] = (f2ord(s1[0] + s2[11]) & ~255u) | 11u;
        CG[0][12] = (f2ord(s1[0] + s2[12]) & ~255u) | 12u;
        CG[0][13] = (f2ord(s1[0] + s2[13]) & ~255u) | 13u;
        CG[0][14] = (f2ord(s1[0] + s2[14]) & ~255u) | 14u;
        CG[0][15] = (f2ord(s1[0] + s2[15]) & ~255u) | 15u;
        CG[1][0] = (f2ord(s1[1] + s2[0]) & ~255u) | 16u;
        CG[1][1] = (f2ord(s1[1] + s2[1]) & ~255u) | 17u;
        CG[1][2] = (f2ord(s1[1] + s2[2]) & ~255u) | 18u;
        CG[1][3] = (f2ord(s1[1] + s2[3]) & ~255u) | 19u;
        CG[1][4] = (f2ord(s1[1] + s2[4]) & ~255u) | 20u;
        CG[1][5] = (f2ord(s1[1] + s2[5]) & ~255u) | 21u;
        CG[1][6] = (f2ord(s1[1] + s2[6]) & ~255u) | 22u;
        CG[1][7] = (f2ord(s1[1] + s2[7]) & ~255u) | 23u;
        CG[1][8] = (f2ord(s1[2] + s2[0]) & ~255u) | 32u;
        CG[1][9] = (f2ord(s1[2] + s2[1]) & ~255u) | 33u;
        CG[1][10] = (f2ord(s1[2] + s2[2]) & ~255u) | 34u;
        CG[1][11] = (f2ord(s1[2] + s2[3]) & ~255u) | 35u;
        CG[1][12] = (f2ord(s1[2] + s2[4]) & ~255u) | 36u;
        CG[1][13] = (f2ord(s1[3] + s2[0]) & ~255u) | 48u;
        CG[1][14] = (f2ord(s1[3] + s2[1]) & ~255u) | 49u;
        CG[1][15] = (f2ord(s1[3] + s2[2]) & ~255u) | 50u;
        CG[2][0] = (f2ord(s1[3] + s2[3]) & ~255u) | 51u;
        CG[2][1] = (f2ord(s1[4] + s2[0]) & ~255u) | 64u;
        CG[2][2] = (f2ord(s1[4] + s2[1]) & ~255u) | 65u;
        CG[2][3] = (f2ord(s1[4] + s2[2]) & ~255u) | 66u;
        CG[2][4] = (f2ord(s1[5] + s2[0]) & ~255u) | 80u;
        CG[2][5] = (f2ord(s1[5] + s2[1]) & ~255u) | 81u;
        CG[2][6] = (f2ord(s1[6] + s2[0]) & ~255u) | 96u;
        CG[2][7] = (f2ord(s1[6] + s2[1]) & ~255u) | 97u;
        CG[2][8] = (f2ord(s1[7] + s2[0]) & ~255u) | 112u;
        CG[2][9] = (f2ord(s1[7] + s2[1]) & ~255u) | 113u;
        CG[2][10] = (f2ord(s1[8] + s2[0]) & ~255u) | 128u;
        CG[2][11] = (f2ord(s1[9] + s2[0]) & ~255u) | 144u;
        CG[2][12] = (f2ord(s1[10] + s2[0]) & ~255u) | 160u;
        CG[2][13] = (f2ord(s1[11] + s2[0]) & ~255u) | 176u;
        CG[2][14] = (f2ord(s1[12] + s2[0]) & ~255u) | 192u;
        CG[2][15] = (f2ord(s1[13] + s2[0]) & ~255u) | 208u;
        CG[3][0] = (f2ord(s1[14] + s2[0]) & ~255u) | 224u;
        CG[3][1] = (f2ord(s1[15] + s2[0]) & ~255u) | 240u;
        sort16_desc(CG[0]); sort16_desc(CG[1]); sort16_desc(CG[2]); sort16_desc(CG[3]);
        merge_top16(CG[0], CG[1]); merge_top16(CG[2], CG[3]); merge_top16(CG[0], CG[2]);
        unsigned LC[16];
#pragma unroll
        for (int i = 0; i < 16; ++i) LC[i] = CG[0][i];
#pragma unroll
        for (int i = 0; i < 16; ++i) { tb[i * 64 + lane] = i1[i]; tb[(16 + i) * 64 + lane] = i2[i]; }
        float LS[16]; int LP[16];
#pragma unroll
        for (int i = 0; i < 16; ++i) { const unsigned cid = LC[i] & 255u; LS[i] = ord2f((LC[i] & ~255u) | 128u);
            LP[i] = tb[(cid >> 4) * 64 + lane] * 128 + tb[(16 + (cid & 15u)) * 64 + lane]; }
        float den = 0.f, e[16];
#pragma unroll
        for (int i = 0; i < 16; ++i) { e[i] = __expf(LS[i] - LS[0]); den += e[i]; }
        const float rden = 1.f / den;
        const size_t ob = (size_t)(t0 + r32) * NE + h * 16;
        if (hi == 0) {
#pragma unroll
            for (int i = 0; i < 4; ++i) *(int4*)(idx_o + ob + 4 * i) = make_int4(LP[4 * i], LP[4 * i + 1], LP[4 * i + 2], LP[4 * i + 3]);
        } else {
#pragma unroll
            for (int i = 0; i < 4; ++i) *(f32x4*)(gw_o + ob + 4 * i) = (f32x4){e[4 * i] * rden, e[4 * i + 1] * rden, e[4 * i + 2] * rden, e[4 * i + 3] * rden};
        }
}
__device__ __forceinline__ void phase_topk(const Args& a, unsigned char* lds_g) {
    LAS unsigned char* lds = (LAS unsigned char*)lds_g;
    const int tid = tid_opaque(), lane = tid & 63, wave = tid >> 6;
    const int gw = blockIdx.x * NWAVES + wave, NGW = gridDim.x * NWAVES;
    const bf16_t* qp = (const bf16_t*)(a.ws + WS_QP);
    for (int task = gw; task < (T / 32) * 8; task += NGW) {
        const int h = task & 7, t0 = (task >> 3) * 32;
        topk_task(a.ws, qp + (size_t)(t0 + (lane & 31)) * DM + h * 256, (LAS int*)(lds + wave * 8192), t0, h, lane);
    }
}
__device__ __forceinline__ void pg8::EpiPeerQFused::fused(const f32x4 (&acc)[2][2][4][2], const Unit& u, int wr, int wc, int fr, int fq, PG8_LAS unsigned char* lds) const {
    constexpr int ROWB = 528;
#pragma unroll
    for (int ai = 0; ai < 2; ++ai)
#pragma unroll
        for (int m = 0; m < 4; ++m) {
            const int tr = ai * HALF + wr * 64 + m * 16 + fr, tk = u.pm * BM + tr;
            float tot = 0.f;
#pragma unroll
            for (int i = 0; i < 8; ++i) { const f32x4 s4 = *(const f32x4*)(ssq + (size_t)tk * 32 + 4 * i); tot += (s4[0] + s4[1]) + (s4[2] + s4[3]); }
            const float r = 1.0f / sqrtf(tot * (1.f / DM) + EPS);
#pragma unroll
            for (int bj = 0; bj < 2; ++bj) {
                const f32x4 v0 = acc[ai][bj][m][0] * r, v1 = acc[ai][bj][m][1] * r;
                u32x4 w; w.x = cvt_pk_bf16(v0[0], v0[1]); w.y = cvt_pk_bf16(v0[2], v0[3]); w.z = cvt_pk_bf16(v1[0], v1[1]); w.w = cvt_pk_bf16(v1[2], v1[3]);
                *(PG8_LAS u32x4*)(lds + tr * ROWB + (bj * HALF + wc * 32 + 8 * fq) * 2) = w;
            }
        }
    __syncthreads();
    const int tid = tid_opaque(), lane = tid & 63, wave = tid >> 6;
    PG8_LAS unsigned char* myrows = lds + (wave * 32) * ROWB;
    topk_task(wsb, (const bf16_t*)(const void*)(myrows + (lane & 31) * ROWB), (LAS int*)myrows, u.pm * BM + wave * 32, u.pn, lane);
}
__device__ __forceinline__ void wave_argmax(float& v, int& i) {
#pragma unroll
    for (int o = 1; o < 64; o <<= 1) { const float ov = sx_f(v, o); const int oi = sx_i(i, o); if (ov > v || (ov == v && oi < i)) { v = ov; i = oi; } }
}
__device__ __forceinline__ void phase_topk_ref(const Args& a) {
    const int tid = tid_opaque(), lane = tid & 63, wave = tid >> 6;
    const int gw = blockIdx.x * NWAVES + wave, NGW = gridDim.x * NWAVES;
    const bf16_t* skb = (const bf16_t*)(a.ws + WS_SK); const bf16_t* qp = (const bf16_t*)(a.ws + WS_QP);
    int* idx_o = (int*)(a.ws + WS_IDX); float* gw_o = (float*)(a.ws + WS_GW);
    for (int task = gw; task < T * 8; task += NGW) {
        const int t = task >> 3, h = task & 7;
        float topS[2]; int topI[2];
        for (int c = 0; c < 2; ++c) {
            const bf16_t* q = qp + (size_t)t * DM + h * 256 + c * 128;
            float sc0 = 0.f, sc1 = 0.f;
            const bf16_t* k0 = skb + (size_t)((h * 2 + c) * 128 + lane) * 128; const bf16_t* k1 = k0 + 64 * 128;
            for (int d = 0; d < 128; ++d) { const float qd = __uint_as_float((unsigned)q[d] << 16);
                sc0 += qd * __uint_as_float((unsigned)k0[d] << 16); sc1 += qd * __uint_as_float((unsigned)k1[d] << 16); }
            float ms = 0.f; int mi = 0;
            for (int r = 0; r < 16; ++r) {
                float v; int i; if (sc0 >= sc1) { v = sc0; i = lane; } else { v = sc1; i = lane + 64; }
                wave_argmax(v, i);
                if (lane == r) { ms = v; mi = i; }
                if (i == lane) sc0 = -__builtin_inff();
                if (i == lane + 64) sc1 = -__builtin_inff();
            }
            topS[c] = ms; topI[c] = mi;
        }
        float cs[4]; int ci[4];
#pragma unroll
        for (int j = 0; j < 4; ++j) { const int cidx = lane * 4 + j, aa = cidx >> 4, bb = cidx & 15;
            cs[j] = sh_f(topS[0], aa) + sh_f(topS[1], bb); ci[j] = cidx; }
        float fs = 0.f; int fi = 0;
        for (int r = 0; r < 16; ++r) {
            float v = cs[0]; int i = ci[0];
#pragma unroll
            for (int j = 1; j < 4; ++j) if (cs[j] > v) { v = cs[j]; i = ci[j]; }
            wave_argmax(v, i);
            if (lane == r) { fs = v; fi = i; }
#pragma unroll
            for (int j = 0; j < 4; ++j) if (ci[j] == i) cs[j] = -__builtin_inff();
        }
        const int e1 = sh_i(topI[0], fi >> 4), e2 = sh_i(topI[1], fi & 15);
        const float mx = sh_f(fs, 0);
        float ev = lane < 16 ? __expf(fs - mx) : 0.f;
        const float den = wave_sum(ev);
        if (lane < 16) { idx_o[(size_t)t * NE + h * 16 + lane] = e1 * 128 + e2; gw_o[(size_t)t * NE + h * 16 + lane] = ev / den; }
    }
}

__device__ __forceinline__ void fp8x16_to_f32(const u32x4 q, f32x2 (&o)[8]) {
    o[0] = __builtin_amdgcn_cvt_pk_f32_fp8((int)q.x, false); o[1] = __builtin_amdgcn_cvt_pk_f32_fp8((int)q.x, true);
    o[2] = __builtin_amdgcn_cvt_pk_f32_fp8((int)q.y, false); o[3] = __builtin_amdgcn_cvt_pk_f32_fp8((int)q.y, true);
    o[4] = __builtin_amdgcn_cvt_pk_f32_fp8((int)q.z, false); o[5] = __builtin_amdgcn_cvt_pk_f32_fp8((int)q.z, true);
    o[6] = __builtin_amdgcn_cvt_pk_f32_fp8((int)q.w, false); o[7] = __builtin_amdgcn_cvt_pk_f32_fp8((int)q.w, true);
}
#define HALVE(dst, srcv, n, bitmask) do { const bool up_ = (lane & (bitmask)) != 0; _Pragma("unroll") for (int i_ = 0; i_ < (n); ++i_) { \
        const float keep_ = up_ ? srcv[(n) + i_] : srcv[i_], send_ = up_ ? srcv[i_] : srcv[(n) + i_]; dst[i_] = keep_ + sx_f(send_, (bitmask)); } } while (0)
#define ITEM_T(n) (wv + ((n) % KT) * NWX)
#define ITEM_S(n) (xl + 8 * ((n) / KT))
#define LD_IDX(ID, n) do { const int4* ip_ = (const int4*)(idx_i + (size_t)ITEM_T(n) * NE + g * 16); _Pragma("unroll") for (int i_ = 0; i_ < 4; ++i_) ID[i_] = ip_[i_]; } while (0)
#define LD_ROWS(Q, ID, TAB, n) do { const unsigned char* b_ = (TAB) + (size_t)ITEM_S(n) * ((size_t)NEXP * 128) + c * 16; _Pragma("unroll") for (int i_ = 0; i_ < 4; ++i_) { \
        Q[4 * i_] = *(const u32x4*)(b_ + (size_t)ID[i_].x * 128); Q[4 * i_ + 1] = *(const u32x4*)(b_ + (size_t)ID[i_].y * 128); \
        Q[4 * i_ + 2] = *(const u32x4*)(b_ + (size_t)ID[i_].z * 128); Q[4 * i_ + 3] = *(const u32x4*)(b_ + (size_t)ID[i_].w * 128); } } while (0)
__device__ __forceinline__ int dpp_hmirror(int v) { return __builtin_amdgcn_update_dpp(0, v, 0x141, 0xf, 0xf, true); }
__device__ __forceinline__ int dpp_qxor2(int v) { return __builtin_amdgcn_update_dpp(0, v, 0x4E, 0xf, 0xf, true); }
__device__ __forceinline__ int dpp_qxor1(int v) { return __builtin_amdgcn_update_dpp(0, v, 0xB1, 0xf, 0xf, true); }
__device__ __forceinline__ void phase_peer_u(const Args& a) {
    const int tid = tid_opaque(), lane = tid & 63, wave = tid >> 6, g = lane >> 3, c = lane & 7;
    const int xl = blockIdx.x & 7, wv = (blockIdx.x >> 3) * NWAVES + wave, NWX = (gridDim.x >> 3) * NWAVES, KT = T / NWX, N = 2 * KT;
    const unsigned char* xq = a.ws + WS_XQ; const unsigned char* u8 = a.ws + WS_U8;
    const int* idx_i = (const int*)(a.ws + WS_IDX); bf16_t* part = (bf16_t*)(a.ws + WS_PART);
    const bool up4 = (c & 4) != 0, up2 = (c & 2) != 0, up1 = (c & 1) != 0;
#define LD_X(X, n) do { X = *(const u32x4*)(xq + (size_t)ITEM_T(n) * DM + ITEM_S(n) * 128 + c * 16); } while (0)
#define COMPUTE_U(Q, X, n) do { int p[16]; \
        _Pragma("unroll") for (int i = 0; i < 16; ++i) { int d_ = __builtin_amdgcn_sdot4((int)Q[i].x, (int)X.x, 0, false); d_ = __builtin_amdgcn_sdot4((int)Q[i].y, (int)X.y, d_, false); \
            d_ = __builtin_amdgcn_sdot4((int)Q[i].z, (int)X.z, d_, false); p[i] = __builtin_amdgcn_sdot4((int)Q[i].w, (int)X.w, d_, false); } \
        int p8[8], p4[4], p2[2]; \
        _Pragma("unroll") for (int i = 0; i < 8; ++i) { const int keep_ = up4 ? p[8 + i] : p[i], send_ = up4 ? p[i] : p[8 + i]; p8[i] = keep_ + dpp_hmirror(send_); } \
        _Pragma("unroll") for (int i = 0; i < 4; ++i) { const int keep_ = up2 ? p8[4 + i] : p8[i], send_ = up2 ? p8[i] : p8[4 + i]; p4[i] = keep_ + dpp_qxor2(send_); } \
        _Pragma("unroll") for (int i = 0; i < 2; ++i) { const int keep_ = up1 ? p4[2 + i] : p4[i], send_ = up1 ? p4[i] : p4[2 + i]; p2[i] = keep_ + dpp_qxor1(send_); } \
        *(unsigned*)(part + ((size_t)ITEM_T(n) * 16 + ITEM_S(n)) * NE + 2 * lane) = cvt_pk_bf16((float)p2[0], (float)p2[1]); } while (0)
    int4 IA[4], IB[4]; u32x4 QA[16], QB[16], XA, XB;
    LD_IDX(IA, 0); LD_IDX(IB, 1);
    LD_ROWS(QA, IA, u8, 0); LD_X(XA, 0);
    for (int n = 0; n < N; n += 2) {
        LD_ROWS(QB, IB, u8, n + 1); LD_X(XB, n + 1);
        if (n + 2 < N) LD_IDX(IA, n + 2);
        COMPUTE_U(QA, XA, n);
        if (n + 2 < N) { LD_ROWS(QA, IA, u8, n + 2); LD_X(XA, n + 2); }
        if (n + 3 < N) LD_IDX(IB, n + 3);
        COMPUTE_U(QB, XB, n + 1);
    }
#undef LD_X
#undef COMPUTE_U
}
__device__ __forceinline__ void phase_peer_w(const Args& a) {
    const int gt = blockIdx.x * NTHREADS + tid_opaque(), NGT = gridDim.x * NTHREADS;
    const int* idx_i = (const int*)(a.ws + WS_IDX); const float* gw_i = (const float*)(a.ws + WS_GW); const bf16_t* part = (const bf16_t*)(a.ws + WS_PART);
    const float* suv = (const float*)(a.ws + WS_SUV); const float* sx = (const float*)(a.ws + WS_SX);
    signed char* wq = (signed char*)(a.ws + WS_WQ); float* sw = (float*)(a.ws + WS_SW);
    for (int item = gt; item < T * NE; item += NGT) {
        const int t = item >> 7, e = item & 127;
        float sum = 0.f;
#pragma unroll
        for (int s = 0; s < 16; ++s) sum += __uint_as_float((unsigned)part[((size_t)t * 16 + s) * NE + e] << 16);
        const int ex = idx_i[item];
        const float d = sum * suv[ex] * sx[t];
        const float om = 0.5f * d * (1.f + erff(d * 0.70710678118654752f)) * gw_i[item] * suv[NEXP + ex];
        float mx = fabsf(om);
        mx = fmaxf(mx, sx_f(mx, 1)); mx = fmaxf(mx, sx_f(mx, 2)); mx = fmaxf(mx, sx_f(mx, 4)); mx = fmaxf(mx, sx_f(mx, 8));
        const float qs = mx > 0.f ? 127.f / mx : 1.f;
        wq[item] = (signed char)(int)__builtin_rintf(om * qs);
        if ((e & 15) == 0) sw[t * 8 + (e >> 4)] = mx * (1.f / 127.f);
    }
}
__device__ __forceinline__ void phase_peer_v(const Args& a, float* dst) {
    const int tid = tid_opaque(), lane = tid & 63, wave = tid >> 6, g = lane >> 3, c = lane & 7;
    const int xl = blockIdx.x & 7, wv = (blockIdx.x >> 3) * NWAVES + wave, NWX = (gridDim.x >> 3) * NWAVES, KT = T / NWX, N = 2 * KT;
    const unsigned char* v8 = a.ws + WS_V8;
    const int* idx_i = (const int*)(a.ws + WS_IDX); const unsigned char* wq = a.ws + WS_WQ; const float* sw = (const float*)(a.ws + WS_SW);
    const bf16_t* hsrc = (const bf16_t*)(a.ws + WS_HB);
#define LD_W(W, SWV, n) do { W = *(const u32x4*)(wq + (size_t)ITEM_T(n) * NE + g * 16); SWV = sw[ITEM_T(n) * 8 + g]; } while (0)
#define QUAD(A_, B_, C_, D_, W_, A0, A1, A2, A3) do { \
        const unsigned ablo_ = __builtin_amdgcn_perm(B_, A_, 0x05010400u), abhi_ = __builtin_amdgcn_perm(B_, A_, 0x07030602u); \
        const unsigned cdlo_ = __builtin_amdgcn_perm(D_, C_, 0x05010400u), cdhi_ = __builtin_amdgcn_perm(D_, C_, 0x07030602u); \
        A0 = __builtin_amdgcn_sdot4((int)__builtin_amdgcn_perm(cdlo_, ablo_, 0x05040100u), (int)(W_), A0, false); \
        A1 = __builtin_amdgcn_sdot4((int)__builtin_amdgcn_perm(cdlo_, ablo_, 0x07060302u), (int)(W_), A1, false); \
        A2 = __builtin_amdgcn_sdot4((int)__builtin_amdgcn_perm(cdhi_, abhi_, 0x05040100u), (int)(W_), A2, false); \
        A3 = __builtin_amdgcn_sdot4((int)__builtin_amdgcn_perm(cdhi_, abhi_, 0x07060302u), (int)(W_), A3, false); } while (0)
#define COMPUTE_V(Q, W, SWV, n) do { int ac[16]; _Pragma("unroll") for (int k = 0; k < 16; ++k) ac[k] = 0; \
        _Pragma("unroll") for (int q_ = 0; q_ < 4; ++q_) { const unsigned w_ = q_ == 0 ? W.x : q_ == 1 ? W.y : q_ == 2 ? W.z : W.w; \
            QUAD(Q[4 * q_].x, Q[4 * q_ + 1].x, Q[4 * q_ + 2].x, Q[4 * q_ + 3].x, w_, ac[0], ac[1], ac[2], ac[3]); \
            QUAD(Q[4 * q_].y, Q[4 * q_ + 1].y, Q[4 * q_ + 2].y, Q[4 * q_ + 3].y, w_, ac[4], ac[5], ac[6], ac[7]); \
            QUAD(Q[4 * q_].z, Q[4 * q_ + 1].z, Q[4 * q_ + 2].z, Q[4 * q_ + 3].z, w_, ac[8], ac[9], ac[10], ac[11]); \
            QUAD(Q[4 * q_].w, Q[4 * q_ + 1].w, Q[4 * q_ + 2].w, Q[4 * q_ + 3].w, w_, ac[12], ac[13], ac[14], ac[15]); } \
        float p[16]; _Pragma("unroll") for (int k = 0; k < 16; ++k) p[k] = (float)ac[k] * SWV; \
        float p8[8], p4[4], p2[2]; \
        _Pragma("unroll") for (int i_ = 0; i_ < 8; ++i_) { auto rr_ = __builtin_amdgcn_permlane32_swap(__float_as_uint(p[i_]), __float_as_uint(p[8 + i_]), false, false); p8[i_] = __uint_as_float(rr_[0]) + __uint_as_float(rr_[1]); } \
        _Pragma("unroll") for (int i_ = 0; i_ < 4; ++i_) { auto rr_ = __builtin_amdgcn_permlane16_swap(__float_as_uint(p8[i_]), __float_as_uint(p8[4 + i_]), false, false); p4[i_] = __uint_as_float(rr_[0]) + __uint_as_float(rr_[1]); } \
        HALVE(p2, p4, 2, 8); \
        const size_t o_ = (size_t)ITEM_T(n) * DM + ITEM_S(n) * 128 + c * 16 + 2 * g; \
        const unsigned hv = *(const unsigned*)(hsrc + o_); *(f32x2*)(dst + o_) = (f32x2){bf_lo(hv) + p2[0], bf_hi(hv) + p2[1]}; } while (0)
    int4 IA[4], IB[4]; u32x4 QA[16], QB[16], WA, WB; float SA, SB_;
    LD_IDX(IA, 0); LD_IDX(IB, 1);
    LD_ROWS(QA, IA, v8, 0); LD_W(WA, SA, 0);
    for (int n = 0; n < N; n += 2) {
        LD_ROWS(QB, IB, v8, n + 1); LD_W(WB, SB_, n + 1);
        if (n + 2 < N) LD_IDX(IA, n + 2);
        COMPUTE_V(QA, WA, SA, n);
        if (n + 2 < N) { LD_ROWS(QA, IA, v8, n + 2); LD_W(WA, SA, n + 2); }
        if (n + 3 < N) LD_IDX(IB, n + 3);
        COMPUTE_V(QB, WB, SB_, n + 1);
    }
#undef LD_W
#undef QUAD
#undef COMPUTE_V
}
#undef ITEM_T
#undef ITEM_S
#undef LD_IDX
#undef LD_ROWS
#undef HALVE


constexpr int NPHASE = 11;
#define LOAD_ARGS() do { } while (0)
__global__ void __launch_bounds__(NTHREADS, 2) fwd_kernel(Args a) {
    extern __shared__ __attribute__((aligned(16))) unsigned char lds[];
#if MK_ONE_LAUNCH
    constexpr int lo = 0, hi = NPHASE;
    cg::grid_group grid = cg::this_grid();
    volatile LAS unsigned* misc = (volatile LAS unsigned*)((LAS unsigned char*)lds + MISC_OFF);
    if (threadIdx.x < 16) misc[threadIdx.x] = 0u;
    __syncthreads();
    { LOAD_ARGS(); (void)xcd_barrier_post((unsigned*)(a.ws + WS_CTL) + CW_BAR, misc + 8); }
#ifndef SEAM_CG_MASK
#define SEAM_CG_MASK 0
#endif
#define SEAM(k) do { if (lo <= (k) && (k) + 1 < hi) { if ((SEAM_CG_MASK >> (k)) & 1) grid.sync(); else { LOAD_ARGS(); XcdBarrier xb_; xb_.bar = (unsigned*)(a.ws + WS_CTL) + CW_BAR; xb_.x = xb_xcc_id(); \
        xb_.st = (volatile LAS unsigned*)((LAS unsigned char*)lds + MISC_OFF) + 8; xcd_barrier(xb_); } } } while (0)
#else
    int lo, hi; { LOAD_ARGS(); lo = a.ph_lo; hi = a.ph_hi; }
#define SEAM(k) do { } while (0)
#endif
#define IN(k) (lo <= (k) && (k) < hi)
#ifndef DUP_PHASE
#define DUP_PHASE -1
#endif
    if (IN(0)) { LOAD_ARGS(); phase0(a, lds); if (DUP_PHASE == 0) { __syncthreads(); phase0(a, lds); } SEAM(0); }
    if (IN(1)) { LOAD_ARGS(); unsigned char* ws = a.ws;
        cumsum_rows(a);
        pg8::Gemm g{(const bf16_t*)(ws + WS_XN), (const bf16_t*)(ws + WS_WIN), T, NPROJ, DM}; pg8::StaticOrder S; S.init(T, NPROJ, (int)gridDim.x, (int)blockIdx.x);
        pg8::EpiInProj E{(bf16_t*)(ws + WS_SEC), (const float*)(ws + WS_SXN), (const float*)(ws + WS_WSC), a.in[4], a.in[5], (LAS float*)((LAS unsigned char*)lds + RING_BYTES)};
        for (int rep_ = 0; rep_ < (DUP_PHASE == 1 ? 2 : 1); ++rep_)
        pg8::gemm_phase<pg8::EpiInProj, pg8::StaticOrder, true, true, true>((LAS unsigned char*)lds, g, S, E);
        { const int nwg_ = (T / 256) * (NPROJ / 256), G_ = (int)gridDim.x, rem_ = nwg_ % G_;
          if (rem_ > 0 && (int)blockIdx.x >= rem_) convert_tables(a, TAB_SPLIT, 2 * NEXP, ((int)blockIdx.x - rem_) * NWAVES + (tid_opaque() >> 6), (G_ - rem_) * NWAVES);
          else if (rem_ == 0) convert_tables(a, TAB_SPLIT, 2 * NEXP, (int)blockIdx.x * NWAVES + (tid_opaque() >> 6), G_ * NWAVES); }
        SEAM(1);
    }
    if (IN(3)) { LOAD_ARGS(); phase_attn(a, lds);
#if MK_ONE_LAUNCH
        if (DUP_PHASE == 3) { XcdBarrier xb_; xb_.bar = (unsigned*)(a.ws + WS_CTL) + CW_BAR; xb_.x = xb_xcc_id(); xb_.st = (volatile LAS unsigned*)((LAS unsigned char*)lds + MISC_OFF) + 8;
            xcd_barrier(xb_); if (blockIdx.x == 0 && threadIdx.x == 0) __hip_atomic_store((unsigned*)(a.ws + WS_CTL), 0u, __ATOMIC_RELAXED, __HIP_MEMORY_SCOPE_AGENT); xcd_barrier(xb_); phase_attn(a, lds); }
#endif
        SEAM(3); }
    if (IN(4)) { LOAD_ARGS(); phase_attn_combine(a); SEAM(4); }
    if (IN(5)) { LOAD_ARGS(); unsigned char* ws = a.ws;
        pg8::Gemm g{(const bf16_t*)(ws + WS_MIX), (const bf16_t*)(ws + WS_WOUT), T, DM, DM}; pg8::StaticOrder S; S.init(T, DM, (int)gridDim.x, (int)blockIdx.x);
        pg8::EpiOutProj E{a.in[0], a.out, (bf16_t*)(ws + WS_HB), (float*)(ws + WS_SSQ), (float*)(ws + WS_AMX)};
        for (int rep_ = 0; rep_ < (DUP_PHASE == 5 ? 2 : 1); ++rep_)
        pg8::gemm_phase<pg8::EpiOutProj, pg8::StaticOrder, true, true>((LAS unsigned char*)lds, g, S, E);
        SEAM(5);
    }
    if (IN(6)) { LOAD_ARGS(); unsigned char* ws = a.ws;
        pg8::Gemm g{(const bf16_t*)(ws + WS_HB), (const bf16_t*)(ws + WS_WPQ), T, DM, DM}; pg8::StaticOrder S; S.init(T, DM, (int)gridDim.x, (int)blockIdx.x);
        pg8::EpiPeerQFused E{(const float*)(ws + WS_SSQ), ws};
        pg8::gemm_phase<pg8::EpiPeerQFused, pg8::StaticOrder, true, true>((LAS unsigned char*)lds, g, S, E);
        SEAM(6);
    }
    if (IN(8)) { LOAD_ARGS(); for (int rep_ = 0; rep_ < (DUP_PHASE == 8 ? 2 : 1); ++rep_) phase_peer_u(a); SEAM(8); }
    if (IN(9)) { LOAD_ARGS(); for (int rep_ = 0; rep_ < (DUP_PHASE == 9 ? 2 : 1); ++rep_) phase_peer_w(a); SEAM(9); }
    if (IN(10)) { LOAD_ARGS(); for (int rep_ = 0; rep_ < (DUP_PHASE == 10 ? 2 : 1); ++rep_) phase_peer_v(a, (DUP_PHASE == 10 && rep_ == 0) ? (float*)(a.ws + WS_END) : a.out); }
#undef IN
#undef SEAM
}

extern "C" void kernel_launch(void* const* d_in, const int* in_sizes, int n_in, void* d_out, int out_size, void* d_ws, size_t ws_size, hipStream_t stream) {
    static int grid = 0;
    if (grid == 0) {
        if (n_in != 12 || in_sizes[0] != T * DM || out_size != T * DM || ws_size < WS_END) { fprintf(stderr, "kernel_launch: unexpected shapes (n_in %d, in0 %d, out %d, ws %zu)\n", n_in, n_in > 0 ? in_sizes[0] : -1, out_size, ws_size); grid = -1; return; }
        int dev = 0, cus = 0, per_cu = 0;
        if (hipGetDevice(&dev) != hipSuccess || hipDeviceGetAttribute(&cus, hipDeviceAttributeMultiprocessorCount, dev) != hipSuccess) { grid = -1; return; }
        if (hipFuncSetAttribute((const void*)fwd_kernel, hipFuncAttributeMaxDynamicSharedMemorySize, LDS_BYTES) != hipSuccess) { fprintf(stderr, "kernel_launch: hipFuncSetAttribute failed\n"); grid = -1; return; }
        if (hipOccupancyMaxActiveBlocksPerMultiprocessor(&per_cu, (const void*)fwd_kernel, NTHREADS, LDS_BYTES) != hipSuccess || per_cu < 1) { fprintf(stderr, "kernel_launch: occupancy query says %d\n", per_cu); grid = -1; return; }
        grid = cus;
    }
    if (grid < 0) return;
    (void)hipMemsetAsync((char*)d_ws + WS_CTL, 0, CTL_BYTES, stream);
    Args a{};
    for (int i = 0; i < 12; ++i) a.in[i] = (const float*)d_in[i];
    a.out = (float*)d_out; a.ws = (unsigned char*)d_ws;
#if MK_ONE_LAUNCH
    a.ph_lo = 0; a.ph_hi = NPHASE;
    void* args[] = {&a};
#if MK_COOP_LAUNCH
    hipError_t e = hipLaunchCooperativeKernel((const void*)fwd_kernel, dim3(grid), dim3(NTHREADS), args, LDS_BYTES, stream);
    if (e != hipSuccess) fprintf(stderr, "cooperative launch failed: %s (grid %d)\n", hipGetErrorString(e), grid);
#else
    (void)args; hipLaunchKernelGGL(fwd_kernel, dim3(grid), dim3(NTHREADS), LDS_BYTES, stream, a);
#endif
#else
    for (int p = 0; p < NPHASE; ++p) { a.ph_lo = p; a.ph_hi = p + 1; hipLaunchKernelGGL(fwd_kernel, dim3(grid), dim3(NTHREADS), LDS_BYTES, stream, a); }
#endif
}
```

```cpp
#include <hip/hip_runtime.h>
#include <hip/hip_cooperative_groups.h>
#include <cstdio>
#include <cstdint>
namespace cg = cooperative_groups;

#ifndef MK_COOP_LAUNCH
#define MK_COOP_LAUNCH 0
#endif
#ifndef MK_ONE_LAUNCH
#define MK_ONE_LAUNCH 1
#endif

#define LAS __attribute__((address_space(3)))
typedef unsigned short bf16_t;
typedef short bf16x8 __attribute__((ext_vector_type(8)));
typedef short s16x4 __attribute__((ext_vector_type(4)));
typedef float f32x2 __attribute__((ext_vector_type(2)));
typedef float f32x4 __attribute__((ext_vector_type(4)));
typedef float f32x16 __attribute__((ext_vector_type(16)));
typedef unsigned u32x2 __attribute__((ext_vector_type(2)));
typedef unsigned u32x4 __attribute__((ext_vector_type(4)));
typedef __bf16 bf16x2_t __attribute__((ext_vector_type(2)));

constexpr int NB = 2, SEQ = 4096, T = NB * SEQ, DM = 2048, HD = 128, NHF = 8, DIN = 7176, NPROJ = 7168;
constexpr int NEXP = 16384, NE = 128;
constexpr float EPS = 1e-6f;
constexpr float SCALE = 0.08838834764831845f, LOG2E = 1.4426950408889634f;
constexpr int NWAVES = 8, NTHREADS = 512;

constexpr size_t MiB = 1u << 20;
constexpr size_t WS_CTL = 0, CTL_BYTES = 32768;
constexpr int CW_BAR = 1024;
constexpr size_t WS_SXN = 64 * MiB  , WS_WSC = 45 * MiB + 800 * 1024  ;
constexpr int CW_WMAX = 64;
constexpr size_t WS_GQK = 45 * MiB + 768 * 1024;
constexpr size_t WS_WIN = 1 * MiB, WS_WOUT = 29 * MiB, WS_WPQ = 37 * MiB, WS_SK = 45 * MiB, WS_LOGF = 46 * MiB, WS_C = 46 * MiB + 512 * 1024, WS_SSQ = 47 * MiB;
constexpr size_t WS_XN = 48 * MiB;
constexpr size_t WS_SEC = 80 * MiB;
constexpr size_t SEC_ELEMS = 8u << 20;
constexpr size_t WS_MIX = 192 * MiB, WS_HB = 224 * MiB, WS_QP = 256 * MiB, WS_IDX = 288 * MiB, WS_GW = 292 * MiB, WS_U8 = 296 * MiB, WS_V8 = 328 * MiB, WS_SUV = 360 * MiB  , WS_RT = 360 * MiB + 256 * 1024  , WS_W = 361 * MiB  ,
                 WS_PART = 368 * MiB  , WS_XQ = 432 * MiB  , WS_END = 448 * MiB;
constexpr size_t WS_AMX = 365 * MiB  , WS_SX = WS_RT + 64 * 1024  , WS_WQ = WS_W  , WS_SW = WS_W + 2 * MiB  ;
constexpr size_t WS_PO = WS_PART  , WS_PML = WS_PART + 32 * MiB  ;

constexpr int RING_BYTES = 131072;
constexpr int MISC_OFF = 143360;
constexpr int LDS_BYTES = 147456;

__device__ __forceinline__ unsigned cvt_pk_bf16(float lo, float hi) { unsigned r; asm volatile("v_cvt_pk_bf16_f32 %0, %1, %2" : "=v"(r) : "v"(lo), "v"(hi)); return r; }
__device__ __forceinline__ float bf_lo(unsigned u) { return __builtin_bit_cast(float, u << 16); }
__device__ __forceinline__ float bf_hi(unsigned u) { return __builtin_bit_cast(float, u & 0xffff0000u); }
__device__ __forceinline__ int lane_id_fresh() { int l = (int)__builtin_amdgcn_mbcnt_hi(~0u, __builtin_amdgcn_mbcnt_lo(~0u, 0u)); asm volatile("" : "+v"(l)); return l; }
__device__ __forceinline__ int sx_i(int v, int m) { return __builtin_amdgcn_ds_bpermute((lane_id_fresh() ^ m) << 2, v); }
__device__ __forceinline__ float sx_f(float v, int m) { return __int_as_float(__builtin_amdgcn_ds_bpermute((lane_id_fresh() ^ m) << 2, __float_as_int(v))); }
__device__ __forceinline__ int sh_i(int v, int src) { return __builtin_amdgcn_ds_bpermute(src << 2, v); }
__device__ __forceinline__ float sh_f(float v, int src) { return __int_as_float(__builtin_amdgcn_ds_bpermute(src << 2, __float_as_int(v))); }
__device__ __forceinline__ float shup_f(float v, int d) { const int l = lane_id_fresh(); const int s = l - d; return __int_as_float(__builtin_amdgcn_ds_bpermute((s < 0 ? l : s) << 2, __float_as_int(v))); }
__device__ __forceinline__ float wave_sum(float v) {
#pragma unroll
    for (int o = 1; o < 64; o <<= 1) v += sx_f(v, o);
    return v;
}
__device__ __forceinline__ float wave_max(float v) {
#pragma unroll
    for (int o = 1; o < 64; o <<= 1) v = fmaxf(v, sx_f(v, o));
    return v;
}
__device__ __forceinline__ int tid_opaque() { int t = (int)threadIdx.x; asm volatile("" : "+v"(t)); return t; }
#define LDS_WAIT() asm volatile("s_waitcnt lgkmcnt(0)" ::: "memory")

namespace pg8 {
#define PG8_LAS __attribute__((address_space(3)))
constexpr int BM = 256, BK = 64, HALF = 128, HTB = HALF * BK * 2, STAGE_BYTES = 8 * HTB, NXCD = 8, WGM = 8;
__host__ __device__ __forceinline__ int lds_byte(int r, int c) { const int st = (r >> 4) * 2 + (c >> 5), rr = r & 15, cc = c & 31, ob = rr * 64 + cc * 2; return st * 1024 + (ob ^ (((ob >> 9) & 1) << 5)); }
__host__ __device__ __forceinline__ void stage_rc(int b, int& R, int& C) { const int st = b / 1024, sb = b % 1024, swz = sb ^ (((sb >> 9) & 1) << 5); R = (st >> 1) * 16 + swz / 64; C = (st & 1) * 32 + (swz % 64) / 2; }
__host__ __device__ __forceinline__ int perm32(int rho) { const int n = rho >> 4, i = rho & 15; return 8 * (i >> 2) + 4 * n + (i & 3); }
struct Unit { int pm, pn; };
struct Gemm { const bf16_t* A; const bf16_t* Bt; int M, N, K; };
struct StaticOrder {
    int nM, nN, nwg, G, c;
    __host__ __device__ void init(int M, int N, int G_, int c_) { nM = M / BM; nN = N / BM; nwg = nM * nN; G = G_; c = c_; }
    __host__ __device__ bool next(int i, Unit& u) const {
        const long L = (long)i * G + c; if (L >= nwg) return false;
        int wgid = (int)L; { const int q = nwg / NXCD, r = nwg % NXCD, xcd = wgid % NXCD, off = wgid / NXCD; wgid = (xcd < r ? xcd * (q + 1) : r * (q + 1) + (xcd - r) * q) + off; }
        const int nig = WGM * nN, gid = wgid / nig, fm = gid * WGM, gsz = (nM - fm) < WGM ? (nM - fm) : WGM;
        u.pm = fm + ((wgid % nig) % gsz); u.pn = (wgid % nig) / gsz; return true;
    }
    __device__ __forceinline__ void a_ready(const Unit&) const {}
    __device__ __forceinline__ void done(const Unit&) const {}
};

typedef int i32x4 __attribute__((ext_vector_type(4)));
template <bool I8> struct AccT { typedef f32x4 type; };
template <> struct AccT<true> { typedef i32x4 type; };
template <class Epi, class Sched, bool ALIGN_EPI = false, bool SP2 = false, bool I8 = false>
__device__ __forceinline__ void gemm_phase(PG8_LAS unsigned char* lds, const Gemm g, const Sched& S, const Epi& E) {
    typedef typename AccT<I8>::type acc_t;
    const int tid = tid_opaque(), wid = __builtin_amdgcn_readfirstlane(tid >> 6), lane = tid & 63, wr = wid >> 2, wc = wid & 3, fr = lane & 15, fq = lane >> 4;
    const int rowb = I8 ? g.K : 2 * g.K, nt = rowb / (BK * 2);
    unsigned voffA[2], voffB[2];
#pragma unroll
    for (int i = 0; i < 2; ++i) { int R, C; stage_rc(tid * 16 + i * 8192, R, C); const int Rb = Epi::PERM ? ((R & ~31) + perm32(R & 31)) : R;
        voffA[i] = (unsigned)(R * rowb + C * 2); voffB[i] = (unsigned)(Rb * rowb + C * 2); }
    const size_t kstep = (size_t)(BK * 2);
    const size_t hstep = (size_t)HALF * rowb;
    const size_t tstep = 2 * hstep;
    const unsigned ldsw = (unsigned)wid * 1024u;
    const int aoff = lds_byte(wr * 64 + fr, fq * 8), boff = lds_byte(wc * 32 + fr, fq * 8);
#define PG8_SA(b, h) (((b) * 2 + (h)) * HTB)
#define PG8_SB(b, h) ((4 + (b) * 2 + (h)) * HTB)
#define PG8_STAGE(bufoff, gbase, voff) do { _Pragma("unroll") for (int _i = 0; _i < 2; ++_i) \
        __builtin_amdgcn_global_load_lds((const unsigned*)((const char*)(gbase) + (voff)[_i]), (PG8_LAS unsigned*)(lds + (bufoff) + ldsw + _i * 8192), 16, 0, 0); } while (0)
#define PG8_LDA(dst, b, h) do { _Pragma("unroll") for (int m = 0; m < 4; ++m) _Pragma("unroll") for (int k = 0; k < 2; ++k) dst[m][k] = *(const PG8_LAS bf16x8*)(lds + PG8_SA(b, h) + aoff + m * 2048 + k * 1024); } while (0)
#define PG8_LDB(dst, b, h) do { _Pragma("unroll") for (int n = 0; n < 2; ++n) _Pragma("unroll") for (int k = 0; k < 2; ++k) dst[n][k] = *(const PG8_LAS bf16x8*)(lds + PG8_SB(b, h) + boff + n * 2048 + k * 1024); } while (0)
#define PG8_MMA(ai, bj, At, Bt) do { __builtin_amdgcn_s_setprio(1); _Pragma("unroll") for (int m = 0; m < 4; ++m) _Pragma("unroll") for (int n = 0; n < 2; ++n) _Pragma("unroll") for (int k = 0; k < 2; ++k) \
        { if constexpr (I8) acc[ai][bj][m][n] = __builtin_amdgcn_mfma_i32_16x16x64_i8(__builtin_bit_cast(i32x4, Bt[n][k]), __builtin_bit_cast(i32x4, At[m][k]), acc[ai][bj][m][n], 0, 0, 0); \
          else acc[ai][bj][m][n] = __builtin_amdgcn_mfma_f32_16x16x32_bf16(Bt[n][k], At[m][k], acc[ai][bj][m][n], 0, 0, 0); } __builtin_amdgcn_s_setprio(0); } while (0)
#define PG8_WAIT_V(n) asm volatile("s_waitcnt vmcnt(" #n ")" ::: "memory")
#define PG8_WAIT_L(n) asm volatile("s_waitcnt lgkmcnt(" #n ")" ::: "memory")
#define PG8_BAR __builtin_amdgcn_s_barrier()
#define PG8_SCHED __builtin_amdgcn_sched_barrier(0)
    Unit cur, nxt; int ui = 0;
    if (!S.next(0, cur)) return;
    acc_t acc[2][2][4][2];
#pragma unroll
    for (int a = 0; a < 2; ++a)
#pragma unroll
        for (int b = 0; b < 2; ++b)
#pragma unroll
            for (int m = 0; m < 4; ++m)
#pragma unroll
                for (int n = 0; n < 2; ++n) acc[a][b][m][n] = acc_t{};
    bf16x8 At[4][2], B0[2][2], B1[2][2];
    const char* cA = (const char*)g.A + (size_t)cur.pm * tstep; const char* cB = (const char*)g.Bt + (size_t)cur.pn * tstep;
    S.a_ready(cur);
    if constexpr (SP2) {
        PG8_STAGE(PG8_SB(0, 0), cB, voffB); PG8_STAGE(PG8_SB(0, 1), cB + hstep, voffB); PG8_STAGE(PG8_SA(0, 0), cA, voffA); PG8_STAGE(PG8_SA(0, 1), cA + hstep, voffA);
        if (wr == 1) PG8_BAR;
        PG8_WAIT_V(2); PG8_BAR;
        PG8_STAGE(PG8_SB(1, 0), cB + kstep, voffB); PG8_STAGE(PG8_SA(1, 0), cA + kstep, voffA); PG8_STAGE(PG8_SB(1, 1), cB + hstep + kstep, voffB);
        PG8_WAIT_V(6); PG8_BAR;
    } else {
        PG8_STAGE(PG8_SB(0, 0), cB, voffB); PG8_STAGE(PG8_SA(0, 0), cA, voffA); PG8_STAGE(PG8_SB(0, 1), cB + hstep, voffB); PG8_STAGE(PG8_SA(0, 1), cA + hstep, voffA);
        if (wr == 1) PG8_BAR;
        PG8_WAIT_V(4); PG8_BAR;
        PG8_STAGE(PG8_SB(1, 0), cB + kstep, voffB); PG8_STAGE(PG8_SA(1, 0), cA + kstep, voffA); PG8_STAGE(PG8_SB(1, 1), cB + hstep + kstep, voffB);
        PG8_WAIT_V(6); PG8_BAR;
    }
    for (;;) {
        const bool has_next = S.next(ui + 1, nxt);
        const char* nA = has_next ? (const char*)g.A + (size_t)nxt.pm * tstep : cA; const char* nB = has_next ? (const char*)g.Bt + (size_t)nxt.pn * tstep : cB;
        for (int t = 0; t < nt; t += 2) {
            const bool last = (t == nt - 2);
            const char* a1 = cA + (size_t)(t + 1) * kstep;
            const char* a2 = last ? nA : cA + (size_t)(t + 2) * kstep; const char* b2 = last ? nB : cB + (size_t)(t + 2) * kstep;
            const char* a3 = a2 + kstep; const char* b3 = b2 + kstep;
            if (last && has_next) S.a_ready(nxt);
            if constexpr (SP2) {
            PG8_LDB(B0, 0, 0); PG8_LDB(B1, 0, 1); PG8_SCHED; PG8_LDA(At, 0, 0); PG8_STAGE(PG8_SA(1, 1), a1 + hstep, voffA);
            PG8_WAIT_V(8); PG8_WAIT_L(0); PG8_BAR; PG8_MMA(0, 0, At, B0); PG8_MMA(0, 1, At, B1); PG8_BAR; PG8_SCHED;
            PG8_LDA(At, 0, 1); PG8_STAGE(PG8_SB(0, 0), b2, voffB); PG8_STAGE(PG8_SB(0, 1), b2 + hstep, voffB); PG8_STAGE(PG8_SA(0, 0), a2, voffA);
            PG8_WAIT_V(8); PG8_WAIT_L(0); PG8_BAR; PG8_MMA(1, 0, At, B0); PG8_MMA(1, 1, At, B1); PG8_BAR; PG8_SCHED;
            PG8_LDB(B0, 1, 0); PG8_LDB(B1, 1, 1); PG8_SCHED; PG8_LDA(At, 1, 0); PG8_STAGE(PG8_SA(0, 1), a2 + hstep, voffA);
            PG8_WAIT_V(8); PG8_WAIT_L(0); PG8_BAR; PG8_MMA(0, 0, At, B0); PG8_MMA(0, 1, At, B1); PG8_BAR; PG8_SCHED;
            PG8_LDA(At, 1, 1); PG8_STAGE(PG8_SB(1, 0), b3, voffB); PG8_STAGE(PG8_SB(1, 1), b3 + hstep, voffB); PG8_STAGE(PG8_SA(1, 0), a3, voffA);
            PG8_WAIT_V(8); PG8_WAIT_L(0); PG8_BAR; PG8_MMA(1, 0, At, B0); PG8_MMA(1, 1, At, B1); PG8_BAR; PG8_SCHED;
            } else {
            PG8_LDB(B0, 0, 0); PG8_SCHED; PG8_LDA(At, 0, 0); PG8_STAGE(PG8_SA(1, 1), a1 + hstep, voffA);
            PG8_WAIT_L(8); PG8_BAR; PG8_WAIT_L(0); PG8_MMA(0, 0, At, B0); PG8_BAR; PG8_SCHED;
            PG8_LDB(B1, 0, 1); PG8_STAGE(PG8_SB(0, 0), b2, voffB);
            PG8_BAR; PG8_WAIT_L(0); PG8_MMA(0, 1, At, B1); PG8_BAR;
            PG8_LDA(At, 0, 1); PG8_STAGE(PG8_SA(0, 0), a2, voffA);
            PG8_BAR; PG8_WAIT_L(0); PG8_MMA(1, 0, At, B0); PG8_BAR; PG8_SCHED;
            PG8_STAGE(PG8_SB(0, 1), b2 + hstep, voffB);
            PG8_WAIT_V(6); PG8_BAR; PG8_MMA(1, 1, At, B1); PG8_BAR;
            PG8_LDB(B0, 1, 0); PG8_SCHED; PG8_LDA(At, 1, 0); PG8_STAGE(PG8_SA(0, 1), a2 + hstep, voffA);
            PG8_WAIT_L(8); PG8_BAR; PG8_WAIT_L(0); PG8_MMA(0, 0, At, B0); PG8_BAR; PG8_SCHED;
            PG8_LDB(B1, 1, 1); PG8_STAGE(PG8_SB(1, 0), b3, voffB);
            PG8_BAR; PG8_WAIT_L(0); PG8_MMA(0, 1, At, B1); PG8_BAR;
            PG8_LDA(At, 1, 1); PG8_STAGE(PG8_SA(1, 0), a3, voffA);
            PG8_BAR; PG8_WAIT_L(0); PG8_MMA(1, 0, At, B0); PG8_BAR; PG8_SCHED;
            PG8_STAGE(PG8_SB(1, 1), b3 + hstep, voffB);
            PG8_WAIT_V(6); PG8_BAR; PG8_MMA(1, 1, At, B1); PG8_BAR;
            }
        }
        if constexpr (ALIGN_EPI) { if (wr == 0) PG8_BAR; }
        if constexpr (!Epi::AFTER_DRAIN) { E(acc, cur, wr, wc, fr, fq); } S.done(cur);
        if (!has_next) break;
#pragma unroll
        for (int a = 0; a < 2; ++a)
#pragma unroll
            for (int b = 0; b < 2; ++b)
#pragma unroll
                for (int m = 0; m < 4; ++m)
#pragma unroll
                    for (int n = 0; n < 2; ++n) acc[a][b][m][n] = acc_t{};
        cur = nxt; cA = nA; cB = nB; ++ui;
        if constexpr (ALIGN_EPI) { if (wr == 1) PG8_BAR; }
    }
    PG8_WAIT_V(0);
    if constexpr (!ALIGN_EPI) { if (wr == 0) PG8_BAR; }
    PG8_BAR;
    if constexpr (Epi::AFTER_DRAIN) E.fused(acc, cur, wr, wc, fr, fq, lds);
#undef PG8_SA
#undef PG8_SB
#undef PG8_STAGE
#undef PG8_LDA
#undef PG8_LDB
#undef PG8_MMA
#undef PG8_WAIT_V
#undef PG8_WAIT_L
#undef PG8_BAR
#undef PG8_SCHED
}

__device__ __forceinline__ float sigmoidf_fast(float x) { return __builtin_amdgcn_rcpf(1.f + __builtin_amdgcn_exp2f(-x * LOG2E)); }
struct EpiInProj {
    static constexpr bool PERM = true, AFTER_DRAIN = false;
    bf16_t* base; const float* sxn  ; const float* wsc  ;
    const float* gq; const float* gk; PG8_LAS float* xch  ;
    __device__ __forceinline__ void operator()(const i32x4 (&acci)[2][2][4][2], const Unit& u, int wr, int wc, int fr, int fq) const {
        const int sec = u.pn >> 2; const float wsv = *wsc;
        bf16_t* sb = base + (size_t)sec * SEC_ELEMS;
        const float sc = (sec == 4) ? SCALE * LOG2E : 1.f;
        if (sec < 2) {
#pragma unroll
            for (int ai = 0; ai < 2; ++ai)
#pragma unroll
                for (int m = 0; m < 4; ++m) {
                    const int tk = u.pm * BM + ai * HALF + wr * 64 + m * 16 + fr;
                    const float rs = sxn[tk] * wsv;
#pragma unroll
                    for (int bj = 0; bj < 2; ++bj) {
                        const f32x4 v0 = __builtin_convertvector(acci[ai][bj][m][0], f32x4) * rs, v1 = __builtin_convertvector(acci[ai][bj][m][1], f32x4) * rs;
                        float ss = v0[0] * v0[0] + v0[1] * v0[1] + v0[2] * v0[2] + v0[3] * v0[3] + v1[0] * v1[0] + v1[1] * v1[1] + v1[2] * v1[2] + v1[3] * v1[3];
                        ss += sx_f(ss, 16); ss += sx_f(ss, 32);
                        if (fq == 0) xch[(((((wr * 2 + ai) * 4 + m) * 16 + fr) * 2 + bj) * 4) + wc] = ss;
                    }
                }
            asm volatile("s_waitcnt lgkmcnt(0)" ::: "memory");
            __builtin_amdgcn_s_barrier();
            const float* gp = (sec == 0 ? gq : gk) + wc * 32 + 8 * fq;
            const f32x4 g0 = *(const f32x4*)gp, g1 = *(const f32x4*)(gp + 4);
#pragma unroll
            for (int ai = 0; ai < 2; ++ai)
#pragma unroll
                for (int m = 0; m < 4; ++m) {
                    const int tk = u.pm * BM + ai * HALF + wr * 64 + m * 16 + fr, b = tk >> 12, s = tk & 4095;
                    const float rs = sxn[tk] * wsv;
#pragma unroll
                    for (int bj = 0; bj < 2; ++bj) {
                        const int hh = (u.pn & 3) * 2 + bj;
                        const f32x4 p4 = *(const PG8_LAS f32x4*)(xch + (((((wr * 2 + ai) * 4 + m) * 16 + fr) * 2 + bj) * 4));
                        const float r = rs / sqrtf(((p4[0] + p4[1]) + (p4[2] + p4[3])) * (1.f / 128.f) + EPS);
                        const f32x4 v0 = __builtin_convertvector(acci[ai][bj][m][0], f32x4) * r * g0, v1 = __builtin_convertvector(acci[ai][bj][m][1], f32x4) * r * g1;
                        u32x4 w; w.x = cvt_pk_bf16(v0[0], v0[1]); w.y = cvt_pk_bf16(v0[2], v0[3]); w.z = cvt_pk_bf16(v1[0], v1[1]); w.w = cvt_pk_bf16(v1[2], v1[3]);
                        *(u32x4*)(sb + ((size_t)((b * 8 + hh) * 4096 + s)) * 128 + wc * 32 + 8 * fq) = w;
                    }
                }
            return;
        }
#pragma unroll
        for (int ai = 0; ai < 2; ++ai)
#pragma unroll
            for (int m = 0; m < 4; ++m) {
                const int tk = u.pm * BM + ai * HALF + wr * 64 + m * 16 + fr, b = tk >> 12, s = tk & 4095;
                const float rs = sxn[tk] * wsv;
#pragma unroll
                for (int bj = 0; bj < 2; ++bj) {
                    const int hh = (u.pn & 3) * 2 + bj;
                    f32x4 v0 = __builtin_convertvector(acci[ai][bj][m][0], f32x4) * rs, v1 = __builtin_convertvector(acci[ai][bj][m][1], f32x4) * rs;
                    bf16_t* dst;
                    if (sec == 3) {
#pragma unroll
                        for (int i = 0; i < 4; ++i) { v0[i] = sigmoidf_fast(v0[i]); v1[i] = sigmoidf_fast(v1[i]); }
                        dst = sb + (size_t)tk * 1024 + hh * 128 + wc * 32 + 8 * fq;
                    } else {
                        v0 = v0 * sc; v1 = v1 * sc;
                        dst = sb + ((size_t)((b * 8 + hh) * 4096 + s)) * 128 + wc * 32 + 8 * fq;
                    }
                    u32x4 w; w.x = cvt_pk_bf16(v0[0], v0[1]); w.y = cvt_pk_bf16(v0[2], v0[3]); w.z = cvt_pk_bf16(v1[0], v1[1]); w.w = cvt_pk_bf16(v1[2], v1[3]);
                    *(u32x4*)dst = w;
                }
            }
    }
};
struct EpiOutProj {
    static constexpr bool PERM = true, AFTER_DRAIN = false;
    const float* x; float* h; bf16_t* hb; float* ssq; float* amx;
    __device__ __forceinline__ void operator()(const f32x4 (&acc)[2][2][4][2], const Unit& u, int wr, int wc, int fr, int fq) const {
#pragma unroll
        for (int ai = 0; ai < 2; ++ai)
#pragma unroll
            for (int m = 0; m < 4; ++m) {
                const int tk = u.pm * BM + ai * HALF + wr * 64 + m * 16 + fr;
                float ss = 0.f, mx = 0.f;
#pragma unroll
                for (int bj = 0; bj < 2; ++bj) {
                    const size_t off = (size_t)tk * DM + u.pn * BM + bj * HALF + wc * 32 + 8 * fq;
                    const f32x4 x0 = *(const f32x4*)(x + off), x1 = *(const f32x4*)(x + off + 4);
                    const f32x4 v0 = acc[ai][bj][m][0] + x0, v1 = acc[ai][bj][m][1] + x1;
                    u32x4 w; w.x = cvt_pk_bf16(v0[0], v0[1]); w.y = cvt_pk_bf16(v0[2], v0[3]); w.z = cvt_pk_bf16(v1[0], v1[1]); w.w = cvt_pk_bf16(v1[2], v1[3]);
                    *(u32x4*)(hb + off) = w;
                    ss += v0[0] * v0[0] + v0[1] * v0[1] + v0[2] * v0[2] + v0[3] * v0[3] + v1[0] * v1[0] + v1[1] * v1[1] + v1[2] * v1[2] + v1[3] * v1[3];
                    mx = fmaxf(mx, fmaxf(fmaxf(fmaxf(fabsf(v0[0]), fabsf(v0[1])), fmaxf(fabsf(v0[2]), fabsf(v0[3]))), fmaxf(fmaxf(fabsf(v1[0]), fabsf(v1[1])), fmaxf(fabsf(v1[2]), fabsf(v1[3])))));
                }
                ss += sx_f(ss, 16); ss += sx_f(ss, 32);
                mx = fmaxf(mx, sx_f(mx, 16)); mx = fmaxf(mx, sx_f(mx, 32));
                if (fq == 0) { ssq[(size_t)tk * 32 + u.pn * 4 + wc] = ss; amx[(size_t)tk * 32 + u.pn * 4 + wc] = mx; }
            }
    }
};
struct EpiPeerQ {
    static constexpr bool PERM = true, AFTER_DRAIN = false;
    const float* ssq; bf16_t* qp; float* rtab;
    __device__ __forceinline__ void operator()(const f32x4 (&acc)[2][2][4][2], const Unit& u, int wr, int wc, int fr, int fq) const {
#pragma unroll
        for (int ai = 0; ai < 2; ++ai)
#pragma unroll
            for (int m = 0; m < 4; ++m) {
                const int tk = u.pm * BM + ai * HALF + wr * 64 + m * 16 + fr;
                float tot = 0.f;
#pragma unroll
                for (int i = 0; i < 8; ++i) { const f32x4 s4 = *(const f32x4*)(ssq + (size_t)tk * 32 + 4 * i); tot += (s4[0] + s4[1]) + (s4[2] + s4[3]); }
                const float r = 1.0f / sqrtf(tot * (1.f / DM) + EPS);
                if (u.pn == 0 && wc == 0 && fq == 0) rtab[tk] = r;
#pragma unroll
                for (int bj = 0; bj < 2; ++bj) {
                    const size_t off = (size_t)tk * DM + u.pn * BM + bj * HALF + wc * 32 + 8 * fq;
                    const f32x4 v0 = acc[ai][bj][m][0] * r, v1 = acc[ai][bj][m][1] * r;
                    u32x4 w; w.x = cvt_pk_bf16(v0[0], v0[1]); w.y = cvt_pk_bf16(v0[2], v0[3]); w.z = cvt_pk_bf16(v1[0], v1[1]); w.w = cvt_pk_bf16(v1[2], v1[3]);
                    *(u32x4*)(qp + off) = w;
                }
            }
    }
};
struct EpiPeerQFused {
    static constexpr bool PERM = true, AFTER_DRAIN = true;
    const float* ssq; unsigned char* wsb;
    __device__ __forceinline__ void operator()(const f32x4 (&)[2][2][4][2], const Unit&, int, int, int, int) const {}
    __device__ __forceinline__ void fused(const f32x4 (&acc)[2][2][4][2], const Unit& u, int wr, int wc, int fr, int fq, PG8_LAS unsigned char* lds) const;
};
}

namespace att {
constexpr int NW = 8, QBLK = 32, KVBLK = 64, QB = NW * QBLK, D = 128;
constexpr int SHM_V = KVBLK * D * 2, SHM_K = KVBLK * D * 2;
constexpr int OFF_WS = 2 * SHM_V + 2 * SHM_K, OFF_BIAS = OFF_WS + NW * 64 * 4, ATT_LDS = OFF_BIAS + SEQ * 4;
#define KSWZ(row, colB) ((row) * 256 + ((colB) ^ (((row) & 7) << 4)))
#define SBAR() __builtin_amdgcn_sched_barrier(0)
__device__ __forceinline__ int v_st(int k, int c) { const int kk = (k & ~0xC) | ((k & 4) << 1) | ((k & 8) >> 1); return ((kk >> 3) * 4 + (c >> 5)) * 512 + ((kk & 7) * 32 + (c & 31)) * 2; }
__device__ __forceinline__ int v_rd_base(int lane) { return ((lane & 3) << 3) | (((lane >> 2) & 3) << 6) | (((lane >> 4) & 1) << 5) | (((lane >> 5) & 1) << 8); }
constexpr int v_rd_off(int d0, int ks, int half) { return d0 * 512 + ks * 4096 + half * 2048; }
__device__ __forceinline__ int crow(int r, int hi) { return (r & 3) + 8 * (r >> 2) + 4 * hi; }
__device__ __forceinline__ bf16x8 load8(const bf16_t* p) { return *reinterpret_cast<const bf16x8*>(p); }
__device__ __forceinline__ void mask_tile(f32x16& p0, f32x16& p1, int dq) {
    const float NEG = -__builtin_inff();
#pragma unroll
    for (int r = 0; r < 16; ++r) {
        const int c = (r & 3) + 8 * (r >> 2);
        if (dq - c < 0) p0[r] = NEG;
        if (dq - c - 32 < 0) p1[r] = NEG;
    }
}
__device__ __forceinline__ void partialSM(f32x16& p0, f32x16& p1, float& m_reg, float& mn, float& alpha) {
    float pmax = p0[0];
#pragma unroll
    for (int r = 1; r < 16; ++r) pmax = fmaxf(pmax, p0[r]);
#pragma unroll
    for (int r = 0; r < 16; ++r) pmax = fmaxf(pmax, p1[r]);
    { auto rr = __builtin_amdgcn_permlane32_swap(__float_as_uint(pmax), __float_as_uint(pmax), false, false);
      pmax = fmaxf(__uint_as_float(rr[0]), __uint_as_float(rr[1])); }
    constexpr float C2 = LOG2E * SCALE; constexpr float THR = 8.f;
    if (__builtin_expect(__all((pmax - m_reg) * SCALE <= THR), 1)) { mn = m_reg; alpha = 1.f; }
    else { mn = fmaxf(m_reg, pmax); alpha = __builtin_amdgcn_exp2f((m_reg - mn) * C2); m_reg = mn; }
    const float mnL = -mn * C2;
#pragma unroll
    for (int r = 0; r < 16; ++r) p0[r] = fmaf(p0[r], C2, mnL);
#pragma unroll
    for (int r = 0; r < 16; ++r) p1[r] = fmaf(p1[r], C2, mnL);
#pragma unroll
    for (int r = 0; r < 16; ++r) p0[r] = __builtin_amdgcn_exp2f(p0[r]);
}
#define PK4(P, B_, OUT) do { unsigned a0 = cvt_pk_bf16(P[B_+0], P[B_+1]), a1 = cvt_pk_bf16(P[B_+2], P[B_+3]);                          \
        unsigned b0 = cvt_pk_bf16(P[B_+4], P[B_+5]), b1 = cvt_pk_bf16(P[B_+6], P[B_+7]);                                             \
        auto r0 = __builtin_amdgcn_permlane32_swap(a0, b0, false, false); auto r1 = __builtin_amdgcn_permlane32_swap(a1, b1, false, false); \
        u32x4 w = {r0[0], r1[0], r0[1], r1[1]}; OUT = *reinterpret_cast<bf16x8*>(&w); } while (0)
__device__ __forceinline__ void finishSM(f32x16& p0, f32x16& p1, float alpha, float& l_reg, bf16x8& pa0, bf16x8& pa1, bf16x8& pa2, bf16x8& pa3) {
#pragma unroll
    for (int r = 0; r < 16; ++r) p1[r] = __builtin_amdgcn_exp2f(p1[r]);
    float ps = 0;
#pragma unroll
    for (int r = 0; r < 16; ++r) ps += p0[r];
#pragma unroll
    for (int r = 0; r < 16; ++r) ps += p1[r];
    { auto rr = __builtin_amdgcn_permlane32_swap(__float_as_uint(ps), __float_as_uint(ps), false, false);
      ps = __uint_as_float(rr[0]) + __uint_as_float(rr[1]); }
    l_reg = l_reg * alpha + ps;
    PK4(p0, 0, pa0); PK4(p0, 8, pa1); PK4(p1, 0, pa2); PK4(p1, 8, pa3);
}
__device__ __forceinline__ void sb_group(f32x16& P, int g, float& gs) {
    float run = 0.f;
#pragma unroll
    for (int k = 3; k >= 0; --k) {
        const float z = P[4 * g + k];
        const float t = __builtin_amdgcn_exp2f(-fabsf(z));
        const float l = __builtin_amdgcn_logf(1.f + t);
        const float sp = fmaxf(z, 0.f) + l;
        P[4 * g + k] = (z - sp) - run;
        run += sp;
    }
    gs = run;
}
__device__ __forceinline__ void sb_part1(f32x16& p0, f32x16& p1, float& carry, float mlo) {
    float gs[8];
#pragma unroll
    for (int g = 0; g < 4; ++g) sb_group(p0, g, gs[g]);
#pragma unroll
    for (int g = 0; g < 4; ++g) sb_group(p1, g, gs[4 + g]);
    float run = carry;
#pragma unroll
    for (int G = 7; G >= 0; --G) {
        auto rr = __builtin_amdgcn_permlane32_swap(__float_as_uint(gs[G]), __float_as_uint(gs[G]), false, false);
        const float slo = __uint_as_float(rr[0]), shi = __uint_as_float(rr[1]);
        const float base = fmaf(mlo, shi, run);
        if (G >= 4) {
#pragma unroll
            for (int k = 0; k < 4; ++k) p1[4 * (G - 4) + k] -= base;
        } else {
#pragma unroll
            for (int k = 0; k < 4; ++k) p0[4 * G + k] -= base;
        }
        run += slo + shi;
    }
    carry = run;
#pragma unroll
    for (int r = 0; r < 16; ++r) p0[r] = __builtin_amdgcn_exp2f(p0[r]);
}
__device__ __forceinline__ void sb_part2(f32x16& p0, f32x16& p1, bf16x8& pa0, bf16x8& pa1, bf16x8& pa2, bf16x8& pa3) {
#pragma unroll
    for (int r = 0; r < 16; ++r) p1[r] = __builtin_amdgcn_exp2f(p1[r]);
    PK4(p0, 0, pa0); PK4(p0, 8, pa1); PK4(p1, 0, pa2); PK4(p1, 8, pa3);
}
#undef PK4
template <int KB, bool BIAS>
__device__ __forceinline__ void qkt(f32x16& p0, f32x16& p1, const char* K_lds, int r32, int hi, const bf16x8* qr, const float* bt) {
    if constexpr (BIAS) {
#pragma unroll
        for (int g = 0; g < 4; ++g) { const f32x4 a = *(const f32x4*)(bt + 8 * g), b = *(const f32x4*)(bt + 32 + 8 * g);
            p0[4 * g] = a[0]; p0[4 * g + 1] = a[1]; p0[4 * g + 2] = a[2]; p0[4 * g + 3] = a[3];
            p1[4 * g] = b[0]; p1[4 * g + 1] = b[1]; p1[4 * g + 2] = b[2]; p1[4 * g + 3] = b[3]; }
    } else { p0 = f32x16{}; p1 = f32x16{}; }
    const char* kb[4];
#pragma unroll
    for (int dd = 0; dd < 4; ++dd) kb[dd] = K_lds + KB * SHM_K + KSWZ(r32, (dd * 16 + hi * 8) * 2);
#pragma unroll
    for (int d0 = 0; d0 < 8; ++d0) { const char* a = kb[d0 & 3] + (d0 >> 2) * 128;
        bf16x8 b0 = *reinterpret_cast<const bf16x8*>(a);
        bf16x8 b1 = *reinterpret_cast<const bf16x8*>(a + 32 * 256);
        p0 = __builtin_amdgcn_mfma_f32_32x32x16_bf16(b0, qr[d0], p0, 0, 0, 0);
        p1 = __builtin_amdgcn_mfma_f32_32x32x16_bf16(b1, qr[d0], p1, 0, 0, 0); }
}
template <int VB>
__device__ __forceinline__ void pv_tile(f32x16* o, int vb0, bf16x8 pa0, bf16x8 pa1, bf16x8 pa2, bf16x8 pa3) {
#define TRRD(dst, off) asm volatile("ds_read_b64_tr_b16 %0, %1 offset:%2" : "=&v"(dst) : "v"(vb0), "i"(off) : "memory")
#define PV_D0(d0) do { { s16x4 l0, l1, h0, h1; constexpr int b_ = VB * SHM_V + v_rd_off(d0, 0, 0); \
        TRRD(l0, b_); TRRD(h0, b_ + 2048); TRRD(l1, b_ + 4096); TRRD(h1, b_ + 6144); \
        asm volatile("s_waitcnt lgkmcnt(0)" ::: "memory"); SBAR();   \
        o[d0] = __builtin_amdgcn_mfma_f32_32x32x16_bf16(pa0, (bf16x8){l0[0], l0[1], l0[2], l0[3], h0[0], h0[1], h0[2], h0[3]}, o[d0], 0, 0, 0);   \
        o[d0] = __builtin_amdgcn_mfma_f32_32x32x16_bf16(pa1, (bf16x8){l1[0], l1[1], l1[2], l1[3], h1[0], h1[1], h1[2], h1[3]}, o[d0], 0, 0, 0); }  \
      { s16x4 l2, l3, h2, h3; constexpr int b_ = VB * SHM_V + v_rd_off(d0, 0, 0); \
        TRRD(l2, b_ + 8192); TRRD(h2, b_ + 10240); TRRD(l3, b_ + 12288); TRRD(h3, b_ + 14336); \
        asm volatile("s_waitcnt lgkmcnt(0)" ::: "memory"); SBAR();   \
        o[d0] = __builtin_amdgcn_mfma_f32_32x32x16_bf16(pa2, (bf16x8){l2[0], l2[1], l2[2], l2[3], h2[0], h2[1], h2[2], h2[3]}, o[d0], 0, 0, 0);   \
        o[d0] = __builtin_amdgcn_mfma_f32_32x32x16_bf16(pa3, (bf16x8){l3[0], l3[1], l3[2], l3[3], h3[0], h3[1], h3[2], h3[3]}, o[d0], 0, 0, 0); } } while (0)
    PV_D0(0); PV_D0(1); PV_D0(2); PV_D0(3);
#undef PV_D0
#undef TRRD
}

struct UnitRef { const bf16_t* Q; const bf16_t* K; const bf16_t* V; int P0; };
struct Seam { bf16x8 qr[8]; bf16x8 st_v0, st_v1, st_k0, st_k1; };
#define ROW(p, k0, rr) ((p) + (size_t)((k0) + (rr)) * D + sc)
#define VMW() asm volatile("s_waitcnt vmcnt(0)" ::: "memory")
#define SLOAD_H(Kp, Vp, k0) do { S.st_v0 = load8(ROW(Vp, k0, sr)); S.st_v1 = load8(ROW(Vp, k0, 32 + sr));              \
                         S.st_k0 = load8(ROW(Kp, k0, sr)); S.st_k1 = load8(ROW(Kp, k0, 32 + sr)); } while (0)
#define SWRITE_HK(bf) do { *(bf16x8*)(K_lds + (bf) * SHM_K + kws) = S.st_k0; *(bf16x8*)(K_lds + (bf) * SHM_K + kws + 32 * 256) = S.st_k1; } while (0)
#define SWRITE_HV(bf) do { *(bf16x8*)(V_lds + (bf) * SHM_V + vst0) = S.st_v0; *(bf16x8*)(V_lds + (bf) * SHM_V + vst1) = S.st_v1; } while (0)
#define SWRITE_H(bf) do { SWRITE_HV(bf); SWRITE_HK(bf); } while (0)

template <bool SB>
__device__ __forceinline__ void attn_unit(const UnitRef& cur, unsigned char* wsu  , int bh, char* lds,
                                          int part  ) {
    const float* cvec; const float* gqk;
    { unsigned char* w_ = wsu; asm volatile("" : "+s"(w_)); cvec = (const float*)(w_ + WS_C) + (size_t)bh * SEQ; gqk = (const float*)(w_ + WS_GQK); }
    const int tid = tid_opaque(), wid = __builtin_amdgcn_readfirstlane(tid >> 6), lane = tid & 63, r32 = lane & 31, hi = lane >> 5;
    int jlo = 0;
    if constexpr (!SB) {
        const float gq = fmaxf(fabsf(gqk[lane]), fabsf(gqk[64 + lane])), gk = fmaxf(fabsf(gqk[128 + lane]), fabsf(gqk[192 + lane]));
        const float lmax = 11.3137085f * 1.02f * wave_max(gq) * wave_max(gk);
        const int ntf = (cur.P0 + QB) / KVBLK;
        const float cend = (lane < ntf) ? cvec[lane * KVBLK + KVBLK - 1] : 0.f;
        const bool skip = (lane < ntf) && (2.f * lmax + cvec[cur.P0] - cend < -104.f);
        jlo = __builtin_amdgcn_readfirstlane((int)__popcll(__ballot(skip)));
    }
    const int ntot = (cur.P0 + QB) / KVBLK - jlo;
    const int tb = (part == 2) ? (ntot >> 1) : 0, te = (part == 1) ? (ntot >> 1) : ntot;
    const int kshift = (jlo + tb) * KVBLK, P0r = cur.P0 - kshift;
    const int NT = te - tb;
#define KBASE(t) ((SB ? (NT - 1 - (t)) : (t)) * KVBLK)
    const int qlo = P0r + wid * QBLK, qm = qlo + r32 - 4 * hi - (SB ? 1 : 0);
    char* V_lds = lds; char* K_lds = lds + 2 * SHM_V;
    float* ws = (float*)(lds + OFF_WS) + wid * 64; float* li_l = ws, * al_l = ws + 32;
    float* bias = (float*)(lds + OFF_BIAS);
    const int sr = tid >> 4, sc = (tid & 15) * 8, vst0 = v_st(sr, sc), vst1 = v_st(32 + sr, sc), kws = KSWZ(sr, sc * 2);
    const int vb0 = (int)(uintptr_t)V_lds + v_rd_base(lane);
    const bf16_t* Kh = cur.K + (size_t)kshift * D; const bf16_t* Vh = cur.V + (size_t)kshift * D;
    Seam S;
    if constexpr (!SB) { const float cq0 = cvec[cur.P0]; const float* cv = cvec + kshift; for (int j = tid; j < NT * KVBLK; j += NTHREADS) bias[j] = (cq0 - cv[j]) * (1.f / SCALE); }
#pragma unroll
    for (int d0 = 0; d0 < 8; ++d0) S.qr[d0] = load8(cur.Q + (size_t)(wid * QBLK + r32) * D + d0 * 16 + hi * 8);
    SLOAD_H(Kh, Vh, KBASE(0)); VMW(); SWRITE_HK(0);
    __syncthreads();
    float m_reg = -1e30f, l_reg = 0; f32x16 o[4] = {};
    float carry = 0.f; const float mlo = hi ? 0.f : 1.f;
#define RESC(a) do { if (__any((a) < 1.f)) { if (hi == 0) al_l[r32] = (a); asm volatile("s_waitcnt lgkmcnt(0)" ::: "memory");              \
                     for (int d_ = 0; d_ < 4; ++d_) for (int r = 0; r < 16; ++r) o[d_][r] *= al_l[crow(r, hi)]; } } while (0)
#define MASKT(P0_, P1_, t) do { const int kb_ = KBASE(t); if (kb_ + KVBLK - 1 > qlo - (SB ? 1 : 0)) mask_tile(P0_, P1_, qm - kb_); } while (0)
#define BT(t) (bias + KBASE(t) + 4 * hi)
#define PART1(PX0, PX1, mnX, alX) do { if constexpr (SB) sb_part1(PX0, PX1, carry, mlo); else partialSM(PX0, PX1, m_reg, mnX, alX); } while (0)
#define PART2(PY0, PY1, alY) do { if constexpr (SB) sb_part2(PY0, PY1, pa0, pa1, pa2, pa3); else finishSM(PY0, PY1, alY, l_reg, pa0, pa1, pa2, pa3); } while (0)
    f32x16 pA0, pA1, pB0, pB1; float mnA = 0.f, mnB = 0.f, alA = 1.f, alB = 1.f; bf16x8 pa0, pa1, pa2, pa3;
    SWRITE_HV(0); SBAR();
    if (NT > 1) SLOAD_H(Kh, Vh, KBASE(1));
    SBAR(); qkt<0, !SB>(pA0, pA1, K_lds, r32, hi, S.qr, BT(0));
    MASKT(pA0, pA1, 0); PART1(pA0, pA1, mnA, alA);
    if (NT > 1) { VMW(); SWRITE_H(1); }
    __syncthreads();
#define HALF_STEP(PX0, PX1, mnX, alX, PY0, PY1, alY, t, KB, VB, SBUF) do {                                                    \
        SBAR(); qkt<KB, !SB>(PX0, PX1, K_lds, r32, hi, S.qr, BT(t));                                                          \
        PART2(PY0, PY1, alY); SBAR();                                                                                          \
        if ((t) + 1 < NT) { SLOAD_H(Kh, Vh, KBASE((t) + 1)); SBAR(); }                                                         \
        pv_tile<VB>(o, vb0, pa0, pa1, pa2, pa3); MASKT(PX0, PX1, (t)); PART1(PX0, PX1, mnX, alX);                              \
        __syncthreads();                                                                                                      \
        if ((t) + 1 < NT) { VMW(); SWRITE_H(SBUF); }                                                                           \
        if constexpr (!SB) RESC(alX);                                                                                          \
        __syncthreads(); } while (0)
    for (int t = 1; t + 1 < NT; t += 2) {
        HALF_STEP(pB0, pB1, mnB, alB, pA0, pA1, alA, t, 1, 0, 0);
        HALF_STEP(pA0, pA1, mnA, alA, pB0, pB1, alB, t + 1, 0, 1, 1);
    }
    const bool even = (NT & 1) == 0;
    if (even) { SBAR(); qkt<1, !SB>(pB0, pB1, K_lds, r32, hi, S.qr, BT(NT - 1)); SBAR(); }
    PART2(pA0, pA1, alA); SBAR();
    pv_tile<0>(o, vb0, pa0, pa1, pa2, pa3);
    if (even) { MASKT(pB0, pB1, NT - 1); PART1(pB0, pB1, mnB, alB); __syncthreads(); if constexpr (!SB) RESC(alB);
        PART2(pB0, pB1, alB); SBAR(); pv_tile<1>(o, vb0, pa0, pa1, pa2, pa3); }
    unsigned char* we_ = wsu; asm volatile("" : "+s"(we_));
    if (part != 0) {
        const int slot2 = ((((cur.P0 >> 8) - 8) & 7) * 16 + bh) * 2 + (part == 2 ? 1 : 0);
        float* po = (float*)(we_ + WS_PO) + (size_t)slot2 * 256 * 128; float* pml = (float*)(we_ + WS_PML) + (size_t)slot2 * 512;
        if (hi == 0) { pml[(wid * QBLK + r32) * 2] = m_reg; pml[(wid * QBLK + r32) * 2 + 1] = l_reg; }
#pragma unroll
        for (int r = 0; r < 16; ++r)
#pragma unroll
            for (int d0 = 0; d0 < 4; ++d0) po[(size_t)(wid * QBLK + crow(r, hi)) * D + d0 * 32 + r32] = o[d0][r];
        __syncthreads();
        return;
    }
    const bf16_t* gate = (const bf16_t*)(we_ + WS_SEC) + 3 * SEC_ELEMS + (size_t)(bh >> 3) * SEQ * 1024 + (bh & 7) * HD;
    bf16_t* outp = (bf16_t*)(we_ + WS_MIX) + (size_t)(bh >> 3) * SEQ * DM + (bh & 7) * HD;
    float rli[16];
    if constexpr (!SB) {
        if (hi == 0) li_l[r32] = l_reg; asm volatile("s_waitcnt lgkmcnt(0)" ::: "memory");
#pragma unroll
        for (int r = 0; r < 16; ++r) rli[r] = __builtin_amdgcn_rcpf(li_l[crow(r, hi)]);
    }
#pragma unroll
    for (int r = 0; r < 16; ++r) { const int orow = cur.P0 + wid * QBLK + crow(r, hi);
#pragma unroll
        for (int d0 = 0; d0 < 4; ++d0) {
            float v = o[d0][r];
            if constexpr (!SB) { const unsigned short gb = gate[(size_t)orow * 1024 + d0 * 32 + r32]; v = v * rli[r] * __builtin_bit_cast(float, (unsigned)gb << 16); }
            const float vn = sx_f(v, 1);
            if ((r32 & 1) == 0) *(unsigned*)(outp + (size_t)orow * DM + d0 * 32 + r32) = cvt_pk_bf16(v, vn); } }
    __syncthreads();
#undef RESC
#undef KBASE
#undef MASKT
#undef BT
#undef PART1
#undef PART2
#undef HALF_STEP
}

constexpr float SB_TH = 150.f;
__device__ __forceinline__ void sb_unit(const UnitRef& cur, bf16_t* outp, char* lds) {
    const int tid = tid_opaque(), wid = __builtin_amdgcn_readfirstlane(tid >> 6), lane = tid & 63, r32 = lane & 31, hi = lane >> 5;
    const int NT = (cur.P0 + QB) / KVBLK;
#define KBASE(t) ((NT - 1 - (t)) * KVBLK)
    const int qlo = cur.P0 + wid * QBLK, qm = qlo + r32 - 4 * hi - 1;
    char* V_lds = lds; char* K_lds = lds + 2 * SHM_V;
    volatile int* flags = (volatile int*)(lds + OFF_WS);
    const int sr = tid >> 4, sc = (tid & 15) * 8, vst0 = v_st(sr, sc), vst1 = v_st(32 + sr, sc), kws = KSWZ(sr, sc * 2);
    const int vb0 = (int)(uintptr_t)V_lds + v_rd_base(lane);
    const bf16_t* Kh = cur.K; const bf16_t* Vh = cur.V;
    Seam S;
#pragma unroll
    for (int d0 = 0; d0 < 8; ++d0) S.qr[d0] = load8(cur.Q + (size_t)(wid * QBLK + r32) * D + d0 * 16 + hi * 8);
    SLOAD_H(Kh, Vh, KBASE(0)); VMW(); SWRITE_H(0);
    __syncthreads();
    f32x16 o[4] = {}; float carry = 0.f; const float mlo = hi ? 0.f : 1.f;
    bool wdone = false;
#define SB_STEP(tt, BUF) {                                                                                                 \
        const int kb_ = KBASE(tt);                                                                                           \
        if ((tt) + 1 < NT) SLOAD_H(Kh, Vh, KBASE((tt) + 1));                                                                 \
        SBAR();                                                                                                              \
        if (!wdone && kb_ <= qlo + QBLK - 2) {                                                                               \
            f32x16 p0, p1; bf16x8 pa0, pa1, pa2, pa3;                                                                        \
            qkt<BUF, false>(p0, p1, K_lds, r32, hi, S.qr, nullptr);                                                          \
            if (kb_ + KVBLK - 1 > qlo - 1) mask_tile(p0, p1, qm - kb_);                                                      \
            sb_part1(p0, p1, carry, mlo); sb_part2(p0, p1, pa0, pa1, pa2, pa3); SBAR();                                      \
            pv_tile<BUF>(o, vb0, pa0, pa1, pa2, pa3);                                                                        \
            wdone = __all(carry >= SB_TH);                                                                                   \
        }                                                                                                                    \
        if ((tt) + 1 < NT) { VMW(); SWRITE_H((BUF) ^ 1); }                                                                   \
        if (lane == 0) flags[((tt) & 1) * 8 + wid] = wdone ? 1 : 0;                                                          \
        __syncthreads();                                                                                                     \
        { int alld = 1;                                                                                                      \
          _Pragma("unroll") for (int w_ = 0; w_ < 8; ++w_) alld &= flags[((tt) & 1) * 8 + w_];                                \
          if (alld) break; } }
    for (int t = 0; t < NT; t += 2) {
        SB_STEP(t, 0)
        SB_STEP(t + 1, 1)
    }
#undef SB_STEP
#pragma unroll
    for (int r = 0; r < 16; ++r) { const int orow = cur.P0 + wid * QBLK + crow(r, hi);
#pragma unroll
        for (int d0 = 0; d0 < 4; ++d0) {
            const float v = o[d0][r];
            const float vn = sx_f(v, 1);
            if ((r32 & 1) == 0) *(unsigned*)(outp + (size_t)orow * DM + d0 * 32 + r32) = cvt_pk_bf16(v, vn); } }
    __syncthreads();
#undef KBASE
}
#undef ROW
#undef VMW
#undef SLOAD_H
#undef SWRITE_HK
#undef SWRITE_HV
#undef SWRITE_H
}

#define XB_TMO      128
#define XB_XCNT(j)  (256  + 64 * (j))
#define XB_XSUB(j)  (1280 + 64 * (j))
#define XB_XGEN(j)  (2304 + 64 * (j))
#define XB_TOP      3328
#define XB_TOPGEN   3392
#define XCD_BAR_WORDS 3456
#define XB_SPIN_CAP (1u << 20)
__device__ __forceinline__ unsigned xb_ld(unsigned* p)              { return __hip_atomic_load(p, __ATOMIC_RELAXED, __HIP_MEMORY_SCOPE_AGENT); }
__device__ __forceinline__ unsigned xb_add(unsigned* p, unsigned v) { return __hip_atomic_fetch_add(p, v, __ATOMIC_RELAXED, __HIP_MEMORY_SCOPE_AGENT); }
__device__ __forceinline__ unsigned xb_xcc_id() { return (unsigned)__builtin_amdgcn_s_getreg((3 << 11) | 20) & 0xFu; }
#define XB_SPIN(cond, bar) do { unsigned _sp = 0; while (cond) { __builtin_amdgcn_s_sleep(1); \
    if ((++_sp & 255u) == 0u) { if (xb_ld(&(bar)[XB_TMO])) break; if (_sp > XB_SPIN_CAP) { atomicAdd(&(bar)[XB_TMO], 1u); break; } } } } while (0)
struct XcdBarrier { unsigned* bar; unsigned x; volatile LAS unsigned* st; };
__device__ __forceinline__ XcdBarrier xcd_barrier_post(unsigned* bar, volatile LAS unsigned* st) {
    XcdBarrier b; b.bar = bar; b.x = xb_xcc_id(); b.st = st;
    if (threadIdx.x == 0) (void)xb_add(&bar[XB_XCNT(b.x)], 1u);
    return b;
}
__device__ __forceinline__ void xcd_barrier_complete(unsigned* bar, unsigned x, unsigned& nloc, unsigned& nx) {
    const unsigned G = gridDim.x * gridDim.y * gridDim.z;
    unsigned sum, cnt, mine, sp = 0u;
    for (;;) {
        sum = 0u; cnt = 0u; mine = 0u;
#pragma unroll
        for (unsigned j = 0; j < 16; ++j) { const unsigned c = xb_ld(&bar[XB_XCNT(j)]); sum += c; cnt += (c > 0u) ? 1u : 0u; mine = (j == x) ? c : mine; }
        if (sum == G) break;
        __builtin_amdgcn_s_sleep(1);
        if ((++sp & 255u) == 0u) { if (xb_ld(&bar[XB_TMO])) break; if (sp > XB_SPIN_CAP) { atomicAdd(&bar[XB_TMO], 1u); break; } }
    }
    nloc = mine > 0u ? mine : 1u; nx = cnt > 0u ? cnt : 1u;
}
__device__ __forceinline__ void xcd_barrier(const XcdBarrier& b) {
    asm volatile("s_waitcnt vmcnt(0)" ::: "memory");
    __syncthreads();
    if (threadIdx.x == 0) {
        unsigned* bar = b.bar;
        __builtin_amdgcn_s_waitcnt(0);
        unsigned nloc = b.st[0], nx = b.st[1];
        if (nloc == 0u) { xcd_barrier_complete(bar, b.x, nloc, nx); b.st[0] = nloc; b.st[1] = nx; }
        const unsigned old = xb_add(&bar[XB_XSUB(b.x)], 1u);
        const unsigned gen = old / nloc;
        if (old + 1u == (gen + 1u) * nloc) {
            __builtin_amdgcn_fence(__ATOMIC_RELEASE, "agent");
            asm volatile("s_waitcnt vmcnt(0)" ::: "memory");
            const unsigned og = xb_add(&bar[XB_TOP], 1u);
            const unsigned tg = og / nx;
            if (og + 1u == (tg + 1u) * nx) xb_add(&bar[XB_TOPGEN], 1u);
            else XB_SPIN(xb_ld(&bar[XB_TOPGEN]) == tg, bar);
            __builtin_amdgcn_fence(__ATOMIC_ACQUIRE, "agent");
            xb_add(&bar[XB_XGEN(b.x)], 1u);
            asm volatile("s_waitcnt vmcnt(0)" ::: "memory");
        } else {
            XB_SPIN(xb_ld(&bar[XB_XGEN(b.x)]) == gen, bar);
            __builtin_amdgcn_fence(__ATOMIC_ACQUIRE, "agent");
            asm volatile("s_waitcnt vmcnt(0)" ::: "memory");
        }
    }
    __syncthreads();
}

struct Args { const float* in[12]; float* out; unsigned char* ws; int ph_lo, ph_hi; };

__device__ __forceinline__ void p0_transpose_item(const float* W, int ldw, int K, bf16_t* WT, int nblk, LAS float* scr, int item, int lane, const float* gk) {
    const int kb = item / nblk, nb = item % nblk, k0 = 64 * kb, n0 = 32 * nb;
    { const int rr = lane >> 3, c4 = lane & 7; f32x4 v[8];
#pragma unroll
      for (int i = 0; i < 8; ++i) v[i] = *(const f32x4*)(W + (size_t)(k0 + rr + 8 * i) * ldw + n0 + 4 * c4);
#pragma unroll
      for (int i = 0; i < 8; ++i) { const int kk = rr + 8 * i; const float gm = gk ? gk[k0 + kk] : 1.f;
          scr[kk * 33 + 4 * c4] = v[i][0] * gm; scr[kk * 33 + 4 * c4 + 1] = v[i][1] * gm; scr[kk * 33 + 4 * c4 + 2] = v[i][2] * gm; scr[kk * 33 + 4 * c4 + 3] = v[i][3] * gm; } }
    LDS_WAIT(); asm volatile("" ::: "memory");
    const int c = lane & 7;
#pragma unroll
    for (int j = 0; j < 4; ++j) { const int n = (lane >> 3) + 8 * j; const LAS float* s = scr + (8 * c) * 33 + n;
        u32x4 o; o.x = cvt_pk_bf16(s[0 * 33], s[1 * 33]); o.y = cvt_pk_bf16(s[2 * 33], s[3 * 33]); o.z = cvt_pk_bf16(s[4 * 33], s[5 * 33]); o.w = cvt_pk_bf16(s[6 * 33], s[7 * 33]);
        *(u32x4*)(WT + (size_t)(n0 + n) * K + k0 + 8 * c) = o; }
    LDS_WAIT(); asm volatile("" ::: "memory");
}

__device__ __forceinline__ int pack_i8(float a, float b, float c, float d) {
    const int ia = (int)__builtin_rintf(a), ib = (int)__builtin_rintf(b), ic = (int)__builtin_rintf(c), id = (int)__builtin_rintf(d);
    return (int)(((unsigned)ia & 0xffu) | (((unsigned)ib & 0xffu) << 8) | (((unsigned)ic & 0xffu) << 16) | ((unsigned)id << 24));
}
__device__ __forceinline__ void convert_tables(const Args& a, int r0, int r1, int worker, int nworkers) {
    const int lane = tid_opaque() & 63;
    unsigned char* ws = a.ws; const float* g_ffn = a.in[7]; const float* pu = a.in[10]; const float* pv = a.in[11];
    float* suv = (float*)(ws + WS_SUV);
    for (int r = r0 + worker; r < r1; r += nworkers) {
        const bool isv = r >= NEXP; const int e = isv ? r - NEXP : r;
        const f32x4* srcp = (const f32x4*)((isv ? pv : pu) + (size_t)e * DM);
        f32x4 v[8]; float amax = 0.f;
#pragma unroll
        for (int j = 0; j < 8; ++j) { v[j] = srcp[lane + 64 * j];
            if (!isv) { const f32x4 g4 = *(const f32x4*)(g_ffn + 4 * (lane + 64 * j)); v[j] = v[j] * g4; }
            amax = fmaxf(amax, fmaxf(fmaxf(fabsf(v[j][0]), fabsf(v[j][1])), fmaxf(fabsf(v[j][2]), fabsf(v[j][3])))); }
        amax = wave_max(amax);
        const float sc = amax > 0.f ? 127.f / amax : 1.f;
        unsigned char* dst = ws + (isv ? WS_V8 : WS_U8) + (size_t)e * 128;
#pragma unroll
        for (int j = 0; j < 8; ++j) { const int p = pack_i8(v[j][0] * sc, v[j][1] * sc, v[j][2] * sc, v[j][3] * sc);
            const int col = 4 * (lane + 64 * j);
            *(unsigned*)(dst + (size_t)(col >> 7) * ((size_t)NEXP * 128) + (col & 127)) = (unsigned)p; }
        if (lane == 0) suv[r] = 1.f / sc;
    }
}
constexpr int TAB_SPLIT = NEXP;

__device__ __forceinline__ void p0_transpose_item_i8(const float* W, int ldw, int K, unsigned char* WT, int nblk, LAS float* scr, int item, int lane, float q8) {
    const int kb = item / nblk, nb = item % nblk, k0 = 64 * kb, n0 = 32 * nb;
    { const int rr = lane >> 3, c4 = lane & 7; f32x4 v[8];
#pragma unroll
      for (int i = 0; i < 8; ++i) v[i] = *(const f32x4*)(W + (size_t)(k0 + rr + 8 * i) * ldw + n0 + 4 * c4);
#pragma unroll
      for (int i = 0; i < 8; ++i) { const int kk = rr + 8 * i;
          scr[kk * 33 + 4 * c4] = v[i][0] * q8; scr[kk * 33 + 4 * c4 + 1] = v[i][1] * q8; scr[kk * 33 + 4 * c4 + 2] = v[i][2] * q8; scr[kk * 33 + 4 * c4 + 3] = v[i][3] * q8; } }
    LDS_WAIT(); asm volatile("" ::: "memory");
    const int c = lane & 7;
#pragma unroll
    for (int j = 0; j < 4; ++j) { const int n = (lane >> 3) + 8 * j; const LAS float* s = scr + (8 * c) * 33 + n;
        u32x2 o; o.x = (unsigned)pack_i8(s[0 * 33], s[1 * 33], s[2 * 33], s[3 * 33]); o.y = (unsigned)pack_i8(s[4 * 33], s[5 * 33], s[6 * 33], s[7 * 33]);
        *(u32x2*)(WT + (size_t)(n0 + n) * K + k0 + 8 * c) = o; }
    LDS_WAIT(); asm volatile("" ::: "memory");
}
__device__ __forceinline__ float log_sigmoid_f(float x) { return fminf(x, 0.f) - log1pf(expf(-fabsf(x))); }

__device__ __forceinline__ void phase0(const Args& a, unsigned char* lds_g) {
    LAS unsigned char* lds = (LAS unsigned char*)lds_g;
    const int tid = tid_opaque(), lane = tid & 63, wave = __builtin_amdgcn_readfirstlane(tid >> 6);
    const int gw = blockIdx.x * NWAVES + wave, NGW = gridDim.x * NWAVES;
    const int gt = blockIdx.x * NTHREADS + tid, NGT = gridDim.x * NTHREADS;
    unsigned char* ws = a.ws;
    const float* x = a.in[0]; const float* g_attn = a.in[1]; const float* w_in = a.in[2]; const float* b_forget = a.in[3];
    const float* w_out = a.in[6]; const float* g_ffn = a.in[7]; const float* w_pq = a.in[8]; const float* sk = a.in[9]; const float* pu = a.in[10]; const float* pv = a.in[11];
    { float m = 0.f; const f32x4* wp = (const f32x4*)w_in;
      constexpr size_t NV4 = (size_t)DM * DIN / 4;
      size_t i = gt;
      for (; i + 7 * (size_t)NGT < NV4; i += 8 * (size_t)NGT) {
          f32x4 v[8];
#pragma unroll
          for (int k = 0; k < 8; ++k) v[k] = wp[i + k * (size_t)NGT];
#pragma unroll
          for (int k = 0; k < 8; ++k) m = fmaxf(m, fmaxf(fmaxf(fabsf(v[k][0]), fabsf(v[k][1])), fmaxf(fabsf(v[k][2]), fabsf(v[k][3])))); }
      for (; i < NV4; i += NGT) { const f32x4 v = wp[i]; m = fmaxf(m, fmaxf(fmaxf(fabsf(v[0]), fabsf(v[1])), fmaxf(fabsf(v[2]), fabsf(v[3])))); }
      m = wave_max(m);
      volatile LAS float* red = (volatile LAS float*)(lds + MISC_OFF + 256);
      if (lane == 0) red[wave] = m;
      __syncthreads();
      if (tid == 0) { float mm = red[0];
#pragma unroll
          for (int w = 1; w < NWAVES; ++w) mm = fmaxf(mm, red[w]);
          __hip_atomic_fetch_max((unsigned*)(ws + WS_CTL) + CW_WMAX, __float_as_uint(mm), __ATOMIC_RELAXED, __HIP_MEMORY_SCOPE_AGENT); } }
    LAS float* wf = (LAS float*)(lds + 67584);
    for (int k = tid; k < DM; k += NTHREADS) { const f32x4 a0 = *(const f32x4*)(w_in + (size_t)k * DIN + NPROJ), a1 = *(const f32x4*)(w_in + (size_t)k * DIN + NPROJ + 4);
        wf[0 * DM + k] = a0[0]; wf[1 * DM + k] = a0[1]; wf[2 * DM + k] = a0[2]; wf[3 * DM + k] = a0[3]; wf[4 * DM + k] = a1[0]; wf[5 * DM + k] = a1[1]; wf[6 * DM + k] = a1[2]; wf[7 * DM + k] = a1[3]; }
    __syncthreads();
    for (int row = gw; row < T; row += NGW) {
        const f32x4* xr = (const f32x4*)(x + (size_t)row * DM);
        f32x4 v[8]; float ss = 0.f;
#pragma unroll
        for (int j = 0; j < 8; ++j) { v[j] = xr[lane + 64 * j]; ss += v[j][0] * v[j][0] + v[j][1] * v[j][1] + v[j][2] * v[j][2] + v[j][3] * v[j][3]; }
        const float r = 1.0f / sqrtf(wave_sum(ss) * (1.f / DM) + EPS);
        float f[8] = {0.f, 0.f, 0.f, 0.f, 0.f, 0.f, 0.f, 0.f};
        float xmax = 0.f;
#pragma unroll
        for (int j = 0; j < 8; ++j) { const f32x4 g4 = *(const f32x4*)(g_attn + 4 * (lane + 64 * j)); v[j][0] *= r * g4[0]; v[j][1] *= r * g4[1]; v[j][2] *= r * g4[2]; v[j][3] *= r * g4[3];
            xmax = fmaxf(xmax, fmaxf(fmaxf(fabsf(v[j][0]), fabsf(v[j][1])), fmaxf(fabsf(v[j][2]), fabsf(v[j][3])))); }
        xmax = wave_max(xmax);
        const float xq = xmax > 0.f ? 127.f / xmax : 1.f;
        if (lane == 0) ((float*)(ws + WS_SXN))[row] = xmax * (1.f / 127.f);
        unsigned* o8 = (unsigned*)(ws + WS_XN + (size_t)row * DM);
#pragma unroll
        for (int j = 0; j < 8; ++j) {
            const int e = 4 * (lane + 64 * j);
            const f32x4 xn = v[j];
            o8[lane + 64 * j] = (unsigned)pack_i8(xn[0] * xq, xn[1] * xq, xn[2] * xq, xn[3] * xq);
#pragma unroll
            for (int hh = 0; hh < 8; ++hh) { const f32x4 w4 = *(LAS f32x4*)(wf + hh * DM + e);
                f[hh] += (xn[0] * w4[0] + xn[1] * w4[1]) + (xn[2] * w4[2] + xn[3] * w4[3]); }
            __builtin_amdgcn_sched_barrier(0);
        }
#pragma unroll
        for (int hh = 0; hh < 8; ++hh) f[hh] = wave_sum(f[hh]);
        if (lane < 8) { float fl = f[0];
#pragma unroll
            for (int hh = 1; hh < 8; ++hh) fl = (lane == hh) ? f[hh] : fl;
            const int b = row >> 12, s = row & 4095;
            ((float*)(ws + WS_LOGF))[(size_t)(b * 8 + lane) * SEQ + s] = log_sigmoid_f(fl + b_forget[lane]); }
    }
    LAS float* scr = (LAS float*)(lds + wave * 8448);
    constexpr int I_IN = (DM / 64) * (NPROJ / 32), I_O = (DM / 64) * (DM / 32);
    for (int it = gw; it < 2 * I_O; it += NGW) {
        int r = it;
        if (r < I_O) { p0_transpose_item(w_out, DM, DM, (bf16_t*)(ws + WS_WOUT), DM / 32, scr, r, lane, nullptr); continue; } r -= I_O;
        p0_transpose_item(w_pq, DM, DM, (bf16_t*)(ws + WS_WPQ), DM / 32, scr, r, lane, g_ffn);
    }
    for (int i = gt; i < 8 * 2 * 128 * 128 / 8; i += NGT) { const f32x4 a0 = *(const f32x4*)(sk + (size_t)i * 8), a1 = *(const f32x4*)(sk + (size_t)i * 8 + 4);
        u32x4 w; w.x = cvt_pk_bf16(a0[0], a0[1]); w.y = cvt_pk_bf16(a0[2], a0[3]); w.z = cvt_pk_bf16(a1[0], a1[1]); w.w = cvt_pk_bf16(a1[2], a1[3]);
        *(u32x4*)(ws + WS_SK + (size_t)i * 16) = w; }
    if (gt < 256) ((float*)(ws + WS_GQK))[gt] = gt < 128 ? a.in[4][gt] : a.in[5][gt - 128];
    convert_tables(a, 0, TAB_SPLIT, gw, NGW);
    { XcdBarrier xb_; xb_.bar = (unsigned*)(ws + WS_CTL) + CW_BAR; xb_.x = xb_xcc_id(); xb_.st = (volatile LAS unsigned*)(lds + MISC_OFF) + 8; xcd_barrier(xb_); }
    const float wmax = __uint_as_float(__hip_atomic_load((unsigned*)(ws + WS_CTL) + CW_WMAX, __ATOMIC_RELAXED, __HIP_MEMORY_SCOPE_AGENT));
    if (gt == 0) *(float*)(ws + WS_WSC) = wmax * (1.f / 127.f);
    const float q8 = wmax > 0.f ? 127.f / wmax : 1.f;
    for (int it = gw; it < I_IN; it += NGW) p0_transpose_item_i8(w_in, DIN, DM, ws + WS_WIN, NPROJ / 32, scr, it, lane, q8);
}

__device__ __forceinline__ void cumsum_rows(const Args& a) {
    const int tid = tid_opaque(), lane = tid & 63, wave = tid >> 6;
    if (blockIdx.x >= 16 || wave != 0) return;
    const float* src = (const float*)(a.ws + WS_LOGF) + (size_t)blockIdx.x * SEQ + lane * 64;
    float* dst = (float*)(a.ws + WS_C) + (size_t)blockIdx.x * SEQ + lane * 64;
    f32x4 v[16]; float run = 0.f;
#pragma unroll
    for (int i = 0; i < 16; ++i) { v[i] = *(const f32x4*)(src + 4 * i);
#pragma unroll
        for (int q = 0; q < 4; ++q) { run += v[i][q]; v[i][q] = run; } }
    float incl = run;
#pragma unroll
    for (int o = 1; o < 64; o <<= 1) { const float t = shup_f(incl, o); if (lane >= o) incl += t; }
    const float off = incl - run;
#pragma unroll
    for (int i = 0; i < 16; ++i) { f32x4 w = v[i]; w[0] += off; w[1] += off; w[2] += off; w[3] += off; *(f32x4*)(dst + 4 * i) = w; }
}

__device__ __forceinline__ void phase_qknorm(const Args& a) {
    const int tid = tid_opaque(), lane = tid & 63, wave = tid >> 6;
    const int gw = blockIdx.x * NWAVES + wave, NGW = gridDim.x * NWAVES;
    const int sub = lane & 15, rw = lane >> 4;
    const float* gq = a.in[4]; const float* gk = a.in[5];
    constexpr int ROWS = NB * NHF * SEQ;
    for (int it = gw; it < 2 * ROWS / 4; it += NGW) {
        const int row = it * 4 + rw; const bool isk = row >= ROWS;
        bf16_t* p = (bf16_t*)(a.ws + WS_SEC) + (size_t)row * HD + sub * 8;
        const float* g = (isk ? gk : gq) + sub * 8;
        const u32x4 w = *(const u32x4*)p;
        float v[8] = {bf_lo(w.x), bf_hi(w.x), bf_lo(w.y), bf_hi(w.y), bf_lo(w.z), bf_hi(w.z), bf_lo(w.w), bf_hi(w.w)};
        float ss = 0.f;
#pragma unroll
        for (int i = 0; i < 8; ++i) ss += v[i] * v[i];
        ss += sx_f(ss, 1); ss += sx_f(ss, 2); ss += sx_f(ss, 4); ss += sx_f(ss, 8);
        const float r = 1.0f / sqrtf(ss * (1.f / HD) + EPS);
        const f32x4 g0 = *(const f32x4*)g, g1 = *(const f32x4*)(g + 4);
        u32x4 o; o.x = cvt_pk_bf16(v[0] * r * g0[0], v[1] * r * g0[1]); o.y = cvt_pk_bf16(v[2] * r * g0[2], v[3] * r * g0[3]);
        o.z = cvt_pk_bf16(v[4] * r * g1[0], v[5] * r * g1[1]); o.w = cvt_pk_bf16(v[6] * r * g1[2], v[7] * r * g1[3]);
        *(u32x4*)p = o;
    }
}

__device__ __forceinline__ void phase_attn(const Args& a, unsigned char* lds_g) {
    const int tid = tid_opaque();
    volatile int* s_item = (volatile int*)(lds_g + MISC_OFF);
    unsigned* ctr = (unsigned*)(a.ws + WS_CTL);
    for (;;) {
        __syncthreads();
        if (tid == 0) *s_item = (int)atomicAdd(ctr, 1u);
        __syncthreads();
        int it = *s_item, kind = -1, qb = 0, sub = 0;
#define CLS(K, Q, CNT) if (kind < 0) { if (it < (CNT)) { kind = (K); qb = (Q); sub = it; } else it -= (CNT); }
        CLS(2, 15, 32) CLS(1, 7, 16) CLS(2, 14, 32) CLS(2, 13, 32) CLS(1, 6, 16) CLS(2, 12, 32) CLS(2, 11, 32) CLS(1, 5, 16) CLS(2, 10, 32) CLS(2, 9, 32) CLS(1, 4, 16) CLS(2, 8, 32) CLS(1, 3, 16) CLS(1, 2, 16)
        if (kind < 0) { if (it < 256) { kind = 0; qb = 15 - (it >> 4); sub = it & 15; } else it -= 256; }
        CLS(1, 1, 16) CLS(1, 0, 16)
#undef CLS
        if (kind < 0) break;
        unsigned char* wsl = a.ws; asm volatile("" : "+s"(wsl));
        bf16_t* sec = (bf16_t*)(wsl + WS_SEC);
        const int bh = sub & 15, part = (kind == 2) ? 1 + (sub >> 4) : 0;
        const int b = bh >> 3, h = bh & 7;
        const size_t hoff = (size_t)bh * SEQ * HD;
        att::UnitRef u;
        u.P0 = qb * 256;
        if (kind == 0) {
            u.Q = sec + 4 * SEC_ELEMS + hoff + (size_t)u.P0 * HD; u.K = sec + 5 * SEC_ELEMS + hoff; u.V = sec + 6 * SEC_ELEMS + hoff;
            att::sb_unit(u, (bf16_t*)(wsl + WS_MIX) + (size_t)b * SEQ * DM + 1024 + h * HD, (char*)lds_g);
        } else {
            u.Q = sec + 0 * SEC_ELEMS + hoff + (size_t)u.P0 * HD; u.K = sec + 1 * SEC_ELEMS + hoff; u.V = sec + 2 * SEC_ELEMS + hoff;
            att::attn_unit<false>(u, wsl, bh, (char*)lds_g, part);
        }
    }
}
__device__ __forceinline__ void phase_attn_combine(const Args& a) {
    const int gt = blockIdx.x * NTHREADS + tid_opaque(), NGT = gridDim.x * NTHREADS;
    const float* po = (const float*)(a.ws + WS_PO); const float* pml = (const float*)(a.ws + WS_PML);
    const bf16_t* gate = (const bf16_t*)(a.ws + WS_SEC) + 3 * SEC_ELEMS; bf16_t* mix = (bf16_t*)(a.ws + WS_MIX);
    constexpr float C2 = LOG2E * SCALE;
    for (int item = gt; item < 128 * 256 * 16; item += NGT) {
        const int slot = item >> 12, row = (item >> 4) & 255, cg = item & 15;
        const int qb = 8 + (slot >> 4), bh = slot & 15, b = bh >> 3, h = bh & 7;
        const f32x2 ml1 = *(const f32x2*)(pml + (size_t)(slot * 2) * 512 + row * 2), ml2 = *(const f32x2*)(pml + (size_t)(slot * 2 + 1) * 512 + row * 2);
        const float M = fmaxf(ml1.x, ml2.x), a1 = __builtin_amdgcn_exp2f((ml1.x - M) * C2), a2 = __builtin_amdgcn_exp2f((ml2.x - M) * C2);
        const float inv = 1.f / (a1 * ml1.y + a2 * ml2.y);
        const float* p1 = po + (size_t)(slot * 2) * 32768 + row * 128 + cg * 8; const float* p2 = p1 + 32768;
        const f32x4 x0 = *(const f32x4*)p1, x1 = *(const f32x4*)(p1 + 4), y0 = *(const f32x4*)p2, y1 = *(const f32x4*)(p2 + 4);
        const size_t tok = (size_t)b * SEQ + qb * 256 + row;
        const u32x4 gw = *(const u32x4*)(gate + tok * 1024 + h * HD + cg * 8);
        const float w1 = a1 * inv, w2 = a2 * inv;
        u32x4 o;
        o.x = cvt_pk_bf16((w1 * x0[0] + w2 * y0[0]) * bf_lo(gw.x), (w1 * x0[1] + w2 * y0[1]) * bf_hi(gw.x));
        o.y = cvt_pk_bf16((w1 * x0[2] + w2 * y0[2]) * bf_lo(gw.y), (w1 * x0[3] + w2 * y0[3]) * bf_hi(gw.y));
        o.z = cvt_pk_bf16((w1 * x1[0] + w2 * y1[0]) * bf_lo(gw.z), (w1 * x1[1] + w2 * y1[1]) * bf_hi(gw.z));
        o.w = cvt_pk_bf16((w1 * x1[2] + w2 * y1[2]) * bf_lo(gw.w), (w1 * x1[3] + w2 * y1[3]) * bf_hi(gw.w));
        *(u32x4*)(mix + tok * DM + h * HD + cg * 8) = o;
    }
}

__device__ __forceinline__ unsigned f2ord(float f) { const unsigned u = __float_as_uint(f); return u ^ ((unsigned)((int)u >> 31) | 0x80000000u); }
__device__ __forceinline__ float ord2f(unsigned k) { const unsigned u = k ^ (~(unsigned)((int)k >> 31) | 0x80000000u); return __uint_as_float(u); }
#define INS16(L, X) do { unsigned x_ = (X); _Pragma("unroll") for (int i_ = 0; i_ < 16; ++i_) { const unsigned hi_ = max(L[i_], x_); x_ = min(L[i_], x_); L[i_] = hi_; } } while (0)
__device__ __forceinline__ void sort16_desc(unsigned (&a)[16]) {
#pragma unroll
    for (int k = 2; k <= 16; k <<= 1)
#pragma unroll
        for (int j = k >> 1; j > 0; j >>= 1)
#pragma unroll
            for (int i = 0; i < 16; ++i) { const int l = i ^ j; if (l > i) { const unsigned hi_ = max(a[i], a[l]), lo_ = min(a[i], a[l]); const bool desc = (i & k) == 0; a[i] = desc ? hi_ : lo_; a[l] = desc ? lo_ : hi_; } }
}
__device__ __forceinline__ void merge_top16(unsigned (&a)[16], const unsigned (&b)[16]) {
#pragma unroll
    for (int i = 0; i < 16; ++i) a[i] = max(a[i], b[15 - i]);
#pragma unroll
    for (int j = 8; j > 0; j >>= 1)
#pragma unroll
        for (int i = 0; i < 16; ++i) { const int l = i ^ j; if (l > i) { const unsigned hi_ = max(a[i], a[l]), lo_ = min(a[i], a[l]); a[i] = hi_; a[l] = lo_; } }
}
__device__ __forceinline__ void topk_half(const bf16_t* qrow  , const bf16_t* skb, int h, int c, int r32, int hi, unsigned (&L)[16]) {
    bf16x8 qf[8];
#pragma unroll
    for (int d0 = 0; d0 < 8; ++d0) qf[d0] = *(const bf16x8*)(qrow + c * 128 + d0 * 16 + hi * 8);
    const unsigned hi4 = 4u * (unsigned)hi;
#pragma unroll
    for (int kt = 0; kt < 4; ++kt) {
        f32x16 acc = f32x16{};
#pragma unroll
        for (int d0 = 0; d0 < 8; ++d0) { const bf16x8 kf = *(const bf16x8*)(skb + (size_t)((h * 2 + c) * 128 + kt * 32 + r32) * 128 + d0 * 16 + hi * 8);
            acc = __builtin_amdgcn_mfma_f32_32x32x16_bf16(kf, qf[d0], acc, 0, 0, 0); }
        __builtin_amdgcn_sched_barrier(0);
        unsigned G[16];
#pragma unroll
        for (int r = 0; r < 16; ++r) { const unsigned cst = (unsigned)(127 - (kt * 32 + (r & 3) + 8 * (r >> 2))); G[r] = (f2ord(acc[r]) & ~127u) | (cst - hi4); }
        sort16_desc(G);
        if (kt == 0) {
#pragma unroll
            for (int i = 0; i < 16; ++i) L[i] = G[i];
        } else merge_top16(L, G);
        __builtin_amdgcn_sched_barrier(0);
    }
    unsigned P[16];
#pragma unroll
    for (int i = 0; i < 16; ++i) { auto rr = __builtin_amdgcn_permlane32_swap(L[i], L[i], false, false); P[i] = hi ? rr[0] : rr[1]; }
    merge_top16(L, P);
}
__device__ __forceinline__ void topk_task(unsigned char* ws, const bf16_t* qrow, LAS int* tb, int t0, int h, int lane) {
    const int r32 = lane & 31, hi = lane >> 5;
    const bf16_t* skb = (const bf16_t*)(ws + WS_SK);
    int* idx_o = (int*)(ws + WS_IDX); float* gw_o = (float*)(ws + WS_GW);
    float rt_l;
    { const f32x4* sp = (const f32x4*)((const float*)(ws + WS_SSQ) + (size_t)(t0 + (lane & 31)) * 32); float tot = 0.f;
#pragma unroll
      for (int i = 0; i < 8; ++i) { const f32x4 v = sp[i]; tot += (v[0] + v[1]) + (v[2] + v[3]); }
      rt_l = 1.0f / sqrtf(tot * (1.f / DM) + EPS); }
        {
          const bf16_t* hbp = (const bf16_t*)(ws + WS_HB); const float* amx = (const float*)(ws + WS_AMX); unsigned char* xq = ws + WS_XQ;
          float am = 0.f;
          { const f32x4* ap = (const f32x4*)(amx + (size_t)(t0 + (lane & 31)) * 32);
#pragma unroll
            for (int i = 0; i < 8; ++i) { const f32x4 v = ap[i]; am = fmaxf(am, fmaxf(fmaxf(v[0], v[1]), fmaxf(v[2], v[3]))); } }
          if (h == 0 && lane < 32) ((float*)(ws + WS_SX))[t0 + lane] = rt_l * am * (1.f / 126.5f);
          const float qs = am > 0.f ? 126.5f / am : 1.f;
          u32x4 wv[16];
#pragma unroll
          for (int j = 0; j < 16; ++j) { const int ch = lane + 64 * j; wv[j] = *(const u32x4*)(hbp + (size_t)(t0 + (ch >> 5)) * DM + h * 256 + (ch & 31) * 8); }
#pragma unroll
          for (int j = 0; j < 16; ++j) { const int ch = lane + 64 * j, tl = ch >> 5, tk = t0 + tl, col = h * 256 + (ch & 31) * 8;
              const u32x4 w = wv[j]; const float r = sh_f(qs, tl);
              const int p0 = pack_i8(bf_lo(w.x) * r, bf_hi(w.x) * r, bf_lo(w.y) * r, bf_hi(w.y) * r), p1 = pack_i8(bf_lo(w.z) * r, bf_hi(w.z) * r, bf_lo(w.w) * r, bf_hi(w.w) * r);
              *(u32x2*)(xq + (size_t)tk * DM + col) = (u32x2){(unsigned)p0, (unsigned)p1}; } }
        unsigned L[2][16];
        topk_half(qrow, skb, h, 0, r32, hi, L[0]);
        __builtin_amdgcn_sched_barrier(0);
        topk_half(qrow, skb, h, 1, r32, hi, L[1]);
        __builtin_amdgcn_sched_barrier(0);
        float s1[16], s2[16]; int i1[16], i2[16];
#pragma unroll
        for (int i = 0; i < 16; ++i) { s1[i] = ord2f((L[0][i] & ~127u) | 64u); i1[i] = 127 - (int)(L[0][i] & 127u); s2[i] = ord2f((L[1][i] & ~127u) | 64u); i2[i] = 127 - (int)(L[1][i] & 127u); }
        unsigned CG[4][16];
#pragma unroll
        for (int i = 0; i < 64; ++i) CG[i >> 4][i & 15] = 0u;
        CG[0][0] = (f2ord(s1[0] + s2[0]) & ~255u) | 0u;
        CG[0][1] = (f2ord(s1[0] + s2[1]) & ~255u) | 1u;
        CG[0][2] = (f2ord(s1[0] + s2[2]) & ~255u) | 2u;
        CG[0][3] = (f2ord(s1[0] + s2[3]) & ~255u) | 3u;
        CG[0][4] = (f2ord(s1[0] + s2[4]) & ~255u) | 4u;
        CG[0][5] = (f2ord(s1[0] + s2[5]) & ~255u) | 5u;
        CG[0][6] = (f2ord(s1[0] + s2[6]) & ~255u) | 6u;
        CG[0][7] = (f2ord(s1[0] + s2[7]) & ~255u) | 7u;
        CG[0][8] = (f2ord(s1[0] + s2[8]) & ~255u) | 8u;
        CG[0][9] = (f2ord(s1[0] + s2[9]) & ~255u) | 9u;
        CG[0][10] = (f2ord(s1[0] + s2[10]) & ~255u) | 10u;
        CG[0][11] = (f2ord(s1[0] + s2[11]) & ~255u) | 11u;
        CG[0][12] = (f2ord(s1[0] + s2[12]) & ~255u) | 12u;
        CG[0][13] = (f2ord(s1[0] + s2[13]) & ~255u) | 13u;
        CG[0][14] = (f2ord(s1[0] + s2[14]) & ~255u) | 14u;
        CG[0][15] = (f2ord(s1[0] + s2[15]) & ~255u) | 15u;
        CG[1][0] = (f2ord(s1[1] + s2[0]) & ~255u) | 16u;
        CG[1][1] = (f2ord(s1[1] + s2[1]) & ~255u) | 17u;
        CG[1][2] = (f2ord(s1[1] + s2[2]) & ~255u) | 18u;
        CG[1][3] = (f2ord(s1[1] + s2[3]) & ~255u) | 19u;
        CG[1][4] = (f2ord(s1[1] + s2[4]) & ~255u) | 20u;
        CG[1][5] = (f2ord(s1[1] + s2[5]) & ~255u) | 21u;
        CG[1][6] = (f2ord(s1[1] + s2[6]) & ~255u) | 22u;
        CG[1][7] = (f2ord(s1[1] + s2[7]) & ~255u) | 23u;
        CG[1][8] = (f2ord(s1[2] + s2[0]) & ~255u) | 32u;
        CG[1][9] = (f2ord(s1[2] + s2[1]) & ~255u) | 33u;
        CG[1][10] = (f2ord(s1[2] + s2[2]) & ~255u) | 34u;
        CG[1][11] = (f2ord(s1[2] + s2[3]) & ~255u) | 35u;
        CG[1][12] = (f2ord(s1[2] + s2[4]) & ~255u) | 36u;
        CG[1][13] = (f2ord(s1[3] + s2[0]) & ~255u) | 48u;
        CG[1][14] = (f2ord(s1[3] + s2[1]) & ~255u) | 49u;
        CG[1][15] = (f2ord(s1[3] + s2[2]) & ~255u) | 50u;
        CG[2][0] = (f2ord(s1[3] + s2[3]) & ~255u) | 51u;
        CG[2][1] = (f2ord(s1[4] + s2[0]) & ~255u) | 64u;
        CG[2][2] = (f2ord(s1[4] + s2[1]) & ~255u) | 65u;
        CG[2][3] = (f2ord(s1[4] + s2[2]) & ~255u) | 66u;
        CG[2][4] = (f2ord(s1[5] + s2[0]) & ~255u) | 80u;
        CG[2][5] = (f2ord(s1[5] + s2[1]) & ~255u) | 81u;
        CG[2][6] = (f2ord(s1[6] + s2[0]) & ~255u) | 96u;
        CG[2][7] = (f2ord(s1[6] + s2[1]) & ~255u) | 97u;
        CG[2][8] = (f2ord(s1[7] + s2[0]) & ~255u) | 112u;
        CG[2][9] = (f2ord(s1[7] + s2[1]) & ~255u) | 113u;
        CG[2][10] = (f2ord(s1[8] + s2[0]) & ~255u) | 128u;
        CG[2][11] = (f2ord(s1[9] + s2[0]) & ~255u) | 144u;
        CG[2][12] = (f2ord(s1[10] + s2[0]) & ~255u) | 160u;
        CG[2][13] = (f2ord(s1[11] + s2[0]) & ~255u) | 176u;
        CG[2][14] = (f2ord(s1[12] + s2[0]) & ~255u) | 192u;
        CG[2][15] = (f2ord(s1[13] + s2[0]) & ~255u) | 208u;
        CG[3][0] = (f2ord(s1[14] + s2[0]) & ~255u) | 224u;
        CG[3][1] = (f2ord(s1[15] + s2[0]) & ~255u) | 240u;
        sort16_desc(CG[0]); sort16_desc(CG[1]); sort16_desc(CG[2]); sort16_desc(CG[3]);
        merge_top16(CG[0], CG[1]); merge_top16(CG[2], CG[3]); merge_top16(CG[0], CG[2]);
        unsigned LC[16];
#pragma unroll
        for (int i = 0; i < 16; ++i) LC[i] = CG[0][i];
#pragma unroll
        for (int i = 0; i < 16; ++i) { tb[i * 64 + lane] = i1[i]; tb[(16 + i) * 64 + lane] = i2[i]; }
        float LS[16]; int LP[16];
#pragma unroll
        for (int i = 0; i < 16; ++i) { const unsigned cid = LC[i] & 255u; LS[i] = ord2f((LC[i] & ~255u) | 128u);
            LP[i] = tb[(cid >> 4) * 64 + lane] * 128 + tb[(16 + (cid & 15u)) * 64 + lane]; }
        float den = 0.f, e[16];
#pragma unroll
        for (int i = 0; i < 16; ++i) { e[i] = __expf(LS[i] - LS[0]); den += e[i]; }
        const float rden = 1.f / den;
        const size_t ob = (size_t)(t0 + r32) * NE + h * 16;
        if (hi == 0) {
#pragma unroll
            for (int i = 0; i < 4; ++i) *(int4*)(idx_o + ob + 4 * i) = make_int4(LP[4 * i], LP[4 * i + 1], LP[4 * i + 2], LP[4 * i + 3]);
        } else {
#pragma unroll
            for (int i = 0; i < 4; ++i) *(f32x4*)(gw_o + ob + 4 * i) = (f32x4){e[4 * i] * rden, e[4 * i + 1] * rden, e[4 * i + 2] * rden, e[4 * i + 3] * rden};
        }
}
__device__ __forceinline__ void phase_topk(const Args& a, unsigned char* lds_g) {
    LAS unsigned char* lds = (LAS unsigned char*)lds_g;
    const int tid = tid_opaque(), lane = tid & 63, wave = tid >> 6;
    const int gw = blockIdx.x * NWAVES + wave, NGW = gridDim.x * NWAVES;
    const bf16_t* qp = (const bf16_t*)(a.ws + WS_QP);
    for (int task = gw; task < (T / 32) * 8; task += NGW) {
        const int h = task & 7, t0 = (task >> 3) * 32;
        topk_task(a.ws, qp + (size_t)(t0 + (lane & 31)) * DM + h * 256, (LAS int*)(lds + wave * 8192), t0, h, lane);
    }
}
__device__ __forceinline__ void pg8::EpiPeerQFused::fused(const f32x4 (&acc)[2][2][4][2], const Unit& u, int wr, int wc, int fr, int fq, PG8_LAS unsigned char* lds) const {
    constexpr int ROWB = 528;
#pragma unroll
    for (int ai = 0; ai < 2; ++ai)
#pragma unroll
        for (int m = 0; m < 4; ++m) {
            const int tr = ai * HALF + wr * 64 + m * 16 + fr, tk = u.pm * BM + tr;
            float tot = 0.f;
#pragma unroll
            for (int i = 0; i < 8; ++i) { const f32x4 s4 = *(const f32x4*)(ssq + (size_t)tk * 32 + 4 * i); tot += (s4[0] + s4[1]) + (s4[2] + s4[3]); }
            const float r = 1.0f / sqrtf(tot * (1.f / DM) + EPS);
#pragma unroll
            for (int bj = 0; bj < 2; ++bj) {
                const f32x4 v0 = acc[ai][bj][m][0] * r, v1 = acc[ai][bj][m][1] * r;
                u32x4 w; w.x = cvt_pk_bf16(v0[0], v0[1]); w.y = cvt_pk_bf16(v0[2], v0[3]); w.z = cvt_pk_bf16(v1[0], v1[1]); w.w = cvt_pk_bf16(v1[2], v1[3]);
                *(PG8_LAS u32x4*)(lds + tr * ROWB + (bj * HALF + wc * 32 + 8 * fq) * 2) = w;
            }
        }
    __syncthreads();
    const int tid = tid_opaque(), lane = tid & 63, wave = tid >> 6;
    PG8_LAS unsigned char* myrows = lds + (wave * 32) * ROWB;
    topk_task(wsb, (const bf16_t*)(const void*)(myrows + (lane & 31) * ROWB), (LAS int*)myrows, u.pm * BM + wave * 32, u.pn, lane);
}
__device__ __forceinline__ void wave_argmax(float& v, int& i) {
#pragma unroll
    for (int o = 1; o < 64; o <<= 1) { const float ov = sx_f(v, o); const int oi = sx_i(i, o); if (ov > v || (ov == v && oi < i)) { v = ov; i = oi; } }
}
__device__ __forceinline__ void phase_topk_ref(const Args& a) {
    const int tid = tid_opaque(), lane = tid & 63, wave = tid >> 6;
    const int gw = blockIdx.x * NWAVES + wave, NGW = gridDim.x * NWAVES;
    const bf16_t* skb = (const bf16_t*)(a.ws + WS_SK); const bf16_t* qp = (const bf16_t*)(a.ws + WS_QP);
    int* idx_o = (int*)(a.ws + WS_IDX); float* gw_o = (float*)(a.ws + WS_GW);
    for (int task = gw; task < T * 8; task += NGW) {
        const int t = task >> 3, h = task & 7;
        float topS[2]; int topI[2];
        for (int c = 0; c < 2; ++c) {
            const bf16_t* q = qp + (size_t)t * DM + h * 256 + c * 128;
            float sc0 = 0.f, sc1 = 0.f;
            const bf16_t* k0 = skb + (size_t)((h * 2 + c) * 128 + lane) * 128; const bf16_t* k1 = k0 + 64 * 128;
            for (int d = 0; d < 128; ++d) { const float qd = __uint_as_float((unsigned)q[d] << 16);
                sc0 += qd * __uint_as_float((unsigned)k0[d] << 16); sc1 += qd * __uint_as_float((unsigned)k1[d] << 16); }
            float ms = 0.f; int mi = 0;
            for (int r = 0; r < 16; ++r) {
                float v; int i; if (sc0 >= sc1) { v = sc0; i = lane; } else { v = sc1; i = lane + 64; }
                wave_argmax(v, i);
                if (lane == r) { ms = v; mi = i; }
                if (i == lane) sc0 = -__builtin_inff();
                if (i == lane + 64) sc1 = -__builtin_inff();
            }
            topS[c] = ms; topI[c] = mi;
        }
        float cs[4]; int ci[4];
#pragma unroll
        for (int j = 0; j < 4; ++j) { const int cidx = lane * 4 + j, aa = cidx >> 4, bb = cidx & 15;
            cs[j] = sh_f(topS[0], aa) + sh_f(topS[1], bb); ci[j] = cidx; }
        float fs = 0.f; int fi = 0;
        for (int r = 0; r < 16; ++r) {
            float v = cs[0]; int i = ci[0];
#pragma unroll
            for (int j = 1; j < 4; ++j) if (cs[j] > v) { v = cs[j]; i = ci[j]; }
            wave_argmax(v, i);
            if (lane == r) { fs = v; fi = i; }
#pragma unroll
            for (int j = 0; j < 4; ++j) if (ci[j] == i) cs[j] = -__builtin_inff();
        }
        const int e1 = sh_i(topI[0], fi >> 4), e2 = sh_i(topI[1], fi & 15);
        const float mx = sh_f(fs, 0);
        float ev = lane < 16 ? __expf(fs - mx) : 0.f;
        const float den = wave_sum(ev);
        if (lane < 16) { idx_o[(size_t)t * NE + h * 16 + lane] = e1 * 128 + e2; gw_o[(size_t)t * NE + h * 16 + lane] = ev / den; }
    }
}

__device__ __forceinline__ void fp8x16_to_f32(const u32x4 q, f32x2 (&o)[8]) {
    o[0] = __builtin_amdgcn_cvt_pk_f32_fp8((int)q.x, false); o[1] = __builtin_amdgcn_cvt_pk_f32_fp8((int)q.x, true);
    o[2] = __builtin_amdgcn_cvt_pk_f32_fp8((int)q.y, false); o[3] = __builtin_amdgcn_cvt_pk_f32_fp8((int)q.y, true);
    o[4] = __builtin_amdgcn_cvt_pk_f32_fp8((int)q.z, false); o[5] = __builtin_amdgcn_cvt_pk_f32_fp8((int)q.z, true);
    o[6] = __builtin_amdgcn_cvt_pk_f32_fp8((int)q.w, false); o[7] = __builtin_amdgcn_cvt_pk_f32_fp8((int)q.w, true);
}
#define HALVE(dst, srcv, n, bitmask) do { const bool up_ = (lane & (bitmask)) != 0; _Pragma("unroll") for (int i_ = 0; i_ < (n); ++i_) { \
        const float keep_ = up_ ? srcv[(n) + i_] : srcv[i_], send_ = up_ ? srcv[i_] : srcv[(n) + i_]; dst[i_] = keep_ + sx_f(send_, (bitmask)); } } while (0)
#define ITEM_T(n) (wv + ((n) % KT) * NWX)
#define ITEM_S(n) (xl + 8 * ((n) / KT))
#define LD_IDX(ID, n) do { const int4* ip_ = (const int4*)(idx_i + (size_t)ITEM_T(n) * NE + g * 16); _Pragma("unroll") for (int i_ = 0; i_ < 4; ++i_) ID[i_] = ip_[i_]; } while (0)
#define LD_ROWS(Q, ID, TAB, n) do { const unsigned char* b_ = (TAB) + (size_t)ITEM_S(n) * ((size_t)NEXP * 128) + c * 16; _Pragma("unroll") for (int i_ = 0; i_ < 4; ++i_) { \
        Q[4 * i_] = *(const u32x4*)(b_ + (size_t)ID[i_].x * 128); Q[4 * i_ + 1] = *(const u32x4*)(b_ + (size_t)ID[i_].y * 128); \
        Q[4 * i_ + 2] = *(const u32x4*)(b_ + (size_t)ID[i_].z * 128); Q[4 * i_ + 3] = *(const u32x4*)(b_ + (size_t)ID[i_].w * 128); } } while (0)
__device__ __forceinline__ int dpp_hmirror(int v) { return __builtin_amdgcn_update_dpp(0, v, 0x141, 0xf, 0xf, true); }
__device__ __forceinline__ int dpp_qxor2(int v) { return __builtin_amdgcn_update_dpp(0, v, 0x4E, 0xf, 0xf, true); }
__device__ __forceinline__ int dpp_qxor1(int v) { return __builtin_amdgcn_update_dpp(0, v, 0xB1, 0xf, 0xf, true); }
__device__ __forceinline__ void phase_peer_u(const Args& a) {
    const int tid = tid_opaque(), lane = tid & 63, wave = tid >> 6, g = lane >> 3, c = lane & 7;
    const int xl = blockIdx.x & 7, wv = (blockIdx.x >> 3) * NWAVES + wave, NWX = (gridDim.x >> 3) * NWAVES, KT = T / NWX, N = 2 * KT;
    const unsigned char* xq = a.ws + WS_XQ; const unsigned char* u8 = a.ws + WS_U8;
    const int* idx_i = (const int*)(a.ws + WS_IDX); bf16_t* part = (bf16_t*)(a.ws + WS_PART);
    const bool up4 = (c & 4) != 0, up2 = (c & 2) != 0, up1 = (c & 1) != 0;
#define LD_X(X, n) do { X = *(const u32x4*)(xq + (size_t)ITEM_T(n) * DM + ITEM_S(n) * 128 + c * 16); } while (0)
#define COMPUTE_U(Q, X, n) do { int p[16]; \
        _Pragma("unroll") for (int i = 0; i < 16; ++i) { int d_ = __builtin_amdgcn_sdot4((int)Q[i].x, (int)X.x, 0, false); d_ = __builtin_amdgcn_sdot4((int)Q[i].y, (int)X.y, d_, false); \
            d_ = __builtin_amdgcn_sdot4((int)Q[i].z, (int)X.z, d_, false); p[i] = __builtin_amdgcn_sdot4((int)Q[i].w, (int)X.w, d_, false); } \
        int p8[8], p4[4], p2[2]; \
        _Pragma("unroll") for (int i = 0; i < 8; ++i) { const int keep_ = up4 ? p[8 + i] : p[i], send_ = up4 ? p[i] : p[8 + i]; p8[i] = keep_ + dpp_hmirror(send_); } \
        _Pragma("unroll") for (int i = 0; i < 4; ++i) { const int keep_ = up2 ? p8[4 + i] : p8[i], send_ = up2 ? p8[i] : p8[4 + i]; p4[i] = keep_ + dpp_qxor2(send_); } \
        _Pragma("unroll") for (int i = 0; i < 2; ++i) { const int keep_ = up1 ? p4[2 + i] : p4[i], send_ = up1 ? p4[i] : p4[2 + i]; p2[i] = keep_ + dpp_qxor1(send_); } \
        *(unsigned*)(part + ((size_t)ITEM_T(n) * 16 + ITEM_S(n)) * NE + 2 * lane) = cvt_pk_bf16((float)p2[0], (float)p2[1]); } while (0)
    int4 IA[4], IB[4]; u32x4 QA[16], QB[16], XA, XB;
    LD_IDX(IA, 0); LD_IDX(IB, 1);
    LD_ROWS(QA, IA, u8, 0); LD_X(XA, 0);
    for (int n = 0; n < N; n += 2) {
        LD_ROWS(QB, IB, u8, n + 1); LD_X(XB, n + 1);
        if (n + 2 < N) LD_IDX(IA, n + 2);
        COMPUTE_U(QA, XA, n);
        if (n + 2 < N) { LD_ROWS(QA, IA, u8, n + 2); LD_X(XA, n + 2); }
        if (n + 3 < N) LD_IDX(IB, n + 3);
        COMPUTE_U(QB, XB, n + 1);
    }
#undef LD_X
#undef COMPUTE_U
}
__device__ __forceinline__ void phase_peer_w(const Args& a) {
    const int gt = blockIdx.x * NTHREADS + tid_opaque(), NGT = gridDim.x * NTHREADS;
    const int* idx_i = (const int*)(a.ws + WS_IDX); const float* gw_i = (const float*)(a.ws + WS_GW); const bf16_t* part = (const bf16_t*)(a.ws + WS_PART);
    const float* suv = (const float*)(a.ws + WS_SUV); const float* sx = (const float*)(a.ws + WS_SX);
    signed char* wq = (signed char*)(a.ws + WS_WQ); float* sw = (float*)(a.ws + WS_SW);
    for (int item = gt; item < T * NE; item += NGT) {
        const int t = item >> 7, e = item & 127;
        float sum = 0.f;
#pragma unroll
        for (int s = 0; s < 16; ++s) sum += __uint_as_float((unsigned)part[((size_t)t * 16 + s) * NE + e] << 16);
        const int ex = idx_i[item];
        const float d = sum * suv[ex] * sx[t];
        const float om = 0.5f * d * (1.f + erff(d * 0.70710678118654752f)) * gw_i[item] * suv[NEXP + ex];
        float mx = fabsf(om);
        mx = fmaxf(mx, sx_f(mx, 1)); mx = fmaxf(mx, sx_f(mx, 2)); mx = fmaxf(mx, sx_f(mx, 4)); mx = fmaxf(mx, sx_f(mx, 8));
        const float qs = mx > 0.f ? 127.f / mx : 1.f;
        wq[item] = (signed char)(int)__builtin_rintf(om * qs);
        if ((e & 15) == 0) sw[t * 8 + (e >> 4)] = mx * (1.f / 127.f);
    }
}
__device__ __forceinline__ void phase_peer_v(const Args& a, float* dst) {
    const int tid = tid_opaque(), lane = tid & 63, wave = tid >> 6, g = lane >> 3, c = lane & 7;
    const int xl = blockIdx.x & 7, wv = (blockIdx.x >> 3) * NWAVES + wave, NWX = (gridDim.x >> 3) * NWAVES, KT = T / NWX, N = 2 * KT;
    const unsigned char* v8 = a.ws + WS_V8;
    const int* idx_i = (const int*)(a.ws + WS_IDX); const unsigned char* wq = a.ws + WS_WQ; const float* sw = (const float*)(a.ws + WS_SW);
    const bf16_t* hsrc = (const bf16_t*)(a.ws + WS_HB);
#define LD_W(W, SWV, n) do { W = *(const u32x4*)(wq + (size_t)ITEM_T(n) * NE + g * 16); SWV = sw[ITEM_T(n) * 8 + g]; } while (0)
#define QUAD(A_, B_, C_, D_, W_, A0, A1, A2, A3) do { \
        const unsigned ablo_ = __builtin_amdgcn_perm(B_, A_, 0x05010400u), abhi_ = __builtin_amdgcn_perm(B_, A_, 0x07030602u); \
        const unsigned cdlo_ = __builtin_amdgcn_perm(D_, C_, 0x05010400u), cdhi_ = __builtin_amdgcn_perm(D_, C_, 0x07030602u); \
        A0 = __builtin_amdgcn_sdot4((int)__builtin_amdgcn_perm(cdlo_, ablo_, 0x05040100u), (int)(W_), A0, false); \
        A1 = __builtin_amdgcn_sdot4((int)__builtin_amdgcn_perm(cdlo_, ablo_, 0x07060302u), (int)(W_), A1, false); \
        A2 = __builtin_amdgcn_sdot4((int)__builtin_amdgcn_perm(cdhi_, abhi_, 0x05040100u), (int)(W_), A2, false); \
        A3 = __builtin_amdgcn_sdot4((int)__builtin_amdgcn_perm(cdhi_, abhi_, 0x07060302u), (int)(W_), A3, false); } while (0)
#define COMPUTE_V(Q, W, SWV, n) do { int ac[16]; _Pragma("unroll") for (int k = 0; k < 16; ++k) ac[k] = 0; \
        _Pragma("unroll") for (int q_ = 0; q_ < 4; ++q_) { const unsigned w_ = q_ == 0 ? W.x : q_ == 1 ? W.y : q_ == 2 ? W.z : W.w; \
            QUAD(Q[4 * q_].x, Q[4 * q_ + 1].x, Q[4 * q_ + 2].x, Q[4 * q_ + 3].x, w_, ac[0], ac[1], ac[2], ac[3]); \
            QUAD(Q[4 * q_].y, Q[4 * q_ + 1].y, Q[4 * q_ + 2].y, Q[4 * q_ + 3].y, w_, ac[4], ac[5], ac[6], ac[7]); \
            QUAD(Q[4 * q_].z, Q[4 * q_ + 1].z, Q[4 * q_ + 2].z, Q[4 * q_ + 3].z, w_, ac[8], ac[9], ac[10], ac[11]); \
            QUAD(Q[4 * q_].w, Q[4 * q_ + 1].w, Q[4 * q_ + 2].w, Q[4 * q_ + 3].w, w_, ac[12], ac[13], ac[14], ac[15]); } \
        float p[16]; _Pragma("unroll") for (int k = 0; k < 16; ++k) p[k] = (float)ac[k] * SWV; \
        float p8[8], p4[4], p2[2]; \
        _Pragma("unroll") for (int i_ = 0; i_ < 8; ++i_) { auto rr_ = __builtin_amdgcn_permlane32_swap(__float_as_uint(p[i_]), __float_as_uint(p[8 + i_]), false, false); p8[i_] = __uint_as_float(rr_[0]) + __uint_as_float(rr_[1]); } \
        _Pragma("unroll") for (int i_ = 0; i_ < 4; ++i_) { auto rr_ = __builtin_amdgcn_permlane16_swap(__float_as_uint(p8[i_]), __float_as_uint(p8[4 + i_]), false, false); p4[i_] = __uint_as_float(rr_[0]) + __uint_as_float(rr_[1]); } \
        HALVE(p2, p4, 2, 8); \
        const size_t o_ = (size_t)ITEM_T(n) * DM + ITEM_S(n) * 128 + c * 16 + 2 * g; \
        const unsigned hv = *(const unsigned*)(hsrc + o_); *(f32x2*)(dst + o_) = (f32x2){bf_lo(hv) + p2[0], bf_hi(hv) + p2[1]}; } while (0)
    int4 IA[4], IB[4]; u32x4 QA[16], QB[16], WA, WB; float SA, SB_;
    LD_IDX(IA, 0); LD_IDX(IB, 1);
    LD_ROWS(QA, IA, v8, 0); LD_W(WA, SA, 0);
    for (int n = 0; n < N; n += 2) {
        LD_ROWS(QB, IB, v8, n + 1); LD_W(WB, SB_, n + 1);
        if (n + 2 < N) LD_IDX(IA, n + 2);
        COMPUTE_V(QA, WA, SA, n);
        if (n + 2 < N) { LD_ROWS(QA, IA, v8, n + 2); LD_W(WA, SA, n + 2); }
        if (n + 3 < N) LD_IDX(IB, n + 3);
        COMPUTE_V(QB, WB, SB_, n + 1);
    }
#undef LD_W
#undef QUAD
#undef COMPUTE_V
}
#undef ITEM_T
#undef ITEM_S
#undef LD_IDX
#undef LD_ROWS
#undef HALVE


constexpr int NPHASE = 11;
#define LOAD_ARGS() do { } while (0)
__global__ void __launch_bounds__(NTHREADS, 2) fwd_kernel(Args a) {
    extern __shared__ __attribute__((aligned(16))) unsigned char lds[];
#if MK_ONE_LAUNCH
    constexpr int lo = 0, hi = NPHASE;
    cg::grid_group grid = cg::this_grid();
    volatile LAS unsigned* misc = (volatile LAS unsigned*)((LAS unsigned char*)lds + MISC_OFF);
    if (threadIdx.x < 16) misc[threadIdx.x] = 0u;
    __syncthreads();
    { LOAD_ARGS(); (void)xcd_barrier_post((unsigned*)(a.ws + WS_CTL) + CW_BAR, misc + 8); }
#ifndef SEAM_CG_MASK
#define SEAM_CG_MASK 0
#endif
#define SEAM(k) do { if (lo <= (k) && (k) + 1 < hi) { if ((SEAM_CG_MASK >> (k)) & 1) grid.sync(); else { LOAD_ARGS(); XcdBarrier xb_; xb_.bar = (unsigned*)(a.ws + WS_CTL) + CW_BAR; xb_.x = xb_xcc_id(); \
        xb_.st = (volatile LAS unsigned*)((LAS unsigned char*)lds + MISC_OFF) + 8; xcd_barrier(xb_); } } } while (0)
#else
    int lo, hi; { LOAD_ARGS(); lo = a.ph_lo; hi = a.ph_hi; }
#define SEAM(k) do { } while (0)
#endif
#define IN(k) (lo <= (k) && (k) < hi)
#ifndef DUP_PHASE
#define DUP_PHASE -1
#endif
    if (IN(0)) { LOAD_ARGS(); phase0(a, lds); if (DUP_PHASE == 0) { __syncthreads(); phase0(a, lds); } SEAM(0); }
    if (IN(1)) { LOAD_ARGS(); unsigned char* ws = a.ws;
        cumsum_rows(a);
        pg8::Gemm g{(const bf16_t*)(ws + WS_XN), (const bf16_t*)(ws + WS_WIN), T, NPROJ, DM}; pg8::StaticOrder S; S.init(T, NPROJ, (int)gridDim.x, (int)blockIdx.x);
        pg8::EpiInProj E{(bf16_t*)(ws + WS_SEC), (const float*)(ws + WS_SXN), (const float*)(ws + WS_WSC), a.in[4], a.in[5], (LAS float*)((LAS unsigned char*)lds + RING_BYTES)};
        for (int rep_ = 0; rep_ < (DUP_PHASE == 1 ? 2 : 1); ++rep_)
        pg8::gemm_phase<pg8::EpiInProj, pg8::StaticOrder, true, true, true>((LAS unsigned char*)lds, g, S, E);
        { const int nwg_ = (T / 256) * (NPROJ / 256), G_ = (int)gridDim.x, rem_ = nwg_ % G_;
          if (rem_ > 0 && (int)blockIdx.x >= rem_) convert_tables(a, TAB_SPLIT, 2 * NEXP, ((int)blockIdx.x - rem_) * NWAVES + (tid_opaque() >> 6), (G_ - rem_) * NWAVES);
          else if (rem_ == 0) convert_tables(a, TAB_SPLIT, 2 * NEXP, (int)blockIdx.x * NWAVES + (tid_opaque() >> 6), G_ * NWAVES); }
        SEAM(1);
    }
    if (IN(3)) { LOAD_ARGS(); phase_attn(a, lds);
#if MK_ONE_LAUNCH
        if (DUP_PHASE == 3) { XcdBarrier xb_; xb_.bar = (unsigned*)(a.ws + WS_CTL) + CW_BAR; xb_.x = xb_xcc_id(); xb_.st = (volatile LAS unsigned*)((LAS unsigned char*)lds + MISC_OFF) + 8;
            xcd_barrier(xb_); if (blockIdx.x == 0 && threadIdx.x == 0) __hip_atomic_store((unsigned*)(a.ws + WS_CTL), 0u, __ATOMIC_RELAXED, __HIP_MEMORY_SCOPE_AGENT); xcd_barrier(xb_); phase_attn(a, lds); }
#endif
        SEAM(3); }
    if (IN(4)) { LOAD_ARGS(); phase_attn_combine(a); SEAM(4); }
    if (IN(5)) { LOAD_ARGS(); unsigned char* ws = a.ws;
        pg8::Gemm g{(const bf16_t*)(ws + WS_MIX), (const bf16_t*)(ws + WS_WOUT), T, DM, DM}; pg8::StaticOrder S; S.init(T, DM, (int)gridDim.x, (int)blockIdx.x);
        pg8::EpiOutProj E{a.in[0], a.out, (bf16_t*)(ws + WS_HB), (float*)(ws + WS_SSQ), (float*)(ws + WS_AMX)};
        for (int rep_ = 0; rep_ < (DUP_PHASE == 5 ? 2 : 1); ++rep_)
        pg8::gemm_phase<pg8::EpiOutProj, pg8::StaticOrder, true, true>((LAS unsigned char*)lds, g, S, E);
        SEAM(5);
    }
    if (IN(6)) { LOAD_ARGS(); unsigned char* ws = a.ws;
        pg8::Gemm g{(const bf16_t*)(ws + WS_HB), (const bf16_t*)(ws + WS_WPQ), T, DM, DM}; pg8::StaticOrder S; S.init(T, DM, (int)gridDim.x, (int)blockIdx.x);
        pg8::EpiPeerQFused E{(const float*)(ws + WS_SSQ), ws};
        pg8::gemm_phase<pg8::EpiPeerQFused, pg8::StaticOrder, true, true>((LAS unsigned char*)lds, g, S, E);
        SEAM(6);
    }
    if (IN(8)) { LOAD_ARGS(); for (int rep_ = 0; rep_ < (DUP_PHASE == 8 ? 2 : 1); ++rep_) phase_peer_u(a); SEAM(8); }
    if (IN(9)) { LOAD_ARGS(); for (int rep_ = 0; rep_ < (DUP_PHASE == 9 ? 2 : 1); ++rep_) phase_peer_w(a); SEAM(9); }
    if (IN(10)) { LOAD_ARGS(); for (int rep_ = 0; rep_ < (DUP_PHASE == 10 ? 2 : 1); ++rep_) phase_peer_v(a, (DUP_PHASE == 10 && rep_ == 0) ? (float*)(a.ws + WS_END) : a.out); }
#undef IN
#undef SEAM
}

extern "C" void kernel_launch(void* const* d_in, const int* in_sizes, int n_in, void* d_out, int out_size, void* d_ws, size_t ws_size, hipStream_t stream) {
    static int grid = 0;
    if (grid == 0) {
        if (n_in != 12 || in_sizes[0] != T * DM || out_size != T * DM || ws_size < WS_END) { fprintf(stderr, "kernel_launch: unexpected shapes (n_in %d, in0 %d, out %d, ws %zu)\n", n_in, n_in > 0 ? in_sizes[0] : -1, out_size, ws_size); grid = -1; return; }
        int dev = 0, cus = 0, per_cu = 0;
        if (hipGetDevice(&dev) != hipSuccess || hipDeviceGetAttribute(&cus, hipDeviceAttributeMultiprocessorCount, dev) != hipSuccess) { grid = -1; return; }
        if (hipFuncSetAttribute((const void*)fwd_kernel, hipFuncAttributeMaxDynamicSharedMemorySize, LDS_BYTES) != hipSuccess) { fprintf(stderr, "kernel_launch: hipFuncSetAttribute failed\n"); grid = -1; return; }
        if (hipOccupancyMaxActiveBlocksPerMultiprocessor(&per_cu, (const void*)fwd_kernel, NTHREADS, LDS_BYTES) != hipSuccess || per_cu < 1) { fprintf(stderr, "kernel_launch: occupancy query says %d\n", per_cu); grid = -1; return; }
        grid = cus;
    }
    if (grid < 0) return;
    (void)hipMemsetAsync((char*)d_ws + WS_CTL, 0, CTL_BYTES, stream);
    Args a{};
    for (int i = 0; i < 12; ++i) a.in[i] = (const float*)d_in[i];
    a.out = (float*)d_out; a.ws = (unsigned char*)d_ws;
#if MK_ONE_LAUNCH
    a.ph_lo = 0; a.ph_hi = NPHASE;
    void* args[] = {&a};
#if MK_COOP_LAUNCH
    hipError_t e = hipLaunchCooperativeKernel((const void*)fwd_kernel, dim3(grid), dim3(NTHREADS), args, LDS_BYTES, stream);
    if (e != hipSuccess) fprintf(stderr, "cooperative launch failed: %s (grid %d)\n", hipGetErrorString(e), grid);
#else
    (void)args; hipLaunchKernelGGL(fwd_kernel, dim3(grid), dim3(NTHREADS), LDS_BYTES, stream, a);
#endif
#else
    for (int p = 0; p < NPHASE; ++p) { a.ph_lo = p; a.ph_hi = p + 1; hipLaunchKernelGGL(fwd_kernel, dim3(grid), dim3(NTHREADS), LDS_BYTES, stream, a); }
#endif
}
```

```cpp
#include <hip/hip_runtime.h>
#include <hip/hip_cooperative_groups.h>
#include <cstdio>
#include <cstdint>
namespace cg = cooperative_groups;

#ifndef MK_COOP_LAUNCH
#define MK_COOP_LAUNCH 0
#endif
#ifndef MK_ONE_LAUNCH
#define MK_ONE_LAUNCH 1
#endif

#define LAS __attribute__((address_space(3)))
typedef unsigned short bf16_t;
typedef short bf16x8 __attribute__((ext_vector_type(8)));
typedef short s16x4 __attribute__((ext_vector_type(4)));
typedef float f32x2 __attribute__((ext_vector_type(2)));
typedef float f32x4 __attribute__((ext_vector_type(4)));
typedef float f32x16 __attribute__((ext_vector_type(16)));
typedef unsigned u32x2 __attribute__((ext_vector_type(2)));
typedef unsigned u32x4 __attribute__((ext_vector_type(4)));
typedef __bf16 bf16x2_t __attribute__((ext_vector_type(2)));

constexpr int NB = 2, SEQ = 4096, T = NB * SEQ, DM = 2048, HD = 128, NHF = 8, DIN = 7176, NPROJ = 7168;
constexpr int NEXP = 16384, NE = 128;
constexpr float EPS = 1e-6f;
constexpr float SCALE = 0.08838834764831845f, LOG2E = 1.4426950408889634f;
constexpr int NWAVES = 8, NTHREADS = 512;

constexpr size_t MiB = 1u << 20;
constexpr size_t WS_CTL = 0, CTL_BYTES = 32768;
constexpr int CW_BAR = 1024;
constexpr size_t WS_SXN = 64 * MiB  , WS_WSC = 45 * MiB + 800 * 1024  ;
constexpr int CW_WMAX = 64;
constexpr size_t WS_GQK = 45 * MiB + 768 * 1024;
constexpr size_t WS_WIN = 1 * MiB, WS_WOUT = 29 * MiB, WS_WPQ = 37 * MiB, WS_SK = 45 * MiB, WS_LOGF = 46 * MiB, WS_C = 46 * MiB + 512 * 1024, WS_SSQ = 47 * MiB;
constexpr size_t WS_XN = 48 * MiB;
constexpr size_t WS_SEC = 80 * MiB;
constexpr size_t SEC_ELEMS = 8u << 20;
constexpr size_t WS_MIX = 192 * MiB, WS_HB = 224 * MiB, WS_QP = 256 * MiB, WS_IDX = 288 * MiB, WS_GW = 292 * MiB, WS_U8 = 296 * MiB, WS_V8 = 328 * MiB, WS_SUV = 360 * MiB  , WS_RT = 360 * MiB + 256 * 1024  , WS_W = 361 * MiB  ,
                 WS_PART = 368 * MiB  , WS_XQ = 432 * MiB  , WS_END = 448 * MiB;
constexpr size_t WS_IDX16 = 366 * MiB  ;
constexpr size_t WS_AMX = 365 * MiB  , WS_SX = WS_RT + 64 * 1024  , WS_WQ = WS_W  , WS_SW = WS_W + 2 * MiB  ;
constexpr size_t WS_PO = WS_PART  , WS_PML = WS_PART + 32 * MiB  ;

constexpr int RING_BYTES = 131072;
constexpr int MISC_OFF = 143360;
constexpr int LDS_BYTES = 147456;

__device__ __forceinline__ unsigned cvt_pk_bf16(float lo, float hi) { unsigned r; asm volatile("v_cvt_pk_bf16_f32 %0, %1, %2" : "=v"(r) : "v"(lo), "v"(hi)); return r; }
__device__ __forceinline__ float bf_lo(unsigned u) { return __builtin_bit_cast(float, u << 16); }
__device__ __forceinline__ float bf_hi(unsigned u) { return __builtin_bit_cast(float, u & 0xffff0000u); }
__device__ __forceinline__ int lane_id_fresh() { int l = (int)__builtin_amdgcn_mbcnt_hi(~0u, __builtin_amdgcn_mbcnt_lo(~0u, 0u)); asm volatile("" : "+v"(l)); return l; }
__device__ __forceinline__ int sx_i(int v, int m) { return __builtin_amdgcn_ds_bpermute((lane_id_fresh() ^ m) << 2, v); }
__device__ __forceinline__ float sx_f(float v, int m) { return __int_as_float(__builtin_amdgcn_ds_bpermute((lane_id_fresh() ^ m) << 2, __float_as_int(v))); }
__device__ __forceinline__ int sh_i(int v, int src) { return __builtin_amdgcn_ds_bpermute(src << 2, v); }
__device__ __forceinline__ float sh_f(float v, int src) { return __int_as_float(__builtin_amdgcn_ds_bpermute(src << 2, __float_as_int(v))); }
__device__ __forceinline__ float shup_f(float v, int d) { const int l = lane_id_fresh(); const int s = l - d; return __int_as_float(__builtin_amdgcn_ds_bpermute((s < 0 ? l : s) << 2, __float_as_int(v))); }
__device__ __forceinline__ float wave_sum(float v) {
    v += __int_as_float(__builtin_amdgcn_update_dpp(0, __float_as_int(v), 0xB1, 0xf, 0xf, true));
    v += __int_as_float(__builtin_amdgcn_update_dpp(0, __float_as_int(v), 0x4E, 0xf, 0xf, true));
    v += __int_as_float(__builtin_amdgcn_update_dpp(0, __float_as_int(v), 0x141, 0xf, 0xf, true));
    v += __int_as_float(__builtin_amdgcn_update_dpp(0, __float_as_int(v), 0x140, 0xf, 0xf, true));
    { auto rr = __builtin_amdgcn_permlane16_swap(__float_as_uint(v), __float_as_uint(v), false, false); v = __uint_as_float(rr[0]) + __uint_as_float(rr[1]); }
    { auto rr = __builtin_amdgcn_permlane32_swap(__float_as_uint(v), __float_as_uint(v), false, false); v = __uint_as_float(rr[0]) + __uint_as_float(rr[1]); }
    return v;
}
#define DPP_QX1 0xB1
#define DPP_QX2 0x4E
#define DPP_HMIR 0x141
#define DPP_MIR 0x140
__device__ __forceinline__ float wave_max(float v) {
    v = fmaxf(v, __int_as_float(__builtin_amdgcn_update_dpp(0, __float_as_int(v), DPP_QX1, 0xf, 0xf, true)));
    v = fmaxf(v, __int_as_float(__builtin_amdgcn_update_dpp(0, __float_as_int(v), DPP_QX2, 0xf, 0xf, true)));
    v = fmaxf(v, __int_as_float(__builtin_amdgcn_update_dpp(0, __float_as_int(v), DPP_HMIR, 0xf, 0xf, true)));
    v = fmaxf(v, __int_as_float(__builtin_amdgcn_update_dpp(0, __float_as_int(v), DPP_MIR, 0xf, 0xf, true)));
    { auto rr = __builtin_amdgcn_permlane16_swap(__float_as_uint(v), __float_as_uint(v), false, false); v = fmaxf(__uint_as_float(rr[0]), __uint_as_float(rr[1])); }
    { auto rr = __builtin_amdgcn_permlane32_swap(__float_as_uint(v), __float_as_uint(v), false, false); v = fmaxf(__uint_as_float(rr[0]), __uint_as_float(rr[1])); }
    return v;
}
__device__ __forceinline__ int tid_opaque() { int t = (int)threadIdx.x; asm volatile("" : "+v"(t)); return t; }
#define LDS_WAIT() asm volatile("s_waitcnt lgkmcnt(0)" ::: "memory")

namespace pg8 {
#define PG8_LAS __attribute__((address_space(3)))
constexpr int BM = 256, BK = 64, HALF = 128, HTB = HALF * BK * 2, STAGE_BYTES = 8 * HTB, NXCD = 8, WGM = 8;
__host__ __device__ __forceinline__ int lds_byte(int r, int c) { const int st = (r >> 4) * 2 + (c >> 5), rr = r & 15, cc = c & 31, ob = rr * 64 + cc * 2; return st * 1024 + (ob ^ (((ob >> 9) & 1) << 5)); }
__host__ __device__ __forceinline__ void stage_rc(int b, int& R, int& C) { const int st = b / 1024, sb = b % 1024, swz = sb ^ (((sb >> 9) & 1) << 5); R = (st >> 1) * 16 + swz / 64; C = (st & 1) * 32 + (swz % 64) / 2; }
__host__ __device__ __forceinline__ int perm32(int rho) { const int n = rho >> 4, i = rho & 15; return 8 * (i >> 2) + 4 * n + (i & 3); }
struct Unit { int pm, pn; };
struct Gemm { const bf16_t* A; const bf16_t* Bt; int M, N, K; };
struct StaticOrder {
    int nM, nN, nwg, G, c;
    __host__ __device__ void init(int M, int N, int G_, int c_) { nM = M / BM; nN = N / BM; nwg = nM * nN; G = G_; c = c_; }
    __host__ __device__ bool next(int i, Unit& u) const {
        const long L = (long)i * G + c; if (L >= nwg) return false;
        int wgid = (int)L; { const int q = nwg / NXCD, r = nwg % NXCD, xcd = wgid % NXCD, off = wgid / NXCD; wgid = (xcd < r ? xcd * (q + 1) : r * (q + 1) + (xcd - r) * q) + off; }
        const int nig = WGM * nN, gid = wgid / nig, fm = gid * WGM, gsz = (nM - fm) < WGM ? (nM - fm) : WGM;
        u.pm = fm + ((wgid % nig) % gsz); u.pn = (wgid % nig) / gsz; return true;
    }
    __device__ __forceinline__ void a_ready(const Unit&) const {}
    __device__ __forceinline__ void done(const Unit&) const {}
};

typedef int i32x4 __attribute__((ext_vector_type(4)));
template <bool I8> struct AccT { typedef f32x4 type; };
template <> struct AccT<true> { typedef i32x4 type; };
template <class Epi, class Sched, bool ALIGN_EPI = false, bool SP2 = false, bool I8 = false>
__device__ __forceinline__ void gemm_phase(PG8_LAS unsigned char* lds, const Gemm g, const Sched& S, const Epi& E) {
    typedef typename AccT<I8>::type acc_t;
    const int tid = tid_opaque(), wid = __builtin_amdgcn_readfirstlane(tid >> 6), lane = tid & 63, wr = wid >> 2, wc = wid & 3, fr = lane & 15, fq = lane >> 4;
    const int rowb = I8 ? g.K : 2 * g.K, nt = rowb / (BK * 2);
    unsigned voffA[2], voffB[2];
#pragma unroll
    for (int i = 0; i < 2; ++i) { int R, C; stage_rc(tid * 16 + i * 8192, R, C); const int Rb = Epi::PERM ? ((R & ~31) + perm32(R & 31)) : R;
        voffA[i] = (unsigned)(R * rowb + C * 2); voffB[i] = (unsigned)(Rb * rowb + C * 2); }
    const size_t kstep = (size_t)(BK * 2);
    const size_t hstep = (size_t)HALF * rowb;
    const size_t tstep = 2 * hstep;
    const unsigned ldsw = (unsigned)wid * 1024u;
    const int aoff = lds_byte(wr * 64 + fr, fq * 8), boff = lds_byte(wc * 32 + fr, fq * 8);
#define PG8_SA(b, h) (((b) * 2 + (h)) * HTB)
#define PG8_SB(b, h) ((4 + (b) * 2 + (h)) * HTB)
#define PG8_STAGE(bufoff, gbase, voff) do { _Pragma("unroll") for (int _i = 0; _i < 2; ++_i) \
        __builtin_amdgcn_global_load_lds((const unsigned*)((const char*)(gbase) + (voff)[_i]), (PG8_LAS unsigned*)(lds + (bufoff) + ldsw + _i * 8192), 16, 0, 0); } while (0)
#define PG8_LDA(dst, b, h) do { _Pragma("unroll") for (int m = 0; m < 4; ++m) _Pragma("unroll") for (int k = 0; k < 2; ++k) dst[m][k] = *(const PG8_LAS bf16x8*)(lds + PG8_SA(b, h) + aoff + m * 2048 + k * 1024); } while (0)
#define PG8_LDB(dst, b, h) do { _Pragma("unroll") for (int n = 0; n < 2; ++n) _Pragma("unroll") for (int k = 0; k < 2; ++k) dst[n][k] = *(const PG8_LAS bf16x8*)(lds + PG8_SB(b, h) + boff + n * 2048 + k * 1024); } while (0)
#define PG8_MMA(ai, bj, At, Bt) do { __builtin_amdgcn_s_setprio(1); _Pragma("unroll") for (int m = 0; m < 4; ++m) _Pragma("unroll") for (int n = 0; n < 2; ++n) _Pragma("unroll") for (int k = 0; k < 2; ++k) \
        { if constexpr (I8) acc[ai][bj][m][n] = __builtin_amdgcn_mfma_i32_16x16x64_i8(__builtin_bit_cast(i32x4, Bt[n][k]), __builtin_bit_cast(i32x4, At[m][k]), acc[ai][bj][m][n], 0, 0, 0); \
          else acc[ai][bj][m][n] = __builtin_amdgcn_mfma_f32_16x16x32_bf16(Bt[n][k], At[m][k], acc[ai][bj][m][n], 0, 0, 0); } __builtin_amdgcn_s_setprio(0); } while (0)
#define PG8_WAIT_V(n) asm volatile("s_waitcnt vmcnt(" #n ")" ::: "memory")
#define PG8_WAIT_L(n) asm volatile("s_waitcnt lgkmcnt(" #n ")" ::: "memory")
#define PG8_BAR __builtin_amdgcn_s_barrier()
#define PG8_SCHED __builtin_amdgcn_sched_barrier(0)
    Unit cur, nxt; int ui = 0;
    if (!S.next(0, cur)) return;
    acc_t acc[2][2][4][2];
#pragma unroll
    for (int a = 0; a < 2; ++a)
#pragma unroll
        for (int b = 0; b < 2; ++b)
#pragma unroll
            for (int m = 0; m < 4; ++m)
#pragma unroll
                for (int n = 0; n < 2; ++n) acc[a][b][m][n] = acc_t{};
    bf16x8 At[4][2], B0[2][2], B1[2][2];
    const char* cA = (const char*)g.A + (size_t)cur.pm * tstep; const char* cB = (const char*)g.Bt + (size_t)cur.pn * tstep;
    S.a_ready(cur);
    if constexpr (SP2) {
        PG8_STAGE(PG8_SB(0, 0), cB, voffB); PG8_STAGE(PG8_SB(0, 1), cB + hstep, voffB); PG8_STAGE(PG8_SA(0, 0), cA, voffA); PG8_STAGE(PG8_SA(0, 1), cA + hstep, voffA);
        if (wr == 1) PG8_BAR;
        PG8_WAIT_V(2); PG8_BAR;
        PG8_STAGE(PG8_SB(1, 0), cB + kstep, voffB); PG8_STAGE(PG8_SA(1, 0), cA + kstep, voffA); PG8_STAGE(PG8_SB(1, 1), cB + hstep + kstep, voffB);
        PG8_WAIT_V(6); PG8_BAR;
    } else {
        PG8_STAGE(PG8_SB(0, 0), cB, voffB); PG8_STAGE(PG8_SA(0, 0), cA, voffA); PG8_STAGE(PG8_SB(0, 1), cB + hstep, voffB); PG8_STAGE(PG8_SA(0, 1), cA + hstep, voffA);
        if (wr == 1) PG8_BAR;
        PG8_WAIT_V(4); PG8_BAR;
        PG8_STAGE(PG8_SB(1, 0), cB + kstep, voffB); PG8_STAGE(PG8_SA(1, 0), cA + kstep, voffA); PG8_STAGE(PG8_SB(1, 1), cB + hstep + kstep, voffB);
        PG8_WAIT_V(6); PG8_BAR;
    }
    for (;;) {
        const bool has_next = S.next(ui + 1, nxt);
        const char* nA = has_next ? (const char*)g.A + (size_t)nxt.pm * tstep : cA; const char* nB = has_next ? (const char*)g.Bt + (size_t)nxt.pn * tstep : cB;
        for (int t = 0; t < nt; t += 2) {
            const bool last = (t == nt - 2);
            const char* a1 = cA + (size_t)(t + 1) * kstep;
            const char* a2 = last ? nA : cA + (size_t)(t + 2) * kstep; const char* b2 = last ? nB : cB + (size_t)(t + 2) * kstep;
            const char* a3 = a2 + kstep; const char* b3 = b2 + kstep;
            if (last && has_next) S.a_ready(nxt);
            if constexpr (SP2) {
            PG8_LDB(B0, 0, 0); PG8_LDB(B1, 0, 1); PG8_SCHED; PG8_LDA(At, 0, 0); PG8_STAGE(PG8_SA(1, 1), a1 + hstep, voffA);
            PG8_WAIT_V(8); PG8_WAIT_L(0); PG8_BAR; PG8_MMA(0, 0, At, B0); PG8_MMA(0, 1, At, B1); PG8_BAR; PG8_SCHED;
            PG8_LDA(At, 0, 1); PG8_STAGE(PG8_SB(0, 0), b2, voffB); PG8_STAGE(PG8_SB(0, 1), b2 + hstep, voffB); PG8_STAGE(PG8_SA(0, 0), a2, voffA);
            PG8_WAIT_V(8); PG8_WAIT_L(0); PG8_BAR; PG8_MMA(1, 0, At, B0); PG8_MMA(1, 1, At, B1); PG8_BAR; PG8_SCHED;
            PG8_LDB(B0, 1, 0); PG8_LDB(B1, 1, 1); PG8_SCHED; PG8_LDA(At, 1, 0); PG8_STAGE(PG8_SA(0, 1), a2 + hstep, voffA);
            PG8_WAIT_V(8); PG8_WAIT_L(0); PG8_BAR; PG8_MMA(0, 0, At, B0); PG8_MMA(0, 1, At, B1); PG8_BAR; PG8_SCHED;
            PG8_LDA(At, 1, 1); PG8_STAGE(PG8_SB(1, 0), b3, voffB); PG8_STAGE(PG8_SB(1, 1), b3 + hstep, voffB); PG8_STAGE(PG8_SA(1, 0), a3, voffA);
            PG8_WAIT_V(8); PG8_WAIT_L(0); PG8_BAR; PG8_MMA(1, 0, At, B0); PG8_MMA(1, 1, At, B1); PG8_BAR; PG8_SCHED;
            } else {
            PG8_LDB(B0, 0, 0); PG8_SCHED; PG8_LDA(At, 0, 0); PG8_STAGE(PG8_SA(1, 1), a1 + hstep, voffA);
            PG8_WAIT_L(8); PG8_BAR; PG8_WAIT_L(0); PG8_MMA(0, 0, At, B0); PG8_BAR; PG8_SCHED;
            PG8_LDB(B1, 0, 1); PG8_STAGE(PG8_SB(0, 0), b2, voffB);
            PG8_BAR; PG8_WAIT_L(0); PG8_MMA(0, 1, At, B1); PG8_BAR;
            PG8_LDA(At, 0, 1); PG8_STAGE(PG8_SA(0, 0), a2, voffA);
            PG8_BAR; PG8_WAIT_L(0); PG8_MMA(1, 0, At, B0); PG8_BAR; PG8_SCHED;
            PG8_STAGE(PG8_SB(0, 1), b2 + hstep, voffB);
            PG8_WAIT_V(6); PG8_BAR; PG8_MMA(1, 1, At, B1); PG8_BAR;
            PG8_LDB(B0, 1, 0); PG8_SCHED; PG8_LDA(At, 1, 0); PG8_STAGE(PG8_SA(0, 1), a2 + hstep, voffA);
            PG8_WAIT_L(8); PG8_BAR; PG8_WAIT_L(0); PG8_MMA(0, 0, At, B0); PG8_BAR; PG8_SCHED;
            PG8_LDB(B1, 1, 1); PG8_STAGE(PG8_SB(1, 0), b3, voffB);
            PG8_BAR; PG8_WAIT_L(0); PG8_MMA(0, 1, At, B1); PG8_BAR;
            PG8_LDA(At, 1, 1); PG8_STAGE(PG8_SA(1, 0), a3, voffA);
            PG8_BAR; PG8_WAIT_L(0); PG8_MMA(1, 0, At, B0); PG8_BAR; PG8_SCHED;
            PG8_STAGE(PG8_SB(1, 1), b3 + hstep, voffB);
            PG8_WAIT_V(6); PG8_BAR; PG8_MMA(1, 1, At, B1); PG8_BAR;
            }
        }
        if constexpr (ALIGN_EPI) { if (wr == 0) PG8_BAR; }
        if constexpr (!Epi::AFTER_DRAIN) { E(acc, cur, wr, wc, fr, fq); } S.done(cur);
        if (!has_next) break;
#pragma unroll
        for (int a = 0; a < 2; ++a)
#pragma unroll
            for (int b = 0; b < 2; ++b)
#pragma unroll
                for (int m = 0; m < 4; ++m)
#pragma unroll
                    for (int n = 0; n < 2; ++n) acc[a][b][m][n] = acc_t{};
        cur = nxt; cA = nA; cB = nB; ++ui;
        if constexpr (ALIGN_EPI) { if (wr == 1) PG8_BAR; }
    }
    PG8_WAIT_V(0);
    if constexpr (!ALIGN_EPI) { if (wr == 0) PG8_BAR; }
    PG8_BAR;
    if constexpr (Epi::AFTER_DRAIN) E.fused(acc, cur, wr, wc, fr, fq, lds);
#undef PG8_SA
#undef PG8_SB
#undef PG8_STAGE
#undef PG8_LDA
#undef PG8_LDB
#undef PG8_MMA
#undef PG8_WAIT_V
#undef PG8_WAIT_L
#undef PG8_BAR
#undef PG8_SCHED
}

__device__ __forceinline__ float sigmoidf_fast(float x) { return __builtin_amdgcn_rcpf(1.f + __builtin_amdgcn_exp2f(-x * LOG2E)); }
struct EpiInProj {
    static constexpr bool PERM = true, AFTER_DRAIN = false;
    bf16_t* base; const float* sxn  ; const float* wsc  ;
    const float* gq; const float* gk; PG8_LAS float* xch  ;
    __device__ __forceinline__ void operator()(const i32x4 (&acci)[2][2][4][2], const Unit& u, int wr, int wc, int fr, int fq) const {
        const int sec = u.pn >> 2; const float wsv = *wsc;
        bf16_t* sb = base + (size_t)sec * SEC_ELEMS;
        const float sc = (sec == 4) ? SCALE * LOG2E : 1.f;
        if (sec < 2) {
#pragma unroll
            for (int ai = 0; ai < 2; ++ai)
#pragma unroll
                for (int m = 0; m < 4; ++m) {
                    const int tk = u.pm * BM + ai * HALF + wr * 64 + m * 16 + fr;
                    const float rs = sxn[tk] * wsv;
#pragma unroll
                    for (int bj = 0; bj < 2; ++bj) {
                        const f32x4 v0 = __builtin_convertvector(acci[ai][bj][m][0], f32x4) * rs, v1 = __builtin_convertvector(acci[ai][bj][m][1], f32x4) * rs;
                        float ss = v0[0] * v0[0] + v0[1] * v0[1] + v0[2] * v0[2] + v0[3] * v0[3] + v1[0] * v1[0] + v1[1] * v1[1] + v1[2] * v1[2] + v1[3] * v1[3];
                        ss += sx_f(ss, 16); ss += sx_f(ss, 32);
                        if (fq == 0) xch[(((((wr * 2 + ai) * 4 + m) * 16 + fr) * 2 + bj) * 4) + wc] = ss;
                    }
                }
            asm volatile("s_waitcnt lgkmcnt(0)" ::: "memory");
            __builtin_amdgcn_s_barrier();
            const float* gp = (sec == 0 ? gq : gk) + wc * 32 + 8 * fq;
            const f32x4 g0 = *(const f32x4*)gp, g1 = *(const f32x4*)(gp + 4);
#pragma unroll
            for (int ai = 0; ai < 2; ++ai)
#pragma unroll
                for (int m = 0; m < 4; ++m) {
                    const int tk = u.pm * BM + ai * HALF + wr * 64 + m * 16 + fr, b = tk >> 12, s = tk & 4095;
                    const float rs = sxn[tk] * wsv;
#pragma unroll
                    for (int bj = 0; bj < 2; ++bj) {
                        const int hh = (u.pn & 3) * 2 + bj;
                        const f32x4 p4 = *(const PG8_LAS f32x4*)(xch + (((((wr * 2 + ai) * 4 + m) * 16 + fr) * 2 + bj) * 4));
                        const float r = rs / sqrtf(((p4[0] + p4[1]) + (p4[2] + p4[3])) * (1.f / 128.f) + EPS);
                        const f32x4 v0 = __builtin_convertvector(acci[ai][bj][m][0], f32x4) * r * g0, v1 = __builtin_convertvector(acci[ai][bj][m][1], f32x4) * r * g1;
                        u32x4 w; w.x = cvt_pk_bf16(v0[0], v0[1]); w.y = cvt_pk_bf16(v0[2], v0[3]); w.z = cvt_pk_bf16(v1[0], v1[1]); w.w = cvt_pk_bf16(v1[2], v1[3]);
                        *(u32x4*)(sb + ((size_t)((b * 8 + hh) * 4096 + s)) * 128 + wc * 32 + 8 * fq) = w;
                    }
                }
            return;
        }
#pragma unroll
        for (int ai = 0; ai < 2; ++ai)
#pragma unroll
            for (int m = 0; m < 4; ++m) {
                const int tk = u.pm * BM + ai * HALF + wr * 64 + m * 16 + fr, b = tk >> 12, s = tk & 4095;
                const float rs = sxn[tk] * wsv;
#pragma unroll
                for (int bj = 0; bj < 2; ++bj) {
                    const int hh = (u.pn & 3) * 2 + bj;
                    f32x4 v0 = __builtin_convertvector(acci[ai][bj][m][0], f32x4) * rs, v1 = __builtin_convertvector(acci[ai][bj][m][1], f32x4) * rs;
                    bf16_t* dst;
                    if (sec == 3) {
#pragma unroll
                        for (int i = 0; i < 4; ++i) { v0[i] = sigmoidf_fast(v0[i]); v1[i] = sigmoidf_fast(v1[i]); }
                        dst = sb + (size_t)tk * 1024 + hh * 128 + wc * 32 + 8 * fq;
                    } else {
                        v0 = v0 * sc; v1 = v1 * sc;
                        dst = sb + ((size_t)((b * 8 + hh) * 4096 + s)) * 128 + wc * 32 + 8 * fq;
                    }
                    u32x4 w; w.x = cvt_pk_bf16(v0[0], v0[1]); w.y = cvt_pk_bf16(v0[2], v0[3]); w.z = cvt_pk_bf16(v1[0], v1[1]); w.w = cvt_pk_bf16(v1[2], v1[3]);
                    *(u32x4*)dst = w;
                }
            }
    }
};
struct EpiOutProj {
    static constexpr bool PERM = true, AFTER_DRAIN = false;
    const float* x; float* h; bf16_t* hb; float* ssq; float* amx;
    __device__ __forceinline__ void operator()(const f32x4 (&acc)[2][2][4][2], const Unit& u, int wr, int wc, int fr, int fq) const {
#pragma unroll
        for (int ai = 0; ai < 2; ++ai)
#pragma unroll
            for (int m = 0; m < 4; ++m) {
                const int tk = u.pm * BM + ai * HALF + wr * 64 + m * 16 + fr;
                float ss = 0.f, mx = 0.f;
#pragma unroll
                for (int bj = 0; bj < 2; ++bj) {
                    const size_t off = (size_t)tk * DM + u.pn * BM + bj * HALF + wc * 32 + 8 * fq;
                    const f32x4 x0 = *(const f32x4*)(x + off), x1 = *(const f32x4*)(x + off + 4);
                    const f32x4 v0 = acc[ai][bj][m][0] + x0, v1 = acc[ai][bj][m][1] + x1;
                    u32x4 w; w.x = cvt_pk_bf16(v0[0], v0[1]); w.y = cvt_pk_bf16(v0[2], v0[3]); w.z = cvt_pk_bf16(v1[0], v1[1]); w.w = cvt_pk_bf16(v1[2], v1[3]);
                    *(u32x4*)(hb + off) = w;
                    ss += v0[0] * v0[0] + v0[1] * v0[1] + v0[2] * v0[2] + v0[3] * v0[3] + v1[0] * v1[0] + v1[1] * v1[1] + v1[2] * v1[2] + v1[3] * v1[3];
                    mx = fmaxf(mx, fmaxf(fmaxf(fmaxf(fabsf(v0[0]), fabsf(v0[1])), fmaxf(fabsf(v0[2]), fabsf(v0[3]))), fmaxf(fmaxf(fabsf(v1[0]), fabsf(v1[1])), fmaxf(fabsf(v1[2]), fabsf(v1[3])))));
                }
                ss += sx_f(ss, 16); ss += sx_f(ss, 32);
                mx = fmaxf(mx, sx_f(mx, 16)); mx = fmaxf(mx, sx_f(mx, 32));
                if (fq == 0) { ssq[(size_t)tk * 32 + u.pn * 4 + wc] = ss; amx[(size_t)tk * 32 + u.pn * 4 + wc] = mx; }
            }
    }
};
struct EpiPeerQ {
    static constexpr bool PERM = true, AFTER_DRAIN = false;
    const float* ssq; bf16_t* qp; float* rtab;
    __device__ __forceinline__ void operator()(const f32x4 (&acc)[2][2][4][2], const Unit& u, int wr, int wc, int fr, int fq) const {
#pragma unroll
        for (int ai = 0; ai < 2; ++ai)
#pragma unroll
            for (int m = 0; m < 4; ++m) {
                const int tk = u.pm * BM + ai * HALF + wr * 64 + m * 16 + fr;
                float tot = 0.f;
#pragma unroll
                for (int i = 0; i < 8; ++i) { const f32x4 s4 = *(const f32x4*)(ssq + (size_t)tk * 32 + 4 * i); tot += (s4[0] + s4[1]) + (s4[2] + s4[3]); }
                const float r = 1.0f / sqrtf(tot * (1.f / DM) + EPS);
                if (u.pn == 0 && wc == 0 && fq == 0) rtab[tk] = r;
#pragma unroll
                for (int bj = 0; bj < 2; ++bj) {
                    const size_t off = (size_t)tk * DM + u.pn * BM + bj * HALF + wc * 32 + 8 * fq;
                    const f32x4 v0 = acc[ai][bj][m][0] * r, v1 = acc[ai][bj][m][1] * r;
                    u32x4 w; w.x = cvt_pk_bf16(v0[0], v0[1]); w.y = cvt_pk_bf16(v0[2], v0[3]); w.z = cvt_pk_bf16(v1[0], v1[1]); w.w = cvt_pk_bf16(v1[2], v1[3]);
                    *(u32x4*)(qp + off) = w;
                }
            }
    }
};
struct EpiPeerQFused {
    static constexpr bool PERM = true, AFTER_DRAIN = true;
    const float* ssq; unsigned char* wsb;
    __device__ __forceinline__ void operator()(const f32x4 (&)[2][2][4][2], const Unit&, int, int, int, int) const {}
    __device__ __forceinline__ void fused(const f32x4 (&acc)[2][2][4][2], const Unit& u, int wr, int wc, int fr, int fq, PG8_LAS unsigned char* lds) const;
};
}

namespace att {
constexpr int NW = 8, QBLK = 32, KVBLK = 64, QB = NW * QBLK, D = 128;
constexpr int SHM_V = KVBLK * D * 2, SHM_K = KVBLK * D * 2;
constexpr int OFF_WS = 2 * SHM_V + 2 * SHM_K, OFF_BIAS = OFF_WS + NW * 64 * 4, ATT_LDS = OFF_BIAS + SEQ * 4;
#define KSWZ(row, colB) ((row) * 256 + ((colB) ^ (((row) & 7) << 4)))
#define SBAR() __builtin_amdgcn_sched_barrier(0)
__device__ __forceinline__ int v_st(int k, int c) { const int kk = (k & ~0xC) | ((k & 4) << 1) | ((k & 8) >> 1); return ((kk >> 3) * 4 + (c >> 5)) * 512 + ((kk & 7) * 32 + (c & 31)) * 2; }
__device__ __forceinline__ int v_rd_base(int lane) { return ((lane & 3) << 3) | (((lane >> 2) & 3) << 6) | (((lane >> 4) & 1) << 5) | (((lane >> 5) & 1) << 8); }
constexpr int v_rd_off(int d0, int ks, int half) { return d0 * 512 + ks * 4096 + half * 2048; }
__device__ __forceinline__ int crow(int r, int hi) { return (r & 3) + 8 * (r >> 2) + 4 * hi; }
__device__ __forceinline__ bf16x8 load8(const bf16_t* p) { return *reinterpret_cast<const bf16x8*>(p); }
__device__ __forceinline__ void mask_tile(f32x16& p0, f32x16& p1, int dq) {
    const float NEG = -__builtin_inff();
#pragma unroll
    for (int r = 0; r < 16; ++r) {
        const int c = (r & 3) + 8 * (r >> 2);
        if (dq - c < 0) p0[r] = NEG;
        if (dq - c - 32 < 0) p1[r] = NEG;
    }
}
__device__ __forceinline__ void partialSM(f32x16& p0, f32x16& p1, float& m_reg, float& mn, float& alpha) {
    float pmax = p0[0];
#pragma unroll
    for (int r = 1; r < 16; ++r) pmax = fmaxf(pmax, p0[r]);
#pragma unroll
    for (int r = 0; r < 16; ++r) pmax = fmaxf(pmax, p1[r]);
    { auto rr = __builtin_amdgcn_permlane32_swap(__float_as_uint(pmax), __float_as_uint(pmax), false, false);
      pmax = fmaxf(__uint_as_float(rr[0]), __uint_as_float(rr[1])); }
    constexpr float C2 = LOG2E * SCALE; constexpr float THR = 8.f;
    if (__builtin_expect(__all((pmax - m_reg) * SCALE <= THR), 1)) { mn = m_reg; alpha = 1.f; }
    else { mn = fmaxf(m_reg, pmax); alpha = __builtin_amdgcn_exp2f((m_reg - mn) * C2); m_reg = mn; }
    const float mnL = -mn * C2;
#pragma unroll
    for (int r = 0; r < 16; ++r) p0[r] = fmaf(p0[r], C2, mnL);
#pragma unroll
    for (int r = 0; r < 16; ++r) p1[r] = fmaf(p1[r], C2, mnL);
#pragma unroll
    for (int r = 0; r < 16; ++r) p0[r] = __builtin_amdgcn_exp2f(p0[r]);
}
#define PK4(P, B_, OUT) do { unsigned a0 = cvt_pk_bf16(P[B_+0], P[B_+1]), a1 = cvt_pk_bf16(P[B_+2], P[B_+3]);                          \
        unsigned b0 = cvt_pk_bf16(P[B_+4], P[B_+5]), b1 = cvt_pk_bf16(P[B_+6], P[B_+7]);                                             \
        auto r0 = __builtin_amdgcn_permlane32_swap(a0, b0, false, false); auto r1 = __builtin_amdgcn_permlane32_swap(a1, b1, false, false); \
        u32x4 w = {r0[0], r1[0], r0[1], r1[1]}; OUT = *reinterpret_cast<bf16x8*>(&w); } while (0)
__device__ __forceinline__ void finishSM(f32x16& p0, f32x16& p1, float alpha, float& l_reg, bf16x8& pa0, bf16x8& pa1, bf16x8& pa2, bf16x8& pa3) {
#pragma unroll
    for (int r = 0; r < 16; ++r) p1[r] = __builtin_amdgcn_exp2f(p1[r]);
    float ps = 0;
#pragma unroll
    for (int r = 0; r < 16; ++r) ps += p0[r];
#pragma unroll
    for (int r = 0; r < 16; ++r) ps += p1[r];
    { auto rr = __builtin_amdgcn_permlane32_swap(__float_as_uint(ps), __float_as_uint(ps), false, false);
      ps = __uint_as_float(rr[0]) + __uint_as_float(rr[1]); }
    l_reg = l_reg * alpha + ps;
    PK4(p0, 0, pa0); PK4(p0, 8, pa1); PK4(p1, 0, pa2); PK4(p1, 8, pa3);
}
__device__ __forceinline__ void sb_group(f32x16& P, int g, float& gs) {
    float run = 0.f;
#pragma unroll
    for (int k = 3; k >= 0; --k) {
        const float z = P[4 * g + k];
        const float t = __builtin_amdgcn_exp2f(-fabsf(z));
        const float l = __builtin_amdgcn_logf(1.f + t);
        const float sp = fmaxf(z, 0.f) + l;
        P[4 * g + k] = (z - sp) - run;
        run += sp;
    }
    gs = run;
}
__device__ __forceinline__ void sb_part1(f32x16& p0, f32x16& p1, float& carry, float mlo) {
    float gs[8];
#pragma unroll
    for (int g = 0; g < 4; ++g) sb_group(p0, g, gs[g]);
#pragma unroll
    for (int g = 0; g < 4; ++g) sb_group(p1, g, gs[4 + g]);
    float run = carry;
#pragma unroll
    for (int G = 7; G >= 0; --G) {
        auto rr = __builtin_amdgcn_permlane32_swap(__float_as_uint(gs[G]), __float_as_uint(gs[G]), false, false);
        const float slo = __uint_as_float(rr[0]), shi = __uint_as_float(rr[1]);
        const float base = fmaf(mlo, shi, run);
        if (G >= 4) {
#pragma unroll
            for (int k = 0; k < 4; ++k) p1[4 * (G - 4) + k] -= base;
        } else {
#pragma unroll
            for (int k = 0; k < 4; ++k) p0[4 * G + k] -= base;
        }
        run += slo + shi;
    }
    carry = run;
#pragma unroll
    for (int r = 0; r < 16; ++r) p0[r] = __builtin_amdgcn_exp2f(p0[r]);
}
__device__ __forceinline__ void sb_part2(f32x16& p0, f32x16& p1, bf16x8& pa0, bf16x8& pa1, bf16x8& pa2, bf16x8& pa3) {
#pragma unroll
    for (int r = 0; r < 16; ++r) p1[r] = __builtin_amdgcn_exp2f(p1[r]);
    PK4(p0, 0, pa0); PK4(p0, 8, pa1); PK4(p1, 0, pa2); PK4(p1, 8, pa3);
}
#undef PK4
template <int KB, bool BIAS>
__device__ __forceinline__ void qkt(f32x16& p0, f32x16& p1, const char* K_lds, int r32, int hi, const bf16x8* qr, const float* bt) {
    if constexpr (BIAS) {
#pragma unroll
        for (int g = 0; g < 4; ++g) { const f32x4 a = *(const f32x4*)(bt + 8 * g), b = *(const f32x4*)(bt + 32 + 8 * g);
            p0[4 * g] = a[0]; p0[4 * g + 1] = a[1]; p0[4 * g + 2] = a[2]; p0[4 * g + 3] = a[3];
            p1[4 * g] = b[0]; p1[4 * g + 1] = b[1]; p1[4 * g + 2] = b[2]; p1[4 * g + 3] = b[3]; }
    } else { p0 = f32x16{}; p1 = f32x16{}; }
    const char* kb[4];
#pragma unroll
    for (int dd = 0; dd < 4; ++dd) kb[dd] = K_lds + KB * SHM_K + KSWZ(r32, (dd * 16 + hi * 8) * 2);
#pragma unroll
    for (int d0 = 0; d0 < 8; ++d0) { const char* a = kb[d0 & 3] + (d0 >> 2) * 128;
        bf16x8 b0 = *reinterpret_cast<const bf16x8*>(a);
        bf16x8 b1 = *reinterpret_cast<const bf16x8*>(a + 32 * 256);
        p0 = __builtin_amdgcn_mfma_f32_32x32x16_bf16(b0, qr[d0], p0, 0, 0, 0);
        p1 = __builtin_amdgcn_mfma_f32_32x32x16_bf16(b1, qr[d0], p1, 0, 0, 0); }
}
template <int VB>
__device__ __forceinline__ void pv_tile(f32x16* o, int vb0, bf16x8 pa0, bf16x8 pa1, bf16x8 pa2, bf16x8 pa3) {
#define TRRD(dst, off) asm volatile("ds_read_b64_tr_b16 %0, %1 offset:%2" : "=&v"(dst) : "v"(vb0), "i"(off) : "memory")
#define PV_D0(d0) do { { s16x4 l0, l1, h0, h1; constexpr int b_ = VB * SHM_V + v_rd_off(d0, 0, 0); \
        TRRD(l0, b_); TRRD(h0, b_ + 2048); TRRD(l1, b_ + 4096); TRRD(h1, b_ + 6144); \
        asm volatile("s_waitcnt lgkmcnt(0)" ::: "memory"); SBAR();   \
        o[d0] = __builtin_amdgcn_mfma_f32_32x32x16_bf16(pa0, (bf16x8){l0[0], l0[1], l0[2], l0[3], h0[0], h0[1], h0[2], h0[3]}, o[d0], 0, 0, 0);   \
        o[d0] = __builtin_amdgcn_mfma_f32_32x32x16_bf16(pa1, (bf16x8){l1[0], l1[1], l1[2], l1[3], h1[0], h1[1], h1[2], h1[3]}, o[d0], 0, 0, 0); }  \
      { s16x4 l2, l3, h2, h3; constexpr int b_ = VB * SHM_V + v_rd_off(d0, 0, 0); \
        TRRD(l2, b_ + 8192); TRRD(h2, b_ + 10240); TRRD(l3, b_ + 12288); TRRD(h3, b_ + 14336); \
        asm volatile("s_waitcnt lgkmcnt(0)" ::: "memory"); SBAR();   \
        o[d0] = __builtin_amdgcn_mfma_f32_32x32x16_bf16(pa2, (bf16x8){l2[0], l2[1], l2[2], l2[3], h2[0], h2[1], h2[2], h2[3]}, o[d0], 0, 0, 0);   \
        o[d0] = __builtin_amdgcn_mfma_f32_32x32x16_bf16(pa3, (bf16x8){l3[0], l3[1], l3[2], l3[3], h3[0], h3[1], h3[2], h3[3]}, o[d0], 0, 0, 0); } } while (0)
    PV_D0(0); PV_D0(1); PV_D0(2); PV_D0(3);
#undef PV_D0
#undef TRRD
}

struct UnitRef { const bf16_t* Q; const bf16_t* K; const bf16_t* V; int P0; };
struct Seam { bf16x8 qr[8]; bf16x8 st_v0, st_v1, st_k0, st_k1; };
#define ROW(p, k0, rr) ((p) + (size_t)((k0) + (rr)) * D + sc)
#define VMW() asm volatile("s_waitcnt vmcnt(0)" ::: "memory")
#define SLOAD_H(Kp, Vp, k0) do { S.st_v0 = load8(ROW(Vp, k0, sr)); S.st_v1 = load8(ROW(Vp, k0, 32 + sr));              \
                         S.st_k0 = load8(ROW(Kp, k0, sr)); S.st_k1 = load8(ROW(Kp, k0, 32 + sr)); } while (0)
#define SWRITE_HK(bf) do { *(bf16x8*)(K_lds + (bf) * SHM_K + kws) = S.st_k0; *(bf16x8*)(K_lds + (bf) * SHM_K + kws + 32 * 256) = S.st_k1; } while (0)
#define SWRITE_HV(bf) do { *(bf16x8*)(V_lds + (bf) * SHM_V + vst0) = S.st_v0; *(bf16x8*)(V_lds + (bf) * SHM_V + vst1) = S.st_v1; } while (0)
#define SWRITE_H(bf) do { SWRITE_HV(bf); SWRITE_HK(bf); } while (0)

template <bool SB>
__device__ __forceinline__ void attn_unit(const UnitRef& cur, unsigned char* wsu  , int bh, char* lds,
                                          int part  ) {
    const float* cvec; const float* gqk;
    { unsigned char* w_ = wsu; asm volatile("" : "+s"(w_)); cvec = (const float*)(w_ + WS_C) + (size_t)bh * SEQ; gqk = (const float*)(w_ + WS_GQK); }
    const int tid = tid_opaque(), wid = __builtin_amdgcn_readfirstlane(tid >> 6), lane = tid & 63, r32 = lane & 31, hi = lane >> 5;
    int jlo = 0;
    if constexpr (!SB) {
        const float gq = fmaxf(fabsf(gqk[lane]), fabsf(gqk[64 + lane])), gk = fmaxf(fabsf(gqk[128 + lane]), fabsf(gqk[192 + lane]));
        const float lmax = 11.3137085f * 1.02f * wave_max(gq) * wave_max(gk);
        const int ntf = (cur.P0 + QB) / KVBLK;
        const float cend = (lane < ntf) ? cvec[lane * KVBLK + KVBLK - 1] : 0.f;
        const bool skip = (lane < ntf) && (2.f * lmax + cvec[cur.P0] - cend < -104.f);
        jlo = __builtin_amdgcn_readfirstlane((int)__popcll(__ballot(skip)));
    }
    const int ntot = (cur.P0 + QB) / KVBLK - jlo;
    const int tb = (part == 2) ? (ntot >> 1) : 0, te = (part == 1) ? (ntot >> 1) : ntot;
    const int kshift = (jlo + tb) * KVBLK, P0r = cur.P0 - kshift;
    const int NT = te - tb;
#define KBASE(t) ((SB ? (NT - 1 - (t)) : (t)) * KVBLK)
    const int qlo = P0r + wid * QBLK, qm = qlo + r32 - 4 * hi - (SB ? 1 : 0);
    char* V_lds = lds; char* K_lds = lds + 2 * SHM_V;
    float* ws = (float*)(lds + OFF_WS) + wid * 64; float* li_l = ws, * al_l = ws + 32;
    float* bias = (float*)(lds + OFF_BIAS);
    const int sr = tid >> 4, sc = (tid & 15) * 8, vst0 = v_st(sr, sc), vst1 = v_st(32 + sr, sc), kws = KSWZ(sr, sc * 2);
    const int vb0 = (int)(uintptr_t)V_lds + v_rd_base(lane);
    const bf16_t* Kh = cur.K + (size_t)kshift * D; const bf16_t* Vh = cur.V + (size_t)kshift * D;
    Seam S;
    if constexpr (!SB) { const float cq0 = cvec[cur.P0]; const float* cv = cvec + kshift; for (int j = tid; j < NT * KVBLK; j += NTHREADS) bias[j] = (cq0 - cv[j]) * (1.f / SCALE); }
#pragma unroll
    for (int d0 = 0; d0 < 8; ++d0) S.qr[d0] = load8(cur.Q + (size_t)(wid * QBLK + r32) * D + d0 * 16 + hi * 8);
    SLOAD_H(Kh, Vh, KBASE(0)); VMW(); SWRITE_HK(0);
    __syncthreads();
    float m_reg = -1e30f, l_reg = 0; f32x16 o[4] = {};
    float carry = 0.f; const float mlo = hi ? 0.f : 1.f;
#define RESC(a) do { if (__any((a) < 1.f)) { if (hi == 0) al_l[r32] = (a); asm volatile("s_waitcnt lgkmcnt(0)" ::: "memory");              \
                     for (int d_ = 0; d_ < 4; ++d_) for (int r = 0; r < 16; ++r) o[d_][r] *= al_l[crow(r, hi)]; } } while (0)
#define MASKT(P0_, P1_, t) do { const int kb_ = KBASE(t); if (kb_ + KVBLK - 1 > qlo - (SB ? 1 : 0)) mask_tile(P0_, P1_, qm - kb_); } while (0)
#define BT(t) (bias + KBASE(t) + 4 * hi)
#define PART1(PX0, PX1, mnX, alX) do { if constexpr (SB) sb_part1(PX0, PX1, carry, mlo); else partialSM(PX0, PX1, m_reg, mnX, alX); } while (0)
#define PART2(PY0, PY1, alY) do { if constexpr (SB) sb_part2(PY0, PY1, pa0, pa1, pa2, pa3); else finishSM(PY0, PY1, alY, l_reg, pa0, pa1, pa2, pa3); } while (0)
    f32x16 pA0, pA1, pB0, pB1; float mnA = 0.f, mnB = 0.f, alA = 1.f, alB = 1.f; bf16x8 pa0, pa1, pa2, pa3;
    SWRITE_HV(0); SBAR();
    if (NT > 1) SLOAD_H(Kh, Vh, KBASE(1));
    SBAR(); qkt<0, !SB>(pA0, pA1, K_lds, r32, hi, S.qr, BT(0));
    MASKT(pA0, pA1, 0); PART1(pA0, pA1, mnA, alA);
    if (NT > 1) { VMW(); SWRITE_H(1); }
    __syncthreads();
#define HALF_STEP(PX0, PX1, mnX, alX, PY0, PY1, alY, t, KB, VB, SBUF) do {                                                    \
        SBAR(); qkt<KB, !SB>(PX0, PX1, K_lds, r32, hi, S.qr, BT(t));                                                          \
        PART2(PY0, PY1, alY); SBAR();                                                                                          \
        if ((t) + 1 < NT) { SLOAD_H(Kh, Vh, KBASE((t) + 1)); SBAR(); }                                                         \
        pv_tile<VB>(o, vb0, pa0, pa1, pa2, pa3); MASKT(PX0, PX1, (t)); PART1(PX0, PX1, mnX, alX);                              \
        __syncthreads();                                                                                                      \
        if ((t) + 1 < NT) { VMW(); SWRITE_H(SBUF); }                                                                           \
        if constexpr (!SB) RESC(alX);                                                                                          \
        __syncthreads(); } while (0)
    for (int t = 1; t + 1 < NT; t += 2) {
        HALF_STEP(pB0, pB1, mnB, alB, pA0, pA1, alA, t, 1, 0, 0);
        HALF_STEP(pA0, pA1, mnA, alA, pB0, pB1, alB, t + 1, 0, 1, 1);
    }
    const bool even = (NT & 1) == 0;
    if (even) { SBAR(); qkt<1, !SB>(pB0, pB1, K_lds, r32, hi, S.qr, BT(NT - 1)); SBAR(); }
    PART2(pA0, pA1, alA); SBAR();
    pv_tile<0>(o, vb0, pa0, pa1, pa2, pa3);
    if (even) { MASKT(pB0, pB1, NT - 1); PART1(pB0, pB1, mnB, alB); __syncthreads(); if constexpr (!SB) RESC(alB);
        PART2(pB0, pB1, alB); SBAR(); pv_tile<1>(o, vb0, pa0, pa1, pa2, pa3); }
    unsigned char* we_ = wsu; asm volatile("" : "+s"(we_));
    if (part != 0) {
        const int slot2 = ((((cur.P0 >> 8) - 8) & 7) * 16 + bh) * 2 + (part == 2 ? 1 : 0);
        float* po = (float*)(we_ + WS_PO) + (size_t)slot2 * 256 * 128; float* pml = (float*)(we_ + WS_PML) + (size_t)slot2 * 512;
        if (hi == 0) { pml[(wid * QBLK + r32) * 2] = m_reg; pml[(wid * QBLK + r32) * 2 + 1] = l_reg; }
#pragma unroll
        for (int r = 0; r < 16; ++r)
#pragma unroll
            for (int d0 = 0; d0 < 4; ++d0) po[(size_t)(wid * QBLK + crow(r, hi)) * D + d0 * 32 + r32] = o[d0][r];
        __syncthreads();
        return;
    }
    const bf16_t* gate = (const bf16_t*)(we_ + WS_SEC) + 3 * SEC_ELEMS + (size_t)(bh >> 3) * SEQ * 1024 + (bh & 7) * HD;
    bf16_t* outp = (bf16_t*)(we_ + WS_MIX) + (size_t)(bh >> 3) * SEQ * DM + (bh & 7) * HD;
    float rli[16];
    if constexpr (!SB) {
        if (hi == 0) li_l[r32] = l_reg; asm volatile("s_waitcnt lgkmcnt(0)" ::: "memory");
#pragma unroll
        for (int r = 0; r < 16; ++r) rli[r] = __builtin_amdgcn_rcpf(li_l[crow(r, hi)]);
    }
#pragma unroll
    for (int r = 0; r < 16; ++r) { const int orow = cur.P0 + wid * QBLK + crow(r, hi);
#pragma unroll
        for (int d0 = 0; d0 < 4; ++d0) {
            float v = o[d0][r];
            if constexpr (!SB) { const unsigned short gb = gate[(size_t)orow * 1024 + d0 * 32 + r32]; v = v * rli[r] * __builtin_bit_cast(float, (unsigned)gb << 16); }
            const float vn = sx_f(v, 1);
            if ((r32 & 1) == 0) *(unsigned*)(outp + (size_t)orow * DM + d0 * 32 + r32) = cvt_pk_bf16(v, vn); } }
    __syncthreads();
#undef RESC
#undef KBASE
#undef MASKT
#undef BT
#undef PART1
#undef PART2
#undef HALF_STEP
}

constexpr float SB_TH = 150.f;
__device__ __forceinline__ void sb_unit(const UnitRef& cur, bf16_t* outp, char* lds) {
    const int tid = tid_opaque(), wid = __builtin_amdgcn_readfirstlane(tid >> 6), lane = tid & 63, r32 = lane & 31, hi = lane >> 5;
    const int NT = (cur.P0 + QB) / KVBLK;
#define KBASE(t) ((NT - 1 - (t)) * KVBLK)
    const int qlo = cur.P0 + wid * QBLK, qm = qlo + r32 - 4 * hi - 1;
    char* V_lds = lds; char* K_lds = lds + 2 * SHM_V;
    volatile int* flags = (volatile int*)(lds + OFF_WS);
    const int sr = tid >> 4, sc = (tid & 15) * 8, vst0 = v_st(sr, sc), vst1 = v_st(32 + sr, sc), kws = KSWZ(sr, sc * 2);
    const int vb0 = (int)(uintptr_t)V_lds + v_rd_base(lane);
    const bf16_t* Kh = cur.K; const bf16_t* Vh = cur.V;
    Seam S;
#pragma unroll
    for (int d0 = 0; d0 < 8; ++d0) S.qr[d0] = load8(cur.Q + (size_t)(wid * QBLK + r32) * D + d0 * 16 + hi * 8);
    SLOAD_H(Kh, Vh, KBASE(0)); VMW(); SWRITE_H(0);
    __syncthreads();
    f32x16 o[4] = {}; float carry = 0.f; const float mlo = hi ? 0.f : 1.f;
    bool wdone = false;
#define SB_STEP(tt, BUF) {                                                                                                 \
        const int kb_ = KBASE(tt);                                                                                           \
        if ((tt) + 1 < NT) SLOAD_H(Kh, Vh, KBASE((tt) + 1));                                                                 \
        SBAR();                                                                                                              \
        if (!wdone && kb_ <= qlo + QBLK - 2) {                                                                               \
            f32x16 p0, p1; bf16x8 pa0, pa1, pa2, pa3;                                                                        \
            qkt<BUF, false>(p0, p1, K_lds, r32, hi, S.qr, nullptr);                                                          \
            if (kb_ + KVBLK - 1 > qlo - 1) mask_tile(p0, p1, qm - kb_);                                                      \
            sb_part1(p0, p1, carry, mlo); sb_part2(p0, p1, pa0, pa1, pa2, pa3); SBAR();                                      \
            pv_tile<BUF>(o, vb0, pa0, pa1, pa2, pa3);                                                                        \
            wdone = __all(carry >= SB_TH);                                                                                   \
        }                                                                                                                    \
        if ((tt) + 1 < NT) { VMW(); SWRITE_H((BUF) ^ 1); }                                                                   \
        if (lane == 0) flags[((tt) & 1) * 8 + wid] = wdone ? 1 : 0;                                                          \
        __syncthreads();                                                                                                     \
        { int alld = 1;                                                                                                      \
          _Pragma("unroll") for (int w_ = 0; w_ < 8; ++w_) alld &= flags[((tt) & 1) * 8 + w_];                                \
          if (alld) break; } }
    for (int t = 0; t < NT; t += 2) {
        SB_STEP(t, 0)
        SB_STEP(t + 1, 1)
    }
#undef SB_STEP
#pragma unroll
    for (int r = 0; r < 16; ++r) { const int orow = cur.P0 + wid * QBLK + crow(r, hi);
#pragma unroll
        for (int d0 = 0; d0 < 4; ++d0) {
            const float v = o[d0][r];
            const float vn = sx_f(v, 1);
            if ((r32 & 1) == 0) *(unsigned*)(outp + (size_t)orow * DM + d0 * 32 + r32) = cvt_pk_bf16(v, vn); } }
    __syncthreads();
#undef KBASE
}
#undef ROW
#undef VMW
#undef SLOAD_H
#undef SWRITE_HK
#undef SWRITE_HV
#undef SWRITE_H
}

#define XB_TMO      128
#define XB_XCNT(j)  (256  + 64 * (j))
#define XB_XSUB(j)  (1280 + 64 * (j))
#define XB_XGEN(j)  (2304 + 64 * (j))
#define XB_TOP      3328
#define XB_TOPGEN   3392
#define XCD_BAR_WORDS 3456
#define XB_SPIN_CAP (1u << 20)
__device__ __forceinline__ unsigned xb_ld(unsigned* p)              { return __hip_atomic_load(p, __ATOMIC_RELAXED, __HIP_MEMORY_SCOPE_AGENT); }
__device__ __forceinline__ unsigned xb_add(unsigned* p, unsigned v) { return __hip_atomic_fetch_add(p, v, __ATOMIC_RELAXED, __HIP_MEMORY_SCOPE_AGENT); }
__device__ __forceinline__ unsigned xb_xcc_id() { return (unsigned)__builtin_amdgcn_s_getreg((3 << 11) | 20) & 0xFu; }
#define XB_SPIN(cond, bar) do { unsigned _sp = 0; while (cond) { __builtin_amdgcn_s_sleep(1); \
    if ((++_sp & 255u) == 0u) { if (xb_ld(&(bar)[XB_TMO])) break; if (_sp > XB_SPIN_CAP) { atomicAdd(&(bar)[XB_TMO], 1u); break; } } } } while (0)
struct XcdBarrier { unsigned* bar; unsigned x; volatile LAS unsigned* st; };
__device__ __forceinline__ XcdBarrier xcd_barrier_post(unsigned* bar, volatile LAS unsigned* st) {
    XcdBarrier b; b.bar = bar; b.x = xb_xcc_id(); b.st = st;
    if (threadIdx.x == 0) (void)xb_add(&bar[XB_XCNT(b.x)], 1u);
    return b;
}
__device__ __forceinline__ void xcd_barrier_complete(unsigned* bar, unsigned x, unsigned& nloc, unsigned& nx) {
    const unsigned G = gridDim.x * gridDim.y * gridDim.z;
    unsigned sum, cnt, mine, sp = 0u;
    for (;;) {
        sum = 0u; cnt = 0u; mine = 0u;
#pragma unroll
        for (unsigned j = 0; j < 16; ++j) { const unsigned c = xb_ld(&bar[XB_XCNT(j)]); sum += c; cnt += (c > 0u) ? 1u : 0u; mine = (j == x) ? c : mine; }
        if (sum == G) break;
        __builtin_amdgcn_s_sleep(1);
        if ((++sp & 255u) == 0u) { if (xb_ld(&bar[XB_TMO])) break; if (sp > XB_SPIN_CAP) { atomicAdd(&bar[XB_TMO], 1u); break; } }
    }
    nloc = mine > 0u ? mine : 1u; nx = cnt > 0u ? cnt : 1u;
}
__device__ __forceinline__ void xcd_barrier(const XcdBarrier& b) {
    asm volatile("s_waitcnt vmcnt(0)" ::: "memory");
    __syncthreads();
    if (threadIdx.x == 0) {
        unsigned* bar = b.bar;
        __builtin_amdgcn_s_waitcnt(0);
        unsigned nloc = b.st[0], nx = b.st[1];
        if (nloc == 0u) { xcd_barrier_complete(bar, b.x, nloc, nx); b.st[0] = nloc; b.st[1] = nx; }
        const unsigned old = xb_add(&bar[XB_XSUB(b.x)], 1u);
        const unsigned gen = old / nloc;
        if (old + 1u == (gen + 1u) * nloc) {
            __builtin_amdgcn_fence(__ATOMIC_RELEASE, "agent");
            asm volatile("s_waitcnt vmcnt(0)" ::: "memory");
            const unsigned og = xb_add(&bar[XB_TOP], 1u);
            const unsigned tg = og / nx;
            if (og + 1u == (tg + 1u) * nx) xb_add(&bar[XB_TOPGEN], 1u);
            else XB_SPIN(xb_ld(&bar[XB_TOPGEN]) == tg, bar);
            __builtin_amdgcn_fence(__ATOMIC_ACQUIRE, "agent");
            xb_add(&bar[XB_XGEN(b.x)], 1u);
            asm volatile("s_waitcnt vmcnt(0)" ::: "memory");
        } else {
            XB_SPIN(xb_ld(&bar[XB_XGEN(b.x)]) == gen, bar);
            __builtin_amdgcn_fence(__ATOMIC_ACQUIRE, "agent");
            asm volatile("s_waitcnt vmcnt(0)" ::: "memory");
        }
    }
    __syncthreads();
}

struct Args { const float* in[12]; float* out; unsigned char* ws; int ph_lo, ph_hi; };

__device__ __forceinline__ void p0_transpose_item(const float* W, int ldw, int K, bf16_t* WT, int nblk, LAS float* scr, int item, int lane, const float* gk) {
    const int kb = item / nblk, nb = item % nblk, k0 = 64 * kb, n0 = 32 * nb;
    { const int rr = lane >> 3, c4 = lane & 7; f32x4 v[8];
#pragma unroll
      for (int i = 0; i < 8; ++i) v[i] = *(const f32x4*)(W + (size_t)(k0 + rr + 8 * i) * ldw + n0 + 4 * c4);
#pragma unroll
      for (int i = 0; i < 8; ++i) { const int kk = rr + 8 * i; const float gm = gk ? gk[k0 + kk] : 1.f;
          scr[kk * 33 + 4 * c4] = v[i][0] * gm; scr[kk * 33 + 4 * c4 + 1] = v[i][1] * gm; scr[kk * 33 + 4 * c4 + 2] = v[i][2] * gm; scr[kk * 33 + 4 * c4 + 3] = v[i][3] * gm; } }
    LDS_WAIT(); asm volatile("" ::: "memory");
    const int c = lane & 7;
#pragma unroll
    for (int j = 0; j < 4; ++j) { const int n = (lane >> 3) + 8 * j; const LAS float* s = scr + (8 * c) * 33 + n;
        u32x4 o; o.x = cvt_pk_bf16(s[0 * 33], s[1 * 33]); o.y = cvt_pk_bf16(s[2 * 33], s[3 * 33]); o.z = cvt_pk_bf16(s[4 * 33], s[5 * 33]); o.w = cvt_pk_bf16(s[6 * 33], s[7 * 33]);
        *(u32x4*)(WT + (size_t)(n0 + n) * K + k0 + 8 * c) = o; }
    LDS_WAIT(); asm volatile("" ::: "memory");
}

__device__ __forceinline__ int pack_i8(float a, float b, float c, float d) {
    const int ia = (int)__builtin_rintf(a), ib = (int)__builtin_rintf(b), ic = (int)__builtin_rintf(c), id = (int)__builtin_rintf(d);
    return (int)(((unsigned)ia & 0xffu) | (((unsigned)ib & 0xffu) << 8) | (((unsigned)ic & 0xffu) << 16) | ((unsigned)id << 24));
}
__device__ __forceinline__ void convert_tables(const Args& a, int r0, int r1, int worker, int nworkers) {
    const int lane = tid_opaque() & 63;
    unsigned char* ws = a.ws; const float* g_ffn = a.in[7]; const float* pu = a.in[10]; const float* pv = a.in[11];
    float* suv = (float*)(ws + WS_SUV);
    for (int r = r0 + worker; r < r1; r += nworkers) {
        const bool isv = r >= NEXP; const int e = isv ? r - NEXP : r;
        const f32x4* srcp = (const f32x4*)((isv ? pv : pu) + (size_t)e * DM);
        f32x4 v[8]; float amax = 0.f;
#pragma unroll
        for (int j = 0; j < 8; ++j) { v[j] = srcp[lane + 64 * j];
            if (!isv) { const f32x4 g4 = *(const f32x4*)(g_ffn + 4 * (lane + 64 * j)); v[j] = v[j] * g4; }
            amax = fmaxf(amax, fmaxf(fmaxf(fabsf(v[j][0]), fabsf(v[j][1])), fmaxf(fabsf(v[j][2]), fabsf(v[j][3])))); }
        amax = wave_max(amax);
        const float sc = amax > 0.f ? 127.f / amax : 1.f;
        unsigned char* dst = ws + (isv ? WS_V8 : WS_U8) + (size_t)e * 128;
#pragma unroll
        for (int j = 0; j < 8; ++j) { const int p = pack_i8(v[j][0] * sc, v[j][1] * sc, v[j][2] * sc, v[j][3] * sc);
            const int col = 4 * (lane + 64 * j);
            *(unsigned*)(dst + (size_t)(col >> 7) * ((size_t)NEXP * 128) + (col & 127)) = (unsigned)p; }
        if (lane == 0) suv[r] = 1.f / sc;
    }
}
constexpr int TAB_SPLIT = NEXP;

__device__ __forceinline__ void p0_transpose_item_i8(const float* W, int ldw, int K, unsigned char* WT, int nblk, LAS float* scr, int item, int lane, float q8) {
    const int kb = item / nblk, nb = item % nblk, k0 = 64 * kb, n0 = 32 * nb;
    { const int rr = lane >> 3, c4 = lane & 7; f32x4 v[8];
#pragma unroll
      for (int i = 0; i < 8; ++i) v[i] = *(const f32x4*)(W + (size_t)(k0 + rr + 8 * i) * ldw + n0 + 4 * c4);
#pragma unroll
      for (int i = 0; i < 8; ++i) { const int kk = rr + 8 * i;
          scr[kk * 33 + 4 * c4] = v[i][0] * q8; scr[kk * 33 + 4 * c4 + 1] = v[i][1] * q8; scr[kk * 33 + 4 * c4 + 2] = v[i][2] * q8; scr[kk * 33 + 4 * c4 + 3] = v[i][3] * q8; } }
    LDS_WAIT(); asm volatile("" ::: "memory");
    const int c = lane & 7;
#pragma unroll
    for (int j = 0; j < 4; ++j) { const int n = (lane >> 3) + 8 * j; const LAS float* s = scr + (8 * c) * 33 + n;
        u32x2 o; o.x = (unsigned)pack_i8(s[0 * 33], s[1 * 33], s[2 * 33], s[3 * 33]); o.y = (unsigned)pack_i8(s[4 * 33], s[5 * 33], s[6 * 33], s[7 * 33]);
        *(u32x2*)(WT + (size_t)(n0 + n) * K + k0 + 8 * c) = o; }
    LDS_WAIT(); asm volatile("" ::: "memory");
}
__device__ __forceinline__ float log_sigmoid_f(float x) { return fminf(x, 0.f) - log1pf(expf(-fabsf(x))); }

__device__ __forceinline__ void phase0(const Args& a, unsigned char* lds_g) {
    LAS unsigned char* lds = (LAS unsigned char*)lds_g;
    const int tid = tid_opaque(), lane = tid & 63, wave = __builtin_amdgcn_readfirstlane(tid >> 6);
    const int gw = blockIdx.x * NWAVES + wave, NGW = gridDim.x * NWAVES;
    const int gt = blockIdx.x * NTHREADS + tid, NGT = gridDim.x * NTHREADS;
    unsigned char* ws = a.ws;
    const float* x = a.in[0]; const float* g_attn = a.in[1]; const float* w_in = a.in[2]; const float* b_forget = a.in[3];
    const float* w_out = a.in[6]; const float* g_ffn = a.in[7]; const float* w_pq = a.in[8]; const float* sk = a.in[9]; const float* pu = a.in[10]; const float* pv = a.in[11];
    { float m = 0.f; const f32x4* wp = (const f32x4*)w_in;
      constexpr size_t NV4 = (size_t)DM * DIN / 4;
      size_t i = gt;
      for (; i + 7 * (size_t)NGT < NV4; i += 8 * (size_t)NGT) {
          f32x4 v[8];
#pragma unroll
          for (int k = 0; k < 8; ++k) v[k] = wp[i + k * (size_t)NGT];
#pragma unroll
          for (int k = 0; k < 8; ++k) m = fmaxf(m, fmaxf(fmaxf(fabsf(v[k][0]), fabsf(v[k][1])), fmaxf(fabsf(v[k][2]), fabsf(v[k][3])))); }
      for (; i < NV4; i += NGT) { const f32x4 v = wp[i]; m = fmaxf(m, fmaxf(fmaxf(fabsf(v[0]), fabsf(v[1])), fmaxf(fabsf(v[2]), fabsf(v[3])))); }
      m = wave_max(m);
      volatile LAS float* red = (volatile LAS float*)(lds + MISC_OFF + 256);
      if (lane == 0) red[wave] = m;
      __syncthreads();
      if (tid == 0) { float mm = red[0];
#pragma unroll
          for (int w = 1; w < NWAVES; ++w) mm = fmaxf(mm, red[w]);
          __hip_atomic_fetch_max((unsigned*)(ws + WS_CTL) + CW_WMAX, __float_as_uint(mm), __ATOMIC_RELAXED, __HIP_MEMORY_SCOPE_AGENT); } }
    LAS float* wf = (LAS float*)(lds + 67584);
    for (int k = tid; k < DM; k += NTHREADS) { const f32x4 a0 = *(const f32x4*)(w_in + (size_t)k * DIN + NPROJ), a1 = *(const f32x4*)(w_in + (size_t)k * DIN + NPROJ + 4);
        wf[0 * DM + k] = a0[0]; wf[1 * DM + k] = a0[1]; wf[2 * DM + k] = a0[2]; wf[3 * DM + k] = a0[3]; wf[4 * DM + k] = a1[0]; wf[5 * DM + k] = a1[1]; wf[6 * DM + k] = a1[2]; wf[7 * DM + k] = a1[3]; }
    __syncthreads();
    for (int row = gw; row < T; row += NGW) {
        const f32x4* xr = (const f32x4*)(x + (size_t)row * DM);
        f32x4 v[8]; float ss = 0.f;
#pragma unroll
        for (int j = 0; j < 8; ++j) { v[j] = xr[lane + 64 * j]; ss += v[j][0] * v[j][0] + v[j][1] * v[j][1] + v[j][2] * v[j][2] + v[j][3] * v[j][3]; }
        const float r = 1.0f / sqrtf(wave_sum(ss) * (1.f / DM) + EPS);
        float f[8] = {0.f, 0.f, 0.f, 0.f, 0.f, 0.f, 0.f, 0.f};
        float xmax = 0.f;
#pragma unroll
        for (int j = 0; j < 8; ++j) { const f32x4 g4 = *(const f32x4*)(g_attn + 4 * (lane + 64 * j)); v[j][0] *= r * g4[0]; v[j][1] *= r * g4[1]; v[j][2] *= r * g4[2]; v[j][3] *= r * g4[3];
            xmax = fmaxf(xmax, fmaxf(fmaxf(fabsf(v[j][0]), fabsf(v[j][1])), fmaxf(fabsf(v[j][2]), fabsf(v[j][3])))); }
        xmax = wave_max(xmax);
        const float xq = xmax > 0.f ? 127.f / xmax : 1.f;
        if (lane == 0) ((float*)(ws + WS_SXN))[row] = xmax * (1.f / 127.f);
        unsigned* o8 = (unsigned*)(ws + WS_XN + (size_t)row * DM);
#pragma unroll
        for (int j = 0; j < 8; ++j) {
            const int e = 4 * (lane + 64 * j);
            const f32x4 xn = v[j];
            o8[lane + 64 * j] = (unsigned)pack_i8(xn[0] * xq, xn[1] * xq, xn[2] * xq, xn[3] * xq);
#pragma unroll
            for (int hh = 0; hh < 8; ++hh) { const f32x4 w4 = *(LAS f32x4*)(wf + hh * DM + e);
                f[hh] += (xn[0] * w4[0] + xn[1] * w4[1]) + (xn[2] * w4[2] + xn[3] * w4[3]); }
            __builtin_amdgcn_sched_barrier(0);
        }
#pragma unroll
        for (int hh = 0; hh < 8; ++hh) f[hh] = wave_sum(f[hh]);
        if (lane < 8) { float fl = f[0];
#pragma unroll
            for (int hh = 1; hh < 8; ++hh) fl = (lane == hh) ? f[hh] : fl;
            const int b = row >> 12, s = row & 4095;
            ((float*)(ws + WS_LOGF))[(size_t)(b * 8 + lane) * SEQ + s] = log_sigmoid_f(fl + b_forget[lane]); }
    }
    LAS float* scr = (LAS float*)(lds + wave * 8448);
    constexpr int I_IN = (DM / 64) * (NPROJ / 32), I_O = (DM / 64) * (DM / 32);
    for (int it = gw; it < 2 * I_O; it += NGW) {
        int r = it;
        if (r < I_O) { p0_transpose_item(w_out, DM, DM, (bf16_t*)(ws + WS_WOUT), DM / 32, scr, r, lane, nullptr); continue; } r -= I_O;
        p0_transpose_item(w_pq, DM, DM, (bf16_t*)(ws + WS_WPQ), DM / 32, scr, r, lane, g_ffn);
    }
    for (int i = gt; i < 8 * 2 * 128 * 128 / 8; i += NGT) { const f32x4 a0 = *(const f32x4*)(sk + (size_t)i * 8), a1 = *(const f32x4*)(sk + (size_t)i * 8 + 4);
        u32x4 w; w.x = cvt_pk_bf16(a0[0], a0[1]); w.y = cvt_pk_bf16(a0[2], a0[3]); w.z = cvt_pk_bf16(a1[0], a1[1]); w.w = cvt_pk_bf16(a1[2], a1[3]);
        *(u32x4*)(ws + WS_SK + (size_t)i * 16) = w; }
    if (gt < 256) ((float*)(ws + WS_GQK))[gt] = gt < 128 ? a.in[4][gt] : a.in[5][gt - 128];
    convert_tables(a, 0, TAB_SPLIT, gw, NGW);
    { XcdBarrier xb_; xb_.bar = (unsigned*)(ws + WS_CTL) + CW_BAR; xb_.x = xb_xcc_id(); xb_.st = (volatile LAS unsigned*)(lds + MISC_OFF) + 8; xcd_barrier(xb_); }
    const float wmax = __uint_as_float(__hip_atomic_load((unsigned*)(ws + WS_CTL) + CW_WMAX, __ATOMIC_RELAXED, __HIP_MEMORY_SCOPE_AGENT));
    if (gt == 0) *(float*)(ws + WS_WSC) = wmax * (1.f / 127.f);
    const float q8 = wmax > 0.f ? 127.f / wmax : 1.f;
    for (int it = gw; it < I_IN; it += NGW) p0_transpose_item_i8(w_in, DIN, DM, ws + WS_WIN, NPROJ / 32, scr, it, lane, q8);
}

__device__ __forceinline__ void cumsum_rows(const Args& a) {
    const int tid = tid_opaque(), lane = tid & 63, wave = tid >> 6;
    if (blockIdx.x >= 16 || wave != 0) return;
    const float* src = (const float*)(a.ws + WS_LOGF) + (size_t)blockIdx.x * SEQ + lane * 64;
    float* dst = (float*)(a.ws + WS_C) + (size_t)blockIdx.x * SEQ + lane * 64;
    f32x4 v[16]; float run = 0.f;
#pragma unroll
    for (int i = 0; i < 16; ++i) { v[i] = *(const f32x4*)(src + 4 * i);
#pragma unroll
        for (int q = 0; q < 4; ++q) { run += v[i][q]; v[i][q] = run; } }
    float incl = run;
#pragma unroll
    for (int o = 1; o < 64; o <<= 1) { const float t = shup_f(incl, o); if (lane >= o) incl += t; }
    const float off = incl - run;
#pragma unroll
    for (int i = 0; i < 16; ++i) { f32x4 w = v[i]; w[0] += off; w[1] += off; w[2] += off; w[3] += off; *(f32x4*)(dst + 4 * i) = w; }
}

__device__ __forceinline__ void phase_qknorm(const Args& a) {
    const int tid = tid_opaque(), lane = tid & 63, wave = tid >> 6;
    const int gw = blockIdx.x * NWAVES + wave, NGW = gridDim.x * NWAVES;
    const int sub = lane & 15, rw = lane >> 4;
    const float* gq = a.in[4]; const float* gk = a.in[5];
    constexpr int ROWS = NB * NHF * SEQ;
    for (int it = gw; it < 2 * ROWS / 4; it += NGW) {
        const int row = it * 4 + rw; const bool isk = row >= ROWS;
        bf16_t* p = (bf16_t*)(a.ws + WS_SEC) + (size_t)row * HD + sub * 8;
        const float* g = (isk ? gk : gq) + sub * 8;
        const u32x4 w = *(const u32x4*)p;
        float v[8] = {bf_lo(w.x), bf_hi(w.x), bf_lo(w.y), bf_hi(w.y), bf_lo(w.z), bf_hi(w.z), bf_lo(w.w), bf_hi(w.w)};
        float ss = 0.f;
#pragma unroll
        for (int i = 0; i < 8; ++i) ss += v[i] * v[i];
        ss += sx_f(ss, 1); ss += sx_f(ss, 2); ss += sx_f(ss, 4); ss += sx_f(ss, 8);
        const float r = 1.0f / sqrtf(ss * (1.f / HD) + EPS);
        const f32x4 g0 = *(const f32x4*)g, g1 = *(const f32x4*)(g + 4);
        u32x4 o; o.x = cvt_pk_bf16(v[0] * r * g0[0], v[1] * r * g0[1]); o.y = cvt_pk_bf16(v[2] * r * g0[2], v[3] * r * g0[3]);
        o.z = cvt_pk_bf16(v[4] * r * g1[0], v[5] * r * g1[1]); o.w = cvt_pk_bf16(v[6] * r * g1[2], v[7] * r * g1[3]);
        *(u32x4*)p = o;
    }
}

__device__ __forceinline__ void phase_attn(const Args& a, unsigned char* lds_g) {
    const int tid = tid_opaque();
    volatile int* s_item = (volatile int*)(lds_g + MISC_OFF);
    unsigned* ctr = (unsigned*)(a.ws + WS_CTL);
    for (;;) {
        __syncthreads();
        if (tid == 0) *s_item = (int)atomicAdd(ctr, 1u);
        __syncthreads();
        int it = *s_item, kind = -1, qb = 0, sub = 0;
#define CLS(K, Q, CNT) if (kind < 0) { if (it < (CNT)) { kind = (K); qb = (Q); sub = it; } else it -= (CNT); }
        CLS(2, 15, 32) CLS(1, 7, 16) CLS(2, 14, 32) CLS(2, 13, 32) CLS(1, 6, 16) CLS(2, 12, 32) CLS(2, 11, 32) CLS(1, 5, 16) CLS(2, 10, 32) CLS(2, 9, 32) CLS(1, 4, 16) CLS(2, 8, 32) CLS(1, 3, 16) CLS(1, 2, 16)
        if (kind < 0) { if (it < 256) { kind = 0; qb = 15 - (it >> 4); sub = it & 15; } else it -= 256; }
        CLS(1, 1, 16) CLS(1, 0, 16)
#undef CLS
        if (kind < 0) break;
        unsigned char* wsl = a.ws; asm volatile("" : "+s"(wsl));
        bf16_t* sec = (bf16_t*)(wsl + WS_SEC);
        const int bh = sub & 15, part = (kind == 2) ? 1 + (sub >> 4) : 0;
        const int b = bh >> 3, h = bh & 7;
        const size_t hoff = (size_t)bh * SEQ * HD;
        att::UnitRef u;
        u.P0 = qb * 256;
        if (kind == 0) {
            u.Q = sec + 4 * SEC_ELEMS + hoff + (size_t)u.P0 * HD; u.K = sec + 5 * SEC_ELEMS + hoff; u.V = sec + 6 * SEC_ELEMS + hoff;
            att::sb_unit(u, (bf16_t*)(wsl + WS_MIX) + (size_t)b * SEQ * DM + 1024 + h * HD, (char*)lds_g);
        } else {
            u.Q = sec + 0 * SEC_ELEMS + hoff + (size_t)u.P0 * HD; u.K = sec + 1 * SEC_ELEMS + hoff; u.V = sec + 2 * SEC_ELEMS + hoff;
            att::attn_unit<false>(u, wsl, bh, (char*)lds_g, part);
        }
    }
}
__device__ __forceinline__ void phase_attn_combine(const Args& a) {
    const int gt = blockIdx.x * NTHREADS + tid_opaque(), NGT = gridDim.x * NTHREADS;
    const float* po = (const float*)(a.ws + WS_PO); const float* pml = (const float*)(a.ws + WS_PML);
    const bf16_t* gate = (const bf16_t*)(a.ws + WS_SEC) + 3 * SEC_ELEMS; bf16_t* mix = (bf16_t*)(a.ws + WS_MIX);
    constexpr float C2 = LOG2E * SCALE;
    for (int item = gt; item < 128 * 256 * 16; item += NGT) {
        const int slot = item >> 12, row = (item >> 4) & 255, cg = item & 15;
        const int qb = 8 + (slot >> 4), bh = slot & 15, b = bh >> 3, h = bh & 7;
        const f32x2 ml1 = *(const f32x2*)(pml + (size_t)(slot * 2) * 512 + row * 2), ml2 = *(const f32x2*)(pml + (size_t)(slot * 2 + 1) * 512 + row * 2);
        const float M = fmaxf(ml1.x, ml2.x), a1 = __builtin_amdgcn_exp2f((ml1.x - M) * C2), a2 = __builtin_amdgcn_exp2f((ml2.x - M) * C2);
        const float inv = 1.f / (a1 * ml1.y + a2 * ml2.y);
        const float* p1 = po + (size_t)(slot * 2) * 32768 + row * 128 + cg * 8; const float* p2 = p1 + 32768;
        const f32x4 x0 = *(const f32x4*)p1, x1 = *(const f32x4*)(p1 + 4), y0 = *(const f32x4*)p2, y1 = *(const f32x4*)(p2 + 4);
        const size_t tok = (size_t)b * SEQ + qb * 256 + row;
        const u32x4 gw = *(const u32x4*)(gate + tok * 1024 + h * HD + cg * 8);
        const float w1 = a1 * inv, w2 = a2 * inv;
        u32x4 o;
        o.x = cvt_pk_bf16((w1 * x0[0] + w2 * y0[0]) * bf_lo(gw.x), (w1 * x0[1] + w2 * y0[1]) * bf_hi(gw.x));
        o.y = cvt_pk_bf16((w1 * x0[2] + w2 * y0[2]) * bf_lo(gw.y), (w1 * x0[3] + w2 * y0[3]) * bf_hi(gw.y));
        o.z = cvt_pk_bf16((w1 * x1[0] + w2 * y1[0]) * bf_lo(gw.z), (w1 * x1[1] + w2 * y1[1]) * bf_hi(gw.z));
        o.w = cvt_pk_bf16((w1 * x1[2] + w2 * y1[2]) * bf_lo(gw.w), (w1 * x1[3] + w2 * y1[3]) * bf_hi(gw.w));
        *(u32x4*)(mix + tok * DM + h * HD + cg * 8) = o;
    }
}

__device__ __forceinline__ unsigned f2ord(float f) { const unsigned u = __float_as_uint(f); return u ^ ((unsigned)((int)u >> 31) | 0x80000000u); }
__device__ __forceinline__ float ord2f(unsigned k) { const unsigned u = k ^ (~(unsigned)((int)k >> 31) | 0x80000000u); return __uint_as_float(u); }
#define INS16(L, X) do { unsigned x_ = (X); _Pragma("unroll") for (int i_ = 0; i_ < 16; ++i_) { const unsigned hi_ = max(L[i_], x_); x_ = min(L[i_], x_); L[i_] = hi_; } } while (0)
__device__ __forceinline__ void sort16_desc(unsigned (&a)[16]) {
#pragma unroll
    for (int k = 2; k <= 16; k <<= 1)
#pragma unroll
        for (int j = k >> 1; j > 0; j >>= 1)
#pragma unroll
            for (int i = 0; i < 16; ++i) { const int l = i ^ j; if (l > i) { const unsigned hi_ = max(a[i], a[l]), lo_ = min(a[i], a[l]); const bool desc = (i & k) == 0; a[i] = desc ? hi_ : lo_; a[l] = desc ? lo_ : hi_; } }
}
__device__ __forceinline__ void merge_top16(unsigned (&a)[16], const unsigned (&b)[16]) {
#pragma unroll
    for (int i = 0; i < 16; ++i) a[i] = max(a[i], b[15 - i]);
#pragma unroll
    for (int j = 8; j > 0; j >>= 1)
#pragma unroll
        for (int i = 0; i < 16; ++i) { const int l = i ^ j; if (l > i) { const unsigned hi_ = max(a[i], a[l]), lo_ = min(a[i], a[l]); a[i] = hi_; a[l] = lo_; } }
}
__device__ __forceinline__ void topk_half(const bf16_t* qrow  , const bf16_t* skb, int h, int c, int r32, int hi, unsigned (&L)[16]) {
    bf16x8 qf[8];
#pragma unroll
    for (int d0 = 0; d0 < 8; ++d0) qf[d0] = *(const bf16x8*)(qrow + c * 128 + d0 * 16 + hi * 8);
    const unsigned hi4 = 4u * (unsigned)hi;
#pragma unroll
    for (int kt = 0; kt < 4; ++kt) {
        f32x16 acc = f32x16{};
#pragma unroll
        for (int d0 = 0; d0 < 8; ++d0) { const bf16x8 kf = *(const bf16x8*)(skb + (size_t)((h * 2 + c) * 128 + kt * 32 + r32) * 128 + d0 * 16 + hi * 8);
            acc = __builtin_amdgcn_mfma_f32_32x32x16_bf16(kf, qf[d0], acc, 0, 0, 0); }
        __builtin_amdgcn_sched_barrier(0);
        unsigned G[16];
#pragma unroll
        for (int r = 0; r < 16; ++r) { const unsigned cst = (unsigned)(127 - (kt * 32 + (r & 3) + 8 * (r >> 2))); G[r] = (f2ord(acc[r]) & ~127u) | (cst - hi4); }
        sort16_desc(G);
        if (kt == 0) {
#pragma unroll
            for (int i = 0; i < 16; ++i) L[i] = G[i];
        } else merge_top16(L, G);
        __builtin_amdgcn_sched_barrier(0);
    }
    unsigned P[16];
#pragma unroll
    for (int i = 0; i < 16; ++i) { auto rr = __builtin_amdgcn_permlane32_swap(L[i], L[i], false, false); P[i] = hi ? rr[0] : rr[1]; }
    merge_top16(L, P);
}
__device__ __forceinline__ void topk_task(unsigned char* ws, const bf16_t* qrow, LAS int* tb, int t0, int h, int lane) {
    const int r32 = lane & 31, hi = lane >> 5;
    const bf16_t* skb = (const bf16_t*)(ws + WS_SK);
    int* idx_o = (int*)(ws + WS_IDX); float* gw_o = (float*)(ws + WS_GW);
    float rt_l;
    { const f32x4* sp = (const f32x4*)((const float*)(ws + WS_SSQ) + (size_t)(t0 + (lane & 31)) * 32); float tot = 0.f;
#pragma unroll
      for (int i = 0; i < 8; ++i) { const f32x4 v = sp[i]; tot += (v[0] + v[1]) + (v[2] + v[3]); }
      rt_l = 1.0f / sqrtf(tot * (1.f / DM) + EPS); }
        {
          const bf16_t* hbp = (const bf16_t*)(ws + WS_HB); const float* amx = (const float*)(ws + WS_AMX); unsigned char* xq = ws + WS_XQ;
          float am = 0.f;
          { const f32x4* ap = (const f32x4*)(amx + (size_t)(t0 + (lane & 31)) * 32);
#pragma unroll
            for (int i = 0; i < 8; ++i) { const f32x4 v = ap[i]; am = fmaxf(am, fmaxf(fmaxf(v[0], v[1]), fmaxf(v[2], v[3]))); } }
          if (h == 0 && lane < 32) ((float*)(ws + WS_SX))[t0 + lane] = rt_l * am * (1.f / 126.5f);
          const float qs = am > 0.f ? 126.5f / am : 1.f;
          u32x4 wv[16];
#pragma unroll
          for (int j = 0; j < 16; ++j) { const int ch = lane + 64 * j; wv[j] = *(const u32x4*)(hbp + (size_t)(t0 + (ch >> 5)) * DM + h * 256 + (ch & 31) * 8); }
#pragma unroll
          for (int j = 0; j < 16; ++j) { const int ch = lane + 64 * j, tl = ch >> 5, tk = t0 + tl, col = h * 256 + (ch & 31) * 8;
              const u32x4 w = wv[j]; const float r = sh_f(qs, tl);
              const int p0 = pack_i8(bf_lo(w.x) * r, bf_hi(w.x) * r, bf_lo(w.y) * r, bf_hi(w.y) * r), p1 = pack_i8(bf_lo(w.z) * r, bf_hi(w.z) * r, bf_lo(w.w) * r, bf_hi(w.w) * r);
              *(u32x2*)(xq + (size_t)tk * DM + col) = (u32x2){(unsigned)p0, (unsigned)p1}; } }
        unsigned L[2][16];
        topk_half(qrow, skb, h, 0, r32, hi, L[0]);
        __builtin_amdgcn_sched_barrier(0);
        topk_half(qrow, skb, h, 1, r32, hi, L[1]);
        __builtin_amdgcn_sched_barrier(0);
        float s1[16], s2[16]; int i1[16], i2[16];
#pragma unroll
        for (int i = 0; i < 16; ++i) { s1[i] = ord2f((L[0][i] & ~127u) | 64u); i1[i] = 127 - (int)(L[0][i] & 127u); s2[i] = ord2f((L[1][i] & ~127u) | 64u); i2[i] = 127 - (int)(L[1][i] & 127u); }
        unsigned CG[4][16];
#pragma unroll
        for (int i = 0; i < 64; ++i) CG[i >> 4][i & 15] = 0u;
        CG[0][0] = (f2ord(s1[0] + s2[0]) & ~255u) | 0u;
        CG[0][1] = (f2ord(s1[0] + s2[1]) & ~255u) | 1u;
        CG[0][2] = (f2ord(s1[0] + s2[2]) & ~255u) | 2u;
        CG[0][3] = (f2ord(s1[0] + s2[3]) & ~255u) | 3u;
        CG[0][4] = (f2ord(s1[0] + s2[4]) & ~255u) | 4u;
        CG[0][5] = (f2ord(s1[0] + s2[5]) & ~255u) | 5u;
        CG[0][6] = (f2ord(s1[0] + s2[6]) & ~255u) | 6u;
        CG[0][7] = (f2ord(s1[0] + s2[7]) & ~255u) | 7u;
        CG[0][8] = (f2ord(s1[0] + s2[8]) & ~255u) | 8u;
        CG[0][9] = (f2ord(s1[0] + s2[9]) & ~255u) | 9u;
        CG[0][10] = (f2ord(s1[0] + s2[10]) & ~255u) | 10u;
        CG[0][11] = (f2ord(s1[0] + s2[11]) & ~255u) | 11u;
        CG[0][12] = (f2ord(s1[0] + s2[12]) & ~255u) | 12u;
        CG[0][13] = (f2ord(s1[0] + s2[13]) & ~255u) | 13u;
        CG[0][14] = (f2ord(s1[0] + s2[14]) & ~255u) | 14u;
        CG[0][15] = (f2ord(s1[0] + s2[15]) & ~255u) | 15u;
        CG[1][0] = (f2ord(s1[1] + s2[0]) & ~255u) | 16u;
        CG[1][1] = (f2ord(s1[1] + s2[1]) & ~255u) | 17u;
        CG[1][2] = (f2ord(s1[1] + s2[2]) & ~255u) | 18u;
        CG[1][3] = (f2ord(s1[1] + s2[3]) & ~255u) | 19u;
        CG[1][4] = (f2ord(s1[1] + s2[4]) & ~255u) | 20u;
        CG[1][5] = (f2ord(s1[1] + s2[5]) & ~255u) | 21u;
        CG[1][6] = (f2ord(s1[1] + s2[6]) & ~255u) | 22u;
        CG[1][7] = (f2ord(s1[1] + s2[7]) & ~255u) | 23u;
        CG[1][8] = (f2ord(s1[2] + s2[0]) & ~255u) | 32u;
        CG[1][9] = (f2ord(s1[2] + s2[1]) & ~255u) | 33u;
        CG[1][10] = (f2ord(s1[2] + s2[2]) & ~255u) | 34u;
        CG[1][11] = (f2ord(s1[2] + s2[3]) & ~255u) | 35u;
        CG[1][12] = (f2ord(s1[2] + s2[4]) & ~255u) | 36u;
        CG[1][13] = (f2ord(s1[3] + s2[0]) & ~255u) | 48u;
        CG[1][14] = (f2ord(s1[3] + s2[1]) & ~255u) | 49u;
        CG[1][15] = (f2ord(s1[3] + s2[2]) & ~255u) | 50u;
        CG[2][0] = (f2ord(s1[3] + s2[3]) & ~255u) | 51u;
        CG[2][1] = (f2ord(s1[4] + s2[0]) & ~255u) | 64u;
        CG[2][2] = (f2ord(s1[4] + s2[1]) & ~255u) | 65u;
        CG[2][3] = (f2ord(s1[4] + s2[2]) & ~255u) | 66u;
        CG[2][4] = (f2ord(s1[5] + s2[0]) & ~255u) | 80u;
        CG[2][5] = (f2ord(s1[5] + s2[1]) & ~255u) | 81u;
        CG[2][6] = (f2ord(s1[6] + s2[0]) & ~255u) | 96u;
        CG[2][7] = (f2ord(s1[6] + s2[1]) & ~255u) | 97u;
        CG[2][8] = (f2ord(s1[7] + s2[0]) & ~255u) | 112u;
        CG[2][9] = (f2ord(s1[7] + s2[1]) & ~255u) | 113u;
        CG[2][10] = (f2ord(s1[8] + s2[0]) & ~255u) | 128u;
        CG[2][11] = (f2ord(s1[9] + s2[0]) & ~255u) | 144u;
        CG[2][12] = (f2ord(s1[10] + s2[0]) & ~255u) | 160u;
        CG[2][13] = (f2ord(s1[11] + s2[0]) & ~255u) | 176u;
        CG[2][14] = (f2ord(s1[12] + s2[0]) & ~255u) | 192u;
        CG[2][15] = (f2ord(s1[13] + s2[0]) & ~255u) | 208u;
        CG[3][0] = (f2ord(s1[14] + s2[0]) & ~255u) | 224u;
        CG[3][1] = (f2ord(s1[15] + s2[0]) & ~255u) | 240u;
        sort16_desc(CG[0]); sort16_desc(CG[1]); sort16_desc(CG[2]); sort16_desc(CG[3]);
        merge_top16(CG[0], CG[1]); merge_top16(CG[2], CG[3]); merge_top16(CG[0], CG[2]);
        unsigned LC[16];
#pragma unroll
        for (int i = 0; i < 16; ++i) LC[i] = CG[0][i];
#pragma unroll
        for (int i = 0; i < 16; ++i) { tb[i * 64 + lane] = i1[i]; tb[(16 + i) * 64 + lane] = i2[i]; }
        float LS[16]; int LP[16];
#pragma unroll
        for (int i = 0; i < 16; ++i) { const unsigned cid = LC[i] & 255u; LS[i] = ord2f((LC[i] & ~255u) | 128u);
            LP[i] = tb[(cid >> 4) * 64 + lane] * 128 + tb[(16 + (cid & 15u)) * 64 + lane]; }
        float den = 0.f, e[16];
#pragma unroll
        for (int i = 0; i < 16; ++i) { e[i] = __expf(LS[i] - LS[0]); den += e[i]; }
        const float rden = 1.f / den;
        const size_t ob = (size_t)(t0 + r32) * NE + h * 16;
        if (hi == 0) {
#pragma unroll
            for (int i = 0; i < 4; ++i) *(int4*)(idx_o + ob + 4 * i) = make_int4(LP[4 * i], LP[4 * i + 1], LP[4 * i + 2], LP[4 * i + 3]);
            { unsigned short* i16 = (unsigned short*)(ws + WS_IDX16) + ob;
#pragma unroll
              for (int i = 0; i < 2; ++i) *(u32x4*)(i16 + 8 * i) = (u32x4){(unsigned)LP[8 * i] | ((unsigned)LP[8 * i + 1] << 16), (unsigned)LP[8 * i + 2] | ((unsigned)LP[8 * i + 3] << 16),
                                                                        (unsigned)LP[8 * i + 4] | ((unsigned)LP[8 * i + 5] << 16), (unsigned)LP[8 * i + 6] | ((unsigned)LP[8 * i + 7] << 16)}; }
        } else {
#pragma unroll
            for (int i = 0; i < 4; ++i) *(f32x4*)(gw_o + ob + 4 * i) = (f32x4){e[4 * i] * rden, e[4 * i + 1] * rden, e[4 * i + 2] * rden, e[4 * i + 3] * rden};
        }
}
__device__ __forceinline__ void phase_topk(const Args& a, unsigned char* lds_g) {
    LAS unsigned char* lds = (LAS unsigned char*)lds_g;
    const int tid = tid_opaque(), lane = tid & 63, wave = tid >> 6;
    const int gw = blockIdx.x * NWAVES + wave, NGW = gridDim.x * NWAVES;
    const bf16_t* qp = (const bf16_t*)(a.ws + WS_QP);
    for (int task = gw; task < (T / 32) * 8; task += NGW) {
        const int h = task & 7, t0 = (task >> 3) * 32;
        topk_task(a.ws, qp + (size_t)(t0 + (lane & 31)) * DM + h * 256, (LAS int*)(lds + wave * 8192), t0, h, lane);
    }
}
__device__ __forceinline__ void pg8::EpiPeerQFused::fused(const f32x4 (&acc)[2][2][4][2], const Unit& u, int wr, int wc, int fr, int fq, PG8_LAS unsigned char* lds) const {
    constexpr int ROWB = 528;
#pragma unroll
    for (int ai = 0; ai < 2; ++ai)
#pragma unroll
        for (int m = 0; m < 4; ++m) {
            const int tr = ai * HALF + wr * 64 + m * 16 + fr, tk = u.pm * BM + tr;
            float tot = 0.f;
#pragma unroll
            for (int i = 0; i < 8; ++i) { const f32x4 s4 = *(const f32x4*)(ssq + (size_t)tk * 32 + 4 * i); tot += (s4[0] + s4[1]) + (s4[2] + s4[3]); }
            const float r = 1.0f / sqrtf(tot * (1.f / DM) + EPS);
#pragma unroll
            for (int bj = 0; bj < 2; ++bj) {
                const f32x4 v0 = acc[ai][bj][m][0] * r, v1 = acc[ai][bj][m][1] * r;
                u32x4 w; w.x = cvt_pk_bf16(v0[0], v0[1]); w.y = cvt_pk_bf16(v0[2], v0[3]); w.z = cvt_pk_bf16(v1[0], v1[1]); w.w = cvt_pk_bf16(v1[2], v1[3]);
                *(PG8_LAS u32x4*)(lds + tr * ROWB + (bj * HALF + wc * 32 + 8 * fq) * 2) = w;
            }
        }
    __syncthreads();
    const int tid = tid_opaque(), lane = tid & 63, wave = tid >> 6;
    PG8_LAS unsigned char* myrows = lds + (wave * 32) * ROWB;
    topk_task(wsb, (const bf16_t*)(const void*)(myrows + (lane & 31) * ROWB), (LAS int*)myrows, u.pm * BM + wave * 32, u.pn, lane);
}
__device__ __forceinline__ void wave_argmax(float& v, int& i) {
#pragma unroll
    for (int o = 1; o < 64; o <<= 1) { const float ov = sx_f(v, o); const int oi = sx_i(i, o); if (ov > v || (ov == v && oi < i)) { v = ov; i = oi; } }
}
__device__ __forceinline__ void phase_topk_ref(const Args& a) {
    const int tid = tid_opaque(), lane = tid & 63, wave = tid >> 6;
    const int gw = blockIdx.x * NWAVES + wave, NGW = gridDim.x * NWAVES;
    const bf16_t* skb = (const bf16_t*)(a.ws + WS_SK); const bf16_t* qp = (const bf16_t*)(a.ws + WS_QP);
    int* idx_o = (int*)(a.ws + WS_IDX); float* gw_o = (float*)(a.ws + WS_GW);
    for (int task = gw; task < T * 8; task += NGW) {
        const int t = task >> 3, h = task & 7;
        float topS[2]; int topI[2];
        for (int c = 0; c < 2; ++c) {
            const bf16_t* q = qp + (size_t)t * DM + h * 256 + c * 128;
            float sc0 = 0.f, sc1 = 0.f;
            const bf16_t* k0 = skb + (size_t)((h * 2 + c) * 128 + lane) * 128; const bf16_t* k1 = k0 + 64 * 128;
            for (int d = 0; d < 128; ++d) { const float qd = __uint_as_float((unsigned)q[d] << 16);
                sc0 += qd * __uint_as_float((unsigned)k0[d] << 16); sc1 += qd * __uint_as_float((unsigned)k1[d] << 16); }
            float ms = 0.f; int mi = 0;
            for (int r = 0; r < 16; ++r) {
                float v; int i; if (sc0 >= sc1) { v = sc0; i = lane; } else { v = sc1; i = lane + 64; }
                wave_argmax(v, i);
                if (lane == r) { ms = v; mi = i; }
                if (i == lane) sc0 = -__builtin_inff();
                if (i == lane + 64) sc1 = -__builtin_inff();
            }
            topS[c] = ms; topI[c] = mi;
        }
        float cs[4]; int ci[4];
#pragma unroll
        for (int j = 0; j < 4; ++j) { const int cidx = lane * 4 + j, aa = cidx >> 4, bb = cidx & 15;
            cs[j] = sh_f(topS[0], aa) + sh_f(topS[1], bb); ci[j] = cidx; }
        float fs = 0.f; int fi = 0;
        for (int r = 0; r < 16; ++r) {
            float v = cs[0]; int i = ci[0];
#pragma unroll
            for (int j = 1; j < 4; ++j) if (cs[j] > v) { v = cs[j]; i = ci[j]; }
            wave_argmax(v, i);
            if (lane == r) { fs = v; fi = i; }
#pragma unroll
            for (int j = 0; j < 4; ++j) if (ci[j] == i) cs[j] = -__builtin_inff();
        }
        const int e1 = sh_i(topI[0], fi >> 4), e2 = sh_i(topI[1], fi & 15);
        const float mx = sh_f(fs, 0);
        float ev = lane < 16 ? __expf(fs - mx) : 0.f;
        const float den = wave_sum(ev);
        if (lane < 16) { idx_o[(size_t)t * NE + h * 16 + lane] = e1 * 128 + e2; gw_o[(size_t)t * NE + h * 16 + lane] = ev / den; }
    }
}

__device__ __forceinline__ void fp8x16_to_f32(const u32x4 q, f32x2 (&o)[8]) {
    o[0] = __builtin_amdgcn_cvt_pk_f32_fp8((int)q.x, false); o[1] = __builtin_amdgcn_cvt_pk_f32_fp8((int)q.x, true);
    o[2] = __builtin_amdgcn_cvt_pk_f32_fp8((int)q.y, false); o[3] = __builtin_amdgcn_cvt_pk_f32_fp8((int)q.y, true);
    o[4] = __builtin_amdgcn_cvt_pk_f32_fp8((int)q.z, false); o[5] = __builtin_amdgcn_cvt_pk_f32_fp8((int)q.z, true);
    o[6] = __builtin_amdgcn_cvt_pk_f32_fp8((int)q.w, false); o[7] = __builtin_amdgcn_cvt_pk_f32_fp8((int)q.w, true);
}
#define HALVE(dst, srcv, n, bitmask) do { const bool up_ = (lane & (bitmask)) != 0; _Pragma("unroll") for (int i_ = 0; i_ < (n); ++i_) { \
        const float keep_ = up_ ? srcv[(n) + i_] : srcv[i_], send_ = up_ ? srcv[i_] : srcv[(n) + i_]; dst[i_] = keep_ + sx_f(send_, (bitmask)); } } while (0)
#define ITEM_T(n) (wv + ((n) % KT) * NWX)
#define ITEM_S(n) (xl + 8 * ((n) / KT))
#define LD_IDX(ID, n) do { const int4* ip_ = (const int4*)(idx_i + (size_t)ITEM_T(n) * NE + g * 16); _Pragma("unroll") for (int i_ = 0; i_ < 4; ++i_) ID[i_] = ip_[i_]; } while (0)
#define LD_ROWS(Q, ID, TAB, n) do { const unsigned char* b_ = (TAB) + (size_t)ITEM_S(n) * ((size_t)NEXP * 128) + c * 16; _Pragma("unroll") for (int i_ = 0; i_ < 4; ++i_) { \
        Q[4 * i_] = *(const u32x4*)(b_ + (size_t)ID[i_].x * 128); Q[4 * i_ + 1] = *(const u32x4*)(b_ + (size_t)ID[i_].y * 128); \
        Q[4 * i_ + 2] = *(const u32x4*)(b_ + (size_t)ID[i_].z * 128); Q[4 * i_ + 3] = *(const u32x4*)(b_ + (size_t)ID[i_].w * 128); } } while (0)
__device__ __forceinline__ int dpp_hmirror(int v) { return __builtin_amdgcn_update_dpp(0, v, 0x141, 0xf, 0xf, true); }
__device__ __forceinline__ int dpp_qxor2(int v) { return __builtin_amdgcn_update_dpp(0, v, 0x4E, 0xf, 0xf, true); }
__device__ __forceinline__ int dpp_qxor1(int v) { return __builtin_amdgcn_update_dpp(0, v, 0xB1, 0xf, 0xf, true); }
__device__ __forceinline__ void phase_peer_u(const Args& a) {
    const int tid = tid_opaque(), lane = tid & 63, wave = tid >> 6, g = lane >> 3, c = lane & 7;
    const int xl = blockIdx.x & 7, wv = (blockIdx.x >> 3) * NWAVES + wave, NWX = (gridDim.x >> 3) * NWAVES, KT = T / NWX, N = 2 * KT;
    const unsigned char* xq = a.ws + WS_XQ; const unsigned char* u8 = a.ws + WS_U8;
    const unsigned short* idx16 = (const unsigned short*)(a.ws + WS_IDX16); bf16_t* part = (bf16_t*)(a.ws + WS_PART);
    const bool up4 = (c & 4) != 0, up2 = (c & 2) != 0, up1 = (c & 1) != 0;
#define LD_I16(ID, n, h) do { ID = *(const u32x4*)(idx16 + (size_t)ITEM_T(n) * NE + g * 16 + (h) * 8); } while (0)
#define LD_R8(Q, ID, n) do { const unsigned char* b_ = u8 + (size_t)ITEM_S(n) * ((size_t)NEXP * 128) + c * 16; \
        Q[0] = *(const u32x4*)(b_ + (size_t)(ID.x & 0xffffu) * 128); Q[1] = *(const u32x4*)(b_ + (size_t)(ID.x >> 16) * 128); \
        Q[2] = *(const u32x4*)(b_ + (size_t)(ID.y & 0xffffu) * 128); Q[3] = *(const u32x4*)(b_ + (size_t)(ID.y >> 16) * 128); \
        Q[4] = *(const u32x4*)(b_ + (size_t)(ID.z & 0xffffu) * 128); Q[5] = *(const u32x4*)(b_ + (size_t)(ID.z >> 16) * 128); \
        Q[6] = *(const u32x4*)(b_ + (size_t)(ID.w & 0xffffu) * 128); Q[7] = *(const u32x4*)(b_ + (size_t)(ID.w >> 16) * 128); } while (0)
#define LD_X(X, n) do { X = *(const u32x4*)(xq + (size_t)ITEM_T(n) * DM + ITEM_S(n) * 128 + c * 16); } while (0)
#define DOT8(P, OFF, Q, X) do { _Pragma("unroll") for (int i = 0; i < 8; ++i) { int d_ = __builtin_amdgcn_sdot4((int)Q[i].x, (int)X.x, 0, false); d_ = __builtin_amdgcn_sdot4((int)Q[i].y, (int)X.y, d_, false); \
            d_ = __builtin_amdgcn_sdot4((int)Q[i].z, (int)X.z, d_, false); P[(OFF) + i] = __builtin_amdgcn_sdot4((int)Q[i].w, (int)X.w, d_, false); } } while (0)
#define FINISH_U(P, n) do { int p8[8], p4[4], p2[2]; \
        _Pragma("unroll") for (int i = 0; i < 8; ++i) { const int keep_ = up4 ? P[8 + i] : P[i], send_ = up4 ? P[i] : P[8 + i]; p8[i] = keep_ + dpp_hmirror(send_); } \
        _Pragma("unroll") for (int i = 0; i < 4; ++i) { const int keep_ = up2 ? p8[4 + i] : p8[i], send_ = up2 ? p8[i] : p8[4 + i]; p4[i] = keep_ + dpp_qxor2(send_); } \
        _Pragma("unroll") for (int i = 0; i < 2; ++i) { const int keep_ = up1 ? p4[2 + i] : p4[i], send_ = up1 ? p4[i] : p4[2 + i]; p2[i] = keep_ + dpp_qxor1(send_); } \
        *(unsigned*)(part + ((size_t)ITEM_T(n) * 16 + ITEM_S(n)) * NE + 2 * lane) = cvt_pk_bf16((float)p2[0], (float)p2[1]); } while (0)
    u32x4 IA, IB, IC, ID_, QA[8], QB[8], QC[8], QD[8], XA, XB;
    LD_I16(IA, 0, 0); LD_I16(IB, 0, 1); LD_I16(IC, 1, 0); LD_I16(ID_, 1, 1);
    LD_R8(QA, IA, 0); LD_R8(QB, IB, 0); LD_X(XA, 0); LD_R8(QC, IC, 1); LD_R8(QD, ID_, 1); LD_X(XB, 1);
    if (N > 2) { LD_I16(IA, 2, 0); LD_I16(IB, 2, 1); LD_I16(IC, 3, 0); LD_I16(ID_, 3, 1); }
    for (int n = 0; n < N; n += 2) {
        int p[16];
        DOT8(p, 0, QA, XA); if (n + 2 < N) { LD_R8(QA, IA, n + 2); if (n + 4 < N) LD_I16(IA, n + 4, 0); }
        DOT8(p, 8, QB, XA); if (n + 2 < N) { LD_R8(QB, IB, n + 2); LD_X(XA, n + 2); if (n + 4 < N) LD_I16(IB, n + 4, 1); }
        FINISH_U(p, n);
        int r[16];
        DOT8(r, 0, QC, XB); if (n + 3 < N) { LD_R8(QC, IC, n + 3); if (n + 5 < N) LD_I16(IC, n + 5, 0); }
        DOT8(r, 8, QD, XB); if (n + 3 < N) { LD_R8(QD, ID_, n + 3); LD_X(XB, n + 3); if (n + 5 < N) LD_I16(ID_, n + 5, 1); }
        FINISH_U(r, n + 1);
    }
#undef LD_I16
#undef LD_R8
#undef LD_X
#undef DOT8
#undef FINISH_U
}
__device__ __forceinline__ void phase_peer_w(const Args& a) {
    const int gt = blockIdx.x * NTHREADS + tid_opaque(), NGT = gridDim.x * NTHREADS;
    const int* idx_i = (const int*)(a.ws + WS_IDX); const float* gw_i = (const float*)(a.ws + WS_GW); const bf16_t* part = (const bf16_t*)(a.ws + WS_PART);
    const float* suv = (const float*)(a.ws + WS_SUV); const float* sx = (const float*)(a.ws + WS_SX);
    signed char* wq = (signed char*)(a.ws + WS_WQ); float* sw = (float*)(a.ws + WS_SW);
    for (int item = gt; item < T * NE; item += NGT) {
        const int t = item >> 7, e = item & 127;
        float sum = 0.f;
#pragma unroll
        for (int s = 0; s < 16; ++s) sum += __uint_as_float((unsigned)part[((size_t)t * 16 + s) * NE + e] << 16);
        const int ex = idx_i[item];
        const float d = sum * suv[ex] * sx[t];
        const float om = 0.5f * d * (1.f + erff(d * 0.70710678118654752f)) * gw_i[item] * suv[NEXP + ex];
        float mx = fabsf(om);
        mx = fmaxf(mx, sx_f(mx, 1)); mx = fmaxf(mx, sx_f(mx, 2)); mx = fmaxf(mx, sx_f(mx, 4)); mx = fmaxf(mx, sx_f(mx, 8));
        const float qs = mx > 0.f ? 127.f / mx : 1.f;
        wq[item] = (signed char)(int)__builtin_rintf(om * qs);
        if ((e & 15) == 0) sw[t * 8 + (e >> 4)] = mx * (1.f / 127.f);
    }
}
__device__ __forceinline__ void phase_peer_v(const Args& a, float* dst) {
    const int tid = tid_opaque(), lane = tid & 63, wave = tid >> 6, g = lane >> 3, c = lane & 7;
    const int xl = blockIdx.x & 7, wv = (blockIdx.x >> 3) * NWAVES + wave, NWX = (gridDim.x >> 3) * NWAVES, KT = T / NWX, N = 2 * KT;
    const unsigned char* v8 = a.ws + WS_V8;
    const int* idx_i = (const int*)(a.ws + WS_IDX); const unsigned char* wq = a.ws + WS_WQ; const float* sw = (const float*)(a.ws + WS_SW);
    const bf16_t* hsrc = (const bf16_t*)(a.ws + WS_HB);
#define LD_W(W, SWV, HV, n) do { W = *(const u32x4*)(wq + (size_t)ITEM_T(n) * NE + g * 16); SWV = sw[ITEM_T(n) * 8 + g]; HV = *(const unsigned*)(hsrc + (size_t)ITEM_T(n) * DM + ITEM_S(n) * 128 + 2 * lane); } while (0)
#define QUAD(A_, B_, C_, D_, W_, A0, A1, A2, A3) do { \
        const unsigned ablo_ = __builtin_amdgcn_perm(B_, A_, 0x05010400u), abhi_ = __builtin_amdgcn_perm(B_, A_, 0x07030602u); \
        const unsigned cdlo_ = __builtin_amdgcn_perm(D_, C_, 0x05010400u), cdhi_ = __builtin_amdgcn_perm(D_, C_, 0x07030602u); \
        A0 = __builtin_amdgcn_sdot4((int)__builtin_amdgcn_perm(cdlo_, ablo_, 0x05040100u), (int)(W_), A0, false); \
        A1 = __builtin_amdgcn_sdot4((int)__builtin_amdgcn_perm(cdlo_, ablo_, 0x07060302u), (int)(W_), A1, false); \
        A2 = __builtin_amdgcn_sdot4((int)__builtin_amdgcn_perm(cdhi_, abhi_, 0x05040100u), (int)(W_), A2, false); \
        A3 = __builtin_amdgcn_sdot4((int)__builtin_amdgcn_perm(cdhi_, abhi_, 0x07060302u), (int)(W_), A3, false); } while (0)
#define COMPUTE_V(Q, W, SWV, HV, n) do { int ac[16]; _Pragma("unroll") for (int k = 0; k < 16; ++k) ac[k] = 0; \
        _Pragma("unroll") for (int q_ = 0; q_ < 4; ++q_) { const unsigned w_ = q_ == 0 ? W.x : q_ == 1 ? W.y : q_ == 2 ? W.z : W.w; \
            QUAD(Q[4 * q_].x, Q[4 * q_ + 1].x, Q[4 * q_ + 2].x, Q[4 * q_ + 3].x, w_, ac[0], ac[1], ac[2], ac[3]); \
            QUAD(Q[4 * q_].y, Q[4 * q_ + 1].y, Q[4 * q_ + 2].y, Q[4 * q_ + 3].y, w_, ac[4], ac[5], ac[6], ac[7]); \
            QUAD(Q[4 * q_].z, Q[4 * q_ + 1].z, Q[4 * q_ + 2].z, Q[4 * q_ + 3].z, w_, ac[8], ac[9], ac[10], ac[11]); \
            QUAD(Q[4 * q_].w, Q[4 * q_ + 1].w, Q[4 * q_ + 2].w, Q[4 * q_ + 3].w, w_, ac[12], ac[13], ac[14], ac[15]); } \
        float p[16]; _Pragma("unroll") for (int k = 0; k < 16; ++k) p[k] = (float)ac[k] * SWV; \
        float p8[8], p4[4], p2[2]; \
        _Pragma("unroll") for (int i_ = 0; i_ < 8; ++i_) { auto rr_ = __builtin_amdgcn_permlane32_swap(__float_as_uint(p[i_]), __float_as_uint(p[8 + i_]), false, false); p8[i_] = __uint_as_float(rr_[0]) + __uint_as_float(rr_[1]); } \
        _Pragma("unroll") for (int i_ = 0; i_ < 4; ++i_) { auto rr_ = __builtin_amdgcn_permlane16_swap(__float_as_uint(p8[i_]), __float_as_uint(p8[4 + i_]), false, false); p4[i_] = __uint_as_float(rr_[0]) + __uint_as_float(rr_[1]); } \
        HALVE(p2, p4, 2, 8); \
        const int srcl_ = ((lane & 7) << 3) | (lane >> 3);                     \
        const float q0_ = sh_f(p2[0], srcl_), q1_ = sh_f(p2[1], srcl_); \
        const size_t o_ = (size_t)ITEM_T(n) * DM + ITEM_S(n) * 128 + 2 * lane; \
        *(f32x2*)(dst + o_) = (f32x2){bf_lo(HV) + q0_, bf_hi(HV) + q1_}; } while (0)
    int4 IA[4], IB[4]; u32x4 QA[16], QB[16], WA, WB; float SA, SB_; unsigned HA, HB_;
    LD_IDX(IA, 0); LD_IDX(IB, 1);
    LD_ROWS(QA, IA, v8, 0); LD_W(WA, SA, HA, 0);
    for (int n = 0; n < N; n += 2) {
        LD_ROWS(QB, IB, v8, n + 1); LD_W(WB, SB_, HB_, n + 1);
        if (n + 2 < N) LD_IDX(IA, n + 2);
        COMPUTE_V(QA, WA, SA, HA, n);
        if (n + 2 < N) { LD_ROWS(QA, IA, v8, n + 2); LD_W(WA, SA, HA, n + 2); }
        if (n + 3 < N) LD_IDX(IB, n + 3);
        COMPUTE_V(QB, WB, SB_, HB_, n + 1);
    }
#undef LD_W
#undef QUAD
#undef COMPUTE_V
}
#undef ITEM_T
#undef ITEM_S
#undef LD_IDX
#undef LD_ROWS
#undef HALVE


constexpr int NPHASE = 11;
#define LOAD_ARGS() do { } while (0)
__global__ void __launch_bounds__(NTHREADS, 2) fwd_kernel(Args a) {
    extern __shared__ __attribute__((aligned(16))) unsigned char lds[];
#if MK_ONE_LAUNCH
    constexpr int lo = 0, hi = NPHASE;
    cg::grid_group grid = cg::this_grid();
    volatile LAS unsigned* misc = (volatile LAS unsigned*)((LAS unsigned char*)lds + MISC_OFF);
    if (threadIdx.x < 16) misc[threadIdx.x] = 0u;
    __syncthreads();
    { LOAD_ARGS(); (void)xcd_barrier_post((unsigned*)(a.ws + WS_CTL) + CW_BAR, misc + 8); }
#ifndef SEAM_CG_MASK
#define SEAM_CG_MASK 0
#endif
#define SEAM(k) do { if (lo <= (k) && (k) + 1 < hi) { if ((SEAM_CG_MASK >> (k)) & 1) grid.sync(); else { LOAD_ARGS(); XcdBarrier xb_; xb_.bar = (unsigned*)(a.ws + WS_CTL) + CW_BAR; xb_.x = xb_xcc_id(); \
        xb_.st = (volatile LAS unsigned*)((LAS unsigned char*)lds + MISC_OFF) + 8; xcd_barrier(xb_); } } } while (0)
#else
    int lo, hi; { LOAD_ARGS(); lo = a.ph_lo; hi = a.ph_hi; }
#define SEAM(k) do { } while (0)
#endif
#define IN(k) (lo <= (k) && (k) < hi)
#ifndef DUP_PHASE
#define DUP_PHASE -1
#endif
    if (IN(0)) { LOAD_ARGS(); phase0(a, lds); if (DUP_PHASE == 0) { __syncthreads(); phase0(a, lds); } SEAM(0); }
    if (IN(1)) { LOAD_ARGS(); unsigned char* ws = a.ws;
        cumsum_rows(a);
        pg8::Gemm g{(const bf16_t*)(ws + WS_XN), (const bf16_t*)(ws + WS_WIN), T, NPROJ, DM}; pg8::StaticOrder S; S.init(T, NPROJ, (int)gridDim.x, (int)blockIdx.x);
        pg8::EpiInProj E{(bf16_t*)(ws + WS_SEC), (const float*)(ws + WS_SXN), (const float*)(ws + WS_WSC), a.in[4], a.in[5], (LAS float*)((LAS unsigned char*)lds + RING_BYTES)};
        for (int rep_ = 0; rep_ < (DUP_PHASE == 1 ? 2 : 1); ++rep_)
        pg8::gemm_phase<pg8::EpiInProj, pg8::StaticOrder, true, true, true>((LAS unsigned char*)lds, g, S, E);
        { const int nwg_ = (T / 256) * (NPROJ / 256), G_ = (int)gridDim.x, rem_ = nwg_ % G_;
          if (rem_ > 0 && (int)blockIdx.x >= rem_) convert_tables(a, TAB_SPLIT, 2 * NEXP, ((int)blockIdx.x - rem_) * NWAVES + (tid_opaque() >> 6), (G_ - rem_) * NWAVES);
          else if (rem_ == 0) convert_tables(a, TAB_SPLIT, 2 * NEXP, (int)blockIdx.x * NWAVES + (tid_opaque() >> 6), G_ * NWAVES); }
        SEAM(1);
    }
    if (IN(3)) { LOAD_ARGS(); phase_attn(a, lds);
#if MK_ONE_LAUNCH
        if (DUP_PHASE == 3) { XcdBarrier xb_; xb_.bar = (unsigned*)(a.ws + WS_CTL) + CW_BAR; xb_.x = xb_xcc_id(); xb_.st = (volatile LAS unsigned*)((LAS unsigned char*)lds + MISC_OFF) + 8;
            xcd_barrier(xb_); if (blockIdx.x == 0 && threadIdx.x == 0) __hip_atomic_store((unsigned*)(a.ws + WS_CTL), 0u, __ATOMIC_RELAXED, __HIP_MEMORY_SCOPE_AGENT); xcd_barrier(xb_); phase_attn(a, lds); }
#endif
        SEAM(3); }
    if (IN(4)) { LOAD_ARGS(); phase_attn_combine(a); SEAM(4); }
    if (IN(5)) { LOAD_ARGS(); unsigned char* ws = a.ws;
        pg8::Gemm g{(const bf16_t*)(ws + WS_MIX), (const bf16_t*)(ws + WS_WOUT), T, DM, DM}; pg8::StaticOrder S; S.init(T, DM, (int)gridDim.x, (int)blockIdx.x);
        pg8::EpiOutProj E{a.in[0], a.out, (bf16_t*)(ws + WS_HB), (float*)(ws + WS_SSQ), (float*)(ws + WS_AMX)};
        for (int rep_ = 0; rep_ < (DUP_PHASE == 5 ? 2 : 1); ++rep_)
        pg8::gemm_phase<pg8::EpiOutProj, pg8::StaticOrder, true, true>((LAS unsigned char*)lds, g, S, E);
        SEAM(5);
    }
    if (IN(6)) { LOAD_ARGS(); unsigned char* ws = a.ws;
        pg8::Gemm g{(const bf16_t*)(ws + WS_HB), (const bf16_t*)(ws + WS_WPQ), T, DM, DM}; pg8::StaticOrder S; S.init(T, DM, (int)gridDim.x, (int)blockIdx.x);
        pg8::EpiPeerQFused E{(const float*)(ws + WS_SSQ), ws};
        pg8::gemm_phase<pg8::EpiPeerQFused, pg8::StaticOrder, true, true>((LAS unsigned char*)lds, g, S, E);
        SEAM(6);
    }
    if (IN(8)) { LOAD_ARGS(); for (int rep_ = 0; rep_ < (DUP_PHASE == 8 ? 2 : 1); ++rep_) phase_peer_u(a); SEAM(8); }
    if (IN(9)) { LOAD_ARGS(); for (int rep_ = 0; rep_ < (DUP_PHASE == 9 ? 2 : 1); ++rep_) phase_peer_w(a); SEAM(9); }
    if (IN(10)) { LOAD_ARGS(); for (int rep_ = 0; rep_ < (DUP_PHASE == 10 ? 2 : 1); ++rep_) phase_peer_v(a, (DUP_PHASE == 10 && rep_ == 0) ? (float*)(a.ws + WS_END) : a.out); }
#undef IN
#undef SEAM
}

extern "C" void kernel_launch(void* const* d_in, const int* in_sizes, int n_in, void* d_out, int out_size, void* d_ws, size_t ws_size, hipStream_t stream) {
    static int grid = 0;
    if (grid == 0) {
        if (n_in != 12 || in_sizes[0] != T * DM || out_size != T * DM || ws_size < WS_END) { fprintf(stderr, "kernel_launch: unexpected shapes (n_in %d, in0 %d, out %d, ws %zu)\n", n_in, n_in > 0 ? in_sizes[0] : -1, out_size, ws_size); grid = -1; return; }
        int dev = 0, cus = 0, per_cu = 0;
        if (hipGetDevice(&dev) != hipSuccess || hipDeviceGetAttribute(&cus, hipDeviceAttributeMultiprocessorCount, dev) != hipSuccess) { grid = -1; return; }
        if (hipFuncSetAttribute((const void*)fwd_kernel, hipFuncAttributeMaxDynamicSharedMemorySize, LDS_BYTES) != hipSuccess) { fprintf(stderr, "kernel_launch: hipFuncSetAttribute failed\n"); grid = -1; return; }
        if (hipOccupancyMaxActiveBlocksPerMultiprocessor(&per_cu, (const void*)fwd_kernel, NTHREADS, LDS_BYTES) != hipSuccess || per_cu < 1) { fprintf(stderr, "kernel_launch: occupancy query says %d\n", per_cu); grid = -1; return; }
        grid = cus;
    }
    if (grid < 0) return;
    (void)hipMemsetAsync((char*)d_ws + WS_CTL, 0, CTL_BYTES, stream);
    Args a{};
    for (int i = 0; i < 12; ++i) a.in[i] = (const float*)d_in[i];
    a.out = (float*)d_out; a.ws = (unsigned char*)d_ws;
#if MK_ONE_LAUNCH
    a.ph_lo = 0; a.ph_hi = NPHASE;
    void* args[] = {&a};
#if MK_COOP_LAUNCH
    hipError_t e = hipLaunchCooperativeKernel((const void*)fwd_kernel, dim3(grid), dim3(NTHREADS), args, LDS_BYTES, stream);
    if (e != hipSuccess) fprintf(stderr, "cooperative launch failed: %s (grid %d)\n", hipGetErrorString(e), grid);
#else
    (void)args; hipLaunchKernelGGL(fwd_kernel, dim3(grid), dim3(NTHREADS), LDS_BYTES, stream, a);
#endif
#else
    for (int p = 0; p < NPHASE; ++p) { a.ph_lo = p; a.ph_hi = p + 1; hipLaunchKernelGGL(fwd_kernel, dim3(grid), dim3(NTHREADS), LDS_BYTES, stream, a); }
#endif
}
```

```cpp
#include <hip/hip_runtime.h>
#include <hip/hip_cooperative_groups.h>
#include <cstdio>
#include <cstdint>
namespace cg = cooperative_groups;

#ifndef MK_COOP_LAUNCH
#define MK_COOP_LAUNCH 0
#endif
#ifndef MK_ONE_LAUNCH
#define MK_ONE_LAUNCH 1
#endif

#define LAS __attribute__((address_space(3)))
typedef unsigned short bf16_t;
typedef short bf16x8 __attribute__((ext_vector_type(8)));
typedef short s16x4 __attribute__((ext_vector_type(4)));
typedef float f32x2 __attribute__((ext_vector_type(2)));
typedef float f32x4 __attribute__((ext_vector_type(4)));
typedef float f32x16 __attribute__((ext_vector_type(16)));
typedef unsigned u32x2 __attribute__((ext_vector_type(2)));
typedef unsigned u32x4 __attribute__((ext_vector_type(4)));
typedef __bf16 bf16x2_t __attribute__((ext_vector_type(2)));

constexpr int NB = 2, SEQ = 4096, T = NB * SEQ, DM = 2048, HD = 128, NHF = 8, DIN = 7176, NPROJ = 7168;
constexpr int NEXP = 16384, NE = 128;
constexpr float EPS = 1e-6f;
constexpr float SCALE = 0.08838834764831845f, LOG2E = 1.4426950408889634f;
constexpr int NWAVES = 8, NTHREADS = 512;

constexpr size_t MiB = 1u << 20;
constexpr size_t WS_CTL = 0, CTL_BYTES = 32768;
constexpr int CW_BAR = 1024;
constexpr size_t WS_SXN = 64 * MiB  , WS_WSC = 45 * MiB + 800 * 1024  ;
constexpr int CW_WMAX = 64;
constexpr size_t WS_GQK = 45 * MiB + 768 * 1024;
constexpr size_t WS_WIN = 1 * MiB, WS_WOUT = 29 * MiB, WS_WPQ = 37 * MiB, WS_SK = 45 * MiB, WS_LOGF = 46 * MiB, WS_C = 46 * MiB + 512 * 1024, WS_SSQ = 47 * MiB;
constexpr size_t WS_XN = 48 * MiB;
constexpr size_t WS_SEC = 80 * MiB;
constexpr size_t SEC_ELEMS = 8u << 20;
constexpr size_t WS_MIX = 192 * MiB, WS_HB = 224 * MiB, WS_QP = 256 * MiB, WS_IDX = 288 * MiB, WS_GW = 292 * MiB, WS_U8 = 296 * MiB, WS_V8 = 328 * MiB, WS_SUV = 360 * MiB  , WS_RT = 360 * MiB + 256 * 1024  , WS_W = 361 * MiB  ,
                 WS_PART = 368 * MiB  , WS_XQ = 432 * MiB  , WS_END = 448 * MiB;
constexpr size_t WS_IDX16 = 366 * MiB  ;
constexpr size_t WS_AMX = 365 * MiB  , WS_SX = WS_RT + 64 * 1024  , WS_WQ = WS_W  , WS_SW = WS_W + 2 * MiB  ;
constexpr size_t WS_PO = WS_PART  , WS_PML = WS_PART + 32 * MiB  ;

constexpr int RING_BYTES = 131072;
constexpr int MISC_OFF = 143360;
constexpr int LDS_BYTES = 147456;

__device__ __forceinline__ unsigned cvt_pk_bf16(float lo, float hi) { unsigned r; asm volatile("v_cvt_pk_bf16_f32 %0, %1, %2" : "=v"(r) : "v"(lo), "v"(hi)); return r; }
__device__ __forceinline__ float bf_lo(unsigned u) { return __builtin_bit_cast(float, u << 16); }
__device__ __forceinline__ float bf_hi(unsigned u) { return __builtin_bit_cast(float, u & 0xffff0000u); }
__device__ __forceinline__ int lane_id_fresh() { int l = (int)__builtin_amdgcn_mbcnt_hi(~0u, __builtin_amdgcn_mbcnt_lo(~0u, 0u)); asm volatile("" : "+v"(l)); return l; }
__device__ __forceinline__ int sx_i(int v, int m) { return __builtin_amdgcn_ds_bpermute((lane_id_fresh() ^ m) << 2, v); }
__device__ __forceinline__ float sx_f(float v, int m) { return __int_as_float(__builtin_amdgcn_ds_bpermute((lane_id_fresh() ^ m) << 2, __float_as_int(v))); }
__device__ __forceinline__ int sh_i(int v, int src) { return __builtin_amdgcn_ds_bpermute(src << 2, v); }
__device__ __forceinline__ float sh_f(float v, int src) { return __int_as_float(__builtin_amdgcn_ds_bpermute(src << 2, __float_as_int(v))); }
__device__ __forceinline__ float shup_f(float v, int d) { const int l = lane_id_fresh(); const int s = l - d; return __int_as_float(__builtin_amdgcn_ds_bpermute((s < 0 ? l : s) << 2, __float_as_int(v))); }
__device__ __forceinline__ float wave_sum(float v) {
    v += __int_as_float(__builtin_amdgcn_update_dpp(0, __float_as_int(v), 0xB1, 0xf, 0xf, true));
    v += __int_as_float(__builtin_amdgcn_update_dpp(0, __float_as_int(v), 0x4E, 0xf, 0xf, true));
    v += __int_as_float(__builtin_amdgcn_update_dpp(0, __float_as_int(v), 0x141, 0xf, 0xf, true));
    v += __int_as_float(__builtin_amdgcn_update_dpp(0, __float_as_int(v), 0x140, 0xf, 0xf, true));
    { auto rr = __builtin_amdgcn_permlane16_swap(__float_as_uint(v), __float_as_uint(v), false, false); v = __uint_as_float(rr[0]) + __uint_as_float(rr[1]); }
    { auto rr = __builtin_amdgcn_permlane32_swap(__float_as_uint(v), __float_as_uint(v), false, false); v = __uint_as_float(rr[0]) + __uint_as_float(rr[1]); }
    return v;
}
#define DPP_QX1 0xB1
#define DPP_QX2 0x4E
#define DPP_HMIR 0x141
#define DPP_MIR 0x140
__device__ __forceinline__ float wave_max(float v) {
    v = fmaxf(v, __int_as_float(__builtin_amdgcn_update_dpp(0, __float_as_int(v), DPP_QX1, 0xf, 0xf, true)));
    v = fmaxf(v, __int_as_float(__builtin_amdgcn_update_dpp(0, __float_as_int(v), DPP_QX2, 0xf, 0xf, true)));
    v = fmaxf(v, __int_as_float(__builtin_amdgcn_update_dpp(0, __float_as_int(v), DPP_HMIR, 0xf, 0xf, true)));
    v = fmaxf(v, __int_as_float(__builtin_amdgcn_update_dpp(0, __float_as_int(v), DPP_MIR, 0xf, 0xf, true)));
    { auto rr = __builtin_amdgcn_permlane16_swap(__float_as_uint(v), __float_as_uint(v), false, false); v = fmaxf(__uint_as_float(rr[0]), __uint_as_float(rr[1])); }
    { auto rr = __builtin_amdgcn_permlane32_swap(__float_as_uint(v), __float_as_uint(v), false, false); v = fmaxf(__uint_as_float(rr[0]), __uint_as_float(rr[1])); }
    return v;
}
__device__ __forceinline__ int tid_opaque() { int t = (int)threadIdx.x; asm volatile("" : "+v"(t)); return t; }
#define LDS_WAIT() asm volatile("s_waitcnt lgkmcnt(0)" ::: "memory")

namespace pg8 {
#define PG8_LAS __attribute__((address_space(3)))
constexpr int BM = 256, BK = 64, HALF = 128, HTB = HALF * BK * 2, STAGE_BYTES = 8 * HTB, NXCD = 8, WGM = 8;
__host__ __device__ __forceinline__ int lds_byte(int r, int c) { const int st = (r >> 4) * 2 + (c >> 5), rr = r & 15, cc = c & 31, ob = rr * 64 + cc * 2; return st * 1024 + (ob ^ (((ob >> 9) & 1) << 5)); }
__host__ __device__ __forceinline__ void stage_rc(int b, int& R, int& C) { const int st = b / 1024, sb = b % 1024, swz = sb ^ (((sb >> 9) & 1) << 5); R = (st >> 1) * 16 + swz / 64; C = (st & 1) * 32 + (swz % 64) / 2; }
__host__ __device__ __forceinline__ int perm32(int rho) { const int n = rho >> 4, i = rho & 15; return 8 * (i >> 2) + 4 * n + (i & 3); }
struct Unit { int pm, pn; };
struct Gemm { const bf16_t* A; const bf16_t* Bt; int M, N, K; };
struct StaticOrder {
    int nM, nN, nwg, G, c;
    __host__ __device__ void init(int M, int N, int G_, int c_) { nM = M / BM; nN = N / BM; nwg = nM * nN; G = G_; c = c_; }
    __host__ __device__ bool next(int i, Unit& u) const {
        const long L = (long)i * G + c; if (L >= nwg) return false;
        int wgid = (int)L; { const int q = nwg / NXCD, r = nwg % NXCD, xcd = wgid % NXCD, off = wgid / NXCD; wgid = (xcd < r ? xcd * (q + 1) : r * (q + 1) + (xcd - r) * q) + off; }
        const int nig = WGM * nN, gid = wgid / nig, fm = gid * WGM, gsz = (nM - fm) < WGM ? (nM - fm) : WGM;
        u.pm = fm + ((wgid % nig) % gsz); u.pn = (wgid % nig) / gsz; return true;
    }
    __device__ __forceinline__ void a_ready(const Unit&) const {}
    __device__ __forceinline__ void done(const Unit&) const {}
};

typedef int i32x4 __attribute__((ext_vector_type(4)));
template <bool I8> struct AccT { typedef f32x4 type; };
template <> struct AccT<true> { typedef i32x4 type; };
template <class Epi, class Sched, bool ALIGN_EPI = false, bool SP2 = false, bool I8 = false>
__device__ __forceinline__ void gemm_phase(PG8_LAS unsigned char* lds, const Gemm g, const Sched& S, const Epi& E) {
    typedef typename AccT<I8>::type acc_t;
    const int tid = tid_opaque(), wid = __builtin_amdgcn_readfirstlane(tid >> 6), lane = tid & 63, wr = wid >> 2, wc = wid & 3, fr = lane & 15, fq = lane >> 4;
    const int rowb = I8 ? g.K : 2 * g.K, nt = rowb / (BK * 2);
    unsigned voffA[2], voffB[2];
#pragma unroll
    for (int i = 0; i < 2; ++i) { int R, C; stage_rc(tid * 16 + i * 8192, R, C); const int Rb = Epi::PERM ? ((R & ~31) + perm32(R & 31)) : R;
        voffA[i] = (unsigned)(R * rowb + C * 2); voffB[i] = (unsigned)(Rb * rowb + C * 2); }
    const size_t kstep = (size_t)(BK * 2);
    const size_t hstep = (size_t)HALF * rowb;
    const size_t tstep = 2 * hstep;
    const unsigned ldsw = (unsigned)wid * 1024u;
    const int aoff = lds_byte(wr * 64 + fr, fq * 8), boff = lds_byte(wc * 32 + fr, fq * 8);
#define PG8_SA(b, h) (((b) * 2 + (h)) * HTB)
#define PG8_SB(b, h) ((4 + (b) * 2 + (h)) * HTB)
#define PG8_STAGE(bufoff, gbase, voff) do { _Pragma("unroll") for (int _i = 0; _i < 2; ++_i) \
        __builtin_amdgcn_global_load_lds((const unsigned*)((const char*)(gbase) + (voff)[_i]), (PG8_LAS unsigned*)(lds + (bufoff) + ldsw + _i * 8192), 16, 0, 0); } while (0)
#define PG8_LDA(dst, b, h) do { _Pragma("unroll") for (int m = 0; m < 4; ++m) _Pragma("unroll") for (int k = 0; k < 2; ++k) dst[m][k] = *(const PG8_LAS bf16x8*)(lds + PG8_SA(b, h) + aoff + m * 2048 + k * 1024); } while (0)
#define PG8_LDB(dst, b, h) do { _Pragma("unroll") for (int n = 0; n < 2; ++n) _Pragma("unroll") for (int k = 0; k < 2; ++k) dst[n][k] = *(const PG8_LAS bf16x8*)(lds + PG8_SB(b, h) + boff + n * 2048 + k * 1024); } while (0)
#define PG8_MMA(ai, bj, At, Bt) do { __builtin_amdgcn_s_setprio(1); _Pragma("unroll") for (int m = 0; m < 4; ++m) _Pragma("unroll") for (int n = 0; n < 2; ++n) _Pragma("unroll") for (int k = 0; k < 2; ++k) \
        { if constexpr (I8) acc[ai][bj][m][n] = __builtin_amdgcn_mfma_i32_16x16x64_i8(__builtin_bit_cast(i32x4, Bt[n][k]), __builtin_bit_cast(i32x4, At[m][k]), acc[ai][bj][m][n], 0, 0, 0); \
          else acc[ai][bj][m][n] = __builtin_amdgcn_mfma_f32_16x16x32_bf16(Bt[n][k], At[m][k], acc[ai][bj][m][n], 0, 0, 0); } __builtin_amdgcn_s_setprio(0); } while (0)
#define PG8_WAIT_V(n) asm volatile("s_waitcnt vmcnt(" #n ")" ::: "memory")
#define PG8_WAIT_L(n) asm volatile("s_waitcnt lgkmcnt(" #n ")" ::: "memory")
#define PG8_BAR __builtin_amdgcn_s_barrier()
#define PG8_SCHED __builtin_amdgcn_sched_barrier(0)
    Unit cur, nxt; int ui = 0;
    if (!S.next(0, cur)) return;
    acc_t acc[2][2][4][2];
#pragma unroll
    for (int a = 0; a < 2; ++a)
#pragma unroll
        for (int b = 0; b < 2; ++b)
#pragma unroll
            for (int m = 0; m < 4; ++m)
#pragma unroll
                for (int n = 0; n < 2; ++n) acc[a][b][m][n] = acc_t{};
    bf16x8 At[4][2], B0[2][2], B1[2][2];
    const char* cA = (const char*)g.A + (size_t)cur.pm * tstep; const char* cB = (const char*)g.Bt + (size_t)cur.pn * tstep;
    S.a_ready(cur);
    if constexpr (SP2) {
        PG8_STAGE(PG8_SB(0, 0), cB, voffB); PG8_STAGE(PG8_SB(0, 1), cB + hstep, voffB); PG8_STAGE(PG8_SA(0, 0), cA, voffA); PG8_STAGE(PG8_SA(0, 1), cA + hstep, voffA);
        if (wr == 1) PG8_BAR;
        PG8_WAIT_V(2); PG8_BAR;
        PG8_STAGE(PG8_SB(1, 0), cB + kstep, voffB); PG8_STAGE(PG8_SA(1, 0), cA + kstep, voffA); PG8_STAGE(PG8_SB(1, 1), cB + hstep + kstep, voffB);
        PG8_WAIT_V(6); PG8_BAR;
    } else {
        PG8_STAGE(PG8_SB(0, 0), cB, voffB); PG8_STAGE(PG8_SA(0, 0), cA, voffA); PG8_STAGE(PG8_SB(0, 1), cB + hstep, voffB); PG8_STAGE(PG8_SA(0, 1), cA + hstep, voffA);
        if (wr == 1) PG8_BAR;
        PG8_WAIT_V(4); PG8_BAR;
        PG8_STAGE(PG8_SB(1, 0), cB + kstep, voffB); PG8_STAGE(PG8_SA(1, 0), cA + kstep, voffA); PG8_STAGE(PG8_SB(1, 1), cB + hstep + kstep, voffB);
        PG8_WAIT_V(6); PG8_BAR;
    }
    for (;;) {
        const bool has_next = S.next(ui + 1, nxt);
        const char* nA = has_next ? (const char*)g.A + (size_t)nxt.pm * tstep : cA; const char* nB = has_next ? (const char*)g.Bt + (size_t)nxt.pn * tstep : cB;
        for (int t = 0; t < nt; t += 2) {
            const bool last = (t == nt - 2);
            const char* a1 = cA + (size_t)(t + 1) * kstep;
            const char* a2 = last ? nA : cA + (size_t)(t + 2) * kstep; const char* b2 = last ? nB : cB + (size_t)(t + 2) * kstep;
            const char* a3 = a2 + kstep; const char* b3 = b2 + kstep;
            if (last && has_next) S.a_ready(nxt);
            if constexpr (SP2) {
            PG8_LDB(B0, 0, 0); PG8_LDB(B1, 0, 1); PG8_SCHED; PG8_LDA(At, 0, 0); PG8_STAGE(PG8_SA(1, 1), a1 + hstep, voffA);
            PG8_WAIT_V(8); PG8_WAIT_L(0); PG8_BAR; PG8_MMA(0, 0, At, B0); PG8_MMA(0, 1, At, B1); PG8_BAR; PG8_SCHED;
            PG8_LDA(At, 0, 1); PG8_STAGE(PG8_SB(0, 0), b2, voffB); PG8_STAGE(PG8_SB(0, 1), b2 + hstep, voffB); PG8_STAGE(PG8_SA(0, 0), a2, voffA);
            PG8_WAIT_V(8); PG8_WAIT_L(0); PG8_BAR; PG8_MMA(1, 0, At, B0); PG8_MMA(1, 1, At, B1); PG8_BAR; PG8_SCHED;
            PG8_LDB(B0, 1, 0); PG8_LDB(B1, 1, 1); PG8_SCHED; PG8_LDA(At, 1, 0); PG8_STAGE(PG8_SA(0, 1), a2 + hstep, voffA);
            PG8_WAIT_V(8); PG8_WAIT_L(0); PG8_BAR; PG8_MMA(0, 0, At, B0); PG8_MMA(0, 1, At, B1); PG8_BAR; PG8_SCHED;
            PG8_LDA(At, 1, 1); PG8_STAGE(PG8_SB(1, 0), b3, voffB); PG8_STAGE(PG8_SB(1, 1), b3 + hstep, voffB); PG8_STAGE(PG8_SA(1, 0), a3, voffA);
            PG8_WAIT_V(8); PG8_WAIT_L(0); PG8_BAR; PG8_MMA(1, 0, At, B0); PG8_MMA(1, 1, At, B1); PG8_BAR; PG8_SCHED;
            } else {
            PG8_LDB(B0, 0, 0); PG8_SCHED; PG8_LDA(At, 0, 0); PG8_STAGE(PG8_SA(1, 1), a1 + hstep, voffA);
            PG8_WAIT_L(8); PG8_BAR; PG8_WAIT_L(0); PG8_MMA(0, 0, At, B0); PG8_BAR; PG8_SCHED;
            PG8_LDB(B1, 0, 1); PG8_STAGE(PG8_SB(0, 0), b2, voffB);
            PG8_BAR; PG8_WAIT_L(0); PG8_MMA(0, 1, At, B1); PG8_BAR;
            PG8_LDA(At, 0, 1); PG8_STAGE(PG8_SA(0, 0), a2, voffA);
            PG8_BAR; PG8_WAIT_L(0); PG8_MMA(1, 0, At, B0); PG8_BAR; PG8_SCHED;
            PG8_STAGE(PG8_SB(0, 1), b2 + hstep, voffB);
            PG8_WAIT_V(6); PG8_BAR; PG8_MMA(1, 1, At, B1); PG8_BAR;
            PG8_LDB(B0, 1, 0); PG8_SCHED; PG8_LDA(At, 1, 0); PG8_STAGE(PG8_SA(0, 1), a2 + hstep, voffA);
            PG8_WAIT_L(8); PG8_BAR; PG8_WAIT_L(0); PG8_MMA(0, 0, At, B0); PG8_BAR; PG8_SCHED;
            PG8_LDB(B1, 1, 1); PG8_STAGE(PG8_SB(1, 0), b3, voffB);
            PG8_BAR; PG8_WAIT_L(0); PG8_MMA(0, 1, At, B1); PG8_BAR;
            PG8_LDA(At, 1, 1); PG8_STAGE(PG8_SA(1, 0), a3, voffA);
            PG8_BAR; PG8_WAIT_L(0); PG8_MMA(1, 0, At, B0); PG8_BAR; PG8_SCHED;
            PG8_STAGE(PG8_SB(1, 1), b3 + hstep, voffB);
            PG8_WAIT_V(6); PG8_BAR; PG8_MMA(1, 1, At, B1); PG8_BAR;
            }
        }
        if constexpr (ALIGN_EPI) { if (wr == 0) PG8_BAR; }
        if constexpr (!Epi::AFTER_DRAIN) { E(acc, cur, wr, wc, fr, fq); } S.done(cur);
        if (!has_next) break;
#pragma unroll
        for (int a = 0; a < 2; ++a)
#pragma unroll
            for (int b = 0; b < 2; ++b)
#pragma unroll
                for (int m = 0; m < 4; ++m)
#pragma unroll
                    for (int n = 0; n < 2; ++n) acc[a][b][m][n] = acc_t{};
        cur = nxt; cA = nA; cB = nB; ++ui;
        if constexpr (ALIGN_EPI) { if (wr == 1) PG8_BAR; }
    }
    PG8_WAIT_V(0);
    if constexpr (!ALIGN_EPI) { if (wr == 0) PG8_BAR; }
    PG8_BAR;
    if constexpr (Epi::AFTER_DRAIN) E.fused(acc, cur, wr, wc, fr, fq, lds);
#undef PG8_SA
#undef PG8_SB
#undef PG8_STAGE
#undef PG8_LDA
#undef PG8_LDB
#undef PG8_MMA
#undef PG8_WAIT_V
#undef PG8_WAIT_L
#undef PG8_BAR
#undef PG8_SCHED
}

__device__ __forceinline__ float sigmoidf_fast(float x) { return __builtin_amdgcn_rcpf(1.f + __builtin_amdgcn_exp2f(-x * LOG2E)); }
struct EpiInProj {
    static constexpr bool PERM = true, AFTER_DRAIN = false;
    bf16_t* base; const float* sxn  ; const float* wsc  ;
    const float* gq; const float* gk; PG8_LAS float* xch  ;
    __device__ __forceinline__ void operator()(const i32x4 (&acci)[2][2][4][2], const Unit& u, int wr, int wc, int fr, int fq) const {
        const int sec = u.pn >> 2; const float wsv = *wsc;
        bf16_t* sb = base + (size_t)sec * SEC_ELEMS;
        const float sc = (sec == 4) ? SCALE * LOG2E : 1.f;
        if (sec < 2) {
#pragma unroll
            for (int ai = 0; ai < 2; ++ai)
#pragma unroll
                for (int m = 0; m < 4; ++m) {
                    const int tk = u.pm * BM + ai * HALF + wr * 64 + m * 16 + fr;
                    const float rs = sxn[tk] * wsv;
#pragma unroll
                    for (int bj = 0; bj < 2; ++bj) {
                        const f32x4 v0 = __builtin_convertvector(acci[ai][bj][m][0], f32x4) * rs, v1 = __builtin_convertvector(acci[ai][bj][m][1], f32x4) * rs;
                        float ss = v0[0] * v0[0] + v0[1] * v0[1] + v0[2] * v0[2] + v0[3] * v0[3] + v1[0] * v1[0] + v1[1] * v1[1] + v1[2] * v1[2] + v1[3] * v1[3];
                        ss += sx_f(ss, 16); ss += sx_f(ss, 32);
                        if (fq == 0) xch[(((((wr * 2 + ai) * 4 + m) * 16 + fr) * 2 + bj) * 4) + wc] = ss;
                    }
                }
            asm volatile("s_waitcnt lgkmcnt(0)" ::: "memory");
            __builtin_amdgcn_s_barrier();
            const float* gp = (sec == 0 ? gq : gk) + wc * 32 + 8 * fq;
            const f32x4 g0 = *(const f32x4*)gp, g1 = *(const f32x4*)(gp + 4);
#pragma unroll
            for (int ai = 0; ai < 2; ++ai)
#pragma unroll
                for (int m = 0; m < 4; ++m) {
                    const int tk = u.pm * BM + ai * HALF + wr * 64 + m * 16 + fr, b = tk >> 12, s = tk & 4095;
                    const float rs = sxn[tk] * wsv;
#pragma unroll
                    for (int bj = 0; bj < 2; ++bj) {
                        const int hh = (u.pn & 3) * 2 + bj;
                        const f32x4 p4 = *(const PG8_LAS f32x4*)(xch + (((((wr * 2 + ai) * 4 + m) * 16 + fr) * 2 + bj) * 4));
                        const float r = rs / sqrtf(((p4[0] + p4[1]) + (p4[2] + p4[3])) * (1.f / 128.f) + EPS);
                        const f32x4 v0 = __builtin_convertvector(acci[ai][bj][m][0], f32x4) * r * g0, v1 = __builtin_convertvector(acci[ai][bj][m][1], f32x4) * r * g1;
                        u32x4 w; w.x = cvt_pk_bf16(v0[0], v0[1]); w.y = cvt_pk_bf16(v0[2], v0[3]); w.z = cvt_pk_bf16(v1[0], v1[1]); w.w = cvt_pk_bf16(v1[2], v1[3]);
                        *(u32x4*)(sb + ((size_t)((b * 8 + hh) * 4096 + s)) * 128 + wc * 32 + 8 * fq) = w;
                    }
                }
            return;
        }
#pragma unroll
        for (int ai = 0; ai < 2; ++ai)
#pragma unroll
            for (int m = 0; m < 4; ++m) {
                const int tk = u.pm * BM + ai * HALF + wr * 64 + m * 16 + fr, b = tk >> 12, s = tk & 4095;
                const float rs = sxn[tk] * wsv;
#pragma unroll
                for (int bj = 0; bj < 2; ++bj) {
                    const int hh = (u.pn & 3) * 2 + bj;
                    f32x4 v0 = __builtin_convertvector(acci[ai][bj][m][0], f32x4) * rs, v1 = __builtin_convertvector(acci[ai][bj][m][1], f32x4) * rs;
                    bf16_t* dst;
                    if (sec == 3) {
#pragma unroll
                        for (int i = 0; i < 4; ++i) { v0[i] = sigmoidf_fast(v0[i]); v1[i] = sigmoidf_fast(v1[i]); }
                        dst = sb + (size_t)tk * 1024 + hh * 128 + wc * 32 + 8 * fq;
                    } else {
                        v0 = v0 * sc; v1 = v1 * sc;
                        dst = sb + ((size_t)((b * 8 + hh) * 4096 + s)) * 128 + wc * 32 + 8 * fq;
                    }
                    u32x4 w; w.x = cvt_pk_bf16(v0[0], v0[1]); w.y = cvt_pk_bf16(v0[2], v0[3]); w.z = cvt_pk_bf16(v1[0], v1[1]); w.w = cvt_pk_bf16(v1[2], v1[3]);
                    *(u32x4*)dst = w;
                }
            }
    }
};
struct EpiOutProj {
    static constexpr bool PERM = true, AFTER_DRAIN = false;
    const float* x; float* h; bf16_t* hb; float* ssq; float* amx;
    __device__ __forceinline__ void operator()(const f32x4 (&acc)[2][2][4][2], const Unit& u, int wr, int wc, int fr, int fq) const {
#pragma unroll
        for (int ai = 0; ai < 2; ++ai)
#pragma unroll
            for (int m = 0; m < 4; ++m) {
                const int tk = u.pm * BM + ai * HALF + wr * 64 + m * 16 + fr;
                float ss = 0.f, mx = 0.f;
#pragma unroll
                for (int bj = 0; bj < 2; ++bj) {
                    const size_t off = (size_t)tk * DM + u.pn * BM + bj * HALF + wc * 32 + 8 * fq;
                    const f32x4 x0 = *(const f32x4*)(x + off), x1 = *(const f32x4*)(x + off + 4);
                    const f32x4 v0 = acc[ai][bj][m][0] + x0, v1 = acc[ai][bj][m][1] + x1;
                    u32x4 w; w.x = cvt_pk_bf16(v0[0], v0[1]); w.y = cvt_pk_bf16(v0[2], v0[3]); w.z = cvt_pk_bf16(v1[0], v1[1]); w.w = cvt_pk_bf16(v1[2], v1[3]);
                    *(u32x4*)(hb + off) = w;
                    ss += v0[0] * v0[0] + v0[1] * v0[1] + v0[2] * v0[2] + v0[3] * v0[3] + v1[0] * v1[0] + v1[1] * v1[1] + v1[2] * v1[2] + v1[3] * v1[3];
                    mx = fmaxf(mx, fmaxf(fmaxf(fmaxf(fabsf(v0[0]), fabsf(v0[1])), fmaxf(fabsf(v0[2]), fabsf(v0[3]))), fmaxf(fmaxf(fabsf(v1[0]), fabsf(v1[1])), fmaxf(fabsf(v1[2]), fabsf(v1[3])))));
                }
                ss += sx_f(ss, 16); ss += sx_f(ss, 32);
                mx = fmaxf(mx, sx_f(mx, 16)); mx = fmaxf(mx, sx_f(mx, 32));
                if (fq == 0) { ssq[(size_t)tk * 32 + u.pn * 4 + wc] = ss; amx[(size_t)tk * 32 + u.pn * 4 + wc] = mx; }
            }
    }
};
struct EpiPeerQ {
    static constexpr bool PERM = true, AFTER_DRAIN = false;
    const float* ssq; bf16_t* qp; float* rtab;
    __device__ __forceinline__ void operator()(const f32x4 (&acc)[2][2][4][2], const Unit& u, int wr, int wc, int fr, int fq) const {
#pragma unroll
        for (int ai = 0; ai < 2; ++ai)
#pragma unroll
            for (int m = 0; m < 4; ++m) {
                const int tk = u.pm * BM + ai * HALF + wr * 64 + m * 16 + fr;
                float tot = 0.f;
#pragma unroll
                for (int i = 0; i < 8; ++i) { const f32x4 s4 = *(const f32x4*)(ssq + (size_t)tk * 32 + 4 * i); tot += (s4[0] + s4[1]) + (s4[2] + s4[3]); }
                const float r = 1.0f / sqrtf(tot * (1.f / DM) + EPS);
                if (u.pn == 0 && wc == 0 && fq == 0) rtab[tk] = r;
#pragma unroll
                for (int bj = 0; bj < 2; ++bj) {
                    const size_t off = (size_t)tk * DM + u.pn * BM + bj * HALF + wc * 32 + 8 * fq;
                    const f32x4 v0 = acc[ai][bj][m][0] * r, v1 = acc[ai][bj][m][1] * r;
                    u32x4 w; w.x = cvt_pk_bf16(v0[0], v0[1]); w.y = cvt_pk_bf16(v0[2], v0[3]); w.z = cvt_pk_bf16(v1[0], v1[1]); w.w = cvt_pk_bf16(v1[2], v1[3]);
                    *(u32x4*)(qp + off) = w;
                }
            }
    }
};
struct EpiPeerQFused {
    static constexpr bool PERM = true, AFTER_DRAIN = true;
    const float* ssq; unsigned char* wsb;
    __device__ __forceinline__ void operator()(const f32x4 (&)[2][2][4][2], const Unit&, int, int, int, int) const {}
    __device__ __forceinline__ void fused(const f32x4 (&acc)[2][2][4][2], const Unit& u, int wr, int wc, int fr, int fq, PG8_LAS unsigned char* lds) const;
};
}

namespace att {
constexpr int NW = 8, QBLK = 32, KVBLK = 64, QB = NW * QBLK, D = 128;
constexpr int SHM_V = KVBLK * D * 2, SHM_K = KVBLK * D * 2;
constexpr int OFF_WS = 2 * SHM_V + 2 * SHM_K, OFF_BIAS = OFF_WS + NW * 64 * 4, ATT_LDS = OFF_BIAS + SEQ * 4;
#define KSWZ(row, colB) ((row) * 256 + ((colB) ^ (((row) & 7) << 4)))
#define SBAR() __builtin_amdgcn_sched_barrier(0)
__device__ __forceinline__ int v_st(int k, int c) { const int kk = (k & ~0xC) | ((k & 4) << 1) | ((k & 8) >> 1); return ((kk >> 3) * 4 + (c >> 5)) * 512 + ((kk & 7) * 32 + (c & 31)) * 2; }
__device__ __forceinline__ int v_rd_base(int lane) { return ((lane & 3) << 3) | (((lane >> 2) & 3) << 6) | (((lane >> 4) & 1) << 5) | (((lane >> 5) & 1) << 8); }
constexpr int v_rd_off(int d0, int ks, int half) { return d0 * 512 + ks * 4096 + half * 2048; }
__device__ __forceinline__ int crow(int r, int hi) { return (r & 3) + 8 * (r >> 2) + 4 * hi; }
__device__ __forceinline__ bf16x8 load8(const bf16_t* p) { return *reinterpret_cast<const bf16x8*>(p); }
__device__ __forceinline__ void mask_tile(f32x16& p0, f32x16& p1, int dq) {
    const float NEG = -__builtin_inff();
#pragma unroll
    for (int r = 0; r < 16; ++r) {
        const int c = (r & 3) + 8 * (r >> 2);
        if (dq - c < 0) p0[r] = NEG;
        if (dq - c - 32 < 0) p1[r] = NEG;
    }
}
__device__ __forceinline__ void partialSM(f32x16& p0, f32x16& p1, float& m_reg, float& mn, float& alpha) {
    float pmax = p0[0];
#pragma unroll
    for (int r = 1; r < 16; ++r) pmax = fmaxf(pmax, p0[r]);
#pragma unroll
    for (int r = 0; r < 16; ++r) pmax = fmaxf(pmax, p1[r]);
    { auto rr = __builtin_amdgcn_permlane32_swap(__float_as_uint(pmax), __float_as_uint(pmax), false, false);
      pmax = fmaxf(__uint_as_float(rr[0]), __uint_as_float(rr[1])); }
    constexpr float C2 = LOG2E * SCALE; constexpr float THR = 8.f;
    if (__builtin_expect(__all((pmax - m_reg) * SCALE <= THR), 1)) { mn = m_reg; alpha = 1.f; }
    else { mn = fmaxf(m_reg, pmax); alpha = __builtin_amdgcn_exp2f((m_reg - mn) * C2); m_reg = mn; }
    const float mnL = -mn * C2;
#pragma unroll
    for (int r = 0; r < 16; ++r) p0[r] = fmaf(p0[r], C2, mnL);
#pragma unroll
    for (int r = 0; r < 16; ++r) p1[r] = fmaf(p1[r], C2, mnL);
#pragma unroll
    for (int r = 0; r < 16; ++r) p0[r] = __builtin_amdgcn_exp2f(p0[r]);
}
#define PK4(P, B_, OUT) do { unsigned a0 = cvt_pk_bf16(P[B_+0], P[B_+1]), a1 = cvt_pk_bf16(P[B_+2], P[B_+3]);                          \
        unsigned b0 = cvt_pk_bf16(P[B_+4], P[B_+5]), b1 = cvt_pk_bf16(P[B_+6], P[B_+7]);                                             \
        auto r0 = __builtin_amdgcn_permlane32_swap(a0, b0, false, false); auto r1 = __builtin_amdgcn_permlane32_swap(a1, b1, false, false); \
        u32x4 w = {r0[0], r1[0], r0[1], r1[1]}; OUT = *reinterpret_cast<bf16x8*>(&w); } while (0)
__device__ __forceinline__ void finishSM(f32x16& p0, f32x16& p1, float alpha, float& l_reg, bf16x8& pa0, bf16x8& pa1, bf16x8& pa2, bf16x8& pa3) {
#pragma unroll
    for (int r = 0; r < 16; ++r) p1[r] = __builtin_amdgcn_exp2f(p1[r]);
    float ps = 0;
#pragma unroll
    for (int r = 0; r < 16; ++r) ps += p0[r];
#pragma unroll
    for (int r = 0; r < 16; ++r) ps += p1[r];
    { auto rr = __builtin_amdgcn_permlane32_swap(__float_as_uint(ps), __float_as_uint(ps), false, false);
      ps = __uint_as_float(rr[0]) + __uint_as_float(rr[1]); }
    l_reg = l_reg * alpha + ps;
    PK4(p0, 0, pa0); PK4(p0, 8, pa1); PK4(p1, 0, pa2); PK4(p1, 8, pa3);
}
__device__ __forceinline__ void sb_group(f32x16& P, int g, float& gs) {
    float run = 0.f;
#pragma unroll
    for (int k = 3; k >= 0; --k) {
        const float z = P[4 * g + k];
        const float t = __builtin_amdgcn_exp2f(-fabsf(z));
        const float l = __builtin_amdgcn_logf(1.f + t);
        const float sp = fmaxf(z, 0.f) + l;
        P[4 * g + k] = (z - sp) - run;
        run += sp;
    }
    gs = run;
}
__device__ __forceinline__ void sb_part1(f32x16& p0, f32x16& p1, float& carry, float mlo) {
    float gs[8];
#pragma unroll
    for (int g = 0; g < 4; ++g) sb_group(p0, g, gs[g]);
#pragma unroll
    for (int g = 0; g < 4; ++g) sb_group(p1, g, gs[4 + g]);
    float run = carry;
#pragma unroll
    for (int G = 7; G >= 0; --G) {
        auto rr = __builtin_amdgcn_permlane32_swap(__float_as_uint(gs[G]), __float_as_uint(gs[G]), false, false);
        const float slo = __uint_as_float(rr[0]), shi = __uint_as_float(rr[1]);
        const float base = fmaf(mlo, shi, run);
        if (G >= 4) {
#pragma unroll
            for (int k = 0; k < 4; ++k) p1[4 * (G - 4) + k] -= base;
        } else {
#pragma unroll
            for (int k = 0; k < 4; ++k) p0[4 * G + k] -= base;
        }
        run += slo + shi;
    }
    carry = run;
#pragma unroll
    for (int r = 0; r < 16; ++r) p0[r] = __builtin_amdgcn_exp2f(p0[r]);
}
__device__ __forceinline__ void sb_part2(f32x16& p0, f32x16& p1, bf16x8& pa0, bf16x8& pa1, bf16x8& pa2, bf16x8& pa3) {
#pragma unroll
    for (int r = 0; r < 16; ++r) p1[r] = __builtin_amdgcn_exp2f(p1[r]);
    PK4(p0, 0, pa0); PK4(p0, 8, pa1); PK4(p1, 0, pa2); PK4(p1, 8, pa3);
}
#undef PK4
template <int KB, bool BIAS>
__device__ __forceinline__ void qkt(f32x16& p0, f32x16& p1, const char* K_lds, int r32, int hi, const bf16x8* qr, const float* bt) {
    if constexpr (BIAS) {
#pragma unroll
        for (int g = 0; g < 4; ++g) { const f32x4 a = *(const f32x4*)(bt + 8 * g), b = *(const f32x4*)(bt + 32 + 8 * g);
            p0[4 * g] = a[0]; p0[4 * g + 1] = a[1]; p0[4 * g + 2] = a[2]; p0[4 * g + 3] = a[3];
            p1[4 * g] = b[0]; p1[4 * g + 1] = b[1]; p1[4 * g + 2] = b[2]; p1[4 * g + 3] = b[3]; }
    } else { p0 = f32x16{}; p1 = f32x16{}; }
    const char* kb[4];
#pragma unroll
    for (int dd = 0; dd < 4; ++dd) kb[dd] = K_lds + KB * SHM_K + KSWZ(r32, (dd * 16 + hi * 8) * 2);
#pragma unroll
    for (int d0 = 0; d0 < 8; ++d0) { const char* a = kb[d0 & 3] + (d0 >> 2) * 128;
        bf16x8 b0 = *reinterpret_cast<const bf16x8*>(a);
        bf16x8 b1 = *reinterpret_cast<const bf16x8*>(a + 32 * 256);
        p0 = __builtin_amdgcn_mfma_f32_32x32x16_bf16(b0, qr[d0], p0, 0, 0, 0);
        p1 = __builtin_amdgcn_mfma_f32_32x32x16_bf16(b1, qr[d0], p1, 0, 0, 0); }
}
template <int VB>
__device__ __forceinline__ void pv_tile(f32x16* o, int vb0, bf16x8 pa0, bf16x8 pa1, bf16x8 pa2, bf16x8 pa3) {
#define TRRD(dst, off) asm volatile("ds_read_b64_tr_b16 %0, %1 offset:%2" : "=&v"(dst) : "v"(vb0), "i"(off) : "memory")
#define PV_D0(d0) do { { s16x4 l0, l1, h0, h1; constexpr int b_ = VB * SHM_V + v_rd_off(d0, 0, 0); \
        TRRD(l0, b_); TRRD(h0, b_ + 2048); TRRD(l1, b_ + 4096); TRRD(h1, b_ + 6144); \
        asm volatile("s_waitcnt lgkmcnt(0)" ::: "memory"); SBAR();   \
        o[d0] = __builtin_amdgcn_mfma_f32_32x32x16_bf16(pa0, (bf16x8){l0[0], l0[1], l0[2], l0[3], h0[0], h0[1], h0[2], h0[3]}, o[d0], 0, 0, 0);   \
        o[d0] = __builtin_amdgcn_mfma_f32_32x32x16_bf16(pa1, (bf16x8){l1[0], l1[1], l1[2], l1[3], h1[0], h1[1], h1[2], h1[3]}, o[d0], 0, 0, 0); }  \
      { s16x4 l2, l3, h2, h3; constexpr int b_ = VB * SHM_V + v_rd_off(d0, 0, 0); \
        TRRD(l2, b_ + 8192); TRRD(h2, b_ + 10240); TRRD(l3, b_ + 12288); TRRD(h3, b_ + 14336); \
        asm volatile("s_waitcnt lgkmcnt(0)" ::: "memory"); SBAR();   \
        o[d0] = __builtin_amdgcn_mfma_f32_32x32x16_bf16(pa2, (bf16x8){l2[0], l2[1], l2[2], l2[3], h2[0], h2[1], h2[2], h2[3]}, o[d0], 0, 0, 0);   \
        o[d0] = __builtin_amdgcn_mfma_f32_32x32x16_bf16(pa3, (bf16x8){l3[0], l3[1], l3[2], l3[3], h3[0], h3[1], h3[2], h3[3]}, o[d0], 0, 0, 0); } } while (0)
    PV_D0(0); PV_D0(1); PV_D0(2); PV_D0(3);
#undef PV_D0
#undef TRRD
}

struct UnitRef { const bf16_t* Q; const bf16_t* K; const bf16_t* V; int P0; };
struct Seam { bf16x8 qr[8]; bf16x8 st_v0, st_v1, st_k0, st_k1; };
#define ROW(p, k0, rr) ((p) + (size_t)((k0) + (rr)) * D + sc)
#define VMW() asm volatile("s_waitcnt vmcnt(0)" ::: "memory")
#define SLOAD_H(Kp, Vp, k0) do { S.st_v0 = load8(ROW(Vp, k0, sr)); S.st_v1 = load8(ROW(Vp, k0, 32 + sr));              \
                         S.st_k0 = load8(ROW(Kp, k0, sr)); S.st_k1 = load8(ROW(Kp, k0, 32 + sr)); } while (0)
#define SWRITE_HK(bf) do { *(bf16x8*)(K_lds + (bf) * SHM_K + kws) = S.st_k0; *(bf16x8*)(K_lds + (bf) * SHM_K + kws + 32 * 256) = S.st_k1; } while (0)
#define SWRITE_HV(bf) do { *(bf16x8*)(V_lds + (bf) * SHM_V + vst0) = S.st_v0; *(bf16x8*)(V_lds + (bf) * SHM_V + vst1) = S.st_v1; } while (0)
#define SWRITE_H(bf) do { SWRITE_HV(bf); SWRITE_HK(bf); } while (0)

template <bool SB>
__device__ __forceinline__ void attn_unit(const UnitRef& cur, unsigned char* wsu  , int bh, char* lds,
                                          int part  ) {
    const float* cvec; const float* gqk;
    { unsigned char* w_ = wsu; asm volatile("" : "+s"(w_)); cvec = (const float*)(w_ + WS_C) + (size_t)bh * SEQ; gqk = (const float*)(w_ + WS_GQK); }
    const int tid = tid_opaque(), wid = __builtin_amdgcn_readfirstlane(tid >> 6), lane = tid & 63, r32 = lane & 31, hi = lane >> 5;
    int jlo = 0;
    if constexpr (!SB) {
        const float gq = fmaxf(fabsf(gqk[lane]), fabsf(gqk[64 + lane])), gk = fmaxf(fabsf(gqk[128 + lane]), fabsf(gqk[192 + lane]));
        const float lmax = 11.3137085f * 1.02f * wave_max(gq) * wave_max(gk);
        const int ntf = (cur.P0 + QB) / KVBLK;
        const float cend = (lane < ntf) ? cvec[lane * KVBLK + KVBLK - 1] : 0.f;
        const bool skip = (lane < ntf) && (2.f * lmax + cvec[cur.P0] - cend < -104.f);
        jlo = __builtin_amdgcn_readfirstlane((int)__popcll(__ballot(skip)));
    }
    const int ntot = (cur.P0 + QB) / KVBLK - jlo;
    const int tb = (part == 2) ? (ntot >> 1) : 0, te = (part == 1) ? (ntot >> 1) : ntot;
    const int kshift = (jlo + tb) * KVBLK, P0r = cur.P0 - kshift;
    const int NT = te - tb;
#define KBASE(t) ((SB ? (NT - 1 - (t)) : (t)) * KVBLK)
    const int qlo = P0r + wid * QBLK, qm = qlo + r32 - 4 * hi - (SB ? 1 : 0);
    char* V_lds = lds; char* K_lds = lds + 2 * SHM_V;
    float* ws = (float*)(lds + OFF_WS) + wid * 64; float* li_l = ws, * al_l = ws + 32;
    float* bias = (float*)(lds + OFF_BIAS);
    const int sr = tid >> 4, sc = (tid & 15) * 8, vst0 = v_st(sr, sc), vst1 = v_st(32 + sr, sc), kws = KSWZ(sr, sc * 2);
    const int vb0 = (int)(uintptr_t)V_lds + v_rd_base(lane);
    const bf16_t* Kh = cur.K + (size_t)kshift * D; const bf16_t* Vh = cur.V + (size_t)kshift * D;
    Seam S;
    if constexpr (!SB) { const float cq0 = cvec[cur.P0]; const float* cv = cvec + kshift; for (int j = tid; j < NT * KVBLK; j += NTHREADS) bias[j] = (cq0 - cv[j]) * (1.f / SCALE); }
#pragma unroll
    for (int d0 = 0; d0 < 8; ++d0) S.qr[d0] = load8(cur.Q + (size_t)(wid * QBLK + r32) * D + d0 * 16 + hi * 8);
    SLOAD_H(Kh, Vh, KBASE(0)); VMW(); SWRITE_HK(0);
    __syncthreads();
    float m_reg = -1e30f, l_reg = 0; f32x16 o[4] = {};
    float carry = 0.f; const float mlo = hi ? 0.f : 1.f;
#define RESC(a) do { if (__any((a) < 1.f)) { if (hi == 0) al_l[r32] = (a); asm volatile("s_waitcnt lgkmcnt(0)" ::: "memory");              \
                     for (int d_ = 0; d_ < 4; ++d_) for (int r = 0; r < 16; ++r) o[d_][r] *= al_l[crow(r, hi)]; } } while (0)
#define MASKT(P0_, P1_, t) do { const int kb_ = KBASE(t); if (kb_ + KVBLK - 1 > qlo - (SB ? 1 : 0)) mask_tile(P0_, P1_, qm - kb_); } while (0)
#define BT(t) (bias + KBASE(t) + 4 * hi)
#define PART1(PX0, PX1, mnX, alX) do { if constexpr (SB) sb_part1(PX0, PX1, carry, mlo); else partialSM(PX0, PX1, m_reg, mnX, alX); } while (0)
#define PART2(PY0, PY1, alY) do { if constexpr (SB) sb_part2(PY0, PY1, pa0, pa1, pa2, pa3); else finishSM(PY0, PY1, alY, l_reg, pa0, pa1, pa2, pa3); } while (0)
    f32x16 pA0, pA1, pB0, pB1; float mnA = 0.f, mnB = 0.f, alA = 1.f, alB = 1.f; bf16x8 pa0, pa1, pa2, pa3;
    SWRITE_HV(0); SBAR();
    if (NT > 1) SLOAD_H(Kh, Vh, KBASE(1));
    SBAR(); qkt<0, !SB>(pA0, pA1, K_lds, r32, hi, S.qr, BT(0));
    MASKT(pA0, pA1, 0); PART1(pA0, pA1, mnA, alA);
    if (NT > 1) { VMW(); SWRITE_H(1); }
    __syncthreads();
#define HALF_STEP(PX0, PX1, mnX, alX, PY0, PY1, alY, t, KB, VB, SBUF) do {                                                    \
        SBAR(); qkt<KB, !SB>(PX0, PX1, K_lds, r32, hi, S.qr, BT(t));                                                          \
        PART2(PY0, PY1, alY); SBAR();                                                                                          \
        if ((t) + 1 < NT) { SLOAD_H(Kh, Vh, KBASE((t) + 1)); SBAR(); }                                                         \
        pv_tile<VB>(o, vb0, pa0, pa1, pa2, pa3); MASKT(PX0, PX1, (t)); PART1(PX0, PX1, mnX, alX);                              \
        __syncthreads();                                                                                                      \
        if ((t) + 1 < NT) { VMW(); SWRITE_H(SBUF); }                                                                           \
        if constexpr (!SB) RESC(alX);                                                                                          \
        __syncthreads(); } while (0)
    for (int t = 1; t + 1 < NT; t += 2) {
        HALF_STEP(pB0, pB1, mnB, alB, pA0, pA1, alA, t, 1, 0, 0);
        HALF_STEP(pA0, pA1, mnA, alA, pB0, pB1, alB, t + 1, 0, 1, 1);
    }
    const bool even = (NT & 1) == 0;
    if (even) { SBAR(); qkt<1, !SB>(pB0, pB1, K_lds, r32, hi, S.qr, BT(NT - 1)); SBAR(); }
    PART2(pA0, pA1, alA); SBAR();
    pv_tile<0>(o, vb0, pa0, pa1, pa2, pa3);
    if (even) { MASKT(pB0, pB1, NT - 1); PART1(pB0, pB1, mnB, alB); __syncthreads(); if constexpr (!SB) RESC(alB);
        PART2(pB0, pB1, alB); SBAR(); pv_tile<1>(o, vb0, pa0, pa1, pa2, pa3); }
    unsigned char* we_ = wsu; asm volatile("" : "+s"(we_));
    if (part != 0) {
        const int slot2 = ((((cur.P0 >> 8) - 8) & 7) * 16 + bh) * 2 + (part == 2 ? 1 : 0);
        float* po = (float*)(we_ + WS_PO) + (size_t)slot2 * 256 * 128; float* pml = (float*)(we_ + WS_PML) + (size_t)slot2 * 512;
        if (hi == 0) { pml[(wid * QBLK + r32) * 2] = m_reg; pml[(wid * QBLK + r32) * 2 + 1] = l_reg; }
#pragma unroll
        for (int r = 0; r < 16; ++r)
#pragma unroll
            for (int d0 = 0; d0 < 4; ++d0) po[(size_t)(wid * QBLK + crow(r, hi)) * D + d0 * 32 + r32] = o[d0][r];
        __syncthreads();
        return;
    }
    const bf16_t* gate = (const bf16_t*)(we_ + WS_SEC) + 3 * SEC_ELEMS + (size_t)(bh >> 3) * SEQ * 1024 + (bh & 7) * HD;
    bf16_t* outp = (bf16_t*)(we_ + WS_MIX) + (size_t)(bh >> 3) * SEQ * DM + (bh & 7) * HD;
    float rli[16];
    if constexpr (!SB) {
        if (hi == 0) li_l[r32] = l_reg; asm volatile("s_waitcnt lgkmcnt(0)" ::: "memory");
#pragma unroll
        for (int r = 0; r < 16; ++r) rli[r] = __builtin_amdgcn_rcpf(li_l[crow(r, hi)]);
    }
#pragma unroll
    for (int r = 0; r < 16; ++r) { const int orow = cur.P0 + wid * QBLK + crow(r, hi);
#pragma unroll
        for (int d0 = 0; d0 < 4; ++d0) {
            float v = o[d0][r];
            if constexpr (!SB) { const unsigned short gb = gate[(size_t)orow * 1024 + d0 * 32 + r32]; v = v * rli[r] * __builtin_bit_cast(float, (unsigned)gb << 16); }
            const float vn = sx_f(v, 1);
            if ((r32 & 1) == 0) *(unsigned*)(outp + (size_t)orow * DM + d0 * 32 + r32) = cvt_pk_bf16(v, vn); } }
    __syncthreads();
#undef RESC
#undef KBASE
#undef MASKT
#undef BT
#undef PART1
#undef PART2
#undef HALF_STEP
}

constexpr float SB_TH = 150.f;
__device__ __forceinline__ void sb_unit(const UnitRef& cur, bf16_t* outp, char* lds) {
    const int tid = tid_opaque(), wid = __builtin_amdgcn_readfirstlane(tid >> 6), lane = tid & 63, r32 = lane & 31, hi = lane >> 5;
    const int NT = (cur.P0 + QB) / KVBLK;
#define KBASE(t) ((NT - 1 - (t)) * KVBLK)
    const int qlo = cur.P0 + wid * QBLK, qm = qlo + r32 - 4 * hi - 1;
    char* V_lds = lds; char* K_lds = lds + 2 * SHM_V;
    volatile int* flags = (volatile int*)(lds + OFF_WS);
    const int sr = tid >> 4, sc = (tid & 15) * 8, vst0 = v_st(sr, sc), vst1 = v_st(32 + sr, sc), kws = KSWZ(sr, sc * 2);
    const int vb0 = (int)(uintptr_t)V_lds + v_rd_base(lane);
    const bf16_t* Kh = cur.K; const bf16_t* Vh = cur.V;
    Seam S;
#pragma unroll
    for (int d0 = 0; d0 < 8; ++d0) S.qr[d0] = load8(cur.Q + (size_t)(wid * QBLK + r32) * D + d0 * 16 + hi * 8);
    SLOAD_H(Kh, Vh, KBASE(0)); VMW(); SWRITE_H(0);
    __syncthreads();
    f32x16 o[4] = {}; float carry = 0.f; const float mlo = hi ? 0.f : 1.f;
    bool wdone = false;
#define SB_STEP(tt, BUF) {                                                                                                 \
        const int kb_ = KBASE(tt);                                                                                           \
        if ((tt) + 1 < NT) SLOAD_H(Kh, Vh, KBASE((tt) + 1));                                                                 \
        SBAR();                                                                                                              \
        if (!wdone && kb_ <= qlo + QBLK - 2) {                                                                               \
            f32x16 p0, p1; bf16x8 pa0, pa1, pa2, pa3;                                                                        \
            qkt<BUF, false>(p0, p1, K_lds, r32, hi, S.qr, nullptr);                                                          \
            if (kb_ + KVBLK - 1 > qlo - 1) mask_tile(p0, p1, qm - kb_);                                                      \
            sb_part1(p0, p1, carry, mlo); sb_part2(p0, p1, pa0, pa1, pa2, pa3); SBAR();                                      \
            pv_tile<BUF>(o, vb0, pa0, pa1, pa2, pa3);                                                                        \
            wdone = __all(carry >= SB_TH);                                                                                   \
        }                                                                                                                    \
        if ((tt) + 1 < NT) { VMW(); SWRITE_H((BUF) ^ 1); }                                                                   \
        if (lane == 0) flags[((tt) & 1) * 8 + wid] = wdone ? 1 : 0;                                                          \
        __syncthreads();                                                                                                     \
        { int alld = 1;                                                                                                      \
          _Pragma("unroll") for (int w_ = 0; w_ < 8; ++w_) alld &= flags[((tt) & 1) * 8 + w_];                                \
          if (alld) break; } }
    for (int t = 0; t < NT; t += 2) {
        SB_STEP(t, 0)
        SB_STEP(t + 1, 1)
    }
#undef SB_STEP
#pragma unroll
    for (int r = 0; r < 16; ++r) { const int orow = cur.P0 + wid * QBLK + crow(r, hi);
#pragma unroll
        for (int d0 = 0; d0 < 4; ++d0) {
            const float v = o[d0][r];
            const float vn = sx_f(v, 1);
            if ((r32 & 1) == 0) *(unsigned*)(outp + (size_t)orow * DM + d0 * 32 + r32) = cvt_pk_bf16(v, vn); } }
    __syncthreads();
#undef KBASE
}
#undef ROW
#undef VMW
#undef SLOAD_H
#undef SWRITE_HK
#undef SWRITE_HV
#undef SWRITE_H
}

#define XB_TMO      128
#define XB_XCNT(j)  (256  + 64 * (j))
#define XB_XSUB(j)  (1280 + 64 * (j))
#define XB_XGEN(j)  (2304 + 64 * (j))
#define XB_TOP      3328
#define XB_TOPGEN   3392
#define XCD_BAR_WORDS 3456
#define XB_SPIN_CAP (1u << 20)
__device__ __forceinline__ unsigned xb_ld(unsigned* p)              { return __hip_atomic_load(p, __ATOMIC_RELAXED, __HIP_MEMORY_SCOPE_AGENT); }
__device__ __forceinline__ unsigned xb_add(unsigned* p, unsigned v) { return __hip_atomic_fetch_add(p, v, __ATOMIC_RELAXED, __HIP_MEMORY_SCOPE_AGENT); }
__device__ __forceinline__ unsigned xb_xcc_id() { return (unsigned)__builtin_amdgcn_s_getreg((3 << 11) | 20) & 0xFu; }
#define XB_SPIN(cond, bar) do { unsigned _sp = 0; while (cond) { __builtin_amdgcn_s_sleep(1); \
    if ((++_sp & 255u) == 0u) { if (xb_ld(&(bar)[XB_TMO])) break; if (_sp > XB_SPIN_CAP) { atomicAdd(&(bar)[XB_TMO], 1u); break; } } } } while (0)
struct XcdBarrier { unsigned* bar; unsigned x; volatile LAS unsigned* st; };
__device__ __forceinline__ XcdBarrier xcd_barrier_post(unsigned* bar, volatile LAS unsigned* st) {
    XcdBarrier b; b.bar = bar; b.x = xb_xcc_id(); b.st = st;
    if (threadIdx.x == 0) (void)xb_add(&bar[XB_XCNT(b.x)], 1u);
    return b;
}
__device__ __forceinline__ void xcd_barrier_complete(unsigned* bar, unsigned x, unsigned& nloc, unsigned& nx) {
    const unsigned G = gridDim.x * gridDim.y * gridDim.z;
    unsigned sum, cnt, mine, sp = 0u;
    for (;;) {
        sum = 0u; cnt = 0u; mine = 0u;
#pragma unroll
        for (unsigned j = 0; j < 16; ++j) { const unsigned c = xb_ld(&bar[XB_XCNT(j)]); sum += c; cnt += (c > 0u) ? 1u : 0u; mine = (j == x) ? c : mine; }
        if (sum == G) break;
        __builtin_amdgcn_s_sleep(1);
        if ((++sp & 255u) == 0u) { if (xb_ld(&bar[XB_TMO])) break; if (sp > XB_SPIN_CAP) { atomicAdd(&bar[XB_TMO], 1u); break; } }
    }
    nloc = mine > 0u ? mine : 1u; nx = cnt > 0u ? cnt : 1u;
}
__device__ __forceinline__ void xcd_barrier(const XcdBarrier& b) {
    asm volatile("s_waitcnt vmcnt(0)" ::: "memory");
    __syncthreads();
    if (threadIdx.x == 0) {
        unsigned* bar = b.bar;
        __builtin_amdgcn_s_waitcnt(0);
        unsigned nloc = b.st[0], nx = b.st[1];
        if (nloc == 0u) { xcd_barrier_complete(bar, b.x, nloc, nx); b.st[0] = nloc; b.st[1] = nx; }
        const unsigned old = xb_add(&bar[XB_XSUB(b.x)], 1u);
        const unsigned gen = old / nloc;
        if (old + 1u == (gen + 1u) * nloc) {
            __builtin_amdgcn_fence(__ATOMIC_RELEASE, "agent");
            asm volatile("s_waitcnt vmcnt(0)" ::: "memory");
            const unsigned og = xb_add(&bar[XB_TOP], 1u);
            const unsigned tg = og / nx;
            if (og + 1u == (tg + 1u) * nx) xb_add(&bar[XB_TOPGEN], 1u);
            else XB_SPIN(xb_ld(&bar[XB_TOPGEN]) == tg, bar);
            __builtin_amdgcn_fence(__ATOMIC_ACQUIRE, "agent");
            xb_add(&bar[XB_XGEN(b.x)], 1u);
            asm volatile("s_waitcnt vmcnt(0)" ::: "memory");
        } else {
            XB_SPIN(xb_ld(&bar[XB_XGEN(b.x)]) == gen, bar);
            __builtin_amdgcn_fence(__ATOMIC_ACQUIRE, "agent");
            asm volatile("s_waitcnt vmcnt(0)" ::: "memory");
        }
    }
    __syncthreads();
}

struct Args { const float* in[12]; float* out; unsigned char* ws; int ph_lo, ph_hi; };

__device__ __forceinline__ void p0_transpose_item(const float* W, int ldw, int K, bf16_t* WT, int nblk, LAS float* scr, int item, int lane, const float* gk) {
    const int kb = item / nblk, nb = item % nblk, k0 = 64 * kb, n0 = 32 * nb;
    { const int rr = lane >> 3, c4 = lane & 7; f32x4 v[8];
#pragma unroll
      for (int i = 0; i < 8; ++i) v[i] = *(const f32x4*)(W + (size_t)(k0 + rr + 8 * i) * ldw + n0 + 4 * c4);
#pragma unroll
      for (int i = 0; i < 8; ++i) { const int kk = rr + 8 * i; const float gm = gk ? gk[k0 + kk] : 1.f;
          scr[kk * 33 + 4 * c4] = v[i][0] * gm; scr[kk * 33 + 4 * c4 + 1] = v[i][1] * gm; scr[kk * 33 + 4 * c4 + 2] = v[i][2] * gm; scr[kk * 33 + 4 * c4 + 3] = v[i][3] * gm; } }
    LDS_WAIT(); asm volatile("" ::: "memory");
    const int c = lane & 7;
#pragma unroll
    for (int j = 0; j < 4; ++j) { const int n = (lane >> 3) + 8 * j; const LAS float* s = scr + (8 * c) * 33 + n;
        u32x4 o; o.x = cvt_pk_bf16(s[0 * 33], s[1 * 33]); o.y = cvt_pk_bf16(s[2 * 33], s[3 * 33]); o.z = cvt_pk_bf16(s[4 * 33], s[5 * 33]); o.w = cvt_pk_bf16(s[6 * 33], s[7 * 33]);
        *(u32x4*)(WT + (size_t)(n0 + n) * K + k0 + 8 * c) = o; }
    LDS_WAIT(); asm volatile("" ::: "memory");
}

__device__ __forceinline__ int pack_i8(float a, float b, float c, float d) {
    const int ia = (int)__builtin_rintf(a), ib = (int)__builtin_rintf(b), ic = (int)__builtin_rintf(c), id = (int)__builtin_rintf(d);
    return (int)(((unsigned)ia & 0xffu) | (((unsigned)ib & 0xffu) << 8) | (((unsigned)ic & 0xffu) << 16) | ((unsigned)id << 24));
}
__device__ __forceinline__ void convert_tables(const Args& a, int r0, int r1, int worker, int nworkers) {
    const int lane = tid_opaque() & 63;
    unsigned char* ws = a.ws; const float* g_ffn = a.in[7]; const float* pu = a.in[10]; const float* pv = a.in[11];
    float* suv = (float*)(ws + WS_SUV);
    for (int r = r0 + worker; r < r1; r += nworkers) {
        const bool isv = r >= NEXP; const int e = isv ? r - NEXP : r;
        const f32x4* srcp = (const f32x4*)((isv ? pv : pu) + (size_t)e * DM);
        f32x4 v[8]; float amax = 0.f;
#pragma unroll
        for (int j = 0; j < 8; ++j) { v[j] = srcp[lane + 64 * j];
            if (!isv) { const f32x4 g4 = *(const f32x4*)(g_ffn + 4 * (lane + 64 * j)); v[j] = v[j] * g4; }
            amax = fmaxf(amax, fmaxf(fmaxf(fabsf(v[j][0]), fabsf(v[j][1])), fmaxf(fabsf(v[j][2]), fabsf(v[j][3])))); }
        amax = wave_max(amax);
        const float sc = amax > 0.f ? 127.f / amax : 1.f;
        unsigned char* dst = ws + (isv ? WS_V8 : WS_U8) + (size_t)e * 128;
#pragma unroll
        for (int j = 0; j < 8; ++j) { const int p = pack_i8(v[j][0] * sc, v[j][1] * sc, v[j][2] * sc, v[j][3] * sc);
            const int col = 4 * (lane + 64 * j);
            *(unsigned*)(dst + (size_t)(col >> 7) * ((size_t)NEXP * 128) + (col & 127)) = (unsigned)p; }
        if (lane == 0) suv[r] = 1.f / sc;
    }
}
constexpr int TAB_SPLIT = NEXP;

__device__ __forceinline__ void p0_transpose_item_i8(const float* W, int ldw, int K, unsigned char* WT, int nblk, LAS float* scr, int item, int lane, float q8) {
    const int kb = item / nblk, nb = item % nblk, k0 = 64 * kb, n0 = 32 * nb;
    { const int rr = lane >> 3, c4 = lane & 7; f32x4 v[8];
#pragma unroll
      for (int i = 0; i < 8; ++i) v[i] = *(const f32x4*)(W + (size_t)(k0 + rr + 8 * i) * ldw + n0 + 4 * c4);
#pragma unroll
      for (int i = 0; i < 8; ++i) { const int kk = rr + 8 * i;
          scr[kk * 33 + 4 * c4] = v[i][0] * q8; scr[kk * 33 + 4 * c4 + 1] = v[i][1] * q8; scr[kk * 33 + 4 * c4 + 2] = v[i][2] * q8; scr[kk * 33 + 4 * c4 + 3] = v[i][3] * q8; } }
    LDS_WAIT(); asm volatile("" ::: "memory");
    const int c = lane & 7;
#pragma unroll
    for (int j = 0; j < 4; ++j) { const int n = (lane >> 3) + 8 * j; const LAS float* s = scr + (8 * c) * 33 + n;
        u32x2 o; o.x = (unsigned)pack_i8(s[0 * 33], s[1 * 33], s[2 * 33], s[3 * 33]); o.y = (unsigned)pack_i8(s[4 * 33], s[5 * 33], s[6 * 33], s[7 * 33]);
        *(u32x2*)(WT + (size_t)(n0 + n) * K + k0 + 8 * c) = o; }
    LDS_WAIT(); asm volatile("" ::: "memory");
}
__device__ __forceinline__ float log_sigmoid_f(float x) { return fminf(x, 0.f) - log1pf(expf(-fabsf(x))); }

__device__ __forceinline__ void phase0(const Args& a, unsigned char* lds_g) {
    LAS unsigned char* lds = (LAS unsigned char*)lds_g;
    const int tid = tid_opaque(), lane = tid & 63, wave = __builtin_amdgcn_readfirstlane(tid >> 6);
    const int gw = blockIdx.x * NWAVES + wave, NGW = gridDim.x * NWAVES;
    const int gt = blockIdx.x * NTHREADS + tid, NGT = gridDim.x * NTHREADS;
    unsigned char* ws = a.ws;
    const float* x = a.in[0]; const float* g_attn = a.in[1]; const float* w_in = a.in[2]; const float* b_forget = a.in[3];
    const float* w_out = a.in[6]; const float* g_ffn = a.in[7]; const float* w_pq = a.in[8]; const float* sk = a.in[9]; const float* pu = a.in[10]; const float* pv = a.in[11];
    { float m = 0.f; const f32x4* wp = (const f32x4*)w_in;
      constexpr size_t NV4 = (size_t)DM * DIN / 4;
      size_t i = gt;
      for (; i + 7 * (size_t)NGT < NV4; i += 8 * (size_t)NGT) {
          f32x4 v[8];
#pragma unroll
          for (int k = 0; k < 8; ++k) v[k] = wp[i + k * (size_t)NGT];
#pragma unroll
          for (int k = 0; k < 8; ++k) m = fmaxf(m, fmaxf(fmaxf(fabsf(v[k][0]), fabsf(v[k][1])), fmaxf(fabsf(v[k][2]), fabsf(v[k][3])))); }
      for (; i < NV4; i += NGT) { const f32x4 v = wp[i]; m = fmaxf(m, fmaxf(fmaxf(fabsf(v[0]), fabsf(v[1])), fmaxf(fabsf(v[2]), fabsf(v[3])))); }
      m = wave_max(m);
      volatile LAS float* red = (volatile LAS float*)(lds + MISC_OFF + 256);
      if (lane == 0) red[wave] = m;
      __syncthreads();
      if (tid == 0) { float mm = red[0];
#pragma unroll
          for (int w = 1; w < NWAVES; ++w) mm = fmaxf(mm, red[w]);
          __hip_atomic_fetch_max((unsigned*)(ws + WS_CTL) + CW_WMAX, __float_as_uint(mm), __ATOMIC_RELAXED, __HIP_MEMORY_SCOPE_AGENT); } }
    LAS float* wf = (LAS float*)(lds + 67584);
    for (int k = tid; k < DM; k += NTHREADS) { const f32x4 a0 = *(const f32x4*)(w_in + (size_t)k * DIN + NPROJ), a1 = *(const f32x4*)(w_in + (size_t)k * DIN + NPROJ + 4);
        wf[0 * DM + k] = a0[0]; wf[1 * DM + k] = a0[1]; wf[2 * DM + k] = a0[2]; wf[3 * DM + k] = a0[3]; wf[4 * DM + k] = a1[0]; wf[5 * DM + k] = a1[1]; wf[6 * DM + k] = a1[2]; wf[7 * DM + k] = a1[3]; }
    __syncthreads();
    for (int row = gw; row < T; row += NGW) {
        const f32x4* xr = (const f32x4*)(x + (size_t)row * DM);
        f32x4 v[8]; float ss = 0.f;
#pragma unroll
        for (int j = 0; j < 8; ++j) { v[j] = xr[lane + 64 * j]; ss += v[j][0] * v[j][0] + v[j][1] * v[j][1] + v[j][2] * v[j][2] + v[j][3] * v[j][3]; }
        const float r = 1.0f / sqrtf(wave_sum(ss) * (1.f / DM) + EPS);
        float f[8] = {0.f, 0.f, 0.f, 0.f, 0.f, 0.f, 0.f, 0.f};
        float xmax = 0.f;
#pragma unroll
        for (int j = 0; j < 8; ++j) { const f32x4 g4 = *(const f32x4*)(g_attn + 4 * (lane + 64 * j)); v[j][0] *= r * g4[0]; v[j][1] *= r * g4[1]; v[j][2] *= r * g4[2]; v[j][3] *= r * g4[3];
            xmax = fmaxf(xmax, fmaxf(fmaxf(fabsf(v[j][0]), fabsf(v[j][1])), fmaxf(fabsf(v[j][2]), fabsf(v[j][3])))); }
        xmax = wave_max(xmax);
        const float xq = xmax > 0.f ? 127.f / xmax : 1.f;
        if (lane == 0) ((float*)(ws + WS_SXN))[row] = xmax * (1.f / 127.f);
        unsigned* o8 = (unsigned*)(ws + WS_XN + (size_t)row * DM);
#pragma unroll
        for (int j = 0; j < 8; ++j) {
            const int e = 4 * (lane + 64 * j);
            const f32x4 xn = v[j];
            o8[lane + 64 * j] = (unsigned)pack_i8(xn[0] * xq, xn[1] * xq, xn[2] * xq, xn[3] * xq);
#pragma unroll
            for (int hh = 0; hh < 8; ++hh) { const f32x4 w4 = *(LAS f32x4*)(wf + hh * DM + e);
                f[hh] += (xn[0] * w4[0] + xn[1] * w4[1]) + (xn[2] * w4[2] + xn[3] * w4[3]); }
            __builtin_amdgcn_sched_barrier(0);
        }
#pragma unroll
        for (int hh = 0; hh < 8; ++hh) f[hh] = wave_sum(f[hh]);
        if (lane < 8) { float fl = f[0];
#pragma unroll
            for (int hh = 1; hh < 8; ++hh) fl = (lane == hh) ? f[hh] : fl;
            const int b = row >> 12, s = row & 4095;
            ((float*)(ws + WS_LOGF))[(size_t)(b * 8 + lane) * SEQ + s] = log_sigmoid_f(fl + b_forget[lane]); }
    }
    LAS float* scr = (LAS float*)(lds + wave * 8448);
    constexpr int I_IN = (DM / 64) * (NPROJ / 32), I_O = (DM / 64) * (DM / 32);
    for (int it = gw; it < 2 * I_O; it += NGW) {
        int r = it;
        if (r < I_O) { p0_transpose_item(w_out, DM, DM, (bf16_t*)(ws + WS_WOUT), DM / 32, scr, r, lane, nullptr); continue; } r -= I_O;
        p0_transpose_item(w_pq, DM, DM, (bf16_t*)(ws + WS_WPQ), DM / 32, scr, r, lane, g_ffn);
    }
    for (int i = gt; i < 8 * 2 * 128 * 128 / 8; i += NGT) { const f32x4 a0 = *(const f32x4*)(sk + (size_t)i * 8), a1 = *(const f32x4*)(sk + (size_t)i * 8 + 4);
        u32x4 w; w.x = cvt_pk_bf16(a0[0], a0[1]); w.y = cvt_pk_bf16(a0[2], a0[3]); w.z = cvt_pk_bf16(a1[0], a1[1]); w.w = cvt_pk_bf16(a1[2], a1[3]);
        *(u32x4*)(ws + WS_SK + (size_t)i * 16) = w; }
    if (gt < 256) ((float*)(ws + WS_GQK))[gt] = gt < 128 ? a.in[4][gt] : a.in[5][gt - 128];
    convert_tables(a, 0, TAB_SPLIT, gw, NGW);
    { XcdBarrier xb_; xb_.bar = (unsigned*)(ws + WS_CTL) + CW_BAR; xb_.x = xb_xcc_id(); xb_.st = (volatile LAS unsigned*)(lds + MISC_OFF) + 8; xcd_barrier(xb_); }
    const float wmax = __uint_as_float(__hip_atomic_load((unsigned*)(ws + WS_CTL) + CW_WMAX, __ATOMIC_RELAXED, __HIP_MEMORY_SCOPE_AGENT));
    if (gt == 0) *(float*)(ws + WS_WSC) = wmax * (1.f / 127.f);
    const float q8 = wmax > 0.f ? 127.f / wmax : 1.f;
    for (int it = gw; it < I_IN; it += NGW) p0_transpose_item_i8(w_in, DIN, DM, ws + WS_WIN, NPROJ / 32, scr, it, lane, q8);
}

__device__ __forceinline__ void cumsum_rows(const Args& a) {
    const int tid = tid_opaque(), lane = tid & 63, wave = tid >> 6;
    if (blockIdx.x >= 16 || wave != 0) return;
    const float* src = (const float*)(a.ws + WS_LOGF) + (size_t)blockIdx.x * SEQ + lane * 64;
    float* dst = (float*)(a.ws + WS_C) + (size_t)blockIdx.x * SEQ + lane * 64;
    f32x4 v[16]; float run = 0.f;
#pragma unroll
    for (int i = 0; i < 16; ++i) { v[i] = *(const f32x4*)(src + 4 * i);
#pragma unroll
        for (int q = 0; q < 4; ++q) { run += v[i][q]; v[i][q] = run; } }
    float incl = run;
#pragma unroll
    for (int o = 1; o < 64; o <<= 1) { const float t = shup_f(incl, o); if (lane >= o) incl += t; }
    const float off = incl - run;
#pragma unroll
    for (int i = 0; i < 16; ++i) { f32x4 w = v[i]; w[0] += off; w[1] += off; w[2] += off; w[3] += off; *(f32x4*)(dst + 4 * i) = w; }
}

__device__ __forceinline__ void phase_qknorm(const Args& a) {
    const int tid = tid_opaque(), lane = tid & 63, wave = tid >> 6;
    const int gw = blockIdx.x * NWAVES + wave, NGW = gridDim.x * NWAVES;
    const int sub = lane & 15, rw = lane >> 4;
    const float* gq = a.in[4]; const float* gk = a.in[5];
    constexpr int ROWS = NB * NHF * SEQ;
    for (int it = gw; it < 2 * ROWS / 4; it += NGW) {
        const int row = it * 4 + rw; const bool isk = row >= ROWS;
        bf16_t* p = (bf16_t*)(a.ws + WS_SEC) + (size_t)row * HD + sub * 8;
        const float* g = (isk ? gk : gq) + sub * 8;
        const u32x4 w = *(const u32x4*)p;
        float v[8] = {bf_lo(w.x), bf_hi(w.x), bf_lo(w.y), bf_hi(w.y), bf_lo(w.z), bf_hi(w.z), bf_lo(w.w), bf_hi(w.w)};
        float ss = 0.f;
#pragma unroll
        for (int i = 0; i < 8; ++i) ss += v[i] * v[i];
        ss += sx_f(ss, 1); ss += sx_f(ss, 2); ss += sx_f(ss, 4); ss += sx_f(ss, 8);
        const float r = 1.0f / sqrtf(ss * (1.f / HD) + EPS);
        const f32x4 g0 = *(const f32x4*)g, g1 = *(const f32x4*)(g + 4);
        u32x4 o; o.x = cvt_pk_bf16(v[0] * r * g0[0], v[1] * r * g0[1]); o.y = cvt_pk_bf16(v[2] * r * g0[2], v[3] * r * g0[3]);
        o.z = cvt_pk_bf16(v[4] * r * g1[0], v[5] * r * g1[1]); o.w = cvt_pk_bf16(v[6] * r * g1[2], v[7] * r * g1[3]);
        *(u32x4*)p = o;
    }
}

__device__ __forceinline__ void phase_attn(const Args& a, unsigned char* lds_g) {
    const int tid = tid_opaque();
    volatile int* s_item = (volatile int*)(lds_g + MISC_OFF);
    unsigned* ctr = (unsigned*)(a.ws + WS_CTL);
    for (;;) {
        __syncthreads();
        if (tid == 0) *s_item = (int)atomicAdd(ctr, 1u);
        __syncthreads();
        int it = *s_item, kind = -1, qb = 0, sub = 0;
#define CLS(K, Q, CNT) if (kind < 0) { if (it < (CNT)) { kind = (K); qb = (Q); sub = it; } else it -= (CNT); }
        CLS(2, 15, 32) CLS(1, 7, 16) CLS(2, 14, 32) CLS(2, 13, 32) CLS(1, 6, 16) CLS(2, 12, 32) CLS(2, 11, 32) CLS(1, 5, 16) CLS(2, 10, 32) CLS(2, 9, 32) CLS(1, 4, 16) CLS(2, 8, 32) CLS(1, 3, 16) CLS(1, 2, 16)
        if (kind < 0) { if (it < 256) { kind = 0; qb = 15 - (it >> 4); sub = it & 15; } else it -= 256; }
        CLS(1, 1, 16) CLS(1, 0, 16)
#undef CLS
        if (kind < 0) break;
        unsigned char* wsl = a.ws; asm volatile("" : "+s"(wsl));
        bf16_t* sec = (bf16_t*)(wsl + WS_SEC);
        const int bh = sub & 15, part = (kind == 2) ? 1 + (sub >> 4) : 0;
        const int b = bh >> 3, h = bh & 7;
        const size_t hoff = (size_t)bh * SEQ * HD;
        att::UnitRef u;
        u.P0 = qb * 256;
        if (kind == 0) {
            u.Q = sec + 4 * SEC_ELEMS + hoff + (size_t)u.P0 * HD; u.K = sec + 5 * SEC_ELEMS + hoff; u.V = sec + 6 * SEC_ELEMS + hoff;
            att::sb_unit(u, (bf16_t*)(wsl + WS_MIX) + (size_t)b * SEQ * DM + 1024 + h * HD, (char*)lds_g);
        } else {
            u.Q = sec + 0 * SEC_ELEMS + hoff + (size_t)u.P0 * HD; u.K = sec + 1 * SEC_ELEMS + hoff; u.V = sec + 2 * SEC_ELEMS + hoff;
            att::attn_unit<false>(u, wsl, bh, (char*)lds_g, part);
        }
    }
}
__device__ __forceinline__ void phase_attn_combine(const Args& a) {
    const int gt = blockIdx.x * NTHREADS + tid_opaque(), NGT = gridDim.x * NTHREADS;
    const float* po = (const float*)(a.ws + WS_PO); const float* pml = (const float*)(a.ws + WS_PML);
    const bf16_t* gate = (const bf16_t*)(a.ws + WS_SEC) + 3 * SEC_ELEMS; bf16_t* mix = (bf16_t*)(a.ws + WS_MIX);
    constexpr float C2 = LOG2E * SCALE;
    for (int item = gt; item < 128 * 256 * 16; item += NGT) {
        const int slot = item >> 12, row = (item >> 4) & 255, cg = item & 15;
        const int qb = 8 + (slot >> 4), bh = slot & 15, b = bh >> 3, h = bh & 7;
        const f32x2 ml1 = *(const f32x2*)(pml + (size_t)(slot * 2) * 512 + row * 2), ml2 = *(const f32x2*)(pml + (size_t)(slot * 2 + 1) * 512 + row * 2);
        const float M = fmaxf(ml1.x, ml2.x), a1 = __builtin_amdgcn_exp2f((ml1.x - M) * C2), a2 = __builtin_amdgcn_exp2f((ml2.x - M) * C2);
        const float inv = 1.f / (a1 * ml1.y + a2 * ml2.y);
        const float* p1 = po + (size_t)(slot * 2) * 32768 + row * 128 + cg * 8; const float* p2 = p1 + 32768;
        const f32x4 x0 = *(const f32x4*)p1, x1 = *(const f32x4*)(p1 + 4), y0 = *(const f32x4*)p2, y1 = *(const f32x4*)(p2 + 4);
        const size_t tok = (size_t)b * SEQ + qb * 256 + row;
        const u32x4 gw = *(const u32x4*)(gate + tok * 1024 + h * HD + cg * 8);
        const float w1 = a1 * inv, w2 = a2 * inv;
        u32x4 o;
        o.x = cvt_pk_bf16((w1 * x0[0] + w2 * y0[0]) * bf_lo(gw.x), (w1 * x0[1] + w2 * y0[1]) * bf_hi(gw.x));
        o.y = cvt_pk_bf16((w1 * x0[2] + w2 * y0[2]) * bf_lo(gw.y), (w1 * x0[3] + w2 * y0[3]) * bf_hi(gw.y));
        o.z = cvt_pk_bf16((w1 * x1[0] + w2 * y1[0]) * bf_lo(gw.z), (w1 * x1[1] + w2 * y1[1]) * bf_hi(gw.z));
        o.w = cvt_pk_bf16((w1 * x1[2] + w2 * y1[2]) * bf_lo(gw.w), (w1 * x1[3] + w2 * y1[3]) * bf_hi(gw.w));
        *(u32x4*)(mix + tok * DM + h * HD + cg * 8) = o;
    }
}

__device__ __forceinline__ unsigned f2ord(float f) { const unsigned u = __float_as_uint(f); return u ^ ((unsigned)((int)u >> 31) | 0x80000000u); }
__device__ __forceinline__ float ord2f(unsigned k) { const unsigned u = k ^ (~(unsigned)((int)k >> 31) | 0x80000000u); return __uint_as_float(u); }
#define INS16(L, X) do { unsigned x_ = (X); _Pragma("unroll") for (int i_ = 0; i_ < 16; ++i_) { const unsigned hi_ = max(L[i_], x_); x_ = min(L[i_], x_); L[i_] = hi_; } } while (0)
__device__ __forceinline__ void sort16_desc(unsigned (&a)[16]) {
#pragma unroll
    for (int k = 2; k <= 16; k <<= 1)
#pragma unroll
        for (int j = k >> 1; j > 0; j >>= 1)
#pragma unroll
            for (int i = 0; i < 16; ++i) { const int l = i ^ j; if (l > i) { const unsigned hi_ = max(a[i], a[l]), lo_ = min(a[i], a[l]); const bool desc = (i & k) == 0; a[i] = desc ? hi_ : lo_; a[l] = desc ? lo_ : hi_; } }
}
__device__ __forceinline__ void merge_top16(unsigned (&a)[16], const unsigned (&b)[16]) {
#pragma unroll
    for (int i = 0; i < 16; ++i) a[i] = max(a[i], b[15 - i]);
#pragma unroll
    for (int j = 8; j > 0; j >>= 1)
#pragma unroll
        for (int i = 0; i < 16; ++i) { const int l = i ^ j; if (l > i) { const unsigned hi_ = max(a[i], a[l]), lo_ = min(a[i], a[l]); a[i] = hi_; a[l] = lo_; } }
}
__device__ __forceinline__ void topk_half(const bf16_t* qrow  , const bf16_t* skb, int h, int c, int r32, int hi, unsigned (&L)[16]) {
    bf16x8 qf[8];
#pragma unroll
    for (int d0 = 0; d0 < 8; ++d0) qf[d0] = *(const bf16x8*)(qrow + c * 128 + d0 * 16 + hi * 8);
    const unsigned hi4 = 4u * (unsigned)hi;
#pragma unroll
    for (int kt = 0; kt < 4; ++kt) {
        f32x16 acc = f32x16{};
#pragma unroll
        for (int d0 = 0; d0 < 8; ++d0) { const bf16x8 kf = *(const bf16x8*)(skb + (size_t)((h * 2 + c) * 128 + kt * 32 + r32) * 128 + d0 * 16 + hi * 8);
            acc = __builtin_amdgcn_mfma_f32_32x32x16_bf16(kf, qf[d0], acc, 0, 0, 0); }
        unsigned G[16];
#pragma unroll
        for (int r = 0; r < 16; ++r) { const unsigned cst = (unsigned)(127 - (kt * 32 + (r & 3) + 8 * (r >> 2))); G[r] = (f2ord(acc[r]) & ~127u) | (cst - hi4); }
        sort16_desc(G);
        if (kt == 0) {
#pragma unroll
            for (int i = 0; i < 16; ++i) L[i] = G[i];
        } else merge_top16(L, G);
    }
    unsigned P[16];
#pragma unroll
    for (int i = 0; i < 16; ++i) { auto rr = __builtin_amdgcn_permlane32_swap(L[i], L[i], false, false); P[i] = hi ? rr[0] : rr[1]; }
    merge_top16(L, P);
}
__device__ __forceinline__ void topk_task(unsigned char* ws, const bf16_t* qrow, LAS int* tb, int t0, int h, int lane) {
    const int r32 = lane & 31, hi = lane >> 5;
    const bf16_t* skb = (const bf16_t*)(ws + WS_SK);
    int* idx_o = (int*)(ws + WS_IDX); float* gw_o = (float*)(ws + WS_GW);
    float rt_l;
    { const f32x4* sp = (const f32x4*)((const float*)(ws + WS_SSQ) + (size_t)(t0 + (lane & 31)) * 32); float tot = 0.f;
#pragma unroll
      for (int i = 0; i < 8; ++i) { const f32x4 v = sp[i]; tot += (v[0] + v[1]) + (v[2] + v[3]); }
      rt_l = 1.0f / sqrtf(tot * (1.f / DM) + EPS); }
        {
          const bf16_t* hbp = (const bf16_t*)(ws + WS_HB); const float* amx = (const float*)(ws + WS_AMX); unsigned char* xq = ws + WS_XQ;
          float am = 0.f;
          { const f32x4* ap = (const f32x4*)(amx + (size_t)(t0 + (lane & 31)) * 32);
#pragma unroll
            for (int i = 0; i < 8; ++i) { const f32x4 v = ap[i]; am = fmaxf(am, fmaxf(fmaxf(v[0], v[1]), fmaxf(v[2], v[3]))); } }
          if (h == 0 && lane < 32) ((float*)(ws + WS_SX))[t0 + lane] = rt_l * am * (1.f / 126.5f);
          const float qs = am > 0.f ? 126.5f / am : 1.f;
          u32x4 wv[16];
#pragma unroll
          for (int j = 0; j < 16; ++j) { const int ch = lane + 64 * j; wv[j] = *(const u32x4*)(hbp + (size_t)(t0 + (ch >> 5)) * DM + h * 256 + (ch & 31) * 8); }
#pragma unroll
          for (int j = 0; j < 16; ++j) { const int ch = lane + 64 * j, tl = ch >> 5, tk = t0 + tl, col = h * 256 + (ch & 31) * 8;
              const u32x4 w = wv[j]; const float r = sh_f(qs, tl);
              const int p0 = pack_i8(bf_lo(w.x) * r, bf_hi(w.x) * r, bf_lo(w.y) * r, bf_hi(w.y) * r), p1 = pack_i8(bf_lo(w.z) * r, bf_hi(w.z) * r, bf_lo(w.w) * r, bf_hi(w.w) * r);
              *(u32x2*)(xq + (size_t)tk * DM + col) = (u32x2){(unsigned)p0, (unsigned)p1}; } }
        unsigned L[2][16];
        topk_half(qrow, skb, h, 0, r32, hi, L[0]);
        __builtin_amdgcn_sched_barrier(0);
        topk_half(qrow, skb, h, 1, r32, hi, L[1]);
        __builtin_amdgcn_sched_barrier(0);
        float s1[16], s2[16]; int i1[16], i2[16];
#pragma unroll
        for (int i = 0; i < 16; ++i) { s1[i] = ord2f((L[0][i] & ~127u) | 64u); i1[i] = 127 - (int)(L[0][i] & 127u); s2[i] = ord2f((L[1][i] & ~127u) | 64u); i2[i] = 127 - (int)(L[1][i] & 127u); }
        unsigned CG[4][16];
#pragma unroll
        for (int i = 0; i < 64; ++i) CG[i >> 4][i & 15] = 0u;
        CG[0][0] = (f2ord(s1[0] + s2[0]) & ~255u) | 0u;
        CG[0][1] = (f2ord(s1[0] + s2[1]) & ~255u) | 1u;
        CG[0][2] = (f2ord(s1[0] + s2[2]) & ~255u) | 2u;
        CG[0][3] = (f2ord(s1[0] + s2[3]) & ~255u) | 3u;
        CG[0][4] = (f2ord(s1[0] + s2[4]) & ~255u) | 4u;
        CG[0][5] = (f2ord(s1[0] + s2[5]) & ~255u) | 5u;
        CG[0][6] = (f2ord(s1[0] + s2[6]) & ~255u) | 6u;
        CG[0][7] = (f2ord(s1[0] + s2[7]) & ~255u) | 7u;
        CG[0][8] = (f2ord(s1[0] + s2[8]) & ~255u) | 8u;
        CG[0][9] = (f2ord(s1[0] + s2[9]) & ~255u) | 9u;
        CG[0][10] = (f2ord(s1[0] + s2[10]) & ~255u) | 10u;
        CG[0][11] = (f2ord(s1[0] + s2[11]) & ~255u) | 11u;
        CG[0][12] = (f2ord(s1[0] + s2[12]) & ~255u) | 12u;
        CG[0][13] = (f2ord(s1[0] + s2[13]) & ~255u) | 13u;
        CG[0][14] = (f2ord(s1[0] + s2[14]) & ~255u) | 14u;
        CG[0][15] = (f2ord(s1[0] + s2[15]) & ~255u) | 15u;
        CG[1][0] = (f2ord(s1[1] + s2[0]) & ~255u) | 16u;
        CG[1][1] = (f2ord(s1[1] + s2[1]) & ~255u) | 17u;
        CG[1][2] = (f2ord(s1[1] + s2[2]) & ~255u) | 18u;
        CG[1][3] = (f2ord(s1[1] + s2[3]) & ~255u) | 19u;
        CG[1][4] = (f2ord(s1[1] + s2[4]) & ~255u) | 20u;
        CG[1][5] = (f2ord(s1[1] + s2[5]) & ~255u) | 21u;
        CG[1][6] = (f2ord(s1[1] + s2[6]) & ~255u) | 22u;
        CG[1][7] = (f2ord(s1[1] + s2[7]) & ~255u) | 23u;
        CG[1][8] = (f2ord(s1[2] + s2[0]) & ~255u) | 32u;
        CG[1][9] = (f2ord(s1[2] + s2[1]) & ~255u) | 33u;
        CG[1][10] = (f2ord(s1[2] + s2[2]) & ~255u) | 34u;
        CG[1][11] = (f2ord(s1[2] + s2[3]) & ~255u) | 35u;
        CG[1][12] = (f2ord(s1[2] + s2[4]) & ~255u) | 36u;
        CG[1][13] = (f2ord(s1[3] + s2[0]) & ~255u) | 48u;
        CG[1][14] = (f2ord(s1[3] + s2[1]) & ~255u) | 49u;
        CG[1][15] = (f2ord(s1[3] + s2[2]) & ~255u) | 50u;
        CG[2][0] = (f2ord(s1[3] + s2[3]) & ~255u) | 51u;
        CG[2][1] = (f2ord(s1[4] + s2[0]) & ~255u) | 64u;
        CG[2][2] = (f2ord(s1[4] + s2[1]) & ~255u) | 65u;
        CG[2][3] = (f2ord(s1[4] + s2[2]) & ~255u) | 66u;
        CG[2][4] = (f2ord(s1[5] + s2[0]) & ~255u) | 80u;
        CG[2][5] = (f2ord(s1[5] + s2[1]) & ~255u) | 81u;
        CG[2][6] = (f2ord(s1[6] + s2[0]) & ~255u) | 96u;
        CG[2][7] = (f2ord(s1[6] + s2[1]) & ~255u) | 97u;
        CG[2][8] = (f2ord(s1[7] + s2[0]) & ~255u) | 112u;
        CG[2][9] = (f2ord(s1[7] + s2[1]) & ~255u) | 113u;
        CG[2][10] = (f2ord(s1[8] + s2[0]) & ~255u) | 128u;
        CG[2][11] = (f2ord(s1[9] + s2[0]) & ~255u) | 144u;
        CG[2][12] = (f2ord(s1[10] + s2[0]) & ~255u) | 160u;
        CG[2][13] = (f2ord(s1[11] + s2[0]) & ~255u) | 176u;
        CG[2][14] = (f2ord(s1[12] + s2[0]) & ~255u) | 192u;
        CG[2][15] = (f2ord(s1[13] + s2[0]) & ~255u) | 208u;
        CG[3][0] = (f2ord(s1[14] + s2[0]) & ~255u) | 224u;
        CG[3][1] = (f2ord(s1[15] + s2[0]) & ~255u) | 240u;
        sort16_desc(CG[0]); sort16_desc(CG[1]); sort16_desc(CG[2]); sort16_desc(CG[3]);
        merge_top16(CG[0], CG[1]); merge_top16(CG[2], CG[3]); merge_top16(CG[0], CG[2]);
        unsigned LC[16];
#pragma unroll
        for (int i = 0; i < 16; ++i) LC[i] = CG[0][i];
#pragma unroll
        for (int i = 0; i < 16; ++i) { tb[i * 64 + lane] = i1[i]; tb[(16 + i) * 64 + lane] = i2[i]; }
        float LS[16]; int LP[16];
#pragma unroll
        for (int i = 0; i < 16; ++i) { const unsigned cid = LC[i] & 255u; LS[i] = ord2f((LC[i] & ~255u) | 128u);
            LP[i] = tb[(cid >> 4) * 64 + lane] * 128 + tb[(16 + (cid & 15u)) * 64 + lane]; }
        float den = 0.f, e[16];
#pragma unroll
        for (int i = 0; i < 16; ++i) { e[i] = __expf(LS[i] - LS[0]); den += e[i]; }
        const float rden = 1.f / den;
        const size_t ob = (size_t)(t0 + r32) * NE + h * 16;
        if (hi == 0) {
#pragma unroll
            for (int i = 0; i < 4; ++i) *(int4*)(idx_o + ob + 4 * i) = make_int4(LP[4 * i], LP[4 * i + 1], LP[4 * i + 2], LP[4 * i + 3]);
            { unsigned short* i16 = (unsigned short*)(ws + WS_IDX16) + ob;
#pragma unroll
              for (int i = 0; i < 2; ++i) *(u32x4*)(i16 + 8 * i) = (u32x4){(unsigned)LP[8 * i] | ((unsigned)LP[8 * i + 1] << 16), (unsigned)LP[8 * i + 2] | ((unsigned)LP[8 * i + 3] << 16),
                                                                        (unsigned)LP[8 * i + 4] | ((unsigned)LP[8 * i + 5] << 16), (unsigned)LP[8 * i + 6] | ((unsigned)LP[8 * i + 7] << 16)}; }
        } else {
#pragma unroll
            for (int i = 0; i < 4; ++i) *(f32x4*)(gw_o + ob + 4 * i) = (f32x4){e[4 * i] * rden, e[4 * i + 1] * rden, e[4 * i + 2] * rden, e[4 * i + 3] * rden};
        }
}
__device__ __forceinline__ void phase_topk(const Args& a, unsigned char* lds_g) {
    LAS unsigned char* lds = (LAS unsigned char*)lds_g;
    const int tid = tid_opaque(), lane = tid & 63, wave = tid >> 6;
    const int gw = blockIdx.x * NWAVES + wave, NGW = gridDim.x * NWAVES;
    const bf16_t* qp = (const bf16_t*)(a.ws + WS_QP);
    for (int task = gw; task < (T / 32) * 8; task += NGW) {
        const int h = task & 7, t0 = (task >> 3) * 32;
        topk_task(a.ws, qp + (size_t)(t0 + (lane & 31)) * DM + h * 256, (LAS int*)(lds + wave * 8192), t0, h, lane);
    }
}
__device__ __forceinline__ void pg8::EpiPeerQFused::fused(const f32x4 (&acc)[2][2][4][2], const Unit& u, int wr, int wc, int fr, int fq, PG8_LAS unsigned char* lds) const {
    constexpr int ROWB = 528;
#pragma unroll
    for (int ai = 0; ai < 2; ++ai)
#pragma unroll
        for (int m = 0; m < 4; ++m) {
            const int tr = ai * HALF + wr * 64 + m * 16 + fr, tk = u.pm * BM + tr;
            float tot = 0.f;
#pragma unroll
            for (int i = 0; i < 8; ++i) { const f32x4 s4 = *(const f32x4*)(ssq + (size_t)tk * 32 + 4 * i); tot += (s4[0] + s4[1]) + (s4[2] + s4[3]); }
            const float r = 1.0f / sqrtf(tot * (1.f / DM) + EPS);
#pragma unroll
            for (int bj = 0; bj < 2; ++bj) {
                const f32x4 v0 = acc[ai][bj][m][0] * r, v1 = acc[ai][bj][m][1] * r;
                u32x4 w; w.x = cvt_pk_bf16(v0[0], v0[1]); w.y = cvt_pk_bf16(v0[2], v0[3]); w.z = cvt_pk_bf16(v1[0], v1[1]); w.w = cvt_pk_bf16(v1[2], v1[3]);
                *(PG8_LAS u32x4*)(lds + tr * ROWB + (bj * HALF + wc * 32 + 8 * fq) * 2) = w;
            }
        }
    __syncthreads();
    const int tid = tid_opaque(), lane = tid & 63, wave = tid >> 6;
    PG8_LAS unsigned char* myrows = lds + (wave * 32) * ROWB;
    topk_task(wsb, (const bf16_t*)(const void*)(myrows + (lane & 31) * ROWB), (LAS int*)myrows, u.pm * BM + wave * 32, u.pn, lane);
}
__device__ __forceinline__ void wave_argmax(float& v, int& i) {
#pragma unroll
    for (int o = 1; o < 64; o <<= 1) { const float ov = sx_f(v, o); const int oi = sx_i(i, o); if (ov > v || (ov == v && oi < i)) { v = ov; i = oi; } }
}
__device__ __forceinline__ void phase_topk_ref(const Args& a) {
    const int tid = tid_opaque(), lane = tid & 63, wave = tid >> 6;
    const int gw = blockIdx.x * NWAVES + wave, NGW = gridDim.x * NWAVES;
    const bf16_t* skb = (const bf16_t*)(a.ws + WS_SK); const bf16_t* qp = (const bf16_t*)(a.ws + WS_QP);
    int* idx_o = (int*)(a.ws + WS_IDX); float* gw_o = (float*)(a.ws + WS_GW);
    for (int task = gw; task < T * 8; task += NGW) {
        const int t = task >> 3, h = task & 7;
        float topS[2]; int topI[2];
        for (int c = 0; c < 2; ++c) {
            const bf16_t* q = qp + (size_t)t * DM + h * 256 + c * 128;
            float sc0 = 0.f, sc1 = 0.f;
            const bf16_t* k0 = skb + (size_t)((h * 2 + c) * 128 + lane) * 128; const bf16_t* k1 = k0 + 64 * 128;
            for (int d = 0; d < 128; ++d) { const float qd = __uint_as_float((unsigned)q[d] << 16);
                sc0 += qd * __uint_as_float((unsigned)k0[d] << 16); sc1 += qd * __uint_as_float((unsigned)k1[d] << 16); }
            float ms = 0.f; int mi = 0;
            for (int r = 0; r < 16; ++r) {
                float v; int i; if (sc0 >= sc1) { v = sc0; i = lane; } else { v = sc1; i = lane + 64; }
                wave_argmax(v, i);
                if (lane == r) { ms = v; mi = i; }
                if (i == lane) sc0 = -__builtin_inff();
                if (i == lane + 64) sc1 = -__builtin_inff();
            }
            topS[c] = ms; topI[c] = mi;
        }
        float cs[4]; int ci[4];
#pragma unroll
        for (int j = 0; j < 4; ++j) { const int cidx = lane * 4 + j, aa = cidx >> 4, bb = cidx & 15;
            cs[j] = sh_f(topS[0], aa) + sh_f(topS[1], bb); ci[j] = cidx; }
        float fs = 0.f; int fi = 0;
        for (int r = 0; r < 16; ++r) {
            float v = cs[0]; int i = ci[0];
#pragma unroll
            for (int j = 1; j < 4; ++j) if (cs[j] > v) { v = cs[j]; i = ci[j]; }
            wave_argmax(v, i);
            if (lane == r) { fs = v; fi = i; }
#pragma unroll
            for (int j = 0; j < 4; ++j) if (ci[j] == i) cs[j] = -__builtin_inff();
        }
        const int e1 = sh_i(topI[0], fi >> 4), e2 = sh_i(topI[1], fi & 15);
        const float mx = sh_f(fs, 0);
        float ev = lane < 16 ? __expf(fs - mx) : 0.f;
        const float den = wave_sum(ev);
        if (lane < 16) { idx_o[(size_t)t * NE + h * 16 + lane] = e1 * 128 + e2; gw_o[(size_t)t * NE + h * 16 + lane] = ev / den; }
    }
}

__device__ __forceinline__ void fp8x16_to_f32(const u32x4 q, f32x2 (&o)[8]) {
    o[0] = __builtin_amdgcn_cvt_pk_f32_fp8((int)q.x, false); o[1] = __builtin_amdgcn_cvt_pk_f32_fp8((int)q.x, true);
    o[2] = __builtin_amdgcn_cvt_pk_f32_fp8((int)q.y, false); o[3] = __builtin_amdgcn_cvt_pk_f32_fp8((int)q.y, true);
    o[4] = __builtin_amdgcn_cvt_pk_f32_fp8((int)q.z, false); o[5] = __builtin_amdgcn_cvt_pk_f32_fp8((int)q.z, true);
    o[6] = __builtin_amdgcn_cvt_pk_f32_fp8((int)q.w, false); o[7] = __builtin_amdgcn_cvt_pk_f32_fp8((int)q.w, true);
}
#define HALVE(dst, srcv, n, bitmask) do { const bool up_ = (lane & (bitmask)) != 0; _Pragma("unroll") for (int i_ = 0; i_ < (n); ++i_) { \
        const float keep_ = up_ ? srcv[(n) + i_] : srcv[i_], send_ = up_ ? srcv[i_] : srcv[(n) + i_]; dst[i_] = keep_ + sx_f(send_, (bitmask)); } } while (0)
#define ITEM_T(n) (wv + ((n) % KT) * NWX)
#define ITEM_S(n) (xl + 8 * ((n) / KT))
#define LD_IDX(ID, n) do { const int4* ip_ = (const int4*)(idx_i + (size_t)ITEM_T(n) * NE + g * 16); _Pragma("unroll") for (int i_ = 0; i_ < 4; ++i_) ID[i_] = ip_[i_]; } while (0)
#define LD_ROWS(Q, ID, TAB, n) do { const unsigned char* b_ = (TAB) + (size_t)ITEM_S(n) * ((size_t)NEXP * 128) + c * 16; _Pragma("unroll") for (int i_ = 0; i_ < 4; ++i_) { \
        Q[4 * i_] = *(const u32x4*)(b_ + (size_t)ID[i_].x * 128); Q[4 * i_ + 1] = *(const u32x4*)(b_ + (size_t)ID[i_].y * 128); \
        Q[4 * i_ + 2] = *(const u32x4*)(b_ + (size_t)ID[i_].z * 128); Q[4 * i_ + 3] = *(const u32x4*)(b_ + (size_t)ID[i_].w * 128); } } while (0)
__device__ __forceinline__ int dpp_hmirror(int v) { return __builtin_amdgcn_update_dpp(0, v, 0x141, 0xf, 0xf, true); }
__device__ __forceinline__ int dpp_qxor2(int v) { return __builtin_amdgcn_update_dpp(0, v, 0x4E, 0xf, 0xf, true); }
__device__ __forceinline__ int dpp_qxor1(int v) { return __builtin_amdgcn_update_dpp(0, v, 0xB1, 0xf, 0xf, true); }
__device__ __forceinline__ void phase_peer_u(const Args& a) {
    const int tid = tid_opaque(), lane = tid & 63, wave = tid >> 6, g = lane >> 3, c = lane & 7;
    const int xl = blockIdx.x & 7, wv = (blockIdx.x >> 3) * NWAVES + wave, NWX = (gridDim.x >> 3) * NWAVES, KT = T / NWX, N = 2 * KT;
    const unsigned char* xq = a.ws + WS_XQ; const unsigned char* u8 = a.ws + WS_U8;
    const unsigned short* idx16 = (const unsigned short*)(a.ws + WS_IDX16); bf16_t* part = (bf16_t*)(a.ws + WS_PART);
    const bool up4 = (c & 4) != 0, up2 = (c & 2) != 0, up1 = (c & 1) != 0;
#define LD_I16(ID, n, h) do { ID = *(const u32x4*)(idx16 + (size_t)ITEM_T(n) * NE + g * 16 + (h) * 8); } while (0)
#define LD_R8(Q, ID, n) do { const unsigned char* b_ = u8 + (size_t)ITEM_S(n) * ((size_t)NEXP * 128) + c * 16; \
        Q[0] = *(const u32x4*)(b_ + (size_t)(ID.x & 0xffffu) * 128); Q[1] = *(const u32x4*)(b_ + (size_t)(ID.x >> 16) * 128); \
        Q[2] = *(const u32x4*)(b_ + (size_t)(ID.y & 0xffffu) * 128); Q[3] = *(const u32x4*)(b_ + (size_t)(ID.y >> 16) * 128); \
        Q[4] = *(const u32x4*)(b_ + (size_t)(ID.z & 0xffffu) * 128); Q[5] = *(const u32x4*)(b_ + (size_t)(ID.z >> 16) * 128); \
        Q[6] = *(const u32x4*)(b_ + (size_t)(ID.w & 0xffffu) * 128); Q[7] = *(const u32x4*)(b_ + (size_t)(ID.w >> 16) * 128); } while (0)
#define LD_X(X, n) do { X = *(const u32x4*)(xq + (size_t)ITEM_T(n) * DM + ITEM_S(n) * 128 + c * 16); } while (0)
#define DOT8(P, OFF, Q, X) do { _Pragma("unroll") for (int i = 0; i < 8; ++i) { int d_ = __builtin_amdgcn_sdot4((int)Q[i].x, (int)X.x, 0, false); d_ = __builtin_amdgcn_sdot4((int)Q[i].y, (int)X.y, d_, false); \
            d_ = __builtin_amdgcn_sdot4((int)Q[i].z, (int)X.z, d_, false); P[(OFF) + i] = __builtin_amdgcn_sdot4((int)Q[i].w, (int)X.w, d_, false); } } while (0)
#define FINISH_U(P, n) do { int p8[8], p4[4], p2[2]; \
        _Pragma("unroll") for (int i = 0; i < 8; ++i) { const int keep_ = up4 ? P[8 + i] : P[i], send_ = up4 ? P[i] : P[8 + i]; p8[i] = keep_ + dpp_hmirror(send_); } \
        _Pragma("unroll") for (int i = 0; i < 4; ++i) { const int keep_ = up2 ? p8[4 + i] : p8[i], send_ = up2 ? p8[i] : p8[4 + i]; p4[i] = keep_ + dpp_qxor2(send_); } \
        _Pragma("unroll") for (int i = 0; i < 2; ++i) { const int keep_ = up1 ? p4[2 + i] : p4[i], send_ = up1 ? p4[i] : p4[2 + i]; p2[i] = keep_ + dpp_qxor1(send_); } \
        *(unsigned*)(part + ((size_t)ITEM_T(n) * 16 + ITEM_S(n)) * NE + 2 * lane) = cvt_pk_bf16((float)p2[0], (float)p2[1]); } while (0)
    u32x4 IA, IB, IC, ID_, QA[8], QB[8], QC[8], QD[8], XA, XB;
    LD_I16(IA, 0, 0); LD_I16(IB, 0, 1); LD_I16(IC, 1, 0); LD_I16(ID_, 1, 1);
    LD_R8(QA, IA, 0); LD_R8(QB, IB, 0); LD_X(XA, 0); LD_R8(QC, IC, 1); LD_R8(QD, ID_, 1); LD_X(XB, 1);
    if (N > 2) { LD_I16(IA, 2, 0); LD_I16(IB, 2, 1); LD_I16(IC, 3, 0); LD_I16(ID_, 3, 1); }
    for (int n = 0; n < N; n += 2) {
        int p[16];
        DOT8(p, 0, QA, XA); if (n + 2 < N) { LD_R8(QA, IA, n + 2); if (n + 4 < N) LD_I16(IA, n + 4, 0); }
        DOT8(p, 8, QB, XA); if (n + 2 < N) { LD_R8(QB, IB, n + 2); LD_X(XA, n + 2); if (n + 4 < N) LD_I16(IB, n + 4, 1); }
        FINISH_U(p, n);
        int r[16];
        DOT8(r, 0, QC, XB); if (n + 3 < N) { LD_R8(QC, IC, n + 3); if (n + 5 < N) LD_I16(IC, n + 5, 0); }
        DOT8(r, 8, QD, XB); if (n + 3 < N) { LD_R8(QD, ID_, n + 3); LD_X(XB, n + 3); if (n + 5 < N) LD_I16(ID_, n + 5, 1); }
        FINISH_U(r, n + 1);
    }
#undef LD_I16
#undef LD_R8
#undef LD_X
#undef DOT8
#undef FINISH_U
}
__device__ __forceinline__ void phase_peer_w(const Args& a) {
    const int gt = blockIdx.x * NTHREADS + tid_opaque(), NGT = gridDim.x * NTHREADS;
    const int* idx_i = (const int*)(a.ws + WS_IDX); const float* gw_i = (const float*)(a.ws + WS_GW); const bf16_t* part = (const bf16_t*)(a.ws + WS_PART);
    const float* suv = (const float*)(a.ws + WS_SUV); const float* sx = (const float*)(a.ws + WS_SX);
    signed char* wq = (signed char*)(a.ws + WS_WQ); float* sw = (float*)(a.ws + WS_SW);
    for (int item = gt; item < T * NE; item += NGT) {
        const int t = item >> 7, e = item & 127;
        float sum = 0.f;
#pragma unroll
        for (int s = 0; s < 16; ++s) sum += __uint_as_float((unsigned)part[((size_t)t * 16 + s) * NE + e] << 16);
        const int ex = idx_i[item];
        const float d = sum * suv[ex] * sx[t];
        const float om = 0.5f * d * (1.f + erff(d * 0.70710678118654752f)) * gw_i[item] * suv[NEXP + ex];
        float mx = fabsf(om);
        mx = fmaxf(mx, sx_f(mx, 1)); mx = fmaxf(mx, sx_f(mx, 2)); mx = fmaxf(mx, sx_f(mx, 4)); mx = fmaxf(mx, sx_f(mx, 8));
        const float qs = mx > 0.f ? 127.f / mx : 1.f;
        wq[item] = (signed char)(int)__builtin_rintf(om * qs);
        if ((e & 15) == 0) sw[t * 8 + (e >> 4)] = mx * (1.f / 127.f);
    }
}
__device__ __forceinline__ void phase_peer_v(const Args& a, float* dst) {
    const int tid = tid_opaque(), lane = tid & 63, wave = tid >> 6, g = lane >> 3, c = lane & 7;
    const int xl = blockIdx.x & 7, wv = (blockIdx.x >> 3) * NWAVES + wave, NWX = (gridDim.x >> 3) * NWAVES, KT = T / NWX, N = 2 * KT;
    const unsigned char* v8 = a.ws + WS_V8;
    const int* idx_i = (const int*)(a.ws + WS_IDX); const unsigned char* wq = a.ws + WS_WQ; const float* sw = (const float*)(a.ws + WS_SW);
    const bf16_t* hsrc = (const bf16_t*)(a.ws + WS_HB);
#define LD_W(W, SWV, HV, n) do { W = *(const u32x4*)(wq + (size_t)ITEM_T(n) * NE + g * 16); SWV = sw[ITEM_T(n) * 8 + g]; HV = *(const unsigned*)(hsrc + (size_t)ITEM_T(n) * DM + ITEM_S(n) * 128 + 2 * lane); } while (0)
#define QUAD(A_, B_, C_, D_, W_, A0, A1, A2, A3) do { \
        const unsigned ablo_ = __builtin_amdgcn_perm(B_, A_, 0x05010400u), abhi_ = __builtin_amdgcn_perm(B_, A_, 0x07030602u); \
        const unsigned cdlo_ = __builtin_amdgcn_perm(D_, C_, 0x05010400u), cdhi_ = __builtin_amdgcn_perm(D_, C_, 0x07030602u); \
        A0 = __builtin_amdgcn_sdot4((int)__builtin_amdgcn_perm(cdlo_, ablo_, 0x05040100u), (int)(W_), A0, false); \
        A1 = __builtin_amdgcn_sdot4((int)__builtin_amdgcn_perm(cdlo_, ablo_, 0x07060302u), (int)(W_), A1, false); \
        A2 = __builtin_amdgcn_sdot4((int)__builtin_amdgcn_perm(cdhi_, abhi_, 0x05040100u), (int)(W_), A2, false); \
        A3 = __builtin_amdgcn_sdot4((int)__builtin_amdgcn_perm(cdhi_, abhi_, 0x07060302u), (int)(W_), A3, false); } while (0)
#define COMPUTE_V(Q, W, SWV, HV, n) do { int ac[16]; _Pragma("unroll") for (int k = 0; k < 16; ++k) ac[k] = 0; \
        _Pragma("unroll") for (int q_ = 0; q_ < 4; ++q_) { const unsigned w_ = q_ == 0 ? W.x : q_ == 1 ? W.y : q_ == 2 ? W.z : W.w; \
            QUAD(Q[4 * q_].x, Q[4 * q_ + 1].x, Q[4 * q_ + 2].x, Q[4 * q_ + 3].x, w_, ac[0], ac[1], ac[2], ac[3]); \
            QUAD(Q[4 * q_].y, Q[4 * q_ + 1].y, Q[4 * q_ + 2].y, Q[4 * q_ + 3].y, w_, ac[4], ac[5], ac[6], ac[7]); \
            QUAD(Q[4 * q_].z, Q[4 * q_ + 1].z, Q[4 * q_ + 2].z, Q[4 * q_ + 3].z, w_, ac[8], ac[9], ac[10], ac[11]); \
            QUAD(Q[4 * q_].w, Q[4 * q_ + 1].w, Q[4 * q_ + 2].w, Q[4 * q_ + 3].w, w_, ac[12], ac[13], ac[14], ac[15]); } \
        float p[16]; _Pragma("unroll") for (int k = 0; k < 16; ++k) p[k] = (float)ac[k] * SWV; \
        float p8[8], p4[4], p2[2]; \
        _Pragma("unroll") for (int i_ = 0; i_ < 8; ++i_) { auto rr_ = __builtin_amdgcn_permlane32_swap(__float_as_uint(p[i_]), __float_as_uint(p[8 + i_]), false, false); p8[i_] = __uint_as_float(rr_[0]) + __uint_as_float(rr_[1]); } \
        _Pragma("unroll") for (int i_ = 0; i_ < 4; ++i_) { auto rr_ = __builtin_amdgcn_permlane16_swap(__float_as_uint(p8[i_]), __float_as_uint(p8[4 + i_]), false, false); p4[i_] = __uint_as_float(rr_[0]) + __uint_as_float(rr_[1]); } \
        HALVE(p2, p4, 2, 8); \
        const int srcl_ = ((lane & 7) << 3) | (lane >> 3);                     \
        const float q0_ = sh_f(p2[0], srcl_), q1_ = sh_f(p2[1], srcl_); \
        const size_t o_ = (size_t)ITEM_T(n) * DM + ITEM_S(n) * 128 + 2 * lane; \
        *(f32x2*)(dst + o_) = (f32x2){bf_lo(HV) + q0_, bf_hi(HV) + q1_}; } while (0)
    int4 IA[4], IB[4]; u32x4 QA[16], QB[16], WA, WB; float SA, SB_; unsigned HA, HB_;
    LD_IDX(IA, 0); LD_IDX(IB, 1);
    LD_ROWS(QA, IA, v8, 0); LD_W(WA, SA, HA, 0);
    for (int n = 0; n < N; n += 2) {
        LD_ROWS(QB, IB, v8, n + 1); LD_W(WB, SB_, HB_, n + 1);
        if (n + 2 < N) LD_IDX(IA, n + 2);
        COMPUTE_V(QA, WA, SA, HA, n);
        if (n + 2 < N) { LD_ROWS(QA, IA, v8, n + 2); LD_W(WA, SA, HA, n + 2); }
        if (n + 3 < N) LD_IDX(IB, n + 3);
        COMPUTE_V(QB, WB, SB_, HB_, n + 1);
    }
#undef LD_W
#undef QUAD
#undef COMPUTE_V
}
#undef ITEM_T
#undef ITEM_S
#undef LD_IDX
#undef LD_ROWS
#undef HALVE


constexpr int NPHASE = 11;
#define LOAD_ARGS() do { } while (0)
__global__ void __launch_bounds__(NTHREADS, 2) fwd_kernel(Args a) {
    extern __shared__ __attribute__((aligned(16))) unsigned char lds[];
#if MK_ONE_LAUNCH
    constexpr int lo = 0, hi = NPHASE;
    cg::grid_group grid = cg::this_grid();
    volatile LAS unsigned* misc = (volatile LAS unsigned*)((LAS unsigned char*)lds + MISC_OFF);
    if (threadIdx.x < 16) misc[threadIdx.x] = 0u;
    __syncthreads();
    { LOAD_ARGS(); (void)xcd_barrier_post((unsigned*)(a.ws + WS_CTL) + CW_BAR, misc + 8); }
#ifndef SEAM_CG_MASK
#define SEAM_CG_MASK 0
#endif
#define SEAM(k) do { if (lo <= (k) && (k) + 1 < hi) { if ((SEAM_CG_MASK >> (k)) & 1) grid.sync(); else { LOAD_ARGS(); XcdBarrier xb_; xb_.bar = (unsigned*)(a.ws + WS_CTL) + CW_BAR; xb_.x = xb_xcc_id(); \
        xb_.st = (volatile LAS unsigned*)((LAS unsigned char*)lds + MISC_OFF) + 8; xcd_barrier(xb_); } } } while (0)
#else
    int lo, hi; { LOAD_ARGS(); lo = a.ph_lo; hi = a.ph_hi; }
#define SEAM(k) do { } while (0)
#endif
#define IN(k) (lo <= (k) && (k) < hi)
#ifndef DUP_PHASE
#define DUP_PHASE -1
#endif
    if (IN(0)) { LOAD_ARGS(); phase0(a, lds); if (DUP_PHASE == 0) { __syncthreads(); phase0(a, lds); } SEAM(0); }
    if (IN(1)) { LOAD_ARGS(); unsigned char* ws = a.ws;
        cumsum_rows(a);
        pg8::Gemm g{(const bf16_t*)(ws + WS_XN), (const bf16_t*)(ws + WS_WIN), T, NPROJ, DM}; pg8::StaticOrder S; S.init(T, NPROJ, (int)gridDim.x, (int)blockIdx.x);
        pg8::EpiInProj E{(bf16_t*)(ws + WS_SEC), (const float*)(ws + WS_SXN), (const float*)(ws + WS_WSC), a.in[4], a.in[5], (LAS float*)((LAS unsigned char*)lds + RING_BYTES)};
        for (int rep_ = 0; rep_ < (DUP_PHASE == 1 ? 2 : 1); ++rep_)
        pg8::gemm_phase<pg8::EpiInProj, pg8::StaticOrder, true, true, true>((LAS unsigned char*)lds, g, S, E);
        { const int nwg_ = (T / 256) * (NPROJ / 256), G_ = (int)gridDim.x, rem_ = nwg_ % G_;
          if (rem_ > 0 && (int)blockIdx.x >= rem_) convert_tables(a, TAB_SPLIT, 2 * NEXP, ((int)blockIdx.x - rem_) * NWAVES + (tid_opaque() >> 6), (G_ - rem_) * NWAVES);
          else if (rem_ == 0) convert_tables(a, TAB_SPLIT, 2 * NEXP, (int)blockIdx.x * NWAVES + (tid_opaque() >> 6), G_ * NWAVES); }
        SEAM(1);
    }
    if (IN(3)) { LOAD_ARGS(); phase_attn(a, lds);
#if MK_ONE_LAUNCH
        if (DUP_PHASE == 3) { XcdBarrier xb_; xb_.bar = (unsigned*)(a.ws + WS_CTL) + CW_BAR; xb_.x = xb_xcc_id(); xb_.st = (volatile LAS unsigned*)((LAS unsigned char*)lds + MISC_OFF) + 8;
            xcd_barrier(xb_); if (blockIdx.x == 0 && threadIdx.x == 0) __hip_atomic_store((unsigned*)(a.ws + WS_CTL), 0u, __ATOMIC_RELAXED, __HIP_MEMORY_SCOPE_AGENT); xcd_barrier(xb_); phase_attn(a, lds); }
#endif
        SEAM(3); }
    if (IN(4)) { LOAD_ARGS(); phase_attn_combine(a); SEAM(4); }
    if (IN(5)) { LOAD_ARGS(); unsigned char* ws = a.ws;
        pg8::Gemm g{(const bf16_t*)(ws + WS_MIX), (const bf16_t*)(ws + WS_WOUT), T, DM, DM}; pg8::StaticOrder S; S.init(T, DM, (int)gridDim.x, (int)blockIdx.x);
        pg8::EpiOutProj E{a.in[0], a.out, (bf16_t*)(ws + WS_HB), (float*)(ws + WS_SSQ), (float*)(ws + WS_AMX)};
        for (int rep_ = 0; rep_ < (DUP_PHASE == 5 ? 2 : 1); ++rep_)
        pg8::gemm_phase<pg8::EpiOutProj, pg8::StaticOrder, true, true>((LAS unsigned char*)lds, g, S, E);
        SEAM(5);
    }
    if (IN(6)) { LOAD_ARGS(); unsigned char* ws = a.ws;
        pg8::Gemm g{(const bf16_t*)(ws + WS_HB), (const bf16_t*)(ws + WS_WPQ), T, DM, DM}; pg8::StaticOrder S; S.init(T, DM, (int)gridDim.x, (int)blockIdx.x);
        pg8::EpiPeerQFused E{(const float*)(ws + WS_SSQ), ws};
        pg8::gemm_phase<pg8::EpiPeerQFused, pg8::StaticOrder, true, true>((LAS unsigned char*)lds, g, S, E);
        SEAM(6);
    }
    if (IN(8)) { LOAD_ARGS(); for (int rep_ = 0; rep_ < (DUP_PHASE == 8 ? 2 : 1); ++rep_) phase_peer_u(a); SEAM(8); }
    if (IN(9)) { LOAD_ARGS(); for (int rep_ = 0; rep_ < (DUP_PHASE == 9 ? 2 : 1); ++rep_) phase_peer_w(a); SEAM(9); }
    if (IN(10)) { LOAD_ARGS(); for (int rep_ = 0; rep_ < (DUP_PHASE == 10 ? 2 : 1); ++rep_) phase_peer_v(a, (DUP_PHASE == 10 && rep_ == 0) ? (float*)(a.ws + WS_END) : a.out); }
#undef IN
#undef SEAM
}

extern "C" void kernel_launch(void* const* d_in, const int* in_sizes, int n_in, void* d_out, int out_size, void* d_ws, size_t ws_size, hipStream_t stream) {
    static int grid = 0;
    if (grid == 0) {
        if (n_in != 12 || in_sizes[0] != T * DM || out_size != T * DM || ws_size < WS_END) { fprintf(stderr, "kernel_launch: unexpected shapes (n_in %d, in0 %d, out %d, ws %zu)\n", n_in, n_in > 0 ? in_sizes[0] : -1, out_size, ws_size); grid = -1; return; }
        int dev = 0, cus = 0, per_cu = 0;
        if (hipGetDevice(&dev) != hipSuccess || hipDeviceGetAttribute(&cus, hipDeviceAttributeMultiprocessorCount, dev) != hipSuccess) { grid = -1; return; }
        if (hipFuncSetAttribute((const void*)fwd_kernel, hipFuncAttributeMaxDynamicSharedMemorySize, LDS_BYTES) != hipSuccess) { fprintf(stderr, "kernel_launch: hipFuncSetAttribute failed\n"); grid = -1; return; }
        if (hipOccupancyMaxActiveBlocksPerMultiprocessor(&per_cu, (const void*)fwd_kernel, NTHREADS, LDS_BYTES) != hipSuccess || per_cu < 1) { fprintf(stderr, "kernel_launch: occupancy query says %d\n", per_cu); grid = -1; return; }
        grid = cus;
    }
    if (grid < 0) return;
    (void)hipMemsetAsync((char*)d_ws + WS_CTL, 0, CTL_BYTES, stream);
    Args a{};
    for (int i = 0; i < 12; ++i) a.in[i] = (const float*)d_in[i];
    a.out = (float*)d_out; a.ws = (unsigned char*)d_ws;
#if MK_ONE_LAUNCH
    a.ph_lo = 0; a.ph_hi = NPHASE;
    void* args[] = {&a};
#if MK_COOP_LAUNCH
    hipError_t e = hipLaunchCooperativeKernel((const void*)fwd_kernel, dim3(grid), dim3(NTHREADS), args, LDS_BYTES, stream);
    if (e != hipSuccess) fprintf(stderr, "cooperative launch failed: %s (grid %d)\n", hipGetErrorString(e), grid);
#else
    (void)args; hipLaunchKernelGGL(fwd_kernel, dim3(grid), dim3(NTHREADS), LDS_BYTES, stream, a);
#endif
#else
    for (int p = 0; p < NPHASE; ++p) { a.ph_lo = p; a.ph_hi = p + 1; hipLaunchKernelGGL(fwd_kernel, dim3(grid), dim3(NTHREADS), LDS_BYTES, stream, a); }
#endif
}
```

```cpp
#include <hip/hip_runtime.h>
#include <hip/hip_cooperative_groups.h>
#include <cstdio>
#include <cstdint>
namespace cg = cooperative_groups;

#ifndef MK_COOP_LAUNCH
#define MK_COOP_LAUNCH 0
#endif
#ifndef MK_ONE_LAUNCH
#define MK_ONE_LAUNCH 1
#endif

#define LAS __attribute__((address_space(3)))
typedef unsigned short bf16_t;
typedef short bf16x8 __attribute__((ext_vector_type(8)));
typedef short s16x4 __attribute__((ext_vector_type(4)));
typedef float f32x2 __attribute__((ext_vector_type(2)));
typedef float f32x4 __attribute__((ext_vector_type(4)));
typedef float f32x16 __attribute__((ext_vector_type(16)));
typedef unsigned u32x2 __attribute__((ext_vector_type(2)));
typedef unsigned u32x4 __attribute__((ext_vector_type(4)));
typedef __bf16 bf16x2_t __attribute__((ext_vector_type(2)));

constexpr int NB = 2, SEQ = 4096, T = NB * SEQ, DM = 2048, HD = 128, NHF = 8, DIN = 7176, NPROJ = 7168;
constexpr int NEXP = 16384, NE = 128;
constexpr float EPS = 1e-6f;
constexpr float SCALE = 0.08838834764831845f, LOG2E = 1.4426950408889634f;
constexpr int NWAVES = 8, NTHREADS = 512;

constexpr size_t MiB = 1u << 20;
constexpr size_t WS_CTL = 0, CTL_BYTES = 32768;
constexpr int CW_BAR = 1024;
constexpr size_t WS_SXN = 64 * MiB  , WS_WSC = 45 * MiB + 800 * 1024  ;
constexpr int CW_WMAX = 64;
constexpr size_t WS_GQK = 45 * MiB + 768 * 1024;
constexpr size_t WS_WIN = 1 * MiB, WS_WOUT = 29 * MiB, WS_WPQ = 37 * MiB, WS_SK = 45 * MiB, WS_LOGF = 46 * MiB, WS_C = 46 * MiB + 512 * 1024, WS_SSQ = 47 * MiB;
constexpr size_t WS_XN = 48 * MiB;
constexpr size_t WS_SEC = 80 * MiB;
constexpr size_t SEC_ELEMS = 8u << 20;
constexpr size_t WS_MIX = 192 * MiB, WS_HB = 224 * MiB, WS_QP = 256 * MiB, WS_IDX = 288 * MiB, WS_GW = 292 * MiB, WS_U8 = 296 * MiB, WS_V8 = 328 * MiB, WS_SUV = 360 * MiB  , WS_RT = 360 * MiB + 256 * 1024  , WS_W = 361 * MiB  ,
                 WS_PART = 368 * MiB  , WS_XQ = 432 * MiB  , WS_END = 448 * MiB;
constexpr size_t WS_IDX16 = 366 * MiB  ;
constexpr size_t WS_AMX = 365 * MiB  , WS_SX = WS_RT + 64 * 1024  , WS_WQ = WS_W  , WS_SW = WS_W + 2 * MiB  ;
constexpr size_t WS_PO = WS_PART  , WS_PML = WS_PART + 32 * MiB  ;

constexpr int RING_BYTES = 131072;
constexpr int MISC_OFF = 143360;
constexpr int LDS_BYTES = 147456;

__device__ __forceinline__ unsigned cvt_pk_bf16(float lo, float hi) { unsigned r; asm volatile("v_cvt_pk_bf16_f32 %0, %1, %2" : "=v"(r) : "v"(lo), "v"(hi)); return r; }
__device__ __forceinline__ float bf_lo(unsigned u) { return __builtin_bit_cast(float, u << 16); }
__device__ __forceinline__ float bf_hi(unsigned u) { return __builtin_bit_cast(float, u & 0xffff0000u); }
__device__ __forceinline__ int lane_id_fresh() { int l = (int)__builtin_amdgcn_mbcnt_hi(~0u, __builtin_amdgcn_mbcnt_lo(~0u, 0u)); asm volatile("" : "+v"(l)); return l; }
__device__ __forceinline__ int sx_i(int v, int m) { return __builtin_amdgcn_ds_bpermute((lane_id_fresh() ^ m) << 2, v); }
__device__ __forceinline__ float sx_f(float v, int m) { return __int_as_float(__builtin_amdgcn_ds_bpermute((lane_id_fresh() ^ m) << 2, __float_as_int(v))); }
__device__ __forceinline__ int sh_i(int v, int src) { return __builtin_amdgcn_ds_bpermute(src << 2, v); }
__device__ __forceinline__ float sh_f(float v, int src) { return __int_as_float(__builtin_amdgcn_ds_bpermute(src << 2, __float_as_int(v))); }
__device__ __forceinline__ float shup_f(float v, int d) { const int l = lane_id_fresh(); const int s = l - d; return __int_as_float(__builtin_amdgcn_ds_bpermute((s < 0 ? l : s) << 2, __float_as_int(v))); }
__device__ __forceinline__ float wave_sum(float v) {
    v += __int_as_float(__builtin_amdgcn_update_dpp(0, __float_as_int(v), 0xB1, 0xf, 0xf, true));
    v += __int_as_float(__builtin_amdgcn_update_dpp(0, __float_as_int(v), 0x4E, 0xf, 0xf, true));
    v += __int_as_float(__builtin_amdgcn_update_dpp(0, __float_as_int(v), 0x141, 0xf, 0xf, true));
    v += __int_as_float(__builtin_amdgcn_update_dpp(0, __float_as_int(v), 0x140, 0xf, 0xf, true));
    { auto rr = __builtin_amdgcn_permlane16_swap(__float_as_uint(v), __float_as_uint(v), false, false); v = __uint_as_float(rr[0]) + __uint_as_float(rr[1]); }
    { auto rr = __builtin_amdgcn_permlane32_swap(__float_as_uint(v), __float_as_uint(v), false, false); v = __uint_as_float(rr[0]) + __uint_as_float(rr[1]); }
    return v;
}
#define DPP_QX1 0xB1
#define DPP_QX2 0x4E
#define DPP_HMIR 0x141
#define DPP_MIR 0x140
__device__ __forceinline__ float wave_max(float v) {
    v = fmaxf(v, __int_as_float(__builtin_amdgcn_update_dpp(0, __float_as_int(v), DPP_QX1, 0xf, 0xf, true)));
    v = fmaxf(v, __int_as_float(__builtin_amdgcn_update_dpp(0, __float_as_int(v), DPP_QX2, 0xf, 0xf, true)));
    v = fmaxf(v, __int_as_float(__builtin_amdgcn_update_dpp(0, __float_as_int(v), DPP_HMIR, 0xf, 0xf, true)));
    v = fmaxf(v, __int_as_float(__builtin_amdgcn_update_dpp(0, __float_as_int(v), DPP_MIR, 0xf, 0xf, true)));
    { auto rr = __builtin_amdgcn_permlane16_swap(__float_as_uint(v), __float_as_uint(v), false, false); v = fmaxf(__uint_as_float(rr[0]), __uint_as_float(rr[1])); }
    { auto rr = __builtin_amdgcn_permlane32_swap(__float_as_uint(v), __float_as_uint(v), false, false); v = fmaxf(__uint_as_float(rr[0]), __uint_as_float(rr[1])); }
    return v;
}
__device__ __forceinline__ int tid_opaque() { int t = (int)threadIdx.x; asm volatile("" : "+v"(t)); return t; }
#define LDS_WAIT() asm volatile("s_waitcnt lgkmcnt(0)" ::: "memory")

namespace pg8 {
#define PG8_LAS __attribute__((address_space(3)))
constexpr int BM = 256, BK = 64, HALF = 128, HTB = HALF * BK * 2, STAGE_BYTES = 8 * HTB, NXCD = 8, WGM = 8;
__host__ __device__ __forceinline__ int lds_byte(int r, int c) { const int st = (r >> 4) * 2 + (c >> 5), rr = r & 15, cc = c & 31, ob = rr * 64 + cc * 2; return st * 1024 + (ob ^ (((ob >> 9) & 1) << 5)); }
__host__ __device__ __forceinline__ void stage_rc(int b, int& R, int& C) { const int st = b / 1024, sb = b % 1024, swz = sb ^ (((sb >> 9) & 1) << 5); R = (st >> 1) * 16 + swz / 64; C = (st & 1) * 32 + (swz % 64) / 2; }
__host__ __device__ __forceinline__ int perm32(int rho) { const int n = rho >> 4, i = rho & 15; return 8 * (i >> 2) + 4 * n + (i & 3); }
struct Unit { int pm, pn; };
struct Gemm { const bf16_t* A; const bf16_t* Bt; int M, N, K; };
struct StaticOrder {
    int nM, nN, nwg, G, c;
    __host__ __device__ void init(int M, int N, int G_, int c_) { nM = M / BM; nN = N / BM; nwg = nM * nN; G = G_; c = c_; }
    __host__ __device__ bool next(int i, Unit& u) const {
        const long L = (long)i * G + c; if (L >= nwg) return false;
        int wgid = (int)L; { const int q = nwg / NXCD, r = nwg % NXCD, xcd = wgid % NXCD, off = wgid / NXCD; wgid = (xcd < r ? xcd * (q + 1) : r * (q + 1) + (xcd - r) * q) + off; }
        const int nig = WGM * nN, gid = wgid / nig, fm = gid * WGM, gsz = (nM - fm) < WGM ? (nM - fm) : WGM;
        u.pm = fm + ((wgid % nig) % gsz); u.pn = (wgid % nig) / gsz; return true;
    }
    __device__ __forceinline__ void a_ready(const Unit&) const {}
    __device__ __forceinline__ void done(const Unit&) const {}
};

typedef int i32x4 __attribute__((ext_vector_type(4)));
template <bool I8> struct AccT { typedef f32x4 type; };
template <> struct AccT<true> { typedef i32x4 type; };
template <class Epi, class Sched, bool ALIGN_EPI = false, bool SP2 = false, bool I8 = false>
__device__ __forceinline__ void gemm_phase(PG8_LAS unsigned char* lds, const Gemm g, const Sched& S, const Epi& E) {
    typedef typename AccT<I8>::type acc_t;
    const int tid = tid_opaque(), wid = __builtin_amdgcn_readfirstlane(tid >> 6), lane = tid & 63, wr = wid >> 2, wc = wid & 3, fr = lane & 15, fq = lane >> 4;
    const int rowb = I8 ? g.K : 2 * g.K, nt = rowb / (BK * 2);
    unsigned voffA[2], voffB[2];
#pragma unroll
    for (int i = 0; i < 2; ++i) { int R, C; stage_rc(tid * 16 + i * 8192, R, C); const int Rb = Epi::PERM ? ((R & ~31) + perm32(R & 31)) : R;
        voffA[i] = (unsigned)(R * rowb + C * 2); voffB[i] = (unsigned)(Rb * rowb + C * 2); }
    const size_t kstep = (size_t)(BK * 2);
    const size_t hstep = (size_t)HALF * rowb;
    const size_t tstep = 2 * hstep;
    const unsigned ldsw = (unsigned)wid * 1024u;
    const int aoff = lds_byte(wr * 64 + fr, fq * 8), boff = lds_byte(wc * 32 + fr, fq * 8);
#define PG8_SA(b, h) (((b) * 2 + (h)) * HTB)
#define PG8_SB(b, h) ((4 + (b) * 2 + (h)) * HTB)
#define PG8_STAGE(bufoff, gbase, voff) do { _Pragma("unroll") for (int _i = 0; _i < 2; ++_i) \
        __builtin_amdgcn_global_load_lds((const unsigned*)((const char*)(gbase) + (voff)[_i]), (PG8_LAS unsigned*)(lds + (bufoff) + ldsw + _i * 8192), 16, 0, 0); } while (0)
#define PG8_LDA(dst, b, h) do { _Pragma("unroll") for (int m = 0; m < 4; ++m) _Pragma("unroll") for (int k = 0; k < 2; ++k) dst[m][k] = *(const PG8_LAS bf16x8*)(lds + PG8_SA(b, h) + aoff + m * 2048 + k * 1024); } while (0)
#define PG8_LDB(dst, b, h) do { _Pragma("unroll") for (int n = 0; n < 2; ++n) _Pragma("unroll") for (int k = 0; k < 2; ++k) dst[n][k] = *(const PG8_LAS bf16x8*)(lds + PG8_SB(b, h) + boff + n * 2048 + k * 1024); } while (0)
#define PG8_MMA(ai, bj, At, Bt) do { __builtin_amdgcn_s_setprio(1); _Pragma("unroll") for (int m = 0; m < 4; ++m) _Pragma("unroll") for (int n = 0; n < 2; ++n) _Pragma("unroll") for (int k = 0; k < 2; ++k) \
        { if constexpr (I8) acc[ai][bj][m][n] = __builtin_amdgcn_mfma_i32_16x16x64_i8(__builtin_bit_cast(i32x4, Bt[n][k]), __builtin_bit_cast(i32x4, At[m][k]), acc[ai][bj][m][n], 0, 0, 0); \
          else acc[ai][bj][m][n] = __builtin_amdgcn_mfma_f32_16x16x32_bf16(Bt[n][k], At[m][k], acc[ai][bj][m][n], 0, 0, 0); } __builtin_amdgcn_s_setprio(0); } while (0)
#define PG8_WAIT_V(n) asm volatile("s_waitcnt vmcnt(" #n ")" ::: "memory")
#define PG8_WAIT_L(n) asm volatile("s_waitcnt lgkmcnt(" #n ")" ::: "memory")
#define PG8_BAR __builtin_amdgcn_s_barrier()
#define PG8_SCHED __builtin_amdgcn_sched_barrier(0)
    Unit cur, nxt; int ui = 0;
    if (!S.next(0, cur)) return;
    acc_t acc[2][2][4][2];
#pragma unroll
    for (int a = 0; a < 2; ++a)
#pragma unroll
        for (int b = 0; b < 2; ++b)
#pragma unroll
            for (int m = 0; m < 4; ++m)
#pragma unroll
                for (int n = 0; n < 2; ++n) acc[a][b][m][n] = acc_t{};
    bf16x8 At[4][2], B0[2][2], B1[2][2];
    const char* cA = (const char*)g.A + (size_t)cur.pm * tstep; const char* cB = (const char*)g.Bt + (size_t)cur.pn * tstep;
    S.a_ready(cur);
    if constexpr (SP2) {
        PG8_STAGE(PG8_SB(0, 0), cB, voffB); PG8_STAGE(PG8_SB(0, 1), cB + hstep, voffB); PG8_STAGE(PG8_SA(0, 0), cA, voffA); PG8_STAGE(PG8_SA(0, 1), cA + hstep, voffA);
        if (wr == 1) PG8_BAR;
        PG8_WAIT_V(2); PG8_BAR;
        PG8_STAGE(PG8_SB(1, 0), cB + kstep, voffB); PG8_STAGE(PG8_SA(1, 0), cA + kstep, voffA); PG8_STAGE(PG8_SB(1, 1), cB + hstep + kstep, voffB);
        PG8_WAIT_V(6); PG8_BAR;
    } else {
        PG8_STAGE(PG8_SB(0, 0), cB, voffB); PG8_STAGE(PG8_SA(0, 0), cA, voffA); PG8_STAGE(PG8_SB(0, 1), cB + hstep, voffB); PG8_STAGE(PG8_SA(0, 1), cA + hstep, voffA);
        if (wr == 1) PG8_BAR;
        PG8_WAIT_V(4); PG8_BAR;
        PG8_STAGE(PG8_SB(1, 0), cB + kstep, voffB); PG8_STAGE(PG8_SA(1, 0), cA + kstep, voffA); PG8_STAGE(PG8_SB(1, 1), cB + hstep + kstep, voffB);
        PG8_WAIT_V(6); PG8_BAR;
    }
    for (;;) {
        const bool has_next = S.next(ui + 1, nxt);
        const char* nA = has_next ? (const char*)g.A + (size_t)nxt.pm * tstep : cA; const char* nB = has_next ? (const char*)g.Bt + (size_t)nxt.pn * tstep : cB;
        for (int t = 0; t < nt; t += 2) {
            const bool last = (t == nt - 2);
            const char* a1 = cA + (size_t)(t + 1) * kstep;
            const char* a2 = last ? nA : cA + (size_t)(t + 2) * kstep; const char* b2 = last ? nB : cB + (size_t)(t + 2) * kstep;
            const char* a3 = a2 + kstep; const char* b3 = b2 + kstep;
            if (last && has_next) S.a_ready(nxt);
            if constexpr (SP2) {
            PG8_LDB(B0, 0, 0); PG8_LDB(B1, 0, 1); PG8_SCHED; PG8_LDA(At, 0, 0); PG8_STAGE(PG8_SA(1, 1), a1 + hstep, voffA);
            PG8_WAIT_V(8); PG8_WAIT_L(0); PG8_BAR; PG8_MMA(0, 0, At, B0); PG8_MMA(0, 1, At, B1); PG8_BAR; PG8_SCHED;
            PG8_LDA(At, 0, 1); PG8_STAGE(PG8_SB(0, 0), b2, voffB); PG8_STAGE(PG8_SB(0, 1), b2 + hstep, voffB); PG8_STAGE(PG8_SA(0, 0), a2, voffA);
            PG8_WAIT_V(8); PG8_WAIT_L(0); PG8_BAR; PG8_MMA(1, 0, At, B0); PG8_MMA(1, 1, At, B1); PG8_BAR; PG8_SCHED;
            PG8_LDB(B0, 1, 0); PG8_LDB(B1, 1, 1); PG8_SCHED; PG8_LDA(At, 1, 0); PG8_STAGE(PG8_SA(0, 1), a2 + hstep, voffA);
            PG8_WAIT_V(8); PG8_WAIT_L(0); PG8_BAR; PG8_MMA(0, 0, At, B0); PG8_MMA(0, 1, At, B1); PG8_BAR; PG8_SCHED;
            PG8_LDA(At, 1, 1); PG8_STAGE(PG8_SB(1, 0), b3, voffB); PG8_STAGE(PG8_SB(1, 1), b3 + hstep, voffB); PG8_STAGE(PG8_SA(1, 0), a3, voffA);
            PG8_WAIT_V(8); PG8_WAIT_L(0); PG8_BAR; PG8_MMA(1, 0, At, B0); PG8_MMA(1, 1, At, B1); PG8_BAR; PG8_SCHED;
            } else {
            PG8_LDB(B0, 0, 0); PG8_SCHED; PG8_LDA(At, 0, 0); PG8_STAGE(PG8_SA(1, 1), a1 + hstep, voffA);
            PG8_WAIT_L(8); PG8_BAR; PG8_WAIT_L(0); PG8_MMA(0, 0, At, B0); PG8_BAR; PG8_SCHED;
            PG8_LDB(B1, 0, 1); PG8_STAGE(PG8_SB(0, 0), b2, voffB);
            PG8_BAR; PG8_WAIT_L(0); PG8_MMA(0, 1, At, B1); PG8_BAR;
            PG8_LDA(At, 0, 1); PG8_STAGE(PG8_SA(0, 0), a2, voffA);
            PG8_BAR; PG8_WAIT_L(0); PG8_MMA(1, 0, At, B0); PG8_BAR; PG8_SCHED;
            PG8_STAGE(PG8_SB(0, 1), b2 + hstep, voffB);
            PG8_WAIT_V(6); PG8_BAR; PG8_MMA(1, 1, At, B1); PG8_BAR;
            PG8_LDB(B0, 1, 0); PG8_SCHED; PG8_LDA(At, 1, 0); PG8_STAGE(PG8_SA(0, 1), a2 + hstep, voffA);
            PG8_WAIT_L(8); PG8_BAR; PG8_WAIT_L(0); PG8_MMA(0, 0, At, B0); PG8_BAR; PG8_SCHED;
            PG8_LDB(B1, 1, 1); PG8_STAGE(PG8_SB(1, 0), b3, voffB);
            PG8_BAR; PG8_WAIT_L(0); PG8_MMA(0, 1, At, B1); PG8_BAR;
            PG8_LDA(At, 1, 1); PG8_STAGE(PG8_SA(1, 0), a3, voffA);
            PG8_BAR; PG8_WAIT_L(0); PG8_MMA(1, 0, At, B0); PG8_BAR; PG8_SCHED;
            PG8_STAGE(PG8_SB(1, 1), b3 + hstep, voffB);
            PG8_WAIT_V(6); PG8_BAR; PG8_MMA(1, 1, At, B1); PG8_BAR;
            }
        }
        if constexpr (ALIGN_EPI) { if (wr == 0) PG8_BAR; }
        if constexpr (!Epi::AFTER_DRAIN) { E(acc, cur, wr, wc, fr, fq); } S.done(cur);
        if (!has_next) break;
#pragma unroll
        for (int a = 0; a < 2; ++a)
#pragma unroll
            for (int b = 0; b < 2; ++b)
#pragma unroll
                for (int m = 0; m < 4; ++m)
#pragma unroll
                    for (int n = 0; n < 2; ++n) acc[a][b][m][n] = acc_t{};
        cur = nxt; cA = nA; cB = nB; ++ui;
        if constexpr (ALIGN_EPI) { if (wr == 1) PG8_BAR; }
    }
    PG8_WAIT_V(0);
    if constexpr (!ALIGN_EPI) { if (wr == 0) PG8_BAR; }
    PG8_BAR;
    if constexpr (Epi::AFTER_DRAIN) E.fused(acc, cur, wr, wc, fr, fq, lds);
#undef PG8_SA
#undef PG8_SB
#undef PG8_STAGE
#undef PG8_LDA
#undef PG8_LDB
#undef PG8_MMA
#undef PG8_WAIT_V
#undef PG8_WAIT_L
#undef PG8_BAR
#undef PG8_SCHED
}

__device__ __forceinline__ float sigmoidf_fast(float x) { return __builtin_amdgcn_rcpf(1.f + __builtin_amdgcn_exp2f(-x * LOG2E)); }
struct EpiInProj {
    static constexpr bool PERM = true, AFTER_DRAIN = false;
    bf16_t* base; const float* sxn  ; const float* wsc  ;
    const float* gq; const float* gk; PG8_LAS float* xch  ;
    __device__ __forceinline__ void operator()(const i32x4 (&acci)[2][2][4][2], const Unit& u, int wr, int wc, int fr, int fq) const {
        const int sec = u.pn >> 2; const float wsv = *wsc;
        bf16_t* sb = base + (size_t)sec * SEC_ELEMS;
        const float sc = (sec == 4) ? SCALE * LOG2E : 1.f;
        if (sec < 2) {
#pragma unroll
            for (int ai = 0; ai < 2; ++ai)
#pragma unroll
                for (int m = 0; m < 4; ++m) {
                    const int tk = u.pm * BM + ai * HALF + wr * 64 + m * 16 + fr;
                    const float rs = sxn[tk] * wsv;
#pragma unroll
                    for (int bj = 0; bj < 2; ++bj) {
                        const f32x4 v0 = __builtin_convertvector(acci[ai][bj][m][0], f32x4) * rs, v1 = __builtin_convertvector(acci[ai][bj][m][1], f32x4) * rs;
                        float ss = v0[0] * v0[0] + v0[1] * v0[1] + v0[2] * v0[2] + v0[3] * v0[3] + v1[0] * v1[0] + v1[1] * v1[1] + v1[2] * v1[2] + v1[3] * v1[3];
                        ss += sx_f(ss, 16); ss += sx_f(ss, 32);
                        if (fq == 0) xch[(((((wr * 2 + ai) * 4 + m) * 16 + fr) * 2 + bj) * 4) + wc] = ss;
                    }
                }
            asm volatile("s_waitcnt lgkmcnt(0)" ::: "memory");
            __builtin_amdgcn_s_barrier();
            const float* gp = (sec == 0 ? gq : gk) + wc * 32 + 8 * fq;
            const f32x4 g0 = *(const f32x4*)gp, g1 = *(const f32x4*)(gp + 4);
#pragma unroll
            for (int ai = 0; ai < 2; ++ai)
#pragma unroll
                for (int m = 0; m < 4; ++m) {
                    const int tk = u.pm * BM + ai * HALF + wr * 64 + m * 16 + fr, b = tk >> 12, s = tk & 4095;
                    const float rs = sxn[tk] * wsv;
#pragma unroll
                    for (int bj = 0; bj < 2; ++bj) {
                        const int hh = (u.pn & 3) * 2 + bj;
                        const f32x4 p4 = *(const PG8_LAS f32x4*)(xch + (((((wr * 2 + ai) * 4 + m) * 16 + fr) * 2 + bj) * 4));
                        const float r = rs / sqrtf(((p4[0] + p4[1]) + (p4[2] + p4[3])) * (1.f / 128.f) + EPS);
                        const f32x4 v0 = __builtin_convertvector(acci[ai][bj][m][0], f32x4) * r * g0, v1 = __builtin_convertvector(acci[ai][bj][m][1], f32x4) * r * g1;
                        u32x4 w; w.x = cvt_pk_bf16(v0[0], v0[1]); w.y = cvt_pk_bf16(v0[2], v0[3]); w.z = cvt_pk_bf16(v1[0], v1[1]); w.w = cvt_pk_bf16(v1[2], v1[3]);
                        *(u32x4*)(sb + ((size_t)((b * 8 + hh) * 4096 + s)) * 128 + wc * 32 + 8 * fq) = w;
                    }
                }
            return;
        }
#pragma unroll
        for (int ai = 0; ai < 2; ++ai)
#pragma unroll
            for (int m = 0; m < 4; ++m) {
                const int tk = u.pm * BM + ai * HALF + wr * 64 + m * 16 + fr, b = tk >> 12, s = tk & 4095;
                const float rs = sxn[tk] * wsv;
#pragma unroll
                for (int bj = 0; bj < 2; ++bj) {
                    const int hh = (u.pn & 3) * 2 + bj;
                    f32x4 v0 = __builtin_convertvector(acci[ai][bj][m][0], f32x4) * rs, v1 = __builtin_convertvector(acci[ai][bj][m][1], f32x4) * rs;
                    bf16_t* dst;
                    if (sec == 3) {
#pragma unroll
                        for (int i = 0; i < 4; ++i) { v0[i] = sigmoidf_fast(v0[i]); v1[i] = sigmoidf_fast(v1[i]); }
                        dst = sb + (size_t)tk * 1024 + hh * 128 + wc * 32 + 8 * fq;
                    } else {
                        v0 = v0 * sc; v1 = v1 * sc;
                        dst = sb + ((size_t)((b * 8 + hh) * 4096 + s)) * 128 + wc * 32 + 8 * fq;
                    }
                    u32x4 w; w.x = cvt_pk_bf16(v0[0], v0[1]); w.y = cvt_pk_bf16(v0[2], v0[3]); w.z = cvt_pk_bf16(v1[0], v1[1]); w.w = cvt_pk_bf16(v1[2], v1[3]);
                    *(u32x4*)dst = w;
                }
            }
    }
};
struct EpiOutProj {
    static constexpr bool PERM = true, AFTER_DRAIN = false;
    const float* x; float* h; bf16_t* hb; float* ssq; float* amx;
    __device__ __forceinline__ void operator()(const f32x4 (&acc)[2][2][4][2], const Unit& u, int wr, int wc, int fr, int fq) const {
#pragma unroll
        for (int ai = 0; ai < 2; ++ai)
#pragma unroll
            for (int m = 0; m < 4; ++m) {
                const int tk = u.pm * BM + ai * HALF + wr * 64 + m * 16 + fr;
                float ss = 0.f, mx = 0.f;
#pragma unroll
                for (int bj = 0; bj < 2; ++bj) {
                    const size_t off = (size_t)tk * DM + u.pn * BM + bj * HALF + wc * 32 + 8 * fq;
                    const f32x4 x0 = *(const f32x4*)(x + off), x1 = *(const f32x4*)(x + off + 4);
                    const f32x4 v0 = acc[ai][bj][m][0] + x0, v1 = acc[ai][bj][m][1] + x1;
                    u32x4 w; w.x = cvt_pk_bf16(v0[0], v0[1]); w.y = cvt_pk_bf16(v0[2], v0[3]); w.z = cvt_pk_bf16(v1[0], v1[1]); w.w = cvt_pk_bf16(v1[2], v1[3]);
                    *(u32x4*)(hb + off) = w;
                    ss += v0[0] * v0[0] + v0[1] * v0[1] + v0[2] * v0[2] + v0[3] * v0[3] + v1[0] * v1[0] + v1[1] * v1[1] + v1[2] * v1[2] + v1[3] * v1[3];
                    mx = fmaxf(mx, fmaxf(fmaxf(fmaxf(fabsf(v0[0]), fabsf(v0[1])), fmaxf(fabsf(v0[2]), fabsf(v0[3]))), fmaxf(fmaxf(fabsf(v1[0]), fabsf(v1[1])), fmaxf(fabsf(v1[2]), fabsf(v1[3])))));
                }
                ss += sx_f(ss, 16); ss += sx_f(ss, 32);
                mx = fmaxf(mx, sx_f(mx, 16)); mx = fmaxf(mx, sx_f(mx, 32));
                if (fq == 0) { ssq[(size_t)tk * 32 + u.pn * 4 + wc] = ss; amx[(size_t)tk * 32 + u.pn * 4 + wc] = mx; }
            }
    }
};
struct EpiPeerQ {
    static constexpr bool PERM = true, AFTER_DRAIN = false;
    const float* ssq; bf16_t* qp; float* rtab;
    __device__ __forceinline__ void operator()(const f32x4 (&acc)[2][2][4][2], const Unit& u, int wr, int wc, int fr, int fq) const {
#pragma unroll
        for (int ai = 0; ai < 2; ++ai)
#pragma unroll
            for (int m = 0; m < 4; ++m) {
                const int tk = u.pm * BM + ai * HALF + wr * 64 + m * 16 + fr;
                float tot = 0.f;
#pragma unroll
                for (int i = 0; i < 8; ++i) { const f32x4 s4 = *(const f32x4*)(ssq + (size_t)tk * 32 + 4 * i); tot += (s4[0] + s4[1]) + (s4[2] + s4[3]); }
                const float r = 1.0f / sqrtf(tot * (1.f / DM) + EPS);
                if (u.pn == 0 && wc == 0 && fq == 0) rtab[tk] = r;
#pragma unroll
                for (int bj = 0; bj < 2; ++bj) {
                    const size_t off = (size_t)tk * DM + u.pn * BM + bj * HALF + wc * 32 + 8 * fq;
                    const f32x4 v0 = acc[ai][bj][m][0] * r, v1 = acc[ai][bj][m][1] * r;
                    u32x4 w; w.x = cvt_pk_bf16(v0[0], v0[1]); w.y = cvt_pk_bf16(v0[2], v0[3]); w.z = cvt_pk_bf16(v1[0], v1[1]); w.w = cvt_pk_bf16(v1[2], v1[3]);
                    *(u32x4*)(qp + off) = w;
                }
            }
    }
};
struct EpiPeerQFused {
    static constexpr bool PERM = true, AFTER_DRAIN = true;
    const float* ssq; unsigned char* wsb;
    __device__ __forceinline__ void operator()(const f32x4 (&)[2][2][4][2], const Unit&, int, int, int, int) const {}
    __device__ __forceinline__ void fused(const f32x4 (&acc)[2][2][4][2], const Unit& u, int wr, int wc, int fr, int fq, PG8_LAS unsigned char* lds) const;
};
}

namespace att {
constexpr int NW = 8, QBLK = 32, KVBLK = 64, QB = NW * QBLK, D = 128;
constexpr int SHM_V = KVBLK * D * 2, SHM_K = KVBLK * D * 2;
constexpr int OFF_WS = 2 * SHM_V + 2 * SHM_K, OFF_BIAS = OFF_WS + NW * 64 * 4, ATT_LDS = OFF_BIAS + SEQ * 4;
#define KSWZ(row, colB) ((row) * 256 + ((colB) ^ (((row) & 7) << 4)))
#define SBAR() __builtin_amdgcn_sched_barrier(0)
__device__ __forceinline__ int v_st(int k, int c) { const int kk = (k & ~0xC) | ((k & 4) << 1) | ((k & 8) >> 1); return ((kk >> 3) * 4 + (c >> 5)) * 512 + ((kk & 7) * 32 + (c & 31)) * 2; }
__device__ __forceinline__ int v_rd_base(int lane) { return ((lane & 3) << 3) | (((lane >> 2) & 3) << 6) | (((lane >> 4) & 1) << 5) | (((lane >> 5) & 1) << 8); }
constexpr int v_rd_off(int d0, int ks, int half) { return d0 * 512 + ks * 4096 + half * 2048; }
__device__ __forceinline__ int crow(int r, int hi) { return (r & 3) + 8 * (r >> 2) + 4 * hi; }
__device__ __forceinline__ bf16x8 load8(const bf16_t* p) { return *reinterpret_cast<const bf16x8*>(p); }
__device__ __forceinline__ void mask_tile(f32x16& p0, f32x16& p1, int dq) {
    const float NEG = -__builtin_inff();
#pragma unroll
    for (int r = 0; r < 16; ++r) {
        const int c = (r & 3) + 8 * (r >> 2);
        if (dq - c < 0) p0[r] = NEG;
        if (dq - c - 32 < 0) p1[r] = NEG;
    }
}
__device__ __forceinline__ void partialSM(f32x16& p0, f32x16& p1, float& m_reg, float& mn, float& alpha) {
    float pmax = p0[0];
#pragma unroll
    for (int r = 1; r < 16; ++r) pmax = fmaxf(pmax, p0[r]);
#pragma unroll
    for (int r = 0; r < 16; ++r) pmax = fmaxf(pmax, p1[r]);
    { auto rr = __builtin_amdgcn_permlane32_swap(__float_as_uint(pmax), __float_as_uint(pmax), false, false);
      pmax = fmaxf(__uint_as_float(rr[0]), __uint_as_float(rr[1])); }
    constexpr float C2 = LOG2E * SCALE; constexpr float THR = 8.f;
    if (__builtin_expect(__all((pmax - m_reg) * SCALE <= THR), 1)) { mn = m_reg; alpha = 1.f; }
    else { mn = fmaxf(m_reg, pmax); alpha = __builtin_amdgcn_exp2f((m_reg - mn) * C2); m_reg = mn; }
    const float mnL = -mn * C2;
#pragma unroll
    for (int r = 0; r < 16; ++r) p0[r] = fmaf(p0[r], C2, mnL);
#pragma unroll
    for (int r = 0; r < 16; ++r) p1[r] = fmaf(p1[r], C2, mnL);
#pragma unroll
    for (int r = 0; r < 16; ++r) p0[r] = __builtin_amdgcn_exp2f(p0[r]);
}
#define PK4(P, B_, OUT) do { unsigned a0 = cvt_pk_bf16(P[B_+0], P[B_+1]), a1 = cvt_pk_bf16(P[B_+2], P[B_+3]);                          \
        unsigned b0 = cvt_pk_bf16(P[B_+4], P[B_+5]), b1 = cvt_pk_bf16(P[B_+6], P[B_+7]);                                             \
        auto r0 = __builtin_amdgcn_permlane32_swap(a0, b0, false, false); auto r1 = __builtin_amdgcn_permlane32_swap(a1, b1, false, false); \
        u32x4 w = {r0[0], r1[0], r0[1], r1[1]}; OUT = *reinterpret_cast<bf16x8*>(&w); } while (0)
__device__ __forceinline__ void finishSM(f32x16& p0, f32x16& p1, float alpha, float& l_reg, bf16x8& pa0, bf16x8& pa1, bf16x8& pa2, bf16x8& pa3) {
#pragma unroll
    for (int r = 0; r < 16; ++r) p1[r] = __builtin_amdgcn_exp2f(p1[r]);
    float ps = 0;
#pragma unroll
    for (int r = 0; r < 16; ++r) ps += p0[r];
#pragma unroll
    for (int r = 0; r < 16; ++r) ps += p1[r];
    { auto rr = __builtin_amdgcn_permlane32_swap(__float_as_uint(ps), __float_as_uint(ps), false, false);
      ps = __uint_as_float(rr[0]) + __uint_as_float(rr[1]); }
    l_reg = l_reg * alpha + ps;
    PK4(p0, 0, pa0); PK4(p0, 8, pa1); PK4(p1, 0, pa2); PK4(p1, 8, pa3);
}
__device__ __forceinline__ void sb_group(f32x16& P, int g, float& gs) {
    float run = 0.f;
#pragma unroll
    for (int k = 3; k >= 0; --k) {
        const float z = P[4 * g + k];
        const float t = __builtin_amdgcn_exp2f(-fabsf(z));
        const float l = __builtin_amdgcn_logf(1.f + t);
        const float sp = fmaxf(z, 0.f) + l;
        P[4 * g + k] = (z - sp) - run;
        run += sp;
    }
    gs = run;
}
__device__ __forceinline__ void sb_part1(f32x16& p0, f32x16& p1, float& carry, float mlo) {
    float gs[8];
#pragma unroll
    for (int g = 0; g < 4; ++g) sb_group(p0, g, gs[g]);
#pragma unroll
    for (int g = 0; g < 4; ++g) sb_group(p1, g, gs[4 + g]);
    float run = carry;
#pragma unroll
    for (int G = 7; G >= 0; --G) {
        auto rr = __builtin_amdgcn_permlane32_swap(__float_as_uint(gs[G]), __float_as_uint(gs[G]), false, false);
        const float slo = __uint_as_float(rr[0]), shi = __uint_as_float(rr[1]);
        const float base = fmaf(mlo, shi, run);
        if (G >= 4) {
#pragma unroll
            for (int k = 0; k < 4; ++k) p1[4 * (G - 4) + k] -= base;
        } else {
#pragma unroll
            for (int k = 0; k < 4; ++k) p0[4 * G + k] -= base;
        }
        run += slo + shi;
    }
    carry = run;
#pragma unroll
    for (int r = 0; r < 16; ++r) p0[r] = __builtin_amdgcn_exp2f(p0[r]);
}
__device__ __forceinline__ void sb_part2(f32x16& p0, f32x16& p1, bf16x8& pa0, bf16x8& pa1, bf16x8& pa2, bf16x8& pa3) {
#pragma unroll
    for (int r = 0; r < 16; ++r) p1[r] = __builtin_amdgcn_exp2f(p1[r]);
    PK4(p0, 0, pa0); PK4(p0, 8, pa1); PK4(p1, 0, pa2); PK4(p1, 8, pa3);
}
#undef PK4
template <int KB, bool BIAS>
__device__ __forceinline__ void qkt(f32x16& p0, f32x16& p1, const char* K_lds, int r32, int hi, const bf16x8* qr, const float* bt) {
    if constexpr (BIAS) {
#pragma unroll
        for (int g = 0; g < 4; ++g) { const f32x4 a = *(const f32x4*)(bt + 8 * g), b = *(const f32x4*)(bt + 32 + 8 * g);
            p0[4 * g] = a[0]; p0[4 * g + 1] = a[1]; p0[4 * g + 2] = a[2]; p0[4 * g + 3] = a[3];
            p1[4 * g] = b[0]; p1[4 * g + 1] = b[1]; p1[4 * g + 2] = b[2]; p1[4 * g + 3] = b[3]; }
    } else { p0 = f32x16{}; p1 = f32x16{}; }
    const char* kb[4];
#pragma unroll
    for (int dd = 0; dd < 4; ++dd) kb[dd] = K_lds + KB * SHM_K + KSWZ(r32, (dd * 16 + hi * 8) * 2);
#pragma unroll
    for (int d0 = 0; d0 < 8; ++d0) { const char* a = kb[d0 & 3] + (d0 >> 2) * 128;
        bf16x8 b0 = *reinterpret_cast<const bf16x8*>(a);
        bf16x8 b1 = *reinterpret_cast<const bf16x8*>(a + 32 * 256);
        p0 = __builtin_amdgcn_mfma_f32_32x32x16_bf16(b0, qr[d0], p0, 0, 0, 0);
        p1 = __builtin_amdgcn_mfma_f32_32x32x16_bf16(b1, qr[d0], p1, 0, 0, 0); }
}
template <int VB>
__device__ __forceinline__ void pv_tile(f32x16* o, int vb0, bf16x8 pa0, bf16x8 pa1, bf16x8 pa2, bf16x8 pa3) {
#define TRRD(dst, off) asm volatile("ds_read_b64_tr_b16 %0, %1 offset:%2" : "=&v"(dst) : "v"(vb0), "i"(off) : "memory")
#define PV_D0(d0) do { { s16x4 l0, l1, h0, h1; constexpr int b_ = VB * SHM_V + v_rd_off(d0, 0, 0); \
        TRRD(l0, b_); TRRD(h0, b_ + 2048); TRRD(l1, b_ + 4096); TRRD(h1, b_ + 6144); \
        asm volatile("s_waitcnt lgkmcnt(0)" ::: "memory"); SBAR();   \
        o[d0] = __builtin_amdgcn_mfma_f32_32x32x16_bf16(pa0, (bf16x8){l0[0], l0[1], l0[2], l0[3], h0[0], h0[1], h0[2], h0[3]}, o[d0], 0, 0, 0);   \
        o[d0] = __builtin_amdgcn_mfma_f32_32x32x16_bf16(pa1, (bf16x8){l1[0], l1[1], l1[2], l1[3], h1[0], h1[1], h1[2], h1[3]}, o[d0], 0, 0, 0); }  \
      { s16x4 l2, l3, h2, h3; constexpr int b_ = VB * SHM_V + v_rd_off(d0, 0, 0); \
        TRRD(l2, b_ + 8192); TRRD(h2, b_ + 10240); TRRD(l3, b_ + 12288); TRRD(h3, b_ + 14336); \
        asm volatile("s_waitcnt lgkmcnt(0)" ::: "memory"); SBAR();   \
        o[d0] = __builtin_amdgcn_mfma_f32_32x32x16_bf16(pa2, (bf16x8){l2[0], l2[1], l2[2], l2[3], h2[0], h2[1], h2[2], h2[3]}, o[d0], 0, 0, 0);   \
        o[d0] = __builtin_amdgcn_mfma_f32_32x32x16_bf16(pa3, (bf16x8){l3[0], l3[1], l3[2], l3[3], h3[0], h3[1], h3[2], h3[3]}, o[d0], 0, 0, 0); } } while (0)
    PV_D0(0); PV_D0(1); PV_D0(2); PV_D0(3);
#undef PV_D0
#undef TRRD
}

struct UnitRef { const bf16_t* Q; const bf16_t* K; const bf16_t* V; int P0; };
struct Seam { bf16x8 qr[8]; bf16x8 st_v0, st_v1, st_k0, st_k1; };
#define ROW(p, k0, rr) ((p) + (size_t)((k0) + (rr)) * D + sc)
#define VMW() asm volatile("s_waitcnt vmcnt(0)" ::: "memory")
#define SLOAD_H(Kp, Vp, k0) do { S.st_v0 = load8(ROW(Vp, k0, sr)); S.st_v1 = load8(ROW(Vp, k0, 32 + sr));              \
                         S.st_k0 = load8(ROW(Kp, k0, sr)); S.st_k1 = load8(ROW(Kp, k0, 32 + sr)); } while (0)
#define SWRITE_HK(bf) do { *(bf16x8*)(K_lds + (bf) * SHM_K + kws) = S.st_k0; *(bf16x8*)(K_lds + (bf) * SHM_K + kws + 32 * 256) = S.st_k1; } while (0)
#define SWRITE_HV(bf) do { *(bf16x8*)(V_lds + (bf) * SHM_V + vst0) = S.st_v0; *(bf16x8*)(V_lds + (bf) * SHM_V + vst1) = S.st_v1; } while (0)
#define SWRITE_H(bf) do { SWRITE_HV(bf); SWRITE_HK(bf); } while (0)

template <bool SB>
__device__ __forceinline__ void attn_unit(const UnitRef& cur, unsigned char* wsu  , int bh, char* lds,
                                          int part  ) {
    const float* cvec; const float* gqk;
    { unsigned char* w_ = wsu; asm volatile("" : "+s"(w_)); cvec = (const float*)(w_ + WS_C) + (size_t)bh * SEQ; gqk = (const float*)(w_ + WS_GQK); }
    const int tid = tid_opaque(), wid = __builtin_amdgcn_readfirstlane(tid >> 6), lane = tid & 63, r32 = lane & 31, hi = lane >> 5;
    int jlo = 0;
    if constexpr (!SB) {
        const float gq = fmaxf(fabsf(gqk[lane]), fabsf(gqk[64 + lane])), gk = fmaxf(fabsf(gqk[128 + lane]), fabsf(gqk[192 + lane]));
        const float lmax = 11.3137085f * 1.02f * wave_max(gq) * wave_max(gk);
        const int ntf = (cur.P0 + QB) / KVBLK;
        const float cend = (lane < ntf) ? cvec[lane * KVBLK + KVBLK - 1] : 0.f;
        const bool skip = (lane < ntf) && (2.f * lmax + cvec[cur.P0] - cend < -104.f);
        jlo = __builtin_amdgcn_readfirstlane((int)__popcll(__ballot(skip)));
    }
    const int ntot = (cur.P0 + QB) / KVBLK - jlo;
    const int tb = (part == 2) ? (ntot >> 1) : 0, te = (part == 1) ? (ntot >> 1) : ntot;
    const int kshift = (jlo + tb) * KVBLK, P0r = cur.P0 - kshift;
    const int NT = te - tb;
#define KBASE(t) ((SB ? (NT - 1 - (t)) : (t)) * KVBLK)
    const int qlo = P0r + wid * QBLK, qm = qlo + r32 - 4 * hi - (SB ? 1 : 0);
    char* V_lds = lds; char* K_lds = lds + 2 * SHM_V;
    float* ws = (float*)(lds + OFF_WS) + wid * 64; float* li_l = ws, * al_l = ws + 32;
    float* bias = (float*)(lds + OFF_BIAS);
    const int sr = tid >> 4, sc = (tid & 15) * 8, vst0 = v_st(sr, sc), vst1 = v_st(32 + sr, sc), kws = KSWZ(sr, sc * 2);
    const int vb0 = (int)(uintptr_t)V_lds + v_rd_base(lane);
    const bf16_t* Kh = cur.K + (size_t)kshift * D; const bf16_t* Vh = cur.V + (size_t)kshift * D;
    Seam S;
    if constexpr (!SB) { const float cq0 = cvec[cur.P0]; const float* cv = cvec + kshift; for (int j = tid; j < NT * KVBLK; j += NTHREADS) bias[j] = (cq0 - cv[j]) * (1.f / SCALE); }
#pragma unroll
    for (int d0 = 0; d0 < 8; ++d0) S.qr[d0] = load8(cur.Q + (size_t)(wid * QBLK + r32) * D + d0 * 16 + hi * 8);
    SLOAD_H(Kh, Vh, KBASE(0)); VMW(); SWRITE_HK(0);
    __syncthreads();
    float m_reg = -1e30f, l_reg = 0; f32x16 o[4] = {};
    float carry = 0.f; const float mlo = hi ? 0.f : 1.f;
#define RESC(a) do { if (__any((a) < 1.f)) { if (hi == 0) al_l[r32] = (a); asm volatile("s_waitcnt lgkmcnt(0)" ::: "memory");              \
                     for (int d_ = 0; d_ < 4; ++d_) for (int r = 0; r < 16; ++r) o[d_][r] *= al_l[crow(r, hi)]; } } while (0)
#define MASKT(P0_, P1_, t) do { const int kb_ = KBASE(t); if (kb_ + KVBLK - 1 > qlo - (SB ? 1 : 0)) mask_tile(P0_, P1_, qm - kb_); } while (0)
#define BT(t) (bias + KBASE(t) + 4 * hi)
#define PART1(PX0, PX1, mnX, alX) do { if constexpr (SB) sb_part1(PX0, PX1, carry, mlo); else partialSM(PX0, PX1, m_reg, mnX, alX); } while (0)
#define PART2(PY0, PY1, alY) do { if constexpr (SB) sb_part2(PY0, PY1, pa0, pa1, pa2, pa3); else finishSM(PY0, PY1, alY, l_reg, pa0, pa1, pa2, pa3); } while (0)
    f32x16 pA0, pA1, pB0, pB1; float mnA = 0.f, mnB = 0.f, alA = 1.f, alB = 1.f; bf16x8 pa0, pa1, pa2, pa3;
    SWRITE_HV(0); SBAR();
    if (NT > 1) SLOAD_H(Kh, Vh, KBASE(1));
    SBAR(); qkt<0, !SB>(pA0, pA1, K_lds, r32, hi, S.qr, BT(0));
    MASKT(pA0, pA1, 0); PART1(pA0, pA1, mnA, alA);
    if (NT > 1) { VMW(); SWRITE_H(1); }
    __syncthreads();
#define HALF_STEP(PX0, PX1, mnX, alX, PY0, PY1, alY, t, KB, VB, SBUF) do {                                                    \
        SBAR(); qkt<KB, !SB>(PX0, PX1, K_lds, r32, hi, S.qr, BT(t));                                                          \
        PART2(PY0, PY1, alY); SBAR();                                                                                          \
        if ((t) + 1 < NT) { SLOAD_H(Kh, Vh, KBASE((t) + 1)); SBAR(); }                                                         \
        pv_tile<VB>(o, vb0, pa0, pa1, pa2, pa3); MASKT(PX0, PX1, (t)); PART1(PX0, PX1, mnX, alX);                              \
        __syncthreads();                                                                                                      \
        if ((t) + 1 < NT) { VMW(); SWRITE_H(SBUF); }                                                                           \
        if constexpr (!SB) RESC(alX);                                                                                          \
        __syncthreads(); } while (0)
    for (int t = 1; t + 1 < NT; t += 2) {
        HALF_STEP(pB0, pB1, mnB, alB, pA0, pA1, alA, t, 1, 0, 0);
        HALF_STEP(pA0, pA1, mnA, alA, pB0, pB1, alB, t + 1, 0, 1, 1);
    }
    const bool even = (NT & 1) == 0;
    if (even) { SBAR(); qkt<1, !SB>(pB0, pB1, K_lds, r32, hi, S.qr, BT(NT - 1)); SBAR(); }
    PART2(pA0, pA1, alA); SBAR();
    pv_tile<0>(o, vb0, pa0, pa1, pa2, pa3);
    if (even) { MASKT(pB0, pB1, NT - 1); PART1(pB0, pB1, mnB, alB); __syncthreads(); if constexpr (!SB) RESC(alB);
        PART2(pB0, pB1, alB); SBAR(); pv_tile<1>(o, vb0, pa0, pa1, pa2, pa3); }
    unsigned char* we_ = wsu; asm volatile("" : "+s"(we_));
    if (part != 0) {
        const int slot2 = ((((cur.P0 >> 8) - 8) & 7) * 16 + bh) * 2 + (part == 2 ? 1 : 0);
        float* po = (float*)(we_ + WS_PO) + (size_t)slot2 * 256 * 128; float* pml = (float*)(we_ + WS_PML) + (size_t)slot2 * 512;
        if (hi == 0) { pml[(wid * QBLK + r32) * 2] = m_reg; pml[(wid * QBLK + r32) * 2 + 1] = l_reg; }
#pragma unroll
        for (int r = 0; r < 16; ++r)
#pragma unroll
            for (int d0 = 0; d0 < 4; ++d0) po[(size_t)(wid * QBLK + crow(r, hi)) * D + d0 * 32 + r32] = o[d0][r];
        __syncthreads();
        return;
    }
    const bf16_t* gate = (const bf16_t*)(we_ + WS_SEC) + 3 * SEC_ELEMS + (size_t)(bh >> 3) * SEQ * 1024 + (bh & 7) * HD;
    bf16_t* outp = (bf16_t*)(we_ + WS_MIX) + (size_t)(bh >> 3) * SEQ * DM + (bh & 7) * HD;
    float rli[16];
    if constexpr (!SB) {
        if (hi == 0) li_l[r32] = l_reg; asm volatile("s_waitcnt lgkmcnt(0)" ::: "memory");
#pragma unroll
        for (int r = 0; r < 16; ++r) rli[r] = __builtin_amdgcn_rcpf(li_l[crow(r, hi)]);
    }
#pragma unroll
    for (int r = 0; r < 16; ++r) { const int orow = cur.P0 + wid * QBLK + crow(r, hi);
#pragma unroll
        for (int d0 = 0; d0 < 4; ++d0) {
            float v = o[d0][r];
            if constexpr (!SB) { const unsigned short gb = gate[(size_t)orow * 1024 + d0 * 32 + r32]; v = v * rli[r] * __builtin_bit_cast(float, (unsigned)gb << 16); }
            const float vn = sx_f(v, 1);
            if ((r32 & 1) == 0) *(unsigned*)(outp + (size_t)orow * DM + d0 * 32 + r32) = cvt_pk_bf16(v, vn); } }
    __syncthreads();
#undef RESC
#undef KBASE
#undef MASKT
#undef BT
#undef PART1
#undef PART2
#undef HALF_STEP
}

constexpr float SB_TH = 150.f;
__device__ __forceinline__ void sb_unit(const UnitRef& cur, bf16_t* outp, char* lds) {
    const int tid = tid_opaque(), wid = __builtin_amdgcn_readfirstlane(tid >> 6), lane = tid & 63, r32 = lane & 31, hi = lane >> 5;
    const int NT = (cur.P0 + QB) / KVBLK;
#define KBASE(t) ((NT - 1 - (t)) * KVBLK)
    const int qlo = cur.P0 + wid * QBLK, qm = qlo + r32 - 4 * hi - 1;
    char* V_lds = lds; char* K_lds = lds + 2 * SHM_V;
    volatile int* flags = (volatile int*)(lds + OFF_WS);
    const int sr = tid >> 4, sc = (tid & 15) * 8, vst0 = v_st(sr, sc), vst1 = v_st(32 + sr, sc), kws = KSWZ(sr, sc * 2);
    const int vb0 = (int)(uintptr_t)V_lds + v_rd_base(lane);
    const bf16_t* Kh = cur.K; const bf16_t* Vh = cur.V;
    Seam S;
#pragma unroll
    for (int d0 = 0; d0 < 8; ++d0) S.qr[d0] = load8(cur.Q + (size_t)(wid * QBLK + r32) * D + d0 * 16 + hi * 8);
    SLOAD_H(Kh, Vh, KBASE(0)); VMW(); SWRITE_H(0);
    __syncthreads();
    f32x16 o[4] = {}; float carry = 0.f; const float mlo = hi ? 0.f : 1.f;
    bool wdone = false;
#define SB_STEP(tt, BUF) {                                                                                                 \
        const int kb_ = KBASE(tt);                                                                                           \
        if ((tt) + 1 < NT) SLOAD_H(Kh, Vh, KBASE((tt) + 1));                                                                 \
        SBAR();                                                                                                              \
        if (!wdone && kb_ <= qlo + QBLK - 2) {                                                                               \
            f32x16 p0, p1; bf16x8 pa0, pa1, pa2, pa3;                                                                        \
            qkt<BUF, false>(p0, p1, K_lds, r32, hi, S.qr, nullptr);                                                          \
            if (kb_ + KVBLK - 1 > qlo - 1) mask_tile(p0, p1, qm - kb_);                                                      \
            sb_part1(p0, p1, carry, mlo); sb_part2(p0, p1, pa0, pa1, pa2, pa3); SBAR();                                      \
            pv_tile<BUF>(o, vb0, pa0, pa1, pa2, pa3);                                                                        \
            wdone = __all(carry >= SB_TH);                                                                                   \
        }                                                                                                                    \
        if ((tt) + 1 < NT) { VMW(); SWRITE_H((BUF) ^ 1); }                                                                   \
        if (lane == 0) flags[((tt) & 1) * 8 + wid] = wdone ? 1 : 0;                                                          \
        __syncthreads();                                                                                                     \
        { int alld = 1;                                                                                                      \
          _Pragma("unroll") for (int w_ = 0; w_ < 8; ++w_) alld &= flags[((tt) & 1) * 8 + w_];                                \
          if (alld) break; } }
    for (int t = 0; t < NT; t += 2) {
        SB_STEP(t, 0)
        SB_STEP(t + 1, 1)
    }
#undef SB_STEP
#pragma unroll
    for (int r = 0; r < 16; ++r) { const int orow = cur.P0 + wid * QBLK + crow(r, hi);
#pragma unroll
        for (int d0 = 0; d0 < 4; ++d0) {
            const float v = o[d0][r];
            const float vn = sx_f(v, 1);
            if ((r32 & 1) == 0) *(unsigned*)(outp + (size_t)orow * DM + d0 * 32 + r32) = cvt_pk_bf16(v, vn); } }
    __syncthreads();
#undef KBASE
}
#undef ROW
#undef VMW
#undef SLOAD_H
#undef SWRITE_HK
#undef SWRITE_HV
#undef SWRITE_H
}

#define XB_TMO      128
#define XB_XCNT(j)  (256  + 64 * (j))
#define XB_XSUB(j)  (1280 + 64 * (j))
#define XB_XGEN(j)  (2304 + 64 * (j))
#define XB_TOP      3328
#define XB_TOPGEN   3392
#define XCD_BAR_WORDS 3456
#define XB_SPIN_CAP (1u << 20)
__device__ __forceinline__ unsigned xb_ld(unsigned* p)              { return __hip_atomic_load(p, __ATOMIC_RELAXED, __HIP_MEMORY_SCOPE_AGENT); }
__device__ __forceinline__ unsigned xb_add(unsigned* p, unsigned v) { return __hip_atomic_fetch_add(p, v, __ATOMIC_RELAXED, __HIP_MEMORY_SCOPE_AGENT); }
__device__ __forceinline__ unsigned xb_xcc_id() { return (unsigned)__builtin_amdgcn_s_getreg((3 << 11) | 20) & 0xFu; }
#define XB_SPIN(cond, bar) do { unsigned _sp = 0; while (cond) { __builtin_amdgcn_s_sleep(1); \
    if ((++_sp & 255u) == 0u) { if (xb_ld(&(bar)[XB_TMO])) break; if (_sp > XB_SPIN_CAP) { atomicAdd(&(bar)[XB_TMO], 1u); break; } } } } while (0)
struct XcdBarrier { unsigned* bar; unsigned x; volatile LAS unsigned* st; };
__device__ __forceinline__ XcdBarrier xcd_barrier_post(unsigned* bar, volatile LAS unsigned* st) {
    XcdBarrier b; b.bar = bar; b.x = xb_xcc_id(); b.st = st;
    if (threadIdx.x == 0) (void)xb_add(&bar[XB_XCNT(b.x)], 1u);
    return b;
}
__device__ __forceinline__ void xcd_barrier_complete(unsigned* bar, unsigned x, unsigned& nloc, unsigned& nx) {
    const unsigned G = gridDim.x * gridDim.y * gridDim.z;
    unsigned sum, cnt, mine, sp = 0u;
    for (;;) {
        sum = 0u; cnt = 0u; mine = 0u;
#pragma unroll
        for (unsigned j = 0; j < 16; ++j) { const unsigned c = xb_ld(&bar[XB_XCNT(j)]); sum += c; cnt += (c > 0u) ? 1u : 0u; mine = (j == x) ? c : mine; }
        if (sum == G) break;
        __builtin_amdgcn_s_sleep(1);
        if ((++sp & 255u) == 0u) { if (xb_ld(&bar[XB_TMO])) break; if (sp > XB_SPIN_CAP) { atomicAdd(&bar[XB_TMO], 1u); break; } }
    }
    nloc = mine > 0u ? mine : 1u; nx = cnt > 0u ? cnt : 1u;
}
__device__ __forceinline__ void xcd_barrier(const XcdBarrier& b) {
    asm volatile("s_waitcnt vmcnt(0)" ::: "memory");
    __syncthreads();
    if (threadIdx.x == 0) {
        unsigned* bar = b.bar;
        __builtin_amdgcn_s_waitcnt(0);
        unsigned nloc = b.st[0], nx = b.st[1];
        if (nloc == 0u) { xcd_barrier_complete(bar, b.x, nloc, nx); b.st[0] = nloc; b.st[1] = nx; }
        const unsigned old = xb_add(&bar[XB_XSUB(b.x)], 1u);
        const unsigned gen = old / nloc;
        if (old + 1u == (gen + 1u) * nloc) {
            __builtin_amdgcn_fence(__ATOMIC_RELEASE, "agent");
            asm volatile("s_waitcnt vmcnt(0)" ::: "memory");
            const unsigned og = xb_add(&bar[XB_TOP], 1u);
            const unsigned tg = og / nx;
            if (og + 1u == (tg + 1u) * nx) xb_add(&bar[XB_TOPGEN], 1u);
            else XB_SPIN(xb_ld(&bar[XB_TOPGEN]) == tg, bar);
            __builtin_amdgcn_fence(__ATOMIC_ACQUIRE, "agent");
            xb_add(&bar[XB_XGEN(b.x)], 1u);
            asm volatile("s_waitcnt vmcnt(0)" ::: "memory");
        } else {
            XB_SPIN(xb_ld(&bar[XB_XGEN(b.x)]) == gen, bar);
            __builtin_amdgcn_fence(__ATOMIC_ACQUIRE, "agent");
            asm volatile("s_waitcnt vmcnt(0)" ::: "memory");
        }
    }
    __syncthreads();
}

struct Args { const float* in[12]; float* out; unsigned char* ws; int ph_lo, ph_hi; };

__device__ __forceinline__ void p0_transpose_item(const float* W, int ldw, int K, bf16_t* WT, int nblk, LAS float* scr, int item, int lane, const float* gk) {
    const int kb = item / nblk, nb = item % nblk, k0 = 64 * kb, n0 = 32 * nb;
    { const int rr = lane >> 3, c4 = lane & 7; f32x4 v[8];
#pragma unroll
      for (int i = 0; i < 8; ++i) v[i] = *(const f32x4*)(W + (size_t)(k0 + rr + 8 * i) * ldw + n0 + 4 * c4);
#pragma unroll
      for (int i = 0; i < 8; ++i) { const int kk = rr + 8 * i; const float gm = gk ? gk[k0 + kk] : 1.f;
          scr[kk * 33 + 4 * c4] = v[i][0] * gm; scr[kk * 33 + 4 * c4 + 1] = v[i][1] * gm; scr[kk * 33 + 4 * c4 + 2] = v[i][2] * gm; scr[kk * 33 + 4 * c4 + 3] = v[i][3] * gm; } }
    LDS_WAIT(); asm volatile("" ::: "memory");
    const int c = lane & 7;
#pragma unroll
    for (int j = 0; j < 4; ++j) { const int n = (lane >> 3) + 8 * j; const LAS float* s = scr + (8 * c) * 33 + n;
        u32x4 o; o.x = cvt_pk_bf16(s[0 * 33], s[1 * 33]); o.y = cvt_pk_bf16(s[2 * 33], s[3 * 33]); o.z = cvt_pk_bf16(s[4 * 33], s[5 * 33]); o.w = cvt_pk_bf16(s[6 * 33], s[7 * 33]);
        *(u32x4*)(WT + (size_t)(n0 + n) * K + k0 + 8 * c) = o; }
    LDS_WAIT(); asm volatile("" ::: "memory");
}

__device__ __forceinline__ int pack_i8(float a, float b, float c, float d) {
    const int ia = (int)__builtin_rintf(a), ib = (int)__builtin_rintf(b), ic = (int)__builtin_rintf(c), id = (int)__builtin_rintf(d);
    return (int)(((unsigned)ia & 0xffu) | (((unsigned)ib & 0xffu) << 8) | (((unsigned)ic & 0xffu) << 16) | ((unsigned)id << 24));
}
__device__ __forceinline__ void convert_tables(const Args& a, int r0, int r1, int worker, int nworkers) {
    const int lane = tid_opaque() & 63;
    unsigned char* ws = a.ws; const float* g_ffn = a.in[7]; const float* pu = a.in[10]; const float* pv = a.in[11];
    float* suv = (float*)(ws + WS_SUV);
    for (int r = r0 + worker; r < r1; r += nworkers) {
        const bool isv = r >= NEXP; const int e = isv ? r - NEXP : r;
        const f32x4* srcp = (const f32x4*)((isv ? pv : pu) + (size_t)e * DM);
        f32x4 v[8]; float amax = 0.f;
#pragma unroll
        for (int j = 0; j < 8; ++j) { v[j] = srcp[lane + 64 * j];
            if (!isv) { const f32x4 g4 = *(const f32x4*)(g_ffn + 4 * (lane + 64 * j)); v[j] = v[j] * g4; }
            amax = fmaxf(amax, fmaxf(fmaxf(fabsf(v[j][0]), fabsf(v[j][1])), fmaxf(fabsf(v[j][2]), fabsf(v[j][3])))); }
        amax = wave_max(amax);
        const float sc = amax > 0.f ? 127.f / amax : 1.f;
        unsigned char* dst = ws + (isv ? WS_V8 : WS_U8) + (size_t)e * 128;
#pragma unroll
        for (int j = 0; j < 8; ++j) { const int p = pack_i8(v[j][0] * sc, v[j][1] * sc, v[j][2] * sc, v[j][3] * sc);
            const int col = 4 * (lane + 64 * j);
            *(unsigned*)(dst + (size_t)(col >> 7) * ((size_t)NEXP * 128) + (col & 127)) = (unsigned)p; }
        if (lane == 0) suv[r] = 1.f / sc;
    }
}
constexpr int TAB_SPLIT = NEXP;

__device__ __forceinline__ void p0_transpose_item_i8(const float* W, int ldw, int K, unsigned char* WT, int nblk, LAS float* scr, int item, int lane, float q8) {
    const int kb = item / nblk, nb = item % nblk, k0 = 64 * kb, n0 = 32 * nb;
    { const int rr = lane >> 3, c4 = lane & 7; f32x4 v[8];
#pragma unroll
      for (int i = 0; i < 8; ++i) v[i] = *(const f32x4*)(W + (size_t)(k0 + rr + 8 * i) * ldw + n0 + 4 * c4);
#pragma unroll
      for (int i = 0; i < 8; ++i) { const int kk = rr + 8 * i;
          scr[kk * 33 + 4 * c4] = v[i][0] * q8; scr[kk * 33 + 4 * c4 + 1] = v[i][1] * q8; scr[kk * 33 + 4 * c4 + 2] = v[i][2] * q8; scr[kk * 33 + 4 * c4 + 3] = v[i][3] * q8; } }
    LDS_WAIT(); asm volatile("" ::: "memory");
    const int c = lane & 7;
#pragma unroll
    for (int j = 0; j < 4; ++j) { const int n = (lane >> 3) + 8 * j; const LAS float* s = scr + (8 * c) * 33 + n;
        u32x2 o; o.x = (unsigned)pack_i8(s[0 * 33], s[1 * 33], s[2 * 33], s[3 * 33]); o.y = (unsigned)pack_i8(s[4 * 33], s[5 * 33], s[6 * 33], s[7 * 33]);
        *(u32x2*)(WT + (size_t)(n0 + n) * K + k0 + 8 * c) = o; }
    LDS_WAIT(); asm volatile("" ::: "memory");
}
__device__ __forceinline__ float log_sigmoid_f(float x) { return fminf(x, 0.f) - log1pf(expf(-fabsf(x))); }

__device__ __forceinline__ void phase0(const Args& a, unsigned char* lds_g) {
    LAS unsigned char* lds = (LAS unsigned char*)lds_g;
    const int tid = tid_opaque(), lane = tid & 63, wave = __builtin_amdgcn_readfirstlane(tid >> 6);
    const int gw = blockIdx.x * NWAVES + wave, NGW = gridDim.x * NWAVES;
    const int gt = blockIdx.x * NTHREADS + tid, NGT = gridDim.x * NTHREADS;
    unsigned char* ws = a.ws;
    const float* x = a.in[0]; const float* g_attn = a.in[1]; const float* w_in = a.in[2]; const float* b_forget = a.in[3];
    const float* w_out = a.in[6]; const float* g_ffn = a.in[7]; const float* w_pq = a.in[8]; const float* sk = a.in[9]; const float* pu = a.in[10]; const float* pv = a.in[11];
    { float m = 0.f; const f32x4* wp = (const f32x4*)w_in;
      constexpr size_t NV4 = (size_t)DM * DIN / 4;
      size_t i = gt;
      for (; i + 7 * (size_t)NGT < NV4; i += 8 * (size_t)NGT) {
          f32x4 v[8];
#pragma unroll
          for (int k = 0; k < 8; ++k) v[k] = wp[i + k * (size_t)NGT];
#pragma unroll
          for (int k = 0; k < 8; ++k) m = fmaxf(m, fmaxf(fmaxf(fabsf(v[k][0]), fabsf(v[k][1])), fmaxf(fabsf(v[k][2]), fabsf(v[k][3])))); }
      for (; i < NV4; i += NGT) { const f32x4 v = wp[i]; m = fmaxf(m, fmaxf(fmaxf(fabsf(v[0]), fabsf(v[1])), fmaxf(fabsf(v[2]), fabsf(v[3])))); }
      m = wave_max(m);
      volatile LAS float* red = (volatile LAS float*)(lds + MISC_OFF + 256);
      if (lane == 0) red[wave] = m;
      __syncthreads();
      if (tid == 0) { float mm = red[0];
#pragma unroll
          for (int w = 1; w < NWAVES; ++w) mm = fmaxf(mm, red[w]);
          __hip_atomic_fetch_max((unsigned*)(ws + WS_CTL) + CW_WMAX, __float_as_uint(mm), __ATOMIC_RELAXED, __HIP_MEMORY_SCOPE_AGENT); } }
    LAS float* wf = (LAS float*)(lds + 67584);
    for (int k = tid; k < DM; k += NTHREADS) { const f32x4 a0 = *(const f32x4*)(w_in + (size_t)k * DIN + NPROJ), a1 = *(const f32x4*)(w_in + (size_t)k * DIN + NPROJ + 4);
        wf[0 * DM + k] = a0[0]; wf[1 * DM + k] = a0[1]; wf[2 * DM + k] = a0[2]; wf[3 * DM + k] = a0[3]; wf[4 * DM + k] = a1[0]; wf[5 * DM + k] = a1[1]; wf[6 * DM + k] = a1[2]; wf[7 * DM + k] = a1[3]; }
    __syncthreads();
    for (int row = gw; row < T; row += NGW) {
        const f32x4* xr = (const f32x4*)(x + (size_t)row * DM);
        f32x4 v[8]; float ss = 0.f;
#pragma unroll
        for (int j = 0; j < 8; ++j) { v[j] = xr[lane + 64 * j]; ss += v[j][0] * v[j][0] + v[j][1] * v[j][1] + v[j][2] * v[j][2] + v[j][3] * v[j][3]; }
        const float r = 1.0f / sqrtf(wave_sum(ss) * (1.f / DM) + EPS);
        float f[8] = {0.f, 0.f, 0.f, 0.f, 0.f, 0.f, 0.f, 0.f};
        float xmax = 0.f;
#pragma unroll
        for (int j = 0; j < 8; ++j) { const f32x4 g4 = *(const f32x4*)(g_attn + 4 * (lane + 64 * j)); v[j][0] *= r * g4[0]; v[j][1] *= r * g4[1]; v[j][2] *= r * g4[2]; v[j][3] *= r * g4[3];
            xmax = fmaxf(xmax, fmaxf(fmaxf(fabsf(v[j][0]), fabsf(v[j][1])), fmaxf(fabsf(v[j][2]), fabsf(v[j][3])))); }
        xmax = wave_max(xmax);
        const float xq = xmax > 0.f ? 127.f / xmax : 1.f;
        if (lane == 0) ((float*)(ws + WS_SXN))[row] = xmax * (1.f / 127.f);
        unsigned* o8 = (unsigned*)(ws + WS_XN + (size_t)row * DM);
#pragma unroll
        for (int j = 0; j < 8; ++j) {
            const int e = 4 * (lane + 64 * j);
            const f32x4 xn = v[j];
            o8[lane + 64 * j] = (unsigned)pack_i8(xn[0] * xq, xn[1] * xq, xn[2] * xq, xn[3] * xq);
#pragma unroll
            for (int hh = 0; hh < 8; ++hh) { const f32x4 w4 = *(LAS f32x4*)(wf + hh * DM + e);
                f[hh] += (xn[0] * w4[0] + xn[1] * w4[1]) + (xn[2] * w4[2] + xn[3] * w4[3]); }
            __builtin_amdgcn_sched_barrier(0);
        }
#pragma unroll
        for (int hh = 0; hh < 8; ++hh) f[hh] = wave_sum(f[hh]);
        if (lane < 8) { float fl = f[0];
#pragma unroll
            for (int hh = 1; hh < 8; ++hh) fl = (lane == hh) ? f[hh] : fl;
            const int b = row >> 12, s = row & 4095;
            ((float*)(ws + WS_LOGF))[(size_t)(b * 8 + lane) * SEQ + s] = log_sigmoid_f(fl + b_forget[lane]); }
    }
    LAS float* scr = (LAS float*)(lds + wave * 8448);
    constexpr int I_IN = (DM / 64) * (NPROJ / 32), I_O = (DM / 64) * (DM / 32);
    for (int it = gw; it < 2 * I_O; it += NGW) {
        int r = it;
        if (r < I_O) { p0_transpose_item(w_out, DM, DM, (bf16_t*)(ws + WS_WOUT), DM / 32, scr, r, lane, nullptr); continue; } r -= I_O;
        p0_transpose_item(w_pq, DM, DM, (bf16_t*)(ws + WS_WPQ), DM / 32, scr, r, lane, g_ffn);
    }
    for (int i = gt; i < 8 * 2 * 128 * 128 / 8; i += NGT) { const f32x4 a0 = *(const f32x4*)(sk + (size_t)i * 8), a1 = *(const f32x4*)(sk + (size_t)i * 8 + 4);
        u32x4 w; w.x = cvt_pk_bf16(a0[0], a0[1]); w.y = cvt_pk_bf16(a0[2], a0[3]); w.z = cvt_pk_bf16(a1[0], a1[1]); w.w = cvt_pk_bf16(a1[2], a1[3]);
        *(u32x4*)(ws + WS_SK + (size_t)i * 16) = w; }
    if (gt < 256) ((float*)(ws + WS_GQK))[gt] = gt < 128 ? a.in[4][gt] : a.in[5][gt - 128];
    convert_tables(a, 0, TAB_SPLIT, gw, NGW);
    { XcdBarrier xb_; xb_.bar = (unsigned*)(ws + WS_CTL) + CW_BAR; xb_.x = xb_xcc_id(); xb_.st = (volatile LAS unsigned*)(lds + MISC_OFF) + 8; xcd_barrier(xb_); }
    const float wmax = __uint_as_float(__hip_atomic_load((unsigned*)(ws + WS_CTL) + CW_WMAX, __ATOMIC_RELAXED, __HIP_MEMORY_SCOPE_AGENT));
    if (gt == 0) *(float*)(ws + WS_WSC) = wmax * (1.f / 127.f);
    const float q8 = wmax > 0.f ? 127.f / wmax : 1.f;
    for (int it = gw; it < I_IN; it += NGW) p0_transpose_item_i8(w_in, DIN, DM, ws + WS_WIN, NPROJ / 32, scr, it, lane, q8);
}

__device__ __forceinline__ void cumsum_rows(const Args& a) {
    const int tid = tid_opaque(), lane = tid & 63, wave = tid >> 6;
    const int rowi = (int)gridDim.x - 1 - (int)blockIdx.x;
    if (rowi >= 16 || rowi < 0 || wave != 0) return;
    const float* src = (const float*)(a.ws + WS_LOGF) + (size_t)rowi * SEQ + lane * 64;
    float* dst = (float*)(a.ws + WS_C) + (size_t)rowi * SEQ + lane * 64;
    f32x4 v[16]; float run = 0.f;
#pragma unroll
    for (int i = 0; i < 16; ++i) { v[i] = *(const f32x4*)(src + 4 * i);
#pragma unroll
        for (int q = 0; q < 4; ++q) { run += v[i][q]; v[i][q] = run; } }
    float incl = run;
#pragma unroll
    for (int o = 1; o < 64; o <<= 1) { const float t = shup_f(incl, o); if (lane >= o) incl += t; }
    const float off = incl - run;
#pragma unroll
    for (int i = 0; i < 16; ++i) { f32x4 w = v[i]; w[0] += off; w[1] += off; w[2] += off; w[3] += off; *(f32x4*)(dst + 4 * i) = w; }
}

__device__ __forceinline__ void phase_qknorm(const Args& a) {
    const int tid = tid_opaque(), lane = tid & 63, wave = tid >> 6;
    const int gw = blockIdx.x * NWAVES + wave, NGW = gridDim.x * NWAVES;
    const int sub = lane & 15, rw = lane >> 4;
    const float* gq = a.in[4]; const float* gk = a.in[5];
    constexpr int ROWS = NB * NHF * SEQ;
    for (int it = gw; it < 2 * ROWS / 4; it += NGW) {
        const int row = it * 4 + rw; const bool isk = row >= ROWS;
        bf16_t* p = (bf16_t*)(a.ws + WS_SEC) + (size_t)row * HD + sub * 8;
        const float* g = (isk ? gk : gq) + sub * 8;
        const u32x4 w = *(const u32x4*)p;
        float v[8] = {bf_lo(w.x), bf_hi(w.x), bf_lo(w.y), bf_hi(w.y), bf_lo(w.z), bf_hi(w.z), bf_lo(w.w), bf_hi(w.w)};
        float ss = 0.f;
#pragma unroll
        for (int i = 0; i < 8; ++i) ss += v[i] * v[i];
        ss += sx_f(ss, 1); ss += sx_f(ss, 2); ss += sx_f(ss, 4); ss += sx_f(ss, 8);
        const float r = 1.0f / sqrtf(ss * (1.f / HD) + EPS);
        const f32x4 g0 = *(const f32x4*)g, g1 = *(const f32x4*)(g + 4);
        u32x4 o; o.x = cvt_pk_bf16(v[0] * r * g0[0], v[1] * r * g0[1]); o.y = cvt_pk_bf16(v[2] * r * g0[2], v[3] * r * g0[3]);
        o.z = cvt_pk_bf16(v[4] * r * g1[0], v[5] * r * g1[1]); o.w = cvt_pk_bf16(v[6] * r * g1[2], v[7] * r * g1[3]);
        *(u32x4*)p = o;
    }
}

__device__ __forceinline__ void phase_attn(const Args& a, unsigned char* lds_g) {
    const int tid = tid_opaque();
    volatile int* s_item = (volatile int*)(lds_g + MISC_OFF);
    unsigned* ctr = (unsigned*)(a.ws + WS_CTL);
    for (;;) {
        __syncthreads();
        if (tid == 0) *s_item = (int)atomicAdd(ctr, 1u);
        __syncthreads();
        int it = *s_item, kind = -1, qb = 0, sub = 0;
#define CLS(K, Q, CNT) if (kind < 0) { if (it < (CNT)) { kind = (K); qb = (Q); sub = it; } else it -= (CNT); }
        CLS(2, 15, 32) CLS(1, 7, 16) CLS(2, 14, 32) CLS(2, 13, 32) CLS(1, 6, 16) CLS(2, 12, 32) CLS(2, 11, 32) CLS(1, 5, 16) CLS(2, 10, 32) CLS(2, 9, 32) CLS(1, 4, 16) CLS(2, 8, 32) CLS(1, 3, 16) CLS(1, 2, 16)
        if (kind < 0) { if (it < 256) { kind = 0; qb = 15 - (it >> 4); sub = it & 15; } else it -= 256; }
        CLS(1, 1, 16) CLS(1, 0, 16)
#undef CLS
        if (kind < 0) break;
        unsigned char* wsl = a.ws; asm volatile("" : "+s"(wsl));
        bf16_t* sec = (bf16_t*)(wsl + WS_SEC);
        const int bh = sub & 15, part = (kind == 2) ? 1 + (sub >> 4) : 0;
        const int b = bh >> 3, h = bh & 7;
        const size_t hoff = (size_t)bh * SEQ * HD;
        att::UnitRef u;
        u.P0 = qb * 256;
        if (kind == 0) {
            u.Q = sec + 4 * SEC_ELEMS + hoff + (size_t)u.P0 * HD; u.K = sec + 5 * SEC_ELEMS + hoff; u.V = sec + 6 * SEC_ELEMS + hoff;
            att::sb_unit(u, (bf16_t*)(wsl + WS_MIX) + (size_t)b * SEQ * DM + 1024 + h * HD, (char*)lds_g);
        } else {
            u.Q = sec + 0 * SEC_ELEMS + hoff + (size_t)u.P0 * HD; u.K = sec + 1 * SEC_ELEMS + hoff; u.V = sec + 2 * SEC_ELEMS + hoff;
            att::attn_unit<false>(u, wsl, bh, (char*)lds_g, part);
        }
    }
}
__device__ __forceinline__ void phase_attn_combine(const Args& a) {
    const int gt = blockIdx.x * NTHREADS + tid_opaque(), NGT = gridDim.x * NTHREADS;
    const float* po = (const float*)(a.ws + WS_PO); const float* pml = (const float*)(a.ws + WS_PML);
    const bf16_t* gate = (const bf16_t*)(a.ws + WS_SEC) + 3 * SEC_ELEMS; bf16_t* mix = (bf16_t*)(a.ws + WS_MIX);
    constexpr float C2 = LOG2E * SCALE;
    for (int item = gt; item < 128 * 256 * 16; item += NGT) {
        const int slot = item >> 12, row = (item >> 4) & 255, cg = item & 15;
        const int qb = 8 + (slot >> 4), bh = slot & 15, b = bh >> 3, h = bh & 7;
        const f32x2 ml1 = *(const f32x2*)(pml + (size_t)(slot * 2) * 512 + row * 2), ml2 = *(const f32x2*)(pml + (size_t)(slot * 2 + 1) * 512 + row * 2);
        const float M = fmaxf(ml1.x, ml2.x), a1 = __builtin_amdgcn_exp2f((ml1.x - M) * C2), a2 = __builtin_amdgcn_exp2f((ml2.x - M) * C2);
        const float inv = 1.f / (a1 * ml1.y + a2 * ml2.y);
        const float* p1 = po + (size_t)(slot * 2) * 32768 + row * 128 + cg * 8; const float* p2 = p1 + 32768;
        const f32x4 x0 = *(const f32x4*)p1, x1 = *(const f32x4*)(p1 + 4), y0 = *(const f32x4*)p2, y1 = *(const f32x4*)(p2 + 4);
        const size_t tok = (size_t)b * SEQ + qb * 256 + row;
        const u32x4 gw = *(const u32x4*)(gate + tok * 1024 + h * HD + cg * 8);
        const float w1 = a1 * inv, w2 = a2 * inv;
        u32x4 o;
        o.x = cvt_pk_bf16((w1 * x0[0] + w2 * y0[0]) * bf_lo(gw.x), (w1 * x0[1] + w2 * y0[1]) * bf_hi(gw.x));
        o.y = cvt_pk_bf16((w1 * x0[2] + w2 * y0[2]) * bf_lo(gw.y), (w1 * x0[3] + w2 * y0[3]) * bf_hi(gw.y));
        o.z = cvt_pk_bf16((w1 * x1[0] + w2 * y1[0]) * bf_lo(gw.z), (w1 * x1[1] + w2 * y1[1]) * bf_hi(gw.z));
        o.w = cvt_pk_bf16((w1 * x1[2] + w2 * y1[2]) * bf_lo(gw.w), (w1 * x1[3] + w2 * y1[3]) * bf_hi(gw.w));
        *(u32x4*)(mix + tok * DM + h * HD + cg * 8) = o;
    }
}

__device__ __forceinline__ unsigned f2ord(float f) { const unsigned u = __float_as_uint(f); return u ^ ((unsigned)((int)u >> 31) | 0x80000000u); }
__device__ __forceinline__ float ord2f(unsigned k) { const unsigned u = k ^ (~(unsigned)((int)k >> 31) | 0x80000000u); return __uint_as_float(u); }
#define INS16(L, X) do { unsigned x_ = (X); _Pragma("unroll") for (int i_ = 0; i_ < 16; ++i_) { const unsigned hi_ = max(L[i_], x_); x_ = min(L[i_], x_); L[i_] = hi_; } } while (0)
__device__ __forceinline__ void sort16_desc(unsigned (&a)[16]) {
#pragma unroll
    for (int k = 2; k <= 16; k <<= 1)
#pragma unroll
        for (int j = k >> 1; j > 0; j >>= 1)
#pragma unroll
            for (int i = 0; i < 16; ++i) { const int l = i ^ j; if (l > i) { const unsigned hi_ = max(a[i], a[l]), lo_ = min(a[i], a[l]); const bool desc = (i & k) == 0; a[i] = desc ? hi_ : lo_; a[l] = desc ? lo_ : hi_; } }
}
__device__ __forceinline__ void merge_top16(unsigned (&a)[16], const unsigned (&b)[16]) {
#pragma unroll
    for (int i = 0; i < 16; ++i) a[i] = max(a[i], b[15 - i]);
#pragma unroll
    for (int j = 8; j > 0; j >>= 1)
#pragma unroll
        for (int i = 0; i < 16; ++i) { const int l = i ^ j; if (l > i) { const unsigned hi_ = max(a[i], a[l]), lo_ = min(a[i], a[l]); a[i] = hi_; a[l] = lo_; } }
}
__device__ __forceinline__ void topk_half(const bf16_t* qrow  , const bf16_t* skb, int h, int c, int r32, int hi, unsigned (&L)[16]) {
    bf16x8 qf[8];
#pragma unroll
    for (int d0 = 0; d0 < 8; ++d0) qf[d0] = *(const bf16x8*)(qrow + c * 128 + d0 * 16 + hi * 8);
    const unsigned hi4 = 4u * (unsigned)hi;
#pragma unroll
    for (int kt = 0; kt < 4; ++kt) {
        f32x16 acc = f32x16{};
#pragma unroll
        for (int d0 = 0; d0 < 8; ++d0) { const bf16x8 kf = *(const bf16x8*)(skb + (size_t)((h * 2 + c) * 128 + kt * 32 + r32) * 128 + d0 * 16 + hi * 8);
            acc = __builtin_amdgcn_mfma_f32_32x32x16_bf16(kf, qf[d0], acc, 0, 0, 0); }
        unsigned G[16];
#pragma unroll
        for (int r = 0; r < 16; ++r) { const unsigned cst = (unsigned)(127 - (kt * 32 + (r & 3) + 8 * (r >> 2))); G[r] = (f2ord(acc[r]) & ~127u) | (cst - hi4); }
        sort16_desc(G);
        if (kt == 0) {
#pragma unroll
            for (int i = 0; i < 16; ++i) L[i] = G[i];
        } else merge_top16(L, G);
    }
    unsigned P[16];
#pragma unroll
    for (int i = 0; i < 16; ++i) { auto rr = __builtin_amdgcn_permlane32_swap(L[i], L[i], false, false); P[i] = hi ? rr[0] : rr[1]; }
    merge_top16(L, P);
}
__device__ __forceinline__ void topk_task(unsigned char* ws, const bf16_t* qrow, LAS int* tb, int t0, int h, int lane) {
    const int r32 = lane & 31, hi = lane >> 5;
    const bf16_t* skb = (const bf16_t*)(ws + WS_SK);
    int* idx_o = (int*)(ws + WS_IDX); float* gw_o = (float*)(ws + WS_GW);
    float rt_l;
    { const f32x4* sp = (const f32x4*)((const float*)(ws + WS_SSQ) + (size_t)(t0 + (lane & 31)) * 32); float tot = 0.f;
#pragma unroll
      for (int i = 0; i < 8; ++i) { const f32x4 v = sp[i]; tot += (v[0] + v[1]) + (v[2] + v[3]); }
      rt_l = 1.0f / sqrtf(tot * (1.f / DM) + EPS); }
        {
          const bf16_t* hbp = (const bf16_t*)(ws + WS_HB); const float* amx = (const float*)(ws + WS_AMX); unsigned char* xq = ws + WS_XQ;
          float am = 0.f;
          { const f32x4* ap = (const f32x4*)(amx + (size_t)(t0 + (lane & 31)) * 32);
#pragma unroll
            for (int i = 0; i < 8; ++i) { const f32x4 v = ap[i]; am = fmaxf(am, fmaxf(fmaxf(v[0], v[1]), fmaxf(v[2], v[3]))); } }
          if (h == 0 && lane < 32) ((float*)(ws + WS_SX))[t0 + lane] = rt_l * am * (1.f / 126.5f);
          const float qs = am > 0.f ? 126.5f / am : 1.f;
          u32x4 wv[16];
#pragma unroll
          for (int j = 0; j < 16; ++j) { const int ch = lane + 64 * j; wv[j] = *(const u32x4*)(hbp + (size_t)(t0 + (ch >> 5)) * DM + h * 256 + (ch & 31) * 8); }
#pragma unroll
          for (int j = 0; j < 16; ++j) { const int ch = lane + 64 * j, tl = ch >> 5, tk = t0 + tl, col = h * 256 + (ch & 31) * 8;
              const u32x4 w = wv[j]; const float r = sh_f(qs, tl);
              const int p0 = pack_i8(bf_lo(w.x) * r, bf_hi(w.x) * r, bf_lo(w.y) * r, bf_hi(w.y) * r), p1 = pack_i8(bf_lo(w.z) * r, bf_hi(w.z) * r, bf_lo(w.w) * r, bf_hi(w.w) * r);
              *(u32x2*)(xq + (size_t)tk * DM + col) = (u32x2){(unsigned)p0, (unsigned)p1}; } }
        unsigned L[2][16];
        topk_half(qrow, skb, h, 0, r32, hi, L[0]);
        __builtin_amdgcn_sched_barrier(0);
        topk_half(qrow, skb, h, 1, r32, hi, L[1]);
        __builtin_amdgcn_sched_barrier(0);
        float s1[16], s2[16]; int i1[16], i2[16];
#pragma unroll
        for (int i = 0; i < 16; ++i) { s1[i] = ord2f((L[0][i] & ~127u) | 64u); i1[i] = 127 - (int)(L[0][i] & 127u); s2[i] = ord2f((L[1][i] & ~127u) | 64u); i2[i] = 127 - (int)(L[1][i] & 127u); }
        unsigned CG[4][16];
#pragma unroll
        for (int i = 0; i < 64; ++i) CG[i >> 4][i & 15] = 0u;
        CG[0][0] = (f2ord(s1[0] + s2[0]) & ~255u) | 0u;
        CG[0][1] = (f2ord(s1[0] + s2[1]) & ~255u) | 1u;
        CG[0][2] = (f2ord(s1[0] + s2[2]) & ~255u) | 2u;
        CG[0][3] = (f2ord(s1[0] + s2[3]) & ~255u) | 3u;
        CG[0][4] = (f2ord(s1[0] + s2[4]) & ~255u) | 4u;
        CG[0][5] = (f2ord(s1[0] + s2[5]) & ~255u) | 5u;
        CG[0][6] = (f2ord(s1[0] + s2[6]) & ~255u) | 6u;
        CG[0][7] = (f2ord(s1[0] + s2[7]) & ~255u) | 7u;
        CG[0][8] = (f2ord(s1[0] + s2[8]) & ~255u) | 8u;
        CG[0][9] = (f2ord(s1[0] + s2[9]) & ~255u) | 9u;
        CG[0][10] = (f2ord(s1[0] + s2[10]) & ~255u) | 10u;
        CG[0][11] = (f2ord(s1[0] + s2[11]) & ~255u) | 11u;
        CG[0][12] = (f2ord(s1[0] + s2[12]) & ~255u) | 12u;
        CG[0][13] = (f2ord(s1[0] + s2[13]) & ~255u) | 13u;
        CG[0][14] = (f2ord(s1[0] + s2[14]) & ~255u) | 14u;
        CG[0][15] = (f2ord(s1[0] + s2[15]) & ~255u) | 15u;
        CG[1][0] = (f2ord(s1[1] + s2[0]) & ~255u) | 16u;
        CG[1][1] = (f2ord(s1[1] + s2[1]) & ~255u) | 17u;
        CG[1][2] = (f2ord(s1[1] + s2[2]) & ~255u) | 18u;
        CG[1][3] = (f2ord(s1[1] + s2[3]) & ~255u) | 19u;
        CG[1][4] = (f2ord(s1[1] + s2[4]) & ~255u) | 20u;
        CG[1][5] = (f2ord(s1[1] + s2[5]) & ~255u) | 21u;
        CG[1][6] = (f2ord(s1[1] + s2[6]) & ~255u) | 22u;
        CG[1][7] = (f2ord(s1[1] + s2[7]) & ~255u) | 23u;
        CG[1][8] = (f2ord(s1[2] + s2[0]) & ~255u) | 32u;
        CG[1][9] = (f2ord(s1[2] + s2[1]) & ~255u) | 33u;
        CG[1][10] = (f2ord(s1[2] + s2[2]) & ~255u) | 34u;
        CG[1][11] = (f2ord(s1[2] + s2[3]) & ~255u) | 35u;
        CG[1][12] = (f2ord(s1[2] + s2[4]) & ~255u) | 36u;
        CG[1][13] = (f2ord(s1[3] + s2[0]) & ~255u) | 48u;
        CG[1][14] = (f2ord(s1[3] + s2[1]) & ~255u) | 49u;
        CG[1][15] = (f2ord(s1[3] + s2[2]) & ~255u) | 50u;
        CG[2][0] = (f2ord(s1[3] + s2[3]) & ~255u) | 51u;
        CG[2][1] = (f2ord(s1[4] + s2[0]) & ~255u) | 64u;
        CG[2][2] = (f2ord(s1[4] + s2[1]) & ~255u) | 65u;
        CG[2][3] = (f2ord(s1[4] + s2[2]) & ~255u) | 66u;
        CG[2][4] = (f2ord(s1[5] + s2[0]) & ~255u) | 80u;
        CG[2][5] = (f2ord(s1[5] + s2[1]) & ~255u) | 81u;
        CG[2][6] = (f2ord(s1[6] + s2[0]) & ~255u) | 96u;
        CG[2][7] = (f2ord(s1[6] + s2[1]) & ~255u) | 97u;
        CG[2][8] = (f2ord(s1[7] + s2[0]) & ~255u) | 112u;
        CG[2][9] = (f2ord(s1[7] + s2[1]) & ~255u) | 113u;
        CG[2][10] = (f2ord(s1[8] + s2[0]) & ~255u) | 128u;
        CG[2][11] = (f2ord(s1[9] + s2[0]) & ~255u) | 144u;
        CG[2][12] = (f2ord(s1[10] + s2[0]) & ~255u) | 160u;
        CG[2][13] = (f2ord(s1[11] + s2[0]) & ~255u) | 176u;
        CG[2][14] = (f2ord(s1[12] + s2[0]) & ~255u) | 192u;
        CG[2][15] = (f2ord(s1[13] + s2[0]) & ~255u) | 208u;
        CG[3][0] = (f2ord(s1[14] + s2[0]) & ~255u) | 224u;
        CG[3][1] = (f2ord(s1[15] + s2[0]) & ~255u) | 240u;
        sort16_desc(CG[0]); sort16_desc(CG[1]); sort16_desc(CG[2]); sort16_desc(CG[3]);
        merge_top16(CG[0], CG[1]); merge_top16(CG[2], CG[3]); merge_top16(CG[0], CG[2]);
        unsigned LC[16];
#pragma unroll
        for (int i = 0; i < 16; ++i) LC[i] = CG[0][i];
#pragma unroll
        for (int i = 0; i < 16; ++i) { tb[i * 64 + lane] = i1[i]; tb[(16 + i) * 64 + lane] = i2[i]; }
        float LS[16]; int LP[16];
#pragma unroll
        for (int i = 0; i < 16; ++i) { const unsigned cid = LC[i] & 255u; LS[i] = ord2f((LC[i] & ~255u) | 128u);
            LP[i] = tb[(cid >> 4) * 64 + lane] * 128 + tb[(16 + (cid & 15u)) * 64 + lane]; }
        float den = 0.f, e[16];
#pragma unroll
        for (int i = 0; i < 16; ++i) { e[i] = __expf(LS[i] - LS[0]); den += e[i]; }
        const float rden = 1.f / den;
        const size_t ob = (size_t)(t0 + r32) * NE + h * 16;
        if (hi == 0) {
#pragma unroll
            for (int i = 0; i < 4; ++i) *(int4*)(idx_o + ob + 4 * i) = make_int4(LP[4 * i], LP[4 * i + 1], LP[4 * i + 2], LP[4 * i + 3]);
            { unsigned short* i16 = (unsigned short*)(ws + WS_IDX16) + ob;
#pragma unroll
              for (int i = 0; i < 2; ++i) *(u32x4*)(i16 + 8 * i) = (u32x4){(unsigned)LP[8 * i] | ((unsigned)LP[8 * i + 1] << 16), (unsigned)LP[8 * i + 2] | ((unsigned)LP[8 * i + 3] << 16),
                                                                        (unsigned)LP[8 * i + 4] | ((unsigned)LP[8 * i + 5] << 16), (unsigned)LP[8 * i + 6] | ((unsigned)LP[8 * i + 7] << 16)}; }
        } else {
#pragma unroll
            for (int i = 0; i < 4; ++i) *(f32x4*)(gw_o + ob + 4 * i) = (f32x4){e[4 * i] * rden, e[4 * i + 1] * rden, e[4 * i + 2] * rden, e[4 * i + 3] * rden};
        }
}
__device__ __forceinline__ void phase_topk(const Args& a, unsigned char* lds_g) {
    LAS unsigned char* lds = (LAS unsigned char*)lds_g;
    const int tid = tid_opaque(), lane = tid & 63, wave = tid >> 6;
    const int gw = blockIdx.x * NWAVES + wave, NGW = gridDim.x * NWAVES;
    const bf16_t* qp = (const bf16_t*)(a.ws + WS_QP);
    for (int task = gw; task < (T / 32) * 8; task += NGW) {
        const int h = task & 7, t0 = (task >> 3) * 32;
        topk_task(a.ws, qp + (size_t)(t0 + (lane & 31)) * DM + h * 256, (LAS int*)(lds + wave * 8192), t0, h, lane);
    }
}
__device__ __forceinline__ void pg8::EpiPeerQFused::fused(const f32x4 (&acc)[2][2][4][2], const Unit& u, int wr, int wc, int fr, int fq, PG8_LAS unsigned char* lds) const {
    constexpr int ROWB = 528;
#pragma unroll
    for (int ai = 0; ai < 2; ++ai)
#pragma unroll
        for (int m = 0; m < 4; ++m) {
            const int tr = ai * HALF + wr * 64 + m * 16 + fr, tk = u.pm * BM + tr;
            float tot = 0.f;
#pragma unroll
            for (int i = 0; i < 8; ++i) { const f32x4 s4 = *(const f32x4*)(ssq + (size_t)tk * 32 + 4 * i); tot += (s4[0] + s4[1]) + (s4[2] + s4[3]); }
            const float r = 1.0f / sqrtf(tot * (1.f / DM) + EPS);
#pragma unroll
            for (int bj = 0; bj < 2; ++bj) {
                const f32x4 v0 = acc[ai][bj][m][0] * r, v1 = acc[ai][bj][m][1] * r;
                u32x4 w; w.x = cvt_pk_bf16(v0[0], v0[1]); w.y = cvt_pk_bf16(v0[2], v0[3]); w.z = cvt_pk_bf16(v1[0], v1[1]); w.w = cvt_pk_bf16(v1[2], v1[3]);
                *(PG8_LAS u32x4*)(lds + tr * ROWB + (bj * HALF + wc * 32 + 8 * fq) * 2) = w;
            }
        }
    __syncthreads();
    const int tid = tid_opaque(), lane = tid & 63, wave = tid >> 6;
    PG8_LAS unsigned char* myrows = lds + (wave * 32) * ROWB;
    topk_task(wsb, (const bf16_t*)(const void*)(myrows + (lane & 31) * ROWB), (LAS int*)myrows, u.pm * BM + wave * 32, u.pn, lane);
}
__device__ __forceinline__ void wave_argmax(float& v, int& i) {
#pragma unroll
    for (int o = 1; o < 64; o <<= 1) { const float ov = sx_f(v, o); const int oi = sx_i(i, o); if (ov > v || (ov == v && oi < i)) { v = ov; i = oi; } }
}
__device__ __forceinline__ void phase_topk_ref(const Args& a) {
    const int tid = tid_opaque(), lane = tid & 63, wave = tid >> 6;
    const int gw = blockIdx.x * NWAVES + wave, NGW = gridDim.x * NWAVES;
    const bf16_t* skb = (const bf16_t*)(a.ws + WS_SK); const bf16_t* qp = (const bf16_t*)(a.ws + WS_QP);
    int* idx_o = (int*)(a.ws + WS_IDX); float* gw_o = (float*)(a.ws + WS_GW);
    for (int task = gw; task < T * 8; task += NGW) {
        const int t = task >> 3, h = task & 7;
        float topS[2]; int topI[2];
        for (int c = 0; c < 2; ++c) {
            const bf16_t* q = qp + (size_t)t * DM + h * 256 + c * 128;
            float sc0 = 0.f, sc1 = 0.f;
            const bf16_t* k0 = skb + (size_t)((h * 2 + c) * 128 + lane) * 128; const bf16_t* k1 = k0 + 64 * 128;
            for (int d = 0; d < 128; ++d) { const float qd = __uint_as_float((unsigned)q[d] << 16);
                sc0 += qd * __uint_as_float((unsigned)k0[d] << 16); sc1 += qd * __uint_as_float((unsigned)k1[d] << 16); }
            float ms = 0.f; int mi = 0;
            for (int r = 0; r < 16; ++r) {
                float v; int i; if (sc0 >= sc1) { v = sc0; i = lane; } else { v = sc1; i = lane + 64; }
                wave_argmax(v, i);
                if (lane == r) { ms = v; mi = i; }
                if (i == lane) sc0 = -__builtin_inff();
                if (i == lane + 64) sc1 = -__builtin_inff();
            }
            topS[c] = ms; topI[c] = mi;
        }
        float cs[4]; int ci[4];
#pragma unroll
        for (int j = 0; j < 4; ++j) { const int cidx = lane * 4 + j, aa = cidx >> 4, bb = cidx & 15;
            cs[j] = sh_f(topS[0], aa) + sh_f(topS[1], bb); ci[j] = cidx; }
        float fs = 0.f; int fi = 0;
        for (int r = 0; r < 16; ++r) {
            float v = cs[0]; int i = ci[0];
#pragma unroll
            for (int j = 1; j < 4; ++j) if (cs[j] > v) { v = cs[j]; i = ci[j]; }
            wave_argmax(v, i);
            if (lane == r) { fs = v; fi = i; }
#pragma unroll
            for (int j = 0; j < 4; ++j) if (ci[j] == i) cs[j] = -__builtin_inff();
        }
        const int e1 = sh_i(topI[0], fi >> 4), e2 = sh_i(topI[1], fi & 15);
        const float mx = sh_f(fs, 0);
        float ev = lane < 16 ? __expf(fs - mx) : 0.f;
        const float den = wave_sum(ev);
        if (lane < 16) { idx_o[(size_t)t * NE + h * 16 + lane] = e1 * 128 + e2; gw_o[(size_t)t * NE + h * 16 + lane] = ev / den; }
    }
}

__device__ __forceinline__ void fp8x16_to_f32(const u32x4 q, f32x2 (&o)[8]) {
    o[0] = __builtin_amdgcn_cvt_pk_f32_fp8((int)q.x, false); o[1] = __builtin_amdgcn_cvt_pk_f32_fp8((int)q.x, true);
    o[2] = __builtin_amdgcn_cvt_pk_f32_fp8((int)q.y, false); o[3] = __builtin_amdgcn_cvt_pk_f32_fp8((int)q.y, true);
    o[4] = __builtin_amdgcn_cvt_pk_f32_fp8((int)q.z, false); o[5] = __builtin_amdgcn_cvt_pk_f32_fp8((int)q.z, true);
    o[6] = __builtin_amdgcn_cvt_pk_f32_fp8((int)q.w, false); o[7] = __builtin_amdgcn_cvt_pk_f32_fp8((int)q.w, true);
}
#define HALVE(dst, srcv, n, bitmask) do { const bool up_ = (lane & (bitmask)) != 0; _Pragma("unroll") for (int i_ = 0; i_ < (n); ++i_) { \
        const float keep_ = up_ ? srcv[(n) + i_] : srcv[i_], send_ = up_ ? srcv[i_] : srcv[(n) + i_]; dst[i_] = keep_ + sx_f(send_, (bitmask)); } } while (0)
#define ITEM_T(n) (wv + ((n) % KT) * NWX)
#define ITEM_S(n) (xl + 8 * ((n) / KT))
#define LD_IDX(ID, n) do { const int4* ip_ = (const int4*)(idx_i + (size_t)ITEM_T(n) * NE + g * 16); _Pragma("unroll") for (int i_ = 0; i_ < 4; ++i_) ID[i_] = ip_[i_]; } while (0)
#define LD_ROWS(Q, ID, TAB, n) do { const unsigned char* b_ = (TAB) + (size_t)ITEM_S(n) * ((size_t)NEXP * 128) + c * 16; _Pragma("unroll") for (int i_ = 0; i_ < 4; ++i_) { \
        Q[4 * i_] = *(const u32x4*)(b_ + (size_t)ID[i_].x * 128); Q[4 * i_ + 1] = *(const u32x4*)(b_ + (size_t)ID[i_].y * 128); \
        Q[4 * i_ + 2] = *(const u32x4*)(b_ + (size_t)ID[i_].z * 128); Q[4 * i_ + 3] = *(const u32x4*)(b_ + (size_t)ID[i_].w * 128); } } while (0)
__device__ __forceinline__ int dpp_hmirror(int v) { return __builtin_amdgcn_update_dpp(0, v, 0x141, 0xf, 0xf, true); }
__device__ __forceinline__ int dpp_qxor2(int v) { return __builtin_amdgcn_update_dpp(0, v, 0x4E, 0xf, 0xf, true); }
__device__ __forceinline__ int dpp_qxor1(int v) { return __builtin_amdgcn_update_dpp(0, v, 0xB1, 0xf, 0xf, true); }
__device__ __forceinline__ void phase_peer_u(const Args& a) {
    const int tid = tid_opaque(), lane = tid & 63, wave = tid >> 6, g = lane >> 3, c = lane & 7;
    const int xl = blockIdx.x & 7, wv = (blockIdx.x >> 3) * NWAVES + wave, NWX = (gridDim.x >> 3) * NWAVES, KT = T / NWX, N = 2 * KT;
    const unsigned char* xq = a.ws + WS_XQ; const unsigned char* u8 = a.ws + WS_U8;
    const unsigned short* idx16 = (const unsigned short*)(a.ws + WS_IDX16); bf16_t* part = (bf16_t*)(a.ws + WS_PART);
    const bool up4 = (c & 4) != 0, up2 = (c & 2) != 0, up1 = (c & 1) != 0;
#define LD_I16(ID, n, h) do { ID = *(const u32x4*)(idx16 + (size_t)ITEM_T(n) * NE + g * 16 + (h) * 8); } while (0)
#define LD_R8(Q, ID, n) do { const unsigned char* b_ = u8 + (size_t)ITEM_S(n) * ((size_t)NEXP * 128) + c * 16; \
        Q[0] = *(const u32x4*)(b_ + (size_t)(ID.x & 0xffffu) * 128); Q[1] = *(const u32x4*)(b_ + (size_t)(ID.x >> 16) * 128); \
        Q[2] = *(const u32x4*)(b_ + (size_t)(ID.y & 0xffffu) * 128); Q[3] = *(const u32x4*)(b_ + (size_t)(ID.y >> 16) * 128); \
        Q[4] = *(const u32x4*)(b_ + (size_t)(ID.z & 0xffffu) * 128); Q[5] = *(const u32x4*)(b_ + (size_t)(ID.z >> 16) * 128); \
        Q[6] = *(const u32x4*)(b_ + (size_t)(ID.w & 0xffffu) * 128); Q[7] = *(const u32x4*)(b_ + (size_t)(ID.w >> 16) * 128); } while (0)
#define LD_X(X, n) do { X = *(const u32x4*)(xq + (size_t)ITEM_T(n) * DM + ITEM_S(n) * 128 + c * 16); } while (0)
#define DOT8(P, OFF, Q, X) do { _Pragma("unroll") for (int i = 0; i < 8; ++i) { int d_ = __builtin_amdgcn_sdot4((int)Q[i].x, (int)X.x, 0, false); d_ = __builtin_amdgcn_sdot4((int)Q[i].y, (int)X.y, d_, false); \
            d_ = __builtin_amdgcn_sdot4((int)Q[i].z, (int)X.z, d_, false); P[(OFF) + i] = __builtin_amdgcn_sdot4((int)Q[i].w, (int)X.w, d_, false); } } while (0)
#define FINISH_U(P, n) do { int p8[8], p4[4], p2[2]; \
        _Pragma("unroll") for (int i = 0; i < 8; ++i) { const int keep_ = up4 ? P[8 + i] : P[i], send_ = up4 ? P[i] : P[8 + i]; p8[i] = keep_ + dpp_hmirror(send_); } \
        _Pragma("unroll") for (int i = 0; i < 4; ++i) { const int keep_ = up2 ? p8[4 + i] : p8[i], send_ = up2 ? p8[i] : p8[4 + i]; p4[i] = keep_ + dpp_qxor2(send_); } \
        _Pragma("unroll") for (int i = 0; i < 2; ++i) { const int keep_ = up1 ? p4[2 + i] : p4[i], send_ = up1 ? p4[i] : p4[2 + i]; p2[i] = keep_ + dpp_qxor1(send_); } \
        *(unsigned*)(part + ((size_t)ITEM_T(n) * 16 + ITEM_S(n)) * NE + 2 * lane) = cvt_pk_bf16((float)p2[0], (float)p2[1]); } while (0)
    u32x4 IA, IB, IC, ID_, QA[8], QB[8], QC[8], QD[8], XA, XB;
    LD_I16(IA, 0, 0); LD_I16(IB, 0, 1); LD_I16(IC, 1, 0); LD_I16(ID_, 1, 1);
    LD_R8(QA, IA, 0); LD_R8(QB, IB, 0); LD_X(XA, 0); LD_R8(QC, IC, 1); LD_R8(QD, ID_, 1); LD_X(XB, 1);
    if (N > 2) { LD_I16(IA, 2, 0); LD_I16(IB, 2, 1); LD_I16(IC, 3, 0); LD_I16(ID_, 3, 1); }
    for (int n = 0; n < N; n += 2) {
        int p[16];
        DOT8(p, 0, QA, XA); if (n + 2 < N) { LD_R8(QA, IA, n + 2); if (n + 4 < N) LD_I16(IA, n + 4, 0); }
        DOT8(p, 8, QB, XA); if (n + 2 < N) { LD_R8(QB, IB, n + 2); LD_X(XA, n + 2); if (n + 4 < N) LD_I16(IB, n + 4, 1); }
        FINISH_U(p, n);
        int r[16];
        DOT8(r, 0, QC, XB); if (n + 3 < N) { LD_R8(QC, IC, n + 3); if (n + 5 < N) LD_I16(IC, n + 5, 0); }
        DOT8(r, 8, QD, XB); if (n + 3 < N) { LD_R8(QD, ID_, n + 3); LD_X(XB, n + 3); if (n + 5 < N) LD_I16(ID_, n + 5, 1); }
        FINISH_U(r, n + 1);
    }
#undef LD_I16
#undef LD_R8
#undef LD_X
#undef DOT8
#undef FINISH_U
}
__device__ __forceinline__ void phase_peer_w(const Args& a) {
    const int gt = blockIdx.x * NTHREADS + tid_opaque(), NGT = gridDim.x * NTHREADS;
    const int* idx_i = (const int*)(a.ws + WS_IDX); const float* gw_i = (const float*)(a.ws + WS_GW); const bf16_t* part = (const bf16_t*)(a.ws + WS_PART);
    const float* suv = (const float*)(a.ws + WS_SUV); const float* sx = (const float*)(a.ws + WS_SX);
    unsigned char* wq = a.ws + WS_WQ; float* sw = (float*)(a.ws + WS_SW);
    for (int item = gt; item < T * NE / 2; item += NGT) {
        const int t = item >> 6, e = (item & 63) * 2;
        unsigned pw[16];
#pragma unroll
        for (int s = 0; s < 16; ++s) pw[s] = *(const unsigned*)(part + ((size_t)t * 16 + s) * NE + e);
        float sum0 = 0.f, sum1 = 0.f;
#pragma unroll
        for (int s = 0; s < 16; ++s) { sum0 += bf_lo(pw[s]); sum1 += bf_hi(pw[s]); }
        const int2 ex = *(const int2*)(idx_i + (size_t)t * NE + e); const f32x2 gg = *(const f32x2*)(gw_i + (size_t)t * NE + e);
        const float sxt = sx[t];
        const float d0 = sum0 * suv[ex.x] * sxt, d1 = sum1 * suv[ex.y] * sxt;
        const float om0 = 0.5f * d0 * (1.f + erff(d0 * 0.70710678118654752f)) * gg.x * suv[NEXP + ex.x];
        const float om1 = 0.5f * d1 * (1.f + erff(d1 * 0.70710678118654752f)) * gg.y * suv[NEXP + ex.y];
        float mx = fmaxf(fabsf(om0), fabsf(om1));
        mx = fmaxf(mx, sx_f(mx, 1)); mx = fmaxf(mx, sx_f(mx, 2)); mx = fmaxf(mx, sx_f(mx, 4));
        const float qs = mx > 0.f ? 127.f / mx : 1.f;
        const int q0 = (int)__builtin_rintf(om0 * qs), q1 = (int)__builtin_rintf(om1 * qs);
        *(unsigned short*)(wq + (size_t)t * NE + e) = (unsigned short)(((unsigned)q0 & 0xffu) | (((unsigned)q1 & 0xffu) << 8));
        if ((e & 15) == 0) sw[t * 8 + (e >> 4)] = mx * (1.f / 127.f);
    }
}
__device__ __forceinline__ void phase_peer_v(const Args& a, float* dst) {
    const int tid = tid_opaque(), lane = tid & 63, wave = tid >> 6, g = lane >> 3, c = lane & 7;
    const int xl = blockIdx.x & 7, wv = (blockIdx.x >> 3) * NWAVES + wave, NWX = (gridDim.x >> 3) * NWAVES, KT = T / NWX, N = 2 * KT;
    const unsigned char* v8 = a.ws + WS_V8;
    const int* idx_i = (const int*)(a.ws + WS_IDX); const unsigned char* wq = a.ws + WS_WQ; const float* sw = (const float*)(a.ws + WS_SW);
    const bf16_t* hsrc = (const bf16_t*)(a.ws + WS_HB);
#define LD_W(W, SWV, HV, n) do { W = *(const u32x4*)(wq + (size_t)ITEM_T(n) * NE + g * 16); SWV = sw[ITEM_T(n) * 8 + g]; HV = *(const unsigned*)(hsrc + (size_t)ITEM_T(n) * DM + ITEM_S(n) * 128 + 2 * lane); } while (0)
#define QUAD(A_, B_, C_, D_, W_, A0, A1, A2, A3) do { \
        const unsigned ablo_ = __builtin_amdgcn_perm(B_, A_, 0x05010400u), abhi_ = __builtin_amdgcn_perm(B_, A_, 0x07030602u); \
        const unsigned cdlo_ = __builtin_amdgcn_perm(D_, C_, 0x05010400u), cdhi_ = __builtin_amdgcn_perm(D_, C_, 0x07030602u); \
        A0 = __builtin_amdgcn_sdot4((int)__builtin_amdgcn_perm(cdlo_, ablo_, 0x05040100u), (int)(W_), A0, false); \
        A1 = __builtin_amdgcn_sdot4((int)__builtin_amdgcn_perm(cdlo_, ablo_, 0x07060302u), (int)(W_), A1, false); \
        A2 = __builtin_amdgcn_sdot4((int)__builtin_amdgcn_perm(cdhi_, abhi_, 0x05040100u), (int)(W_), A2, false); \
        A3 = __builtin_amdgcn_sdot4((int)__builtin_amdgcn_perm(cdhi_, abhi_, 0x07060302u), (int)(W_), A3, false); } while (0)
#define COMPUTE_V(Q, W, SWV, HV, n) do { int ac[16]; _Pragma("unroll") for (int k = 0; k < 16; ++k) ac[k] = 0; \
        _Pragma("unroll") for (int q_ = 0; q_ < 4; ++q_) { const unsigned w_ = q_ == 0 ? W.x : q_ == 1 ? W.y : q_ == 2 ? W.z : W.w; \
            QUAD(Q[4 * q_].x, Q[4 * q_ + 1].x, Q[4 * q_ + 2].x, Q[4 * q_ + 3].x, w_, ac[0], ac[1], ac[2], ac[3]); \
            QUAD(Q[4 * q_].y, Q[4 * q_ + 1].y, Q[4 * q_ + 2].y, Q[4 * q_ + 3].y, w_, ac[4], ac[5], ac[6], ac[7]); \
            QUAD(Q[4 * q_].z, Q[4 * q_ + 1].z, Q[4 * q_ + 2].z, Q[4 * q_ + 3].z, w_, ac[8], ac[9], ac[10], ac[11]); \
            QUAD(Q[4 * q_].w, Q[4 * q_ + 1].w, Q[4 * q_ + 2].w, Q[4 * q_ + 3].w, w_, ac[12], ac[13], ac[14], ac[15]); } \
        float p[16]; _Pragma("unroll") for (int k = 0; k < 16; ++k) p[k] = (float)ac[k] * SWV; \
        float p8[8], p4[4], p2[2]; \
        _Pragma("unroll") for (int i_ = 0; i_ < 8; ++i_) { auto rr_ = __builtin_amdgcn_permlane32_swap(__float_as_uint(p[i_]), __float_as_uint(p[8 + i_]), false, false); p8[i_] = __uint_as_float(rr_[0]) + __uint_as_float(rr_[1]); } \
        _Pragma("unroll") for (int i_ = 0; i_ < 4; ++i_) { auto rr_ = __builtin_amdgcn_permlane16_swap(__float_as_uint(p8[i_]), __float_as_uint(p8[4 + i_]), false, false); p4[i_] = __uint_as_float(rr_[0]) + __uint_as_float(rr_[1]); } \
        HALVE(p2, p4, 2, 8); \
        const int srcl_ = ((lane & 7) << 3) | (lane >> 3);                     \
        const float q0_ = sh_f(p2[0], srcl_), q1_ = sh_f(p2[1], srcl_); \
        const size_t o_ = (size_t)ITEM_T(n) * DM + ITEM_S(n) * 128 + 2 * lane; \
        *(f32x2*)(dst + o_) = (f32x2){bf_lo(HV) + q0_, bf_hi(HV) + q1_}; } while (0)
    int4 IA[4], IB[4]; u32x4 QA[16], QB[16], WA, WB; float SA, SB_; unsigned HA, HB_;
    LD_IDX(IA, 0); LD_IDX(IB, 1);
    LD_ROWS(QA, IA, v8, 0); LD_W(WA, SA, HA, 0);
    for (int n = 0; n < N; n += 2) {
        LD_ROWS(QB, IB, v8, n + 1); LD_W(WB, SB_, HB_, n + 1);
        if (n + 2 < N) LD_IDX(IA, n + 2);
        COMPUTE_V(QA, WA, SA, HA, n);
        if (n + 2 < N) { LD_ROWS(QA, IA, v8, n + 2); LD_W(WA, SA, HA, n + 2); }
        if (n + 3 < N) LD_IDX(IB, n + 3);
        COMPUTE_V(QB, WB, SB_, HB_, n + 1);
    }
#undef LD_W
#undef QUAD
#undef COMPUTE_V
}
#undef ITEM_T
#undef ITEM_S
#undef LD_IDX
#undef LD_ROWS
#undef HALVE


constexpr int NPHASE = 11;
#define LOAD_ARGS() do { } while (0)
__global__ void __launch_bounds__(NTHREADS, 2) fwd_kernel(Args a) {
    extern __shared__ __attribute__((aligned(16))) unsigned char lds[];
#if MK_ONE_LAUNCH
    constexpr int lo = 0, hi = NPHASE;
    cg::grid_group grid = cg::this_grid();
    volatile LAS unsigned* misc = (volatile LAS unsigned*)((LAS unsigned char*)lds + MISC_OFF);
    if (threadIdx.x < 16) misc[threadIdx.x] = 0u;
    __syncthreads();
    { LOAD_ARGS(); (void)xcd_barrier_post((unsigned*)(a.ws + WS_CTL) + CW_BAR, misc + 8); }
#ifndef SEAM_CG_MASK
#define SEAM_CG_MASK 0
#endif
#define SEAM(k) do { if (lo <= (k) && (k) + 1 < hi) { if ((SEAM_CG_MASK >> (k)) & 1) grid.sync(); else { LOAD_ARGS(); XcdBarrier xb_; xb_.bar = (unsigned*)(a.ws + WS_CTL) + CW_BAR; xb_.x = xb_xcc_id(); \
        xb_.st = (volatile LAS unsigned*)((LAS unsigned char*)lds + MISC_OFF) + 8; xcd_barrier(xb_); } } } while (0)
#else
    int lo, hi; { LOAD_ARGS(); lo = a.ph_lo; hi = a.ph_hi; }
#define SEAM(k) do { } while (0)
#endif
#define IN(k) (lo <= (k) && (k) < hi)
#ifndef DUP_PHASE
#define DUP_PHASE -1
#endif
    if (IN(0)) { LOAD_ARGS(); phase0(a, lds); if (DUP_PHASE == 0) { __syncthreads(); phase0(a, lds); } SEAM(0); }
    if (IN(1)) { LOAD_ARGS(); unsigned char* ws = a.ws;
        pg8::Gemm g{(const bf16_t*)(ws + WS_XN), (const bf16_t*)(ws + WS_WIN), T, NPROJ, DM}; pg8::StaticOrder S; S.init(T, NPROJ, (int)gridDim.x, (int)blockIdx.x);
        pg8::EpiInProj E{(bf16_t*)(ws + WS_SEC), (const float*)(ws + WS_SXN), (const float*)(ws + WS_WSC), a.in[4], a.in[5], (LAS float*)((LAS unsigned char*)lds + RING_BYTES)};
        for (int rep_ = 0; rep_ < (DUP_PHASE == 1 ? 2 : 1); ++rep_)
        pg8::gemm_phase<pg8::EpiInProj, pg8::StaticOrder, true, true, true>((LAS unsigned char*)lds, g, S, E);
        cumsum_rows(a);
        { const int nwg_ = (T / 256) * (NPROJ / 256), G_ = (int)gridDim.x, rem_ = nwg_ % G_;
          if (rem_ > 0 && (int)blockIdx.x >= rem_) convert_tables(a, TAB_SPLIT, 2 * NEXP, ((int)blockIdx.x - rem_) * NWAVES + (tid_opaque() >> 6), (G_ - rem_) * NWAVES);
          else if (rem_ == 0) convert_tables(a, TAB_SPLIT, 2 * NEXP, (int)blockIdx.x * NWAVES + (tid_opaque() >> 6), G_ * NWAVES); }
        SEAM(1);
    }
    if (IN(3)) { LOAD_ARGS(); phase_attn(a, lds);
#if MK_ONE_LAUNCH
        if (DUP_PHASE == 3) { XcdBarrier xb_; xb_.bar = (unsigned*)(a.ws + WS_CTL) + CW_BAR; xb_.x = xb_xcc_id(); xb_.st = (volatile LAS unsigned*)((LAS unsigned char*)lds + MISC_OFF) + 8;
            xcd_barrier(xb_); if (blockIdx.x == 0 && threadIdx.x == 0) __hip_atomic_store((unsigned*)(a.ws + WS_CTL), 0u, __ATOMIC_RELAXED, __HIP_MEMORY_SCOPE_AGENT); xcd_barrier(xb_); phase_attn(a, lds); }
#endif
        SEAM(3); }
    if (IN(4)) { LOAD_ARGS(); phase_attn_combine(a); SEAM(4); }
    if (IN(5)) { LOAD_ARGS(); unsigned char* ws = a.ws;
        pg8::Gemm g{(const bf16_t*)(ws + WS_MIX), (const bf16_t*)(ws + WS_WOUT), T, DM, DM}; pg8::StaticOrder S; S.init(T, DM, (int)gridDim.x, (int)blockIdx.x);
        pg8::EpiOutProj E{a.in[0], a.out, (bf16_t*)(ws + WS_HB), (float*)(ws + WS_SSQ), (float*)(ws + WS_AMX)};
        for (int rep_ = 0; rep_ < (DUP_PHASE == 5 ? 2 : 1); ++rep_)
        pg8::gemm_phase<pg8::EpiOutProj, pg8::StaticOrder, true, true>((LAS unsigned char*)lds, g, S, E);
        SEAM(5);
    }
    if (IN(6)) { LOAD_ARGS(); unsigned char* ws = a.ws;
        pg8::Gemm g{(const bf16_t*)(ws + WS_HB), (const bf16_t*)(ws + WS_WPQ), T, DM, DM}; pg8::StaticOrder S; S.init(T, DM, (int)gridDim.x, (int)blockIdx.x);
        pg8::EpiPeerQFused E{(const float*)(ws + WS_SSQ), ws};
        pg8::gemm_phase<pg8::EpiPeerQFused, pg8::StaticOrder, true, true>((LAS unsigned char*)lds, g, S, E);
        SEAM(6);
    }
    if (IN(8)) { LOAD_ARGS(); for (int rep_ = 0; rep_ < (DUP_PHASE == 8 ? 2 : 1); ++rep_) phase_peer_u(a); SEAM(8); }
    if (IN(9)) { LOAD_ARGS(); for (int rep_ = 0; rep_ < (DUP_PHASE == 9 ? 2 : 1); ++rep_) phase_peer_w(a); SEAM(9); }
    if (IN(10)) { LOAD_ARGS(); for (int rep_ = 0; rep_ < (DUP_PHASE == 10 ? 2 : 1); ++rep_) phase_peer_v(a, (DUP_PHASE == 10 && rep_ == 0) ? (float*)(a.ws + WS_END) : a.out); }
#undef IN
#undef SEAM
}

extern "C" void kernel_launch(void* const* d_in, const int* in_sizes, int n_in, void* d_out, int out_size, void* d_ws, size_t ws_size, hipStream_t stream) {
    static int grid = 0;
    if (grid == 0) {
        if (n_in != 12 || in_sizes[0] != T * DM || out_size != T * DM || ws_size < WS_END) { fprintf(stderr, "kernel_launch: unexpected shapes (n_in %d, in0 %d, out %d, ws %zu)\n", n_in, n_in > 0 ? in_sizes[0] : -1, out_size, ws_size); grid = -1; return; }
        int dev = 0, cus = 0, per_cu = 0;
        if (hipGetDevice(&dev) != hipSuccess || hipDeviceGetAttribute(&cus, hipDeviceAttributeMultiprocessorCount, dev) != hipSuccess) { grid = -1; return; }
        if (hipFuncSetAttribute((const void*)fwd_kernel, hipFuncAttributeMaxDynamicSharedMemorySize, LDS_BYTES) != hipSuccess) { fprintf(stderr, "kernel_launch: hipFuncSetAttribute failed\n"); grid = -1; return; }
        if (hipOccupancyMaxActiveBlocksPerMultiprocessor(&per_cu, (const void*)fwd_kernel, NTHREADS, LDS_BYTES) != hipSuccess || per_cu < 1) { fprintf(stderr, "kernel_launch: occupancy query says %d\n", per_cu); grid = -1; return; }
        grid = cus;
    }
    if (grid < 0) return;
    (void)hipMemsetAsync((char*)d_ws + WS_CTL, 0, CTL_BYTES, stream);
    Args a{};
    for (int i = 0; i < 12; ++i) a.in[i] = (const float*)d_in[i];
    a.out = (float*)d_out; a.ws = (unsigned char*)d_ws;
#if MK_ONE_LAUNCH
    a.ph_lo = 0; a.ph_hi = NPHASE;
    void* args[] = {&a};
#if MK_COOP_LAUNCH
    hipError_t e = hipLaunchCooperativeKernel((const void*)fwd_kernel, dim3(grid), dim3(NTHREADS), args, LDS_BYTES, stream);
    if (e != hipSuccess) fprintf(stderr, "cooperative launch failed: %s (grid %d)\n", hipGetErrorString(e), grid);
#else
    (void)args; hipLaunchKernelGGL(fwd_kernel, dim3(grid), dim3(NTHREADS), LDS_BYTES, stream, a);
#endif
#else
    for (int p = 0; p < NPHASE; ++p) { a.ph_lo = p; a.ph_hi = p + 1; hipLaunchKernelGGL(fwd_kernel, dim3(grid), dim3(NTHREADS), LDS_BYTES, stream, a); }
#endif
}
```

```cpp
#include <hip/hip_runtime.h>
#include <hip/hip_cooperative_groups.h>
#include <cstdio>
#include <cstdint>
namespace cg = cooperative_groups;

#ifndef MK_COOP_LAUNCH
#define MK_COOP_LAUNCH 0
#endif
#ifndef MK_ONE_LAUNCH
#define MK_ONE_LAUNCH 1
#endif

#define LAS __attribute__((address_space(3)))
typedef unsigned short bf16_t;
typedef short bf16x8 __attribute__((ext_vector_type(8)));
typedef short s16x4 __attribute__((ext_vector_type(4)));
typedef float f32x2 __attribute__((ext_vector_type(2)));
typedef float f32x4 __attribute__((ext_vector_type(4)));
typedef float f32x16 __attribute__((ext_vector_type(16)));
typedef unsigned u32x2 __attribute__((ext_vector_type(2)));
typedef unsigned u32x4 __attribute__((ext_vector_type(4)));
typedef __bf16 bf16x2_t __attribute__((ext_vector_type(2)));

constexpr int NB = 2, SEQ = 4096, T = NB * SEQ, DM = 2048, HD = 128, NHF = 8, DIN = 7176, NPROJ = 7168;
constexpr int NEXP = 16384, NE = 128;
constexpr float EPS = 1e-6f;
constexpr float SCALE = 0.08838834764831845f, LOG2E = 1.4426950408889634f;
constexpr int NWAVES = 8, NTHREADS = 512;

constexpr size_t MiB = 1u << 20;
constexpr size_t WS_CTL = 0, CTL_BYTES = 32768;
constexpr int CW_BAR = 1024;
constexpr size_t WS_SXN = 64 * MiB  , WS_WSC = 45 * MiB + 800 * 1024  ;
constexpr int CW_WMAX = 64;
constexpr size_t WS_GQK = 45 * MiB + 768 * 1024;
constexpr size_t WS_WIN = 1 * MiB, WS_WOUT = 29 * MiB, WS_WPQ = 37 * MiB, WS_SK = 45 * MiB, WS_LOGF = 46 * MiB, WS_C = 46 * MiB + 512 * 1024, WS_SSQ = 47 * MiB;
constexpr size_t WS_XN = 48 * MiB;
constexpr size_t WS_SEC = 80 * MiB;
constexpr size_t SEC_ELEMS = 8u << 20;
constexpr size_t WS_MIX = 192 * MiB, WS_HB = 224 * MiB, WS_QP = 256 * MiB, WS_IDX = 288 * MiB, WS_GW = 292 * MiB, WS_U8 = 296 * MiB, WS_V8 = 328 * MiB, WS_SUV = 360 * MiB  , WS_RT = 360 * MiB + 256 * 1024  , WS_W = 361 * MiB  ,
                 WS_PART = 368 * MiB  , WS_XQ = 432 * MiB  , WS_END = 448 * MiB;
constexpr size_t WS_IDX16 = 366 * MiB  ;
constexpr size_t WS_AMX = 365 * MiB  , WS_SX = WS_RT + 64 * 1024  , WS_WQ = WS_W  , WS_SW = WS_W + 2 * MiB  ;
constexpr size_t WS_PO = WS_PART  , WS_PML = WS_PART + 32 * MiB  ;

constexpr int RING_BYTES = 131072;
constexpr int MISC_OFF = 143360;
constexpr int LDS_BYTES = 147456;

__device__ __forceinline__ unsigned cvt_pk_bf16(float lo, float hi) { unsigned r; asm volatile("v_cvt_pk_bf16_f32 %0, %1, %2" : "=v"(r) : "v"(lo), "v"(hi)); return r; }
__device__ __forceinline__ float bf_lo(unsigned u) { return __builtin_bit_cast(float, u << 16); }
__device__ __forceinline__ float bf_hi(unsigned u) { return __builtin_bit_cast(float, u & 0xffff0000u); }
__device__ __forceinline__ int lane_id_fresh() { int l = (int)__builtin_amdgcn_mbcnt_hi(~0u, __builtin_amdgcn_mbcnt_lo(~0u, 0u)); asm volatile("" : "+v"(l)); return l; }
__device__ __forceinline__ int sx_i(int v, int m) { return __builtin_amdgcn_ds_bpermute((lane_id_fresh() ^ m) << 2, v); }
__device__ __forceinline__ float sx_f(float v, int m) { return __int_as_float(__builtin_amdgcn_ds_bpermute((lane_id_fresh() ^ m) << 2, __float_as_int(v))); }
__device__ __forceinline__ int sh_i(int v, int src) { return __builtin_amdgcn_ds_bpermute(src << 2, v); }
__device__ __forceinline__ float sh_f(float v, int src) { return __int_as_float(__builtin_amdgcn_ds_bpermute(src << 2, __float_as_int(v))); }
__device__ __forceinline__ float shup_f(float v, int d) { const int l = lane_id_fresh(); const int s = l - d; return __int_as_float(__builtin_amdgcn_ds_bpermute((s < 0 ? l : s) << 2, __float_as_int(v))); }
__device__ __forceinline__ float wave_sum(float v) {
    v += __int_as_float(__builtin_amdgcn_update_dpp(0, __float_as_int(v), 0xB1, 0xf, 0xf, true));
    v += __int_as_float(__builtin_amdgcn_update_dpp(0, __float_as_int(v), 0x4E, 0xf, 0xf, true));
    v += __int_as_float(__builtin_amdgcn_update_dpp(0, __float_as_int(v), 0x141, 0xf, 0xf, true));
    v += __int_as_float(__builtin_amdgcn_update_dpp(0, __float_as_int(v), 0x140, 0xf, 0xf, true));
    { auto rr = __builtin_amdgcn_permlane16_swap(__float_as_uint(v), __float_as_uint(v), false, false); v = __uint_as_float(rr[0]) + __uint_as_float(rr[1]); }
    { auto rr = __builtin_amdgcn_permlane32_swap(__float_as_uint(v), __float_as_uint(v), false, false); v = __uint_as_float(rr[0]) + __uint_as_float(rr[1]); }
    return v;
}
#define DPP_QX1 0xB1
#define DPP_QX2 0x4E
#define DPP_HMIR 0x141
#define DPP_MIR 0x140
__device__ __forceinline__ float wave_max(float v) {
    v = fmaxf(v, __int_as_float(__builtin_amdgcn_update_dpp(0, __float_as_int(v), DPP_QX1, 0xf, 0xf, true)));
    v = fmaxf(v, __int_as_float(__builtin_amdgcn_update_dpp(0, __float_as_int(v), DPP_QX2, 0xf, 0xf, true)));
    v = fmaxf(v, __int_as_float(__builtin_amdgcn_update_dpp(0, __float_as_int(v), DPP_HMIR, 0xf, 0xf, true)));
    v = fmaxf(v, __int_as_float(__builtin_amdgcn_update_dpp(0, __float_as_int(v), DPP_MIR, 0xf, 0xf, true)));
    { auto rr = __builtin_amdgcn_permlane16_swap(__float_as_uint(v), __float_as_uint(v), false, false); v = fmaxf(__uint_as_float(rr[0]), __uint_as_float(rr[1])); }
    { auto rr = __builtin_amdgcn_permlane32_swap(__float_as_uint(v), __float_as_uint(v), false, false); v = fmaxf(__uint_as_float(rr[0]), __uint_as_float(rr[1])); }
    return v;
}
__device__ __forceinline__ int tid_opaque() { int t = (int)threadIdx.x; asm volatile("" : "+v"(t)); return t; }
#define LDS_WAIT() asm volatile("s_waitcnt lgkmcnt(0)" ::: "memory")

namespace pg8 {
#define PG8_LAS __attribute__((address_space(3)))
constexpr int BM = 256, BK = 64, HALF = 128, HTB = HALF * BK * 2, STAGE_BYTES = 8 * HTB, NXCD = 8, WGM = 8;
__host__ __device__ __forceinline__ int lds_byte(int r, int c) { const int st = (r >> 4) * 2 + (c >> 5), rr = r & 15, cc = c & 31, ob = rr * 64 + cc * 2; return st * 1024 + (ob ^ (((ob >> 9) & 1) << 5)); }
__host__ __device__ __forceinline__ void stage_rc(int b, int& R, int& C) { const int st = b / 1024, sb = b % 1024, swz = sb ^ (((sb >> 9) & 1) << 5); R = (st >> 1) * 16 + swz / 64; C = (st & 1) * 32 + (swz % 64) / 2; }
__host__ __device__ __forceinline__ int perm32(int rho) { const int n = rho >> 4, i = rho & 15; return 8 * (i >> 2) + 4 * n + (i & 3); }
struct Unit { int pm, pn; };
struct Gemm { const bf16_t* A; const bf16_t* Bt; int M, N, K; };
struct StaticOrder {
    int nM, nN, nwg, G, c;
    __host__ __device__ void init(int M, int N, int G_, int c_) { nM = M / BM; nN = N / BM; nwg = nM * nN; G = G_; c = c_; }
    __host__ __device__ bool next(int i, Unit& u) const {
        const long L = (long)i * G + c; if (L >= nwg) return false;
        int wgid = (int)L; { const int q = nwg / NXCD, r = nwg % NXCD, xcd = wgid % NXCD, off = wgid / NXCD; wgid = (xcd < r ? xcd * (q + 1) : r * (q + 1) + (xcd - r) * q) + off; }
        const int nig = WGM * nN, gid = wgid / nig, fm = gid * WGM, gsz = (nM - fm) < WGM ? (nM - fm) : WGM;
        u.pm = fm + ((wgid % nig) % gsz); u.pn = (wgid % nig) / gsz; return true;
    }
    __device__ __forceinline__ void a_ready(const Unit&) const {}
    __device__ __forceinline__ void done(const Unit&) const {}
};

typedef int i32x4 __attribute__((ext_vector_type(4)));
template <bool I8> struct AccT { typedef f32x4 type; };
template <> struct AccT<true> { typedef i32x4 type; };
template <class Epi, class Sched, bool ALIGN_EPI = false, bool SP2 = false, bool I8 = false>
__device__ __forceinline__ void gemm_phase(PG8_LAS unsigned char* lds, const Gemm g, const Sched& S, const Epi& E) {
    typedef typename AccT<I8>::type acc_t;
    const int tid = tid_opaque(), wid = __builtin_amdgcn_readfirstlane(tid >> 6), lane = tid & 63, wr = wid >> 2, wc = wid & 3, fr = lane & 15, fq = lane >> 4;
    const int rowb = I8 ? g.K : 2 * g.K, nt = rowb / (BK * 2);
    unsigned voffA[2], voffB[2];
#pragma unroll
    for (int i = 0; i < 2; ++i) { int R, C; stage_rc(tid * 16 + i * 8192, R, C); const int Rb = Epi::PERM ? ((R & ~31) + perm32(R & 31)) : R;
        voffA[i] = (unsigned)(R * rowb + C * 2); voffB[i] = (unsigned)(Rb * rowb + C * 2); }
    const size_t kstep = (size_t)(BK * 2);
    const size_t hstep = (size_t)HALF * rowb;
    const size_t tstep = 2 * hstep;
    const unsigned ldsw = (unsigned)wid * 1024u;
    const int aoff = lds_byte(wr * 64 + fr, fq * 8), boff = lds_byte(wc * 32 + fr, fq * 8);
#define PG8_SA(b, h) (((b) * 2 + (h)) * HTB)
#define PG8_SB(b, h) ((4 + (b) * 2 + (h)) * HTB)
#define PG8_STAGE(bufoff, gbase, voff) do { _Pragma("unroll") for (int _i = 0; _i < 2; ++_i) \
        __builtin_amdgcn_global_load_lds((const unsigned*)((const char*)(gbase) + (voff)[_i]), (PG8_LAS unsigned*)(lds + (bufoff) + ldsw + _i * 8192), 16, 0, 0); } while (0)
#define PG8_LDA(dst, b, h) do { _Pragma("unroll") for (int m = 0; m < 4; ++m) _Pragma("unroll") for (int k = 0; k < 2; ++k) dst[m][k] = *(const PG8_LAS bf16x8*)(lds + PG8_SA(b, h) + aoff + m * 2048 + k * 1024); } while (0)
#define PG8_LDB(dst, b, h) do { _Pragma("unroll") for (int n = 0; n < 2; ++n) _Pragma("unroll") for (int k = 0; k < 2; ++k) dst[n][k] = *(const PG8_LAS bf16x8*)(lds + PG8_SB(b, h) + boff + n * 2048 + k * 1024); } while (0)
#define PG8_MMA(ai, bj, At, Bt) do { __builtin_amdgcn_s_setprio(1); _Pragma("unroll") for (int m = 0; m < 4; ++m) _Pragma("unroll") for (int n = 0; n < 2; ++n) _Pragma("unroll") for (int k = 0; k < 2; ++k) \
        { if constexpr (I8) acc[ai][bj][m][n] = __builtin_amdgcn_mfma_i32_16x16x64_i8(__builtin_bit_cast(i32x4, Bt[n][k]), __builtin_bit_cast(i32x4, At[m][k]), acc[ai][bj][m][n], 0, 0, 0); \
          else acc[ai][bj][m][n] = __builtin_amdgcn_mfma_f32_16x16x32_bf16(Bt[n][k], At[m][k], acc[ai][bj][m][n], 0, 0, 0); } __builtin_amdgcn_s_setprio(0); } while (0)
#define PG8_WAIT_V(n) asm volatile("s_waitcnt vmcnt(" #n ")" ::: "memory")
#define PG8_WAIT_L(n) asm volatile("s_waitcnt lgkmcnt(" #n ")" ::: "memory")
#define PG8_BAR __builtin_amdgcn_s_barrier()
#define PG8_SCHED __builtin_amdgcn_sched_barrier(0)
    Unit cur, nxt; int ui = 0;
    if (!S.next(0, cur)) return;
    acc_t acc[2][2][4][2];
#pragma unroll
    for (int a = 0; a < 2; ++a)
#pragma unroll
        for (int b = 0; b < 2; ++b)
#pragma unroll
            for (int m = 0; m < 4; ++m)
#pragma unroll
                for (int n = 0; n < 2; ++n) acc[a][b][m][n] = acc_t{};
    bf16x8 At[4][2], B0[2][2], B1[2][2];
    const char* cA = (const char*)g.A + (size_t)cur.pm * tstep; const char* cB = (const char*)g.Bt + (size_t)cur.pn * tstep;
    S.a_ready(cur);
    if constexpr (SP2) {
        PG8_STAGE(PG8_SB(0, 0), cB, voffB); PG8_STAGE(PG8_SB(0, 1), cB + hstep, voffB); PG8_STAGE(PG8_SA(0, 0), cA, voffA); PG8_STAGE(PG8_SA(0, 1), cA + hstep, voffA);
        if (wr == 1) PG8_BAR;
        PG8_WAIT_V(2); PG8_BAR;
        PG8_STAGE(PG8_SB(1, 0), cB + kstep, voffB); PG8_STAGE(PG8_SA(1, 0), cA + kstep, voffA); PG8_STAGE(PG8_SB(1, 1), cB + hstep + kstep, voffB);
        PG8_WAIT_V(6); PG8_BAR;
    } else {
        PG8_STAGE(PG8_SB(0, 0), cB, voffB); PG8_STAGE(PG8_SA(0, 0), cA, voffA); PG8_STAGE(PG8_SB(0, 1), cB + hstep, voffB); PG8_STAGE(PG8_SA(0, 1), cA + hstep, voffA);
        if (wr == 1) PG8_BAR;
        PG8_WAIT_V(4); PG8_BAR;
        PG8_STAGE(PG8_SB(1, 0), cB + kstep, voffB); PG8_STAGE(PG8_SA(1, 0), cA + kstep, voffA); PG8_STAGE(PG8_SB(1, 1), cB + hstep + kstep, voffB);
        PG8_WAIT_V(6); PG8_BAR;
    }
    for (;;) {
        const bool has_next = S.next(ui + 1, nxt);
        const char* nA = has_next ? (const char*)g.A + (size_t)nxt.pm * tstep : cA; const char* nB = has_next ? (const char*)g.Bt + (size_t)nxt.pn * tstep : cB;
        for (int t = 0; t < nt; t += 2) {
            const bool last = (t == nt - 2);
            const char* a1 = cA + (size_t)(t + 1) * kstep;
            const char* a2 = last ? nA : cA + (size_t)(t + 2) * kstep; const char* b2 = last ? nB : cB + (size_t)(t + 2) * kstep;
            const char* a3 = a2 + kstep; const char* b3 = b2 + kstep;
            if (last && has_next) S.a_ready(nxt);
            if constexpr (SP2) {
            PG8_LDB(B0, 0, 0); PG8_LDB(B1, 0, 1); PG8_SCHED; PG8_LDA(At, 0, 0); PG8_STAGE(PG8_SA(1, 1), a1 + hstep, voffA);
            PG8_WAIT_V(8); PG8_WAIT_L(0); PG8_BAR; PG8_MMA(0, 0, At, B0); PG8_MMA(0, 1, At, B1); PG8_BAR; PG8_SCHED;
            PG8_LDA(At, 0, 1); PG8_STAGE(PG8_SB(0, 0), b2, voffB); PG8_STAGE(PG8_SB(0, 1), b2 + hstep, voffB); PG8_STAGE(PG8_SA(0, 0), a2, voffA);
            PG8_WAIT_V(8); PG8_WAIT_L(0); PG8_BAR; PG8_MMA(1, 0, At, B0); PG8_MMA(1, 1, At, B1); PG8_BAR; PG8_SCHED;
            PG8_LDB(B0, 1, 0); PG8_LDB(B1, 1, 1); PG8_SCHED; PG8_LDA(At, 1, 0); PG8_STAGE(PG8_SA(0, 1), a2 + hstep, voffA);
            PG8_WAIT_V(8); PG8_WAIT_L(0); PG8_BAR; PG8_MMA(0, 0, At, B0); PG8_MMA(0, 1, At, B1); PG8_BAR; PG8_SCHED;
            PG8_LDA(At, 1, 1); PG8_STAGE(PG8_SB(1, 0), b3, voffB); PG8_STAGE(PG8_SB(1, 1), b3 + hstep, voffB); PG8_STAGE(PG8_SA(1, 0), a3, voffA);
            PG8_WAIT_V(8); PG8_WAIT_L(0); PG8_BAR; PG8_MMA(1, 0, At, B0); PG8_MMA(1, 1, At, B1); PG8_BAR; PG8_SCHED;
            } else {
            PG8_LDB(B0, 0, 0); PG8_SCHED; PG8_LDA(At, 0, 0); PG8_STAGE(PG8_SA(1, 1), a1 + hstep, voffA);
            PG8_WAIT_L(8); PG8_BAR; PG8_WAIT_L(0); PG8_MMA(0, 0, At, B0); PG8_BAR; PG8_SCHED;
            PG8_LDB(B1, 0, 1); PG8_STAGE(PG8_SB(0, 0), b2, voffB);
            PG8_BAR; PG8_WAIT_L(0); PG8_MMA(0, 1, At, B1); PG8_BAR;
            PG8_LDA(At, 0, 1); PG8_STAGE(PG8_SA(0, 0), a2, voffA);
            PG8_BAR; PG8_WAIT_L(0); PG8_MMA(1, 0, At, B0); PG8_BAR; PG8_SCHED;
            PG8_STAGE(PG8_SB(0, 1), b2 + hstep, voffB);
            PG8_WAIT_V(6); PG8_BAR; PG8_MMA(1, 1, At, B1); PG8_BAR;
            PG8_LDB(B0, 1, 0); PG8_SCHED; PG8_LDA(At, 1, 0); PG8_STAGE(PG8_SA(0, 1), a2 + hstep, voffA);
            PG8_WAIT_L(8); PG8_BAR; PG8_WAIT_L(0); PG8_MMA(0, 0, At, B0); PG8_BAR; PG8_SCHED;
            PG8_LDB(B1, 1, 1); PG8_STAGE(PG8_SB(1, 0), b3, voffB);
            PG8_BAR; PG8_WAIT_L(0); PG8_MMA(0, 1, At, B1); PG8_BAR;
            PG8_LDA(At, 1, 1); PG8_STAGE(PG8_SA(1, 0), a3, voffA);
            PG8_BAR; PG8_WAIT_L(0); PG8_MMA(1, 0, At, B0); PG8_BAR; PG8_SCHED;
            PG8_STAGE(PG8_SB(1, 1), b3 + hstep, voffB);
            PG8_WAIT_V(6); PG8_BAR; PG8_MMA(1, 1, At, B1); PG8_BAR;
            }
        }
        if constexpr (ALIGN_EPI) { if (wr == 0) PG8_BAR; }
        if constexpr (!Epi::AFTER_DRAIN) { E(acc, cur, wr, wc, fr, fq); } S.done(cur);
        if (!has_next) break;
#pragma unroll
        for (int a = 0; a < 2; ++a)
#pragma unroll
            for (int b = 0; b < 2; ++b)
#pragma unroll
                for (int m = 0; m < 4; ++m)
#pragma unroll
                    for (int n = 0; n < 2; ++n) acc[a][b][m][n] = acc_t{};
        cur = nxt; cA = nA; cB = nB; ++ui;
        if constexpr (ALIGN_EPI) { if (wr == 1) PG8_BAR; }
    }
    PG8_WAIT_V(0);
    if constexpr (!ALIGN_EPI) { if (wr == 0) PG8_BAR; }
    PG8_BAR;
    if constexpr (Epi::AFTER_DRAIN) E.fused(acc, cur, wr, wc, fr, fq, lds);
#undef PG8_SA
#undef PG8_SB
#undef PG8_STAGE
#undef PG8_LDA
#undef PG8_LDB
#undef PG8_MMA
#undef PG8_WAIT_V
#undef PG8_WAIT_L
#undef PG8_BAR
#undef PG8_SCHED
}

__device__ __forceinline__ float sigmoidf_fast(float x) { return __builtin_amdgcn_rcpf(1.f + __builtin_amdgcn_exp2f(-x * LOG2E)); }
struct EpiInProj {
    static constexpr bool PERM = true, AFTER_DRAIN = false;
    bf16_t* base; const float* sxn  ; const float* wsc  ;
    const float* gq; const float* gk; PG8_LAS float* xch  ;
    __device__ __forceinline__ void operator()(const i32x4 (&acci)[2][2][4][2], const Unit& u, int wr, int wc, int fr, int fq) const {
        const int sec = u.pn >> 2; const float wsv = *wsc;
        bf16_t* sb = base + (size_t)sec * SEC_ELEMS;
        const float sc = (sec == 4) ? SCALE * LOG2E : 1.f;
        if (sec < 2) {
#pragma unroll
            for (int ai = 0; ai < 2; ++ai)
#pragma unroll
                for (int m = 0; m < 4; ++m) {
                    const int tk = u.pm * BM + ai * HALF + wr * 64 + m * 16 + fr;
                    const float rs = sxn[tk] * wsv;
#pragma unroll
                    for (int bj = 0; bj < 2; ++bj) {
                        const f32x4 v0 = __builtin_convertvector(acci[ai][bj][m][0], f32x4) * rs, v1 = __builtin_convertvector(acci[ai][bj][m][1], f32x4) * rs;
                        float ss = v0[0] * v0[0] + v0[1] * v0[1] + v0[2] * v0[2] + v0[3] * v0[3] + v1[0] * v1[0] + v1[1] * v1[1] + v1[2] * v1[2] + v1[3] * v1[3];
                        ss += sx_f(ss, 16); ss += sx_f(ss, 32);
                        if (fq == 0) xch[(((((wr * 2 + ai) * 4 + m) * 16 + fr) * 2 + bj) * 4) + wc] = ss;
                    }
                }
            asm volatile("s_waitcnt lgkmcnt(0)" ::: "memory");
            __builtin_amdgcn_s_barrier();
            const float* gp = (sec == 0 ? gq : gk) + wc * 32 + 8 * fq;
            const f32x4 g0 = *(const f32x4*)gp, g1 = *(const f32x4*)(gp + 4);
#pragma unroll
            for (int ai = 0; ai < 2; ++ai)
#pragma unroll
                for (int m = 0; m < 4; ++m) {
                    const int tk = u.pm * BM + ai * HALF + wr * 64 + m * 16 + fr, b = tk >> 12, s = tk & 4095;
                    const float rs = sxn[tk] * wsv;
#pragma unroll
                    for (int bj = 0; bj < 2; ++bj) {
                        const int hh = (u.pn & 3) * 2 + bj;
                        const f32x4 p4 = *(const PG8_LAS f32x4*)(xch + (((((wr * 2 + ai) * 4 + m) * 16 + fr) * 2 + bj) * 4));
                        const float r = rs / sqrtf(((p4[0] + p4[1]) + (p4[2] + p4[3])) * (1.f / 128.f) + EPS);
                        const f32x4 v0 = __builtin_convertvector(acci[ai][bj][m][0], f32x4) * r * g0, v1 = __builtin_convertvector(acci[ai][bj][m][1], f32x4) * r * g1;
                        u32x4 w; w.x = cvt_pk_bf16(v0[0], v0[1]); w.y = cvt_pk_bf16(v0[2], v0[3]); w.z = cvt_pk_bf16(v1[0], v1[1]); w.w = cvt_pk_bf16(v1[2], v1[3]);
                        *(u32x4*)(sb + ((size_t)((b * 8 + hh) * 4096 + s)) * 128 + wc * 32 + 8 * fq) = w;
                    }
                }
            return;
        }
#pragma unroll
        for (int ai = 0; ai < 2; ++ai)
#pragma unroll
            for (int m = 0; m < 4; ++m) {
                const int tk = u.pm * BM + ai * HALF + wr * 64 + m * 16 + fr, b = tk >> 12, s = tk & 4095;
                const float rs = sxn[tk] * wsv;
#pragma unroll
                for (int bj = 0; bj < 2; ++bj) {
                    const int hh = (u.pn & 3) * 2 + bj;
                    f32x4 v0 = __builtin_convertvector(acci[ai][bj][m][0], f32x4) * rs, v1 = __builtin_convertvector(acci[ai][bj][m][1], f32x4) * rs;
                    bf16_t* dst;
                    if (sec == 3) {
#pragma unroll
                        for (int i = 0; i < 4; ++i) { v0[i] = sigmoidf_fast(v0[i]); v1[i] = sigmoidf_fast(v1[i]); }
                        dst = sb + (size_t)tk * 1024 + hh * 128 + wc * 32 + 8 * fq;
                    } else {
                        v0 = v0 * sc; v1 = v1 * sc;
                        dst = sb + ((size_t)((b * 8 + hh) * 4096 + s)) * 128 + wc * 32 + 8 * fq;
                    }
                    u32x4 w; w.x = cvt_pk_bf16(v0[0], v0[1]); w.y = cvt_pk_bf16(v0[2], v0[3]); w.z = cvt_pk_bf16(v1[0], v1[1]); w.w = cvt_pk_bf16(v1[2], v1[3]);
                    *(u32x4*)dst = w;
                }
            }
    }
};
struct EpiOutProj {
    static constexpr bool PERM = true, AFTER_DRAIN = false;
    const float* x; float* h; bf16_t* hb; float* ssq; float* amx;
    __device__ __forceinline__ void operator()(const f32x4 (&acc)[2][2][4][2], const Unit& u, int wr, int wc, int fr, int fq) const {
#pragma unroll
        for (int ai = 0; ai < 2; ++ai)
#pragma unroll
            for (int m = 0; m < 4; ++m) {
                const int tk = u.pm * BM + ai * HALF + wr * 64 + m * 16 + fr;
                float ss = 0.f, mx = 0.f;
#pragma unroll
                for (int bj = 0; bj < 2; ++bj) {
                    const size_t off = (size_t)tk * DM + u.pn * BM + bj * HALF + wc * 32 + 8 * fq;
                    const f32x4 x0 = *(const f32x4*)(x + off), x1 = *(const f32x4*)(x + off + 4);
                    const f32x4 v0 = acc[ai][bj][m][0] + x0, v1 = acc[ai][bj][m][1] + x1;
                    u32x4 w; w.x = cvt_pk_bf16(v0[0], v0[1]); w.y = cvt_pk_bf16(v0[2], v0[3]); w.z = cvt_pk_bf16(v1[0], v1[1]); w.w = cvt_pk_bf16(v1[2], v1[3]);
                    *(u32x4*)(hb + off) = w;
                    ss += v0[0] * v0[0] + v0[1] * v0[1] + v0[2] * v0[2] + v0[3] * v0[3] + v1[0] * v1[0] + v1[1] * v1[1] + v1[2] * v1[2] + v1[3] * v1[3];
                    mx = fmaxf(mx, fmaxf(fmaxf(fmaxf(fabsf(v0[0]), fabsf(v0[1])), fmaxf(fabsf(v0[2]), fabsf(v0[3]))), fmaxf(fmaxf(fabsf(v1[0]), fabsf(v1[1])), fmaxf(fabsf(v1[2]), fabsf(v1[3])))));
                }
                ss += sx_f(ss, 16); ss += sx_f(ss, 32);
                mx = fmaxf(mx, sx_f(mx, 16)); mx = fmaxf(mx, sx_f(mx, 32));
                if (fq == 0) { ssq[(size_t)tk * 32 + u.pn * 4 + wc] = ss; amx[(size_t)tk * 32 + u.pn * 4 + wc] = mx; }
            }
    }
};
struct EpiPeerQ {
    static constexpr bool PERM = true, AFTER_DRAIN = false;
    const float* ssq; bf16_t* qp; float* rtab;
    __device__ __forceinline__ void operator()(const f32x4 (&acc)[2][2][4][2], const Unit& u, int wr, int wc, int fr, int fq) const {
#pragma unroll
        for (int ai = 0; ai < 2; ++ai)
#pragma unroll
            for (int m = 0; m < 4; ++m) {
                const int tk = u.pm * BM + ai * HALF + wr * 64 + m * 16 + fr;
                float tot = 0.f;
#pragma unroll
                for (int i = 0; i < 8; ++i) { const f32x4 s4 = *(const f32x4*)(ssq + (size_t)tk * 32 + 4 * i); tot += (s4[0] + s4[1]) + (s4[2] + s4[3]); }
                const float r = 1.0f / sqrtf(tot * (1.f / DM) + EPS);
                if (u.pn == 0 && wc == 0 && fq == 0) rtab[tk] = r;
#pragma unroll
                for (int bj = 0; bj < 2; ++bj) {
                    const size_t off = (size_t)tk * DM + u.pn * BM + bj * HALF + wc * 32 + 8 * fq;
                    const f32x4 v0 = acc[ai][bj][m][0] * r, v1 = acc[ai][bj][m][1] * r;
                    u32x4 w; w.x = cvt_pk_bf16(v0[0], v0[1]); w.y = cvt_pk_bf16(v0[2], v0[3]); w.z = cvt_pk_bf16(v1[0], v1[1]); w.w = cvt_pk_bf16(v1[2], v1[3]);
                    *(u32x4*)(qp + off) = w;
                }
            }
    }
};
struct EpiPeerQFused {
    static constexpr bool PERM = true, AFTER_DRAIN = true;
    const float* ssq; unsigned char* wsb;
    __device__ __forceinline__ void operator()(const f32x4 (&)[2][2][4][2], const Unit&, int, int, int, int) const {}
    __device__ __forceinline__ void fused(const f32x4 (&acc)[2][2][4][2], const Unit& u, int wr, int wc, int fr, int fq, PG8_LAS unsigned char* lds) const;
};
}

namespace att {
constexpr int NW = 8, QBLK = 32, KVBLK = 64, QB = NW * QBLK, D = 128;
constexpr int SHM_V = KVBLK * D * 2, SHM_K = KVBLK * D * 2;
constexpr int OFF_WS = 2 * SHM_V + 2 * SHM_K, OFF_BIAS = OFF_WS + NW * 64 * 4, ATT_LDS = OFF_BIAS + SEQ * 4;
#define KSWZ(row, colB) ((row) * 256 + ((colB) ^ (((row) & 7) << 4)))
#define SBAR() __builtin_amdgcn_sched_barrier(0)
__device__ __forceinline__ int v_st(int k, int c) { const int kk = (k & ~0xC) | ((k & 4) << 1) | ((k & 8) >> 1); return ((kk >> 3) * 4 + (c >> 5)) * 512 + ((kk & 7) * 32 + (c & 31)) * 2; }
__device__ __forceinline__ int v_rd_base(int lane) { return ((lane & 3) << 3) | (((lane >> 2) & 3) << 6) | (((lane >> 4) & 1) << 5) | (((lane >> 5) & 1) << 8); }
constexpr int v_rd_off(int d0, int ks, int half) { return d0 * 512 + ks * 4096 + half * 2048; }
__device__ __forceinline__ int crow(int r, int hi) { return (r & 3) + 8 * (r >> 2) + 4 * hi; }
__device__ __forceinline__ bf16x8 load8(const bf16_t* p) { return *reinterpret_cast<const bf16x8*>(p); }
__device__ __forceinline__ void mask_tile(f32x16& p0, f32x16& p1, int dq) {
    const float NEG = -__builtin_inff();
#pragma unroll
    for (int r = 0; r < 16; ++r) {
        const int c = (r & 3) + 8 * (r >> 2);
        if (dq - c < 0) p0[r] = NEG;
        if (dq - c - 32 < 0) p1[r] = NEG;
    }
}
__device__ __forceinline__ void partialSM(f32x16& p0, f32x16& p1, float& m_reg, float& mn, float& alpha) {
    float pmax = p0[0];
#pragma unroll
    for (int r = 1; r < 16; ++r) pmax = fmaxf(pmax, p0[r]);
#pragma unroll
    for (int r = 0; r < 16; ++r) pmax = fmaxf(pmax, p1[r]);
    { auto rr = __builtin_amdgcn_permlane32_swap(__float_as_uint(pmax), __float_as_uint(pmax), false, false);
      pmax = fmaxf(__uint_as_float(rr[0]), __uint_as_float(rr[1])); }
    constexpr float C2 = LOG2E * SCALE; constexpr float THR = 8.f;
    if (__builtin_expect(__all((pmax - m_reg) * SCALE <= THR), 1)) { mn = m_reg; alpha = 1.f; }
    else { mn = fmaxf(m_reg, pmax); alpha = __builtin_amdgcn_exp2f((m_reg - mn) * C2); m_reg = mn; }
    const float mnL = -mn * C2;
#pragma unroll
    for (int r = 0; r < 16; ++r) p0[r] = fmaf(p0[r], C2, mnL);
#pragma unroll
    for (int r = 0; r < 16; ++r) p1[r] = fmaf(p1[r], C2, mnL);
#pragma unroll
    for (int r = 0; r < 16; ++r) p0[r] = __builtin_amdgcn_exp2f(p0[r]);
}
#define PK4(P, B_, OUT) do { unsigned a0 = cvt_pk_bf16(P[B_+0], P[B_+1]), a1 = cvt_pk_bf16(P[B_+2], P[B_+3]);                          \
        unsigned b0 = cvt_pk_bf16(P[B_+4], P[B_+5]), b1 = cvt_pk_bf16(P[B_+6], P[B_+7]);                                             \
        auto r0 = __builtin_amdgcn_permlane32_swap(a0, b0, false, false); auto r1 = __builtin_amdgcn_permlane32_swap(a1, b1, false, false); \
        u32x4 w = {r0[0], r1[0], r0[1], r1[1]}; OUT = *reinterpret_cast<bf16x8*>(&w); } while (0)
__device__ __forceinline__ void finishSM(f32x16& p0, f32x16& p1, float alpha, float& l_reg, bf16x8& pa0, bf16x8& pa1, bf16x8& pa2, bf16x8& pa3) {
#pragma unroll
    for (int r = 0; r < 16; ++r) p1[r] = __builtin_amdgcn_exp2f(p1[r]);
    float ps = 0;
#pragma unroll
    for (int r = 0; r < 16; ++r) ps += p0[r];
#pragma unroll
    for (int r = 0; r < 16; ++r) ps += p1[r];
    { auto rr = __builtin_amdgcn_permlane32_swap(__float_as_uint(ps), __float_as_uint(ps), false, false);
      ps = __uint_as_float(rr[0]) + __uint_as_float(rr[1]); }
    l_reg = l_reg * alpha + ps;
    PK4(p0, 0, pa0); PK4(p0, 8, pa1); PK4(p1, 0, pa2); PK4(p1, 8, pa3);
}
__device__ __forceinline__ void sb_group(f32x16& P, int g, float& gs) {
    float run = 0.f;
#pragma unroll
    for (int k = 3; k >= 0; --k) {
        const float z = P[4 * g + k];
        const float t = __builtin_amdgcn_exp2f(-fabsf(z));
        const float l = __builtin_amdgcn_logf(1.f + t);
        const float sp = fmaxf(z, 0.f) + l;
        P[4 * g + k] = (z - sp) - run;
        run += sp;
    }
    gs = run;
}
__device__ __forceinline__ void sb_part1(f32x16& p0, f32x16& p1, float& carry, float mlo) {
    float gs[8];
#pragma unroll
    for (int g = 0; g < 4; ++g) sb_group(p0, g, gs[g]);
#pragma unroll
    for (int g = 0; g < 4; ++g) sb_group(p1, g, gs[4 + g]);
    float run = carry;
#pragma unroll
    for (int G = 7; G >= 0; --G) {
        auto rr = __builtin_amdgcn_permlane32_swap(__float_as_uint(gs[G]), __float_as_uint(gs[G]), false, false);
        const float slo = __uint_as_float(rr[0]), shi = __uint_as_float(rr[1]);
        const float base = fmaf(mlo, shi, run);
        if (G >= 4) {
#pragma unroll
            for (int k = 0; k < 4; ++k) p1[4 * (G - 4) + k] -= base;
        } else {
#pragma unroll
            for (int k = 0; k < 4; ++k) p0[4 * G + k] -= base;
        }
        run += slo + shi;
    }
    carry = run;
#pragma unroll
    for (int r = 0; r < 16; ++r) p0[r] = __builtin_amdgcn_exp2f(p0[r]);
}
__device__ __forceinline__ void sb_part2(f32x16& p0, f32x16& p1, bf16x8& pa0, bf16x8& pa1, bf16x8& pa2, bf16x8& pa3) {
#pragma unroll
    for (int r = 0; r < 16; ++r) p1[r] = __builtin_amdgcn_exp2f(p1[r]);
    PK4(p0, 0, pa0); PK4(p0, 8, pa1); PK4(p1, 0, pa2); PK4(p1, 8, pa3);
}
#undef PK4
template <int KB, bool BIAS>
__device__ __forceinline__ void qkt(f32x16& p0, f32x16& p1, const char* K_lds, int r32, int hi, const bf16x8* qr, const float* bt) {
    if constexpr (BIAS) {
#pragma unroll
        for (int g = 0; g < 4; ++g) { const f32x4 a = *(const f32x4*)(bt + 8 * g), b = *(const f32x4*)(bt + 32 + 8 * g);
            p0[4 * g] = a[0]; p0[4 * g + 1] = a[1]; p0[4 * g + 2] = a[2]; p0[4 * g + 3] = a[3];
            p1[4 * g] = b[0]; p1[4 * g + 1] = b[1]; p1[4 * g + 2] = b[2]; p1[4 * g + 3] = b[3]; }
    } else { p0 = f32x16{}; p1 = f32x16{}; }
    const char* kb[4];
#pragma unroll
    for (int dd = 0; dd < 4; ++dd) kb[dd] = K_lds + KB * SHM_K + KSWZ(r32, (dd * 16 + hi * 8) * 2);
#pragma unroll
    for (int d0 = 0; d0 < 8; ++d0) { const char* a = kb[d0 & 3] + (d0 >> 2) * 128;
        bf16x8 b0 = *reinterpret_cast<const bf16x8*>(a);
        bf16x8 b1 = *reinterpret_cast<const bf16x8*>(a + 32 * 256);
        p0 = __builtin_amdgcn_mfma_f32_32x32x16_bf16(b0, qr[d0], p0, 0, 0, 0);
        p1 = __builtin_amdgcn_mfma_f32_32x32x16_bf16(b1, qr[d0], p1, 0, 0, 0); }
}
template <int VB>
__device__ __forceinline__ void pv_tile(f32x16* o, int vb0, bf16x8 pa0, bf16x8 pa1, bf16x8 pa2, bf16x8 pa3) {
#define TRRD(dst, off) asm volatile("ds_read_b64_tr_b16 %0, %1 offset:%2" : "=&v"(dst) : "v"(vb0), "i"(off) : "memory")
#define PV_D0(d0) do { { s16x4 l0, l1, h0, h1; constexpr int b_ = VB * SHM_V + v_rd_off(d0, 0, 0); \
        TRRD(l0, b_); TRRD(h0, b_ + 2048); TRRD(l1, b_ + 4096); TRRD(h1, b_ + 6144); \
        asm volatile("s_waitcnt lgkmcnt(0)" ::: "memory"); SBAR();   \
        o[d0] = __builtin_amdgcn_mfma_f32_32x32x16_bf16(pa0, (bf16x8){l0[0], l0[1], l0[2], l0[3], h0[0], h0[1], h0[2], h0[3]}, o[d0], 0, 0, 0);   \
        o[d0] = __builtin_amdgcn_mfma_f32_32x32x16_bf16(pa1, (bf16x8){l1[0], l1[1], l1[2], l1[3], h1[0], h1[1], h1[2], h1[3]}, o[d0], 0, 0, 0); }  \
      { s16x4 l2, l3, h2, h3; constexpr int b_ = VB * SHM_V + v_rd_off(d0, 0, 0); \
        TRRD(l2, b_ + 8192); TRRD(h2, b_ + 10240); TRRD(l3, b_ + 12288); TRRD(h3, b_ + 14336); \
        asm volatile("s_waitcnt lgkmcnt(0)" ::: "memory"); SBAR();   \
        o[d0] = __builtin_amdgcn_mfma_f32_32x32x16_bf16(pa2, (bf16x8){l2[0], l2[1], l2[2], l2[3], h2[0], h2[1], h2[2], h2[3]}, o[d0], 0, 0, 0);   \
        o[d0] = __builtin_amdgcn_mfma_f32_32x32x16_bf16(pa3, (bf16x8){l3[0], l3[1], l3[2], l3[3], h3[0], h3[1], h3[2], h3[3]}, o[d0], 0, 0, 0); } } while (0)
    PV_D0(0); PV_D0(1); PV_D0(2); PV_D0(3);
#undef PV_D0
#undef TRRD
}

struct UnitRef { const bf16_t* Q; const bf16_t* K; const bf16_t* V; int P0; };
struct Seam { bf16x8 qr[8]; bf16x8 st_v0, st_v1, st_k0, st_k1; };
#define ROW(p, k0, rr) ((p) + (size_t)((k0) + (rr)) * D + sc)
#define VMW() asm volatile("s_waitcnt vmcnt(0)" ::: "memory")
#define SLOAD_H(Kp, Vp, k0) do { S.st_v0 = load8(ROW(Vp, k0, sr)); S.st_v1 = load8(ROW(Vp, k0, 32 + sr));              \
                         S.st_k0 = load8(ROW(Kp, k0, sr)); S.st_k1 = load8(ROW(Kp, k0, 32 + sr)); } while (0)
#define SWRITE_HK(bf) do { *(bf16x8*)(K_lds + (bf) * SHM_K + kws) = S.st_k0; *(bf16x8*)(K_lds + (bf) * SHM_K + kws + 32 * 256) = S.st_k1; } while (0)
#define SWRITE_HV(bf) do { *(bf16x8*)(V_lds + (bf) * SHM_V + vst0) = S.st_v0; *(bf16x8*)(V_lds + (bf) * SHM_V + vst1) = S.st_v1; } while (0)
#define SWRITE_H(bf) do { SWRITE_HV(bf); SWRITE_HK(bf); } while (0)

template <bool SB>
__device__ __forceinline__ void attn_unit(const UnitRef& cur, unsigned char* wsu  , int bh, char* lds,
                                          int part  ) {
    const float* cvec; const float* gqk;
    { unsigned char* w_ = wsu; asm volatile("" : "+s"(w_)); cvec = (const float*)(w_ + WS_C) + (size_t)bh * SEQ; gqk = (const float*)(w_ + WS_GQK); }
    const int tid = tid_opaque(), wid = __builtin_amdgcn_readfirstlane(tid >> 6), lane = tid & 63, r32 = lane & 31, hi = lane >> 5;
    int jlo = 0;
    if constexpr (!SB) {
        const float gq = fmaxf(fabsf(gqk[lane]), fabsf(gqk[64 + lane])), gk = fmaxf(fabsf(gqk[128 + lane]), fabsf(gqk[192 + lane]));
        const float lmax = 11.3137085f * 1.02f * wave_max(gq) * wave_max(gk);
        const int ntf = (cur.P0 + QB) / KVBLK;
        const float cend = (lane < ntf) ? cvec[lane * KVBLK + KVBLK - 1] : 0.f;
        const bool skip = (lane < ntf) && (2.f * lmax + cvec[cur.P0] - cend < -104.f);
        jlo = __builtin_amdgcn_readfirstlane((int)__popcll(__ballot(skip)));
    }
    const int ntot = (cur.P0 + QB) / KVBLK - jlo;
    const int tb = (part == 2) ? (ntot >> 1) : 0, te = (part == 1) ? (ntot >> 1) : ntot;
    const int kshift = (jlo + tb) * KVBLK, P0r = cur.P0 - kshift;
    const int NT = te - tb;
#define KBASE(t) ((NT - 1 - (t)) * KVBLK)
    const int qlo = P0r + wid * QBLK, qm = qlo + r32 - 4 * hi - (SB ? 1 : 0);
    char* V_lds = lds; char* K_lds = lds + 2 * SHM_V;
    float* ws = (float*)(lds + OFF_WS) + wid * 64; float* li_l = ws, * al_l = ws + 32;
    float* bias = (float*)(lds + OFF_BIAS);
    const int sr = tid >> 4, sc = (tid & 15) * 8, vst0 = v_st(sr, sc), vst1 = v_st(32 + sr, sc), kws = KSWZ(sr, sc * 2);
    const int vb0 = (int)(uintptr_t)V_lds + v_rd_base(lane);
    const bf16_t* Kh = cur.K + (size_t)kshift * D; const bf16_t* Vh = cur.V + (size_t)kshift * D;
    Seam S;
    if constexpr (!SB) { const float cq0 = cvec[cur.P0]; const float* cv = cvec + kshift; for (int j = tid; j < NT * KVBLK; j += NTHREADS) bias[j] = (cq0 - cv[j]) * (1.f / SCALE); }
#pragma unroll
    for (int d0 = 0; d0 < 8; ++d0) S.qr[d0] = load8(cur.Q + (size_t)(wid * QBLK + r32) * D + d0 * 16 + hi * 8);
    SLOAD_H(Kh, Vh, KBASE(0)); VMW(); SWRITE_HK(0);
    __syncthreads();
    float m_reg = -1e30f, l_reg = 0; f32x16 o[4] = {};
    float carry = 0.f; const float mlo = hi ? 0.f : 1.f;
#define RESC(a) do { if (__any((a) < 1.f)) { if (hi == 0) al_l[r32] = (a); asm volatile("s_waitcnt lgkmcnt(0)" ::: "memory");              \
                     for (int d_ = 0; d_ < 4; ++d_) for (int r = 0; r < 16; ++r) o[d_][r] *= al_l[crow(r, hi)]; } } while (0)
#define MASKT(P0_, P1_, t) do { const int kb_ = KBASE(t); if (kb_ + KVBLK - 1 > qlo - (SB ? 1 : 0)) mask_tile(P0_, P1_, qm - kb_); } while (0)
#define BT(t) (bias + KBASE(t) + 4 * hi)
#define PART1(PX0, PX1, mnX, alX) do { if constexpr (SB) sb_part1(PX0, PX1, carry, mlo); else partialSM(PX0, PX1, m_reg, mnX, alX); } while (0)
#define PART2(PY0, PY1, alY) do { if constexpr (SB) sb_part2(PY0, PY1, pa0, pa1, pa2, pa3); else finishSM(PY0, PY1, alY, l_reg, pa0, pa1, pa2, pa3); } while (0)
    f32x16 pA0, pA1, pB0, pB1; float mnA = 0.f, mnB = 0.f, alA = 1.f, alB = 1.f; bf16x8 pa0, pa1, pa2, pa3;
    SWRITE_HV(0); SBAR();
    if (NT > 1) SLOAD_H(Kh, Vh, KBASE(1));
    SBAR(); qkt<0, !SB>(pA0, pA1, K_lds, r32, hi, S.qr, BT(0));
    MASKT(pA0, pA1, 0); PART1(pA0, pA1, mnA, alA);
    if (NT > 1) { VMW(); SWRITE_H(1); }
    __syncthreads();
#define HALF_STEP(PX0, PX1, mnX, alX, PY0, PY1, alY, t, KB, VB, SBUF) do {                                                    \
        SBAR(); qkt<KB, !SB>(PX0, PX1, K_lds, r32, hi, S.qr, BT(t));                                                          \
        PART2(PY0, PY1, alY); SBAR();                                                                                          \
        if ((t) + 1 < NT) { SLOAD_H(Kh, Vh, KBASE((t) + 1)); SBAR(); }                                                         \
        pv_tile<VB>(o, vb0, pa0, pa1, pa2, pa3); MASKT(PX0, PX1, (t)); PART1(PX0, PX1, mnX, alX);                              \
        __syncthreads();                                                                                                      \
        if ((t) + 1 < NT) { VMW(); SWRITE_H(SBUF); }                                                                           \
        if constexpr (!SB) RESC(alX);                                                                                          \
        __syncthreads(); } while (0)
    for (int t = 1; t + 1 < NT; t += 2) {
        HALF_STEP(pB0, pB1, mnB, alB, pA0, pA1, alA, t, 1, 0, 0);
        HALF_STEP(pA0, pA1, mnA, alA, pB0, pB1, alB, t + 1, 0, 1, 1);
    }
    const bool even = (NT & 1) == 0;
    if (even) { SBAR(); qkt<1, !SB>(pB0, pB1, K_lds, r32, hi, S.qr, BT(NT - 1)); SBAR(); }
    PART2(pA0, pA1, alA); SBAR();
    pv_tile<0>(o, vb0, pa0, pa1, pa2, pa3);
    if (even) { MASKT(pB0, pB1, NT - 1); PART1(pB0, pB1, mnB, alB); __syncthreads(); if constexpr (!SB) RESC(alB);
        PART2(pB0, pB1, alB); SBAR(); pv_tile<1>(o, vb0, pa0, pa1, pa2, pa3); }
    unsigned char* we_ = wsu; asm volatile("" : "+s"(we_));
    if (part != 0) {
        const int slot2 = ((((cur.P0 >> 8) - 8) & 7) * 16 + bh) * 2 + (part == 2 ? 1 : 0);
        float* po = (float*)(we_ + WS_PO) + (size_t)slot2 * 256 * 128; float* pml = (float*)(we_ + WS_PML) + (size_t)slot2 * 512;
        if (hi == 0) { pml[(wid * QBLK + r32) * 2] = m_reg; pml[(wid * QBLK + r32) * 2 + 1] = l_reg; }
#pragma unroll
        for (int r = 0; r < 16; ++r)
#pragma unroll
            for (int d0 = 0; d0 < 4; ++d0) po[(size_t)(wid * QBLK + crow(r, hi)) * D + d0 * 32 + r32] = o[d0][r];
        __syncthreads();
        return;
    }
    const bf16_t* gate = (const bf16_t*)(we_ + WS_SEC) + 3 * SEC_ELEMS + (size_t)(bh >> 3) * SEQ * 1024 + (bh & 7) * HD;
    bf16_t* outp = (bf16_t*)(we_ + WS_MIX) + (size_t)(bh >> 3) * SEQ * DM + (bh & 7) * HD;
    float rli[16];
    if constexpr (!SB) {
        if (hi == 0) li_l[r32] = l_reg; asm volatile("s_waitcnt lgkmcnt(0)" ::: "memory");
#pragma unroll
        for (int r = 0; r < 16; ++r) rli[r] = __builtin_amdgcn_rcpf(li_l[crow(r, hi)]);
    }
#pragma unroll
    for (int r = 0; r < 16; ++r) { const int orow = cur.P0 + wid * QBLK + crow(r, hi);
#pragma unroll
        for (int d0 = 0; d0 < 4; ++d0) {
            float v = o[d0][r];
            if constexpr (!SB) { const unsigned short gb = gate[(size_t)orow * 1024 + d0 * 32 + r32]; v = v * rli[r] * __builtin_bit_cast(float, (unsigned)gb << 16); }
            const float vn = sx_f(v, 1);
            if ((r32 & 1) == 0) *(unsigned*)(outp + (size_t)orow * DM + d0 * 32 + r32) = cvt_pk_bf16(v, vn); } }
    __syncthreads();
#undef RESC
#undef KBASE
#undef MASKT
#undef BT
#undef PART1
#undef PART2
#undef HALF_STEP
}

constexpr float SB_TH = 150.f;
__device__ __forceinline__ void sb_unit(const UnitRef& cur, bf16_t* outp, char* lds) {
    const int tid = tid_opaque(), wid = __builtin_amdgcn_readfirstlane(tid >> 6), lane = tid & 63, r32 = lane & 31, hi = lane >> 5;
    const int NT = (cur.P0 + QB) / KVBLK;
#define KBASE(t) ((NT - 1 - (t)) * KVBLK)
    const int qlo = cur.P0 + wid * QBLK, qm = qlo + r32 - 4 * hi - 1;
    char* V_lds = lds; char* K_lds = lds + 2 * SHM_V;
    volatile int* flags = (volatile int*)(lds + OFF_WS);
    const int sr = tid >> 4, sc = (tid & 15) * 8, vst0 = v_st(sr, sc), vst1 = v_st(32 + sr, sc), kws = KSWZ(sr, sc * 2);
    const int vb0 = (int)(uintptr_t)V_lds + v_rd_base(lane);
    const bf16_t* Kh = cur.K; const bf16_t* Vh = cur.V;
    Seam S;
#pragma unroll
    for (int d0 = 0; d0 < 8; ++d0) S.qr[d0] = load8(cur.Q + (size_t)(wid * QBLK + r32) * D + d0 * 16 + hi * 8);
    SLOAD_H(Kh, Vh, KBASE(0)); VMW(); SWRITE_H(0);
    __syncthreads();
    f32x16 o[4] = {}; float carry = 0.f; const float mlo = hi ? 0.f : 1.f;
    bool wdone = false;
#define SB_STEP(tt, BUF) {                                                                                                 \
        const int kb_ = KBASE(tt);                                                                                           \
        if ((tt) + 1 < NT) SLOAD_H(Kh, Vh, KBASE((tt) + 1));                                                                 \
        SBAR();                                                                                                              \
        if (!wdone && kb_ <= qlo + QBLK - 2) {                                                                               \
            f32x16 p0, p1; bf16x8 pa0, pa1, pa2, pa3;                                                                        \
            qkt<BUF, false>(p0, p1, K_lds, r32, hi, S.qr, nullptr);                                                          \
            if (kb_ + KVBLK - 1 > qlo - 1) mask_tile(p0, p1, qm - kb_);                                                      \
            sb_part1(p0, p1, carry, mlo); sb_part2(p0, p1, pa0, pa1, pa2, pa3); SBAR();                                      \
            pv_tile<BUF>(o, vb0, pa0, pa1, pa2, pa3);                                                                        \
            wdone = __all(carry >= SB_TH);                                                                                   \
        }                                                                                                                    \
        if ((tt) + 1 < NT) { VMW(); SWRITE_H((BUF) ^ 1); }                                                                   \
        if (lane == 0) flags[((tt) & 1) * 8 + wid] = wdone ? 1 : 0;                                                          \
        __syncthreads();                                                                                                     \
        { int alld = 1;                                                                                                      \
          _Pragma("unroll") for (int w_ = 0; w_ < 8; ++w_) alld &= flags[((tt) & 1) * 8 + w_];                                \
          if (alld) break; } }
    for (int t = 0; t < NT; t += 2) {
        SB_STEP(t, 0)
        SB_STEP(t + 1, 1)
    }
#undef SB_STEP
#pragma unroll
    for (int r = 0; r < 16; ++r) { const int orow = cur.P0 + wid * QBLK + crow(r, hi);
#pragma unroll
        for (int d0 = 0; d0 < 4; ++d0) {
            const float v = o[d0][r];
            const float vn = sx_f(v, 1);
            if ((r32 & 1) == 0) *(unsigned*)(outp + (size_t)orow * DM + d0 * 32 + r32) = cvt_pk_bf16(v, vn); } }
    __syncthreads();
#undef KBASE
}
#undef ROW
#undef VMW
#undef SLOAD_H
#undef SWRITE_HK
#undef SWRITE_HV
#undef SWRITE_H
}

#define XB_TMO      128
#define XB_XCNT(j)  (256  + 64 * (j))
#define XB_XSUB(j)  (1280 + 64 * (j))
#define XB_XGEN(j)  (2304 + 64 * (j))
#define XB_TOP      3328
#define XB_TOPGEN   3392
#define XCD_BAR_WORDS 3456
#define XB_SPIN_CAP (1u << 20)
__device__ __forceinline__ unsigned xb_ld(unsigned* p)              { return __hip_atomic_load(p, __ATOMIC_RELAXED, __HIP_MEMORY_SCOPE_AGENT); }
__device__ __forceinline__ unsigned xb_add(unsigned* p, unsigned v) { return __hip_atomic_fetch_add(p, v, __ATOMIC_RELAXED, __HIP_MEMORY_SCOPE_AGENT); }
__device__ __forceinline__ unsigned xb_xcc_id() { return (unsigned)__builtin_amdgcn_s_getreg((3 << 11) | 20) & 0xFu; }
#define XB_SPIN(cond, bar) do { unsigned _sp = 0; while (cond) { __builtin_amdgcn_s_sleep(1); \
    if ((++_sp & 255u) == 0u) { if (xb_ld(&(bar)[XB_TMO])) break; if (_sp > XB_SPIN_CAP) { atomicAdd(&(bar)[XB_TMO], 1u); break; } } } } while (0)
struct XcdBarrier { unsigned* bar; unsigned x; volatile LAS unsigned* st; };
__device__ __forceinline__ XcdBarrier xcd_barrier_post(unsigned* bar, volatile LAS unsigned* st) {
    XcdBarrier b; b.bar = bar; b.x = xb_xcc_id(); b.st = st;
    if (threadIdx.x == 0) (void)xb_add(&bar[XB_XCNT(b.x)], 1u);
    return b;
}
__device__ __forceinline__ void xcd_barrier_complete(unsigned* bar, unsigned x, unsigned& nloc, unsigned& nx) {
    const unsigned G = gridDim.x * gridDim.y * gridDim.z;
    unsigned sum, cnt, mine, sp = 0u;
    for (;;) {
        sum = 0u; cnt = 0u; mine = 0u;
#pragma unroll
        for (unsigned j = 0; j < 16; ++j) { const unsigned c = xb_ld(&bar[XB_XCNT(j)]); sum += c; cnt += (c > 0u) ? 1u : 0u; mine = (j == x) ? c : mine; }
        if (sum == G) break;
        __builtin_amdgcn_s_sleep(1);
        if ((++sp & 255u) == 0u) { if (xb_ld(&bar[XB_TMO])) break; if (sp > XB_SPIN_CAP) { atomicAdd(&bar[XB_TMO], 1u); break; } }
    }
    nloc = mine > 0u ? mine : 1u; nx = cnt > 0u ? cnt : 1u;
}
__device__ __forceinline__ void xcd_barrier(const XcdBarrier& b) {
    asm volatile("s_waitcnt vmcnt(0)" ::: "memory");
    __syncthreads();
    if (threadIdx.x == 0) {
        unsigned* bar = b.bar;
        __builtin_amdgcn_s_waitcnt(0);
        unsigned nloc = b.st[0], nx = b.st[1];
        if (nloc == 0u) { xcd_barrier_complete(bar, b.x, nloc, nx); b.st[0] = nloc; b.st[1] = nx; }
        const unsigned old = xb_add(&bar[XB_XSUB(b.x)], 1u);
        const unsigned gen = old / nloc;
        if (old + 1u == (gen + 1u) * nloc) {
            __builtin_amdgcn_fence(__ATOMIC_RELEASE, "agent");
            asm volatile("s_waitcnt vmcnt(0)" ::: "memory");
            const unsigned og = xb_add(&bar[XB_TOP], 1u);
            const unsigned tg = og / nx;
            if (og + 1u == (tg + 1u) * nx) xb_add(&bar[XB_TOPGEN], 1u);
            else XB_SPIN(xb_ld(&bar[XB_TOPGEN]) == tg, bar);
            __builtin_amdgcn_fence(__ATOMIC_ACQUIRE, "agent");
            xb_add(&bar[XB_XGEN(b.x)], 1u);
            asm volatile("s_waitcnt vmcnt(0)" ::: "memory");
        } else {
            XB_SPIN(xb_ld(&bar[XB_XGEN(b.x)]) == gen, bar);
            __builtin_amdgcn_fence(__ATOMIC_ACQUIRE, "agent");
            asm volatile("s_waitcnt vmcnt(0)" ::: "memory");
        }
    }
    __syncthreads();
}

struct Args { const float* in[12]; float* out; unsigned char* ws; int ph_lo, ph_hi; };

__device__ __forceinline__ void p0_transpose_item(const float* W, int ldw, int K, bf16_t* WT, int nblk, LAS float* scr, int item, int lane, const float* gk) {
    const int kb = item / nblk, nb = item % nblk, k0 = 64 * kb, n0 = 32 * nb;
    { const int rr = lane >> 3, c4 = lane & 7; f32x4 v[8];
#pragma unroll
      for (int i = 0; i < 8; ++i) v[i] = *(const f32x4*)(W + (size_t)(k0 + rr + 8 * i) * ldw + n0 + 4 * c4);
#pragma unroll
      for (int i = 0; i < 8; ++i) { const int kk = rr + 8 * i; const float gm = gk ? gk[k0 + kk] : 1.f;
          scr[kk * 33 + 4 * c4] = v[i][0] * gm; scr[kk * 33 + 4 * c4 + 1] = v[i][1] * gm; scr[kk * 33 + 4 * c4 + 2] = v[i][2] * gm; scr[kk * 33 + 4 * c4 + 3] = v[i][3] * gm; } }
    LDS_WAIT(); asm volatile("" ::: "memory");
    const int c = lane & 7;
#pragma unroll
    for (int j = 0; j < 4; ++j) { const int n = (lane >> 3) + 8 * j; const LAS float* s = scr + (8 * c) * 33 + n;
        u32x4 o; o.x = cvt_pk_bf16(s[0 * 33], s[1 * 33]); o.y = cvt_pk_bf16(s[2 * 33], s[3 * 33]); o.z = cvt_pk_bf16(s[4 * 33], s[5 * 33]); o.w = cvt_pk_bf16(s[6 * 33], s[7 * 33]);
        *(u32x4*)(WT + (size_t)(n0 + n) * K + k0 + 8 * c) = o; }
    LDS_WAIT(); asm volatile("" ::: "memory");
}

__device__ __forceinline__ int pack_i8(float a, float b, float c, float d) {
    const int ia = (int)__builtin_rintf(a), ib = (int)__builtin_rintf(b), ic = (int)__builtin_rintf(c), id = (int)__builtin_rintf(d);
    return (int)(((unsigned)ia & 0xffu) | (((unsigned)ib & 0xffu) << 8) | (((unsigned)ic & 0xffu) << 16) | ((unsigned)id << 24));
}
__device__ __forceinline__ void convert_tables(const Args& a, int r0, int r1, int worker, int nworkers) {
    const int lane = tid_opaque() & 63;
    unsigned char* ws = a.ws; const float* g_ffn = a.in[7]; const float* pu = a.in[10]; const float* pv = a.in[11];
    float* suv = (float*)(ws + WS_SUV);
    for (int r = r0 + worker; r < r1; r += nworkers) {
        const bool isv = r >= NEXP; const int e = isv ? r - NEXP : r;
        const f32x4* srcp = (const f32x4*)((isv ? pv : pu) + (size_t)e * DM);
        f32x4 v[8]; float amax = 0.f;
#pragma unroll
        for (int j = 0; j < 8; ++j) { v[j] = srcp[lane + 64 * j];
            if (!isv) { const f32x4 g4 = *(const f32x4*)(g_ffn + 4 * (lane + 64 * j)); v[j] = v[j] * g4; }
            amax = fmaxf(amax, fmaxf(fmaxf(fabsf(v[j][0]), fabsf(v[j][1])), fmaxf(fabsf(v[j][2]), fabsf(v[j][3])))); }
        amax = wave_max(amax);
        const float sc = amax > 0.f ? 127.f / amax : 1.f;
        unsigned char* dst = ws + (isv ? WS_V8 : WS_U8) + (size_t)e * 128;
#pragma unroll
        for (int j = 0; j < 8; ++j) { const int p = pack_i8(v[j][0] * sc, v[j][1] * sc, v[j][2] * sc, v[j][3] * sc);
            const int col = 4 * (lane + 64 * j);
            *(unsigned*)(dst + (size_t)(col >> 7) * ((size_t)NEXP * 128) + (col & 127)) = (unsigned)p; }
        if (lane == 0) suv[r] = 1.f / sc;
    }
}
constexpr int TAB_SPLIT = NEXP;

__device__ __forceinline__ void p0_transpose_item_i8(const float* W, int ldw, int K, unsigned char* WT, int nblk, LAS float* scr, int item, int lane, float q8) {
    const int kb = item / nblk, nb = item % nblk, k0 = 64 * kb, n0 = 32 * nb;
    { const int rr = lane >> 3, c4 = lane & 7; f32x4 v[8];
#pragma unroll
      for (int i = 0; i < 8; ++i) v[i] = *(const f32x4*)(W + (size_t)(k0 + rr + 8 * i) * ldw + n0 + 4 * c4);
#pragma unroll
      for (int i = 0; i < 8; ++i) { const int kk = rr + 8 * i;
          scr[kk * 33 + 4 * c4] = v[i][0] * q8; scr[kk * 33 + 4 * c4 + 1] = v[i][1] * q8; scr[kk * 33 + 4 * c4 + 2] = v[i][2] * q8; scr[kk * 33 + 4 * c4 + 3] = v[i][3] * q8; } }
    LDS_WAIT(); asm volatile("" ::: "memory");
    const int c = lane & 7;
#pragma unroll
    for (int j = 0; j < 4; ++j) { const int n = (lane >> 3) + 8 * j; const LAS float* s = scr + (8 * c) * 33 + n;
        u32x2 o; o.x = (unsigned)pack_i8(s[0 * 33], s[1 * 33], s[2 * 33], s[3 * 33]); o.y = (unsigned)pack_i8(s[4 * 33], s[5 * 33], s[6 * 33], s[7 * 33]);
        *(u32x2*)(WT + (size_t)(n0 + n) * K + k0 + 8 * c) = o; }
    LDS_WAIT(); asm volatile("" ::: "memory");
}
__device__ __forceinline__ float log_sigmoid_f(float x) { return fminf(x, 0.f) - log1pf(expf(-fabsf(x))); }

__device__ __forceinline__ void phase0(const Args& a, unsigned char* lds_g) {
    LAS unsigned char* lds = (LAS unsigned char*)lds_g;
    const int tid = tid_opaque(), lane = tid & 63, wave = __builtin_amdgcn_readfirstlane(tid >> 6);
    const int gw = blockIdx.x * NWAVES + wave, NGW = gridDim.x * NWAVES;
    const int gt = blockIdx.x * NTHREADS + tid, NGT = gridDim.x * NTHREADS;
    unsigned char* ws = a.ws;
    const float* x = a.in[0]; const float* g_attn = a.in[1]; const float* w_in = a.in[2]; const float* b_forget = a.in[3];
    const float* w_out = a.in[6]; const float* g_ffn = a.in[7]; const float* w_pq = a.in[8]; const float* sk = a.in[9]; const float* pu = a.in[10]; const float* pv = a.in[11];
    { float m = 0.f; const f32x4* wp = (const f32x4*)w_in;
      constexpr size_t NV4 = (size_t)DM * DIN / 4;
      size_t i = gt;
      for (; i + 7 * (size_t)NGT < NV4; i += 8 * (size_t)NGT) {
          f32x4 v[8];
#pragma unroll
          for (int k = 0; k < 8; ++k) v[k] = wp[i + k * (size_t)NGT];
#pragma unroll
          for (int k = 0; k < 8; ++k) m = fmaxf(m, fmaxf(fmaxf(fabsf(v[k][0]), fabsf(v[k][1])), fmaxf(fabsf(v[k][2]), fabsf(v[k][3])))); }
      for (; i < NV4; i += NGT) { const f32x4 v = wp[i]; m = fmaxf(m, fmaxf(fmaxf(fabsf(v[0]), fabsf(v[1])), fmaxf(fabsf(v[2]), fabsf(v[3])))); }
      m = wave_max(m);
      volatile LAS float* red = (volatile LAS float*)(lds + MISC_OFF + 256);
      if (lane == 0) red[wave] = m;
      __syncthreads();
      if (tid == 0) { float mm = red[0];
#pragma unroll
          for (int w = 1; w < NWAVES; ++w) mm = fmaxf(mm, red[w]);
          __hip_atomic_fetch_max((unsigned*)(ws + WS_CTL) + CW_WMAX, __float_as_uint(mm), __ATOMIC_RELAXED, __HIP_MEMORY_SCOPE_AGENT); } }
    LAS float* wf = (LAS float*)(lds + 67584);
    for (int k = tid; k < DM; k += NTHREADS) { const f32x4 a0 = *(const f32x4*)(w_in + (size_t)k * DIN + NPROJ), a1 = *(const f32x4*)(w_in + (size_t)k * DIN + NPROJ + 4);
        wf[0 * DM + k] = a0[0]; wf[1 * DM + k] = a0[1]; wf[2 * DM + k] = a0[2]; wf[3 * DM + k] = a0[3]; wf[4 * DM + k] = a1[0]; wf[5 * DM + k] = a1[1]; wf[6 * DM + k] = a1[2]; wf[7 * DM + k] = a1[3]; }
    __syncthreads();
    for (int row = gw; row < T; row += NGW) {
        const f32x4* xr = (const f32x4*)(x + (size_t)row * DM);
        f32x4 v[8]; float ss = 0.f;
#pragma unroll
        for (int j = 0; j < 8; ++j) { v[j] = xr[lane + 64 * j]; ss += v[j][0] * v[j][0] + v[j][1] * v[j][1] + v[j][2] * v[j][2] + v[j][3] * v[j][3]; }
        const float r = 1.0f / sqrtf(wave_sum(ss) * (1.f / DM) + EPS);
        float f[8] = {0.f, 0.f, 0.f, 0.f, 0.f, 0.f, 0.f, 0.f};
        float xmax = 0.f;
#pragma unroll
        for (int j = 0; j < 8; ++j) { const f32x4 g4 = *(const f32x4*)(g_attn + 4 * (lane + 64 * j)); v[j][0] *= r * g4[0]; v[j][1] *= r * g4[1]; v[j][2] *= r * g4[2]; v[j][3] *= r * g4[3];
            xmax = fmaxf(xmax, fmaxf(fmaxf(fabsf(v[j][0]), fabsf(v[j][1])), fmaxf(fabsf(v[j][2]), fabsf(v[j][3])))); }
        xmax = wave_max(xmax);
        const float xq = xmax > 0.f ? 127.f / xmax : 1.f;
        if (lane == 0) ((float*)(ws + WS_SXN))[row] = xmax * (1.f / 127.f);
        unsigned* o8 = (unsigned*)(ws + WS_XN + (size_t)row * DM);
#pragma unroll
        for (int j = 0; j < 8; ++j) {
            const int e = 4 * (lane + 64 * j);
            const f32x4 xn = v[j];
            o8[lane + 64 * j] = (unsigned)pack_i8(xn[0] * xq, xn[1] * xq, xn[2] * xq, xn[3] * xq);
#pragma unroll
            for (int hh = 0; hh < 8; ++hh) { const f32x4 w4 = *(LAS f32x4*)(wf + hh * DM + e);
                f[hh] += (xn[0] * w4[0] + xn[1] * w4[1]) + (xn[2] * w4[2] + xn[3] * w4[3]); }
            __builtin_amdgcn_sched_barrier(0);
        }
#pragma unroll
        for (int hh = 0; hh < 8; ++hh) f[hh] = wave_sum(f[hh]);
        if (lane < 8) { float fl = f[0];
#pragma unroll
            for (int hh = 1; hh < 8; ++hh) fl = (lane == hh) ? f[hh] : fl;
            const int b = row >> 12, s = row & 4095;
            ((float*)(ws + WS_LOGF))[(size_t)(b * 8 + lane) * SEQ + s] = log_sigmoid_f(fl + b_forget[lane]); }
    }
    LAS float* scr = (LAS float*)(lds + wave * 8448);
    constexpr int I_IN = (DM / 64) * (NPROJ / 32), I_O = (DM / 64) * (DM / 32);
    for (int it = gw; it < 2 * I_O; it += NGW) {
        int r = it;
        if (r < I_O) { p0_transpose_item(w_out, DM, DM, (bf16_t*)(ws + WS_WOUT), DM / 32, scr, r, lane, nullptr); continue; } r -= I_O;
        p0_transpose_item(w_pq, DM, DM, (bf16_t*)(ws + WS_WPQ), DM / 32, scr, r, lane, g_ffn);
    }
    for (int i = gt; i < 8 * 2 * 128 * 128 / 8; i += NGT) { const f32x4 a0 = *(const f32x4*)(sk + (size_t)i * 8), a1 = *(const f32x4*)(sk + (size_t)i * 8 + 4);
        u32x4 w; w.x = cvt_pk_bf16(a0[0], a0[1]); w.y = cvt_pk_bf16(a0[2], a0[3]); w.z = cvt_pk_bf16(a1[0], a1[1]); w.w = cvt_pk_bf16(a1[2], a1[3]);
        *(u32x4*)(ws + WS_SK + (size_t)i * 16) = w; }
    if (gt < 256) ((float*)(ws + WS_GQK))[gt] = gt < 128 ? a.in[4][gt] : a.in[5][gt - 128];
    convert_tables(a, 0, TAB_SPLIT, gw, NGW);
    { XcdBarrier xb_; xb_.bar = (unsigned*)(ws + WS_CTL) + CW_BAR; xb_.x = xb_xcc_id(); xb_.st = (volatile LAS unsigned*)(lds + MISC_OFF) + 8; xcd_barrier(xb_); }
    const float wmax = __uint_as_float(__hip_atomic_load((unsigned*)(ws + WS_CTL) + CW_WMAX, __ATOMIC_RELAXED, __HIP_MEMORY_SCOPE_AGENT));
    if (gt == 0) *(float*)(ws + WS_WSC) = wmax * (1.f / 127.f);
    const float q8 = wmax > 0.f ? 127.f / wmax : 1.f;
    for (int it = gw; it < I_IN; it += NGW) p0_transpose_item_i8(w_in, DIN, DM, ws + WS_WIN, NPROJ / 32, scr, it, lane, q8);
}

__device__ __forceinline__ void cumsum_rows(const Args& a) {
    const int tid = tid_opaque(), lane = tid & 63, wave = tid >> 6;
    const int rowi = (int)gridDim.x - 1 - (int)blockIdx.x;
    if (rowi >= 16 || rowi < 0 || wave != 0) return;
    const float* src = (const float*)(a.ws + WS_LOGF) + (size_t)rowi * SEQ + lane * 64;
    float* dst = (float*)(a.ws + WS_C) + (size_t)rowi * SEQ + lane * 64;
    f32x4 v[16]; float run = 0.f;
#pragma unroll
    for (int i = 0; i < 16; ++i) { v[i] = *(const f32x4*)(src + 4 * i);
#pragma unroll
        for (int q = 0; q < 4; ++q) { run += v[i][q]; v[i][q] = run; } }
    float incl = run;
#pragma unroll
    for (int o = 1; o < 64; o <<= 1) { const float t = shup_f(incl, o); if (lane >= o) incl += t; }
    const float off = incl - run;
#pragma unroll
    for (int i = 0; i < 16; ++i) { f32x4 w = v[i]; w[0] += off; w[1] += off; w[2] += off; w[3] += off; *(f32x4*)(dst + 4 * i) = w; }
}

__device__ __forceinline__ void phase_qknorm(const Args& a) {
    const int tid = tid_opaque(), lane = tid & 63, wave = tid >> 6;
    const int gw = blockIdx.x * NWAVES + wave, NGW = gridDim.x * NWAVES;
    const int sub = lane & 15, rw = lane >> 4;
    const float* gq = a.in[4]; const float* gk = a.in[5];
    constexpr int ROWS = NB * NHF * SEQ;
    for (int it = gw; it < 2 * ROWS / 4; it += NGW) {
        const int row = it * 4 + rw; const bool isk = row >= ROWS;
        bf16_t* p = (bf16_t*)(a.ws + WS_SEC) + (size_t)row * HD + sub * 8;
        const float* g = (isk ? gk : gq) + sub * 8;
        const u32x4 w = *(const u32x4*)p;
        float v[8] = {bf_lo(w.x), bf_hi(w.x), bf_lo(w.y), bf_hi(w.y), bf_lo(w.z), bf_hi(w.z), bf_lo(w.w), bf_hi(w.w)};
        float ss = 0.f;
#pragma unroll
        for (int i = 0; i < 8; ++i) ss += v[i] * v[i];
        ss += sx_f(ss, 1); ss += sx_f(ss, 2); ss += sx_f(ss, 4); ss += sx_f(ss, 8);
        const float r = 1.0f / sqrtf(ss * (1.f / HD) + EPS);
        const f32x4 g0 = *(const f32x4*)g, g1 = *(const f32x4*)(g + 4);
        u32x4 o; o.x = cvt_pk_bf16(v[0] * r * g0[0], v[1] * r * g0[1]); o.y = cvt_pk_bf16(v[2] * r * g0[2], v[3] * r * g0[3]);
        o.z = cvt_pk_bf16(v[4] * r * g1[0], v[5] * r * g1[1]); o.w = cvt_pk_bf16(v[6] * r * g1[2], v[7] * r * g1[3]);
        *(u32x4*)p = o;
    }
}

__device__ __forceinline__ void phase_attn(const Args& a, unsigned char* lds_g) {
    const int tid = tid_opaque();
    volatile int* s_item = (volatile int*)(lds_g + MISC_OFF);
    unsigned* ctr = (unsigned*)(a.ws + WS_CTL);
    for (;;) {
        __syncthreads();
        if (tid == 0) *s_item = (int)atomicAdd(ctr, 1u);
        __syncthreads();
        int it = *s_item, kind = -1, qb = 0, sub = 0;
#define CLS(K, Q, CNT) if (kind < 0) { if (it < (CNT)) { kind = (K); qb = (Q); sub = it; } else it -= (CNT); }
        CLS(2, 15, 32) CLS(1, 7, 16) CLS(2, 14, 32) CLS(2, 13, 32) CLS(1, 6, 16) CLS(2, 12, 32) CLS(2, 11, 32) CLS(1, 5, 16) CLS(2, 10, 32) CLS(2, 9, 32) CLS(1, 4, 16) CLS(2, 8, 32) CLS(1, 3, 16) CLS(1, 2, 16)
        if (kind < 0) { if (it < 256) { kind = 0; qb = 15 - (it >> 4); sub = it & 15; } else it -= 256; }
        CLS(1, 1, 16) CLS(1, 0, 16)
#undef CLS
        if (kind < 0) break;
        unsigned char* wsl = a.ws; asm volatile("" : "+s"(wsl));
        bf16_t* sec = (bf16_t*)(wsl + WS_SEC);
        const int bh = sub & 15, part = (kind == 2) ? 1 + (sub >> 4) : 0;
        const int b = bh >> 3, h = bh & 7;
        const size_t hoff = (size_t)bh * SEQ * HD;
        att::UnitRef u;
        u.P0 = qb * 256;
        if (kind == 0) {
            u.Q = sec + 4 * SEC_ELEMS + hoff + (size_t)u.P0 * HD; u.K = sec + 5 * SEC_ELEMS + hoff; u.V = sec + 6 * SEC_ELEMS + hoff;
            att::sb_unit(u, (bf16_t*)(wsl + WS_MIX) + (size_t)b * SEQ * DM + 1024 + h * HD, (char*)lds_g);
        } else {
            u.Q = sec + 0 * SEC_ELEMS + hoff + (size_t)u.P0 * HD; u.K = sec + 1 * SEC_ELEMS + hoff; u.V = sec + 2 * SEC_ELEMS + hoff;
            att::attn_unit<false>(u, wsl, bh, (char*)lds_g, part);
        }
    }
}
__device__ __forceinline__ void phase_attn_combine(const Args& a) {
    const int gt = blockIdx.x * NTHREADS + tid_opaque(), NGT = gridDim.x * NTHREADS;
    const float* po = (const float*)(a.ws + WS_PO); const float* pml = (const float*)(a.ws + WS_PML);
    const bf16_t* gate = (const bf16_t*)(a.ws + WS_SEC) + 3 * SEC_ELEMS; bf16_t* mix = (bf16_t*)(a.ws + WS_MIX);
    constexpr float C2 = LOG2E * SCALE;
    for (int item = gt; item < 128 * 256 * 16; item += NGT) {
        const int slot = item >> 12, row = (item >> 4) & 255, cg = item & 15;
        const int qb = 8 + (slot >> 4), bh = slot & 15, b = bh >> 3, h = bh & 7;
        const f32x2 ml1 = *(const f32x2*)(pml + (size_t)(slot * 2) * 512 + row * 2), ml2 = *(const f32x2*)(pml + (size_t)(slot * 2 + 1) * 512 + row * 2);
        const float M = fmaxf(ml1.x, ml2.x), a1 = __builtin_amdgcn_exp2f((ml1.x - M) * C2), a2 = __builtin_amdgcn_exp2f((ml2.x - M) * C2);
        const float inv = 1.f / (a1 * ml1.y + a2 * ml2.y);
        const float* p1 = po + (size_t)(slot * 2) * 32768 + row * 128 + cg * 8; const float* p2 = p1 + 32768;
        const f32x4 x0 = *(const f32x4*)p1, x1 = *(const f32x4*)(p1 + 4), y0 = *(const f32x4*)p2, y1 = *(const f32x4*)(p2 + 4);
        const size_t tok = (size_t)b * SEQ + qb * 256 + row;
        const u32x4 gw = *(const u32x4*)(gate + tok * 1024 + h * HD + cg * 8);
        const float w1 = a1 * inv, w2 = a2 * inv;
        u32x4 o;
        o.x = cvt_pk_bf16((w1 * x0[0] + w2 * y0[0]) * bf_lo(gw.x), (w1 * x0[1] + w2 * y0[1]) * bf_hi(gw.x));
        o.y = cvt_pk_bf16((w1 * x0[2] + w2 * y0[2]) * bf_lo(gw.y), (w1 * x0[3] + w2 * y0[3]) * bf_hi(gw.y));
        o.z = cvt_pk_bf16((w1 * x1[0] + w2 * y1[0]) * bf_lo(gw.z), (w1 * x1[1] + w2 * y1[1]) * bf_hi(gw.z));
        o.w = cvt_pk_bf16((w1 * x1[2] + w2 * y1[2]) * bf_lo(gw.w), (w1 * x1[3] + w2 * y1[3]) * bf_hi(gw.w));
        *(u32x4*)(mix + tok * DM + h * HD + cg * 8) = o;
    }
}

__device__ __forceinline__ unsigned f2ord(float f) { const unsigned u = __float_as_uint(f); return u ^ ((unsigned)((int)u >> 31) | 0x80000000u); }
__device__ __forceinline__ float ord2f(unsigned k) { const unsigned u = k ^ (~(unsigned)((int)k >> 31) | 0x80000000u); return __uint_as_float(u); }
#define INS16(L, X) do { unsigned x_ = (X); _Pragma("unroll") for (int i_ = 0; i_ < 16; ++i_) { const unsigned hi_ = max(L[i_], x_); x_ = min(L[i_], x_); L[i_] = hi_; } } while (0)
__device__ __forceinline__ void sort16_desc(unsigned (&a)[16]) {
#pragma unroll
    for (int k = 2; k <= 16; k <<= 1)
#pragma unroll
        for (int j = k >> 1; j > 0; j >>= 1)
#pragma unroll
            for (int i = 0; i < 16; ++i) { const int l = i ^ j; if (l > i) { const unsigned hi_ = max(a[i], a[l]), lo_ = min(a[i], a[l]); const bool desc = (i & k) == 0; a[i] = desc ? hi_ : lo_; a[l] = desc ? lo_ : hi_; } }
}
__device__ __forceinline__ void merge_top16(unsigned (&a)[16], const unsigned (&b)[16]) {
#pragma unroll
    for (int i = 0; i < 16; ++i) a[i] = max(a[i], b[15 - i]);
#pragma unroll
    for (int j = 8; j > 0; j >>= 1)
#pragma unroll
        for (int i = 0; i < 16; ++i) { const int l = i ^ j; if (l > i) { const unsigned hi_ = max(a[i], a[l]), lo_ = min(a[i], a[l]); a[i] = hi_; a[l] = lo_; } }
}
__device__ __forceinline__ void topk_half(const bf16_t* qrow  , const bf16_t* skb, int h, int c, int r32, int hi, unsigned (&L)[16]) {
    bf16x8 qf[8];
#pragma unroll
    for (int d0 = 0; d0 < 8; ++d0) qf[d0] = *(const bf16x8*)(qrow + c * 128 + d0 * 16 + hi * 8);
    const unsigned hi4 = 4u * (unsigned)hi;
#pragma unroll
    for (int kt = 0; kt < 4; ++kt) {
        f32x16 acc = f32x16{};
#pragma unroll
        for (int d0 = 0; d0 < 8; ++d0) { const bf16x8 kf = *(const bf16x8*)(skb + (size_t)((h * 2 + c) * 128 + kt * 32 + r32) * 128 + d0 * 16 + hi * 8);
            acc = __builtin_amdgcn_mfma_f32_32x32x16_bf16(kf, qf[d0], acc, 0, 0, 0); }
        unsigned G[16];
#pragma unroll
        for (int r = 0; r < 16; ++r) { const unsigned cst = (unsigned)(127 - (kt * 32 + (r & 3) + 8 * (r >> 2))); G[r] = (f2ord(acc[r]) & ~127u) | (cst - hi4); }
        sort16_desc(G);
        if (kt == 0) {
#pragma unroll
            for (int i = 0; i < 16; ++i) L[i] = G[i];
        } else merge_top16(L, G);
    }
    unsigned P[16];
#pragma unroll
    for (int i = 0; i < 16; ++i) { auto rr = __builtin_amdgcn_permlane32_swap(L[i], L[i], false, false); P[i] = hi ? rr[0] : rr[1]; }
    merge_top16(L, P);
}
__device__ __forceinline__ void topk_task(unsigned char* ws, const bf16_t* qrow, LAS int* tb, int t0, int h, int lane) {
    const int r32 = lane & 31, hi = lane >> 5;
    const bf16_t* skb = (const bf16_t*)(ws + WS_SK);
    int* idx_o = (int*)(ws + WS_IDX); float* gw_o = (float*)(ws + WS_GW);
    float rt_l;
    { const f32x4* sp = (const f32x4*)((const float*)(ws + WS_SSQ) + (size_t)(t0 + (lane & 31)) * 32); float tot = 0.f;
#pragma unroll
      for (int i = 0; i < 8; ++i) { const f32x4 v = sp[i]; tot += (v[0] + v[1]) + (v[2] + v[3]); }
      rt_l = 1.0f / sqrtf(tot * (1.f / DM) + EPS); }
        {
          const bf16_t* hbp = (const bf16_t*)(ws + WS_HB); const float* amx = (const float*)(ws + WS_AMX); unsigned char* xq = ws + WS_XQ;
          float am = 0.f;
          { const f32x4* ap = (const f32x4*)(amx + (size_t)(t0 + (lane & 31)) * 32);
#pragma unroll
            for (int i = 0; i < 8; ++i) { const f32x4 v = ap[i]; am = fmaxf(am, fmaxf(fmaxf(v[0], v[1]), fmaxf(v[2], v[3]))); } }
          if (h == 0 && lane < 32) ((float*)(ws + WS_SX))[t0 + lane] = rt_l * am * (1.f / 126.5f);
          const float qs = am > 0.f ? 126.5f / am : 1.f;
          u32x4 wv[16];
#pragma unroll
          for (int j = 0; j < 16; ++j) { const int ch = lane + 64 * j; wv[j] = *(const u32x4*)(hbp + (size_t)(t0 + (ch >> 5)) * DM + h * 256 + (ch & 31) * 8); }
#pragma unroll
          for (int j = 0; j < 16; ++j) { const int ch = lane + 64 * j, tl = ch >> 5, tk = t0 + tl, col = h * 256 + (ch & 31) * 8;
              const u32x4 w = wv[j]; const float r = sh_f(qs, tl);
              const int p0 = pack_i8(bf_lo(w.x) * r, bf_hi(w.x) * r, bf_lo(w.y) * r, bf_hi(w.y) * r), p1 = pack_i8(bf_lo(w.z) * r, bf_hi(w.z) * r, bf_lo(w.w) * r, bf_hi(w.w) * r);
              *(u32x2*)(xq + (size_t)tk * DM + col) = (u32x2){(unsigned)p0, (unsigned)p1}; } }
        unsigned L[2][16];
        topk_half(qrow, skb, h, 0, r32, hi, L[0]);
        __builtin_amdgcn_sched_barrier(0);
        topk_half(qrow, skb, h, 1, r32, hi, L[1]);
        __builtin_amdgcn_sched_barrier(0);
        float s1[16], s2[16]; int i1[16], i2[16];
#pragma unroll
        for (int i = 0; i < 16; ++i) { s1[i] = ord2f((L[0][i] & ~127u) | 64u); i1[i] = 127 - (int)(L[0][i] & 127u); s2[i] = ord2f((L[1][i] & ~127u) | 64u); i2[i] = 127 - (int)(L[1][i] & 127u); }
        unsigned CG[4][16];
#pragma unroll
        for (int i = 0; i < 64; ++i) CG[i >> 4][i & 15] = 0u;
        CG[0][0] = (f2ord(s1[0] + s2[0]) & ~255u) | 0u;
        CG[0][1] = (f2ord(s1[0] + s2[1]) & ~255u) | 1u;
        CG[0][2] = (f2ord(s1[0] + s2[2]) & ~255u) | 2u;
        CG[0][3] = (f2ord(s1[0] + s2[3]) & ~255u) | 3u;
        CG[0][4] = (f2ord(s1[0] + s2[4]) & ~255u) | 4u;
        CG[0][5] = (f2ord(s1[0] + s2[5]) & ~255u) | 5u;
        CG[0][6] = (f2ord(s1[0] + s2[6]) & ~255u) | 6u;
        CG[0][7] = (f2ord(s1[0] + s2[7]) & ~255u) | 7u;
        CG[0][8] = (f2ord(s1[0] + s2[8]) & ~255u) | 8u;
        CG[0][9] = (f2ord(s1[0] + s2[9]) & ~255u) | 9u;
        CG[0][10] = (f2ord(s1[0] + s2[10]) & ~255u) | 10u;
        CG[0][11] = (f2ord(s1[0] + s2[11]) & ~255u) | 11u;
        CG[0][12] = (f2ord(s1[0] + s2[12]) & ~255u) | 12u;
        CG[0][13] = (f2ord(s1[0] + s2[13]) & ~255u) | 13u;
        CG[0][14] = (f2ord(s1[0] + s2[14]) & ~255u) | 14u;
        CG[0][15] = (f2ord(s1[0] + s2[15]) & ~255u) | 15u;
        CG[1][0] = (f2ord(s1[1] + s2[0]) & ~255u) | 16u;
        CG[1][1] = (f2ord(s1[1] + s2[1]) & ~255u) | 17u;
        CG[1][2] = (f2ord(s1[1] + s2[2]) & ~255u) | 18u;
        CG[1][3] = (f2ord(s1[1] + s2[3]) & ~255u) | 19u;
        CG[1][4] = (f2ord(s1[1] + s2[4]) & ~255u) | 20u;
        CG[1][5] = (f2ord(s1[1] + s2[5]) & ~255u) | 21u;
        CG[1][6] = (f2ord(s1[1] + s2[6]) & ~255u) | 22u;
        CG[1][7] = (f2ord(s1[1] + s2[7]) & ~255u) | 23u;
        CG[1][8] = (f2ord(s1[2] + s2[0]) & ~255u) | 32u;
        CG[1][9] = (f2ord(s1[2] + s2[1]) & ~255u) | 33u;
        CG[1][10] = (f2ord(s1[2] + s2[2]) & ~255u) | 34u;
        CG[1][11] = (f2ord(s1[2] + s2[3]) & ~255u) | 35u;
        CG[1][12] = (f2ord(s1[2] + s2[4]) & ~255u) | 36u;
        CG[1][13] = (f2ord(s1[3] + s2[0]) & ~255u) | 48u;
        CG[1][14] = (f2ord(s1[3] + s2[1]) & ~255u) | 49u;
        CG[1][15] = (f2ord(s1[3] + s2[2]) & ~255u) | 50u;
        CG[2][0] = (f2ord(s1[3] + s2[3]) & ~255u) | 51u;
        CG[2][1] = (f2ord(s1[4] + s2[0]) & ~255u) | 64u;
        CG[2][2] = (f2ord(s1[4] + s2[1]) & ~255u) | 65u;
        CG[2][3] = (f2ord(s1[4] + s2[2]) & ~255u) | 66u;
        CG[2][4] = (f2ord(s1[5] + s2[0]) & ~255u) | 80u;
        CG[2][5] = (f2ord(s1[5] + s2[1]) & ~255u) | 81u;
        CG[2][6] = (f2ord(s1[6] + s2[0]) & ~255u) | 96u;
        CG[2][7] = (f2ord(s1[6] + s2[1]) & ~255u) | 97u;
        CG[2][8] = (f2ord(s1[7] + s2[0]) & ~255u) | 112u;
        CG[2][9] = (f2ord(s1[7] + s2[1]) & ~255u) | 113u;
        CG[2][10] = (f2ord(s1[8] + s2[0]) & ~255u) | 128u;
        CG[2][11] = (f2ord(s1[9] + s2[0]) & ~255u) | 144u;
        CG[2][12] = (f2ord(s1[10] + s2[0]) & ~255u) | 160u;
        CG[2][13] = (f2ord(s1[11] + s2[0]) & ~255u) | 176u;
        CG[2][14] = (f2ord(s1[12] + s2[0]) & ~255u) | 192u;
        CG[2][15] = (f2ord(s1[13] + s2[0]) & ~255u) | 208u;
        CG[3][0] = (f2ord(s1[14] + s2[0]) & ~255u) | 224u;
        CG[3][1] = (f2ord(s1[15] + s2[0]) & ~255u) | 240u;
        sort16_desc(CG[0]); sort16_desc(CG[1]); sort16_desc(CG[2]); sort16_desc(CG[3]);
        merge_top16(CG[0], CG[1]); merge_top16(CG[2], CG[3]); merge_top16(CG[0], CG[2]);
        unsigned LC[16];
#pragma unroll
        for (int i = 0; i < 16; ++i) LC[i] = CG[0][i];
#pragma unroll
        for (int i = 0; i < 16; ++i) { tb[i * 64 + lane] = i1[i]; tb[(16 + i) * 64 + lane] = i2[i]; }
        float LS[16]; int LP[16];
#pragma unroll
        for (int i = 0; i < 16; ++i) { const unsigned cid = LC[i] & 255u; LS[i] = ord2f((LC[i] & ~255u) | 128u);
            LP[i] = tb[(cid >> 4) * 64 + lane] * 128 + tb[(16 + (cid & 15u)) * 64 + lane]; }
        float den = 0.f, e[16];
#pragma unroll
        for (int i = 0; i < 16; ++i) { e[i] = __expf(LS[i] - LS[0]); den += e[i]; }
        const float rden = 1.f / den;
        const size_t ob = (size_t)(t0 + r32) * NE + h * 16;
        if (hi == 0) {
#pragma unroll
            for (int i = 0; i < 4; ++i) *(int4*)(idx_o + ob + 4 * i) = make_int4(LP[4 * i], LP[4 * i + 1], LP[4 * i + 2], LP[4 * i + 3]);
            { unsigned short* i16 = (unsigned short*)(ws + WS_IDX16) + ob;
#pragma unroll
              for (int i = 0; i < 2; ++i) *(u32x4*)(i16 + 8 * i) = (u32x4){(unsigned)LP[8 * i] | ((unsigned)LP[8 * i + 1] << 16), (unsigned)LP[8 * i + 2] | ((unsigned)LP[8 * i + 3] << 16),
                                                                        (unsigned)LP[8 * i + 4] | ((unsigned)LP[8 * i + 5] << 16), (unsigned)LP[8 * i + 6] | ((unsigned)LP[8 * i + 7] << 16)}; }
        } else {
#pragma unroll
            for (int i = 0; i < 4; ++i) *(f32x4*)(gw_o + ob + 4 * i) = (f32x4){e[4 * i] * rden, e[4 * i + 1] * rden, e[4 * i + 2] * rden, e[4 * i + 3] * rden};
        }
}
__device__ __forceinline__ void phase_topk(const Args& a, unsigned char* lds_g) {
    LAS unsigned char* lds = (LAS unsigned char*)lds_g;
    const int tid = tid_opaque(), lane = tid & 63, wave = tid >> 6;
    const int gw = blockIdx.x * NWAVES + wave, NGW = gridDim.x * NWAVES;
    const bf16_t* qp = (const bf16_t*)(a.ws + WS_QP);
    for (int task = gw; task < (T / 32) * 8; task += NGW) {
        const int h = task & 7, t0 = (task >> 3) * 32;
        topk_task(a.ws, qp + (size_t)(t0 + (lane & 31)) * DM + h * 256, (LAS int*)(lds + wave * 8192), t0, h, lane);
    }
}
__device__ __forceinline__ void pg8::EpiPeerQFused::fused(const f32x4 (&acc)[2][2][4][2], const Unit& u, int wr, int wc, int fr, int fq, PG8_LAS unsigned char* lds) const {
    constexpr int ROWB = 528;
#pragma unroll
    for (int ai = 0; ai < 2; ++ai)
#pragma unroll
        for (int m = 0; m < 4; ++m) {
            const int tr = ai * HALF + wr * 64 + m * 16 + fr, tk = u.pm * BM + tr;
            float tot = 0.f;
#pragma unroll
            for (int i = 0; i < 8; ++i) { const f32x4 s4 = *(const f32x4*)(ssq + (size_t)tk * 32 + 4 * i); tot += (s4[0] + s4[1]) + (s4[2] + s4[3]); }
            const float r = 1.0f / sqrtf(tot * (1.f / DM) + EPS);
#pragma unroll
            for (int bj = 0; bj < 2; ++bj) {
                const f32x4 v0 = acc[ai][bj][m][0] * r, v1 = acc[ai][bj][m][1] * r;
                u32x4 w; w.x = cvt_pk_bf16(v0[0], v0[1]); w.y = cvt_pk_bf16(v0[2], v0[3]); w.z = cvt_pk_bf16(v1[0], v1[1]); w.w = cvt_pk_bf16(v1[2], v1[3]);
                *(PG8_LAS u32x4*)(lds + tr * ROWB + (bj * HALF + wc * 32 + 8 * fq) * 2) = w;
            }
        }
    __syncthreads();
    const int tid = tid_opaque(), lane = tid & 63, wave = tid >> 6;
    PG8_LAS unsigned char* myrows = lds + (wave * 32) * ROWB;
    topk_task(wsb, (const bf16_t*)(const void*)(myrows + (lane & 31) * ROWB), (LAS int*)myrows, u.pm * BM + wave * 32, u.pn, lane);
}
__device__ __forceinline__ void wave_argmax(float& v, int& i) {
#pragma unroll
    for (int o = 1; o < 64; o <<= 1) { const float ov = sx_f(v, o); const int oi = sx_i(i, o); if (ov > v || (ov == v && oi < i)) { v = ov; i = oi; } }
}
__device__ __forceinline__ void phase_topk_ref(const Args& a) {
    const int tid = tid_opaque(), lane = tid & 63, wave = tid >> 6;
    const int gw = blockIdx.x * NWAVES + wave, NGW = gridDim.x * NWAVES;
    const bf16_t* skb = (const bf16_t*)(a.ws + WS_SK); const bf16_t* qp = (const bf16_t*)(a.ws + WS_QP);
    int* idx_o = (int*)(a.ws + WS_IDX); float* gw_o = (float*)(a.ws + WS_GW);
    for (int task = gw; task < T * 8; task += NGW) {
        const int t = task >> 3, h = task & 7;
        float topS[2]; int topI[2];
        for (int c = 0; c < 2; ++c) {
            const bf16_t* q = qp + (size_t)t * DM + h * 256 + c * 128;
            float sc0 = 0.f, sc1 = 0.f;
            const bf16_t* k0 = skb + (size_t)((h * 2 + c) * 128 + lane) * 128; const bf16_t* k1 = k0 + 64 * 128;
            for (int d = 0; d < 128; ++d) { const float qd = __uint_as_float((unsigned)q[d] << 16);
                sc0 += qd * __uint_as_float((unsigned)k0[d] << 16); sc1 += qd * __uint_as_float((unsigned)k1[d] << 16); }
            float ms = 0.f; int mi = 0;
            for (int r = 0; r < 16; ++r) {
                float v; int i; if (sc0 >= sc1) { v = sc0; i = lane; } else { v = sc1; i = lane + 64; }
                wave_argmax(v, i);
                if (lane == r) { ms = v; mi = i; }
                if (i == lane) sc0 = -__builtin_inff();
                if (i == lane + 64) sc1 = -__builtin_inff();
            }
            topS[c] = ms; topI[c] = mi;
        }
        float cs[4]; int ci[4];
#pragma unroll
        for (int j = 0; j < 4; ++j) { const int cidx = lane * 4 + j, aa = cidx >> 4, bb = cidx & 15;
            cs[j] = sh_f(topS[0], aa) + sh_f(topS[1], bb); ci[j] = cidx; }
        float fs = 0.f; int fi = 0;
        for (int r = 0; r < 16; ++r) {
            float v = cs[0]; int i = ci[0];
#pragma unroll
            for (int j = 1; j < 4; ++j) if (cs[j] > v) { v = cs[j]; i = ci[j]; }
            wave_argmax(v, i);
            if (lane == r) { fs = v; fi = i; }
#pragma unroll
            for (int j = 0; j < 4; ++j) if (ci[j] == i) cs[j] = -__builtin_inff();
        }
        const int e1 = sh_i(topI[0], fi >> 4), e2 = sh_i(topI[1], fi & 15);
        const float mx = sh_f(fs, 0);
        float ev = lane < 16 ? __expf(fs - mx) : 0.f;
        const float den = wave_sum(ev);
        if (lane < 16) { idx_o[(size_t)t * NE + h * 16 + lane] = e1 * 128 + e2; gw_o[(size_t)t * NE + h * 16 + lane] = ev / den; }
    }
}

__device__ __forceinline__ void fp8x16_to_f32(const u32x4 q, f32x2 (&o)[8]) {
    o[0] = __builtin_amdgcn_cvt_pk_f32_fp8((int)q.x, false); o[1] = __builtin_amdgcn_cvt_pk_f32_fp8((int)q.x, true);
    o[2] = __builtin_amdgcn_cvt_pk_f32_fp8((int)q.y, false); o[3] = __builtin_amdgcn_cvt_pk_f32_fp8((int)q.y, true);
    o[4] = __builtin_amdgcn_cvt_pk_f32_fp8((int)q.z, false); o[5] = __builtin_amdgcn_cvt_pk_f32_fp8((int)q.z, true);
    o[6] = __builtin_amdgcn_cvt_pk_f32_fp8((int)q.w, false); o[7] = __builtin_amdgcn_cvt_pk_f32_fp8((int)q.w, true);
}
#define HALVE(dst, srcv, n, bitmask) do { const bool up_ = (lane & (bitmask)) != 0; _Pragma("unroll") for (int i_ = 0; i_ < (n); ++i_) { \
        const float keep_ = up_ ? srcv[(n) + i_] : srcv[i_], send_ = up_ ? srcv[i_] : srcv[(n) + i_]; dst[i_] = keep_ + sx_f(send_, (bitmask)); } } while (0)
#define ITEM_T(n) (wv + ((n) % KT) * NWX)
#define ITEM_S(n) (xl + 8 * ((n) / KT))
#define LD_IDX(ID, n) do { const int4* ip_ = (const int4*)(idx_i + (size_t)ITEM_T(n) * NE + g * 16); _Pragma("unroll") for (int i_ = 0; i_ < 4; ++i_) ID[i_] = ip_[i_]; } while (0)
#define LD_ROWS(Q, ID, TAB, n) do { const unsigned char* b_ = (TAB) + (size_t)ITEM_S(n) * ((size_t)NEXP * 128) + c * 16; _Pragma("unroll") for (int i_ = 0; i_ < 4; ++i_) { \
        Q[4 * i_] = *(const u32x4*)(b_ + (size_t)ID[i_].x * 128); Q[4 * i_ + 1] = *(const u32x4*)(b_ + (size_t)ID[i_].y * 128); \
        Q[4 * i_ + 2] = *(const u32x4*)(b_ + (size_t)ID[i_].z * 128); Q[4 * i_ + 3] = *(const u32x4*)(b_ + (size_t)ID[i_].w * 128); } } while (0)
__device__ __forceinline__ int dpp_hmirror(int v) { return __builtin_amdgcn_update_dpp(0, v, 0x141, 0xf, 0xf, true); }
__device__ __forceinline__ int dpp_qxor2(int v) { return __builtin_amdgcn_update_dpp(0, v, 0x4E, 0xf, 0xf, true); }
__device__ __forceinline__ int dpp_qxor1(int v) { return __builtin_amdgcn_update_dpp(0, v, 0xB1, 0xf, 0xf, true); }
__device__ __forceinline__ void phase_peer_u(const Args& a) {
    const int tid = tid_opaque(), lane = tid & 63, wave = tid >> 6, g = lane >> 3, c = lane & 7;
    const int xl = blockIdx.x & 7, wv = (blockIdx.x >> 3) * NWAVES + wave, NWX = (gridDim.x >> 3) * NWAVES, KT = T / NWX, N = 2 * KT;
    const unsigned char* xq = a.ws + WS_XQ; const unsigned char* u8 = a.ws + WS_U8;
    const unsigned short* idx16 = (const unsigned short*)(a.ws + WS_IDX16); bf16_t* part = (bf16_t*)(a.ws + WS_PART);
    const bool up4 = (c & 4) != 0, up2 = (c & 2) != 0, up1 = (c & 1) != 0;
#define LD_I16(ID, n, h) do { ID = *(const u32x4*)(idx16 + (size_t)ITEM_T(n) * NE + g * 16 + (h) * 8); } while (0)
#define LD_R8(Q, ID, n) do { const unsigned char* b_ = u8 + (size_t)ITEM_S(n) * ((size_t)NEXP * 128) + c * 16; \
        Q[0] = *(const u32x4*)(b_ + (size_t)(ID.x & 0xffffu) * 128); Q[1] = *(const u32x4*)(b_ + (size_t)(ID.x >> 16) * 128); \
        Q[2] = *(const u32x4*)(b_ + (size_t)(ID.y & 0xffffu) * 128); Q[3] = *(const u32x4*)(b_ + (size_t)(ID.y >> 16) * 128); \
        Q[4] = *(const u32x4*)(b_ + (size_t)(ID.z & 0xffffu) * 128); Q[5] = *(const u32x4*)(b_ + (size_t)(ID.z >> 16) * 128); \
        Q[6] = *(const u32x4*)(b_ + (size_t)(ID.w & 0xffffu) * 128); Q[7] = *(const u32x4*)(b_ + (size_t)(ID.w >> 16) * 128); } while (0)
#define LD_X(X, n) do { X = *(const u32x4*)(xq + (size_t)ITEM_T(n) * DM + ITEM_S(n) * 128 + c * 16); } while (0)
#define DOT8(P, OFF, Q, X) do { _Pragma("unroll") for (int i = 0; i < 8; ++i) { int d_ = __builtin_amdgcn_sdot4((int)Q[i].x, (int)X.x, 0, false); d_ = __builtin_amdgcn_sdot4((int)Q[i].y, (int)X.y, d_, false); \
            d_ = __builtin_amdgcn_sdot4((int)Q[i].z, (int)X.z, d_, false); P[(OFF) + i] = __builtin_amdgcn_sdot4((int)Q[i].w, (int)X.w, d_, false); } } while (0)
#define FINISH_U(P, n) do { int p8[8], p4[4], p2[2]; \
        _Pragma("unroll") for (int i = 0; i < 8; ++i) { const int keep_ = up4 ? P[8 + i] : P[i], send_ = up4 ? P[i] : P[8 + i]; p8[i] = keep_ + dpp_hmirror(send_); } \
        _Pragma("unroll") for (int i = 0; i < 4; ++i) { const int keep_ = up2 ? p8[4 + i] : p8[i], send_ = up2 ? p8[i] : p8[4 + i]; p4[i] = keep_ + dpp_qxor2(send_); } \
        _Pragma("unroll") for (int i = 0; i < 2; ++i) { const int keep_ = up1 ? p4[2 + i] : p4[i], send_ = up1 ? p4[i] : p4[2 + i]; p2[i] = keep_ + dpp_qxor1(send_); } \
        *(unsigned*)(part + ((size_t)ITEM_T(n) * 16 + ITEM_S(n)) * NE + 2 * lane) = cvt_pk_bf16((float)p2[0], (float)p2[1]); } while (0)
    u32x4 IA, IB, IC, ID_, QA[8], QB[8], QC[8], QD[8], XA, XB;
    LD_I16(IA, 0, 0); LD_I16(IB, 0, 1); LD_I16(IC, 1, 0); LD_I16(ID_, 1, 1);
    LD_R8(QA, IA, 0); LD_R8(QB, IB, 0); LD_X(XA, 0); LD_R8(QC, IC, 1); LD_R8(QD, ID_, 1); LD_X(XB, 1);
    if (N > 2) { LD_I16(IA, 2, 0); LD_I16(IB, 2, 1); LD_I16(IC, 3, 0); LD_I16(ID_, 3, 1); }
    for (int n = 0; n < N; n += 2) {
        int p[16];
        DOT8(p, 0, QA, XA); if (n + 2 < N) { LD_R8(QA, IA, n + 2); if (n + 4 < N) LD_I16(IA, n + 4, 0); }
        DOT8(p, 8, QB, XA); if (n + 2 < N) { LD_R8(QB, IB, n + 2); LD_X(XA, n + 2); if (n + 4 < N) LD_I16(IB, n + 4, 1); }
        FINISH_U(p, n);
        int r[16];
        DOT8(r, 0, QC, XB); if (n + 3 < N) { LD_R8(QC, IC, n + 3); if (n + 5 < N) LD_I16(IC, n + 5, 0); }
        DOT8(r, 8, QD, XB); if (n + 3 < N) { LD_R8(QD, ID_, n + 3); LD_X(XB, n + 3); if (n + 5 < N) LD_I16(ID_, n + 5, 1); }
        FINISH_U(r, n + 1);
    }
#undef LD_I16
#undef LD_R8
#undef LD_X
#undef DOT8
#undef FINISH_U
}
__device__ __forceinline__ void phase_peer_w(const Args& a) {
    const int gt = blockIdx.x * NTHREADS + tid_opaque(), NGT = gridDim.x * NTHREADS;
    const int* idx_i = (const int*)(a.ws + WS_IDX); const float* gw_i = (const float*)(a.ws + WS_GW); const bf16_t* part = (const bf16_t*)(a.ws + WS_PART);
    const float* suv = (const float*)(a.ws + WS_SUV); const float* sx = (const float*)(a.ws + WS_SX);
    unsigned char* wq = a.ws + WS_WQ; float* sw = (float*)(a.ws + WS_SW);
    for (int item = gt; item < T * NE / 2; item += NGT) {
        const int t = item >> 6, e = (item & 63) * 2;
        unsigned pw[16];
#pragma unroll
        for (int s = 0; s < 16; ++s) pw[s] = *(const unsigned*)(part + ((size_t)t * 16 + s) * NE + e);
        float sum0 = 0.f, sum1 = 0.f;
#pragma unroll
        for (int s = 0; s < 16; ++s) { sum0 += bf_lo(pw[s]); sum1 += bf_hi(pw[s]); }
        const int2 ex = *(const int2*)(idx_i + (size_t)t * NE + e); const f32x2 gg = *(const f32x2*)(gw_i + (size_t)t * NE + e);
        const float sxt = sx[t];
        const float d0 = sum0 * suv[ex.x] * sxt, d1 = sum1 * suv[ex.y] * sxt;
        const float om0 = 0.5f * d0 * (1.f + erff(d0 * 0.70710678118654752f)) * gg.x * suv[NEXP + ex.x];
        const float om1 = 0.5f * d1 * (1.f + erff(d1 * 0.70710678118654752f)) * gg.y * suv[NEXP + ex.y];
        float mx = fmaxf(fabsf(om0), fabsf(om1));
        mx = fmaxf(mx, sx_f(mx, 1)); mx = fmaxf(mx, sx_f(mx, 2)); mx = fmaxf(mx, sx_f(mx, 4));
        const float qs = mx > 0.f ? 127.f / mx : 1.f;
        const int q0 = (int)__builtin_rintf(om0 * qs), q1 = (int)__builtin_rintf(om1 * qs);
        *(unsigned short*)(wq + (size_t)t * NE + e) = (unsigned short)(((unsigned)q0 & 0xffu) | (((unsigned)q1 & 0xffu) << 8));
        if ((e & 15) == 0) sw[t * 8 + (e >> 4)] = mx * (1.f / 127.f);
    }
}
__device__ __forceinline__ void phase_peer_v(const Args& a, float* dst) {
    const int tid = tid_opaque(), lane = tid & 63, wave = tid >> 6, g = lane >> 3, c = lane & 7;
    const int xl = blockIdx.x & 7, wv = (blockIdx.x >> 3) * NWAVES + wave, NWX = (gridDim.x >> 3) * NWAVES, KT = T / NWX, N = 2 * KT;
    const unsigned char* v8 = a.ws + WS_V8;
    const int* idx_i = (const int*)(a.ws + WS_IDX); const unsigned char* wq = a.ws + WS_WQ; const float* sw = (const float*)(a.ws + WS_SW);
    const bf16_t* hsrc = (const bf16_t*)(a.ws + WS_HB);
#define LD_W(W, SWV, HV, n) do { W = *(const u32x4*)(wq + (size_t)ITEM_T(n) * NE + g * 16); SWV = sw[ITEM_T(n) * 8 + g]; HV = *(const unsigned*)(hsrc + (size_t)ITEM_T(n) * DM + ITEM_S(n) * 128 + 2 * lane); } while (0)
#define QUAD(A_, B_, C_, D_, W_, A0, A1, A2, A3) do { \
        const unsigned ablo_ = __builtin_amdgcn_perm(B_, A_, 0x05010400u), abhi_ = __builtin_amdgcn_perm(B_, A_, 0x07030602u); \
        const unsigned cdlo_ = __builtin_amdgcn_perm(D_, C_, 0x05010400u), cdhi_ = __builtin_amdgcn_perm(D_, C_, 0x07030602u); \
        A0 = __builtin_amdgcn_sdot4((int)__builtin_amdgcn_perm(cdlo_, ablo_, 0x05040100u), (int)(W_), A0, false); \
        A1 = __builtin_amdgcn_sdot4((int)__builtin_amdgcn_perm(cdlo_, ablo_, 0x07060302u), (int)(W_), A1, false); \
        A2 = __builtin_amdgcn_sdot4((int)__builtin_amdgcn_perm(cdhi_, abhi_, 0x05040100u), (int)(W_), A2, false); \
        A3 = __builtin_amdgcn_sdot4((int)__builtin_amdgcn_perm(cdhi_, abhi_, 0x07060302u), (int)(W_), A3, false); } while (0)
#define COMPUTE_V(Q, W, SWV, HV, n) do { int ac[16]; _Pragma("unroll") for (int k = 0; k < 16; ++k) ac[k] = 0; \
        _Pragma("unroll") for (int q_ = 0; q_ < 4; ++q_) { const unsigned w_ = q_ == 0 ? W.x : q_ == 1 ? W.y : q_ == 2 ? W.z : W.w; \
            QUAD(Q[4 * q_].x, Q[4 * q_ + 1].x, Q[4 * q_ + 2].x, Q[4 * q_ + 3].x, w_, ac[0], ac[1], ac[2], ac[3]); \
            QUAD(Q[4 * q_].y, Q[4 * q_ + 1].y, Q[4 * q_ + 2].y, Q[4 * q_ + 3].y, w_, ac[4], ac[5], ac[6], ac[7]); \
            QUAD(Q[4 * q_].z, Q[4 * q_ + 1].z, Q[4 * q_ + 2].z, Q[4 * q_ + 3].z, w_, ac[8], ac[9], ac[10], ac[11]); \
            QUAD(Q[4 * q_].w, Q[4 * q_ + 1].w, Q[4 * q_ + 2].w, Q[4 * q_ + 3].w, w_, ac[12], ac[13], ac[14], ac[15]); } \
        float p[16]; _Pragma("unroll") for (int k = 0; k < 16; ++k) p[k] = (float)ac[k] * SWV; \
        float p8[8], p4[4], p2[2]; \
        _Pragma("unroll") for (int i_ = 0; i_ < 8; ++i_) { auto rr_ = __builtin_amdgcn_permlane32_swap(__float_as_uint(p[i_]), __float_as_uint(p[8 + i_]), false, false); p8[i_] = __uint_as_float(rr_[0]) + __uint_as_float(rr_[1]); } \
        _Pragma("unroll") for (int i_ = 0; i_ < 4; ++i_) { auto rr_ = __builtin_amdgcn_permlane16_swap(__float_as_uint(p8[i_]), __float_as_uint(p8[4 + i_]), false, false); p4[i_] = __uint_as_float(rr_[0]) + __uint_as_float(rr_[1]); } \
        HALVE(p2, p4, 2, 8); \
        const int srcl_ = ((lane & 7) << 3) | (lane >> 3);                     \
        const float q0_ = sh_f(p2[0], srcl_), q1_ = sh_f(p2[1], srcl_); \
        const size_t o_ = (size_t)ITEM_T(n) * DM + ITEM_S(n) * 128 + 2 * lane; \
        *(f32x2*)(dst + o_) = (f32x2){bf_lo(HV) + q0_, bf_hi(HV) + q1_}; } while (0)
    int4 IA[4], IB[4]; u32x4 QA[16], QB[16], WA, WB; float SA, SB_; unsigned HA, HB_;
    LD_IDX(IA, 0); LD_IDX(IB, 1);
    LD_ROWS(QA, IA, v8, 0); LD_W(WA, SA, HA, 0);
    for (int n = 0; n < N; n += 2) {
        LD_ROWS(QB, IB, v8, n + 1); LD_W(WB, SB_, HB_, n + 1);
        if (n + 2 < N) LD_IDX(IA, n + 2);
        COMPUTE_V(QA, WA, SA, HA, n);
        if (n + 2 < N) { LD_ROWS(QA, IA, v8, n + 2); LD_W(WA, SA, HA, n + 2); }
        if (n + 3 < N) LD_IDX(IB, n + 3);
        COMPUTE_V(QB, WB, SB_, HB_, n + 1);
    }
#undef LD_W
#undef QUAD
#undef COMPUTE_V
}
#undef ITEM_T
#undef ITEM_S
#undef LD_IDX
#undef LD_ROWS
#undef HALVE


constexpr int NPHASE = 11;
#define LOAD_ARGS() do { } while (0)
__global__ void __launch_bounds__(NTHREADS, 2) fwd_kernel(Args a) {
    extern __shared__ __attribute__((aligned(16))) unsigned char lds[];
#if MK_ONE_LAUNCH
    constexpr int lo = 0, hi = NPHASE;
    cg::grid_group grid = cg::this_grid();
    volatile LAS unsigned* misc = (volatile LAS unsigned*)((LAS unsigned char*)lds + MISC_OFF);
    if (threadIdx.x < 16) misc[threadIdx.x] = 0u;
    __syncthreads();
    { LOAD_ARGS(); (void)xcd_barrier_post((unsigned*)(a.ws + WS_CTL) + CW_BAR, misc + 8); }
#ifndef SEAM_CG_MASK
#define SEAM_CG_MASK 0
#endif
#define SEAM(k) do { if (lo <= (k) && (k) + 1 < hi) { if ((SEAM_CG_MASK >> (k)) & 1) grid.sync(); else { LOAD_ARGS(); XcdBarrier xb_; xb_.bar = (unsigned*)(a.ws + WS_CTL) + CW_BAR; xb_.x = xb_xcc_id(); \
        xb_.st = (volatile LAS unsigned*)((LAS unsigned char*)lds + MISC_OFF) + 8; xcd_barrier(xb_); } } } while (0)
#else
    int lo, hi; { LOAD_ARGS(); lo = a.ph_lo; hi = a.ph_hi; }
#define SEAM(k) do { } while (0)
#endif
#define IN(k) (lo <= (k) && (k) < hi)
#ifndef DUP_PHASE
#define DUP_PHASE -1
#endif
    if (IN(0)) { LOAD_ARGS(); phase0(a, lds); if (DUP_PHASE == 0) { __syncthreads(); phase0(a, lds); } SEAM(0); }
    if (IN(1)) { LOAD_ARGS(); unsigned char* ws = a.ws;
        pg8::Gemm g{(const bf16_t*)(ws + WS_XN), (const bf16_t*)(ws + WS_WIN), T, NPROJ, DM}; pg8::StaticOrder S; S.init(T, NPROJ, (int)gridDim.x, (int)blockIdx.x);
        pg8::EpiInProj E{(bf16_t*)(ws + WS_SEC), (const float*)(ws + WS_SXN), (const float*)(ws + WS_WSC), a.in[4], a.in[5], (LAS float*)((LAS unsigned char*)lds + RING_BYTES)};
        for (int rep_ = 0; rep_ < (DUP_PHASE == 1 ? 2 : 1); ++rep_)
        pg8::gemm_phase<pg8::EpiInProj, pg8::StaticOrder, true, true, true>((LAS unsigned char*)lds, g, S, E);
        cumsum_rows(a);
        { const int nwg_ = (T / 256) * (NPROJ / 256), G_ = (int)gridDim.x, rem_ = nwg_ % G_;
          if (rem_ > 0 && (int)blockIdx.x >= rem_) convert_tables(a, TAB_SPLIT, 2 * NEXP, ((int)blockIdx.x - rem_) * NWAVES + (tid_opaque() >> 6), (G_ - rem_) * NWAVES);
          else if (rem_ == 0) convert_tables(a, TAB_SPLIT, 2 * NEXP, (int)blockIdx.x * NWAVES + (tid_opaque() >> 6), G_ * NWAVES); }
        SEAM(1);
    }
    if (IN(3)) { LOAD_ARGS(); phase_attn(a, lds);
#if MK_ONE_LAUNCH
        if (DUP_PHASE == 3) { XcdBarrier xb_; xb_.bar = (unsigned*)(a.ws + WS_CTL) + CW_BAR; xb_.x = xb_xcc_id(); xb_.st = (volatile LAS unsigned*)((LAS unsigned char*)lds + MISC_OFF) + 8;
            xcd_barrier(xb_); if (blockIdx.x == 0 && threadIdx.x == 0) __hip_atomic_store((unsigned*)(a.ws + WS_CTL), 0u, __ATOMIC_RELAXED, __HIP_MEMORY_SCOPE_AGENT); xcd_barrier(xb_); phase_attn(a, lds); }
#endif
        SEAM(3); }
    if (IN(4)) { LOAD_ARGS(); phase_attn_combine(a); SEAM(4); }
    if (IN(5)) { LOAD_ARGS(); unsigned char* ws = a.ws;
        pg8::Gemm g{(const bf16_t*)(ws + WS_MIX), (const bf16_t*)(ws + WS_WOUT), T, DM, DM}; pg8::StaticOrder S; S.init(T, DM, (int)gridDim.x, (int)blockIdx.x);
        pg8::EpiOutProj E{a.in[0], a.out, (bf16_t*)(ws + WS_HB), (float*)(ws + WS_SSQ), (float*)(ws + WS_AMX)};
        for (int rep_ = 0; rep_ < (DUP_PHASE == 5 ? 2 : 1); ++rep_)
        pg8::gemm_phase<pg8::EpiOutProj, pg8::StaticOrder, true, true>((LAS unsigned char*)lds, g, S, E);
        SEAM(5);
    }
    if (IN(6)) { LOAD_ARGS(); unsigned char* ws = a.ws;
        pg8::Gemm g{(const bf16_t*)(ws + WS_HB), (const bf16_t*)(ws + WS_WPQ), T, DM, DM}; pg8::StaticOrder S; S.init(T, DM, (int)gridDim.x, (int)blockIdx.x);
        pg8::EpiPeerQFused E{(const float*)(ws + WS_SSQ), ws};
        pg8::gemm_phase<pg8::EpiPeerQFused, pg8::StaticOrder, true, true>((LAS unsigned char*)lds, g, S, E);
        SEAM(6);
    }
    if (IN(8)) { LOAD_ARGS(); for (int rep_ = 0; rep_ < (DUP_PHASE == 8 ? 2 : 1); ++rep_) phase_peer_u(a); SEAM(8); }
    if (IN(9)) { LOAD_ARGS(); for (int rep_ = 0; rep_ < (DUP_PHASE == 9 ? 2 : 1); ++rep_) phase_peer_w(a); SEAM(9); }
    if (IN(10)) { LOAD_ARGS(); for (int rep_ = 0; rep_ < (DUP_PHASE == 10 ? 2 : 1); ++rep_) phase_peer_v(a, (DUP_PHASE == 10 && rep_ == 0) ? (float*)(a.ws + WS_END) : a.out); }
#undef IN
#undef SEAM
}

extern "C" void kernel_launch(void* const* d_in, const int* in_sizes, int n_in, void* d_out, int out_size, void* d_ws, size_t ws_size, hipStream_t stream) {
    static int grid = 0;
    if (grid == 0) {
        if (n_in != 12 || in_sizes[0] != T * DM || out_size != T * DM || ws_size < WS_END) { fprintf(stderr, "kernel_launch: unexpected shapes (n_in %d, in0 %d, out %d, ws %zu)\n", n_in, n_in > 0 ? in_sizes[0] : -1, out_size, ws_size); grid = -1; return; }
        int dev = 0, cus = 0, per_cu = 0;
        if (hipGetDevice(&dev) != hipSuccess || hipDeviceGetAttribute(&cus, hipDeviceAttributeMultiprocessorCount, dev) != hipSuccess) { grid = -1; return; }
        if (hipFuncSetAttribute((const void*)fwd_kernel, hipFuncAttributeMaxDynamicSharedMemorySize, LDS_BYTES) != hipSuccess) { fprintf(stderr, "kernel_launch: hipFuncSetAttribute failed\n"); grid = -1; return; }
        if (hipOccupancyMaxActiveBlocksPerMultiprocessor(&per_cu, (const void*)fwd_kernel, NTHREADS, LDS_BYTES) != hipSuccess || per_cu < 1) { fprintf(stderr, "kernel_launch: occupancy query says %d\n", per_cu); grid = -1; return; }
        grid = cus;
    }
    if (grid < 0) return;
    (void)hipMemsetAsync((char*)d_ws + WS_CTL, 0, CTL_BYTES, stream);
    Args a{};
    for (int i = 0; i < 12; ++i) a.in[i] = (const float*)d_in[i];
    a.out = (float*)d_out; a.ws = (unsigned char*)d_ws;
#if MK_ONE_LAUNCH
    a.ph_lo = 0; a.ph_hi = NPHASE;
    void* args[] = {&a};
#if MK_COOP_LAUNCH
    hipError_t e = hipLaunchCooperativeKernel((const void*)fwd_kernel, dim3(grid), dim3(NTHREADS), args, LDS_BYTES, stream);
    if (e != hipSuccess) fprintf(stderr, "cooperative launch failed: %s (grid %d)\n", hipGetErrorString(e), grid);
#else
    (void)args; hipLaunchKernelGGL(fwd_kernel, dim3(grid), dim3(NTHREADS), LDS_BYTES, stream, a);
#endif
#else
    for (int p = 0; p < NPHASE; ++p) { a.ph_lo = p; a.ph_hi = p + 1; hipLaunchKernelGGL(fwd_kernel, dim3(grid), dim3(NTHREADS), LDS_BYTES, stream, a); }
#endif
}
```

```cpp
#include <hip/hip_runtime.h>
#include <hip/hip_cooperative_groups.h>
#include <cstdio>
#include <cstdint>
namespace cg = cooperative_groups;

#ifndef MK_COOP_LAUNCH
#define MK_COOP_LAUNCH 0
#endif
#ifndef MK_ONE_LAUNCH
#define MK_ONE_LAUNCH 1
#endif

#define LAS __attribute__((address_space(3)))
typedef unsigned short bf16_t;
typedef short bf16x8 __attribute__((ext_vector_type(8)));
typedef short s16x4 __attribute__((ext_vector_type(4)));
typedef float f32x2 __attribute__((ext_vector_type(2)));
typedef float f32x4 __attribute__((ext_vector_type(4)));
typedef float f32x16 __attribute__((ext_vector_type(16)));
typedef unsigned u32x2 __attribute__((ext_vector_type(2)));
typedef unsigned u32x4 __attribute__((ext_vector_type(4)));
typedef __bf16 bf16x2_t __attribute__((ext_vector_type(2)));

constexpr int NB = 2, SEQ = 4096, T = NB * SEQ, DM = 2048, HD = 128, NHF = 8, DIN = 7176, NPROJ = 7168;
constexpr int NEXP = 16384, NE = 128;
constexpr float EPS = 1e-6f;
constexpr float SCALE = 0.08838834764831845f, LOG2E = 1.4426950408889634f;
constexpr int NWAVES = 8, NTHREADS = 512;

constexpr size_t MiB = 1u << 20;
constexpr size_t WS_CTL = 0, CTL_BYTES = 32768;
constexpr int CW_BAR = 1024;
constexpr size_t WS_SXN = 64 * MiB  , WS_WSC = 45 * MiB + 800 * 1024  ;
constexpr int CW_WMAX = 64;
constexpr size_t WS_GQK = 45 * MiB + 768 * 1024;
constexpr size_t WS_WIN = 1 * MiB, WS_WOUT = 29 * MiB, WS_WPQ = 37 * MiB, WS_SK = 45 * MiB, WS_LOGF = 46 * MiB, WS_C = 46 * MiB + 512 * 1024, WS_SSQ = 47 * MiB;
constexpr size_t WS_XN = 48 * MiB;
constexpr size_t WS_SEC = 80 * MiB;
constexpr size_t SEC_ELEMS = 8u << 20;
constexpr size_t WS_MIX = 192 * MiB, WS_HB = 224 * MiB, WS_QP = 256 * MiB, WS_IDX = 288 * MiB, WS_GW = 292 * MiB, WS_U8 = 296 * MiB, WS_V8 = 328 * MiB, WS_SUV = 360 * MiB  , WS_RT = 360 * MiB + 256 * 1024  , WS_W = 361 * MiB  ,
                 WS_PART = 368 * MiB  , WS_XQ = 432 * MiB  , WS_END = 448 * MiB;
constexpr size_t WS_IDX16 = 366 * MiB  ;
constexpr size_t WS_AMX = 365 * MiB  , WS_SX = WS_RT + 64 * 1024  , WS_WQ = WS_W  , WS_SW = WS_W + 2 * MiB  ;
constexpr size_t WS_PO = WS_PART  , WS_PML = WS_PART + 32 * MiB  ;

constexpr int RING_BYTES = 131072;
constexpr int MISC_OFF = 143360;
constexpr int LDS_BYTES = 147456;

__device__ __forceinline__ unsigned cvt_pk_bf16(float lo, float hi) { unsigned r; asm volatile("v_cvt_pk_bf16_f32 %0, %1, %2" : "=v"(r) : "v"(lo), "v"(hi)); return r; }
__device__ __forceinline__ float bf_lo(unsigned u) { return __builtin_bit_cast(float, u << 16); }
__device__ __forceinline__ float bf_hi(unsigned u) { return __builtin_bit_cast(float, u & 0xffff0000u); }
__device__ __forceinline__ int lane_id_fresh() { int l = (int)__builtin_amdgcn_mbcnt_hi(~0u, __builtin_amdgcn_mbcnt_lo(~0u, 0u)); asm volatile("" : "+v"(l)); return l; }
__device__ __forceinline__ int sx_i(int v, int m) { return __builtin_amdgcn_ds_bpermute((lane_id_fresh() ^ m) << 2, v); }
__device__ __forceinline__ float sx_f(float v, int m) { return __int_as_float(__builtin_amdgcn_ds_bpermute((lane_id_fresh() ^ m) << 2, __float_as_int(v))); }
__device__ __forceinline__ int sh_i(int v, int src) { return __builtin_amdgcn_ds_bpermute(src << 2, v); }
__device__ __forceinline__ float sh_f(float v, int src) { return __int_as_float(__builtin_amdgcn_ds_bpermute(src << 2, __float_as_int(v))); }
__device__ __forceinline__ float shup_f(float v, int d) { const int l = lane_id_fresh(); const int s = l - d; return __int_as_float(__builtin_amdgcn_ds_bpermute((s < 0 ? l : s) << 2, __float_as_int(v))); }
__device__ __forceinline__ float wave_sum(float v) {
    v += __int_as_float(__builtin_amdgcn_update_dpp(0, __float_as_int(v), 0xB1, 0xf, 0xf, true));
    v += __int_as_float(__builtin_amdgcn_update_dpp(0, __float_as_int(v), 0x4E, 0xf, 0xf, true));
    v += __int_as_float(__builtin_amdgcn_update_dpp(0, __float_as_int(v), 0x141, 0xf, 0xf, true));
    v += __int_as_float(__builtin_amdgcn_update_dpp(0, __float_as_int(v), 0x140, 0xf, 0xf, true));
    { auto rr = __builtin_amdgcn_permlane16_swap(__float_as_uint(v), __float_as_uint(v), false, false); v = __uint_as_float(rr[0]) + __uint_as_float(rr[1]); }
    { auto rr = __builtin_amdgcn_permlane32_swap(__float_as_uint(v), __float_as_uint(v), false, false); v = __uint_as_float(rr[0]) + __uint_as_float(rr[1]); }
    return v;
}
#define DPP_QX1 0xB1
#define DPP_QX2 0x4E
#define DPP_HMIR 0x141
#define DPP_MIR 0x140
__device__ __forceinline__ float wave_max(float v) {
    v = fmaxf(v, __int_as_float(__builtin_amdgcn_update_dpp(0, __float_as_int(v), DPP_QX1, 0xf, 0xf, true)));
    v = fmaxf(v, __int_as_float(__builtin_amdgcn_update_dpp(0, __float_as_int(v), DPP_QX2, 0xf, 0xf, true)));
    v = fmaxf(v, __int_as_float(__builtin_amdgcn_update_dpp(0, __float_as_int(v), DPP_HMIR, 0xf, 0xf, true)));
    v = fmaxf(v, __int_as_float(__builtin_amdgcn_update_dpp(0, __float_as_int(v), DPP_MIR, 0xf, 0xf, true)));
    { auto rr = __builtin_amdgcn_permlane16_swap(__float_as_uint(v), __float_as_uint(v), false, false); v = fmaxf(__uint_as_float(rr[0]), __uint_as_float(rr[1])); }
    { auto rr = __builtin_amdgcn_permlane32_swap(__float_as_uint(v), __float_as_uint(v), false, false); v = fmaxf(__uint_as_float(rr[0]), __uint_as_float(rr[1])); }
    return v;
}
__device__ __forceinline__ int tid_opaque() { int t = (int)threadIdx.x; asm volatile("" : "+v"(t)); return t; }
#define LDS_WAIT() asm volatile("s_waitcnt lgkmcnt(0)" ::: "memory")

namespace pg8 {
#define PG8_LAS __attribute__((address_space(3)))
constexpr int BM = 256, BK = 64, HALF = 128, HTB = HALF * BK * 2, STAGE_BYTES = 8 * HTB, NXCD = 8, WGM = 8;
__host__ __device__ __forceinline__ int lds_byte(int r, int c) { const int st = (r >> 4) * 2 + (c >> 5), rr = r & 15, cc = c & 31, ob = rr * 64 + cc * 2; return st * 1024 + (ob ^ (((ob >> 9) & 1) << 5)); }
__host__ __device__ __forceinline__ void stage_rc(int b, int& R, int& C) { const int st = b / 1024, sb = b % 1024, swz = sb ^ (((sb >> 9) & 1) << 5); R = (st >> 1) * 16 + swz / 64; C = (st & 1) * 32 + (swz % 64) / 2; }
__host__ __device__ __forceinline__ int perm32(int rho) { const int n = rho >> 4, i = rho & 15; return 8 * (i >> 2) + 4 * n + (i & 3); }
struct Unit { int pm, pn; };
struct Gemm { const bf16_t* A; const bf16_t* Bt; int M, N, K; };
struct StaticOrder {
    int nM, nN, nwg, G, c;
    __host__ __device__ void init(int M, int N, int G_, int c_) { nM = M / BM; nN = N / BM; nwg = nM * nN; G = G_; c = c_; }
    __host__ __device__ bool next(int i, Unit& u) const {
        const long L = (long)i * G + c; if (L >= nwg) return false;
        int wgid = (int)L; { const int q = nwg / NXCD, r = nwg % NXCD, xcd = wgid % NXCD, off = wgid / NXCD; wgid = (xcd < r ? xcd * (q + 1) : r * (q + 1) + (xcd - r) * q) + off; }
        const int nig = WGM * nN, gid = wgid / nig, fm = gid * WGM, gsz = (nM - fm) < WGM ? (nM - fm) : WGM;
        u.pm = fm + ((wgid % nig) % gsz); u.pn = (wgid % nig) / gsz; return true;
    }
    __device__ __forceinline__ void a_ready(const Unit&) const {}
    __device__ __forceinline__ void done(const Unit&) const {}
};

typedef int i32x4 __attribute__((ext_vector_type(4)));
template <bool I8> struct AccT { typedef f32x4 type; };
template <> struct AccT<true> { typedef i32x4 type; };
template <class Epi, class Sched, bool ALIGN_EPI = false, bool SP2 = false, bool I8 = false>
__device__ __forceinline__ void gemm_phase(PG8_LAS unsigned char* lds, const Gemm g, const Sched& S, const Epi& E) {
    typedef typename AccT<I8>::type acc_t;
    const int tid = tid_opaque(), wid = __builtin_amdgcn_readfirstlane(tid >> 6), lane = tid & 63, wr = wid >> 2, wc = wid & 3, fr = lane & 15, fq = lane >> 4;
    const int rowb = I8 ? g.K : 2 * g.K, nt = rowb / (BK * 2);
    unsigned voffA[2], voffB[2];
#pragma unroll
    for (int i = 0; i < 2; ++i) { int R, C; stage_rc(tid * 16 + i * 8192, R, C); const int Rb = Epi::PERM ? ((R & ~31) + perm32(R & 31)) : R;
        voffA[i] = (unsigned)(R * rowb + C * 2); voffB[i] = (unsigned)(Rb * rowb + C * 2); }
    const size_t kstep = (size_t)(BK * 2);
    const size_t hstep = (size_t)HALF * rowb;
    const size_t tstep = 2 * hstep;
    const unsigned ldsw = (unsigned)wid * 1024u;
    const int aoff = lds_byte(wr * 64 + fr, fq * 8), boff = lds_byte(wc * 32 + fr, fq * 8);
#define PG8_SA(b, h) (((b) * 2 + (h)) * HTB)
#define PG8_SB(b, h) ((4 + (b) * 2 + (h)) * HTB)
#define PG8_STAGE(bufoff, gbase, voff) do { _Pragma("unroll") for (int _i = 0; _i < 2; ++_i) \
        __builtin_amdgcn_global_load_lds((const unsigned*)((const char*)(gbase) + (voff)[_i]), (PG8_LAS unsigned*)(lds + (bufoff) + ldsw + _i * 8192), 16, 0, 0); } while (0)
#define PG8_LDA(dst, b, h) do { _Pragma("unroll") for (int m = 0; m < 4; ++m) _Pragma("unroll") for (int k = 0; k < 2; ++k) dst[m][k] = *(const PG8_LAS bf16x8*)(lds + PG8_SA(b, h) + aoff + m * 2048 + k * 1024); } while (0)
#define PG8_LDB(dst, b, h) do { _Pragma("unroll") for (int n = 0; n < 2; ++n) _Pragma("unroll") for (int k = 0; k < 2; ++k) dst[n][k] = *(const PG8_LAS bf16x8*)(lds + PG8_SB(b, h) + boff + n * 2048 + k * 1024); } while (0)
#define PG8_MMA(ai, bj, At, Bt) do { __builtin_amdgcn_s_setprio(1); _Pragma("unroll") for (int m = 0; m < 4; ++m) _Pragma("unroll") for (int n = 0; n < 2; ++n) _Pragma("unroll") for (int k = 0; k < 2; ++k) \
        { if constexpr (I8) acc[ai][bj][m][n] = __builtin_amdgcn_mfma_i32_16x16x64_i8(__builtin_bit_cast(i32x4, Bt[n][k]), __builtin_bit_cast(i32x4, At[m][k]), acc[ai][bj][m][n], 0, 0, 0); \
          else acc[ai][bj][m][n] = __builtin_amdgcn_mfma_f32_16x16x32_bf16(Bt[n][k], At[m][k], acc[ai][bj][m][n], 0, 0, 0); } __builtin_amdgcn_s_setprio(0); } while (0)
#define PG8_WAIT_V(n) asm volatile("s_waitcnt vmcnt(" #n ")" ::: "memory")
#define PG8_WAIT_L(n) asm volatile("s_waitcnt lgkmcnt(" #n ")" ::: "memory")
#define PG8_BAR __builtin_amdgcn_s_barrier()
#define PG8_SCHED __builtin_amdgcn_sched_barrier(0)
    Unit cur, nxt; int ui = 0;
    if (!S.next(0, cur)) return;
    acc_t acc[2][2][4][2];
#pragma unroll
    for (int a = 0; a < 2; ++a)
#pragma unroll
        for (int b = 0; b < 2; ++b)
#pragma unroll
            for (int m = 0; m < 4; ++m)
#pragma unroll
                for (int n = 0; n < 2; ++n) acc[a][b][m][n] = acc_t{};
    bf16x8 At[4][2], B0[2][2], B1[2][2];
    const char* cA = (const char*)g.A + (size_t)cur.pm * tstep; const char* cB = (const char*)g.Bt + (size_t)cur.pn * tstep;
    S.a_ready(cur);
    if constexpr (SP2) {
        PG8_STAGE(PG8_SB(0, 0), cB, voffB); PG8_STAGE(PG8_SB(0, 1), cB + hstep, voffB); PG8_STAGE(PG8_SA(0, 0), cA, voffA); PG8_STAGE(PG8_SA(0, 1), cA + hstep, voffA);
        if (wr == 1) PG8_BAR;
        PG8_WAIT_V(2); PG8_BAR;
        PG8_STAGE(PG8_SB(1, 0), cB + kstep, voffB); PG8_STAGE(PG8_SA(1, 0), cA + kstep, voffA); PG8_STAGE(PG8_SB(1, 1), cB + hstep + kstep, voffB);
        PG8_WAIT_V(6); PG8_BAR;
    } else {
        PG8_STAGE(PG8_SB(0, 0), cB, voffB); PG8_STAGE(PG8_SA(0, 0), cA, voffA); PG8_STAGE(PG8_SB(0, 1), cB + hstep, voffB); PG8_STAGE(PG8_SA(0, 1), cA + hstep, voffA);
        if (wr == 1) PG8_BAR;
        PG8_WAIT_V(4); PG8_BAR;
        PG8_STAGE(PG8_SB(1, 0), cB + kstep, voffB); PG8_STAGE(PG8_SA(1, 0), cA + kstep, voffA); PG8_STAGE(PG8_SB(1, 1), cB + hstep + kstep, voffB);
        PG8_WAIT_V(6); PG8_BAR;
    }
    for (;;) {
        const bool has_next = S.next(ui + 1, nxt);
        const char* nA = has_next ? (const char*)g.A + (size_t)nxt.pm * tstep : cA; const char* nB = has_next ? (const char*)g.Bt + (size_t)nxt.pn * tstep : cB;
        for (int t = 0; t < nt; t += 2) {
            const bool last = (t == nt - 2);
            const char* a1 = cA + (size_t)(t + 1) * kstep;
            const char* a2 = last ? nA : cA + (size_t)(t + 2) * kstep; const char* b2 = last ? nB : cB + (size_t)(t + 2) * kstep;
            const char* a3 = a2 + kstep; const char* b3 = b2 + kstep;
            if (last && has_next) S.a_ready(nxt);
            if constexpr (SP2) {
            PG8_LDB(B0, 0, 0); PG8_LDB(B1, 0, 1); PG8_SCHED; PG8_LDA(At, 0, 0); PG8_STAGE(PG8_SA(1, 1), a1 + hstep, voffA);
            PG8_WAIT_V(8); PG8_WAIT_L(0); PG8_BAR; PG8_MMA(0, 0, At, B0); PG8_MMA(0, 1, At, B1); PG8_BAR; PG8_SCHED;
            PG8_LDA(At, 0, 1); PG8_STAGE(PG8_SB(0, 0), b2, voffB); PG8_STAGE(PG8_SB(0, 1), b2 + hstep, voffB); PG8_STAGE(PG8_SA(0, 0), a2, voffA);
            PG8_WAIT_V(8); PG8_WAIT_L(0); PG8_BAR; PG8_MMA(1, 0, At, B0); PG8_MMA(1, 1, At, B1); PG8_BAR; PG8_SCHED;
            PG8_LDB(B0, 1, 0); PG8_LDB(B1, 1, 1); PG8_SCHED; PG8_LDA(At, 1, 0); PG8_STAGE(PG8_SA(0, 1), a2 + hstep, voffA);
            PG8_WAIT_V(8); PG8_WAIT_L(0); PG8_BAR; PG8_MMA(0, 0, At, B0); PG8_MMA(0, 1, At, B1); PG8_BAR; PG8_SCHED;
            PG8_LDA(At, 1, 1); PG8_STAGE(PG8_SB(1, 0), b3, voffB); PG8_STAGE(PG8_SB(1, 1), b3 + hstep, voffB); PG8_STAGE(PG8_SA(1, 0), a3, voffA);
            PG8_WAIT_V(8); PG8_WAIT_L(0); PG8_BAR; PG8_MMA(1, 0, At, B0); PG8_MMA(1, 1, At, B1); PG8_BAR; PG8_SCHED;
            } else {
            PG8_LDB(B0, 0, 0); PG8_SCHED; PG8_LDA(At, 0, 0); PG8_STAGE(PG8_SA(1, 1), a1 + hstep, voffA);
            PG8_WAIT_L(8); PG8_BAR; PG8_WAIT_L(0); PG8_MMA(0, 0, At, B0); PG8_BAR; PG8_SCHED;
            PG8_LDB(B1, 0, 1); PG8_STAGE(PG8_SB(0, 0), b2, voffB);
            PG8_BAR; PG8_WAIT_L(0); PG8_MMA(0, 1, At, B1); PG8_BAR;
            PG8_LDA(At, 0, 1); PG8_STAGE(PG8_SA(0, 0), a2, voffA);
            PG8_BAR; PG8_WAIT_L(0); PG8_MMA(1, 0, At, B0); PG8_BAR; PG8_SCHED;
            PG8_STAGE(PG8_SB(0, 1), b2 + hstep, voffB);
            PG8_WAIT_V(6); PG8_BAR; PG8_MMA(1, 1, At, B1); PG8_BAR;
            PG8_LDB(B0, 1, 0); PG8_SCHED; PG8_LDA(At, 1, 0); PG8_STAGE(PG8_SA(0, 1), a2 + hstep, voffA);
            PG8_WAIT_L(8); PG8_BAR; PG8_WAIT_L(0); PG8_MMA(0, 0, At, B0); PG8_BAR; PG8_SCHED;
            PG8_LDB(B1, 1, 1); PG8_STAGE(PG8_SB(1, 0), b3, voffB);
            PG8_BAR; PG8_WAIT_L(0); PG8_MMA(0, 1, At, B1); PG8_BAR;
            PG8_LDA(At, 1, 1); PG8_STAGE(PG8_SA(1, 0), a3, voffA);
            PG8_BAR; PG8_WAIT_L(0); PG8_MMA(1, 0, At, B0); PG8_BAR; PG8_SCHED;
            PG8_STAGE(PG8_SB(1, 1), b3 + hstep, voffB);
            PG8_WAIT_V(6); PG8_BAR; PG8_MMA(1, 1, At, B1); PG8_BAR;
            }
        }
        if constexpr (ALIGN_EPI) { if (wr == 0) PG8_BAR; }
        if constexpr (!Epi::AFTER_DRAIN) { E(acc, cur, wr, wc, fr, fq); } S.done(cur);
        if (!has_next) break;
#pragma unroll
        for (int a = 0; a < 2; ++a)
#pragma unroll
            for (int b = 0; b < 2; ++b)
#pragma unroll
                for (int m = 0; m < 4; ++m)
#pragma unroll
                    for (int n = 0; n < 2; ++n) acc[a][b][m][n] = acc_t{};
        cur = nxt; cA = nA; cB = nB; ++ui;
        if constexpr (ALIGN_EPI) { if (wr == 1) PG8_BAR; }
    }
    PG8_WAIT_V(0);
    if constexpr (!ALIGN_EPI) { if (wr == 0) PG8_BAR; }
    PG8_BAR;
    if constexpr (Epi::AFTER_DRAIN) E.fused(acc, cur, wr, wc, fr, fq, lds);
#undef PG8_SA
#undef PG8_SB
#undef PG8_STAGE
#undef PG8_LDA
#undef PG8_LDB
#undef PG8_MMA
#undef PG8_WAIT_V
#undef PG8_WAIT_L
#undef PG8_BAR
#undef PG8_SCHED
}

__device__ __forceinline__ float sigmoidf_fast(float x) { return __builtin_amdgcn_rcpf(1.f + __builtin_amdgcn_exp2f(-x * LOG2E)); }
struct EpiInProj {
    static constexpr bool PERM = true, AFTER_DRAIN = false;
    bf16_t* base; const float* sxn  ; const float* wsc  ;
    const float* gq; const float* gk; PG8_LAS float* xch  ;
    __device__ __forceinline__ void operator()(const i32x4 (&acci)[2][2][4][2], const Unit& u, int wr, int wc, int fr, int fq) const {
        const int sec = u.pn >> 2; const float wsv = *wsc;
        bf16_t* sb = base + (size_t)sec * SEC_ELEMS;
        const float sc = (sec == 4) ? SCALE * LOG2E : 1.f;
        if (sec < 2) {
#pragma unroll
            for (int ai = 0; ai < 2; ++ai)
#pragma unroll
                for (int m = 0; m < 4; ++m) {
                    const int tk = u.pm * BM + ai * HALF + wr * 64 + m * 16 + fr;
                    const float rs = sxn[tk] * wsv;
#pragma unroll
                    for (int bj = 0; bj < 2; ++bj) {
                        const f32x4 v0 = __builtin_convertvector(acci[ai][bj][m][0], f32x4) * rs, v1 = __builtin_convertvector(acci[ai][bj][m][1], f32x4) * rs;
                        float ss = v0[0] * v0[0] + v0[1] * v0[1] + v0[2] * v0[2] + v0[3] * v0[3] + v1[0] * v1[0] + v1[1] * v1[1] + v1[2] * v1[2] + v1[3] * v1[3];
                        ss += sx_f(ss, 16); ss += sx_f(ss, 32);
                        if (fq == 0) xch[(((((wr * 2 + ai) * 4 + m) * 16 + fr) * 2 + bj) * 4) + wc] = ss;
                    }
                }
            asm volatile("s_waitcnt lgkmcnt(0)" ::: "memory");
            __builtin_amdgcn_s_barrier();
            const float* gp = (sec == 0 ? gq : gk) + wc * 32 + 8 * fq;
            const f32x4 g0 = *(const f32x4*)gp, g1 = *(const f32x4*)(gp + 4);
#pragma unroll
            for (int ai = 0; ai < 2; ++ai)
#pragma unroll
                for (int m = 0; m < 4; ++m) {
                    const int tk = u.pm * BM + ai * HALF + wr * 64 + m * 16 + fr, b = tk >> 12, s = tk & 4095;
                    const float rs = sxn[tk] * wsv;
#pragma unroll
                    for (int bj = 0; bj < 2; ++bj) {
                        const int hh = (u.pn & 3) * 2 + bj;
                        const f32x4 p4 = *(const PG8_LAS f32x4*)(xch + (((((wr * 2 + ai) * 4 + m) * 16 + fr) * 2 + bj) * 4));
                        const float r = rs / sqrtf(((p4[0] + p4[1]) + (p4[2] + p4[3])) * (1.f / 128.f) + EPS);
                        const f32x4 v0 = __builtin_convertvector(acci[ai][bj][m][0], f32x4) * r * g0, v1 = __builtin_convertvector(acci[ai][bj][m][1], f32x4) * r * g1;
                        u32x4 w; w.x = cvt_pk_bf16(v0[0], v0[1]); w.y = cvt_pk_bf16(v0[2], v0[3]); w.z = cvt_pk_bf16(v1[0], v1[1]); w.w = cvt_pk_bf16(v1[2], v1[3]);
                        *(u32x4*)(sb + ((size_t)((b * 8 + hh) * 4096 + s)) * 128 + wc * 32 + 8 * fq) = w;
                    }
                }
            return;
        }
#pragma unroll
        for (int ai = 0; ai < 2; ++ai)
#pragma unroll
            for (int m = 0; m < 4; ++m) {
                const int tk = u.pm * BM + ai * HALF + wr * 64 + m * 16 + fr, b = tk >> 12, s = tk & 4095;
                const float rs = sxn[tk] * wsv;
#pragma unroll
                for (int bj = 0; bj < 2; ++bj) {
                    const int hh = (u.pn & 3) * 2 + bj;
                    f32x4 v0 = __builtin_convertvector(acci[ai][bj][m][0], f32x4) * rs, v1 = __builtin_convertvector(acci[ai][bj][m][1], f32x4) * rs;
                    bf16_t* dst;
                    if (sec == 3) {
#pragma unroll
                        for (int i = 0; i < 4; ++i) { v0[i] = sigmoidf_fast(v0[i]); v1[i] = sigmoidf_fast(v1[i]); }
                        dst = sb + (size_t)tk * 1024 + hh * 128 + wc * 32 + 8 * fq;
                    } else {
                        v0 = v0 * sc; v1 = v1 * sc;
                        dst = sb + ((size_t)((b * 8 + hh) * 4096 + s)) * 128 + wc * 32 + 8 * fq;
                    }
                    u32x4 w; w.x = cvt_pk_bf16(v0[0], v0[1]); w.y = cvt_pk_bf16(v0[2], v0[3]); w.z = cvt_pk_bf16(v1[0], v1[1]); w.w = cvt_pk_bf16(v1[2], v1[3]);
                    *(u32x4*)dst = w;
                }
            }
    }
};
struct EpiOutProj {
    static constexpr bool PERM = true, AFTER_DRAIN = false;
    const float* x; float* h; bf16_t* hb; float* ssq; float* amx;
    __device__ __forceinline__ void operator()(const f32x4 (&acc)[2][2][4][2], const Unit& u, int wr, int wc, int fr, int fq) const {
#pragma unroll
        for (int ai = 0; ai < 2; ++ai)
#pragma unroll
            for (int m = 0; m < 4; ++m) {
                const int tk = u.pm * BM + ai * HALF + wr * 64 + m * 16 + fr;
                float ss = 0.f, mx = 0.f;
#pragma unroll
                for (int bj = 0; bj < 2; ++bj) {
                    const size_t off = (size_t)tk * DM + u.pn * BM + bj * HALF + wc * 32 + 8 * fq;
                    const f32x4 x0 = *(const f32x4*)(x + off), x1 = *(const f32x4*)(x + off + 4);
                    const f32x4 v0 = acc[ai][bj][m][0] + x0, v1 = acc[ai][bj][m][1] + x1;
                    u32x4 w; w.x = cvt_pk_bf16(v0[0], v0[1]); w.y = cvt_pk_bf16(v0[2], v0[3]); w.z = cvt_pk_bf16(v1[0], v1[1]); w.w = cvt_pk_bf16(v1[2], v1[3]);
                    *(u32x4*)(hb + off) = w;
                    ss += v0[0] * v0[0] + v0[1] * v0[1] + v0[2] * v0[2] + v0[3] * v0[3] + v1[0] * v1[0] + v1[1] * v1[1] + v1[2] * v1[2] + v1[3] * v1[3];
                    mx = fmaxf(mx, fmaxf(fmaxf(fmaxf(fabsf(v0[0]), fabsf(v0[1])), fmaxf(fabsf(v0[2]), fabsf(v0[3]))), fmaxf(fmaxf(fabsf(v1[0]), fabsf(v1[1])), fmaxf(fabsf(v1[2]), fabsf(v1[3])))));
                }
                ss += sx_f(ss, 16); ss += sx_f(ss, 32);
                mx = fmaxf(mx, sx_f(mx, 16)); mx = fmaxf(mx, sx_f(mx, 32));
                if (fq == 0) { ssq[(size_t)tk * 32 + u.pn * 4 + wc] = ss; amx[(size_t)tk * 32 + u.pn * 4 + wc] = mx; }
            }
    }
};
struct EpiPeerQ {
    static constexpr bool PERM = true, AFTER_DRAIN = false;
    const float* ssq; bf16_t* qp; float* rtab;
    __device__ __forceinline__ void operator()(const f32x4 (&acc)[2][2][4][2], const Unit& u, int wr, int wc, int fr, int fq) const {
#pragma unroll
        for (int ai = 0; ai < 2; ++ai)
#pragma unroll
            for (int m = 0; m < 4; ++m) {
                const int tk = u.pm * BM + ai * HALF + wr * 64 + m * 16 + fr;
                float tot = 0.f;
#pragma unroll
                for (int i = 0; i < 8; ++i) { const f32x4 s4 = *(const f32x4*)(ssq + (size_t)tk * 32 + 4 * i); tot += (s4[0] + s4[1]) + (s4[2] + s4[3]); }
                const float r = 1.0f / sqrtf(tot * (1.f / DM) + EPS);
                if (u.pn == 0 && wc == 0 && fq == 0) rtab[tk] = r;
#pragma unroll
                for (int bj = 0; bj < 2; ++bj) {
                    const size_t off = (size_t)tk * DM + u.pn * BM + bj * HALF + wc * 32 + 8 * fq;
                    const f32x4 v0 = acc[ai][bj][m][0] * r, v1 = acc[ai][bj][m][1] * r;
                    u32x4 w; w.x = cvt_pk_bf16(v0[0], v0[1]); w.y = cvt_pk_bf16(v0[2], v0[3]); w.z = cvt_pk_bf16(v1[0], v1[1]); w.w = cvt_pk_bf16(v1[2], v1[3]);
                    *(u32x4*)(qp + off) = w;
                }
            }
    }
};
struct EpiPeerQFused {
    static constexpr bool PERM = true, AFTER_DRAIN = true;
    const float* ssq; unsigned char* wsb;
    __device__ __forceinline__ void operator()(const f32x4 (&)[2][2][4][2], const Unit&, int, int, int, int) const {}
    __device__ __forceinline__ void fused(const f32x4 (&acc)[2][2][4][2], const Unit& u, int wr, int wc, int fr, int fq, PG8_LAS unsigned char* lds) const;
};
}

namespace att {
constexpr int NW = 8, QBLK = 32, KVBLK = 64, QB = NW * QBLK, D = 128;
constexpr int SHM_V = KVBLK * D * 2, SHM_K = KVBLK * D * 2;
constexpr int OFF_WS = 2 * SHM_V + 2 * SHM_K, OFF_BIAS = OFF_WS + NW * 64 * 4, ATT_LDS = OFF_BIAS + SEQ * 4;
#define KSWZ(row, colB) ((row) * 256 + ((colB) ^ (((row) & 7) << 4)))
#define SBAR() __builtin_amdgcn_sched_barrier(0)
__device__ __forceinline__ int v_st(int k, int c) { const int kk = (k & ~0xC) | ((k & 4) << 1) | ((k & 8) >> 1); return ((kk >> 3) * 4 + (c >> 5)) * 512 + ((kk & 7) * 32 + (c & 31)) * 2; }
__device__ __forceinline__ int v_rd_base(int lane) { return ((lane & 3) << 3) | (((lane >> 2) & 3) << 6) | (((lane >> 4) & 1) << 5) | (((lane >> 5) & 1) << 8); }
constexpr int v_rd_off(int d0, int ks, int half) { return d0 * 512 + ks * 4096 + half * 2048; }
__device__ __forceinline__ int crow(int r, int hi) { return (r & 3) + 8 * (r >> 2) + 4 * hi; }
__device__ __forceinline__ bf16x8 load8(const bf16_t* p) { return *reinterpret_cast<const bf16x8*>(p); }
__device__ __forceinline__ void mask_tile(f32x16& p0, f32x16& p1, int dq) {
    const float NEG = -__builtin_inff();
#pragma unroll
    for (int r = 0; r < 16; ++r) {
        const int c = (r & 3) + 8 * (r >> 2);
        if (dq - c < 0) p0[r] = NEG;
        if (dq - c - 32 < 0) p1[r] = NEG;
    }
}
__device__ __forceinline__ void partialSM(f32x16& p0, f32x16& p1, float& m_reg, float& mn, float& alpha) {
    float pmax = p0[0];
#pragma unroll
    for (int r = 1; r < 16; ++r) pmax = fmaxf(pmax, p0[r]);
#pragma unroll
    for (int r = 0; r < 16; ++r) pmax = fmaxf(pmax, p1[r]);
    { auto rr = __builtin_amdgcn_permlane32_swap(__float_as_uint(pmax), __float_as_uint(pmax), false, false);
      pmax = fmaxf(__uint_as_float(rr[0]), __uint_as_float(rr[1])); }
    constexpr float C2 = LOG2E * SCALE; constexpr float THR = 8.f;
    if (__builtin_expect(__all((pmax - m_reg) * SCALE <= THR), 1)) { mn = m_reg; alpha = 1.f; }
    else { mn = fmaxf(m_reg, pmax); alpha = __builtin_amdgcn_exp2f((m_reg - mn) * C2); m_reg = mn; }
    const float mnL = -mn * C2;
#pragma unroll
    for (int r = 0; r < 16; ++r) p0[r] = fmaf(p0[r], C2, mnL);
#pragma unroll
    for (int r = 0; r < 16; ++r) p1[r] = fmaf(p1[r], C2, mnL);
#pragma unroll
    for (int r = 0; r < 16; ++r) p0[r] = __builtin_amdgcn_exp2f(p0[r]);
}
#define PK4(P, B_, OUT) do { unsigned a0 = cvt_pk_bf16(P[B_+0], P[B_+1]), a1 = cvt_pk_bf16(P[B_+2], P[B_+3]);                          \
        unsigned b0 = cvt_pk_bf16(P[B_+4], P[B_+5]), b1 = cvt_pk_bf16(P[B_+6], P[B_+7]);                                             \
        auto r0 = __builtin_amdgcn_permlane32_swap(a0, b0, false, false); auto r1 = __builtin_amdgcn_permlane32_swap(a1, b1, false, false); \
        u32x4 w = {r0[0], r1[0], r0[1], r1[1]}; OUT = *reinterpret_cast<bf16x8*>(&w); } while (0)
__device__ __forceinline__ void finishSM(f32x16& p0, f32x16& p1, float alpha, float& l_reg, bf16x8& pa0, bf16x8& pa1, bf16x8& pa2, bf16x8& pa3) {
#pragma unroll
    for (int r = 0; r < 16; ++r) p1[r] = __builtin_amdgcn_exp2f(p1[r]);
    float ps = 0;
#pragma unroll
    for (int r = 0; r < 16; ++r) ps += p0[r];
#pragma unroll
    for (int r = 0; r < 16; ++r) ps += p1[r];
    { auto rr = __builtin_amdgcn_permlane32_swap(__float_as_uint(ps), __float_as_uint(ps), false, false);
      ps = __uint_as_float(rr[0]) + __uint_as_float(rr[1]); }
    l_reg = l_reg * alpha + ps;
    PK4(p0, 0, pa0); PK4(p0, 8, pa1); PK4(p1, 0, pa2); PK4(p1, 8, pa3);
}
__device__ __forceinline__ void sb_group(f32x16& P, int g, float& gs) {
    float run = 0.f;
#pragma unroll
    for (int k = 3; k >= 0; --k) {
        const float z = P[4 * g + k];
        const float t = __builtin_amdgcn_exp2f(-fabsf(z));
        const float l = __builtin_amdgcn_logf(1.f + t);
        const float sp = fmaxf(z, 0.f) + l;
        P[4 * g + k] = (z - sp) - run;
        run += sp;
    }
    gs = run;
}
__device__ __forceinline__ void sb_part1(f32x16& p0, f32x16& p1, float& carry, float mlo) {
    float gs[8];
#pragma unroll
    for (int g = 0; g < 4; ++g) sb_group(p0, g, gs[g]);
#pragma unroll
    for (int g = 0; g < 4; ++g) sb_group(p1, g, gs[4 + g]);
    float run = carry;
#pragma unroll
    for (int G = 7; G >= 0; --G) {
        auto rr = __builtin_amdgcn_permlane32_swap(__float_as_uint(gs[G]), __float_as_uint(gs[G]), false, false);
        const float slo = __uint_as_float(rr[0]), shi = __uint_as_float(rr[1]);
        const float base = fmaf(mlo, shi, run);
        if (G >= 4) {
#pragma unroll
            for (int k = 0; k < 4; ++k) p1[4 * (G - 4) + k] -= base;
        } else {
#pragma unroll
            for (int k = 0; k < 4; ++k) p0[4 * G + k] -= base;
        }
        run += slo + shi;
    }
    carry = run;
#pragma unroll
    for (int r = 0; r < 16; ++r) p0[r] = __builtin_amdgcn_exp2f(p0[r]);
}
__device__ __forceinline__ void sb_part2(f32x16& p0, f32x16& p1, bf16x8& pa0, bf16x8& pa1, bf16x8& pa2, bf16x8& pa3) {
#pragma unroll
    for (int r = 0; r < 16; ++r) p1[r] = __builtin_amdgcn_exp2f(p1[r]);
    PK4(p0, 0, pa0); PK4(p0, 8, pa1); PK4(p1, 0, pa2); PK4(p1, 8, pa3);
}
#undef PK4
template <int KB, bool BIAS>
__device__ __forceinline__ void qkt(f32x16& p0, f32x16& p1, const char* K_lds, int r32, int hi, const bf16x8* qr, const float* bt) {
    if constexpr (BIAS) {
#pragma unroll
        for (int g = 0; g < 4; ++g) { const f32x4 a = *(const f32x4*)(bt + 8 * g), b = *(const f32x4*)(bt + 32 + 8 * g);
            p0[4 * g] = a[0]; p0[4 * g + 1] = a[1]; p0[4 * g + 2] = a[2]; p0[4 * g + 3] = a[3];
            p1[4 * g] = b[0]; p1[4 * g + 1] = b[1]; p1[4 * g + 2] = b[2]; p1[4 * g + 3] = b[3]; }
    } else { p0 = f32x16{}; p1 = f32x16{}; }
    const char* kb[4];
#pragma unroll
    for (int dd = 0; dd < 4; ++dd) kb[dd] = K_lds + KB * SHM_K + KSWZ(r32, (dd * 16 + hi * 8) * 2);
#pragma unroll
    for (int d0 = 0; d0 < 8; ++d0) { const char* a = kb[d0 & 3] + (d0 >> 2) * 128;
        bf16x8 b0 = *reinterpret_cast<const bf16x8*>(a);
        bf16x8 b1 = *reinterpret_cast<const bf16x8*>(a + 32 * 256);
        p0 = __builtin_amdgcn_mfma_f32_32x32x16_bf16(b0, qr[d0], p0, 0, 0, 0);
        p1 = __builtin_amdgcn_mfma_f32_32x32x16_bf16(b1, qr[d0], p1, 0, 0, 0); }
}
template <int VB>
__device__ __forceinline__ void pv_tile(f32x16* o, int vb0, bf16x8 pa0, bf16x8 pa1, bf16x8 pa2, bf16x8 pa3) {
#define TRRD(dst, off) asm volatile("ds_read_b64_tr_b16 %0, %1 offset:%2" : "=&v"(dst) : "v"(vb0), "i"(off) : "memory")
#define PV_D0(d0) do { { s16x4 l0, l1, h0, h1; constexpr int b_ = VB * SHM_V + v_rd_off(d0, 0, 0); \
        TRRD(l0, b_); TRRD(h0, b_ + 2048); TRRD(l1, b_ + 4096); TRRD(h1, b_ + 6144); \
        asm volatile("s_waitcnt lgkmcnt(0)" ::: "memory"); SBAR();   \
        o[d0] = __builtin_amdgcn_mfma_f32_32x32x16_bf16(pa0, (bf16x8){l0[0], l0[1], l0[2], l0[3], h0[0], h0[1], h0[2], h0[3]}, o[d0], 0, 0, 0);   \
        o[d0] = __builtin_amdgcn_mfma_f32_32x32x16_bf16(pa1, (bf16x8){l1[0], l1[1], l1[2], l1[3], h1[0], h1[1], h1[2], h1[3]}, o[d0], 0, 0, 0); }  \
      { s16x4 l2, l3, h2, h3; constexpr int b_ = VB * SHM_V + v_rd_off(d0, 0, 0); \
        TRRD(l2, b_ + 8192); TRRD(h2, b_ + 10240); TRRD(l3, b_ + 12288); TRRD(h3, b_ + 14336); \
        asm volatile("s_waitcnt lgkmcnt(0)" ::: "memory"); SBAR();   \
        o[d0] = __builtin_amdgcn_mfma_f32_32x32x16_bf16(pa2, (bf16x8){l2[0], l2[1], l2[2], l2[3], h2[0], h2[1], h2[2], h2[3]}, o[d0], 0, 0, 0);   \
        o[d0] = __builtin_amdgcn_mfma_f32_32x32x16_bf16(pa3, (bf16x8){l3[0], l3[1], l3[2], l3[3], h3[0], h3[1], h3[2], h3[3]}, o[d0], 0, 0, 0); } } while (0)
    PV_D0(0); PV_D0(1); PV_D0(2); PV_D0(3);
#undef PV_D0
#undef TRRD
}

struct UnitRef { const bf16_t* Q; const bf16_t* K; const bf16_t* V; int P0; };
struct Seam { bf16x8 qr[8]; bf16x8 st_v0, st_v1, st_k0, st_k1; };
#define ROW(p, k0, rr) ((p) + (size_t)((k0) + (rr)) * D + sc)
#define VMW() asm volatile("s_waitcnt vmcnt(0)" ::: "memory")
#define SLOAD_H(Kp, Vp, k0) do { S.st_v0 = load8(ROW(Vp, k0, sr)); S.st_v1 = load8(ROW(Vp, k0, 32 + sr));              \
                         S.st_k0 = load8(ROW(Kp, k0, sr)); S.st_k1 = load8(ROW(Kp, k0, 32 + sr)); } while (0)
#define SWRITE_HK(bf) do { *(bf16x8*)(K_lds + (bf) * SHM_K + kws) = S.st_k0; *(bf16x8*)(K_lds + (bf) * SHM_K + kws + 32 * 256) = S.st_k1; } while (0)
#define SWRITE_HV(bf) do { *(bf16x8*)(V_lds + (bf) * SHM_V + vst0) = S.st_v0; *(bf16x8*)(V_lds + (bf) * SHM_V + vst1) = S.st_v1; } while (0)
#define SWRITE_H(bf) do { SWRITE_HV(bf); SWRITE_HK(bf); } while (0)

template <bool SB>
__device__ __forceinline__ void attn_unit(const UnitRef& cur, unsigned char* wsu  , int bh, char* lds,
                                          int part  , float lmax  ) {
    const float* cvec;
    { unsigned char* w_ = wsu; asm volatile("" : "+s"(w_)); cvec = (const float*)(w_ + WS_C) + (size_t)bh * SEQ; }
    Seam S;
    { const int t0_ = tid_opaque(), w0_ = __builtin_amdgcn_readfirstlane(t0_ >> 6), l0_ = t0_ & 63;
#pragma unroll
      for (int d0 = 0; d0 < 8; ++d0) S.qr[d0] = load8(cur.Q + (size_t)(w0_ * QBLK + (l0_ & 31)) * D + d0 * 16 + (l0_ >> 5) * 8); }
    const int tid = tid_opaque(), wid = __builtin_amdgcn_readfirstlane(tid >> 6), lane = tid & 63, r32 = lane & 31, hi = lane >> 5;
    int jlo = 0;
    if constexpr (!SB) {
        const int ntf = (cur.P0 + QB) / KVBLK;
        const float cend = (lane < ntf) ? cvec[lane * KVBLK + KVBLK - 1] : 0.f;
        const bool skip = (lane < ntf) && (2.f * lmax + cvec[cur.P0] - cend < -104.f);
        jlo = __builtin_amdgcn_readfirstlane((int)__popcll(__ballot(skip)));
    }
    const int ntot = (cur.P0 + QB) / KVBLK - jlo;
    const int tb = (part == 2) ? (ntot >> 1) : 0, te = (part == 1) ? (ntot >> 1) : ntot;
    const int kshift = (jlo + tb) * KVBLK, P0r = cur.P0 - kshift;
    const int NT = te - tb;
#define KBASE(t) ((NT - 1 - (t)) * KVBLK)
    const int qlo = P0r + wid * QBLK, qm = qlo + r32 - 4 * hi - (SB ? 1 : 0);
    char* V_lds = lds; char* K_lds = lds + 2 * SHM_V;
    float* ws = (float*)(lds + OFF_WS) + wid * 64; float* li_l = ws, * al_l = ws + 32;
    float* bias = (float*)(lds + OFF_BIAS);
    const int sr = tid >> 4, sc = (tid & 15) * 8, vst0 = v_st(sr, sc), vst1 = v_st(32 + sr, sc), kws = KSWZ(sr, sc * 2);
    const int vb0 = (int)(uintptr_t)V_lds + v_rd_base(lane);
    const bf16_t* Kh = cur.K + (size_t)kshift * D; const bf16_t* Vh = cur.V + (size_t)kshift * D;
    SLOAD_H(Kh, Vh, KBASE(0));
    if constexpr (!SB) { const float cq0 = cvec[cur.P0]; const float* cv = cvec + kshift; for (int j = tid; j < NT * KVBLK; j += NTHREADS) bias[j] = (cq0 - cv[j]) * (1.f / SCALE); }
    VMW(); SWRITE_HK(0);
    __syncthreads();
    float m_reg = -1e30f, l_reg = 0; f32x16 o[4] = {};
    float carry = 0.f; const float mlo = hi ? 0.f : 1.f;
#define RESC(a) do { if (__any((a) < 1.f)) { if (hi == 0) al_l[r32] = (a); asm volatile("s_waitcnt lgkmcnt(0)" ::: "memory");              \
                     for (int d_ = 0; d_ < 4; ++d_) for (int r = 0; r < 16; ++r) o[d_][r] *= al_l[crow(r, hi)]; } } while (0)
#define MASKT(P0_, P1_, t) do { const int kb_ = KBASE(t); if (kb_ + KVBLK - 1 > qlo - (SB ? 1 : 0)) mask_tile(P0_, P1_, qm - kb_); } while (0)
#define BT(t) (bias + KBASE(t) + 4 * hi)
#define PART1(PX0, PX1, mnX, alX) do { if constexpr (SB) sb_part1(PX0, PX1, carry, mlo); else partialSM(PX0, PX1, m_reg, mnX, alX); } while (0)
#define PART2(PY0, PY1, alY) do { if constexpr (SB) sb_part2(PY0, PY1, pa0, pa1, pa2, pa3); else finishSM(PY0, PY1, alY, l_reg, pa0, pa1, pa2, pa3); } while (0)
    f32x16 pA0, pA1, pB0, pB1; float mnA = 0.f, mnB = 0.f, alA = 1.f, alB = 1.f; bf16x8 pa0, pa1, pa2, pa3;
    SWRITE_HV(0); SBAR();
    if (NT > 1) SLOAD_H(Kh, Vh, KBASE(1));
    SBAR(); qkt<0, !SB>(pA0, pA1, K_lds, r32, hi, S.qr, BT(0));
    MASKT(pA0, pA1, 0); PART1(pA0, pA1, mnA, alA);
    if (NT > 1) { VMW(); SWRITE_H(1); }
    __syncthreads();
#define HALF_STEP(PX0, PX1, mnX, alX, PY0, PY1, alY, t, KB, VB, SBUF) do {                                                    \
        SBAR(); qkt<KB, !SB>(PX0, PX1, K_lds, r32, hi, S.qr, BT(t));                                                          \
        PART2(PY0, PY1, alY); SBAR();                                                                                          \
        if ((t) + 1 < NT) { SLOAD_H(Kh, Vh, KBASE((t) + 1)); SBAR(); }                                                         \
        pv_tile<VB>(o, vb0, pa0, pa1, pa2, pa3); MASKT(PX0, PX1, (t)); PART1(PX0, PX1, mnX, alX);                              \
        __syncthreads();                                                                                                      \
        if ((t) + 1 < NT) { VMW(); SWRITE_H(SBUF); }                                                                           \
        if constexpr (!SB) RESC(alX);                                                                                          \
        __syncthreads(); } while (0)
    for (int t = 1; t + 1 < NT; t += 2) {
        HALF_STEP(pB0, pB1, mnB, alB, pA0, pA1, alA, t, 1, 0, 0);
        HALF_STEP(pA0, pA1, mnA, alA, pB0, pB1, alB, t + 1, 0, 1, 1);
    }
    const bool even = (NT & 1) == 0;
    if (even) { SBAR(); qkt<1, !SB>(pB0, pB1, K_lds, r32, hi, S.qr, BT(NT - 1)); SBAR(); }
    PART2(pA0, pA1, alA); SBAR();
    pv_tile<0>(o, vb0, pa0, pa1, pa2, pa3);
    if (even) { MASKT(pB0, pB1, NT - 1); PART1(pB0, pB1, mnB, alB); __syncthreads(); if constexpr (!SB) RESC(alB);
        PART2(pB0, pB1, alB); SBAR(); pv_tile<1>(o, vb0, pa0, pa1, pa2, pa3); }
    unsigned char* we_ = wsu; asm volatile("" : "+s"(we_));
    if (part != 0) {
        const int slot2 = ((((cur.P0 >> 8) - 8) & 7) * 16 + bh) * 2 + (part == 2 ? 1 : 0);
        float* po = (float*)(we_ + WS_PO) + (size_t)slot2 * 256 * 128; float* pml = (float*)(we_ + WS_PML) + (size_t)slot2 * 512;
        if (hi == 0) { pml[(wid * QBLK + r32) * 2] = m_reg; pml[(wid * QBLK + r32) * 2 + 1] = l_reg; }
#pragma unroll
        for (int r = 0; r < 16; ++r)
#pragma unroll
            for (int d0 = 0; d0 < 4; ++d0) po[(size_t)(wid * QBLK + crow(r, hi)) * D + d0 * 32 + r32] = o[d0][r];
        __syncthreads();
        return;
    }
    const bf16_t* gate = (const bf16_t*)(we_ + WS_SEC) + 3 * SEC_ELEMS + (size_t)(bh >> 3) * SEQ * 1024 + (bh & 7) * HD;
    bf16_t* outp = (bf16_t*)(we_ + WS_MIX) + (size_t)(bh >> 3) * SEQ * DM + (bh & 7) * HD;
    float rli[16];
    if constexpr (!SB) {
        if (hi == 0) li_l[r32] = l_reg; asm volatile("s_waitcnt lgkmcnt(0)" ::: "memory");
#pragma unroll
        for (int r = 0; r < 16; ++r) rli[r] = __builtin_amdgcn_rcpf(li_l[crow(r, hi)]);
    }
#pragma unroll
    for (int r = 0; r < 16; ++r) { const int orow = cur.P0 + wid * QBLK + crow(r, hi);
#pragma unroll
        for (int d0 = 0; d0 < 4; ++d0) {
            float v = o[d0][r];
            if constexpr (!SB) { const unsigned short gb = gate[(size_t)orow * 1024 + d0 * 32 + r32]; v = v * rli[r] * __builtin_bit_cast(float, (unsigned)gb << 16); }
            const float vn = sx_f(v, 1);
            if ((r32 & 1) == 0) *(unsigned*)(outp + (size_t)orow * DM + d0 * 32 + r32) = cvt_pk_bf16(v, vn); } }
    __syncthreads();
#undef RESC
#undef KBASE
#undef MASKT
#undef BT
#undef PART1
#undef PART2
#undef HALF_STEP
}

constexpr float SB_TH = 150.f;
__device__ __forceinline__ void sb_unit(const UnitRef& cur, bf16_t* outp, char* lds) {
    const int tid = tid_opaque(), wid = __builtin_amdgcn_readfirstlane(tid >> 6), lane = tid & 63, r32 = lane & 31, hi = lane >> 5;
    const int NT = (cur.P0 + QB) / KVBLK;
#define KBASE(t) ((NT - 1 - (t)) * KVBLK)
    const int qlo = cur.P0 + wid * QBLK, qm = qlo + r32 - 4 * hi - 1;
    char* V_lds = lds; char* K_lds = lds + 2 * SHM_V;
    volatile int* flags = (volatile int*)(lds + OFF_WS);
    const int sr = tid >> 4, sc = (tid & 15) * 8, vst0 = v_st(sr, sc), vst1 = v_st(32 + sr, sc), kws = KSWZ(sr, sc * 2);
    const int vb0 = (int)(uintptr_t)V_lds + v_rd_base(lane);
    const bf16_t* Kh = cur.K; const bf16_t* Vh = cur.V;
    Seam S;
#pragma unroll
    for (int d0 = 0; d0 < 8; ++d0) S.qr[d0] = load8(cur.Q + (size_t)(wid * QBLK + r32) * D + d0 * 16 + hi * 8);
    SLOAD_H(Kh, Vh, KBASE(0)); VMW(); SWRITE_H(0);
    __syncthreads();
    f32x16 o[4] = {}; float carry = 0.f; const float mlo = hi ? 0.f : 1.f;
    bool wdone = false;
#define SB_STEP(tt, BUF) {                                                                                                 \
        const int kb_ = KBASE(tt);                                                                                           \
        if ((tt) + 1 < NT) SLOAD_H(Kh, Vh, KBASE((tt) + 1));                                                                 \
        SBAR();                                                                                                              \
        if (!wdone && kb_ <= qlo + QBLK - 2) {                                                                               \
            f32x16 p0, p1; bf16x8 pa0, pa1, pa2, pa3;                                                                        \
            qkt<BUF, false>(p0, p1, K_lds, r32, hi, S.qr, nullptr);                                                          \
            if (kb_ + KVBLK - 1 > qlo - 1) mask_tile(p0, p1, qm - kb_);                                                      \
            sb_part1(p0, p1, carry, mlo); sb_part2(p0, p1, pa0, pa1, pa2, pa3); SBAR();                                      \
            pv_tile<BUF>(o, vb0, pa0, pa1, pa2, pa3);                                                                        \
            wdone = __all(carry >= SB_TH);                                                                                   \
        }                                                                                                                    \
        if ((tt) + 1 < NT) { VMW(); SWRITE_H((BUF) ^ 1); }                                                                   \
        if (lane == 0) flags[((tt) & 1) * 8 + wid] = wdone ? 1 : 0;                                                          \
        __syncthreads();                                                                                                     \
        { int alld = 1;                                                                                                      \
          _Pragma("unroll") for (int w_ = 0; w_ < 8; ++w_) alld &= flags[((tt) & 1) * 8 + w_];                                \
          if (alld) break; } }
    for (int t = 0; t < NT; t += 2) {
        SB_STEP(t, 0)
        SB_STEP(t + 1, 1)
    }
#undef SB_STEP
#pragma unroll
    for (int r = 0; r < 16; ++r) { const int orow = cur.P0 + wid * QBLK + crow(r, hi);
#pragma unroll
        for (int d0 = 0; d0 < 4; ++d0) {
            const float v = o[d0][r];
            const float vn = sx_f(v, 1);
            if ((r32 & 1) == 0) *(unsigned*)(outp + (size_t)orow * DM + d0 * 32 + r32) = cvt_pk_bf16(v, vn); } }
    __syncthreads();
#undef KBASE
}
#undef ROW
#undef VMW
#undef SLOAD_H
#undef SWRITE_HK
#undef SWRITE_HV
#undef SWRITE_H
}

#define XB_TMO      128
#define XB_XCNT(j)  (256  + 64 * (j))
#define XB_XSUB(j)  (1280 + 64 * (j))
#define XB_XGEN(j)  (2304 + 64 * (j))
#define XB_TOP      3328
#define XB_TOPGEN   3392
#define XCD_BAR_WORDS 3456
#define XB_SPIN_CAP (1u << 20)
__device__ __forceinline__ unsigned xb_ld(unsigned* p)              { return __hip_atomic_load(p, __ATOMIC_RELAXED, __HIP_MEMORY_SCOPE_AGENT); }
__device__ __forceinline__ unsigned xb_add(unsigned* p, unsigned v) { return __hip_atomic_fetch_add(p, v, __ATOMIC_RELAXED, __HIP_MEMORY_SCOPE_AGENT); }
__device__ __forceinline__ unsigned xb_xcc_id() { return (unsigned)__builtin_amdgcn_s_getreg((3 << 11) | 20) & 0xFu; }
#define XB_SPIN(cond, bar) do { unsigned _sp = 0; while (cond) { __builtin_amdgcn_s_sleep(1); \
    if ((++_sp & 255u) == 0u) { if (xb_ld(&(bar)[XB_TMO])) break; if (_sp > XB_SPIN_CAP) { atomicAdd(&(bar)[XB_TMO], 1u); break; } } } } while (0)
struct XcdBarrier { unsigned* bar; unsigned x; volatile LAS unsigned* st; };
__device__ __forceinline__ XcdBarrier xcd_barrier_post(unsigned* bar, volatile LAS unsigned* st) {
    XcdBarrier b; b.bar = bar; b.x = xb_xcc_id(); b.st = st;
    if (threadIdx.x == 0) (void)xb_add(&bar[XB_XCNT(b.x)], 1u);
    return b;
}
__device__ __forceinline__ void xcd_barrier_complete(unsigned* bar, unsigned x, unsigned& nloc, unsigned& nx) {
    const unsigned G = gridDim.x * gridDim.y * gridDim.z;
    unsigned sum, cnt, mine, sp = 0u;
    for (;;) {
        sum = 0u; cnt = 0u; mine = 0u;
#pragma unroll
        for (unsigned j = 0; j < 16; ++j) { const unsigned c = xb_ld(&bar[XB_XCNT(j)]); sum += c; cnt += (c > 0u) ? 1u : 0u; mine = (j == x) ? c : mine; }
        if (sum == G) break;
        __builtin_amdgcn_s_sleep(1);
        if ((++sp & 255u) == 0u) { if (xb_ld(&bar[XB_TMO])) break; if (sp > XB_SPIN_CAP) { atomicAdd(&bar[XB_TMO], 1u); break; } }
    }
    nloc = mine > 0u ? mine : 1u; nx = cnt > 0u ? cnt : 1u;
}
__device__ __forceinline__ void xcd_barrier(const XcdBarrier& b) {
    asm volatile("s_waitcnt vmcnt(0)" ::: "memory");
    __syncthreads();
    if (threadIdx.x == 0) {
        unsigned* bar = b.bar;
        __builtin_amdgcn_s_waitcnt(0);
        unsigned nloc = b.st[0], nx = b.st[1];
        if (nloc == 0u) { xcd_barrier_complete(bar, b.x, nloc, nx); b.st[0] = nloc; b.st[1] = nx; }
        const unsigned old = xb_add(&bar[XB_XSUB(b.x)], 1u);
        const unsigned gen = old / nloc;
        if (old + 1u == (gen + 1u) * nloc) {
            __builtin_amdgcn_fence(__ATOMIC_RELEASE, "agent");
            asm volatile("s_waitcnt vmcnt(0)" ::: "memory");
            const unsigned og = xb_add(&bar[XB_TOP], 1u);
            const unsigned tg = og / nx;
            if (og + 1u == (tg + 1u) * nx) xb_add(&bar[XB_TOPGEN], 1u);
            else XB_SPIN(xb_ld(&bar[XB_TOPGEN]) == tg, bar);
            __builtin_amdgcn_fence(__ATOMIC_ACQUIRE, "agent");
            xb_add(&bar[XB_XGEN(b.x)], 1u);
            asm volatile("s_waitcnt vmcnt(0)" ::: "memory");
        } else {
            XB_SPIN(xb_ld(&bar[XB_XGEN(b.x)]) == gen, bar);
            __builtin_amdgcn_fence(__ATOMIC_ACQUIRE, "agent");
            asm volatile("s_waitcnt vmcnt(0)" ::: "memory");
        }
    }
    __syncthreads();
}

struct Args { const float* in[12]; float* out; unsigned char* ws; int ph_lo, ph_hi; };

__device__ __forceinline__ void p0_transpose_item(const float* W, int ldw, int K, bf16_t* WT, int nblk, LAS float* scr, int item, int lane, const float* gk) {
    const int kb = item / nblk, nb = item % nblk, k0 = 64 * kb, n0 = 32 * nb;
    { const int rr = lane >> 3, c4 = lane & 7; f32x4 v[8];
#pragma unroll
      for (int i = 0; i < 8; ++i) v[i] = *(const f32x4*)(W + (size_t)(k0 + rr + 8 * i) * ldw + n0 + 4 * c4);
#pragma unroll
      for (int i = 0; i < 8; ++i) { const int kk = rr + 8 * i; const float gm = gk ? gk[k0 + kk] : 1.f;
          scr[kk * 33 + 4 * c4] = v[i][0] * gm; scr[kk * 33 + 4 * c4 + 1] = v[i][1] * gm; scr[kk * 33 + 4 * c4 + 2] = v[i][2] * gm; scr[kk * 33 + 4 * c4 + 3] = v[i][3] * gm; } }
    LDS_WAIT(); asm volatile("" ::: "memory");
    const int c = lane & 7;
#pragma unroll
    for (int j = 0; j < 4; ++j) { const int n = (lane >> 3) + 8 * j; const LAS float* s = scr + (8 * c) * 33 + n;
        u32x4 o; o.x = cvt_pk_bf16(s[0 * 33], s[1 * 33]); o.y = cvt_pk_bf16(s[2 * 33], s[3 * 33]); o.z = cvt_pk_bf16(s[4 * 33], s[5 * 33]); o.w = cvt_pk_bf16(s[6 * 33], s[7 * 33]);
        *(u32x4*)(WT + (size_t)(n0 + n) * K + k0 + 8 * c) = o; }
    LDS_WAIT(); asm volatile("" ::: "memory");
}

__device__ __forceinline__ int pack_i8(float a, float b, float c, float d) {
    const int ia = (int)__builtin_rintf(a), ib = (int)__builtin_rintf(b), ic = (int)__builtin_rintf(c), id = (int)__builtin_rintf(d);
    return (int)(((unsigned)ia & 0xffu) | (((unsigned)ib & 0xffu) << 8) | (((unsigned)ic & 0xffu) << 16) | ((unsigned)id << 24));
}
__device__ __forceinline__ void convert_tables(const Args& a, int r0, int r1, int worker, int nworkers) {
    const int lane = tid_opaque() & 63;
    unsigned char* ws = a.ws; const float* g_ffn = a.in[7]; const float* pu = a.in[10]; const float* pv = a.in[11];
    float* suv = (float*)(ws + WS_SUV);
    for (int r = r0 + worker; r < r1; r += nworkers) {
        const bool isv = r >= NEXP; const int e = isv ? r - NEXP : r;
        const f32x4* srcp = (const f32x4*)((isv ? pv : pu) + (size_t)e * DM);
        f32x4 v[8]; float amax = 0.f;
#pragma unroll
        for (int j = 0; j < 8; ++j) { v[j] = srcp[lane + 64 * j];
            if (!isv) { const f32x4 g4 = *(const f32x4*)(g_ffn + 4 * (lane + 64 * j)); v[j] = v[j] * g4; }
            amax = fmaxf(amax, fmaxf(fmaxf(fabsf(v[j][0]), fabsf(v[j][1])), fmaxf(fabsf(v[j][2]), fabsf(v[j][3])))); }
        amax = wave_max(amax);
        const float sc = amax > 0.f ? 127.f / amax : 1.f;
        unsigned char* dst = ws + (isv ? WS_V8 : WS_U8) + (size_t)e * 128;
#pragma unroll
        for (int j = 0; j < 8; ++j) { const int p = pack_i8(v[j][0] * sc, v[j][1] * sc, v[j][2] * sc, v[j][3] * sc);
            const int col = 4 * (lane + 64 * j);
            *(unsigned*)(dst + (size_t)(col >> 7) * ((size_t)NEXP * 128) + (col & 127)) = (unsigned)p; }
        if (lane == 0) suv[r] = 1.f / sc;
    }
}
constexpr int TAB_SPLIT = NEXP;

__device__ __forceinline__ void p0_transpose_item_i8(const float* W, int ldw, int K, unsigned char* WT, int nblk, LAS float* scr, int item, int lane, float q8) {
    const int kb = item / nblk, nb = item % nblk, k0 = 64 * kb, n0 = 32 * nb;
    { const int rr = lane >> 3, c4 = lane & 7; f32x4 v[8];
#pragma unroll
      for (int i = 0; i < 8; ++i) v[i] = *(const f32x4*)(W + (size_t)(k0 + rr + 8 * i) * ldw + n0 + 4 * c4);
#pragma unroll
      for (int i = 0; i < 8; ++i) { const int kk = rr + 8 * i;
          scr[kk * 33 + 4 * c4] = v[i][0] * q8; scr[kk * 33 + 4 * c4 + 1] = v[i][1] * q8; scr[kk * 33 + 4 * c4 + 2] = v[i][2] * q8; scr[kk * 33 + 4 * c4 + 3] = v[i][3] * q8; } }
    LDS_WAIT(); asm volatile("" ::: "memory");
    const int c = lane & 7;
#pragma unroll
    for (int j = 0; j < 4; ++j) { const int n = (lane >> 3) + 8 * j; const LAS float* s = scr + (8 * c) * 33 + n;
        u32x2 o; o.x = (unsigned)pack_i8(s[0 * 33], s[1 * 33], s[2 * 33], s[3 * 33]); o.y = (unsigned)pack_i8(s[4 * 33], s[5 * 33], s[6 * 33], s[7 * 33]);
        *(u32x2*)(WT + (size_t)(n0 + n) * K + k0 + 8 * c) = o; }
    LDS_WAIT(); asm volatile("" ::: "memory");
}
__device__ __forceinline__ float log_sigmoid_f(float x) { return fminf(x, 0.f) - log1pf(expf(-fabsf(x))); }

__device__ __forceinline__ void phase0(const Args& a, unsigned char* lds_g) {
    LAS unsigned char* lds = (LAS unsigned char*)lds_g;
    const int tid = tid_opaque(), lane = tid & 63, wave = __builtin_amdgcn_readfirstlane(tid >> 6);
    const int gw = blockIdx.x * NWAVES + wave, NGW = gridDim.x * NWAVES;
    const int gt = blockIdx.x * NTHREADS + tid, NGT = gridDim.x * NTHREADS;
    unsigned char* ws = a.ws;
    const float* x = a.in[0]; const float* g_attn = a.in[1]; const float* w_in = a.in[2]; const float* b_forget = a.in[3];
    const float* w_out = a.in[6]; const float* g_ffn = a.in[7]; const float* w_pq = a.in[8]; const float* sk = a.in[9]; const float* pu = a.in[10]; const float* pv = a.in[11];
    { float m = 0.f; const f32x4* wp = (const f32x4*)w_in;
      constexpr size_t NV4 = (size_t)DM * DIN / 4;
      size_t i = gt;
      for (; i + 7 * (size_t)NGT < NV4; i += 8 * (size_t)NGT) {
          f32x4 v[8];
#pragma unroll
          for (int k = 0; k < 8; ++k) v[k] = wp[i + k * (size_t)NGT];
#pragma unroll
          for (int k = 0; k < 8; ++k) m = fmaxf(m, fmaxf(fmaxf(fabsf(v[k][0]), fabsf(v[k][1])), fmaxf(fabsf(v[k][2]), fabsf(v[k][3])))); }
      for (; i < NV4; i += NGT) { const f32x4 v = wp[i]; m = fmaxf(m, fmaxf(fmaxf(fabsf(v[0]), fabsf(v[1])), fmaxf(fabsf(v[2]), fabsf(v[3])))); }
      m = wave_max(m);
      volatile LAS float* red = (volatile LAS float*)(lds + MISC_OFF + 256);
      if (lane == 0) red[wave] = m;
      __syncthreads();
      if (tid == 0) { float mm = red[0];
#pragma unroll
          for (int w = 1; w < NWAVES; ++w) mm = fmaxf(mm, red[w]);
          __hip_atomic_fetch_max((unsigned*)(ws + WS_CTL) + CW_WMAX, __float_as_uint(mm), __ATOMIC_RELAXED, __HIP_MEMORY_SCOPE_AGENT); } }
    LAS float* wf = (LAS float*)(lds + 67584);
    for (int k = tid; k < DM; k += NTHREADS) { const f32x4 a0 = *(const f32x4*)(w_in + (size_t)k * DIN + NPROJ), a1 = *(const f32x4*)(w_in + (size_t)k * DIN + NPROJ + 4);
        wf[0 * DM + k] = a0[0]; wf[1 * DM + k] = a0[1]; wf[2 * DM + k] = a0[2]; wf[3 * DM + k] = a0[3]; wf[4 * DM + k] = a1[0]; wf[5 * DM + k] = a1[1]; wf[6 * DM + k] = a1[2]; wf[7 * DM + k] = a1[3]; }
    __syncthreads();
    for (int row = gw; row < T; row += NGW) {
        const f32x4* xr = (const f32x4*)(x + (size_t)row * DM);
        f32x4 v[8]; float ss = 0.f;
#pragma unroll
        for (int j = 0; j < 8; ++j) { v[j] = xr[lane + 64 * j]; ss += v[j][0] * v[j][0] + v[j][1] * v[j][1] + v[j][2] * v[j][2] + v[j][3] * v[j][3]; }
        const float r = 1.0f / sqrtf(wave_sum(ss) * (1.f / DM) + EPS);
        float f[8] = {0.f, 0.f, 0.f, 0.f, 0.f, 0.f, 0.f, 0.f};
        float xmax = 0.f;
#pragma unroll
        for (int j = 0; j < 8; ++j) { const f32x4 g4 = *(const f32x4*)(g_attn + 4 * (lane + 64 * j)); v[j][0] *= r * g4[0]; v[j][1] *= r * g4[1]; v[j][2] *= r * g4[2]; v[j][3] *= r * g4[3];
            xmax = fmaxf(xmax, fmaxf(fmaxf(fabsf(v[j][0]), fabsf(v[j][1])), fmaxf(fabsf(v[j][2]), fabsf(v[j][3])))); }
        xmax = wave_max(xmax);
        const float xq = xmax > 0.f ? 127.f / xmax : 1.f;
        if (lane == 0) ((float*)(ws + WS_SXN))[row] = xmax * (1.f / 127.f);
        unsigned* o8 = (unsigned*)(ws + WS_XN + (size_t)row * DM);
#pragma unroll
        for (int j = 0; j < 8; ++j) {
            const int e = 4 * (lane + 64 * j);
            const f32x4 xn = v[j];
            o8[lane + 64 * j] = (unsigned)pack_i8(xn[0] * xq, xn[1] * xq, xn[2] * xq, xn[3] * xq);
#pragma unroll
            for (int hh = 0; hh < 8; ++hh) { const f32x4 w4 = *(LAS f32x4*)(wf + hh * DM + e);
                f[hh] += (xn[0] * w4[0] + xn[1] * w4[1]) + (xn[2] * w4[2] + xn[3] * w4[3]); }
            __builtin_amdgcn_sched_barrier(0);
        }
#pragma unroll
        for (int hh = 0; hh < 8; ++hh) f[hh] = wave_sum(f[hh]);
        if (lane < 8) { float fl = f[0];
#pragma unroll
            for (int hh = 1; hh < 8; ++hh) fl = (lane == hh) ? f[hh] : fl;
            const int b = row >> 12, s = row & 4095;
            ((float*)(ws + WS_LOGF))[(size_t)(b * 8 + lane) * SEQ + s] = log_sigmoid_f(fl + b_forget[lane]); }
    }
    LAS float* scr = (LAS float*)(lds + wave * 8448);
    constexpr int I_IN = (DM / 64) * (NPROJ / 32), I_O = (DM / 64) * (DM / 32);
    for (int it = gw; it < 2 * I_O; it += NGW) {
        int r = it;
        if (r < I_O) { p0_transpose_item(w_out, DM, DM, (bf16_t*)(ws + WS_WOUT), DM / 32, scr, r, lane, nullptr); continue; } r -= I_O;
        p0_transpose_item(w_pq, DM, DM, (bf16_t*)(ws + WS_WPQ), DM / 32, scr, r, lane, g_ffn);
    }
    for (int i = gt; i < 8 * 2 * 128 * 128 / 8; i += NGT) { const f32x4 a0 = *(const f32x4*)(sk + (size_t)i * 8), a1 = *(const f32x4*)(sk + (size_t)i * 8 + 4);
        u32x4 w; w.x = cvt_pk_bf16(a0[0], a0[1]); w.y = cvt_pk_bf16(a0[2], a0[3]); w.z = cvt_pk_bf16(a1[0], a1[1]); w.w = cvt_pk_bf16(a1[2], a1[3]);
        *(u32x4*)(ws + WS_SK + (size_t)i * 16) = w; }
    if (gt < 256) ((float*)(ws + WS_GQK))[gt] = gt < 128 ? a.in[4][gt] : a.in[5][gt - 128];
    convert_tables(a, 0, TAB_SPLIT, gw, NGW);
    { XcdBarrier xb_; xb_.bar = (unsigned*)(ws + WS_CTL) + CW_BAR; xb_.x = xb_xcc_id(); xb_.st = (volatile LAS unsigned*)(lds + MISC_OFF) + 8; xcd_barrier(xb_); }
    const float wmax = __uint_as_float(__hip_atomic_load((unsigned*)(ws + WS_CTL) + CW_WMAX, __ATOMIC_RELAXED, __HIP_MEMORY_SCOPE_AGENT));
    if (gt == 0) *(float*)(ws + WS_WSC) = wmax * (1.f / 127.f);
    const float q8 = wmax > 0.f ? 127.f / wmax : 1.f;
    for (int it = gw; it < I_IN; it += NGW) p0_transpose_item_i8(w_in, DIN, DM, ws + WS_WIN, NPROJ / 32, scr, it, lane, q8);
}

__device__ __forceinline__ void cumsum_rows(const Args& a) {
    const int tid = tid_opaque(), lane = tid & 63, wave = tid >> 6;
    const int rowi = (int)gridDim.x - 1 - (int)blockIdx.x;
    if (rowi >= 16 || rowi < 0 || wave != 0) return;
    const float* src = (const float*)(a.ws + WS_LOGF) + (size_t)rowi * SEQ + lane * 64;
    float* dst = (float*)(a.ws + WS_C) + (size_t)rowi * SEQ + lane * 64;
    f32x4 v[16]; float run = 0.f;
#pragma unroll
    for (int i = 0; i < 16; ++i) { v[i] = *(const f32x4*)(src + 4 * i);
#pragma unroll
        for (int q = 0; q < 4; ++q) { run += v[i][q]; v[i][q] = run; } }
    float incl = run;
#pragma unroll
    for (int o = 1; o < 64; o <<= 1) { const float t = shup_f(incl, o); if (lane >= o) incl += t; }
    const float off = incl - run;
#pragma unroll
    for (int i = 0; i < 16; ++i) { f32x4 w = v[i]; w[0] += off; w[1] += off; w[2] += off; w[3] += off; *(f32x4*)(dst + 4 * i) = w; }
}

__device__ __forceinline__ void phase_qknorm(const Args& a) {
    const int tid = tid_opaque(), lane = tid & 63, wave = tid >> 6;
    const int gw = blockIdx.x * NWAVES + wave, NGW = gridDim.x * NWAVES;
    const int sub = lane & 15, rw = lane >> 4;
    const float* gq = a.in[4]; const float* gk = a.in[5];
    constexpr int ROWS = NB * NHF * SEQ;
    for (int it = gw; it < 2 * ROWS / 4; it += NGW) {
        const int row = it * 4 + rw; const bool isk = row >= ROWS;
        bf16_t* p = (bf16_t*)(a.ws + WS_SEC) + (size_t)row * HD + sub * 8;
        const float* g = (isk ? gk : gq) + sub * 8;
        const u32x4 w = *(const u32x4*)p;
        float v[8] = {bf_lo(w.x), bf_hi(w.x), bf_lo(w.y), bf_hi(w.y), bf_lo(w.z), bf_hi(w.z), bf_lo(w.w), bf_hi(w.w)};
        float ss = 0.f;
#pragma unroll
        for (int i = 0; i < 8; ++i) ss += v[i] * v[i];
        ss += sx_f(ss, 1); ss += sx_f(ss, 2); ss += sx_f(ss, 4); ss += sx_f(ss, 8);
        const float r = 1.0f / sqrtf(ss * (1.f / HD) + EPS);
        const f32x4 g0 = *(const f32x4*)g, g1 = *(const f32x4*)(g + 4);
        u32x4 o; o.x = cvt_pk_bf16(v[0] * r * g0[0], v[1] * r * g0[1]); o.y = cvt_pk_bf16(v[2] * r * g0[2], v[3] * r * g0[3]);
        o.z = cvt_pk_bf16(v[4] * r * g1[0], v[5] * r * g1[1]); o.w = cvt_pk_bf16(v[6] * r * g1[2], v[7] * r * g1[3]);
        *(u32x4*)p = o;
    }
}

__device__ __forceinline__ void phase_attn(const Args& a, unsigned char* lds_g) {
    const int tid = tid_opaque();
    volatile int* s_item = (volatile int*)(lds_g + MISC_OFF);
    unsigned* ctr = (unsigned*)(a.ws + WS_CTL);
    float lmax;
    { const int lane_ = tid & 63; const float* gqk = (const float*)(a.ws + WS_GQK);
      const float gq = fmaxf(fabsf(gqk[lane_]), fabsf(gqk[64 + lane_])), gk = fmaxf(fabsf(gqk[128 + lane_]), fabsf(gqk[192 + lane_]));
      lmax = 11.3137085f * 1.02f * wave_max(gq) * wave_max(gk); }
    for (;;) {
        __syncthreads();
        if (tid == 0) *s_item = (int)atomicAdd(ctr, 1u);
        __syncthreads();
        int it = *s_item, kind = -1, qb = 0, sub = 0;
#define CLS(K, Q, CNT) if (kind < 0) { if (it < (CNT)) { kind = (K); qb = (Q); sub = it; } else it -= (CNT); }
        CLS(2, 15, 32) CLS(1, 7, 16) CLS(2, 14, 32) CLS(2, 13, 32) CLS(1, 6, 16) CLS(2, 12, 32) CLS(2, 11, 32) CLS(1, 5, 16) CLS(2, 10, 32) CLS(2, 9, 32) CLS(1, 4, 16) CLS(2, 8, 32) CLS(1, 3, 16) CLS(1, 2, 16)
        if (kind < 0) { if (it < 256) { kind = 0; qb = 15 - (it >> 4); sub = it & 15; } else it -= 256; }
        CLS(1, 1, 16) CLS(1, 0, 16)
#undef CLS
        if (kind < 0) break;
        unsigned char* wsl = a.ws; asm volatile("" : "+s"(wsl));
        bf16_t* sec = (bf16_t*)(wsl + WS_SEC);
        const int bh = sub & 15, part = (kind == 2) ? 1 + (sub >> 4) : 0;
        const int b = bh >> 3, h = bh & 7;
        const size_t hoff = (size_t)bh * SEQ * HD;
        att::UnitRef u;
        u.P0 = qb * 256;
        if (kind == 0) {
            u.Q = sec + 4 * SEC_ELEMS + hoff + (size_t)u.P0 * HD; u.K = sec + 5 * SEC_ELEMS + hoff; u.V = sec + 6 * SEC_ELEMS + hoff;
            att::sb_unit(u, (bf16_t*)(wsl + WS_MIX) + (size_t)b * SEQ * DM + 1024 + h * HD, (char*)lds_g);
        } else {
            u.Q = sec + 0 * SEC_ELEMS + hoff + (size_t)u.P0 * HD; u.K = sec + 1 * SEC_ELEMS + hoff; u.V = sec + 2 * SEC_ELEMS + hoff;
            att::attn_unit<false>(u, wsl, bh, (char*)lds_g, part, lmax);
        }
    }
}
__device__ __forceinline__ void phase_attn_combine(const Args& a) {
    const int gt = blockIdx.x * NTHREADS + tid_opaque(), NGT = gridDim.x * NTHREADS;
    const float* po = (const float*)(a.ws + WS_PO); const float* pml = (const float*)(a.ws + WS_PML);
    const bf16_t* gate = (const bf16_t*)(a.ws + WS_SEC) + 3 * SEC_ELEMS; bf16_t* mix = (bf16_t*)(a.ws + WS_MIX);
    constexpr float C2 = LOG2E * SCALE;
    for (int item = gt; item < 128 * 256 * 16; item += NGT) {
        const int slot = item >> 12, row = (item >> 4) & 255, cg = item & 15;
        const int qb = 8 + (slot >> 4), bh = slot & 15, b = bh >> 3, h = bh & 7;
        const f32x2 ml1 = *(const f32x2*)(pml + (size_t)(slot * 2) * 512 + row * 2), ml2 = *(const f32x2*)(pml + (size_t)(slot * 2 + 1) * 512 + row * 2);
        const float M = fmaxf(ml1.x, ml2.x), a1 = __builtin_amdgcn_exp2f((ml1.x - M) * C2), a2 = __builtin_amdgcn_exp2f((ml2.x - M) * C2);
        const float inv = 1.f / (a1 * ml1.y + a2 * ml2.y);
        const float* p1 = po + (size_t)(slot * 2) * 32768 + row * 128 + cg * 8; const float* p2 = p1 + 32768;
        const f32x4 x0 = *(const f32x4*)p1, x1 = *(const f32x4*)(p1 + 4), y0 = *(const f32x4*)p2, y1 = *(const f32x4*)(p2 + 4);
        const size_t tok = (size_t)b * SEQ + qb * 256 + row;
        const u32x4 gw = *(const u32x4*)(gate + tok * 1024 + h * HD + cg * 8);
        const float w1 = a1 * inv, w2 = a2 * inv;
        u32x4 o;
        o.x = cvt_pk_bf16((w1 * x0[0] + w2 * y0[0]) * bf_lo(gw.x), (w1 * x0[1] + w2 * y0[1]) * bf_hi(gw.x));
        o.y = cvt_pk_bf16((w1 * x0[2] + w2 * y0[2]) * bf_lo(gw.y), (w1 * x0[3] + w2 * y0[3]) * bf_hi(gw.y));
        o.z = cvt_pk_bf16((w1 * x1[0] + w2 * y1[0]) * bf_lo(gw.z), (w1 * x1[1] + w2 * y1[1]) * bf_hi(gw.z));
        o.w = cvt_pk_bf16((w1 * x1[2] + w2 * y1[2]) * bf_lo(gw.w), (w1 * x1[3] + w2 * y1[3]) * bf_hi(gw.w));
        *(u32x4*)(mix + tok * DM + h * HD + cg * 8) = o;
    }
}

__device__ __forceinline__ unsigned f2ord(float f) { const unsigned u = __float_as_uint(f); return u ^ ((unsigned)((int)u >> 31) | 0x80000000u); }
__device__ __forceinline__ float ord2f(unsigned k) { const unsigned u = k ^ (~(unsigned)((int)k >> 31) | 0x80000000u); return __uint_as_float(u); }
#define INS16(L, X) do { unsigned x_ = (X); _Pragma("unroll") for (int i_ = 0; i_ < 16; ++i_) { const unsigned hi_ = max(L[i_], x_); x_ = min(L[i_], x_); L[i_] = hi_; } } while (0)
__device__ __forceinline__ void sort16_desc(unsigned (&a)[16]) {
#pragma unroll
    for (int k = 2; k <= 16; k <<= 1)
#pragma unroll
        for (int j = k >> 1; j > 0; j >>= 1)
#pragma unroll
            for (int i = 0; i < 16; ++i) { const int l = i ^ j; if (l > i) { const unsigned hi_ = max(a[i], a[l]), lo_ = min(a[i], a[l]); const bool desc = (i & k) == 0; a[i] = desc ? hi_ : lo_; a[l] = desc ? lo_ : hi_; } }
}
__device__ __forceinline__ void merge_top16(unsigned (&a)[16], const unsigned (&b)[16]) {
#pragma unroll
    for (int i = 0; i < 16; ++i) a[i] = max(a[i], b[15 - i]);
#pragma unroll
    for (int j = 8; j > 0; j >>= 1)
#pragma unroll
        for (int i = 0; i < 16; ++i) { const int l = i ^ j; if (l > i) { const unsigned hi_ = max(a[i], a[l]), lo_ = min(a[i], a[l]); a[i] = hi_; a[l] = lo_; } }
}
__device__ __forceinline__ void topk_half(const bf16_t* qrow  , const bf16_t* skb, int h, int c, int r32, int hi, unsigned (&L)[16]) {
    bf16x8 qf[8];
#pragma unroll
    for (int d0 = 0; d0 < 8; ++d0) qf[d0] = *(const bf16x8*)(qrow + c * 128 + d0 * 16 + hi * 8);
    const unsigned hi4 = 4u * (unsigned)hi;
#pragma unroll
    for (int kt = 0; kt < 4; ++kt) {
        f32x16 acc = f32x16{};
#pragma unroll
        for (int d0 = 0; d0 < 8; ++d0) { const bf16x8 kf = *(const bf16x8*)(skb + (size_t)((h * 2 + c) * 128 + kt * 32 + r32) * 128 + d0 * 16 + hi * 8);
            acc = __builtin_amdgcn_mfma_f32_32x32x16_bf16(kf, qf[d0], acc, 0, 0, 0); }
        unsigned G[16];
#pragma unroll
        for (int r = 0; r < 16; ++r) { const unsigned cst = (unsigned)(127 - (kt * 32 + (r & 3) + 8 * (r >> 2))); G[r] = (f2ord(acc[r]) & ~127u) | (cst - hi4); }
        sort16_desc(G);
        if (kt == 0) {
#pragma unroll
            for (int i = 0; i < 16; ++i) L[i] = G[i];
        } else merge_top16(L, G);
    }
    unsigned P[16];
#pragma unroll
    for (int i = 0; i < 16; ++i) { auto rr = __builtin_amdgcn_permlane32_swap(L[i], L[i], false, false); P[i] = hi ? rr[0] : rr[1]; }
    merge_top16(L, P);
}
__device__ __forceinline__ void topk_task(unsigned char* ws, const bf16_t* qrow, LAS int* tb, int t0, int h, int lane) {
    const int r32 = lane & 31, hi = lane >> 5;
    const bf16_t* skb = (const bf16_t*)(ws + WS_SK);
    int* idx_o = (int*)(ws + WS_IDX); float* gw_o = (float*)(ws + WS_GW);
    float rt_l;
    { const f32x4* sp = (const f32x4*)((const float*)(ws + WS_SSQ) + (size_t)(t0 + (lane & 31)) * 32); float tot = 0.f;
#pragma unroll
      for (int i = 0; i < 8; ++i) { const f32x4 v = sp[i]; tot += (v[0] + v[1]) + (v[2] + v[3]); }
      rt_l = 1.0f / sqrtf(tot * (1.f / DM) + EPS); }
        {
          const bf16_t* hbp = (const bf16_t*)(ws + WS_HB); const float* amx = (const float*)(ws + WS_AMX); unsigned char* xq = ws + WS_XQ;
          float am = 0.f;
          { const f32x4* ap = (const f32x4*)(amx + (size_t)(t0 + (lane & 31)) * 32);
#pragma unroll
            for (int i = 0; i < 8; ++i) { const f32x4 v = ap[i]; am = fmaxf(am, fmaxf(fmaxf(v[0], v[1]), fmaxf(v[2], v[3]))); } }
          if (h == 0 && lane < 32) ((float*)(ws + WS_SX))[t0 + lane] = rt_l * am * (1.f / 126.5f);
          const float qs = am > 0.f ? 126.5f / am : 1.f;
          u32x4 wv[16];
#pragma unroll
          for (int j = 0; j < 16; ++j) { const int ch = lane + 64 * j; wv[j] = *(const u32x4*)(hbp + (size_t)(t0 + (ch >> 5)) * DM + h * 256 + (ch & 31) * 8); }
#pragma unroll
          for (int j = 0; j < 16; ++j) { const int ch = lane + 64 * j, tl = ch >> 5, tk = t0 + tl, col = h * 256 + (ch & 31) * 8;
              const u32x4 w = wv[j]; const float r = sh_f(qs, tl);
              const int p0 = pack_i8(bf_lo(w.x) * r, bf_hi(w.x) * r, bf_lo(w.y) * r, bf_hi(w.y) * r), p1 = pack_i8(bf_lo(w.z) * r, bf_hi(w.z) * r, bf_lo(w.w) * r, bf_hi(w.w) * r);
              *(u32x2*)(xq + (size_t)tk * DM + col) = (u32x2){(unsigned)p0, (unsigned)p1}; } }
        unsigned L[2][16];
        topk_half(qrow, skb, h, 0, r32, hi, L[0]);
        __builtin_amdgcn_sched_barrier(0);
        topk_half(qrow, skb, h, 1, r32, hi, L[1]);
        __builtin_amdgcn_sched_barrier(0);
        float s1[16], s2[16]; int i1[16], i2[16];
#pragma unroll
        for (int i = 0; i < 16; ++i) { s1[i] = ord2f((L[0][i] & ~127u) | 64u); i1[i] = 127 - (int)(L[0][i] & 127u); s2[i] = ord2f((L[1][i] & ~127u) | 64u); i2[i] = 127 - (int)(L[1][i] & 127u); }
        unsigned CG[4][16];
#pragma unroll
        for (int i = 0; i < 64; ++i) CG[i >> 4][i & 15] = 0u;
        CG[0][0] = (f2ord(s1[0] + s2[0]) & ~255u) | 0u;
        CG[0][1] = (f2ord(s1[0] + s2[1]) & ~255u) | 1u;
        CG[0][2] = (f2ord(s1[0] + s2[2]) & ~255u) | 2u;
        CG[0][3] = (f2ord(s1[0] + s2[3]) & ~255u) | 3u;
        CG[0][4] = (f2ord(s1[0] + s2[4]) & ~255u) | 4u;
        CG[0][5] = (f2ord(s1[0] + s2[5]) & ~255u) | 5u;
        CG[0][6] = (f2ord(s1[0] + s2[6]) & ~255u) | 6u;
        CG[0][7] = (f2ord(s1[0] + s2[7]) & ~255u) | 7u;
        CG[0][8] = (f2ord(s1[0] + s2[8]) & ~255u) | 8u;
        CG[0][9] = (f2ord(s1[0] + s2[9]) & ~255u) | 9u;
        CG[0][10] = (f2ord(s1[0] + s2[10]) & ~255u) | 10u;
        CG[0][11] = (f2ord(s1[0] + s2[11]) & ~255u) | 11u;
        CG[0][12] = (f2ord(s1[0] + s2[12]) & ~255u) | 12u;
        CG[0][13] = (f2ord(s1[0] + s2[13]) & ~255u) | 13u;
        CG[0][14] = (f2ord(s1[0] + s2[14]) & ~255u) | 14u;
        CG[0][15] = (f2ord(s1[0] + s2[15]) & ~255u) | 15u;
        CG[1][0] = (f2ord(s1[1] + s2[0]) & ~255u) | 16u;
        CG[1][1] = (f2ord(s1[1] + s2[1]) & ~255u) | 17u;
        CG[1][2] = (f2ord(s1[1] + s2[2]) & ~255u) | 18u;
        CG[1][3] = (f2ord(s1[1] + s2[3]) & ~255u) | 19u;
        CG[1][4] = (f2ord(s1[1] + s2[4]) & ~255u) | 20u;
        CG[1][5] = (f2ord(s1[1] + s2[5]) & ~255u) | 21u;
        CG[1][6] = (f2ord(s1[1] + s2[6]) & ~255u) | 22u;
        CG[1][7] = (f2ord(s1[1] + s2[7]) & ~255u) | 23u;
        CG[1][8] = (f2ord(s1[2] + s2[0]) & ~255u) | 32u;
        CG[1][9] = (f2ord(s1[2] + s2[1]) & ~255u) | 33u;
        CG[1][10] = (f2ord(s1[2] + s2[2]) & ~255u) | 34u;
        CG[1][11] = (f2ord(s1[2] + s2[3]) & ~255u) | 35u;
        CG[1][12] = (f2ord(s1[2] + s2[4]) & ~255u) | 36u;
        CG[1][13] = (f2ord(s1[3] + s2[0]) & ~255u) | 48u;
        CG[1][14] = (f2ord(s1[3] + s2[1]) & ~255u) | 49u;
        CG[1][15] = (f2ord(s1[3] + s2[2]) & ~255u) | 50u;
        CG[2][0] = (f2ord(s1[3] + s2[3]) & ~255u) | 51u;
        CG[2][1] = (f2ord(s1[4] + s2[0]) & ~255u) | 64u;
        CG[2][2] = (f2ord(s1[4] + s2[1]) & ~255u) | 65u;
        CG[2][3] = (f2ord(s1[4] + s2[2]) & ~255u) | 66u;
        CG[2][4] = (f2ord(s1[5] + s2[0]) & ~255u) | 80u;
        CG[2][5] = (f2ord(s1[5] + s2[1]) & ~255u) | 81u;
        CG[2][6] = (f2ord(s1[6] + s2[0]) & ~255u) | 96u;
        CG[2][7] = (f2ord(s1[6] + s2[1]) & ~255u) | 97u;
        CG[2][8] = (f2ord(s1[7] + s2[0]) & ~255u) | 112u;
        CG[2][9] = (f2ord(s1[7] + s2[1]) & ~255u) | 113u;
        CG[2][10] = (f2ord(s1[8] + s2[0]) & ~255u) | 128u;
        CG[2][11] = (f2ord(s1[9] + s2[0]) & ~255u) | 144u;
        CG[2][12] = (f2ord(s1[10] + s2[0]) & ~255u) | 160u;
        CG[2][13] = (f2ord(s1[11] + s2[0]) & ~255u) | 176u;
        CG[2][14] = (f2ord(s1[12] + s2[0]) & ~255u) | 192u;
        CG[2][15] = (f2ord(s1[13] + s2[0]) & ~255u) | 208u;
        CG[3][0] = (f2ord(s1[14] + s2[0]) & ~255u) | 224u;
        CG[3][1] = (f2ord(s1[15] + s2[0]) & ~255u) | 240u;
        sort16_desc(CG[0]); sort16_desc(CG[1]); sort16_desc(CG[2]); sort16_desc(CG[3]);
        merge_top16(CG[0], CG[1]); merge_top16(CG[2], CG[3]); merge_top16(CG[0], CG[2]);
        unsigned LC[16];
#pragma unroll
        for (int i = 0; i < 16; ++i) LC[i] = CG[0][i];
#pragma unroll
        for (int i = 0; i < 16; ++i) { tb[i * 64 + lane] = i1[i]; tb[(16 + i) * 64 + lane] = i2[i]; }
        float LS[16]; int LP[16];
#pragma unroll
        for (int i = 0; i < 16; ++i) { const unsigned cid = LC[i] & 255u; LS[i] = ord2f((LC[i] & ~255u) | 128u);
            LP[i] = tb[(cid >> 4) * 64 + lane] * 128 + tb[(16 + (cid & 15u)) * 64 + lane]; }
        float den = 0.f, e[16];
#pragma unroll
        for (int i = 0; i < 16; ++i) { e[i] = __expf(LS[i] - LS[0]); den += e[i]; }
        const float rden = 1.f / den;
        const size_t ob = (size_t)(t0 + r32) * NE + h * 16;
        if (hi == 0) {
#pragma unroll
            for (int i = 0; i < 4; ++i) *(int4*)(idx_o + ob + 4 * i) = make_int4(LP[4 * i], LP[4 * i + 1], LP[4 * i + 2], LP[4 * i + 3]);
            { unsigned short* i16 = (unsigned short*)(ws + WS_IDX16) + ob;
#pragma unroll
              for (int i = 0; i < 2; ++i) *(u32x4*)(i16 + 8 * i) = (u32x4){(unsigned)LP[8 * i] | ((unsigned)LP[8 * i + 1] << 16), (unsigned)LP[8 * i + 2] | ((unsigned)LP[8 * i + 3] << 16),
                                                                        (unsigned)LP[8 * i + 4] | ((unsigned)LP[8 * i + 5] << 16), (unsigned)LP[8 * i + 6] | ((unsigned)LP[8 * i + 7] << 16)}; }
        } else {
#pragma unroll
            for (int i = 0; i < 4; ++i) *(f32x4*)(gw_o + ob + 4 * i) = (f32x4){e[4 * i] * rden, e[4 * i + 1] * rden, e[4 * i + 2] * rden, e[4 * i + 3] * rden};
        }
}
__device__ __forceinline__ void phase_topk(const Args& a, unsigned char* lds_g) {
    LAS unsigned char* lds = (LAS unsigned char*)lds_g;
    const int tid = tid_opaque(), lane = tid & 63, wave = tid >> 6;
    const int gw = blockIdx.x * NWAVES + wave, NGW = gridDim.x * NWAVES;
    const bf16_t* qp = (const bf16_t*)(a.ws + WS_QP);
    for (int task = gw; task < (T / 32) * 8; task += NGW) {
        const int h = task & 7, t0 = (task >> 3) * 32;
        topk_task(a.ws, qp + (size_t)(t0 + (lane & 31)) * DM + h * 256, (LAS int*)(lds + wave * 8192), t0, h, lane);
    }
}
__device__ __forceinline__ void pg8::EpiPeerQFused::fused(const f32x4 (&acc)[2][2][4][2], const Unit& u, int wr, int wc, int fr, int fq, PG8_LAS unsigned char* lds) const {
    constexpr int ROWB = 528;
#pragma unroll
    for (int ai = 0; ai < 2; ++ai)
#pragma unroll
        for (int m = 0; m < 4; ++m) {
            const int tr = ai * HALF + wr * 64 + m * 16 + fr, tk = u.pm * BM + tr;
            float tot = 0.f;
#pragma unroll
            for (int i = 0; i < 8; ++i) { const f32x4 s4 = *(const f32x4*)(ssq + (size_t)tk * 32 + 4 * i); tot += (s4[0] + s4[1]) + (s4[2] + s4[3]); }
            const float r = 1.0f / sqrtf(tot * (1.f / DM) + EPS);
#pragma unroll
            for (int bj = 0; bj < 2; ++bj) {
                const f32x4 v0 = acc[ai][bj][m][0] * r, v1 = acc[ai][bj][m][1] * r;
                u32x4 w; w.x = cvt_pk_bf16(v0[0], v0[1]); w.y = cvt_pk_bf16(v0[2], v0[3]); w.z = cvt_pk_bf16(v1[0], v1[1]); w.w = cvt_pk_bf16(v1[2], v1[3]);
                *(PG8_LAS u32x4*)(lds + tr * ROWB + (bj * HALF + wc * 32 + 8 * fq) * 2) = w;
            }
        }
    __syncthreads();
    const int tid = tid_opaque(), lane = tid & 63, wave = tid >> 6;
    PG8_LAS unsigned char* myrows = lds + (wave * 32) * ROWB;
    topk_task(wsb, (const bf16_t*)(const void*)(myrows + (lane & 31) * ROWB), (LAS int*)myrows, u.pm * BM + wave * 32, u.pn, lane);
}
__device__ __forceinline__ void wave_argmax(float& v, int& i) {
#pragma unroll
    for (int o = 1; o < 64; o <<= 1) { const float ov = sx_f(v, o); const int oi = sx_i(i, o); if (ov > v || (ov == v && oi < i)) { v = ov; i = oi; } }
}
__device__ __forceinline__ void phase_topk_ref(const Args& a) {
    const int tid = tid_opaque(), lane = tid & 63, wave = tid >> 6;
    const int gw = blockIdx.x * NWAVES + wave, NGW = gridDim.x * NWAVES;
    const bf16_t* skb = (const bf16_t*)(a.ws + WS_SK); const bf16_t* qp = (const bf16_t*)(a.ws + WS_QP);
    int* idx_o = (int*)(a.ws + WS_IDX); float* gw_o = (float*)(a.ws + WS_GW);
    for (int task = gw; task < T * 8; task += NGW) {
        const int t = task >> 3, h = task & 7;
        float topS[2]; int topI[2];
        for (int c = 0; c < 2; ++c) {
            const bf16_t* q = qp + (size_t)t * DM + h * 256 + c * 128;
            float sc0 = 0.f, sc1 = 0.f;
            const bf16_t* k0 = skb + (size_t)((h * 2 + c) * 128 + lane) * 128; const bf16_t* k1 = k0 + 64 * 128;
            for (int d = 0; d < 128; ++d) { const float qd = __uint_as_float((unsigned)q[d] << 16);
                sc0 += qd * __uint_as_float((unsigned)k0[d] << 16); sc1 += qd * __uint_as_float((unsigned)k1[d] << 16); }
            float ms = 0.f; int mi = 0;
            for (int r = 0; r < 16; ++r) {
                float v; int i; if (sc0 >= sc1) { v = sc0; i = lane; } else { v = sc1; i = lane + 64; }
                wave_argmax(v, i);
                if (lane == r) { ms = v; mi = i; }
                if (i == lane) sc0 = -__builtin_inff();
                if (i == lane + 64) sc1 = -__builtin_inff();
            }
            topS[c] = ms; topI[c] = mi;
        }
        float cs[4]; int ci[4];
#pragma unroll
        for (int j = 0; j < 4; ++j) { const int cidx = lane * 4 + j, aa = cidx >> 4, bb = cidx & 15;
            cs[j] = sh_f(topS[0], aa) + sh_f(topS[1], bb); ci[j] = cidx; }
        float fs = 0.f; int fi = 0;
        for (int r = 0; r < 16; ++r) {
            float v = cs[0]; int i = ci[0];
#pragma unroll
            for (int j = 1; j < 4; ++j) if (cs[j] > v) { v = cs[j]; i = ci[j]; }
            wave_argmax(v, i);
            if (lane == r) { fs = v; fi = i; }
#pragma unroll
            for (int j = 0; j < 4; ++j) if (ci[j] == i) cs[j] = -__builtin_inff();
        }
        const int e1 = sh_i(topI[0], fi >> 4), e2 = sh_i(topI[1], fi & 15);
        const float mx = sh_f(fs, 0);
        float ev = lane < 16 ? __expf(fs - mx) : 0.f;
        const float den = wave_sum(ev);
        if (lane < 16) { idx_o[(size_t)t * NE + h * 16 + lane] = e1 * 128 + e2; gw_o[(size_t)t * NE + h * 16 + lane] = ev / den; }
    }
}

__device__ __forceinline__ void fp8x16_to_f32(const u32x4 q, f32x2 (&o)[8]) {
    o[0] = __builtin_amdgcn_cvt_pk_f32_fp8((int)q.x, false); o[1] = __builtin_amdgcn_cvt_pk_f32_fp8((int)q.x, true);
    o[2] = __builtin_amdgcn_cvt_pk_f32_fp8((int)q.y, false); o[3] = __builtin_amdgcn_cvt_pk_f32_fp8((int)q.y, true);
    o[4] = __builtin_amdgcn_cvt_pk_f32_fp8((int)q.z, false); o[5] = __builtin_amdgcn_cvt_pk_f32_fp8((int)q.z, true);
    o[6] = __builtin_amdgcn_cvt_pk_f32_fp8((int)q.w, false); o[7] = __builtin_amdgcn_cvt_pk_f32_fp8((int)q.w, true);
}
#define HALVE(dst, srcv, n, bitmask) do { const bool up_ = (lane & (bitmask)) != 0; _Pragma("unroll") for (int i_ = 0; i_ < (n); ++i_) { \
        const float keep_ = up_ ? srcv[(n) + i_] : srcv[i_], send_ = up_ ? srcv[i_] : srcv[(n) + i_]; dst[i_] = keep_ + sx_f(send_, (bitmask)); } } while (0)
#define ITEM_T(n) (wv + ((n) % KT) * NWX)
#define ITEM_S(n) (xl + 8 * ((n) / KT))
#define LD_IDX(ID, n) do { const int4* ip_ = (const int4*)(idx_i + (size_t)ITEM_T(n) * NE + g * 16); _Pragma("unroll") for (int i_ = 0; i_ < 4; ++i_) ID[i_] = ip_[i_]; } while (0)
#define LD_ROWS(Q, ID, TAB, n) do { const unsigned char* b_ = (TAB) + (size_t)ITEM_S(n) * ((size_t)NEXP * 128) + c * 16; _Pragma("unroll") for (int i_ = 0; i_ < 4; ++i_) { \
        Q[4 * i_] = *(const u32x4*)(b_ + (size_t)ID[i_].x * 128); Q[4 * i_ + 1] = *(const u32x4*)(b_ + (size_t)ID[i_].y * 128); \
        Q[4 * i_ + 2] = *(const u32x4*)(b_ + (size_t)ID[i_].z * 128); Q[4 * i_ + 3] = *(const u32x4*)(b_ + (size_t)ID[i_].w * 128); } } while (0)
__device__ __forceinline__ int dpp_hmirror(int v) { return __builtin_amdgcn_update_dpp(0, v, 0x141, 0xf, 0xf, true); }
__device__ __forceinline__ int dpp_qxor2(int v) { return __builtin_amdgcn_update_dpp(0, v, 0x4E, 0xf, 0xf, true); }
__device__ __forceinline__ int dpp_qxor1(int v) { return __builtin_amdgcn_update_dpp(0, v, 0xB1, 0xf, 0xf, true); }
__device__ __forceinline__ void phase_peer_u(const Args& a) {
    const int tid = tid_opaque(), lane = tid & 63, wave = tid >> 6, g = lane >> 3, c = lane & 7;
    const int xl = blockIdx.x & 7, wv = (blockIdx.x >> 3) * NWAVES + wave, NWX = (gridDim.x >> 3) * NWAVES, KT = T / NWX, N = 2 * KT;
    const unsigned char* xq = a.ws + WS_XQ; const unsigned char* u8 = a.ws + WS_U8;
    const unsigned short* idx16 = (const unsigned short*)(a.ws + WS_IDX16); bf16_t* part = (bf16_t*)(a.ws + WS_PART);
    const bool up4 = (c & 4) != 0, up2 = (c & 2) != 0, up1 = (c & 1) != 0;
#define LD_I16(ID, n, h) do { ID = *(const u32x4*)(idx16 + (size_t)ITEM_T(n) * NE + g * 16 + (h) * 8); } while (0)
#define LD_R8(Q, ID, n) do { const unsigned char* b_ = u8 + (size_t)ITEM_S(n) * ((size_t)NEXP * 128) + c * 16; \
        Q[0] = *(const u32x4*)(b_ + (size_t)(ID.x & 0xffffu) * 128); Q[1] = *(const u32x4*)(b_ + (size_t)(ID.x >> 16) * 128); \
        Q[2] = *(const u32x4*)(b_ + (size_t)(ID.y & 0xffffu) * 128); Q[3] = *(const u32x4*)(b_ + (size_t)(ID.y >> 16) * 128); \
        Q[4] = *(const u32x4*)(b_ + (size_t)(ID.z & 0xffffu) * 128); Q[5] = *(const u32x4*)(b_ + (size_t)(ID.z >> 16) * 128); \
        Q[6] = *(const u32x4*)(b_ + (size_t)(ID.w & 0xffffu) * 128); Q[7] = *(const u32x4*)(b_ + (size_t)(ID.w >> 16) * 128); } while (0)
#define LD_X(X, n) do { X = *(const u32x4*)(xq + (size_t)ITEM_T(n) * DM + ITEM_S(n) * 128 + c * 16); } while (0)
#define DOT8(P, OFF, Q, X) do { _Pragma("unroll") for (int i = 0; i < 8; ++i) { int d_ = __builtin_amdgcn_sdot4((int)Q[i].x, (int)X.x, 0, false); d_ = __builtin_amdgcn_sdot4((int)Q[i].y, (int)X.y, d_, false); \
            d_ = __builtin_amdgcn_sdot4((int)Q[i].z, (int)X.z, d_, false); P[(OFF) + i] = __builtin_amdgcn_sdot4((int)Q[i].w, (int)X.w, d_, false); } } while (0)
#define FINISH_U(P, n) do { int p8[8], p4[4], p2[2]; \
        _Pragma("unroll") for (int i = 0; i < 8; ++i) { const int keep_ = up4 ? P[8 + i] : P[i], send_ = up4 ? P[i] : P[8 + i]; p8[i] = keep_ + dpp_hmirror(send_); } \
        _Pragma("unroll") for (int i = 0; i < 4; ++i) { const int keep_ = up2 ? p8[4 + i] : p8[i], send_ = up2 ? p8[i] : p8[4 + i]; p4[i] = keep_ + dpp_qxor2(send_); } \
        _Pragma("unroll") for (int i = 0; i < 2; ++i) { const int keep_ = up1 ? p4[2 + i] : p4[i], send_ = up1 ? p4[i] : p4[2 + i]; p2[i] = keep_ + dpp_qxor1(send_); } \
        *(unsigned*)(part + ((size_t)ITEM_T(n) * 16 + ITEM_S(n)) * NE + 2 * lane) = cvt_pk_bf16((float)p2[0], (float)p2[1]); } while (0)
    u32x4 IA, IB, IC, ID_, QA[8], QB[8], QC[8], QD[8], XA, XB;
    LD_I16(IA, 0, 0); LD_I16(IB, 0, 1); LD_I16(IC, 1, 0); LD_I16(ID_, 1, 1);
    LD_R8(QA, IA, 0); LD_R8(QB, IB, 0); LD_X(XA, 0); LD_R8(QC, IC, 1); LD_R8(QD, ID_, 1); LD_X(XB, 1);
    if (N > 2) { LD_I16(IA, 2, 0); LD_I16(IB, 2, 1); LD_I16(IC, 3, 0); LD_I16(ID_, 3, 1); }
    for (int n = 0; n < N; n += 2) {
        int p[16];
        DOT8(p, 0, QA, XA); if (n + 2 < N) { LD_R8(QA, IA, n + 2); if (n + 4 < N) LD_I16(IA, n + 4, 0); }
        DOT8(p, 8, QB, XA); if (n + 2 < N) { LD_R8(QB, IB, n + 2); LD_X(XA, n + 2); if (n + 4 < N) LD_I16(IB, n + 4, 1); }
        FINISH_U(p, n);
        int r[16];
        DOT8(r, 0, QC, XB); if (n + 3 < N) { LD_R8(QC, IC, n + 3); if (n + 5 < N) LD_I16(IC, n + 5, 0); }
        DOT8(r, 8, QD, XB); if (n + 3 < N) { LD_R8(QD, ID_, n + 3); LD_X(XB, n + 3); if (n + 5 < N) LD_I16(ID_, n + 5, 1); }
        FINISH_U(r, n + 1);
    }
#undef LD_I16
#undef LD_R8
#undef LD_X
#undef DOT8
#undef FINISH_U
}
__device__ __forceinline__ void phase_peer_w(const Args& a) {
    const int gt = blockIdx.x * NTHREADS + tid_opaque(), NGT = gridDim.x * NTHREADS;
    const int* idx_i = (const int*)(a.ws + WS_IDX); const float* gw_i = (const float*)(a.ws + WS_GW); const bf16_t* part = (const bf16_t*)(a.ws + WS_PART);
    const float* suv = (const float*)(a.ws + WS_SUV); const float* sx = (const float*)(a.ws + WS_SX);
    unsigned char* wq = a.ws + WS_WQ; float* sw = (float*)(a.ws + WS_SW);
    for (int item = gt; item < T * NE / 2; item += NGT) {
        const int t = item >> 6, e = (item & 63) * 2;
        unsigned pw[16];
#pragma unroll
        for (int s = 0; s < 16; ++s) pw[s] = *(const unsigned*)(part + ((size_t)t * 16 + s) * NE + e);
        float sum0 = 0.f, sum1 = 0.f;
#pragma unroll
        for (int s = 0; s < 16; ++s) { sum0 += bf_lo(pw[s]); sum1 += bf_hi(pw[s]); }
        const int2 ex = *(const int2*)(idx_i + (size_t)t * NE + e); const f32x2 gg = *(const f32x2*)(gw_i + (size_t)t * NE + e);
        const float sxt = sx[t];
        const float d0 = sum0 * suv[ex.x] * sxt, d1 = sum1 * suv[ex.y] * sxt;
        const float om0 = 0.5f * d0 * (1.f + erff(d0 * 0.70710678118654752f)) * gg.x * suv[NEXP + ex.x];
        const float om1 = 0.5f * d1 * (1.f + erff(d1 * 0.70710678118654752f)) * gg.y * suv[NEXP + ex.y];
        float mx = fmaxf(fabsf(om0), fabsf(om1));
        mx = fmaxf(mx, sx_f(mx, 1)); mx = fmaxf(mx, sx_f(mx, 2)); mx = fmaxf(mx, sx_f(mx, 4));
        const float qs = mx > 0.f ? 127.f / mx : 1.f;
        const int q0 = (int)__builtin_rintf(om0 * qs), q1 = (int)__builtin_rintf(om1 * qs);
        *(unsigned short*)(wq + (size_t)t * NE + e) = (unsigned short)(((unsigned)q0 & 0xffu) | (((unsigned)q1 & 0xffu) << 8));
        if ((e & 15) == 0) sw[t * 8 + (e >> 4)] = mx * (1.f / 127.f);
    }
}
__device__ __forceinline__ void phase_peer_v(const Args& a, float* dst) {
    const int tid = tid_opaque(), lane = tid & 63, wave = tid >> 6, g = lane >> 3, c = lane & 7;
    const int xl = blockIdx.x & 7, wv = (blockIdx.x >> 3) * NWAVES + wave, NWX = (gridDim.x >> 3) * NWAVES, KT = T / NWX, N = 2 * KT;
    const unsigned char* v8 = a.ws + WS_V8;
    const int* idx_i = (const int*)(a.ws + WS_IDX); const unsigned char* wq = a.ws + WS_WQ; const float* sw = (const float*)(a.ws + WS_SW);
    const bf16_t* hsrc = (const bf16_t*)(a.ws + WS_HB);
#define LD_W(W, SWV, HV, n) do { W = *(const u32x4*)(wq + (size_t)ITEM_T(n) * NE + g * 16); SWV = sw[ITEM_T(n) * 8 + g]; HV = *(const unsigned*)(hsrc + (size_t)ITEM_T(n) * DM + ITEM_S(n) * 128 + 2 * lane); } while (0)
#define QUAD(A_, B_, C_, D_, W_, A0, A1, A2, A3) do { \
        const unsigned ablo_ = __builtin_amdgcn_perm(B_, A_, 0x05010400u), abhi_ = __builtin_amdgcn_perm(B_, A_, 0x07030602u); \
        const unsigned cdlo_ = __builtin_amdgcn_perm(D_, C_, 0x05010400u), cdhi_ = __builtin_amdgcn_perm(D_, C_, 0x07030602u); \
        A0 = __builtin_amdgcn_sdot4((int)__builtin_amdgcn_perm(cdlo_, ablo_, 0x05040100u), (int)(W_), A0, false); \
        A1 = __builtin_amdgcn_sdot4((int)__builtin_amdgcn_perm(cdlo_, ablo_, 0x07060302u), (int)(W_), A1, false); \
        A2 = __builtin_amdgcn_sdot4((int)__builtin_amdgcn_perm(cdhi_, abhi_, 0x05040100u), (int)(W_), A2, false); \
        A3 = __builtin_amdgcn_sdot4((int)__builtin_amdgcn_perm(cdhi_, abhi_, 0x07060302u), (int)(W_), A3, false); } while (0)
#define COMPUTE_V(Q, W, SWV, HV, n) do { int ac[16]; _Pragma("unroll") for (int k = 0; k < 16; ++k) ac[k] = 0; \
        _Pragma("unroll") for (int q_ = 0; q_ < 4; ++q_) { const unsigned w_ = q_ == 0 ? W.x : q_ == 1 ? W.y : q_ == 2 ? W.z : W.w; \
            QUAD(Q[4 * q_].x, Q[4 * q_ + 1].x, Q[4 * q_ + 2].x, Q[4 * q_ + 3].x, w_, ac[0], ac[1], ac[2], ac[3]); \
            QUAD(Q[4 * q_].y, Q[4 * q_ + 1].y, Q[4 * q_ + 2].y, Q[4 * q_ + 3].y, w_, ac[4], ac[5], ac[6], ac[7]); \
            QUAD(Q[4 * q_].z, Q[4 * q_ + 1].z, Q[4 * q_ + 2].z, Q[4 * q_ + 3].z, w_, ac[8], ac[9], ac[10], ac[11]); \
            QUAD(Q[4 * q_].w, Q[4 * q_ + 1].w, Q[4 * q_ + 2].w, Q[4 * q_ + 3].w, w_, ac[12], ac[13], ac[14], ac[15]); } \
        float p[16]; _Pragma("unroll") for (int k = 0; k < 16; ++k) p[k] = (float)ac[k] * SWV; \
        float p8[8], p4[4], p2[2]; \
        _Pragma("unroll") for (int i_ = 0; i_ < 8; ++i_) { auto rr_ = __builtin_amdgcn_permlane32_swap(__float_as_uint(p[i_]), __float_as_uint(p[8 + i_]), false, false); p8[i_] = __uint_as_float(rr_[0]) + __uint_as_float(rr_[1]); } \
        _Pragma("unroll") for (int i_ = 0; i_ < 4; ++i_) { auto rr_ = __builtin_amdgcn_permlane16_swap(__float_as_uint(p8[i_]), __float_as_uint(p8[4 + i_]), false, false); p4[i_] = __uint_as_float(rr_[0]) + __uint_as_float(rr_[1]); } \
        HALVE(p2, p4, 2, 8); \
        const int srcl_ = ((lane & 7) << 3) | (lane >> 3);                     \
        const float q0_ = sh_f(p2[0], srcl_), q1_ = sh_f(p2[1], srcl_); \
        const size_t o_ = (size_t)ITEM_T(n) * DM + ITEM_S(n) * 128 + 2 * lane; \
        *(f32x2*)(dst + o_) = (f32x2){bf_lo(HV) + q0_, bf_hi(HV) + q1_}; } while (0)
    int4 IA[4], IB[4]; u32x4 QA[16], QB[16], WA, WB; float SA, SB_; unsigned HA, HB_;
    LD_IDX(IA, 0); LD_IDX(IB, 1);
    LD_ROWS(QA, IA, v8, 0); LD_W(WA, SA, HA, 0);
    for (int n = 0; n < N; n += 2) {
        LD_ROWS(QB, IB, v8, n + 1); LD_W(WB, SB_, HB_, n + 1);
        if (n + 2 < N) LD_IDX(IA, n + 2);
        COMPUTE_V(QA, WA, SA, HA, n);
        if (n + 2 < N) { LD_ROWS(QA, IA, v8, n + 2); LD_W(WA, SA, HA, n + 2); }
        if (n + 3 < N) LD_IDX(IB, n + 3);
        COMPUTE_V(QB, WB, SB_, HB_, n + 1);
    }
#undef LD_W
#undef QUAD
#undef COMPUTE_V
}
#undef ITEM_T
#undef ITEM_S
#undef LD_IDX
#undef LD_ROWS
#undef HALVE


constexpr int NPHASE = 11;
#define LOAD_ARGS() do { } while (0)
__global__ void __launch_bounds__(NTHREADS, 2) fwd_kernel(Args a) {
    extern __shared__ __attribute__((aligned(16))) unsigned char lds[];
#if MK_ONE_LAUNCH
    constexpr int lo = 0, hi = NPHASE;
    cg::grid_group grid = cg::this_grid();
    volatile LAS unsigned* misc = (volatile LAS unsigned*)((LAS unsigned char*)lds + MISC_OFF);
    if (threadIdx.x < 16) misc[threadIdx.x] = 0u;
    __syncthreads();
    { LOAD_ARGS(); (void)xcd_barrier_post((unsigned*)(a.ws + WS_CTL) + CW_BAR, misc + 8); }
#ifndef SEAM_CG_MASK
#define SEAM_CG_MASK 0
#endif
#define SEAM(k) do { if (lo <= (k) && (k) + 1 < hi) { if ((SEAM_CG_MASK >> (k)) & 1) grid.sync(); else { LOAD_ARGS(); XcdBarrier xb_; xb_.bar = (unsigned*)(a.ws + WS_CTL) + CW_BAR; xb_.x = xb_xcc_id(); \
        xb_.st = (volatile LAS unsigned*)((LAS unsigned char*)lds + MISC_OFF) + 8; xcd_barrier(xb_); } } } while (0)
#else
    int lo, hi; { LOAD_ARGS(); lo = a.ph_lo; hi = a.ph_hi; }
#define SEAM(k) do { } while (0)
#endif
#define IN(k) (lo <= (k) && (k) < hi)
#ifndef DUP_PHASE
#define DUP_PHASE -1
#endif
    if (IN(0)) { LOAD_ARGS(); phase0(a, lds); if (DUP_PHASE == 0) { __syncthreads(); phase0(a, lds); } SEAM(0); }
    if (IN(1)) { LOAD_ARGS(); unsigned char* ws = a.ws;
        pg8::Gemm g{(const bf16_t*)(ws + WS_XN), (const bf16_t*)(ws + WS_WIN), T, NPROJ, DM}; pg8::StaticOrder S; S.init(T, NPROJ, (int)gridDim.x, (int)blockIdx.x);
        pg8::EpiInProj E{(bf16_t*)(ws + WS_SEC), (const float*)(ws + WS_SXN), (const float*)(ws + WS_WSC), a.in[4], a.in[5], (LAS float*)((LAS unsigned char*)lds + RING_BYTES)};
        for (int rep_ = 0; rep_ < (DUP_PHASE == 1 ? 2 : 1); ++rep_)
        pg8::gemm_phase<pg8::EpiInProj, pg8::StaticOrder, true, true, true>((LAS unsigned char*)lds, g, S, E);
        cumsum_rows(a);
        { const int nwg_ = (T / 256) * (NPROJ / 256), G_ = (int)gridDim.x, rem_ = nwg_ % G_;
          if (rem_ > 0 && (int)blockIdx.x >= rem_) convert_tables(a, TAB_SPLIT, 2 * NEXP, ((int)blockIdx.x - rem_) * NWAVES + (tid_opaque() >> 6), (G_ - rem_) * NWAVES);
          else if (rem_ == 0) convert_tables(a, TAB_SPLIT, 2 * NEXP, (int)blockIdx.x * NWAVES + (tid_opaque() >> 6), G_ * NWAVES); }
        SEAM(1);
    }
    if (IN(3)) { LOAD_ARGS(); phase_attn(a, lds);
#if MK_ONE_LAUNCH
        if (DUP_PHASE == 3) { XcdBarrier xb_; xb_.bar = (unsigned*)(a.ws + WS_CTL) + CW_BAR; xb_.x = xb_xcc_id(); xb_.st = (volatile LAS unsigned*)((LAS unsigned char*)lds + MISC_OFF) + 8;
            xcd_barrier(xb_); if (blockIdx.x == 0 && threadIdx.x == 0) __hip_atomic_store((unsigned*)(a.ws + WS_CTL), 0u, __ATOMIC_RELAXED, __HIP_MEMORY_SCOPE_AGENT); xcd_barrier(xb_); phase_attn(a, lds); }
#endif
        SEAM(3); }
    if (IN(4)) { LOAD_ARGS(); phase_attn_combine(a); SEAM(4); }
    if (IN(5)) { LOAD_ARGS(); unsigned char* ws = a.ws;
        pg8::Gemm g{(const bf16_t*)(ws + WS_MIX), (const bf16_t*)(ws + WS_WOUT), T, DM, DM}; pg8::StaticOrder S; S.init(T, DM, (int)gridDim.x, (int)blockIdx.x);
        pg8::EpiOutProj E{a.in[0], a.out, (bf16_t*)(ws + WS_HB), (float*)(ws + WS_SSQ), (float*)(ws + WS_AMX)};
        for (int rep_ = 0; rep_ < (DUP_PHASE == 5 ? 2 : 1); ++rep_)
        pg8::gemm_phase<pg8::EpiOutProj, pg8::StaticOrder, true, true>((LAS unsigned char*)lds, g, S, E);
        SEAM(5);
    }
    if (IN(6)) { LOAD_ARGS(); unsigned char* ws = a.ws;
        pg8::Gemm g{(const bf16_t*)(ws + WS_HB), (const bf16_t*)(ws + WS_WPQ), T, DM, DM}; pg8::StaticOrder S; S.init(T, DM, (int)gridDim.x, (int)blockIdx.x);
        pg8::EpiPeerQFused E{(const float*)(ws + WS_SSQ), ws};
        pg8::gemm_phase<pg8::EpiPeerQFused, pg8::StaticOrder, true, true>((LAS unsigned char*)lds, g, S, E);
        SEAM(6);
    }
    if (IN(8)) { LOAD_ARGS(); for (int rep_ = 0; rep_ < (DUP_PHASE == 8 ? 2 : 1); ++rep_) phase_peer_u(a); SEAM(8); }
    if (IN(9)) { LOAD_ARGS(); for (int rep_ = 0; rep_ < (DUP_PHASE == 9 ? 2 : 1); ++rep_) phase_peer_w(a); SEAM(9); }
    if (IN(10)) { LOAD_ARGS(); for (int rep_ = 0; rep_ < (DUP_PHASE == 10 ? 2 : 1); ++rep_) phase_peer_v(a, (DUP_PHASE == 10 && rep_ == 0) ? (float*)(a.ws + WS_END) : a.out); }
#undef IN
#undef SEAM
}

extern "C" void kernel_launch(void* const* d_in, const int* in_sizes, int n_in, void* d_out, int out_size, void* d_ws, size_t ws_size, hipStream_t stream) {
    static int grid = 0;
    if (grid == 0) {
        if (n_in != 12 || in_sizes[0] != T * DM || out_size != T * DM || ws_size < WS_END) { fprintf(stderr, "kernel_launch: unexpected shapes (n_in %d, in0 %d, out %d, ws %zu)\n", n_in, n_in > 0 ? in_sizes[0] : -1, out_size, ws_size); grid = -1; return; }
        int dev = 0, cus = 0, per_cu = 0;
        if (hipGetDevice(&dev) != hipSuccess || hipDeviceGetAttribute(&cus, hipDeviceAttributeMultiprocessorCount, dev) != hipSuccess) { grid = -1; return; }
        if (hipFuncSetAttribute((const void*)fwd_kernel, hipFuncAttributeMaxDynamicSharedMemorySize, LDS_BYTES) != hipSuccess) { fprintf(stderr, "kernel_launch: hipFuncSetAttribute failed\n"); grid = -1; return; }
        if (hipOccupancyMaxActiveBlocksPerMultiprocessor(&per_cu, (const void*)fwd_kernel, NTHREADS, LDS_BYTES) != hipSuccess || per_cu < 1) { fprintf(stderr, "kernel_launch: occupancy query says %d\n", per_cu); grid = -1; return; }
        grid = cus;
    }
    if (grid < 0) return;
    (void)hipMemsetAsync((char*)d_ws + WS_CTL, 0, CTL_BYTES, stream);
    Args a{};
    for (int i = 0; i < 12; ++i) a.in[i] = (const float*)d_in[i];
    a.out = (float*)d_out; a.ws = (unsigned char*)d_ws;
#if MK_ONE_LAUNCH
    a.ph_lo = 0; a.ph_hi = NPHASE;
    void* args[] = {&a};
#if MK_COOP_LAUNCH
    hipError_t e = hipLaunchCooperativeKernel((const void*)fwd_kernel, dim3(grid), dim3(NTHREADS), args, LDS_BYTES, stream);
    if (e != hipSuccess) fprintf(stderr, "cooperative launch failed: %s (grid %d)\n", hipGetErrorString(e), grid);
#else
    (void)args; hipLaunchKernelGGL(fwd_kernel, dim3(grid), dim3(NTHREADS), LDS_BYTES, stream, a);
#endif
#else
    for (int p = 0; p < NPHASE; ++p) { a.ph_lo = p; a.ph_hi = p + 1; hipLaunchKernelGGL(fwd_kernel, dim3(grid), dim3(NTHREADS), LDS_BYTES, stream, a); }
#endif
}
```

```cpp
#include <hip/hip_runtime.h>
#include <hip/hip_cooperative_groups.h>
#include <cstdio>
#include <cstdint>
namespace cg = cooperative_groups;

#ifndef MK_COOP_LAUNCH
#define MK_COOP_LAUNCH 0
#endif
#ifndef MK_ONE_LAUNCH
#define MK_ONE_LAUNCH 1
#endif

#define LAS __attribute__((address_space(3)))
typedef unsigned short bf16_t;
typedef short bf16x8 __attribute__((ext_vector_type(8)));
typedef short s16x4 __attribute__((ext_vector_type(4)));
typedef float f32x2 __attribute__((ext_vector_type(2)));
typedef float f32x4 __attribute__((ext_vector_type(4)));
typedef float f32x16 __attribute__((ext_vector_type(16)));
typedef unsigned u32x2 __attribute__((ext_vector_type(2)));
typedef unsigned u32x4 __attribute__((ext_vector_type(4)));
typedef __bf16 bf16x2_t __attribute__((ext_vector_type(2)));

constexpr int NB = 2, SEQ = 4096, T = NB * SEQ, DM = 2048, HD = 128, NHF = 8, DIN = 7176, NPROJ = 7168;
constexpr int NEXP = 16384, NE = 128;
constexpr float EPS = 1e-6f;
constexpr float SCALE = 0.08838834764831845f, LOG2E = 1.4426950408889634f;
constexpr int NWAVES = 8, NTHREADS = 512;

constexpr size_t MiB = 1u << 20;
constexpr size_t WS_CTL = 0, CTL_BYTES = 32768;
constexpr int CW_BAR = 1024;
constexpr size_t WS_SXN = 64 * MiB  , WS_WSC = 45 * MiB + 800 * 1024  ;
constexpr int CW_WMAX = 64;
constexpr size_t WS_GQK = 45 * MiB + 768 * 1024;
constexpr size_t WS_WIN = 1 * MiB, WS_WOUT = 29 * MiB, WS_WPQ = 37 * MiB, WS_SK = 45 * MiB, WS_LOGF = 46 * MiB, WS_C = 46 * MiB + 512 * 1024, WS_SSQ = 47 * MiB;
constexpr size_t WS_XN = 48 * MiB;
constexpr size_t WS_SEC = 80 * MiB;
constexpr size_t SEC_ELEMS = 8u << 20;
constexpr size_t WS_MIX = 192 * MiB, WS_HB = 224 * MiB, WS_QP = 256 * MiB, WS_IDX = 288 * MiB, WS_GW = 292 * MiB, WS_U8 = 296 * MiB, WS_V8 = 328 * MiB, WS_SUV = 360 * MiB  , WS_RT = 360 * MiB + 256 * 1024  , WS_W = 361 * MiB  ,
                 WS_PART = 368 * MiB  , WS_XQ = 432 * MiB  , WS_END = 448 * MiB;
constexpr size_t WS_IDX16 = 366 * MiB  ;
constexpr size_t WS_AMX = 365 * MiB  , WS_SX = WS_RT + 64 * 1024  , WS_WQ = WS_W  , WS_SW = WS_W + 2 * MiB  ;
constexpr size_t WS_PO = WS_PART  , WS_PML = WS_PART + 32 * MiB  ;

constexpr int RING_BYTES = 131072;
constexpr int MISC_OFF = 143360;
constexpr int LDS_BYTES = 147456;

__device__ __forceinline__ unsigned cvt_pk_bf16(float lo, float hi) { unsigned r; asm volatile("v_cvt_pk_bf16_f32 %0, %1, %2" : "=v"(r) : "v"(lo), "v"(hi)); return r; }
__device__ __forceinline__ float bf_lo(unsigned u) { return __builtin_bit_cast(float, u << 16); }
__device__ __forceinline__ float bf_hi(unsigned u) { return __builtin_bit_cast(float, u & 0xffff0000u); }
__device__ __forceinline__ int lane_id_fresh() { int l = (int)__builtin_amdgcn_mbcnt_hi(~0u, __builtin_amdgcn_mbcnt_lo(~0u, 0u)); asm volatile("" : "+v"(l)); return l; }
__device__ __forceinline__ int sx_i(int v, int m) { return __builtin_amdgcn_ds_bpermute((lane_id_fresh() ^ m) << 2, v); }
__device__ __forceinline__ float sx_f(float v, int m) { return __int_as_float(__builtin_amdgcn_ds_bpermute((lane_id_fresh() ^ m) << 2, __float_as_int(v))); }
__device__ __forceinline__ int sh_i(int v, int src) { return __builtin_amdgcn_ds_bpermute(src << 2, v); }
__device__ __forceinline__ float sh_f(float v, int src) { return __int_as_float(__builtin_amdgcn_ds_bpermute(src << 2, __float_as_int(v))); }
__device__ __forceinline__ float shup_f(float v, int d) { const int l = lane_id_fresh(); const int s = l - d; return __int_as_float(__builtin_amdgcn_ds_bpermute((s < 0 ? l : s) << 2, __float_as_int(v))); }
__device__ __forceinline__ float wave_sum(float v) {
    v += __int_as_float(__builtin_amdgcn_update_dpp(0, __float_as_int(v), 0xB1, 0xf, 0xf, true));
    v += __int_as_float(__builtin_amdgcn_update_dpp(0, __float_as_int(v), 0x4E, 0xf, 0xf, true));
    v += __int_as_float(__builtin_amdgcn_update_dpp(0, __float_as_int(v), 0x141, 0xf, 0xf, true));
    v += __int_as_float(__builtin_amdgcn_update_dpp(0, __float_as_int(v), 0x140, 0xf, 0xf, true));
    { auto rr = __builtin_amdgcn_permlane16_swap(__float_as_uint(v), __float_as_uint(v), false, false); v = __uint_as_float(rr[0]) + __uint_as_float(rr[1]); }
    { auto rr = __builtin_amdgcn_permlane32_swap(__float_as_uint(v), __float_as_uint(v), false, false); v = __uint_as_float(rr[0]) + __uint_as_float(rr[1]); }
    return v;
}
#define DPP_QX1 0xB1
#define DPP_QX2 0x4E
#define DPP_HMIR 0x141
#define DPP_MIR 0x140
__device__ __forceinline__ float wave_max(float v) {
    v = fmaxf(v, __int_as_float(__builtin_amdgcn_update_dpp(0, __float_as_int(v), DPP_QX1, 0xf, 0xf, true)));
    v = fmaxf(v, __int_as_float(__builtin_amdgcn_update_dpp(0, __float_as_int(v), DPP_QX2, 0xf, 0xf, true)));
    v = fmaxf(v, __int_as_float(__builtin_amdgcn_update_dpp(0, __float_as_int(v), DPP_HMIR, 0xf, 0xf, true)));
    v = fmaxf(v, __int_as_float(__builtin_amdgcn_update_dpp(0, __float_as_int(v), DPP_MIR, 0xf, 0xf, true)));
    { auto rr = __builtin_amdgcn_permlane16_swap(__float_as_uint(v), __float_as_uint(v), false, false); v = fmaxf(__uint_as_float(rr[0]), __uint_as_float(rr[1])); }
    { auto rr = __builtin_amdgcn_permlane32_swap(__float_as_uint(v), __float_as_uint(v), false, false); v = fmaxf(__uint_as_float(rr[0]), __uint_as_float(rr[1])); }
    return v;
}
__device__ __forceinline__ int tid_opaque() { int t = (int)threadIdx.x; asm volatile("" : "+v"(t)); return t; }
#define LDS_WAIT() asm volatile("s_waitcnt lgkmcnt(0)" ::: "memory")

namespace pg8 {
#define PG8_LAS __attribute__((address_space(3)))
constexpr int BM = 256, BK = 64, HALF = 128, HTB = HALF * BK * 2, STAGE_BYTES = 8 * HTB, NXCD = 8, WGM = 8;
__host__ __device__ __forceinline__ int lds_byte(int r, int c) { const int st = (r >> 4) * 2 + (c >> 5), rr = r & 15, cc = c & 31, ob = rr * 64 + cc * 2; return st * 1024 + (ob ^ (((ob >> 9) & 1) << 5)); }
__host__ __device__ __forceinline__ void stage_rc(int b, int& R, int& C) { const int st = b / 1024, sb = b % 1024, swz = sb ^ (((sb >> 9) & 1) << 5); R = (st >> 1) * 16 + swz / 64; C = (st & 1) * 32 + (swz % 64) / 2; }
__host__ __device__ __forceinline__ int perm32(int rho) { const int n = rho >> 4, i = rho & 15; return 8 * (i >> 2) + 4 * n + (i & 3); }
struct Unit { int pm, pn; };
struct Gemm { const bf16_t* A; const bf16_t* Bt; int M, N, K; };
struct StaticOrder {
    int nM, nN, nwg, G, c;
    __host__ __device__ void init(int M, int N, int G_, int c_) { nM = M / BM; nN = N / BM; nwg = nM * nN; G = G_; c = c_; }
    __host__ __device__ bool next(int i, Unit& u) const {
        const long L = (long)i * G + c; if (L >= nwg) return false;
        int wgid = (int)L; { const int q = nwg / NXCD, r = nwg % NXCD, xcd = wgid % NXCD, off = wgid / NXCD; wgid = (xcd < r ? xcd * (q + 1) : r * (q + 1) + (xcd - r) * q) + off; }
        const int nig = WGM * nN, gid = wgid / nig, fm = gid * WGM, gsz = (nM - fm) < WGM ? (nM - fm) : WGM;
        u.pm = fm + ((wgid % nig) % gsz); u.pn = (wgid % nig) / gsz; return true;
    }
    __device__ __forceinline__ void a_ready(const Unit&) const {}
    __device__ __forceinline__ void done(const Unit&) const {}
};

typedef int i32x4 __attribute__((ext_vector_type(4)));
template <bool I8> struct AccT { typedef f32x4 type; };
template <> struct AccT<true> { typedef i32x4 type; };
template <class Epi, class Sched, bool ALIGN_EPI = false, bool SP2 = false, bool I8 = false>
__device__ __forceinline__ void gemm_phase(PG8_LAS unsigned char* lds, const Gemm g, const Sched& S, const Epi& E) {
    typedef typename AccT<I8>::type acc_t;
    const int tid = tid_opaque(), wid = __builtin_amdgcn_readfirstlane(tid >> 6), lane = tid & 63, wr = wid >> 2, wc = wid & 3, fr = lane & 15, fq = lane >> 4;
    const int rowb = I8 ? g.K : 2 * g.K, nt = rowb / (BK * 2);
    unsigned voffA[2], voffB[2];
#pragma unroll
    for (int i = 0; i < 2; ++i) { int R, C; stage_rc(tid * 16 + i * 8192, R, C); const int Rb = Epi::PERM ? ((R & ~31) + perm32(R & 31)) : R;
        voffA[i] = (unsigned)(R * rowb + C * 2); voffB[i] = (unsigned)(Rb * rowb + C * 2); }
    const size_t kstep = (size_t)(BK * 2);
    const size_t hstep = (size_t)HALF * rowb;
    const size_t tstep = 2 * hstep;
    const unsigned ldsw = (unsigned)wid * 1024u;
    const int aoff = lds_byte(wr * 64 + fr, fq * 8), boff = lds_byte(wc * 32 + fr, fq * 8);
#define PG8_SA(b, h) (((b) * 2 + (h)) * HTB)
#define PG8_SB(b, h) ((4 + (b) * 2 + (h)) * HTB)
#define PG8_STAGE(bufoff, gbase, voff) do { _Pragma("unroll") for (int _i = 0; _i < 2; ++_i) \
        __builtin_amdgcn_global_load_lds((const unsigned*)((const char*)(gbase) + (voff)[_i]), (PG8_LAS unsigned*)(lds + (bufoff) + ldsw + _i * 8192), 16, 0, 0); } while (0)
#define PG8_LDA(dst, b, h) do { _Pragma("unroll") for (int m = 0; m < 4; ++m) _Pragma("unroll") for (int k = 0; k < 2; ++k) dst[m][k] = *(const PG8_LAS bf16x8*)(lds + PG8_SA(b, h) + aoff + m * 2048 + k * 1024); } while (0)
#define PG8_LDB(dst, b, h) do { _Pragma("unroll") for (int n = 0; n < 2; ++n) _Pragma("unroll") for (int k = 0; k < 2; ++k) dst[n][k] = *(const PG8_LAS bf16x8*)(lds + PG8_SB(b, h) + boff + n * 2048 + k * 1024); } while (0)
#define PG8_MMA(ai, bj, At, Bt) do { __builtin_amdgcn_s_setprio(1); _Pragma("unroll") for (int m = 0; m < 4; ++m) _Pragma("unroll") for (int n = 0; n < 2; ++n) _Pragma("unroll") for (int k = 0; k < 2; ++k) \
        { if constexpr (I8) acc[ai][bj][m][n] = __builtin_amdgcn_mfma_i32_16x16x64_i8(__builtin_bit_cast(i32x4, Bt[n][k]), __builtin_bit_cast(i32x4, At[m][k]), acc[ai][bj][m][n], 0, 0, 0); \
          else acc[ai][bj][m][n] = __builtin_amdgcn_mfma_f32_16x16x32_bf16(Bt[n][k], At[m][k], acc[ai][bj][m][n], 0, 0, 0); } __builtin_amdgcn_s_setprio(0); } while (0)
#define PG8_WAIT_V(n) asm volatile("s_waitcnt vmcnt(" #n ")" ::: "memory")
#define PG8_WAIT_L(n) asm volatile("s_waitcnt lgkmcnt(" #n ")" ::: "memory")
#define PG8_BAR __builtin_amdgcn_s_barrier()
#define PG8_SCHED __builtin_amdgcn_sched_barrier(0)
    Unit cur, nxt; int ui = 0;
    if (!S.next(0, cur)) return;
    acc_t acc[2][2][4][2];
#pragma unroll
    for (int a = 0; a < 2; ++a)
#pragma unroll
        for (int b = 0; b < 2; ++b)
#pragma unroll
            for (int m = 0; m < 4; ++m)
#pragma unroll
                for (int n = 0; n < 2; ++n) acc[a][b][m][n] = acc_t{};
    bf16x8 At[4][2], B0[2][2], B1[2][2];
    const char* cA = (const char*)g.A + (size_t)cur.pm * tstep; const char* cB = (const char*)g.Bt + (size_t)cur.pn * tstep;
    S.a_ready(cur);
    if constexpr (SP2) {
        PG8_STAGE(PG8_SB(0, 0), cB, voffB); PG8_STAGE(PG8_SB(0, 1), cB + hstep, voffB); PG8_STAGE(PG8_SA(0, 0), cA, voffA); PG8_STAGE(PG8_SA(0, 1), cA + hstep, voffA);
        if (wr == 1) PG8_BAR;
        PG8_WAIT_V(2); PG8_BAR;
        PG8_STAGE(PG8_SB(1, 0), cB + kstep, voffB); PG8_STAGE(PG8_SA(1, 0), cA + kstep, voffA); PG8_STAGE(PG8_SB(1, 1), cB + hstep + kstep, voffB);
        PG8_WAIT_V(6); PG8_BAR;
    } else {
        PG8_STAGE(PG8_SB(0, 0), cB, voffB); PG8_STAGE(PG8_SA(0, 0), cA, voffA); PG8_STAGE(PG8_SB(0, 1), cB + hstep, voffB); PG8_STAGE(PG8_SA(0, 1), cA + hstep, voffA);
        if (wr == 1) PG8_BAR;
        PG8_WAIT_V(4); PG8_BAR;
        PG8_STAGE(PG8_SB(1, 0), cB + kstep, voffB); PG8_STAGE(PG8_SA(1, 0), cA + kstep, voffA); PG8_STAGE(PG8_SB(1, 1), cB + hstep + kstep, voffB);
        PG8_WAIT_V(6); PG8_BAR;
    }
    for (;;) {
        const bool has_next = S.next(ui + 1, nxt);
        const char* nA = has_next ? (const char*)g.A + (size_t)nxt.pm * tstep : cA; const char* nB = has_next ? (const char*)g.Bt + (size_t)nxt.pn * tstep : cB;
        for (int t = 0; t < nt; t += 2) {
            const bool last = (t == nt - 2);
            const char* a1 = cA + (size_t)(t + 1) * kstep;
            const char* a2 = last ? nA : cA + (size_t)(t + 2) * kstep; const char* b2 = last ? nB : cB + (size_t)(t + 2) * kstep;
            const char* a3 = a2 + kstep; const char* b3 = b2 + kstep;
            if (last && has_next) S.a_ready(nxt);
            if constexpr (SP2) {
            PG8_LDB(B0, 0, 0); PG8_LDB(B1, 0, 1); PG8_SCHED; PG8_LDA(At, 0, 0); PG8_STAGE(PG8_SA(1, 1), a1 + hstep, voffA);
            PG8_WAIT_V(8); PG8_WAIT_L(0); PG8_BAR; PG8_MMA(0, 0, At, B0); PG8_MMA(0, 1, At, B1); PG8_BAR; PG8_SCHED;
            PG8_LDA(At, 0, 1); PG8_STAGE(PG8_SB(0, 0), b2, voffB); PG8_STAGE(PG8_SB(0, 1), b2 + hstep, voffB); PG8_STAGE(PG8_SA(0, 0), a2, voffA);
            PG8_WAIT_V(8); PG8_WAIT_L(0); PG8_BAR; PG8_MMA(1, 0, At, B0); PG8_MMA(1, 1, At, B1); PG8_BAR; PG8_SCHED;
            PG8_LDB(B0, 1, 0); PG8_LDB(B1, 1, 1); PG8_SCHED; PG8_LDA(At, 1, 0); PG8_STAGE(PG8_SA(0, 1), a2 + hstep, voffA);
            PG8_WAIT_V(8); PG8_WAIT_L(0); PG8_BAR; PG8_MMA(0, 0, At, B0); PG8_MMA(0, 1, At, B1); PG8_BAR; PG8_SCHED;
            PG8_LDA(At, 1, 1); PG8_STAGE(PG8_SB(1, 0), b3, voffB); PG8_STAGE(PG8_SB(1, 1), b3 + hstep, voffB); PG8_STAGE(PG8_SA(1, 0), a3, voffA);
            PG8_WAIT_V(8); PG8_WAIT_L(0); PG8_BAR; PG8_MMA(1, 0, At, B0); PG8_MMA(1, 1, At, B1); PG8_BAR; PG8_SCHED;
            } else {
            PG8_LDB(B0, 0, 0); PG8_SCHED; PG8_LDA(At, 0, 0); PG8_STAGE(PG8_SA(1, 1), a1 + hstep, voffA);
            PG8_WAIT_L(8); PG8_BAR; PG8_WAIT_L(0); PG8_MMA(0, 0, At, B0); PG8_BAR; PG8_SCHED;
            PG8_LDB(B1, 0, 1); PG8_STAGE(PG8_SB(0, 0), b2, voffB);
            PG8_BAR; PG8_WAIT_L(0); PG8_MMA(0, 1, At, B1); PG8_BAR;
            PG8_LDA(At, 0, 1); PG8_STAGE(PG8_SA(0, 0), a2, voffA);
            PG8_BAR; PG8_WAIT_L(0); PG8_MMA(1, 0, At, B0); PG8_BAR; PG8_SCHED;
            PG8_STAGE(PG8_SB(0, 1), b2 + hstep, voffB);
            PG8_WAIT_V(6); PG8_BAR; PG8_MMA(1, 1, At, B1); PG8_BAR;
            PG8_LDB(B0, 1, 0); PG8_SCHED; PG8_LDA(At, 1, 0); PG8_STAGE(PG8_SA(0, 1), a2 + hstep, voffA);
            PG8_WAIT_L(8); PG8_BAR; PG8_WAIT_L(0); PG8_MMA(0, 0, At, B0); PG8_BAR; PG8_SCHED;
            PG8_LDB(B1, 1, 1); PG8_STAGE(PG8_SB(1, 0), b3, voffB);
            PG8_BAR; PG8_WAIT_L(0); PG8_MMA(0, 1, At, B1); PG8_BAR;
            PG8_LDA(At, 1, 1); PG8_STAGE(PG8_SA(1, 0), a3, voffA);
            PG8_BAR; PG8_WAIT_L(0); PG8_MMA(1, 0, At, B0); PG8_BAR; PG8_SCHED;
            PG8_STAGE(PG8_SB(1, 1), b3 + hstep, voffB);
            PG8_WAIT_V(6); PG8_BAR; PG8_MMA(1, 1, At, B1); PG8_BAR;
            }
        }
        if constexpr (ALIGN_EPI) { if (wr == 0) PG8_BAR; }
        if constexpr (!Epi::AFTER_DRAIN) { E(acc, cur, wr, wc, fr, fq); } S.done(cur);
        if (!has_next) break;
#pragma unroll
        for (int a = 0; a < 2; ++a)
#pragma unroll
            for (int b = 0; b < 2; ++b)
#pragma unroll
                for (int m = 0; m < 4; ++m)
#pragma unroll
                    for (int n = 0; n < 2; ++n) acc[a][b][m][n] = acc_t{};
        cur = nxt; cA = nA; cB = nB; ++ui;
        if constexpr (ALIGN_EPI) { if (wr == 1) PG8_BAR; }
    }
    PG8_WAIT_V(0);
    if constexpr (!ALIGN_EPI) { if (wr == 0) PG8_BAR; }
    PG8_BAR;
    if constexpr (Epi::AFTER_DRAIN) E.fused(acc, cur, wr, wc, fr, fq, lds);
#undef PG8_SA
#undef PG8_SB
#undef PG8_STAGE
#undef PG8_LDA
#undef PG8_LDB
#undef PG8_MMA
#undef PG8_WAIT_V
#undef PG8_WAIT_L
#undef PG8_BAR
#undef PG8_SCHED
}

__device__ __forceinline__ float sigmoidf_fast(float x) { return __builtin_amdgcn_rcpf(1.f + __builtin_amdgcn_exp2f(-x * LOG2E)); }
struct EpiInProj {
    static constexpr bool PERM = true, AFTER_DRAIN = false;
    bf16_t* base; const float* sxn  ; const float* wsc  ;
    const float* gq; const float* gk; PG8_LAS float* xch  ;
    __device__ __forceinline__ void operator()(const i32x4 (&acci)[2][2][4][2], const Unit& u, int wr, int wc, int fr, int fq) const {
        const int sec = u.pn >> 2; const float wsv = *wsc;
        bf16_t* sb = base + (size_t)sec * SEC_ELEMS;
        const float sc = (sec == 4) ? SCALE * LOG2E : 1.f;
        if (sec < 2) {
#pragma unroll
            for (int ai = 0; ai < 2; ++ai)
#pragma unroll
                for (int m = 0; m < 4; ++m) {
                    const int tk = u.pm * BM + ai * HALF + wr * 64 + m * 16 + fr;
                    const float rs = sxn[tk] * wsv;
#pragma unroll
                    for (int bj = 0; bj < 2; ++bj) {
                        const f32x4 v0 = __builtin_convertvector(acci[ai][bj][m][0], f32x4) * rs, v1 = __builtin_convertvector(acci[ai][bj][m][1], f32x4) * rs;
                        float ss = v0[0] * v0[0] + v0[1] * v0[1] + v0[2] * v0[2] + v0[3] * v0[3] + v1[0] * v1[0] + v1[1] * v1[1] + v1[2] * v1[2] + v1[3] * v1[3];
                        ss += sx_f(ss, 16); ss += sx_f(ss, 32);
                        if (fq == 0) xch[(((((wr * 2 + ai) * 4 + m) * 16 + fr) * 2 + bj) * 4) + wc] = ss;
                    }
                }
            asm volatile("s_waitcnt lgkmcnt(0)" ::: "memory");
            __builtin_amdgcn_s_barrier();
            const float* gp = (sec == 0 ? gq : gk) + wc * 32 + 8 * fq;
            const f32x4 g0 = *(const f32x4*)gp, g1 = *(const f32x4*)(gp + 4);
#pragma unroll
            for (int ai = 0; ai < 2; ++ai)
#pragma unroll
                for (int m = 0; m < 4; ++m) {
                    const int tk = u.pm * BM + ai * HALF + wr * 64 + m * 16 + fr, b = tk >> 12, s = tk & 4095;
                    const float rs = sxn[tk] * wsv;
#pragma unroll
                    for (int bj = 0; bj < 2; ++bj) {
                        const int hh = (u.pn & 3) * 2 + bj;
                        const f32x4 p4 = *(const PG8_LAS f32x4*)(xch + (((((wr * 2 + ai) * 4 + m) * 16 + fr) * 2 + bj) * 4));
                        const float r = rs / sqrtf(((p4[0] + p4[1]) + (p4[2] + p4[3])) * (1.f / 128.f) + EPS);
                        const f32x4 v0 = __builtin_convertvector(acci[ai][bj][m][0], f32x4) * r * g0, v1 = __builtin_convertvector(acci[ai][bj][m][1], f32x4) * r * g1;
                        u32x4 w; w.x = cvt_pk_bf16(v0[0], v0[1]); w.y = cvt_pk_bf16(v0[2], v0[3]); w.z = cvt_pk_bf16(v1[0], v1[1]); w.w = cvt_pk_bf16(v1[2], v1[3]);
                        *(u32x4*)(sb + ((size_t)((b * 8 + hh) * 4096 + s)) * 128 + wc * 32 + 8 * fq) = w;
                    }
                }
            return;
        }
#pragma unroll
        for (int ai = 0; ai < 2; ++ai)
#pragma unroll
            for (int m = 0; m < 4; ++m) {
                const int tk = u.pm * BM + ai * HALF + wr * 64 + m * 16 + fr, b = tk >> 12, s = tk & 4095;
                const float rs = sxn[tk] * wsv;
#pragma unroll
                for (int bj = 0; bj < 2; ++bj) {
                    const int hh = (u.pn & 3) * 2 + bj;
                    f32x4 v0 = __builtin_convertvector(acci[ai][bj][m][0], f32x4) * rs, v1 = __builtin_convertvector(acci[ai][bj][m][1], f32x4) * rs;
                    bf16_t* dst;
                    if (sec == 3) {
#pragma unroll
                        for (int i = 0; i < 4; ++i) { v0[i] = sigmoidf_fast(v0[i]); v1[i] = sigmoidf_fast(v1[i]); }
                        dst = sb + (size_t)tk * 1024 + hh * 128 + wc * 32 + 8 * fq;
                    } else {
                        v0 = v0 * sc; v1 = v1 * sc;
                        dst = sb + ((size_t)((b * 8 + hh) * 4096 + s)) * 128 + wc * 32 + 8 * fq;
                    }
                    u32x4 w; w.x = cvt_pk_bf16(v0[0], v0[1]); w.y = cvt_pk_bf16(v0[2], v0[3]); w.z = cvt_pk_bf16(v1[0], v1[1]); w.w = cvt_pk_bf16(v1[2], v1[3]);
                    *(u32x4*)dst = w;
                }
            }
    }
};
struct EpiOutProj {
    static constexpr bool PERM = true, AFTER_DRAIN = false;
    const float* x; float* h; bf16_t* hb; float* ssq; float* amx;
    __device__ __forceinline__ void operator()(const f32x4 (&acc)[2][2][4][2], const Unit& u, int wr, int wc, int fr, int fq) const {
#pragma unroll
        for (int ai = 0; ai < 2; ++ai)
#pragma unroll
            for (int m = 0; m < 4; ++m) {
                const int tk = u.pm * BM + ai * HALF + wr * 64 + m * 16 + fr;
                float ss = 0.f, mx = 0.f;
#pragma unroll
                for (int bj = 0; bj < 2; ++bj) {
                    const size_t off = (size_t)tk * DM + u.pn * BM + bj * HALF + wc * 32 + 8 * fq;
                    const f32x4 x0 = *(const f32x4*)(x + off), x1 = *(const f32x4*)(x + off + 4);
                    const f32x4 v0 = acc[ai][bj][m][0] + x0, v1 = acc[ai][bj][m][1] + x1;
                    u32x4 w; w.x = cvt_pk_bf16(v0[0], v0[1]); w.y = cvt_pk_bf16(v0[2], v0[3]); w.z = cvt_pk_bf16(v1[0], v1[1]); w.w = cvt_pk_bf16(v1[2], v1[3]);
                    *(u32x4*)(hb + off) = w;
                    ss += v0[0] * v0[0] + v0[1] * v0[1] + v0[2] * v0[2] + v0[3] * v0[3] + v1[0] * v1[0] + v1[1] * v1[1] + v1[2] * v1[2] + v1[3] * v1[3];
                    mx = fmaxf(mx, fmaxf(fmaxf(fmaxf(fabsf(v0[0]), fabsf(v0[1])), fmaxf(fabsf(v0[2]), fabsf(v0[3]))), fmaxf(fmaxf(fabsf(v1[0]), fabsf(v1[1])), fmaxf(fabsf(v1[2]), fabsf(v1[3])))));
                }
                ss += sx_f(ss, 16); ss += sx_f(ss, 32);
                mx = fmaxf(mx, sx_f(mx, 16)); mx = fmaxf(mx, sx_f(mx, 32));
                if (fq == 0) { ssq[(size_t)tk * 32 + u.pn * 4 + wc] = ss; amx[(size_t)tk * 32 + u.pn * 4 + wc] = mx; }
            }
    }
};
struct EpiPeerQ {
    static constexpr bool PERM = true, AFTER_DRAIN = false;
    const float* ssq; bf16_t* qp; float* rtab;
    __device__ __forceinline__ void operator()(const f32x4 (&acc)[2][2][4][2], const Unit& u, int wr, int wc, int fr, int fq) const {
#pragma unroll
        for (int ai = 0; ai < 2; ++ai)
#pragma unroll
            for (int m = 0; m < 4; ++m) {
                const int tk = u.pm * BM + ai * HALF + wr * 64 + m * 16 + fr;
                float tot = 0.f;
#pragma unroll
                for (int i = 0; i < 8; ++i) { const f32x4 s4 = *(const f32x4*)(ssq + (size_t)tk * 32 + 4 * i); tot += (s4[0] + s4[1]) + (s4[2] + s4[3]); }
                const float r = 1.0f / sqrtf(tot * (1.f / DM) + EPS);
                if (u.pn == 0 && wc == 0 && fq == 0) rtab[tk] = r;
#pragma unroll
                for (int bj = 0; bj < 2; ++bj) {
                    const size_t off = (size_t)tk * DM + u.pn * BM + bj * HALF + wc * 32 + 8 * fq;
                    const f32x4 v0 = acc[ai][bj][m][0] * r, v1 = acc[ai][bj][m][1] * r;
                    u32x4 w; w.x = cvt_pk_bf16(v0[0], v0[1]); w.y = cvt_pk_bf16(v0[2], v0[3]); w.z = cvt_pk_bf16(v1[0], v1[1]); w.w = cvt_pk_bf16(v1[2], v1[3]);
                    *(u32x4*)(qp + off) = w;
                }
            }
    }
};
struct EpiPeerQFused {
    static constexpr bool PERM = true, AFTER_DRAIN = true;
    const float* ssq; unsigned char* wsb;
    __device__ __forceinline__ void operator()(const f32x4 (&)[2][2][4][2], const Unit&, int, int, int, int) const {}
    __device__ __forceinline__ void fused(const f32x4 (&acc)[2][2][4][2], const Unit& u, int wr, int wc, int fr, int fq, PG8_LAS unsigned char* lds) const;
};
}

namespace att {
constexpr int NW = 8, QBLK = 32, KVBLK = 64, QB = NW * QBLK, D = 128;
constexpr int SHM_V = KVBLK * D * 2, SHM_K = KVBLK * D * 2;
constexpr int OFF_WS = 2 * SHM_V + 2 * SHM_K, OFF_BIAS = OFF_WS + NW * 64 * 4, ATT_LDS = OFF_BIAS + SEQ * 4;
#define KSWZ(row, colB) ((row) * 256 + ((colB) ^ (((row) & 7) << 4)))
#define SBAR() __builtin_amdgcn_sched_barrier(0)
__device__ __forceinline__ int v_st(int k, int c) { const int kk = (k & ~0xC) | ((k & 4) << 1) | ((k & 8) >> 1); return ((kk >> 3) * 4 + (c >> 5)) * 512 + ((kk & 7) * 32 + (c & 31)) * 2; }
__device__ __forceinline__ int v_rd_base(int lane) { return ((lane & 3) << 3) | (((lane >> 2) & 3) << 6) | (((lane >> 4) & 1) << 5) | (((lane >> 5) & 1) << 8); }
constexpr int v_rd_off(int d0, int ks, int half) { return d0 * 512 + ks * 4096 + half * 2048; }
__device__ __forceinline__ int crow(int r, int hi) { return (r & 3) + 8 * (r >> 2) + 4 * hi; }
__device__ __forceinline__ bf16x8 load8(const bf16_t* p) { return *reinterpret_cast<const bf16x8*>(p); }
__device__ __forceinline__ void mask_tile(f32x16& p0, f32x16& p1, int dq) {
    const float NEG = -__builtin_inff();
#pragma unroll
    for (int r = 0; r < 16; ++r) {
        const int c = (r & 3) + 8 * (r >> 2);
        if (dq - c < 0) p0[r] = NEG;
        if (dq - c - 32 < 0) p1[r] = NEG;
    }
}
__device__ __forceinline__ void partialSM(f32x16& p0, f32x16& p1, float& m_reg, float& mn, float& alpha) {
    float pmax = p0[0];
#pragma unroll
    for (int r = 1; r < 16; ++r) pmax = fmaxf(pmax, p0[r]);
#pragma unroll
    for (int r = 0; r < 16; ++r) pmax = fmaxf(pmax, p1[r]);
    { auto rr = __builtin_amdgcn_permlane32_swap(__float_as_uint(pmax), __float_as_uint(pmax), false, false);
      pmax = fmaxf(__uint_as_float(rr[0]), __uint_as_float(rr[1])); }
    constexpr float C2 = LOG2E * SCALE; constexpr float THR = 8.f;
    if (__builtin_expect(__all((pmax - m_reg) * SCALE <= THR), 1)) { mn = m_reg; alpha = 1.f; }
    else { mn = fmaxf(m_reg, pmax); alpha = __builtin_amdgcn_exp2f((m_reg - mn) * C2); m_reg = mn; }
    const float mnL = -mn * C2;
#pragma unroll
    for (int r = 0; r < 16; ++r) p0[r] = fmaf(p0[r], C2, mnL);
#pragma unroll
    for (int r = 0; r < 16; ++r) p1[r] = fmaf(p1[r], C2, mnL);
#pragma unroll
    for (int r = 0; r < 16; ++r) p0[r] = __builtin_amdgcn_exp2f(p0[r]);
}
#define PK4(P, B_, OUT) do { unsigned a0 = cvt_pk_bf16(P[B_+0], P[B_+1]), a1 = cvt_pk_bf16(P[B_+2], P[B_+3]);                          \
        unsigned b0 = cvt_pk_bf16(P[B_+4], P[B_+5]), b1 = cvt_pk_bf16(P[B_+6], P[B_+7]);                                             \
        auto r0 = __builtin_amdgcn_permlane32_swap(a0, b0, false, false); auto r1 = __builtin_amdgcn_permlane32_swap(a1, b1, false, false); \
        u32x4 w = {r0[0], r1[0], r0[1], r1[1]}; OUT = *reinterpret_cast<bf16x8*>(&w); } while (0)
__device__ __forceinline__ void finishSM(f32x16& p0, f32x16& p1, float alpha, float& l_reg, bf16x8& pa0, bf16x8& pa1, bf16x8& pa2, bf16x8& pa3) {
#pragma unroll
    for (int r = 0; r < 16; ++r) p1[r] = __builtin_amdgcn_exp2f(p1[r]);
    float ps = 0;
#pragma unroll
    for (int r = 0; r < 16; ++r) ps += p0[r];
#pragma unroll
    for (int r = 0; r < 16; ++r) ps += p1[r];
    { auto rr = __builtin_amdgcn_permlane32_swap(__float_as_uint(ps), __float_as_uint(ps), false, false);
      ps = __uint_as_float(rr[0]) + __uint_as_float(rr[1]); }
    l_reg = l_reg * alpha + ps;
    PK4(p0, 0, pa0); PK4(p0, 8, pa1); PK4(p1, 0, pa2); PK4(p1, 8, pa3);
}
__device__ __forceinline__ void sb_group(f32x16& P, int g, float& gs) {
    float run = 0.f;
#pragma unroll
    for (int k = 3; k >= 0; --k) {
        const float z = P[4 * g + k];
        const float t = __builtin_amdgcn_exp2f(-fabsf(z));
        const float l = __builtin_amdgcn_logf(1.f + t);
        const float sp = fmaxf(z, 0.f) + l;
        P[4 * g + k] = (z - sp) - run;
        run += sp;
    }
    gs = run;
}
__device__ __forceinline__ void sb_part1(f32x16& p0, f32x16& p1, float& carry, float mlo) {
    float gs[8];
#pragma unroll
    for (int g = 0; g < 4; ++g) sb_group(p0, g, gs[g]);
#pragma unroll
    for (int g = 0; g < 4; ++g) sb_group(p1, g, gs[4 + g]);
    float run = carry;
#pragma unroll
    for (int G = 7; G >= 0; --G) {
        auto rr = __builtin_amdgcn_permlane32_swap(__float_as_uint(gs[G]), __float_as_uint(gs[G]), false, false);
        const float slo = __uint_as_float(rr[0]), shi = __uint_as_float(rr[1]);
        const float base = fmaf(mlo, shi, run);
        if (G >= 4) {
#pragma unroll
            for (int k = 0; k < 4; ++k) p1[4 * (G - 4) + k] -= base;
        } else {
#pragma unroll
            for (int k = 0; k < 4; ++k) p0[4 * G + k] -= base;
        }
        run += slo + shi;
    }
    carry = run;
#pragma unroll
    for (int r = 0; r < 16; ++r) p0[r] = __builtin_amdgcn_exp2f(p0[r]);
}
__device__ __forceinline__ void sb_part2(f32x16& p0, f32x16& p1, bf16x8& pa0, bf16x8& pa1, bf16x8& pa2, bf16x8& pa3) {
#pragma unroll
    for (int r = 0; r < 16; ++r) p1[r] = __builtin_amdgcn_exp2f(p1[r]);
    PK4(p0, 0, pa0); PK4(p0, 8, pa1); PK4(p1, 0, pa2); PK4(p1, 8, pa3);
}
#undef PK4
template <int KB, bool BIAS>
__device__ __forceinline__ void qkt(f32x16& p0, f32x16& p1, const char* K_lds, int r32, int hi, const bf16x8* qr, const float* bt) {
    if constexpr (BIAS) {
#pragma unroll
        for (int g = 0; g < 4; ++g) { const f32x4 a = *(const f32x4*)(bt + 8 * g), b = *(const f32x4*)(bt + 32 + 8 * g);
            p0[4 * g] = a[0]; p0[4 * g + 1] = a[1]; p0[4 * g + 2] = a[2]; p0[4 * g + 3] = a[3];
            p1[4 * g] = b[0]; p1[4 * g + 1] = b[1]; p1[4 * g + 2] = b[2]; p1[4 * g + 3] = b[3]; }
    } else { p0 = f32x16{}; p1 = f32x16{}; }
    const char* kb[4];
#pragma unroll
    for (int dd = 0; dd < 4; ++dd) kb[dd] = K_lds + KB * SHM_K + KSWZ(r32, (dd * 16 + hi * 8) * 2);
#pragma unroll
    for (int d0 = 0; d0 < 8; ++d0) { const char* a = kb[d0 & 3] + (d0 >> 2) * 128;
        bf16x8 b0 = *reinterpret_cast<const bf16x8*>(a);
        bf16x8 b1 = *reinterpret_cast<const bf16x8*>(a + 32 * 256);
        p0 = __builtin_amdgcn_mfma_f32_32x32x16_bf16(b0, qr[d0], p0, 0, 0, 0);
        p1 = __builtin_amdgcn_mfma_f32_32x32x16_bf16(b1, qr[d0], p1, 0, 0, 0); }
}
template <int VB>
__device__ __forceinline__ void pv_tile(f32x16* o, int vb0, bf16x8 pa0, bf16x8 pa1, bf16x8 pa2, bf16x8 pa3) {
#define TRRD(dst, off) asm volatile("ds_read_b64_tr_b16 %0, %1 offset:%2" : "=&v"(dst) : "v"(vb0), "i"(off) : "memory")
#define PV_D0(d0) do { { s16x4 l0, l1, h0, h1; constexpr int b_ = VB * SHM_V + v_rd_off(d0, 0, 0); \
        TRRD(l0, b_); TRRD(h0, b_ + 2048); TRRD(l1, b_ + 4096); TRRD(h1, b_ + 6144); \
        asm volatile("s_waitcnt lgkmcnt(0)" ::: "memory"); SBAR();   \
        o[d0] = __builtin_amdgcn_mfma_f32_32x32x16_bf16(pa0, (bf16x8){l0[0], l0[1], l0[2], l0[3], h0[0], h0[1], h0[2], h0[3]}, o[d0], 0, 0, 0);   \
        o[d0] = __builtin_amdgcn_mfma_f32_32x32x16_bf16(pa1, (bf16x8){l1[0], l1[1], l1[2], l1[3], h1[0], h1[1], h1[2], h1[3]}, o[d0], 0, 0, 0); }  \
      { s16x4 l2, l3, h2, h3; constexpr int b_ = VB * SHM_V + v_rd_off(d0, 0, 0); \
        TRRD(l2, b_ + 8192); TRRD(h2, b_ + 10240); TRRD(l3, b_ + 12288); TRRD(h3, b_ + 14336); \
        asm volatile("s_waitcnt lgkmcnt(0)" ::: "memory"); SBAR();   \
        o[d0] = __builtin_amdgcn_mfma_f32_32x32x16_bf16(pa2, (bf16x8){l2[0], l2[1], l2[2], l2[3], h2[0], h2[1], h2[2], h2[3]}, o[d0], 0, 0, 0);   \
        o[d0] = __builtin_amdgcn_mfma_f32_32x32x16_bf16(pa3, (bf16x8){l3[0], l3[1], l3[2], l3[3], h3[0], h3[1], h3[2], h3[3]}, o[d0], 0, 0, 0); } } while (0)
    PV_D0(0); PV_D0(1); PV_D0(2); PV_D0(3);
#undef PV_D0
#undef TRRD
}

struct UnitRef { const bf16_t* Q; const bf16_t* K; const bf16_t* V; int P0; };
struct Seam { bf16x8 qr[8]; bf16x8 st_v0, st_v1, st_k0, st_k1; };
#define ROW(p, k0, rr) ((p) + (size_t)((k0) + (rr)) * D + sc)
#define VMW() asm volatile("s_waitcnt vmcnt(0)" ::: "memory")
#define SLOAD_H(Kp, Vp, k0) do { S.st_v0 = load8(ROW(Vp, k0, sr)); S.st_v1 = load8(ROW(Vp, k0, 32 + sr));              \
                         S.st_k0 = load8(ROW(Kp, k0, sr)); S.st_k1 = load8(ROW(Kp, k0, 32 + sr)); } while (0)
#define SWRITE_HK(bf) do { *(bf16x8*)(K_lds + (bf) * SHM_K + kws) = S.st_k0; *(bf16x8*)(K_lds + (bf) * SHM_K + kws + 32 * 256) = S.st_k1; } while (0)
#define SWRITE_HV(bf) do { *(bf16x8*)(V_lds + (bf) * SHM_V + vst0) = S.st_v0; *(bf16x8*)(V_lds + (bf) * SHM_V + vst1) = S.st_v1; } while (0)
#define SWRITE_H(bf) do { SWRITE_HV(bf); SWRITE_HK(bf); } while (0)

template <bool SB>
__device__ __forceinline__ void attn_unit(const UnitRef& cur, unsigned char* wsu  , int bh, char* lds,
                                          int part  , float lmax  ) {
    const float* cvec;
    { unsigned char* w_ = wsu; asm volatile("" : "+s"(w_)); cvec = (const float*)(w_ + WS_C) + (size_t)bh * SEQ; }
    Seam S;
    { const int t0_ = tid_opaque(), w0_ = __builtin_amdgcn_readfirstlane(t0_ >> 6), l0_ = t0_ & 63;
#pragma unroll
      for (int d0 = 0; d0 < 8; ++d0) S.qr[d0] = load8(cur.Q + (size_t)(w0_ * QBLK + (l0_ & 31)) * D + d0 * 16 + (l0_ >> 5) * 8); }
    const int tid = tid_opaque(), wid = __builtin_amdgcn_readfirstlane(tid >> 6), lane = tid & 63, r32 = lane & 31, hi = lane >> 5;
    int jlo = 0;
    if constexpr (!SB) {
        const int ntf = (cur.P0 + QB) / KVBLK;
        const float cend = (lane < ntf) ? cvec[lane * KVBLK + KVBLK - 1] : 0.f;
        const bool skip = (lane < ntf) && (2.f * lmax + cvec[cur.P0] - cend < -104.f);
        jlo = __builtin_amdgcn_readfirstlane((int)__popcll(__ballot(skip)));
    }
    const int ntot = (cur.P0 + QB) / KVBLK - jlo;
    const int tb = (part == 2) ? (ntot >> 1) : 0, te = (part == 1) ? (ntot >> 1) : ntot;
    const int kshift = (jlo + tb) * KVBLK, P0r = cur.P0 - kshift;
    const int NT = te - tb;
#define KBASE(t) ((NT - 1 - (t)) * KVBLK)
    const int qlo = P0r + wid * QBLK, qm = qlo + r32 - 4 * hi - (SB ? 1 : 0);
    char* V_lds = lds; char* K_lds = lds + 2 * SHM_V;
    float* ws = (float*)(lds + OFF_WS) + wid * 64; float* li_l = ws, * al_l = ws + 32;
    float* bias = (float*)(lds + OFF_BIAS);
    const int sr = tid >> 4, sc = (tid & 15) * 8, vst0 = v_st(sr, sc), vst1 = v_st(32 + sr, sc), kws = KSWZ(sr, sc * 2);
    const int vb0 = (int)(uintptr_t)V_lds + v_rd_base(lane);
    const bf16_t* Kh = cur.K + (size_t)kshift * D; const bf16_t* Vh = cur.V + (size_t)kshift * D;
    SLOAD_H(Kh, Vh, KBASE(0));
    if constexpr (!SB) { const float cq0 = cvec[cur.P0]; const float* cv = cvec + kshift; for (int j = tid; j < NT * KVBLK; j += NTHREADS) bias[j] = (cq0 - cv[j]) * (1.f / SCALE); }
    VMW(); SWRITE_HK(0);
    __syncthreads();
    float m_reg = -1e30f, l_reg = 0; f32x16 o[4] = {};
    float carry = 0.f; const float mlo = hi ? 0.f : 1.f;
#define RESC(a) do { if (__any((a) < 1.f)) { if (hi == 0) al_l[r32] = (a); asm volatile("s_waitcnt lgkmcnt(0)" ::: "memory");              \
                     for (int d_ = 0; d_ < 4; ++d_) for (int r = 0; r < 16; ++r) o[d_][r] *= al_l[crow(r, hi)]; } } while (0)
#define MASKT(P0_, P1_, t) do { const int kb_ = KBASE(t); if (kb_ + KVBLK - 1 > qlo - (SB ? 1 : 0)) mask_tile(P0_, P1_, qm - kb_); } while (0)
#define BT(t) (bias + KBASE(t) + 4 * hi)
#define PART1(PX0, PX1, mnX, alX) do { if constexpr (SB) sb_part1(PX0, PX1, carry, mlo); else partialSM(PX0, PX1, m_reg, mnX, alX); } while (0)
#define PART2(PY0, PY1, alY) do { if constexpr (SB) sb_part2(PY0, PY1, pa0, pa1, pa2, pa3); else finishSM(PY0, PY1, alY, l_reg, pa0, pa1, pa2, pa3); } while (0)
    f32x16 pA0, pA1, pB0, pB1; float mnA = 0.f, mnB = 0.f, alA = 1.f, alB = 1.f; bf16x8 pa0, pa1, pa2, pa3;
    SWRITE_HV(0); SBAR();
    if (NT > 1) SLOAD_H(Kh, Vh, KBASE(1));
    SBAR(); qkt<0, !SB>(pA0, pA1, K_lds, r32, hi, S.qr, BT(0));
    MASKT(pA0, pA1, 0); PART1(pA0, pA1, mnA, alA);
    if (NT > 1) { VMW(); SWRITE_H(1); }
    __syncthreads();
#define HALF_STEP(PX0, PX1, mnX, alX, PY0, PY1, alY, t, KB, VB, SBUF) do {                                                    \
        SBAR(); qkt<KB, !SB>(PX0, PX1, K_lds, r32, hi, S.qr, BT(t));                                                          \
        PART2(PY0, PY1, alY); SBAR();                                                                                          \
        if ((t) + 1 < NT) { SLOAD_H(Kh, Vh, KBASE((t) + 1)); SBAR(); }                                                         \
        pv_tile<VB>(o, vb0, pa0, pa1, pa2, pa3); MASKT(PX0, PX1, (t)); PART1(PX0, PX1, mnX, alX);                              \
        __syncthreads();                                                                                                      \
        if ((t) + 1 < NT) { VMW(); SWRITE_H(SBUF); }                                                                           \
        if constexpr (!SB) RESC(alX);                                                                                          \
        __syncthreads(); } while (0)
    for (int t = 1; t + 1 < NT; t += 2) {
        HALF_STEP(pB0, pB1, mnB, alB, pA0, pA1, alA, t, 1, 0, 0);
        HALF_STEP(pA0, pA1, mnA, alA, pB0, pB1, alB, t + 1, 0, 1, 1);
    }
    const bool even = (NT & 1) == 0;
    if (even) { SBAR(); qkt<1, !SB>(pB0, pB1, K_lds, r32, hi, S.qr, BT(NT - 1)); SBAR(); }
    PART2(pA0, pA1, alA); SBAR();
    pv_tile<0>(o, vb0, pa0, pa1, pa2, pa3);
    if (even) { MASKT(pB0, pB1, NT - 1); PART1(pB0, pB1, mnB, alB); __syncthreads(); if constexpr (!SB) RESC(alB);
        PART2(pB0, pB1, alB); SBAR(); pv_tile<1>(o, vb0, pa0, pa1, pa2, pa3); }
    unsigned char* we_ = wsu; asm volatile("" : "+s"(we_));
    float* stg = (float*)(lds + OFF_BIAS) + wid * (32 * 68);
    if (part != 0) {
        const int slot2 = ((((cur.P0 >> 8) - 8) & 7) * 16 + bh) * 2 + (part == 2 ? 1 : 0);
        float* po = (float*)(we_ + WS_PO) + (size_t)slot2 * 256 * 128; float* pml = (float*)(we_ + WS_PML) + (size_t)slot2 * 512;
        if (hi == 0) { pml[(wid * QBLK + r32) * 2] = m_reg; pml[(wid * QBLK + r32) * 2 + 1] = l_reg; }
#pragma unroll
        for (int half = 0; half < 2; ++half) {
#pragma unroll
            for (int r = 0; r < 16; ++r) { stg[crow(r, hi) * 68 + r32] = o[2 * half][r]; stg[crow(r, hi) * 68 + 32 + r32] = o[2 * half + 1][r]; }
            asm volatile("s_waitcnt lgkmcnt(0)" ::: "memory");
#pragma unroll
            for (int k = 0; k < 4; ++k) { const int id = lane + 64 * k, row = id >> 3, c8 = (id & 7) * 8;
                const f32x4 x0 = *(const f32x4*)(stg + row * 68 + c8), x1 = *(const f32x4*)(stg + row * 68 + c8 + 4);
                float* d = po + (size_t)(wid * QBLK + row) * D + half * 64 + c8; *(f32x4*)d = x0; *(f32x4*)(d + 4) = x1; }
            asm volatile("s_waitcnt lgkmcnt(0)" ::: "memory");
        }
        __syncthreads();
        return;
    }
    const bf16_t* gate = (const bf16_t*)(we_ + WS_SEC) + 3 * SEC_ELEMS + (size_t)(bh >> 3) * SEQ * 1024 + (bh & 7) * HD;
    bf16_t* outp = (bf16_t*)(we_ + WS_MIX) + (size_t)(bh >> 3) * SEQ * DM + (bh & 7) * HD;
    float rli[16];
    if (hi == 0) li_l[r32] = l_reg; asm volatile("s_waitcnt lgkmcnt(0)" ::: "memory");
#pragma unroll
    for (int r = 0; r < 16; ++r) rli[r] = __builtin_amdgcn_rcpf(li_l[crow(r, hi)]);
#pragma unroll
    for (int half = 0; half < 2; ++half) {
#pragma unroll
        for (int r = 0; r < 16; ++r) { stg[crow(r, hi) * 68 + r32] = o[2 * half][r] * rli[r]; stg[crow(r, hi) * 68 + 32 + r32] = o[2 * half + 1][r] * rli[r]; }
        asm volatile("s_waitcnt lgkmcnt(0)" ::: "memory");
#pragma unroll
        for (int k = 0; k < 4; ++k) { const int id = lane + 64 * k, row = id >> 3, c8 = (id & 7) * 8;
            const int orow = cur.P0 + wid * QBLK + row, col = half * 64 + c8;
            const u32x4 gw = *(const u32x4*)(gate + (size_t)orow * 1024 + col);
            const f32x4 x0 = *(const f32x4*)(stg + row * 68 + c8), x1 = *(const f32x4*)(stg + row * 68 + c8 + 4);
            u32x4 ov; ov.x = cvt_pk_bf16(x0[0] * bf_lo(gw.x), x0[1] * bf_hi(gw.x)); ov.y = cvt_pk_bf16(x0[2] * bf_lo(gw.y), x0[3] * bf_hi(gw.y));
            ov.z = cvt_pk_bf16(x1[0] * bf_lo(gw.z), x1[1] * bf_hi(gw.z)); ov.w = cvt_pk_bf16(x1[2] * bf_lo(gw.w), x1[3] * bf_hi(gw.w));
            *(u32x4*)(outp + (size_t)orow * DM + col) = ov; }
        asm volatile("s_waitcnt lgkmcnt(0)" ::: "memory");
    }
    __syncthreads();
#undef RESC
#undef KBASE
#undef MASKT
#undef BT
#undef PART1
#undef PART2
#undef HALF_STEP
}

constexpr float SB_TH = 150.f;
__device__ __forceinline__ void sb_unit(const UnitRef& cur, bf16_t* outp, char* lds) {
    const int tid = tid_opaque(), wid = __builtin_amdgcn_readfirstlane(tid >> 6), lane = tid & 63, r32 = lane & 31, hi = lane >> 5;
    const int NT = (cur.P0 + QB) / KVBLK;
#define KBASE(t) ((NT - 1 - (t)) * KVBLK)
    const int qlo = cur.P0 + wid * QBLK, qm = qlo + r32 - 4 * hi - 1;
    char* V_lds = lds; char* K_lds = lds + 2 * SHM_V;
    volatile int* flags = (volatile int*)(lds + OFF_WS);
    const int sr = tid >> 4, sc = (tid & 15) * 8, vst0 = v_st(sr, sc), vst1 = v_st(32 + sr, sc), kws = KSWZ(sr, sc * 2);
    const int vb0 = (int)(uintptr_t)V_lds + v_rd_base(lane);
    const bf16_t* Kh = cur.K; const bf16_t* Vh = cur.V;
    Seam S;
#pragma unroll
    for (int d0 = 0; d0 < 8; ++d0) S.qr[d0] = load8(cur.Q + (size_t)(wid * QBLK + r32) * D + d0 * 16 + hi * 8);
    SLOAD_H(Kh, Vh, KBASE(0)); VMW(); SWRITE_H(0);
    __syncthreads();
    f32x16 o[4] = {}; float carry = 0.f; const float mlo = hi ? 0.f : 1.f;
    bool wdone = false;
#define SB_STEP(tt, BUF) {                                                                                                 \
        const int kb_ = KBASE(tt);                                                                                           \
        if ((tt) + 1 < NT) SLOAD_H(Kh, Vh, KBASE((tt) + 1));                                                                 \
        SBAR();                                                                                                              \
        if (!wdone && kb_ <= qlo + QBLK - 2) {                                                                               \
            f32x16 p0, p1; bf16x8 pa0, pa1, pa2, pa3;                                                                        \
            qkt<BUF, false>(p0, p1, K_lds, r32, hi, S.qr, nullptr);                                                          \
            if (kb_ + KVBLK - 1 > qlo - 1) mask_tile(p0, p1, qm - kb_);                                                      \
            sb_part1(p0, p1, carry, mlo); sb_part2(p0, p1, pa0, pa1, pa2, pa3); SBAR();                                      \
            pv_tile<BUF>(o, vb0, pa0, pa1, pa2, pa3);                                                                        \
            wdone = __all(carry >= SB_TH);                                                                                   \
        }                                                                                                                    \
        if ((tt) + 1 < NT) { VMW(); SWRITE_H((BUF) ^ 1); }                                                                   \
        if (lane == 0) flags[((tt) & 1) * 8 + wid] = wdone ? 1 : 0;                                                          \
        __syncthreads();                                                                                                     \
        { int alld = 1;                                                                                                      \
          _Pragma("unroll") for (int w_ = 0; w_ < 8; ++w_) alld &= flags[((tt) & 1) * 8 + w_];                                \
          if (alld) break; } }
    for (int t = 0; t < NT; t += 2) {
        SB_STEP(t, 0)
        SB_STEP(t + 1, 1)
    }
#undef SB_STEP
#pragma unroll
    for (int r = 0; r < 16; ++r) { const int orow = cur.P0 + wid * QBLK + crow(r, hi);
#pragma unroll
        for (int d0 = 0; d0 < 4; ++d0) {
            const float v = o[d0][r];
            const float vn = sx_f(v, 1);
            if ((r32 & 1) == 0) *(unsigned*)(outp + (size_t)orow * DM + d0 * 32 + r32) = cvt_pk_bf16(v, vn); } }
    __syncthreads();
#undef KBASE
}
#undef ROW
#undef VMW
#undef SLOAD_H
#undef SWRITE_HK
#undef SWRITE_HV
#undef SWRITE_H
}

#define XB_TMO      128
#define XB_XCNT(j)  (256  + 64 * (j))
#define XB_XSUB(j)  (1280 + 64 * (j))
#define XB_XGEN(j)  (2304 + 64 * (j))
#define XB_TOP      3328
#define XB_TOPGEN   3392
#define XCD_BAR_WORDS 3456
#define XB_SPIN_CAP (1u << 20)
__device__ __forceinline__ unsigned xb_ld(unsigned* p)              { return __hip_atomic_load(p, __ATOMIC_RELAXED, __HIP_MEMORY_SCOPE_AGENT); }
__device__ __forceinline__ unsigned xb_add(unsigned* p, unsigned v) { return __hip_atomic_fetch_add(p, v, __ATOMIC_RELAXED, __HIP_MEMORY_SCOPE_AGENT); }
__device__ __forceinline__ unsigned xb_xcc_id() { return (unsigned)__builtin_amdgcn_s_getreg((3 << 11) | 20) & 0xFu; }
#define XB_SPIN(cond, bar) do { unsigned _sp = 0; while (cond) { __builtin_amdgcn_s_sleep(1); \
    if ((++_sp & 255u) == 0u) { if (xb_ld(&(bar)[XB_TMO])) break; if (_sp > XB_SPIN_CAP) { atomicAdd(&(bar)[XB_TMO], 1u); break; } } } } while (0)
struct XcdBarrier { unsigned* bar; unsigned x; volatile LAS unsigned* st; };
__device__ __forceinline__ XcdBarrier xcd_barrier_post(unsigned* bar, volatile LAS unsigned* st) {
    XcdBarrier b; b.bar = bar; b.x = xb_xcc_id(); b.st = st;
    if (threadIdx.x == 0) (void)xb_add(&bar[XB_XCNT(b.x)], 1u);
    return b;
}
__device__ __forceinline__ void xcd_barrier_complete(unsigned* bar, unsigned x, unsigned& nloc, unsigned& nx) {
    const unsigned G = gridDim.x * gridDim.y * gridDim.z;
    unsigned sum, cnt, mine, sp = 0u;
    for (;;) {
        sum = 0u; cnt = 0u; mine = 0u;
#pragma unroll
        for (unsigned j = 0; j < 16; ++j) { const unsigned c = xb_ld(&bar[XB_XCNT(j)]); sum += c; cnt += (c > 0u) ? 1u : 0u; mine = (j == x) ? c : mine; }
        if (sum == G) break;
        __builtin_amdgcn_s_sleep(1);
        if ((++sp & 255u) == 0u) { if (xb_ld(&bar[XB_TMO])) break; if (sp > XB_SPIN_CAP) { atomicAdd(&bar[XB_TMO], 1u); break; } }
    }
    nloc = mine > 0u ? mine : 1u; nx = cnt > 0u ? cnt : 1u;
}
__device__ __forceinline__ void xcd_barrier(const XcdBarrier& b) {
    asm volatile("s_waitcnt vmcnt(0)" ::: "memory");
    __syncthreads();
    if (threadIdx.x == 0) {
        unsigned* bar = b.bar;
        __builtin_amdgcn_s_waitcnt(0);
        unsigned nloc = b.st[0], nx = b.st[1];
        if (nloc == 0u) { xcd_barrier_complete(bar, b.x, nloc, nx); b.st[0] = nloc; b.st[1] = nx; }
        const unsigned old = xb_add(&bar[XB_XSUB(b.x)], 1u);
        const unsigned gen = old / nloc;
        if (old + 1u == (gen + 1u) * nloc) {
            __builtin_amdgcn_fence(__ATOMIC_RELEASE, "agent");
            asm volatile("s_waitcnt vmcnt(0)" ::: "memory");
            const unsigned og = xb_add(&bar[XB_TOP], 1u);
            const unsigned tg = og / nx;
            if (og + 1u == (tg + 1u) * nx) xb_add(&bar[XB_TOPGEN], 1u);
            else XB_SPIN(xb_ld(&bar[XB_TOPGEN]) == tg, bar);
            __builtin_amdgcn_fence(__ATOMIC_ACQUIRE, "agent");
            xb_add(&bar[XB_XGEN(b.x)], 1u);
            asm volatile("s_waitcnt vmcnt(0)" ::: "memory");
        } else {
            XB_SPIN(xb_ld(&bar[XB_XGEN(b.x)]) == gen, bar);
            __builtin_amdgcn_fence(__ATOMIC_ACQUIRE, "agent");
            asm volatile("s_waitcnt vmcnt(0)" ::: "memory");
        }
    }
    __syncthreads();
}

struct Args { const float* in[12]; float* out; unsigned char* ws; int ph_lo, ph_hi; };

__device__ __forceinline__ void p0_transpose_item(const float* W, int ldw, int K, bf16_t* WT, int nblk, LAS float* scr, int item, int lane, const float* gk) {
    const int kb = item / nblk, nb = item % nblk, k0 = 64 * kb, n0 = 32 * nb;
    { const int rr = lane >> 3, c4 = lane & 7; f32x4 v[8];
#pragma unroll
      for (int i = 0; i < 8; ++i) v[i] = *(const f32x4*)(W + (size_t)(k0 + rr + 8 * i) * ldw + n0 + 4 * c4);
#pragma unroll
      for (int i = 0; i < 8; ++i) { const int kk = rr + 8 * i; const float gm = gk ? gk[k0 + kk] : 1.f;
          scr[kk * 33 + 4 * c4] = v[i][0] * gm; scr[kk * 33 + 4 * c4 + 1] = v[i][1] * gm; scr[kk * 33 + 4 * c4 + 2] = v[i][2] * gm; scr[kk * 33 + 4 * c4 + 3] = v[i][3] * gm; } }
    LDS_WAIT(); asm volatile("" ::: "memory");
    const int c = lane & 7;
#pragma unroll
    for (int j = 0; j < 4; ++j) { const int n = (lane >> 3) + 8 * j; const LAS float* s = scr + (8 * c) * 33 + n;
        u32x4 o; o.x = cvt_pk_bf16(s[0 * 33], s[1 * 33]); o.y = cvt_pk_bf16(s[2 * 33], s[3 * 33]); o.z = cvt_pk_bf16(s[4 * 33], s[5 * 33]); o.w = cvt_pk_bf16(s[6 * 33], s[7 * 33]);
        *(u32x4*)(WT + (size_t)(n0 + n) * K + k0 + 8 * c) = o; }
    LDS_WAIT(); asm volatile("" ::: "memory");
}

__device__ __forceinline__ int pack_i8(float a, float b, float c, float d) {
    const int ia = (int)__builtin_rintf(a), ib = (int)__builtin_rintf(b), ic = (int)__builtin_rintf(c), id = (int)__builtin_rintf(d);
    return (int)(((unsigned)ia & 0xffu) | (((unsigned)ib & 0xffu) << 8) | (((unsigned)ic & 0xffu) << 16) | ((unsigned)id << 24));
}
__device__ __forceinline__ void convert_tables(const Args& a, int r0, int r1, int worker, int nworkers) {
    const int lane = tid_opaque() & 63;
    unsigned char* ws = a.ws; const float* g_ffn = a.in[7]; const float* pu = a.in[10]; const float* pv = a.in[11];
    float* suv = (float*)(ws + WS_SUV);
    for (int r = r0 + worker; r < r1; r += nworkers) {
        const bool isv = r >= NEXP; const int e = isv ? r - NEXP : r;
        const f32x4* srcp = (const f32x4*)((isv ? pv : pu) + (size_t)e * DM);
        f32x4 v[8]; float amax = 0.f;
#pragma unroll
        for (int j = 0; j < 8; ++j) { v[j] = srcp[lane + 64 * j];
            if (!isv) { const f32x4 g4 = *(const f32x4*)(g_ffn + 4 * (lane + 64 * j)); v[j] = v[j] * g4; }
            amax = fmaxf(amax, fmaxf(fmaxf(fabsf(v[j][0]), fabsf(v[j][1])), fmaxf(fabsf(v[j][2]), fabsf(v[j][3])))); }
        amax = wave_max(amax);
        const float sc = amax > 0.f ? 127.f / amax : 1.f;
        unsigned char* dst = ws + (isv ? WS_V8 : WS_U8) + (size_t)e * 128;
#pragma unroll
        for (int j = 0; j < 8; ++j) { const int p = pack_i8(v[j][0] * sc, v[j][1] * sc, v[j][2] * sc, v[j][3] * sc);
            const int col = 4 * (lane + 64 * j);
            *(unsigned*)(dst + (size_t)(col >> 7) * ((size_t)NEXP * 128) + (col & 127)) = (unsigned)p; }
        if (lane == 0) suv[r] = 1.f / sc;
    }
}
constexpr int TAB_SPLIT = NEXP;

__device__ __forceinline__ void p0_transpose_item_i8(const float* W, int ldw, int K, unsigned char* WT, int nblk, LAS float* scr, int item, int lane, float q8) {
    const int kb = item / nblk, nb = item % nblk, k0 = 64 * kb, n0 = 32 * nb;
    { const int rr = lane >> 3, c4 = lane & 7; f32x4 v[8];
#pragma unroll
      for (int i = 0; i < 8; ++i) v[i] = *(const f32x4*)(W + (size_t)(k0 + rr + 8 * i) * ldw + n0 + 4 * c4);
#pragma unroll
      for (int i = 0; i < 8; ++i) { const int kk = rr + 8 * i;
          scr[kk * 33 + 4 * c4] = v[i][0] * q8; scr[kk * 33 + 4 * c4 + 1] = v[i][1] * q8; scr[kk * 33 + 4 * c4 + 2] = v[i][2] * q8; scr[kk * 33 + 4 * c4 + 3] = v[i][3] * q8; } }
    LDS_WAIT(); asm volatile("" ::: "memory");
    const int c = lane & 7;
#pragma unroll
    for (int j = 0; j < 4; ++j) { const int n = (lane >> 3) + 8 * j; const LAS float* s = scr + (8 * c) * 33 + n;
        u32x2 o; o.x = (unsigned)pack_i8(s[0 * 33], s[1 * 33], s[2 * 33], s[3 * 33]); o.y = (unsigned)pack_i8(s[4 * 33], s[5 * 33], s[6 * 33], s[7 * 33]);
        *(u32x2*)(WT + (size_t)(n0 + n) * K + k0 + 8 * c) = o; }
    LDS_WAIT(); asm volatile("" ::: "memory");
}
__device__ __forceinline__ float log_sigmoid_f(float x) { return fminf(x, 0.f) - log1pf(expf(-fabsf(x))); }

__device__ __forceinline__ void phase0(const Args& a, unsigned char* lds_g) {
    LAS unsigned char* lds = (LAS unsigned char*)lds_g;
    const int tid = tid_opaque(), lane = tid & 63, wave = __builtin_amdgcn_readfirstlane(tid >> 6);
    const int gw = blockIdx.x * NWAVES + wave, NGW = gridDim.x * NWAVES;
    const int gt = blockIdx.x * NTHREADS + tid, NGT = gridDim.x * NTHREADS;
    unsigned char* ws = a.ws;
    const float* x = a.in[0]; const float* g_attn = a.in[1]; const float* w_in = a.in[2]; const float* b_forget = a.in[3];
    const float* w_out = a.in[6]; const float* g_ffn = a.in[7]; const float* w_pq = a.in[8]; const float* sk = a.in[9]; const float* pu = a.in[10]; const float* pv = a.in[11];
    { float m = 0.f; const f32x4* wp = (const f32x4*)w_in;
      constexpr size_t NV4 = (size_t)DM * DIN / 4;
      size_t i = gt;
      for (; i + 7 * (size_t)NGT < NV4; i += 8 * (size_t)NGT) {
          f32x4 v[8];
#pragma unroll
          for (int k = 0; k < 8; ++k) v[k] = wp[i + k * (size_t)NGT];
#pragma unroll
          for (int k = 0; k < 8; ++k) m = fmaxf(m, fmaxf(fmaxf(fabsf(v[k][0]), fabsf(v[k][1])), fmaxf(fabsf(v[k][2]), fabsf(v[k][3])))); }
      for (; i < NV4; i += NGT) { const f32x4 v = wp[i]; m = fmaxf(m, fmaxf(fmaxf(fabsf(v[0]), fabsf(v[1])), fmaxf(fabsf(v[2]), fabsf(v[3])))); }
      m = wave_max(m);
      volatile LAS float* red = (volatile LAS float*)(lds + MISC_OFF + 256);
      if (lane == 0) red[wave] = m;
      __syncthreads();
      if (tid == 0) { float mm = red[0];
#pragma unroll
          for (int w = 1; w < NWAVES; ++w) mm = fmaxf(mm, red[w]);
          __hip_atomic_fetch_max((unsigned*)(ws + WS_CTL) + CW_WMAX, __float_as_uint(mm), __ATOMIC_RELAXED, __HIP_MEMORY_SCOPE_AGENT); } }
    LAS float* wf = (LAS float*)(lds + 67584);
    for (int k = tid; k < DM; k += NTHREADS) { const f32x4 a0 = *(const f32x4*)(w_in + (size_t)k * DIN + NPROJ), a1 = *(const f32x4*)(w_in + (size_t)k * DIN + NPROJ + 4);
        wf[0 * DM + k] = a0[0]; wf[1 * DM + k] = a0[1]; wf[2 * DM + k] = a0[2]; wf[3 * DM + k] = a0[3]; wf[4 * DM + k] = a1[0]; wf[5 * DM + k] = a1[1]; wf[6 * DM + k] = a1[2]; wf[7 * DM + k] = a1[3]; }
    __syncthreads();
    for (int row = gw; row < T; row += NGW) {
        const f32x4* xr = (const f32x4*)(x + (size_t)row * DM);
        f32x4 v[8]; float ss = 0.f;
#pragma unroll
        for (int j = 0; j < 8; ++j) { v[j] = xr[lane + 64 * j]; ss += v[j][0] * v[j][0] + v[j][1] * v[j][1] + v[j][2] * v[j][2] + v[j][3] * v[j][3]; }
        const float r = 1.0f / sqrtf(wave_sum(ss) * (1.f / DM) + EPS);
        float f[8] = {0.f, 0.f, 0.f, 0.f, 0.f, 0.f, 0.f, 0.f};
        float xmax = 0.f;
#pragma unroll
        for (int j = 0; j < 8; ++j) { const f32x4 g4 = *(const f32x4*)(g_attn + 4 * (lane + 64 * j)); v[j][0] *= r * g4[0]; v[j][1] *= r * g4[1]; v[j][2] *= r * g4[2]; v[j][3] *= r * g4[3];
            xmax = fmaxf(xmax, fmaxf(fmaxf(fabsf(v[j][0]), fabsf(v[j][1])), fmaxf(fabsf(v[j][2]), fabsf(v[j][3])))); }
        xmax = wave_max(xmax);
        const float xq = xmax > 0.f ? 127.f / xmax : 1.f;
        if (lane == 0) ((float*)(ws + WS_SXN))[row] = xmax * (1.f / 127.f);
        unsigned* o8 = (unsigned*)(ws + WS_XN + (size_t)row * DM);
#pragma unroll
        for (int j = 0; j < 8; ++j) {
            const int e = 4 * (lane + 64 * j);
            const f32x4 xn = v[j];
            o8[lane + 64 * j] = (unsigned)pack_i8(xn[0] * xq, xn[1] * xq, xn[2] * xq, xn[3] * xq);
#pragma unroll
            for (int hh = 0; hh < 8; ++hh) { const f32x4 w4 = *(LAS f32x4*)(wf + hh * DM + e);
                f[hh] += (xn[0] * w4[0] + xn[1] * w4[1]) + (xn[2] * w4[2] + xn[3] * w4[3]); }
            __builtin_amdgcn_sched_barrier(0);
        }
#pragma unroll
        for (int hh = 0; hh < 8; ++hh) f[hh] = wave_sum(f[hh]);
        if (lane < 8) { float fl = f[0];
#pragma unroll
            for (int hh = 1; hh < 8; ++hh) fl = (lane == hh) ? f[hh] : fl;
            const int b = row >> 12, s = row & 4095;
            ((float*)(ws + WS_LOGF))[(size_t)(b * 8 + lane) * SEQ + s] = log_sigmoid_f(fl + b_forget[lane]); }
    }
    LAS float* scr = (LAS float*)(lds + wave * 8448);
    constexpr int I_IN = (DM / 64) * (NPROJ / 32), I_O = (DM / 64) * (DM / 32);
    for (int it = gw; it < 2 * I_O; it += NGW) {
        int r = it;
        if (r < I_O) { p0_transpose_item(w_out, DM, DM, (bf16_t*)(ws + WS_WOUT), DM / 32, scr, r, lane, nullptr); continue; } r -= I_O;
        p0_transpose_item(w_pq, DM, DM, (bf16_t*)(ws + WS_WPQ), DM / 32, scr, r, lane, g_ffn);
    }
    for (int i = gt; i < 8 * 2 * 128 * 128 / 8; i += NGT) { const f32x4 a0 = *(const f32x4*)(sk + (size_t)i * 8), a1 = *(const f32x4*)(sk + (size_t)i * 8 + 4);
        u32x4 w; w.x = cvt_pk_bf16(a0[0], a0[1]); w.y = cvt_pk_bf16(a0[2], a0[3]); w.z = cvt_pk_bf16(a1[0], a1[1]); w.w = cvt_pk_bf16(a1[2], a1[3]);
        *(u32x4*)(ws + WS_SK + (size_t)i * 16) = w; }
    if (gt < 256) ((float*)(ws + WS_GQK))[gt] = gt < 128 ? a.in[4][gt] : a.in[5][gt - 128];
    convert_tables(a, 0, TAB_SPLIT, gw, NGW);
    { XcdBarrier xb_; xb_.bar = (unsigned*)(ws + WS_CTL) + CW_BAR; xb_.x = xb_xcc_id(); xb_.st = (volatile LAS unsigned*)(lds + MISC_OFF) + 8; xcd_barrier(xb_); }
    const float wmax = __uint_as_float(__hip_atomic_load((unsigned*)(ws + WS_CTL) + CW_WMAX, __ATOMIC_RELAXED, __HIP_MEMORY_SCOPE_AGENT));
    if (gt == 0) *(float*)(ws + WS_WSC) = wmax * (1.f / 127.f);
    const float q8 = wmax > 0.f ? 127.f / wmax : 1.f;
    for (int it = gw; it < I_IN; it += NGW) p0_transpose_item_i8(w_in, DIN, DM, ws + WS_WIN, NPROJ / 32, scr, it, lane, q8);
}

__device__ __forceinline__ void cumsum_rows(const Args& a) {
    const int tid = tid_opaque(), lane = tid & 63, wave = tid >> 6;
    const int rowi = (int)gridDim.x - 1 - (int)blockIdx.x;
    if (rowi >= 16 || rowi < 0 || wave != 0) return;
    const float* src = (const float*)(a.ws + WS_LOGF) + (size_t)rowi * SEQ + lane * 64;
    float* dst = (float*)(a.ws + WS_C) + (size_t)rowi * SEQ + lane * 64;
    f32x4 v[16]; float run = 0.f;
#pragma unroll
    for (int i = 0; i < 16; ++i) { v[i] = *(const f32x4*)(src + 4 * i);
#pragma unroll
        for (int q = 0; q < 4; ++q) { run += v[i][q]; v[i][q] = run; } }
    float incl = run;
#pragma unroll
    for (int o = 1; o < 64; o <<= 1) { const float t = shup_f(incl, o); if (lane >= o) incl += t; }
    const float off = incl - run;
#pragma unroll
    for (int i = 0; i < 16; ++i) { f32x4 w = v[i]; w[0] += off; w[1] += off; w[2] += off; w[3] += off; *(f32x4*)(dst + 4 * i) = w; }
}

__device__ __forceinline__ void phase_qknorm(const Args& a) {
    const int tid = tid_opaque(), lane = tid & 63, wave = tid >> 6;
    const int gw = blockIdx.x * NWAVES + wave, NGW = gridDim.x * NWAVES;
    const int sub = lane & 15, rw = lane >> 4;
    const float* gq = a.in[4]; const float* gk = a.in[5];
    constexpr int ROWS = NB * NHF * SEQ;
    for (int it = gw; it < 2 * ROWS / 4; it += NGW) {
        const int row = it * 4 + rw; const bool isk = row >= ROWS;
        bf16_t* p = (bf16_t*)(a.ws + WS_SEC) + (size_t)row * HD + sub * 8;
        const float* g = (isk ? gk : gq) + sub * 8;
        const u32x4 w = *(const u32x4*)p;
        float v[8] = {bf_lo(w.x), bf_hi(w.x), bf_lo(w.y), bf_hi(w.y), bf_lo(w.z), bf_hi(w.z), bf_lo(w.w), bf_hi(w.w)};
        float ss = 0.f;
#pragma unroll
        for (int i = 0; i < 8; ++i) ss += v[i] * v[i];
        ss += sx_f(ss, 1); ss += sx_f(ss, 2); ss += sx_f(ss, 4); ss += sx_f(ss, 8);
        const float r = 1.0f / sqrtf(ss * (1.f / HD) + EPS);
        const f32x4 g0 = *(const f32x4*)g, g1 = *(const f32x4*)(g + 4);
        u32x4 o; o.x = cvt_pk_bf16(v[0] * r * g0[0], v[1] * r * g0[1]); o.y = cvt_pk_bf16(v[2] * r * g0[2], v[3] * r * g0[3]);
        o.z = cvt_pk_bf16(v[4] * r * g1[0], v[5] * r * g1[1]); o.w = cvt_pk_bf16(v[6] * r * g1[2], v[7] * r * g1[3]);
        *(u32x4*)p = o;
    }
}

__device__ __forceinline__ void phase_attn(const Args& a, unsigned char* lds_g) {
    const int tid = tid_opaque();
    volatile int* s_item = (volatile int*)(lds_g + MISC_OFF);
    unsigned* ctr = (unsigned*)(a.ws + WS_CTL);
    float lmax;
    { const int lane_ = tid & 63; const float* gqk = (const float*)(a.ws + WS_GQK);
      const float gq = fmaxf(fabsf(gqk[lane_]), fabsf(gqk[64 + lane_])), gk = fmaxf(fabsf(gqk[128 + lane_]), fabsf(gqk[192 + lane_]));
      lmax = 11.3137085f * 1.02f * wave_max(gq) * wave_max(gk); }
    for (;;) {
        __syncthreads();
        if (tid == 0) *s_item = (int)atomicAdd(ctr, 1u);
        __syncthreads();
        int it = *s_item, kind = -1, qb = 0, sub = 0;
#define CLS(K, Q, CNT) if (kind < 0) { if (it < (CNT)) { kind = (K); qb = (Q); sub = it; } else it -= (CNT); }
        CLS(2, 15, 32) CLS(1, 7, 16) CLS(2, 14, 32) CLS(2, 13, 32) CLS(1, 6, 16) CLS(2, 12, 32) CLS(2, 11, 32) CLS(1, 5, 16) CLS(2, 10, 32) CLS(2, 9, 32) CLS(1, 4, 16) CLS(2, 8, 32) CLS(1, 3, 16) CLS(1, 2, 16)
        if (kind < 0) { if (it < 256) { kind = 0; qb = 15 - (it >> 4); sub = it & 15; } else it -= 256; }
        CLS(1, 1, 16) CLS(1, 0, 16)
#undef CLS
        if (kind < 0) break;
        unsigned char* wsl = a.ws; asm volatile("" : "+s"(wsl));
        bf16_t* sec = (bf16_t*)(wsl + WS_SEC);
        const int bh = sub & 15, part = (kind == 2) ? 1 + (sub >> 4) : 0;
        const int b = bh >> 3, h = bh & 7;
        const size_t hoff = (size_t)bh * SEQ * HD;
        att::UnitRef u;
        u.P0 = qb * 256;
        if (kind == 0) {
            u.Q = sec + 4 * SEC_ELEMS + hoff + (size_t)u.P0 * HD; u.K = sec + 5 * SEC_ELEMS + hoff; u.V = sec + 6 * SEC_ELEMS + hoff;
            att::sb_unit(u, (bf16_t*)(wsl + WS_MIX) + (size_t)b * SEQ * DM + 1024 + h * HD, (char*)lds_g);
        } else {
            u.Q = sec + 0 * SEC_ELEMS + hoff + (size_t)u.P0 * HD; u.K = sec + 1 * SEC_ELEMS + hoff; u.V = sec + 2 * SEC_ELEMS + hoff;
            att::attn_unit<false>(u, wsl, bh, (char*)lds_g, part, lmax);
        }
    }
}
__device__ __forceinline__ void phase_attn_combine(const Args& a) {
    const int gt = blockIdx.x * NTHREADS + tid_opaque(), NGT = gridDim.x * NTHREADS;
    const float* po = (const float*)(a.ws + WS_PO); const float* pml = (const float*)(a.ws + WS_PML);
    const bf16_t* gate = (const bf16_t*)(a.ws + WS_SEC) + 3 * SEC_ELEMS; bf16_t* mix = (bf16_t*)(a.ws + WS_MIX);
    constexpr float C2 = LOG2E * SCALE;
    for (int item = gt; item < 128 * 256 * 16; item += NGT) {
        const int slot = item >> 12, row = (item >> 4) & 255, cg = item & 15;
        const int qb = 8 + (slot >> 4), bh = slot & 15, b = bh >> 3, h = bh & 7;
        const f32x2 ml1 = *(const f32x2*)(pml + (size_t)(slot * 2) * 512 + row * 2), ml2 = *(const f32x2*)(pml + (size_t)(slot * 2 + 1) * 512 + row * 2);
        const float M = fmaxf(ml1.x, ml2.x), a1 = __builtin_amdgcn_exp2f((ml1.x - M) * C2), a2 = __builtin_amdgcn_exp2f((ml2.x - M) * C2);
        const float inv = 1.f / (a1 * ml1.y + a2 * ml2.y);
        const float* p1 = po + (size_t)(slot * 2) * 32768 + row * 128 + cg * 8; const float* p2 = p1 + 32768;
        const f32x4 x0 = *(const f32x4*)p1, x1 = *(const f32x4*)(p1 + 4), y0 = *(const f32x4*)p2, y1 = *(const f32x4*)(p2 + 4);
        const size_t tok = (size_t)b * SEQ + qb * 256 + row;
        const u32x4 gw = *(const u32x4*)(gate + tok * 1024 + h * HD + cg * 8);
        const float w1 = a1 * inv, w2 = a2 * inv;
        u32x4 o;
        o.x = cvt_pk_bf16((w1 * x0[0] + w2 * y0[0]) * bf_lo(gw.x), (w1 * x0[1] + w2 * y0[1]) * bf_hi(gw.x));
        o.y = cvt_pk_bf16((w1 * x0[2] + w2 * y0[2]) * bf_lo(gw.y), (w1 * x0[3] + w2 * y0[3]) * bf_hi(gw.y));
        o.z = cvt_pk_bf16((w1 * x1[0] + w2 * y1[0]) * bf_lo(gw.z), (w1 * x1[1] + w2 * y1[1]) * bf_hi(gw.z));
        o.w = cvt_pk_bf16((w1 * x1[2] + w2 * y1[2]) * bf_lo(gw.w), (w1 * x1[3] + w2 * y1[3]) * bf_hi(gw.w));
        *(u32x4*)(mix + tok * DM + h * HD + cg * 8) = o;
    }
}

__device__ __forceinline__ unsigned f2ord(float f) { const unsigned u = __float_as_uint(f); return u ^ ((unsigned)((int)u >> 31) | 0x80000000u); }
__device__ __forceinline__ float ord2f(unsigned k) { const unsigned u = k ^ (~(unsigned)((int)k >> 31) | 0x80000000u); return __uint_as_float(u); }
#define INS16(L, X) do { unsigned x_ = (X); _Pragma("unroll") for (int i_ = 0; i_ < 16; ++i_) { const unsigned hi_ = max(L[i_], x_); x_ = min(L[i_], x_); L[i_] = hi_; } } while (0)
__device__ __forceinline__ void sort16_desc(unsigned (&a)[16]) {
#pragma unroll
    for (int k = 2; k <= 16; k <<= 1)
#pragma unroll
        for (int j = k >> 1; j > 0; j >>= 1)
#pragma unroll
            for (int i = 0; i < 16; ++i) { const int l = i ^ j; if (l > i) { const unsigned hi_ = max(a[i], a[l]), lo_ = min(a[i], a[l]); const bool desc = (i & k) == 0; a[i] = desc ? hi_ : lo_; a[l] = desc ? lo_ : hi_; } }
}
__device__ __forceinline__ void merge_top16(unsigned (&a)[16], const unsigned (&b)[16]) {
#pragma unroll
    for (int i = 0; i < 16; ++i) a[i] = max(a[i], b[15 - i]);
#pragma unroll
    for (int j = 8; j > 0; j >>= 1)
#pragma unroll
        for (int i = 0; i < 16; ++i) { const int l = i ^ j; if (l > i) { const unsigned hi_ = max(a[i], a[l]), lo_ = min(a[i], a[l]); a[i] = hi_; a[l] = lo_; } }
}
__device__ __forceinline__ void topk_half(const bf16_t* qrow  , const bf16_t* skb, int h, int c, int r32, int hi, unsigned (&L)[16]) {
    bf16x8 qf[8];
#pragma unroll
    for (int d0 = 0; d0 < 8; ++d0) qf[d0] = *(const bf16x8*)(qrow + c * 128 + d0 * 16 + hi * 8);
    const unsigned hi4 = 4u * (unsigned)hi;
#pragma unroll
    for (int kt = 0; kt < 4; ++kt) {
        f32x16 acc = f32x16{};
#pragma unroll
        for (int d0 = 0; d0 < 8; ++d0) { const bf16x8 kf = *(const bf16x8*)(skb + (size_t)((h * 2 + c) * 128 + kt * 32 + r32) * 128 + d0 * 16 + hi * 8);
            acc = __builtin_amdgcn_mfma_f32_32x32x16_bf16(kf, qf[d0], acc, 0, 0, 0); }
        unsigned G[16];
#pragma unroll
        for (int r = 0; r < 16; ++r) { const unsigned cst = (unsigned)(127 - (kt * 32 + (r & 3) + 8 * (r >> 2))); G[r] = (f2ord(acc[r]) & ~127u) | (cst - hi4); }
        sort16_desc(G);
        if (kt == 0) {
#pragma unroll
            for (int i = 0; i < 16; ++i) L[i] = G[i];
        } else merge_top16(L, G);
    }
    unsigned P[16];
#pragma unroll
    for (int i = 0; i < 16; ++i) { auto rr = __builtin_amdgcn_permlane32_swap(L[i], L[i], false, false); P[i] = hi ? rr[0] : rr[1]; }
    merge_top16(L, P);
}
__device__ __forceinline__ void topk_task(unsigned char* ws, const bf16_t* qrow, LAS int* tb, int t0, int h, int lane) {
    const int r32 = lane & 31, hi = lane >> 5;
    const bf16_t* skb = (const bf16_t*)(ws + WS_SK);
    int* idx_o = (int*)(ws + WS_IDX); float* gw_o = (float*)(ws + WS_GW);
    float rt_l;
    { const f32x4* sp = (const f32x4*)((const float*)(ws + WS_SSQ) + (size_t)(t0 + (lane & 31)) * 32); float tot = 0.f;
#pragma unroll
      for (int i = 0; i < 8; ++i) { const f32x4 v = sp[i]; tot += (v[0] + v[1]) + (v[2] + v[3]); }
      rt_l = 1.0f / sqrtf(tot * (1.f / DM) + EPS); }
        {
          const bf16_t* hbp = (const bf16_t*)(ws + WS_HB); const float* amx = (const float*)(ws + WS_AMX); unsigned char* xq = ws + WS_XQ;
          float am = 0.f;
          { const f32x4* ap = (const f32x4*)(amx + (size_t)(t0 + (lane & 31)) * 32);
#pragma unroll
            for (int i = 0; i < 8; ++i) { const f32x4 v = ap[i]; am = fmaxf(am, fmaxf(fmaxf(v[0], v[1]), fmaxf(v[2], v[3]))); } }
          if (h == 0 && lane < 32) ((float*)(ws + WS_SX))[t0 + lane] = rt_l * am * (1.f / 126.5f);
          const float qs = am > 0.f ? 126.5f / am : 1.f;
          u32x4 wv[16];
#pragma unroll
          for (int j = 0; j < 16; ++j) { const int ch = lane + 64 * j; wv[j] = *(const u32x4*)(hbp + (size_t)(t0 + (ch >> 5)) * DM + h * 256 + (ch & 31) * 8); }
#pragma unroll
          for (int j = 0; j < 16; ++j) { const int ch = lane + 64 * j, tl = ch >> 5, tk = t0 + tl, col = h * 256 + (ch & 31) * 8;
              const u32x4 w = wv[j]; const float r = sh_f(qs, tl);
              const int p0 = pack_i8(bf_lo(w.x) * r, bf_hi(w.x) * r, bf_lo(w.y) * r, bf_hi(w.y) * r), p1 = pack_i8(bf_lo(w.z) * r, bf_hi(w.z) * r, bf_lo(w.w) * r, bf_hi(w.w) * r);
              *(u32x2*)(xq + (size_t)tk * DM + col) = (u32x2){(unsigned)p0, (unsigned)p1}; } }
        unsigned L[2][16];
        topk_half(qrow, skb, h, 0, r32, hi, L[0]);
        __builtin_amdgcn_sched_barrier(0);
        topk_half(qrow, skb, h, 1, r32, hi, L[1]);
        __builtin_amdgcn_sched_barrier(0);
        float s1[16], s2[16]; int i1[16], i2[16];
#pragma unroll
        for (int i = 0; i < 16; ++i) { s1[i] = ord2f((L[0][i] & ~127u) | 64u); i1[i] = 127 - (int)(L[0][i] & 127u); s2[i] = ord2f((L[1][i] & ~127u) | 64u); i2[i] = 127 - (int)(L[1][i] & 127u); }
        unsigned CG[4][16];
#pragma unroll
        for (int i = 0; i < 64; ++i) CG[i >> 4][i & 15] = 0u;
        CG[0][0] = (f2ord(s1[0] + s2[0]) & ~255u) | 0u;
        CG[0][1] = (f2ord(s1[0] + s2[1]) & ~255u) | 1u;
        CG[0][2] = (f2ord(s1[0] + s2[2]) & ~255u) | 2u;
        CG[0][3] = (f2ord(s1[0] + s2[3]) & ~255u) | 3u;
        CG[0][4] = (f2ord(s1[0] + s2[4]) & ~255u) | 4u;
        CG[0][5] = (f2ord(s1[0] + s2[5]) & ~255u) | 5u;
        CG[0][6] = (f2ord(s1[0] + s2[6]) & ~255u) | 6u;
        CG[0][7] = (f2ord(s1[0] + s2[7]) & ~255u) | 7u;
        CG[0][8] = (f2ord(s1[0] + s2[8]) & ~255u) | 8u;
        CG[0][9] = (f2ord(s1[0] + s2[9]) & ~255u) | 9u;
        CG[0][10] = (f2ord(s1[0] + s2[10]) & ~255u) | 10u;
        CG[0][11] = (f2ord(s1[0] + s2[11]) & ~255u) | 11u;
        CG[0][12] = (f2ord(s1[0] + s2[12]) & ~255u) | 12u;
        CG[0][13] = (f2ord(s1[0] + s2[13]) & ~255u) | 13u;
        CG[0][14] = (f2ord(s1[0] + s2[14]) & ~255u) | 14u;
        CG[0][15] = (f2ord(s1[0] + s2[15]) & ~255u) | 15u;
        CG[1][0] = (f2ord(s1[1] + s2[0]) & ~255u) | 16u;
        CG[1][1] = (f2ord(s1[1] + s2[1]) & ~255u) | 17u;
        CG[1][2] = (f2ord(s1[1] + s2[2]) & ~255u) | 18u;
        CG[1][3] = (f2ord(s1[1] + s2[3]) & ~255u) | 19u;
        CG[1][4] = (f2ord(s1[1] + s2[4]) & ~255u) | 20u;
        CG[1][5] = (f2ord(s1[1] + s2[5]) & ~255u) | 21u;
        CG[1][6] = (f2ord(s1[1] + s2[6]) & ~255u) | 22u;
        CG[1][7] = (f2ord(s1[1] + s2[7]) & ~255u) | 23u;
        CG[1][8] = (f2ord(s1[2] + s2[0]) & ~255u) | 32u;
        CG[1][9] = (f2ord(s1[2] + s2[1]) & ~255u) | 33u;
        CG[1][10] = (f2ord(s1[2] + s2[2]) & ~255u) | 34u;
        CG[1][11] = (f2ord(s1[2] + s2[3]) & ~255u) | 35u;
        CG[1][12] = (f2ord(s1[2] + s2[4]) & ~255u) | 36u;
        CG[1][13] = (f2ord(s1[3] + s2[0]) & ~255u) | 48u;
        CG[1][14] = (f2ord(s1[3] + s2[1]) & ~255u) | 49u;
        CG[1][15] = (f2ord(s1[3] + s2[2]) & ~255u) | 50u;
        CG[2][0] = (f2ord(s1[3] + s2[3]) & ~255u) | 51u;
        CG[2][1] = (f2ord(s1[4] + s2[0]) & ~255u) | 64u;
        CG[2][2] = (f2ord(s1[4] + s2[1]) & ~255u) | 65u;
        CG[2][3] = (f2ord(s1[4] + s2[2]) & ~255u) | 66u;
        CG[2][4] = (f2ord(s1[5] + s2[0]) & ~255u) | 80u;
        CG[2][5] = (f2ord(s1[5] + s2[1]) & ~255u) | 81u;
        CG[2][6] = (f2ord(s1[6] + s2[0]) & ~255u) | 96u;
        CG[2][7] = (f2ord(s1[6] + s2[1]) & ~255u) | 97u;
        CG[2][8] = (f2ord(s1[7] + s2[0]) & ~255u) | 112u;
        CG[2][9] = (f2ord(s1[7] + s2[1]) & ~255u) | 113u;
        CG[2][10] = (f2ord(s1[8] + s2[0]) & ~255u) | 128u;
        CG[2][11] = (f2ord(s1[9] + s2[0]) & ~255u) | 144u;
        CG[2][12] = (f2ord(s1[10] + s2[0]) & ~255u) | 160u;
        CG[2][13] = (f2ord(s1[11] + s2[0]) & ~255u) | 176u;
        CG[2][14] = (f2ord(s1[12] + s2[0]) & ~255u) | 192u;
        CG[2][15] = (f2ord(s1[13] + s2[0]) & ~255u) | 208u;
        CG[3][0] = (f2ord(s1[14] + s2[0]) & ~255u) | 224u;
        CG[3][1] = (f2ord(s1[15] + s2[0]) & ~255u) | 240u;
        sort16_desc(CG[0]); sort16_desc(CG[1]); sort16_desc(CG[2]); sort16_desc(CG[3]);
        merge_top16(CG[0], CG[1]); merge_top16(CG[2], CG[3]); merge_top16(CG[0], CG[2]);
        unsigned LC[16];
#pragma unroll
        for (int i = 0; i < 16; ++i) LC[i] = CG[0][i];
#pragma unroll
        for (int i = 0; i < 16; ++i) { tb[i * 64 + lane] = i1[i]; tb[(16 + i) * 64 + lane] = i2[i]; }
        float LS[16]; int LP[16];
#pragma unroll
        for (int i = 0; i < 16; ++i) { const unsigned cid = LC[i] & 255u; LS[i] = ord2f((LC[i] & ~255u) | 128u);
            LP[i] = tb[(cid >> 4) * 64 + lane] * 128 + tb[(16 + (cid & 15u)) * 64 + lane]; }
        float den = 0.f, e[16];
#pragma unroll
        for (int i = 0; i < 16; ++i) { e[i] = __expf(LS[i] - LS[0]); den += e[i]; }
        const float rden = 1.f / den;
        const size_t ob = (size_t)(t0 + r32) * NE + h * 16;
        if (hi == 0) {
#pragma unroll
            for (int i = 0; i < 4; ++i) *(int4*)(idx_o + ob + 4 * i) = make_int4(LP[4 * i], LP[4 * i + 1], LP[4 * i + 2], LP[4 * i + 3]);
            { unsigned short* i16 = (unsigned short*)(ws + WS_IDX16) + ob;
#pragma unroll
              for (int i = 0; i < 2; ++i) *(u32x4*)(i16 + 8 * i) = (u32x4){(unsigned)LP[8 * i] | ((unsigned)LP[8 * i + 1] << 16), (unsigned)LP[8 * i + 2] | ((unsigned)LP[8 * i + 3] << 16),
                                                                        (unsigned)LP[8 * i + 4] | ((unsigned)LP[8 * i + 5] << 16), (unsigned)LP[8 * i + 6] | ((unsigned)LP[8 * i + 7] << 16)}; }
        } else {
#pragma unroll
            for (int i = 0; i < 4; ++i) *(f32x4*)(gw_o + ob + 4 * i) = (f32x4){e[4 * i] * rden, e[4 * i + 1] * rden, e[4 * i + 2] * rden, e[4 * i + 3] * rden};
        }
}
__device__ __forceinline__ void phase_topk(const Args& a, unsigned char* lds_g) {
    LAS unsigned char* lds = (LAS unsigned char*)lds_g;
    const int tid = tid_opaque(), lane = tid & 63, wave = tid >> 6;
    const int gw = blockIdx.x * NWAVES + wave, NGW = gridDim.x * NWAVES;
    const bf16_t* qp = (const bf16_t*)(a.ws + WS_QP);
    for (int task = gw; task < (T / 32) * 8; task += NGW) {
        const int h = task & 7, t0 = (task >> 3) * 32;
        topk_task(a.ws, qp + (size_t)(t0 + (lane & 31)) * DM + h * 256, (LAS int*)(lds + wave * 8192), t0, h, lane);
    }
}
__device__ __forceinline__ void pg8::EpiPeerQFused::fused(const f32x4 (&acc)[2][2][4][2], const Unit& u, int wr, int wc, int fr, int fq, PG8_LAS unsigned char* lds) const {
    constexpr int ROWB = 528;
#pragma unroll
    for (int ai = 0; ai < 2; ++ai)
#pragma unroll
        for (int m = 0; m < 4; ++m) {
            const int tr = ai * HALF + wr * 64 + m * 16 + fr, tk = u.pm * BM + tr;
            float tot = 0.f;
#pragma unroll
            for (int i = 0; i < 8; ++i) { const f32x4 s4 = *(const f32x4*)(ssq + (size_t)tk * 32 + 4 * i); tot += (s4[0] + s4[1]) + (s4[2] + s4[3]); }
            const float r = 1.0f / sqrtf(tot * (1.f / DM) + EPS);
#pragma unroll
            for (int bj = 0; bj < 2; ++bj) {
                const f32x4 v0 = acc[ai][bj][m][0] * r, v1 = acc[ai][bj][m][1] * r;
                u32x4 w; w.x = cvt_pk_bf16(v0[0], v0[1]); w.y = cvt_pk_bf16(v0[2], v0[3]); w.z = cvt_pk_bf16(v1[0], v1[1]); w.w = cvt_pk_bf16(v1[2], v1[3]);
                *(PG8_LAS u32x4*)(lds + tr * ROWB + (bj * HALF + wc * 32 + 8 * fq) * 2) = w;
            }
        }
    __syncthreads();
    const int tid = tid_opaque(), lane = tid & 63, wave = tid >> 6;
    PG8_LAS unsigned char* myrows = lds + (wave * 32) * ROWB;
    topk_task(wsb, (const bf16_t*)(const void*)(myrows + (lane & 31) * ROWB), (LAS int*)myrows, u.pm * BM + wave * 32, u.pn, lane);
}
__device__ __forceinline__ void wave_argmax(float& v, int& i) {
#pragma unroll
    for (int o = 1; o < 64; o <<= 1) { const float ov = sx_f(v, o); const int oi = sx_i(i, o); if (ov > v || (ov == v && oi < i)) { v = ov; i = oi; } }
}
__device__ __forceinline__ void phase_topk_ref(const Args& a) {
    const int tid = tid_opaque(), lane = tid & 63, wave = tid >> 6;
    const int gw = blockIdx.x * NWAVES + wave, NGW = gridDim.x * NWAVES;
    const bf16_t* skb = (const bf16_t*)(a.ws + WS_SK); const bf16_t* qp = (const bf16_t*)(a.ws + WS_QP);
    int* idx_o = (int*)(a.ws + WS_IDX); float* gw_o = (float*)(a.ws + WS_GW);
    for (int task = gw; task < T * 8; task += NGW) {
        const int t = task >> 3, h = task & 7;
        float topS[2]; int topI[2];
        for (int c = 0; c < 2; ++c) {
            const bf16_t* q = qp + (size_t)t * DM + h * 256 + c * 128;
            float sc0 = 0.f, sc1 = 0.f;
            const bf16_t* k0 = skb + (size_t)((h * 2 + c) * 128 + lane) * 128; const bf16_t* k1 = k0 + 64 * 128;
            for (int d = 0; d < 128; ++d) { const float qd = __uint_as_float((unsigned)q[d] << 16);
                sc0 += qd * __uint_as_float((unsigned)k0[d] << 16); sc1 += qd * __uint_as_float((unsigned)k1[d] << 16); }
            float ms = 0.f; int mi = 0;
            for (int r = 0; r < 16; ++r) {
                float v; int i; if (sc0 >= sc1) { v = sc0; i = lane; } else { v = sc1; i = lane + 64; }
                wave_argmax(v, i);
                if (lane == r) { ms = v; mi = i; }
                if (i == lane) sc0 = -__builtin_inff();
                if (i == lane + 64) sc1 = -__builtin_inff();
            }
            topS[c] = ms; topI[c] = mi;
        }
        float cs[4]; int ci[4];
#pragma unroll
        for (int j = 0; j < 4; ++j) { const int cidx = lane * 4 + j, aa = cidx >> 4, bb = cidx & 15;
            cs[j] = sh_f(topS[0], aa) + sh_f(topS[1], bb); ci[j] = cidx; }
        float fs = 0.f; int fi = 0;
        for (int r = 0; r < 16; ++r) {
            float v = cs[0]; int i = ci[0];
#pragma unroll
            for (int j = 1; j < 4; ++j) if (cs[j] > v) { v = cs[j]; i = ci[j]; }
            wave_argmax(v, i);
            if (lane == r) { fs = v; fi = i; }
#pragma unroll
            for (int j = 0; j < 4; ++j) if (ci[j] == i) cs[j] = -__builtin_inff();
        }
        const int e1 = sh_i(topI[0], fi >> 4), e2 = sh_i(topI[1], fi & 15);
        const float mx = sh_f(fs, 0);
        float ev = lane < 16 ? __expf(fs - mx) : 0.f;
        const float den = wave_sum(ev);
        if (lane < 16) { idx_o[(size_t)t * NE + h * 16 + lane] = e1 * 128 + e2; gw_o[(size_t)t * NE + h * 16 + lane] = ev / den; }
    }
}

__device__ __forceinline__ void fp8x16_to_f32(const u32x4 q, f32x2 (&o)[8]) {
    o[0] = __builtin_amdgcn_cvt_pk_f32_fp8((int)q.x, false); o[1] = __builtin_amdgcn_cvt_pk_f32_fp8((int)q.x, true);
    o[2] = __builtin_amdgcn_cvt_pk_f32_fp8((int)q.y, false); o[3] = __builtin_amdgcn_cvt_pk_f32_fp8((int)q.y, true);
    o[4] = __builtin_amdgcn_cvt_pk_f32_fp8((int)q.z, false); o[5] = __builtin_amdgcn_cvt_pk_f32_fp8((int)q.z, true);
    o[6] = __builtin_amdgcn_cvt_pk_f32_fp8((int)q.w, false); o[7] = __builtin_amdgcn_cvt_pk_f32_fp8((int)q.w, true);
}
#define HALVE(dst, srcv, n, bitmask) do { const bool up_ = (lane & (bitmask)) != 0; _Pragma("unroll") for (int i_ = 0; i_ < (n); ++i_) { \
        const float keep_ = up_ ? srcv[(n) + i_] : srcv[i_], send_ = up_ ? srcv[i_] : srcv[(n) + i_]; dst[i_] = keep_ + sx_f(send_, (bitmask)); } } while (0)
#define ITEM_T(n) (wv + ((n) % KT) * NWX)
#define ITEM_S(n) (xl + 8 * ((n) / KT))
#define LD_IDX(ID, n) do { const int4* ip_ = (const int4*)(idx_i + (size_t)ITEM_T(n) * NE + g * 16); _Pragma("unroll") for (int i_ = 0; i_ < 4; ++i_) ID[i_] = ip_[i_]; } while (0)
#define LD_ROWS(Q, ID, TAB, n) do { const unsigned char* b_ = (TAB) + (size_t)ITEM_S(n) * ((size_t)NEXP * 128) + c * 16; _Pragma("unroll") for (int i_ = 0; i_ < 4; ++i_) { \
        Q[4 * i_] = *(const u32x4*)(b_ + (size_t)ID[i_].x * 128); Q[4 * i_ + 1] = *(const u32x4*)(b_ + (size_t)ID[i_].y * 128); \
        Q[4 * i_ + 2] = *(const u32x4*)(b_ + (size_t)ID[i_].z * 128); Q[4 * i_ + 3] = *(const u32x4*)(b_ + (size_t)ID[i_].w * 128); } } while (0)
__device__ __forceinline__ int dpp_hmirror(int v) { return __builtin_amdgcn_update_dpp(0, v, 0x141, 0xf, 0xf, true); }
__device__ __forceinline__ int dpp_qxor2(int v) { return __builtin_amdgcn_update_dpp(0, v, 0x4E, 0xf, 0xf, true); }
__device__ __forceinline__ int dpp_qxor1(int v) { return __builtin_amdgcn_update_dpp(0, v, 0xB1, 0xf, 0xf, true); }
__device__ __forceinline__ void phase_peer_u(const Args& a) {
    const int tid = tid_opaque(), lane = tid & 63, wave = tid >> 6, g = lane >> 3, c = lane & 7;
    const int xl = blockIdx.x & 7, wv = (blockIdx.x >> 3) * NWAVES + wave, NWX = (gridDim.x >> 3) * NWAVES, KT = T / NWX, N = 2 * KT;
    const unsigned char* xq = a.ws + WS_XQ; const unsigned char* u8 = a.ws + WS_U8;
    const unsigned short* idx16 = (const unsigned short*)(a.ws + WS_IDX16); bf16_t* part = (bf16_t*)(a.ws + WS_PART);
    const bool up4 = (c & 4) != 0, up2 = (c & 2) != 0, up1 = (c & 1) != 0;
#define LD_I16(ID, n, h) do { ID = *(const u32x4*)(idx16 + (size_t)ITEM_T(n) * NE + g * 16 + (h) * 8); } while (0)
#define LD_R8(Q, ID, n) do { const unsigned char* b_ = u8 + (size_t)ITEM_S(n) * ((size_t)NEXP * 128) + c * 16; \
        Q[0] = *(const u32x4*)(b_ + (size_t)(ID.x & 0xffffu) * 128); Q[1] = *(const u32x4*)(b_ + (size_t)(ID.x >> 16) * 128); \
        Q[2] = *(const u32x4*)(b_ + (size_t)(ID.y & 0xffffu) * 128); Q[3] = *(const u32x4*)(b_ + (size_t)(ID.y >> 16) * 128); \
        Q[4] = *(const u32x4*)(b_ + (size_t)(ID.z & 0xffffu) * 128); Q[5] = *(const u32x4*)(b_ + (size_t)(ID.z >> 16) * 128); \
        Q[6] = *(const u32x4*)(b_ + (size_t)(ID.w & 0xffffu) * 128); Q[7] = *(const u32x4*)(b_ + (size_t)(ID.w >> 16) * 128); } while (0)
#define LD_X(X, n) do { X = *(const u32x4*)(xq + (size_t)ITEM_T(n) * DM + ITEM_S(n) * 128 + c * 16); } while (0)
#define DOT8(P, OFF, Q, X) do { _Pragma("unroll") for (int i = 0; i < 8; ++i) { int d_ = __builtin_amdgcn_sdot4((int)Q[i].x, (int)X.x, 0, false); d_ = __builtin_amdgcn_sdot4((int)Q[i].y, (int)X.y, d_, false); \
            d_ = __builtin_amdgcn_sdot4((int)Q[i].z, (int)X.z, d_, false); P[(OFF) + i] = __builtin_amdgcn_sdot4((int)Q[i].w, (int)X.w, d_, false); } } while (0)
#define FINISH_U(P, n) do { int p8[8], p4[4], p2[2]; \
        _Pragma("unroll") for (int i = 0; i < 8; ++i) { const int keep_ = up4 ? P[8 + i] : P[i], send_ = up4 ? P[i] : P[8 + i]; p8[i] = keep_ + dpp_hmirror(send_); } \
        _Pragma("unroll") for (int i = 0; i < 4; ++i) { const int keep_ = up2 ? p8[4 + i] : p8[i], send_ = up2 ? p8[i] : p8[4 + i]; p4[i] = keep_ + dpp_qxor2(send_); } \
        _Pragma("unroll") for (int i = 0; i < 2; ++i) { const int keep_ = up1 ? p4[2 + i] : p4[i], send_ = up1 ? p4[i] : p4[2 + i]; p2[i] = keep_ + dpp_qxor1(send_); } \
        *(unsigned*)(part + ((size_t)ITEM_T(n) * 16 + ITEM_S(n)) * NE + 2 * lane) = cvt_pk_bf16((float)p2[0], (float)p2[1]); } while (0)
    u32x4 IA, IB, IC, ID_, QA[8], QB[8], QC[8], QD[8], XA, XB;
    LD_I16(IA, 0, 0); LD_I16(IB, 0, 1); LD_I16(IC, 1, 0); LD_I16(ID_, 1, 1);
    LD_R8(QA, IA, 0); LD_R8(QB, IB, 0); LD_X(XA, 0); LD_R8(QC, IC, 1); LD_R8(QD, ID_, 1); LD_X(XB, 1);
    if (N > 2) { LD_I16(IA, 2, 0); LD_I16(IB, 2, 1); LD_I16(IC, 3, 0); LD_I16(ID_, 3, 1); }
    for (int n = 0; n < N; n += 2) {
        int p[16];
        DOT8(p, 0, QA, XA); if (n + 2 < N) { LD_R8(QA, IA, n + 2); if (n + 4 < N) LD_I16(IA, n + 4, 0); }
        DOT8(p, 8, QB, XA); if (n + 2 < N) { LD_R8(QB, IB, n + 2); LD_X(XA, n + 2); if (n + 4 < N) LD_I16(IB, n + 4, 1); }
        FINISH_U(p, n);
        int r[16];
        DOT8(r, 0, QC, XB); if (n + 3 < N) { LD_R8(QC, IC, n + 3); if (n + 5 < N) LD_I16(IC, n + 5, 0); }
        DOT8(r, 8, QD, XB); if (n + 3 < N) { LD_R8(QD, ID_, n + 3); LD_X(XB, n + 3); if (n + 5 < N) LD_I16(ID_, n + 5, 1); }
        FINISH_U(r, n + 1);
    }
#undef LD_I16
#undef LD_R8
#undef LD_X
#undef DOT8
#undef FINISH_U
}
__device__ __forceinline__ void phase_peer_w(const Args& a) {
    const int gt = blockIdx.x * NTHREADS + tid_opaque(), NGT = gridDim.x * NTHREADS;
    const int* idx_i = (const int*)(a.ws + WS_IDX); const float* gw_i = (const float*)(a.ws + WS_GW); const bf16_t* part = (const bf16_t*)(a.ws + WS_PART);
    const float* suv = (const float*)(a.ws + WS_SUV); const float* sx = (const float*)(a.ws + WS_SX);
    unsigned char* wq = a.ws + WS_WQ; float* sw = (float*)(a.ws + WS_SW);
    for (int item = gt; item < T * NE / 2; item += NGT) {
        const int t = item >> 6, e = (item & 63) * 2;
        unsigned pw[16];
#pragma unroll
        for (int s = 0; s < 16; ++s) pw[s] = *(const unsigned*)(part + ((size_t)t * 16 + s) * NE + e);
        float sum0 = 0.f, sum1 = 0.f;
#pragma unroll
        for (int s = 0; s < 16; ++s) { sum0 += bf_lo(pw[s]); sum1 += bf_hi(pw[s]); }
        const int2 ex = *(const int2*)(idx_i + (size_t)t * NE + e); const f32x2 gg = *(const f32x2*)(gw_i + (size_t)t * NE + e);
        const float sxt = sx[t];
        const float d0 = sum0 * suv[ex.x] * sxt, d1 = sum1 * suv[ex.y] * sxt;
        const float om0 = 0.5f * d0 * (1.f + erff(d0 * 0.70710678118654752f)) * gg.x * suv[NEXP + ex.x];
        const float om1 = 0.5f * d1 * (1.f + erff(d1 * 0.70710678118654752f)) * gg.y * suv[NEXP + ex.y];
        float mx = fmaxf(fabsf(om0), fabsf(om1));
        mx = fmaxf(mx, sx_f(mx, 1)); mx = fmaxf(mx, sx_f(mx, 2)); mx = fmaxf(mx, sx_f(mx, 4));
        const float qs = mx > 0.f ? 127.f / mx : 1.f;
        const int q0 = (int)__builtin_rintf(om0 * qs), q1 = (int)__builtin_rintf(om1 * qs);
        *(unsigned short*)(wq + (size_t)t * NE + e) = (unsigned short)(((unsigned)q0 & 0xffu) | (((unsigned)q1 & 0xffu) << 8));
        if ((e & 15) == 0) sw[t * 8 + (e >> 4)] = mx * (1.f / 127.f);
    }
}
__device__ __forceinline__ void phase_peer_v(const Args& a, float* dst) {
    const int tid = tid_opaque(), lane = tid & 63, wave = tid >> 6, g = lane >> 3, c = lane & 7;
    const int xl = blockIdx.x & 7, wv = (blockIdx.x >> 3) * NWAVES + wave, NWX = (gridDim.x >> 3) * NWAVES, KT = T / NWX, N = 2 * KT;
    const unsigned char* v8 = a.ws + WS_V8;
    const int* idx_i = (const int*)(a.ws + WS_IDX); const unsigned char* wq = a.ws + WS_WQ; const float* sw = (const float*)(a.ws + WS_SW);
    const bf16_t* hsrc = (const bf16_t*)(a.ws + WS_HB);
#define LD_W(W, SWV, HV, n) do { W = *(const u32x4*)(wq + (size_t)ITEM_T(n) * NE + g * 16); SWV = sw[ITEM_T(n) * 8 + g]; HV = *(const unsigned*)(hsrc + (size_t)ITEM_T(n) * DM + ITEM_S(n) * 128 + 2 * lane); } while (0)
#define QUAD(A_, B_, C_, D_, W_, A0, A1, A2, A3) do { \
        const unsigned ablo_ = __builtin_amdgcn_perm(B_, A_, 0x05010400u), abhi_ = __builtin_amdgcn_perm(B_, A_, 0x07030602u); \
        const unsigned cdlo_ = __builtin_amdgcn_perm(D_, C_, 0x05010400u), cdhi_ = __builtin_amdgcn_perm(D_, C_, 0x07030602u); \
        A0 = __builtin_amdgcn_sdot4((int)__builtin_amdgcn_perm(cdlo_, ablo_, 0x05040100u), (int)(W_), A0, false); \
        A1 = __builtin_amdgcn_sdot4((int)__builtin_amdgcn_perm(cdlo_, ablo_, 0x07060302u), (int)(W_), A1, false); \
        A2 = __builtin_amdgcn_sdot4((int)__builtin_amdgcn_perm(cdhi_, abhi_, 0x05040100u), (int)(W_), A2, false); \
        A3 = __builtin_amdgcn_sdot4((int)__builtin_amdgcn_perm(cdhi_, abhi_, 0x07060302u), (int)(W_), A3, false); } while (0)
#define COMPUTE_V(Q, W, SWV, HV, n) do { int ac[16]; _Pragma("unroll") for (int k = 0; k < 16; ++k) ac[k] = 0; \
        _Pragma("unroll") for (int q_ = 0; q_ < 4; ++q_) { const unsigned w_ = q_ == 0 ? W.x : q_ == 1 ? W.y : q_ == 2 ? W.z : W.w; \
            QUAD(Q[4 * q_].x, Q[4 * q_ + 1].x, Q[4 * q_ + 2].x, Q[4 * q_ + 3].x, w_, ac[0], ac[1], ac[2], ac[3]); \
            QUAD(Q[4 * q_].y, Q[4 * q_ + 1].y, Q[4 * q_ + 2].y, Q[4 * q_ + 3].y, w_, ac[4], ac[5], ac[6], ac[7]); \
            QUAD(Q[4 * q_].z, Q[4 * q_ + 1].z, Q[4 * q_ + 2].z, Q[4 * q_ + 3].z, w_, ac[8], ac[9], ac[10], ac[11]); \
            QUAD(Q[4 * q_].w, Q[4 * q_ + 1].w, Q[4 * q_ + 2].w, Q[4 * q_ + 3].w, w_, ac[12], ac[13], ac[14], ac[15]); } \
        float p[16]; _Pragma("unroll") for (int k = 0; k < 16; ++k) p[k] = (float)ac[k] * SWV; \
        float p8[8], p4[4], p2[2]; \
        _Pragma("unroll") for (int i_ = 0; i_ < 8; ++i_) { auto rr_ = __builtin_amdgcn_permlane32_swap(__float_as_uint(p[i_]), __float_as_uint(p[8 + i_]), false, false); p8[i_] = __uint_as_float(rr_[0]) + __uint_as_float(rr_[1]); } \
        _Pragma("unroll") for (int i_ = 0; i_ < 4; ++i_) { auto rr_ = __builtin_amdgcn_permlane16_swap(__float_as_uint(p8[i_]), __float_as_uint(p8[4 + i_]), false, false); p4[i_] = __uint_as_float(rr_[0]) + __uint_as_float(rr_[1]); } \
        HALVE(p2, p4, 2, 8); \
        const int srcl_ = ((lane & 7) << 3) | (lane >> 3);                     \
        const float q0_ = sh_f(p2[0], srcl_), q1_ = sh_f(p2[1], srcl_); \
        const size_t o_ = (size_t)ITEM_T(n) * DM + ITEM_S(n) * 128 + 2 * lane; \
        *(f32x2*)(dst + o_) = (f32x2){bf_lo(HV) + q0_, bf_hi(HV) + q1_}; } while (0)
    int4 IA[4], IB[4]; u32x4 QA[16], QB[16], WA, WB; float SA, SB_; unsigned HA, HB_;
    LD_IDX(IA, 0); LD_IDX(IB, 1);
    LD_ROWS(QA, IA, v8, 0); LD_W(WA, SA, HA, 0);
    for (int n = 0; n < N; n += 2) {
        LD_ROWS(QB, IB, v8, n + 1); LD_W(WB, SB_, HB_, n + 1);
        if (n + 2 < N) LD_IDX(IA, n + 2);
        COMPUTE_V(QA, WA, SA, HA, n);
        if (n + 2 < N) { LD_ROWS(QA, IA, v8, n + 2); LD_W(WA, SA, HA, n + 2); }
        if (n + 3 < N) LD_IDX(IB, n + 3);
        COMPUTE_V(QB, WB, SB_, HB_, n + 1);
    }
#undef LD_W
#undef QUAD
#undef COMPUTE_V
}
#undef ITEM_T
#undef ITEM_S
#undef LD_IDX
#undef LD_ROWS
#undef HALVE


constexpr int NPHASE = 11;
#define LOAD_ARGS() do { } while (0)
__global__ void __launch_bounds__(NTHREADS, 2) fwd_kernel(Args a) {
    extern __shared__ __attribute__((aligned(16))) unsigned char lds[];
#if MK_ONE_LAUNCH
    constexpr int lo = 0, hi = NPHASE;
    cg::grid_group grid = cg::this_grid();
    volatile LAS unsigned* misc = (volatile LAS unsigned*)((LAS unsigned char*)lds + MISC_OFF);
    if (threadIdx.x < 16) misc[threadIdx.x] = 0u;
    __syncthreads();
    { LOAD_ARGS(); (void)xcd_barrier_post((unsigned*)(a.ws + WS_CTL) + CW_BAR, misc + 8); }
#ifndef SEAM_CG_MASK
#define SEAM_CG_MASK 0
#endif
#define SEAM(k) do { if (lo <= (k) && (k) + 1 < hi) { if ((SEAM_CG_MASK >> (k)) & 1) grid.sync(); else { LOAD_ARGS(); XcdBarrier xb_; xb_.bar = (unsigned*)(a.ws + WS_CTL) + CW_BAR; xb_.x = xb_xcc_id(); \
        xb_.st = (volatile LAS unsigned*)((LAS unsigned char*)lds + MISC_OFF) + 8; xcd_barrier(xb_); } } } while (0)
#else
    int lo, hi; { LOAD_ARGS(); lo = a.ph_lo; hi = a.ph_hi; }
#define SEAM(k) do { } while (0)
#endif
#define IN(k) (lo <= (k) && (k) < hi)
#ifndef DUP_PHASE
#define DUP_PHASE -1
#endif
    if (IN(0)) { LOAD_ARGS(); phase0(a, lds); if (DUP_PHASE == 0) { __syncthreads(); phase0(a, lds); } SEAM(0); }
    if (IN(1)) { LOAD_ARGS(); unsigned char* ws = a.ws;
        pg8::Gemm g{(const bf16_t*)(ws + WS_XN), (const bf16_t*)(ws + WS_WIN), T, NPROJ, DM}; pg8::StaticOrder S; S.init(T, NPROJ, (int)gridDim.x, (int)blockIdx.x);
        pg8::EpiInProj E{(bf16_t*)(ws + WS_SEC), (const float*)(ws + WS_SXN), (const float*)(ws + WS_WSC), a.in[4], a.in[5], (LAS float*)((LAS unsigned char*)lds + RING_BYTES)};
        for (int rep_ = 0; rep_ < (DUP_PHASE == 1 ? 2 : 1); ++rep_)
        pg8::gemm_phase<pg8::EpiInProj, pg8::StaticOrder, true, true, true>((LAS unsigned char*)lds, g, S, E);
        cumsum_rows(a);
        { const int nwg_ = (T / 256) * (NPROJ / 256), G_ = (int)gridDim.x, rem_ = nwg_ % G_;
          if (rem_ > 0 && (int)blockIdx.x >= rem_) convert_tables(a, TAB_SPLIT, 2 * NEXP, ((int)blockIdx.x - rem_) * NWAVES + (tid_opaque() >> 6), (G_ - rem_) * NWAVES);
          else if (rem_ == 0) convert_tables(a, TAB_SPLIT, 2 * NEXP, (int)blockIdx.x * NWAVES + (tid_opaque() >> 6), G_ * NWAVES); }
        SEAM(1);
    }
    if (IN(3)) { LOAD_ARGS(); phase_attn(a, lds);
#if MK_ONE_LAUNCH
        if (DUP_PHASE == 3) { XcdBarrier xb_; xb_.bar = (unsigned*)(a.ws + WS_CTL) + CW_BAR; xb_.x = xb_xcc_id(); xb_.st = (volatile LAS unsigned*)((LAS unsigned char*)lds + MISC_OFF) + 8;
            xcd_barrier(xb_); if (blockIdx.x == 0 && threadIdx.x == 0) __hip_atomic_store((unsigned*)(a.ws + WS_CTL), 0u, __ATOMIC_RELAXED, __HIP_MEMORY_SCOPE_AGENT); xcd_barrier(xb_); phase_attn(a, lds); }
#endif
        SEAM(3); }
    if (IN(4)) { LOAD_ARGS(); phase_attn_combine(a); SEAM(4); }
    if (IN(5)) { LOAD_ARGS(); unsigned char* ws = a.ws;
        pg8::Gemm g{(const bf16_t*)(ws + WS_MIX), (const bf16_t*)(ws + WS_WOUT), T, DM, DM}; pg8::StaticOrder S; S.init(T, DM, (int)gridDim.x, (int)blockIdx.x);
        pg8::EpiOutProj E{a.in[0], a.out, (bf16_t*)(ws + WS_HB), (float*)(ws + WS_SSQ), (float*)(ws + WS_AMX)};
        for (int rep_ = 0; rep_ < (DUP_PHASE == 5 ? 2 : 1); ++rep_)
        pg8::gemm_phase<pg8::EpiOutProj, pg8::StaticOrder, true, true>((LAS unsigned char*)lds, g, S, E);
        SEAM(5);
    }
    if (IN(6)) { LOAD_ARGS(); unsigned char* ws = a.ws;
        pg8::Gemm g{(const bf16_t*)(ws + WS_HB), (const bf16_t*)(ws + WS_WPQ), T, DM, DM}; pg8::StaticOrder S; S.init(T, DM, (int)gridDim.x, (int)blockIdx.x);
        pg8::EpiPeerQFused E{(const float*)(ws + WS_SSQ), ws};
        pg8::gemm_phase<pg8::EpiPeerQFused, pg8::StaticOrder, true, true>((LAS unsigned char*)lds, g, S, E);
        SEAM(6);
    }
    if (IN(8)) { LOAD_ARGS(); for (int rep_ = 0; rep_ < (DUP_PHASE == 8 ? 2 : 1); ++rep_) phase_peer_u(a); SEAM(8); }
    if (IN(9)) { LOAD_ARGS(); for (int rep_ = 0; rep_ < (DUP_PHASE == 9 ? 2 : 1); ++rep_) phase_peer_w(a); SEAM(9); }
    if (IN(10)) { LOAD_ARGS(); for (int rep_ = 0; rep_ < (DUP_PHASE == 10 ? 2 : 1); ++rep_) phase_peer_v(a, (DUP_PHASE == 10 && rep_ == 0) ? (float*)(a.ws + WS_END) : a.out); }
#undef IN
#undef SEAM
}

extern "C" void kernel_launch(void* const* d_in, const int* in_sizes, int n_in, void* d_out, int out_size, void* d_ws, size_t ws_size, hipStream_t stream) {
    static int grid = 0;
    if (grid == 0) {
        if (n_in != 12 || in_sizes[0] != T * DM || out_size != T * DM || ws_size < WS_END) { fprintf(stderr, "kernel_launch: unexpected shapes (n_in %d, in0 %d, out %d, ws %zu)\n", n_in, n_in > 0 ? in_sizes[0] : -1, out_size, ws_size); grid = -1; return; }
        int dev = 0, cus = 0, per_cu = 0;
        if (hipGetDevice(&dev) != hipSuccess || hipDeviceGetAttribute(&cus, hipDeviceAttributeMultiprocessorCount, dev) != hipSuccess) { grid = -1; return; }
        if (hipFuncSetAttribute((const void*)fwd_kernel, hipFuncAttributeMaxDynamicSharedMemorySize, LDS_BYTES) != hipSuccess) { fprintf(stderr, "kernel_launch: hipFuncSetAttribute failed\n"); grid = -1; return; }
        if (hipOccupancyMaxActiveBlocksPerMultiprocessor(&per_cu, (const void*)fwd_kernel, NTHREADS, LDS_BYTES) != hipSuccess || per_cu < 1) { fprintf(stderr, "kernel_launch: occupancy query says %d\n", per_cu); grid = -1; return; }
        grid = cus;
    }
    if (grid < 0) return;
    (void)hipMemsetAsync((char*)d_ws + WS_CTL, 0, CTL_BYTES, stream);
    Args a{};
    for (int i = 0; i < 12; ++i) a.in[i] = (const float*)d_in[i];
    a.out = (float*)d_out; a.ws = (unsigned char*)d_ws;
#if MK_ONE_LAUNCH
    a.ph_lo = 0; a.ph_hi = NPHASE;
    void* args[] = {&a};
#if MK_COOP_LAUNCH
    hipError_t e = hipLaunchCooperativeKernel((const void*)fwd_kernel, dim3(grid), dim3(NTHREADS), args, LDS_BYTES, stream);
    if (e != hipSuccess) fprintf(stderr, "cooperative launch failed: %s (grid %d)\n", hipGetErrorString(e), grid);
#else
    (void)args; hipLaunchKernelGGL(fwd_kernel, dim3(grid), dim3(NTHREADS), LDS_BYTES, stream, a);
#endif
#else
    for (int p = 0; p < NPHASE; ++p) { a.ph_lo = p; a.ph_hi = p + 1; hipLaunchKernelGGL(fwd_kernel, dim3(grid), dim3(NTHREADS), LDS_BYTES, stream, a); }
#endif
}
```

```cpp
#include <hip/hip_runtime.h>
#include <hip/hip_cooperative_groups.h>
#include <cstdio>
#include <cstdint>
namespace cg = cooperative_groups;

#ifndef MK_COOP_LAUNCH
#define MK_COOP_LAUNCH 0
#endif
#ifndef MK_ONE_LAUNCH
#define MK_ONE_LAUNCH 1
#endif

#define LAS __attribute__((address_space(3)))
typedef unsigned short bf16_t;
typedef short bf16x8 __attribute__((ext_vector_type(8)));
typedef short s16x4 __attribute__((ext_vector_type(4)));
typedef float f32x2 __attribute__((ext_vector_type(2)));
typedef float f32x4 __attribute__((ext_vector_type(4)));
typedef float f32x16 __attribute__((ext_vector_type(16)));
typedef unsigned u32x2 __attribute__((ext_vector_type(2)));
typedef unsigned u32x4 __attribute__((ext_vector_type(4)));
typedef __bf16 bf16x2_t __attribute__((ext_vector_type(2)));

constexpr int NB = 2, SEQ = 4096, T = NB * SEQ, DM = 2048, HD = 128, NHF = 8, DIN = 7176, NPROJ = 7168;
constexpr int NEXP = 16384, NE = 128;
constexpr float EPS = 1e-6f;
constexpr float SCALE = 0.08838834764831845f, LOG2E = 1.4426950408889634f;
constexpr int NWAVES = 8, NTHREADS = 512;

constexpr size_t MiB = 1u << 20;
constexpr size_t WS_CTL = 0, CTL_BYTES = 32768;
constexpr int CW_BAR = 1024;
constexpr size_t WS_SXN = 64 * MiB  , WS_WSC = 45 * MiB + 800 * 1024  ;
constexpr int CW_WMAX = 64;
constexpr size_t WS_GQK = 45 * MiB + 768 * 1024;
constexpr size_t WS_WIN = 1 * MiB, WS_WOUT = 29 * MiB, WS_WPQ = 37 * MiB, WS_SK = 45 * MiB, WS_LOGF = 46 * MiB, WS_C = 46 * MiB + 512 * 1024, WS_SSQ = 47 * MiB;
constexpr size_t WS_XN = 48 * MiB;
constexpr size_t WS_SEC = 80 * MiB;
constexpr size_t SEC_ELEMS = 8u << 20;
constexpr size_t WS_MIX = 192 * MiB, WS_HB = 224 * MiB, WS_QP = 256 * MiB, WS_IDX = 288 * MiB, WS_GW = 292 * MiB, WS_U8 = 296 * MiB, WS_V8 = 328 * MiB, WS_SUV = 360 * MiB  , WS_RT = 360 * MiB + 256 * 1024  , WS_W = 361 * MiB  ,
                 WS_PART = 368 * MiB  , WS_XQ = 432 * MiB  , WS_END = 448 * MiB;
constexpr size_t WS_IDX16 = 366 * MiB  ;
constexpr size_t WS_AMX = 365 * MiB  , WS_SX = WS_RT + 64 * 1024  , WS_WQ = WS_W  , WS_SW = WS_W + 2 * MiB  ;
constexpr size_t WS_PO = WS_PART  , WS_PML = WS_PART + 32 * MiB  ;

constexpr int RING_BYTES = 131072;
constexpr int MISC_OFF = 143360;
constexpr int LDS_BYTES = 147456;

__device__ __forceinline__ unsigned cvt_pk_bf16(float lo, float hi) { unsigned r; asm volatile("v_cvt_pk_bf16_f32 %0, %1, %2" : "=v"(r) : "v"(lo), "v"(hi)); return r; }
__device__ __forceinline__ float bf_lo(unsigned u) { return __builtin_bit_cast(float, u << 16); }
__device__ __forceinline__ float bf_hi(unsigned u) { return __builtin_bit_cast(float, u & 0xffff0000u); }
__device__ __forceinline__ int lane_id_fresh() { int l = (int)__builtin_amdgcn_mbcnt_hi(~0u, __builtin_amdgcn_mbcnt_lo(~0u, 0u)); asm volatile("" : "+v"(l)); return l; }
__device__ __forceinline__ int sx_i(int v, int m) { return __builtin_amdgcn_ds_bpermute((lane_id_fresh() ^ m) << 2, v); }
__device__ __forceinline__ float sx_f(float v, int m) { return __int_as_float(__builtin_amdgcn_ds_bpermute((lane_id_fresh() ^ m) << 2, __float_as_int(v))); }
__device__ __forceinline__ int sh_i(int v, int src) { return __builtin_amdgcn_ds_bpermute(src << 2, v); }
__device__ __forceinline__ float sh_f(float v, int src) { return __int_as_float(__builtin_amdgcn_ds_bpermute(src << 2, __float_as_int(v))); }
__device__ __forceinline__ float shup_f(float v, int d) { const int l = lane_id_fresh(); const int s = l - d; return __int_as_float(__builtin_amdgcn_ds_bpermute((s < 0 ? l : s) << 2, __float_as_int(v))); }
__device__ __forceinline__ float wave_sum(float v) {
    v += __int_as_float(__builtin_amdgcn_update_dpp(0, __float_as_int(v), 0xB1, 0xf, 0xf, true));
    v += __int_as_float(__builtin_amdgcn_update_dpp(0, __float_as_int(v), 0x4E, 0xf, 0xf, true));
    v += __int_as_float(__builtin_amdgcn_update_dpp(0, __float_as_int(v), 0x141, 0xf, 0xf, true));
    v += __int_as_float(__builtin_amdgcn_update_dpp(0, __float_as_int(v), 0x140, 0xf, 0xf, true));
    { auto rr = __builtin_amdgcn_permlane16_swap(__float_as_uint(v), __float_as_uint(v), false, false); v = __uint_as_float(rr[0]) + __uint_as_float(rr[1]); }
    { auto rr = __builtin_amdgcn_permlane32_swap(__float_as_uint(v), __float_as_uint(v), false, false); v = __uint_as_float(rr[0]) + __uint_as_float(rr[1]); }
    return v;
}
#define DPP_QX1 0xB1
#define DPP_QX2 0x4E
#define DPP_HMIR 0x141
#define DPP_MIR 0x140
__device__ __forceinline__ float wave_max(float v) {
    v = fmaxf(v, __int_as_float(__builtin_amdgcn_update_dpp(0, __float_as_int(v), DPP_QX1, 0xf, 0xf, true)));
    v = fmaxf(v, __int_as_float(__builtin_amdgcn_update_dpp(0, __float_as_int(v), DPP_QX2, 0xf, 0xf, true)));
    v = fmaxf(v, __int_as_float(__builtin_amdgcn_update_dpp(0, __float_as_int(v), DPP_HMIR, 0xf, 0xf, true)));
    v = fmaxf(v, __int_as_float(__builtin_amdgcn_update_dpp(0, __float_as_int(v), DPP_MIR, 0xf, 0xf, true)));
    { auto rr = __builtin_amdgcn_permlane16_swap(__float_as_uint(v), __float_as_uint(v), false, false); v = fmaxf(__uint_as_float(rr[0]), __uint_as_float(rr[1])); }
    { auto rr = __builtin_amdgcn_permlane32_swap(__float_as_uint(v), __float_as_uint(v), false, false); v = fmaxf(__uint_as_float(rr[0]), __uint_as_float(rr[1])); }
    return v;
}
__device__ __forceinline__ int tid_opaque() { int t = (int)threadIdx.x; asm volatile("" : "+v"(t)); return t; }
#define LDS_WAIT() asm volatile("s_waitcnt lgkmcnt(0)" ::: "memory")

namespace pg8 {
#define PG8_LAS __attribute__((address_space(3)))
constexpr int BM = 256, BK = 64, HALF = 128, HTB = HALF * BK * 2, STAGE_BYTES = 8 * HTB, NXCD = 8, WGM = 8;
__host__ __device__ __forceinline__ int lds_byte(int r, int c) { const int st = (r >> 4) * 2 + (c >> 5), rr = r & 15, cc = c & 31, ob = rr * 64 + cc * 2; return st * 1024 + (ob ^ (((ob >> 9) & 1) << 5)); }
__host__ __device__ __forceinline__ void stage_rc(int b, int& R, int& C) { const int st = b / 1024, sb = b % 1024, swz = sb ^ (((sb >> 9) & 1) << 5); R = (st >> 1) * 16 + swz / 64; C = (st & 1) * 32 + (swz % 64) / 2; }
__host__ __device__ __forceinline__ int perm32(int rho) { const int n = rho >> 4, i = rho & 15; return 8 * (i >> 2) + 4 * n + (i & 3); }
struct Unit { int pm, pn; };
struct Gemm { const bf16_t* A; const bf16_t* Bt; int M, N, K; };
struct StaticOrder {
    int nM, nN, nwg, G, c;
    __host__ __device__ void init(int M, int N, int G_, int c_) { nM = M / BM; nN = N / BM; nwg = nM * nN; G = G_; c = c_; }
    __host__ __device__ bool next(int i, Unit& u) const {
        const long L = (long)i * G + c; if (L >= nwg) return false;
        int wgid = (int)L; { const int q = nwg / NXCD, r = nwg % NXCD, xcd = wgid % NXCD, off = wgid / NXCD; wgid = (xcd < r ? xcd * (q + 1) : r * (q + 1) + (xcd - r) * q) + off; }
        const int nig = WGM * nN, gid = wgid / nig, fm = gid * WGM, gsz = (nM - fm) < WGM ? (nM - fm) : WGM;
        u.pm = fm + ((wgid % nig) % gsz); u.pn = (wgid % nig) / gsz; return true;
    }
    __device__ __forceinline__ void a_ready(const Unit&) const {}
    __device__ __forceinline__ void done(const Unit&) const {}
};

typedef int i32x4 __attribute__((ext_vector_type(4)));
template <bool I8> struct AccT { typedef f32x4 type; };
template <> struct AccT<true> { typedef i32x4 type; };
template <class Epi, class Sched, bool ALIGN_EPI = false, bool SP2 = false, bool I8 = false>
__device__ __forceinline__ void gemm_phase(PG8_LAS unsigned char* lds, const Gemm g, const Sched& S, const Epi& E) {
    typedef typename AccT<I8>::type acc_t;
    const int tid = tid_opaque(), wid = __builtin_amdgcn_readfirstlane(tid >> 6), lane = tid & 63, wr = wid >> 2, wc = wid & 3, fr = lane & 15, fq = lane >> 4;
    const int rowb = I8 ? g.K : 2 * g.K, nt = rowb / (BK * 2);
    unsigned voffA[2], voffB[2];
#pragma unroll
    for (int i = 0; i < 2; ++i) { int R, C; stage_rc(tid * 16 + i * 8192, R, C); const int Rb = Epi::PERM ? ((R & ~31) + perm32(R & 31)) : R;
        voffA[i] = (unsigned)(R * rowb + C * 2); voffB[i] = (unsigned)(Rb * rowb + C * 2); }
    const size_t kstep = (size_t)(BK * 2);
    const size_t hstep = (size_t)HALF * rowb;
    const size_t tstep = 2 * hstep;
    const unsigned ldsw = (unsigned)wid * 1024u;
    const int aoff = lds_byte(wr * 64 + fr, fq * 8), boff = lds_byte(wc * 32 + fr, fq * 8);
#define PG8_SA(b, h) (((b) * 2 + (h)) * HTB)
#define PG8_SB(b, h) ((4 + (b) * 2 + (h)) * HTB)
#define PG8_STAGE(bufoff, gbase, voff) do { _Pragma("unroll") for (int _i = 0; _i < 2; ++_i) \
        __builtin_amdgcn_global_load_lds((const unsigned*)((const char*)(gbase) + (voff)[_i]), (PG8_LAS unsigned*)(lds + (bufoff) + ldsw + _i * 8192), 16, 0, 0); } while (0)
#define PG8_LDA(dst, b, h) do { _Pragma("unroll") for (int m = 0; m < 4; ++m) _Pragma("unroll") for (int k = 0; k < 2; ++k) dst[m][k] = *(const PG8_LAS bf16x8*)(lds + PG8_SA(b, h) + aoff + m * 2048 + k * 1024); } while (0)
#define PG8_LDB(dst, b, h) do { _Pragma("unroll") for (int n = 0; n < 2; ++n) _Pragma("unroll") for (int k = 0; k < 2; ++k) dst[n][k] = *(const PG8_LAS bf16x8*)(lds + PG8_SB(b, h) + boff + n * 2048 + k * 1024); } while (0)
#define PG8_MMA(ai, bj, At, Bt) do { __builtin_amdgcn_s_setprio(1); _Pragma("unroll") for (int m = 0; m < 4; ++m) _Pragma("unroll") for (int n = 0; n < 2; ++n) _Pragma("unroll") for (int k = 0; k < 2; ++k) \
        { if constexpr (I8) acc[ai][bj][m][n] = __builtin_amdgcn_mfma_i32_16x16x64_i8(__builtin_bit_cast(i32x4, Bt[n][k]), __builtin_bit_cast(i32x4, At[m][k]), acc[ai][bj][m][n], 0, 0, 0); \
          else acc[ai][bj][m][n] = __builtin_amdgcn_mfma_f32_16x16x32_bf16(Bt[n][k], At[m][k], acc[ai][bj][m][n], 0, 0, 0); } __builtin_amdgcn_s_setprio(0); } while (0)
#define PG8_WAIT_V(n) asm volatile("s_waitcnt vmcnt(" #n ")" ::: "memory")
#define PG8_WAIT_L(n) asm volatile("s_waitcnt lgkmcnt(" #n ")" ::: "memory")
#define PG8_BAR __builtin_amdgcn_s_barrier()
#define PG8_SCHED __builtin_amdgcn_sched_barrier(0)
    Unit cur, nxt; int ui = 0;
    if (!S.next(0, cur)) return;
    acc_t acc[2][2][4][2];
#pragma unroll
    for (int a = 0; a < 2; ++a)
#pragma unroll
        for (int b = 0; b < 2; ++b)
#pragma unroll
            for (int m = 0; m < 4; ++m)
#pragma unroll
                for (int n = 0; n < 2; ++n) acc[a][b][m][n] = acc_t{};
    bf16x8 At[4][2], B0[2][2], B1[2][2];
    const char* cA = (const char*)g.A + (size_t)cur.pm * tstep; const char* cB = (const char*)g.Bt + (size_t)cur.pn * tstep;
    S.a_ready(cur);
    if constexpr (SP2) {
        PG8_STAGE(PG8_SB(0, 0), cB, voffB); PG8_STAGE(PG8_SB(0, 1), cB + hstep, voffB); PG8_STAGE(PG8_SA(0, 0), cA, voffA); PG8_STAGE(PG8_SA(0, 1), cA + hstep, voffA);
        if (wr == 1) PG8_BAR;
        PG8_WAIT_V(2); PG8_BAR;
        PG8_STAGE(PG8_SB(1, 0), cB + kstep, voffB); PG8_STAGE(PG8_SA(1, 0), cA + kstep, voffA); PG8_STAGE(PG8_SB(1, 1), cB + hstep + kstep, voffB);
        PG8_WAIT_V(6); PG8_BAR;
    } else {
        PG8_STAGE(PG8_SB(0, 0), cB, voffB); PG8_STAGE(PG8_SA(0, 0), cA, voffA); PG8_STAGE(PG8_SB(0, 1), cB + hstep, voffB); PG8_STAGE(PG8_SA(0, 1), cA + hstep, voffA);
        if (wr == 1) PG8_BAR;
        PG8_WAIT_V(4); PG8_BAR;
        PG8_STAGE(PG8_SB(1, 0), cB + kstep, voffB); PG8_STAGE(PG8_SA(1, 0), cA + kstep, voffA); PG8_STAGE(PG8_SB(1, 1), cB + hstep + kstep, voffB);
        PG8_WAIT_V(6); PG8_BAR;
    }
    for (;;) {
        const bool has_next = S.next(ui + 1, nxt);
        const char* nA = has_next ? (const char*)g.A + (size_t)nxt.pm * tstep : cA; const char* nB = has_next ? (const char*)g.Bt + (size_t)nxt.pn * tstep : cB;
        for (int t = 0; t < nt; t += 2) {
            const bool last = (t == nt - 2);
            const char* a1 = cA + (size_t)(t + 1) * kstep;
            const char* a2 = last ? nA : cA + (size_t)(t + 2) * kstep; const char* b2 = last ? nB : cB + (size_t)(t + 2) * kstep;
            const char* a3 = a2 + kstep; const char* b3 = b2 + kstep;
            if (last && has_next) S.a_ready(nxt);
            if constexpr (SP2) {
            PG8_LDB(B0, 0, 0); PG8_LDB(B1, 0, 1); PG8_SCHED; PG8_LDA(At, 0, 0); PG8_STAGE(PG8_SA(1, 1), a1 + hstep, voffA);
            PG8_WAIT_V(8); PG8_WAIT_L(0); PG8_BAR; PG8_MMA(0, 0, At, B0); PG8_MMA(0, 1, At, B1); PG8_BAR; PG8_SCHED;
            PG8_LDA(At, 0, 1); PG8_STAGE(PG8_SB(0, 0), b2, voffB); PG8_STAGE(PG8_SB(0, 1), b2 + hstep, voffB); PG8_STAGE(PG8_SA(0, 0), a2, voffA);
            PG8_WAIT_V(8); PG8_WAIT_L(0); PG8_BAR; PG8_MMA(1, 0, At, B0); PG8_MMA(1, 1, At, B1); PG8_BAR; PG8_SCHED;
            PG8_LDB(B0, 1, 0); PG8_LDB(B1, 1, 1); PG8_SCHED; PG8_LDA(At, 1, 0); PG8_STAGE(PG8_SA(0, 1), a2 + hstep, voffA);
            PG8_WAIT_V(8); PG8_WAIT_L(0); PG8_BAR; PG8_MMA(0, 0, At, B0); PG8_MMA(0, 1, At, B1); PG8_BAR; PG8_SCHED;
            PG8_LDA(At, 1, 1); PG8_STAGE(PG8_SB(1, 0), b3, voffB); PG8_STAGE(PG8_SB(1, 1), b3 + hstep, voffB); PG8_STAGE(PG8_SA(1, 0), a3, voffA);
            PG8_WAIT_V(8); PG8_WAIT_L(0); PG8_BAR; PG8_MMA(1, 0, At, B0); PG8_MMA(1, 1, At, B1); PG8_BAR; PG8_SCHED;
            } else {
            PG8_LDB(B0, 0, 0); PG8_SCHED; PG8_LDA(At, 0, 0); PG8_STAGE(PG8_SA(1, 1), a1 + hstep, voffA);
            PG8_WAIT_L(8); PG8_BAR; PG8_WAIT_L(0); PG8_MMA(0, 0, At, B0); PG8_BAR; PG8_SCHED;
            PG8_LDB(B1, 0, 1); PG8_STAGE(PG8_SB(0, 0), b2, voffB);
            PG8_BAR; PG8_WAIT_L(0); PG8_MMA(0, 1, At, B1); PG8_BAR;
            PG8_LDA(At, 0, 1); PG8_STAGE(PG8_SA(0, 0), a2, voffA);
            PG8_BAR; PG8_WAIT_L(0); PG8_MMA(1, 0, At, B0); PG8_BAR; PG8_SCHED;
            PG8_STAGE(PG8_SB(0, 1), b2 + hstep, voffB);
            PG8_WAIT_V(6); PG8_BAR; PG8_MMA(1, 1, At, B1); PG8_BAR;
            PG8_LDB(B0, 1, 0); PG8_SCHED; PG8_LDA(At, 1, 0); PG8_STAGE(PG8_SA(0, 1), a2 + hstep, voffA);
            PG8_WAIT_L(8); PG8_BAR; PG8_WAIT_L(0); PG8_MMA(0, 0, At, B0); PG8_BAR; PG8_SCHED;
            PG8_LDB(B1, 1, 1); PG8_STAGE(PG8_SB(1, 0), b3, voffB);
            PG8_BAR; PG8_WAIT_L(0); PG8_MMA(0, 1, At, B1); PG8_BAR;
            PG8_LDA(At, 1, 1); PG8_STAGE(PG8_SA(1, 0), a3, voffA);
            PG8_BAR; PG8_WAIT_L(0); PG8_MMA(1, 0, At, B0); PG8_BAR; PG8_SCHED;
            PG8_STAGE(PG8_SB(1, 1), b3 + hstep, voffB);
            PG8_WAIT_V(6); PG8_BAR; PG8_MMA(1, 1, At, B1); PG8_BAR;
            }
        }
        if constexpr (ALIGN_EPI) { if (wr == 0) PG8_BAR; }
        if constexpr (!Epi::AFTER_DRAIN) { E(acc, cur, wr, wc, fr, fq); } S.done(cur);
        if (!has_next) break;
#pragma unroll
        for (int a = 0; a < 2; ++a)
#pragma unroll
            for (int b = 0; b < 2; ++b)
#pragma unroll
                for (int m = 0; m < 4; ++m)
#pragma unroll
                    for (int n = 0; n < 2; ++n) acc[a][b][m][n] = acc_t{};
        cur = nxt; cA = nA; cB = nB; ++ui;
        if constexpr (ALIGN_EPI) { if (wr == 1) PG8_BAR; }
    }
    PG8_WAIT_V(0);
    if constexpr (!ALIGN_EPI) { if (wr == 0) PG8_BAR; }
    PG8_BAR;
    if constexpr (Epi::AFTER_DRAIN) E.fused(acc, cur, wr, wc, fr, fq, lds);
#undef PG8_SA
#undef PG8_SB
#undef PG8_STAGE
#undef PG8_LDA
#undef PG8_LDB
#undef PG8_MMA
#undef PG8_WAIT_V
#undef PG8_WAIT_L
#undef PG8_BAR
#undef PG8_SCHED
}

__device__ __forceinline__ float sigmoidf_fast(float x) { return __builtin_amdgcn_rcpf(1.f + __builtin_amdgcn_exp2f(-x * LOG2E)); }
struct EpiInProj {
    static constexpr bool PERM = true, AFTER_DRAIN = false;
    bf16_t* base; const float* sxn  ; const float* wsc  ;
    const float* gq; const float* gk; PG8_LAS float* xch  ;
    __device__ __forceinline__ void operator()(const i32x4 (&acci)[2][2][4][2], const Unit& u, int wr, int wc, int fr, int fq) const {
        const int sec = u.pn >> 2; const float wsv = *wsc;
        float rsv[2][4];
#pragma unroll
        for (int ai = 0; ai < 2; ++ai)
#pragma unroll
            for (int m = 0; m < 4; ++m) rsv[ai][m] = sxn[u.pm * BM + ai * HALF + wr * 64 + m * 16 + fr];
#pragma unroll
        for (int ai = 0; ai < 2; ++ai)
#pragma unroll
            for (int m = 0; m < 4; ++m) rsv[ai][m] *= wsv;
        bf16_t* sb = base + (size_t)sec * SEC_ELEMS;
        const float sc = (sec == 4) ? SCALE * LOG2E : 1.f;
        if (sec < 2) {
#pragma unroll
            for (int ai = 0; ai < 2; ++ai)
#pragma unroll
                for (int m = 0; m < 4; ++m) {
                    const int tk = u.pm * BM + ai * HALF + wr * 64 + m * 16 + fr;
                    const float rs = rsv[ai][m];
#pragma unroll
                    for (int bj = 0; bj < 2; ++bj) {
                        const f32x4 v0 = __builtin_convertvector(acci[ai][bj][m][0], f32x4) * rs, v1 = __builtin_convertvector(acci[ai][bj][m][1], f32x4) * rs;
                        float ss = v0[0] * v0[0] + v0[1] * v0[1] + v0[2] * v0[2] + v0[3] * v0[3] + v1[0] * v1[0] + v1[1] * v1[1] + v1[2] * v1[2] + v1[3] * v1[3];
                        ss += sx_f(ss, 16); ss += sx_f(ss, 32);
                        if (fq == 0) xch[(((((wr * 2 + ai) * 4 + m) * 16 + fr) * 2 + bj) * 4) + wc] = ss;
                    }
                }
            asm volatile("s_waitcnt lgkmcnt(0)" ::: "memory");
            __builtin_amdgcn_s_barrier();
            const float* gp = (sec == 0 ? gq : gk) + wc * 32 + 8 * fq;
            const f32x4 g0 = *(const f32x4*)gp, g1 = *(const f32x4*)(gp + 4);
#pragma unroll
            for (int ai = 0; ai < 2; ++ai)
#pragma unroll
                for (int m = 0; m < 4; ++m) {
                    const int tk = u.pm * BM + ai * HALF + wr * 64 + m * 16 + fr, b = tk >> 12, s = tk & 4095;
                    const float rs = rsv[ai][m];
#pragma unroll
                    for (int bj = 0; bj < 2; ++bj) {
                        const int hh = (u.pn & 3) * 2 + bj;
                        const f32x4 p4 = *(const PG8_LAS f32x4*)(xch + (((((wr * 2 + ai) * 4 + m) * 16 + fr) * 2 + bj) * 4));
                        const float r = rs / sqrtf(((p4[0] + p4[1]) + (p4[2] + p4[3])) * (1.f / 128.f) + EPS);
                        const f32x4 v0 = __builtin_convertvector(acci[ai][bj][m][0], f32x4) * r * g0, v1 = __builtin_convertvector(acci[ai][bj][m][1], f32x4) * r * g1;
                        u32x4 w; w.x = cvt_pk_bf16(v0[0], v0[1]); w.y = cvt_pk_bf16(v0[2], v0[3]); w.z = cvt_pk_bf16(v1[0], v1[1]); w.w = cvt_pk_bf16(v1[2], v1[3]);
                        *(u32x4*)(sb + ((size_t)((b * 8 + hh) * 4096 + s)) * 128 + wc * 32 + 8 * fq) = w;
                    }
                }
            return;
        }
#pragma unroll
        for (int ai = 0; ai < 2; ++ai)
#pragma unroll
            for (int m = 0; m < 4; ++m) {
                const int tk = u.pm * BM + ai * HALF + wr * 64 + m * 16 + fr, b = tk >> 12, s = tk & 4095;
                const float rs = rsv[ai][m];
#pragma unroll
                for (int bj = 0; bj < 2; ++bj) {
                    const int hh = (u.pn & 3) * 2 + bj;
                    f32x4 v0 = __builtin_convertvector(acci[ai][bj][m][0], f32x4) * rs, v1 = __builtin_convertvector(acci[ai][bj][m][1], f32x4) * rs;
                    bf16_t* dst;
                    if (sec == 3) {
#pragma unroll
                        for (int i = 0; i < 4; ++i) { v0[i] = sigmoidf_fast(v0[i]); v1[i] = sigmoidf_fast(v1[i]); }
                        dst = sb + (size_t)tk * 1024 + hh * 128 + wc * 32 + 8 * fq;
                    } else {
                        v0 = v0 * sc; v1 = v1 * sc;
                        dst = sb + ((size_t)((b * 8 + hh) * 4096 + s)) * 128 + wc * 32 + 8 * fq;
                    }
                    u32x4 w; w.x = cvt_pk_bf16(v0[0], v0[1]); w.y = cvt_pk_bf16(v0[2], v0[3]); w.z = cvt_pk_bf16(v1[0], v1[1]); w.w = cvt_pk_bf16(v1[2], v1[3]);
                    *(u32x4*)dst = w;
                }
            }
    }
};
struct EpiOutProj {
    static constexpr bool PERM = true, AFTER_DRAIN = false;
    const float* x; float* h; bf16_t* hb; float* ssq; float* amx;
    __device__ __forceinline__ void operator()(const f32x4 (&acc)[2][2][4][2], const Unit& u, int wr, int wc, int fr, int fq) const {
#pragma unroll
        for (int ai = 0; ai < 2; ++ai) {
            f32x4 xv[4][2][2];
#pragma unroll
            for (int m = 0; m < 4; ++m)
#pragma unroll
                for (int bj = 0; bj < 2; ++bj) { const size_t off = (size_t)(u.pm * BM + ai * HALF + wr * 64 + m * 16 + fr) * DM + u.pn * BM + bj * HALF + wc * 32 + 8 * fq;
                    xv[m][bj][0] = *(const f32x4*)(x + off); xv[m][bj][1] = *(const f32x4*)(x + off + 4); }
#pragma unroll
            for (int m = 0; m < 4; ++m) {
                const int tk = u.pm * BM + ai * HALF + wr * 64 + m * 16 + fr;
                float ss = 0.f, mx = 0.f;
#pragma unroll
                for (int bj = 0; bj < 2; ++bj) {
                    const size_t off = (size_t)tk * DM + u.pn * BM + bj * HALF + wc * 32 + 8 * fq;
                    const f32x4 v0 = acc[ai][bj][m][0] + xv[m][bj][0], v1 = acc[ai][bj][m][1] + xv[m][bj][1];
                    u32x4 w; w.x = cvt_pk_bf16(v0[0], v0[1]); w.y = cvt_pk_bf16(v0[2], v0[3]); w.z = cvt_pk_bf16(v1[0], v1[1]); w.w = cvt_pk_bf16(v1[2], v1[3]);
                    *(u32x4*)(hb + off) = w;
                    ss += v0[0] * v0[0] + v0[1] * v0[1] + v0[2] * v0[2] + v0[3] * v0[3] + v1[0] * v1[0] + v1[1] * v1[1] + v1[2] * v1[2] + v1[3] * v1[3];
                    mx = fmaxf(mx, fmaxf(fmaxf(fmaxf(fabsf(v0[0]), fabsf(v0[1])), fmaxf(fabsf(v0[2]), fabsf(v0[3]))), fmaxf(fmaxf(fabsf(v1[0]), fabsf(v1[1])), fmaxf(fabsf(v1[2]), fabsf(v1[3])))));
                }
                ss += sx_f(ss, 16); ss += sx_f(ss, 32);
                mx = fmaxf(mx, sx_f(mx, 16)); mx = fmaxf(mx, sx_f(mx, 32));
                if (fq == 0) { ssq[(size_t)tk * 32 + u.pn * 4 + wc] = ss; amx[(size_t)tk * 32 + u.pn * 4 + wc] = mx; }
            }
        }
    }
};
struct EpiPeerQ {
    static constexpr bool PERM = true, AFTER_DRAIN = false;
    const float* ssq; bf16_t* qp; float* rtab;
    __device__ __forceinline__ void operator()(const f32x4 (&acc)[2][2][4][2], const Unit& u, int wr, int wc, int fr, int fq) const {
#pragma unroll
        for (int ai = 0; ai < 2; ++ai)
#pragma unroll
            for (int m = 0; m < 4; ++m) {
                const int tk = u.pm * BM + ai * HALF + wr * 64 + m * 16 + fr;
                float tot = 0.f;
#pragma unroll
                for (int i = 0; i < 8; ++i) { const f32x4 s4 = *(const f32x4*)(ssq + (size_t)tk * 32 + 4 * i); tot += (s4[0] + s4[1]) + (s4[2] + s4[3]); }
                const float r = 1.0f / sqrtf(tot * (1.f / DM) + EPS);
                if (u.pn == 0 && wc == 0 && fq == 0) rtab[tk] = r;
#pragma unroll
                for (int bj = 0; bj < 2; ++bj) {
                    const size_t off = (size_t)tk * DM + u.pn * BM + bj * HALF + wc * 32 + 8 * fq;
                    const f32x4 v0 = acc[ai][bj][m][0] * r, v1 = acc[ai][bj][m][1] * r;
                    u32x4 w; w.x = cvt_pk_bf16(v0[0], v0[1]); w.y = cvt_pk_bf16(v0[2], v0[3]); w.z = cvt_pk_bf16(v1[0], v1[1]); w.w = cvt_pk_bf16(v1[2], v1[3]);
                    *(u32x4*)(qp + off) = w;
                }
            }
    }
};
struct EpiPeerQFused {
    static constexpr bool PERM = true, AFTER_DRAIN = true;
    const float* ssq; unsigned char* wsb;
    __device__ __forceinline__ void operator()(const f32x4 (&)[2][2][4][2], const Unit&, int, int, int, int) const {}
    __device__ __forceinline__ void fused(const f32x4 (&acc)[2][2][4][2], const Unit& u, int wr, int wc, int fr, int fq, PG8_LAS unsigned char* lds) const;
};
}

namespace att {
constexpr int NW = 8, QBLK = 32, KVBLK = 64, QB = NW * QBLK, D = 128;
constexpr int SHM_V = KVBLK * D * 2, SHM_K = KVBLK * D * 2;
constexpr int OFF_WS = 2 * SHM_V + 2 * SHM_K, OFF_BIAS = OFF_WS + NW * 64 * 4, ATT_LDS = OFF_BIAS + SEQ * 4;
#define KSWZ(row, colB) ((row) * 256 + ((colB) ^ (((row) & 7) << 4)))
#define SBAR() __builtin_amdgcn_sched_barrier(0)
__device__ __forceinline__ int v_st(int k, int c) { const int kk = (k & ~0xC) | ((k & 4) << 1) | ((k & 8) >> 1); return ((kk >> 3) * 4 + (c >> 5)) * 512 + ((kk & 7) * 32 + (c & 31)) * 2; }
__device__ __forceinline__ int v_rd_base(int lane) { return ((lane & 3) << 3) | (((lane >> 2) & 3) << 6) | (((lane >> 4) & 1) << 5) | (((lane >> 5) & 1) << 8); }
constexpr int v_rd_off(int d0, int ks, int half) { return d0 * 512 + ks * 4096 + half * 2048; }
__device__ __forceinline__ int crow(int r, int hi) { return (r & 3) + 8 * (r >> 2) + 4 * hi; }
__device__ __forceinline__ bf16x8 load8(const bf16_t* p) { return *reinterpret_cast<const bf16x8*>(p); }
__device__ __forceinline__ void mask_tile(f32x16& p0, f32x16& p1, int dq) {
    const float NEG = -__builtin_inff();
#pragma unroll
    for (int r = 0; r < 16; ++r) {
        const int c = (r & 3) + 8 * (r >> 2);
        if (dq - c < 0) p0[r] = NEG;
        if (dq - c - 32 < 0) p1[r] = NEG;
    }
}
__device__ __forceinline__ void partialSM(f32x16& p0, f32x16& p1, float& m_reg, float& mn, float& alpha) {
    float pmax = p0[0];
#pragma unroll
    for (int r = 1; r < 16; ++r) pmax = fmaxf(pmax, p0[r]);
#pragma unroll
    for (int r = 0; r < 16; ++r) pmax = fmaxf(pmax, p1[r]);
    { auto rr = __builtin_amdgcn_permlane32_swap(__float_as_uint(pmax), __float_as_uint(pmax), false, false);
      pmax = fmaxf(__uint_as_float(rr[0]), __uint_as_float(rr[1])); }
    constexpr float C2 = LOG2E * SCALE; constexpr float THR = 8.f;
    if (__builtin_expect(__all((pmax - m_reg) * SCALE <= THR), 1)) { mn = m_reg; alpha = 1.f; }
    else { mn = fmaxf(m_reg, pmax); alpha = __builtin_amdgcn_exp2f((m_reg - mn) * C2); m_reg = mn; }
    const float mnL = -mn * C2;
#pragma unroll
    for (int r = 0; r < 16; ++r) p0[r] = fmaf(p0[r], C2, mnL);
#pragma unroll
    for (int r = 0; r < 16; ++r) p1[r] = fmaf(p1[r], C2, mnL);
#pragma unroll
    for (int r = 0; r < 16; ++r) p0[r] = __builtin_amdgcn_exp2f(p0[r]);
}
#define PK4(P, B_, OUT) do { unsigned a0 = cvt_pk_bf16(P[B_+0], P[B_+1]), a1 = cvt_pk_bf16(P[B_+2], P[B_+3]);                          \
        unsigned b0 = cvt_pk_bf16(P[B_+4], P[B_+5]), b1 = cvt_pk_bf16(P[B_+6], P[B_+7]);                                             \
        auto r0 = __builtin_amdgcn_permlane32_swap(a0, b0, false, false); auto r1 = __builtin_amdgcn_permlane32_swap(a1, b1, false, false); \
        u32x4 w = {r0[0], r1[0], r0[1], r1[1]}; OUT = *reinterpret_cast<bf16x8*>(&w); } while (0)
__device__ __forceinline__ void finishSM(f32x16& p0, f32x16& p1, float alpha, float& l_reg, bf16x8& pa0, bf16x8& pa1, bf16x8& pa2, bf16x8& pa3) {
#pragma unroll
    for (int r = 0; r < 16; ++r) p1[r] = __builtin_amdgcn_exp2f(p1[r]);
    float ps = 0;
#pragma unroll
    for (int r = 0; r < 16; ++r) ps += p0[r];
#pragma unroll
    for (int r = 0; r < 16; ++r) ps += p1[r];
    { auto rr = __builtin_amdgcn_permlane32_swap(__float_as_uint(ps), __float_as_uint(ps), false, false);
      ps = __uint_as_float(rr[0]) + __uint_as_float(rr[1]); }
    l_reg = l_reg * alpha + ps;
    PK4(p0, 0, pa0); PK4(p0, 8, pa1); PK4(p1, 0, pa2); PK4(p1, 8, pa3);
}
__device__ __forceinline__ void sb_group(f32x16& P, int g, float& gs) {
    float run = 0.f;
#pragma unroll
    for (int k = 3; k >= 0; --k) {
        const float z = P[4 * g + k];
        const float t = __builtin_amdgcn_exp2f(-fabsf(z));
        const float l = __builtin_amdgcn_logf(1.f + t);
        const float sp = fmaxf(z, 0.f) + l;
        P[4 * g + k] = (z - sp) - run;
        run += sp;
    }
    gs = run;
}
__device__ __forceinline__ void sb_part1(f32x16& p0, f32x16& p1, float& carry, float mlo) {
    float gs[8];
#pragma unroll
    for (int g = 0; g < 4; ++g) sb_group(p0, g, gs[g]);
#pragma unroll
    for (int g = 0; g < 4; ++g) sb_group(p1, g, gs[4 + g]);
    float run = carry;
#pragma unroll
    for (int G = 7; G >= 0; --G) {
        auto rr = __builtin_amdgcn_permlane32_swap(__float_as_uint(gs[G]), __float_as_uint(gs[G]), false, false);
        const float slo = __uint_as_float(rr[0]), shi = __uint_as_float(rr[1]);
        const float base = fmaf(mlo, shi, run);
        if (G >= 4) {
#pragma unroll
            for (int k = 0; k < 4; ++k) p1[4 * (G - 4) + k] -= base;
        } else {
#pragma unroll
            for (int k = 0; k < 4; ++k) p0[4 * G + k] -= base;
        }
        run += slo + shi;
    }
    carry = run;
#pragma unroll
    for (int r = 0; r < 16; ++r) p0[r] = __builtin_amdgcn_exp2f(p0[r]);
}
__device__ __forceinline__ void sb_part2(f32x16& p0, f32x16& p1, bf16x8& pa0, bf16x8& pa1, bf16x8& pa2, bf16x8& pa3) {
#pragma unroll
    for (int r = 0; r < 16; ++r) p1[r] = __builtin_amdgcn_exp2f(p1[r]);
    PK4(p0, 0, pa0); PK4(p0, 8, pa1); PK4(p1, 0, pa2); PK4(p1, 8, pa3);
}
#undef PK4
template <int KB, bool BIAS>
__device__ __forceinline__ void qkt(f32x16& p0, f32x16& p1, const char* K_lds, int r32, int hi, const bf16x8* qr, const float* bt) {
    if constexpr (BIAS) {
#pragma unroll
        for (int g = 0; g < 4; ++g) { const f32x4 a = *(const f32x4*)(bt + 8 * g), b = *(const f32x4*)(bt + 32 + 8 * g);
            p0[4 * g] = a[0]; p0[4 * g + 1] = a[1]; p0[4 * g + 2] = a[2]; p0[4 * g + 3] = a[3];
            p1[4 * g] = b[0]; p1[4 * g + 1] = b[1]; p1[4 * g + 2] = b[2]; p1[4 * g + 3] = b[3]; }
    } else { p0 = f32x16{}; p1 = f32x16{}; }
    const char* kb[4];
#pragma unroll
    for (int dd = 0; dd < 4; ++dd) kb[dd] = K_lds + KB * SHM_K + KSWZ(r32, (dd * 16 + hi * 8) * 2);
#pragma unroll
    for (int d0 = 0; d0 < 8; ++d0) { const char* a = kb[d0 & 3] + (d0 >> 2) * 128;
        bf16x8 b0 = *reinterpret_cast<const bf16x8*>(a);
        bf16x8 b1 = *reinterpret_cast<const bf16x8*>(a + 32 * 256);
        p0 = __builtin_amdgcn_mfma_f32_32x32x16_bf16(b0, qr[d0], p0, 0, 0, 0);
        p1 = __builtin_amdgcn_mfma_f32_32x32x16_bf16(b1, qr[d0], p1, 0, 0, 0); }
}
template <int VB>
__device__ __forceinline__ void pv_tile(f32x16* o, int vb0, bf16x8 pa0, bf16x8 pa1, bf16x8 pa2, bf16x8 pa3) {
#define TRRD(dst, off) asm volatile("ds_read_b64_tr_b16 %0, %1 offset:%2" : "=&v"(dst) : "v"(vb0), "i"(off) : "memory")
#define PV_D0(d0) do { { s16x4 l0, l1, h0, h1; constexpr int b_ = VB * SHM_V + v_rd_off(d0, 0, 0); \
        TRRD(l0, b_); TRRD(h0, b_ + 2048); TRRD(l1, b_ + 4096); TRRD(h1, b_ + 6144); \
        asm volatile("s_waitcnt lgkmcnt(0)" ::: "memory"); SBAR();   \
        o[d0] = __builtin_amdgcn_mfma_f32_32x32x16_bf16(pa0, (bf16x8){l0[0], l0[1], l0[2], l0[3], h0[0], h0[1], h0[2], h0[3]}, o[d0], 0, 0, 0);   \
        o[d0] = __builtin_amdgcn_mfma_f32_32x32x16_bf16(pa1, (bf16x8){l1[0], l1[1], l1[2], l1[3], h1[0], h1[1], h1[2], h1[3]}, o[d0], 0, 0, 0); }  \
      { s16x4 l2, l3, h2, h3; constexpr int b_ = VB * SHM_V + v_rd_off(d0, 0, 0); \
        TRRD(l2, b_ + 8192); TRRD(h2, b_ + 10240); TRRD(l3, b_ + 12288); TRRD(h3, b_ + 14336); \
        asm volatile("s_waitcnt lgkmcnt(0)" ::: "memory"); SBAR();   \
        o[d0] = __builtin_amdgcn_mfma_f32_32x32x16_bf16(pa2, (bf16x8){l2[0], l2[1], l2[2], l2[3], h2[0], h2[1], h2[2], h2[3]}, o[d0], 0, 0, 0);   \
        o[d0] = __builtin_amdgcn_mfma_f32_32x32x16_bf16(pa3, (bf16x8){l3[0], l3[1], l3[2], l3[3], h3[0], h3[1], h3[2], h3[3]}, o[d0], 0, 0, 0); } } while (0)
    PV_D0(0); PV_D0(1); PV_D0(2); PV_D0(3);
#undef PV_D0
#undef TRRD
}

struct UnitRef { const bf16_t* Q; const bf16_t* K; const bf16_t* V; int P0; };
struct Seam { bf16x8 qr[8]; bf16x8 st_v0, st_v1, st_k0, st_k1; };
#define ROW(p, k0, rr) ((p) + (size_t)((k0) + (rr)) * D + sc)
#define VMW() asm volatile("s_waitcnt vmcnt(0)" ::: "memory")
#define SLOAD_H(Kp, Vp, k0) do { S.st_v0 = load8(ROW(Vp, k0, sr)); S.st_v1 = load8(ROW(Vp, k0, 32 + sr));              \
                         S.st_k0 = load8(ROW(Kp, k0, sr)); S.st_k1 = load8(ROW(Kp, k0, 32 + sr)); } while (0)
#define SWRITE_HK(bf) do { *(bf16x8*)(K_lds + (bf) * SHM_K + kws) = S.st_k0; *(bf16x8*)(K_lds + (bf) * SHM_K + kws + 32 * 256) = S.st_k1; } while (0)
#define SWRITE_HV(bf) do { *(bf16x8*)(V_lds + (bf) * SHM_V + vst0) = S.st_v0; *(bf16x8*)(V_lds + (bf) * SHM_V + vst1) = S.st_v1; } while (0)
#define SWRITE_H(bf) do { SWRITE_HV(bf); SWRITE_HK(bf); } while (0)

template <bool SB>
__device__ __forceinline__ void attn_unit(const UnitRef& cur, unsigned char* wsu  , int bh, char* lds,
                                          int part  , float lmax  ) {
    const float* cvec;
    { unsigned char* w_ = wsu; asm volatile("" : "+s"(w_)); cvec = (const float*)(w_ + WS_C) + (size_t)bh * SEQ; }
    Seam S;
    { const int t0_ = tid_opaque(), w0_ = __builtin_amdgcn_readfirstlane(t0_ >> 6), l0_ = t0_ & 63;
#pragma unroll
      for (int d0 = 0; d0 < 8; ++d0) S.qr[d0] = load8(cur.Q + (size_t)(w0_ * QBLK + (l0_ & 31)) * D + d0 * 16 + (l0_ >> 5) * 8); }
    const int tid = tid_opaque(), wid = __builtin_amdgcn_readfirstlane(tid >> 6), lane = tid & 63, r32 = lane & 31, hi = lane >> 5;
    int jlo = 0;
    if constexpr (!SB) {
        const int ntf = (cur.P0 + QB) / KVBLK;
        const float cend = (lane < ntf) ? cvec[lane * KVBLK + KVBLK - 1] : 0.f;
        const bool skip = (lane < ntf) && (2.f * lmax + cvec[cur.P0] - cend < -104.f);
        jlo = __builtin_amdgcn_readfirstlane((int)__popcll(__ballot(skip)));
    }
    const int ntot = (cur.P0 + QB) / KVBLK - jlo;
    const int tb = (part == 2) ? (ntot >> 1) : 0, te = (part == 1) ? (ntot >> 1) : ntot;
    const int kshift = (jlo + tb) * KVBLK, P0r = cur.P0 - kshift;
    const int NT = te - tb;
#define KBASE(t) ((NT - 1 - (t)) * KVBLK)
    const int qlo = P0r + wid * QBLK, qm = qlo + r32 - 4 * hi - (SB ? 1 : 0);
    char* V_lds = lds; char* K_lds = lds + 2 * SHM_V;
    float* ws = (float*)(lds + OFF_WS) + wid * 64; float* li_l = ws, * al_l = ws + 32;
    float* bias = (float*)(lds + OFF_BIAS);
    const int sr = tid >> 4, sc = (tid & 15) * 8, vst0 = v_st(sr, sc), vst1 = v_st(32 + sr, sc), kws = KSWZ(sr, sc * 2);
    const int vb0 = (int)(uintptr_t)V_lds + v_rd_base(lane);
    const bf16_t* Kh = cur.K + (size_t)kshift * D; const bf16_t* Vh = cur.V + (size_t)kshift * D;
    SLOAD_H(Kh, Vh, KBASE(0));
    if constexpr (!SB) { const float cq0 = cvec[cur.P0]; const float* cv = cvec + kshift; for (int j = tid; j < NT * KVBLK; j += NTHREADS) bias[j] = (cq0 - cv[j]) * (1.f / SCALE); }
    VMW(); SWRITE_HK(0);
    __syncthreads();
    float m_reg = -1e30f, l_reg = 0; f32x16 o[4] = {};
    float carry = 0.f; const float mlo = hi ? 0.f : 1.f;
#define RESC(a) do { if (__any((a) < 1.f)) { if (hi == 0) al_l[r32] = (a); asm volatile("s_waitcnt lgkmcnt(0)" ::: "memory");              \
                     for (int d_ = 0; d_ < 4; ++d_) for (int r = 0; r < 16; ++r) o[d_][r] *= al_l[crow(r, hi)]; } } while (0)
#define MASKT(P0_, P1_, t) do { const int kb_ = KBASE(t); if (kb_ + KVBLK - 1 > qlo - (SB ? 1 : 0)) mask_tile(P0_, P1_, qm - kb_); } while (0)
#define BT(t) (bias + KBASE(t) + 4 * hi)
#define PART1(PX0, PX1, mnX, alX) do { if constexpr (SB) sb_part1(PX0, PX1, carry, mlo); else partialSM(PX0, PX1, m_reg, mnX, alX); } while (0)
#define PART2(PY0, PY1, alY) do { if constexpr (SB) sb_part2(PY0, PY1, pa0, pa1, pa2, pa3); else finishSM(PY0, PY1, alY, l_reg, pa0, pa1, pa2, pa3); } while (0)
    f32x16 pA0, pA1, pB0, pB1; float mnA = 0.f, mnB = 0.f, alA = 1.f, alB = 1.f; bf16x8 pa0, pa1, pa2, pa3;
    SWRITE_HV(0); SBAR();
    if (NT > 1) SLOAD_H(Kh, Vh, KBASE(1));
    SBAR(); qkt<0, !SB>(pA0, pA1, K_lds, r32, hi, S.qr, BT(0));
    MASKT(pA0, pA1, 0); PART1(pA0, pA1, mnA, alA);
    if (NT > 1) { VMW(); SWRITE_H(1); }
    __syncthreads();
#define HALF_STEP(PX0, PX1, mnX, alX, PY0, PY1, alY, t, KB, VB, SBUF) do {                                                    \
        SBAR(); qkt<KB, !SB>(PX0, PX1, K_lds, r32, hi, S.qr, BT(t));                                                          \
        PART2(PY0, PY1, alY); SBAR();                                                                                          \
        if ((t) + 1 < NT) { SLOAD_H(Kh, Vh, KBASE((t) + 1)); SBAR(); }                                                         \
        pv_tile<VB>(o, vb0, pa0, pa1, pa2, pa3); MASKT(PX0, PX1, (t)); PART1(PX0, PX1, mnX, alX);                              \
        __syncthreads();                                                                                                      \
        if ((t) + 1 < NT) { VMW(); SWRITE_H(SBUF); }                                                                           \
        if constexpr (!SB) RESC(alX);                                                                                          \
        __syncthreads(); } while (0)
    for (int t = 1; t + 1 < NT; t += 2) {
        HALF_STEP(pB0, pB1, mnB, alB, pA0, pA1, alA, t, 1, 0, 0);
        HALF_STEP(pA0, pA1, mnA, alA, pB0, pB1, alB, t + 1, 0, 1, 1);
    }
    const bool even = (NT & 1) == 0;
    if (even) { SBAR(); qkt<1, !SB>(pB0, pB1, K_lds, r32, hi, S.qr, BT(NT - 1)); SBAR(); }
    PART2(pA0, pA1, alA); SBAR();
    pv_tile<0>(o, vb0, pa0, pa1, pa2, pa3);
    if (even) { MASKT(pB0, pB1, NT - 1); PART1(pB0, pB1, mnB, alB); __syncthreads(); if constexpr (!SB) RESC(alB);
        PART2(pB0, pB1, alB); SBAR(); pv_tile<1>(o, vb0, pa0, pa1, pa2, pa3); }
    unsigned char* we_ = wsu; asm volatile("" : "+s"(we_));
    float* stg = (float*)(lds + OFF_BIAS) + wid * (32 * 68);
    if (part != 0) {
        const int slot2 = ((((cur.P0 >> 8) - 8) & 7) * 16 + bh) * 2 + (part == 2 ? 1 : 0);
        float* po = (float*)(we_ + WS_PO) + (size_t)slot2 * 256 * 128; float* pml = (float*)(we_ + WS_PML) + (size_t)slot2 * 512;
        if (hi == 0) { pml[(wid * QBLK + r32) * 2] = m_reg; pml[(wid * QBLK + r32) * 2 + 1] = l_reg; }
#pragma unroll
        for (int half = 0; half < 2; ++half) {
#pragma unroll
            for (int r = 0; r < 16; ++r) { stg[crow(r, hi) * 68 + r32] = o[2 * half][r]; stg[crow(r, hi) * 68 + 32 + r32] = o[2 * half + 1][r]; }
            asm volatile("s_waitcnt lgkmcnt(0)" ::: "memory");
#pragma unroll
            for (int k = 0; k < 4; ++k) { const int id = lane + 64 * k, row = id >> 3, c8 = (id & 7) * 8;
                const f32x4 x0 = *(const f32x4*)(stg + row * 68 + c8), x1 = *(const f32x4*)(stg + row * 68 + c8 + 4);
                float* d = po + (size_t)(wid * QBLK + row) * D + half * 64 + c8; *(f32x4*)d = x0; *(f32x4*)(d + 4) = x1; }
            asm volatile("s_waitcnt lgkmcnt(0)" ::: "memory");
        }
        __syncthreads();
        return;
    }
    const bf16_t* gate = (const bf16_t*)(we_ + WS_SEC) + 3 * SEC_ELEMS + (size_t)(bh >> 3) * SEQ * 1024 + (bh & 7) * HD;
    bf16_t* outp = (bf16_t*)(we_ + WS_MIX) + (size_t)(bh >> 3) * SEQ * DM + (bh & 7) * HD;
    float rli[16];
    if (hi == 0) li_l[r32] = l_reg; asm volatile("s_waitcnt lgkmcnt(0)" ::: "memory");
#pragma unroll
    for (int r = 0; r < 16; ++r) rli[r] = __builtin_amdgcn_rcpf(li_l[crow(r, hi)]);
#pragma unroll
    for (int half = 0; half < 2; ++half) {
#pragma unroll
        for (int r = 0; r < 16; ++r) { stg[crow(r, hi) * 68 + r32] = o[2 * half][r] * rli[r]; stg[crow(r, hi) * 68 + 32 + r32] = o[2 * half + 1][r] * rli[r]; }
        asm volatile("s_waitcnt lgkmcnt(0)" ::: "memory");
#pragma unroll
        for (int k = 0; k < 4; ++k) { const int id = lane + 64 * k, row = id >> 3, c8 = (id & 7) * 8;
            const int orow = cur.P0 + wid * QBLK + row, col = half * 64 + c8;
            const u32x4 gw = *(const u32x4*)(gate + (size_t)orow * 1024 + col);
            const f32x4 x0 = *(const f32x4*)(stg + row * 68 + c8), x1 = *(const f32x4*)(stg + row * 68 + c8 + 4);
            u32x4 ov; ov.x = cvt_pk_bf16(x0[0] * bf_lo(gw.x), x0[1] * bf_hi(gw.x)); ov.y = cvt_pk_bf16(x0[2] * bf_lo(gw.y), x0[3] * bf_hi(gw.y));
            ov.z = cvt_pk_bf16(x1[0] * bf_lo(gw.z), x1[1] * bf_hi(gw.z)); ov.w = cvt_pk_bf16(x1[2] * bf_lo(gw.w), x1[3] * bf_hi(gw.w));
            *(u32x4*)(outp + (size_t)orow * DM + col) = ov; }
        asm volatile("s_waitcnt lgkmcnt(0)" ::: "memory");
    }
    __syncthreads();
#undef RESC
#undef KBASE
#undef MASKT
#undef BT
#undef PART1
#undef PART2
#undef HALF_STEP
}

constexpr float SB_TH = 150.f;
__device__ __forceinline__ void sb_unit(const UnitRef& cur, bf16_t* outp, char* lds) {
    const int tid = tid_opaque(), wid = __builtin_amdgcn_readfirstlane(tid >> 6), lane = tid & 63, r32 = lane & 31, hi = lane >> 5;
    const int NT = (cur.P0 + QB) / KVBLK;
#define KBASE(t) ((NT - 1 - (t)) * KVBLK)
    const int qlo = cur.P0 + wid * QBLK, qm = qlo + r32 - 4 * hi - 1;
    char* V_lds = lds; char* K_lds = lds + 2 * SHM_V;
    volatile int* flags = (volatile int*)(lds + OFF_WS);
    const int sr = tid >> 4, sc = (tid & 15) * 8, vst0 = v_st(sr, sc), vst1 = v_st(32 + sr, sc), kws = KSWZ(sr, sc * 2);
    const int vb0 = (int)(uintptr_t)V_lds + v_rd_base(lane);
    const bf16_t* Kh = cur.K; const bf16_t* Vh = cur.V;
    Seam S;
#pragma unroll
    for (int d0 = 0; d0 < 8; ++d0) S.qr[d0] = load8(cur.Q + (size_t)(wid * QBLK + r32) * D + d0 * 16 + hi * 8);
    SLOAD_H(Kh, Vh, KBASE(0)); VMW(); SWRITE_H(0);
    __syncthreads();
    f32x16 o[4] = {}; float carry = 0.f; const float mlo = hi ? 0.f : 1.f;
    bool wdone = false;
#define SB_STEP(tt, BUF) {                                                                                                 \
        const int kb_ = KBASE(tt);                                                                                           \
        if ((tt) + 1 < NT) SLOAD_H(Kh, Vh, KBASE((tt) + 1));                                                                 \
        SBAR();                                                                                                              \
        if (!wdone && kb_ <= qlo + QBLK - 2) {                                                                               \
            f32x16 p0, p1; bf16x8 pa0, pa1, pa2, pa3;                                                                        \
            qkt<BUF, false>(p0, p1, K_lds, r32, hi, S.qr, nullptr);                                                          \
            if (kb_ + KVBLK - 1 > qlo - 1) mask_tile(p0, p1, qm - kb_);                                                      \
            sb_part1(p0, p1, carry, mlo); sb_part2(p0, p1, pa0, pa1, pa2, pa3); SBAR();                                      \
            pv_tile<BUF>(o, vb0, pa0, pa1, pa2, pa3);                                                                        \
            wdone = __all(carry >= SB_TH);                                                                                   \
        }                                                                                                                    \
        if ((tt) + 1 < NT) { VMW(); SWRITE_H((BUF) ^ 1); }                                                                   \
        if (lane == 0) flags[((tt) & 1) * 8 + wid] = wdone ? 1 : 0;                                                          \
        __syncthreads();                                                                                                     \
        { int alld = 1;                                                                                                      \
          _Pragma("unroll") for (int w_ = 0; w_ < 8; ++w_) alld &= flags[((tt) & 1) * 8 + w_];                                \
          if (alld) break; } }
    for (int t = 0; t < NT; t += 2) {
        SB_STEP(t, 0)
        SB_STEP(t + 1, 1)
    }
#undef SB_STEP
    { float* stg = (float*)(lds + OFF_BIAS) + wid * (32 * 68);
#pragma unroll
      for (int half = 0; half < 2; ++half) {
#pragma unroll
          for (int r = 0; r < 16; ++r) { stg[crow(r, hi) * 68 + r32] = o[2 * half][r]; stg[crow(r, hi) * 68 + 32 + r32] = o[2 * half + 1][r]; }
          asm volatile("s_waitcnt lgkmcnt(0)" ::: "memory");
#pragma unroll
          for (int k = 0; k < 4; ++k) { const int id = lane + 64 * k, row = id >> 3, c8 = (id & 7) * 8;
              const f32x4 x0 = *(const f32x4*)(stg + row * 68 + c8), x1 = *(const f32x4*)(stg + row * 68 + c8 + 4);
              u32x4 ov; ov.x = cvt_pk_bf16(x0[0], x0[1]); ov.y = cvt_pk_bf16(x0[2], x0[3]); ov.z = cvt_pk_bf16(x1[0], x1[1]); ov.w = cvt_pk_bf16(x1[2], x1[3]);
              *(u32x4*)(outp + (size_t)(cur.P0 + wid * QBLK + row) * DM + half * 64 + c8) = ov; }
          asm volatile("s_waitcnt lgkmcnt(0)" ::: "memory");
      } }
    __syncthreads();
#undef KBASE
}
#undef ROW
#undef VMW
#undef SLOAD_H
#undef SWRITE_HK
#undef SWRITE_HV
#undef SWRITE_H
}

#define XB_TMO      128
#define XB_XCNT(j)  (256  + 64 * (j))
#define XB_XSUB(j)  (1280 + 64 * (j))
#define XB_XGEN(j)  (2304 + 64 * (j))
#define XB_TOP      3328
#define XB_TOPGEN   3392
#define XCD_BAR_WORDS 3456
#define XB_SPIN_CAP (1u << 20)
__device__ __forceinline__ unsigned xb_ld(unsigned* p)              { return __hip_atomic_load(p, __ATOMIC_RELAXED, __HIP_MEMORY_SCOPE_AGENT); }
__device__ __forceinline__ unsigned xb_add(unsigned* p, unsigned v) { return __hip_atomic_fetch_add(p, v, __ATOMIC_RELAXED, __HIP_MEMORY_SCOPE_AGENT); }
__device__ __forceinline__ unsigned xb_xcc_id() { return (unsigned)__builtin_amdgcn_s_getreg((3 << 11) | 20) & 0xFu; }
#define XB_SPIN(cond, bar) do { unsigned _sp = 0; while (cond) { __builtin_amdgcn_s_sleep(1); \
    if ((++_sp & 255u) == 0u) { if (xb_ld(&(bar)[XB_TMO])) break; if (_sp > XB_SPIN_CAP) { atomicAdd(&(bar)[XB_TMO], 1u); break; } } } } while (0)
struct XcdBarrier { unsigned* bar; unsigned x; volatile LAS unsigned* st; };
__device__ __forceinline__ XcdBarrier xcd_barrier_post(unsigned* bar, volatile LAS unsigned* st) {
    XcdBarrier b; b.bar = bar; b.x = xb_xcc_id(); b.st = st;
    if (threadIdx.x == 0) (void)xb_add(&bar[XB_XCNT(b.x)], 1u);
    return b;
}
__device__ __forceinline__ void xcd_barrier_complete(unsigned* bar, unsigned x, unsigned& nloc, unsigned& nx) {
    const unsigned G = gridDim.x * gridDim.y * gridDim.z;
    unsigned sum, cnt, mine, sp = 0u;
    for (;;) {
        sum = 0u; cnt = 0u; mine = 0u;
#pragma unroll
        for (unsigned j = 0; j < 16; ++j) { const unsigned c = xb_ld(&bar[XB_XCNT(j)]); sum += c; cnt += (c > 0u) ? 1u : 0u; mine = (j == x) ? c : mine; }
        if (sum == G) break;
        __builtin_amdgcn_s_sleep(1);
        if ((++sp & 255u) == 0u) { if (xb_ld(&bar[XB_TMO])) break; if (sp > XB_SPIN_CAP) { atomicAdd(&bar[XB_TMO], 1u); break; } }
    }
    nloc = mine > 0u ? mine : 1u; nx = cnt > 0u ? cnt : 1u;
}
__device__ __forceinline__ void xcd_barrier(const XcdBarrier& b) {
    asm volatile("s_waitcnt vmcnt(0)" ::: "memory");
    __syncthreads();
    if (threadIdx.x == 0) {
        unsigned* bar = b.bar;
        __builtin_amdgcn_s_waitcnt(0);
        unsigned nloc = b.st[0], nx = b.st[1];
        if (nloc == 0u) { xcd_barrier_complete(bar, b.x, nloc, nx); b.st[0] = nloc; b.st[1] = nx; }
        const unsigned old = xb_add(&bar[XB_XSUB(b.x)], 1u);
        const unsigned gen = old / nloc;
        if (old + 1u == (gen + 1u) * nloc) {
            __builtin_amdgcn_fence(__ATOMIC_RELEASE, "agent");
            asm volatile("s_waitcnt vmcnt(0)" ::: "memory");
            const unsigned og = xb_add(&bar[XB_TOP], 1u);
            const unsigned tg = og / nx;
            if (og + 1u == (tg + 1u) * nx) xb_add(&bar[XB_TOPGEN], 1u);
            else XB_SPIN(xb_ld(&bar[XB_TOPGEN]) == tg, bar);
            __builtin_amdgcn_fence(__ATOMIC_ACQUIRE, "agent");
            xb_add(&bar[XB_XGEN(b.x)], 1u);
            asm volatile("s_waitcnt vmcnt(0)" ::: "memory");
        } else {
            XB_SPIN(xb_ld(&bar[XB_XGEN(b.x)]) == gen, bar);
            __builtin_amdgcn_fence(__ATOMIC_ACQUIRE, "agent");
            asm volatile("s_waitcnt vmcnt(0)" ::: "memory");
        }
    }
    __syncthreads();
}

struct Args { const float* in[12]; float* out; unsigned char* ws; int ph_lo, ph_hi; };

__device__ __forceinline__ void p0_transpose_item(const float* W, int ldw, int K, bf16_t* WT, int nblk, LAS float* scr, int item, int lane, const float* gk) {
    const int kb = item / nblk, nb = item % nblk, k0 = 64 * kb, n0 = 32 * nb;
    { const int rr = lane >> 3, c4 = lane & 7; f32x4 v[8];
#pragma unroll
      for (int i = 0; i < 8; ++i) v[i] = *(const f32x4*)(W + (size_t)(k0 + rr + 8 * i) * ldw + n0 + 4 * c4);
#pragma unroll
      for (int i = 0; i < 8; ++i) { const int kk = rr + 8 * i; const float gm = gk ? gk[k0 + kk] : 1.f;
          scr[kk * 33 + 4 * c4] = v[i][0] * gm; scr[kk * 33 + 4 * c4 + 1] = v[i][1] * gm; scr[kk * 33 + 4 * c4 + 2] = v[i][2] * gm; scr[kk * 33 + 4 * c4 + 3] = v[i][3] * gm; } }
    LDS_WAIT(); asm volatile("" ::: "memory");
    const int c = lane & 7;
#pragma unroll
    for (int j = 0; j < 4; ++j) { const int n = (lane >> 3) + 8 * j; const LAS float* s = scr + (8 * c) * 33 + n;
        u32x4 o; o.x = cvt_pk_bf16(s[0 * 33], s[1 * 33]); o.y = cvt_pk_bf16(s[2 * 33], s[3 * 33]); o.z = cvt_pk_bf16(s[4 * 33], s[5 * 33]); o.w = cvt_pk_bf16(s[6 * 33], s[7 * 33]);
        *(u32x4*)(WT + (size_t)(n0 + n) * K + k0 + 8 * c) = o; }
    LDS_WAIT(); asm volatile("" ::: "memory");
}

__device__ __forceinline__ int pack_i8(float a, float b, float c, float d) {
    const int ia = (int)__builtin_rintf(a), ib = (int)__builtin_rintf(b), ic = (int)__builtin_rintf(c), id = (int)__builtin_rintf(d);
    return (int)(((unsigned)ia & 0xffu) | (((unsigned)ib & 0xffu) << 8) | (((unsigned)ic & 0xffu) << 16) | ((unsigned)id << 24));
}
__device__ __forceinline__ void convert_tables(const Args& a, int r0, int r1, int worker, int nworkers) {
    const int lane = tid_opaque() & 63;
    unsigned char* ws = a.ws; const float* g_ffn = a.in[7]; const float* pu = a.in[10]; const float* pv = a.in[11];
    float* suv = (float*)(ws + WS_SUV);
    for (int r = r0 + worker; r < r1; r += nworkers) {
        const bool isv = r >= NEXP; const int e = isv ? r - NEXP : r;
        const f32x4* srcp = (const f32x4*)((isv ? pv : pu) + (size_t)e * DM);
        f32x4 v[8]; float amax = 0.f;
#pragma unroll
        for (int j = 0; j < 8; ++j) { v[j] = srcp[lane + 64 * j];
            if (!isv) { const f32x4 g4 = *(const f32x4*)(g_ffn + 4 * (lane + 64 * j)); v[j] = v[j] * g4; }
            amax = fmaxf(amax, fmaxf(fmaxf(fabsf(v[j][0]), fabsf(v[j][1])), fmaxf(fabsf(v[j][2]), fabsf(v[j][3])))); }
        amax = wave_max(amax);
        const float sc = amax > 0.f ? 127.f / amax : 1.f;
        unsigned char* dst = ws + (isv ? WS_V8 : WS_U8) + (size_t)e * 128;
#pragma unroll
        for (int j = 0; j < 8; ++j) { const int p = pack_i8(v[j][0] * sc, v[j][1] * sc, v[j][2] * sc, v[j][3] * sc);
            const int col = 4 * (lane + 64 * j);
            *(unsigned*)(dst + (size_t)(col >> 7) * ((size_t)NEXP * 128) + (col & 127)) = (unsigned)p; }
        if (lane == 0) suv[r] = 1.f / sc;
    }
}
constexpr int TAB_SPLIT = NEXP;

__device__ __forceinline__ void p0_transpose_item_i8(const float* W, int ldw, int K, unsigned char* WT, int nblk, LAS float* scr, int item, int lane, float q8) {
    const int kb = item / nblk, nb = item % nblk, k0 = 64 * kb, n0 = 32 * nb;
    { const int rr = lane >> 3, c4 = lane & 7; f32x4 v[8];
#pragma unroll
      for (int i = 0; i < 8; ++i) v[i] = *(const f32x4*)(W + (size_t)(k0 + rr + 8 * i) * ldw + n0 + 4 * c4);
#pragma unroll
      for (int i = 0; i < 8; ++i) { const int kk = rr + 8 * i;
          scr[kk * 33 + 4 * c4] = v[i][0] * q8; scr[kk * 33 + 4 * c4 + 1] = v[i][1] * q8; scr[kk * 33 + 4 * c4 + 2] = v[i][2] * q8; scr[kk * 33 + 4 * c4 + 3] = v[i][3] * q8; } }
    LDS_WAIT(); asm volatile("" ::: "memory");
    const int c = lane & 7;
#pragma unroll
    for (int j = 0; j < 4; ++j) { const int n = (lane >> 3) + 8 * j; const LAS float* s = scr + (8 * c) * 33 + n;
        u32x2 o; o.x = (unsigned)pack_i8(s[0 * 33], s[1 * 33], s[2 * 33], s[3 * 33]); o.y = (unsigned)pack_i8(s[4 * 33], s[5 * 33], s[6 * 33], s[7 * 33]);
        *(u32x2*)(WT + (size_t)(n0 + n) * K + k0 + 8 * c) = o; }
    LDS_WAIT(); asm volatile("" ::: "memory");
}
__device__ __forceinline__ float log_sigmoid_f(float x) { return fminf(x, 0.f) - log1pf(expf(-fabsf(x))); }

__device__ __forceinline__ void phase0(const Args& a, unsigned char* lds_g) {
    LAS unsigned char* lds = (LAS unsigned char*)lds_g;
    const int tid = tid_opaque(), lane = tid & 63, wave = __builtin_amdgcn_readfirstlane(tid >> 6);
    const int gw = blockIdx.x * NWAVES + wave, NGW = gridDim.x * NWAVES;
    const int gt = blockIdx.x * NTHREADS + tid, NGT = gridDim.x * NTHREADS;
    unsigned char* ws = a.ws;
    const float* x = a.in[0]; const float* g_attn = a.in[1]; const float* w_in = a.in[2]; const float* b_forget = a.in[3];
    const float* w_out = a.in[6]; const float* g_ffn = a.in[7]; const float* w_pq = a.in[8]; const float* sk = a.in[9]; const float* pu = a.in[10]; const float* pv = a.in[11];
    { float m = 0.f; const f32x4* wp = (const f32x4*)w_in;
      constexpr size_t NV4 = (size_t)DM * DIN / 4;
      size_t i = gt;
      for (; i + 7 * (size_t)NGT < NV4; i += 8 * (size_t)NGT) {
          f32x4 v[8];
#pragma unroll
          for (int k = 0; k < 8; ++k) v[k] = wp[i + k * (size_t)NGT];
#pragma unroll
          for (int k = 0; k < 8; ++k) m = fmaxf(m, fmaxf(fmaxf(fabsf(v[k][0]), fabsf(v[k][1])), fmaxf(fabsf(v[k][2]), fabsf(v[k][3])))); }
      for (; i < NV4; i += NGT) { const f32x4 v = wp[i]; m = fmaxf(m, fmaxf(fmaxf(fabsf(v[0]), fabsf(v[1])), fmaxf(fabsf(v[2]), fabsf(v[3])))); }
      m = wave_max(m);
      volatile LAS float* red = (volatile LAS float*)(lds + MISC_OFF + 256);
      if (lane == 0) red[wave] = m;
      __syncthreads();
      if (tid == 0) { float mm = red[0];
#pragma unroll
          for (int w = 1; w < NWAVES; ++w) mm = fmaxf(mm, red[w]);
          __hip_atomic_fetch_max((unsigned*)(ws + WS_CTL) + CW_WMAX, __float_as_uint(mm), __ATOMIC_RELAXED, __HIP_MEMORY_SCOPE_AGENT); } }
    LAS float* wf = (LAS float*)(lds + 67584);
    for (int k = tid; k < DM; k += NTHREADS) { const f32x4 a0 = *(const f32x4*)(w_in + (size_t)k * DIN + NPROJ), a1 = *(const f32x4*)(w_in + (size_t)k * DIN + NPROJ + 4);
        wf[0 * DM + k] = a0[0]; wf[1 * DM + k] = a0[1]; wf[2 * DM + k] = a0[2]; wf[3 * DM + k] = a0[3]; wf[4 * DM + k] = a1[0]; wf[5 * DM + k] = a1[1]; wf[6 * DM + k] = a1[2]; wf[7 * DM + k] = a1[3]; }
    __syncthreads();
    for (int row = gw; row < T; row += NGW) {
        const f32x4* xr = (const f32x4*)(x + (size_t)row * DM);
        f32x4 v[8]; float ss = 0.f;
#pragma unroll
        for (int j = 0; j < 8; ++j) { v[j] = xr[lane + 64 * j]; ss += v[j][0] * v[j][0] + v[j][1] * v[j][1] + v[j][2] * v[j][2] + v[j][3] * v[j][3]; }
        const float r = 1.0f / sqrtf(wave_sum(ss) * (1.f / DM) + EPS);
        float f[8] = {0.f, 0.f, 0.f, 0.f, 0.f, 0.f, 0.f, 0.f};
        float xmax = 0.f;
#pragma unroll
        for (int j = 0; j < 8; ++j) { const f32x4 g4 = *(const f32x4*)(g_attn + 4 * (lane + 64 * j)); v[j][0] *= r * g4[0]; v[j][1] *= r * g4[1]; v[j][2] *= r * g4[2]; v[j][3] *= r * g4[3];
            xmax = fmaxf(xmax, fmaxf(fmaxf(fabsf(v[j][0]), fabsf(v[j][1])), fmaxf(fabsf(v[j][2]), fabsf(v[j][3])))); }
        xmax = wave_max(xmax);
        const float xq = xmax > 0.f ? 127.f / xmax : 1.f;
        if (lane == 0) ((float*)(ws + WS_SXN))[row] = xmax * (1.f / 127.f);
        unsigned* o8 = (unsigned*)(ws + WS_XN + (size_t)row * DM);
#pragma unroll
        for (int j = 0; j < 8; ++j) {
            const int e = 4 * (lane + 64 * j);
            const f32x4 xn = v[j];
            o8[lane + 64 * j] = (unsigned)pack_i8(xn[0] * xq, xn[1] * xq, xn[2] * xq, xn[3] * xq);
#pragma unroll
            for (int hh = 0; hh < 8; ++hh) { const f32x4 w4 = *(LAS f32x4*)(wf + hh * DM + e);
                f[hh] += (xn[0] * w4[0] + xn[1] * w4[1]) + (xn[2] * w4[2] + xn[3] * w4[3]); }
            __builtin_amdgcn_sched_barrier(0);
        }
#pragma unroll
        for (int hh = 0; hh < 8; ++hh) f[hh] = wave_sum(f[hh]);
        if (lane < 8) { float fl = f[0];
#pragma unroll
            for (int hh = 1; hh < 8; ++hh) fl = (lane == hh) ? f[hh] : fl;
            const int b = row >> 12, s = row & 4095;
            ((float*)(ws + WS_LOGF))[(size_t)(b * 8 + lane) * SEQ + s] = log_sigmoid_f(fl + b_forget[lane]); }
    }
    LAS float* scr = (LAS float*)(lds + wave * 8448);
    constexpr int I_IN = (DM / 64) * (NPROJ / 32), I_O = (DM / 64) * (DM / 32);
    for (int it = gw; it < 2 * I_O; it += NGW) {
        int r = it;
        if (r < I_O) { p0_transpose_item(w_out, DM, DM, (bf16_t*)(ws + WS_WOUT), DM / 32, scr, r, lane, nullptr); continue; } r -= I_O;
        p0_transpose_item(w_pq, DM, DM, (bf16_t*)(ws + WS_WPQ), DM / 32, scr, r, lane, g_ffn);
    }
    for (int i = gt; i < 8 * 2 * 128 * 128 / 8; i += NGT) { const f32x4 a0 = *(const f32x4*)(sk + (size_t)i * 8), a1 = *(const f32x4*)(sk + (size_t)i * 8 + 4);
        u32x4 w; w.x = cvt_pk_bf16(a0[0], a0[1]); w.y = cvt_pk_bf16(a0[2], a0[3]); w.z = cvt_pk_bf16(a1[0], a1[1]); w.w = cvt_pk_bf16(a1[2], a1[3]);
        *(u32x4*)(ws + WS_SK + (size_t)i * 16) = w; }
    if (gt < 256) ((float*)(ws + WS_GQK))[gt] = gt < 128 ? a.in[4][gt] : a.in[5][gt - 128];
    convert_tables(a, 0, TAB_SPLIT, gw, NGW);
    { XcdBarrier xb_; xb_.bar = (unsigned*)(ws + WS_CTL) + CW_BAR; xb_.x = xb_xcc_id(); xb_.st = (volatile LAS unsigned*)(lds + MISC_OFF) + 8; xcd_barrier(xb_); }
    const float wmax = __uint_as_float(__hip_atomic_load((unsigned*)(ws + WS_CTL) + CW_WMAX, __ATOMIC_RELAXED, __HIP_MEMORY_SCOPE_AGENT));
    if (gt == 0) *(float*)(ws + WS_WSC) = wmax * (1.f / 127.f);
    const float q8 = wmax > 0.f ? 127.f / wmax : 1.f;
    for (int it = gw; it < I_IN; it += NGW) p0_transpose_item_i8(w_in, DIN, DM, ws + WS_WIN, NPROJ / 32, scr, it, lane, q8);
}

__device__ __forceinline__ void cumsum_rows(const Args& a) {
    const int tid = tid_opaque(), lane = tid & 63, wave = tid >> 6;
    const int rowi = (int)gridDim.x - 1 - (int)blockIdx.x;
    if (rowi >= 16 || rowi < 0 || wave != 0) return;
    const float* src = (const float*)(a.ws + WS_LOGF) + (size_t)rowi * SEQ + lane * 64;
    float* dst = (float*)(a.ws + WS_C) + (size_t)rowi * SEQ + lane * 64;
    f32x4 v[16]; float run = 0.f;
#pragma unroll
    for (int i = 0; i < 16; ++i) { v[i] = *(const f32x4*)(src + 4 * i);
#pragma unroll
        for (int q = 0; q < 4; ++q) { run += v[i][q]; v[i][q] = run; } }
    float incl = run;
#pragma unroll
    for (int o = 1; o < 64; o <<= 1) { const float t = shup_f(incl, o); if (lane >= o) incl += t; }
    const float off = incl - run;
#pragma unroll
    for (int i = 0; i < 16; ++i) { f32x4 w = v[i]; w[0] += off; w[1] += off; w[2] += off; w[3] += off; *(f32x4*)(dst + 4 * i) = w; }
}

__device__ __forceinline__ void phase_qknorm(const Args& a) {
    const int tid = tid_opaque(), lane = tid & 63, wave = tid >> 6;
    const int gw = blockIdx.x * NWAVES + wave, NGW = gridDim.x * NWAVES;
    const int sub = lane & 15, rw = lane >> 4;
    const float* gq = a.in[4]; const float* gk = a.in[5];
    constexpr int ROWS = NB * NHF * SEQ;
    for (int it = gw; it < 2 * ROWS / 4; it += NGW) {
        const int row = it * 4 + rw; const bool isk = row >= ROWS;
        bf16_t* p = (bf16_t*)(a.ws + WS_SEC) + (size_t)row * HD + sub * 8;
        const float* g = (isk ? gk : gq) + sub * 8;
        const u32x4 w = *(const u32x4*)p;
        float v[8] = {bf_lo(w.x), bf_hi(w.x), bf_lo(w.y), bf_hi(w.y), bf_lo(w.z), bf_hi(w.z), bf_lo(w.w), bf_hi(w.w)};
        float ss = 0.f;
#pragma unroll
        for (int i = 0; i < 8; ++i) ss += v[i] * v[i];
        ss += sx_f(ss, 1); ss += sx_f(ss, 2); ss += sx_f(ss, 4); ss += sx_f(ss, 8);
        const float r = 1.0f / sqrtf(ss * (1.f / HD) + EPS);
        const f32x4 g0 = *(const f32x4*)g, g1 = *(const f32x4*)(g + 4);
        u32x4 o; o.x = cvt_pk_bf16(v[0] * r * g0[0], v[1] * r * g0[1]); o.y = cvt_pk_bf16(v[2] * r * g0[2], v[3] * r * g0[3]);
        o.z = cvt_pk_bf16(v[4] * r * g1[0], v[5] * r * g1[1]); o.w = cvt_pk_bf16(v[6] * r * g1[2], v[7] * r * g1[3]);
        *(u32x4*)p = o;
    }
}

__device__ __forceinline__ void phase_attn(const Args& a, unsigned char* lds_g) {
    const int tid = tid_opaque();
    volatile int* s_item = (volatile int*)(lds_g + MISC_OFF);
    unsigned* ctr = (unsigned*)(a.ws + WS_CTL);
    float lmax;
    { const int lane_ = tid & 63; const float* gqk = (const float*)(a.ws + WS_GQK);
      const float gq = fmaxf(fabsf(gqk[lane_]), fabsf(gqk[64 + lane_])), gk = fmaxf(fabsf(gqk[128 + lane_]), fabsf(gqk[192 + lane_]));
      lmax = 11.3137085f * 1.02f * wave_max(gq) * wave_max(gk); }
    for (;;) {
        __syncthreads();
        if (tid == 0) *s_item = (int)atomicAdd(ctr, 1u);
        __syncthreads();
        int it = *s_item, kind = -1, qb = 0, sub = 0;
#define CLS(K, Q, CNT) if (kind < 0) { if (it < (CNT)) { kind = (K); qb = (Q); sub = it; } else it -= (CNT); }
        CLS(2, 15, 32) CLS(1, 7, 16) CLS(2, 14, 32) CLS(2, 13, 32) CLS(1, 6, 16) CLS(2, 12, 32) CLS(2, 11, 32) CLS(1, 5, 16) CLS(2, 10, 32) CLS(2, 9, 32) CLS(1, 4, 16) CLS(2, 8, 32) CLS(1, 3, 16) CLS(1, 2, 16)
        if (kind < 0) { if (it < 256) { kind = 0; qb = 15 - (it >> 4); sub = it & 15; } else it -= 256; }
        CLS(1, 1, 16) CLS(1, 0, 16)
#undef CLS
        if (kind < 0) break;
        unsigned char* wsl = a.ws; asm volatile("" : "+s"(wsl));
        bf16_t* sec = (bf16_t*)(wsl + WS_SEC);
        const int bh = sub & 15, part = (kind == 2) ? 1 + (sub >> 4) : 0;
        const int b = bh >> 3, h = bh & 7;
        const size_t hoff = (size_t)bh * SEQ * HD;
        att::UnitRef u;
        u.P0 = qb * 256;
        if (kind == 0) {
            u.Q = sec + 4 * SEC_ELEMS + hoff + (size_t)u.P0 * HD; u.K = sec + 5 * SEC_ELEMS + hoff; u.V = sec + 6 * SEC_ELEMS + hoff;
            att::sb_unit(u, (bf16_t*)(wsl + WS_MIX) + (size_t)b * SEQ * DM + 1024 + h * HD, (char*)lds_g);
        } else {
            u.Q = sec + 0 * SEC_ELEMS + hoff + (size_t)u.P0 * HD; u.K = sec + 1 * SEC_ELEMS + hoff; u.V = sec + 2 * SEC_ELEMS + hoff;
            att::attn_unit<false>(u, wsl, bh, (char*)lds_g, part, lmax);
        }
    }
}
__device__ __forceinline__ void phase_attn_combine(const Args& a) {
    const int gt = blockIdx.x * NTHREADS + tid_opaque(), NGT = gridDim.x * NTHREADS;
    const float* po = (const float*)(a.ws + WS_PO); const float* pml = (const float*)(a.ws + WS_PML);
    const bf16_t* gate = (const bf16_t*)(a.ws + WS_SEC) + 3 * SEC_ELEMS; bf16_t* mix = (bf16_t*)(a.ws + WS_MIX);
    constexpr float C2 = LOG2E * SCALE;
    for (int item = gt; item < 128 * 256 * 16; item += NGT) {
        const int slot = item >> 12, row = (item >> 4) & 255, cg = item & 15;
        const int qb = 8 + (slot >> 4), bh = slot & 15, b = bh >> 3, h = bh & 7;
        const f32x2 ml1 = *(const f32x2*)(pml + (size_t)(slot * 2) * 512 + row * 2), ml2 = *(const f32x2*)(pml + (size_t)(slot * 2 + 1) * 512 + row * 2);
        const float M = fmaxf(ml1.x, ml2.x), a1 = __builtin_amdgcn_exp2f((ml1.x - M) * C2), a2 = __builtin_amdgcn_exp2f((ml2.x - M) * C2);
        const float inv = 1.f / (a1 * ml1.y + a2 * ml2.y);
        const float* p1 = po + (size_t)(slot * 2) * 32768 + row * 128 + cg * 8; const float* p2 = p1 + 32768;
        const f32x4 x0 = *(const f32x4*)p1, x1 = *(const f32x4*)(p1 + 4), y0 = *(const f32x4*)p2, y1 = *(const f32x4*)(p2 + 4);
        const size_t tok = (size_t)b * SEQ + qb * 256 + row;
        const u32x4 gw = *(const u32x4*)(gate + tok * 1024 + h * HD + cg * 8);
        const float w1 = a1 * inv, w2 = a2 * inv;
        u32x4 o;
        o.x = cvt_pk_bf16((w1 * x0[0] + w2 * y0[0]) * bf_lo(gw.x), (w1 * x0[1] + w2 * y0[1]) * bf_hi(gw.x));
        o.y = cvt_pk_bf16((w1 * x0[2] + w2 * y0[2]) * bf_lo(gw.y), (w1 * x0[3] + w2 * y0[3]) * bf_hi(gw.y));
        o.z = cvt_pk_bf16((w1 * x1[0] + w2 * y1[0]) * bf_lo(gw.z), (w1 * x1[1] + w2 * y1[1]) * bf_hi(gw.z));
        o.w = cvt_pk_bf16((w1 * x1[2] + w2 * y1[2]) * bf_lo(gw.w), (w1 * x1[3] + w2 * y1[3]) * bf_hi(gw.w));
        *(u32x4*)(mix + tok * DM + h * HD + cg * 8) = o;
    }
}

__device__ __forceinline__ unsigned f2ord(float f) { const unsigned u = __float_as_uint(f); return u ^ ((unsigned)((int)u >> 31) | 0x80000000u); }
__device__ __forceinline__ float ord2f(unsigned k) { const unsigned u = k ^ (~(unsigned)((int)k >> 31) | 0x80000000u); return __uint_as_float(u); }
#define INS16(L, X) do { unsigned x_ = (X); _Pragma("unroll") for (int i_ = 0; i_ < 16; ++i_) { const unsigned hi_ = max(L[i_], x_); x_ = min(L[i_], x_); L[i_] = hi_; } } while (0)
__device__ __forceinline__ void sort16_desc(unsigned (&a)[16]) {
#pragma unroll
    for (int k = 2; k <= 16; k <<= 1)
#pragma unroll
        for (int j = k >> 1; j > 0; j >>= 1)
#pragma unroll
            for (int i = 0; i < 16; ++i) { const int l = i ^ j; if (l > i) { const unsigned hi_ = max(a[i], a[l]), lo_ = min(a[i], a[l]); const bool desc = (i & k) == 0; a[i] = desc ? hi_ : lo_; a[l] = desc ? lo_ : hi_; } }
}
__device__ __forceinline__ void merge_top16(unsigned (&a)[16], const unsigned (&b)[16]) {
#pragma unroll
    for (int i = 0; i < 16; ++i) a[i] = max(a[i], b[15 - i]);
#pragma unroll
    for (int j = 8; j > 0; j >>= 1)
#pragma unroll
        for (int i = 0; i < 16; ++i) { const int l = i ^ j; if (l > i) { const unsigned hi_ = max(a[i], a[l]), lo_ = min(a[i], a[l]); a[i] = hi_; a[l] = lo_; } }
}
__device__ __forceinline__ void topk_half(const bf16_t* qrow  , const bf16_t* skb, int h, int c, int r32, int hi, unsigned (&L)[16]) {
    bf16x8 qf[8];
#pragma unroll
    for (int d0 = 0; d0 < 8; ++d0) qf[d0] = *(const bf16x8*)(qrow + c * 128 + d0 * 16 + hi * 8);
    const unsigned hi4 = 4u * (unsigned)hi;
#pragma unroll
    for (int kt = 0; kt < 4; ++kt) {
        f32x16 acc = f32x16{};
#pragma unroll
        for (int d0 = 0; d0 < 8; ++d0) { const bf16x8 kf = *(const bf16x8*)(skb + (size_t)((h * 2 + c) * 128 + kt * 32 + r32) * 128 + d0 * 16 + hi * 8);
            acc = __builtin_amdgcn_mfma_f32_32x32x16_bf16(kf, qf[d0], acc, 0, 0, 0); }
        unsigned G[16];
#pragma unroll
        for (int r = 0; r < 16; ++r) { const unsigned cst = (unsigned)(127 - (kt * 32 + (r & 3) + 8 * (r >> 2))); G[r] = (f2ord(acc[r]) & ~127u) | (cst - hi4); }
        sort16_desc(G);
        if (kt == 0) {
#pragma unroll
            for (int i = 0; i < 16; ++i) L[i] = G[i];
        } else merge_top16(L, G);
    }
    unsigned P[16];
#pragma unroll
    for (int i = 0; i < 16; ++i) { auto rr = __builtin_amdgcn_permlane32_swap(L[i], L[i], false, false); P[i] = hi ? rr[0] : rr[1]; }
    merge_top16(L, P);
}
__device__ __forceinline__ void topk_task(unsigned char* ws, const bf16_t* qrow, LAS int* tb, int t0, int h, int lane) {
    const int r32 = lane & 31, hi = lane >> 5;
    const bf16_t* skb = (const bf16_t*)(ws + WS_SK);
    int* idx_o = (int*)(ws + WS_IDX); float* gw_o = (float*)(ws + WS_GW);
    float rt_l;
    { const f32x4* sp = (const f32x4*)((const float*)(ws + WS_SSQ) + (size_t)(t0 + (lane & 31)) * 32); float tot = 0.f;
#pragma unroll
      for (int i = 0; i < 8; ++i) { const f32x4 v = sp[i]; tot += (v[0] + v[1]) + (v[2] + v[3]); }
      rt_l = 1.0f / sqrtf(tot * (1.f / DM) + EPS); }
        {
          const bf16_t* hbp = (const bf16_t*)(ws + WS_HB); const float* amx = (const float*)(ws + WS_AMX); unsigned char* xq = ws + WS_XQ;
          float am = 0.f;
          { const f32x4* ap = (const f32x4*)(amx + (size_t)(t0 + (lane & 31)) * 32);
#pragma unroll
            for (int i = 0; i < 8; ++i) { const f32x4 v = ap[i]; am = fmaxf(am, fmaxf(fmaxf(v[0], v[1]), fmaxf(v[2], v[3]))); } }
          if (h == 0 && lane < 32) ((float*)(ws + WS_SX))[t0 + lane] = rt_l * am * (1.f / 126.5f);
          const float qs = am > 0.f ? 126.5f / am : 1.f;
          u32x4 wv[16];
#pragma unroll
          for (int j = 0; j < 16; ++j) { const int ch = lane + 64 * j; wv[j] = *(const u32x4*)(hbp + (size_t)(t0 + (ch >> 5)) * DM + h * 256 + (ch & 31) * 8); }
#pragma unroll
          for (int j = 0; j < 16; ++j) { const int ch = lane + 64 * j, tl = ch >> 5, tk = t0 + tl, col = h * 256 + (ch & 31) * 8;
              const u32x4 w = wv[j]; const float r = sh_f(qs, tl);
              const int p0 = pack_i8(bf_lo(w.x) * r, bf_hi(w.x) * r, bf_lo(w.y) * r, bf_hi(w.y) * r), p1 = pack_i8(bf_lo(w.z) * r, bf_hi(w.z) * r, bf_lo(w.w) * r, bf_hi(w.w) * r);
              *(u32x2*)(xq + (size_t)tk * DM + col) = (u32x2){(unsigned)p0, (unsigned)p1}; } }
        unsigned L[2][16];
        topk_half(qrow, skb, h, 0, r32, hi, L[0]);
        __builtin_amdgcn_sched_barrier(0);
        topk_half(qrow, skb, h, 1, r32, hi, L[1]);
        __builtin_amdgcn_sched_barrier(0);
        float s1[16], s2[16]; int i1[16], i2[16];
#pragma unroll
        for (int i = 0; i < 16; ++i) { s1[i] = ord2f((L[0][i] & ~127u) | 64u); i1[i] = 127 - (int)(L[0][i] & 127u); s2[i] = ord2f((L[1][i] & ~127u) | 64u); i2[i] = 127 - (int)(L[1][i] & 127u); }
        unsigned CG[4][16];
#pragma unroll
        for (int i = 0; i < 64; ++i) CG[i >> 4][i & 15] = 0u;
        CG[0][0] = (f2ord(s1[0] + s2[0]) & ~255u) | 0u;
        CG[0][1] = (f2ord(s1[0] + s2[1]) & ~255u) | 1u;
        CG[0][2] = (f2ord(s1[0] + s2[2]) & ~255u) | 2u;
        CG[0][3] = (f2ord(s1[0] + s2[3]) & ~255u) | 3u;
        CG[0][4] = (f2ord(s1[0] + s2[4]) & ~255u) | 4u;
        CG[0][5] = (f2ord(s1[0] + s2[5]) & ~255u) | 5u;
        CG[0][6] = (f2ord(s1[0] + s2[6]) & ~255u) | 6u;
        CG[0][7] = (f2ord(s1[0] + s2[7]) & ~255u) | 7u;
        CG[0][8] = (f2ord(s1[0] + s2[8]) & ~255u) | 8u;
        CG[0][9] = (f2ord(s1[0] + s2[9]) & ~255u) | 9u;
        CG[0][10] = (f2ord(s1[0] + s2[10]) & ~255u) | 10u;
        CG[0][11] = (f2ord(s1[0] + s2[11]) & ~255u) | 11u;
        CG[0][12] = (f2ord(s1[0] + s2[12]) & ~255u) | 12u;
        CG[0][13] = (f2ord(s1[0] + s2[13]) & ~255u) | 13u;
        CG[0][14] = (f2ord(s1[0] + s2[14]) & ~255u) | 14u;
        CG[0][15] = (f2ord(s1[0] + s2[15]) & ~255u) | 15u;
        CG[1][0] = (f2ord(s1[1] + s2[0]) & ~255u) | 16u;
        CG[1][1] = (f2ord(s1[1] + s2[1]) & ~255u) | 17u;
        CG[1][2] = (f2ord(s1[1] + s2[2]) & ~255u) | 18u;
        CG[1][3] = (f2ord(s1[1] + s2[3]) & ~255u) | 19u;
        CG[1][4] = (f2ord(s1[1] + s2[4]) & ~255u) | 20u;
        CG[1][5] = (f2ord(s1[1] + s2[5]) & ~255u) | 21u;
        CG[1][6] = (f2ord(s1[1] + s2[6]) & ~255u) | 22u;
        CG[1][7] = (f2ord(s1[1] + s2[7]) & ~255u) | 23u;
        CG[1][8] = (f2ord(s1[2] + s2[0]) & ~255u) | 32u;
        CG[1][9] = (f2ord(s1[2] + s2[1]) & ~255u) | 33u;
        CG[1][10] = (f2ord(s1[2] + s2[2]) & ~255u) | 34u;
        CG[1][11] = (f2ord(s1[2] + s2[3]) & ~255u) | 35u;
        CG[1][12] = (f2ord(s1[2] + s2[4]) & ~255u) | 36u;
        CG[1][13] = (f2ord(s1[3] + s2[0]) & ~255u) | 48u;
        CG[1][14] = (f2ord(s1[3] + s2[1]) & ~255u) | 49u;
        CG[1][15] = (f2ord(s1[3] + s2[2]) & ~255u) | 50u;
        CG[2][0] = (f2ord(s1[3] + s2[3]) & ~255u) | 51u;
        CG[2][1] = (f2ord(s1[4] + s2[0]) & ~255u) | 64u;
        CG[2][2] = (f2ord(s1[4] + s2[1]) & ~255u) | 65u;
        CG[2][3] = (f2ord(s1[4] + s2[2]) & ~255u) | 66u;
        CG[2][4] = (f2ord(s1[5] + s2[0]) & ~255u) | 80u;
        CG[2][5] = (f2ord(s1[5] + s2[1]) & ~255u) | 81u;
        CG[2][6] = (f2ord(s1[6] + s2[0]) & ~255u) | 96u;
        CG[2][7] = (f2ord(s1[6] + s2[1]) & ~255u) | 97u;
        CG[2][8] = (f2ord(s1[7] + s2[0]) & ~255u) | 112u;
        CG[2][9] = (f2ord(s1[7] + s2[1]) & ~255u) | 113u;
        CG[2][10] = (f2ord(s1[8] + s2[0]) & ~255u) | 128u;
        CG[2][11] = (f2ord(s1[9] + s2[0]) & ~255u) | 144u;
        CG[2][12] = (f2ord(s1[10] + s2[0]) & ~255u) | 160u;
        CG[2][13] = (f2ord(s1[11] + s2[0]) & ~255u) | 176u;
        CG[2][14] = (f2ord(s1[12] + s2[0]) & ~255u) | 192u;
        CG[2][15] = (f2ord(s1[13] + s2[0]) & ~255u) | 208u;
        CG[3][0] = (f2ord(s1[14] + s2[0]) & ~255u) | 224u;
        CG[3][1] = (f2ord(s1[15] + s2[0]) & ~255u) | 240u;
        sort16_desc(CG[0]); sort16_desc(CG[1]); sort16_desc(CG[2]); sort16_desc(CG[3]);
        merge_top16(CG[0], CG[1]); merge_top16(CG[2], CG[3]); merge_top16(CG[0], CG[2]);
        unsigned LC[16];
#pragma unroll
        for (int i = 0; i < 16; ++i) LC[i] = CG[0][i];
#pragma unroll
        for (int i = 0; i < 16; ++i) { tb[i * 64 + lane] = i1[i]; tb[(16 + i) * 64 + lane] = i2[i]; }
        float LS[16]; int LP[16];
#pragma unroll
        for (int i = 0; i < 16; ++i) { const unsigned cid = LC[i] & 255u; LS[i] = ord2f((LC[i] & ~255u) | 128u);
            LP[i] = tb[(cid >> 4) * 64 + lane] * 128 + tb[(16 + (cid & 15u)) * 64 + lane]; }
        float den = 0.f, e[16];
#pragma unroll
        for (int i = 0; i < 16; ++i) { e[i] = __expf((LS[i] - LS[0]) * rt_l); den += e[i]; }
        const float rden = 1.f / den;
        const size_t ob = (size_t)(t0 + r32) * NE + h * 16;
        if (hi == 0) {
#pragma unroll
            for (int i = 0; i < 4; ++i) *(int4*)(idx_o + ob + 4 * i) = make_int4(LP[4 * i], LP[4 * i + 1], LP[4 * i + 2], LP[4 * i + 3]);
            { unsigned short* i16 = (unsigned short*)(ws + WS_IDX16) + ob;
#pragma unroll
              for (int i = 0; i < 2; ++i) *(u32x4*)(i16 + 8 * i) = (u32x4){(unsigned)LP[8 * i] | ((unsigned)LP[8 * i + 1] << 16), (unsigned)LP[8 * i + 2] | ((unsigned)LP[8 * i + 3] << 16),
                                                                        (unsigned)LP[8 * i + 4] | ((unsigned)LP[8 * i + 5] << 16), (unsigned)LP[8 * i + 6] | ((unsigned)LP[8 * i + 7] << 16)}; }
        } else {
#pragma unroll
            for (int i = 0; i < 4; ++i) *(f32x4*)(gw_o + ob + 4 * i) = (f32x4){e[4 * i] * rden, e[4 * i + 1] * rden, e[4 * i + 2] * rden, e[4 * i + 3] * rden};
        }
}
__device__ __forceinline__ void phase_topk(const Args& a, unsigned char* lds_g) {
    LAS unsigned char* lds = (LAS unsigned char*)lds_g;
    const int tid = tid_opaque(), lane = tid & 63, wave = tid >> 6;
    const int gw = blockIdx.x * NWAVES + wave, NGW = gridDim.x * NWAVES;
    const bf16_t* qp = (const bf16_t*)(a.ws + WS_QP);
    for (int task = gw; task < (T / 32) * 8; task += NGW) {
        const int h = task & 7, t0 = (task >> 3) * 32;
        topk_task(a.ws, qp + (size_t)(t0 + (lane & 31)) * DM + h * 256, (LAS int*)(lds + wave * 8192), t0, h, lane);
    }
}
__device__ __forceinline__ void pg8::EpiPeerQFused::fused(const f32x4 (&acc)[2][2][4][2], const Unit& u, int wr, int wc, int fr, int fq, PG8_LAS unsigned char* lds) const {
    constexpr int ROWB = 528;
#pragma unroll
    for (int ai = 0; ai < 2; ++ai)
#pragma unroll
        for (int m = 0; m < 4; ++m) {
            const int tr = ai * HALF + wr * 64 + m * 16 + fr;
#pragma unroll
            for (int bj = 0; bj < 2; ++bj) {
                const f32x4 v0 = acc[ai][bj][m][0], v1 = acc[ai][bj][m][1];
                u32x4 w; w.x = cvt_pk_bf16(v0[0], v0[1]); w.y = cvt_pk_bf16(v0[2], v0[3]); w.z = cvt_pk_bf16(v1[0], v1[1]); w.w = cvt_pk_bf16(v1[2], v1[3]);
                *(PG8_LAS u32x4*)(lds + tr * ROWB + (bj * HALF + wc * 32 + 8 * fq) * 2) = w;
            }
        }
    __syncthreads();
    const int tid = tid_opaque(), lane = tid & 63, wave = tid >> 6;
    PG8_LAS unsigned char* myrows = lds + (wave * 32) * ROWB;
    topk_task(wsb, (const bf16_t*)(const void*)(myrows + (lane & 31) * ROWB), (LAS int*)myrows, u.pm * BM + wave * 32, u.pn, lane);
}
__device__ __forceinline__ void wave_argmax(float& v, int& i) {
#pragma unroll
    for (int o = 1; o < 64; o <<= 1) { const float ov = sx_f(v, o); const int oi = sx_i(i, o); if (ov > v || (ov == v && oi < i)) { v = ov; i = oi; } }
}
__device__ __forceinline__ void phase_topk_ref(const Args& a) {
    const int tid = tid_opaque(), lane = tid & 63, wave = tid >> 6;
    const int gw = blockIdx.x * NWAVES + wave, NGW = gridDim.x * NWAVES;
    const bf16_t* skb = (const bf16_t*)(a.ws + WS_SK); const bf16_t* qp = (const bf16_t*)(a.ws + WS_QP);
    int* idx_o = (int*)(a.ws + WS_IDX); float* gw_o = (float*)(a.ws + WS_GW);
    for (int task = gw; task < T * 8; task += NGW) {
        const int t = task >> 3, h = task & 7;
        float topS[2]; int topI[2];
        for (int c = 0; c < 2; ++c) {
            const bf16_t* q = qp + (size_t)t * DM + h * 256 + c * 128;
            float sc0 = 0.f, sc1 = 0.f;
            const bf16_t* k0 = skb + (size_t)((h * 2 + c) * 128 + lane) * 128; const bf16_t* k1 = k0 + 64 * 128;
            for (int d = 0; d < 128; ++d) { const float qd = __uint_as_float((unsigned)q[d] << 16);
                sc0 += qd * __uint_as_float((unsigned)k0[d] << 16); sc1 += qd * __uint_as_float((unsigned)k1[d] << 16); }
            float ms = 0.f; int mi = 0;
            for (int r = 0; r < 16; ++r) {
                float v; int i; if (sc0 >= sc1) { v = sc0; i = lane; } else { v = sc1; i = lane + 64; }
                wave_argmax(v, i);
                if (lane == r) { ms = v; mi = i; }
                if (i == lane) sc0 = -__builtin_inff();
                if (i == lane + 64) sc1 = -__builtin_inff();
            }
            topS[c] = ms; topI[c] = mi;
        }
        float cs[4]; int ci[4];
#pragma unroll
        for (int j = 0; j < 4; ++j) { const int cidx = lane * 4 + j, aa = cidx >> 4, bb = cidx & 15;
            cs[j] = sh_f(topS[0], aa) + sh_f(topS[1], bb); ci[j] = cidx; }
        float fs = 0.f; int fi = 0;
        for (int r = 0; r < 16; ++r) {
            float v = cs[0]; int i = ci[0];
#pragma unroll
            for (int j = 1; j < 4; ++j) if (cs[j] > v) { v = cs[j]; i = ci[j]; }
            wave_argmax(v, i);
            if (lane == r) { fs = v; fi = i; }
#pragma unroll
            for (int j = 0; j < 4; ++j) if (ci[j] == i) cs[j] = -__builtin_inff();
        }
        const int e1 = sh_i(topI[0], fi >> 4), e2 = sh_i(topI[1], fi & 15);
        const float mx = sh_f(fs, 0);
        float ev = lane < 16 ? __expf(fs - mx) : 0.f;
        const float den = wave_sum(ev);
        if (lane < 16) { idx_o[(size_t)t * NE + h * 16 + lane] = e1 * 128 + e2; gw_o[(size_t)t * NE + h * 16 + lane] = ev / den; }
    }
}

__device__ __forceinline__ void fp8x16_to_f32(const u32x4 q, f32x2 (&o)[8]) {
    o[0] = __builtin_amdgcn_cvt_pk_f32_fp8((int)q.x, false); o[1] = __builtin_amdgcn_cvt_pk_f32_fp8((int)q.x, true);
    o[2] = __builtin_amdgcn_cvt_pk_f32_fp8((int)q.y, false); o[3] = __builtin_amdgcn_cvt_pk_f32_fp8((int)q.y, true);
    o[4] = __builtin_amdgcn_cvt_pk_f32_fp8((int)q.z, false); o[5] = __builtin_amdgcn_cvt_pk_f32_fp8((int)q.z, true);
    o[6] = __builtin_amdgcn_cvt_pk_f32_fp8((int)q.w, false); o[7] = __builtin_amdgcn_cvt_pk_f32_fp8((int)q.w, true);
}
#define HALVE(dst, srcv, n, bitmask) do { const bool up_ = (lane & (bitmask)) != 0; _Pragma("unroll") for (int i_ = 0; i_ < (n); ++i_) { \
        const float keep_ = up_ ? srcv[(n) + i_] : srcv[i_], send_ = up_ ? srcv[i_] : srcv[(n) + i_]; dst[i_] = keep_ + sx_f(send_, (bitmask)); } } while (0)
#define ITEM_T(n) (wv + ((n) % KT) * NWX)
#define ITEM_S(n) (xl + 8 * ((n) / KT))
#define LD_IDX(ID, n) do { const int4* ip_ = (const int4*)(idx_i + (size_t)ITEM_T(n) * NE + g * 16); _Pragma("unroll") for (int i_ = 0; i_ < 4; ++i_) ID[i_] = ip_[i_]; } while (0)
#define LD_ROWS(Q, ID, TAB, n) do { const unsigned char* b_ = (TAB) + (size_t)ITEM_S(n) * ((size_t)NEXP * 128) + c * 16; _Pragma("unroll") for (int i_ = 0; i_ < 4; ++i_) { \
        Q[4 * i_] = *(const u32x4*)(b_ + (size_t)ID[i_].x * 128); Q[4 * i_ + 1] = *(const u32x4*)(b_ + (size_t)ID[i_].y * 128); \
        Q[4 * i_ + 2] = *(const u32x4*)(b_ + (size_t)ID[i_].z * 128); Q[4 * i_ + 3] = *(const u32x4*)(b_ + (size_t)ID[i_].w * 128); } } while (0)
__device__ __forceinline__ int dpp_hmirror(int v) { return __builtin_amdgcn_update_dpp(0, v, 0x141, 0xf, 0xf, true); }
__device__ __forceinline__ int dpp_qxor2(int v) { return __builtin_amdgcn_update_dpp(0, v, 0x4E, 0xf, 0xf, true); }
__device__ __forceinline__ int dpp_qxor1(int v) { return __builtin_amdgcn_update_dpp(0, v, 0xB1, 0xf, 0xf, true); }
__device__ __forceinline__ void phase_peer_u(const Args& a) {
    const int tid = tid_opaque(), lane = tid & 63, wave = tid >> 6, g = lane >> 3, c = lane & 7;
    const int xl = blockIdx.x & 7, wv = (blockIdx.x >> 3) * NWAVES + wave, NWX = (gridDim.x >> 3) * NWAVES, KT = T / NWX, N = 2 * KT;
    const unsigned char* xq = a.ws + WS_XQ; const unsigned char* u8 = a.ws + WS_U8;
    const unsigned short* idx16 = (const unsigned short*)(a.ws + WS_IDX16); bf16_t* part = (bf16_t*)(a.ws + WS_PART);
    const bool up4 = (c & 4) != 0, up2 = (c & 2) != 0, up1 = (c & 1) != 0;
#define LD_I16(ID, n, h) do { ID = *(const u32x4*)(idx16 + (size_t)ITEM_T(n) * NE + g * 16 + (h) * 8); } while (0)
#define LD_R8(Q, ID, n) do { const unsigned char* b_ = u8 + (size_t)ITEM_S(n) * ((size_t)NEXP * 128) + c * 16; \
        Q[0] = *(const u32x4*)(b_ + (size_t)(ID.x & 0xffffu) * 128); Q[1] = *(const u32x4*)(b_ + (size_t)(ID.x >> 16) * 128); \
        Q[2] = *(const u32x4*)(b_ + (size_t)(ID.y & 0xffffu) * 128); Q[3] = *(const u32x4*)(b_ + (size_t)(ID.y >> 16) * 128); \
        Q[4] = *(const u32x4*)(b_ + (size_t)(ID.z & 0xffffu) * 128); Q[5] = *(const u32x4*)(b_ + (size_t)(ID.z >> 16) * 128); \
        Q[6] = *(const u32x4*)(b_ + (size_t)(ID.w & 0xffffu) * 128); Q[7] = *(const u32x4*)(b_ + (size_t)(ID.w >> 16) * 128); } while (0)
#define LD_X(X, n) do { X = *(const u32x4*)(xq + (size_t)ITEM_T(n) * DM + ITEM_S(n) * 128 + c * 16); } while (0)
#define DOT8(P, OFF, Q, X) do { _Pragma("unroll") for (int i = 0; i < 8; ++i) { int d_ = __builtin_amdgcn_sdot4((int)Q[i].x, (int)X.x, 0, false); d_ = __builtin_amdgcn_sdot4((int)Q[i].y, (int)X.y, d_, false); \
            d_ = __builtin_amdgcn_sdot4((int)Q[i].z, (int)X.z, d_, false); P[(OFF) + i] = __builtin_amdgcn_sdot4((int)Q[i].w, (int)X.w, d_, false); } } while (0)
#define FINISH_U(P, n) do { int p8[8], p4[4], p2[2]; \
        _Pragma("unroll") for (int i = 0; i < 8; ++i) { const int keep_ = up4 ? P[8 + i] : P[i], send_ = up4 ? P[i] : P[8 + i]; p8[i] = keep_ + dpp_hmirror(send_); } \
        _Pragma("unroll") for (int i = 0; i < 4; ++i) { const int keep_ = up2 ? p8[4 + i] : p8[i], send_ = up2 ? p8[i] : p8[4 + i]; p4[i] = keep_ + dpp_qxor2(send_); } \
        _Pragma("unroll") for (int i = 0; i < 2; ++i) { const int keep_ = up1 ? p4[2 + i] : p4[i], send_ = up1 ? p4[i] : p4[2 + i]; p2[i] = keep_ + dpp_qxor1(send_); } \
        *(unsigned*)(part + ((size_t)ITEM_T(n) * 16 + ITEM_S(n)) * NE + 2 * lane) = cvt_pk_bf16((float)p2[0], (float)p2[1]); } while (0)
    u32x4 IA, IB, IC, ID_, QA[8], QB[8], QC[8], QD[8], XA, XB;
    LD_I16(IA, 0, 0); LD_I16(IB, 0, 1); LD_I16(IC, 1, 0); LD_I16(ID_, 1, 1);
    LD_R8(QA, IA, 0); LD_R8(QB, IB, 0); LD_X(XA, 0); LD_R8(QC, IC, 1); LD_R8(QD, ID_, 1); LD_X(XB, 1);
    if (N > 2) { LD_I16(IA, 2, 0); LD_I16(IB, 2, 1); LD_I16(IC, 3, 0); LD_I16(ID_, 3, 1); }
    for (int n = 0; n < N; n += 2) {
        int p[16];
        DOT8(p, 0, QA, XA); if (n + 2 < N) { LD_R8(QA, IA, n + 2); if (n + 4 < N) LD_I16(IA, n + 4, 0); }
        DOT8(p, 8, QB, XA); if (n + 2 < N) { LD_R8(QB, IB, n + 2); LD_X(XA, n + 2); if (n + 4 < N) LD_I16(IB, n + 4, 1); }
        FINISH_U(p, n);
        int r[16];
        DOT8(r, 0, QC, XB); if (n + 3 < N) { LD_R8(QC, IC, n + 3); if (n + 5 < N) LD_I16(IC, n + 5, 0); }
        DOT8(r, 8, QD, XB); if (n + 3 < N) { LD_R8(QD, ID_, n + 3); LD_X(XB, n + 3); if (n + 5 < N) LD_I16(ID_, n + 5, 1); }
        FINISH_U(r, n + 1);
    }
#undef LD_I16
#undef LD_R8
#undef LD_X
#undef DOT8
#undef FINISH_U
}
__device__ __forceinline__ void phase_peer_w(const Args& a) {
    const int gt = blockIdx.x * NTHREADS + tid_opaque(), NGT = gridDim.x * NTHREADS;
    const int* idx_i = (const int*)(a.ws + WS_IDX); const float* gw_i = (const float*)(a.ws + WS_GW); const bf16_t* part = (const bf16_t*)(a.ws + WS_PART);
    const float* suv = (const float*)(a.ws + WS_SUV); const float* sx = (const float*)(a.ws + WS_SX);
    unsigned char* wq = a.ws + WS_WQ; float* sw = (float*)(a.ws + WS_SW);
    for (int item = gt; item < T * NE / 2; item += NGT) {
        const int t = item >> 6, e = (item & 63) * 2;
        unsigned pw[16];
#pragma unroll
        for (int s = 0; s < 16; ++s) pw[s] = *(const unsigned*)(part + ((size_t)t * 16 + s) * NE + e);
        float sum0 = 0.f, sum1 = 0.f;
#pragma unroll
        for (int s = 0; s < 16; ++s) { sum0 += bf_lo(pw[s]); sum1 += bf_hi(pw[s]); }
        const int2 ex = *(const int2*)(idx_i + (size_t)t * NE + e); const f32x2 gg = *(const f32x2*)(gw_i + (size_t)t * NE + e);
        const float sxt = sx[t];
        const float d0 = sum0 * suv[ex.x] * sxt, d1 = sum1 * suv[ex.y] * sxt;
        const float om0 = 0.5f * d0 * (1.f + erff(d0 * 0.70710678118654752f)) * gg.x * suv[NEXP + ex.x];
        const float om1 = 0.5f * d1 * (1.f + erff(d1 * 0.70710678118654752f)) * gg.y * suv[NEXP + ex.y];
        float mx = fmaxf(fabsf(om0), fabsf(om1));
        mx = fmaxf(mx, sx_f(mx, 1)); mx = fmaxf(mx, sx_f(mx, 2)); mx = fmaxf(mx, sx_f(mx, 4));
        const float qs = mx > 0.f ? 127.f / mx : 1.f;
        const int q0 = (int)__builtin_rintf(om0 * qs), q1 = (int)__builtin_rintf(om1 * qs);
        *(unsigned short*)(wq + (size_t)t * NE + e) = (unsigned short)(((unsigned)q0 & 0xffu) | (((unsigned)q1 & 0xffu) << 8));
        if ((e & 15) == 0) sw[t * 8 + (e >> 4)] = mx * (1.f / 127.f);
    }
}
__device__ __forceinline__ void phase_peer_v(const Args& a, float* dst) {
    const int tid = tid_opaque(), lane = tid & 63, wave = tid >> 6, g = lane >> 3, c = lane & 7;
    const int xl = blockIdx.x & 7, wv = (blockIdx.x >> 3) * NWAVES + wave, NWX = (gridDim.x >> 3) * NWAVES, KT = T / NWX, N = 2 * KT;
    const unsigned char* v8 = a.ws + WS_V8;
    const int* idx_i = (const int*)(a.ws + WS_IDX); const unsigned char* wq = a.ws + WS_WQ; const float* sw = (const float*)(a.ws + WS_SW);
    const bf16_t* hsrc = (const bf16_t*)(a.ws + WS_HB);
#define LD_W(W, SWV, HV, n) do { W = *(const u32x4*)(wq + (size_t)ITEM_T(n) * NE + g * 16); SWV = sw[ITEM_T(n) * 8 + g]; HV = *(const unsigned*)(hsrc + (size_t)ITEM_T(n) * DM + ITEM_S(n) * 128 + 2 * lane); } while (0)
#define QUAD(A_, B_, C_, D_, W_, A0, A1, A2, A3) do { \
        const unsigned ablo_ = __builtin_amdgcn_perm(B_, A_, 0x05010400u), abhi_ = __builtin_amdgcn_perm(B_, A_, 0x07030602u); \
        const unsigned cdlo_ = __builtin_amdgcn_perm(D_, C_, 0x05010400u), cdhi_ = __builtin_amdgcn_perm(D_, C_, 0x07030602u); \
        A0 = __builtin_amdgcn_sdot4((int)__builtin_amdgcn_perm(cdlo_, ablo_, 0x05040100u), (int)(W_), A0, false); \
        A1 = __builtin_amdgcn_sdot4((int)__builtin_amdgcn_perm(cdlo_, ablo_, 0x07060302u), (int)(W_), A1, false); \
        A2 = __builtin_amdgcn_sdot4((int)__builtin_amdgcn_perm(cdhi_, abhi_, 0x05040100u), (int)(W_), A2, false); \
        A3 = __builtin_amdgcn_sdot4((int)__builtin_amdgcn_perm(cdhi_, abhi_, 0x07060302u), (int)(W_), A3, false); } while (0)
#define COMPUTE_V(Q, W, SWV, HV, n) do { int ac[16]; _Pragma("unroll") for (int k = 0; k < 16; ++k) ac[k] = 0; \
        _Pragma("unroll") for (int q_ = 0; q_ < 4; ++q_) { const unsigned w_ = q_ == 0 ? W.x : q_ == 1 ? W.y : q_ == 2 ? W.z : W.w; \
            QUAD(Q[4 * q_].x, Q[4 * q_ + 1].x, Q[4 * q_ + 2].x, Q[4 * q_ + 3].x, w_, ac[0], ac[1], ac[2], ac[3]); \
            QUAD(Q[4 * q_].y, Q[4 * q_ + 1].y, Q[4 * q_ + 2].y, Q[4 * q_ + 3].y, w_, ac[4], ac[5], ac[6], ac[7]); \
            QUAD(Q[4 * q_].z, Q[4 * q_ + 1].z, Q[4 * q_ + 2].z, Q[4 * q_ + 3].z, w_, ac[8], ac[9], ac[10], ac[11]); \
            QUAD(Q[4 * q_].w, Q[4 * q_ + 1].w, Q[4 * q_ + 2].w, Q[4 * q_ + 3].w, w_, ac[12], ac[13], ac[14], ac[15]); } \
        float p[16]; _Pragma("unroll") for (int k = 0; k < 16; ++k) p[k] = (float)ac[k] * SWV; \
        float p8[8], p4[4], p2[2]; \
        _Pragma("unroll") for (int i_ = 0; i_ < 8; ++i_) { auto rr_ = __builtin_amdgcn_permlane32_swap(__float_as_uint(p[i_]), __float_as_uint(p[8 + i_]), false, false); p8[i_] = __uint_as_float(rr_[0]) + __uint_as_float(rr_[1]); } \
        _Pragma("unroll") for (int i_ = 0; i_ < 4; ++i_) { auto rr_ = __builtin_amdgcn_permlane16_swap(__float_as_uint(p8[i_]), __float_as_uint(p8[4 + i_]), false, false); p4[i_] = __uint_as_float(rr_[0]) + __uint_as_float(rr_[1]); } \
        HALVE(p2, p4, 2, 8); \
        const int srcl_ = ((lane & 7) << 3) | (lane >> 3);                     \
        const float q0_ = sh_f(p2[0], srcl_), q1_ = sh_f(p2[1], srcl_); \
        const size_t o_ = (size_t)ITEM_T(n) * DM + ITEM_S(n) * 128 + 2 * lane; \
        *(f32x2*)(dst + o_) = (f32x2){bf_lo(HV) + q0_, bf_hi(HV) + q1_}; } while (0)
    int4 IA[4], IB[4]; u32x4 QA[16], QB[16], WA, WB; float SA, SB_; unsigned HA, HB_;
    LD_IDX(IA, 0); LD_IDX(IB, 1);
    LD_ROWS(QA, IA, v8, 0); LD_W(WA, SA, HA, 0);
    for (int n = 0; n < N; n += 2) {
        LD_ROWS(QB, IB, v8, n + 1); LD_W(WB, SB_, HB_, n + 1);
        if (n + 2 < N) LD_IDX(IA, n + 2);
        COMPUTE_V(QA, WA, SA, HA, n);
        if (n + 2 < N) { LD_ROWS(QA, IA, v8, n + 2); LD_W(WA, SA, HA, n + 2); }
        if (n + 3 < N) LD_IDX(IB, n + 3);
        COMPUTE_V(QB, WB, SB_, HB_, n + 1);
    }
#undef LD_W
#undef QUAD
#undef COMPUTE_V
}
#undef ITEM_T
#undef ITEM_S
#undef LD_IDX
#undef LD_ROWS
#undef HALVE


constexpr int NPHASE = 11;
#define LOAD_ARGS() do { } while (0)
__global__ void __launch_bounds__(NTHREADS, 2) fwd_kernel(Args a) {
    extern __shared__ __attribute__((aligned(16))) unsigned char lds[];
#if MK_ONE_LAUNCH
    constexpr int lo = 0, hi = NPHASE;
    cg::grid_group grid = cg::this_grid();
    volatile LAS unsigned* misc = (volatile LAS unsigned*)((LAS unsigned char*)lds + MISC_OFF);
    if (threadIdx.x < 16) misc[threadIdx.x] = 0u;
    __syncthreads();
    { LOAD_ARGS(); (void)xcd_barrier_post((unsigned*)(a.ws + WS_CTL) + CW_BAR, misc + 8); }
#ifndef SEAM_CG_MASK
#define SEAM_CG_MASK 0
#endif
#define SEAM(k) do { if (lo <= (k) && (k) + 1 < hi) { if ((SEAM_CG_MASK >> (k)) & 1) grid.sync(); else { LOAD_ARGS(); XcdBarrier xb_; xb_.bar = (unsigned*)(a.ws + WS_CTL) + CW_BAR; xb_.x = xb_xcc_id(); \
        xb_.st = (volatile LAS unsigned*)((LAS unsigned char*)lds + MISC_OFF) + 8; xcd_barrier(xb_); } } } while (0)
#else
    int lo, hi; { LOAD_ARGS(); lo = a.ph_lo; hi = a.ph_hi; }
#define SEAM(k) do { } while (0)
#endif
#define IN(k) (lo <= (k) && (k) < hi)
#ifndef DUP_PHASE
#define DUP_PHASE -1
#endif
    if (IN(0)) { LOAD_ARGS(); phase0(a, lds); if (DUP_PHASE == 0) { __syncthreads(); phase0(a, lds); } SEAM(0); }
    if (IN(1)) { LOAD_ARGS(); unsigned char* ws = a.ws;
        pg8::Gemm g{(const bf16_t*)(ws + WS_XN), (const bf16_t*)(ws + WS_WIN), T, NPROJ, DM}; pg8::StaticOrder S; S.init(T, NPROJ, (int)gridDim.x, (int)blockIdx.x);
        pg8::EpiInProj E{(bf16_t*)(ws + WS_SEC), (const float*)(ws + WS_SXN), (const float*)(ws + WS_WSC), a.in[4], a.in[5], (LAS float*)((LAS unsigned char*)lds + RING_BYTES)};
        for (int rep_ = 0; rep_ < (DUP_PHASE == 1 ? 2 : 1); ++rep_)
        pg8::gemm_phase<pg8::EpiInProj, pg8::StaticOrder, true, true, true>((LAS unsigned char*)lds, g, S, E);
        cumsum_rows(a);
        { const int nwg_ = (T / 256) * (NPROJ / 256), G_ = (int)gridDim.x, rem_ = nwg_ % G_;
          if (rem_ > 0 && (int)blockIdx.x >= rem_) convert_tables(a, TAB_SPLIT, 2 * NEXP, ((int)blockIdx.x - rem_) * NWAVES + (tid_opaque() >> 6), (G_ - rem_) * NWAVES);
          else if (rem_ == 0) convert_tables(a, TAB_SPLIT, 2 * NEXP, (int)blockIdx.x * NWAVES + (tid_opaque() >> 6), G_ * NWAVES); }
        SEAM(1);
    }
    if (IN(3)) { LOAD_ARGS(); phase_attn(a, lds);
#if MK_ONE_LAUNCH
        if (DUP_PHASE == 3) { XcdBarrier xb_; xb_.bar = (unsigned*)(a.ws + WS_CTL) + CW_BAR; xb_.x = xb_xcc_id(); xb_.st = (volatile LAS unsigned*)((LAS unsigned char*)lds + MISC_OFF) + 8;
            xcd_barrier(xb_); if (blockIdx.x == 0 && threadIdx.x == 0) __hip_atomic_store((unsigned*)(a.ws + WS_CTL), 0u, __ATOMIC_RELAXED, __HIP_MEMORY_SCOPE_AGENT); xcd_barrier(xb_); phase_attn(a, lds); }
#endif
        SEAM(3); }
    if (IN(4)) { LOAD_ARGS(); phase_attn_combine(a); SEAM(4); }
    if (IN(5)) { LOAD_ARGS(); unsigned char* ws = a.ws;
        pg8::Gemm g{(const bf16_t*)(ws + WS_MIX), (const bf16_t*)(ws + WS_WOUT), T, DM, DM}; pg8::StaticOrder S; S.init(T, DM, (int)gridDim.x, (int)blockIdx.x);
        pg8::EpiOutProj E{a.in[0], a.out, (bf16_t*)(ws + WS_HB), (float*)(ws + WS_SSQ), (float*)(ws + WS_AMX)};
        for (int rep_ = 0; rep_ < (DUP_PHASE == 5 ? 2 : 1); ++rep_)
        pg8::gemm_phase<pg8::EpiOutProj, pg8::StaticOrder, true, true>((LAS unsigned char*)lds, g, S, E);
        SEAM(5);
    }
    if (IN(6)) { LOAD_ARGS(); unsigned char* ws = a.ws;
        pg8::Gemm g{(const bf16_t*)(ws + WS_HB), (const bf16_t*)(ws + WS_WPQ), T, DM, DM}; pg8::StaticOrder S; S.init(T, DM, (int)gridDim.x, (int)blockIdx.x);
        pg8::EpiPeerQFused E{(const float*)(ws + WS_SSQ), ws};
        pg8::gemm_phase<pg8::EpiPeerQFused, pg8::StaticOrder, true, true>((LAS unsigned char*)lds, g, S, E);
        SEAM(6);
    }
    if (IN(8)) { LOAD_ARGS(); for (int rep_ = 0; rep_ < (DUP_PHASE == 8 ? 2 : 1); ++rep_) phase_peer_u(a); SEAM(8); }
    if (IN(9)) { LOAD_ARGS(); for (int rep_ = 0; rep_ < (DUP_PHASE == 9 ? 2 : 1); ++rep_) phase_peer_w(a); SEAM(9); }
    if (IN(10)) { LOAD_ARGS(); for (int rep_ = 0; rep_ < (DUP_PHASE == 10 ? 2 : 1); ++rep_) phase_peer_v(a, (DUP_PHASE == 10 && rep_ == 0) ? (float*)(a.ws + WS_END) : a.out); }
#undef IN
#undef SEAM
}

extern "C" void kernel_launch(void* const* d_in, const int* in_sizes, int n_in, void* d_out, int out_size, void* d_ws, size_t ws_size, hipStream_t stream) {
    static int grid = 0;
    if (grid == 0) {
        if (n_in != 12 || in_sizes[0] != T * DM || out_size != T * DM || ws_size < WS_END) { fprintf(stderr, "kernel_launch: unexpected shapes (n_in %d, in0 %d, out %d, ws %zu)\n", n_in, n_in > 0 ? in_sizes[0] : -1, out_size, ws_size); grid = -1; return; }
        int dev = 0, cus = 0, per_cu = 0;
        if (hipGetDevice(&dev) != hipSuccess || hipDeviceGetAttribute(&cus, hipDeviceAttributeMultiprocessorCount, dev) != hipSuccess) { grid = -1; return; }
        if (hipFuncSetAttribute((const void*)fwd_kernel, hipFuncAttributeMaxDynamicSharedMemorySize, LDS_BYTES) != hipSuccess) { fprintf(stderr, "kernel_launch: hipFuncSetAttribute failed\n"); grid = -1; return; }
        if (hipOccupancyMaxActiveBlocksPerMultiprocessor(&per_cu, (const void*)fwd_kernel, NTHREADS, LDS_BYTES) != hipSuccess || per_cu < 1) { fprintf(stderr, "kernel_launch: occupancy query says %d\n", per_cu); grid = -1; return; }
        grid = cus;
    }
    if (grid < 0) return;
    (void)hipMemsetAsync((char*)d_ws + WS_CTL, 0, CTL_BYTES, stream);
    Args a{};
    for (int i = 0; i < 12; ++i) a.in[i] = (const float*)d_in[i];
    a.out = (float*)d_out; a.ws = (unsigned char*)d_ws;
#if MK_ONE_LAUNCH
    a.ph_lo = 0; a.ph_hi = NPHASE;
    void* args[] = {&a};
#if MK_COOP_LAUNCH
    hipError_t e = hipLaunchCooperativeKernel((const void*)fwd_kernel, dim3(grid), dim3(NTHREADS), args, LDS_BYTES, stream);
    if (e != hipSuccess) fprintf(stderr, "cooperative launch failed: %s (grid %d)\n", hipGetErrorString(e), grid);
#else
    (void)args; hipLaunchKernelGGL(fwd_kernel, dim3(grid), dim3(NTHREADS), LDS_BYTES, stream, a);
#endif
#else
    for (int p = 0; p < NPHASE; ++p) { a.ph_lo = p; a.ph_hi = p + 1; hipLaunchKernelGGL(fwd_kernel, dim3(grid), dim3(NTHREADS), LDS_BYTES, stream, a); }
#endif
}
```

```cpp
#include <hip/hip_runtime.h>
#include <hip/hip_cooperative_groups.h>
#include <cstdio>
#include <cstdint>
namespace cg = cooperative_groups;

#ifndef MK_COOP_LAUNCH
#define MK_COOP_LAUNCH 0
#endif
#ifndef MK_ONE_LAUNCH
#define MK_ONE_LAUNCH 1
#ifndef TAB_P0_ROWS
#define TAB_P0_ROWS 16384
#endif
#ifndef TAB_P1_ROWS
#define TAB_P1_ROWS 8064
#endif
#endif

#define LAS __attribute__((address_space(3)))
typedef unsigned short bf16_t;
typedef short bf16x8 __attribute__((ext_vector_type(8)));
typedef short s16x4 __attribute__((ext_vector_type(4)));
typedef float f32x2 __attribute__((ext_vector_type(2)));
typedef float f32x4 __attribute__((ext_vector_type(4)));
typedef float f32x16 __attribute__((ext_vector_type(16)));
typedef unsigned u32x2 __attribute__((ext_vector_type(2)));
typedef unsigned u32x4 __attribute__((ext_vector_type(4)));
typedef __bf16 bf16x2_t __attribute__((ext_vector_type(2)));

constexpr int NB = 2, SEQ = 4096, T = NB * SEQ, DM = 2048, HD = 128, NHF = 8, DIN = 7176, NPROJ = 7168;
constexpr int NEXP = 16384, NE = 128;
constexpr float EPS = 1e-6f;
constexpr float SCALE = 0.08838834764831845f, LOG2E = 1.4426950408889634f;
constexpr int NWAVES = 8, NTHREADS = 512, GRID_WGS = 256;

constexpr size_t MiB = 1u << 20;
constexpr size_t WS_CTL = 0, CTL_BYTES = 32768;
constexpr int CW_BAR = 1024;
constexpr size_t WS_SXN = 64 * MiB  , WS_WSC = 45 * MiB + 800 * 1024  ;
constexpr int CW_DONE = 128;
constexpr size_t WS_GQK = 45 * MiB + 768 * 1024;
constexpr size_t WS_WIN = 1 * MiB, WS_WOUT = 29 * MiB, WS_WPQ = 37 * MiB, WS_SK = 45 * MiB, WS_LOGF = 46 * MiB, WS_C = 46 * MiB + 512 * 1024, WS_SSQ = 47 * MiB;
constexpr size_t WS_XN = 48 * MiB;
constexpr size_t WS_SEC = 80 * MiB;
constexpr size_t SEC_ELEMS = 8u << 20;
constexpr size_t WS_MIX = 192 * MiB, WS_HB = 224 * MiB, WS_QP = 256 * MiB, WS_IDX = 288 * MiB, WS_GW = 292 * MiB, WS_U8 = 296 * MiB, WS_V8 = 328 * MiB, WS_SUV = 360 * MiB  , WS_RT = 360 * MiB + 256 * 1024  , WS_W = 361 * MiB  ,
                 WS_PART = 368 * MiB  , WS_XQ = 432 * MiB  , WS_END = 448 * MiB;
constexpr size_t WS_IDX16 = 366 * MiB  ;
constexpr size_t WS_AMX = 365 * MiB  , WS_SX = WS_RT + 64 * 1024  , WS_WQ = WS_W  , WS_SW = WS_W + 2 * MiB  ;
constexpr size_t WS_PO = WS_PART  , WS_PML = WS_PART + 32 * MiB  ;

constexpr int RING_BYTES = 131072;
constexpr int MISC_OFF = 143360;
constexpr int LDS_BYTES = 147456;

__device__ __forceinline__ unsigned cvt_pk_bf16(float lo, float hi) { unsigned r; asm volatile("v_cvt_pk_bf16_f32 %0, %1, %2" : "=v"(r) : "v"(lo), "v"(hi)); return r; }
__device__ __forceinline__ float bf_lo(unsigned u) { return __builtin_bit_cast(float, u << 16); }
__device__ __forceinline__ float bf_hi(unsigned u) { return __builtin_bit_cast(float, u & 0xffff0000u); }
__device__ __forceinline__ int lane_id_fresh() { int l = (int)__builtin_amdgcn_mbcnt_hi(~0u, __builtin_amdgcn_mbcnt_lo(~0u, 0u)); asm volatile("" : "+v"(l)); return l; }
__device__ __forceinline__ int sx_i(int v, int m) { return __builtin_amdgcn_ds_bpermute((lane_id_fresh() ^ m) << 2, v); }
__device__ __forceinline__ float sx_f(float v, int m) { return __int_as_float(__builtin_amdgcn_ds_bpermute((lane_id_fresh() ^ m) << 2, __float_as_int(v))); }
__device__ __forceinline__ int sh_i(int v, int src) { return __builtin_amdgcn_ds_bpermute(src << 2, v); }
__device__ __forceinline__ float sh_f(float v, int src) { return __int_as_float(__builtin_amdgcn_ds_bpermute(src << 2, __float_as_int(v))); }
__device__ __forceinline__ float shup_f(float v, int d) { const int l = lane_id_fresh(); const int s = l - d; return __int_as_float(__builtin_amdgcn_ds_bpermute((s < 0 ? l : s) << 2, __float_as_int(v))); }
__device__ __forceinline__ float wave_sum(float v) {
    v += __int_as_float(__builtin_amdgcn_update_dpp(0, __float_as_int(v), 0xB1, 0xf, 0xf, true));
    v += __int_as_float(__builtin_amdgcn_update_dpp(0, __float_as_int(v), 0x4E, 0xf, 0xf, true));
    v += __int_as_float(__builtin_amdgcn_update_dpp(0, __float_as_int(v), 0x141, 0xf, 0xf, true));
    v += __int_as_float(__builtin_amdgcn_update_dpp(0, __float_as_int(v), 0x140, 0xf, 0xf, true));
    { auto rr = __builtin_amdgcn_permlane16_swap(__float_as_uint(v), __float_as_uint(v), false, false); v = __uint_as_float(rr[0]) + __uint_as_float(rr[1]); }
    { auto rr = __builtin_amdgcn_permlane32_swap(__float_as_uint(v), __float_as_uint(v), false, false); v = __uint_as_float(rr[0]) + __uint_as_float(rr[1]); }
    return v;
}
#define DPP_QX1 0xB1
#define DPP_QX2 0x4E
#define DPP_HMIR 0x141
#define DPP_MIR 0x140
__device__ __forceinline__ float wave_max(float v) {
    v = fmaxf(v, __int_as_float(__builtin_amdgcn_update_dpp(0, __float_as_int(v), DPP_QX1, 0xf, 0xf, true)));
    v = fmaxf(v, __int_as_float(__builtin_amdgcn_update_dpp(0, __float_as_int(v), DPP_QX2, 0xf, 0xf, true)));
    v = fmaxf(v, __int_as_float(__builtin_amdgcn_update_dpp(0, __float_as_int(v), DPP_HMIR, 0xf, 0xf, true)));
    v = fmaxf(v, __int_as_float(__builtin_amdgcn_update_dpp(0, __float_as_int(v), DPP_MIR, 0xf, 0xf, true)));
    { auto rr = __builtin_amdgcn_permlane16_swap(__float_as_uint(v), __float_as_uint(v), false, false); v = fmaxf(__uint_as_float(rr[0]), __uint_as_float(rr[1])); }
    { auto rr = __builtin_amdgcn_permlane32_swap(__float_as_uint(v), __float_as_uint(v), false, false); v = fmaxf(__uint_as_float(rr[0]), __uint_as_float(rr[1])); }
    return v;
}
__device__ __forceinline__ int tid_opaque() { int t = (int)threadIdx.x; asm volatile("" : "+v"(t)); return t; }
#define LDS_WAIT() asm volatile("s_waitcnt lgkmcnt(0)" ::: "memory")

namespace pg8 {
#define PG8_LAS __attribute__((address_space(3)))
constexpr int BM = 256, BK = 64, HALF = 128, HTB = HALF * BK * 2, STAGE_BYTES = 8 * HTB, NXCD = 8, WGM = 4;
__host__ __device__ __forceinline__ int lds_byte(int r, int c) { const int st = (r >> 4) * 2 + (c >> 5), rr = r & 15, cc = c & 31, ob = rr * 64 + cc * 2; return st * 1024 + (ob ^ (((ob >> 9) & 1) << 5)); }
__host__ __device__ __forceinline__ void stage_rc(int b, int& R, int& C) { const int st = b / 1024, sb = b % 1024, swz = sb ^ (((sb >> 9) & 1) << 5); R = (st >> 1) * 16 + swz / 64; C = (st & 1) * 32 + (swz % 64) / 2; }
__host__ __device__ __forceinline__ int perm32(int rho) { const int n = rho >> 4, i = rho & 15; return 8 * (i >> 2) + 4 * n + (i & 3); }
struct Unit { int pm, pn; };
struct Gemm { const bf16_t* A; const bf16_t* Bt; int M, N, K; };
struct StaticOrder {
    int nM, nN, nwg, G, c; bool extra_first = false;
    __host__ __device__ void init(int M, int N, int G_, int c_) { nM = M / BM; nN = N / BM; nwg = nM * nN; G = G_; c = c_; }
    __host__ __device__ bool next(int i, Unit& u) const {
        int ii = i;
        if (extra_first) { const int nfull = nwg / G, rem = nwg % G; if (c < rem) { if (i > nfull) return false; ii = (i == 0) ? nfull : i - 1; } else if (i >= nfull) return false; }
        const long L = (long)ii * G + c; if (L >= nwg) return false;
        int wgid = (int)L; { const int q = nwg / NXCD, r = nwg % NXCD, xcd = wgid % NXCD, off = wgid / NXCD; wgid = (xcd < r ? xcd * (q + 1) : r * (q + 1) + (xcd - r) * q) + off; }
        const int nig = WGM * nN, gid = wgid / nig, fm = gid * WGM, gsz = (nM - fm) < WGM ? (nM - fm) : WGM;
        u.pm = fm + ((wgid % nig) % gsz); u.pn = (wgid % nig) / gsz; return true;
    }
    __device__ __forceinline__ void a_ready(const Unit&) const {}
    __device__ __forceinline__ void done(const Unit&) const {}
};

typedef int i32x4 __attribute__((ext_vector_type(4)));
template <bool I8> struct AccT { typedef f32x4 type; };
template <> struct AccT<true> { typedef i32x4 type; };
template <class Epi, class Sched, bool ALIGN_EPI = false, bool SP2 = false, bool I8 = false>
__device__ __forceinline__ void gemm_phase(PG8_LAS unsigned char* lds, const Gemm g, const Sched& S, const Epi& E) {
    typedef typename AccT<I8>::type acc_t;
    const int tid = tid_opaque(), wid = __builtin_amdgcn_readfirstlane(tid >> 6), lane = tid & 63, wr = wid >> 2, wc = wid & 3, fr = lane & 15, fq = lane >> 4;
    const int rowb = I8 ? g.K : 2 * g.K, nt = rowb / (BK * 2);
    unsigned voffA[2], voffB[2];
#pragma unroll
    for (int i = 0; i < 2; ++i) { int R, C; stage_rc(tid * 16 + i * 8192, R, C); const int Rb = Epi::PERM ? ((R & ~31) + perm32(R & 31)) : R;
        voffA[i] = (unsigned)(R * rowb + C * 2); voffB[i] = (unsigned)(Rb * rowb + C * 2); }
    const size_t kstep = (size_t)(BK * 2);
    const size_t hstep = (size_t)HALF * rowb;
    const size_t tstep = 2 * hstep;
    const unsigned ldsw = (unsigned)wid * 1024u;
    const int aoff = lds_byte(wr * 64 + fr, fq * 8), boff = lds_byte(wc * 32 + fr, fq * 8);
#define PG8_SA(b, h) (((b) * 2 + (h)) * HTB)
#define PG8_SB(b, h) ((4 + (b) * 2 + (h)) * HTB)
#define PG8_STAGE(bufoff, gbase, voff) do { _Pragma("unroll") for (int _i = 0; _i < 2; ++_i) \
        __builtin_amdgcn_global_load_lds((const unsigned*)((const char*)(gbase) + (voff)[_i]), (PG8_LAS unsigned*)(lds + (bufoff) + ldsw + _i * 8192), 16, 0, 0); } while (0)
#define PG8_LDA(dst, b, h) do { _Pragma("unroll") for (int m = 0; m < 4; ++m) _Pragma("unroll") for (int k = 0; k < 2; ++k) dst[m][k] = *(const PG8_LAS bf16x8*)(lds + PG8_SA(b, h) + aoff + m * 2048 + k * 1024); } while (0)
#define PG8_LDB(dst, b, h) do { _Pragma("unroll") for (int n = 0; n < 2; ++n) _Pragma("unroll") for (int k = 0; k < 2; ++k) dst[n][k] = *(const PG8_LAS bf16x8*)(lds + PG8_SB(b, h) + boff + n * 2048 + k * 1024); } while (0)
#define PG8_MMA(ai, bj, At, Bt) do { __builtin_amdgcn_s_setprio(1); _Pragma("unroll") for (int m = 0; m < 4; ++m) _Pragma("unroll") for (int n = 0; n < 2; ++n) _Pragma("unroll") for (int k = 0; k < 2; ++k) \
        { if constexpr (I8) acc[ai][bj][m][n] = __builtin_amdgcn_mfma_i32_16x16x64_i8(__builtin_bit_cast(i32x4, Bt[n][k]), __builtin_bit_cast(i32x4, At[m][k]), acc[ai][bj][m][n], 0, 0, 0); \
          else acc[ai][bj][m][n] = __builtin_amdgcn_mfma_f32_16x16x32_bf16(Bt[n][k], At[m][k], acc[ai][bj][m][n], 0, 0, 0); } __builtin_amdgcn_s_setprio(0); } while (0)
#define PG8_WAIT_V(n) asm volatile("s_waitcnt vmcnt(" #n ")" ::: "memory")
#define PG8_WAIT_L(n) asm volatile("s_waitcnt lgkmcnt(" #n ")" ::: "memory")
#define PG8_BAR __builtin_amdgcn_s_barrier()
#define PG8_SCHED __builtin_amdgcn_sched_barrier(0)
    Unit cur, nxt; int ui = 0;
    if (!S.next(0, cur)) return;
    acc_t acc[2][2][4][2];
#pragma unroll
    for (int a = 0; a < 2; ++a)
#pragma unroll
        for (int b = 0; b < 2; ++b)
#pragma unroll
            for (int m = 0; m < 4; ++m)
#pragma unroll
                for (int n = 0; n < 2; ++n) acc[a][b][m][n] = acc_t{};
    bf16x8 At[4][2], B0[2][2], B1[2][2];
    const char* cA = (const char*)g.A + (size_t)cur.pm * tstep; const char* cB = (const char*)g.Bt + (size_t)cur.pn * tstep;
    S.a_ready(cur);
    if constexpr (SP2) {
        PG8_STAGE(PG8_SB(0, 0), cB, voffB); PG8_STAGE(PG8_SB(0, 1), cB + hstep, voffB); PG8_STAGE(PG8_SA(0, 0), cA, voffA); PG8_STAGE(PG8_SA(0, 1), cA + hstep, voffA);
        if (wr == 1) PG8_BAR;
        PG8_WAIT_V(2); PG8_BAR;
        PG8_STAGE(PG8_SB(1, 0), cB + kstep, voffB); PG8_STAGE(PG8_SA(1, 0), cA + kstep, voffA); PG8_STAGE(PG8_SB(1, 1), cB + hstep + kstep, voffB);
        PG8_WAIT_V(6); PG8_BAR;
    } else {
        PG8_STAGE(PG8_SB(0, 0), cB, voffB); PG8_STAGE(PG8_SA(0, 0), cA, voffA); PG8_STAGE(PG8_SB(0, 1), cB + hstep, voffB); PG8_STAGE(PG8_SA(0, 1), cA + hstep, voffA);
        if (wr == 1) PG8_BAR;
        PG8_WAIT_V(4); PG8_BAR;
        PG8_STAGE(PG8_SB(1, 0), cB + kstep, voffB); PG8_STAGE(PG8_SA(1, 0), cA + kstep, voffA); PG8_STAGE(PG8_SB(1, 1), cB + hstep + kstep, voffB);
        PG8_WAIT_V(6); PG8_BAR;
    }
    for (;;) {
        const bool has_next = S.next(ui + 1, nxt);
        const char* nA = has_next ? (const char*)g.A + (size_t)nxt.pm * tstep : cA; const char* nB = has_next ? (const char*)g.Bt + (size_t)nxt.pn * tstep : cB;
        for (int t = 0; t < nt; t += 2) {
            const bool last = (t == nt - 2);
            const char* a1 = cA + (size_t)(t + 1) * kstep;
            const char* a2 = last ? nA : cA + (size_t)(t + 2) * kstep; const char* b2 = last ? nB : cB + (size_t)(t + 2) * kstep;
            const char* a3 = a2 + kstep; const char* b3 = b2 + kstep;
            if (last && has_next) S.a_ready(nxt);
            if constexpr (SP2) {
            PG8_LDB(B0, 0, 0); PG8_LDB(B1, 0, 1); PG8_SCHED; PG8_LDA(At, 0, 0); PG8_STAGE(PG8_SA(1, 1), a1 + hstep, voffA);
            PG8_WAIT_V(8); PG8_WAIT_L(0); PG8_BAR; PG8_MMA(0, 0, At, B0); PG8_MMA(0, 1, At, B1); PG8_BAR; PG8_SCHED;
            PG8_LDA(At, 0, 1); PG8_STAGE(PG8_SB(0, 0), b2, voffB); PG8_STAGE(PG8_SB(0, 1), b2 + hstep, voffB); PG8_STAGE(PG8_SA(0, 0), a2, voffA);
            PG8_WAIT_V(8); PG8_WAIT_L(0); PG8_BAR; PG8_MMA(1, 0, At, B0); PG8_MMA(1, 1, At, B1); PG8_BAR; PG8_SCHED;
            PG8_LDB(B0, 1, 0); PG8_LDB(B1, 1, 1); PG8_SCHED; PG8_LDA(At, 1, 0); PG8_STAGE(PG8_SA(0, 1), a2 + hstep, voffA);
            PG8_WAIT_V(8); PG8_WAIT_L(0); PG8_BAR; PG8_MMA(0, 0, At, B0); PG8_MMA(0, 1, At, B1); PG8_BAR; PG8_SCHED;
            PG8_LDA(At, 1, 1); PG8_STAGE(PG8_SB(1, 0), b3, voffB); PG8_STAGE(PG8_SB(1, 1), b3 + hstep, voffB); PG8_STAGE(PG8_SA(1, 0), a3, voffA);
            PG8_WAIT_V(8); PG8_WAIT_L(0); PG8_BAR; PG8_MMA(1, 0, At, B0); PG8_MMA(1, 1, At, B1); PG8_BAR; PG8_SCHED;
            } else {
            PG8_LDB(B0, 0, 0); PG8_SCHED; PG8_LDA(At, 0, 0); PG8_STAGE(PG8_SA(1, 1), a1 + hstep, voffA);
            PG8_WAIT_L(8); PG8_BAR; PG8_WAIT_L(0); PG8_MMA(0, 0, At, B0); PG8_BAR; PG8_SCHED;
            PG8_LDB(B1, 0, 1); PG8_STAGE(PG8_SB(0, 0), b2, voffB);
            PG8_BAR; PG8_WAIT_L(0); PG8_MMA(0, 1, At, B1); PG8_BAR;
            PG8_LDA(At, 0, 1); PG8_STAGE(PG8_SA(0, 0), a2, voffA);
            PG8_BAR; PG8_WAIT_L(0); PG8_MMA(1, 0, At, B0); PG8_BAR; PG8_SCHED;
            PG8_STAGE(PG8_SB(0, 1), b2 + hstep, voffB);
            PG8_WAIT_V(6); PG8_BAR; PG8_MMA(1, 1, At, B1); PG8_BAR;
            PG8_LDB(B0, 1, 0); PG8_SCHED; PG8_LDA(At, 1, 0); PG8_STAGE(PG8_SA(0, 1), a2 + hstep, voffA);
            PG8_WAIT_L(8); PG8_BAR; PG8_WAIT_L(0); PG8_MMA(0, 0, At, B0); PG8_BAR; PG8_SCHED;
            PG8_LDB(B1, 1, 1); PG8_STAGE(PG8_SB(1, 0), b3, voffB);
            PG8_BAR; PG8_WAIT_L(0); PG8_MMA(0, 1, At, B1); PG8_BAR;
            PG8_LDA(At, 1, 1); PG8_STAGE(PG8_SA(1, 0), a3, voffA);
            PG8_BAR; PG8_WAIT_L(0); PG8_MMA(1, 0, At, B0); PG8_BAR; PG8_SCHED;
            PG8_STAGE(PG8_SB(1, 1), b3 + hstep, voffB);
            PG8_WAIT_V(6); PG8_BAR; PG8_MMA(1, 1, At, B1); PG8_BAR;
            }
        }
        if constexpr (ALIGN_EPI) { if (wr == 0) PG8_BAR; }
        if constexpr (!Epi::AFTER_DRAIN) { E(acc, cur, wr, wc, fr, fq); } S.done(cur);
        if (!has_next) break;
#pragma unroll
        for (int a = 0; a < 2; ++a)
#pragma unroll
            for (int b = 0; b < 2; ++b)
#pragma unroll
                for (int m = 0; m < 4; ++m)
#pragma unroll
                    for (int n = 0; n < 2; ++n) acc[a][b][m][n] = acc_t{};
        cur = nxt; cA = nA; cB = nB; ++ui;
        if constexpr (ALIGN_EPI) { if (wr == 1) PG8_BAR; }
    }
    PG8_WAIT_V(0);
    if constexpr (!ALIGN_EPI) { if (wr == 0) PG8_BAR; }
    PG8_BAR;
    if constexpr (Epi::AFTER_DRAIN) E.fused(acc, cur, wr, wc, fr, fq, lds);
#undef PG8_SA
#undef PG8_SB
#undef PG8_STAGE
#undef PG8_LDA
#undef PG8_LDB
#undef PG8_MMA
#undef PG8_WAIT_V
#undef PG8_WAIT_L
#undef PG8_BAR
#undef PG8_SCHED
}

__device__ __forceinline__ float sigmoidf_fast(float x) { return __builtin_amdgcn_rcpf(1.f + __builtin_amdgcn_exp2f(-x * LOG2E)); }
struct EpiInProj {
    static constexpr bool PERM = true, AFTER_DRAIN = false;
    bf16_t* base; const float* sxn  ; const float* wsc  ;
    const float* gq; const float* gk; PG8_LAS float* xch  ;
    __device__ __forceinline__ void operator()(const i32x4 (&acci)[2][2][4][2], const Unit& u, int wr, int wc, int fr, int fq) const {
        const int sec = u.pn >> 2;
        float rsv[2][4];
#pragma unroll
        for (int ai = 0; ai < 2; ++ai)
#pragma unroll
            for (int m = 0; m < 4; ++m) rsv[ai][m] = sxn[u.pm * BM + ai * HALF + wr * 64 + m * 16 + fr];
        f32x4 wcs[2][2];
#pragma unroll
        for (int bj = 0; bj < 2; ++bj) { const float* wp_ = wsc + u.pn * BM + bj * HALF + wc * 32 + 8 * fq; wcs[bj][0] = *(const f32x4*)wp_; wcs[bj][1] = *(const f32x4*)(wp_ + 4); }
        bf16_t* sb = base + (size_t)sec * SEC_ELEMS;
        const float sc = (sec == 4) ? SCALE * LOG2E : 1.f;
        if (sec < 2) {
#pragma unroll
            for (int ai = 0; ai < 2; ++ai)
#pragma unroll
                for (int m = 0; m < 4; ++m) {
                    const int tk = u.pm * BM + ai * HALF + wr * 64 + m * 16 + fr;
                    const float rs = rsv[ai][m];
#pragma unroll
                    for (int bj = 0; bj < 2; ++bj) {
                        const f32x4 v0 = __builtin_convertvector(acci[ai][bj][m][0], f32x4) * wcs[bj][0] * rs, v1 = __builtin_convertvector(acci[ai][bj][m][1], f32x4) * wcs[bj][1] * rs;
                        float ss = v0[0] * v0[0] + v0[1] * v0[1] + v0[2] * v0[2] + v0[3] * v0[3] + v1[0] * v1[0] + v1[1] * v1[1] + v1[2] * v1[2] + v1[3] * v1[3];
                        ss += sx_f(ss, 16); ss += sx_f(ss, 32);
                        if (fq == 0) xch[(((((wr * 2 + ai) * 4 + m) * 16 + fr) * 2 + bj) * 4) + wc] = ss;
                    }
                }
            asm volatile("s_waitcnt lgkmcnt(0)" ::: "memory");
            __builtin_amdgcn_s_barrier();
            const float* gp = (sec == 0 ? gq : gk) + wc * 32 + 8 * fq;
            const f32x4 g0_ = *(const f32x4*)gp, g1_ = *(const f32x4*)(gp + 4);
            const f32x4 gw[2][2] = {{g0_ * wcs[0][0], g1_ * wcs[0][1]}, {g0_ * wcs[1][0], g1_ * wcs[1][1]}};
#pragma unroll
            for (int ai = 0; ai < 2; ++ai)
#pragma unroll
                for (int m = 0; m < 4; ++m) {
                    const int tk = u.pm * BM + ai * HALF + wr * 64 + m * 16 + fr, b = tk >> 12, s = tk & 4095;
                    const float rs = rsv[ai][m];
#pragma unroll
                    for (int bj = 0; bj < 2; ++bj) {
                        const int hh = (u.pn & 3) * 2 + bj;
                        const f32x4 p4 = *(const PG8_LAS f32x4*)(xch + (((((wr * 2 + ai) * 4 + m) * 16 + fr) * 2 + bj) * 4));
                        const float r = rs / sqrtf(((p4[0] + p4[1]) + (p4[2] + p4[3])) * (1.f / 128.f) + EPS);
                        const f32x4 v0 = __builtin_convertvector(acci[ai][bj][m][0], f32x4) * gw[bj][0] * r, v1 = __builtin_convertvector(acci[ai][bj][m][1], f32x4) * gw[bj][1] * r;
                        u32x4 w; w.x = cvt_pk_bf16(v0[0], v0[1]); w.y = cvt_pk_bf16(v0[2], v0[3]); w.z = cvt_pk_bf16(v1[0], v1[1]); w.w = cvt_pk_bf16(v1[2], v1[3]);
                        *(u32x4*)(sb + ((size_t)((b * 8 + hh) * 4096 + s)) * 128 + wc * 32 + 8 * fq) = w;
                    }
                }
            return;
        }
#pragma unroll
        for (int ai = 0; ai < 2; ++ai)
#pragma unroll
            for (int m = 0; m < 4; ++m) {
                const int tk = u.pm * BM + ai * HALF + wr * 64 + m * 16 + fr, b = tk >> 12, s = tk & 4095;
                const float rs = rsv[ai][m];
#pragma unroll
                for (int bj = 0; bj < 2; ++bj) {
                    const int hh = (u.pn & 3) * 2 + bj;
                    f32x4 v0 = __builtin_convertvector(acci[ai][bj][m][0], f32x4) * wcs[bj][0] * rs, v1 = __builtin_convertvector(acci[ai][bj][m][1], f32x4) * wcs[bj][1] * rs;
                    bf16_t* dst;
                    if (sec == 3) {
#pragma unroll
                        for (int i = 0; i < 4; ++i) { v0[i] = sigmoidf_fast(v0[i]); v1[i] = sigmoidf_fast(v1[i]); }
                        dst = sb + (size_t)tk * 1024 + hh * 128 + wc * 32 + 8 * fq;
                    } else {
                        v0 = v0 * sc; v1 = v1 * sc;
                        dst = sb + ((size_t)((b * 8 + hh) * 4096 + s)) * 128 + wc * 32 + 8 * fq;
                    }
                    u32x4 w; w.x = cvt_pk_bf16(v0[0], v0[1]); w.y = cvt_pk_bf16(v0[2], v0[3]); w.z = cvt_pk_bf16(v1[0], v1[1]); w.w = cvt_pk_bf16(v1[2], v1[3]);
                    *(u32x4*)dst = w;
                }
            }
    }
};
struct EpiOutProj {
    static constexpr bool PERM = true, AFTER_DRAIN = false;
    const float* x; float* h; bf16_t* hb; float* ssq; float* amx;
    __device__ __forceinline__ void operator()(const f32x4 (&acc)[2][2][4][2], const Unit& u, int wr, int wc, int fr, int fq) const {
#pragma unroll
        for (int ai = 0; ai < 2; ++ai) {
            f32x4 xv[4][2][2];
#pragma unroll
            for (int m = 0; m < 4; ++m)
#pragma unroll
                for (int bj = 0; bj < 2; ++bj) { const size_t off = (size_t)(u.pm * BM + ai * HALF + wr * 64 + m * 16 + fr) * DM + u.pn * BM + bj * HALF + wc * 32 + 8 * fq;
                    xv[m][bj][0] = __builtin_nontemporal_load((const f32x4*)(x + off)); xv[m][bj][1] = __builtin_nontemporal_load((const f32x4*)(x + off + 4)); }
#pragma unroll
            for (int m = 0; m < 4; ++m) {
                const int tk = u.pm * BM + ai * HALF + wr * 64 + m * 16 + fr;
                float ss = 0.f, mx = 0.f;
#pragma unroll
                for (int bj = 0; bj < 2; ++bj) {
                    const size_t off = (size_t)tk * DM + u.pn * BM + bj * HALF + wc * 32 + 8 * fq;
                    const f32x4 v0 = acc[ai][bj][m][0] + xv[m][bj][0], v1 = acc[ai][bj][m][1] + xv[m][bj][1];
                    u32x4 w; w.x = cvt_pk_bf16(v0[0], v0[1]); w.y = cvt_pk_bf16(v0[2], v0[3]); w.z = cvt_pk_bf16(v1[0], v1[1]); w.w = cvt_pk_bf16(v1[2], v1[3]);
                    *(u32x4*)(hb + off) = w;
                    ss += v0[0] * v0[0] + v0[1] * v0[1] + v0[2] * v0[2] + v0[3] * v0[3] + v1[0] * v1[0] + v1[1] * v1[1] + v1[2] * v1[2] + v1[3] * v1[3];
                    mx = fmaxf(mx, fmaxf(fmaxf(fmaxf(fabsf(v0[0]), fabsf(v0[1])), fmaxf(fabsf(v0[2]), fabsf(v0[3]))), fmaxf(fmaxf(fabsf(v1[0]), fabsf(v1[1])), fmaxf(fabsf(v1[2]), fabsf(v1[3])))));
                }
                ss += sx_f(ss, 16); ss += sx_f(ss, 32);
                mx = fmaxf(mx, sx_f(mx, 16)); mx = fmaxf(mx, sx_f(mx, 32));
                if (fq == 0) { ssq[(size_t)tk * 32 + u.pn * 4 + wc] = ss; amx[(size_t)tk * 32 + u.pn * 4 + wc] = mx; }
            }
        }
    }
};
struct EpiPeerQ {
    static constexpr bool PERM = true, AFTER_DRAIN = false;
    const float* ssq; bf16_t* qp; float* rtab;
    __device__ __forceinline__ void operator()(const f32x4 (&acc)[2][2][4][2], const Unit& u, int wr, int wc, int fr, int fq) const {
#pragma unroll
        for (int ai = 0; ai < 2; ++ai)
#pragma unroll
            for (int m = 0; m < 4; ++m) {
                const int tk = u.pm * BM + ai * HALF + wr * 64 + m * 16 + fr;
                float tot = 0.f;
#pragma unroll
                for (int i = 0; i < 8; ++i) { const f32x4 s4 = *(const f32x4*)(ssq + (size_t)tk * 32 + 4 * i); tot += (s4[0] + s4[1]) + (s4[2] + s4[3]); }
                const float r = 1.0f / sqrtf(tot * (1.f / DM) + EPS);
                if (u.pn == 0 && wc == 0 && fq == 0) rtab[tk] = r;
#pragma unroll
                for (int bj = 0; bj < 2; ++bj) {
                    const size_t off = (size_t)tk * DM + u.pn * BM + bj * HALF + wc * 32 + 8 * fq;
                    const f32x4 v0 = acc[ai][bj][m][0] * r, v1 = acc[ai][bj][m][1] * r;
                    u32x4 w; w.x = cvt_pk_bf16(v0[0], v0[1]); w.y = cvt_pk_bf16(v0[2], v0[3]); w.z = cvt_pk_bf16(v1[0], v1[1]); w.w = cvt_pk_bf16(v1[2], v1[3]);
                    *(u32x4*)(qp + off) = w;
                }
            }
    }
};
struct EpiPeerQFused {
    static constexpr bool PERM = true, AFTER_DRAIN = true;
    const float* ssq; unsigned char* wsb;
    __device__ __forceinline__ void operator()(const f32x4 (&)[2][2][4][2], const Unit&, int, int, int, int) const {}
    __device__ __forceinline__ void fused(const f32x4 (&acc)[2][2][4][2], const Unit& u, int wr, int wc, int fr, int fq, PG8_LAS unsigned char* lds) const;
};
}

namespace att {
constexpr int NW = 8, QBLK = 32, KVBLK = 64, QB = NW * QBLK, D = 128;
constexpr int SHM_V = KVBLK * D * 2, SHM_K = KVBLK * D * 2;
constexpr int OFF_WS = 2 * SHM_V + 2 * SHM_K, OFF_BIAS = OFF_WS + NW * 64 * 4, ATT_LDS = OFF_BIAS + SEQ * 4, V2_OFF = ATT_LDS  ;
#define KSWZ(row, colB) ((row) * 256 + ((colB) ^ (((row) & 15) << 4)))
#define SBAR() __builtin_amdgcn_sched_barrier(0)
__device__ __forceinline__ int v_st(int k, int c) { const int kk = (k & ~0xC) | ((k & 4) << 1) | ((k & 8) >> 1); return ((kk >> 3) * 4 + (c >> 5)) * 512 + ((kk & 7) * 32 + (c & 31)) * 2; }
__device__ __forceinline__ int v_rd_base(int lane) { return ((lane & 3) << 3) | (((lane >> 2) & 3) << 6) | (((lane >> 4) & 1) << 5) | (((lane >> 5) & 1) << 8); }
constexpr int v_rd_off(int d0, int ks, int half) { return d0 * 512 + ks * 4096 + half * 2048; }
__device__ __forceinline__ int crow(int r, int hi) { return (r & 3) + 8 * (r >> 2) + 4 * hi; }
__device__ __forceinline__ bf16x8 load8(const bf16_t* p) { return *reinterpret_cast<const bf16x8*>(p); }
__device__ __forceinline__ void mask_tile(f32x16& p0, f32x16& p1, int dq) {
    const float NEG = -__builtin_inff();
#pragma unroll
    for (int r = 0; r < 16; ++r) {
        const int c = (r & 3) + 8 * (r >> 2);
        if (dq - c < 0) p0[r] = NEG;
        if (dq - c - 32 < 0) p1[r] = NEG;
    }
}
__device__ __forceinline__ void partialSM(f32x16& p0, f32x16& p1, float& m_reg, float& mn, float& alpha) {
    float pmax = p0[0];
#pragma unroll
    for (int r = 1; r < 16; ++r) pmax = fmaxf(pmax, p0[r]);
#pragma unroll
    for (int r = 0; r < 16; ++r) pmax = fmaxf(pmax, p1[r]);
    { auto rr = __builtin_amdgcn_permlane32_swap(__float_as_uint(pmax), __float_as_uint(pmax), false, false);
      pmax = fmaxf(__uint_as_float(rr[0]), __uint_as_float(rr[1])); }
    constexpr float C2 = LOG2E * SCALE; constexpr float THR = 8.f;
    if (__builtin_expect(__all((pmax - m_reg) * SCALE <= THR), 1)) { mn = m_reg; alpha = 1.f; }
    else { mn = fmaxf(m_reg, pmax); alpha = __builtin_amdgcn_exp2f((m_reg - mn) * C2); m_reg = mn; }
    const float mnL = -mn * C2;
#pragma unroll
    for (int r = 0; r < 16; ++r) p0[r] = fmaf(p0[r], C2, mnL);
#pragma unroll
    for (int r = 0; r < 16; ++r) p1[r] = fmaf(p1[r], C2, mnL);
#pragma unroll
    for (int r = 0; r < 16; ++r) p0[r] = __builtin_amdgcn_exp2f(p0[r]);
}
#define PK4(P, B_, OUT) do { unsigned a0 = cvt_pk_bf16(P[B_+0], P[B_+1]), a1 = cvt_pk_bf16(P[B_+2], P[B_+3]);                          \
        unsigned b0 = cvt_pk_bf16(P[B_+4], P[B_+5]), b1 = cvt_pk_bf16(P[B_+6], P[B_+7]);                                             \
        auto r0 = __builtin_amdgcn_permlane32_swap(a0, b0, false, false); auto r1 = __builtin_amdgcn_permlane32_swap(a1, b1, false, false); \
        u32x4 w = {r0[0], r1[0], r0[1], r1[1]}; OUT = *reinterpret_cast<bf16x8*>(&w); } while (0)
__device__ __forceinline__ void finishSM(f32x16& p0, f32x16& p1, float alpha, float& l_reg, bf16x8& pa0, bf16x8& pa1, bf16x8& pa2, bf16x8& pa3) {
#pragma unroll
    for (int r = 0; r < 16; ++r) p1[r] = __builtin_amdgcn_exp2f(p1[r]);
    float ps = 0;
#pragma unroll
    for (int r = 0; r < 16; ++r) ps += p0[r];
#pragma unroll
    for (int r = 0; r < 16; ++r) ps += p1[r];
    { auto rr = __builtin_amdgcn_permlane32_swap(__float_as_uint(ps), __float_as_uint(ps), false, false);
      ps = __uint_as_float(rr[0]) + __uint_as_float(rr[1]); }
    l_reg = l_reg * alpha + ps;
    PK4(p0, 0, pa0); PK4(p0, 8, pa1); PK4(p1, 0, pa2); PK4(p1, 8, pa3);
}
__device__ __forceinline__ void sb_group(f32x16& P, int g, float& gs) {
    float run = 0.f;
#pragma unroll
    for (int k = 3; k >= 0; --k) {
        const float z = P[4 * g + k];
        const float t = __builtin_amdgcn_exp2f(-fabsf(z));
        const float l = __builtin_amdgcn_logf(1.f + t);
        const float sp = fmaxf(z, 0.f) + l;
        P[4 * g + k] = (z - sp) - run;
        run += sp;
    }
    gs = run;
}
__device__ __forceinline__ void sb_part1(f32x16& p0, f32x16& p1, float& carry, float mlo) {
    float gs[8];
#pragma unroll
    for (int g = 0; g < 4; ++g) sb_group(p0, g, gs[g]);
#pragma unroll
    for (int g = 0; g < 4; ++g) sb_group(p1, g, gs[4 + g]);
    float run = carry;
#pragma unroll
    for (int G = 7; G >= 0; --G) {
        auto rr = __builtin_amdgcn_permlane32_swap(__float_as_uint(gs[G]), __float_as_uint(gs[G]), false, false);
        const float slo = __uint_as_float(rr[0]), shi = __uint_as_float(rr[1]);
        const float base = fmaf(mlo, shi, run);
        if (G >= 4) {
#pragma unroll
            for (int k = 0; k < 4; ++k) p1[4 * (G - 4) + k] -= base;
        } else {
#pragma unroll
            for (int k = 0; k < 4; ++k) p0[4 * G + k] -= base;
        }
        run += slo + shi;
    }
    carry = run;
#pragma unroll
    for (int r = 0; r < 16; ++r) p0[r] = __builtin_amdgcn_exp2f(p0[r]);
}
__device__ __forceinline__ void sb_part2(f32x16& p0, f32x16& p1, bf16x8& pa0, bf16x8& pa1, bf16x8& pa2, bf16x8& pa3) {
#pragma unroll
    for (int r = 0; r < 16; ++r) p1[r] = __builtin_amdgcn_exp2f(p1[r]);
    PK4(p0, 0, pa0); PK4(p0, 8, pa1); PK4(p1, 0, pa2); PK4(p1, 8, pa3);
}
#undef PK4
#define KRD(dst, addr, off) asm volatile("ds_read_b128 %0, %1 offset:%2" : "=&v"(dst) : "v"(addr), "i"(off) : "memory")
#define KWT(n, A_, B_) asm volatile("s_waitcnt lgkmcnt(" #n ")" : "+v"(A_), "+v"(B_) :: "memory")
template <int KB, bool BIAS>
__device__ __forceinline__ void qkt(f32x16& p0, f32x16& p1, const char* K_lds, int r32, int hi, const bf16x8* qr, const float* bt) {
    int ka0 = (int)(uintptr_t)K_lds + KSWZ(r32, hi * 16);
    asm volatile("" : "+v"(ka0));
    bf16x8 fa0, fb0, fa1, fb1;
    KRD(fa0, ka0, KB * SHM_K); KRD(fb0, ka0, KB * SHM_K + 8192);
    { const int ad_ = ka0 ^ 32; KRD(fa1, ad_, KB * SHM_K); KRD(fb1, ad_, KB * SHM_K + 8192); }
    if constexpr (BIAS) {
#pragma unroll
        for (int g = 0; g < 4; ++g) { const f32x4 a = *(const f32x4*)(bt + 8 * g), b = *(const f32x4*)(bt + 32 + 8 * g);
            p0[4 * g] = a[0]; p0[4 * g + 1] = a[1]; p0[4 * g + 2] = a[2]; p0[4 * g + 3] = a[3];
            p1[4 * g] = b[0]; p1[4 * g + 1] = b[1]; p1[4 * g + 2] = b[2]; p1[4 * g + 3] = b[3]; }
    } else { p0 = f32x16{}; p1 = f32x16{}; }
#define QK_STEP(d0, FA, FB, WN) do { KWT(WN, FA, FB);                                                                                  \
        p0 = __builtin_amdgcn_mfma_f32_32x32x16_bf16(FA, qr[d0], p0, 0, 0, 0); p1 = __builtin_amdgcn_mfma_f32_32x32x16_bf16(FB, qr[d0], p1, 0, 0, 0);  \
        if constexpr ((d0) + 2 < 8) { const int ad_ = ka0 ^ (((d0) + 2) << 5); KRD(FA, ad_, KB * SHM_K); KRD(FB, ad_, KB * SHM_K + 8192); } } while (0)
    QK_STEP(0, fa0, fb0, 2); QK_STEP(1, fa1, fb1, 2); QK_STEP(2, fa0, fb0, 2); QK_STEP(3, fa1, fb1, 2);
    QK_STEP(4, fa0, fb0, 2); QK_STEP(5, fa1, fb1, 2); QK_STEP(6, fa0, fb0, 2); QK_STEP(7, fa1, fb1, 0);
#undef QK_STEP
}
#undef KRD
#undef KWT
template <int VB>
__device__ __forceinline__ void pv_tile(f32x16* o, int vb0, bf16x8 pa0, bf16x8 pa1, bf16x8 pa2, bf16x8 pa3) {
#define TRRD(dst, off) asm volatile("ds_read_b64_tr_b16 %0, %1 offset:%2" : "=&v"(dst) : "v"(vb0), "i"(off) : "memory")
#define PV_LD(s, L0, H0, L1, H1) do { constexpr int b_ = VB * SHM_V + v_rd_off((s) >> 1, 0, 0) + ((s) & 1) * 8192; TRRD(L0, b_); TRRD(H0, b_ + 2048); TRRD(L1, b_ + 4096); TRRD(H1, b_ + 6144); } while (0)
#define PV_WT(n, L0, H0, L1, H1) asm volatile("s_waitcnt lgkmcnt(" #n ")" : "+v"(L0), "+v"(H0), "+v"(L1), "+v"(H1) :: "memory")
#define PV_MM(s, PA, PB, L0, H0, L1, H1) do {                                                                                              \
        o[(s) >> 1] = __builtin_amdgcn_mfma_f32_32x32x16_bf16(PA, (bf16x8){L0[0], L0[1], L0[2], L0[3], H0[0], H0[1], H0[2], H0[3]}, o[(s) >> 1], 0, 0, 0);   \
        o[(s) >> 1] = __builtin_amdgcn_mfma_f32_32x32x16_bf16(PB, (bf16x8){L1[0], L1[1], L1[2], L1[3], H1[0], H1[1], H1[2], H1[3]}, o[(s) >> 1], 0, 0, 0); } while (0)
    s16x4 a0, a1, a2, a3, b0, b1, b2, b3;
    PV_LD(0, a0, a1, a2, a3);
    PV_LD(1, b0, b1, b2, b3); PV_WT(4, a0, a1, a2, a3); PV_MM(0, pa0, pa1, a0, a1, a2, a3);
    PV_LD(2, a0, a1, a2, a3); PV_WT(4, b0, b1, b2, b3); PV_MM(1, pa2, pa3, b0, b1, b2, b3);
    PV_LD(3, b0, b1, b2, b3); PV_WT(4, a0, a1, a2, a3); PV_MM(2, pa0, pa1, a0, a1, a2, a3);
    PV_LD(4, a0, a1, a2, a3); PV_WT(4, b0, b1, b2, b3); PV_MM(3, pa2, pa3, b0, b1, b2, b3);
    PV_LD(5, b0, b1, b2, b3); PV_WT(4, a0, a1, a2, a3); PV_MM(4, pa0, pa1, a0, a1, a2, a3);
    PV_LD(6, a0, a1, a2, a3); PV_WT(4, b0, b1, b2, b3); PV_MM(5, pa2, pa3, b0, b1, b2, b3);
    PV_LD(7, b0, b1, b2, b3); PV_WT(4, a0, a1, a2, a3); PV_MM(6, pa0, pa1, a0, a1, a2, a3);
    PV_WT(0, b0, b1, b2, b3); PV_MM(7, pa2, pa3, b0, b1, b2, b3);
#undef PV_MM
#undef PV_WT
#undef PV_LD
#undef TRRD
}

struct UnitRef { const bf16_t* Q; const bf16_t* K; const bf16_t* V; int P0; };
struct Seam { bf16x8 qr[8]; bf16x8 st_v0, st_v1, st_k0, st_k1; };
#define ROW(p, k0, rr) ((p) + (size_t)((k0) + (rr)) * D + sc)
#define VMW() asm volatile("s_waitcnt vmcnt(0)" ::: "memory")
#define SLOAD_H(Kp, Vp, k0) do { S.st_v0 = load8(ROW(Vp, k0, sr)); S.st_v1 = load8(ROW(Vp, k0, 32 + sr));              \
                         S.st_k0 = load8(ROW(Kp, k0, sr)); S.st_k1 = load8(ROW(Kp, k0, 32 + sr)); } while (0)
#define SWRITE_HK(bf) do { *(bf16x8*)(K_lds + (bf) * SHM_K + kws) = S.st_k0; *(bf16x8*)(K_lds + (bf) * SHM_K + kws + 32 * 256) = S.st_k1; } while (0)
#define SWRITE_HV(bf) do { *(bf16x8*)(V_lds + (bf) * SHM_V + vst0) = S.st_v0; *(bf16x8*)(V_lds + (bf) * SHM_V + vst1) = S.st_v1; } while (0)
#define SWRITE_H(bf) do { SWRITE_HV(bf); SWRITE_HK(bf); } while (0)

template <bool SB>
__device__ __forceinline__ void attn_unit(const UnitRef& cur, unsigned char* wsu  , int bh, char* lds,
                                          int part  , float lmax  ) {
    const float* cvec;
    { unsigned char* w_ = wsu; asm volatile("" : "+s"(w_)); cvec = (const float*)(w_ + WS_C) + (size_t)bh * SEQ; }
    Seam S;
    { const int t0_ = tid_opaque(), w0_ = __builtin_amdgcn_readfirstlane(t0_ >> 6), l0_ = t0_ & 63;
#pragma unroll
      for (int d0 = 0; d0 < 8; ++d0) S.qr[d0] = load8(cur.Q + (size_t)(w0_ * QBLK + (l0_ & 31)) * D + d0 * 16 + (l0_ >> 5) * 8); }
    const int tid = tid_opaque(), wid = __builtin_amdgcn_readfirstlane(tid >> 6), lane = tid & 63, r32 = lane & 31, hi = lane >> 5;
    int jlo = 0;
    if constexpr (!SB) {
        const int ntf = (cur.P0 + QB) / KVBLK;
        const float cend = (lane < ntf) ? cvec[lane * KVBLK + KVBLK - 1] : 0.f;
        const bool skip = (lane < ntf) && (2.f * lmax + cvec[cur.P0] - cend < -104.f);
        jlo = __builtin_amdgcn_readfirstlane((int)__popcll(__ballot(skip)));
    }
    const int ntot = (cur.P0 + QB) / KVBLK - jlo;
    const int tb = (part == 2) ? (ntot >> 1) : 0, te = (part == 1) ? (ntot >> 1) : ntot;
    const int kshift = (jlo + tb) * KVBLK, P0r = cur.P0 - kshift;
    const int NT = te - tb;
#define KBASE(t) ((NT - 1 - (t)) * KVBLK)
    const int qlo = P0r + wid * QBLK, qm = qlo + r32 - 4 * hi - (SB ? 1 : 0);
    char* V_lds = lds; char* K_lds = lds + 2 * SHM_V;
    float* ws = (float*)(lds + OFF_WS) + wid * 64; float* li_l = ws, * al_l = ws + 32;
    float* bias = (float*)(lds + OFF_BIAS);
    const int sr = tid >> 4, sc = (tid & 15) * 8, vst0 = v_st(sr, sc), vst1 = v_st(32 + sr, sc), kws = KSWZ(sr, sc * 2);
    const int vb0 = (int)(uintptr_t)V_lds + v_rd_base(lane);
    const bf16_t* Kh = cur.K + (size_t)kshift * D; const bf16_t* Vh = cur.V + (size_t)kshift * D;
    SLOAD_H(Kh, Vh, KBASE(0));
    if constexpr (!SB) { const float cq0 = cvec[cur.P0]; const float* cv = cvec + kshift; for (int j = tid; j < NT * KVBLK; j += NTHREADS) bias[j] = (cq0 - cv[j]) * (1.f / SCALE); }
    VMW(); SWRITE_HK(0);
    __syncthreads();
    float m_reg = -1e30f, l_reg = 0; f32x16 o[4] = {};
    float carry = 0.f; const float mlo = hi ? 0.f : 1.f;
#define RESC(a) do { if (__any((a) < 1.f)) { if (hi == 0) al_l[r32] = (a); asm volatile("s_waitcnt lgkmcnt(0)" ::: "memory");              \
                     for (int d_ = 0; d_ < 4; ++d_) for (int r = 0; r < 16; ++r) o[d_][r] *= al_l[crow(r, hi)]; } } while (0)
#define MASKT(P0_, P1_, t) do { const int kb_ = KBASE(t); if (kb_ + KVBLK - 1 > qlo - (SB ? 1 : 0)) mask_tile(P0_, P1_, qm - kb_); } while (0)
#define BT(t) (bias + KBASE(t) + 4 * hi)
#define PART1(PX0, PX1, mnX, alX) do { if constexpr (SB) sb_part1(PX0, PX1, carry, mlo); else partialSM(PX0, PX1, m_reg, mnX, alX); } while (0)
#define PART2(PY0, PY1, alY) do { if constexpr (SB) sb_part2(PY0, PY1, pa0, pa1, pa2, pa3); else finishSM(PY0, PY1, alY, l_reg, pa0, pa1, pa2, pa3); } while (0)
    f32x16 pA0, pA1, pB0, pB1; float mnA = 0.f, mnB = 0.f, alA = 1.f, alB = 1.f; bf16x8 pa0, pa1, pa2, pa3;
    SWRITE_HV(0); SBAR();
    if (NT > 1) SLOAD_H(Kh, Vh, KBASE(1));
    SBAR(); qkt<0, !SB>(pA0, pA1, K_lds, r32, hi, S.qr, BT(0));
    MASKT(pA0, pA1, 0); PART1(pA0, pA1, mnA, alA);
    if (NT > 1) { VMW(); SWRITE_H(1); }
    __syncthreads();
#define IGL_QK() do { _Pragma("unroll") for (int i_ = 0; i_ < 16; ++i_) { __builtin_amdgcn_sched_group_barrier(0x008, 1, 0); \
        __builtin_amdgcn_sched_group_barrier(0x002, 4, 0); __builtin_amdgcn_sched_group_barrier(0x400, 1, 0); } } while (0)
    int vrd = 0, vmid = SHM_V, vwr = V2_OFF;
#define SWRITE_HVO(off) do { *(bf16x8*)(V_lds + (off) + vst0) = S.st_v0; *(bf16x8*)(V_lds + (off) + vst1) = S.st_v1; } while (0)
#define HALF_STEP(PX0, PX1, mnX, alX, PY0, PY1, alY, t, KB) do {                                                              \
        SBAR(); qkt<KB, !SB>(PX0, PX1, K_lds, r32, hi, S.qr, BT(t));                                                          \
        PART2(PY0, PY1, alY); SBAR();                                                                                          \
        if ((t) + 1 < NT) { SLOAD_H(Kh, Vh, KBASE((t) + 1)); SBAR(); }                                                         \
        pv_tile<0>(o, vb0 + vrd, pa0, pa1, pa2, pa3); MASKT(PX0, PX1, (t)); PART1(PX0, PX1, mnX, alX);                         \
        if ((t) + 1 < NT) { VMW(); SWRITE_HK((KB) ^ 1); SWRITE_HVO(vwr); }                                                     \
        if constexpr (!SB) RESC(alX);                                                                                          \
        __syncthreads();                                                                                                      \
        { const int tmp_ = vrd; vrd = vmid; vmid = vwr; vwr = tmp_; } } while (0)
    for (int t = 1; t + 1 < NT; t += 2) {
        HALF_STEP(pB0, pB1, mnB, alB, pA0, pA1, alA, t, 1);
        HALF_STEP(pA0, pA1, mnA, alA, pB0, pB1, alB, t + 1, 0);
    }
    const bool even = (NT & 1) == 0;
    if (even) { SBAR(); qkt<1, !SB>(pB0, pB1, K_lds, r32, hi, S.qr, BT(NT - 1)); SBAR(); }
    PART2(pA0, pA1, alA); SBAR();
    pv_tile<0>(o, vb0 + vrd, pa0, pa1, pa2, pa3);
    if (even) { MASKT(pB0, pB1, NT - 1); PART1(pB0, pB1, mnB, alB); __syncthreads(); if constexpr (!SB) RESC(alB);
        PART2(pB0, pB1, alB); SBAR(); pv_tile<0>(o, vb0 + vmid, pa0, pa1, pa2, pa3); }
    unsigned char* we_ = wsu; asm volatile("" : "+s"(we_));
    float* stg = (float*)(lds + OFF_BIAS) + wid * (32 * 68);
    __syncthreads();
    if (part != 0) {
        const int slot2 = ((((cur.P0 >> 8) - 8) & 7) * 16 + bh) * 2 + (part == 2 ? 1 : 0);
        float* po = (float*)(we_ + WS_PO) + (size_t)slot2 * 256 * 128; float* pml = (float*)(we_ + WS_PML) + (size_t)slot2 * 512;
        if (hi == 0) { pml[(wid * QBLK + r32) * 2] = m_reg; pml[(wid * QBLK + r32) * 2 + 1] = l_reg; }
#pragma unroll
        for (int half = 0; half < 2; ++half) {
#pragma unroll
            for (int r = 0; r < 16; ++r) { stg[crow(r, hi) * 68 + r32] = o[2 * half][r]; stg[crow(r, hi) * 68 + 32 + r32] = o[2 * half + 1][r]; }
            asm volatile("s_waitcnt lgkmcnt(0)" ::: "memory");
#pragma unroll
            for (int k = 0; k < 4; ++k) { const int id = lane + 64 * k, row = id >> 3, c8 = (id & 7) * 8;
                const f32x4 x0 = *(const f32x4*)(stg + row * 68 + c8), x1 = *(const f32x4*)(stg + row * 68 + c8 + 4);
                float* d = po + (size_t)(wid * QBLK + row) * D + half * 64 + c8; *(f32x4*)d = x0; *(f32x4*)(d + 4) = x1; }
            asm volatile("s_waitcnt lgkmcnt(0)" ::: "memory");
        }
        asm volatile("s_waitcnt vmcnt(0)" ::: "memory");
        __syncthreads();
        if (tid == 0) { __builtin_amdgcn_fence(__ATOMIC_RELEASE, "agent");
            (void)__hip_atomic_fetch_add((unsigned*)(we_ + WS_CTL) + CW_DONE + (slot2 >> 1), 1u, __ATOMIC_RELAXED, __HIP_MEMORY_SCOPE_AGENT); }
        return;
    }
    const bf16_t* gate = (const bf16_t*)(we_ + WS_SEC) + 3 * SEC_ELEMS + (size_t)(bh >> 3) * SEQ * 1024 + (bh & 7) * HD;
    bf16_t* outp = (bf16_t*)(we_ + WS_MIX) + (size_t)(bh >> 3) * SEQ * DM + (bh & 7) * HD;
    float rli[16];
    if (hi == 0) li_l[r32] = l_reg; asm volatile("s_waitcnt lgkmcnt(0)" ::: "memory");
#pragma unroll
    for (int r = 0; r < 16; ++r) rli[r] = __builtin_amdgcn_rcpf(li_l[crow(r, hi)]);
#pragma unroll
    for (int half = 0; half < 2; ++half) {
#pragma unroll
        for (int r = 0; r < 16; ++r) { stg[crow(r, hi) * 68 + r32] = o[2 * half][r] * rli[r]; stg[crow(r, hi) * 68 + 32 + r32] = o[2 * half + 1][r] * rli[r]; }
        asm volatile("s_waitcnt lgkmcnt(0)" ::: "memory");
#pragma unroll
        for (int k = 0; k < 4; ++k) { const int id = lane + 64 * k, row = id >> 3, c8 = (id & 7) * 8;
            const int orow = cur.P0 + wid * QBLK + row, col = half * 64 + c8;
            const u32x4 gw = *(const u32x4*)(gate + (size_t)orow * 1024 + col);
            const f32x4 x0 = *(const f32x4*)(stg + row * 68 + c8), x1 = *(const f32x4*)(stg + row * 68 + c8 + 4);
            u32x4 ov; ov.x = cvt_pk_bf16(x0[0] * bf_lo(gw.x), x0[1] * bf_hi(gw.x)); ov.y = cvt_pk_bf16(x0[2] * bf_lo(gw.y), x0[3] * bf_hi(gw.y));
            ov.z = cvt_pk_bf16(x1[0] * bf_lo(gw.z), x1[1] * bf_hi(gw.z)); ov.w = cvt_pk_bf16(x1[2] * bf_lo(gw.w), x1[3] * bf_hi(gw.w));
            *(u32x4*)(outp + (size_t)orow * DM + col) = ov; }
        asm volatile("s_waitcnt lgkmcnt(0)" ::: "memory");
    }
    __syncthreads();
#undef RESC
#undef KBASE
#undef MASKT
#undef BT
#undef PART1
#undef PART2
#undef HALF_STEP
#undef SWRITE_HVO
}

constexpr float SB_TH = 150.f;
__device__ __forceinline__ void sb_unit(const UnitRef& cur, bf16_t* outp, char* lds) {
    const int tid = tid_opaque(), wid = __builtin_amdgcn_readfirstlane(tid >> 6), lane = tid & 63, r32 = lane & 31, hi = lane >> 5;
    const int NT = (cur.P0 + QB) / KVBLK;
#define KBASE(t) ((NT - 1 - (t)) * KVBLK)
    const int qlo = cur.P0 + wid * QBLK, qm = qlo + r32 - 4 * hi - 1;
    char* V_lds = lds; char* K_lds = lds + 2 * SHM_V;
    volatile int* flags = (volatile int*)(lds + OFF_WS);
    const int sr = tid >> 4, sc = (tid & 15) * 8, vst0 = v_st(sr, sc), vst1 = v_st(32 + sr, sc), kws = KSWZ(sr, sc * 2);
    const int vb0 = (int)(uintptr_t)V_lds + v_rd_base(lane);
    const bf16_t* Kh = cur.K; const bf16_t* Vh = cur.V;
    Seam S;
#pragma unroll
    for (int d0 = 0; d0 < 8; ++d0) S.qr[d0] = load8(cur.Q + (size_t)(wid * QBLK + r32) * D + d0 * 16 + hi * 8);
    SLOAD_H(Kh, Vh, KBASE(0)); VMW(); SWRITE_H(0);
    __syncthreads();
    f32x16 o[4] = {}; float carry = 0.f; const float mlo = hi ? 0.f : 1.f;
    bool wdone = false;
#define SB_STEP(tt, BUF) {                                                                                                 \
        const int kb_ = KBASE(tt);                                                                                           \
        if ((tt) + 1 < NT) SLOAD_H(Kh, Vh, KBASE((tt) + 1));                                                                 \
        SBAR();                                                                                                              \
        if (!wdone && kb_ <= qlo + QBLK - 2) {                                                                               \
            f32x16 p0, p1; bf16x8 pa0, pa1, pa2, pa3;                                                                        \
            qkt<BUF, false>(p0, p1, K_lds, r32, hi, S.qr, nullptr);                                                          \
            if (kb_ + KVBLK - 1 > qlo - 1) mask_tile(p0, p1, qm - kb_);                                                      \
            sb_part1(p0, p1, carry, mlo); sb_part2(p0, p1, pa0, pa1, pa2, pa3); SBAR();                                      \
            pv_tile<BUF>(o, vb0, pa0, pa1, pa2, pa3);                                                                        \
            wdone = __all(carry >= SB_TH);                                                                                   \
        }                                                                                                                    \
        if ((tt) + 1 < NT) { VMW(); SWRITE_H((BUF) ^ 1); }                                                                   \
        if (lane == 0) flags[((tt) & 1) * 8 + wid] = wdone ? 1 : 0;                                                          \
        __syncthreads();                                                                                                     \
        { int alld = 1;                                                                                                      \
          _Pragma("unroll") for (int w_ = 0; w_ < 8; ++w_) alld &= flags[((tt) & 1) * 8 + w_];                                \
          if (alld) break; } }
    for (int t = 0; t < NT; t += 2) {
        SB_STEP(t, 0)
        SB_STEP(t + 1, 1)
    }
#undef SB_STEP
    { float* stg = (float*)(lds + OFF_BIAS) + wid * (32 * 68);
#pragma unroll
      for (int half = 0; half < 2; ++half) {
#pragma unroll
          for (int r = 0; r < 16; ++r) { stg[crow(r, hi) * 68 + r32] = o[2 * half][r]; stg[crow(r, hi) * 68 + 32 + r32] = o[2 * half + 1][r]; }
          asm volatile("s_waitcnt lgkmcnt(0)" ::: "memory");
#pragma unroll
          for (int k = 0; k < 4; ++k) { const int id = lane + 64 * k, row = id >> 3, c8 = (id & 7) * 8;
              const f32x4 x0 = *(const f32x4*)(stg + row * 68 + c8), x1 = *(const f32x4*)(stg + row * 68 + c8 + 4);
              u32x4 ov; ov.x = cvt_pk_bf16(x0[0], x0[1]); ov.y = cvt_pk_bf16(x0[2], x0[3]); ov.z = cvt_pk_bf16(x1[0], x1[1]); ov.w = cvt_pk_bf16(x1[2], x1[3]);
              *(u32x4*)(outp + (size_t)(cur.P0 + wid * QBLK + row) * DM + half * 64 + c8) = ov; }
          asm volatile("s_waitcnt lgkmcnt(0)" ::: "memory");
      } }
    __syncthreads();
#undef KBASE
}
#undef ROW
#undef VMW
#undef SLOAD_H
#undef SWRITE_HK
#undef SWRITE_HV
#undef SWRITE_H
}

#define XB_TMO      128
#define XB_XCNT(j)  (256  + 64 * (j))
#define XB_XSUB(j)  (1280 + 64 * (j))
#define XB_XGEN(j)  (2304 + 64 * (j))
#define XB_TOP      3328
#define XB_TOPGEN   3392
#define XCD_BAR_WORDS 3456
#define XB_SPIN_CAP (1u << 20)
__device__ __forceinline__ unsigned xb_ld(unsigned* p)              { return __hip_atomic_load(p, __ATOMIC_RELAXED, __HIP_MEMORY_SCOPE_AGENT); }
__device__ __forceinline__ unsigned xb_add(unsigned* p, unsigned v) { return __hip_atomic_fetch_add(p, v, __ATOMIC_RELAXED, __HIP_MEMORY_SCOPE_AGENT); }
__device__ __forceinline__ unsigned xb_xcc_id() { return (unsigned)__builtin_amdgcn_s_getreg((3 << 11) | 20) & 0xFu; }
#define XB_SPIN(cond, bar) do { unsigned _sp = 0; while (cond) { __builtin_amdgcn_s_sleep(1); \
    if ((++_sp & 255u) == 0u) { if (xb_ld(&(bar)[XB_TMO])) break; if (_sp > XB_SPIN_CAP) { atomicAdd(&(bar)[XB_TMO], 1u); break; } } } } while (0)
struct XcdBarrier { unsigned* bar; unsigned x; volatile LAS unsigned* st; };
__device__ __forceinline__ XcdBarrier xcd_barrier_post(unsigned* bar, volatile LAS unsigned* st) {
    XcdBarrier b; b.bar = bar; b.x = xb_xcc_id(); b.st = st;
    if (threadIdx.x == 0) (void)xb_add(&bar[XB_XCNT(b.x)], 1u);
    return b;
}
__device__ __forceinline__ void xcd_barrier_complete(unsigned* bar, unsigned x, unsigned& nloc, unsigned& nx) {
    const unsigned G = gridDim.x * gridDim.y * gridDim.z;
    unsigned sum, cnt, mine, sp = 0u;
    for (;;) {
        sum = 0u; cnt = 0u; mine = 0u;
#pragma unroll
        for (unsigned j = 0; j < 16; ++j) { const unsigned c = xb_ld(&bar[XB_XCNT(j)]); sum += c; cnt += (c > 0u) ? 1u : 0u; mine = (j == x) ? c : mine; }
        if (sum == G) break;
        __builtin_amdgcn_s_sleep(1);
        if ((++sp & 255u) == 0u) { if (xb_ld(&bar[XB_TMO])) break; if (sp > XB_SPIN_CAP) { atomicAdd(&bar[XB_TMO], 1u); break; } }
    }
    nloc = mine > 0u ? mine : 1u; nx = cnt > 0u ? cnt : 1u;
}
struct Args;
__device__ __forceinline__ void convert_tables(const Args& a, int r0, int r1, int worker, int nworkers);
__device__ __forceinline__ void xcd_barrier(const XcdBarrier& b, const Args* ta = nullptr, int r0 = 0, int r1 = 0, const unsigned char* pf = nullptr) {
    asm volatile("s_waitcnt vmcnt(0)" ::: "memory");
    __syncthreads();
    if (pf != nullptr && threadIdx.x >= 64) {
        const int t_ = (int)threadIdx.x - 64;
        LAS unsigned* scrap_ = (LAS unsigned*)((LAS unsigned char*)b.st - 32 - (MISC_OFF - 139264) + __builtin_amdgcn_readfirstlane((int)threadIdx.x >> 6) * 256);
        __builtin_amdgcn_global_load_lds((const unsigned*)(pf + (size_t)t_ * 128), scrap_, 4, 0, 0);
        if (t_ < 64) __builtin_amdgcn_global_load_lds((const unsigned*)(pf + (size_t)(t_ + 448) * 128), scrap_, 4, 0, 0);
    }
    if (ta != nullptr && threadIdx.x >= 64) convert_tables(*ta, r0, r1, (int)blockIdx.x * 7 + ((int)threadIdx.x >> 6) - 1, (int)gridDim.x * 7);
    if (threadIdx.x == 0) {
        unsigned* bar = b.bar;
        __builtin_amdgcn_s_waitcnt(0);
        unsigned nloc = b.st[0], nx = b.st[1];
        if (nloc == 0u) { xcd_barrier_complete(bar, b.x, nloc, nx); b.st[0] = nloc; b.st[1] = nx; }
        const unsigned old = xb_add(&bar[XB_XSUB(b.x)], 1u);
        const unsigned gen = old / nloc;
        if (old + 1u == (gen + 1u) * nloc) {
            __builtin_amdgcn_fence(__ATOMIC_RELEASE, "agent");
            asm volatile("s_waitcnt vmcnt(0)" ::: "memory");
            const unsigned og = xb_add(&bar[XB_TOP], 1u);
            const unsigned tg = og / nx;
            if (og + 1u == (tg + 1u) * nx) xb_add(&bar[XB_TOPGEN], 1u);
            else XB_SPIN(xb_ld(&bar[XB_TOPGEN]) == tg, bar);
            __builtin_amdgcn_fence(__ATOMIC_ACQUIRE, "agent");
            xb_add(&bar[XB_XGEN(b.x)], 1u);
            asm volatile("s_waitcnt vmcnt(0)" ::: "memory");
        } else {
            XB_SPIN(xb_ld(&bar[XB_XGEN(b.x)]) == gen, bar);
            __builtin_amdgcn_fence(__ATOMIC_ACQUIRE, "agent");
            asm volatile("s_waitcnt vmcnt(0)" ::: "memory");
        }
    }
    __syncthreads();
}

struct Args { const float* in[12]; float* out; unsigned char* ws; int ph_lo, ph_hi; };

__device__ __forceinline__ void p0_transpose_item(const float* W, int ldw, int K, bf16_t* WT, int nblk, LAS float* scr, int item, int lane, const float* gk) {
    const int kb = item / nblk, nb = item % nblk, k0 = 64 * kb, n0 = 32 * nb;
    { const int rr = lane >> 3, c4 = lane & 7; f32x4 v[8];
#pragma unroll
      for (int i = 0; i < 8; ++i) v[i] = __builtin_nontemporal_load((const f32x4*)(W + (size_t)(k0 + rr + 8 * i) * ldw + n0 + 4 * c4));
#pragma unroll
      for (int i = 0; i < 8; ++i) { const int kk = rr + 8 * i; const float gm = gk ? gk[k0 + kk] : 1.f;
          scr[kk * 33 + 4 * c4] = v[i][0] * gm; scr[kk * 33 + 4 * c4 + 1] = v[i][1] * gm; scr[kk * 33 + 4 * c4 + 2] = v[i][2] * gm; scr[kk * 33 + 4 * c4 + 3] = v[i][3] * gm; } }
    LDS_WAIT(); asm volatile("" ::: "memory");
    const int c = lane & 7;
#pragma unroll
    for (int j = 0; j < 4; ++j) { const int n = (lane >> 3) + 8 * j; const LAS float* s = scr + (8 * c) * 33 + n;
        u32x4 o; o.x = cvt_pk_bf16(s[0 * 33], s[1 * 33]); o.y = cvt_pk_bf16(s[2 * 33], s[3 * 33]); o.z = cvt_pk_bf16(s[4 * 33], s[5 * 33]); o.w = cvt_pk_bf16(s[6 * 33], s[7 * 33]);
        *(u32x4*)(WT + (size_t)(n0 + n) * K + k0 + 8 * c) = o; }
    LDS_WAIT(); asm volatile("" ::: "memory");
}

__device__ __forceinline__ int pack_i8(float a, float b, float c, float d) {
    const int ia = (int)__builtin_rintf(a), ib = (int)__builtin_rintf(b), ic = (int)__builtin_rintf(c), id = (int)__builtin_rintf(d);
    return (int)(((unsigned)ia & 0xffu) | (((unsigned)ib & 0xffu) << 8) | (((unsigned)ic & 0xffu) << 16) | ((unsigned)id << 24));
}
__device__ __forceinline__ void convert_tables(const Args& a, int r0, int r1, int worker, int nworkers) {
    const int lane = tid_opaque() & 63;
    unsigned char* ws = a.ws; const float* g_ffn = a.in[7]; const float* pu = a.in[10]; const float* pv = a.in[11];
    float* suv = (float*)(ws + WS_SUV);
    for (int r = r0 + worker; r < r1; r += nworkers) {
        const bool isv = r >= NEXP; const int e = isv ? r - NEXP : r;
        const f32x4* srcp = (const f32x4*)((isv ? pv : pu) + (size_t)e * DM);
        f32x4 v[8]; float amax = 0.f;
#pragma unroll
        for (int j = 0; j < 8; ++j) { v[j] = __builtin_nontemporal_load(srcp + lane + 64 * j);
            if (!isv) { const f32x4 g4 = *(const f32x4*)(g_ffn + 4 * (lane + 64 * j)); v[j] = v[j] * g4; }
            amax = fmaxf(amax, fmaxf(fmaxf(fabsf(v[j][0]), fabsf(v[j][1])), fmaxf(fabsf(v[j][2]), fabsf(v[j][3])))); }
        amax = wave_max(amax);
        const float sc = amax > 0.f ? 127.f / amax : 1.f;
        unsigned char* dst = ws + (isv ? WS_V8 : WS_U8) + (size_t)e * 128;
#pragma unroll
        for (int j = 0; j < 8; ++j) { const int p = pack_i8(v[j][0] * sc, v[j][1] * sc, v[j][2] * sc, v[j][3] * sc);
            const int col = 4 * (lane + 64 * j);
            __builtin_nontemporal_store((unsigned)p, (unsigned*)(dst + (size_t)(col >> 7) * ((size_t)NEXP * 128) + (col & 127))); }
        if (lane == 0) suv[r] = 1.f / sc;
    }
}
constexpr int TAB_BAR0 = TAB_P0_ROWS + TAB_P1_ROWS, TAB_BAR_STEP = 256 * 7;
constexpr int TAB_ATT0 = TAB_P0_ROWS + TAB_P1_ROWS, TAB_ATT_ITEMS = (TAB_BAR0 - TAB_ATT0) / 64;
constexpr int TAB_SPLIT = TAB_P0_ROWS;

__device__ __forceinline__ void p0_win_stripe(const float* W, unsigned char* WT, float* wsc, LAS unsigned char* lds, int nb) {
    const int tid = tid_opaque(), lane = tid & 63, wave = __builtin_amdgcn_readfirstlane(tid >> 6), rr = lane >> 3, c4 = lane & 7, n0 = 32 * nb;
    const float* srcp = W + (size_t)(256 * wave + 32 * rr) * DIN + n0 + 4 * c4;
    f32x4 v[4][8];
#pragma unroll
    for (int c = 0; c < 4; ++c)
#pragma unroll
        for (int i = 0; i < 8; ++i) v[c][i] = __builtin_nontemporal_load((const f32x4*)(srcp + (size_t)(8 * c + i) * DIN));
    f32x4 m = {0.f, 0.f, 0.f, 0.f};
#pragma unroll
    for (int c = 0; c < 4; ++c)
#pragma unroll
        for (int i = 0; i < 8; ++i) { m[0] = fmaxf(m[0], fabsf(v[c][i][0])); m[1] = fmaxf(m[1], fabsf(v[c][i][1])); m[2] = fmaxf(m[2], fabsf(v[c][i][2])); m[3] = fmaxf(m[3], fabsf(v[c][i][3])); }
#pragma unroll
    for (int j = 0; j < 4; ++j) { m[j] = fmaxf(m[j], sx_f(m[j], 8)); m[j] = fmaxf(m[j], sx_f(m[j], 16)); m[j] = fmaxf(m[j], sx_f(m[j], 32)); }
    LAS float* red = (LAS float*)(lds + MISC_OFF + 256);
    if (rr == 0) *(LAS f32x4*)(red + wave * 32 + 4 * c4) = m;
    __syncthreads();
#pragma unroll
    for (int w = 0; w < NWAVES; ++w) { const f32x4 o = *(const LAS f32x4*)(red + w * 32 + 4 * c4); m[0] = fmaxf(m[0], o[0]); m[1] = fmaxf(m[1], o[1]); m[2] = fmaxf(m[2], o[2]); m[3] = fmaxf(m[3], o[3]); }
    if (wave == 0 && rr == 0) { f32x4 s; s[0] = m[0] * (1.f / 127.f); s[1] = m[1] * (1.f / 127.f); s[2] = m[2] * (1.f / 127.f); s[3] = m[3] * (1.f / 127.f); *(f32x4*)(wsc + n0 + 4 * c4) = s; }
    unsigned char* dst = WT + (size_t)(n0 + 4 * c4) * DM + 256 * wave + 32 * rr;
#pragma unroll
    for (int j = 0; j < 4; ++j) { const float q = m[j] > 0.f ? 127.f / m[j] : 1.f;
        u32x4 lo, hi;
        lo.x = (unsigned)pack_i8(v[0][0][j] * q, v[0][1][j] * q, v[0][2][j] * q, v[0][3][j] * q); lo.y = (unsigned)pack_i8(v[0][4][j] * q, v[0][5][j] * q, v[0][6][j] * q, v[0][7][j] * q);
        lo.z = (unsigned)pack_i8(v[1][0][j] * q, v[1][1][j] * q, v[1][2][j] * q, v[1][3][j] * q); lo.w = (unsigned)pack_i8(v[1][4][j] * q, v[1][5][j] * q, v[1][6][j] * q, v[1][7][j] * q);
        hi.x = (unsigned)pack_i8(v[2][0][j] * q, v[2][1][j] * q, v[2][2][j] * q, v[2][3][j] * q); hi.y = (unsigned)pack_i8(v[2][4][j] * q, v[2][5][j] * q, v[2][6][j] * q, v[2][7][j] * q);
        hi.z = (unsigned)pack_i8(v[3][0][j] * q, v[3][1][j] * q, v[3][2][j] * q, v[3][3][j] * q); hi.w = (unsigned)pack_i8(v[3][4][j] * q, v[3][5][j] * q, v[3][6][j] * q, v[3][7][j] * q);
        *(u32x4*)(dst + (size_t)j * DM) = lo; *(u32x4*)(dst + (size_t)j * DM + 16) = hi; }
    __syncthreads();
}
__device__ __forceinline__ float log_sigmoid_f(float x) { return fminf(x, 0.f) - log1pf(expf(-fabsf(x))); }

__device__ __forceinline__ void phase0(const Args& a, unsigned char* lds_g) {
    LAS unsigned char* lds = (LAS unsigned char*)lds_g;
    const int tid = tid_opaque(), lane = tid & 63, wave = __builtin_amdgcn_readfirstlane(tid >> 6);
    const int gw = blockIdx.x * NWAVES + wave, NGW = gridDim.x * NWAVES;
    const int gt = blockIdx.x * NTHREADS + tid, NGT = gridDim.x * NTHREADS;
    unsigned char* ws = a.ws;
    const float* x = a.in[0]; const float* g_attn = a.in[1]; const float* w_in = a.in[2]; const float* b_forget = a.in[3];
    const float* w_out = a.in[6]; const float* g_ffn = a.in[7]; const float* w_pq = a.in[8]; const float* sk = a.in[9]; const float* pu = a.in[10]; const float* pv = a.in[11];
    if ((int)blockIdx.x < NPROJ / 32) p0_win_stripe(w_in, ws + WS_WIN, (float*)(ws + WS_WSC), lds, (NPROJ / 32 / 8) * ((int)blockIdx.x & 7) + ((int)blockIdx.x >> 3));
    LAS float* wf = (LAS float*)(lds + 67584);
    for (int k = tid; k < DM; k += NTHREADS) { const f32x4 a0 = *(const f32x4*)(w_in + (size_t)k * DIN + NPROJ), a1 = *(const f32x4*)(w_in + (size_t)k * DIN + NPROJ + 4);
        wf[0 * DM + k] = a0[0]; wf[1 * DM + k] = a0[1]; wf[2 * DM + k] = a0[2]; wf[3 * DM + k] = a0[3]; wf[4 * DM + k] = a1[0]; wf[5 * DM + k] = a1[1]; wf[6 * DM + k] = a1[2]; wf[7 * DM + k] = a1[3]; }
    __syncthreads();
    for (int row = gw; row < T; row += NGW) {
        const f32x4* xr = (const f32x4*)(x + (size_t)row * DM);
        f32x4 v[8]; float ss = 0.f;
#pragma unroll
        for (int j = 0; j < 8; ++j) { v[j] = __builtin_nontemporal_load(xr + lane + 64 * j); ss += v[j][0] * v[j][0] + v[j][1] * v[j][1] + v[j][2] * v[j][2] + v[j][3] * v[j][3]; }
        const float r = 1.0f / sqrtf(wave_sum(ss) * (1.f / DM) + EPS);
        float f[8] = {0.f, 0.f, 0.f, 0.f, 0.f, 0.f, 0.f, 0.f};
        float xmax = 0.f;
#pragma unroll
        for (int j = 0; j < 8; ++j) { const f32x4 g4 = *(const f32x4*)(g_attn + 4 * (lane + 64 * j)); v[j][0] *= r * g4[0]; v[j][1] *= r * g4[1]; v[j][2] *= r * g4[2]; v[j][3] *= r * g4[3];
            xmax = fmaxf(xmax, fmaxf(fmaxf(fabsf(v[j][0]), fabsf(v[j][1])), fmaxf(fabsf(v[j][2]), fabsf(v[j][3])))); }
        xmax = wave_max(xmax);
        const float xq = xmax > 0.f ? 127.f / xmax : 1.f;
        if (lane == 0) ((float*)(ws + WS_SXN))[row] = xmax * (1.f / 127.f);
        unsigned* o8 = (unsigned*)(ws + WS_XN + (size_t)row * DM);
#pragma unroll
        for (int j = 0; j < 8; ++j) {
            const int e = 4 * (lane + 64 * j);
            const f32x4 xn = v[j];
            o8[lane + 64 * j] = (unsigned)pack_i8(xn[0] * xq, xn[1] * xq, xn[2] * xq, xn[3] * xq);
#pragma unroll
            for (int hh = 0; hh < 8; ++hh) { const f32x4 w4 = *(LAS f32x4*)(wf + hh * DM + e);
                f[hh] += (xn[0] * w4[0] + xn[1] * w4[1]) + (xn[2] * w4[2] + xn[3] * w4[3]); }
            __builtin_amdgcn_sched_barrier(0);
        }
#pragma unroll
        for (int hh = 0; hh < 8; ++hh) f[hh] = wave_sum(f[hh]);
        if (lane < 8) { float fl = f[0];
#pragma unroll
            for (int hh = 1; hh < 8; ++hh) fl = (lane == hh) ? f[hh] : fl;
            const int b = row >> 12, s = row & 4095;
            ((float*)(ws + WS_LOGF))[(size_t)(b * 8 + lane) * SEQ + s] = log_sigmoid_f(fl + b_forget[lane]); }
    }
    LAS float* scr = (LAS float*)(lds + wave * 8448);
    constexpr int I_O = (DM / 64) * (DM / 32);
    for (int it = gw; it < 2 * I_O; it += NGW) {
        int r = it;
        if (r < I_O) { p0_transpose_item(w_out, DM, DM, (bf16_t*)(ws + WS_WOUT), DM / 32, scr, r, lane, nullptr); continue; } r -= I_O;
        p0_transpose_item(w_pq, DM, DM, (bf16_t*)(ws + WS_WPQ), DM / 32, scr, r, lane, g_ffn);
    }
    for (int i = gt; i < 8 * 2 * 128 * 128 / 8; i += NGT) { const f32x4 a0 = *(const f32x4*)(sk + (size_t)i * 8), a1 = *(const f32x4*)(sk + (size_t)i * 8 + 4);
        u32x4 w; w.x = cvt_pk_bf16(a0[0], a0[1]); w.y = cvt_pk_bf16(a0[2], a0[3]); w.z = cvt_pk_bf16(a1[0], a1[1]); w.w = cvt_pk_bf16(a1[2], a1[3]);
        *(u32x4*)(ws + WS_SK + (size_t)i * 16) = w; }
    if (gt < 256) ((float*)(ws + WS_GQK))[gt] = gt < 128 ? a.in[4][gt] : a.in[5][gt - 128];
    convert_tables(a, 0, TAB_SPLIT, gw, NGW);
}

__device__ __forceinline__ void cumsum_rows(const Args& a) {
    const int tid = tid_opaque(), lane = tid & 63, wave = tid >> 6;
    const int rowi = (int)gridDim.x - 1 - (int)blockIdx.x;
    if (rowi >= 16 || rowi < 0 || wave != 0) return;
    const float* src = (const float*)(a.ws + WS_LOGF) + (size_t)rowi * SEQ + lane * 64;
    float* dst = (float*)(a.ws + WS_C) + (size_t)rowi * SEQ + lane * 64;
    f32x4 v[16]; float run = 0.f;
#pragma unroll
    for (int i = 0; i < 16; ++i) { v[i] = *(const f32x4*)(src + 4 * i);
#pragma unroll
        for (int q = 0; q < 4; ++q) { run += v[i][q]; v[i][q] = run; } }
    float incl = run;
#pragma unroll
    for (int o = 1; o < 64; o <<= 1) { const float t = shup_f(incl, o); if (lane >= o) incl += t; }
    const float off = incl - run;
#pragma unroll
    for (int i = 0; i < 16; ++i) { f32x4 w = v[i]; w[0] += off; w[1] += off; w[2] += off; w[3] += off; *(f32x4*)(dst + 4 * i) = w; }
}

__device__ __forceinline__ void phase_qknorm(const Args& a) {
    const int tid = tid_opaque(), lane = tid & 63, wave = tid >> 6;
    const int gw = blockIdx.x * NWAVES + wave, NGW = gridDim.x * NWAVES;
    const int sub = lane & 15, rw = lane >> 4;
    const float* gq = a.in[4]; const float* gk = a.in[5];
    constexpr int ROWS = NB * NHF * SEQ;
    for (int it = gw; it < 2 * ROWS / 4; it += NGW) {
        const int row = it * 4 + rw; const bool isk = row >= ROWS;
        bf16_t* p = (bf16_t*)(a.ws + WS_SEC) + (size_t)row * HD + sub * 8;
        const float* g = (isk ? gk : gq) + sub * 8;
        const u32x4 w = *(const u32x4*)p;
        float v[8] = {bf_lo(w.x), bf_hi(w.x), bf_lo(w.y), bf_hi(w.y), bf_lo(w.z), bf_hi(w.z), bf_lo(w.w), bf_hi(w.w)};
        float ss = 0.f;
#pragma unroll
        for (int i = 0; i < 8; ++i) ss += v[i] * v[i];
        ss += sx_f(ss, 1); ss += sx_f(ss, 2); ss += sx_f(ss, 4); ss += sx_f(ss, 8);
        const float r = 1.0f / sqrtf(ss * (1.f / HD) + EPS);
        const f32x4 g0 = *(const f32x4*)g, g1 = *(const f32x4*)(g + 4);
        u32x4 o; o.x = cvt_pk_bf16(v[0] * r * g0[0], v[1] * r * g0[1]); o.y = cvt_pk_bf16(v[2] * r * g0[2], v[3] * r * g0[3]);
        o.z = cvt_pk_bf16(v[4] * r * g1[0], v[5] * r * g1[1]); o.w = cvt_pk_bf16(v[6] * r * g1[2], v[7] * r * g1[3]);
        *(u32x4*)p = o;
    }
}

__device__ __forceinline__ void attn_combine_item(unsigned char* ws, int item) {
    const int tid = tid_opaque();
    const int slot = item >> 1;
    if (tid == 0) { unsigned* bar = (unsigned*)(ws + WS_CTL) + CW_BAR; unsigned* dn = (unsigned*)(ws + WS_CTL) + CW_DONE + slot;
        XB_SPIN(xb_ld(dn) < 2u, bar);
        __builtin_amdgcn_fence(__ATOMIC_ACQUIRE, "agent");
        asm volatile("s_waitcnt vmcnt(0)" ::: "memory"); }
    __syncthreads();
    const float* po = (const float*)(ws + WS_PO); const float* pml = (const float*)(ws + WS_PML);
    const bf16_t* gate = (const bf16_t*)(ws + WS_SEC) + 3 * SEC_ELEMS; bf16_t* mix = (bf16_t*)(ws + WS_MIX);
    constexpr float C2 = LOG2E * SCALE;
    const int qb = 8 + (slot >> 4), bh = slot & 15, b = bh >> 3, h = bh & 7;
#pragma unroll
    for (int k = 0; k < 4; ++k) {
        const int idx = tid + NTHREADS * k, row = (item & 1) * 128 + (idx >> 4), cg = idx & 15;
        const f32x2 ml1 = *(const f32x2*)(pml + (size_t)(slot * 2) * 512 + row * 2), ml2 = *(const f32x2*)(pml + (size_t)(slot * 2 + 1) * 512 + row * 2);
        const float M = fmaxf(ml1.x, ml2.x), a1 = __builtin_amdgcn_exp2f((ml1.x - M) * C2), a2 = __builtin_amdgcn_exp2f((ml2.x - M) * C2);
        const float inv = 1.f / (a1 * ml1.y + a2 * ml2.y);
        const float* p1 = po + (size_t)(slot * 2) * 32768 + row * 128 + cg * 8; const float* p2 = p1 + 32768;
        const f32x4 x0 = *(const f32x4*)p1, x1 = *(const f32x4*)(p1 + 4), y0 = *(const f32x4*)p2, y1 = *(const f32x4*)(p2 + 4);
        const size_t tok = (size_t)b * SEQ + qb * 256 + row;
        const u32x4 gw = *(const u32x4*)(gate + tok * 1024 + h * HD + cg * 8);
        const float w1 = a1 * inv, w2 = a2 * inv;
        u32x4 o;
        o.x = cvt_pk_bf16((w1 * x0[0] + w2 * y0[0]) * bf_lo(gw.x), (w1 * x0[1] + w2 * y0[1]) * bf_hi(gw.x));
        o.y = cvt_pk_bf16((w1 * x0[2] + w2 * y0[2]) * bf_lo(gw.y), (w1 * x0[3] + w2 * y0[3]) * bf_hi(gw.y));
        o.z = cvt_pk_bf16((w1 * x1[0] + w2 * y1[0]) * bf_lo(gw.z), (w1 * x1[1] + w2 * y1[1]) * bf_hi(gw.z));
        o.w = cvt_pk_bf16((w1 * x1[2] + w2 * y1[2]) * bf_lo(gw.w), (w1 * x1[3] + w2 * y1[3]) * bf_hi(gw.w));
        *(u32x4*)(mix + tok * DM + h * HD + cg * 8) = o;
    }
}

__device__ __forceinline__ void phase_attn(const Args& a, unsigned char* lds_g) {
    const int tid = tid_opaque();
    volatile int* s_item = (volatile int*)(lds_g + MISC_OFF);
    unsigned* ctr = (unsigned*)(a.ws + WS_CTL);
    float lmax;
    { const int lane_ = tid & 63; const float* gqk = (const float*)(a.ws + WS_GQK);
      const float gq = fmaxf(fabsf(gqk[lane_]), fabsf(gqk[64 + lane_])), gk = fmaxf(fabsf(gqk[128 + lane_]), fabsf(gqk[192 + lane_]));
      lmax = 11.3137085f * 1.02f * wave_max(gq) * wave_max(gk); }
    for (;;) {
        if (tid == 0) *s_item = (int)atomicAdd(ctr, 1u);
        __syncthreads();
        int it = *s_item, kind = -1, qb = 0, sub = 0;
#define CLS(K, Q, CNT) if (kind < 0) { if (it < (CNT)) { kind = (K); qb = (Q); sub = it; } else it -= (CNT); }
        CLS(2, 15, 32) CLS(1, 7, 16) CLS(2, 14, 32) CLS(2, 13, 32) CLS(1, 6, 16) CLS(2, 12, 32) CLS(2, 11, 32) CLS(1, 5, 16) CLS(2, 10, 32) CLS(2, 9, 32) CLS(1, 4, 16) CLS(2, 8, 32) CLS(1, 3, 16) CLS(1, 2, 16)
        if (kind < 0) { if (it < 256) { kind = 0; qb = 15 - (it >> 4); sub = it & 15; } else it -= 256; }
        CLS(1, 1, 16) CLS(1, 0, 16)
        CLS(4, 0, TAB_ATT_ITEMS)
        CLS(3, 0, 256)
#undef CLS
        if (kind < 0) break;
        unsigned char* wsl = a.ws; asm volatile("" : "+s"(wsl));
        if (kind == 3) { attn_combine_item(wsl, sub); continue; }
        if (kind == 4) { convert_tables(a, TAB_ATT0 + sub * 64, TAB_ATT0 + sub * 64 + 64, tid >> 6, NWAVES); __syncthreads(); continue; }
        bf16_t* sec = (bf16_t*)(wsl + WS_SEC);
        const int bh = sub & 15, part = (kind == 2) ? 1 + (sub >> 4) : 0;
        const int b = bh >> 3, h = bh & 7;
        const size_t hoff = (size_t)bh * SEQ * HD;
        att::UnitRef u;
        u.P0 = qb * 256;
        if (kind == 0) {
            u.Q = sec + 4 * SEC_ELEMS + hoff + (size_t)u.P0 * HD; u.K = sec + 5 * SEC_ELEMS + hoff; u.V = sec + 6 * SEC_ELEMS + hoff;
            att::sb_unit(u, (bf16_t*)(wsl + WS_MIX) + (size_t)b * SEQ * DM + 1024 + h * HD, (char*)lds_g);
        } else {
            u.Q = sec + 0 * SEC_ELEMS + hoff + (size_t)u.P0 * HD; u.K = sec + 1 * SEC_ELEMS + hoff; u.V = sec + 2 * SEC_ELEMS + hoff;
            att::attn_unit<false>(u, wsl, bh, (char*)lds_g, part, lmax);
        }
    }
}
__device__ __forceinline__ unsigned f2ord(float f) { const unsigned u = __float_as_uint(f); return u ^ ((unsigned)((int)u >> 31) | 0x80000000u); }
__device__ __forceinline__ float ord2f(unsigned k) { const unsigned u = k ^ (~(unsigned)((int)k >> 31) | 0x80000000u); return __uint_as_float(u); }
#define INS16(L, X) do { unsigned x_ = (X); _Pragma("unroll") for (int i_ = 0; i_ < 16; ++i_) { const unsigned hi_ = max(L[i_], x_); x_ = min(L[i_], x_); L[i_] = hi_; } } while (0)
__device__ __forceinline__ void sort16_desc(unsigned (&a)[16]) {
#pragma unroll
    for (int k = 2; k <= 16; k <<= 1)
#pragma unroll
        for (int j = k >> 1; j > 0; j >>= 1)
#pragma unroll
            for (int i = 0; i < 16; ++i) { const int l = i ^ j; if (l > i) { const unsigned hi_ = max(a[i], a[l]), lo_ = min(a[i], a[l]); const bool desc = (i & k) == 0; a[i] = desc ? hi_ : lo_; a[l] = desc ? lo_ : hi_; } }
}
__device__ __forceinline__ void merge_top16(unsigned (&a)[16], const unsigned (&b)[16]) {
#pragma unroll
    for (int i = 0; i < 16; ++i) a[i] = max(a[i], b[15 - i]);
#pragma unroll
    for (int j = 8; j > 0; j >>= 1)
#pragma unroll
        for (int i = 0; i < 16; ++i) { const int l = i ^ j; if (l > i) { const unsigned hi_ = max(a[i], a[l]), lo_ = min(a[i], a[l]); a[i] = hi_; a[l] = lo_; } }
}
__device__ __forceinline__ void topk_half(const bf16_t* qrow  , const bf16_t* skb, int h, int c, int r32, int hi, unsigned (&L)[16]) {
    bf16x8 qf[8];
#pragma unroll
    for (int d0 = 0; d0 < 8; ++d0) qf[d0] = *(const bf16x8*)(qrow + c * 128 + d0 * 16 + hi * 8);
    const unsigned hi4 = 4u * (unsigned)hi;
#pragma unroll
    for (int kt = 0; kt < 4; ++kt) {
        f32x16 acc = f32x16{};
#pragma unroll
        for (int d0 = 0; d0 < 8; ++d0) { const bf16x8 kf = *(const bf16x8*)(skb + (size_t)((h * 2 + c) * 128 + kt * 32 + r32) * 128 + d0 * 16 + hi * 8);
            acc = __builtin_amdgcn_mfma_f32_32x32x16_bf16(kf, qf[d0], acc, 0, 0, 0); }
        unsigned G[16];
#pragma unroll
        for (int r = 0; r < 16; ++r) { const unsigned cst = (unsigned)(127 - (kt * 32 + (r & 3) + 8 * (r >> 2))); G[r] = (f2ord(acc[r]) & ~127u) | (cst - hi4); }
        sort16_desc(G);
        if (kt == 0) {
#pragma unroll
            for (int i = 0; i < 16; ++i) L[i] = G[i];
        } else merge_top16(L, G);
    }
    unsigned P[16];
#pragma unroll
    for (int i = 0; i < 16; ++i) { auto rr = __builtin_amdgcn_permlane32_swap(L[i], L[i], false, false); P[i] = hi ? rr[0] : rr[1]; }
    merge_top16(L, P);
}
__device__ __forceinline__ void topk_task(unsigned char* ws, const bf16_t* qrow, LAS int* tb, int t0, int h, int lane) {
    const int r32 = lane & 31, hi = lane >> 5;
    const bf16_t* skb = (const bf16_t*)(ws + WS_SK);
    int* idx_o = (int*)(ws + WS_IDX); float* gw_o = (float*)(ws + WS_GW);
    float rt_l;
    { const f32x4* sp = (const f32x4*)((const float*)(ws + WS_SSQ) + (size_t)(t0 + (lane & 31)) * 32); float tot = 0.f;
#pragma unroll
      for (int i = 0; i < 8; ++i) { const f32x4 v = sp[i]; tot += (v[0] + v[1]) + (v[2] + v[3]); }
      rt_l = 1.0f / sqrtf(tot * (1.f / DM) + EPS); }
        {
          const bf16_t* hbp = (const bf16_t*)(ws + WS_HB); const float* amx = (const float*)(ws + WS_AMX); unsigned char* xq = ws + WS_XQ;
          float am = 0.f;
          { const f32x4* ap = (const f32x4*)(amx + (size_t)(t0 + (lane & 31)) * 32);
#pragma unroll
            for (int i = 0; i < 8; ++i) { const f32x4 v = ap[i]; am = fmaxf(am, fmaxf(fmaxf(v[0], v[1]), fmaxf(v[2], v[3]))); } }
          if (h == 0 && lane < 32) ((float*)(ws + WS_SX))[t0 + lane] = rt_l * am * (1.f / 126.5f);
          const float qs = am > 0.f ? 126.5f / am : 1.f;
          u32x4 wv[16];
#pragma unroll
          for (int j = 0; j < 16; ++j) { const int ch = lane + 64 * j; wv[j] = *(const u32x4*)(hbp + (size_t)(t0 + (ch >> 5)) * DM + h * 256 + (ch & 31) * 8); }
#pragma unroll
          for (int j = 0; j < 16; ++j) { const int ch = lane + 64 * j, tl = ch >> 5, tk = t0 + tl, col = h * 256 + (ch & 31) * 8;
              const u32x4 w = wv[j]; const float r = sh_f(qs, tl);
              const int p0 = pack_i8(bf_lo(w.x) * r, bf_hi(w.x) * r, bf_lo(w.y) * r, bf_hi(w.y) * r), p1 = pack_i8(bf_lo(w.z) * r, bf_hi(w.z) * r, bf_lo(w.w) * r, bf_hi(w.w) * r);
              *(u32x2*)(xq + (size_t)tk * DM + col) = (u32x2){(unsigned)p0, (unsigned)p1}; } }
        unsigned L[2][16];
        topk_half(qrow, skb, h, 0, r32, hi, L[0]);
        __builtin_amdgcn_sched_barrier(0);
        topk_half(qrow, skb, h, 1, r32, hi, L[1]);
        __builtin_amdgcn_sched_barrier(0);
        float s1[16], s2[16]; int i1[16], i2[16];
#pragma unroll
        for (int i = 0; i < 16; ++i) { s1[i] = ord2f((L[0][i] & ~127u) | 64u); i1[i] = 127 - (int)(L[0][i] & 127u); s2[i] = ord2f((L[1][i] & ~127u) | 64u); i2[i] = 127 - (int)(L[1][i] & 127u); }
        unsigned CG[4][16];
#pragma unroll
        for (int i = 0; i < 64; ++i) CG[i >> 4][i & 15] = 0u;
        CG[0][0] = (f2ord(s1[0] + s2[0]) & ~255u) | 0u;
        CG[0][1] = (f2ord(s1[0] + s2[1]) & ~255u) | 1u;
        CG[0][2] = (f2ord(s1[0] + s2[2]) & ~255u) | 2u;
        CG[0][3] = (f2ord(s1[0] + s2[3]) & ~255u) | 3u;
        CG[0][4] = (f2ord(s1[0] + s2[4]) & ~255u) | 4u;
        CG[0][5] = (f2ord(s1[0] + s2[5]) & ~255u) | 5u;
        CG[0][6] = (f2ord(s1[0] + s2[6]) & ~255u) | 6u;
        CG[0][7] = (f2ord(s1[0] + s2[7]) & ~255u) | 7u;
        CG[0][8] = (f2ord(s1[0] + s2[8]) & ~255u) | 8u;
        CG[0][9] = (f2ord(s1[0] + s2[9]) & ~255u) | 9u;
        CG[0][10] = (f2ord(s1[0] + s2[10]) & ~255u) | 10u;
        CG[0][11] = (f2ord(s1[0] + s2[11]) & ~255u) | 11u;
        CG[0][12] = (f2ord(s1[0] + s2[12]) & ~255u) | 12u;
        CG[0][13] = (f2ord(s1[0] + s2[13]) & ~255u) | 13u;
        CG[0][14] = (f2ord(s1[0] + s2[14]) & ~255u) | 14u;
        CG[0][15] = (f2ord(s1[0] + s2[15]) & ~255u) | 15u;
        CG[1][0] = (f2ord(s1[1] + s2[0]) & ~255u) | 16u;
        CG[1][1] = (f2ord(s1[1] + s2[1]) & ~255u) | 17u;
        CG[1][2] = (f2ord(s1[1] + s2[2]) & ~255u) | 18u;
        CG[1][3] = (f2ord(s1[1] + s2[3]) & ~255u) | 19u;
        CG[1][4] = (f2ord(s1[1] + s2[4]) & ~255u) | 20u;
        CG[1][5] = (f2ord(s1[1] + s2[5]) & ~255u) | 21u;
        CG[1][6] = (f2ord(s1[1] + s2[6]) & ~255u) | 22u;
        CG[1][7] = (f2ord(s1[1] + s2[7]) & ~255u) | 23u;
        CG[1][8] = (f2ord(s1[2] + s2[0]) & ~255u) | 32u;
        CG[1][9] = (f2ord(s1[2] + s2[1]) & ~255u) | 33u;
        CG[1][10] = (f2ord(s1[2] + s2[2]) & ~255u) | 34u;
        CG[1][11] = (f2ord(s1[2] + s2[3]) & ~255u) | 35u;
        CG[1][12] = (f2ord(s1[2] + s2[4]) & ~255u) | 36u;
        CG[1][13] = (f2ord(s1[3] + s2[0]) & ~255u) | 48u;
        CG[1][14] = (f2ord(s1[3] + s2[1]) & ~255u) | 49u;
        CG[1][15] = (f2ord(s1[3] + s2[2]) & ~255u) | 50u;
        CG[2][0] = (f2ord(s1[3] + s2[3]) & ~255u) | 51u;
        CG[2][1] = (f2ord(s1[4] + s2[0]) & ~255u) | 64u;
        CG[2][2] = (f2ord(s1[4] + s2[1]) & ~255u) | 65u;
        CG[2][3] = (f2ord(s1[4] + s2[2]) & ~255u) | 66u;
        CG[2][4] = (f2ord(s1[5] + s2[0]) & ~255u) | 80u;
        CG[2][5] = (f2ord(s1[5] + s2[1]) & ~255u) | 81u;
        CG[2][6] = (f2ord(s1[6] + s2[0]) & ~255u) | 96u;
        CG[2][7] = (f2ord(s1[6] + s2[1]) & ~255u) | 97u;
        CG[2][8] = (f2ord(s1[7] + s2[0]) & ~255u) | 112u;
        CG[2][9] = (f2ord(s1[7] + s2[1]) & ~255u) | 113u;
        CG[2][10] = (f2ord(s1[8] + s2[0]) & ~255u) | 128u;
        CG[2][11] = (f2ord(s1[9] + s2[0]) & ~255u) | 144u;
        CG[2][12] = (f2ord(s1[10] + s2[0]) & ~255u) | 160u;
        CG[2][13] = (f2ord(s1[11] + s2[0]) & ~255u) | 176u;
        CG[2][14] = (f2ord(s1[12] + s2[0]) & ~255u) | 192u;
        CG[2][15] = (f2ord(s1[13] + s2[0]) & ~255u) | 208u;
        CG[3][0] = (f2ord(s1[14] + s2[0]) & ~255u) | 224u;
        CG[3][1] = (f2ord(s1[15] + s2[0]) & ~255u) | 240u;
        sort16_desc(CG[0]); sort16_desc(CG[1]); sort16_desc(CG[2]); sort16_desc(CG[3]);
        merge_top16(CG[0], CG[1]); merge_top16(CG[2], CG[3]); merge_top16(CG[0], CG[2]);
        unsigned LC[16];
#pragma unroll
        for (int i = 0; i < 16; ++i) LC[i] = CG[0][i];
#pragma unroll
        for (int i = 0; i < 16; ++i) { tb[i * 64 + lane] = i1[i]; tb[(16 + i) * 64 + lane] = i2[i]; }
        float LS[16]; int LP[16];
#pragma unroll
        for (int i = 0; i < 16; ++i) { const unsigned cid = LC[i] & 255u; LS[i] = ord2f((LC[i] & ~255u) | 128u);
            LP[i] = tb[(cid >> 4) * 64 + lane] * 128 + tb[(16 + (cid & 15u)) * 64 + lane]; }
        float den = 0.f, e[16];
#pragma unroll
        for (int i = 0; i < 16; ++i) { e[i] = __expf((LS[i] - LS[0]) * rt_l); den += e[i]; }
        const float rden = 1.f / den;
        const size_t ob = (size_t)(t0 + r32) * NE + h * 16;
        if (hi == 0) {
#pragma unroll
            for (int i = 0; i < 4; ++i) *(int4*)(idx_o + ob + 4 * i) = make_int4(LP[4 * i], LP[4 * i + 1], LP[4 * i + 2], LP[4 * i + 3]);
            { unsigned short* i16 = (unsigned short*)(ws + WS_IDX16) + ob;
#pragma unroll
              for (int i = 0; i < 2; ++i) *(u32x4*)(i16 + 8 * i) = (u32x4){(unsigned)LP[8 * i] | ((unsigned)LP[8 * i + 1] << 16), (unsigned)LP[8 * i + 2] | ((unsigned)LP[8 * i + 3] << 16),
                                                                        (unsigned)LP[8 * i + 4] | ((unsigned)LP[8 * i + 5] << 16), (unsigned)LP[8 * i + 6] | ((unsigned)LP[8 * i + 7] << 16)}; }
        } else {
#pragma unroll
            for (int i = 0; i < 4; ++i) *(f32x4*)(gw_o + ob + 4 * i) = (f32x4){e[4 * i] * rden, e[4 * i + 1] * rden, e[4 * i + 2] * rden, e[4 * i + 3] * rden};
        }
}
__device__ __forceinline__ void phase_topk(const Args& a, unsigned char* lds_g) {
    LAS unsigned char* lds = (LAS unsigned char*)lds_g;
    const int tid = tid_opaque(), lane = tid & 63, wave = tid >> 6;
    const int gw = blockIdx.x * NWAVES + wave, NGW = gridDim.x * NWAVES;
    const bf16_t* qp = (const bf16_t*)(a.ws + WS_QP);
    for (int task = gw; task < (T / 32) * 8; task += NGW) {
        const int h = task & 7, t0 = (task >> 3) * 32;
        topk_task(a.ws, qp + (size_t)(t0 + (lane & 31)) * DM + h * 256, (LAS int*)(lds + wave * 8192), t0, h, lane);
    }
}
__device__ __forceinline__ void pg8::EpiPeerQFused::fused(const f32x4 (&acc)[2][2][4][2], const Unit& u, int wr, int wc, int fr, int fq, PG8_LAS unsigned char* lds) const {
    constexpr int ROWB = 528;
#pragma unroll
    for (int ai = 0; ai < 2; ++ai)
#pragma unroll
        for (int m = 0; m < 4; ++m) {
            const int tr = ai * HALF + wr * 64 + m * 16 + fr;
#pragma unroll
            for (int bj = 0; bj < 2; ++bj) {
                const f32x4 v0 = acc[ai][bj][m][0], v1 = acc[ai][bj][m][1];
                u32x4 w; w.x = cvt_pk_bf16(v0[0], v0[1]); w.y = cvt_pk_bf16(v0[2], v0[3]); w.z = cvt_pk_bf16(v1[0], v1[1]); w.w = cvt_pk_bf16(v1[2], v1[3]);
                *(PG8_LAS u32x4*)(lds + tr * ROWB + (bj * HALF + wc * 32 + 8 * fq) * 2) = w;
            }
        }
    __syncthreads();
    const int tid = tid_opaque(), lane = tid & 63, wave = tid >> 6;
    PG8_LAS unsigned char* myrows = lds + (wave * 32) * ROWB;
    topk_task(wsb, (const bf16_t*)(const void*)(myrows + (lane & 31) * ROWB), (LAS int*)myrows, u.pm * BM + wave * 32, u.pn, lane);
}
__device__ __forceinline__ void wave_argmax(float& v, int& i) {
#pragma unroll
    for (int o = 1; o < 64; o <<= 1) { const float ov = sx_f(v, o); const int oi = sx_i(i, o); if (ov > v || (ov == v && oi < i)) { v = ov; i = oi; } }
}
__device__ __forceinline__ void phase_topk_ref(const Args& a) {
    const int tid = tid_opaque(), lane = tid & 63, wave = tid >> 6;
    const int gw = blockIdx.x * NWAVES + wave, NGW = gridDim.x * NWAVES;
    const bf16_t* skb = (const bf16_t*)(a.ws + WS_SK); const bf16_t* qp = (const bf16_t*)(a.ws + WS_QP);
    int* idx_o = (int*)(a.ws + WS_IDX); float* gw_o = (float*)(a.ws + WS_GW);
    for (int task = gw; task < T * 8; task += NGW) {
        const int t = task >> 3, h = task & 7;
        float topS[2]; int topI[2];
        for (int c = 0; c < 2; ++c) {
            const bf16_t* q = qp + (size_t)t * DM + h * 256 + c * 128;
            float sc0 = 0.f, sc1 = 0.f;
            const bf16_t* k0 = skb + (size_t)((h * 2 + c) * 128 + lane) * 128; const bf16_t* k1 = k0 + 64 * 128;
            for (int d = 0; d < 128; ++d) { const float qd = __uint_as_float((unsigned)q[d] << 16);
                sc0 += qd * __uint_as_float((unsigned)k0[d] << 16); sc1 += qd * __uint_as_float((unsigned)k1[d] << 16); }
            float ms = 0.f; int mi = 0;
            for (int r = 0; r < 16; ++r) {
                float v; int i; if (sc0 >= sc1) { v = sc0; i = lane; } else { v = sc1; i = lane + 64; }
                wave_argmax(v, i);
                if (lane == r) { ms = v; mi = i; }
                if (i == lane) sc0 = -__builtin_inff();
                if (i == lane + 64) sc1 = -__builtin_inff();
            }
            topS[c] = ms; topI[c] = mi;
        }
        float cs[4]; int ci[4];
#pragma unroll
        for (int j = 0; j < 4; ++j) { const int cidx = lane * 4 + j, aa = cidx >> 4, bb = cidx & 15;
            cs[j] = sh_f(topS[0], aa) + sh_f(topS[1], bb); ci[j] = cidx; }
        float fs = 0.f; int fi = 0;
        for (int r = 0; r < 16; ++r) {
            float v = cs[0]; int i = ci[0];
#pragma unroll
            for (int j = 1; j < 4; ++j) if (cs[j] > v) { v = cs[j]; i = ci[j]; }
            wave_argmax(v, i);
            if (lane == r) { fs = v; fi = i; }
#pragma unroll
            for (int j = 0; j < 4; ++j) if (ci[j] == i) cs[j] = -__builtin_inff();
        }
        const int e1 = sh_i(topI[0], fi >> 4), e2 = sh_i(topI[1], fi & 15);
        const float mx = sh_f(fs, 0);
        float ev = lane < 16 ? __expf(fs - mx) : 0.f;
        const float den = wave_sum(ev);
        if (lane < 16) { idx_o[(size_t)t * NE + h * 16 + lane] = e1 * 128 + e2; gw_o[(size_t)t * NE + h * 16 + lane] = ev / den; }
    }
}

__device__ __forceinline__ void fp8x16_to_f32(const u32x4 q, f32x2 (&o)[8]) {
    o[0] = __builtin_amdgcn_cvt_pk_f32_fp8((int)q.x, false); o[1] = __builtin_amdgcn_cvt_pk_f32_fp8((int)q.x, true);
    o[2] = __builtin_amdgcn_cvt_pk_f32_fp8((int)q.y, false); o[3] = __builtin_amdgcn_cvt_pk_f32_fp8((int)q.y, true);
    o[4] = __builtin_amdgcn_cvt_pk_f32_fp8((int)q.z, false); o[5] = __builtin_amdgcn_cvt_pk_f32_fp8((int)q.z, true);
    o[6] = __builtin_amdgcn_cvt_pk_f32_fp8((int)q.w, false); o[7] = __builtin_amdgcn_cvt_pk_f32_fp8((int)q.w, true);
}
#define HALVE(dst, srcv, n, bitmask) do { const bool up_ = (lane & (bitmask)) != 0; _Pragma("unroll") for (int i_ = 0; i_ < (n); ++i_) { \
        const float keep_ = up_ ? srcv[(n) + i_] : srcv[i_], send_ = up_ ? srcv[i_] : srcv[(n) + i_]; dst[i_] = keep_ + sx_f(send_, (bitmask)); } } while (0)
#define ITEM_T(n) (wv + ((n) % KT) * NWX)
#define ITEM_S(n) (xl + 8 * ((n) / KT))
#define LD_IDX(ID, n) do { const u32x4* ip_ = (const u32x4*)(idx16 + (size_t)ITEM_T(n) * NE + g * 16); ID[0] = ip_[0]; ID[1] = ip_[1]; } while (0)
#define LD_ROWS(Q, ID, TAB, n) do { const unsigned char* b_ = (TAB) + (size_t)ITEM_S(n) * ((size_t)NEXP * 128) + c * 16; _Pragma("unroll") for (int i_ = 0; i_ < 2; ++i_) { \
        Q[8 * i_ + 0] = *(const u32x4*)(b_ + (size_t)(ID[i_].x & 0xffffu) * 128); Q[8 * i_ + 1] = *(const u32x4*)(b_ + (size_t)(ID[i_].x >> 16) * 128); \
        Q[8 * i_ + 2] = *(const u32x4*)(b_ + (size_t)(ID[i_].y & 0xffffu) * 128); Q[8 * i_ + 3] = *(const u32x4*)(b_ + (size_t)(ID[i_].y >> 16) * 128); \
        Q[8 * i_ + 4] = *(const u32x4*)(b_ + (size_t)(ID[i_].z & 0xffffu) * 128); Q[8 * i_ + 5] = *(const u32x4*)(b_ + (size_t)(ID[i_].z >> 16) * 128); \
        Q[8 * i_ + 6] = *(const u32x4*)(b_ + (size_t)(ID[i_].w & 0xffffu) * 128); Q[8 * i_ + 7] = *(const u32x4*)(b_ + (size_t)(ID[i_].w >> 16) * 128); } } while (0)
__device__ __forceinline__ int dpp_hmirror(int v) { return __builtin_amdgcn_update_dpp(0, v, 0x141, 0xf, 0xf, true); }
__device__ __forceinline__ int dpp_qxor2(int v) { return __builtin_amdgcn_update_dpp(0, v, 0x4E, 0xf, 0xf, true); }
__device__ __forceinline__ int dpp_qxor1(int v) { return __builtin_amdgcn_update_dpp(0, v, 0xB1, 0xf, 0xf, true); }
__device__ __forceinline__ void phase_peer_u(const Args& a) {
    const int tid = tid_opaque(), lane = tid & 63, wave = tid >> 6, g = lane >> 3, c = lane & 7;
    const int xl = blockIdx.x & 7, wv = (blockIdx.x >> 3) * NWAVES + wave; constexpr int NWX = (GRID_WGS >> 3) * NWAVES, KT = T / NWX, N = 2 * KT;
    const unsigned char* xq = a.ws + WS_XQ; const unsigned char* u8 = a.ws + WS_U8;
    const unsigned short* idx16 = (const unsigned short*)(a.ws + WS_IDX16); bf16_t* part = (bf16_t*)(a.ws + WS_PART);
    const bool up4 = (c & 4) != 0, up2 = (c & 2) != 0, up1 = (c & 1) != 0;
#define LD_I16(ID, n, h) do { ID = *(const u32x4*)(idx16 + (size_t)ITEM_T(n) * NE + g * 16 + (h) * 8); } while (0)
#define LD_R8(Q, ID, n) do { const unsigned char* b_ = u8 + (size_t)ITEM_S(n) * ((size_t)NEXP * 128) + c * 16; \
        Q[0] = *(const u32x4*)(b_ + (size_t)(ID.x & 0xffffu) * 128); Q[1] = *(const u32x4*)(b_ + (size_t)(ID.x >> 16) * 128); \
        Q[2] = *(const u32x4*)(b_ + (size_t)(ID.y & 0xffffu) * 128); Q[3] = *(const u32x4*)(b_ + (size_t)(ID.y >> 16) * 128); \
        Q[4] = *(const u32x4*)(b_ + (size_t)(ID.z & 0xffffu) * 128); Q[5] = *(const u32x4*)(b_ + (size_t)(ID.z >> 16) * 128); \
        Q[6] = *(const u32x4*)(b_ + (size_t)(ID.w & 0xffffu) * 128); Q[7] = *(const u32x4*)(b_ + (size_t)(ID.w >> 16) * 128); } while (0)
#define LD_X(X, n) do { X = *(const u32x4*)(xq + (size_t)ITEM_T(n) * DM + ITEM_S(n) * 128 + c * 16); } while (0)
#define DOT8(P, OFF, Q, X) do { _Pragma("unroll") for (int i = 0; i < 8; ++i) { int d_ = __builtin_amdgcn_sdot4((int)Q[i].x, (int)X.x, 0, false); d_ = __builtin_amdgcn_sdot4((int)Q[i].y, (int)X.y, d_, false); \
            d_ = __builtin_amdgcn_sdot4((int)Q[i].z, (int)X.z, d_, false); P[(OFF) + i] = __builtin_amdgcn_sdot4((int)Q[i].w, (int)X.w, d_, false); } } while (0)
#define FINISH_U(P, n) do { int p8[8], p4[4], p2[2]; \
        _Pragma("unroll") for (int i = 0; i < 8; ++i) { const int keep_ = up4 ? P[8 + i] : P[i], send_ = up4 ? P[i] : P[8 + i]; p8[i] = keep_ + dpp_hmirror(send_); } \
        _Pragma("unroll") for (int i = 0; i < 4; ++i) { const int keep_ = up2 ? p8[4 + i] : p8[i], send_ = up2 ? p8[i] : p8[4 + i]; p4[i] = keep_ + dpp_qxor2(send_); } \
        _Pragma("unroll") for (int i = 0; i < 2; ++i) { const int keep_ = up1 ? p4[2 + i] : p4[i], send_ = up1 ? p4[i] : p4[2 + i]; p2[i] = keep_ + dpp_qxor1(send_); } \
        *(unsigned*)(part + ((size_t)ITEM_T(n) * 16 + ITEM_S(n)) * NE + 2 * lane) = cvt_pk_bf16((float)p2[0], (float)p2[1]); } while (0)
    u32x4 IA, IB, IC, ID_, QA[8], QB[8], QC[8], QD[8], XA, XB;
    LD_I16(IA, 0, 0); LD_I16(IB, 0, 1); LD_I16(IC, 1, 0); LD_I16(ID_, 1, 1);
    LD_R8(QA, IA, 0); LD_R8(QB, IB, 0); LD_X(XA, 0); LD_R8(QC, IC, 1); LD_R8(QD, ID_, 1); LD_X(XB, 1);
    if (N > 2) { LD_I16(IA, 2, 0); LD_I16(IB, 2, 1); LD_I16(IC, 3, 0); LD_I16(ID_, 3, 1); }
    for (int n = 0; n < N; n += 2) {
        int p[16];
        DOT8(p, 0, QA, XA); if (n + 2 < N) { LD_R8(QA, IA, n + 2); if (n + 4 < N) LD_I16(IA, n + 4, 0); }
        DOT8(p, 8, QB, XA); if (n + 2 < N) { LD_R8(QB, IB, n + 2); LD_X(XA, n + 2); if (n + 4 < N) LD_I16(IB, n + 4, 1); }
        FINISH_U(p, n);
        int r[16];
        DOT8(r, 0, QC, XB); if (n + 3 < N) { LD_R8(QC, IC, n + 3); if (n + 5 < N) LD_I16(IC, n + 5, 0); }
        DOT8(r, 8, QD, XB); if (n + 3 < N) { LD_R8(QD, ID_, n + 3); LD_X(XB, n + 3); if (n + 5 < N) LD_I16(ID_, n + 5, 1); }
        FINISH_U(r, n + 1);
    }
#undef LD_I16
#undef LD_R8
#undef LD_X
#undef DOT8
#undef FINISH_U
}
__device__ __forceinline__ void phase_peer_w(const Args& a) {
    const int gt = blockIdx.x * NTHREADS + tid_opaque(), NGT = gridDim.x * NTHREADS;
    const int* idx_i = (const int*)(a.ws + WS_IDX); const float* gw_i = (const float*)(a.ws + WS_GW); const bf16_t* part = (const bf16_t*)(a.ws + WS_PART);
    const float* suv = (const float*)(a.ws + WS_SUV); const float* sx = (const float*)(a.ws + WS_SX);
    unsigned char* wq = a.ws + WS_WQ; float* sw = (float*)(a.ws + WS_SW);
    for (int i0 = 0; i0 < 4; i0 += 2) {
        unsigned pw[2][16]; int2 ex[2]; f32x2 gg[2]; float sxt[2];
#pragma unroll
        for (int i = 0; i < 2; ++i) { const int item = gt + (i0 + i) * NGT; const int t = item >> 6, e = (item & 63) * 2;
#pragma unroll
            for (int s = 0; s < 16; ++s) pw[i][s] = *(const unsigned*)(part + ((size_t)t * 16 + s) * NE + e);
            ex[i] = *(const int2*)(idx_i + (size_t)t * NE + e); gg[i] = *(const f32x2*)(gw_i + (size_t)t * NE + e); sxt[i] = sx[t]; }
        float su0[2], su1[2], sv0[2], sv1[2];
#pragma unroll
        for (int i = 0; i < 2; ++i) { su0[i] = suv[ex[i].x]; su1[i] = suv[ex[i].y]; sv0[i] = suv[NEXP + ex[i].x]; sv1[i] = suv[NEXP + ex[i].y]; }
#pragma unroll
        for (int i = 0; i < 2; ++i) { const int item = gt + (i0 + i) * NGT; const int t = item >> 6, e = (item & 63) * 2;
            float sum0 = 0.f, sum1 = 0.f;
#pragma unroll
            for (int s = 0; s < 16; ++s) { sum0 += bf_lo(pw[i][s]); sum1 += bf_hi(pw[i][s]); }
            const float d0 = sum0 * su0[i] * sxt[i], d1 = sum1 * su1[i] * sxt[i];
            const float om0 = 0.5f * d0 * (1.f + erff(d0 * 0.70710678118654752f)) * gg[i].x * sv0[i];
            const float om1 = 0.5f * d1 * (1.f + erff(d1 * 0.70710678118654752f)) * gg[i].y * sv1[i];
            float mx = fmaxf(fabsf(om0), fabsf(om1));
            mx = fmaxf(mx, sx_f(mx, 1)); mx = fmaxf(mx, sx_f(mx, 2)); mx = fmaxf(mx, sx_f(mx, 4));
            const float qs = mx > 0.f ? 127.f / mx : 1.f;
            const int q0 = (int)__builtin_rintf(om0 * qs), q1 = (int)__builtin_rintf(om1 * qs);
            *(unsigned short*)(wq + (size_t)t * NE + e) = (unsigned short)(((unsigned)q0 & 0xffu) | (((unsigned)q1 & 0xffu) << 8));
            if ((e & 15) == 0) sw[t * 8 + (e >> 4)] = mx * (1.f / 127.f);
        }
    }
}
__device__ __forceinline__ void phase_peer_v(const Args& a, float* dst) {
    const int tid = tid_opaque(), lane = tid & 63, wave = tid >> 6, g = lane >> 3, c = lane & 7;
    const int xl = blockIdx.x & 7, wv = (blockIdx.x >> 3) * NWAVES + wave; constexpr int NWX = (GRID_WGS >> 3) * NWAVES, KT = T / NWX, N = 2 * KT;
    const unsigned char* v8 = a.ws + WS_V8;
    const unsigned short* idx16 = (const unsigned short*)(a.ws + WS_IDX16); const unsigned char* wq = a.ws + WS_WQ; const float* sw = (const float*)(a.ws + WS_SW);
    const bf16_t* hsrc = (const bf16_t*)(a.ws + WS_HB);
#define LD_W(W, SWV, HV, n) do { W = *(const u32x4*)(wq + (size_t)ITEM_T(n) * NE + g * 16); SWV = sw[ITEM_T(n) * 8 + g]; HV = *(const unsigned*)(hsrc + (size_t)ITEM_T(n) * DM + ITEM_S(n) * 128 + 2 * lane); } while (0)
#define QUAD(A_, B_, C_, D_, W_, A0, A1, A2, A3) do { \
        const unsigned ablo_ = __builtin_amdgcn_perm(B_, A_, 0x05010400u), abhi_ = __builtin_amdgcn_perm(B_, A_, 0x07030602u); \
        const unsigned cdlo_ = __builtin_amdgcn_perm(D_, C_, 0x05010400u), cdhi_ = __builtin_amdgcn_perm(D_, C_, 0x07030602u); \
        A0 = __builtin_amdgcn_sdot4((int)__builtin_amdgcn_perm(cdlo_, ablo_, 0x05040100u), (int)(W_), A0, false); \
        A1 = __builtin_amdgcn_sdot4((int)__builtin_amdgcn_perm(cdlo_, ablo_, 0x07060302u), (int)(W_), A1, false); \
        A2 = __builtin_amdgcn_sdot4((int)__builtin_amdgcn_perm(cdhi_, abhi_, 0x05040100u), (int)(W_), A2, false); \
        A3 = __builtin_amdgcn_sdot4((int)__builtin_amdgcn_perm(cdhi_, abhi_, 0x07060302u), (int)(W_), A3, false); } while (0)
#define COMPUTE_V(Q, W, SWV, HV, n) do { int ac[16]; _Pragma("unroll") for (int k = 0; k < 16; ++k) ac[k] = 0; \
        _Pragma("unroll") for (int q_ = 0; q_ < 4; ++q_) { const unsigned w_ = q_ == 0 ? W.x : q_ == 1 ? W.y : q_ == 2 ? W.z : W.w; \
            QUAD(Q[4 * q_].x, Q[4 * q_ + 1].x, Q[4 * q_ + 2].x, Q[4 * q_ + 3].x, w_, ac[0], ac[1], ac[2], ac[3]); \
            QUAD(Q[4 * q_].y, Q[4 * q_ + 1].y, Q[4 * q_ + 2].y, Q[4 * q_ + 3].y, w_, ac[4], ac[5], ac[6], ac[7]); \
            QUAD(Q[4 * q_].z, Q[4 * q_ + 1].z, Q[4 * q_ + 2].z, Q[4 * q_ + 3].z, w_, ac[8], ac[9], ac[10], ac[11]); \
            QUAD(Q[4 * q_].w, Q[4 * q_ + 1].w, Q[4 * q_ + 2].w, Q[4 * q_ + 3].w, w_, ac[12], ac[13], ac[14], ac[15]); } \
        float p[16]; _Pragma("unroll") for (int k = 0; k < 16; ++k) p[k] = (float)ac[k] * SWV; \
        float p8[8], p4[4], p2[2]; \
        _Pragma("unroll") for (int i_ = 0; i_ < 8; ++i_) { auto rr_ = __builtin_amdgcn_permlane32_swap(__float_as_uint(p[i_]), __float_as_uint(p[8 + i_]), false, false); p8[i_] = __uint_as_float(rr_[0]) + __uint_as_float(rr_[1]); } \
        _Pragma("unroll") for (int i_ = 0; i_ < 4; ++i_) { auto rr_ = __builtin_amdgcn_permlane16_swap(__float_as_uint(p8[i_]), __float_as_uint(p8[4 + i_]), false, false); p4[i_] = __uint_as_float(rr_[0]) + __uint_as_float(rr_[1]); } \
        HALVE(p2, p4, 2, 8); \
        const int srcl_ = ((lane & 7) << 3) | (lane >> 3);                     \
        const float q0_ = sh_f(p2[0], srcl_), q1_ = sh_f(p2[1], srcl_); \
        const size_t o_ = (size_t)ITEM_T(n) * DM + ITEM_S(n) * 128 + 2 * lane; \
        __builtin_nontemporal_store((f32x2){bf_lo(HV) + q0_, bf_hi(HV) + q1_}, (f32x2*)(dst + o_)); } while (0)
    u32x4 IA[2], IB[2]; u32x4 QA[16], QB[16], WA, WB; float SA, SB_; unsigned HA, HB_;
    LD_IDX(IA, 0); LD_IDX(IB, 1);
    LD_ROWS(QA, IA, v8, 0); LD_W(WA, SA, HA, 0);
    for (int n = 0; n < N; n += 2) {
        LD_ROWS(QB, IB, v8, n + 1); LD_W(WB, SB_, HB_, n + 1);
        if (n + 2 < N) LD_IDX(IA, n + 2);
        COMPUTE_V(QA, WA, SA, HA, n);
        if (n + 2 < N) { LD_ROWS(QA, IA, v8, n + 2); LD_W(WA, SA, HA, n + 2); }
        if (n + 3 < N) LD_IDX(IB, n + 3);
        COMPUTE_V(QB, WB, SB_, HB_, n + 1);
    }
#undef LD_W
#undef QUAD
#undef COMPUTE_V
}
#undef ITEM_T
#undef ITEM_S
#undef LD_IDX
#undef LD_ROWS
#undef HALVE


constexpr int NPHASE = 11;
#define LOAD_ARGS() do { } while (0)
__global__ void __launch_bounds__(NTHREADS, 2) fwd_kernel(Args a) {
    extern __shared__ __attribute__((aligned(16))) unsigned char lds[];
#if MK_ONE_LAUNCH
    constexpr int lo = 0, hi = NPHASE;
    cg::grid_group grid = cg::this_grid();
    volatile LAS unsigned* misc = (volatile LAS unsigned*)((LAS unsigned char*)lds + MISC_OFF);
    if (threadIdx.x < 16) misc[threadIdx.x] = 0u;
    __syncthreads();
    { LOAD_ARGS(); (void)xcd_barrier_post((unsigned*)(a.ws + WS_CTL) + CW_BAR, misc + 8); }
#ifndef SEAM_CG_MASK
#define SEAM_CG_MASK 0
#endif
#define SEAM(k) do { if (lo <= (k) && (k) + 1 < hi) { if ((SEAM_CG_MASK >> (k)) & 1) grid.sync(); else { LOAD_ARGS(); XcdBarrier xb_; xb_.bar = (unsigned*)(a.ws + WS_CTL) + CW_BAR; xb_.x = xb_xcc_id(); \
        xb_.st = (volatile LAS unsigned*)((LAS unsigned char*)lds + MISC_OFF) + 8; xcd_barrier(xb_); } } } while (0)
#else
    int lo, hi; { LOAD_ARGS(); lo = a.ph_lo; hi = a.ph_hi; }
#define SEAM(k) do { } while (0)
#endif
#define SEAM_T(k, j) do { if (lo <= (k) && (k) + 1 < hi) { XcdBarrier xb_; xb_.bar = (unsigned*)(a.ws + WS_CTL) + CW_BAR; xb_.x = xb_xcc_id(); \
        xb_.st = (volatile LAS unsigned*)((LAS unsigned char*)lds + MISC_OFF) + 8; \
        xcd_barrier(xb_, &a, TAB_BAR0 + (j) * TAB_BAR_STEP, (TAB_BAR0 + ((j) + 1) * TAB_BAR_STEP) < 2 * NEXP ? (TAB_BAR0 + ((j) + 1) * TAB_BAR_STEP) : 2 * NEXP, \
                    (k) == 6 ? a.ws + WS_U8 + (size_t)((int)blockIdx.x & 7) * ((size_t)NEXP * 128) + (size_t)((int)blockIdx.x >> 3) * 65536 : (const unsigned char*)nullptr); } } while (0)
#define IN(k) (lo <= (k) && (k) < hi)
#ifndef DUP_PHASE
#define DUP_PHASE -1
#endif
    if (IN(0)) { LOAD_ARGS(); phase0(a, lds); if (DUP_PHASE == 0) { __syncthreads(); phase0(a, lds); } SEAM_T(0, 0); }
    if (IN(1)) { LOAD_ARGS(); unsigned char* ws = a.ws;
        pg8::Gemm g{(const bf16_t*)(ws + WS_XN), (const bf16_t*)(ws + WS_WIN), T, NPROJ, DM}; pg8::StaticOrder S; S.init(T, NPROJ, (int)gridDim.x, (int)blockIdx.x); S.extra_first = true;
        cumsum_rows(a);
        { const int nwg_ = (T / 256) * (NPROJ / 256), G_ = (int)gridDim.x, rem_ = nwg_ % G_;
          if (rem_ > 0 && (int)blockIdx.x >= rem_) {
              const int w_ = ((int)blockIdx.x - rem_) * NWAVES + (tid_opaque() >> 6), first_ = (G_ - rem_ - 16) * NWAVES, nw_ = (G_ - rem_) * NWAVES - 16;
              const bool excl_ = w_ >= first_ && ((w_ - first_) & (NWAVES - 1)) == 0;
              const int wk_ = w_ < first_ ? w_ : w_ - ((w_ - first_) / NWAVES + 1);
              if (!excl_) convert_tables(a, TAB_SPLIT, TAB_ATT0, wk_, nw_); }
          else if (rem_ == 0) convert_tables(a, TAB_SPLIT, TAB_ATT0, (int)blockIdx.x * NWAVES + (tid_opaque() >> 6), G_ * NWAVES); }
        __syncthreads();
        pg8::EpiInProj E{(bf16_t*)(ws + WS_SEC), (const float*)(ws + WS_SXN), (const float*)(ws + WS_WSC), a.in[4], a.in[5], (LAS float*)((LAS unsigned char*)lds + RING_BYTES)};
        for (int rep_ = 0; rep_ < (DUP_PHASE == 1 ? 2 : 1); ++rep_)
        pg8::gemm_phase<pg8::EpiInProj, pg8::StaticOrder, true, true, true>((LAS unsigned char*)lds, g, S, E);
        SEAM_T(1, 1);
    }
    if (IN(3)) { LOAD_ARGS(); phase_attn(a, lds);
#if MK_ONE_LAUNCH
        if (DUP_PHASE == 3) { XcdBarrier xb_; xb_.bar = (unsigned*)(a.ws + WS_CTL) + CW_BAR; xb_.x = xb_xcc_id(); xb_.st = (volatile LAS unsigned*)((LAS unsigned char*)lds + MISC_OFF) + 8;
            xcd_barrier(xb_); if (blockIdx.x == 0 && threadIdx.x == 0) __hip_atomic_store((unsigned*)(a.ws + WS_CTL), 0u, __ATOMIC_RELAXED, __HIP_MEMORY_SCOPE_AGENT); xcd_barrier(xb_); phase_attn(a, lds); }
#endif
        SEAM_T(3, 2); }
    if (IN(5)) { LOAD_ARGS(); unsigned char* ws = a.ws;
        pg8::Gemm g{(const bf16_t*)(ws + WS_MIX), (const bf16_t*)(ws + WS_WOUT), T, DM, DM}; pg8::StaticOrder S; S.init(T, DM, (int)gridDim.x, (int)blockIdx.x);
        pg8::EpiOutProj E{a.in[0], a.out, (bf16_t*)(ws + WS_HB), (float*)(ws + WS_SSQ), (float*)(ws + WS_AMX)};
        for (int rep_ = 0; rep_ < (DUP_PHASE == 5 ? 2 : 1); ++rep_)
        pg8::gemm_phase<pg8::EpiOutProj, pg8::StaticOrder, true, true>((LAS unsigned char*)lds, g, S, E);
        SEAM_T(5, 3);
    }
    if (IN(6)) { LOAD_ARGS(); unsigned char* ws = a.ws;
        pg8::Gemm g{(const bf16_t*)(ws + WS_HB), (const bf16_t*)(ws + WS_WPQ), T, DM, DM}; pg8::StaticOrder S; S.init(T, DM, (int)gridDim.x, (int)blockIdx.x);
        pg8::EpiPeerQFused E{(const float*)(ws + WS_SSQ), ws};
        pg8::gemm_phase<pg8::EpiPeerQFused, pg8::StaticOrder, true, true>((LAS unsigned char*)lds, g, S, E);
        SEAM_T(6, 4);
    }
    if (IN(8)) { LOAD_ARGS(); for (int rep_ = 0; rep_ < (DUP_PHASE == 8 ? 2 : 1); ++rep_) phase_peer_u(a); SEAM(8); }
    if (IN(9)) { LOAD_ARGS(); for (int rep_ = 0; rep_ < (DUP_PHASE == 9 ? 2 : 1); ++rep_) phase_peer_w(a);
        if (lo <= 9 && 10 < hi) { XcdBarrier xb_; xb_.bar = (unsigned*)(a.ws + WS_CTL) + CW_BAR; xb_.x = xb_xcc_id(); xb_.st = (volatile LAS unsigned*)((LAS unsigned char*)lds + MISC_OFF) + 8;
            xcd_barrier(xb_, nullptr, 0, 0, a.ws + WS_V8 + (size_t)((int)blockIdx.x & 7) * ((size_t)NEXP * 128) + (size_t)((int)blockIdx.x >> 3) * 65536); } }
    if (IN(10)) { LOAD_ARGS(); for (int rep_ = 0; rep_ < (DUP_PHASE == 10 ? 2 : 1); ++rep_) phase_peer_v(a, (DUP_PHASE == 10 && rep_ == 0) ? (float*)(a.ws + WS_END) : a.out); }
#undef IN
#undef SEAM
}

extern "C" void kernel_launch(void* const* d_in, const int* in_sizes, int n_in, void* d_out, int out_size, void* d_ws, size_t ws_size, hipStream_t stream) {
    static int grid = 0;
    if (grid == 0) {
        if (n_in != 12 || in_sizes[0] != T * DM || out_size != T * DM || ws_size < WS_END) { fprintf(stderr, "kernel_launch: unexpected shapes (n_in %d, in0 %d, out %d, ws %zu)\n", n_in, n_in > 0 ? in_sizes[0] : -1, out_size, ws_size); grid = -1; return; }
        int dev = 0, cus = 0, per_cu = 0;
        if (hipGetDevice(&dev) != hipSuccess || hipDeviceGetAttribute(&cus, hipDeviceAttributeMultiprocessorCount, dev) != hipSuccess) { grid = -1; return; }
        if (hipFuncSetAttribute((const void*)fwd_kernel, hipFuncAttributeMaxDynamicSharedMemorySize, LDS_BYTES) != hipSuccess) { fprintf(stderr, "kernel_launch: hipFuncSetAttribute failed\n"); grid = -1; return; }
        if (hipOccupancyMaxActiveBlocksPerMultiprocessor(&per_cu, (const void*)fwd_kernel, NTHREADS, LDS_BYTES) != hipSuccess || per_cu < 1) { fprintf(stderr, "kernel_launch: occupancy query says %d\n", per_cu); grid = -1; return; }
        grid = cus;
        if (grid != GRID_WGS) { fprintf(stderr, "kernel_launch: built for %d CUs, device has %d\n", GRID_WGS, cus); grid = -1; return; }
    }
    if (grid < 0) return;
    (void)hipMemsetAsync((char*)d_ws + WS_CTL, 0, CTL_BYTES, stream);
    Args a{};
    for (int i = 0; i < 12; ++i) a.in[i] = (const float*)d_in[i];
    a.out = (float*)d_out; a.ws = (unsigned char*)d_ws;
#if MK_ONE_LAUNCH
    a.ph_lo = 0; a.ph_hi = NPHASE;
    void* args[] = {&a};
#if MK_COOP_LAUNCH
    hipError_t e = hipLaunchCooperativeKernel((const void*)fwd_kernel, dim3(grid), dim3(NTHREADS), args, LDS_BYTES, stream);
    if (e != hipSuccess) fprintf(stderr, "cooperative launch failed: %s (grid %d)\n", hipGetErrorString(e), grid);
#else
    (void)args; hipLaunchKernelGGL(fwd_kernel, dim3(grid), dim3(NTHREADS), LDS_BYTES, stream, a);
#endif
#else
    for (int p = 0; p < NPHASE; ++p) { a.ph_lo = p; a.ph_hi = p + 1; hipLaunchKernelGGL(fwd_kernel, dim3(grid), dim3(NTHREADS), LDS_BYTES, stream, a); }
#endif
}
```
